# Optimizing an MI355X kernel written in HIP

```python
import math
import jax, jax.numpy as jnp
from jax import lax
import numpy as np

D_MODEL = 1024
BATCH = 4
SEQ = 4096
DEPTH = 2

MIX_WIDTH = D_MODEL
RWKV_WIDTH = MIX_WIDTH // 2
HEAD_SIZE = 64
RWKV_HEADS = RWKV_WIDTH // HEAD_SIZE
DECAY_LORA = 64
AAA_LORA = 64
MV_LORA = 32
GATE_LORA = 128
RWKV_COLS = 3 * RWKV_WIDTH + DECAY_LORA + AAA_LORA + GATE_LORA
POOL_WIDTH = MIX_WIDTH - RWKV_WIDTH
POOL_WINDOWS = (2, 4, 8, 16)
POOL_GROUP = POOL_WIDTH // len(POOL_WINDOWS)
IN_COLS = RWKV_COLS + POOL_WIDTH
GN_EPS = 64e-5
NORM_EPS = 1e-6
N_KEYS = 128
N_EXPERTS = N_KEYS * N_KEYS
PEER_HEADS = 8
PEER_QDIM = 256
PEER_HALF = PEER_QDIM // 2
PEER_TOPK = 16
TOK_BLOCK = 128

kernel_name = "hybrid_rwkv7_pool_peer_adaln"


def rmsnorm(x, g):
    x32 = x.astype(jnp.float32)
    y = x32 * lax.rsqrt(jnp.mean(x32 * x32, axis=-1, keepdims=True) + NORM_EPS)
    return (y * g.astype(jnp.float32)).astype(x.dtype)


def modulate(h, shift, scale):
    return h * (1 + scale[:, None, :]) + shift[:, None, :]


def token_shift(z, mu):
    prev = jnp.pad(z, ((0, 0), (1, 0), (0, 0)))[:, :-1]
    return z + (prev - z) * mu


def rwkv7_step(state, inp):
    r_t, w_t, k_t, v_t, kk_t, a_t = inp
    sa = jnp.einsum('bhvk,bhk->bhv', state, -kk_t)
    state = (state * w_t[:, :, None, :]
             + sa[..., None] * (kk_t * a_t)[:, :, None, :]
             + v_t[..., None] * k_t[:, :, None, :])
    y = jnp.einsum('bhvk,bhk->bhv', state, r_t)
    return state, y


def rwkv7_mix(r, k, v, wd, ad, gd, w0, w_up, a0, a_up, g_up, k_k, k_a, r_k, lnx_g, lnx_b):
    B, S, _ = r.shape
    f32 = jnp.float32
    w = -jax.nn.softplus(-(w0 + jnp.tanh(wd) @ w_up)) - 0.5
    decay = jnp.exp(-jnp.exp(w.astype(f32)))
    a = jax.nn.sigmoid(a0 + ad @ a_up)
    g = jax.nn.sigmoid(gd) @ g_up

    def heads(t):
        return t.reshape(B, S, RWKV_HEADS, HEAD_SIZE).astype(f32)

    kk = heads(k * k_k)
    kk = kk / jnp.maximum(jnp.sqrt(jnp.sum(kk * kk, axis=-1, keepdims=True)), 1e-12)
    k = k * (1 + (a - 1) * k_a)
    rh, kh, vh, ah, wh = heads(r), heads(k), heads(v), heads(a), heads(decay)
    tm = lambda t: jnp.moveaxis(t, 1, 0)
    s0 = jnp.zeros((B, RWKV_HEADS, HEAD_SIZE, HEAD_SIZE), f32)
    _, ys = lax.scan(rwkv7_step, s0, (tm(rh), tm(wh), tm(kh), tm(vh), tm(kk), tm(ah)))
    y = jnp.moveaxis(ys, 0, 1)
    mean = jnp.mean(y, axis=-1, keepdims=True)
    var = jnp.mean(jnp.square(y - mean), axis=-1, keepdims=True)
    yn = ((y - mean) * lax.rsqrt(var + GN_EPS)).reshape(B, S, RWKV_WIDTH)
    yn = yn * lnx_g.astype(f32) + lnx_b.astype(f32)
    bonus = jnp.sum(rh * kh * r_k.astype(f32), axis=-1, keepdims=True) * vh
    out = (yn + bonus.reshape(B, S, RWKV_WIDTH)) * g.astype(f32)
    return out.astype(r.dtype)


def multiscale_pool(p, pool_w, pool_scale):
    B, S, _ = p.shape
    f32 = jnp.float32
    p32 = p.astype(f32)
    cs = jnp.cumsum(p32, axis=1)
    pos = jnp.arange(1, S + 1, dtype=f32)
    groups = []
    for j, win in enumerate(POOL_WINDOWS):
        sl = slice(j * POOL_GROUP, (j + 1) * POOL_GROUP)
        csj = cs[..., sl]
        lag = jnp.pad(csj, ((0, 0), (win, 0), (0, 0)))[:, :S]
        mean = (csj - lag) / jnp.minimum(pos, float(win))[None, :, None]
        groups.append(mean - p32[..., sl])
    d = jnp.stack(groups, axis=2)
    out = jnp.einsum('bsgc,gcd->bsgd', d, pool_w.astype(f32)).reshape(B, S, POOL_WIDTH)
    return (out * pool_scale.astype(f32)).astype(p.dtype)


def peer_ffn(h, peer_q, peer_keys, peer_u, peer_v):
    B, S, D = h.shape
    q = (h @ peer_q).reshape(B, S, PEER_HEADS, 2, PEER_HALF)
    scores = jnp.einsum('bshpd,hpkd->bshpk', q, peer_keys)
    s, i = lax.top_k(scores, PEER_TOPK)
    cand_s = (s[..., 0, :, None] + s[..., 1, None, :]).reshape(B, S, PEER_HEADS, PEER_TOPK * PEER_TOPK)
    cand_i = (i[..., 0, :, None] * N_KEYS + i[..., 1, None, :]).reshape(B, S, PEER_HEADS, PEER_TOPK * PEER_TOPK)
    top_s, sel = lax.top_k(cand_s, PEER_TOPK)
    idx = jnp.take_along_axis(cand_i, sel, axis=-1)
    gate = jax.nn.softmax(top_s.astype(jnp.float32), axis=-1)
    T = B * S
    E = PEER_HEADS * PEER_TOPK
    nb = T // TOK_BLOCK
    hb = h.reshape(nb, TOK_BLOCK, D)
    ib = idx.reshape(nb, TOK_BLOCK, E)
    gb = gate.astype(h.dtype).reshape(nb, TOK_BLOCK, E)

    def block(args):
        hx, ix, gx = args
        u_sel = jnp.take(peer_u, ix, axis=0)
        v_sel = jnp.take(peer_v, ix, axis=0)
        act = jax.nn.gelu(jnp.einsum('td,ted->te', hx, u_sel), approximate=False)
        return jnp.einsum('te,ted->td', gx * act, v_sel)

    out = lax.map(block, (hb, ib, gb))
    return out.reshape(B, S, D)


def setup_inputs(seed: int = 0) -> dict:
    key = jax.random.key(seed)
    ks = jax.random.split(key, 32)
    nrm = lambda k, shape, s: jax.random.normal(k, shape, jnp.float32) * s
    L, Lr = DEPTH, DEPTH - 1
    return {
        "x": nrm(ks[0], (BATCH, SEQ, D_MODEL), 1.0),
        "c": nrm(ks[1], (BATCH, D_MODEL), 1.0),
        "ada_w": nrm(ks[2], (L, D_MODEL, 6 * D_MODEL), 0.5 * D_MODEL ** -0.5),
        "ada_b": nrm(ks[3], (L, 6 * D_MODEL), 0.01),
        "ln1_g": 1.0 + nrm(ks[4], (L, D_MODEL), 0.01),
        "w_in": nrm(ks[5], (L, D_MODEL, IN_COLS), D_MODEL ** -0.5),
        "mu_shift": jax.random.uniform(ks[6], (L, RWKV_COLS), jnp.float32),
        "w0": nrm(ks[7], (L, RWKV_WIDTH), 0.5),
        "w_up": nrm(ks[8], (L, DECAY_LORA, RWKV_WIDTH), 0.1 * DECAY_LORA ** -0.5),
        "a0": nrm(ks[9], (L, RWKV_WIDTH), 0.1),
        "a_up": nrm(ks[10], (L, AAA_LORA, RWKV_WIDTH), 0.1 * AAA_LORA ** -0.5),
        "g_up": nrm(ks[11], (L, GATE_LORA, RWKV_WIDTH), GATE_LORA ** -0.5),
        "vres_down": nrm(ks[12], (Lr, D_MODEL, MV_LORA), D_MODEL ** -0.5),
        "vres_mu": jax.random.uniform(ks[13], (Lr, MV_LORA), jnp.float32),
        "vres_v0": 1.0 + nrm(ks[14], (Lr, RWKV_WIDTH), 0.1),
        "vres_up": nrm(ks[15], (Lr, MV_LORA, RWKV_WIDTH), 0.1 * MV_LORA ** -0.5),
        "k_k": 0.85 + nrm(ks[16], (L, RWKV_WIDTH), 0.02),
        "k_a": 1.0 + nrm(ks[17], (L, RWKV_WIDTH), 0.02),
        "r_k": -0.04 + nrm(ks[18], (L, RWKV_HEADS, HEAD_SIZE), 0.02),
        "lnx_g": 1.0 + nrm(ks[19], (L, RWKV_WIDTH), 0.01),
        "lnx_b": nrm(ks[20], (L, RWKV_WIDTH), 0.01),
        "pool_w": nrm(ks[21], (L, len(POOL_WINDOWS), POOL_GROUP, POOL_GROUP), POOL_GROUP ** -0.5),
        "pool_scale": 1.0 + nrm(ks[22], (L, POOL_WIDTH), 0.01),
        "w_out": nrm(ks[23], (L, MIX_WIDTH, D_MODEL), MIX_WIDTH ** -0.5),
        "ln2_g": 1.0 + nrm(ks[24], (L, D_MODEL), 0.01),
        "peer_q": nrm(ks[25], (L, D_MODEL, PEER_HEADS * PEER_QDIM), D_MODEL ** -0.5),
        "peer_keys": nrm(ks[26], (L, PEER_HEADS, 2, N_KEYS, PEER_HALF), PEER_HALF ** -0.5),
        "peer_u": nrm(ks[27], (L, N_EXPERTS, D_MODEL), D_MODEL ** -0.5),
        "peer_v": nrm(ks[28], (L, N_EXPERTS, D_MODEL), PEER_HEADS ** -0.5),
        "lnf_g": 1.0 + nrm(ks[29], (D_MODEL,), 0.01),
    }


def reference(x, c, ada_w, ada_b, ln1_g, w_in, mu_shift, w0, w_up, a0, a_up, g_up,
              vres_down, vres_mu, vres_v0, vres_up, k_k, k_a, r_k, lnx_g, lnx_b,
              pool_w, pool_scale, w_out, ln2_g, peer_q, peer_keys, peer_u, peer_v, lnf_g):
    split_pts = [RWKV_WIDTH, 2 * RWKV_WIDTH, 3 * RWKV_WIDTH,
                 3 * RWKV_WIDTH + DECAY_LORA, 3 * RWKV_WIDTH + DECAY_LORA + AAA_LORA]
    c_act = jax.nn.silu(c)
    v_first = None
    for l in range(DEPTH):
        mod = c_act @ ada_w[l] + ada_b[l]
        sh1, sc1, g1, sh2, sc2, g2 = jnp.split(mod, 6, axis=-1)

        h = modulate(rmsnorm(x, ln1_g[l]), sh1, sc1)
        w_full = w_in[l] if l == 0 else jnp.concatenate([w_in[l], vres_down[l - 1]], axis=1)
        proj = h @ w_full
        rw = token_shift(proj[..., :RWKV_COLS], mu_shift[l])
        r, k, v, wd, ad, gd = jnp.split(rw, split_pts, axis=-1)
        pool_in = proj[..., RWKV_COLS:RWKV_COLS + POOL_WIDTH]
        if l == 0:
            v_first = v
        else:
            vd = token_shift(proj[..., RWKV_COLS + POOL_WIDTH:], vres_mu[l - 1])
            v = v + (v_first - v) * jax.nn.sigmoid(vres_v0[l - 1] + vd @ vres_up[l - 1])
        y_rwkv = rwkv7_mix(r, k, v, wd, ad, gd, w0[l], w_up[l], a0[l], a_up[l], g_up[l],
                           k_k[l], k_a[l], r_k[l], lnx_g[l], lnx_b[l])
        y_pool = multiscale_pool(pool_in, pool_w[l], pool_scale[l])
        mix = jnp.concatenate([y_rwkv, y_pool], axis=-1) @ w_out[l]
        x = x + g1[:, None, :] * mix

        h2 = modulate(rmsnorm(x, ln2_g[l]), sh2, sc2)
        x = x + g2[:, None, :] * peer_ffn(h2, peer_q[l], peer_keys[l], peer_u[l], peer_v[l])
    return rmsnorm(x, lnf_g)
```

```cpp
#include <hip/hip_runtime.h>
#include <cstdio>
#include <cstdint>
#include <cmath>

constexpr int D = 1024, BATCH = 4, SEQ = 4096, T = BATCH * SEQ, DEPTH = 2;
constexpr int RW = 512, HS = 64, NH = 8;
constexpr int DL = 64, AL = 64, MVL = 32, GL = 128;
constexpr int RWKV_COLS = 3 * RW + DL + AL + GL;
constexpr int PW = 512, PG = 128;
constexpr int IN_COLS = RWKV_COLS + PW;
constexpr int LDP = 2560;
constexpr int NKEYS = 128, NEXP = NKEYS * NKEYS, PH = 8, PQ = 256, PHALF = 128, TOPK = 16;
constexpr int NE = PH * TOPK;
constexpr float NORM_EPS = 1e-6f, GN_EPS = 64e-5f;

typedef unsigned short bf16;
__device__ __forceinline__ float bf2f(bf16 u) { return __uint_as_float((unsigned)u << 16); }
__device__ __forceinline__ bf16 f2bf(float f) { unsigned u = __float_as_uint(f); return (bf16)((u + 0x7fffu + ((u >> 16) & 1u)) >> 16); }

constexpr size_t MiB = 1u << 20;
constexpr size_t WS_MOD = 1 * MiB;
constexpr size_t WS_H = 2 * MiB;
constexpr size_t WS_PROJ = 34 * MiB;
constexpr size_t WS_Q = WS_PROJ;
constexpr size_t WS_R = 114 * MiB;
constexpr size_t WS_K = 130 * MiB;
constexpr size_t WS_V0 = 146 * MiB;
constexpr size_t WS_V1 = 162 * MiB;
constexpr size_t WS_KK = 178 * MiB;
constexpr size_t WS_B = 194 * MiB;
constexpr size_t WS_G = 210 * MiB;
constexpr size_t WS_BG = 226 * MiB;
constexpr size_t WS_W = 242 * MiB;
constexpr size_t WS_Y = 274 * MiB;
constexpr size_t WS_MIX = 306 * MiB;
constexpr size_t WS_IDX = 338 * MiB;
constexpr size_t WS_GATE = 346 * MiB;
constexpr size_t WS_END = 354 * MiB;

__device__ __forceinline__ float wave_sum(float v) {
#pragma unroll
    for (int o = 1; o < 64; o <<= 1) v += __shfl_xor(v, o);
    return v;
}
__device__ __forceinline__ float sigmoidf_(float x) { return 1.f / (1.f + expf(-x)); }

__global__ void __launch_bounds__(256) k_mod(const float* __restrict__ c, const float* __restrict__ ada_w, const float* __restrict__ ada_b, float* __restrict__ mod) {
    __shared__ float ca[BATCH][D];
    const int l = blockIdx.y, n = blockIdx.x * 256 + threadIdx.x;
    for (int i = threadIdx.x; i < BATCH * D; i += 256) { float v = c[i]; ca[i / D][i % D] = v / (1.f + expf(-v)); }
    __syncthreads();
    float a0 = 0, a1 = 0, a2 = 0, a3 = 0;
    const float* w = ada_w + (size_t)l * D * 6 * D + n;
    for (int k = 0; k < D; ++k) { float wv = w[(size_t)k * 6 * D]; a0 += ca[0][k] * wv; a1 += ca[1][k] * wv; a2 += ca[2][k] * wv; a3 += ca[3][k] * wv; }
    const float bb = ada_b[l * 6 * D + n];
    float* m = mod + (size_t)l * BATCH * 6 * D + n;
    m[0] = a0 + bb; m[6 * D] = a1 + bb; m[2 * 6 * D] = a2 + bb; m[3 * 6 * D] = a3 + bb;
}

__global__ void __launch_bounds__(256) k_norm_mod(const float* __restrict__ x, const float* __restrict__ gamma, const float* __restrict__ modl, int seg_shift, int seg_scale, bf16* __restrict__ H) {
    const int row = blockIdx.x * 4 + (threadIdx.x >> 6), lane = threadIdx.x & 63, b = row / SEQ;
    const float* xr = x + (size_t)row * D;
    float v[16]; float ss = 0.f;
#pragma unroll
    for (int j = 0; j < 4; ++j) { float4 q = *(const float4*)(xr + j * 256 + lane * 4); v[4 * j] = q.x; v[4 * j + 1] = q.y; v[4 * j + 2] = q.z; v[4 * j + 3] = q.w; ss += q.x * q.x + q.y * q.y + q.z * q.z + q.w * q.w; }
    const float rs = rsqrtf(wave_sum(ss) * (1.f / D) + NORM_EPS);
    const float* sh = modl + (size_t)b * 6 * D + seg_shift * D; const float* sc = modl + (size_t)b * 6 * D + seg_scale * D;
#pragma unroll
    for (int j = 0; j < 4; ++j)
#pragma unroll
        for (int i = 0; i < 4; ++i) { const int d = j * 256 + lane * 4 + i; const float y = v[4 * j + i] * rs * gamma[d]; H[(size_t)row * D + d] = f2bf(y * (1.f + sc[d]) + sh[d]); }
}

template <int MODE>
__global__ void __launch_bounds__(256) k_gemm(const bf16* __restrict__ A, int lda, const float* __restrict__ W, int ldw, int N, int K, bf16* __restrict__ O, int ldo, int ocol0,
                                               const float* xold, float* X, const float* __restrict__ modl, int seg_gate) {
    __shared__ float As[8][128 + 4]; __shared__ float Bs[8][128 + 4];
    const int tid = threadIdx.x, tx = tid & 15, ty = tid >> 4, m0 = blockIdx.y * 128, n0 = blockIdx.x * 128;
    float acc[8][8];
#pragma unroll
    for (int i = 0; i < 8; ++i)
#pragma unroll
        for (int j = 0; j < 8; ++j) acc[i][j] = 0.f;
    const int ar = tid >> 1, ak = (tid & 1) * 4; const int bk = tid >> 5, bc = (tid & 31) * 4;
    for (int k0 = 0; k0 < K; k0 += 8) {
        { const bf16* ap = A + (size_t)(m0 + ar) * lda + k0 + ak; ushort4 q = *(const ushort4*)ap; As[ak][ar] = bf2f(q.x); As[ak + 1][ar] = bf2f(q.y); As[ak + 2][ar] = bf2f(q.z); As[ak + 3][ar] = bf2f(q.w); }
        { const float* wp = W + (size_t)(k0 + bk) * ldw + n0 + bc;
#pragma unroll
          for (int i = 0; i < 4; ++i) Bs[bk][bc + i] = (n0 + bc + i < N) ? wp[i] : 0.f; }
        __syncthreads();
#pragma unroll
        for (int k = 0; k < 8; ++k) {
            float a[8], b[8];
#pragma unroll
            for (int i = 0; i < 8; ++i) { a[i] = As[k][ty * 8 + i]; b[i] = Bs[k][tx * 8 + i]; }
#pragma unroll
            for (int i = 0; i < 8; ++i)
#pragma unroll
                for (int j = 0; j < 8; ++j) acc[i][j] += a[i] * b[j];
        }
        __syncthreads();
    }
#pragma unroll
    for (int i = 0; i < 8; ++i) { const int m = m0 + ty * 8 + i;
#pragma unroll
        for (int j = 0; j < 8; ++j) { const int n = n0 + tx * 8 + j; if (n >= N) continue;
            if (MODE == 0) O[(size_t)m * ldo + ocol0 + n] = f2bf(acc[i][j]);
            else { const int b = m / SEQ; X[(size_t)m * D + n] = xold[(size_t)m * D + n] + modl[(size_t)b * 6 * D + seg_gate * D + n] * acc[i][j]; } } }
}

constexpr int TT = 8;
struct PrepW { const float *mu, *w0, *w_up, *a0, *a_up, *g_up, *vres_mu, *vres_v0, *vres_up, *k_k, *k_a, *r_k; };
__global__ void __launch_bounds__(512) k_prep(const bf16* __restrict__ PROJ, PrepW pw, int layer, const bf16* __restrict__ VF,
                                              bf16* __restrict__ R, bf16* __restrict__ Kb, bf16* __restrict__ V, bf16* __restrict__ KK, bf16* __restrict__ Bb, bf16* __restrict__ G, bf16* __restrict__ BG, float* __restrict__ Wd) {
    __shared__ float lin[TT][288];
    const int c = threadIdx.x, t0 = blockIdx.x * TT;
    for (int e = c; e < TT * 288; e += 512) {
        const int tok = e / 288, j = e % 288, t = t0 + tok, s = t % SEQ;
        const int col = j < 256 ? 3 * RW + j : IN_COLS + (j - 256);
        float val = 0.f;
        if (j < 256 || layer > 0) {
            const float cur = bf2f(PROJ[(size_t)t * LDP + col]); const float prev = s > 0 ? bf2f(PROJ[(size_t)(t - 1) * LDP + col]) : 0.f;
            const float mu = j < 256 ? pw.mu[col] : pw.vres_mu[j - 256];
            val = cur + (prev - cur) * mu;
            if (j < 64) val = tanhf(val); else if (j >= 128 && j < 256) val = sigmoidf_(val);
        }
        lin[tok][j] = val;
    }
    __syncthreads();
    float aw[TT], aa[TT], ag[TT], av[TT];
#pragma unroll
    for (int i = 0; i < TT; ++i) { aw[i] = 0.f; aa[i] = 0.f; ag[i] = 0.f; av[i] = 0.f; }
    for (int k = 0; k < 64; ++k) { const float w1 = pw.w_up[k * RW + c], w2 = pw.a_up[k * RW + c];
#pragma unroll
        for (int i = 0; i < TT; ++i) { aw[i] += lin[i][k] * w1; aa[i] += lin[i][64 + k] * w2; } }
    for (int k = 0; k < 128; ++k) { const float w3 = pw.g_up[k * RW + c];
#pragma unroll
        for (int i = 0; i < TT; ++i) ag[i] += lin[i][128 + k] * w3; }
    if (layer > 0) for (int k = 0; k < 32; ++k) { const float w4 = pw.vres_up[k * RW + c];
#pragma unroll
        for (int i = 0; i < TT; ++i) av[i] += lin[i][256 + k] * w4; }
    const float mur = pw.mu[c], muk = pw.mu[RW + c], muv = pw.mu[2 * RW + c];
    const float w0 = pw.w0[c], a0 = pw.a0[c], kkc = pw.k_k[c], kac = pw.k_a[c], rkc = pw.r_k[c];
    const float v0c = layer > 0 ? pw.vres_v0[c] : 0.f;
#pragma unroll
    for (int i = 0; i < TT; ++i) {
        const int t = t0 + i, s = t % SEQ; const size_t o = (size_t)t * RW + c;
        const bf16* pr = PROJ + (size_t)t * LDP; const bf16* pp = pr - LDP;
        float r = bf2f(pr[c]), k = bf2f(pr[RW + c]), v = bf2f(pr[2 * RW + c]);
        const float rp = s > 0 ? bf2f(pp[c]) : 0.f, kp = s > 0 ? bf2f(pp[RW + c]) : 0.f, vp = s > 0 ? bf2f(pp[2 * RW + c]) : 0.f;
        r += (rp - r) * mur; k += (kp - k) * muk; v += (vp - v) * muv;
        const float wpre = w0 + aw[i];
        const float z = -wpre; const float sp = fmaxf(z, 0.f) + log1pf(expf(-fabsf(z)));
        const float w = -sp - 0.5f; const float decay = expf(-expf(w));
        const float a = sigmoidf_(a0 + aa[i]); const float g = ag[i];
        if (layer > 0) { const float vf = bf2f(VF[o]); v = v + (vf - v) * sigmoidf_(v0c + av[i]); }
        float kk = k * kkc; const float nrm = sqrtf(wave_sum(kk * kk)); kk = kk / fmaxf(nrm, 1e-12f);
        const float k2 = k * (1.f + (a - 1.f) * kac);
        const float bon = wave_sum(r * k2 * rkc) * v;
        R[o] = f2bf(r); Kb[o] = f2bf(k2); V[o] = f2bf(v); KK[o] = f2bf(kk); Bb[o] = f2bf(kk * a); G[o] = f2bf(g); BG[o] = f2bf(bon * g); Wd[o] = decay;
    }
}

__global__ void __launch_bounds__(64) k_scan(const bf16* __restrict__ R, const float* __restrict__ Wd, const bf16* __restrict__ Kb, const bf16* __restrict__ V, const bf16* __restrict__ KK, const bf16* __restrict__ Bb, float* __restrict__ Y) {
    __shared__ float sr[64], sw[64], sk[64], skk[64], sb[64];
    const int b = blockIdx.x / NH, h = blockIdx.x % NH, lane = threadIdx.x;
    float st[64];
#pragma unroll
    for (int k = 0; k < 64; ++k) st[k] = 0.f;
    for (int s = 0; s < SEQ; ++s) {
        const size_t o = (size_t)(b * SEQ + s) * RW + h * HS + lane;
        sr[lane] = bf2f(R[o]); sw[lane] = Wd[o]; sk[lane] = bf2f(Kb[o]); skk[lane] = bf2f(KK[o]); sb[lane] = bf2f(Bb[o]);
        const float vv = bf2f(V[o]);
        __syncthreads();
        float sa = 0.f;
#pragma unroll
        for (int k = 0; k < 64; ++k) sa -= st[k] * skk[k];
        float y = 0.f;
#pragma unroll
        for (int k = 0; k < 64; ++k) { st[k] = st[k] * sw[k] + sa * sb[k] + vv * sk[k]; y += st[k] * sr[k]; }
        Y[o] = y;
        __syncthreads();
    }
}

__global__ void __launch_bounds__(512) k_post(const float* __restrict__ Y, const bf16* __restrict__ G, const bf16* __restrict__ BG, const float* __restrict__ lnx_g, const float* __restrict__ lnx_b, bf16* __restrict__ MIX) {
    const int t = blockIdx.x, c = threadIdx.x; const size_t o = (size_t)t * RW + c;
    const float y = Y[o]; const float mean = wave_sum(y) * (1.f / 64.f); const float d = y - mean; const float var = wave_sum(d * d) * (1.f / 64.f);
    const float yn = d * rsqrtf(var + GN_EPS) * lnx_g[c] + lnx_b[c];
    MIX[(size_t)t * D + c] = f2bf(yn * bf2f(G[o]) + bf2f(BG[o]));
}

__global__ void __launch_bounds__(512) k_pool(const bf16* __restrict__ PROJ, const float* __restrict__ pool_w, const float* __restrict__ pool_scale, bf16* __restrict__ MIX) {
    __shared__ float dl[16][512];
    const int c = threadIdx.x, g = c >> 7, dd = c & 127, win = 2 << g, t0 = blockIdx.x * 16;
    for (int i = 0; i < 16; ++i) { const int t = t0 + i, s = t % SEQ; const int n = min(s + 1, win); float sum = 0.f;
        for (int j = 0; j < n; ++j) sum += bf2f(PROJ[(size_t)(t - j) * LDP + RWKV_COLS + c]);
        dl[i][c] = sum / (float)n - bf2f(PROJ[(size_t)t * LDP + RWKV_COLS + c]); }
    __syncthreads();
    float acc[16];
#pragma unroll
    for (int i = 0; i < 16; ++i) acc[i] = 0.f;
    for (int cc = 0; cc < PG; ++cc) { const float w = pool_w[((size_t)g * PG + cc) * PG + dd];
#pragma unroll
        for (int i = 0; i < 16; ++i) acc[i] += dl[i][g * PG + cc] * w; }
    const float ps = pool_scale[c];
#pragma unroll
    for (int i = 0; i < 16; ++i) MIX[(size_t)(t0 + i) * D + RW + c] = f2bf(acc[i] * ps);
}

__global__ void __launch_bounds__(128) k_router(const bf16* __restrict__ Q, const float* __restrict__ keys, int* __restrict__ IDX, float* __restrict__ GATE) {
    __shared__ float q[2][PHALF]; __shared__ float sc[2][NKEYS]; __shared__ float ts[2][TOPK]; __shared__ int ti[2][TOPK]; __shared__ float cs[256]; __shared__ float fs[TOPK]; __shared__ int fi[TOPK];
    const int t = blockIdx.x / PH, h = blockIdx.x % PH, tid = threadIdx.x;
    q[0][tid] = bf2f(Q[(size_t)t * (PH * PQ) + h * PQ + tid]); q[1][tid] = bf2f(Q[(size_t)t * (PH * PQ) + h * PQ + PHALF + tid]);
    __syncthreads();
    for (int p = 0; p < 2; ++p) { const float* kr = keys + (((size_t)h * 2 + p) * NKEYS + tid) * PHALF; float a = 0.f;
        for (int d = 0; d < PHALF; ++d) a += q[p][d] * kr[d];
        sc[p][tid] = a; }
    __syncthreads();
    for (int p = 0; p < 2; ++p) { const float me = sc[p][tid]; int rank = 0;
        for (int j = 0; j < NKEYS; ++j) { const float o = sc[p][j]; rank += (o > me || (o == me && j < tid)) ? 1 : 0; }
        if (rank < TOPK) { ts[p][rank] = me; ti[p][rank] = tid; } }
    __syncthreads();
    cs[tid] = ts[0][tid >> 4] + ts[1][tid & 15]; cs[tid + 128] = ts[0][(tid + 128) >> 4] + ts[1][(tid + 128) & 15];
    __syncthreads();
    for (int e = tid; e < 256; e += 128) { const float me = cs[e]; int rank = 0;
        for (int j = 0; j < 256; ++j) { const float o = cs[j]; rank += (o > me || (o == me && j < e)) ? 1 : 0; }
        if (rank < TOPK) { fs[rank] = me; fi[rank] = ti[0][e >> 4] * NKEYS + ti[1][e & 15]; } }
    __syncthreads();
    if (tid < TOPK) { const float mx = fs[0]; float den = 0.f;
        for (int j = 0; j < TOPK; ++j) den += expf(fs[j] - mx);
        IDX[(size_t)t * NE + h * TOPK + tid] = fi[tid]; GATE[(size_t)t * NE + h * TOPK + tid] = expf(fs[tid] - mx) / den; }
}

__global__ void __launch_bounds__(256) k_peer(const bf16* __restrict__ H, const int* __restrict__ IDX, const float* __restrict__ GATE, const float* __restrict__ U, const float* __restrict__ Vt,
                                              const float* __restrict__ modl, float* __restrict__ X, const float* __restrict__ lnf_g, int final_norm) {
    __shared__ float hs[D]; __shared__ float coef[NE]; __shared__ int eidx[NE]; __shared__ float red[4];
    const int t = blockIdx.x, tid = threadIdx.x, lane = tid & 63, wv = tid >> 6, b = t / SEQ;
    for (int i = tid; i < D; i += 256) hs[i] = bf2f(H[(size_t)t * D + i]);
    if (tid < NE) eidx[tid] = IDX[(size_t)t * NE + tid];
    __syncthreads();
    for (int e = wv; e < NE; e += 4) { const float* ur = U + (size_t)eidx[e] * D; float a = 0.f;
#pragma unroll
        for (int j = 0; j < 4; ++j) { const float4 q = *(const float4*)(ur + j * 256 + lane * 4); const float* hp = hs + j * 256 + lane * 4; a += q.x * hp[0] + q.y * hp[1] + q.z * hp[2] + q.w * hp[3]; }
        a = wave_sum(a);
        if (lane == 0) coef[e] = GATE[(size_t)t * NE + e] * 0.5f * a * (1.f + erff(a * 0.70710678118654752f)); }
    __syncthreads();
    float4 o = {0.f, 0.f, 0.f, 0.f};
    for (int e = 0; e < NE; ++e) { const float4 q = *(const float4*)(Vt + (size_t)eidx[e] * D + tid * 4); const float cf = coef[e]; o.x += cf * q.x; o.y += cf * q.y; o.z += cf * q.z; o.w += cf * q.w; }
    float4 xv = *(const float4*)(X + (size_t)t * D + tid * 4); const float4 g2 = *(const float4*)(modl + (size_t)b * 6 * D + 5 * D + tid * 4);
    xv.x += g2.x * o.x; xv.y += g2.y * o.y; xv.z += g2.z * o.z; xv.w += g2.w * o.w;
    if (final_norm) {
        float ss = wave_sum(xv.x * xv.x + xv.y * xv.y + xv.z * xv.z + xv.w * xv.w);
        if (lane == 0) red[wv] = ss;
        __syncthreads();
        const float rs = rsqrtf((red[0] + red[1] + red[2] + red[3]) * (1.f / D) + NORM_EPS); const float4 gf = *(const float4*)(lnf_g + tid * 4);
        xv.x *= rs * gf.x; xv.y *= rs * gf.y; xv.z *= rs * gf.z; xv.w *= rs * gf.w;
    }
    *(float4*)(X + (size_t)t * D + tid * 4) = xv;
}

extern "C" void kernel_launch(void* const* d_in, const int* in_sizes, int n_in, void* d_out, int out_size, void* d_ws, size_t ws_size, hipStream_t stream) {
    if (n_in != 30 || ws_size < WS_END) { fprintf(stderr, "kernel_launch: unexpected n_in %d / ws_size %zu\n", n_in, ws_size); return; }
    const float* x = (const float*)d_in[0]; const float* c = (const float*)d_in[1]; const float* ada_w = (const float*)d_in[2]; const float* ada_b = (const float*)d_in[3];
    const float* ln1_g = (const float*)d_in[4]; const float* w_in = (const float*)d_in[5]; const float* mu_shift = (const float*)d_in[6]; const float* w0 = (const float*)d_in[7];
    const float* w_up = (const float*)d_in[8]; const float* a0 = (const float*)d_in[9]; const float* a_up = (const float*)d_in[10]; const float* g_up = (const float*)d_in[11];
    const float* vres_down = (const float*)d_in[12]; const float* vres_mu = (const float*)d_in[13]; const float* vres_v0 = (const float*)d_in[14]; const float* vres_up = (const float*)d_in[15];
    const float* k_k = (const float*)d_in[16]; const float* k_a = (const float*)d_in[17]; const float* r_k = (const float*)d_in[18]; const float* lnx_g = (const float*)d_in[19];
    const float* lnx_b = (const float*)d_in[20]; const float* pool_w = (const float*)d_in[21]; const float* pool_scale = (const float*)d_in[22]; const float* w_out = (const float*)d_in[23];
    const float* ln2_g = (const float*)d_in[24]; const float* peer_q = (const float*)d_in[25]; const float* peer_keys = (const float*)d_in[26]; const float* peer_u = (const float*)d_in[27];
    const float* peer_v = (const float*)d_in[28]; const float* lnf_g = (const float*)d_in[29];
    unsigned char* ws = (unsigned char*)d_ws; float* X = (float*)d_out;
    float* MOD = (float*)(ws + WS_MOD); bf16* H = (bf16*)(ws + WS_H); bf16* PROJ = (bf16*)(ws + WS_PROJ); bf16* Q = (bf16*)(ws + WS_Q);
    bf16* R = (bf16*)(ws + WS_R); bf16* Kb = (bf16*)(ws + WS_K); bf16* V0 = (bf16*)(ws + WS_V0); bf16* V1 = (bf16*)(ws + WS_V1); bf16* KK = (bf16*)(ws + WS_KK);
    bf16* Bb = (bf16*)(ws + WS_B); bf16* G = (bf16*)(ws + WS_G); bf16* BG = (bf16*)(ws + WS_BG); float* Wd = (float*)(ws + WS_W); float* Y = (float*)(ws + WS_Y);
    bf16* MIX = (bf16*)(ws + WS_MIX); int* IDX = (int*)(ws + WS_IDX); float* GATE = (float*)(ws + WS_GATE);

    k_mod<<<dim3(6 * D / 256, DEPTH), 256, 0, stream>>>(c, ada_w, ada_b, MOD);
    for (int l = 0; l < DEPTH; ++l) {
        const float* modl = MOD + (size_t)l * BATCH * 6 * D; const float* xin = l == 0 ? x : X;
        k_norm_mod<<<T / 4, 256, 0, stream>>>(xin, ln1_g + l * D, modl, 0, 1, H);
        k_gemm<0><<<dim3(IN_COLS / 128, T / 128), 256, 0, stream>>>(H, D, w_in + (size_t)l * D * IN_COLS, IN_COLS, IN_COLS, D, PROJ, LDP, 0, nullptr, nullptr, nullptr, 0);
        if (l > 0) k_gemm<0><<<dim3(1, T / 128), 256, 0, stream>>>(H, D, vres_down + (size_t)(l - 1) * D * MVL, MVL, MVL, D, PROJ, LDP, IN_COLS, nullptr, nullptr, nullptr, 0);
        PrepW pw{mu_shift + l * RWKV_COLS, w0 + l * RW, w_up + (size_t)l * DL * RW, a0 + l * RW, a_up + (size_t)l * AL * RW, g_up + (size_t)l * GL * RW,
                 l > 0 ? vres_mu + (l - 1) * MVL : vres_mu, l > 0 ? vres_v0 + (l - 1) * RW : vres_v0, l > 0 ? vres_up + (size_t)(l - 1) * MVL * RW : vres_up,
                 k_k + l * RW, k_a + l * RW, r_k + l * RW};
        bf16* Vl = l == 0 ? V0 : V1;
        k_prep<<<T / TT, 512, 0, stream>>>(PROJ, pw, l, V0, R, Kb, Vl, KK, Bb, G, BG, Wd);
        k_scan<<<BATCH * NH, 64, 0, stream>>>(R, Wd, Kb, Vl, KK, Bb, Y);
        k_pool<<<T / 16, 512, 0, stream>>>(PROJ, pool_w + (size_t)l * 4 * PG * PG, pool_scale + l * PW, MIX);
        k_post<<<T, 512, 0, stream>>>(Y, G, BG, lnx_g + l * RW, lnx_b + l * RW, MIX);
        k_gemm<1><<<dim3(D / 128, T / 128), 256, 0, stream>>>(MIX, D, w_out + (size_t)l * D * D, D, D, D, nullptr, 0, 0, xin, X, modl, 2);
        k_norm_mod<<<T / 4, 256, 0, stream>>>(X, ln2_g + l * D, modl, 3, 4, H);
        k_gemm<0><<<dim3(PH * PQ / 128, T / 128), 256, 0, stream>>>(H, D, peer_q + (size_t)l * D * PH * PQ, PH * PQ, PH * PQ, D, Q, PH * PQ, 0, nullptr, nullptr, nullptr, 0);
        k_router<<<T * PH, 128, 0, stream>>>(Q, peer_keys + (size_t)l * PH * 2 * NKEYS * PHALF, IDX, GATE);
        k_peer<<<T, 256, 0, stream>>>(H, IDX, GATE, peer_u + (size_t)l * NEXP * D, peer_v + (size_t)l * NEXP * D, modl, X, lnf_g, l == DEPTH - 1);
    }
}
```

```cpp
#include <hip/hip_runtime.h>
#include <hip/hip_cooperative_groups.h>
namespace cg = cooperative_groups;
#include <cstdio>
#include <cstdint>
#include <cmath>

constexpr int D = 1024, BATCH = 4, SEQ = 4096, T = BATCH * SEQ, DEPTH = 2;
constexpr int RW = 512, HS = 64, NH = 8;
constexpr int DL = 64, AL = 64, MVL = 32, GL = 128;
constexpr int RWKV_COLS = 3 * RW + DL + AL + GL;
constexpr int PW = 512, PG = 128;
constexpr int IN_COLS = RWKV_COLS + PW;
constexpr int LDP = 2560;
constexpr int NKEYS = 128, NEXP = NKEYS * NKEYS, PH = 8, PQ = 256, PHALF = 128, TOPK = 16;
constexpr int NE = PH * TOPK;
constexpr float NORM_EPS = 1e-6f, GN_EPS = 64e-5f;

typedef unsigned short bf16;
__device__ __forceinline__ float bf2f(bf16 u) { return __uint_as_float((unsigned)u << 16); }
__device__ __forceinline__ bf16 f2bf(float f) { unsigned u = __float_as_uint(f); return (bf16)((u + 0x7fffu + ((u >> 16) & 1u)) >> 16); }

constexpr size_t MiB = 1u << 20;
constexpr size_t WS_MOD = 1 * MiB;
constexpr size_t WS_H = 2 * MiB;
constexpr size_t WS_PROJ = 34 * MiB;
constexpr size_t WS_Q = WS_PROJ;
constexpr size_t WS_R = 114 * MiB;
constexpr size_t WS_K = 130 * MiB;
constexpr size_t WS_V0 = 146 * MiB;
constexpr size_t WS_V1 = 162 * MiB;
constexpr size_t WS_KK = 178 * MiB;
constexpr size_t WS_B = 194 * MiB;
constexpr size_t WS_G = 210 * MiB;
constexpr size_t WS_BG = 226 * MiB;
constexpr size_t WS_W = 242 * MiB;
constexpr size_t WS_Y = 274 * MiB;
constexpr size_t WS_MIX = 306 * MiB;
constexpr size_t WS_IDX = 338 * MiB;
constexpr size_t WS_GATE = 346 * MiB;
constexpr size_t WS_WIN_T = 354 * MiB;
constexpr size_t WS_WOUT_T = 364 * MiB;
constexpr size_t WS_PQ_T = 368 * MiB;
constexpr size_t WS_KEYS = 376 * MiB;
constexpr size_t WS_U = 378 * MiB;
constexpr size_t WS_V = 442 * MiB;
constexpr size_t WS_END = 506 * MiB;

__device__ __forceinline__ float wave_sum(float v) {
#pragma unroll
    for (int o = 1; o < 64; o <<= 1) v += __shfl_xor(v, o);
    return v;
}
__device__ __forceinline__ float sigmoidf_(float x) { return 1.f / (1.f + expf(-x)); }

namespace pg8 {
#define PG8_LAS __attribute__((address_space(3)))
typedef unsigned short bf16_t;
typedef short bf16x8 __attribute__((ext_vector_type(8)));
typedef float f32x4 __attribute__((ext_vector_type(4)));
typedef unsigned u32x4 __attribute__((ext_vector_type(4)));
constexpr int BM = 256, BK = 64, HALF = 128, HTB = HALF * BK * 2  , STAGE_BYTES = 8 * HTB, NXCD = 8, WGM = 8;

__host__ __device__ __forceinline__ int lds_byte(int r, int c) { const int st = (r >> 4) * 2 + (c >> 5), rr = r & 15, cc = c & 31, ob = rr * 64 + cc * 2; return st * 1024 + (ob ^ (((ob >> 9) & 1) << 5)); }
__host__ __device__ __forceinline__ void stage_rc(int b, int& R, int& C) { const int st = b / 1024, sb = b % 1024, swz = sb ^ (((sb >> 9) & 1) << 5); R = (st >> 1) * 16 + swz / 64; C = (st & 1) * 32 + (swz % 64) / 2; }
__host__ __device__ __forceinline__ int perm32(int rho) { const int n = rho >> 4, i = rho & 15; return 8 * (i >> 2) + 4 * n + (i & 3); }

struct Unit { int pm, pn; };
struct Gemm { const bf16_t* A; const bf16_t* Bt; int M, N, K; };

struct StaticOrder {
    int nM, nN, nwg, G, c;
    __host__ __device__ void init(int M, int N, int G_, int c_) { nM = M / BM; nN = N / BM; nwg = nM * nN; G = G_; c = c_; }
    __host__ __device__ bool next(int i, Unit& u) const {
        const long L = (long)i * G + c; if (L >= nwg) return false;
        int wgid = (int)L; { const int q = nwg / NXCD, r = nwg % NXCD, xcd = wgid % NXCD, off = wgid / NXCD; wgid = (xcd < r ? xcd * (q + 1) : r * (q + 1) + (xcd - r) * q) + off; }
        const int nig = WGM * nN, gid = wgid / nig, fm = gid * WGM, gsz = (nM - fm) < WGM ? (nM - fm) : WGM;
        u.pm = fm + ((wgid % nig) % gsz); u.pn = (wgid % nig) / gsz; return true;
    }
    __device__ __forceinline__ void a_ready(const Unit&) const {}
    __device__ __forceinline__ void done(const Unit&) const {}
};

__device__ __forceinline__ unsigned cvt_pk_bf16(float lo, float hi) { unsigned r; asm volatile("v_cvt_pk_bf16_f32 %0, %1, %2" : "=v"(r) : "v"(lo), "v"(hi)); return r; }
typedef float f32x2 __attribute__((ext_vector_type(2)));
__device__ __forceinline__ f32x2 gelu_pk(f32x2 v) {
    const f32x2 av = __builtin_elementwise_abs(v), d = av * 0.2316418882f + 1.0f;
    f32x2 t; t.x = __builtin_amdgcn_rcpf(d.x); t.y = __builtin_amdgcn_rcpf(d.y);
    f32x2 q = t * 0.5307027145f + (-0.7265760135f); q = q * t + 0.7107068705f; q = q * t + (-0.142248368f); q = q * t + 0.127414796f; q = q * t;
    const f32x2 s = (v * v) * (-0.72134752044f);
    f32x2 e; e.x = __builtin_amdgcn_exp2f(s.x); e.y = __builtin_amdgcn_exp2f(s.y);
    const f32x2 m = v * (q * e), r = v - m;
    f32x2 o; o.x = v.x < 0.f ? m.x : r.x; o.y = v.y < 0.f ? m.y : r.y; return o;
}

template <int ACT  > struct EpiBf16 {
    static constexpr bool PERM = true, AFTER_DRAIN = false; static_assert(ACT == 0 || ACT == 1, "EpiBf16: ACT is 0 (none) or 1 (gelu_pk)");
    bf16_t* O; int ldc; const float* bias; int split_cols; size_t split_stride; float scale0;
    __device__ __forceinline__ void operator()(const f32x4 (&acc)[2][2][4][2], const Unit& u, int wr, int wc, int fr, int fq) const {
        const int row0 = u.pm * BM + wr * 64 + fr; int colt = u.pn * BM; bf16_t* base = O;
        float sc = 1.f; if (split_cols) { const int t = colt / split_cols; base += (size_t)t * split_stride; colt -= t * split_cols; if (t == 0) sc = scale0; }
        const int col0 = colt + wc * 32 + 8 * fq, bcol0 = u.pn * BM + wc * 32 + 8 * fq;
        f32x4 bv[2][2];
#pragma unroll
        for (int bj = 0; bj < 2; ++bj)
#pragma unroll
            for (int n = 0; n < 2; ++n) bv[bj][n] = bias ? *(const f32x4*)(bias + bcol0 + bj * HALF + 4 * n) : (f32x4){0.f, 0.f, 0.f, 0.f};
#pragma unroll
        for (int ai = 0; ai < 2; ++ai)
#pragma unroll
            for (int m = 0; m < 4; ++m) { bf16_t* rowp = base + (size_t)(row0 + ai * HALF + m * 16) * ldc + col0;
#pragma unroll
                for (int bj = 0; bj < 2; ++bj) { f32x4 v0 = acc[ai][bj][m][0] + bv[bj][0], v1 = acc[ai][bj][m][1] + bv[bj][1];
                    if (ACT == 1) { f32x2 a = gelu_pk((f32x2){v0[0], v0[1]}), b = gelu_pk((f32x2){v0[2], v0[3]}), c = gelu_pk((f32x2){v1[0], v1[1]}), d = gelu_pk((f32x2){v1[2], v1[3]});
                        v0 = (f32x4){a.x, a.y, b.x, b.y}; v1 = (f32x4){c.x, c.y, d.x, d.y}; }
                    v0 = v0 * sc; v1 = v1 * sc; u32x4 w; w.x = cvt_pk_bf16(v0[0], v0[1]); w.y = cvt_pk_bf16(v0[2], v0[3]); w.z = cvt_pk_bf16(v1[0], v1[1]); w.w = cvt_pk_bf16(v1[2], v1[3]);
                    *(u32x4*)(rowp + bj * HALF) = w; } }
    }
};

struct EpiResGate {
    static constexpr bool PERM = false, AFTER_DRAIN = false;
    const float* xold; float* X; const float* gate;
    __device__ __forceinline__ void operator()(const f32x4 (&acc)[2][2][4][2], const Unit& u, int wr, int wc, int fr, int fq) const {
        const int col0 = u.pn * BM + wc * 32 + 4 * fq; const int b = (u.pm * BM) / SEQ;
        f32x4 gv[2][2];
#pragma unroll
        for (int bj = 0; bj < 2; ++bj)
#pragma unroll
            for (int n = 0; n < 2; ++n) gv[bj][n] = *(const f32x4*)(gate + (size_t)b * 6 * D + col0 + bj * HALF + n * 16);
#pragma unroll
        for (int ai = 0; ai < 2; ++ai)
#pragma unroll
            for (int m = 0; m < 4; ++m) { const size_t off = (size_t)(u.pm * BM + ai * HALF + wr * 64 + m * 16 + fr) * D + col0;
#pragma unroll
                for (int bj = 0; bj < 2; ++bj)
#pragma unroll
                    for (int n = 0; n < 2; ++n) { const f32x4 xo = *(const f32x4*)(xold + off + bj * HALF + n * 16); *(f32x4*)(X + off + bj * HALF + n * 16) = xo + gv[bj][n] * acc[ai][bj][m][n]; } }
    }
};
template <class Epi, class Sched, bool ALIGN_EPI = false, bool SP2 = false>
__device__ __forceinline__ void gemm_phase(PG8_LAS unsigned char* lds, const Gemm g, const Sched& S, const Epi& E) {
    const int tid = threadIdx.x, wid = __builtin_amdgcn_readfirstlane(tid >> 6), lane = tid & 63, wr = wid >> 2, wc = wid & 3, fr = lane & 15, fq = lane >> 4;
    const int K = g.K, nt = K / BK;
    unsigned voffA[2], voffB[2];
#pragma unroll
    for (int i = 0; i < 2; ++i) { int R, C; stage_rc(tid * 16 + i * 8192, R, C); const int Rb = Epi::PERM ? ((R & ~31) + perm32(R & 31)) : R;
        voffA[i] = (unsigned)(R * K + C) * 2u; voffB[i] = (unsigned)(Rb * K + C) * 2u; }
    const size_t kstep = (size_t)(BK * 2);
    const size_t hstep = (size_t)HALF * K * 2;
    const size_t tstep = 2 * hstep;
    const unsigned ldsw = (unsigned)wid * 1024u;
    const int aoff = lds_byte(wr * 64 + fr, fq * 8), boff = lds_byte(wc * 32 + fr, fq * 8);
#define PG8_SA(b, h) (((b) * 2 + (h)) * HTB)
#define PG8_SB(b, h) ((4 + (b) * 2 + (h)) * HTB)
#define PG8_STAGE(bufoff, gbase, voff) do { _Pragma("unroll") for (int _i = 0; _i < 2; ++_i) \
        __builtin_amdgcn_global_load_lds((const unsigned*)((const char*)(gbase) + (voff)[_i]), (PG8_LAS unsigned*)(lds + (bufoff) + ldsw + _i * 8192), 16, 0, 0); } while (0)
#define PG8_LDA(dst, b, h) do { _Pragma("unroll") for (int m = 0; m < 4; ++m) _Pragma("unroll") for (int k = 0; k < 2; ++k) dst[m][k] = *(const PG8_LAS bf16x8*)(lds + PG8_SA(b, h) + aoff + m * 2048 + k * 1024); } while (0)
#define PG8_LDB(dst, b, h) do { _Pragma("unroll") for (int n = 0; n < 2; ++n) _Pragma("unroll") for (int k = 0; k < 2; ++k) dst[n][k] = *(const PG8_LAS bf16x8*)(lds + PG8_SB(b, h) + boff + n * 2048 + k * 1024); } while (0)
#define PG8_MMA(ai, bj, At, Bt) do { __builtin_amdgcn_s_setprio(1); _Pragma("unroll") for (int m = 0; m < 4; ++m) _Pragma("unroll") for (int n = 0; n < 2; ++n) _Pragma("unroll") for (int k = 0; k < 2; ++k) \
        acc[ai][bj][m][n] = __builtin_amdgcn_mfma_f32_16x16x32_bf16(Bt[n][k], At[m][k], acc[ai][bj][m][n], 0, 0, 0); __builtin_amdgcn_s_setprio(0); } while (0)
#define PG8_WAIT_V(n) asm volatile("s_waitcnt vmcnt(" #n ")" ::: "memory")
#define PG8_WAIT_L(n) asm volatile("s_waitcnt lgkmcnt(" #n ")" ::: "memory")
#define PG8_BAR __builtin_amdgcn_s_barrier()
#define PG8_SCHED __builtin_amdgcn_sched_barrier(0)
    Unit cur, nxt; int ui = 0;
    if (!S.next(0, cur)) return;
    f32x4 acc[2][2][4][2];
#pragma unroll
    for (int a = 0; a < 2; ++a)
#pragma unroll
        for (int b = 0; b < 2; ++b)
#pragma unroll
            for (int m = 0; m < 4; ++m)
#pragma unroll
                for (int n = 0; n < 2; ++n) acc[a][b][m][n] = (f32x4){0.f, 0.f, 0.f, 0.f};
    bf16x8 At[4][2], B0[2][2], B1[2][2];
    const char* cA = (const char*)g.A + (size_t)cur.pm * tstep; const char* cB = (const char*)g.Bt + (size_t)cur.pn * tstep;
    S.a_ready(cur);
    if constexpr (SP2) {
        PG8_STAGE(PG8_SB(0, 0), cB, voffB); PG8_STAGE(PG8_SB(0, 1), cB + hstep, voffB); PG8_STAGE(PG8_SA(0, 0), cA, voffA); PG8_STAGE(PG8_SA(0, 1), cA + hstep, voffA);
        if (wr == 1) PG8_BAR;
        PG8_WAIT_V(2); PG8_BAR;
        PG8_STAGE(PG8_SB(1, 0), cB + kstep, voffB); PG8_STAGE(PG8_SA(1, 0), cA + kstep, voffA); PG8_STAGE(PG8_SB(1, 1), cB + hstep + kstep, voffB);
        PG8_WAIT_V(6); PG8_BAR;
    } else {
        PG8_STAGE(PG8_SB(0, 0), cB, voffB); PG8_STAGE(PG8_SA(0, 0), cA, voffA); PG8_STAGE(PG8_SB(0, 1), cB + hstep, voffB); PG8_STAGE(PG8_SA(0, 1), cA + hstep, voffA);
        if (wr == 1) PG8_BAR;
        PG8_WAIT_V(4); PG8_BAR;
        PG8_STAGE(PG8_SB(1, 0), cB + kstep, voffB); PG8_STAGE(PG8_SA(1, 0), cA + kstep, voffA); PG8_STAGE(PG8_SB(1, 1), cB + hstep + kstep, voffB);
        PG8_WAIT_V(6); PG8_BAR;
    }
    for (;;) {
        const bool has_next = S.next(ui + 1, nxt);
        const char* nA = has_next ? (const char*)g.A + (size_t)nxt.pm * tstep : cA; const char* nB = has_next ? (const char*)g.Bt + (size_t)nxt.pn * tstep : cB;
        for (int t = 0; t < nt; t += 2) {
            const bool last = (t == nt - 2);
            const char* a1 = cA + (size_t)(t + 1) * kstep;
            const char* a2 = last ? nA : cA + (size_t)(t + 2) * kstep; const char* b2 = last ? nB : cB + (size_t)(t + 2) * kstep;
            const char* a3 = a2 + kstep; const char* b3 = b2 + kstep;
            if (last && has_next) S.a_ready(nxt);
            if constexpr (SP2) {
            PG8_LDB(B0, 0, 0); PG8_LDB(B1, 0, 1); PG8_SCHED; PG8_LDA(At, 0, 0); PG8_STAGE(PG8_SA(1, 1), a1 + hstep, voffA);
            PG8_WAIT_V(8); PG8_WAIT_L(0); PG8_BAR; PG8_MMA(0, 0, At, B0); PG8_MMA(0, 1, At, B1); PG8_BAR; PG8_SCHED;
            PG8_LDA(At, 0, 1); PG8_STAGE(PG8_SB(0, 0), b2, voffB); PG8_STAGE(PG8_SB(0, 1), b2 + hstep, voffB); PG8_STAGE(PG8_SA(0, 0), a2, voffA);
            PG8_WAIT_V(8); PG8_WAIT_L(0); PG8_BAR; PG8_MMA(1, 0, At, B0); PG8_MMA(1, 1, At, B1); PG8_BAR; PG8_SCHED;
            PG8_LDB(B0, 1, 0); PG8_LDB(B1, 1, 1); PG8_SCHED; PG8_LDA(At, 1, 0); PG8_STAGE(PG8_SA(0, 1), a2 + hstep, voffA);
            PG8_WAIT_V(8); PG8_WAIT_L(0); PG8_BAR; PG8_MMA(0, 0, At, B0); PG8_MMA(0, 1, At, B1); PG8_BAR; PG8_SCHED;
            PG8_LDA(At, 1, 1); PG8_STAGE(PG8_SB(1, 0), b3, voffB); PG8_STAGE(PG8_SB(1, 1), b3 + hstep, voffB); PG8_STAGE(PG8_SA(1, 0), a3, voffA);
            PG8_WAIT_V(8); PG8_WAIT_L(0); PG8_BAR; PG8_MMA(1, 0, At, B0); PG8_MMA(1, 1, At, B1); PG8_BAR; PG8_SCHED;
            } else {
            PG8_LDB(B0, 0, 0); PG8_SCHED; PG8_LDA(At, 0, 0); PG8_STAGE(PG8_SA(1, 1), a1 + hstep, voffA);
            PG8_WAIT_L(8); PG8_BAR; PG8_WAIT_L(0); PG8_MMA(0, 0, At, B0); PG8_BAR; PG8_SCHED;
            PG8_LDB(B1, 0, 1); PG8_STAGE(PG8_SB(0, 0), b2, voffB);
            PG8_BAR; PG8_WAIT_L(0); PG8_MMA(0, 1, At, B1); PG8_BAR;
            PG8_LDA(At, 0, 1); PG8_STAGE(PG8_SA(0, 0), a2, voffA);
            PG8_BAR; PG8_WAIT_L(0); PG8_MMA(1, 0, At, B0); PG8_BAR; PG8_SCHED;
            PG8_STAGE(PG8_SB(0, 1), b2 + hstep, voffB);
            PG8_WAIT_V(6); PG8_BAR; PG8_MMA(1, 1, At, B1); PG8_BAR;
            PG8_LDB(B0, 1, 0); PG8_SCHED; PG8_LDA(At, 1, 0); PG8_STAGE(PG8_SA(0, 1), a2 + hstep, voffA);
            PG8_WAIT_L(8); PG8_BAR; PG8_WAIT_L(0); PG8_MMA(0, 0, At, B0); PG8_BAR; PG8_SCHED;
            PG8_LDB(B1, 1, 1); PG8_STAGE(PG8_SB(1, 0), b3, voffB);
            PG8_BAR; PG8_WAIT_L(0); PG8_MMA(0, 1, At, B1); PG8_BAR;
            PG8_LDA(At, 1, 1); PG8_STAGE(PG8_SA(1, 0), a3, voffA);
            PG8_BAR; PG8_WAIT_L(0); PG8_MMA(1, 0, At, B0); PG8_BAR; PG8_SCHED;
            PG8_STAGE(PG8_SB(1, 1), b3 + hstep, voffB);
            PG8_WAIT_V(6); PG8_BAR; PG8_MMA(1, 1, At, B1); PG8_BAR;
            }
        }
        if constexpr (ALIGN_EPI) { if (wr == 0) PG8_BAR; }
        if constexpr (!Epi::AFTER_DRAIN) { E(acc, cur, wr, wc, fr, fq); S.done(cur); }
        if (!has_next) break;
#pragma unroll
        for (int a = 0; a < 2; ++a)
#pragma unroll
            for (int b = 0; b < 2; ++b)
#pragma unroll
                for (int m = 0; m < 4; ++m)
#pragma unroll
                    for (int n = 0; n < 2; ++n) acc[a][b][m][n] = (f32x4){0.f, 0.f, 0.f, 0.f};
        cur = nxt; cA = nA; cB = nB; ++ui;
        if constexpr (ALIGN_EPI) { if (wr == 1) PG8_BAR; }
    }
    PG8_WAIT_V(0);
    if constexpr (!ALIGN_EPI) { if (wr == 0) PG8_BAR; }
    PG8_BAR;
    if constexpr (Epi::AFTER_DRAIN) { E.fused(acc, cur, wr, wc, fr, fq, lds, wid, lane); S.done(cur); }
#undef PG8_SA
#undef PG8_SB
#undef PG8_STAGE
#undef PG8_LDA
#undef PG8_LDB
#undef PG8_MMA
#undef PG8_WAIT_V
#undef PG8_WAIT_L
#undef PG8_BAR
#undef PG8_SCHED
}
}

#define LAS __attribute__((address_space(3)))
constexpr int NWAVES = 8, NTHR = 512;
constexpr int LDS_BYTES = 147456;
constexpr int NPH = 21;
typedef float f32x4 __attribute__((ext_vector_type(4)));
typedef unsigned u32x4 __attribute__((ext_vector_type(4)));

struct Args { const float* in[30]; float* out; unsigned char* ws; int ph_lo, ph_hi; };

__device__ __forceinline__ unsigned pk2(float lo, float hi) { return (unsigned)f2bf(lo) | ((unsigned)f2bf(hi) << 16); }

__device__ __forceinline__ void p0_transpose_item(const float* W, int K, int N, bf16* WT, int row_off, LAS float* scr, int item, int lane) {
    const int nblk = N / 32, kb = item / nblk, nb = item % nblk, k0 = 64 * kb, n0 = 32 * nb;
#pragma unroll 8
    for (int i = 0; i < 32; ++i) { const int kk = 2 * i + (lane >> 5); scr[kk * 33 + (lane & 31)] = W[(size_t)(k0 + kk) * N + n0 + (lane & 31)]; }
    asm volatile("s_waitcnt lgkmcnt(0)" ::: "memory");
    const int c = lane & 7;
#pragma unroll
    for (int j = 0; j < 4; ++j) { const int n = (lane >> 3) + 8 * j; const LAS float* s = scr + (8 * c) * 33 + n;
        u32x4 o; o.x = pk2(s[0 * 33], s[1 * 33]); o.y = pk2(s[2 * 33], s[3 * 33]); o.z = pk2(s[4 * 33], s[5 * 33]); o.w = pk2(s[6 * 33], s[7 * 33]);
        *(u32x4*)(WT + (size_t)(row_off + n0 + n) * K + k0 + 8 * c) = o; }
    asm volatile("s_waitcnt lgkmcnt(0)" ::: "memory");
}

__device__ __forceinline__ void norm_mod_row(const float* xr, const float* gamma, const float* sh, const float* sc, bf16* orow, int lane) {
    f32x4 v[4]; float ss = 0.f;
#pragma unroll
    for (int j = 0; j < 4; ++j) { v[j] = *(const f32x4*)(xr + j * 256 + lane * 4); ss += (v[j].x * v[j].x + v[j].y * v[j].y) + (v[j].z * v[j].z + v[j].w * v[j].w); }
    const float rs = rsqrtf(wave_sum(ss) * (1.f / D) + NORM_EPS);
#pragma unroll
    for (int j = 0; j < 4; ++j) { const int d = j * 256 + lane * 4; const f32x4 g = *(const f32x4*)(gamma + d), a = *(const f32x4*)(sc + d), s = *(const f32x4*)(sh + d);
        const f32x4 y = v[j] * rs * g * (a + 1.f) + s; uint2 o; o.x = pk2(y.x, y.y); o.y = pk2(y.z, y.w); *(uint2*)(orow + d) = o; }
}


__device__ __forceinline__ unsigned mono_u32(float f) { unsigned u = __float_as_uint(f); return (u & 0x80000000u) ? ~u : (u | 0x80000000u); }
__device__ __forceinline__ float demono_u32(unsigned u) { return __uint_as_float((u & 0x80000000u) ? (u & 0x7FFFFFFFu) : ~u); }
__device__ __forceinline__ unsigned pack_key7(float f, int idx) { return (mono_u32(f) & 0xFFFFFF80u) | (unsigned)(127 - idx); }
__device__ __forceinline__ float unpack_key7(unsigned k) { return demono_u32((k & 0xFFFFFF80u) | 0x40u); }
__device__ __forceinline__ float unpack_key8(unsigned k) { return demono_u32((k & 0xFFFFFF00u) | 0x80u); }
__device__ __forceinline__ void ce_desc(unsigned& a, unsigned& b) { const unsigned hi = a > b ? a : b, lo = a > b ? b : a; a = hi; b = lo; }
__device__ __forceinline__ void sort16_desc(unsigned* v) {
#pragma unroll
    for (int k = 2; k <= 16; k <<= 1)
#pragma unroll
        for (int j = k >> 1; j > 0; j >>= 1)
#pragma unroll
            for (int i = 0; i < 16; ++i) { const int l = i ^ j; if (l > i) { if ((i & k) == 0) ce_desc(v[i], v[l]); else ce_desc(v[l], v[i]); } }
}
__device__ __forceinline__ void bmerge16_desc(unsigned* v) {
#pragma unroll
    for (int j = 8; j > 0; j >>= 1)
#pragma unroll
        for (int i = 0; i < 16; ++i) { const int l = i ^ j; if (l > i) ce_desc(v[i], v[l]); }
}
__device__ __forceinline__ void merge_top16(unsigned* a, const unsigned* b) {
#pragma unroll
    for (int i = 0; i < 16; ++i) { const unsigned o = b[15 - i]; a[i] = a[i] > o ? a[i] : o; }
    bmerge16_desc(a);
}
__device__ __forceinline__ void stage2_cands(const unsigned* s0, const unsigned* s1, int hh, unsigned* c) {
    float A[16], B[16];
#pragma unroll
    for (int i = 0; i < 16; ++i) { const float f0 = unpack_key7(s0[i]), f1 = unpack_key7(s1[i]); A[i] = hh ? f1 : f0; B[i] = hh ? f0 : f1; }
    int n = 0;
#pragma unroll
    for (int i = 0; i < 4; ++i)
#pragma unroll
        for (int j = i; j < 16; ++j) { if ((i + 1) * (j + 1) > 16) continue;
            const float val = A[i] + B[j]; const unsigned id = hh ? (unsigned)((j << 4) | i) : (unsigned)((i << 4) | j);
            unsigned key = (mono_u32(val) & 0xFFFFFF00u) | id; if (hh && i == j) key = 0u; c[n++] = key; }
#pragma unroll
    for (; n < 32; ++n) c[n] = 0u;
}

template <int CTRL> __device__ __forceinline__ float dppf(float x) { return __int_as_float(__builtin_amdgcn_update_dpp(0, __float_as_int(x), CTRL, 0xF, 0xF, false)); }
__device__ __forceinline__ float red16(float x) { x += dppf<0xB1>(x); x += dppf<0x4E>(x); x += dppf<0x141>(x); x += dppf<0x140>(x); return x; }
typedef short bf16x8_t __attribute__((ext_vector_type(8)));
typedef float f32x16 __attribute__((ext_vector_type(16)));
__device__ __forceinline__ float gelu_erf(float a) { return 0.5f * a * (1.f + erff(a * 0.70710678118654752f)); }

__global__ void __launch_bounds__(NTHR, 2) mega(Args args) {
    extern __shared__ __attribute__((aligned(16))) unsigned char lds_raw[];
    LAS unsigned char* lds = (LAS unsigned char*)lds_raw;
    const int G = gridDim.x, bx = blockIdx.x, NGW = G * NWAVES;
    typedef const unsigned char __attribute__((address_space(4))) kbyte;
#define PHASE_IDS int tid = threadIdx.x; asm volatile("" : "+v"(tid)); const int lane = tid & 63, wave = __builtin_amdgcn_readfirstlane(tid >> 6), gw = bx * NWAVES + wave; (void)lane; (void)gw; \
    kbyte* kp = (kbyte*)__builtin_amdgcn_kernarg_segment_ptr(); asm volatile("" : "+s"(kp)); \
    unsigned char* const ws = *(unsigned char* const __attribute__((address_space(4)))*)(kp + 31 * 8); float* const X = *(float* const __attribute__((address_space(4)))*)(kp + 30 * 8); (void)ws; (void)X;
#define INP(i) (*(const float* const __attribute__((address_space(4)))*)(kp + (i) * 8))
#define MOD ((float*)(ws + WS_MOD))
#define H ((bf16*)(ws + WS_H))
#define PROJ ((bf16*)(ws + WS_PROJ))
#define Q ((bf16*)(ws + WS_Q))
#define MIX ((bf16*)(ws + WS_MIX))
#define Rb ((bf16*)(ws + WS_R))
#define Kb ((bf16*)(ws + WS_K))
#define V0 ((bf16*)(ws + WS_V0))
#define V1 ((bf16*)(ws + WS_V1))
#define KKb ((bf16*)(ws + WS_KK))
#define Bb ((bf16*)(ws + WS_B))
#define Gb ((bf16*)(ws + WS_G))
#define BGb ((bf16*)(ws + WS_BG))
#define Wd ((float*)(ws + WS_W))
#define Y ((float*)(ws + WS_Y))
#define IDX ((int*)(ws + WS_IDX))
#define GATE ((float*)(ws + WS_GATE))
#define WinT ((bf16*)(ws + WS_WIN_T))
#define WoutT ((bf16*)(ws + WS_WOUT_T))
#define PqT ((bf16*)(ws + WS_PQ_T))
#define KEYS ((bf16*)(ws + WS_KEYS))
#define Ub ((bf16*)(ws + WS_U))
#define Vb ((bf16*)(ws + WS_V))
    const int lo = args.ph_lo, hi = args.ph_hi;
#define IN(k) (lo <= (k) && (k) < hi)
#define SEAM(k) do { if (IN(k) && IN((k) + 1)) { cg::this_grid().sync(); } } while (0)

    if (IN(0)) { PHASE_IDS
        { LAS float* ca = (LAS float*)lds; LAS float* red = (LAS float*)(lds + 16384);
          const float* c = INP(1); const float* ada_w = INP(2); const float* ada_b = INP(3);
          bool have = false;
          for (int it = bx; it < 96; it += G) {
              if (!have) { for (int i = tid; i < BATCH * D; i += NTHR) { const float v = c[i]; ca[i] = v / (1.f + expf(-v)); } have = true; __syncthreads(); }
              const int l = it / 48, n = (it % 48) * 128 + (tid & 127), kq = tid >> 7;
              const float* w = ada_w + (size_t)l * D * 6 * D + (size_t)(kq * 256) * 6 * D + n;
              float a0 = 0.f, a1 = 0.f, a2 = 0.f, a3 = 0.f;
#pragma unroll 8
              for (int k = 0; k < 256; ++k) { const float wv = w[(size_t)k * 6 * D]; const int kk = kq * 256 + k; a0 += ca[kk] * wv; a1 += ca[D + kk] * wv; a2 += ca[2 * D + kk] * wv; a3 += ca[3 * D + kk] * wv; }
              red[(kq * 4 + 0) * 128 + (tid & 127)] = a0; red[(kq * 4 + 1) * 128 + (tid & 127)] = a1; red[(kq * 4 + 2) * 128 + (tid & 127)] = a2; red[(kq * 4 + 3) * 128 + (tid & 127)] = a3;
              __syncthreads();
              { const int b = tid >> 7, col = tid & 127, nn = (it % 48) * 128 + col;
                const float s = red[(0 * 4 + b) * 128 + col] + red[(1 * 4 + b) * 128 + col] + red[(2 * 4 + b) * 128 + col] + red[(3 * 4 + b) * 128 + col];
                MOD[(size_t)l * BATCH * 6 * D + (size_t)b * 6 * D + nn] = s + ada_b[l * 6 * D + nn]; }
              __syncthreads();
          }
          __syncthreads(); }
        { LAS float* scr = (LAS float*)(lds + wave * 16384);
          constexpr int I_IN = (D / 64) * (IN_COLS / 32), I_VR = (D / 64) * (MVL / 32), I_OUT = (D / 64) * (D / 32), I_PQ = (D / 64) * (PH * PQ / 32);
          constexpr int NIT = 2 * I_IN + I_VR + 2 * I_OUT + 2 * I_PQ;
          for (int it = gw; it < NIT; it += NGW) { int r = it;
              if (r < 2 * I_IN) { const int l = r / I_IN; p0_transpose_item(INP(5) + (size_t)l * D * IN_COLS, D, IN_COLS, WinT + (size_t)l * LDP * D, 0, scr, r % I_IN, lane); continue; } r -= 2 * I_IN;
              if (r < I_VR) { p0_transpose_item(INP(12), D, MVL, WinT + (size_t)1 * LDP * D, IN_COLS, scr, r, lane); continue; } r -= I_VR;
              if (r < 2 * I_OUT) { const int l = r / I_OUT; p0_transpose_item(INP(23) + (size_t)l * D * D, D, D, WoutT + (size_t)l * D * D, 0, scr, r % I_OUT, lane); continue; } r -= 2 * I_OUT;
              { const int l = r / I_PQ; p0_transpose_item(INP(25) + (size_t)l * D * PH * PQ, D, PH * PQ, PqT + (size_t)l * PH * PQ * D, 0, scr, r % I_PQ, lane); } } }
        { const size_t gt = (size_t)bx * NTHR + tid, NT = (size_t)G * NTHR;
          constexpr size_t NK8 = (size_t)2 * PH * 2 * NKEYS * PHALF / 8, NU8 = (size_t)2 * NEXP * D / 8;
          for (size_t i = gt; i < NK8 + 2 * NU8; i += NT) {
              const float* src; bf16* dst; size_t j = i;
              if (j < NK8) { src = INP(26); dst = KEYS; } else { j -= NK8; if (j < NU8) { src = INP(27); dst = Ub; } else { j -= NU8; src = INP(28); dst = Vb; } }
              const f32x4 a = *(const f32x4*)(src + j * 8), b = *(const f32x4*)(src + j * 8 + 4);
              u32x4 o; o.x = pk2(a.x, a.y); o.y = pk2(a.z, a.w); o.z = pk2(b.x, b.y); o.w = pk2(b.z, b.w); *(u32x4*)(dst + j * 8) = o; } }
    }
    SEAM(0);

#pragma unroll
    for (int l = 0; l < DEPTH; ++l) {
        const int pb = 1 + 10 * l;
#define modl (MOD + (size_t)l * BATCH * 6 * D)
#define xin (l == 0 ? INP(0) : (const float*)X)
        if (IN(pb + 0)) { PHASE_IDS const float* gamma = INP(4) + l * D;
            for (int row = gw; row < T; row += NGW) { const int b = row / SEQ; norm_mod_row(xin + (size_t)row * D, gamma, modl + (size_t)b * 6 * D, modl + (size_t)b * 6 * D + D, H + (size_t)row * D, lane); } }
        SEAM(pb + 0);
        if (IN(pb + 1)) { PHASE_IDS const int N1 = l == 0 ? IN_COLS : LDP;
            pg8::Gemm g{H, WinT + (size_t)l * LDP * D, T, N1, D}; pg8::StaticOrder S; S.init(T, N1, G, bx);
            pg8::EpiBf16<0> E{PROJ, LDP, nullptr, 0, 0, 1.f};
            pg8::gemm_phase<pg8::EpiBf16<0>, pg8::StaticOrder, true, true>(lds, g, S, E); }
        SEAM(pb + 1);

        if (IN(pb + 2)) { PHASE_IDS
            constexpr int TP = 16; LAS float* lin = (LAS float*)lds;
            const float* mu = INP(6) + l * RWKV_COLS; const float* w_up = INP(8) + (size_t)l * DL * RW; const float* a_up = INP(10) + (size_t)l * AL * RW; const float* g_up = INP(11) + (size_t)l * GL * RW;
            const float* vmu = INP(13); const float* vup = INP(15);
            const int c = tid;
            const float mur = mu[c], muk = mu[RW + c], muv = mu[2 * RW + c];
            const float w0c = INP(7)[l * RW + c], a0c = INP(9)[l * RW + c], kkc = INP(16)[l * RW + c], kac = INP(17)[l * RW + c], rkc = INP(18)[l * RW + c];
            const float v0c = l > 0 ? INP(14)[c] : 0.f;
            bf16* Vl = l == 0 ? V0 : V1;
            for (int tile = bx; tile < T / TP; tile += G) {
                const int t0 = tile * TP;
                __syncthreads();
                for (int e = c; e < TP * 288; e += NTHR) {
                    const int tok = e / 288, j = e % 288, t = t0 + tok, sq = t % SEQ;
                    const int col = j < 256 ? 3 * RW + j : IN_COLS + (j - 256);
                    float val = 0.f;
                    if (j < 256 || l > 0) {
                        const float cur = bf2f(PROJ[(size_t)t * LDP + col]); const float prev = sq > 0 ? bf2f(PROJ[(size_t)(t - 1) * LDP + col]) : 0.f;
                        const float m = j < 256 ? mu[col] : vmu[j - 256];
                        val = cur + (prev - cur) * m;
                        if (j < 64) val = tanhf(val); else if (j >= 128 && j < 256) val = sigmoidf_(val);
                    }
                    lin[tok * 288 + j] = val;
                }
                __syncthreads();
                float aw[TP], aa[TP], ag[TP], av[TP];
#pragma unroll
                for (int i = 0; i < TP; ++i) { aw[i] = 0.f; aa[i] = 0.f; ag[i] = 0.f; av[i] = 0.f; }
#pragma unroll 2
                for (int k = 0; k < 64; ++k) { const float w1 = w_up[k * RW + c], w2 = a_up[k * RW + c];
#pragma unroll
                    for (int i = 0; i < TP; ++i) { aw[i] += lin[i * 288 + k] * w1; aa[i] += lin[i * 288 + 64 + k] * w2; } }
#pragma unroll 2
                for (int k = 0; k < 128; ++k) { const float w3 = g_up[k * RW + c];
#pragma unroll
                    for (int i = 0; i < TP; ++i) ag[i] += lin[i * 288 + 128 + k] * w3; }
                if (l > 0) {
#pragma unroll 2
                    for (int k = 0; k < 32; ++k) { const float w4 = vup[k * RW + c];
#pragma unroll
                        for (int i = 0; i < TP; ++i) av[i] += lin[i * 288 + 256 + k] * w4; } }
#pragma unroll
                for (int i = 0; i < TP; ++i) {
                    const int t = t0 + i, sq = t % SEQ; const size_t o = (size_t)t * RW + c;
                    const bf16* pr = PROJ + (size_t)t * LDP; const bf16* pp = pr - LDP;
                    float r = bf2f(pr[c]), k = bf2f(pr[RW + c]), v = bf2f(pr[2 * RW + c]);
                    const float rp = sq > 0 ? bf2f(pp[c]) : 0.f, kp = sq > 0 ? bf2f(pp[RW + c]) : 0.f, vp = sq > 0 ? bf2f(pp[2 * RW + c]) : 0.f;
                    r += (rp - r) * mur; k += (kp - k) * muk; v += (vp - v) * muv;
                    const float z = -(w0c + aw[i]); const float sp = fmaxf(z, 0.f) + log1pf(expf(-fabsf(z)));
                    const float decay = expf(-expf(-sp - 0.5f));
                    const float a = sigmoidf_(a0c + aa[i]); const float g = ag[i];
                    if (l > 0) { const float vf = bf2f(V0[o]); v = v + (vf - v) * sigmoidf_(v0c + av[i]); }
                    float kk = k * kkc; const float nrm = sqrtf(wave_sum(kk * kk)); kk = kk / fmaxf(nrm, 1e-12f);
                    const float k2 = k * (1.f + (a - 1.f) * kac);
                    const float bon = wave_sum(r * k2 * rkc) * v;
                    Rb[o] = f2bf(r); Kb[o] = f2bf(k2); Vl[o] = f2bf(v); KKb[o] = f2bf(kk); Bb[o] = f2bf(kk * a); Gb[o] = f2bf(g); BGb[o] = f2bf(bon * g); Wd[o] = decay;
                }
            }
        }
        SEAM(pb + 2);

        if (IN(pb + 3)) { PHASE_IDS
            const bf16* Vl = l == 0 ? V0 : V1;
            constexpr int SB = 32, STP = 352, BUFB = SB * STP * 4;
            const int nscan = (G >= 128) ? 64 : 0;
            for (int it = bx; it < 64; it += G) {
                const int b = it >> 4, h = (it >> 1) & 7, half = it & 1;
                const int rowl = wave * 4 + (lane >> 4), kq = lane & 15;
                LAS float* ybuf = (LAS float*)(lds + 2 * BUFB);
                const size_t tb = (size_t)b * SEQ;
                const int id0 = tid, id1 = tid + 512;
                const bf16* arrs[4] = {Rb, Kb, KKb, Bb}; const int slot[4] = {0, 128, 192, 256};
                const int a0_ = id0 >> 8, tk0 = (id0 >> 3) & 31, pt0 = id0 & 7, a1_ = id1 >> 8, tk1 = (id1 >> 3) & 31, pt1 = id1 & 7;
                const bf16* s0p = arrs[a0_] + (tb + tk0) * RW + h * HS + pt0 * 8; const bf16* s1p = arrs[a1_] + (tb + tk1) * RW + h * HS + pt1 * 8;
                const int d0 = tk0 * STP + slot[a0_] + pt0 * 8, d1 = tk1 * STP + slot[a1_] + pt1 * 8;
                const int tkw = tid >> 4, ptw = tid & 15; const float* swp = Wd + (tb + tkw) * RW + h * HS + ptw * 4; const int dw = tkw * STP + 64 + ptw * 4;
                const int tkv = (tid & 127) >> 2, ptv = tid & 3; const bf16* svp = Vl + (tb + tkv) * RW + h * HS + half * 32 + ptv * 8; const int dv = tkv * STP + 320 + ptv * 8;
                u32x4 q0, q1, qv; f32x4 qw;
#define SCAN_LOAD(blk) do { const size_t go = (size_t)(blk) * SB * RW; q0 = *(const u32x4*)(s0p + go); q1 = *(const u32x4*)(s1p + go); qw = *(const f32x4*)(swp + go); if (tid < 128) qv = *(const u32x4*)(svp + go); } while (0)
#define SCAN_UNPK(dst, q) do { (dst)[0] = __uint_as_float((q).x << 16); (dst)[1] = __uint_as_float((q).x & 0xffff0000u); (dst)[2] = __uint_as_float((q).y << 16); (dst)[3] = __uint_as_float((q).y & 0xffff0000u); \
                               (dst)[4] = __uint_as_float((q).z << 16); (dst)[5] = __uint_as_float((q).z & 0xffff0000u); (dst)[6] = __uint_as_float((q).w << 16); (dst)[7] = __uint_as_float((q).w & 0xffff0000u); } while (0)
#define SCAN_STORE(bufi) do { LAS float* bb = (LAS float*)(lds + (bufi) * BUFB); SCAN_UNPK(bb + d0, q0); SCAN_UNPK(bb + d1, q1); *(LAS f32x4*)(bb + dw) = qw; if (tid < 128) SCAN_UNPK(bb + dv, qv); } while (0)
                __syncthreads();
                SCAN_LOAD(0); SCAN_STORE(0);
                __syncthreads();
                f32x4 st = {0.f, 0.f, 0.f, 0.f};
                for (int blk = 0; blk < SEQ / SB; ++blk) {
                    if (blk + 1 < SEQ / SB) SCAN_LOAD(blk + 1);
                    const LAS float* bb = (const LAS float*)(lds + (blk & 1) * BUFB);
#pragma unroll 4
                    for (int s = 0; s < SB; ++s) {
                        const LAS float* p = bb + s * STP;
                        const f32x4 r4 = *(const LAS f32x4*)(p + 4 * kq), w4 = *(const LAS f32x4*)(p + 64 + 4 * kq), k4 = *(const LAS f32x4*)(p + 128 + 4 * kq), kk4 = *(const LAS f32x4*)(p + 192 + 4 * kq), b4 = *(const LAS f32x4*)(p + 256 + 4 * kq);
                        const float v = p[320 + rowl];
                        float sa = -((st.x * kk4.x + st.y * kk4.y) + (st.z * kk4.z + st.w * kk4.w)); sa = red16(sa);
                        st = st * w4 + v * k4 + sa * b4;
                        float y = (st.x * r4.x + st.y * r4.y) + (st.z * r4.z + st.w * r4.w); y = red16(y);
                        if (kq == 0) ybuf[s * 32 + rowl] = y;
                    }
                    __syncthreads();
                    if (lane < 32) { const f32x4 yv = *(const LAS f32x4*)(ybuf + lane * 32 + wave * 4); *(f32x4*)(Y + (tb + (size_t)blk * SB + lane) * RW + h * HS + half * 32 + wave * 4) = yv; }
                    if (blk + 1 < SEQ / SB) SCAN_STORE((blk + 1) & 1);
                    __syncthreads();
                }
#undef SCAN_LOAD
#undef SCAN_UNPK
#undef SCAN_STORE
            }
            if (bx >= nscan) {
                LAS float* dl = (LAS float*)lds;
                const float* pool_w = INP(21) + (size_t)l * 4 * PG * PG; const float ps = INP(22)[l * PW + tid];
                const int c = tid, g = c >> 7, dd = c & 127, win = 2 << g;
                for (int tile = bx - nscan; tile < T / 16; tile += G - nscan) {
                    const int t0 = tile * 16;
                    __syncthreads();
                    for (int i = 0; i < 16; ++i) { const int t = t0 + i, sq = t % SEQ; const int n = min(sq + 1, win); float sum = 0.f;
                        for (int j = 0; j < n; ++j) sum += bf2f(PROJ[(size_t)(t - j) * LDP + RWKV_COLS + c]);
                        dl[i * 512 + c] = sum / (float)n - bf2f(PROJ[(size_t)t * LDP + RWKV_COLS + c]); }
                    __syncthreads();
                    float acc[16];
#pragma unroll
                    for (int i = 0; i < 16; ++i) acc[i] = 0.f;
#pragma unroll 2
                    for (int cc = 0; cc < PG; ++cc) { const float w = pool_w[((size_t)g * PG + cc) * PG + dd];
#pragma unroll
                        for (int i = 0; i < 16; ++i) acc[i] += dl[i * 512 + g * PG + cc] * w; }
#pragma unroll
                    for (int i = 0; i < 16; ++i) MIX[(size_t)(t0 + i) * D + RW + c] = f2bf(acc[i] * ps);
                }
            }
        }
        SEAM(pb + 3);

        if (IN(pb + 4)) { PHASE_IDS
            const int c = tid; const float lg = INP(19)[l * RW + c], lb = INP(20)[l * RW + c];
            for (int tile = bx; tile < T / 8; tile += G) {
                float y[8], g[8], bg[8];
#pragma unroll
                for (int i = 0; i < 8; ++i) { const size_t o = (size_t)(tile * 8 + i) * RW + c; y[i] = Y[o]; g[i] = bf2f(Gb[o]); bg[i] = bf2f(BGb[o]); }
#pragma unroll
                for (int i = 0; i < 8; ++i) { const float mean = wave_sum(y[i]) * (1.f / 64.f); const float d = y[i] - mean; const float var = wave_sum(d * d) * (1.f / 64.f);
                    const float yn = d * rsqrtf(var + GN_EPS) * lg + lb; MIX[(size_t)(tile * 8 + i) * D + c] = f2bf(yn * g[i] + bg[i]); }
            }
        }
        SEAM(pb + 4);
        if (IN(pb + 5)) { PHASE_IDS
            pg8::Gemm g{MIX, WoutT + (size_t)l * D * D, T, D, D}; pg8::StaticOrder S; S.init(T, D, G, bx);
            pg8::EpiResGate E{xin, X, modl + 2 * D};
            pg8::gemm_phase<pg8::EpiResGate, pg8::StaticOrder, true, true>(lds, g, S, E); }
        SEAM(pb + 5);
        if (IN(pb + 6)) { PHASE_IDS const float* gamma = INP(24) + l * D;
            for (int row = gw; row < T; row += NGW) { const int b = row / SEQ; norm_mod_row(X + (size_t)row * D, gamma, modl + (size_t)b * 6 * D + 3 * D, modl + (size_t)b * 6 * D + 4 * D, H + (size_t)row * D, lane); } }
        SEAM(pb + 6);
        if (IN(pb + 7)) { PHASE_IDS
            pg8::Gemm g{H, PqT + (size_t)l * PH * PQ * D, T, PH * PQ, D}; pg8::StaticOrder S; S.init(T, PH * PQ, G, bx);
            pg8::EpiBf16<0> E{Q, PH * PQ, nullptr, 0, 0, 1.f};
            pg8::gemm_phase<pg8::EpiBf16<0>, pg8::StaticOrder, true, true>(lds, g, S, E); }
        SEAM(pb + 7);

        if (IN(pb + 8)) { PHASE_IDS
            const bf16* KEYSl = KEYS + (size_t)l * PH * 2 * NKEYS * PHALF;
            LAS unsigned char* scr = lds + wave * 2048 + lane * 32;
            const int r = lane & 31, hh = lane >> 5;
            for (int it = gw; it < (T / 32) * PH; it += NGW) {
                const int tok = (it >> 3) * 32 + r, h = it & 7;
                unsigned sp0[16], sp1[16];
#pragma unroll
                for (int e = 0; e < 16; ++e) { sp0[e] = 0u; sp1[e] = 0u; }
#pragma unroll 1
                for (int p = 0; p < 2; ++p) {
                    const bf16* qp = Q + (size_t)tok * (PH * PQ) + h * PQ + p * PHALF + 8 * hh;
                    const bf16* kp_ = KEYSl + ((size_t)(h * 2 + p) * NKEYS + r) * PHALF + 8 * hh;
                    bf16x8_t bq[8];
#pragma unroll
                    for (int ks = 0; ks < 8; ++ks) bq[ks] = *(const bf16x8_t*)(qp + ks * 16);
                    unsigned best[16];
#pragma unroll
                    for (int e = 0; e < 16; ++e) best[e] = 0u;
#pragma unroll 1
                    for (int kt = 0; kt < 4; ++kt) {
                        f32x16 acc;
#pragma unroll
                        for (int e = 0; e < 16; ++e) acc[e] = 0.f;
#pragma unroll
                        for (int ks = 0; ks < 8; ++ks) { const bf16x8_t ak = *(const bf16x8_t*)(kp_ + (size_t)kt * 32 * PHALF + ks * 16); acc = __builtin_amdgcn_mfma_f32_32x32x16_bf16(ak, bq[ks], acc, 0, 0, 0); }
                        unsigned g[16];
#pragma unroll
                        for (int e = 0; e < 16; ++e) g[e] = pack_key7(acc[e], kt * 32 + (e & 3) + 8 * (e >> 2) + 4 * hh);
                        sort16_desc(g);
                        merge_top16(best, g);
                    }
                    unsigned ob[16];
#pragma unroll
                    for (int e = 0; e < 16; ++e) ob[e] = (unsigned)__shfl_xor((int)best[e], 32);
                    merge_top16(best, ob);
#pragma unroll
                    for (int e = 0; e < 16; ++e) { sp0[e] = p == 0 ? best[e] : sp0[e]; sp1[e] = p == 0 ? sp1[e] : best[e]; }
                }
                unsigned c2[32];
                stage2_cands(sp0, sp1, hh, c2);
                sort16_desc(c2); sort16_desc(c2 + 16); merge_top16(c2, c2 + 16);
                { unsigned ob[16];
#pragma unroll
                  for (int e = 0; e < 16; ++e) ob[e] = (unsigned)__shfl_xor((int)c2[e], 32);
                  merge_top16(c2, ob); }
#pragma unroll
                for (int e = 0; e < 16; e += 4) {
                    *(LAS unsigned*)(scr + e) = (127u - (sp0[e] & 127u)) | ((127u - (sp0[e + 1] & 127u)) << 8) | ((127u - (sp0[e + 2] & 127u)) << 16) | ((127u - (sp0[e + 3] & 127u)) << 24);
                    *(LAS unsigned*)(scr + 16 + e) = (127u - (sp1[e] & 127u)) | ((127u - (sp1[e + 1] & 127u)) << 8) | ((127u - (sp1[e + 2] & 127u)) << 16) | ((127u - (sp1[e + 3] & 127u)) << 24); }
                asm volatile("s_waitcnt lgkmcnt(0)" ::: "memory");
                float sm[16]; int ex[16];
#pragma unroll
                for (int e = 0; e < 16; ++e) { const unsigned key = c2[e]; sm[e] = unpack_key8(key); const int i0 = (key >> 4) & 15, j0 = key & 15; ex[e] = (int)scr[i0] * NKEYS + (int)scr[16 + j0]; }
                float den = 0.f;
#pragma unroll
                for (int e = 0; e < 16; ++e) { sm[e] = expf(sm[e] - unpack_key8(c2[0])); den += sm[e]; }
                const float inv = 1.f / den;
                if (hh == 0) {
                    int* ip = IDX + (size_t)tok * NE + h * TOPK; float* gp = GATE + (size_t)tok * NE + h * TOPK;
#pragma unroll
                    for (int e = 0; e < 16; e += 4) { *(int4*)(ip + e) = make_int4(ex[e], ex[e + 1], ex[e + 2], ex[e + 3]); *(f32x4*)(gp + e) = (f32x4){sm[e] * inv, sm[e + 1] * inv, sm[e + 2] * inv, sm[e + 3] * inv}; }
                }
                asm volatile("s_waitcnt lgkmcnt(0)" ::: "memory");
            }
        }
        SEAM(pb + 8);

        if (IN(pb + 9)) { PHASE_IDS
            const bf16* Ul = Ub + (size_t)l * NEXP * D; const bf16* Vtl = Vb + (size_t)l * NEXP * D; const float* lnf = INP(29);
            const bool fin = (l == DEPTH - 1);
            for (int t = gw; t < T; t += NGW) {
                const int b = t / SEQ;
                float hf[16];
                { const u32x4 h0 = *(const u32x4*)(H + (size_t)t * D + lane * 8), h1 = *(const u32x4*)(H + (size_t)t * D + 512 + lane * 8);
                  hf[0] = __uint_as_float(h0.x << 16); hf[1] = __uint_as_float(h0.x & 0xffff0000u); hf[2] = __uint_as_float(h0.y << 16); hf[3] = __uint_as_float(h0.y & 0xffff0000u);
                  hf[4] = __uint_as_float(h0.z << 16); hf[5] = __uint_as_float(h0.z & 0xffff0000u); hf[6] = __uint_as_float(h0.w << 16); hf[7] = __uint_as_float(h0.w & 0xffff0000u);
                  hf[8] = __uint_as_float(h1.x << 16); hf[9] = __uint_as_float(h1.x & 0xffff0000u); hf[10] = __uint_as_float(h1.y << 16); hf[11] = __uint_as_float(h1.y & 0xffff0000u);
                  hf[12] = __uint_as_float(h1.z << 16); hf[13] = __uint_as_float(h1.z & 0xffff0000u); hf[14] = __uint_as_float(h1.w << 16); hf[15] = __uint_as_float(h1.w & 0xffff0000u); }
                float acc[16];
#pragma unroll
                for (int i = 0; i < 16; ++i) acc[i] = 0.f;
#pragma unroll 1
                for (int half = 0; half < 2; ++half) {
                    const int myidx = IDX[(size_t)t * NE + half * 64 + lane]; const float mygate = GATE[(size_t)t * NE + half * 64 + lane];
                    float p[64];
#pragma unroll
                    for (int e = 0; e < 64; ++e) {
                        const int ei = __builtin_amdgcn_readlane(myidx, e);
                        const bf16* ur = Ul + (size_t)ei * D + lane * 8;
                        const u32x4 u0 = *(const u32x4*)ur, u1 = *(const u32x4*)(ur + 512);
                        float a = hf[0] * __uint_as_float(u0.x << 16);
                        a += hf[1] * __uint_as_float(u0.x & 0xffff0000u); a += hf[2] * __uint_as_float(u0.y << 16); a += hf[3] * __uint_as_float(u0.y & 0xffff0000u);
                        a += hf[4] * __uint_as_float(u0.z << 16); a += hf[5] * __uint_as_float(u0.z & 0xffff0000u); a += hf[6] * __uint_as_float(u0.w << 16); a += hf[7] * __uint_as_float(u0.w & 0xffff0000u);
                        a += hf[8] * __uint_as_float(u1.x << 16); a += hf[9] * __uint_as_float(u1.x & 0xffff0000u); a += hf[10] * __uint_as_float(u1.y << 16); a += hf[11] * __uint_as_float(u1.y & 0xffff0000u);
                        a += hf[12] * __uint_as_float(u1.z << 16); a += hf[13] * __uint_as_float(u1.z & 0xffff0000u); a += hf[14] * __uint_as_float(u1.w << 16); a += hf[15] * __uint_as_float(u1.w & 0xffff0000u);
                        p[e] = a;
                    }
#pragma unroll
                    for (int off = 32; off >= 1; off >>= 1) {
                        const bool up = (lane & off) != 0;
#pragma unroll
                        for (int i = 0; i < off; ++i) { const float keep = up ? p[i + off] : p[i], send = up ? p[i] : p[i + off]; p[i] = keep + __shfl_xor(send, off); }
                    }
                    const float coef = mygate * gelu_erf(p[0]);
#pragma unroll 8
                    for (int e = 0; e < 64; ++e) {
                        const int ei = __builtin_amdgcn_readlane(myidx, e); const float cf = __int_as_float(__builtin_amdgcn_readlane(__float_as_int(coef), e));
                        const bf16* vr = Vtl + (size_t)ei * D + lane * 8;
                        const u32x4 v0 = *(const u32x4*)vr, v1 = *(const u32x4*)(vr + 512);
                        acc[0] += cf * __uint_as_float(v0.x << 16); acc[1] += cf * __uint_as_float(v0.x & 0xffff0000u); acc[2] += cf * __uint_as_float(v0.y << 16); acc[3] += cf * __uint_as_float(v0.y & 0xffff0000u);
                        acc[4] += cf * __uint_as_float(v0.z << 16); acc[5] += cf * __uint_as_float(v0.z & 0xffff0000u); acc[6] += cf * __uint_as_float(v0.w << 16); acc[7] += cf * __uint_as_float(v0.w & 0xffff0000u);
                        acc[8] += cf * __uint_as_float(v1.x << 16); acc[9] += cf * __uint_as_float(v1.x & 0xffff0000u); acc[10] += cf * __uint_as_float(v1.y << 16); acc[11] += cf * __uint_as_float(v1.y & 0xffff0000u);
                        acc[12] += cf * __uint_as_float(v1.z << 16); acc[13] += cf * __uint_as_float(v1.z & 0xffff0000u); acc[14] += cf * __uint_as_float(v1.w << 16); acc[15] += cf * __uint_as_float(v1.w & 0xffff0000u);
                    }
                }
                float* xr = X + (size_t)t * D; const float* g2 = modl + (size_t)b * 6 * D + 5 * D;
                f32x4 xv[4]; float ss = 0.f;
#pragma unroll
                for (int q = 0; q < 4; ++q) { const int d = (q >> 1) * 512 + lane * 8 + (q & 1) * 4; const f32x4 xo = *(const f32x4*)(xr + d), gg = *(const f32x4*)(g2 + d);
                    xv[q] = xo + gg * (f32x4){acc[q * 4], acc[q * 4 + 1], acc[q * 4 + 2], acc[q * 4 + 3]}; ss += (xv[q].x * xv[q].x + xv[q].y * xv[q].y) + (xv[q].z * xv[q].z + xv[q].w * xv[q].w); }
                if (fin) { const float rs = rsqrtf(wave_sum(ss) * (1.f / D) + NORM_EPS);
#pragma unroll
                    for (int q = 0; q < 4; ++q) { const int d = (q >> 1) * 512 + lane * 8 + (q & 1) * 4; xv[q] = xv[q] * rs * *(const f32x4*)(lnf + d); } }
#pragma unroll
                for (int q = 0; q < 4; ++q) { const int d = (q >> 1) * 512 + lane * 8 + (q & 1) * 4; *(f32x4*)(xr + d) = xv[q]; }
            }
        }
    }
#undef modl
#undef xin
#undef IN
#undef SEAM
}
#undef MOD
#undef H
#undef PROJ
#undef Q
#undef MIX
#undef Rb
#undef Kb
#undef V0
#undef V1
#undef KKb
#undef Bb
#undef Gb
#undef BGb
#undef Wd
#undef Y
#undef IDX
#undef GATE
#undef WinT
#undef WoutT
#undef PqT
#undef KEYS
#undef Ub
#undef Vb
#undef INP
#undef PHASE_IDS

extern "C" void kernel_launch(void* const* d_in, const int* in_sizes, int n_in, void* d_out, int out_size, void* d_ws, size_t ws_size, hipStream_t stream) {
    if (n_in != 30 || ws_size < WS_END) { fprintf(stderr, "kernel_launch: unexpected n_in %d / ws_size %zu\n", n_in, ws_size); return; }
    static int grid = 0;
    if (grid == 0) {
        int dev = 0, cus = 0, per_cu = 0;
        (void)hipGetDevice(&dev); (void)hipDeviceGetAttribute(&cus, hipDeviceAttributeMultiprocessorCount, dev);
        if (hipFuncSetAttribute((const void*)mega, hipFuncAttributeMaxDynamicSharedMemorySize, LDS_BYTES) != hipSuccess) { fprintf(stderr, "hipFuncSetAttribute failed\n"); grid = -1; return; }
        if (hipOccupancyMaxActiveBlocksPerMultiprocessor(&per_cu, (const void*)mega, NTHR, LDS_BYTES) != hipSuccess || per_cu < 1) { fprintf(stderr, "occupancy query failed (%d)\n", per_cu); per_cu = 1; }
        (void)hipGetLastError();
        grid = (cus > 0 ? cus : 256) * 1;
    }
    if (grid < 0) return;
    Args a{}; for (int i = 0; i < 30; ++i) a.in[i] = (const float*)d_in[i]; a.out = (float*)d_out; a.ws = (unsigned char*)d_ws;
    a.ph_lo = 0; a.ph_hi = NPH;
    void* kargs[] = {&a};
    hipError_t e = hipLaunchCooperativeKernel((const void*)mega, dim3(grid), dim3(NTHR), kargs, LDS_BYTES, stream);
    if (e != hipSuccess) fprintf(stderr, "cooperative launch failed: %s (grid %d)\n", hipGetErrorString(e), grid);
}
```

```cpp
#include <hip/hip_runtime.h>
#include <hip/hip_cooperative_groups.h>
namespace cg = cooperative_groups;
#include <cstdio>
#include <cstdint>
#include <cmath>

constexpr int D = 1024, BATCH = 4, SEQ = 4096, T = BATCH * SEQ, DEPTH = 2;
constexpr int RW = 512, HS = 64, NH = 8;
constexpr int DL = 64, AL = 64, MVL = 32, GL = 128;
constexpr int RWKV_COLS = 3 * RW + DL + AL + GL;
constexpr int PW = 512, PG = 128;
constexpr int IN_COLS = RWKV_COLS + PW;
constexpr int LDP = 2560;
constexpr int NKEYS = 128, NEXP = NKEYS * NKEYS, PH = 8, PQ = 256, PHALF = 128, TOPK = 16;
constexpr int NE = PH * TOPK;
constexpr float NORM_EPS = 1e-6f, GN_EPS = 64e-5f;

typedef unsigned short bf16;
__device__ __forceinline__ float bf2f(bf16 u) { return __uint_as_float((unsigned)u << 16); }
__device__ __forceinline__ bf16 f2bf(float f) { unsigned u = __float_as_uint(f); return (bf16)((u + 0x7fffu + ((u >> 16) & 1u)) >> 16); }

constexpr size_t MiB = 1u << 20;
constexpr size_t WS_MOD = 1 * MiB;
constexpr size_t WS_US = 1 * MiB + 256 * 1024;
constexpr size_t WS_VS = 1 * MiB + 512 * 1024;
constexpr size_t WS_H = 2 * MiB;
constexpr size_t WS_PROJ = 34 * MiB;
constexpr size_t WS_Q = WS_PROJ;
constexpr size_t WS_R = 114 * MiB;
constexpr size_t WS_K = 130 * MiB;
constexpr size_t WS_V0 = 146 * MiB;
constexpr size_t WS_V1 = 162 * MiB;
constexpr size_t WS_KK = 178 * MiB;
constexpr size_t WS_B = 194 * MiB;
constexpr size_t WS_G = 210 * MiB;
constexpr size_t WS_BG = 226 * MiB;
constexpr size_t WS_W = 242 * MiB;
constexpr size_t WS_Y = 274 * MiB;
constexpr size_t WS_MIX = 306 * MiB;
constexpr size_t WS_IDX = 338 * MiB;
constexpr size_t WS_GATE = 346 * MiB;
constexpr size_t WS_WIN_T = 354 * MiB;
constexpr size_t WS_WOUT_T = 364 * MiB;
constexpr size_t WS_PQ_T = 368 * MiB;
constexpr size_t WS_KEYS = 376 * MiB;
constexpr size_t WS_U = 378 * MiB;
constexpr size_t WS_V = 442 * MiB;
constexpr size_t WS_END = 506 * MiB;

__device__ __forceinline__ float wave_sum(float v) {
#pragma unroll
    for (int o = 1; o < 64; o <<= 1) v += __shfl_xor(v, o);
    return v;
}
__device__ __forceinline__ float sigmoidf_(float x) { return 1.f / (1.f + expf(-x)); }

namespace pg8 {
#define PG8_LAS __attribute__((address_space(3)))
typedef unsigned short bf16_t;
typedef short bf16x8 __attribute__((ext_vector_type(8)));
typedef float f32x4 __attribute__((ext_vector_type(4)));
typedef unsigned u32x4 __attribute__((ext_vector_type(4)));
constexpr int BM = 256, BK = 64, HALF = 128, HTB = HALF * BK * 2  , STAGE_BYTES = 8 * HTB, NXCD = 8, WGM = 8;

__host__ __device__ __forceinline__ int lds_byte(int r, int c) { const int st = (r >> 4) * 2 + (c >> 5), rr = r & 15, cc = c & 31, ob = rr * 64 + cc * 2; return st * 1024 + (ob ^ (((ob >> 9) & 1) << 5)); }
__host__ __device__ __forceinline__ void stage_rc(int b, int& R, int& C) { const int st = b / 1024, sb = b % 1024, swz = sb ^ (((sb >> 9) & 1) << 5); R = (st >> 1) * 16 + swz / 64; C = (st & 1) * 32 + (swz % 64) / 2; }
__host__ __device__ __forceinline__ int perm32(int rho) { const int n = rho >> 4, i = rho & 15; return 8 * (i >> 2) + 4 * n + (i & 3); }

struct Unit { int pm, pn; };
struct Gemm { const bf16_t* A; const bf16_t* Bt; int M, N, K; };

struct StaticOrder {
    int nM, nN, nwg, G, c;
    __host__ __device__ void init(int M, int N, int G_, int c_) { nM = M / BM; nN = N / BM; nwg = nM * nN; G = G_; c = c_; }
    __host__ __device__ bool next(int i, Unit& u) const {
        const long L = (long)i * G + c; if (L >= nwg) return false;
        int wgid = (int)L; { const int q = nwg / NXCD, r = nwg % NXCD, xcd = wgid % NXCD, off = wgid / NXCD; wgid = (xcd < r ? xcd * (q + 1) : r * (q + 1) + (xcd - r) * q) + off; }
        const int nig = WGM * nN, gid = wgid / nig, fm = gid * WGM, gsz = (nM - fm) < WGM ? (nM - fm) : WGM;
        u.pm = fm + ((wgid % nig) % gsz); u.pn = (wgid % nig) / gsz; return true;
    }
    __device__ __forceinline__ void a_ready(const Unit&) const {}
    __device__ __forceinline__ void done(const Unit&) const {}
};

__device__ __forceinline__ unsigned cvt_pk_bf16(float lo, float hi) { unsigned r; asm volatile("v_cvt_pk_bf16_f32 %0, %1, %2" : "=v"(r) : "v"(lo), "v"(hi)); return r; }
typedef float f32x2 __attribute__((ext_vector_type(2)));
__device__ __forceinline__ f32x2 gelu_pk(f32x2 v) {
    const f32x2 av = __builtin_elementwise_abs(v), d = av * 0.2316418882f + 1.0f;
    f32x2 t; t.x = __builtin_amdgcn_rcpf(d.x); t.y = __builtin_amdgcn_rcpf(d.y);
    f32x2 q = t * 0.5307027145f + (-0.7265760135f); q = q * t + 0.7107068705f; q = q * t + (-0.142248368f); q = q * t + 0.127414796f; q = q * t;
    const f32x2 s = (v * v) * (-0.72134752044f);
    f32x2 e; e.x = __builtin_amdgcn_exp2f(s.x); e.y = __builtin_amdgcn_exp2f(s.y);
    const f32x2 m = v * (q * e), r = v - m;
    f32x2 o; o.x = v.x < 0.f ? m.x : r.x; o.y = v.y < 0.f ? m.y : r.y; return o;
}

template <int ACT  > struct EpiBf16 {
    static constexpr bool PERM = true, AFTER_DRAIN = false; static_assert(ACT == 0 || ACT == 1, "EpiBf16: ACT is 0 (none) or 1 (gelu_pk)");
    bf16_t* O; int ldc; const float* bias; int split_cols; size_t split_stride; float scale0;
    __device__ __forceinline__ void operator()(const f32x4 (&acc)[2][2][4][2], const Unit& u, int wr, int wc, int fr, int fq) const {
        const int row0 = u.pm * BM + wr * 64 + fr; int colt = u.pn * BM; bf16_t* base = O;
        float sc = 1.f; if (split_cols) { const int t = colt / split_cols; base += (size_t)t * split_stride; colt -= t * split_cols; if (t == 0) sc = scale0; }
        const int col0 = colt + wc * 32 + 8 * fq, bcol0 = u.pn * BM + wc * 32 + 8 * fq;
        f32x4 bv[2][2];
#pragma unroll
        for (int bj = 0; bj < 2; ++bj)
#pragma unroll
            for (int n = 0; n < 2; ++n) bv[bj][n] = bias ? *(const f32x4*)(bias + bcol0 + bj * HALF + 4 * n) : (f32x4){0.f, 0.f, 0.f, 0.f};
#pragma unroll
        for (int ai = 0; ai < 2; ++ai)
#pragma unroll
            for (int m = 0; m < 4; ++m) { bf16_t* rowp = base + (size_t)(row0 + ai * HALF + m * 16) * ldc + col0;
#pragma unroll
                for (int bj = 0; bj < 2; ++bj) { f32x4 v0 = acc[ai][bj][m][0] + bv[bj][0], v1 = acc[ai][bj][m][1] + bv[bj][1];
                    if (ACT == 1) { f32x2 a = gelu_pk((f32x2){v0[0], v0[1]}), b = gelu_pk((f32x2){v0[2], v0[3]}), c = gelu_pk((f32x2){v1[0], v1[1]}), d = gelu_pk((f32x2){v1[2], v1[3]});
                        v0 = (f32x4){a.x, a.y, b.x, b.y}; v1 = (f32x4){c.x, c.y, d.x, d.y}; }
                    v0 = v0 * sc; v1 = v1 * sc; u32x4 w; w.x = cvt_pk_bf16(v0[0], v0[1]); w.y = cvt_pk_bf16(v0[2], v0[3]); w.z = cvt_pk_bf16(v1[0], v1[1]); w.w = cvt_pk_bf16(v1[2], v1[3]);
                    *(u32x4*)(rowp + bj * HALF) = w; } }
    }
};

struct EpiResGate {
    static constexpr bool PERM = false, AFTER_DRAIN = false;
    const float* xold; float* X; const float* gate;
    __device__ __forceinline__ void operator()(const f32x4 (&acc)[2][2][4][2], const Unit& u, int wr, int wc, int fr, int fq) const {
        const int col0 = u.pn * BM + wc * 32 + 4 * fq; const int b = (u.pm * BM) / SEQ;
        f32x4 gv[2][2];
#pragma unroll
        for (int bj = 0; bj < 2; ++bj)
#pragma unroll
            for (int n = 0; n < 2; ++n) gv[bj][n] = *(const f32x4*)(gate + (size_t)b * 6 * D + col0 + bj * HALF + n * 16);
#pragma unroll
        for (int ai = 0; ai < 2; ++ai)
#pragma unroll
            for (int m = 0; m < 4; ++m) { const size_t off = (size_t)(u.pm * BM + ai * HALF + wr * 64 + m * 16 + fr) * D + col0;
#pragma unroll
                for (int bj = 0; bj < 2; ++bj)
#pragma unroll
                    for (int n = 0; n < 2; ++n) { const f32x4 xo = *(const f32x4*)(xold + off + bj * HALF + n * 16); *(f32x4*)(X + off + bj * HALF + n * 16) = xo + gv[bj][n] * acc[ai][bj][m][n]; } }
    }
};
template <class Epi, class Sched, bool ALIGN_EPI = false, bool SP2 = false>
__device__ __forceinline__ void gemm_phase(PG8_LAS unsigned char* lds, const Gemm g, const Sched& S, const Epi& E) {
    const int tid = threadIdx.x, wid = __builtin_amdgcn_readfirstlane(tid >> 6), lane = tid & 63, wr = wid >> 2, wc = wid & 3, fr = lane & 15, fq = lane >> 4;
    const int K = g.K, nt = K / BK;
    unsigned voffA[2], voffB[2];
#pragma unroll
    for (int i = 0; i < 2; ++i) { int R, C; stage_rc(tid * 16 + i * 8192, R, C); const int Rb = Epi::PERM ? ((R & ~31) + perm32(R & 31)) : R;
        voffA[i] = (unsigned)(R * K + C) * 2u; voffB[i] = (unsigned)(Rb * K + C) * 2u; }
    const size_t kstep = (size_t)(BK * 2);
    const size_t hstep = (size_t)HALF * K * 2;
    const size_t tstep = 2 * hstep;
    const unsigned ldsw = (unsigned)wid * 1024u;
    const int aoff = lds_byte(wr * 64 + fr, fq * 8), boff = lds_byte(wc * 32 + fr, fq * 8);
#define PG8_SA(b, h) (((b) * 2 + (h)) * HTB)
#define PG8_SB(b, h) ((4 + (b) * 2 + (h)) * HTB)
#define PG8_STAGE(bufoff, gbase, voff) do { _Pragma("unroll") for (int _i = 0; _i < 2; ++_i) \
        __builtin_amdgcn_global_load_lds((const unsigned*)((const char*)(gbase) + (voff)[_i]), (PG8_LAS unsigned*)(lds + (bufoff) + ldsw + _i * 8192), 16, 0, 0); } while (0)
#define PG8_LDA(dst, b, h) do { _Pragma("unroll") for (int m = 0; m < 4; ++m) _Pragma("unroll") for (int k = 0; k < 2; ++k) dst[m][k] = *(const PG8_LAS bf16x8*)(lds + PG8_SA(b, h) + aoff + m * 2048 + k * 1024); } while (0)
#define PG8_LDB(dst, b, h) do { _Pragma("unroll") for (int n = 0; n < 2; ++n) _Pragma("unroll") for (int k = 0; k < 2; ++k) dst[n][k] = *(const PG8_LAS bf16x8*)(lds + PG8_SB(b, h) + boff + n * 2048 + k * 1024); } while (0)
#define PG8_MMA(ai, bj, At, Bt) do { __builtin_amdgcn_s_setprio(1); _Pragma("unroll") for (int m = 0; m < 4; ++m) _Pragma("unroll") for (int n = 0; n < 2; ++n) _Pragma("unroll") for (int k = 0; k < 2; ++k) \
        acc[ai][bj][m][n] = __builtin_amdgcn_mfma_f32_16x16x32_bf16(Bt[n][k], At[m][k], acc[ai][bj][m][n], 0, 0, 0); __builtin_amdgcn_s_setprio(0); } while (0)
#define PG8_WAIT_V(n) asm volatile("s_waitcnt vmcnt(" #n ")" ::: "memory")
#define PG8_WAIT_L(n) asm volatile("s_waitcnt lgkmcnt(" #n ")" ::: "memory")
#define PG8_BAR __builtin_amdgcn_s_barrier()
#define PG8_SCHED __builtin_amdgcn_sched_barrier(0)
    Unit cur, nxt; int ui = 0;
    if (!S.next(0, cur)) return;
    f32x4 acc[2][2][4][2];
#pragma unroll
    for (int a = 0; a < 2; ++a)
#pragma unroll
        for (int b = 0; b < 2; ++b)
#pragma unroll
            for (int m = 0; m < 4; ++m)
#pragma unroll
                for (int n = 0; n < 2; ++n) acc[a][b][m][n] = (f32x4){0.f, 0.f, 0.f, 0.f};
    bf16x8 At[4][2], B0[2][2], B1[2][2];
    const char* cA = (const char*)g.A + (size_t)cur.pm * tstep; const char* cB = (const char*)g.Bt + (size_t)cur.pn * tstep;
    S.a_ready(cur);
    if constexpr (SP2) {
        PG8_STAGE(PG8_SB(0, 0), cB, voffB); PG8_STAGE(PG8_SB(0, 1), cB + hstep, voffB); PG8_STAGE(PG8_SA(0, 0), cA, voffA); PG8_STAGE(PG8_SA(0, 1), cA + hstep, voffA);
        if (wr == 1) PG8_BAR;
        PG8_WAIT_V(2); PG8_BAR;
        PG8_STAGE(PG8_SB(1, 0), cB + kstep, voffB); PG8_STAGE(PG8_SA(1, 0), cA + kstep, voffA); PG8_STAGE(PG8_SB(1, 1), cB + hstep + kstep, voffB);
        PG8_WAIT_V(6); PG8_BAR;
    } else {
        PG8_STAGE(PG8_SB(0, 0), cB, voffB); PG8_STAGE(PG8_SA(0, 0), cA, voffA); PG8_STAGE(PG8_SB(0, 1), cB + hstep, voffB); PG8_STAGE(PG8_SA(0, 1), cA + hstep, voffA);
        if (wr == 1) PG8_BAR;
        PG8_WAIT_V(4); PG8_BAR;
        PG8_STAGE(PG8_SB(1, 0), cB + kstep, voffB); PG8_STAGE(PG8_SA(1, 0), cA + kstep, voffA); PG8_STAGE(PG8_SB(1, 1), cB + hstep + kstep, voffB);
        PG8_WAIT_V(6); PG8_BAR;
    }
    for (;;) {
        const bool has_next = S.next(ui + 1, nxt);
        const char* nA = has_next ? (const char*)g.A + (size_t)nxt.pm * tstep : cA; const char* nB = has_next ? (const char*)g.Bt + (size_t)nxt.pn * tstep : cB;
        for (int t = 0; t < nt; t += 2) {
            const bool last = (t == nt - 2);
            const char* a1 = cA + (size_t)(t + 1) * kstep;
            const char* a2 = last ? nA : cA + (size_t)(t + 2) * kstep; const char* b2 = last ? nB : cB + (size_t)(t + 2) * kstep;
            const char* a3 = a2 + kstep; const char* b3 = b2 + kstep;
            if (last && has_next) S.a_ready(nxt);
            if constexpr (SP2) {
            PG8_LDB(B0, 0, 0); PG8_LDB(B1, 0, 1); PG8_SCHED; PG8_LDA(At, 0, 0); PG8_STAGE(PG8_SA(1, 1), a1 + hstep, voffA);
            PG8_WAIT_V(8); PG8_WAIT_L(0); PG8_BAR; PG8_MMA(0, 0, At, B0); PG8_MMA(0, 1, At, B1); PG8_BAR; PG8_SCHED;
            PG8_LDA(At, 0, 1); PG8_STAGE(PG8_SB(0, 0), b2, voffB); PG8_STAGE(PG8_SB(0, 1), b2 + hstep, voffB); PG8_STAGE(PG8_SA(0, 0), a2, voffA);
            PG8_WAIT_V(8); PG8_WAIT_L(0); PG8_BAR; PG8_MMA(1, 0, At, B0); PG8_MMA(1, 1, At, B1); PG8_BAR; PG8_SCHED;
            PG8_LDB(B0, 1, 0); PG8_LDB(B1, 1, 1); PG8_SCHED; PG8_LDA(At, 1, 0); PG8_STAGE(PG8_SA(0, 1), a2 + hstep, voffA);
            PG8_WAIT_V(8); PG8_WAIT_L(0); PG8_BAR; PG8_MMA(0, 0, At, B0); PG8_MMA(0, 1, At, B1); PG8_BAR; PG8_SCHED;
            PG8_LDA(At, 1, 1); PG8_STAGE(PG8_SB(1, 0), b3, voffB); PG8_STAGE(PG8_SB(1, 1), b3 + hstep, voffB); PG8_STAGE(PG8_SA(1, 0), a3, voffA);
            PG8_WAIT_V(8); PG8_WAIT_L(0); PG8_BAR; PG8_MMA(1, 0, At, B0); PG8_MMA(1, 1, At, B1); PG8_BAR; PG8_SCHED;
            } else {
            PG8_LDB(B0, 0, 0); PG8_SCHED; PG8_LDA(At, 0, 0); PG8_STAGE(PG8_SA(1, 1), a1 + hstep, voffA);
            PG8_WAIT_L(8); PG8_BAR; PG8_WAIT_L(0); PG8_MMA(0, 0, At, B0); PG8_BAR; PG8_SCHED;
            PG8_LDB(B1, 0, 1); PG8_STAGE(PG8_SB(0, 0), b2, voffB);
            PG8_BAR; PG8_WAIT_L(0); PG8_MMA(0, 1, At, B1); PG8_BAR;
            PG8_LDA(At, 0, 1); PG8_STAGE(PG8_SA(0, 0), a2, voffA);
            PG8_BAR; PG8_WAIT_L(0); PG8_MMA(1, 0, At, B0); PG8_BAR; PG8_SCHED;
            PG8_STAGE(PG8_SB(0, 1), b2 + hstep, voffB);
            PG8_WAIT_V(6); PG8_BAR; PG8_MMA(1, 1, At, B1); PG8_BAR;
            PG8_LDB(B0, 1, 0); PG8_SCHED; PG8_LDA(At, 1, 0); PG8_STAGE(PG8_SA(0, 1), a2 + hstep, voffA);
            PG8_WAIT_L(8); PG8_BAR; PG8_WAIT_L(0); PG8_MMA(0, 0, At, B0); PG8_BAR; PG8_SCHED;
            PG8_LDB(B1, 1, 1); PG8_STAGE(PG8_SB(1, 0), b3, voffB);
            PG8_BAR; PG8_WAIT_L(0); PG8_MMA(0, 1, At, B1); PG8_BAR;
            PG8_LDA(At, 1, 1); PG8_STAGE(PG8_SA(1, 0), a3, voffA);
            PG8_BAR; PG8_WAIT_L(0); PG8_MMA(1, 0, At, B0); PG8_BAR; PG8_SCHED;
            PG8_STAGE(PG8_SB(1, 1), b3 + hstep, voffB);
            PG8_WAIT_V(6); PG8_BAR; PG8_MMA(1, 1, At, B1); PG8_BAR;
            }
        }
        if constexpr (ALIGN_EPI) { if (wr == 0) PG8_BAR; }
        if constexpr (!Epi::AFTER_DRAIN) { E(acc, cur, wr, wc, fr, fq); S.done(cur); }
        if (!has_next) break;
#pragma unroll
        for (int a = 0; a < 2; ++a)
#pragma unroll
            for (int b = 0; b < 2; ++b)
#pragma unroll
                for (int m = 0; m < 4; ++m)
#pragma unroll
                    for (int n = 0; n < 2; ++n) acc[a][b][m][n] = (f32x4){0.f, 0.f, 0.f, 0.f};
        cur = nxt; cA = nA; cB = nB; ++ui;
        if constexpr (ALIGN_EPI) { if (wr == 1) PG8_BAR; }
    }
    PG8_WAIT_V(0);
    if constexpr (!ALIGN_EPI) { if (wr == 0) PG8_BAR; }
    PG8_BAR;
    if constexpr (Epi::AFTER_DRAIN) { E.fused(acc, cur, wr, wc, fr, fq, lds, wid, lane); S.done(cur); }
#undef PG8_SA
#undef PG8_SB
#undef PG8_STAGE
#undef PG8_LDA
#undef PG8_LDB
#undef PG8_MMA
#undef PG8_WAIT_V
#undef PG8_WAIT_L
#undef PG8_BAR
#undef PG8_SCHED
}
}

#define LAS __attribute__((address_space(3)))
constexpr int NWAVES = 8, NTHR = 512;
constexpr int LDS_BYTES = 147456;
constexpr int NPH = 21;
typedef float f32x4 __attribute__((ext_vector_type(4)));
typedef unsigned u32x4 __attribute__((ext_vector_type(4)));

struct Args { const float* in[30]; float* out; unsigned char* ws; int ph_lo, ph_hi; };

__device__ __forceinline__ unsigned pk2(float lo, float hi) { return (unsigned)f2bf(lo) | ((unsigned)f2bf(hi) << 16); }

__device__ __forceinline__ void p0_transpose_item(const float* W, int K, int N, bf16* WT, int row_off, LAS float* scr, int item, int lane) {
    const int nblk = N / 32, kb = item / nblk, nb = item % nblk, k0 = 64 * kb, n0 = 32 * nb;
#pragma unroll 8
    for (int i = 0; i < 32; ++i) { const int kk = 2 * i + (lane >> 5); scr[kk * 33 + (lane & 31)] = W[(size_t)(k0 + kk) * N + n0 + (lane & 31)]; }
    asm volatile("s_waitcnt lgkmcnt(0)" ::: "memory");
    const int c = lane & 7;
#pragma unroll
    for (int j = 0; j < 4; ++j) { const int n = (lane >> 3) + 8 * j; const LAS float* s = scr + (8 * c) * 33 + n;
        u32x4 o; o.x = pk2(s[0 * 33], s[1 * 33]); o.y = pk2(s[2 * 33], s[3 * 33]); o.z = pk2(s[4 * 33], s[5 * 33]); o.w = pk2(s[6 * 33], s[7 * 33]);
        *(u32x4*)(WT + (size_t)(row_off + n0 + n) * K + k0 + 8 * c) = o; }
    asm volatile("s_waitcnt lgkmcnt(0)" ::: "memory");
}

__device__ __forceinline__ void norm_mod_row(const float* xr, const float* gamma, const float* sh, const float* sc, bf16* orow, int lane) {
    f32x4 v[4]; float ss = 0.f;
#pragma unroll
    for (int j = 0; j < 4; ++j) { v[j] = *(const f32x4*)(xr + j * 256 + lane * 4); ss += (v[j].x * v[j].x + v[j].y * v[j].y) + (v[j].z * v[j].z + v[j].w * v[j].w); }
    const float rs = rsqrtf(wave_sum(ss) * (1.f / D) + NORM_EPS);
#pragma unroll
    for (int j = 0; j < 4; ++j) { const int d = j * 256 + lane * 4; const f32x4 g = *(const f32x4*)(gamma + d), a = *(const f32x4*)(sc + d), s = *(const f32x4*)(sh + d);
        const f32x4 y = v[j] * rs * g * (a + 1.f) + s; uint2 o; o.x = pk2(y.x, y.y); o.y = pk2(y.z, y.w); *(uint2*)(orow + d) = o; }
}


#define XB_TMO      128
#define XB_XCNT(j)  (256  + 64 * (j))
#define XB_XSUB(j)  (1280 + 64 * (j))
#define XB_XGEN(j)  (2304 + 64 * (j))
#define XB_TOP      3328
#define XB_TOPGEN   3392
#define XCD_BAR_WORDS 3456
#define XB_SPIN_CAP (1u << 18)

__device__ __forceinline__ unsigned xb_ld(unsigned* p)              { return __hip_atomic_load(p, __ATOMIC_RELAXED, __HIP_MEMORY_SCOPE_AGENT); }
__device__ __forceinline__ unsigned xb_add(unsigned* p, unsigned v) { return __hip_atomic_fetch_add(p, v, __ATOMIC_RELAXED, __HIP_MEMORY_SCOPE_AGENT); }
__device__ __forceinline__ unsigned xb_xcc_id() { return (unsigned)__builtin_amdgcn_s_getreg((3 << 11) | 20) & 0xFu; }
#define XB_SPIN(cond, bar) do { unsigned _sp = 0; while (cond) { __builtin_amdgcn_s_sleep(1); \
    if ((++_sp & 255u) == 0u) { if (xb_ld(&(bar)[XB_TMO])) break; if (_sp > XB_SPIN_CAP) { atomicAdd(&(bar)[XB_TMO], 1u); break; } } } } while (0)

struct XcdBarrier {
    unsigned* bar; unsigned x;
    volatile __attribute__((address_space(3))) unsigned* st;
};

__device__ __forceinline__ XcdBarrier xcd_barrier_post(unsigned* bar, volatile __attribute__((address_space(3))) unsigned* st) {
    XcdBarrier b; b.bar = bar; b.x = xb_xcc_id(); b.st = st;
    if (threadIdx.x == 0) (void)xb_add(&bar[XB_XCNT(b.x)], 1u);
    return b;
}
__device__ __forceinline__ void xcd_barrier_complete(unsigned* bar, unsigned x, unsigned& nloc, unsigned& nx) {
    const unsigned G = gridDim.x * gridDim.y * gridDim.z;
    unsigned sum, cnt, mine, sp = 0u;
    for (;;) {
        sum = 0u; cnt = 0u; mine = 0u;
#pragma unroll
        for (unsigned j = 0; j < 16; ++j) { const unsigned c = xb_ld(&bar[XB_XCNT(j)]); sum += c; cnt += (c > 0u) ? 1u : 0u; mine = (j == x) ? c : mine; }
        if (sum == G) break;
        __builtin_amdgcn_s_sleep(1);
        if ((++sp & 255u) == 0u) { if (xb_ld(&bar[XB_TMO])) break; if (sp > XB_SPIN_CAP) { atomicAdd(&bar[XB_TMO], 1u); break; } }
    }
    nloc = mine > 0u ? mine : 1u; nx = cnt > 0u ? cnt : 1u;
}

__device__ __forceinline__ void xcd_barrier(const XcdBarrier& b) {
    asm volatile("s_waitcnt vmcnt(0)" ::: "memory");
    __syncthreads();
    if (threadIdx.x == 0) {
        unsigned* bar = b.bar;
        __builtin_amdgcn_s_waitcnt(0);
        unsigned nloc = b.st[0], nx = b.st[1];
        if (nloc == 0u) { xcd_barrier_complete(bar, b.x, nloc, nx); b.st[0] = nloc; b.st[1] = nx; }
        const unsigned old = xb_add(&bar[XB_XSUB(b.x)], 1u);
        const unsigned gen = old / nloc;
        if (old + 1u == (gen + 1u) * nloc) {
            __builtin_amdgcn_fence(__ATOMIC_RELEASE, "agent");
            asm volatile("s_waitcnt vmcnt(0)" ::: "memory");
            const unsigned og = xb_add(&bar[XB_TOP], 1u);
            const unsigned tg = og / nx;
            if (og + 1u == (tg + 1u) * nx) xb_add(&bar[XB_TOPGEN], 1u);
            else XB_SPIN(xb_ld(&bar[XB_TOPGEN]) == tg, bar);
            __builtin_amdgcn_fence(__ATOMIC_ACQUIRE, "agent");
            xb_add(&bar[XB_XGEN(b.x)], 1u);
            asm volatile("s_waitcnt vmcnt(0)" ::: "memory");
        } else {
            XB_SPIN(xb_ld(&bar[XB_XGEN(b.x)]) == gen, bar);
            __builtin_amdgcn_fence(__ATOMIC_ACQUIRE, "agent");
            asm volatile("s_waitcnt vmcnt(0)" ::: "memory");
        }
    }
    __syncthreads();
}


__device__ __forceinline__ unsigned mono_u32(float f) { unsigned u = __float_as_uint(f); return (u & 0x80000000u) ? ~u : (u | 0x80000000u); }
__device__ __forceinline__ float demono_u32(unsigned u) { return __uint_as_float((u & 0x80000000u) ? (u & 0x7FFFFFFFu) : ~u); }
__device__ __forceinline__ unsigned pack_key7(float f, int idx) { return (mono_u32(f) & 0xFFFFFF80u) | (unsigned)(127 - idx); }
__device__ __forceinline__ float unpack_key7(unsigned k) { return demono_u32((k & 0xFFFFFF80u) | 0x40u); }
__device__ __forceinline__ float unpack_key8(unsigned k) { return demono_u32((k & 0xFFFFFF00u) | 0x80u); }
__device__ __forceinline__ void ce_desc(unsigned& a, unsigned& b) { const unsigned hi = a > b ? a : b, lo = a > b ? b : a; a = hi; b = lo; }
__device__ __forceinline__ void sort16_desc(unsigned* v) {
#pragma unroll
    for (int k = 2; k <= 16; k <<= 1)
#pragma unroll
        for (int j = k >> 1; j > 0; j >>= 1)
#pragma unroll
            for (int i = 0; i < 16; ++i) { const int l = i ^ j; if (l > i) { if ((i & k) == 0) ce_desc(v[i], v[l]); else ce_desc(v[l], v[i]); } }
}
__device__ __forceinline__ void bmerge16_desc(unsigned* v) {
#pragma unroll
    for (int j = 8; j > 0; j >>= 1)
#pragma unroll
        for (int i = 0; i < 16; ++i) { const int l = i ^ j; if (l > i) ce_desc(v[i], v[l]); }
}
__device__ __forceinline__ void merge_top16(unsigned* a, const unsigned* b) {
#pragma unroll
    for (int i = 0; i < 16; ++i) { const unsigned o = b[15 - i]; a[i] = a[i] > o ? a[i] : o; }
    bmerge16_desc(a);
}
__device__ __forceinline__ void stage2_cands(const unsigned* s0, const unsigned* s1, int hh, unsigned* c) {
    float A[16], B[16];
#pragma unroll
    for (int i = 0; i < 16; ++i) { const float f0 = unpack_key7(s0[i]), f1 = unpack_key7(s1[i]); A[i] = hh ? f1 : f0; B[i] = hh ? f0 : f1; }
    int n = 0;
#pragma unroll
    for (int i = 0; i < 4; ++i)
#pragma unroll
        for (int j = i; j < 16; ++j) { if ((i + 1) * (j + 1) > 16) continue;
            const float val = A[i] + B[j]; const unsigned id = hh ? (unsigned)((j << 4) | i) : (unsigned)((i << 4) | j);
            unsigned key = (mono_u32(val) & 0xFFFFFF00u) | id; if (hh && i == j) key = 0u; c[n++] = key; }
#pragma unroll
    for (; n < 32; ++n) c[n] = 0u;
}

template <int CTRL> __device__ __forceinline__ float dppf(float x) { return __int_as_float(__builtin_amdgcn_update_dpp(0, __float_as_int(x), CTRL, 0xF, 0xF, false)); }
__device__ __forceinline__ float red16(float x) { x += dppf<0xB1>(x); x += dppf<0x4E>(x); x += dppf<0x141>(x); x += dppf<0x140>(x); return x; }
typedef short bf16x8_t __attribute__((ext_vector_type(8)));
typedef float f32x16 __attribute__((ext_vector_type(16)));
__device__ __forceinline__ float gelu_erf(float a) { return 0.5f * a * (1.f + erff(a * 0.70710678118654752f)); }

__global__ void __launch_bounds__(NTHR, 2) mega(Args args) {
    extern __shared__ __attribute__((aligned(16))) unsigned char lds_raw[];
    LAS unsigned char* lds = (LAS unsigned char*)lds_raw;
    const int G = gridDim.x, bx = blockIdx.x, NGW = G * NWAVES;
    typedef const unsigned char __attribute__((address_space(4))) kbyte;
#define PHASE_IDS int tid = threadIdx.x; asm volatile("" : "+v"(tid)); const int lane = tid & 63, wave = __builtin_amdgcn_readfirstlane(tid >> 6), gw = bx * NWAVES + wave; (void)lane; (void)gw; \
    kbyte* kp = (kbyte*)__builtin_amdgcn_kernarg_segment_ptr(); asm volatile("" : "+s"(kp)); \
    unsigned char* const ws = *(unsigned char* const __attribute__((address_space(4)))*)(kp + 31 * 8); float* const X = *(float* const __attribute__((address_space(4)))*)(kp + 30 * 8); (void)ws; (void)X;
#define INP(i) (*(const float* const __attribute__((address_space(4)))*)(kp + (i) * 8))
#define MOD ((float*)(ws + WS_MOD))
#define H ((bf16*)(ws + WS_H))
#define PROJ ((bf16*)(ws + WS_PROJ))
#define Q ((bf16*)(ws + WS_Q))
#define MIX ((bf16*)(ws + WS_MIX))
#define Rb ((bf16*)(ws + WS_R))
#define Kb ((bf16*)(ws + WS_K))
#define V0 ((bf16*)(ws + WS_V0))
#define V1 ((bf16*)(ws + WS_V1))
#define KKb ((bf16*)(ws + WS_KK))
#define Bb ((bf16*)(ws + WS_B))
#define Gb ((bf16*)(ws + WS_G))
#define BGb ((bf16*)(ws + WS_BG))
#define Wd ((float*)(ws + WS_W))
#define Y ((float*)(ws + WS_Y))
#define IDX ((int*)(ws + WS_IDX))
#define GATE ((float*)(ws + WS_GATE))
#define WinT ((bf16*)(ws + WS_WIN_T))
#define WoutT ((bf16*)(ws + WS_WOUT_T))
#define PqT ((bf16*)(ws + WS_PQ_T))
#define KEYS ((bf16*)(ws + WS_KEYS))
#define U8 ((unsigned char*)(ws + WS_U))
#define V8 ((unsigned char*)(ws + WS_V))
#define USc ((float*)(ws + WS_US))
#define VSc ((float*)(ws + WS_VS))
    const int lo = args.ph_lo, hi = args.ph_hi;
    { volatile LAS unsigned* misc = (volatile LAS unsigned*)(lds + 131072 + 64); if (threadIdx.x < 4) misc[threadIdx.x] = 0u; __syncthreads(); }
    const XcdBarrier xbar = xcd_barrier_post((unsigned*)(args.ws) + 4096, (volatile LAS unsigned*)(lds + 131072 + 64));
#define IN(k) (lo <= (k) && (k) < hi)
#ifndef REP_PHASE
#define REP_PHASE (-1)
#endif
#define REPS(k) ((k) == REP_PHASE ? 3 : 1)
#define SEAM(k) do { if (IN(k) && IN((k) + 1)) { if ((k) == 0) cg::this_grid().sync(); else xcd_barrier(xbar); } } while (0)

    for (int rep_ = 0; rep_ < REPS(0); ++rep_) if (IN(0)) { PHASE_IDS
        { LAS float* ca = (LAS float*)lds; LAS float* red = (LAS float*)(lds + 16384);
          const float* c = INP(1); const float* ada_w = INP(2); const float* ada_b = INP(3);
          bool have = false;
          for (int it = bx; it < 96; it += G) {
              if (!have) { for (int i = tid; i < BATCH * D; i += NTHR) { const float v = c[i]; ca[i] = v / (1.f + expf(-v)); } have = true; __syncthreads(); }
              const int l = it / 48, n = (it % 48) * 128 + (tid & 127), kq = tid >> 7;
              const float* w = ada_w + (size_t)l * D * 6 * D + (size_t)(kq * 256) * 6 * D + n;
              float a0 = 0.f, a1 = 0.f, a2 = 0.f, a3 = 0.f;
#pragma unroll 8
              for (int k = 0; k < 256; ++k) { const float wv = w[(size_t)k * 6 * D]; const int kk = kq * 256 + k; a0 += ca[kk] * wv; a1 += ca[D + kk] * wv; a2 += ca[2 * D + kk] * wv; a3 += ca[3 * D + kk] * wv; }
              red[(kq * 4 + 0) * 128 + (tid & 127)] = a0; red[(kq * 4 + 1) * 128 + (tid & 127)] = a1; red[(kq * 4 + 2) * 128 + (tid & 127)] = a2; red[(kq * 4 + 3) * 128 + (tid & 127)] = a3;
              __syncthreads();
              { const int b = tid >> 7, col = tid & 127, nn = (it % 48) * 128 + col;
                const float s = red[(0 * 4 + b) * 128 + col] + red[(1 * 4 + b) * 128 + col] + red[(2 * 4 + b) * 128 + col] + red[(3 * 4 + b) * 128 + col];
                MOD[(size_t)l * BATCH * 6 * D + (size_t)b * 6 * D + nn] = s + ada_b[l * 6 * D + nn]; }
              __syncthreads();
          }
          __syncthreads(); }
        { LAS float* scr = (LAS float*)(lds + wave * 16384);
          constexpr int I_IN = (D / 64) * (IN_COLS / 32), I_VR = (D / 64) * (MVL / 32), I_OUT = (D / 64) * (D / 32), I_PQ = (D / 64) * (PH * PQ / 32);
          constexpr int NIT = 2 * I_IN + I_VR + 2 * I_OUT + 2 * I_PQ;
          for (int it = gw; it < NIT; it += NGW) { int r = it;
              if (r < 2 * I_IN) { const int l = r / I_IN; p0_transpose_item(INP(5) + (size_t)l * D * IN_COLS, D, IN_COLS, WinT + (size_t)l * LDP * D, 0, scr, r % I_IN, lane); continue; } r -= 2 * I_IN;
              if (r < I_VR) { p0_transpose_item(INP(12), D, MVL, WinT + (size_t)1 * LDP * D, IN_COLS, scr, r, lane); continue; } r -= I_VR;
              if (r < 2 * I_OUT) { const int l = r / I_OUT; p0_transpose_item(INP(23) + (size_t)l * D * D, D, D, WoutT + (size_t)l * D * D, 0, scr, r % I_OUT, lane); continue; } r -= 2 * I_OUT;
              { const int l = r / I_PQ; p0_transpose_item(INP(25) + (size_t)l * D * PH * PQ, D, PH * PQ, PqT + (size_t)l * PH * PQ * D, 0, scr, r % I_PQ, lane); } } }
        { const size_t gt = (size_t)bx * NTHR + tid, NT = (size_t)G * NTHR;
          constexpr size_t NK8 = (size_t)2 * PH * 2 * NKEYS * PHALF / 8;
          const float* src = INP(26); bf16* dst = KEYS;
          for (size_t i = gt; i < NK8; i += NT) {
              const f32x4 a = *(const f32x4*)(src + i * 8), b = *(const f32x4*)(src + i * 8 + 4);
              u32x4 o; o.x = pk2(a.x, a.y); o.y = pk2(a.z, a.w); o.z = pk2(b.x, b.y); o.w = pk2(b.z, b.w); *(u32x4*)(dst + i * 8) = o; }
          const float* pu = INP(27); const float* pv = INP(28);
          for (int row0 = gw * 2; row0 < 4 * NEXP; row0 += NGW * 2) {
              f32x4 v[2][4]; float m[2];
#pragma unroll
              for (int rr = 0; rr < 2; ++rr) { const int row = row0 + rr; const float* sp_ = (row < 2 * NEXP ? pu + (size_t)row * D : pv + (size_t)(row - 2 * NEXP) * D) + lane * 16;
#pragma unroll
                  for (int q = 0; q < 4; ++q) v[rr][q] = *(const f32x4*)(sp_ + q * 4); }
#pragma unroll
              for (int rr = 0; rr < 2; ++rr) { float mm = 0.f;
#pragma unroll
                  for (int q = 0; q < 4; ++q) mm = fmaxf(fmaxf(mm, fmaxf(fabsf(v[rr][q].x), fabsf(v[rr][q].y))), fmaxf(fabsf(v[rr][q].z), fabsf(v[rr][q].w)));
#pragma unroll
                  for (int o = 1; o < 64; o <<= 1) mm = fmaxf(mm, __shfl_xor(mm, o));
                  m[rr] = mm; }
#pragma unroll
              for (int rr = 0; rr < 2; ++rr) { const int row = row0 + rr; const float sc = m[rr] > 0.f ? 448.f / m[rr] : 1.f;
                  u32x4 o; int w;
                  w = 0; w = __builtin_amdgcn_cvt_pk_fp8_f32(v[rr][0].x * sc, v[rr][0].y * sc, w, false); w = __builtin_amdgcn_cvt_pk_fp8_f32(v[rr][0].z * sc, v[rr][0].w * sc, w, true); o.x = (unsigned)w;
                  w = 0; w = __builtin_amdgcn_cvt_pk_fp8_f32(v[rr][1].x * sc, v[rr][1].y * sc, w, false); w = __builtin_amdgcn_cvt_pk_fp8_f32(v[rr][1].z * sc, v[rr][1].w * sc, w, true); o.y = (unsigned)w;
                  w = 0; w = __builtin_amdgcn_cvt_pk_fp8_f32(v[rr][2].x * sc, v[rr][2].y * sc, w, false); w = __builtin_amdgcn_cvt_pk_fp8_f32(v[rr][2].z * sc, v[rr][2].w * sc, w, true); o.z = (unsigned)w;
                  w = 0; w = __builtin_amdgcn_cvt_pk_fp8_f32(v[rr][3].x * sc, v[rr][3].y * sc, w, false); w = __builtin_amdgcn_cvt_pk_fp8_f32(v[rr][3].z * sc, v[rr][3].w * sc, w, true); o.w = (unsigned)w;
                  unsigned char* d8 = (row < 2 * NEXP ? U8 + (size_t)row * D : V8 + (size_t)(row - 2 * NEXP) * D) + lane * 16;
                  *(u32x4*)d8 = o;
                  if (lane == 0) { if (row < 2 * NEXP) USc[row] = m[rr] > 0.f ? m[rr] * (1.f / 448.f) : 1.f; else VSc[row - 2 * NEXP] = m[rr] > 0.f ? m[rr] * (1.f / 448.f) : 1.f; } }
          } }
    }
    SEAM(0);

#pragma unroll
    for (int l = 0; l < DEPTH; ++l) {
        const int pb = 1 + 10 * l;
#define modl (MOD + (size_t)l * BATCH * 6 * D)
#define xin (l == 0 ? INP(0) : (const float*)X)
        for (int rep_ = 0; rep_ < REPS(pb + 0); ++rep_) if (IN(pb + 0)) { PHASE_IDS const float* gamma = INP(4) + l * D;
            for (int row = gw; row < T; row += NGW) { const int b = row / SEQ; norm_mod_row(xin + (size_t)row * D, gamma, modl + (size_t)b * 6 * D, modl + (size_t)b * 6 * D + D, H + (size_t)row * D, lane); } }
        SEAM(pb + 0);
        for (int rep_ = 0; rep_ < REPS(pb + 1); ++rep_) if (IN(pb + 1)) { PHASE_IDS const int N1 = l == 0 ? IN_COLS : LDP;
            pg8::Gemm g{H, WinT + (size_t)l * LDP * D, T, N1, D}; pg8::StaticOrder S; S.init(T, N1, G, bx);
            pg8::EpiBf16<0> E{PROJ, LDP, nullptr, 0, 0, 1.f};
            pg8::gemm_phase<pg8::EpiBf16<0>, pg8::StaticOrder, true, true>(lds, g, S, E); }
        SEAM(pb + 1);

        for (int rep_ = 0; rep_ < REPS(pb + 2); ++rep_) if (IN(pb + 2)) { PHASE_IDS
            constexpr int TP = 16; LAS float* lin = (LAS float*)lds;
            const float* mu = INP(6) + l * RWKV_COLS; const float* w_up = INP(8) + (size_t)l * DL * RW; const float* a_up = INP(10) + (size_t)l * AL * RW; const float* g_up = INP(11) + (size_t)l * GL * RW;
            const float* vmu = INP(13); const float* vup = INP(15);
            const int c = tid;
            const float mur = mu[c], muk = mu[RW + c], muv = mu[2 * RW + c];
            const float w0c = INP(7)[l * RW + c], a0c = INP(9)[l * RW + c], kkc = INP(16)[l * RW + c], kac = INP(17)[l * RW + c], rkc = INP(18)[l * RW + c];
            const float v0c = l > 0 ? INP(14)[c] : 0.f;
            bf16* Vl = l == 0 ? V0 : V1;
            for (int tile = bx; tile < T / TP; tile += G) {
                const int t0 = tile * TP;
                __syncthreads();
                for (int e = c; e < TP * 288; e += NTHR) {
                    const int tok = e / 288, j = e % 288, t = t0 + tok, sq = t % SEQ;
                    const int col = j < 256 ? 3 * RW + j : IN_COLS + (j - 256);
                    float val = 0.f;
                    if (j < 256 || l > 0) {
                        const float cur = bf2f(PROJ[(size_t)t * LDP + col]); const float prev = sq > 0 ? bf2f(PROJ[(size_t)(t - 1) * LDP + col]) : 0.f;
                        const float m = j < 256 ? mu[col] : vmu[j - 256];
                        val = cur + (prev - cur) * m;
                        if (j < 64) val = tanhf(val); else if (j >= 128 && j < 256) val = sigmoidf_(val);
                    }
                    lin[tok * 288 + j] = val;
                }
                __syncthreads();
                float aw[TP], aa[TP], ag[TP], av[TP];
#pragma unroll
                for (int i = 0; i < TP; ++i) { aw[i] = 0.f; aa[i] = 0.f; ag[i] = 0.f; av[i] = 0.f; }
#pragma unroll 2
                for (int k = 0; k < 64; k += 4) {
                    const float u0 = w_up[k * RW + c], u1 = w_up[(k + 1) * RW + c], u2 = w_up[(k + 2) * RW + c], u3 = w_up[(k + 3) * RW + c];
                    const float e0 = a_up[k * RW + c], e1 = a_up[(k + 1) * RW + c], e2 = a_up[(k + 2) * RW + c], e3 = a_up[(k + 3) * RW + c];
#pragma unroll
                    for (int i = 0; i < TP; ++i) { const f32x4 x1 = *(const LAS f32x4*)(lin + i * 288 + k), x2 = *(const LAS f32x4*)(lin + i * 288 + 64 + k);
                        aw[i] += (x1.x * u0 + x1.y * u1) + (x1.z * u2 + x1.w * u3); aa[i] += (x2.x * e0 + x2.y * e1) + (x2.z * e2 + x2.w * e3); } }
#pragma unroll 2
                for (int k = 0; k < 128; k += 4) {
                    const float u0 = g_up[k * RW + c], u1 = g_up[(k + 1) * RW + c], u2 = g_up[(k + 2) * RW + c], u3 = g_up[(k + 3) * RW + c];
#pragma unroll
                    for (int i = 0; i < TP; ++i) { const f32x4 x1 = *(const LAS f32x4*)(lin + i * 288 + 128 + k); ag[i] += (x1.x * u0 + x1.y * u1) + (x1.z * u2 + x1.w * u3); } }
                if (l > 0) {
#pragma unroll 2
                    for (int k = 0; k < 32; k += 4) {
                        const float u0 = vup[k * RW + c], u1 = vup[(k + 1) * RW + c], u2 = vup[(k + 2) * RW + c], u3 = vup[(k + 3) * RW + c];
#pragma unroll
                        for (int i = 0; i < TP; ++i) { const f32x4 x1 = *(const LAS f32x4*)(lin + i * 288 + 256 + k); av[i] += (x1.x * u0 + x1.y * u1) + (x1.z * u2 + x1.w * u3); } } }
#pragma unroll
                for (int i = 0; i < TP; ++i) {
                    const int t = t0 + i, sq = t % SEQ; const size_t o = (size_t)t * RW + c;
                    const bf16* pr = PROJ + (size_t)t * LDP; const bf16* pp = pr - LDP;
                    float r = bf2f(pr[c]), k = bf2f(pr[RW + c]), v = bf2f(pr[2 * RW + c]);
                    const float rp = sq > 0 ? bf2f(pp[c]) : 0.f, kp = sq > 0 ? bf2f(pp[RW + c]) : 0.f, vp = sq > 0 ? bf2f(pp[2 * RW + c]) : 0.f;
                    r += (rp - r) * mur; k += (kp - k) * muk; v += (vp - v) * muv;
                    const float z = -(w0c + aw[i]); const float sp = fmaxf(z, 0.f) + log1pf(expf(-fabsf(z)));
                    const float decay = expf(-expf(-sp - 0.5f));
                    const float a = sigmoidf_(a0c + aa[i]); const float g = ag[i];
                    if (l > 0) { const float vf = bf2f(V0[o]); v = v + (vf - v) * sigmoidf_(v0c + av[i]); }
                    float kk = k * kkc; const float nrm = sqrtf(wave_sum(kk * kk)); kk = kk / fmaxf(nrm, 1e-12f);
                    const float k2 = k * (1.f + (a - 1.f) * kac);
                    const float bon = wave_sum(r * k2 * rkc) * v;
                    Rb[o] = f2bf(r); Kb[o] = f2bf(k2); Vl[o] = f2bf(v); KKb[o] = f2bf(kk); Bb[o] = f2bf(kk * a); Gb[o] = f2bf(g); BGb[o] = f2bf(bon * g); Wd[o] = decay;
                }
            }
        }
        SEAM(pb + 2);

        for (int rep_ = 0; rep_ < REPS(pb + 3); ++rep_) if (IN(pb + 3)) { PHASE_IDS
            const bf16* Vl = l == 0 ? V0 : V1;
            constexpr int SB = 32, STP = 340, BUFB = SB * STP * 4;
            constexpr int YB_OFF = 2 * BUFB, YB_BYTES = SB * 16 * 4;
            const int nscan = (G >= 256) ? 128 : 0;
            for (int it = bx; it < 128; it += G) {
                const int b = it >> 5, h = (it >> 2) & 7, qr = it & 3;
                const size_t tb = (size_t)b * SEQ;
                __syncthreads();
                if (wave >= 4) {
                    const int lt = tid - 256, tok = lt >> 3, part = lt & 7;
                    const size_t gofs = (tb + tok) * RW + h * HS + part * 8;
                    const bf16* vsrc = Vl + (tb + tok) * RW + h * HS + qr * 16 + (part & 1) * 8;
                    u32x4 qr_, qk_, qkk_, qb_, qv_; f32x4 qw0, qw1;
#define LD_ISSUE(blk) do { const size_t go = (size_t)(blk) * SB * RW; qr_ = *(const u32x4*)(Rb + gofs + go); qk_ = *(const u32x4*)(Kb + gofs + go); qkk_ = *(const u32x4*)(KKb + gofs + go); qb_ = *(const u32x4*)(Bb + gofs + go); \
                               qw0 = *(const f32x4*)(Wd + gofs + go); qw1 = *(const f32x4*)(Wd + gofs + go + 4); if (part < 2) qv_ = *(const u32x4*)(vsrc + go); } while (0)
#define UNPK8(dst, q) do { (dst)[0] = __uint_as_float((q).x << 16); (dst)[1] = __uint_as_float((q).x & 0xffff0000u); (dst)[2] = __uint_as_float((q).y << 16); (dst)[3] = __uint_as_float((q).y & 0xffff0000u); \
                           (dst)[4] = __uint_as_float((q).z << 16); (dst)[5] = __uint_as_float((q).z & 0xffff0000u); (dst)[6] = __uint_as_float((q).w << 16); (dst)[7] = __uint_as_float((q).w & 0xffff0000u); } while (0)
#define LD_WRITE(bufi) do { LAS float* rec = (LAS float*)(lds + (bufi) * BUFB) + tok * STP; float r8[8], k8[8], kk8[8], b8[8]; UNPK8(r8, qr_); UNPK8(k8, qk_); UNPK8(kk8, qkk_); UNPK8(b8, qb_); \
                        const float w8[8] = {qw0.x, qw0.y, qw0.z, qw0.w, qw1.x, qw1.y, qw1.z, qw1.w}; float kr = 0.f, br = 0.f; \
                        _Pragma("unroll") for (int i = 0; i < 8; ++i) { kr += k8[i] * r8[i]; br += b8[i] * r8[i]; } \
                        kr += dppf<0xB1>(kr); br += dppf<0xB1>(br); kr += dppf<0x4E>(kr); br += dppf<0x4E>(br); kr += dppf<0x141>(kr); br += dppf<0x141>(br); \
                        *(LAS f32x4*)(rec + part * 8) = (f32x4){w8[0] * r8[0], w8[1] * r8[1], w8[2] * r8[2], w8[3] * r8[3]}; *(LAS f32x4*)(rec + part * 8 + 4) = (f32x4){w8[4] * r8[4], w8[5] * r8[5], w8[6] * r8[6], w8[7] * r8[7]}; \
                        *(LAS f32x4*)(rec + 64 + part * 8) = qw0; *(LAS f32x4*)(rec + 64 + part * 8 + 4) = qw1; \
                        *(LAS f32x4*)(rec + 128 + part * 8) = (f32x4){k8[0], k8[1], k8[2], k8[3]}; *(LAS f32x4*)(rec + 128 + part * 8 + 4) = (f32x4){k8[4], k8[5], k8[6], k8[7]}; \
                        *(LAS f32x4*)(rec + 192 + part * 8) = (f32x4){-kk8[0], -kk8[1], -kk8[2], -kk8[3]}; *(LAS f32x4*)(rec + 192 + part * 8 + 4) = (f32x4){-kk8[4], -kk8[5], -kk8[6], -kk8[7]}; \
                        *(LAS f32x4*)(rec + 256 + part * 8) = (f32x4){b8[0], b8[1], b8[2], b8[3]}; *(LAS f32x4*)(rec + 256 + part * 8 + 4) = (f32x4){b8[4], b8[5], b8[6], b8[7]}; \
                        if (part < 2) { float v8[8]; UNPK8(v8, qv_); *(LAS f32x4*)(rec + 320 + part * 8) = (f32x4){v8[0], v8[1], v8[2], v8[3]}; *(LAS f32x4*)(rec + 320 + part * 8 + 4) = (f32x4){v8[4], v8[5], v8[6], v8[7]}; } \
                        if (part == 0) { rec[336] = kr; rec[337] = br; } } while (0)
                    LD_ISSUE(0); LD_WRITE(0); LD_ISSUE(1);
                    __syncthreads();
                    for (int blk = 0; blk < SEQ / SB; ++blk) {
                        if (blk + 1 < SEQ / SB) { LD_WRITE((blk + 1) & 1); if (blk + 2 < SEQ / SB) LD_ISSUE(blk + 2); }
                        if (blk > 0 && lt < 128) {
                            const LAS float* yb = (const LAS float*)(lds + YB_OFF + ((blk - 1) & 1) * YB_BYTES);
                            const int ys = lt >> 2, yc = lt & 3; const f32x4 yv = *(const LAS f32x4*)(yb + ys * 16 + yc * 4);
                            *(f32x4*)(Y + (tb + (size_t)(blk - 1) * SB + ys) * RW + h * HS + qr * 16 + yc * 4) = yv; }
                        __syncthreads();
                    }
                    if (lt < 128) { const LAS float* yb = (const LAS float*)(lds + YB_OFF + ((SEQ / SB - 1) & 1) * YB_BYTES);
                        const int ys = lt >> 2, yc = lt & 3; const f32x4 yv = *(const LAS f32x4*)(yb + ys * 16 + yc * 4);
                        *(f32x4*)(Y + (tb + (size_t)(SEQ / SB - 1) * SB + ys) * RW + h * HS + qr * 16 + yc * 4) = yv; }
#undef LD_ISSUE
#undef UNPK8
#undef LD_WRITE
                } else {
                    const int rowl = wave * 4 + (lane >> 4), kq = lane & 15;
                    f32x4 st = {0.f, 0.f, 0.f, 0.f};
                    __syncthreads();
                    for (int blk = 0; blk < SEQ / SB; ++blk) {
                        const LAS float* bb = (const LAS float*)(lds + (blk & 1) * BUFB);
                        LAS float* yb = (LAS float*)(lds + YB_OFF + (blk & 1) * YB_BYTES);
                        struct Ops { f32x4 wr4, w4, k4, nk4, b4; float v, kr, br; };
#define LOAD_OPS(o, sidx) do { const LAS float* p_ = bb + (sidx) * STP; (o).wr4 = *(const LAS f32x4*)(p_ + 4 * kq); (o).w4 = *(const LAS f32x4*)(p_ + 64 + 4 * kq); (o).k4 = *(const LAS f32x4*)(p_ + 128 + 4 * kq); \
                               (o).nk4 = *(const LAS f32x4*)(p_ + 192 + 4 * kq); (o).b4 = *(const LAS f32x4*)(p_ + 256 + 4 * kq); (o).v = p_[320 + rowl]; (o).kr = p_[336]; (o).br = p_[337]; } while (0)
                        Ops ops[3];
                        LOAD_OPS(ops[0], 0); LOAD_OPS(ops[1], 1);
                        float ykeep = 0.f;
#pragma unroll
                        for (int j = 0; j < SB; ++j) {
                            if (j + 2 < SB) LOAD_OPS(ops[(j + 2) % 3], j + 2);
                            __builtin_amdgcn_sched_barrier(0);
                            const Ops& o = ops[j % 3];
                            float d1 = (st.x * o.nk4.x + st.y * o.nk4.y) + (st.z * o.nk4.z + st.w * o.nk4.w);
                            float d2 = (st.x * o.wr4.x + st.y * o.wr4.y) + (st.z * o.wr4.z + st.w * o.wr4.w);
                            d1 += dppf<0xB1>(d1); d2 += dppf<0xB1>(d2); d1 += dppf<0x4E>(d1); d2 += dppf<0x4E>(d2);
                            d1 += dppf<0x141>(d1); d2 += dppf<0x141>(d2); d1 += dppf<0x140>(d1); d2 += dppf<0x140>(d2);
                            st = st * o.w4 + o.v * o.k4 + d1 * o.b4;
                            const float y = d2 + o.v * o.kr + d1 * o.br;
                            ykeep = (kq == (j & 15)) ? y : ykeep;
                            if ((j & 15) == 15) yb[((j >> 4) * 16 + kq) * 16 + rowl] = ykeep;
                        }
#undef LOAD_OPS
                        __syncthreads();
                    }
                }
            }
            if (bx >= nscan) {
                LAS float* dl = (LAS float*)lds;
                const float* pool_w = INP(21) + (size_t)l * 4 * PG * PG; const float ps = INP(22)[l * PW + tid];
                const int c = tid, g = c >> 7, dd = c & 127, win = 2 << g;
                for (int tile = bx - nscan; tile < T / 16; tile += G - nscan) {
                    const int t0 = tile * 16; const bool first = (t0 % SEQ) == 0;
                    __syncthreads();
                    float p[31];
#pragma unroll
                    for (int j = 0; j < 31; ++j) p[j] = (j >= 15 || !first) ? bf2f(PROJ[(size_t)(t0 - 15 + j) * LDP + RWKV_COLS + c]) : 0.f;
                    float sw = 0.f;
                    for (int j = 1; j <= 16; ++j) sw += (j < win) ? p[15 - j] : 0.f;
                    const float invw = 1.f / (float)win;
#pragma unroll
                    for (int i = 0; i < 16; ++i) {
                        sw += p[15 + i];
                        const float inv = first ? 1.f / (float)min(i + 1, win) : invw;
                        dl[i * 512 + c] = sw * inv - p[15 + i];
                        float drop = 0.f;
#pragma unroll
                        for (int q = 0; q < 4; ++q) { const int w_ = 2 << q; if (g == q) drop = p[15 + i - w_ + 1]; }
                        sw -= drop;
                    }
                    __syncthreads();
                    float acc[16];
#pragma unroll
                    for (int i = 0; i < 16; ++i) acc[i] = 0.f;
#pragma unroll 2
                    for (int cc = 0; cc < PG; cc += 4) {
                        const float* wp = pool_w + ((size_t)g * PG + cc) * PG + dd; const float w0 = wp[0], w1 = wp[PG], w2 = wp[2 * PG], w3 = wp[3 * PG];
#pragma unroll
                        for (int i = 0; i < 16; ++i) { const f32x4 d4 = *(const LAS f32x4*)(dl + i * 512 + g * PG + cc); acc[i] += (d4.x * w0 + d4.y * w1) + (d4.z * w2 + d4.w * w3); } }
#pragma unroll
                    for (int i = 0; i < 16; ++i) MIX[(size_t)(t0 + i) * D + RW + c] = f2bf(acc[i] * ps);
                }
            }
        }
        SEAM(pb + 3);

        for (int rep_ = 0; rep_ < REPS(pb + 4); ++rep_) if (IN(pb + 4)) { PHASE_IDS
            const int c = tid; const float lg = INP(19)[l * RW + c], lb = INP(20)[l * RW + c];
            for (int tile = bx; tile < T / 8; tile += G) {
                float y[8], g[8], bg[8];
#pragma unroll
                for (int i = 0; i < 8; ++i) { const size_t o = (size_t)(tile * 8 + i) * RW + c; y[i] = Y[o]; g[i] = bf2f(Gb[o]); bg[i] = bf2f(BGb[o]); }
#pragma unroll
                for (int i = 0; i < 8; ++i) { const float mean = wave_sum(y[i]) * (1.f / 64.f); const float d = y[i] - mean; const float var = wave_sum(d * d) * (1.f / 64.f);
                    const float yn = d * rsqrtf(var + GN_EPS) * lg + lb; MIX[(size_t)(tile * 8 + i) * D + c] = f2bf(yn * g[i] + bg[i]); }
            }
        }
        SEAM(pb + 4);
        for (int rep_ = 0; rep_ < REPS(pb + 5); ++rep_) if (IN(pb + 5)) { PHASE_IDS
            pg8::Gemm g{MIX, WoutT + (size_t)l * D * D, T, D, D}; pg8::StaticOrder S; S.init(T, D, G, bx);
            pg8::EpiResGate E{xin, X, modl + 2 * D};
            pg8::gemm_phase<pg8::EpiResGate, pg8::StaticOrder, true, true>(lds, g, S, E); }
        SEAM(pb + 5);
        for (int rep_ = 0; rep_ < REPS(pb + 6); ++rep_) if (IN(pb + 6)) { PHASE_IDS const float* gamma = INP(24) + l * D;
            for (int row = gw; row < T; row += NGW) { const int b = row / SEQ; norm_mod_row(X + (size_t)row * D, gamma, modl + (size_t)b * 6 * D + 3 * D, modl + (size_t)b * 6 * D + 4 * D, H + (size_t)row * D, lane); } }
        SEAM(pb + 6);
        for (int rep_ = 0; rep_ < REPS(pb + 7); ++rep_) if (IN(pb + 7)) { PHASE_IDS
            pg8::Gemm g{H, PqT + (size_t)l * PH * PQ * D, T, PH * PQ, D}; pg8::StaticOrder S; S.init(T, PH * PQ, G, bx);
            pg8::EpiBf16<0> E{Q, PH * PQ, nullptr, 0, 0, 1.f};
            pg8::gemm_phase<pg8::EpiBf16<0>, pg8::StaticOrder, true, true>(lds, g, S, E); }
        SEAM(pb + 7);

        for (int rep_ = 0; rep_ < REPS(pb + 8); ++rep_) if (IN(pb + 8)) { PHASE_IDS
            const bf16* KEYSl = KEYS + (size_t)l * PH * 2 * NKEYS * PHALF;
            LAS unsigned char* scr = lds + wave * 2048 + lane * 32;
            const int r = lane & 31, hh = lane >> 5;
            for (int it = gw; it < (T / 32) * PH; it += NGW) {
                const int tok = (it >> 3) * 32 + r, h = it & 7;
                unsigned sp0[16], sp1[16];
#pragma unroll
                for (int e = 0; e < 16; ++e) { sp0[e] = 0u; sp1[e] = 0u; }
#pragma unroll 1
                for (int p = 0; p < 2; ++p) {
                    const bf16* qp = Q + (size_t)tok * (PH * PQ) + h * PQ + p * PHALF + 8 * hh;
                    const bf16* kp_ = KEYSl + ((size_t)(h * 2 + p) * NKEYS + r) * PHALF + 8 * hh;
                    bf16x8_t bq[8];
#pragma unroll
                    for (int ks = 0; ks < 8; ++ks) bq[ks] = *(const bf16x8_t*)(qp + ks * 16);
                    unsigned best[16];
#pragma unroll
                    for (int e = 0; e < 16; ++e) best[e] = 0u;
#pragma unroll 1
                    for (int kt = 0; kt < 4; ++kt) {
                        f32x16 acc;
#pragma unroll
                        for (int e = 0; e < 16; ++e) acc[e] = 0.f;
#pragma unroll
                        for (int ks = 0; ks < 8; ++ks) { const bf16x8_t ak = *(const bf16x8_t*)(kp_ + (size_t)kt * 32 * PHALF + ks * 16); acc = __builtin_amdgcn_mfma_f32_32x32x16_bf16(ak, bq[ks], acc, 0, 0, 0); }
                        unsigned g[16];
#pragma unroll
                        for (int e = 0; e < 16; ++e) g[e] = pack_key7(acc[e], kt * 32 + (e & 3) + 8 * (e >> 2) + 4 * hh);
                        sort16_desc(g);
                        merge_top16(best, g);
                    }
                    unsigned ob[16];
#pragma unroll
                    for (int e = 0; e < 16; ++e) ob[e] = (unsigned)__shfl_xor((int)best[e], 32);
                    merge_top16(best, ob);
#pragma unroll
                    for (int e = 0; e < 16; ++e) { sp0[e] = p == 0 ? best[e] : sp0[e]; sp1[e] = p == 0 ? sp1[e] : best[e]; }
                }
                unsigned c2[32];
                stage2_cands(sp0, sp1, hh, c2);
                sort16_desc(c2); sort16_desc(c2 + 16); merge_top16(c2, c2 + 16);
                { unsigned ob[16];
#pragma unroll
                  for (int e = 0; e < 16; ++e) ob[e] = (unsigned)__shfl_xor((int)c2[e], 32);
                  merge_top16(c2, ob); }
#pragma unroll
                for (int e = 0; e < 16; e += 4) {
                    *(LAS unsigned*)(scr + e) = (127u - (sp0[e] & 127u)) | ((127u - (sp0[e + 1] & 127u)) << 8) | ((127u - (sp0[e + 2] & 127u)) << 16) | ((127u - (sp0[e + 3] & 127u)) << 24);
                    *(LAS unsigned*)(scr + 16 + e) = (127u - (sp1[e] & 127u)) | ((127u - (sp1[e + 1] & 127u)) << 8) | ((127u - (sp1[e + 2] & 127u)) << 16) | ((127u - (sp1[e + 3] & 127u)) << 24); }
                asm volatile("s_waitcnt lgkmcnt(0)" ::: "memory");
                float sm[16]; int ex[16];
#pragma unroll
                for (int e = 0; e < 16; ++e) { const unsigned key = c2[e]; sm[e] = unpack_key8(key); const int i0 = (key >> 4) & 15, j0 = key & 15; ex[e] = (int)scr[i0] * NKEYS + (int)scr[16 + j0]; }
                float den = 0.f;
#pragma unroll
                for (int e = 0; e < 16; ++e) { sm[e] = expf(sm[e] - unpack_key8(c2[0])); den += sm[e]; }
                const float inv = 1.f / den;
                if (hh == 0) {
                    int* ip = IDX + (size_t)tok * NE + h * TOPK; float* gp = GATE + (size_t)tok * NE + h * TOPK;
#pragma unroll
                    for (int e = 0; e < 16; e += 4) { *(int4*)(ip + e) = make_int4(ex[e], ex[e + 1], ex[e + 2], ex[e + 3]); *(f32x4*)(gp + e) = (f32x4){sm[e] * inv, sm[e + 1] * inv, sm[e + 2] * inv, sm[e + 3] * inv}; }
                }
                asm volatile("s_waitcnt lgkmcnt(0)" ::: "memory");
            }
        }
        SEAM(pb + 8);

        for (int rep_ = 0; rep_ < REPS(pb + 9); ++rep_) if (IN(pb + 9)) { PHASE_IDS
            const unsigned char* Ul = U8 + (size_t)l * NEXP * D; const unsigned char* Vtl = V8 + (size_t)l * NEXP * D; const float* usl = USc + l * NEXP; const float* vsl = VSc + l * NEXP; const float* lnf = INP(29);
            const bool fin = (l == DEPTH - 1);
            typedef float f32x2_t __attribute__((ext_vector_type(2)));
            const __amdgpu_buffer_rsrc_t ru = __builtin_amdgcn_make_buffer_rsrc((void*)Ul, 0, NEXP * D, 0x00020000), rv = __builtin_amdgcn_make_buffer_rsrc((void*)Vtl, 0, NEXP * D, 0x00020000);
            const int voff = lane * 16;
            LAS float* pl = (LAS float*)(lds + wave * 8704);
            for (int t = gw; t < T; t += NGW) {
                const int b = t / SEQ;
                f32x2_t hf2[8];
                { const u32x4 h0 = *(const u32x4*)(H + (size_t)t * D + lane * 16), h1 = *(const u32x4*)(H + (size_t)t * D + lane * 16 + 8);
                  hf2[0] = (f32x2_t){__uint_as_float(h0.x << 16), __uint_as_float(h0.x & 0xffff0000u)}; hf2[1] = (f32x2_t){__uint_as_float(h0.y << 16), __uint_as_float(h0.y & 0xffff0000u)};
                  hf2[2] = (f32x2_t){__uint_as_float(h0.z << 16), __uint_as_float(h0.z & 0xffff0000u)}; hf2[3] = (f32x2_t){__uint_as_float(h0.w << 16), __uint_as_float(h0.w & 0xffff0000u)};
                  hf2[4] = (f32x2_t){__uint_as_float(h1.x << 16), __uint_as_float(h1.x & 0xffff0000u)}; hf2[5] = (f32x2_t){__uint_as_float(h1.y << 16), __uint_as_float(h1.y & 0xffff0000u)};
                  hf2[6] = (f32x2_t){__uint_as_float(h1.z << 16), __uint_as_float(h1.z & 0xffff0000u)}; hf2[7] = (f32x2_t){__uint_as_float(h1.w << 16), __uint_as_float(h1.w & 0xffff0000u)}; }
                f32x2_t acc2[8];
#pragma unroll
                for (int i = 0; i < 8; ++i) acc2[i] = (f32x2_t){0.f, 0.f};
                int myidx = IDX[(size_t)t * NE + (lane & 31)]; float mygate = GATE[(size_t)t * NE + (lane & 31)];
                float myus = usl[myidx], myvs = vsl[myidx];
#define ROWLD(dst, rs, ix, e) dst = __builtin_amdgcn_raw_buffer_load_b128(rs, voff, __builtin_amdgcn_readlane(ix, (e)) * D, 0)
#define LOADB(buf, rs, ix, e0) do { _Pragma("unroll") for (int j_ = 0; j_ < 4; ++j_) ROWLD((buf)[j_], rs, ix, (e0) + j_); __builtin_amdgcn_sched_barrier(0); } while (0)
#define CVT8(u) const f32x2_t u0 = __builtin_amdgcn_cvt_pk_f32_fp8((int)(u).x, false), u1 = __builtin_amdgcn_cvt_pk_f32_fp8((int)(u).x, true), u2 = __builtin_amdgcn_cvt_pk_f32_fp8((int)(u).y, false), u3 = __builtin_amdgcn_cvt_pk_f32_fp8((int)(u).y, true), \
                        u4 = __builtin_amdgcn_cvt_pk_f32_fp8((int)(u).z, false), u5 = __builtin_amdgcn_cvt_pk_f32_fp8((int)(u).z, true), u6 = __builtin_amdgcn_cvt_pk_f32_fp8((int)(u).w, false), u7 = __builtin_amdgcn_cvt_pk_f32_fp8((int)(u).w, true)
#define DOT1(u, dst) do { CVT8(u); f32x2_t a_ = hf2[0] * u0; a_ += hf2[1] * u1; a_ += hf2[2] * u2; a_ += hf2[3] * u3; a_ += hf2[4] * u4; a_ += hf2[5] * u5; a_ += hf2[6] * u6; a_ += hf2[7] * u7; dst = a_.x + a_.y; } while (0)
#define DOTB(buf, e0) do { _Pragma("unroll") for (int j_ = 0; j_ < 4; ++j_) { float d_; DOT1((buf)[j_], d_); pl[((e0) + j_) * 68 + lane] = d_; } } while (0)
#define AXPYB(buf, e0) do { _Pragma("unroll") for (int j_ = 0; j_ < 4; ++j_) { CVT8((buf)[j_]); const float cf = __int_as_float(__builtin_amdgcn_readlane(__float_as_int(coef), (e0) + j_)); \
                        acc2[0] += cf * u0; acc2[1] += cf * u1; acc2[2] += cf * u2; acc2[3] += cf * u3; acc2[4] += cf * u4; acc2[5] += cf * u5; acc2[6] += cf * u6; acc2[7] += cf * u7; } } while (0)
                u32x4 ba[4], bb_[4];
                LOADB(ba, ru, myidx, 0);
#pragma unroll 1
                for (int q = 0; q < 4; ++q) {
                    int nidx = 0; float ngate = 0.f;
                    if (q < 3) { nidx = IDX[(size_t)t * NE + (q + 1) * 32 + (lane & 31)]; ngate = GATE[(size_t)t * NE + (q + 1) * 32 + (lane & 31)]; }
#pragma unroll
                    for (int e0 = 0; e0 < 32; e0 += 8) {
                        LOADB(bb_, ru, myidx, e0 + 4); DOTB(ba, e0);
                        if (e0 + 8 < 32) LOADB(ba, ru, myidx, e0 + 8); else LOADB(ba, rv, myidx, 0);
                        DOTB(bb_, e0 + 4);
                    }
                    const float nus = usl[nidx], nvs = vsl[nidx];
                    __builtin_amdgcn_wave_barrier(); asm volatile("s_waitcnt lgkmcnt(0)" ::: "memory");
                    float dsum;
                    { const LAS float* rp = pl + (lane & 31) * 68 + (lane >> 5) * 32; f32x4 s4 = *(const LAS f32x4*)rp;
#pragma unroll
                      for (int j = 1; j < 8; ++j) s4 += *(const LAS f32x4*)(rp + j * 4);
                      dsum = (s4.x + s4.y) + (s4.z + s4.w); }
                    dsum += __shfl_xor(dsum, 32);
                    __builtin_amdgcn_wave_barrier(); asm volatile("s_waitcnt lgkmcnt(0)" ::: "memory");
                    const float coef = mygate * gelu_erf(dsum * myus) * myvs;
#pragma unroll
                    for (int e0 = 0; e0 < 32; e0 += 8) {
                        LOADB(bb_, rv, myidx, e0 + 4); AXPYB(ba, e0);
                        if (e0 + 8 < 32) LOADB(ba, rv, myidx, e0 + 8); else if (q < 3) LOADB(ba, ru, nidx, 0);
                        AXPYB(bb_, e0 + 4);
                    }
                    myidx = nidx; mygate = ngate; myus = nus; myvs = nvs;
                }
#undef ROWLD
#undef LOADB
#undef CVT8
#undef DOTB
#undef DOT1
#undef AXPYB
                float* xr = X + (size_t)t * D + lane * 16; const float* g2 = modl + (size_t)b * 6 * D + 5 * D + lane * 16;
                f32x4 xv[4]; float ss = 0.f;
#pragma unroll
                for (int q = 0; q < 4; ++q) { const f32x4 xo = *(const f32x4*)(xr + q * 4), gg = *(const f32x4*)(g2 + q * 4);
                    xv[q] = xo + gg * (f32x4){acc2[q * 2].x, acc2[q * 2].y, acc2[q * 2 + 1].x, acc2[q * 2 + 1].y}; ss += (xv[q].x * xv[q].x + xv[q].y * xv[q].y) + (xv[q].z * xv[q].z + xv[q].w * xv[q].w); }
                if (fin) { const float rs = rsqrtf(wave_sum(ss) * (1.f / D) + NORM_EPS);
#pragma unroll
                    for (int q = 0; q < 4; ++q) xv[q] = xv[q] * rs * *(const f32x4*)(lnf + lane * 16 + q * 4); }
#pragma unroll
                for (int q = 0; q < 4; ++q) *(f32x4*)(xr + q * 4) = xv[q];
            }
        }
    }
#undef modl
#undef xin
#undef IN
#undef SEAM
}
#undef MOD
#undef H
#undef PROJ
#undef Q
#undef MIX
#undef Rb
#undef Kb
#undef V0
#undef V1
#undef KKb
#undef Bb
#undef Gb
#undef BGb
#undef Wd
#undef Y
#undef IDX
#undef GATE
#undef WinT
#undef WoutT
#undef PqT
#undef KEYS
#undef U8
#undef V8
#undef USc
#undef VSc
#undef INP
#undef PHASE_IDS

extern "C" void kernel_launch(void* const* d_in, const int* in_sizes, int n_in, void* d_out, int out_size, void* d_ws, size_t ws_size, hipStream_t stream) {
    if (n_in != 30 || ws_size < WS_END) { fprintf(stderr, "kernel_launch: unexpected n_in %d / ws_size %zu\n", n_in, ws_size); return; }
    static int grid = 0;
    if (grid == 0) {
        int dev = 0, cus = 0, per_cu = 0;
        (void)hipGetDevice(&dev); (void)hipDeviceGetAttribute(&cus, hipDeviceAttributeMultiprocessorCount, dev);
        if (hipFuncSetAttribute((const void*)mega, hipFuncAttributeMaxDynamicSharedMemorySize, LDS_BYTES) != hipSuccess) { fprintf(stderr, "hipFuncSetAttribute failed\n"); grid = -1; return; }
        if (hipOccupancyMaxActiveBlocksPerMultiprocessor(&per_cu, (const void*)mega, NTHR, LDS_BYTES) != hipSuccess || per_cu < 1) { fprintf(stderr, "occupancy query failed (%d)\n", per_cu); per_cu = 1; }
        (void)hipGetLastError();
        grid = (cus > 0 ? cus : 256) * 1;
    }
    if (grid < 0) return;
    Args a{}; for (int i = 0; i < 30; ++i) a.in[i] = (const float*)d_in[i]; a.out = (float*)d_out; a.ws = (unsigned char*)d_ws;
    a.ph_lo = 0; a.ph_hi = NPH;
    if (hipMemsetAsync(d_ws, 0, 65536, stream) != hipSuccess) { fprintf(stderr, "memset failed\n"); return; }
    void* kargs[] = {&a};
    hipError_t e = hipLaunchCooperativeKernel((const void*)mega, dim3(grid), dim3(NTHR), kargs, LDS_BYTES, stream);
    if (e != hipSuccess) fprintf(stderr, "cooperative launch failed: %s (grid %d)\n", hipGetErrorString(e), grid);
}
```

```cpp
#include <hip/hip_runtime.h>
#include <hip/hip_cooperative_groups.h>
namespace cg = cooperative_groups;
#include <cstdio>
#include <cstdint>
#include <cmath>

constexpr int D = 1024, BATCH = 4, SEQ = 4096, T = BATCH * SEQ, DEPTH = 2;
constexpr int RW = 512, HS = 64, NH = 8;
constexpr int DL = 64, AL = 64, MVL = 32, GL = 128;
constexpr int RWKV_COLS = 3 * RW + DL + AL + GL;
constexpr int PW = 512, PG = 128;
constexpr int IN_COLS = RWKV_COLS + PW;
constexpr int LDP = 2560;
constexpr int NKEYS = 128, NEXP = NKEYS * NKEYS, PH = 8, PQ = 256, PHALF = 128, TOPK = 16;
constexpr int NE = PH * TOPK;
constexpr float NORM_EPS = 1e-6f, GN_EPS = 64e-5f;

typedef unsigned short bf16;
__device__ __forceinline__ float bf2f(bf16 u) { return __uint_as_float((unsigned)u << 16); }
__device__ __forceinline__ bf16 f2bf(float f) { unsigned u = __float_as_uint(f); return (bf16)((u + 0x7fffu + ((u >> 16) & 1u)) >> 16); }

constexpr size_t MiB = 1u << 20;
constexpr size_t WS_MOD = 1 * MiB;
constexpr size_t WS_US = 1 * MiB + 256 * 1024;
constexpr size_t WS_VS = 1 * MiB + 512 * 1024;
constexpr size_t WS_H = 2 * MiB;
constexpr size_t WS_PROJ = 34 * MiB;
constexpr size_t WS_Q = WS_PROJ;
constexpr size_t WS_R = 114 * MiB;
constexpr size_t WS_K = 130 * MiB;
constexpr size_t WS_V0 = 146 * MiB;
constexpr size_t WS_V1 = 162 * MiB;
constexpr size_t WS_KK = 178 * MiB;
constexpr size_t WS_B = 194 * MiB;
constexpr size_t WS_G = 210 * MiB;
constexpr size_t WS_BG = 226 * MiB;
constexpr size_t WS_W = 242 * MiB;
constexpr size_t WS_Y = 274 * MiB;
constexpr size_t WS_MIX = 306 * MiB;
constexpr size_t WS_IDX = 338 * MiB;
constexpr size_t WS_GATE = 346 * MiB;
constexpr size_t WS_WIN_T = 354 * MiB;
constexpr size_t WS_WOUT_T = 364 * MiB;
constexpr size_t WS_PQ_T = 368 * MiB;
constexpr size_t WS_KEYS = 376 * MiB;
constexpr size_t WS_U = 378 * MiB;
constexpr size_t WS_V = 442 * MiB;
constexpr size_t WS_QB = 410 * MiB;
constexpr size_t WS_SH = 426 * MiB;
constexpr size_t WS_LORA = 428 * MiB;
constexpr size_t WS_INVN = 430 * MiB;
constexpr size_t WS_BSUM = 431 * MiB;
constexpr size_t WS_END = 506 * MiB;

template <int CTRL> __device__ __forceinline__ float dppf(float x) { return __int_as_float(__builtin_amdgcn_update_dpp(0, __float_as_int(x), CTRL, 0xF, 0xF, false)); }
__device__ __forceinline__ float red16(float x) { x += dppf<0xB1>(x); x += dppf<0x4E>(x); x += dppf<0x141>(x); x += dppf<0x140>(x); return x; }
__device__ __forceinline__ float shflx(float v, int lane, int off) { return __int_as_float(__builtin_amdgcn_ds_bpermute((lane ^ off) << 2, __float_as_int(v))); }
__device__ __forceinline__ unsigned shflxu(unsigned v, int lane, int off) { return (unsigned)__builtin_amdgcn_ds_bpermute((lane ^ off) << 2, (int)v); }
__device__ __forceinline__ float wave_sum(float v, int lane) { v = red16(v); v += shflx(v, lane, 16); v += shflx(v, lane, 32); return v; }
__device__ __forceinline__ float sigmoidf_(float x) { return 1.f / (1.f + expf(-x)); }

namespace pg8 {
#define PG8_LAS __attribute__((address_space(3)))
typedef unsigned short bf16_t;
typedef short bf16x8 __attribute__((ext_vector_type(8)));
typedef float f32x4 __attribute__((ext_vector_type(4)));
typedef unsigned u32x4 __attribute__((ext_vector_type(4)));
constexpr int BM = 256, BK = 64, HALF = 128, HTB = HALF * BK * 2  , STAGE_BYTES = 8 * HTB, NXCD = 8, WGM = 8;

__host__ __device__ __forceinline__ int lds_byte(int r, int c) { const int st = (r >> 4) * 2 + (c >> 5), rr = r & 15, cc = c & 31, ob = rr * 64 + cc * 2; return st * 1024 + (ob ^ (((ob >> 9) & 1) << 5)); }
__host__ __device__ __forceinline__ void stage_rc(int b, int& R, int& C) { const int st = b / 1024, sb = b % 1024, swz = sb ^ (((sb >> 9) & 1) << 5); R = (st >> 1) * 16 + swz / 64; C = (st & 1) * 32 + (swz % 64) / 2; }
__host__ __device__ __forceinline__ int perm32(int rho) { const int n = rho >> 4, i = rho & 15; return 8 * (i >> 2) + 4 * n + (i & 3); }

struct Unit { int pm, pn; };
struct Gemm { const bf16_t* A; const bf16_t* Bt; int M, N, K; };

struct StaticOrder {
    int nM, nN, nwg, G, c;
    __host__ __device__ void init(int M, int N, int G_, int c_) { nM = M / BM; nN = N / BM; nwg = nM * nN; G = G_; c = c_; }
    __host__ __device__ bool next(int i, Unit& u) const {
        const long L = (long)i * G + c; if (L >= nwg) return false;
        int wgid = (int)L; { const int q = nwg / NXCD, r = nwg % NXCD, xcd = wgid % NXCD, off = wgid / NXCD; wgid = (xcd < r ? xcd * (q + 1) : r * (q + 1) + (xcd - r) * q) + off; }
        const int nig = WGM * nN, gid = wgid / nig, fm = gid * WGM, gsz = (nM - fm) < WGM ? (nM - fm) : WGM;
        u.pm = fm + ((wgid % nig) % gsz); u.pn = (wgid % nig) / gsz; return true;
    }
    __device__ __forceinline__ void a_ready(const Unit&) const {}
    __device__ __forceinline__ void done(const Unit&) const {}
};

__device__ __forceinline__ unsigned cvt_pk_bf16(float lo, float hi) { unsigned r; asm volatile("v_cvt_pk_bf16_f32 %0, %1, %2" : "=v"(r) : "v"(lo), "v"(hi)); return r; }
typedef float f32x2 __attribute__((ext_vector_type(2)));
__device__ __forceinline__ f32x2 gelu_pk(f32x2 v) {
    const f32x2 av = __builtin_elementwise_abs(v), d = av * 0.2316418882f + 1.0f;
    f32x2 t; t.x = __builtin_amdgcn_rcpf(d.x); t.y = __builtin_amdgcn_rcpf(d.y);
    f32x2 q = t * 0.5307027145f + (-0.7265760135f); q = q * t + 0.7107068705f; q = q * t + (-0.142248368f); q = q * t + 0.127414796f; q = q * t;
    const f32x2 s = (v * v) * (-0.72134752044f);
    f32x2 e; e.x = __builtin_amdgcn_exp2f(s.x); e.y = __builtin_amdgcn_exp2f(s.y);
    const f32x2 m = v * (q * e), r = v - m;
    f32x2 o; o.x = v.x < 0.f ? m.x : r.x; o.y = v.y < 0.f ? m.y : r.y; return o;
}

template <int ACT  > struct EpiBf16 {
    static constexpr bool PERM = true, AFTER_DRAIN = false; static_assert(ACT == 0 || ACT == 1, "EpiBf16: ACT is 0 (none) or 1 (gelu_pk)");
    bf16_t* O; int ldc; const float* bias; int split_cols; size_t split_stride; float scale0;
    __device__ __forceinline__ void operator()(const f32x4 (&acc)[2][2][4][2], const Unit& u, int wr, int wc, int fr, int fq) const {
        const int row0 = u.pm * BM + wr * 64 + fr; int colt = u.pn * BM; bf16_t* base = O;
        float sc = 1.f; if (split_cols) { const int t = colt / split_cols; base += (size_t)t * split_stride; colt -= t * split_cols; if (t == 0) sc = scale0; }
        const int col0 = colt + wc * 32 + 8 * fq, bcol0 = u.pn * BM + wc * 32 + 8 * fq;
        f32x4 bv[2][2];
#pragma unroll
        for (int bj = 0; bj < 2; ++bj)
#pragma unroll
            for (int n = 0; n < 2; ++n) bv[bj][n] = bias ? *(const f32x4*)(bias + bcol0 + bj * HALF + 4 * n) : (f32x4){0.f, 0.f, 0.f, 0.f};
#pragma unroll
        for (int ai = 0; ai < 2; ++ai)
#pragma unroll
            for (int m = 0; m < 4; ++m) { bf16_t* rowp = base + (size_t)(row0 + ai * HALF + m * 16) * ldc + col0;
#pragma unroll
                for (int bj = 0; bj < 2; ++bj) { f32x4 v0 = acc[ai][bj][m][0] + bv[bj][0], v1 = acc[ai][bj][m][1] + bv[bj][1];
                    if (ACT == 1) { f32x2 a = gelu_pk((f32x2){v0[0], v0[1]}), b = gelu_pk((f32x2){v0[2], v0[3]}), c = gelu_pk((f32x2){v1[0], v1[1]}), d = gelu_pk((f32x2){v1[2], v1[3]});
                        v0 = (f32x4){a.x, a.y, b.x, b.y}; v1 = (f32x4){c.x, c.y, d.x, d.y}; }
                    v0 = v0 * sc; v1 = v1 * sc; u32x4 w; w.x = cvt_pk_bf16(v0[0], v0[1]); w.y = cvt_pk_bf16(v0[2], v0[3]); w.z = cvt_pk_bf16(v1[0], v1[1]); w.w = cvt_pk_bf16(v1[2], v1[3]);
                    *(u32x4*)(rowp + bj * HALF) = w; } }
    }
};

struct EpiResGate {
    static constexpr bool PERM = false, AFTER_DRAIN = false;
    const float* xold; float* X; const float* gate;
    __device__ __forceinline__ void operator()(const f32x4 (&acc)[2][2][4][2], const Unit& u, int wr, int wc, int fr, int fq) const {
        const int col0 = u.pn * BM + wc * 32 + 4 * fq; const int b = (u.pm * BM) / SEQ;
        const float* gp = gate + (size_t)b * 6 * D + col0;
#pragma unroll
        for (int bj = 0; bj < 2; ++bj)
#pragma unroll
            for (int n = 0; n < 2; ++n) { const f32x4 gv = *(const f32x4*)(gp + bj * HALF + n * 16);
#pragma unroll
                for (int ai = 0; ai < 2; ++ai)
#pragma unroll
                    for (int m = 0; m < 4; ++m) { const size_t off = (size_t)(u.pm * BM + ai * HALF + wr * 64 + m * 16 + fr) * D + col0 + bj * HALF + n * 16;
                        const f32x4 xo = *(const f32x4*)(xold + off); *(f32x4*)(X + off) = xo + gv * acc[ai][bj][m][n]; } }
    }
};
template <class Epi, class Sched, bool ALIGN_EPI = false, bool SP2 = false>
__device__ __forceinline__ void gemm_phase(PG8_LAS unsigned char* lds, const Gemm g, const Sched& S, const Epi& E, int tid) {
    asm volatile("" : "+v"(tid));
    const int wid = __builtin_amdgcn_readfirstlane(tid >> 6), lane = tid & 63, wr = wid >> 2, wc = wid & 3, fr = lane & 15, fq = lane >> 4;
    const int K = g.K, nt = K / BK;
    unsigned voffA[2], voffB[2];
#pragma unroll
    for (int i = 0; i < 2; ++i) { int R, C; stage_rc(tid * 16 + i * 8192, R, C); const int Rb = Epi::PERM ? ((R & ~31) + perm32(R & 31)) : R;
        voffA[i] = (unsigned)(R * K + C) * 2u; voffB[i] = (unsigned)(Rb * K + C) * 2u; }
    const size_t kstep = (size_t)(BK * 2);
    const size_t hstep = (size_t)HALF * K * 2;
    const size_t tstep = 2 * hstep;
    const unsigned ldsw = (unsigned)wid * 1024u;
    const int aoff = lds_byte(wr * 64 + fr, fq * 8), boff = lds_byte(wc * 32 + fr, fq * 8);
#define PG8_SA(b, h) (((b) * 2 + (h)) * HTB)
#define PG8_SB(b, h) ((4 + (b) * 2 + (h)) * HTB)
#define PG8_STAGE(bufoff, gbase, voff) do { _Pragma("unroll") for (int _i = 0; _i < 2; ++_i) \
        __builtin_amdgcn_global_load_lds((const unsigned*)((const char*)(gbase) + (voff)[_i]), (PG8_LAS unsigned*)(lds + (bufoff) + ldsw + _i * 8192), 16, 0, 0); } while (0)
#define PG8_LDA(dst, b, h) do { _Pragma("unroll") for (int m = 0; m < 4; ++m) _Pragma("unroll") for (int k = 0; k < 2; ++k) dst[m][k] = *(const PG8_LAS bf16x8*)(lds + PG8_SA(b, h) + aoff + m * 2048 + k * 1024); } while (0)
#define PG8_LDB(dst, b, h) do { _Pragma("unroll") for (int n = 0; n < 2; ++n) _Pragma("unroll") for (int k = 0; k < 2; ++k) dst[n][k] = *(const PG8_LAS bf16x8*)(lds + PG8_SB(b, h) + boff + n * 2048 + k * 1024); } while (0)
#define PG8_MMA(ai, bj, At, Bt) do { __builtin_amdgcn_s_setprio(1); _Pragma("unroll") for (int m = 0; m < 4; ++m) _Pragma("unroll") for (int n = 0; n < 2; ++n) _Pragma("unroll") for (int k = 0; k < 2; ++k) \
        acc[ai][bj][m][n] = __builtin_amdgcn_mfma_f32_16x16x32_bf16(Bt[n][k], At[m][k], acc[ai][bj][m][n], 0, 0, 0); __builtin_amdgcn_s_setprio(0); } while (0)
#define PG8_WAIT_V(n) asm volatile("s_waitcnt vmcnt(" #n ")" ::: "memory")
#define PG8_WAIT_L(n) asm volatile("s_waitcnt lgkmcnt(" #n ")" ::: "memory")
#define PG8_BAR __builtin_amdgcn_s_barrier()
#define PG8_SCHED __builtin_amdgcn_sched_barrier(0)
    Unit cur, nxt; int ui = 0;
    if (!S.next(0, cur)) return;
    f32x4 acc[2][2][4][2];
#pragma unroll
    for (int a = 0; a < 2; ++a)
#pragma unroll
        for (int b = 0; b < 2; ++b)
#pragma unroll
            for (int m = 0; m < 4; ++m)
#pragma unroll
                for (int n = 0; n < 2; ++n) acc[a][b][m][n] = (f32x4){0.f, 0.f, 0.f, 0.f};
    bf16x8 At[4][2], B0[2][2], B1[2][2];
    const char* cA = (const char*)g.A + (size_t)cur.pm * tstep; const char* cB = (const char*)g.Bt + (size_t)cur.pn * tstep;
    S.a_ready(cur);
    if constexpr (SP2) {
        PG8_STAGE(PG8_SB(0, 0), cB, voffB); PG8_STAGE(PG8_SB(0, 1), cB + hstep, voffB); PG8_STAGE(PG8_SA(0, 0), cA, voffA); PG8_STAGE(PG8_SA(0, 1), cA + hstep, voffA);
        if (wr == 1) PG8_BAR;
        PG8_WAIT_V(2); PG8_BAR;
        PG8_STAGE(PG8_SB(1, 0), cB + kstep, voffB); PG8_STAGE(PG8_SA(1, 0), cA + kstep, voffA); PG8_STAGE(PG8_SB(1, 1), cB + hstep + kstep, voffB);
        PG8_WAIT_V(6); PG8_BAR;
    } else {
        PG8_STAGE(PG8_SB(0, 0), cB, voffB); PG8_STAGE(PG8_SA(0, 0), cA, voffA); PG8_STAGE(PG8_SB(0, 1), cB + hstep, voffB); PG8_STAGE(PG8_SA(0, 1), cA + hstep, voffA);
        if (wr == 1) PG8_BAR;
        PG8_WAIT_V(4); PG8_BAR;
        PG8_STAGE(PG8_SB(1, 0), cB + kstep, voffB); PG8_STAGE(PG8_SA(1, 0), cA + kstep, voffA); PG8_STAGE(PG8_SB(1, 1), cB + hstep + kstep, voffB);
        PG8_WAIT_V(6); PG8_BAR;
    }
    for (;;) {
        const bool has_next = S.next(ui + 1, nxt);
        const char* nA = has_next ? (const char*)g.A + (size_t)nxt.pm * tstep : cA; const char* nB = has_next ? (const char*)g.Bt + (size_t)nxt.pn * tstep : cB;
        for (int t = 0; t < nt; t += 2) {
            const bool last = (t == nt - 2);
            const char* a1 = cA + (size_t)(t + 1) * kstep;
            const char* a2 = last ? nA : cA + (size_t)(t + 2) * kstep; const char* b2 = last ? nB : cB + (size_t)(t + 2) * kstep;
            const char* a3 = a2 + kstep; const char* b3 = b2 + kstep;
            if (last && has_next) S.a_ready(nxt);
            if constexpr (SP2) {
            PG8_LDB(B0, 0, 0); PG8_LDB(B1, 0, 1); PG8_SCHED; PG8_LDA(At, 0, 0); PG8_STAGE(PG8_SA(1, 1), a1 + hstep, voffA);
            PG8_WAIT_V(8); PG8_WAIT_L(0); PG8_BAR; PG8_MMA(0, 0, At, B0); PG8_MMA(0, 1, At, B1); PG8_BAR; PG8_SCHED;
            PG8_LDA(At, 0, 1); PG8_STAGE(PG8_SB(0, 0), b2, voffB); PG8_STAGE(PG8_SB(0, 1), b2 + hstep, voffB); PG8_STAGE(PG8_SA(0, 0), a2, voffA);
            PG8_WAIT_V(8); PG8_WAIT_L(0); PG8_BAR; PG8_MMA(1, 0, At, B0); PG8_MMA(1, 1, At, B1); PG8_BAR; PG8_SCHED;
            PG8_LDB(B0, 1, 0); PG8_LDB(B1, 1, 1); PG8_SCHED; PG8_LDA(At, 1, 0); PG8_STAGE(PG8_SA(0, 1), a2 + hstep, voffA);
            PG8_WAIT_V(8); PG8_WAIT_L(0); PG8_BAR; PG8_MMA(0, 0, At, B0); PG8_MMA(0, 1, At, B1); PG8_BAR; PG8_SCHED;
            PG8_LDA(At, 1, 1); PG8_STAGE(PG8_SB(1, 0), b3, voffB); PG8_STAGE(PG8_SB(1, 1), b3 + hstep, voffB); PG8_STAGE(PG8_SA(1, 0), a3, voffA);
            PG8_WAIT_V(8); PG8_WAIT_L(0); PG8_BAR; PG8_MMA(1, 0, At, B0); PG8_MMA(1, 1, At, B1); PG8_BAR; PG8_SCHED;
            } else {
            PG8_LDB(B0, 0, 0); PG8_SCHED; PG8_LDA(At, 0, 0); PG8_STAGE(PG8_SA(1, 1), a1 + hstep, voffA);
            PG8_WAIT_L(8); PG8_BAR; PG8_WAIT_L(0); PG8_MMA(0, 0, At, B0); PG8_BAR; PG8_SCHED;
            PG8_LDB(B1, 0, 1); PG8_STAGE(PG8_SB(0, 0), b2, voffB);
            PG8_BAR; PG8_WAIT_L(0); PG8_MMA(0, 1, At, B1); PG8_BAR;
            PG8_LDA(At, 0, 1); PG8_STAGE(PG8_SA(0, 0), a2, voffA);
            PG8_BAR; PG8_WAIT_L(0); PG8_MMA(1, 0, At, B0); PG8_BAR; PG8_SCHED;
            PG8_STAGE(PG8_SB(0, 1), b2 + hstep, voffB);
            PG8_WAIT_V(6); PG8_BAR; PG8_MMA(1, 1, At, B1); PG8_BAR;
            PG8_LDB(B0, 1, 0); PG8_SCHED; PG8_LDA(At, 1, 0); PG8_STAGE(PG8_SA(0, 1), a2 + hstep, voffA);
            PG8_WAIT_L(8); PG8_BAR; PG8_WAIT_L(0); PG8_MMA(0, 0, At, B0); PG8_BAR; PG8_SCHED;
            PG8_LDB(B1, 1, 1); PG8_STAGE(PG8_SB(1, 0), b3, voffB);
            PG8_BAR; PG8_WAIT_L(0); PG8_MMA(0, 1, At, B1); PG8_BAR;
            PG8_LDA(At, 1, 1); PG8_STAGE(PG8_SA(1, 0), a3, voffA);
            PG8_BAR; PG8_WAIT_L(0); PG8_MMA(1, 0, At, B0); PG8_BAR; PG8_SCHED;
            PG8_STAGE(PG8_SB(1, 1), b3 + hstep, voffB);
            PG8_WAIT_V(6); PG8_BAR; PG8_MMA(1, 1, At, B1); PG8_BAR;
            }
        }
        if constexpr (ALIGN_EPI) { if (wr == 0) PG8_BAR; }
        if constexpr (!Epi::AFTER_DRAIN) { E(acc, cur, wr, wc, fr, fq); S.done(cur); }
        if (!has_next) break;
#pragma unroll
        for (int a = 0; a < 2; ++a)
#pragma unroll
            for (int b = 0; b < 2; ++b)
#pragma unroll
                for (int m = 0; m < 4; ++m)
#pragma unroll
                    for (int n = 0; n < 2; ++n) acc[a][b][m][n] = (f32x4){0.f, 0.f, 0.f, 0.f};
        cur = nxt; cA = nA; cB = nB; ++ui;
        if constexpr (ALIGN_EPI) { if (wr == 1) PG8_BAR; }
    }
    PG8_WAIT_V(0);
    if constexpr (!ALIGN_EPI) { if (wr == 0) PG8_BAR; }
    PG8_BAR;
    if constexpr (Epi::AFTER_DRAIN) { E.fused(acc, cur, wr, wc, fr, fq, lds, wid, lane); S.done(cur); }
#undef PG8_SA
#undef PG8_SB
#undef PG8_STAGE
#undef PG8_LDA
#undef PG8_LDB
#undef PG8_MMA
#undef PG8_WAIT_V
#undef PG8_WAIT_L
#undef PG8_BAR
#undef PG8_SCHED
}
}

#define LAS __attribute__((address_space(3)))
constexpr int NWAVES = 8, NTHR = 512;
constexpr int LDS_BYTES = 147456;
constexpr int NPH = 21;
typedef float f32x4 __attribute__((ext_vector_type(4)));
typedef unsigned u32x4 __attribute__((ext_vector_type(4)));

struct Args { const float* in[30]; float* out; unsigned char* ws; int ph_lo, ph_hi; };

__device__ __forceinline__ unsigned pk2(float lo, float hi) { return (unsigned)f2bf(lo) | ((unsigned)f2bf(hi) << 16); }

__device__ __forceinline__ void p0_transpose_item(const float* W, int K, int N, bf16* WT, int row_off, LAS float* scr, int item, int lane) {
    const int nblk = N / 32, kb = item / nblk, nb = item % nblk, k0 = 64 * kb, n0 = 32 * nb;
#pragma unroll 8
    for (int i = 0; i < 32; ++i) { const int kk = 2 * i + (lane >> 5); scr[kk * 33 + (lane & 31)] = W[(size_t)(k0 + kk) * N + n0 + (lane & 31)]; }
    asm volatile("s_waitcnt lgkmcnt(0)" ::: "memory");
    const int c = lane & 7;
#pragma unroll
    for (int j = 0; j < 4; ++j) { const int n = (lane >> 3) + 8 * j; const LAS float* s = scr + (8 * c) * 33 + n;
        u32x4 o; o.x = pk2(s[0 * 33], s[1 * 33]); o.y = pk2(s[2 * 33], s[3 * 33]); o.z = pk2(s[4 * 33], s[5 * 33]); o.w = pk2(s[6 * 33], s[7 * 33]);
        *(u32x4*)(WT + (size_t)(row_off + n0 + n) * K + k0 + 8 * c) = o; }
    asm volatile("s_waitcnt lgkmcnt(0)" ::: "memory");
}

__device__ __forceinline__ void norm_mod_row(const float* xr, const float* gamma, const float* sh, const float* sc, bf16* orow, int lane) {
    f32x4 v[4]; float ss = 0.f;
#pragma unroll
    for (int j = 0; j < 4; ++j) { v[j] = *(const f32x4*)(xr + j * 256 + lane * 4); ss += (v[j].x * v[j].x + v[j].y * v[j].y) + (v[j].z * v[j].z + v[j].w * v[j].w); }
    const float rs = rsqrtf(wave_sum(ss, lane) * (1.f / D) + NORM_EPS);
#pragma unroll
    for (int j = 0; j < 4; ++j) { const int d = j * 256 + lane * 4; const f32x4 g = *(const f32x4*)(gamma + d), a = *(const f32x4*)(sc + d), s = *(const f32x4*)(sh + d);
        const f32x4 y = v[j] * rs * g * (a + 1.f) + s; uint2 o; o.x = pk2(y.x, y.y); o.y = pk2(y.z, y.w); *(uint2*)(orow + d) = o; }
}


#define XB_TMO      128
#define XB_XCNT(j)  (256  + 64 * (j))
#define XB_XSUB(j)  (1280 + 64 * (j))
#define XB_XGEN(j)  (2304 + 64 * (j))
#define XB_TOP      3328
#define XB_TOPGEN   3392
#define XCD_BAR_WORDS 3456
#define XB_SPIN_CAP (1u << 18)

__device__ __forceinline__ unsigned xb_ld(unsigned* p)              { return __hip_atomic_load(p, __ATOMIC_RELAXED, __HIP_MEMORY_SCOPE_AGENT); }
__device__ __forceinline__ unsigned xb_add(unsigned* p, unsigned v) { return __hip_atomic_fetch_add(p, v, __ATOMIC_RELAXED, __HIP_MEMORY_SCOPE_AGENT); }
__device__ __forceinline__ unsigned xb_xcc_id() { return (unsigned)__builtin_amdgcn_s_getreg((3 << 11) | 20) & 0xFu; }
#define XB_SPIN(cond, bar) do { unsigned _sp = 0; while (cond) { __builtin_amdgcn_s_sleep(1); \
    if ((++_sp & 255u) == 0u) { if (xb_ld(&(bar)[XB_TMO])) break; if (_sp > XB_SPIN_CAP) { atomicAdd(&(bar)[XB_TMO], 1u); break; } } } } while (0)

struct XcdBarrier {
    unsigned* bar; unsigned x; int w0;
    volatile __attribute__((address_space(3))) unsigned* st;
};

__device__ __forceinline__ XcdBarrier xcd_barrier_post(unsigned* bar, volatile __attribute__((address_space(3))) unsigned* st) {
    XcdBarrier b; b.bar = bar; b.x = xb_xcc_id(); b.st = st; b.w0 = __builtin_amdgcn_readfirstlane((int)threadIdx.x >> 6);
    if (threadIdx.x == 0) (void)xb_add(&bar[XB_XCNT(b.x)], 1u);
    return b;
}
__device__ __forceinline__ void xcd_barrier_complete(unsigned* bar, unsigned x, unsigned& nloc, unsigned& nx) {
    const unsigned G = gridDim.x * gridDim.y * gridDim.z;
    unsigned sum, cnt, mine, sp = 0u;
    for (;;) {
        sum = 0u; cnt = 0u; mine = 0u;
#pragma unroll
        for (unsigned j = 0; j < 16; ++j) { const unsigned c = xb_ld(&bar[XB_XCNT(j)]); sum += c; cnt += (c > 0u) ? 1u : 0u; }
        mine = xb_ld(&bar[XB_XCNT(x)]);
        if (sum == G) break;
        __builtin_amdgcn_s_sleep(1);
        if ((++sp & 255u) == 0u) { if (xb_ld(&bar[XB_TMO])) break; if (sp > XB_SPIN_CAP) { atomicAdd(&bar[XB_TMO], 1u); break; } }
    }
    nloc = mine > 0u ? mine : 1u; nx = cnt > 0u ? cnt : 1u;
}

template <bool FIRST> __device__ __forceinline__ void xcd_barrier(const XcdBarrier& b) {
    asm volatile("s_waitcnt vmcnt(0)" ::: "memory");
    __syncthreads();
    int lid_; asm volatile("v_mbcnt_lo_u32_b32 %0, -1, 0\n\tv_mbcnt_hi_u32_b32 %0, -1, %0" : "=v"(lid_));
    if (b.w0 == 0 && lid_ == 0) {
        unsigned* bar = b.bar;
        __builtin_amdgcn_s_waitcnt(0);
        unsigned nloc = b.st[0], nx = b.st[1];
        if (FIRST && nloc == 0u) { xcd_barrier_complete(bar, b.x, nloc, nx); b.st[0] = nloc; b.st[1] = nx; }
        const unsigned old = xb_add(&bar[XB_XSUB(b.x)], 1u);
        const unsigned gen = old / nloc;
        if (old + 1u == (gen + 1u) * nloc) {
            __builtin_amdgcn_fence(__ATOMIC_RELEASE, "agent");
            asm volatile("s_waitcnt vmcnt(0)" ::: "memory");
            const unsigned og = xb_add(&bar[XB_TOP], 1u);
            const unsigned tg = og / nx;
            if (og + 1u == (tg + 1u) * nx) xb_add(&bar[XB_TOPGEN], 1u);
            else XB_SPIN(xb_ld(&bar[XB_TOPGEN]) == tg, bar);
            __builtin_amdgcn_fence(__ATOMIC_ACQUIRE, "agent");
            xb_add(&bar[XB_XGEN(b.x)], 1u);
            asm volatile("s_waitcnt vmcnt(0)" ::: "memory");
        } else {
            XB_SPIN(xb_ld(&bar[XB_XGEN(b.x)]) == gen, bar);
            __builtin_amdgcn_fence(__ATOMIC_ACQUIRE, "agent");
            asm volatile("s_waitcnt vmcnt(0)" ::: "memory");
        }
    }
    __syncthreads();
}


__device__ __forceinline__ unsigned mono_u32(float f) { unsigned u = __float_as_uint(f); return (u & 0x80000000u) ? ~u : (u | 0x80000000u); }
__device__ __forceinline__ float demono_u32(unsigned u) { return __uint_as_float((u & 0x80000000u) ? (u & 0x7FFFFFFFu) : ~u); }
__device__ __forceinline__ unsigned pack_key7(float f, int idx) { return (mono_u32(f) & 0xFFFFFF80u) | (unsigned)(127 - idx); }
__device__ __forceinline__ float unpack_key7(unsigned k) { return demono_u32((k & 0xFFFFFF80u) | 0x40u); }
__device__ __forceinline__ float unpack_key8(unsigned k) { return demono_u32((k & 0xFFFFFF00u) | 0x80u); }
__device__ __forceinline__ void ce_desc(unsigned& a, unsigned& b) { const unsigned hi = a > b ? a : b, lo = a > b ? b : a; a = hi; b = lo; }
__device__ __forceinline__ void sort16_desc(unsigned* v) {
#pragma unroll
    for (int k = 2; k <= 16; k <<= 1)
#pragma unroll
        for (int j = k >> 1; j > 0; j >>= 1)
#pragma unroll
            for (int i = 0; i < 16; ++i) { const int l = i ^ j; if (l > i) { if ((i & k) == 0) ce_desc(v[i], v[l]); else ce_desc(v[l], v[i]); } }
}
__device__ __forceinline__ void bmerge16_desc(unsigned* v) {
#pragma unroll
    for (int j = 8; j > 0; j >>= 1)
#pragma unroll
        for (int i = 0; i < 16; ++i) { const int l = i ^ j; if (l > i) ce_desc(v[i], v[l]); }
}
__device__ __forceinline__ void merge_top16(unsigned* a, const unsigned* b) {
#pragma unroll
    for (int i = 0; i < 16; ++i) { const unsigned o = b[15 - i]; a[i] = a[i] > o ? a[i] : o; }
    bmerge16_desc(a);
}
__device__ __forceinline__ void stage2_cands(const unsigned* s0, const unsigned* s1, int hh, unsigned* c) {
    float A[16], B[16];
#pragma unroll
    for (int i = 0; i < 16; ++i) { const float f0 = unpack_key7(s0[i]), f1 = unpack_key7(s1[i]); A[i] = hh ? f1 : f0; B[i] = hh ? f0 : f1; }
    int n = 0;
#pragma unroll
    for (int i = 0; i < 4; ++i)
#pragma unroll
        for (int j = i; j < 16; ++j) { if ((i + 1) * (j + 1) > 16) continue;
            const float val = A[i] + B[j]; const unsigned id = hh ? (unsigned)((j << 4) | i) : (unsigned)((i << 4) | j);
            unsigned key = (mono_u32(val) & 0xFFFFFF00u) | id; if (hh && i == j) key = 0u; c[n++] = key; }
#pragma unroll
    for (; n < 32; ++n) c[n] = 0u;
}

typedef short bf16x8_t __attribute__((ext_vector_type(8)));
typedef float f32x16 __attribute__((ext_vector_type(16)));
__device__ __forceinline__ float gelu_erf(float a) { return 0.5f * a * (1.f + erff(a * 0.70710678118654752f)); }

__global__ void __launch_bounds__(NTHR, 2) mega(Args args) {
    extern __shared__ __attribute__((aligned(16))) unsigned char lds_raw[];
    LAS unsigned char* lds = (LAS unsigned char*)lds_raw;
    const int G = gridDim.x, bx = blockIdx.x, NGW = G * NWAVES;
    const int wave0 = __builtin_amdgcn_readfirstlane((int)threadIdx.x >> 6);
    typedef const unsigned char __attribute__((address_space(4))) kbyte;
#define PHASE_IDS int tid; asm volatile("v_mbcnt_lo_u32_b32 %0, -1, 0\n\tv_mbcnt_hi_u32_b32 %0, -1, %0" : "=v"(tid)); tid += wave0 * 64;     const int lane = tid & 63, wave = __builtin_amdgcn_readfirstlane(tid >> 6), gw = bx * NWAVES + wave; (void)lane; (void)gw; \
    kbyte* kp = (kbyte*)__builtin_amdgcn_kernarg_segment_ptr(); asm volatile("" : "+s"(kp)); \
    unsigned char* const ws = (unsigned char*)*(__attribute__((address_space(1))) unsigned char* const __attribute__((address_space(4)))*)(kp + 31 * 8); float* const X = (float*)*(__attribute__((address_space(1))) float* const __attribute__((address_space(4)))*)(kp + 30 * 8); (void)ws; (void)X;
#define INP(i) ((const float*)(*(const __attribute__((address_space(1))) float* const __attribute__((address_space(4)))*)(kp + (i) * 8)))
#define MOD ((float*)(ws + WS_MOD))
#define H ((bf16*)(ws + WS_H))
#define PROJ ((bf16*)(ws + WS_PROJ))
#define Q ((bf16*)(ws + WS_Q))
#define MIX ((bf16*)(ws + WS_MIX))
#define Rb ((bf16*)(ws + WS_R))
#define Kb ((bf16*)(ws + WS_K))
#define V0 ((bf16*)(ws + WS_V0))
#define V1 ((bf16*)(ws + WS_V1))
#define KKb ((bf16*)(ws + WS_KK))
#define Bb ((bf16*)(ws + WS_B))
#define Gb ((bf16*)(ws + WS_G))
#define BGb ((bf16*)(ws + WS_BG))
#define Wd ((float*)(ws + WS_W))
#define Y ((float*)(ws + WS_Y))
#define QB ((float*)(ws + WS_QB))
#define SH ((float*)(ws + WS_SH))
#define WUPT ((bf16*)(ws + WS_LORA))
#define AUPT ((bf16*)(ws + WS_LORA + 131072))
#define GUPT ((bf16*)(ws + WS_LORA + 262144))
#define VUPT ((bf16*)(ws + WS_LORA + 524288))
#define INVN ((float*)(ws + WS_INVN))
#define BSUM ((float*)(ws + WS_BSUM))
#define IDX ((int*)(ws + WS_IDX))
#define GATE ((float*)(ws + WS_GATE))
#define WinT ((bf16*)(ws + WS_WIN_T))
#define WoutT ((bf16*)(ws + WS_WOUT_T))
#define PqT ((bf16*)(ws + WS_PQ_T))
#define KEYS ((bf16*)(ws + WS_KEYS))
#define U8 ((unsigned char*)(ws + WS_U))
#define V8 ((unsigned char*)(ws + WS_V))
#define USc ((float*)(ws + WS_US))
#define VSc ((float*)(ws + WS_VS))
    const int lo = args.ph_lo, hi = args.ph_hi;
    { volatile LAS unsigned* misc = (volatile LAS unsigned*)(lds + 131072 + 64); if (threadIdx.x < 4) misc[threadIdx.x] = 0u; __syncthreads(); }
    const XcdBarrier xbar = xcd_barrier_post((unsigned*)(args.ws) + 4096, (volatile LAS unsigned*)(lds + 131072 + 64));
#define IN(k) (lo <= (k) && (k) < hi)
#ifndef REP_PHASE
#define REP_PHASE (-1)
#endif
#define REPS(k) ((k) == REP_PHASE ? 3 : 1)
#define SEAM(k) do { if (IN(k) && IN((k) + 1)) { if ((k) == 0) cg::this_grid().sync(); else { XcdBarrier xb_ = xbar; asm volatile("" : "+s"(xb_.bar)); if ((k) == 1) xcd_barrier<true>(xb_); else xcd_barrier<false>(xb_); } } } while (0)

    if (IN(0)) { PHASE_IDS
        { LAS float* ca = (LAS float*)lds; LAS float* red = (LAS float*)(lds + 16384);
          const float* c = INP(1); const float* ada_w = INP(2); const float* ada_b = INP(3);
          bool have = false;
          for (int it = bx; it < 96; it += G) {
              if (!have) { for (int i = tid; i < BATCH * D; i += NTHR) { const float v = c[i]; ca[i] = v / (1.f + expf(-v)); } have = true; __syncthreads(); }
              const int l = it / 48, n = (it % 48) * 128 + (tid & 127), kq = tid >> 7;
              const float* w = ada_w + (size_t)l * D * 6 * D + (size_t)(kq * 256) * 6 * D + n;
              float a0 = 0.f, a1 = 0.f, a2 = 0.f, a3 = 0.f;
#pragma unroll 8
              for (int k = 0; k < 256; ++k) { const float wv = w[(size_t)k * 6 * D]; const int kk = kq * 256 + k; a0 += ca[kk] * wv; a1 += ca[D + kk] * wv; a2 += ca[2 * D + kk] * wv; a3 += ca[3 * D + kk] * wv; }
              red[(kq * 4 + 0) * 128 + (tid & 127)] = a0; red[(kq * 4 + 1) * 128 + (tid & 127)] = a1; red[(kq * 4 + 2) * 128 + (tid & 127)] = a2; red[(kq * 4 + 3) * 128 + (tid & 127)] = a3;
              __syncthreads();
              { const int b = tid >> 7, col = tid & 127, nn = (it % 48) * 128 + col;
                const float s = red[(0 * 4 + b) * 128 + col] + red[(1 * 4 + b) * 128 + col] + red[(2 * 4 + b) * 128 + col] + red[(3 * 4 + b) * 128 + col];
                MOD[(size_t)l * BATCH * 6 * D + (size_t)b * 6 * D + nn] = s + ada_b[l * 6 * D + nn]; }
              __syncthreads();
          }
          __syncthreads(); }
        { LAS float* scr = (LAS float*)(lds + wave * 16384);
          constexpr int I_IN = (D / 64) * (IN_COLS / 32), I_VR = (D / 64) * (MVL / 32), I_OUT = (D / 64) * (D / 32), I_PQ = (D / 64) * (PH * PQ / 32);
          constexpr int NIT = 2 * I_IN + I_VR + 2 * I_OUT + 2 * I_PQ;
          for (int it = gw; it < NIT; it += NGW) { int r = it;
              if (r < 2 * I_IN) { const int l = r / I_IN; p0_transpose_item(INP(5) + (size_t)l * D * IN_COLS, D, IN_COLS, WinT + (size_t)l * LDP * D, 0, scr, r % I_IN, lane); continue; } r -= 2 * I_IN;
              if (r < I_VR) { p0_transpose_item(INP(12), D, MVL, WinT + (size_t)1 * LDP * D, IN_COLS, scr, r, lane); continue; } r -= I_VR;
              if (r < 2 * I_OUT) { const int l = r / I_OUT; p0_transpose_item(INP(23) + (size_t)l * D * D, D, D, WoutT + (size_t)l * D * D, 0, scr, r % I_OUT, lane); continue; } r -= 2 * I_OUT;
              { const int l = r / I_PQ; p0_transpose_item(INP(25) + (size_t)l * D * PH * PQ, D, PH * PQ, PqT + (size_t)l * PH * PQ * D, 0, scr, r % I_PQ, lane); } }
          for (int it = gw; it < 2 * 16 + 2 * 16 + 2 * 32; it += NGW) { int r = it;
              if (r < 32) { const int l = r / 16; p0_transpose_item(INP(8) + (size_t)l * DL * RW, DL, RW, WUPT + (size_t)l * RW * DL, 0, scr, r % 16, lane); continue; } r -= 32;
              if (r < 32) { const int l = r / 16; p0_transpose_item(INP(10) + (size_t)l * AL * RW, AL, RW, AUPT + (size_t)l * RW * AL, 0, scr, r % 16, lane); continue; } r -= 32;
              { const int l = r / 32; p0_transpose_item(INP(11) + (size_t)l * GL * RW, GL, RW, GUPT + (size_t)l * RW * GL, 0, scr, r % 32, lane); } }
          { const float* vu = INP(15); for (int e = bx * NTHR + tid; e < MVL * RW; e += G * NTHR) { const int n = e >> 5, k = e & 31; VUPT[e] = f2bf(vu[k * RW + n]); } } }
        { const size_t gt = (size_t)bx * NTHR + tid, NT = (size_t)G * NTHR;
          constexpr size_t NK8 = (size_t)2 * PH * 2 * NKEYS * PHALF / 8;
          const float* src = INP(26); bf16* dst = KEYS;
          for (size_t i = gt; i < NK8; i += NT) {
              const f32x4 a = *(const f32x4*)(src + i * 8), b = *(const f32x4*)(src + i * 8 + 4);
              u32x4 o; o.x = pk2(a.x, a.y); o.y = pk2(a.z, a.w); o.z = pk2(b.x, b.y); o.w = pk2(b.z, b.w); *(u32x4*)(dst + i * 8) = o; }
          const float* pu = INP(27); const float* pv = INP(28);
          for (int row0 = gw * 2; row0 < 4 * NEXP; row0 += NGW * 2) {
              f32x4 v[2][4]; float m[2];
#pragma unroll
              for (int rr = 0; rr < 2; ++rr) { const int row = row0 + rr; const float* sp_ = (row < 2 * NEXP ? pu + (size_t)row * D : pv + (size_t)(row - 2 * NEXP) * D) + lane * 16;
#pragma unroll
                  for (int q = 0; q < 4; ++q) v[rr][q] = *(const f32x4*)(sp_ + q * 4); }
#pragma unroll
              for (int rr = 0; rr < 2; ++rr) { float mm = 0.f;
#pragma unroll
                  for (int q = 0; q < 4; ++q) mm = fmaxf(fmaxf(mm, fmaxf(fabsf(v[rr][q].x), fabsf(v[rr][q].y))), fmaxf(fabsf(v[rr][q].z), fabsf(v[rr][q].w)));
#pragma unroll
                  for (int o = 1; o < 64; o <<= 1) mm = fmaxf(mm, shflx(mm, lane, o));
                  m[rr] = mm; }
#pragma unroll
              for (int rr = 0; rr < 2; ++rr) { const int row = row0 + rr; const float sc = m[rr] > 0.f ? 448.f / m[rr] : 1.f;
                  u32x4 o; int w;
                  w = 0; w = __builtin_amdgcn_cvt_pk_fp8_f32(v[rr][0].x * sc, v[rr][0].y * sc, w, false); w = __builtin_amdgcn_cvt_pk_fp8_f32(v[rr][0].z * sc, v[rr][0].w * sc, w, true); o.x = (unsigned)w;
                  w = 0; w = __builtin_amdgcn_cvt_pk_fp8_f32(v[rr][1].x * sc, v[rr][1].y * sc, w, false); w = __builtin_amdgcn_cvt_pk_fp8_f32(v[rr][1].z * sc, v[rr][1].w * sc, w, true); o.y = (unsigned)w;
                  w = 0; w = __builtin_amdgcn_cvt_pk_fp8_f32(v[rr][2].x * sc, v[rr][2].y * sc, w, false); w = __builtin_amdgcn_cvt_pk_fp8_f32(v[rr][2].z * sc, v[rr][2].w * sc, w, true); o.z = (unsigned)w;
                  w = 0; w = __builtin_amdgcn_cvt_pk_fp8_f32(v[rr][3].x * sc, v[rr][3].y * sc, w, false); w = __builtin_amdgcn_cvt_pk_fp8_f32(v[rr][3].z * sc, v[rr][3].w * sc, w, true); o.w = (unsigned)w;
                  unsigned char* d8 = (row < 2 * NEXP ? U8 + (size_t)row * D : V8 + (size_t)(row - 2 * NEXP) * D) + lane * 16;
                  *(u32x4*)d8 = o;
                  if (lane == 0) { if (row < 2 * NEXP) USc[row] = m[rr] > 0.f ? m[rr] * (1.f / 448.f) : 1.f; else VSc[row - 2 * NEXP] = m[rr] > 0.f ? m[rr] * (1.f / 448.f) : 1.f; } }
          } }
    }
    SEAM(0);

#pragma unroll
    for (int l = 0; l < DEPTH; ++l) {
        const int pb = 1 + 10 * l;
#define modl (MOD + (size_t)l * BATCH * 6 * D)
#define xin (l == 0 ? INP(0) : (const float*)X)
        if (IN(pb + 0)) { PHASE_IDS const float* gamma = INP(4) + l * D;
            for (int row = gw; row < T; row += NGW) { const int b = row / SEQ; norm_mod_row(xin + (size_t)row * D, gamma, modl + (size_t)b * 6 * D, modl + (size_t)b * 6 * D + D, H + (size_t)row * D, lane); } }
        SEAM(pb + 0);
        if (IN(pb + 1)) { PHASE_IDS const int N1 = l == 0 ? IN_COLS : LDP;
            pg8::Gemm g{H, WinT + (size_t)l * LDP * D, T, N1, D}; pg8::StaticOrder S; S.init(T, N1, G, bx);
            pg8::EpiBf16<0> E{PROJ, LDP, nullptr, 0, 0, 1.f};
            pg8::gemm_phase<pg8::EpiBf16<0>, pg8::StaticOrder, true, true>(lds, g, S, E, tid); }
        SEAM(pb + 1);

        if (IN(pb + 2)) { PHASE_IDS
            constexpr int LST = 296;
            LAS bf16* lin = (LAS bf16*)lds;
            const float* mu = INP(6) + l * RWKV_COLS; const float* vmu = INP(13);
            const float* w0p = INP(7) + l * RW; const float* a0p = INP(9) + l * RW; const float* kkp = INP(16) + l * RW; const float* kap = INP(17) + l * RW; const float* rkp = INP(18) + l * RW; const float* v0p = INP(14);
            const bf16* wupT = WUPT + (size_t)l * RW * DL; const bf16* aupT = AUPT + (size_t)l * RW * AL; const bf16* gupT = GUPT + (size_t)l * RW * GL; const bf16* vupT = VUPT;
            bf16* Vl = l == 0 ? V0 : V1;
            const int r32 = lane & 31, hh = lane >> 5, h = wave;
            for (int tile = bx; tile < T / 32; tile += G) {
                const int t0 = tile * 32;
                __syncthreads();
                for (int c8 = tid; c8 < 32 * 36; c8 += NTHR) {
                    const int tok = c8 / 36, jc = c8 % 36, t = t0 + tok, sq = t % SEQ;
                    u32x4 o = {0u, 0u, 0u, 0u};
                    if (jc < 32 || l > 0) {
                        const int col = jc < 32 ? 3 * RW + jc * 8 : IN_COLS + (jc - 32) * 8;
                        const u32x4 cu = *(const u32x4*)(PROJ + (size_t)t * LDP + col); u32x4 pv = {0u, 0u, 0u, 0u}; if (sq > 0) pv = *(const u32x4*)(PROJ + (size_t)(t - 1) * LDP + col);
                        const float* mp = jc < 32 ? mu + col : vmu + (jc - 32) * 8; const f32x4 m0 = *(const f32x4*)mp, m1 = *(const f32x4*)(mp + 4);
                        float x[8]; const unsigned cw[4] = {cu.x, cu.y, cu.z, cu.w}, pw[4] = {pv.x, pv.y, pv.z, pv.w}; const float mm[8] = {m0.x, m0.y, m0.z, m0.w, m1.x, m1.y, m1.z, m1.w};
#pragma unroll
                        for (int i = 0; i < 4; ++i) { const float c0 = __uint_as_float(cw[i] << 16), c1 = __uint_as_float(cw[i] & 0xffff0000u), p0 = __uint_as_float(pw[i] << 16), p1 = __uint_as_float(pw[i] & 0xffff0000u);
                            x[2 * i] = c0 + (p0 - c0) * mm[2 * i]; x[2 * i + 1] = c1 + (p1 - c1) * mm[2 * i + 1]; }
                        if (jc < 8) {
#pragma unroll
                            for (int i = 0; i < 8; ++i) { const float e2 = __expf(-2.f * fabsf(x[i])); const float th = (1.f - e2) * __builtin_amdgcn_rcpf(1.f + e2); x[i] = x[i] < 0.f ? -th : th; } }
                        else if (jc >= 16 && jc < 32) {
#pragma unroll
                            for (int i = 0; i < 8; ++i) x[i] = __builtin_amdgcn_rcpf(1.f + __expf(-x[i])); }
                        o.x = pk2(x[0], x[1]); o.y = pk2(x[2], x[3]); o.z = pk2(x[4], x[5]); o.w = pk2(x[6], x[7]);
                    }
                    *(LAS u32x4*)(lin + tok * LST + jc * 8) = o;
                }
                __syncthreads();
                const int t = t0 + r32, sq = t % SEQ;
                const bf16* prow = PROJ + (size_t)t * LDP; const bf16* pprev = prow - LDP;
                float ss = 0.f, bs = 0.f;
#pragma unroll 1
                for (int rt = 0; rt < 2; ++rt) {
                    f32x16 accW, accA, accG, accV;
#pragma unroll
                    for (int e = 0; e < 16; ++e) { accW[e] = 0.f; accA[e] = 0.f; accG[e] = 0.f; accV[e] = 0.f; }
                    const int crow = h * HS + rt * 32 + r32;
                    const LAS bf16* lrow = lin + r32 * LST + 8 * hh;
#pragma unroll
                    for (int ks = 0; ks < 4; ++ks) { const bf16x8_t a = *(const bf16x8_t*)(wupT + (size_t)crow * DL + ks * 16 + 8 * hh); const bf16x8_t bq = *(const LAS bf16x8_t*)(lrow + ks * 16); accW = __builtin_amdgcn_mfma_f32_32x32x16_bf16(a, bq, accW, 0, 0, 0); }
#pragma unroll
                    for (int ks = 0; ks < 4; ++ks) { const bf16x8_t a = *(const bf16x8_t*)(aupT + (size_t)crow * AL + ks * 16 + 8 * hh); const bf16x8_t bq = *(const LAS bf16x8_t*)(lrow + 64 + ks * 16); accA = __builtin_amdgcn_mfma_f32_32x32x16_bf16(a, bq, accA, 0, 0, 0); }
#pragma unroll
                    for (int ks = 0; ks < 8; ++ks) { const bf16x8_t a = *(const bf16x8_t*)(gupT + (size_t)crow * GL + ks * 16 + 8 * hh); const bf16x8_t bq = *(const LAS bf16x8_t*)(lrow + 128 + ks * 16); accG = __builtin_amdgcn_mfma_f32_32x32x16_bf16(a, bq, accG, 0, 0, 0); }
                    if (l > 0) {
#pragma unroll
                        for (int ks = 0; ks < 2; ++ks) { const bf16x8_t a = *(const bf16x8_t*)(vupT + (size_t)crow * MVL + ks * 16 + 8 * hh); const bf16x8_t bq = *(const LAS bf16x8_t*)(lrow + 256 + ks * 16); accV = __builtin_amdgcn_mfma_f32_32x32x16_bf16(a, bq, accV, 0, 0, 0); } }
#pragma unroll
                    for (int g4 = 0; g4 < 4; ++g4) {
                        const int c0 = h * HS + rt * 32 + 8 * g4 + 4 * hh;
                        const uint2 rc = *(const uint2*)(prow + c0), kc = *(const uint2*)(prow + RW + c0), vc = *(const uint2*)(prow + 2 * RW + c0);
                        uint2 rp = {0u, 0u}, kp2 = {0u, 0u}, vp = {0u, 0u};
                        if (sq > 0) { rp = *(const uint2*)(pprev + c0); kp2 = *(const uint2*)(pprev + RW + c0); vp = *(const uint2*)(pprev + 2 * RW + c0); }
                        const f32x4 mur = *(const f32x4*)(mu + c0), muk = *(const f32x4*)(mu + RW + c0), muv = *(const f32x4*)(mu + 2 * RW + c0);
                        const f32x4 w0v = *(const f32x4*)(w0p + c0), a0v = *(const f32x4*)(a0p + c0), kkv = *(const f32x4*)(kkp + c0), kav = *(const f32x4*)(kap + c0), rkv = *(const f32x4*)(rkp + c0);
                        f32x4 v0v = {0.f, 0.f, 0.f, 0.f}; uint2 vf = {0u, 0u};
                        if (l > 0) { v0v = *(const f32x4*)(v0p + c0); vf = *(const uint2*)(V0 + (size_t)t * RW + c0); }
                        float ro[4], ko[4], vo[4], kko[4], bo[4], go[4], vgo[4], wdo[4];
#pragma unroll
                        for (int i = 0; i < 4; ++i) {
                            const unsigned rw_ = i < 2 ? rc.x : rc.y, kw_ = i < 2 ? kc.x : kc.y, vw_ = i < 2 ? vc.x : vc.y, rpw = i < 2 ? rp.x : rp.y, kpw = i < 2 ? kp2.x : kp2.y, vpw = i < 2 ? vp.x : vp.y, vfw = i < 2 ? vf.x : vf.y;
                            const bool hi = (i & 1) != 0;
                            float r = __uint_as_float(hi ? (rw_ & 0xffff0000u) : (rw_ << 16)), k = __uint_as_float(hi ? (kw_ & 0xffff0000u) : (kw_ << 16)), v = __uint_as_float(hi ? (vw_ & 0xffff0000u) : (vw_ << 16));
                            const float rpv = __uint_as_float(hi ? (rpw & 0xffff0000u) : (rpw << 16)), kpv = __uint_as_float(hi ? (kpw & 0xffff0000u) : (kpw << 16)), vpv = __uint_as_float(hi ? (vpw & 0xffff0000u) : (vpw << 16));
                            r += (rpv - r) * mur[i]; k += (kpv - k) * muk[i]; v += (vpv - v) * muv[i];
                            const int e = g4 * 4 + i;
                            const float z = -(w0v[i] + accW[e]); const float sp = fmaxf(z, 0.f) + __logf(1.f + __expf(-fabsf(z)));
                            const float decay = __expf(-__expf(-sp - 0.5f));
                            const float a = __builtin_amdgcn_rcpf(1.f + __expf(-(a0v[i] + accA[e]))); const float g = accG[e];
                            if (l > 0) { const float vfv = __uint_as_float(hi ? (vfw & 0xffff0000u) : (vfw << 16)); v = v + (vfv - v) * __builtin_amdgcn_rcpf(1.f + __expf(-(v0v[i] + accV[e]))); }
                            const float kk = k * kkv[i]; const float k2 = k * (1.f + (a - 1.f) * kav[i]);
                            ss += kk * kk; bs += r * k2 * rkv[i];
                            ro[i] = r; ko[i] = k2; vo[i] = v; kko[i] = kk; bo[i] = kk * a; go[i] = g; vgo[i] = v * g; wdo[i] = decay;
                        }
                        const size_t o = (size_t)t * RW + c0;
                        *(uint2*)(Rb + o) = make_uint2(pk2(ro[0], ro[1]), pk2(ro[2], ro[3])); *(uint2*)(Kb + o) = make_uint2(pk2(ko[0], ko[1]), pk2(ko[2], ko[3])); *(uint2*)(Vl + o) = make_uint2(pk2(vo[0], vo[1]), pk2(vo[2], vo[3]));
                        *(uint2*)(KKb + o) = make_uint2(pk2(kko[0], kko[1]), pk2(kko[2], kko[3])); *(uint2*)(Bb + o) = make_uint2(pk2(bo[0], bo[1]), pk2(bo[2], bo[3]));
                        *(uint2*)(Gb + o) = make_uint2(pk2(go[0], go[1]), pk2(go[2], go[3])); *(uint2*)(BGb + o) = make_uint2(pk2(vgo[0], vgo[1]), pk2(vgo[2], vgo[3]));
                        *(f32x4*)(Wd + o) = (f32x4){wdo[0], wdo[1], wdo[2], wdo[3]};
                    }
                }
                ss += shflx(ss, lane, 32); bs += shflx(bs, lane, 32);
                if (hh == 0) { INVN[(size_t)t * NH + h] = rsqrtf(fmaxf(ss, 1e-24f)); BSUM[(size_t)t * NH + h] = bs; }
            }
        }
        SEAM(pb + 2);

        if (IN(pb + 3)) { PHASE_IDS
            const bf16* Vl = l == 0 ? V0 : V1;
            constexpr int SB = 32, STP = 340, BUFB = SB * STP * 4;
            constexpr int YB_OFF = 2 * BUFB, YB_BYTES = SB * 16 * 4;
            const int nscan = (G >= 256) ? 128 : 0;
            for (int it = bx; it < 128; it += G) {
                const int b = it >> 5, h = (it >> 2) & 7, qr = it & 3;
                const size_t tb = (size_t)b * SEQ;
                __syncthreads();
                if (wave >= 4) {
                    const int lt = tid - 256, tok = lt >> 3, part = lt & 7;
                    const size_t gofs = (tb + tok) * RW + h * HS + part * 8;
                    const bf16* vsrc = Vl + (tb + tok) * RW + h * HS + qr * 16 + (part & 1) * 8;
                    u32x4 qr_, qk_, qkk_, qb_, qv_; f32x4 qw0, qw1; float qin_;
#define LD_ISSUE(blk) do { const size_t go = (size_t)(blk) * SB * RW; qin_ = INVN[(tb + tok + (size_t)(blk) * SB) * NH + h]; qr_ = *(const u32x4*)(Rb + gofs + go); qk_ = *(const u32x4*)(Kb + gofs + go); qkk_ = *(const u32x4*)(KKb + gofs + go); qb_ = *(const u32x4*)(Bb + gofs + go); \
                               qw0 = *(const f32x4*)(Wd + gofs + go); qw1 = *(const f32x4*)(Wd + gofs + go + 4); if (part < 2) qv_ = *(const u32x4*)(vsrc + go); } while (0)
#define UNPK8(dst, q) do { (dst)[0] = __uint_as_float((q).x << 16); (dst)[1] = __uint_as_float((q).x & 0xffff0000u); (dst)[2] = __uint_as_float((q).y << 16); (dst)[3] = __uint_as_float((q).y & 0xffff0000u); \
                           (dst)[4] = __uint_as_float((q).z << 16); (dst)[5] = __uint_as_float((q).z & 0xffff0000u); (dst)[6] = __uint_as_float((q).w << 16); (dst)[7] = __uint_as_float((q).w & 0xffff0000u); } while (0)
#define LD_WRITE(bufi) do { LAS float* rec = (LAS float*)(lds + (bufi) * BUFB) + tok * STP; float r8[8], k8[8], kk8[8], b8[8]; UNPK8(r8, qr_); UNPK8(k8, qk_); UNPK8(kk8, qkk_); UNPK8(b8, qb_); \
                        _Pragma("unroll") for (int i = 0; i < 8; ++i) { kk8[i] *= qin_; b8[i] *= qin_; } \
                        const float w8[8] = {qw0.x, qw0.y, qw0.z, qw0.w, qw1.x, qw1.y, qw1.z, qw1.w}; float kr = 0.f, br = 0.f; \
                        _Pragma("unroll") for (int i = 0; i < 8; ++i) { kr += k8[i] * r8[i]; br += b8[i] * r8[i]; } \
                        kr += dppf<0xB1>(kr); br += dppf<0xB1>(br); kr += dppf<0x4E>(kr); br += dppf<0x4E>(br); kr += dppf<0x141>(kr); br += dppf<0x141>(br); \
                        *(LAS f32x4*)(rec + part * 8) = (f32x4){w8[0] * r8[0], w8[1] * r8[1], w8[2] * r8[2], w8[3] * r8[3]}; *(LAS f32x4*)(rec + part * 8 + 4) = (f32x4){w8[4] * r8[4], w8[5] * r8[5], w8[6] * r8[6], w8[7] * r8[7]}; \
                        *(LAS f32x4*)(rec + 64 + part * 8) = qw0; *(LAS f32x4*)(rec + 64 + part * 8 + 4) = qw1; \
                        *(LAS f32x4*)(rec + 128 + part * 8) = (f32x4){k8[0], k8[1], k8[2], k8[3]}; *(LAS f32x4*)(rec + 128 + part * 8 + 4) = (f32x4){k8[4], k8[5], k8[6], k8[7]}; \
                        *(LAS f32x4*)(rec + 192 + part * 8) = (f32x4){-kk8[0], -kk8[1], -kk8[2], -kk8[3]}; *(LAS f32x4*)(rec + 192 + part * 8 + 4) = (f32x4){-kk8[4], -kk8[5], -kk8[6], -kk8[7]}; \
                        *(LAS f32x4*)(rec + 256 + part * 8) = (f32x4){b8[0], b8[1], b8[2], b8[3]}; *(LAS f32x4*)(rec + 256 + part * 8 + 4) = (f32x4){b8[4], b8[5], b8[6], b8[7]}; \
                        if (part < 2) { float v8[8]; UNPK8(v8, qv_); *(LAS f32x4*)(rec + 320 + part * 8) = (f32x4){v8[0], v8[1], v8[2], v8[3]}; *(LAS f32x4*)(rec + 320 + part * 8 + 4) = (f32x4){v8[4], v8[5], v8[6], v8[7]}; } \
                        if (part == 0) { rec[336] = kr; rec[337] = br; } } while (0)
                    LD_ISSUE(0); LD_WRITE(0); LD_ISSUE(1);
                    __syncthreads();
                    for (int blk = 0; blk < SEQ / SB; ++blk) {
                        if (blk + 1 < SEQ / SB) { LD_WRITE((blk + 1) & 1); if (blk + 2 < SEQ / SB) LD_ISSUE(blk + 2); }
                        if (blk > 0 && lt < 128) {
                            const LAS float* yb = (const LAS float*)(lds + YB_OFF + ((blk - 1) & 1) * YB_BYTES);
                            const int ys = lt >> 2, yc = lt & 3; const f32x4 yv = *(const LAS f32x4*)(yb + ys * 16 + yc * 4);
                            *(f32x4*)(Y + (tb + (size_t)(blk - 1) * SB + ys) * RW + h * HS + qr * 16 + yc * 4) = yv; }
                        __syncthreads();
                    }
                    if (lt < 128) { const LAS float* yb = (const LAS float*)(lds + YB_OFF + ((SEQ / SB - 1) & 1) * YB_BYTES);
                        const int ys = lt >> 2, yc = lt & 3; const f32x4 yv = *(const LAS f32x4*)(yb + ys * 16 + yc * 4);
                        *(f32x4*)(Y + (tb + (size_t)(SEQ / SB - 1) * SB + ys) * RW + h * HS + qr * 16 + yc * 4) = yv; }
#undef LD_ISSUE
#undef UNPK8
#undef LD_WRITE
                } else {
                    const int rowl = wave * 4 + (lane >> 4), kq = lane & 15;
                    f32x4 st = {0.f, 0.f, 0.f, 0.f};
                    __syncthreads();
                    for (int blk = 0; blk < SEQ / SB; ++blk) {
                        const LAS float* bb = (const LAS float*)(lds + (blk & 1) * BUFB);
                        LAS float* yb = (LAS float*)(lds + YB_OFF + (blk & 1) * YB_BYTES);
                        struct Ops { f32x4 wr4, w4, k4, nk4, b4; float v, kr, br; };
#define LOAD_OPS(o, sidx) do { const LAS float* p_ = bb + (sidx) * STP; (o).wr4 = *(const LAS f32x4*)(p_ + 4 * kq); (o).w4 = *(const LAS f32x4*)(p_ + 64 + 4 * kq); (o).k4 = *(const LAS f32x4*)(p_ + 128 + 4 * kq); \
                               (o).nk4 = *(const LAS f32x4*)(p_ + 192 + 4 * kq); (o).b4 = *(const LAS f32x4*)(p_ + 256 + 4 * kq); (o).v = p_[320 + rowl]; (o).kr = p_[336]; (o).br = p_[337]; } while (0)
                        Ops ops[3];
                        LOAD_OPS(ops[0], 0); LOAD_OPS(ops[1], 1);
                        float ykeep = 0.f;
#pragma unroll
                        for (int j = 0; j < SB; ++j) {
                            if (j + 2 < SB) LOAD_OPS(ops[(j + 2) % 3], j + 2);
                            __builtin_amdgcn_sched_barrier(0);
                            const Ops& o = ops[j % 3];
                            float d1 = (st.x * o.nk4.x + st.y * o.nk4.y) + (st.z * o.nk4.z + st.w * o.nk4.w);
                            float d2 = (st.x * o.wr4.x + st.y * o.wr4.y) + (st.z * o.wr4.z + st.w * o.wr4.w);
                            d1 += dppf<0xB1>(d1); d2 += dppf<0xB1>(d2); d1 += dppf<0x4E>(d1); d2 += dppf<0x4E>(d2);
                            d1 += dppf<0x141>(d1); d2 += dppf<0x141>(d2); d1 += dppf<0x140>(d1); d2 += dppf<0x140>(d2);
                            st = st * o.w4 + o.v * o.k4 + d1 * o.b4;
                            const float y = d2 + o.v * o.kr + d1 * o.br;
                            ykeep = (kq == (j & 15)) ? y : ykeep;
                            if ((j & 15) == 15) yb[((j >> 4) * 16 + kq) * 16 + rowl] = ykeep;
                        }
#undef LOAD_OPS
                        __syncthreads();
                    }
                }
            }
            if (bx >= nscan) {
                LAS float* dl = (LAS float*)lds;
                const float* pool_w = INP(21) + (size_t)l * 4 * PG * PG; const float ps = INP(22)[l * PW + tid];
                const int c = tid, g = c >> 7, dd = c & 127, win = 2 << g;
                for (int tile = bx - nscan; tile < T / 16; tile += G - nscan) {
                    const int t0 = tile * 16; const bool first = (t0 % SEQ) == 0;
                    __syncthreads();
                    float p[31];
#pragma unroll
                    for (int j = 0; j < 31; ++j) p[j] = (j >= 15 || !first) ? bf2f(PROJ[(size_t)(t0 - 15 + j) * LDP + RWKV_COLS + c]) : 0.f;
                    float sw = 0.f;
                    for (int j = 1; j <= 16; ++j) sw += (j < win) ? p[15 - j] : 0.f;
                    const float invw = 1.f / (float)win;
#pragma unroll
                    for (int i = 0; i < 16; ++i) {
                        sw += p[15 + i];
                        const float inv = first ? 1.f / (float)min(i + 1, win) : invw;
                        dl[i * 512 + c] = sw * inv - p[15 + i];
                        float drop = 0.f;
#pragma unroll
                        for (int q = 0; q < 4; ++q) { const int w_ = 2 << q; if (g == q) drop = p[15 + i - w_ + 1]; }
                        sw -= drop;
                    }
                    __syncthreads();
                    float acc[16];
#pragma unroll
                    for (int i = 0; i < 16; ++i) acc[i] = 0.f;
#pragma unroll 2
                    for (int cc = 0; cc < PG; cc += 4) {
                        const float* wp = pool_w + ((size_t)g * PG + cc) * PG + dd; const float w0 = wp[0], w1 = wp[PG], w2 = wp[2 * PG], w3 = wp[3 * PG];
#pragma unroll
                        for (int i = 0; i < 16; ++i) { const f32x4 d4 = *(const LAS f32x4*)(dl + i * 512 + g * PG + cc); acc[i] += (d4.x * w0 + d4.y * w1) + (d4.z * w2 + d4.w * w3); } }
#pragma unroll
                    for (int i = 0; i < 16; ++i) MIX[(size_t)(t0 + i) * D + RW + c] = f2bf(acc[i] * ps);
                }
            }
        }
        SEAM(pb + 3);

        if (IN(pb + 4)) { PHASE_IDS
            const int c = tid; const float lg = INP(19)[l * RW + c], lb = INP(20)[l * RW + c];
            for (int tile = bx; tile < T / 8; tile += G) {
                float y[8], g[8], bg[8];
#pragma unroll
                for (int i = 0; i < 8; ++i) { const size_t o = (size_t)(tile * 8 + i) * RW + c; y[i] = Y[o]; g[i] = bf2f(Gb[o]); bg[i] = bf2f(BGb[o]) * BSUM[(size_t)(tile * 8 + i) * NH + wave]; }
#pragma unroll
                for (int i = 0; i < 8; ++i) { const float mean = wave_sum(y[i], lane) * (1.f / 64.f); const float d = y[i] - mean; const float var = wave_sum(d * d, lane) * (1.f / 64.f);
                    const float yn = d * rsqrtf(var + GN_EPS) * lg + lb; MIX[(size_t)(tile * 8 + i) * D + c] = f2bf(yn * g[i] + bg[i]); }
            }
        }
        SEAM(pb + 4);
        if (IN(pb + 5)) { PHASE_IDS
            pg8::Gemm g{MIX, WoutT + (size_t)l * D * D, T, D, D}; pg8::StaticOrder S; S.init(T, D, G, bx);
            pg8::EpiResGate E{xin, X, modl + 2 * D};
            pg8::gemm_phase<pg8::EpiResGate, pg8::StaticOrder, true, true>(lds, g, S, E, tid); }
        SEAM(pb + 5);
        if (IN(pb + 6)) { PHASE_IDS const float* gamma = INP(24) + l * D;
            for (int row = gw; row < T; row += NGW) { const int b = row / SEQ; norm_mod_row(X + (size_t)row * D, gamma, modl + (size_t)b * 6 * D + 3 * D, modl + (size_t)b * 6 * D + 4 * D, H + (size_t)row * D, lane); } }
        SEAM(pb + 6);
        if (IN(pb + 7)) { PHASE_IDS
            pg8::Gemm g{H, PqT + (size_t)l * PH * PQ * D, T, PH * PQ, D}; pg8::StaticOrder S; S.init(T, PH * PQ, G, bx);
            pg8::EpiBf16<0> E{Q, PH * PQ, nullptr, 0, 0, 1.f};
            pg8::gemm_phase<pg8::EpiBf16<0>, pg8::StaticOrder, true, true>(lds, g, S, E, tid); }
        SEAM(pb + 7);

        if (IN(pb + 8)) { PHASE_IDS
            const bf16* KEYSl = KEYS + (size_t)l * PH * 2 * NKEYS * PHALF;
            LAS unsigned char* scr = lds + wave * 2048 + lane * 32;
            const int r = lane & 31, hh = lane >> 5;
            for (int it = gw; it < (T / 32) * PH; it += NGW) {
                const int tok = (it >> 3) * 32 + r, h = it & 7;
                unsigned sp0[16], sp1[16];
#pragma unroll
                for (int e = 0; e < 16; ++e) { sp0[e] = 0u; sp1[e] = 0u; }
#pragma unroll 1
                for (int p = 0; p < 2; ++p) {
                    const bf16* qp = Q + (size_t)tok * (PH * PQ) + h * PQ + p * PHALF + 8 * hh;
                    const bf16* kp_ = KEYSl + ((size_t)(h * 2 + p) * NKEYS + r) * PHALF + 8 * hh;
                    bf16x8_t bq[8];
#pragma unroll
                    for (int ks = 0; ks < 8; ++ks) bq[ks] = *(const bf16x8_t*)(qp + ks * 16);
                    unsigned best[16];
#pragma unroll
                    for (int e = 0; e < 16; ++e) best[e] = 0u;
#pragma unroll 1
                    for (int kt = 0; kt < 4; ++kt) {
                        f32x16 acc;
#pragma unroll
                        for (int e = 0; e < 16; ++e) acc[e] = 0.f;
#pragma unroll
                        for (int ks = 0; ks < 8; ++ks) { const bf16x8_t ak = *(const bf16x8_t*)(kp_ + (size_t)kt * 32 * PHALF + ks * 16); acc = __builtin_amdgcn_mfma_f32_32x32x16_bf16(ak, bq[ks], acc, 0, 0, 0); }
                        unsigned g[16];
#pragma unroll
                        for (int e = 0; e < 16; ++e) g[e] = pack_key7(acc[e], kt * 32 + (e & 3) + 8 * (e >> 2) + 4 * hh);
                        sort16_desc(g);
                        merge_top16(best, g);
                    }
                    unsigned ob[16];
#pragma unroll
                    for (int e = 0; e < 16; ++e) ob[e] = shflxu(best[e], lane, 32);
                    merge_top16(best, ob);
#pragma unroll
                    for (int e = 0; e < 16; ++e) { sp0[e] = p == 0 ? best[e] : sp0[e]; sp1[e] = p == 0 ? sp1[e] : best[e]; }
                }
                unsigned c2[32];
                stage2_cands(sp0, sp1, hh, c2);
                sort16_desc(c2); sort16_desc(c2 + 16); merge_top16(c2, c2 + 16);
                { unsigned ob[16];
#pragma unroll
                  for (int e = 0; e < 16; ++e) ob[e] = shflxu(c2[e], lane, 32);
                  merge_top16(c2, ob); }
#pragma unroll
                for (int e = 0; e < 16; e += 4) {
                    *(LAS unsigned*)(scr + e) = (127u - (sp0[e] & 127u)) | ((127u - (sp0[e + 1] & 127u)) << 8) | ((127u - (sp0[e + 2] & 127u)) << 16) | ((127u - (sp0[e + 3] & 127u)) << 24);
                    *(LAS unsigned*)(scr + 16 + e) = (127u - (sp1[e] & 127u)) | ((127u - (sp1[e + 1] & 127u)) << 8) | ((127u - (sp1[e + 2] & 127u)) << 16) | ((127u - (sp1[e + 3] & 127u)) << 24); }
                asm volatile("s_waitcnt lgkmcnt(0)" ::: "memory");
                float sm[16]; int ex[16];
#pragma unroll
                for (int e = 0; e < 16; ++e) { const unsigned key = c2[e]; sm[e] = unpack_key8(key); const int i0 = (key >> 4) & 15, j0 = key & 15; ex[e] = (int)scr[i0] * NKEYS + (int)scr[16 + j0]; }
                float den = 0.f;
#pragma unroll
                for (int e = 0; e < 16; ++e) { sm[e] = expf(sm[e] - unpack_key8(c2[0])); den += sm[e]; }
                const float inv = 1.f / den;
                if (hh == 0) {
                    int* ip = IDX + (size_t)tok * NE + h * TOPK; float* gp = GATE + (size_t)tok * NE + h * TOPK;
#pragma unroll
                    for (int e = 0; e < 16; e += 4) { *(int4*)(ip + e) = make_int4(ex[e], ex[e + 1], ex[e + 2], ex[e + 3]); *(f32x4*)(gp + e) = (f32x4){sm[e] * inv, sm[e + 1] * inv, sm[e + 2] * inv, sm[e + 3] * inv}; }
                }
                asm volatile("s_waitcnt lgkmcnt(0)" ::: "memory");
            }
        }
        SEAM(pb + 8);

        if (IN(pb + 9)) { PHASE_IDS
            const unsigned char* Ul = U8 + (size_t)l * NEXP * D; const unsigned char* Vtl = V8 + (size_t)l * NEXP * D; const float* usl = USc + l * NEXP; const float* vsl = VSc + l * NEXP; const float* lnf = INP(29);
            const bool fin = (l == DEPTH - 1);
            typedef float f32x2_t __attribute__((ext_vector_type(2)));
            const __amdgpu_buffer_rsrc_t ru = __builtin_amdgcn_make_buffer_rsrc((void*)Ul, 0, NEXP * D, 0x00020000), rv = __builtin_amdgcn_make_buffer_rsrc((void*)Vtl, 0, NEXP * D, 0x00020000);
            const int voff = lane * 16;
            LAS float* pl = (LAS float*)(lds + wave * 8704);
            for (int t = gw; t < T; t += NGW) {
                const int b = t / SEQ;
                f32x2_t hf2[8];
                { const u32x4 h0 = *(const u32x4*)(H + (size_t)t * D + lane * 16), h1 = *(const u32x4*)(H + (size_t)t * D + lane * 16 + 8);
                  hf2[0] = (f32x2_t){__uint_as_float(h0.x << 16), __uint_as_float(h0.x & 0xffff0000u)}; hf2[1] = (f32x2_t){__uint_as_float(h0.y << 16), __uint_as_float(h0.y & 0xffff0000u)};
                  hf2[2] = (f32x2_t){__uint_as_float(h0.z << 16), __uint_as_float(h0.z & 0xffff0000u)}; hf2[3] = (f32x2_t){__uint_as_float(h0.w << 16), __uint_as_float(h0.w & 0xffff0000u)};
                  hf2[4] = (f32x2_t){__uint_as_float(h1.x << 16), __uint_as_float(h1.x & 0xffff0000u)}; hf2[5] = (f32x2_t){__uint_as_float(h1.y << 16), __uint_as_float(h1.y & 0xffff0000u)};
                  hf2[6] = (f32x2_t){__uint_as_float(h1.z << 16), __uint_as_float(h1.z & 0xffff0000u)}; hf2[7] = (f32x2_t){__uint_as_float(h1.w << 16), __uint_as_float(h1.w & 0xffff0000u)}; }
                f32x2_t acc2[8];
#pragma unroll
                for (int i = 0; i < 8; ++i) acc2[i] = (f32x2_t){0.f, 0.f};
                int myidx = IDX[(size_t)t * NE + (lane & 31)]; float mygate = GATE[(size_t)t * NE + (lane & 31)];
                float myus = usl[myidx], myvs = vsl[myidx];
#define ROWLD(dst, rs, ix, e) dst = __builtin_amdgcn_raw_buffer_load_b128(rs, voff, __builtin_amdgcn_readlane(ix, (e)) * D, 0)
#define LOADB(buf, rs, ix, e0) do { _Pragma("unroll") for (int j_ = 0; j_ < 4; ++j_) ROWLD((buf)[j_], rs, ix, (e0) + j_); __builtin_amdgcn_sched_barrier(0); } while (0)
#define CVT8(u) const f32x2_t u0 = __builtin_amdgcn_cvt_pk_f32_fp8((int)(u).x, false), u1 = __builtin_amdgcn_cvt_pk_f32_fp8((int)(u).x, true), u2 = __builtin_amdgcn_cvt_pk_f32_fp8((int)(u).y, false), u3 = __builtin_amdgcn_cvt_pk_f32_fp8((int)(u).y, true), \
                        u4 = __builtin_amdgcn_cvt_pk_f32_fp8((int)(u).z, false), u5 = __builtin_amdgcn_cvt_pk_f32_fp8((int)(u).z, true), u6 = __builtin_amdgcn_cvt_pk_f32_fp8((int)(u).w, false), u7 = __builtin_amdgcn_cvt_pk_f32_fp8((int)(u).w, true)
#define DOT1(u, dst) do { CVT8(u); f32x2_t a_ = hf2[0] * u0; a_ += hf2[1] * u1; a_ += hf2[2] * u2; a_ += hf2[3] * u3; a_ += hf2[4] * u4; a_ += hf2[5] * u5; a_ += hf2[6] * u6; a_ += hf2[7] * u7; dst = a_.x + a_.y; } while (0)
#define DOTB(buf, e0) do { _Pragma("unroll") for (int j_ = 0; j_ < 4; ++j_) { float d_; DOT1((buf)[j_], d_); pl[((e0) + j_) * 68 + lane] = d_; } } while (0)
#define AXPYB(buf, e0) do { _Pragma("unroll") for (int j_ = 0; j_ < 4; ++j_) { CVT8((buf)[j_]); const float cf = __int_as_float(__builtin_amdgcn_readlane(__float_as_int(coef), (e0) + j_)); \
                        acc2[0] += cf * u0; acc2[1] += cf * u1; acc2[2] += cf * u2; acc2[3] += cf * u3; acc2[4] += cf * u4; acc2[5] += cf * u5; acc2[6] += cf * u6; acc2[7] += cf * u7; } } while (0)
                u32x4 ba[4], bb_[4];
                LOADB(ba, ru, myidx, 0);
#pragma unroll 1
                for (int q = 0; q < 4; ++q) {
                    int nidx = 0; float ngate = 0.f;
                    if (q < 3) { nidx = IDX[(size_t)t * NE + (q + 1) * 32 + (lane & 31)]; ngate = GATE[(size_t)t * NE + (q + 1) * 32 + (lane & 31)]; }
#pragma unroll
                    for (int e0 = 0; e0 < 32; e0 += 8) {
                        LOADB(bb_, ru, myidx, e0 + 4); DOTB(ba, e0);
                        if (e0 + 8 < 32) LOADB(ba, ru, myidx, e0 + 8); else LOADB(ba, rv, myidx, 0);
                        DOTB(bb_, e0 + 4);
                    }
                    const float nus = usl[nidx], nvs = vsl[nidx];
                    __builtin_amdgcn_wave_barrier(); asm volatile("s_waitcnt lgkmcnt(0)" ::: "memory");
                    float dsum;
                    { const LAS float* rp = pl + (lane & 31) * 68 + (lane >> 5) * 32; f32x4 s4 = *(const LAS f32x4*)rp;
#pragma unroll
                      for (int j = 1; j < 8; ++j) s4 += *(const LAS f32x4*)(rp + j * 4);
                      dsum = (s4.x + s4.y) + (s4.z + s4.w); }
                    dsum += shflx(dsum, lane, 32);
                    __builtin_amdgcn_wave_barrier(); asm volatile("s_waitcnt lgkmcnt(0)" ::: "memory");
                    const float coef = mygate * gelu_erf(dsum * myus) * myvs;
#pragma unroll
                    for (int e0 = 0; e0 < 32; e0 += 8) {
                        LOADB(bb_, rv, myidx, e0 + 4); AXPYB(ba, e0);
                        if (e0 + 8 < 32) LOADB(ba, rv, myidx, e0 + 8); else if (q < 3) LOADB(ba, ru, nidx, 0);
                        AXPYB(bb_, e0 + 4);
                    }
                    myidx = nidx; mygate = ngate; myus = nus; myvs = nvs;
                }
#undef ROWLD
#undef LOADB
#undef CVT8
#undef DOTB
#undef DOT1
#undef AXPYB
                float* xr = X + (size_t)t * D + lane * 16; const float* g2 = modl + (size_t)b * 6 * D + 5 * D + lane * 16;
                f32x4 xv[4]; float ss = 0.f;
#pragma unroll
                for (int q = 0; q < 4; ++q) { const f32x4 xo = *(const f32x4*)(xr + q * 4), gg = *(const f32x4*)(g2 + q * 4);
                    xv[q] = xo + gg * (f32x4){acc2[q * 2].x, acc2[q * 2].y, acc2[q * 2 + 1].x, acc2[q * 2 + 1].y}; ss += (xv[q].x * xv[q].x + xv[q].y * xv[q].y) + (xv[q].z * xv[q].z + xv[q].w * xv[q].w); }
                if (fin) { const float rs = rsqrtf(wave_sum(ss, lane) * (1.f / D) + NORM_EPS);
#pragma unroll
                    for (int q = 0; q < 4; ++q) xv[q] = xv[q] * rs * *(const f32x4*)(lnf + lane * 16 + q * 4); }
#pragma unroll
                for (int q = 0; q < 4; ++q) *(f32x4*)(xr + q * 4) = xv[q];
            }
        }
    }
#undef modl
#undef xin
#undef IN
#undef SEAM
}
#undef MOD
#undef H
#undef PROJ
#undef Q
#undef MIX
#undef Rb
#undef Kb
#undef V0
#undef V1
#undef KKb
#undef Bb
#undef Gb
#undef BGb
#undef Wd
#undef Y
#undef IDX
#undef GATE
#undef WinT
#undef WoutT
#undef PqT
#undef KEYS
#undef QB
#undef SH
#undef WUPT
#undef AUPT
#undef GUPT
#undef VUPT
#undef INVN
#undef BSUM
#undef U8
#undef V8
#undef USc
#undef VSc
#undef INP
#undef PHASE_IDS

extern "C" void kernel_launch(void* const* d_in, const int* in_sizes, int n_in, void* d_out, int out_size, void* d_ws, size_t ws_size, hipStream_t stream) {
    if (n_in != 30 || ws_size < WS_END) { fprintf(stderr, "kernel_launch: unexpected n_in %d / ws_size %zu\n", n_in, ws_size); return; }
    static int grid = 0;
    if (grid == 0) {
        int dev = 0, cus = 0, per_cu = 0;
        (void)hipGetDevice(&dev); (void)hipDeviceGetAttribute(&cus, hipDeviceAttributeMultiprocessorCount, dev);
        if (hipFuncSetAttribute((const void*)mega, hipFuncAttributeMaxDynamicSharedMemorySize, LDS_BYTES) != hipSuccess) { fprintf(stderr, "hipFuncSetAttribute failed\n"); grid = -1; return; }
        if (hipOccupancyMaxActiveBlocksPerMultiprocessor(&per_cu, (const void*)mega, NTHR, LDS_BYTES) != hipSuccess || per_cu < 1) { fprintf(stderr, "occupancy query failed (%d)\n", per_cu); per_cu = 1; }
        (void)hipGetLastError();
        grid = (cus > 0 ? cus : 256) * 1;
    }
    if (grid < 0) return;
    Args a{}; for (int i = 0; i < 30; ++i) a.in[i] = (const float*)d_in[i]; a.out = (float*)d_out; a.ws = (unsigned char*)d_ws;
    a.ph_lo = 0; a.ph_hi = NPH;
    if (hipMemsetAsync(d_ws, 0, 65536, stream) != hipSuccess) { fprintf(stderr, "memset failed\n"); return; }
    void* kargs[] = {&a};
    hipError_t e = hipLaunchCooperativeKernel((const void*)mega, dim3(grid), dim3(NTHR), kargs, LDS_BYTES, stream);
    if (e != hipSuccess) fprintf(stderr, "cooperative launch failed: %s (grid %d)\n", hipGetErrorString(e), grid);
}
```

```cpp
#include <hip/hip_runtime.h>
#include <hip/hip_cooperative_groups.h>
namespace cg = cooperative_groups;
#include <cstdio>
#include <cstdint>
#include <cmath>

constexpr int D = 1024, BATCH = 4, SEQ = 4096, T = BATCH * SEQ, DEPTH = 2;
constexpr int RW = 512, HS = 64, NH = 8;
constexpr int DL = 64, AL = 64, MVL = 32, GL = 128;
constexpr int RWKV_COLS = 3 * RW + DL + AL + GL;
constexpr int PW = 512, PG = 128;
constexpr int IN_COLS = RWKV_COLS + PW;
constexpr int LDP = 2560;
constexpr int NKEYS = 128, NEXP = NKEYS * NKEYS, PH = 8, PQ = 256, PHALF = 128, TOPK = 16;
constexpr int NE = PH * TOPK;
constexpr float NORM_EPS = 1e-6f, GN_EPS = 64e-5f;

typedef unsigned short bf16;
__device__ __forceinline__ float bf2f(bf16 u) { return __uint_as_float((unsigned)u << 16); }
__device__ __forceinline__ bf16 f2bf(float f) { unsigned u = __float_as_uint(f); return (bf16)((u + 0x7fffu + ((u >> 16) & 1u)) >> 16); }

constexpr size_t MiB = 1u << 20;
constexpr size_t WS_MOD = 1 * MiB;
constexpr size_t WS_US = 1 * MiB + 256 * 1024;
constexpr size_t WS_VS = 1 * MiB + 512 * 1024;
constexpr size_t WS_H = 2 * MiB;
constexpr size_t WS_PROJ = 34 * MiB;
constexpr size_t WS_Q = WS_PROJ;
constexpr size_t WS_R = 114 * MiB;
constexpr size_t WS_K = 130 * MiB;
constexpr size_t WS_V0 = 146 * MiB;
constexpr size_t WS_V1 = 162 * MiB;
constexpr size_t WS_KK = 178 * MiB;
constexpr size_t WS_B = 194 * MiB;
constexpr size_t WS_G = 210 * MiB;
constexpr size_t WS_BG = 226 * MiB;
constexpr size_t WS_W = 242 * MiB;
constexpr size_t WS_Y = 274 * MiB;
constexpr size_t WS_MIX = 306 * MiB;
constexpr size_t WS_IDX = 338 * MiB;
constexpr size_t WS_GATE = 346 * MiB;
constexpr size_t WS_WIN_T = 354 * MiB;
constexpr size_t WS_WOUT_T = 364 * MiB;
constexpr size_t WS_PQ_T = 368 * MiB;
constexpr size_t WS_KEYS = 376 * MiB;
constexpr size_t WS_U = 378 * MiB;
constexpr size_t WS_V = 442 * MiB;
constexpr size_t WS_QB = 410 * MiB;
constexpr size_t WS_SH = 426 * MiB;
constexpr size_t WS_LORA = 428 * MiB;
constexpr size_t WS_INVN = 430 * MiB;
constexpr size_t WS_BSUM = 431 * MiB;
constexpr size_t WS_END = 506 * MiB;

template <int CTRL> __device__ __forceinline__ float dppf(float x) { return __int_as_float(__builtin_amdgcn_update_dpp(0, __float_as_int(x), CTRL, 0xF, 0xF, false)); }
__device__ __forceinline__ float red16(float x) { x += dppf<0xB1>(x); x += dppf<0x4E>(x); x += dppf<0x141>(x); x += dppf<0x140>(x); return x; }
__device__ __forceinline__ float shflx(float v, int lane, int off) { return __int_as_float(__builtin_amdgcn_ds_bpermute((lane ^ off) << 2, __float_as_int(v))); }
__device__ __forceinline__ unsigned shflxu(unsigned v, int lane, int off) { return (unsigned)__builtin_amdgcn_ds_bpermute((lane ^ off) << 2, (int)v); }
__device__ __forceinline__ float wave_sum(float v, int lane) { v = red16(v); v += shflx(v, lane, 16); v += shflx(v, lane, 32); return v; }
__device__ __forceinline__ float sigmoidf_(float x) { return 1.f / (1.f + expf(-x)); }

namespace pg8 {
#define PG8_LAS __attribute__((address_space(3)))
typedef unsigned short bf16_t;
typedef short bf16x8 __attribute__((ext_vector_type(8)));
typedef float f32x4 __attribute__((ext_vector_type(4)));
typedef unsigned u32x4 __attribute__((ext_vector_type(4)));
constexpr int BM = 256, BK = 64, HALF = 128, HTB = HALF * BK * 2  , STAGE_BYTES = 8 * HTB, NXCD = 8, WGM = 8;

__host__ __device__ __forceinline__ int lds_byte(int r, int c) { const int st = (r >> 4) * 2 + (c >> 5), rr = r & 15, cc = c & 31, ob = rr * 64 + cc * 2; return st * 1024 + (ob ^ (((ob >> 9) & 1) << 5)); }
__host__ __device__ __forceinline__ void stage_rc(int b, int& R, int& C) { const int st = b / 1024, sb = b % 1024, swz = sb ^ (((sb >> 9) & 1) << 5); R = (st >> 1) * 16 + swz / 64; C = (st & 1) * 32 + (swz % 64) / 2; }
__host__ __device__ __forceinline__ int perm32(int rho) { const int n = rho >> 4, i = rho & 15; return 8 * (i >> 2) + 4 * n + (i & 3); }

struct Unit { int pm, pn; };
struct Gemm { const bf16_t* A; const bf16_t* Bt; int M, N, K; };

struct StaticOrder {
    int nM, nN, nwg, G, c;
    __host__ __device__ void init(int M, int N, int G_, int c_) { nM = M / BM; nN = N / BM; nwg = nM * nN; G = G_; c = c_; }
    __host__ __device__ bool next(int i, Unit& u) const {
        const long L = (long)i * G + c; if (L >= nwg) return false;
        int wgid = (int)L; { const int q = nwg / NXCD, r = nwg % NXCD, xcd = wgid % NXCD, off = wgid / NXCD; wgid = (xcd < r ? xcd * (q + 1) : r * (q + 1) + (xcd - r) * q) + off; }
        const int nig = WGM * nN, gid = wgid / nig, fm = gid * WGM, gsz = (nM - fm) < WGM ? (nM - fm) : WGM;
        u.pm = fm + ((wgid % nig) % gsz); u.pn = (wgid % nig) / gsz; return true;
    }
    __device__ __forceinline__ void a_ready(const Unit&) const {}
    __device__ __forceinline__ void done(const Unit&) const {}
};

__device__ __forceinline__ unsigned cvt_pk_bf16(float lo, float hi) { unsigned r; asm volatile("v_cvt_pk_bf16_f32 %0, %1, %2" : "=v"(r) : "v"(lo), "v"(hi)); return r; }
typedef float f32x2 __attribute__((ext_vector_type(2)));
__device__ __forceinline__ f32x2 gelu_pk(f32x2 v) {
    const f32x2 av = __builtin_elementwise_abs(v), d = av * 0.2316418882f + 1.0f;
    f32x2 t; t.x = __builtin_amdgcn_rcpf(d.x); t.y = __builtin_amdgcn_rcpf(d.y);
    f32x2 q = t * 0.5307027145f + (-0.7265760135f); q = q * t + 0.7107068705f; q = q * t + (-0.142248368f); q = q * t + 0.127414796f; q = q * t;
    const f32x2 s = (v * v) * (-0.72134752044f);
    f32x2 e; e.x = __builtin_amdgcn_exp2f(s.x); e.y = __builtin_amdgcn_exp2f(s.y);
    const f32x2 m = v * (q * e), r = v - m;
    f32x2 o; o.x = v.x < 0.f ? m.x : r.x; o.y = v.y < 0.f ? m.y : r.y; return o;
}

template <int ACT  > struct EpiBf16 {
    static constexpr bool PERM = true, AFTER_DRAIN = false; static_assert(ACT == 0 || ACT == 1, "EpiBf16: ACT is 0 (none) or 1 (gelu_pk)");
    bf16_t* O; int ldc; const float* bias; int split_cols; size_t split_stride; float scale0;
    __device__ __forceinline__ void operator()(const f32x4 (&acc)[2][2][4][2], const Unit& u, int wr, int wc, int fr, int fq) const {
        const int row0 = u.pm * BM + wr * 64 + fr; int colt = u.pn * BM; bf16_t* base = O;
        float sc = 1.f; if (split_cols) { const int t = colt / split_cols; base += (size_t)t * split_stride; colt -= t * split_cols; if (t == 0) sc = scale0; }
        const int col0 = colt + wc * 32 + 8 * fq, bcol0 = u.pn * BM + wc * 32 + 8 * fq;
        f32x4 bv[2][2];
#pragma unroll
        for (int bj = 0; bj < 2; ++bj)
#pragma unroll
            for (int n = 0; n < 2; ++n) bv[bj][n] = bias ? *(const f32x4*)(bias + bcol0 + bj * HALF + 4 * n) : (f32x4){0.f, 0.f, 0.f, 0.f};
#pragma unroll
        for (int ai = 0; ai < 2; ++ai)
#pragma unroll
            for (int m = 0; m < 4; ++m) { bf16_t* rowp = base + (size_t)(row0 + ai * HALF + m * 16) * ldc + col0;
#pragma unroll
                for (int bj = 0; bj < 2; ++bj) { f32x4 v0 = acc[ai][bj][m][0] + bv[bj][0], v1 = acc[ai][bj][m][1] + bv[bj][1];
                    if (ACT == 1) { f32x2 a = gelu_pk((f32x2){v0[0], v0[1]}), b = gelu_pk((f32x2){v0[2], v0[3]}), c = gelu_pk((f32x2){v1[0], v1[1]}), d = gelu_pk((f32x2){v1[2], v1[3]});
                        v0 = (f32x4){a.x, a.y, b.x, b.y}; v1 = (f32x4){c.x, c.y, d.x, d.y}; }
                    v0 = v0 * sc; v1 = v1 * sc; u32x4 w; w.x = cvt_pk_bf16(v0[0], v0[1]); w.y = cvt_pk_bf16(v0[2], v0[3]); w.z = cvt_pk_bf16(v1[0], v1[1]); w.w = cvt_pk_bf16(v1[2], v1[3]);
                    *(u32x4*)(rowp + bj * HALF) = w; } }
    }
};

struct EpiResGate {
    static constexpr bool PERM = false, AFTER_DRAIN = false;
    const float* xold; float* X; const float* gate;
    __device__ __forceinline__ void operator()(const f32x4 (&acc)[2][2][4][2], const Unit& u, int wr, int wc, int fr, int fq) const {
        const int col0 = u.pn * BM + wc * 32 + 4 * fq; const int b = (u.pm * BM) / SEQ;
        const float* gp = gate + (size_t)b * 6 * D + col0;
#pragma unroll
        for (int bj = 0; bj < 2; ++bj)
#pragma unroll
            for (int n = 0; n < 2; ++n) { const f32x4 gv = *(const f32x4*)(gp + bj * HALF + n * 16);
#pragma unroll
                for (int ai = 0; ai < 2; ++ai)
#pragma unroll
                    for (int m = 0; m < 4; ++m) { const size_t off = (size_t)(u.pm * BM + ai * HALF + wr * 64 + m * 16 + fr) * D + col0 + bj * HALF + n * 16;
                        const f32x4 xo = *(const f32x4*)(xold + off); *(f32x4*)(X + off) = xo + gv * acc[ai][bj][m][n]; } }
    }
};
template <class Epi, class Sched, bool ALIGN_EPI = false, bool SP2 = false>
__device__ __forceinline__ void gemm_phase(PG8_LAS unsigned char* lds, const Gemm g, const Sched& S, const Epi& E, int tid) {
    asm volatile("" : "+v"(tid));
    const int wid = __builtin_amdgcn_readfirstlane(tid >> 6), lane = tid & 63, wr = wid >> 2, wc = wid & 3, fr = lane & 15, fq = lane >> 4;
    const int K = g.K, nt = K / BK;
    unsigned voffA[2], voffB[2];
#pragma unroll
    for (int i = 0; i < 2; ++i) { int R, C; stage_rc(tid * 16 + i * 8192, R, C); const int Rb = Epi::PERM ? ((R & ~31) + perm32(R & 31)) : R;
        voffA[i] = (unsigned)(R * K + C) * 2u; voffB[i] = (unsigned)(Rb * K + C) * 2u; }
    const size_t kstep = (size_t)(BK * 2);
    const size_t hstep = (size_t)HALF * K * 2;
    const size_t tstep = 2 * hstep;
    const unsigned ldsw = (unsigned)wid * 1024u;
    const int aoff = lds_byte(wr * 64 + fr, fq * 8), boff = lds_byte(wc * 32 + fr, fq * 8);
#define PG8_SA(b, h) (((b) * 2 + (h)) * HTB)
#define PG8_SB(b, h) ((4 + (b) * 2 + (h)) * HTB)
#define PG8_STAGE(bufoff, gbase, voff) do { _Pragma("unroll") for (int _i = 0; _i < 2; ++_i) \
        __builtin_amdgcn_global_load_lds((const unsigned*)((const char*)(gbase) + (voff)[_i]), (PG8_LAS unsigned*)(lds + (bufoff) + ldsw + _i * 8192), 16, 0, 0); } while (0)
#define PG8_LDA(dst, b, h) do { _Pragma("unroll") for (int m = 0; m < 4; ++m) _Pragma("unroll") for (int k = 0; k < 2; ++k) dst[m][k] = *(const PG8_LAS bf16x8*)(lds + PG8_SA(b, h) + aoff + m * 2048 + k * 1024); } while (0)
#define PG8_LDB(dst, b, h) do { _Pragma("unroll") for (int n = 0; n < 2; ++n) _Pragma("unroll") for (int k = 0; k < 2; ++k) dst[n][k] = *(const PG8_LAS bf16x8*)(lds + PG8_SB(b, h) + boff + n * 2048 + k * 1024); } while (0)
#define PG8_MMA(ai, bj, At, Bt) do { __builtin_amdgcn_s_setprio(1); _Pragma("unroll") for (int m = 0; m < 4; ++m) _Pragma("unroll") for (int n = 0; n < 2; ++n) _Pragma("unroll") for (int k = 0; k < 2; ++k) \
        acc[ai][bj][m][n] = __builtin_amdgcn_mfma_f32_16x16x32_bf16(Bt[n][k], At[m][k], acc[ai][bj][m][n], 0, 0, 0); __builtin_amdgcn_s_setprio(0); } while (0)
#define PG8_WAIT_V(n) asm volatile("s_waitcnt vmcnt(" #n ")" ::: "memory")
#define PG8_WAIT_L(n) asm volatile("s_waitcnt lgkmcnt(" #n ")" ::: "memory")
#define PG8_BAR __builtin_amdgcn_s_barrier()
#define PG8_SCHED __builtin_amdgcn_sched_barrier(0)
    Unit cur, nxt; int ui = 0;
    if (!S.next(0, cur)) return;
    f32x4 acc[2][2][4][2];
#pragma unroll
    for (int a = 0; a < 2; ++a)
#pragma unroll
        for (int b = 0; b < 2; ++b)
#pragma unroll
            for (int m = 0; m < 4; ++m)
#pragma unroll
                for (int n = 0; n < 2; ++n) acc[a][b][m][n] = (f32x4){0.f, 0.f, 0.f, 0.f};
    bf16x8 At[4][2], B0[2][2], B1[2][2];
    const char* cA = (const char*)g.A + (size_t)cur.pm * tstep; const char* cB = (const char*)g.Bt + (size_t)cur.pn * tstep;
    S.a_ready(cur);
    if constexpr (SP2) {
        PG8_STAGE(PG8_SB(0, 0), cB, voffB); PG8_STAGE(PG8_SB(0, 1), cB + hstep, voffB); PG8_STAGE(PG8_SA(0, 0), cA, voffA); PG8_STAGE(PG8_SA(0, 1), cA + hstep, voffA);
        if (wr == 1) PG8_BAR;
        PG8_WAIT_V(2); PG8_BAR;
        PG8_STAGE(PG8_SB(1, 0), cB + kstep, voffB); PG8_STAGE(PG8_SA(1, 0), cA + kstep, voffA); PG8_STAGE(PG8_SB(1, 1), cB + hstep + kstep, voffB);
        PG8_WAIT_V(6); PG8_BAR;
    } else {
        PG8_STAGE(PG8_SB(0, 0), cB, voffB); PG8_STAGE(PG8_SA(0, 0), cA, voffA); PG8_STAGE(PG8_SB(0, 1), cB + hstep, voffB); PG8_STAGE(PG8_SA(0, 1), cA + hstep, voffA);
        if (wr == 1) PG8_BAR;
        PG8_WAIT_V(4); PG8_BAR;
        PG8_STAGE(PG8_SB(1, 0), cB + kstep, voffB); PG8_STAGE(PG8_SA(1, 0), cA + kstep, voffA); PG8_STAGE(PG8_SB(1, 1), cB + hstep + kstep, voffB);
        PG8_WAIT_V(6); PG8_BAR;
    }
    for (;;) {
        const bool has_next = S.next(ui + 1, nxt);
        const char* nA = has_next ? (const char*)g.A + (size_t)nxt.pm * tstep : cA; const char* nB = has_next ? (const char*)g.Bt + (size_t)nxt.pn * tstep : cB;
        for (int t = 0; t < nt; t += 2) {
            const bool last = (t == nt - 2);
            const char* a1 = cA + (size_t)(t + 1) * kstep;
            const char* a2 = last ? nA : cA + (size_t)(t + 2) * kstep; const char* b2 = last ? nB : cB + (size_t)(t + 2) * kstep;
            const char* a3 = a2 + kstep; const char* b3 = b2 + kstep;
            if (last && has_next) S.a_ready(nxt);
            if constexpr (SP2) {
            PG8_LDB(B0, 0, 0); PG8_LDB(B1, 0, 1); PG8_SCHED; PG8_LDA(At, 0, 0); PG8_STAGE(PG8_SA(1, 1), a1 + hstep, voffA);
            PG8_WAIT_V(8); PG8_WAIT_L(0); PG8_BAR; PG8_MMA(0, 0, At, B0); PG8_MMA(0, 1, At, B1); PG8_BAR; PG8_SCHED;
            PG8_LDA(At, 0, 1); PG8_STAGE(PG8_SB(0, 0), b2, voffB); PG8_STAGE(PG8_SB(0, 1), b2 + hstep, voffB); PG8_STAGE(PG8_SA(0, 0), a2, voffA);
            PG8_WAIT_V(8); PG8_WAIT_L(0); PG8_BAR; PG8_MMA(1, 0, At, B0); PG8_MMA(1, 1, At, B1); PG8_BAR; PG8_SCHED;
            PG8_LDB(B0, 1, 0); PG8_LDB(B1, 1, 1); PG8_SCHED; PG8_LDA(At, 1, 0); PG8_STAGE(PG8_SA(0, 1), a2 + hstep, voffA);
            PG8_WAIT_V(8); PG8_WAIT_L(0); PG8_BAR; PG8_MMA(0, 0, At, B0); PG8_MMA(0, 1, At, B1); PG8_BAR; PG8_SCHED;
            PG8_LDA(At, 1, 1); PG8_STAGE(PG8_SB(1, 0), b3, voffB); PG8_STAGE(PG8_SB(1, 1), b3 + hstep, voffB); PG8_STAGE(PG8_SA(1, 0), a3, voffA);
            PG8_WAIT_V(8); PG8_WAIT_L(0); PG8_BAR; PG8_MMA(1, 0, At, B0); PG8_MMA(1, 1, At, B1); PG8_BAR; PG8_SCHED;
            } else {
            PG8_LDB(B0, 0, 0); PG8_SCHED; PG8_LDA(At, 0, 0); PG8_STAGE(PG8_SA(1, 1), a1 + hstep, voffA);
            PG8_WAIT_L(8); PG8_BAR; PG8_WAIT_L(0); PG8_MMA(0, 0, At, B0); PG8_BAR; PG8_SCHED;
            PG8_LDB(B1, 0, 1); PG8_STAGE(PG8_SB(0, 0), b2, voffB);
            PG8_BAR; PG8_WAIT_L(0); PG8_MMA(0, 1, At, B1); PG8_BAR;
            PG8_LDA(At, 0, 1); PG8_STAGE(PG8_SA(0, 0), a2, voffA);
            PG8_BAR; PG8_WAIT_L(0); PG8_MMA(1, 0, At, B0); PG8_BAR; PG8_SCHED;
            PG8_STAGE(PG8_SB(0, 1), b2 + hstep, voffB);
            PG8_WAIT_V(6); PG8_BAR; PG8_MMA(1, 1, At, B1); PG8_BAR;
            PG8_LDB(B0, 1, 0); PG8_SCHED; PG8_LDA(At, 1, 0); PG8_STAGE(PG8_SA(0, 1), a2 + hstep, voffA);
            PG8_WAIT_L(8); PG8_BAR; PG8_WAIT_L(0); PG8_MMA(0, 0, At, B0); PG8_BAR; PG8_SCHED;
            PG8_LDB(B1, 1, 1); PG8_STAGE(PG8_SB(1, 0), b3, voffB);
            PG8_BAR; PG8_WAIT_L(0); PG8_MMA(0, 1, At, B1); PG8_BAR;
            PG8_LDA(At, 1, 1); PG8_STAGE(PG8_SA(1, 0), a3, voffA);
            PG8_BAR; PG8_WAIT_L(0); PG8_MMA(1, 0, At, B0); PG8_BAR; PG8_SCHED;
            PG8_STAGE(PG8_SB(1, 1), b3 + hstep, voffB);
            PG8_WAIT_V(6); PG8_BAR; PG8_MMA(1, 1, At, B1); PG8_BAR;
            }
        }
        if constexpr (ALIGN_EPI) { if (wr == 0) PG8_BAR; }
        if constexpr (!Epi::AFTER_DRAIN) { E(acc, cur, wr, wc, fr, fq); S.done(cur); }
        if (!has_next) break;
#pragma unroll
        for (int a = 0; a < 2; ++a)
#pragma unroll
            for (int b = 0; b < 2; ++b)
#pragma unroll
                for (int m = 0; m < 4; ++m)
#pragma unroll
                    for (int n = 0; n < 2; ++n) acc[a][b][m][n] = (f32x4){0.f, 0.f, 0.f, 0.f};
        cur = nxt; cA = nA; cB = nB; ++ui;
        if constexpr (ALIGN_EPI) { if (wr == 1) PG8_BAR; }
    }
    PG8_WAIT_V(0);
    if constexpr (!ALIGN_EPI) { if (wr == 0) PG8_BAR; }
    PG8_BAR;
    if constexpr (Epi::AFTER_DRAIN) { E.fused(acc, cur, wr, wc, fr, fq, lds, wid, lane); S.done(cur); }
#undef PG8_SA
#undef PG8_SB
#undef PG8_STAGE
#undef PG8_LDA
#undef PG8_LDB
#undef PG8_MMA
#undef PG8_WAIT_V
#undef PG8_WAIT_L
#undef PG8_BAR
#undef PG8_SCHED
}
}

#define LAS __attribute__((address_space(3)))
constexpr int NWAVES = 8, NTHR = 512;
constexpr int LDS_BYTES = 147456;
constexpr int NPH = 21;
typedef float f32x4 __attribute__((ext_vector_type(4)));
typedef unsigned u32x4 __attribute__((ext_vector_type(4)));

struct Args { const float* in[30]; float* out; unsigned char* ws; int ph_lo, ph_hi; };

__device__ __forceinline__ unsigned pk2(float lo, float hi) { return (unsigned)f2bf(lo) | ((unsigned)f2bf(hi) << 16); }

__device__ __forceinline__ void p0_transpose_item(const float* W, int K, int N, bf16* WT, int row_off, LAS float* scr, int item, int lane) {
    const int nblk = N / 32, kb = item / nblk, nb = item % nblk, k0 = 64 * kb, n0 = 32 * nb;
#pragma unroll 8
    for (int i = 0; i < 32; ++i) { const int kk = 2 * i + (lane >> 5); scr[kk * 33 + (lane & 31)] = W[(size_t)(k0 + kk) * N + n0 + (lane & 31)]; }
    asm volatile("s_waitcnt lgkmcnt(0)" ::: "memory");
    const int c = lane & 7;
#pragma unroll
    for (int j = 0; j < 4; ++j) { const int n = (lane >> 3) + 8 * j; const LAS float* s = scr + (8 * c) * 33 + n;
        u32x4 o; o.x = pk2(s[0 * 33], s[1 * 33]); o.y = pk2(s[2 * 33], s[3 * 33]); o.z = pk2(s[4 * 33], s[5 * 33]); o.w = pk2(s[6 * 33], s[7 * 33]);
        *(u32x4*)(WT + (size_t)(row_off + n0 + n) * K + k0 + 8 * c) = o; }
    asm volatile("s_waitcnt lgkmcnt(0)" ::: "memory");
}

__device__ __forceinline__ void norm_mod_row(const float* xr, const float* gamma, const float* sh, const float* sc, bf16* orow, int lane) {
    f32x4 v[4]; float ss = 0.f;
#pragma unroll
    for (int j = 0; j < 4; ++j) { v[j] = *(const f32x4*)(xr + j * 256 + lane * 4); ss += (v[j].x * v[j].x + v[j].y * v[j].y) + (v[j].z * v[j].z + v[j].w * v[j].w); }
    const float rs = rsqrtf(wave_sum(ss, lane) * (1.f / D) + NORM_EPS);
#pragma unroll
    for (int j = 0; j < 4; ++j) { const int d = j * 256 + lane * 4; const f32x4 g = *(const f32x4*)(gamma + d), a = *(const f32x4*)(sc + d), s = *(const f32x4*)(sh + d);
        const f32x4 y = v[j] * rs * g * (a + 1.f) + s; uint2 o; o.x = pk2(y.x, y.y); o.y = pk2(y.z, y.w); *(uint2*)(orow + d) = o; }
}


#define XB_TMO      128
#define XB_XCNT(j)  (256  + 64 * (j))
#define XB_XSUB(j)  (1280 + 64 * (j))
#define XB_XGEN(j)  (2304 + 64 * (j))
#define XB_TOP      3328
#define XB_TOPGEN   3392
#define XCD_BAR_WORDS 3456
#define XB_SPIN_CAP (1u << 18)

__device__ __forceinline__ unsigned xb_ld(unsigned* p)              { return __hip_atomic_load(p, __ATOMIC_RELAXED, __HIP_MEMORY_SCOPE_AGENT); }
__device__ __forceinline__ unsigned xb_add(unsigned* p, unsigned v) { return __hip_atomic_fetch_add(p, v, __ATOMIC_RELAXED, __HIP_MEMORY_SCOPE_AGENT); }
__device__ __forceinline__ unsigned xb_xcc_id() { return (unsigned)__builtin_amdgcn_s_getreg((3 << 11) | 20) & 0xFu; }
#define XB_SPIN(cond, bar) do { unsigned _sp = 0; while (cond) { __builtin_amdgcn_s_sleep(1); \
    if ((++_sp & 255u) == 0u) { if (xb_ld(&(bar)[XB_TMO])) break; if (_sp > XB_SPIN_CAP) { atomicAdd(&(bar)[XB_TMO], 1u); break; } } } } while (0)

struct XcdBarrier {
    unsigned* bar; unsigned x; int w0;
    volatile __attribute__((address_space(3))) unsigned* st;
};

__device__ __forceinline__ XcdBarrier xcd_barrier_post(unsigned* bar, volatile __attribute__((address_space(3))) unsigned* st) {
    XcdBarrier b; b.bar = bar; b.x = xb_xcc_id(); b.st = st; b.w0 = __builtin_amdgcn_readfirstlane((int)threadIdx.x >> 6);
    if (threadIdx.x == 0) (void)xb_add(&bar[XB_XCNT(b.x)], 1u);
    return b;
}
__device__ __forceinline__ void xcd_barrier_complete(unsigned* bar, unsigned x, unsigned& nloc, unsigned& nx) {
    const unsigned G = gridDim.x * gridDim.y * gridDim.z;
    unsigned sum, cnt, mine, sp = 0u;
    for (;;) {
        sum = 0u; cnt = 0u; mine = 0u;
#pragma unroll
        for (unsigned j = 0; j < 16; ++j) { const unsigned c = xb_ld(&bar[XB_XCNT(j)]); sum += c; cnt += (c > 0u) ? 1u : 0u; }
        mine = xb_ld(&bar[XB_XCNT(x)]);
        if (sum == G) break;
        __builtin_amdgcn_s_sleep(1);
        if ((++sp & 255u) == 0u) { if (xb_ld(&bar[XB_TMO])) break; if (sp > XB_SPIN_CAP) { atomicAdd(&bar[XB_TMO], 1u); break; } }
    }
    nloc = mine > 0u ? mine : 1u; nx = cnt > 0u ? cnt : 1u;
}

template <bool FIRST> __device__ __forceinline__ void xcd_barrier(const XcdBarrier& b) {
    asm volatile("s_waitcnt vmcnt(0)" ::: "memory");
    __syncthreads();
    int lid_; asm volatile("v_mbcnt_lo_u32_b32 %0, -1, 0\n\tv_mbcnt_hi_u32_b32 %0, -1, %0" : "=v"(lid_));
    if (b.w0 == 0 && lid_ == 0) {
        unsigned* bar = b.bar;
        __builtin_amdgcn_s_waitcnt(0);
        unsigned nloc = b.st[0], nx = b.st[1];
        if (FIRST && nloc == 0u) { xcd_barrier_complete(bar, b.x, nloc, nx); b.st[0] = nloc; b.st[1] = nx; }
        const unsigned old = xb_add(&bar[XB_XSUB(b.x)], 1u);
        const unsigned gen = old / nloc;
        if (old + 1u == (gen + 1u) * nloc) {
            __builtin_amdgcn_fence(__ATOMIC_RELEASE, "agent");
            asm volatile("s_waitcnt vmcnt(0)" ::: "memory");
            const unsigned og = xb_add(&bar[XB_TOP], 1u);
            const unsigned tg = og / nx;
            if (og + 1u == (tg + 1u) * nx) xb_add(&bar[XB_TOPGEN], 1u);
            else XB_SPIN(xb_ld(&bar[XB_TOPGEN]) == tg, bar);
            __builtin_amdgcn_fence(__ATOMIC_ACQUIRE, "agent");
            xb_add(&bar[XB_XGEN(b.x)], 1u);
            asm volatile("s_waitcnt vmcnt(0)" ::: "memory");
        } else {
            XB_SPIN(xb_ld(&bar[XB_XGEN(b.x)]) == gen, bar);
            __builtin_amdgcn_fence(__ATOMIC_ACQUIRE, "agent");
            asm volatile("s_waitcnt vmcnt(0)" ::: "memory");
        }
    }
    __syncthreads();
}


__device__ __forceinline__ unsigned mono_u32(float f) { unsigned u = __float_as_uint(f); return (u & 0x80000000u) ? ~u : (u | 0x80000000u); }
__device__ __forceinline__ float demono_u32(unsigned u) { return __uint_as_float((u & 0x80000000u) ? (u & 0x7FFFFFFFu) : ~u); }
__device__ __forceinline__ unsigned pack_key7(float f, int idx) { return (mono_u32(f) & 0xFFFFFF80u) | (unsigned)(127 - idx); }
__device__ __forceinline__ float unpack_key7(unsigned k) { return demono_u32((k & 0xFFFFFF80u) | 0x40u); }
__device__ __forceinline__ float unpack_key8(unsigned k) { return demono_u32((k & 0xFFFFFF00u) | 0x80u); }
__device__ __forceinline__ void ce_desc(unsigned& a, unsigned& b) { const unsigned hi = a > b ? a : b, lo = a > b ? b : a; a = hi; b = lo; }
__device__ __forceinline__ void sort16_desc(unsigned* v) {
#pragma unroll
    for (int k = 2; k <= 16; k <<= 1)
#pragma unroll
        for (int j = k >> 1; j > 0; j >>= 1)
#pragma unroll
            for (int i = 0; i < 16; ++i) { const int l = i ^ j; if (l > i) { if ((i & k) == 0) ce_desc(v[i], v[l]); else ce_desc(v[l], v[i]); } }
}
__device__ __forceinline__ void bmerge16_desc(unsigned* v) {
#pragma unroll
    for (int j = 8; j > 0; j >>= 1)
#pragma unroll
        for (int i = 0; i < 16; ++i) { const int l = i ^ j; if (l > i) ce_desc(v[i], v[l]); }
}
__device__ __forceinline__ void merge_top16(unsigned* a, const unsigned* b) {
#pragma unroll
    for (int i = 0; i < 16; ++i) { const unsigned o = b[15 - i]; a[i] = a[i] > o ? a[i] : o; }
    bmerge16_desc(a);
}
__device__ __forceinline__ void stage2_cands(const unsigned* s0, const unsigned* s1, int hh, unsigned* c) {
    float A[16], B[16];
#pragma unroll
    for (int i = 0; i < 16; ++i) { const float f0 = unpack_key7(s0[i]), f1 = unpack_key7(s1[i]); A[i] = hh ? f1 : f0; B[i] = hh ? f0 : f1; }
    int n = 0;
#pragma unroll
    for (int i = 0; i < 4; ++i)
#pragma unroll
        for (int j = i; j < 16; ++j) { if ((i + 1) * (j + 1) > 16) continue;
            const float val = A[i] + B[j]; const unsigned id = hh ? (unsigned)((j << 4) | i) : (unsigned)((i << 4) | j);
            unsigned key = (mono_u32(val) & 0xFFFFFF00u) | id; if (hh && i == j) key = 0u; c[n++] = key; }
#pragma unroll
    for (; n < 32; ++n) c[n] = 0u;
}

typedef short bf16x8_t __attribute__((ext_vector_type(8)));
typedef float f32x16 __attribute__((ext_vector_type(16)));
__device__ __forceinline__ float gelu_erf(float a) { return 0.5f * a * (1.f + erff(a * 0.70710678118654752f)); }


__device__ __forceinline__ void convert_tables_fp8(const float* pu, const float* pv, unsigned char* u8, unsigned char* v8, float* usc, float* vsc, int l, int wv, int nw, int lane) {
    for (int rr0 = wv * 2; rr0 < 2 * NEXP; rr0 += nw * 2) {
        f32x4 v[2][4]; float m[2];
#pragma unroll
        for (int rr = 0; rr < 2; ++rr) { const int q = rr0 + rr; const size_t row = (size_t)l * NEXP + (q < NEXP ? q : q - NEXP); const float* sp_ = (q < NEXP ? pu : pv) + row * D + lane * 16;
#pragma unroll
            for (int k = 0; k < 4; ++k) v[rr][k] = *(const f32x4*)(sp_ + k * 4); }
#pragma unroll
        for (int rr = 0; rr < 2; ++rr) { float mm = 0.f;
#pragma unroll
            for (int k = 0; k < 4; ++k) mm = fmaxf(fmaxf(mm, fmaxf(fabsf(v[rr][k].x), fabsf(v[rr][k].y))), fmaxf(fabsf(v[rr][k].z), fabsf(v[rr][k].w)));
#pragma unroll
            for (int o = 1; o < 64; o <<= 1) mm = fmaxf(mm, shflx(mm, lane, o));
            m[rr] = mm; }
#pragma unroll
        for (int rr = 0; rr < 2; ++rr) { const int q = rr0 + rr; const size_t row = (size_t)l * NEXP + (q < NEXP ? q : q - NEXP); const float sc = m[rr] > 0.f ? 448.f / m[rr] : 1.f;
            u32x4 o; int w;
            w = 0; w = __builtin_amdgcn_cvt_pk_fp8_f32(v[rr][0].x * sc, v[rr][0].y * sc, w, false); w = __builtin_amdgcn_cvt_pk_fp8_f32(v[rr][0].z * sc, v[rr][0].w * sc, w, true); o.x = (unsigned)w;
            w = 0; w = __builtin_amdgcn_cvt_pk_fp8_f32(v[rr][1].x * sc, v[rr][1].y * sc, w, false); w = __builtin_amdgcn_cvt_pk_fp8_f32(v[rr][1].z * sc, v[rr][1].w * sc, w, true); o.y = (unsigned)w;
            w = 0; w = __builtin_amdgcn_cvt_pk_fp8_f32(v[rr][2].x * sc, v[rr][2].y * sc, w, false); w = __builtin_amdgcn_cvt_pk_fp8_f32(v[rr][2].z * sc, v[rr][2].w * sc, w, true); o.z = (unsigned)w;
            w = 0; w = __builtin_amdgcn_cvt_pk_fp8_f32(v[rr][3].x * sc, v[rr][3].y * sc, w, false); w = __builtin_amdgcn_cvt_pk_fp8_f32(v[rr][3].z * sc, v[rr][3].w * sc, w, true); o.w = (unsigned)w;
            *(u32x4*)((q < NEXP ? u8 : v8) + row * D + lane * 16) = o;
            if (lane == 0) (q < NEXP ? usc : vsc)[row] = m[rr] > 0.f ? m[rr] * (1.f / 448.f) : 1.f; }
    }
}

__global__ void __launch_bounds__(NTHR, 2) mega(Args args) {
    extern __shared__ __attribute__((aligned(16))) unsigned char lds_raw[];
    LAS unsigned char* lds = (LAS unsigned char*)lds_raw;
    const int G = gridDim.x, bx = blockIdx.x, NGW = G * NWAVES;
    const int wave0 = __builtin_amdgcn_readfirstlane((int)threadIdx.x >> 6);
    typedef const unsigned char __attribute__((address_space(4))) kbyte;
#define PHASE_IDS int tid; asm volatile("v_mbcnt_lo_u32_b32 %0, -1, 0\n\tv_mbcnt_hi_u32_b32 %0, -1, %0" : "=v"(tid)); tid += wave0 * 64;     const int lane = tid & 63, wave = __builtin_amdgcn_readfirstlane(tid >> 6), gw = bx * NWAVES + wave; (void)lane; (void)gw; \
    kbyte* kp = (kbyte*)__builtin_amdgcn_kernarg_segment_ptr(); asm volatile("" : "+s"(kp)); \
    unsigned char* const ws = (unsigned char*)*(__attribute__((address_space(1))) unsigned char* const __attribute__((address_space(4)))*)(kp + 31 * 8); float* const X = (float*)*(__attribute__((address_space(1))) float* const __attribute__((address_space(4)))*)(kp + 30 * 8); (void)ws; (void)X;
#define INP(i) ((const float*)(*(const __attribute__((address_space(1))) float* const __attribute__((address_space(4)))*)(kp + (i) * 8)))
#define MOD ((float*)(ws + WS_MOD))
#define H ((bf16*)(ws + WS_H))
#define PROJ ((bf16*)(ws + WS_PROJ))
#define Q ((bf16*)(ws + WS_Q))
#define MIX ((bf16*)(ws + WS_MIX))
#define Rb ((bf16*)(ws + WS_R))
#define Kb ((bf16*)(ws + WS_K))
#define V0 ((bf16*)(ws + WS_V0))
#define V1 ((bf16*)(ws + WS_V1))
#define KKb ((bf16*)(ws + WS_KK))
#define Bb ((bf16*)(ws + WS_B))
#define Gb ((bf16*)(ws + WS_G))
#define BGb ((bf16*)(ws + WS_BG))
#define Wd ((float*)(ws + WS_W))
#define Y ((float*)(ws + WS_Y))
#define QB ((float*)(ws + WS_QB))
#define SH ((float*)(ws + WS_SH))
#define WUPT ((bf16*)(ws + WS_LORA))
#define AUPT ((bf16*)(ws + WS_LORA + 131072))
#define GUPT ((bf16*)(ws + WS_LORA + 262144))
#define VUPT ((bf16*)(ws + WS_LORA + 524288))
#define INVN ((float*)(ws + WS_INVN))
#define BSUM ((float*)(ws + WS_BSUM))
#define IDX ((int*)(ws + WS_IDX))
#define GATE ((float*)(ws + WS_GATE))
#define WinT ((bf16*)(ws + WS_WIN_T))
#define WoutT ((bf16*)(ws + WS_WOUT_T))
#define PqT ((bf16*)(ws + WS_PQ_T))
#define KEYS ((bf16*)(ws + WS_KEYS))
#define U8 ((unsigned char*)(ws + WS_U))
#define V8 ((unsigned char*)(ws + WS_V))
#define USc ((float*)(ws + WS_US))
#define VSc ((float*)(ws + WS_VS))
    const int lo = args.ph_lo, hi = args.ph_hi;
    { volatile LAS unsigned* misc = (volatile LAS unsigned*)(lds + 131072 + 64); if (threadIdx.x < 4) misc[threadIdx.x] = 0u; __syncthreads(); }
    const XcdBarrier xbar = xcd_barrier_post((unsigned*)(args.ws) + 4096, (volatile LAS unsigned*)(lds + 131072 + 64));
#define IN(k) (lo <= (k) && (k) < hi)
#ifndef REP_PHASE
#define REP_PHASE (-1)
#endif
#define REPS(k) ((k) == REP_PHASE ? 3 : 1)
#define SEAM(k) do { if (IN(k) && IN((k) + 1)) { if ((k) == 0) cg::this_grid().sync(); else { XcdBarrier xb_ = xbar; asm volatile("" : "+s"(xb_.bar)); if ((k) == 1) xcd_barrier<true>(xb_); else xcd_barrier<false>(xb_); } } } while (0)

    if (IN(0)) { PHASE_IDS
        { LAS float* ca = (LAS float*)lds; LAS float* red = (LAS float*)(lds + 16384);
          const float* c = INP(1); const float* ada_w = INP(2); const float* ada_b = INP(3);
          bool have = false;
          for (int it = bx; it < 96; it += G) {
              if (!have) { for (int i = tid; i < BATCH * D; i += NTHR) { const float v = c[i]; ca[i] = v / (1.f + expf(-v)); } have = true; __syncthreads(); }
              const int l = it / 48, n = (it % 48) * 128 + (tid & 127), kq = tid >> 7;
              const float* w = ada_w + (size_t)l * D * 6 * D + (size_t)(kq * 256) * 6 * D + n;
              float a0 = 0.f, a1 = 0.f, a2 = 0.f, a3 = 0.f;
#pragma unroll 32
              for (int k = 0; k < 256; ++k) { const float wv = w[(size_t)k * 6 * D]; const int kk = kq * 256 + k; a0 += ca[kk] * wv; a1 += ca[D + kk] * wv; a2 += ca[2 * D + kk] * wv; a3 += ca[3 * D + kk] * wv; }
              red[(kq * 4 + 0) * 128 + (tid & 127)] = a0; red[(kq * 4 + 1) * 128 + (tid & 127)] = a1; red[(kq * 4 + 2) * 128 + (tid & 127)] = a2; red[(kq * 4 + 3) * 128 + (tid & 127)] = a3;
              __syncthreads();
              { const int b = tid >> 7, col = tid & 127, nn = (it % 48) * 128 + col;
                const float s = red[(0 * 4 + b) * 128 + col] + red[(1 * 4 + b) * 128 + col] + red[(2 * 4 + b) * 128 + col] + red[(3 * 4 + b) * 128 + col];
                MOD[(size_t)l * BATCH * 6 * D + (size_t)b * 6 * D + nn] = s + ada_b[l * 6 * D + nn]; }
              __syncthreads();
          }
          __syncthreads(); }
        { LAS float* scr = (LAS float*)(lds + wave * 16384);
          constexpr int I_IN = (D / 64) * (IN_COLS / 32), I_VR = (D / 64) * (MVL / 32), I_OUT = (D / 64) * (D / 32), I_PQ = (D / 64) * (PH * PQ / 32);
          constexpr int NIT = 2 * I_IN + I_VR + 2 * I_OUT + 2 * I_PQ;
          for (int it = gw; it < NIT; it += NGW) { int r = it;
              if (r < 2 * I_IN) { const int l = r / I_IN; p0_transpose_item(INP(5) + (size_t)l * D * IN_COLS, D, IN_COLS, WinT + (size_t)l * LDP * D, 0, scr, r % I_IN, lane); continue; } r -= 2 * I_IN;
              if (r < I_VR) { p0_transpose_item(INP(12), D, MVL, WinT + (size_t)1 * LDP * D, IN_COLS, scr, r, lane); continue; } r -= I_VR;
              if (r < 2 * I_OUT) { const int l = r / I_OUT; p0_transpose_item(INP(23) + (size_t)l * D * D, D, D, WoutT + (size_t)l * D * D, 0, scr, r % I_OUT, lane); continue; } r -= 2 * I_OUT;
              { const int l = r / I_PQ; p0_transpose_item(INP(25) + (size_t)l * D * PH * PQ, D, PH * PQ, PqT + (size_t)l * PH * PQ * D, 0, scr, r % I_PQ, lane); } }
          for (int it = gw; it < 2 * 16 + 2 * 16 + 2 * 32; it += NGW) { int r = it;
              if (r < 32) { const int l = r / 16; p0_transpose_item(INP(8) + (size_t)l * DL * RW, DL, RW, WUPT + (size_t)l * RW * DL, 0, scr, r % 16, lane); continue; } r -= 32;
              if (r < 32) { const int l = r / 16; p0_transpose_item(INP(10) + (size_t)l * AL * RW, AL, RW, AUPT + (size_t)l * RW * AL, 0, scr, r % 16, lane); continue; } r -= 32;
              { const int l = r / 32; p0_transpose_item(INP(11) + (size_t)l * GL * RW, GL, RW, GUPT + (size_t)l * RW * GL, 0, scr, r % 32, lane); } }
          { const float* vu = INP(15); for (int e = bx * NTHR + tid; e < MVL * RW; e += G * NTHR) { const int n = e >> 5, k = e & 31; VUPT[e] = f2bf(vu[k * RW + n]); } } }
        { const size_t gt = (size_t)bx * NTHR + tid, NT = (size_t)G * NTHR;
          constexpr size_t NK8 = (size_t)2 * PH * 2 * NKEYS * PHALF / 8;
          const float* src = INP(26); bf16* dst = KEYS;
          for (size_t i = gt; i < NK8; i += NT) {
              const f32x4 a = *(const f32x4*)(src + i * 8), b = *(const f32x4*)(src + i * 8 + 4);
              u32x4 o; o.x = pk2(a.x, a.y); o.y = pk2(a.z, a.w); o.z = pk2(b.x, b.y); o.w = pk2(b.z, b.w); *(u32x4*)(dst + i * 8) = o; }
        }
    }
    SEAM(0);

#pragma unroll
    for (int l = 0; l < DEPTH; ++l) {
        const int pb = 1 + 10 * l;
#define modl (MOD + (size_t)l * BATCH * 6 * D)
#define xin (l == 0 ? INP(0) : (const float*)X)
        if (l == 0 && IN(pb + 0)) { PHASE_IDS const float* gamma = INP(4) + l * D;
            for (int row = gw; row < T; row += NGW) { const int b = row / SEQ; norm_mod_row(xin + (size_t)row * D, gamma, modl + (size_t)b * 6 * D, modl + (size_t)b * 6 * D + D, H + (size_t)row * D, lane); } }
        SEAM(pb + 0);
        if (IN(pb + 1)) { PHASE_IDS const int N1 = l == 0 ? IN_COLS : LDP;
            pg8::Gemm g{H, WinT + (size_t)l * LDP * D, T, N1, D}; pg8::StaticOrder S; S.init(T, N1, G, bx);
            pg8::EpiBf16<0> E{PROJ, LDP, nullptr, 0, 0, 1.f};
            pg8::gemm_phase<pg8::EpiBf16<0>, pg8::StaticOrder, true, true>(lds, g, S, E, tid); }
        SEAM(pb + 1);

        if (IN(pb + 2)) { PHASE_IDS
            constexpr int LST = 296;
            LAS bf16* lin = (LAS bf16*)lds;
            const float* mu = INP(6) + l * RWKV_COLS; const float* vmu = INP(13);
            const float* w0p = INP(7) + l * RW; const float* a0p = INP(9) + l * RW; const float* kkp = INP(16) + l * RW; const float* kap = INP(17) + l * RW; const float* rkp = INP(18) + l * RW; const float* v0p = INP(14);
            const bf16* wupT = WUPT + (size_t)l * RW * DL; const bf16* aupT = AUPT + (size_t)l * RW * AL; const bf16* gupT = GUPT + (size_t)l * RW * GL; const bf16* vupT = VUPT;
            bf16* Vl = l == 0 ? V0 : V1;
            const int r32 = lane & 31, hh = lane >> 5, h = wave;
            for (int tile = bx; tile < T / 32; tile += G) {
                const int t0 = tile * 32;
                __syncthreads();
                for (int c8 = tid; c8 < 32 * 36; c8 += NTHR) {
                    const int tok = c8 / 36, jc = c8 % 36, t = t0 + tok, sq = t % SEQ;
                    u32x4 o = {0u, 0u, 0u, 0u};
                    if (jc < 32 || l > 0) {
                        const int col = jc < 32 ? 3 * RW + jc * 8 : IN_COLS + (jc - 32) * 8;
                        const u32x4 cu = *(const u32x4*)(PROJ + (size_t)t * LDP + col); u32x4 pv = {0u, 0u, 0u, 0u}; if (sq > 0) pv = *(const u32x4*)(PROJ + (size_t)(t - 1) * LDP + col);
                        const float* mp = jc < 32 ? mu + col : vmu + (jc - 32) * 8; const f32x4 m0 = *(const f32x4*)mp, m1 = *(const f32x4*)(mp + 4);
                        float x[8]; const unsigned cw[4] = {cu.x, cu.y, cu.z, cu.w}, pw[4] = {pv.x, pv.y, pv.z, pv.w}; const float mm[8] = {m0.x, m0.y, m0.z, m0.w, m1.x, m1.y, m1.z, m1.w};
#pragma unroll
                        for (int i = 0; i < 4; ++i) { const float c0 = __uint_as_float(cw[i] << 16), c1 = __uint_as_float(cw[i] & 0xffff0000u), p0 = __uint_as_float(pw[i] << 16), p1 = __uint_as_float(pw[i] & 0xffff0000u);
                            x[2 * i] = c0 + (p0 - c0) * mm[2 * i]; x[2 * i + 1] = c1 + (p1 - c1) * mm[2 * i + 1]; }
                        if (jc < 8) {
#pragma unroll
                            for (int i = 0; i < 8; ++i) { const float e2 = __expf(-2.f * fabsf(x[i])); const float th = (1.f - e2) * __builtin_amdgcn_rcpf(1.f + e2); x[i] = x[i] < 0.f ? -th : th; } }
                        else if (jc >= 16 && jc < 32) {
#pragma unroll
                            for (int i = 0; i < 8; ++i) x[i] = __builtin_amdgcn_rcpf(1.f + __expf(-x[i])); }
                        o.x = pk2(x[0], x[1]); o.y = pk2(x[2], x[3]); o.z = pk2(x[4], x[5]); o.w = pk2(x[6], x[7]);
                    }
                    *(LAS u32x4*)(lin + tok * LST + jc * 8) = o;
                }
                __syncthreads();
                float ssq[16], bsm[16];
#pragma unroll
                for (int e = 0; e < 16; ++e) { ssq[e] = 0.f; bsm[e] = 0.f; }
                const bool first = (t0 % SEQ) == 0;
#pragma unroll 1
                for (int rt = 0; rt < 2; ++rt) {
                    f32x16 accW, accA, accG, accV;
#pragma unroll
                    for (int e = 0; e < 16; ++e) { accW[e] = 0.f; accA[e] = 0.f; accG[e] = 0.f; accV[e] = 0.f; }
                    const int c = h * HS + rt * 32 + r32;
                    const LAS bf16* lrow = lin + r32 * LST + 8 * hh;
#pragma unroll
                    for (int ks = 0; ks < 4; ++ks) { const bf16x8_t wv = *(const bf16x8_t*)(wupT + (size_t)c * DL + ks * 16 + 8 * hh); const bf16x8_t xq = *(const LAS bf16x8_t*)(lrow + ks * 16); accW = __builtin_amdgcn_mfma_f32_32x32x16_bf16(xq, wv, accW, 0, 0, 0); }
#pragma unroll
                    for (int ks = 0; ks < 4; ++ks) { const bf16x8_t wv = *(const bf16x8_t*)(aupT + (size_t)c * AL + ks * 16 + 8 * hh); const bf16x8_t xq = *(const LAS bf16x8_t*)(lrow + 64 + ks * 16); accA = __builtin_amdgcn_mfma_f32_32x32x16_bf16(xq, wv, accA, 0, 0, 0); }
#pragma unroll
                    for (int ks = 0; ks < 8; ++ks) { const bf16x8_t wv = *(const bf16x8_t*)(gupT + (size_t)c * GL + ks * 16 + 8 * hh); const bf16x8_t xq = *(const LAS bf16x8_t*)(lrow + 128 + ks * 16); accG = __builtin_amdgcn_mfma_f32_32x32x16_bf16(xq, wv, accG, 0, 0, 0); }
                    if (l > 0) {
#pragma unroll
                        for (int ks = 0; ks < 2; ++ks) { const bf16x8_t wv = *(const bf16x8_t*)(vupT + (size_t)c * MVL + ks * 16 + 8 * hh); const bf16x8_t xq = *(const LAS bf16x8_t*)(lrow + 256 + ks * 16); accV = __builtin_amdgcn_mfma_f32_32x32x16_bf16(xq, wv, accV, 0, 0, 0); } }
                    const float mur = mu[c], muk = mu[RW + c], muv = mu[2 * RW + c], w0c = w0p[c], a0c = a0p[c], kkc = kkp[c], kac = kap[c], rkc = rkp[c];
                    const float v0c = l > 0 ? v0p[c] : 0.f;
#pragma unroll
                    for (int e = 0; e < 16; ++e) {
                        const int tok = (e & 3) + 8 * (e >> 2) + 4 * hh, t = t0 + tok; const bool hasprev = !(first && tok == 0);
                        const bf16* pr = PROJ + (size_t)t * LDP + c; const size_t o = (size_t)t * RW + c;
                        float r = bf2f(pr[0]), k = bf2f(pr[RW]), v = bf2f(pr[2 * RW]);
                        const float rp = hasprev ? bf2f(pr[-LDP]) : 0.f, kp_ = hasprev ? bf2f(pr[RW - LDP]) : 0.f, vp = hasprev ? bf2f(pr[2 * RW - LDP]) : 0.f;
                        r += (rp - r) * mur; k += (kp_ - k) * muk; v += (vp - v) * muv;
                        const float z = -(w0c + accW[e]); const float sp = fmaxf(z, 0.f) + __logf(1.f + __expf(-fabsf(z)));
                        const float decay = __expf(-__expf(-sp - 0.5f));
                        const float a = __builtin_amdgcn_rcpf(1.f + __expf(-(a0c + accA[e]))); const float g = accG[e];
                        if (l > 0) { const float vfv = bf2f(V0[o]); v = v + (vfv - v) * __builtin_amdgcn_rcpf(1.f + __expf(-(v0c + accV[e]))); }
                        const float kk = k * kkc; const float k2 = k * (1.f + (a - 1.f) * kac);
                        ssq[e] += kk * kk; bsm[e] += r * k2 * rkc;
                        Rb[o] = f2bf(r); Kb[o] = f2bf(k2); Vl[o] = f2bf(v); KKb[o] = f2bf(kk); Bb[o] = f2bf(kk * a); Gb[o] = f2bf(g); BGb[o] = f2bf(v * g); Wd[o] = decay;
                    }
                }
#pragma unroll
                for (int e = 0; e < 16; ++e) { float a_ = red16(ssq[e]), b_ = red16(bsm[e]); a_ += shflx(a_, lane, 16); b_ += shflx(b_, lane, 16); ssq[e] = a_; bsm[e] = b_; }
                if (r32 == 0) {
#pragma unroll
                    for (int e = 0; e < 16; ++e) { const int tok = (e & 3) + 8 * (e >> 2) + 4 * hh; INVN[(size_t)(t0 + tok) * NH + h] = rsqrtf(fmaxf(ssq[e], 1e-24f)); BSUM[(size_t)(t0 + tok) * NH + h] = bsm[e]; } }
            }
        }
        SEAM(pb + 2);

        if (IN(pb + 3)) { PHASE_IDS
            const bf16* Vl = l == 0 ? V0 : V1;
            constexpr int SB = 32, STP = 340, BUFB = SB * STP * 4;
            constexpr int YB_OFF = 2 * BUFB, YB_BYTES = SB * 16 * 4;
            const int nscan = (G >= 256) ? 128 : 0;
            for (int it = bx; it < 128; it += G) {
                const int b = it >> 5, h = (it >> 2) & 7, qr = it & 3;
                const size_t tb = (size_t)b * SEQ;
                __syncthreads();
                if (wave >= 4) {
                    const int lt = tid - 256, tok = lt >> 3, part = lt & 7;
                    const size_t gofs = (tb + tok) * RW + h * HS + part * 8;
                    const bf16* vsrc = Vl + (tb + tok) * RW + h * HS + qr * 16 + (part & 1) * 8;
                    u32x4 qr_, qk_, qkk_, qb_, qv_; f32x4 qw0, qw1; float qin_;
#define LD_ISSUE(blk) do { const size_t go = (size_t)(blk) * SB * RW; qin_ = INVN[(tb + tok + (size_t)(blk) * SB) * NH + h]; qr_ = *(const u32x4*)(Rb + gofs + go); qk_ = *(const u32x4*)(Kb + gofs + go); qkk_ = *(const u32x4*)(KKb + gofs + go); qb_ = *(const u32x4*)(Bb + gofs + go); \
                               qw0 = *(const f32x4*)(Wd + gofs + go); qw1 = *(const f32x4*)(Wd + gofs + go + 4); if (part < 2) qv_ = *(const u32x4*)(vsrc + go); } while (0)
#define UNPK8(dst, q) do { (dst)[0] = __uint_as_float((q).x << 16); (dst)[1] = __uint_as_float((q).x & 0xffff0000u); (dst)[2] = __uint_as_float((q).y << 16); (dst)[3] = __uint_as_float((q).y & 0xffff0000u); \
                           (dst)[4] = __uint_as_float((q).z << 16); (dst)[5] = __uint_as_float((q).z & 0xffff0000u); (dst)[6] = __uint_as_float((q).w << 16); (dst)[7] = __uint_as_float((q).w & 0xffff0000u); } while (0)
#define LD_WRITE(bufi) do { LAS float* rec = (LAS float*)(lds + (bufi) * BUFB) + tok * STP; float r8[8], k8[8], kk8[8], b8[8]; UNPK8(r8, qr_); UNPK8(k8, qk_); UNPK8(kk8, qkk_); UNPK8(b8, qb_); \
                        _Pragma("unroll") for (int i = 0; i < 8; ++i) { kk8[i] *= qin_; b8[i] *= qin_; } \
                        const float w8[8] = {qw0.x, qw0.y, qw0.z, qw0.w, qw1.x, qw1.y, qw1.z, qw1.w}; float kr = 0.f, br = 0.f; \
                        _Pragma("unroll") for (int i = 0; i < 8; ++i) { kr += k8[i] * r8[i]; br += b8[i] * r8[i]; } \
                        kr += dppf<0xB1>(kr); br += dppf<0xB1>(br); kr += dppf<0x4E>(kr); br += dppf<0x4E>(br); kr += dppf<0x141>(kr); br += dppf<0x141>(br); \
                        *(LAS f32x4*)(rec + part * 8) = (f32x4){w8[0] * r8[0], w8[1] * r8[1], w8[2] * r8[2], w8[3] * r8[3]}; *(LAS f32x4*)(rec + part * 8 + 4) = (f32x4){w8[4] * r8[4], w8[5] * r8[5], w8[6] * r8[6], w8[7] * r8[7]}; \
                        *(LAS f32x4*)(rec + 64 + part * 8) = qw0; *(LAS f32x4*)(rec + 64 + part * 8 + 4) = qw1; \
                        *(LAS f32x4*)(rec + 128 + part * 8) = (f32x4){k8[0], k8[1], k8[2], k8[3]}; *(LAS f32x4*)(rec + 128 + part * 8 + 4) = (f32x4){k8[4], k8[5], k8[6], k8[7]}; \
                        *(LAS f32x4*)(rec + 192 + part * 8) = (f32x4){-kk8[0], -kk8[1], -kk8[2], -kk8[3]}; *(LAS f32x4*)(rec + 192 + part * 8 + 4) = (f32x4){-kk8[4], -kk8[5], -kk8[6], -kk8[7]}; \
                        *(LAS f32x4*)(rec + 256 + part * 8) = (f32x4){b8[0], b8[1], b8[2], b8[3]}; *(LAS f32x4*)(rec + 256 + part * 8 + 4) = (f32x4){b8[4], b8[5], b8[6], b8[7]}; \
                        if (part < 2) { float v8[8]; UNPK8(v8, qv_); *(LAS f32x4*)(rec + 320 + part * 8) = (f32x4){v8[0], v8[1], v8[2], v8[3]}; *(LAS f32x4*)(rec + 320 + part * 8 + 4) = (f32x4){v8[4], v8[5], v8[6], v8[7]}; } \
                        if (part == 0) { rec[336] = kr; rec[337] = br; } } while (0)
                    LD_ISSUE(0); LD_WRITE(0); LD_ISSUE(1);
                    __syncthreads();
                    for (int blk = 0; blk < SEQ / SB; ++blk) {
                        if (blk + 1 < SEQ / SB) { LD_WRITE((blk + 1) & 1); if (blk + 2 < SEQ / SB) LD_ISSUE(blk + 2); }
                        if (blk > 0 && lt < 128) {
                            const LAS float* yb = (const LAS float*)(lds + YB_OFF + ((blk - 1) & 1) * YB_BYTES);
                            const int ys = lt >> 2, yc = lt & 3; const f32x4 yv = *(const LAS f32x4*)(yb + ys * 16 + yc * 4);
                            *(f32x4*)(Y + (tb + (size_t)(blk - 1) * SB + ys) * RW + h * HS + qr * 16 + yc * 4) = yv; }
                        __syncthreads();
                    }
                    if (lt < 128) { const LAS float* yb = (const LAS float*)(lds + YB_OFF + ((SEQ / SB - 1) & 1) * YB_BYTES);
                        const int ys = lt >> 2, yc = lt & 3; const f32x4 yv = *(const LAS f32x4*)(yb + ys * 16 + yc * 4);
                        *(f32x4*)(Y + (tb + (size_t)(SEQ / SB - 1) * SB + ys) * RW + h * HS + qr * 16 + yc * 4) = yv; }
#undef LD_ISSUE
#undef UNPK8
#undef LD_WRITE
                } else {
                    const int rowl = wave * 4 + (lane >> 4), kq = lane & 15;
                    f32x4 st = {0.f, 0.f, 0.f, 0.f};
                    __syncthreads();
                    for (int blk = 0; blk < SEQ / SB; ++blk) {
                        const LAS float* bb = (const LAS float*)(lds + (blk & 1) * BUFB);
                        LAS float* yb = (LAS float*)(lds + YB_OFF + (blk & 1) * YB_BYTES);
                        struct Ops { f32x4 wr4, w4, k4, nk4, b4; float v, kr, br; };
#define LOAD_OPS(o, sidx) do { const LAS float* p_ = bb + (sidx) * STP; (o).wr4 = *(const LAS f32x4*)(p_ + 4 * kq); (o).w4 = *(const LAS f32x4*)(p_ + 64 + 4 * kq); (o).k4 = *(const LAS f32x4*)(p_ + 128 + 4 * kq); \
                               (o).nk4 = *(const LAS f32x4*)(p_ + 192 + 4 * kq); (o).b4 = *(const LAS f32x4*)(p_ + 256 + 4 * kq); (o).v = p_[320 + rowl]; (o).kr = p_[336]; (o).br = p_[337]; } while (0)
                        Ops ops[3];
                        LOAD_OPS(ops[0], 0); LOAD_OPS(ops[1], 1);
                        float ykeep = 0.f;
#pragma unroll
                        for (int j = 0; j < SB; ++j) {
                            if (j + 2 < SB) LOAD_OPS(ops[(j + 2) % 3], j + 2);
                            __builtin_amdgcn_sched_barrier(0);
                            const Ops& o = ops[j % 3];
                            float d1 = (st.x * o.nk4.x + st.y * o.nk4.y) + (st.z * o.nk4.z + st.w * o.nk4.w);
                            float d2 = (st.x * o.wr4.x + st.y * o.wr4.y) + (st.z * o.wr4.z + st.w * o.wr4.w);
                            d1 += dppf<0xB1>(d1); d2 += dppf<0xB1>(d2); d1 += dppf<0x4E>(d1); d2 += dppf<0x4E>(d2);
                            d1 += dppf<0x141>(d1); d2 += dppf<0x141>(d2); d1 += dppf<0x140>(d1); d2 += dppf<0x140>(d2);
                            st = st * o.w4 + o.v * o.k4 + d1 * o.b4;
                            const float y = d2 + o.v * o.kr + d1 * o.br;
                            ykeep = (kq == (j & 15)) ? y : ykeep;
                            if ((j & 15) == 15) yb[((j >> 4) * 16 + kq) * 16 + rowl] = ykeep;
                        }
#undef LOAD_OPS
                        __syncthreads();
                    }
                }
            }
            if (bx >= nscan) {
                LAS float* dl = (LAS float*)lds;
                const float* pool_w = INP(21) + (size_t)l * 4 * PG * PG; const float ps = INP(22)[l * PW + tid];
                const int c = tid, g = c >> 7, dd = c & 127, win = 2 << g;
                for (int tile = bx - nscan; tile < T / 16; tile += G - nscan) {
                    const int t0 = tile * 16; const bool first = (t0 % SEQ) == 0;
                    __syncthreads();
                    float p[31];
#pragma unroll
                    for (int j = 0; j < 31; ++j) p[j] = (j >= 15 || !first) ? bf2f(PROJ[(size_t)(t0 - 15 + j) * LDP + RWKV_COLS + c]) : 0.f;
                    float sw = 0.f;
                    for (int j = 1; j <= 16; ++j) sw += (j < win) ? p[15 - j] : 0.f;
                    const float invw = 1.f / (float)win;
#pragma unroll
                    for (int i = 0; i < 16; ++i) {
                        sw += p[15 + i];
                        const float inv = first ? 1.f / (float)min(i + 1, win) : invw;
                        dl[i * 512 + c] = sw * inv - p[15 + i];
                        float drop = 0.f;
#pragma unroll
                        for (int q = 0; q < 4; ++q) { const int w_ = 2 << q; if (g == q) drop = p[15 + i - w_ + 1]; }
                        sw -= drop;
                    }
                    __syncthreads();
                    float acc[16];
#pragma unroll
                    for (int i = 0; i < 16; ++i) acc[i] = 0.f;
#pragma unroll 2
                    for (int cc = 0; cc < PG; cc += 4) {
                        const float* wp = pool_w + ((size_t)g * PG + cc) * PG + dd; const float w0 = wp[0], w1 = wp[PG], w2 = wp[2 * PG], w3 = wp[3 * PG];
#pragma unroll
                        for (int i = 0; i < 16; ++i) { const f32x4 d4 = *(const LAS f32x4*)(dl + i * 512 + g * PG + cc); acc[i] += (d4.x * w0 + d4.y * w1) + (d4.z * w2 + d4.w * w3); } }
#pragma unroll
                    for (int i = 0; i < 16; ++i) MIX[(size_t)(t0 + i) * D + RW + c] = f2bf(acc[i] * ps);
                }
                convert_tables_fp8(INP(27), INP(28), U8, V8, USc, VSc, l, (bx - nscan) * NWAVES + wave, (G - nscan) * NWAVES, lane);
            }
        }
        SEAM(pb + 3);

        if (IN(pb + 4)) { PHASE_IDS
            const int c = tid; const float lg = INP(19)[l * RW + c], lb = INP(20)[l * RW + c];
            for (int tile = bx; tile < T / 8; tile += G) {
                float y[8], g[8], bg[8];
#pragma unroll
                for (int i = 0; i < 8; ++i) { const size_t o = (size_t)(tile * 8 + i) * RW + c; y[i] = Y[o]; g[i] = bf2f(Gb[o]); bg[i] = bf2f(BGb[o]) * BSUM[(size_t)(tile * 8 + i) * NH + wave]; }
#pragma unroll
                for (int i = 0; i < 8; ++i) { const float mean = wave_sum(y[i], lane) * (1.f / 64.f); const float d = y[i] - mean; const float var = wave_sum(d * d, lane) * (1.f / 64.f);
                    const float yn = d * rsqrtf(var + GN_EPS) * lg + lb; MIX[(size_t)(tile * 8 + i) * D + c] = f2bf(yn * g[i] + bg[i]); }
            }
        }
        SEAM(pb + 4);
        if (IN(pb + 5)) { PHASE_IDS
            pg8::Gemm g{MIX, WoutT + (size_t)l * D * D, T, D, D}; pg8::StaticOrder S; S.init(T, D, G, bx);
            pg8::EpiResGate E{xin, X, modl + 2 * D};
            pg8::gemm_phase<pg8::EpiResGate, pg8::StaticOrder, true, true>(lds, g, S, E, tid); }
        SEAM(pb + 5);
        if (IN(pb + 6)) { PHASE_IDS const float* gamma = INP(24) + l * D;
            for (int row = gw; row < T; row += NGW) { const int b = row / SEQ; norm_mod_row(X + (size_t)row * D, gamma, modl + (size_t)b * 6 * D + 3 * D, modl + (size_t)b * 6 * D + 4 * D, H + (size_t)row * D, lane); } }
        SEAM(pb + 6);
        if (IN(pb + 7)) { PHASE_IDS
            pg8::Gemm g{H, PqT + (size_t)l * PH * PQ * D, T, PH * PQ, D}; pg8::StaticOrder S; S.init(T, PH * PQ, G, bx);
            pg8::EpiBf16<0> E{Q, PH * PQ, nullptr, 0, 0, 1.f};
            pg8::gemm_phase<pg8::EpiBf16<0>, pg8::StaticOrder, true, true>(lds, g, S, E, tid); }
        SEAM(pb + 7);

        if (IN(pb + 8)) { PHASE_IDS
            const bf16* KEYSl = KEYS + (size_t)l * PH * 2 * NKEYS * PHALF;
            LAS unsigned char* scr = lds + wave * 2048 + lane * 32;
            const int r = lane & 31, hh = lane >> 5;
            for (int it = gw; it < (T / 32) * PH; it += NGW) {
                const int tok = (it >> 3) * 32 + r, h = it & 7;
                unsigned sp0[16], sp1[16];
#pragma unroll
                for (int e = 0; e < 16; ++e) { sp0[e] = 0u; sp1[e] = 0u; }
#pragma unroll 1
                for (int p = 0; p < 2; ++p) {
                    const bf16* qp = Q + (size_t)tok * (PH * PQ) + h * PQ + p * PHALF + 8 * hh;
                    const bf16* kp_ = KEYSl + ((size_t)(h * 2 + p) * NKEYS + r) * PHALF + 8 * hh;
                    bf16x8_t bq[8];
#pragma unroll
                    for (int ks = 0; ks < 8; ++ks) bq[ks] = *(const bf16x8_t*)(qp + ks * 16);
                    unsigned best[16];
#pragma unroll
                    for (int e = 0; e < 16; ++e) best[e] = 0u;
#pragma unroll 1
                    for (int kt = 0; kt < 4; ++kt) {
                        f32x16 acc;
#pragma unroll
                        for (int e = 0; e < 16; ++e) acc[e] = 0.f;
#pragma unroll
                        for (int ks = 0; ks < 8; ++ks) { const bf16x8_t ak = *(const bf16x8_t*)(kp_ + (size_t)kt * 32 * PHALF + ks * 16); acc = __builtin_amdgcn_mfma_f32_32x32x16_bf16(ak, bq[ks], acc, 0, 0, 0); }
                        unsigned g[16];
#pragma unroll
                        for (int e = 0; e < 16; ++e) g[e] = pack_key7(acc[e], kt * 32 + (e & 3) + 8 * (e >> 2) + 4 * hh);
                        sort16_desc(g);
                        merge_top16(best, g);
                    }
                    unsigned ob[16];
#pragma unroll
                    for (int e = 0; e < 16; ++e) ob[e] = shflxu(best[e], lane, 32);
                    merge_top16(best, ob);
#pragma unroll
                    for (int e = 0; e < 16; ++e) { sp0[e] = p == 0 ? best[e] : sp0[e]; sp1[e] = p == 0 ? sp1[e] : best[e]; }
                }
                unsigned c2[32];
                stage2_cands(sp0, sp1, hh, c2);
                sort16_desc(c2); sort16_desc(c2 + 16); merge_top16(c2, c2 + 16);
                { unsigned ob[16];
#pragma unroll
                  for (int e = 0; e < 16; ++e) ob[e] = shflxu(c2[e], lane, 32);
                  merge_top16(c2, ob); }
#pragma unroll
                for (int e = 0; e < 16; e += 4) {
                    *(LAS unsigned*)(scr + e) = (127u - (sp0[e] & 127u)) | ((127u - (sp0[e + 1] & 127u)) << 8) | ((127u - (sp0[e + 2] & 127u)) << 16) | ((127u - (sp0[e + 3] & 127u)) << 24);
                    *(LAS unsigned*)(scr + 16 + e) = (127u - (sp1[e] & 127u)) | ((127u - (sp1[e + 1] & 127u)) << 8) | ((127u - (sp1[e + 2] & 127u)) << 16) | ((127u - (sp1[e + 3] & 127u)) << 24); }
                asm volatile("s_waitcnt lgkmcnt(0)" ::: "memory");
                float sm[16]; int ex[16];
#pragma unroll
                for (int e = 0; e < 16; ++e) { const unsigned key = c2[e]; sm[e] = unpack_key8(key); const int i0 = (key >> 4) & 15, j0 = key & 15; ex[e] = (int)scr[i0] * NKEYS + (int)scr[16 + j0]; }
                float den = 0.f;
#pragma unroll
                for (int e = 0; e < 16; ++e) { sm[e] = expf(sm[e] - unpack_key8(c2[0])); den += sm[e]; }
                const float inv = 1.f / den;
                if (hh == 0) {
                    int* ip = IDX + (size_t)tok * NE + h * TOPK; float* gp = GATE + (size_t)tok * NE + h * TOPK;
#pragma unroll
                    for (int e = 0; e < 16; e += 4) { *(int4*)(ip + e) = make_int4(ex[e], ex[e + 1], ex[e + 2], ex[e + 3]); *(f32x4*)(gp + e) = (f32x4){sm[e] * inv, sm[e + 1] * inv, sm[e + 2] * inv, sm[e + 3] * inv}; }
                }
                asm volatile("s_waitcnt lgkmcnt(0)" ::: "memory");
            }
        }
        SEAM(pb + 8);

        if (IN(pb + 9)) { PHASE_IDS
            const unsigned char* Ul = U8 + (size_t)l * NEXP * D; const unsigned char* Vtl = V8 + (size_t)l * NEXP * D; const float* usl = USc + l * NEXP; const float* vsl = VSc + l * NEXP; const float* lnf = INP(29);
            const bool fin = (l == DEPTH - 1);
            typedef float f32x2_t __attribute__((ext_vector_type(2)));
            const __amdgpu_buffer_rsrc_t ru = __builtin_amdgcn_make_buffer_rsrc((void*)Ul, 0, NEXP * D, 0x00020000), rv = __builtin_amdgcn_make_buffer_rsrc((void*)Vtl, 0, NEXP * D, 0x00020000);
            const int voff = lane * 16;
            LAS float* pl = (LAS float*)(lds + wave * 8704);
            for (int t = gw; t < T; t += NGW) {
                const int b = t / SEQ;
                f32x2_t hf2[8];
                { const u32x4 h0 = *(const u32x4*)(H + (size_t)t * D + lane * 16), h1 = *(const u32x4*)(H + (size_t)t * D + lane * 16 + 8);
                  hf2[0] = (f32x2_t){__uint_as_float(h0.x << 16), __uint_as_float(h0.x & 0xffff0000u)}; hf2[1] = (f32x2_t){__uint_as_float(h0.y << 16), __uint_as_float(h0.y & 0xffff0000u)};
                  hf2[2] = (f32x2_t){__uint_as_float(h0.z << 16), __uint_as_float(h0.z & 0xffff0000u)}; hf2[3] = (f32x2_t){__uint_as_float(h0.w << 16), __uint_as_float(h0.w & 0xffff0000u)};
                  hf2[4] = (f32x2_t){__uint_as_float(h1.x << 16), __uint_as_float(h1.x & 0xffff0000u)}; hf2[5] = (f32x2_t){__uint_as_float(h1.y << 16), __uint_as_float(h1.y & 0xffff0000u)};
                  hf2[6] = (f32x2_t){__uint_as_float(h1.z << 16), __uint_as_float(h1.z & 0xffff0000u)}; hf2[7] = (f32x2_t){__uint_as_float(h1.w << 16), __uint_as_float(h1.w & 0xffff0000u)}; }
                f32x2_t acc2[8];
#pragma unroll
                for (int i = 0; i < 8; ++i) acc2[i] = (f32x2_t){0.f, 0.f};
                int myidx = IDX[(size_t)t * NE + (lane & 31)]; float mygate = GATE[(size_t)t * NE + (lane & 31)];
                float myus = usl[myidx], myvs = vsl[myidx];
#define ROWLD(dst, rs, ix, e) dst = __builtin_amdgcn_raw_buffer_load_b128(rs, voff, __builtin_amdgcn_readlane(ix, (e)) * D, 0)
#define LOADB(buf, rs, ix, e0) do { _Pragma("unroll") for (int j_ = 0; j_ < 8; ++j_) ROWLD((buf)[j_], rs, ix, (e0) + j_); __builtin_amdgcn_sched_barrier(0); } while (0)
#define CVT8(u) const f32x2_t u0 = __builtin_amdgcn_cvt_pk_f32_fp8((int)(u).x, false), u1 = __builtin_amdgcn_cvt_pk_f32_fp8((int)(u).x, true), u2 = __builtin_amdgcn_cvt_pk_f32_fp8((int)(u).y, false), u3 = __builtin_amdgcn_cvt_pk_f32_fp8((int)(u).y, true), \
                        u4 = __builtin_amdgcn_cvt_pk_f32_fp8((int)(u).z, false), u5 = __builtin_amdgcn_cvt_pk_f32_fp8((int)(u).z, true), u6 = __builtin_amdgcn_cvt_pk_f32_fp8((int)(u).w, false), u7 = __builtin_amdgcn_cvt_pk_f32_fp8((int)(u).w, true)
#define DOT1(u, dst) do { CVT8(u); f32x2_t a_ = hf2[0] * u0; a_ += hf2[1] * u1; a_ += hf2[2] * u2; a_ += hf2[3] * u3; a_ += hf2[4] * u4; a_ += hf2[5] * u5; a_ += hf2[6] * u6; a_ += hf2[7] * u7; dst = a_.x + a_.y; } while (0)
#define DOTB(buf, e0) do { _Pragma("unroll") for (int j_ = 0; j_ < 8; ++j_) { float d_; DOT1((buf)[j_], d_); pl[((e0) + j_) * 68 + lane] = d_; } } while (0)
#define AXPYB(buf, e0) do { _Pragma("unroll") for (int j_ = 0; j_ < 8; ++j_) { CVT8((buf)[j_]); const float cf = __int_as_float(__builtin_amdgcn_readlane(__float_as_int(coef), (e0) + j_)); \
                        acc2[0] += cf * u0; acc2[1] += cf * u1; acc2[2] += cf * u2; acc2[3] += cf * u3; acc2[4] += cf * u4; acc2[5] += cf * u5; acc2[6] += cf * u6; acc2[7] += cf * u7; } } while (0)
                u32x4 ba[8], bb_[8];
                LOADB(ba, ru, myidx, 0);
#pragma unroll 1
                for (int q = 0; q < 4; ++q) {
                    int nidx = 0; float ngate = 0.f;
                    if (q < 3) { nidx = IDX[(size_t)t * NE + (q + 1) * 32 + (lane & 31)]; ngate = GATE[(size_t)t * NE + (q + 1) * 32 + (lane & 31)]; }
#pragma unroll
                    for (int e0 = 0; e0 < 32; e0 += 16) {
                        LOADB(bb_, ru, myidx, e0 + 8); DOTB(ba, e0);
                        if (e0 + 16 < 32) LOADB(ba, ru, myidx, e0 + 16); else LOADB(ba, rv, myidx, 0);
                        DOTB(bb_, e0 + 8);
                    }
                    const float nus = usl[nidx], nvs = vsl[nidx];
                    __builtin_amdgcn_wave_barrier(); asm volatile("s_waitcnt lgkmcnt(0)" ::: "memory");
                    float dsum;
                    { const LAS float* rp = pl + (lane & 31) * 68 + (lane >> 5) * 32; f32x4 s4 = *(const LAS f32x4*)rp;
#pragma unroll
                      for (int j = 1; j < 8; ++j) s4 += *(const LAS f32x4*)(rp + j * 4);
                      dsum = (s4.x + s4.y) + (s4.z + s4.w); }
                    dsum += shflx(dsum, lane, 32);
                    __builtin_amdgcn_wave_barrier(); asm volatile("s_waitcnt lgkmcnt(0)" ::: "memory");
                    const float coef = mygate * gelu_erf(dsum * myus) * myvs;
#pragma unroll
                    for (int e0 = 0; e0 < 32; e0 += 16) {
                        LOADB(bb_, rv, myidx, e0 + 8); AXPYB(ba, e0);
                        if (e0 + 16 < 32) LOADB(ba, rv, myidx, e0 + 16); else if (q < 3) LOADB(ba, ru, nidx, 0);
                        AXPYB(bb_, e0 + 8);
                    }
                    myidx = nidx; mygate = ngate; myus = nus; myvs = nvs;
                }
#undef ROWLD
#undef LOADB
#undef CVT8
#undef DOTB
#undef DOT1
#undef AXPYB
                float* xr = X + (size_t)t * D + lane * 16; const float* g2 = modl + (size_t)b * 6 * D + 5 * D + lane * 16;
                f32x4 xv[4]; float ss = 0.f;
#pragma unroll
                for (int q = 0; q < 4; ++q) { const f32x4 xo = *(const f32x4*)(xr + q * 4), gg = *(const f32x4*)(g2 + q * 4);
                    xv[q] = xo + gg * (f32x4){acc2[q * 2].x, acc2[q * 2].y, acc2[q * 2 + 1].x, acc2[q * 2 + 1].y}; ss += (xv[q].x * xv[q].x + xv[q].y * xv[q].y) + (xv[q].z * xv[q].z + xv[q].w * xv[q].w); }
                const float rs = rsqrtf(wave_sum(ss, lane) * (1.f / D) + NORM_EPS);
                if (fin) {
#pragma unroll
                    for (int q = 0; q < 4; ++q) xv[q] = xv[q] * rs * *(const f32x4*)(lnf + lane * 16 + q * 4); }
                else {
                    const float* gam = INP(4) + (l + 1) * D + lane * 16; const float* mn = MOD + (size_t)(l + 1) * BATCH * 6 * D + (size_t)b * 6 * D + lane * 16; u32x4 ho[2];
#pragma unroll
                    for (int q = 0; q < 4; ++q) { const f32x4 y = xv[q] * rs * *(const f32x4*)(gam + q * 4) * (*(const f32x4*)(mn + D + q * 4) + 1.f) + *(const f32x4*)(mn + q * 4);
                        if (q & 1) { ho[q >> 1].z = pk2(y.x, y.y); ho[q >> 1].w = pk2(y.z, y.w); } else { ho[q >> 1].x = pk2(y.x, y.y); ho[q >> 1].y = pk2(y.z, y.w); } }
                    *(u32x4*)(H + (size_t)t * D + lane * 16) = ho[0]; *(u32x4*)(H + (size_t)t * D + lane * 16 + 8) = ho[1]; }
#pragma unroll
                for (int q = 0; q < 4; ++q) *(f32x4*)(xr + q * 4) = xv[q];
            }
        }
    }
#undef modl
#undef xin
#undef IN
#undef SEAM
}
#undef MOD
#undef H
#undef PROJ
#undef Q
#undef MIX
#undef Rb
#undef Kb
#undef V0
#undef V1
#undef KKb
#undef Bb
#undef Gb
#undef BGb
#undef Wd
#undef Y
#undef IDX
#undef GATE
#undef WinT
#undef WoutT
#undef PqT
#undef KEYS
#undef QB
#undef SH
#undef WUPT
#undef AUPT
#undef GUPT
#undef VUPT
#undef INVN
#undef BSUM
#undef U8
#undef V8
#undef USc
#undef VSc
#undef INP
#undef PHASE_IDS

extern "C" void kernel_launch(void* const* d_in, const int* in_sizes, int n_in, void* d_out, int out_size, void* d_ws, size_t ws_size, hipStream_t stream) {
    if (n_in != 30 || ws_size < WS_END) { fprintf(stderr, "kernel_launch: unexpected n_in %d / ws_size %zu\n", n_in, ws_size); return; }
    static int grid = 0;
    if (grid == 0) {
        int dev = 0, cus = 0, per_cu = 0;
        (void)hipGetDevice(&dev); (void)hipDeviceGetAttribute(&cus, hipDeviceAttributeMultiprocessorCount, dev);
        if (hipFuncSetAttribute((const void*)mega, hipFuncAttributeMaxDynamicSharedMemorySize, LDS_BYTES) != hipSuccess) { fprintf(stderr, "hipFuncSetAttribute failed\n"); grid = -1; return; }
        if (hipOccupancyMaxActiveBlocksPerMultiprocessor(&per_cu, (const void*)mega, NTHR, LDS_BYTES) != hipSuccess || per_cu < 1) { fprintf(stderr, "occupancy query failed (%d)\n", per_cu); per_cu = 1; }
        (void)hipGetLastError();
        grid = (cus > 0 ? cus : 256) * 1;
    }
    if (grid < 0) return;
    Args a{}; for (int i = 0; i < 30; ++i) a.in[i] = (const float*)d_in[i]; a.out = (float*)d_out; a.ws = (unsigned char*)d_ws;
    a.ph_lo = 0; a.ph_hi = NPH;
    if (hipMemsetAsync(d_ws, 0, 65536, stream) != hipSuccess) { fprintf(stderr, "memset failed\n"); return; }
    void* kargs[] = {&a};
    hipError_t e = hipLaunchCooperativeKernel((const void*)mega, dim3(grid), dim3(NTHR), kargs, LDS_BYTES, stream);
    if (e != hipSuccess) fprintf(stderr, "cooperative launch failed: %s (grid %d)\n", hipGetErrorString(e), grid);
}
```

```cpp
#include <hip/hip_runtime.h>
#include <hip/hip_cooperative_groups.h>
namespace cg = cooperative_groups;
#include <cstdio>
#include <cstdint>
#include <cmath>

constexpr int D = 1024, BATCH = 4, SEQ = 4096, T = BATCH * SEQ, DEPTH = 2;
constexpr int RW = 512, HS = 64, NH = 8;
constexpr int DL = 64, AL = 64, MVL = 32, GL = 128;
constexpr int RWKV_COLS = 3 * RW + DL + AL + GL;
constexpr int PW = 512, PG = 128;
constexpr int IN_COLS = RWKV_COLS + PW;
constexpr int LDP = 2560;
constexpr int NKEYS = 128, NEXP = NKEYS * NKEYS, PH = 8, PQ = 256, PHALF = 128, TOPK = 16;
constexpr int NE = PH * TOPK;
constexpr float NORM_EPS = 1e-6f, GN_EPS = 64e-5f;

typedef unsigned short bf16;
__device__ __forceinline__ float bf2f(bf16 u) { return __uint_as_float((unsigned)u << 16); }
__device__ __forceinline__ bf16 f2bf(float f) { unsigned u = __float_as_uint(f); return (bf16)((u + 0x7fffu + ((u >> 16) & 1u)) >> 16); }

constexpr size_t MiB = 1u << 20;
constexpr size_t WS_MOD = 1 * MiB;
constexpr size_t WS_US = 1 * MiB + 256 * 1024;
constexpr size_t WS_VS = 1 * MiB + 512 * 1024;
constexpr size_t WS_H = 2 * MiB;
constexpr size_t WS_PROJ = 34 * MiB;
constexpr size_t WS_Q = WS_PROJ;
constexpr size_t WS_R = 114 * MiB;
constexpr size_t WS_K = 130 * MiB;
constexpr size_t WS_V0 = 146 * MiB;
constexpr size_t WS_V1 = 162 * MiB;
constexpr size_t WS_KK = 178 * MiB;
constexpr size_t WS_B = 194 * MiB;
constexpr size_t WS_G = 210 * MiB;
constexpr size_t WS_BG = 226 * MiB;
constexpr size_t WS_W = 242 * MiB;
constexpr size_t WS_Y = 274 * MiB;
constexpr size_t WS_MIX = 306 * MiB;
constexpr size_t WS_IDX = 338 * MiB;
constexpr size_t WS_GATE = 346 * MiB;
constexpr size_t WS_WIN_T = 354 * MiB;
constexpr size_t WS_WOUT_T = 364 * MiB;
constexpr size_t WS_PQ_T = 368 * MiB;
constexpr size_t WS_KEYS = 376 * MiB;
constexpr size_t WS_U = 378 * MiB;
constexpr size_t WS_V = 442 * MiB;
constexpr size_t WS_QB = 410 * MiB;
constexpr size_t WS_SH = 426 * MiB;
constexpr size_t WS_LORA = 428 * MiB;
constexpr size_t WS_INVN = 430 * MiB;
constexpr size_t WS_BSUM = 431 * MiB;
constexpr size_t WS_SCN = 2 * MiB;
constexpr size_t WS_END = 506 * MiB;

template <int CTRL> __device__ __forceinline__ float dppf(float x) { return __int_as_float(__builtin_amdgcn_update_dpp(0, __float_as_int(x), CTRL, 0xF, 0xF, false)); }
__device__ __forceinline__ float red16(float x) { x += dppf<0xB1>(x); x += dppf<0x4E>(x); x += dppf<0x141>(x); x += dppf<0x140>(x); return x; }
__device__ __forceinline__ float shflx(float v, int lane, int off) { return __int_as_float(__builtin_amdgcn_ds_bpermute((lane ^ off) << 2, __float_as_int(v))); }
__device__ __forceinline__ unsigned shflxu(unsigned v, int lane, int off) { return (unsigned)__builtin_amdgcn_ds_bpermute((lane ^ off) << 2, (int)v); }
__device__ __forceinline__ float wave_sum(float v, int lane) { v = red16(v); v += shflx(v, lane, 16); v += shflx(v, lane, 32); return v; }
__device__ __forceinline__ float sigmoidf_(float x) { return 1.f / (1.f + expf(-x)); }

namespace pg8 {
#define PG8_LAS __attribute__((address_space(3)))
typedef unsigned short bf16_t;
typedef short bf16x8 __attribute__((ext_vector_type(8)));
typedef float f32x4 __attribute__((ext_vector_type(4)));
typedef unsigned u32x4 __attribute__((ext_vector_type(4)));
constexpr int BM = 256, BK = 64, HALF = 128, HTB = HALF * BK * 2  , STAGE_BYTES = 8 * HTB, NXCD = 8, WGM = 8;

__host__ __device__ __forceinline__ int lds_byte(int r, int c) { const int st = (r >> 4) * 2 + (c >> 5), rr = r & 15, cc = c & 31, ob = rr * 64 + cc * 2; return st * 1024 + (ob ^ (((ob >> 9) & 1) << 5)); }
__host__ __device__ __forceinline__ void stage_rc(int b, int& R, int& C) { const int st = b / 1024, sb = b % 1024, swz = sb ^ (((sb >> 9) & 1) << 5); R = (st >> 1) * 16 + swz / 64; C = (st & 1) * 32 + (swz % 64) / 2; }
__host__ __device__ __forceinline__ int perm32(int rho) { const int n = rho >> 4, i = rho & 15; return 8 * (i >> 2) + 4 * n + (i & 3); }

struct Unit { int pm, pn; };
struct Gemm { const bf16_t* A; const bf16_t* Bt; int M, N, K; };

struct StaticOrder {
    int nM, nN, nwg, G, c;
    __host__ __device__ void init(int M, int N, int G_, int c_) { nM = M / BM; nN = N / BM; nwg = nM * nN; G = G_; c = c_; }
    __host__ __device__ bool next(int i, Unit& u) const {
        const long L = (long)i * G + c; if (L >= nwg) return false;
        int wgid = (int)L; { const int q = nwg / NXCD, r = nwg % NXCD, xcd = wgid % NXCD, off = wgid / NXCD; wgid = (xcd < r ? xcd * (q + 1) : r * (q + 1) + (xcd - r) * q) + off; }
        const int nig = WGM * nN, gid = wgid / nig, fm = gid * WGM, gsz = (nM - fm) < WGM ? (nM - fm) : WGM;
        u.pm = fm + ((wgid % nig) % gsz); u.pn = (wgid % nig) / gsz; return true;
    }
    __device__ __forceinline__ void a_ready(const Unit&) const {}
    __device__ __forceinline__ void done(const Unit&) const {}
};

__device__ __forceinline__ unsigned cvt_pk_bf16(float lo, float hi) { unsigned r; asm volatile("v_cvt_pk_bf16_f32 %0, %1, %2" : "=v"(r) : "v"(lo), "v"(hi)); return r; }
typedef float f32x2 __attribute__((ext_vector_type(2)));
__device__ __forceinline__ f32x2 gelu_pk(f32x2 v) {
    const f32x2 av = __builtin_elementwise_abs(v), d = av * 0.2316418882f + 1.0f;
    f32x2 t; t.x = __builtin_amdgcn_rcpf(d.x); t.y = __builtin_amdgcn_rcpf(d.y);
    f32x2 q = t * 0.5307027145f + (-0.7265760135f); q = q * t + 0.7107068705f; q = q * t + (-0.142248368f); q = q * t + 0.127414796f; q = q * t;
    const f32x2 s = (v * v) * (-0.72134752044f);
    f32x2 e; e.x = __builtin_amdgcn_exp2f(s.x); e.y = __builtin_amdgcn_exp2f(s.y);
    const f32x2 m = v * (q * e), r = v - m;
    f32x2 o; o.x = v.x < 0.f ? m.x : r.x; o.y = v.y < 0.f ? m.y : r.y; return o;
}

template <int ACT  > struct EpiBf16 {
    static constexpr bool PERM = true, AFTER_DRAIN = false; static_assert(ACT == 0 || ACT == 1, "EpiBf16: ACT is 0 (none) or 1 (gelu_pk)");
    bf16_t* O; int ldc; const float* bias; int split_cols; size_t split_stride; float scale0;
    __device__ __forceinline__ void operator()(const f32x4 (&acc)[2][2][4][2], const Unit& u, int wr, int wc, int fr, int fq) const {
        const int row0 = u.pm * BM + wr * 64 + fr; int colt = u.pn * BM; bf16_t* base = O;
        float sc = 1.f; if (split_cols) { const int t = colt / split_cols; base += (size_t)t * split_stride; colt -= t * split_cols; if (t == 0) sc = scale0; }
        const int col0 = colt + wc * 32 + 8 * fq, bcol0 = u.pn * BM + wc * 32 + 8 * fq;
        f32x4 bv[2][2];
#pragma unroll
        for (int bj = 0; bj < 2; ++bj)
#pragma unroll
            for (int n = 0; n < 2; ++n) bv[bj][n] = bias ? *(const f32x4*)(bias + bcol0 + bj * HALF + 4 * n) : (f32x4){0.f, 0.f, 0.f, 0.f};
#pragma unroll
        for (int ai = 0; ai < 2; ++ai)
#pragma unroll
            for (int m = 0; m < 4; ++m) { bf16_t* rowp = base + (size_t)(row0 + ai * HALF + m * 16) * ldc + col0;
#pragma unroll
                for (int bj = 0; bj < 2; ++bj) { f32x4 v0 = acc[ai][bj][m][0] + bv[bj][0], v1 = acc[ai][bj][m][1] + bv[bj][1];
                    if (ACT == 1) { f32x2 a = gelu_pk((f32x2){v0[0], v0[1]}), b = gelu_pk((f32x2){v0[2], v0[3]}), c = gelu_pk((f32x2){v1[0], v1[1]}), d = gelu_pk((f32x2){v1[2], v1[3]});
                        v0 = (f32x4){a.x, a.y, b.x, b.y}; v1 = (f32x4){c.x, c.y, d.x, d.y}; }
                    v0 = v0 * sc; v1 = v1 * sc; u32x4 w; w.x = cvt_pk_bf16(v0[0], v0[1]); w.y = cvt_pk_bf16(v0[2], v0[3]); w.z = cvt_pk_bf16(v1[0], v1[1]); w.w = cvt_pk_bf16(v1[2], v1[3]);
                    *(u32x4*)(rowp + bj * HALF) = w; } }
    }
};

struct EpiResGate {
    static constexpr bool PERM = false, AFTER_DRAIN = false;
    const float* xold; float* X; const float* gate;
    __device__ __forceinline__ void operator()(const f32x4 (&acc)[2][2][4][2], const Unit& u, int wr, int wc, int fr, int fq) const {
        const int col0 = u.pn * BM + wc * 32 + 4 * fq; const int b = (u.pm * BM) / SEQ;
        const float* gp = gate + (size_t)b * 6 * D + col0;
#pragma unroll
        for (int bj = 0; bj < 2; ++bj)
#pragma unroll
            for (int n = 0; n < 2; ++n) { const f32x4 gv = *(const f32x4*)(gp + bj * HALF + n * 16);
#pragma unroll
                for (int ai = 0; ai < 2; ++ai)
#pragma unroll
                    for (int m = 0; m < 4; ++m) { const size_t off = (size_t)(u.pm * BM + ai * HALF + wr * 64 + m * 16 + fr) * D + col0 + bj * HALF + n * 16;
                        const f32x4 xo = *(const f32x4*)(xold + off); *(f32x4*)(X + off) = xo + gv * acc[ai][bj][m][n]; } }
    }
};
template <class Epi, class Sched, bool ALIGN_EPI = false, bool SP2 = false>
__device__ __forceinline__ void gemm_phase(PG8_LAS unsigned char* lds, const Gemm g, const Sched& S, const Epi& E, int tid) {
    asm volatile("" : "+v"(tid));
    const int wid = __builtin_amdgcn_readfirstlane(tid >> 6), lane = tid & 63, wr = wid >> 2, wc = wid & 3, fr = lane & 15, fq = lane >> 4;
    const int K = g.K, nt = K / BK;
    unsigned voffA[2], voffB[2];
#pragma unroll
    for (int i = 0; i < 2; ++i) { int R, C; stage_rc(tid * 16 + i * 8192, R, C); const int Rb = Epi::PERM ? ((R & ~31) + perm32(R & 31)) : R;
        voffA[i] = (unsigned)(R * K + C) * 2u; voffB[i] = (unsigned)(Rb * K + C) * 2u; }
    const size_t kstep = (size_t)(BK * 2);
    const size_t hstep = (size_t)HALF * K * 2;
    const size_t tstep = 2 * hstep;
    const unsigned ldsw = (unsigned)wid * 1024u;
    const int aoff = lds_byte(wr * 64 + fr, fq * 8), boff = lds_byte(wc * 32 + fr, fq * 8);
#define PG8_SA(b, h) (((b) * 2 + (h)) * HTB)
#define PG8_SB(b, h) ((4 + (b) * 2 + (h)) * HTB)
#define PG8_STAGE(bufoff, gbase, voff) do { _Pragma("unroll") for (int _i = 0; _i < 2; ++_i) \
        __builtin_amdgcn_global_load_lds((const unsigned*)((const char*)(gbase) + (voff)[_i]), (PG8_LAS unsigned*)(lds + (bufoff) + ldsw + _i * 8192), 16, 0, 0); } while (0)
#define PG8_LDA(dst, b, h) do { _Pragma("unroll") for (int m = 0; m < 4; ++m) _Pragma("unroll") for (int k = 0; k < 2; ++k) dst[m][k] = *(const PG8_LAS bf16x8*)(lds + PG8_SA(b, h) + aoff + m * 2048 + k * 1024); } while (0)
#define PG8_LDB(dst, b, h) do { _Pragma("unroll") for (int n = 0; n < 2; ++n) _Pragma("unroll") for (int k = 0; k < 2; ++k) dst[n][k] = *(const PG8_LAS bf16x8*)(lds + PG8_SB(b, h) + boff + n * 2048 + k * 1024); } while (0)
#define PG8_MMA(ai, bj, At, Bt) do { __builtin_amdgcn_s_setprio(1); _Pragma("unroll") for (int m = 0; m < 4; ++m) _Pragma("unroll") for (int n = 0; n < 2; ++n) _Pragma("unroll") for (int k = 0; k < 2; ++k) \
        acc[ai][bj][m][n] = __builtin_amdgcn_mfma_f32_16x16x32_bf16(Bt[n][k], At[m][k], acc[ai][bj][m][n], 0, 0, 0); __builtin_amdgcn_s_setprio(0); } while (0)
#define PG8_WAIT_V(n) asm volatile("s_waitcnt vmcnt(" #n ")" ::: "memory")
#define PG8_WAIT_L(n) asm volatile("s_waitcnt lgkmcnt(" #n ")" ::: "memory")
#define PG8_BAR __builtin_amdgcn_s_barrier()
#define PG8_SCHED __builtin_amdgcn_sched_barrier(0)
    Unit cur, nxt; int ui = 0;
    if (!S.next(0, cur)) return;
    f32x4 acc[2][2][4][2];
#pragma unroll
    for (int a = 0; a < 2; ++a)
#pragma unroll
        for (int b = 0; b < 2; ++b)
#pragma unroll
            for (int m = 0; m < 4; ++m)
#pragma unroll
                for (int n = 0; n < 2; ++n) acc[a][b][m][n] = (f32x4){0.f, 0.f, 0.f, 0.f};
    bf16x8 At[4][2], B0[2][2], B1[2][2];
    const char* cA = (const char*)g.A + (size_t)cur.pm * tstep; const char* cB = (const char*)g.Bt + (size_t)cur.pn * tstep;
    S.a_ready(cur);
    if constexpr (SP2) {
        PG8_STAGE(PG8_SB(0, 0), cB, voffB); PG8_STAGE(PG8_SB(0, 1), cB + hstep, voffB); PG8_STAGE(PG8_SA(0, 0), cA, voffA); PG8_STAGE(PG8_SA(0, 1), cA + hstep, voffA);
        if (wr == 1) PG8_BAR;
        PG8_WAIT_V(2); PG8_BAR;
        PG8_STAGE(PG8_SB(1, 0), cB + kstep, voffB); PG8_STAGE(PG8_SA(1, 0), cA + kstep, voffA); PG8_STAGE(PG8_SB(1, 1), cB + hstep + kstep, voffB);
        PG8_WAIT_V(6); PG8_BAR;
    } else {
        PG8_STAGE(PG8_SB(0, 0), cB, voffB); PG8_STAGE(PG8_SA(0, 0), cA, voffA); PG8_STAGE(PG8_SB(0, 1), cB + hstep, voffB); PG8_STAGE(PG8_SA(0, 1), cA + hstep, voffA);
        if (wr == 1) PG8_BAR;
        PG8_WAIT_V(4); PG8_BAR;
        PG8_STAGE(PG8_SB(1, 0), cB + kstep, voffB); PG8_STAGE(PG8_SA(1, 0), cA + kstep, voffA); PG8_STAGE(PG8_SB(1, 1), cB + hstep + kstep, voffB);
        PG8_WAIT_V(6); PG8_BAR;
    }
    for (;;) {
        const bool has_next = S.next(ui + 1, nxt);
        const char* nA = has_next ? (const char*)g.A + (size_t)nxt.pm * tstep : cA; const char* nB = has_next ? (const char*)g.Bt + (size_t)nxt.pn * tstep : cB;
        for (int t = 0; t < nt; t += 2) {
            const bool last = (t == nt - 2);
            const char* a1 = cA + (size_t)(t + 1) * kstep;
            const char* a2 = last ? nA : cA + (size_t)(t + 2) * kstep; const char* b2 = last ? nB : cB + (size_t)(t + 2) * kstep;
            const char* a3 = a2 + kstep; const char* b3 = b2 + kstep;
            if (last && has_next) S.a_ready(nxt);
            if constexpr (SP2) {
            PG8_LDB(B0, 0, 0); PG8_LDB(B1, 0, 1); PG8_SCHED; PG8_LDA(At, 0, 0); PG8_STAGE(PG8_SA(1, 1), a1 + hstep, voffA);
            PG8_WAIT_V(8); PG8_WAIT_L(0); PG8_BAR; PG8_MMA(0, 0, At, B0); PG8_MMA(0, 1, At, B1); PG8_BAR; PG8_SCHED;
            PG8_LDA(At, 0, 1); PG8_STAGE(PG8_SB(0, 0), b2, voffB); PG8_STAGE(PG8_SB(0, 1), b2 + hstep, voffB); PG8_STAGE(PG8_SA(0, 0), a2, voffA);
            PG8_WAIT_V(8); PG8_WAIT_L(0); PG8_BAR; PG8_MMA(1, 0, At, B0); PG8_MMA(1, 1, At, B1); PG8_BAR; PG8_SCHED;
            PG8_LDB(B0, 1, 0); PG8_LDB(B1, 1, 1); PG8_SCHED; PG8_LDA(At, 1, 0); PG8_STAGE(PG8_SA(0, 1), a2 + hstep, voffA);
            PG8_WAIT_V(8); PG8_WAIT_L(0); PG8_BAR; PG8_MMA(0, 0, At, B0); PG8_MMA(0, 1, At, B1); PG8_BAR; PG8_SCHED;
            PG8_LDA(At, 1, 1); PG8_STAGE(PG8_SB(1, 0), b3, voffB); PG8_STAGE(PG8_SB(1, 1), b3 + hstep, voffB); PG8_STAGE(PG8_SA(1, 0), a3, voffA);
            PG8_WAIT_V(8); PG8_WAIT_L(0); PG8_BAR; PG8_MMA(1, 0, At, B0); PG8_MMA(1, 1, At, B1); PG8_BAR; PG8_SCHED;
            } else {
            PG8_LDB(B0, 0, 0); PG8_SCHED; PG8_LDA(At, 0, 0); PG8_STAGE(PG8_SA(1, 1), a1 + hstep, voffA);
            PG8_WAIT_L(8); PG8_BAR; PG8_WAIT_L(0); PG8_MMA(0, 0, At, B0); PG8_BAR; PG8_SCHED;
            PG8_LDB(B1, 0, 1); PG8_STAGE(PG8_SB(0, 0), b2, voffB);
            PG8_BAR; PG8_WAIT_L(0); PG8_MMA(0, 1, At, B1); PG8_BAR;
            PG8_LDA(At, 0, 1); PG8_STAGE(PG8_SA(0, 0), a2, voffA);
            PG8_BAR; PG8_WAIT_L(0); PG8_MMA(1, 0, At, B0); PG8_BAR; PG8_SCHED;
            PG8_STAGE(PG8_SB(0, 1), b2 + hstep, voffB);
            PG8_WAIT_V(6); PG8_BAR; PG8_MMA(1, 1, At, B1); PG8_BAR;
            PG8_LDB(B0, 1, 0); PG8_SCHED; PG8_LDA(At, 1, 0); PG8_STAGE(PG8_SA(0, 1), a2 + hstep, voffA);
            PG8_WAIT_L(8); PG8_BAR; PG8_WAIT_L(0); PG8_MMA(0, 0, At, B0); PG8_BAR; PG8_SCHED;
            PG8_LDB(B1, 1, 1); PG8_STAGE(PG8_SB(1, 0), b3, voffB);
            PG8_BAR; PG8_WAIT_L(0); PG8_MMA(0, 1, At, B1); PG8_BAR;
            PG8_LDA(At, 1, 1); PG8_STAGE(PG8_SA(1, 0), a3, voffA);
            PG8_BAR; PG8_WAIT_L(0); PG8_MMA(1, 0, At, B0); PG8_BAR; PG8_SCHED;
            PG8_STAGE(PG8_SB(1, 1), b3 + hstep, voffB);
            PG8_WAIT_V(6); PG8_BAR; PG8_MMA(1, 1, At, B1); PG8_BAR;
            }
        }
        if constexpr (ALIGN_EPI) { if (wr == 0) PG8_BAR; }
        if constexpr (!Epi::AFTER_DRAIN) { E(acc, cur, wr, wc, fr, fq); S.done(cur); }
        if (!has_next) break;
#pragma unroll
        for (int a = 0; a < 2; ++a)
#pragma unroll
            for (int b = 0; b < 2; ++b)
#pragma unroll
                for (int m = 0; m < 4; ++m)
#pragma unroll
                    for (int n = 0; n < 2; ++n) acc[a][b][m][n] = (f32x4){0.f, 0.f, 0.f, 0.f};
        cur = nxt; cA = nA; cB = nB; ++ui;
        if constexpr (ALIGN_EPI) { if (wr == 1) PG8_BAR; }
    }
    PG8_WAIT_V(0);
    if constexpr (!ALIGN_EPI) { if (wr == 0) PG8_BAR; }
    PG8_BAR;
    if constexpr (Epi::AFTER_DRAIN) { E.fused(acc, cur, wr, wc, fr, fq, lds, wid, lane); S.done(cur); }
#undef PG8_SA
#undef PG8_SB
#undef PG8_STAGE
#undef PG8_LDA
#undef PG8_LDB
#undef PG8_MMA
#undef PG8_WAIT_V
#undef PG8_WAIT_L
#undef PG8_BAR
#undef PG8_SCHED
}
}

#define LAS __attribute__((address_space(3)))
constexpr int NWAVES = 8, NTHR = 512;
constexpr int LDS_BYTES = 147456;
constexpr int NPH = 21;
typedef float f32x4 __attribute__((ext_vector_type(4)));
typedef unsigned u32x4 __attribute__((ext_vector_type(4)));

struct Args { const float* in[30]; float* out; unsigned char* ws; int ph_lo, ph_hi; };

__device__ __forceinline__ unsigned pk2(float lo, float hi) { return (unsigned)f2bf(lo) | ((unsigned)f2bf(hi) << 16); }

__device__ __forceinline__ void p0_transpose_item(const float* W, int K, int N, bf16* WT, int row_off, LAS float* scr, int item, int lane) {
    const int nblk = N / 32, kb = item / nblk, nb = item % nblk, k0 = 64 * kb, n0 = 32 * nb;
#pragma unroll 8
    for (int i = 0; i < 32; ++i) { const int kk = 2 * i + (lane >> 5); scr[kk * 33 + (lane & 31)] = W[(size_t)(k0 + kk) * N + n0 + (lane & 31)]; }
    asm volatile("s_waitcnt lgkmcnt(0)" ::: "memory");
    const int c = lane & 7;
#pragma unroll
    for (int j = 0; j < 4; ++j) { const int n = (lane >> 3) + 8 * j; const LAS float* s = scr + (8 * c) * 33 + n;
        u32x4 o; o.x = pk2(s[0 * 33], s[1 * 33]); o.y = pk2(s[2 * 33], s[3 * 33]); o.z = pk2(s[4 * 33], s[5 * 33]); o.w = pk2(s[6 * 33], s[7 * 33]);
        *(u32x4*)(WT + (size_t)(row_off + n0 + n) * K + k0 + 8 * c) = o; }
    asm volatile("s_waitcnt lgkmcnt(0)" ::: "memory");
}

__device__ __forceinline__ void norm_mod_row(const float* xr, const float* gamma, const float* sh, const float* sc, bf16* orow, int lane) {
    f32x4 v[4]; float ss = 0.f;
#pragma unroll
    for (int j = 0; j < 4; ++j) { v[j] = *(const f32x4*)(xr + j * 256 + lane * 4); ss += (v[j].x * v[j].x + v[j].y * v[j].y) + (v[j].z * v[j].z + v[j].w * v[j].w); }
    const float rs = rsqrtf(wave_sum(ss, lane) * (1.f / D) + NORM_EPS);
#pragma unroll
    for (int j = 0; j < 4; ++j) { const int d = j * 256 + lane * 4; const f32x4 g = *(const f32x4*)(gamma + d), a = *(const f32x4*)(sc + d), s = *(const f32x4*)(sh + d);
        const f32x4 y = v[j] * rs * g * (a + 1.f) + s; uint2 o; o.x = pk2(y.x, y.y); o.y = pk2(y.z, y.w); *(uint2*)(orow + d) = o; }
}


#define XB_TMO      128
#define XB_XCNT(j)  (256  + 64 * (j))
#define XB_XSUB(j)  (1280 + 64 * (j))
#define XB_XGEN(j)  (2304 + 64 * (j))
#define XB_TOP      3328
#define XB_TOPGEN   3392
#define XCD_BAR_WORDS 3456
#define XB_SPIN_CAP (1u << 18)

__device__ __forceinline__ unsigned xb_ld(unsigned* p)              { return __hip_atomic_load(p, __ATOMIC_RELAXED, __HIP_MEMORY_SCOPE_AGENT); }
__device__ __forceinline__ unsigned xb_add(unsigned* p, unsigned v) { return __hip_atomic_fetch_add(p, v, __ATOMIC_RELAXED, __HIP_MEMORY_SCOPE_AGENT); }
__device__ __forceinline__ unsigned xb_xcc_id() { return (unsigned)__builtin_amdgcn_s_getreg((3 << 11) | 20) & 0xFu; }
#define XB_SPIN(cond, bar) do { unsigned _sp = 0; while (cond) { __builtin_amdgcn_s_sleep(1); \
    if ((++_sp & 255u) == 0u) { if (xb_ld(&(bar)[XB_TMO])) break; if (_sp > XB_SPIN_CAP) { atomicAdd(&(bar)[XB_TMO], 1u); break; } } } } while (0)

struct XcdBarrier {
    unsigned* bar; unsigned x; int w0;
    volatile __attribute__((address_space(3))) unsigned* st;
};

__device__ __forceinline__ XcdBarrier xcd_barrier_post(unsigned* bar, volatile __attribute__((address_space(3))) unsigned* st) {
    XcdBarrier b; b.bar = bar; b.x = xb_xcc_id(); b.st = st; b.w0 = __builtin_amdgcn_readfirstlane((int)threadIdx.x >> 6);
    if (threadIdx.x == 0) (void)xb_add(&bar[XB_XCNT(b.x)], 1u);
    return b;
}
__device__ __forceinline__ void xcd_barrier_complete(unsigned* bar, unsigned x, unsigned& nloc, unsigned& nx) {
    const unsigned G = gridDim.x * gridDim.y * gridDim.z;
    unsigned sum, cnt, mine, sp = 0u;
    for (;;) {
        sum = 0u; cnt = 0u; mine = 0u;
#pragma unroll
        for (unsigned j = 0; j < 16; ++j) { const unsigned c = xb_ld(&bar[XB_XCNT(j)]); sum += c; cnt += (c > 0u) ? 1u : 0u; }
        mine = xb_ld(&bar[XB_XCNT(x)]);
        if (sum == G) break;
        __builtin_amdgcn_s_sleep(1);
        if ((++sp & 255u) == 0u) { if (xb_ld(&bar[XB_TMO])) break; if (sp > XB_SPIN_CAP) { atomicAdd(&bar[XB_TMO], 1u); break; } }
    }
    nloc = mine > 0u ? mine : 1u; nx = cnt > 0u ? cnt : 1u;
}

template <bool FIRST> __device__ __forceinline__ void xcd_barrier(const XcdBarrier& b) {
    asm volatile("s_waitcnt vmcnt(0)" ::: "memory");
    __syncthreads();
    int lid_; asm volatile("v_mbcnt_lo_u32_b32 %0, -1, 0\n\tv_mbcnt_hi_u32_b32 %0, -1, %0" : "=v"(lid_));
    if (b.w0 == 0 && lid_ == 0) {
        unsigned* bar = b.bar;
        __builtin_amdgcn_s_waitcnt(0);
        unsigned nloc = b.st[0], nx = b.st[1];
        if (FIRST && nloc == 0u) { xcd_barrier_complete(bar, b.x, nloc, nx); b.st[0] = nloc; b.st[1] = nx; }
        const unsigned old = xb_add(&bar[XB_XSUB(b.x)], 1u);
        const unsigned gen = old / nloc;
        if (old + 1u == (gen + 1u) * nloc) {
            __builtin_amdgcn_fence(__ATOMIC_RELEASE, "agent");
            asm volatile("s_waitcnt vmcnt(0)" ::: "memory");
            const unsigned og = xb_add(&bar[XB_TOP], 1u);
            const unsigned tg = og / nx;
            if (og + 1u == (tg + 1u) * nx) xb_add(&bar[XB_TOPGEN], 1u);
            else XB_SPIN(xb_ld(&bar[XB_TOPGEN]) == tg, bar);
            __builtin_amdgcn_fence(__ATOMIC_ACQUIRE, "agent");
            xb_add(&bar[XB_XGEN(b.x)], 1u);
            asm volatile("s_waitcnt vmcnt(0)" ::: "memory");
        } else {
            XB_SPIN(xb_ld(&bar[XB_XGEN(b.x)]) == gen, bar);
            __builtin_amdgcn_fence(__ATOMIC_ACQUIRE, "agent");
            asm volatile("s_waitcnt vmcnt(0)" ::: "memory");
        }
    }
    __syncthreads();
}


__device__ __forceinline__ unsigned mono_u32(float f) { unsigned u = __float_as_uint(f); return (u & 0x80000000u) ? ~u : (u | 0x80000000u); }
__device__ __forceinline__ float demono_u32(unsigned u) { return __uint_as_float((u & 0x80000000u) ? (u & 0x7FFFFFFFu) : ~u); }
__device__ __forceinline__ unsigned pack_key7(float f, int idx) { return (mono_u32(f) & 0xFFFFFF80u) | (unsigned)(127 - idx); }
__device__ __forceinline__ float unpack_key7(unsigned k) { return demono_u32((k & 0xFFFFFF80u) | 0x40u); }
__device__ __forceinline__ float unpack_key8(unsigned k) { return demono_u32((k & 0xFFFFFF00u) | 0x80u); }
__device__ __forceinline__ void ce_desc(unsigned& a, unsigned& b) { const unsigned hi = a > b ? a : b, lo = a > b ? b : a; a = hi; b = lo; }
__device__ __forceinline__ void sort16_desc(unsigned* v) {
#pragma unroll
    for (int k = 2; k <= 16; k <<= 1)
#pragma unroll
        for (int j = k >> 1; j > 0; j >>= 1)
#pragma unroll
            for (int i = 0; i < 16; ++i) { const int l = i ^ j; if (l > i) { if ((i & k) == 0) ce_desc(v[i], v[l]); else ce_desc(v[l], v[i]); } }
}
__device__ __forceinline__ void bmerge16_desc(unsigned* v) {
#pragma unroll
    for (int j = 8; j > 0; j >>= 1)
#pragma unroll
        for (int i = 0; i < 16; ++i) { const int l = i ^ j; if (l > i) ce_desc(v[i], v[l]); }
}
__device__ __forceinline__ void merge_top16(unsigned* a, const unsigned* b) {
#pragma unroll
    for (int i = 0; i < 16; ++i) { const unsigned o = b[15 - i]; a[i] = a[i] > o ? a[i] : o; }
    bmerge16_desc(a);
}
__device__ __forceinline__ void stage2_cands(const unsigned* s0, const unsigned* s1, int hh, unsigned* c) {
    float A[16], B[16];
#pragma unroll
    for (int i = 0; i < 16; ++i) { const float f0 = unpack_key7(s0[i]), f1 = unpack_key7(s1[i]); A[i] = hh ? f1 : f0; B[i] = hh ? f0 : f1; }
    int n = 0;
#pragma unroll
    for (int i = 0; i < 4; ++i)
#pragma unroll
        for (int j = i; j < 16; ++j) { if ((i + 1) * (j + 1) > 16) continue;
            const float val = A[i] + B[j]; const unsigned id = hh ? (unsigned)((j << 4) | i) : (unsigned)((i << 4) | j);
            unsigned key = (mono_u32(val) & 0xFFFFFF00u) | id; if (hh && i == j) key = 0u; c[n++] = key; }
#pragma unroll
    for (; n < 32; ++n) c[n] = 0u;
}

typedef short bf16x8_t __attribute__((ext_vector_type(8)));
typedef float f32x16 __attribute__((ext_vector_type(16)));
__device__ __forceinline__ float gelu_erf(float a) { return 0.5f * a * (1.f + erff(a * 0.70710678118654752f)); }


typedef __attribute__((address_space(3))) bf16 lbf16;
typedef float cvt_f32x2 __attribute__((ext_vector_type(2))); typedef __bf16 cvt_bf16x2 __attribute__((ext_vector_type(2)));
__device__ __forceinline__ unsigned cvtpk(float lo, float hi) { const cvt_f32x2 v = {lo, hi}; const cvt_bf16x2 b = __builtin_convertvector(v, cvt_bf16x2); return __builtin_bit_cast(unsigned, b); }
__device__ __forceinline__ f32x16 mm32(bf16x8_t a, bf16x8_t b, f32x16 c) { return __builtin_amdgcn_mfma_f32_32x32x16_bf16(a, b, c, 0, 0, 0); }
__device__ __forceinline__ bf16x8_t frag_from_u32x4(unsigned x, unsigned y, unsigned z, unsigned w) { typedef unsigned u4 __attribute__((ext_vector_type(4))); u4 t = {x, y, z, w}; return __builtin_bit_cast(bf16x8_t, t); }
template <int S> __device__ __forceinline__ bf16x8_t accop(const f32x16& z) {
    return frag_from_u32x4(cvtpk(z[8 * S], z[8 * S + 1]), cvtpk(z[8 * S + 2], z[8 * S + 3]), cvtpk(z[8 * S + 4], z[8 * S + 5]), cvtpk(z[8 * S + 6], z[8 * S + 7])); }
template <int S> __device__ __forceinline__ bf16x8_t ldpermcol(const lbf16* a, int col, int hh) {
    const lbf16* p = a + (16 * S + 4 * hh) * 72 + col;
    const unsigned e0 = p[0], e1 = p[72], e2 = p[144], e3 = p[216], e4 = p[8 * 72], e5 = p[9 * 72], e6 = p[10 * 72], e7 = p[11 * 72];
    return frag_from_u32x4(e0 | (e1 << 16), e2 | (e3 << 16), e4 | (e5 << 16), e6 | (e7 << 16)); }
__device__ __forceinline__ bf16x8_t ldrow(const lbf16* a, int row, int ks, int hh) { return *(const __attribute__((address_space(3))) bf16x8_t*)(a + row * 72 + ks * 16 + 8 * hh); }
__device__ __forceinline__ int rowidx(int e, int hh) { return (e & 3) + 8 * (e >> 2) + 4 * hh; }

__device__ __forceinline__ void convert_tables_fp8(const float* pu, const float* pv, unsigned char* u8, unsigned char* v8, float* usc, float* vsc, int l, int wv, int nw, int lane) {
    for (int rr0 = wv * 2; rr0 < 2 * NEXP; rr0 += nw * 2) {
        f32x4 v[2][4]; float m[2];
#pragma unroll
        for (int rr = 0; rr < 2; ++rr) { const int q = rr0 + rr; const size_t row = (size_t)l * NEXP + (q < NEXP ? q : q - NEXP); const float* sp_ = (q < NEXP ? pu : pv) + row * D + lane * 16;
#pragma unroll
            for (int k = 0; k < 4; ++k) v[rr][k] = *(const f32x4*)(sp_ + k * 4); }
#pragma unroll
        for (int rr = 0; rr < 2; ++rr) { float mm = 0.f;
#pragma unroll
            for (int k = 0; k < 4; ++k) mm = fmaxf(fmaxf(mm, fmaxf(fabsf(v[rr][k].x), fabsf(v[rr][k].y))), fmaxf(fabsf(v[rr][k].z), fabsf(v[rr][k].w)));
#pragma unroll
            for (int o = 1; o < 64; o <<= 1) mm = fmaxf(mm, shflx(mm, lane, o));
            m[rr] = mm; }
#pragma unroll
        for (int rr = 0; rr < 2; ++rr) { const int q = rr0 + rr; const size_t row = (size_t)l * NEXP + (q < NEXP ? q : q - NEXP); const float sc = m[rr] > 0.f ? 448.f / m[rr] : 1.f;
            u32x4 o; int w;
            w = 0; w = __builtin_amdgcn_cvt_pk_fp8_f32(v[rr][0].x * sc, v[rr][0].y * sc, w, false); w = __builtin_amdgcn_cvt_pk_fp8_f32(v[rr][0].z * sc, v[rr][0].w * sc, w, true); o.x = (unsigned)w;
            w = 0; w = __builtin_amdgcn_cvt_pk_fp8_f32(v[rr][1].x * sc, v[rr][1].y * sc, w, false); w = __builtin_amdgcn_cvt_pk_fp8_f32(v[rr][1].z * sc, v[rr][1].w * sc, w, true); o.y = (unsigned)w;
            w = 0; w = __builtin_amdgcn_cvt_pk_fp8_f32(v[rr][2].x * sc, v[rr][2].y * sc, w, false); w = __builtin_amdgcn_cvt_pk_fp8_f32(v[rr][2].z * sc, v[rr][2].w * sc, w, true); o.z = (unsigned)w;
            w = 0; w = __builtin_amdgcn_cvt_pk_fp8_f32(v[rr][3].x * sc, v[rr][3].y * sc, w, false); w = __builtin_amdgcn_cvt_pk_fp8_f32(v[rr][3].z * sc, v[rr][3].w * sc, w, true); o.w = (unsigned)w;
            *(u32x4*)((q < NEXP ? u8 : v8) + row * D + lane * 16) = o;
            if (lane == 0) (q < NEXP ? usc : vsc)[row] = m[rr] > 0.f ? m[rr] * (1.f / 448.f) : 1.f; }
    }
}

__global__ void __launch_bounds__(NTHR, 2) mega(Args args) {
    extern __shared__ __attribute__((aligned(16))) unsigned char lds_raw[];
    LAS unsigned char* lds = (LAS unsigned char*)lds_raw;
    const int G = gridDim.x, bx = blockIdx.x, NGW = G * NWAVES;
    const int wave0 = __builtin_amdgcn_readfirstlane((int)threadIdx.x >> 6);
    typedef const unsigned char __attribute__((address_space(4))) kbyte;
#define PHASE_IDS int tid; asm volatile("v_mbcnt_lo_u32_b32 %0, -1, 0\n\tv_mbcnt_hi_u32_b32 %0, -1, %0" : "=v"(tid)); tid += wave0 * 64;     const int lane = tid & 63, wave = __builtin_amdgcn_readfirstlane(tid >> 6), gw = bx * NWAVES + wave; (void)lane; (void)gw; \
    kbyte* kp = (kbyte*)__builtin_amdgcn_kernarg_segment_ptr(); asm volatile("" : "+s"(kp)); \
    unsigned char* const ws = (unsigned char*)*(__attribute__((address_space(1))) unsigned char* const __attribute__((address_space(4)))*)(kp + 31 * 8); float* const X = (float*)*(__attribute__((address_space(1))) float* const __attribute__((address_space(4)))*)(kp + 30 * 8); (void)ws; (void)X;
#define INP(i) ((const float*)(*(const __attribute__((address_space(1))) float* const __attribute__((address_space(4)))*)(kp + (i) * 8)))
#define MOD ((float*)(ws + WS_MOD))
#define H ((bf16*)(ws + WS_H))
#define PROJ ((bf16*)(ws + WS_PROJ))
#define Q ((bf16*)(ws + WS_Q))
#define MIX ((bf16*)(ws + WS_MIX))
#define Rb ((bf16*)(ws + WS_R))
#define Kb ((bf16*)(ws + WS_K))
#define V0 ((bf16*)(ws + WS_V0))
#define V1 ((bf16*)(ws + WS_V1))
#define KKb ((bf16*)(ws + WS_KK))
#define Bb ((bf16*)(ws + WS_B))
#define Gb ((bf16*)(ws + WS_G))
#define BGb ((bf16*)(ws + WS_BG))
#define Wd ((float*)(ws + WS_W))
#define Y ((float*)(ws + WS_Y))
#define QB ((float*)(ws + WS_QB))
#define SH ((float*)(ws + WS_SH))
#define WUPT ((bf16*)(ws + WS_LORA))
#define AUPT ((bf16*)(ws + WS_LORA + 131072))
#define GUPT ((bf16*)(ws + WS_LORA + 262144))
#define VUPT ((bf16*)(ws + WS_LORA + 524288))
#define INVN ((float*)(ws + WS_INVN))
#define BSUM ((float*)(ws + WS_BSUM))
#define SCN ((unsigned char*)(ws + WS_SCN))
#define IDX ((int*)(ws + WS_IDX))
#define GATE ((float*)(ws + WS_GATE))
#define WinT ((bf16*)(ws + WS_WIN_T))
#define WoutT ((bf16*)(ws + WS_WOUT_T))
#define PqT ((bf16*)(ws + WS_PQ_T))
#define KEYS ((bf16*)(ws + WS_KEYS))
#define U8 ((unsigned char*)(ws + WS_U))
#define V8 ((unsigned char*)(ws + WS_V))
#define USc ((float*)(ws + WS_US))
#define VSc ((float*)(ws + WS_VS))
    const int lo = args.ph_lo, hi = args.ph_hi;
    { volatile LAS unsigned* misc = (volatile LAS unsigned*)(lds + LDS_BYTES - 64); if (threadIdx.x < 4) misc[threadIdx.x] = 0u; __syncthreads(); }
    const XcdBarrier xbar = xcd_barrier_post((unsigned*)(args.ws) + 4096, (volatile LAS unsigned*)(lds + LDS_BYTES - 64));
#define IN(k) (lo <= (k) && (k) < hi)
#ifndef REP_PHASE
#define REP_PHASE (-1)
#endif
#define REPS(k) ((k) == REP_PHASE ? 3 : 1)
#define SEAM(k) do { if (IN(k) && IN((k) + 1)) { if ((k) == 0) cg::this_grid().sync(); else { XcdBarrier xb_ = xbar; asm volatile("" : "+s"(xb_.bar)); if ((k) == 1) xcd_barrier<true>(xb_); else xcd_barrier<false>(xb_); } } } while (0)

    if (IN(0)) { PHASE_IDS
        { LAS float* ca = (LAS float*)lds; LAS float* red = (LAS float*)(lds + 16384);
          const float* c = INP(1); const float* ada_w = INP(2); const float* ada_b = INP(3);
          bool have = false;
          for (int it = bx; it < 96; it += G) {
              if (!have) { for (int i = tid; i < BATCH * D; i += NTHR) { const float v = c[i]; ca[i] = v / (1.f + expf(-v)); } have = true; __syncthreads(); }
              const int l = it / 48, n = (it % 48) * 128 + (tid & 127), kq = tid >> 7;
              const float* w = ada_w + (size_t)l * D * 6 * D + (size_t)(kq * 256) * 6 * D + n;
              float a0 = 0.f, a1 = 0.f, a2 = 0.f, a3 = 0.f;
#pragma unroll 32
              for (int k = 0; k < 256; ++k) { const float wv = w[(size_t)k * 6 * D]; const int kk = kq * 256 + k; a0 += ca[kk] * wv; a1 += ca[D + kk] * wv; a2 += ca[2 * D + kk] * wv; a3 += ca[3 * D + kk] * wv; }
              red[(kq * 4 + 0) * 128 + (tid & 127)] = a0; red[(kq * 4 + 1) * 128 + (tid & 127)] = a1; red[(kq * 4 + 2) * 128 + (tid & 127)] = a2; red[(kq * 4 + 3) * 128 + (tid & 127)] = a3;
              __syncthreads();
              { const int b = tid >> 7, col = tid & 127, nn = (it % 48) * 128 + col;
                const float s = red[(0 * 4 + b) * 128 + col] + red[(1 * 4 + b) * 128 + col] + red[(2 * 4 + b) * 128 + col] + red[(3 * 4 + b) * 128 + col];
                MOD[(size_t)l * BATCH * 6 * D + (size_t)b * 6 * D + nn] = s + ada_b[l * 6 * D + nn]; }
              __syncthreads();
          }
          __syncthreads(); }
        { LAS float* scr = (LAS float*)(lds + wave * 16384);
          constexpr int I_IN = (D / 64) * (IN_COLS / 32), I_VR = (D / 64) * (MVL / 32), I_OUT = (D / 64) * (D / 32), I_PQ = (D / 64) * (PH * PQ / 32);
          constexpr int NIT = 2 * I_IN + I_VR + 2 * I_OUT + 2 * I_PQ;
          for (int it = gw; it < NIT; it += NGW) { int r = it;
              if (r < 2 * I_IN) { const int l = r / I_IN; p0_transpose_item(INP(5) + (size_t)l * D * IN_COLS, D, IN_COLS, WinT + (size_t)l * LDP * D, 0, scr, r % I_IN, lane); continue; } r -= 2 * I_IN;
              if (r < I_VR) { p0_transpose_item(INP(12), D, MVL, WinT + (size_t)1 * LDP * D, IN_COLS, scr, r, lane); continue; } r -= I_VR;
              if (r < 2 * I_OUT) { const int l = r / I_OUT; p0_transpose_item(INP(23) + (size_t)l * D * D, D, D, WoutT + (size_t)l * D * D, 0, scr, r % I_OUT, lane); continue; } r -= 2 * I_OUT;
              { const int l = r / I_PQ; p0_transpose_item(INP(25) + (size_t)l * D * PH * PQ, D, PH * PQ, PqT + (size_t)l * PH * PQ * D, 0, scr, r % I_PQ, lane); } }
          for (int it = gw; it < 2 * 16 + 2 * 16 + 2 * 32; it += NGW) { int r = it;
              if (r < 32) { const int l = r / 16; p0_transpose_item(INP(8) + (size_t)l * DL * RW, DL, RW, WUPT + (size_t)l * RW * DL, 0, scr, r % 16, lane); continue; } r -= 32;
              if (r < 32) { const int l = r / 16; p0_transpose_item(INP(10) + (size_t)l * AL * RW, AL, RW, AUPT + (size_t)l * RW * AL, 0, scr, r % 16, lane); continue; } r -= 32;
              { const int l = r / 32; p0_transpose_item(INP(11) + (size_t)l * GL * RW, GL, RW, GUPT + (size_t)l * RW * GL, 0, scr, r % 32, lane); } }
          { const float* vu = INP(15); for (int e = bx * NTHR + tid; e < MVL * RW; e += G * NTHR) { const int n = e >> 5, k = e & 31; VUPT[e] = f2bf(vu[k * RW + n]); } } }
        { const size_t gt = (size_t)bx * NTHR + tid, NT = (size_t)G * NTHR;
          constexpr size_t NK8 = (size_t)2 * PH * 2 * NKEYS * PHALF / 8;
          const float* src = INP(26); bf16* dst = KEYS;
          for (size_t i = gt; i < NK8; i += NT) {
              const f32x4 a = *(const f32x4*)(src + i * 8), b = *(const f32x4*)(src + i * 8 + 4);
              u32x4 o; o.x = pk2(a.x, a.y); o.y = pk2(a.z, a.w); o.z = pk2(b.x, b.y); o.w = pk2(b.z, b.w); *(u32x4*)(dst + i * 8) = o; }
        }
    }
    SEAM(0);

#pragma unroll
    for (int l = 0; l < DEPTH; ++l) {
        const int pb = 1 + 10 * l;
#define modl (MOD + (size_t)l * BATCH * 6 * D)
#define xin (l == 0 ? INP(0) : (const float*)X)
        if (l == 0 && IN(pb + 0)) { PHASE_IDS const float* gamma = INP(4) + l * D;
            for (int row = gw; row < T; row += NGW) { const int b = row / SEQ; norm_mod_row(xin + (size_t)row * D, gamma, modl + (size_t)b * 6 * D, modl + (size_t)b * 6 * D + D, H + (size_t)row * D, lane); } }
        SEAM(pb + 0);
        if (IN(pb + 1)) { PHASE_IDS const int N1 = l == 0 ? IN_COLS : LDP;
            pg8::Gemm g{H, WinT + (size_t)l * LDP * D, T, N1, D}; pg8::StaticOrder S; S.init(T, N1, G, bx);
            pg8::EpiBf16<0> E{PROJ, LDP, nullptr, 0, 0, 1.f};
            pg8::gemm_phase<pg8::EpiBf16<0>, pg8::StaticOrder, true, true>(lds, g, S, E, tid); }
        SEAM(pb + 1);

        if (IN(pb + 2)) { PHASE_IDS
            constexpr int LST = 296;
            LAS bf16* lin = (LAS bf16*)lds;
            const float* mu = INP(6) + l * RWKV_COLS; const float* vmu = INP(13);
            const float* w0p = INP(7) + l * RW; const float* a0p = INP(9) + l * RW; const float* kkp = INP(16) + l * RW; const float* kap = INP(17) + l * RW; const float* rkp = INP(18) + l * RW; const float* v0p = INP(14);
            const bf16* wupT = WUPT + (size_t)l * RW * DL; const bf16* aupT = AUPT + (size_t)l * RW * AL; const bf16* gupT = GUPT + (size_t)l * RW * GL; const bf16* vupT = VUPT;
            bf16* Vl = l == 0 ? V0 : V1;
            const int r32 = lane & 31, hh = lane >> 5, h = wave;
            for (int tile = bx; tile < T / 32; tile += G) {
                const int t0 = tile * 32;
                __syncthreads();
                for (int c8 = tid; c8 < 32 * 36; c8 += NTHR) {
                    const int tok = c8 / 36, jc = c8 % 36, t = t0 + tok, sq = t % SEQ;
                    u32x4 o = {0u, 0u, 0u, 0u};
                    if (jc < 32 || l > 0) {
                        const int col = jc < 32 ? 3 * RW + jc * 8 : IN_COLS + (jc - 32) * 8;
                        const u32x4 cu = *(const u32x4*)(PROJ + (size_t)t * LDP + col); u32x4 pv = {0u, 0u, 0u, 0u}; if (sq > 0) pv = *(const u32x4*)(PROJ + (size_t)(t - 1) * LDP + col);
                        const float* mp = jc < 32 ? mu + col : vmu + (jc - 32) * 8; const f32x4 m0 = *(const f32x4*)mp, m1 = *(const f32x4*)(mp + 4);
                        float x[8]; const unsigned cw[4] = {cu.x, cu.y, cu.z, cu.w}, pw[4] = {pv.x, pv.y, pv.z, pv.w}; const float mm[8] = {m0.x, m0.y, m0.z, m0.w, m1.x, m1.y, m1.z, m1.w};
#pragma unroll
                        for (int i = 0; i < 4; ++i) { const float c0 = __uint_as_float(cw[i] << 16), c1 = __uint_as_float(cw[i] & 0xffff0000u), p0 = __uint_as_float(pw[i] << 16), p1 = __uint_as_float(pw[i] & 0xffff0000u);
                            x[2 * i] = c0 + (p0 - c0) * mm[2 * i]; x[2 * i + 1] = c1 + (p1 - c1) * mm[2 * i + 1]; }
                        if (jc < 8) {
#pragma unroll
                            for (int i = 0; i < 8; ++i) { const float e2 = __expf(-2.f * fabsf(x[i])); const float th = (1.f - e2) * __builtin_amdgcn_rcpf(1.f + e2); x[i] = x[i] < 0.f ? -th : th; } }
                        else if (jc >= 16 && jc < 32) {
#pragma unroll
                            for (int i = 0; i < 8; ++i) x[i] = __builtin_amdgcn_rcpf(1.f + __expf(-x[i])); }
                        o.x = pk2(x[0], x[1]); o.y = pk2(x[2], x[3]); o.z = pk2(x[4], x[5]); o.w = pk2(x[6], x[7]);
                    }
                    *(LAS u32x4*)(lin + tok * LST + jc * 8) = o;
                }
                __syncthreads();
                float ssq[16], bsm[16];
#pragma unroll
                for (int e = 0; e < 16; ++e) { ssq[e] = 0.f; bsm[e] = 0.f; }
                const bool first = (t0 % SEQ) == 0;
#pragma unroll 1
                for (int rt = 0; rt < 2; ++rt) {
                    f32x16 accW, accA, accG, accV;
#pragma unroll
                    for (int e = 0; e < 16; ++e) { accW[e] = 0.f; accA[e] = 0.f; accG[e] = 0.f; accV[e] = 0.f; }
                    const int c = h * HS + rt * 32 + r32;
                    const LAS bf16* lrow = lin + r32 * LST + 8 * hh;
#pragma unroll
                    for (int ks = 0; ks < 4; ++ks) { const bf16x8_t wv = *(const bf16x8_t*)(wupT + (size_t)c * DL + ks * 16 + 8 * hh); const bf16x8_t xq = *(const LAS bf16x8_t*)(lrow + ks * 16); accW = __builtin_amdgcn_mfma_f32_32x32x16_bf16(xq, wv, accW, 0, 0, 0); }
#pragma unroll
                    for (int ks = 0; ks < 4; ++ks) { const bf16x8_t wv = *(const bf16x8_t*)(aupT + (size_t)c * AL + ks * 16 + 8 * hh); const bf16x8_t xq = *(const LAS bf16x8_t*)(lrow + 64 + ks * 16); accA = __builtin_amdgcn_mfma_f32_32x32x16_bf16(xq, wv, accA, 0, 0, 0); }
#pragma unroll
                    for (int ks = 0; ks < 8; ++ks) { const bf16x8_t wv = *(const bf16x8_t*)(gupT + (size_t)c * GL + ks * 16 + 8 * hh); const bf16x8_t xq = *(const LAS bf16x8_t*)(lrow + 128 + ks * 16); accG = __builtin_amdgcn_mfma_f32_32x32x16_bf16(xq, wv, accG, 0, 0, 0); }
                    if (l > 0) {
#pragma unroll
                        for (int ks = 0; ks < 2; ++ks) { const bf16x8_t wv = *(const bf16x8_t*)(vupT + (size_t)c * MVL + ks * 16 + 8 * hh); const bf16x8_t xq = *(const LAS bf16x8_t*)(lrow + 256 + ks * 16); accV = __builtin_amdgcn_mfma_f32_32x32x16_bf16(xq, wv, accV, 0, 0, 0); } }
                    const float mur = mu[c], muk = mu[RW + c], muv = mu[2 * RW + c], w0c = w0p[c], a0c = a0p[c], kkc = kkp[c], kac = kap[c], rkc = rkp[c];
                    const float v0c = l > 0 ? v0p[c] : 0.f;
#pragma unroll
                    for (int e = 0; e < 16; ++e) {
                        const int tok = (e & 3) + 8 * (e >> 2) + 4 * hh, t = t0 + tok; const bool hasprev = !(first && tok == 0);
                        const bf16* pr = PROJ + (size_t)t * LDP + c; const size_t o = (size_t)t * RW + c;
                        float r = bf2f(pr[0]), k = bf2f(pr[RW]), v = bf2f(pr[2 * RW]);
                        const float rp = hasprev ? bf2f(pr[-LDP]) : 0.f, kp_ = hasprev ? bf2f(pr[RW - LDP]) : 0.f, vp = hasprev ? bf2f(pr[2 * RW - LDP]) : 0.f;
                        r += (rp - r) * mur; k += (kp_ - k) * muk; v += (vp - v) * muv;
                        const float z = -(w0c + accW[e]); const float sp = fmaxf(z, 0.f) + __logf(1.f + __expf(-fabsf(z)));
                        const float decay = __expf(-__expf(-sp - 0.5f));
                        const float a = __builtin_amdgcn_rcpf(1.f + __expf(-(a0c + accA[e]))); const float g = accG[e];
                        if (l > 0) { const float vfv = bf2f(V0[o]); v = v + (vfv - v) * __builtin_amdgcn_rcpf(1.f + __expf(-(v0c + accV[e]))); }
                        const float kk = k * kkc; const float k2 = k * (1.f + (a - 1.f) * kac);
                        ssq[e] += kk * kk; bsm[e] += r * k2 * rkc;
                        Rb[o] = f2bf(r); Kb[o] = f2bf(k2); Vl[o] = f2bf(v); KKb[o] = f2bf(kk); Bb[o] = f2bf(kk * a); Gb[o] = f2bf(g); BGb[o] = f2bf(v * g); Wd[o] = decay;
                    }
                }
#pragma unroll
                for (int e = 0; e < 16; ++e) { float a_ = red16(ssq[e]), b_ = red16(bsm[e]); a_ += shflx(a_, lane, 16); b_ += shflx(b_, lane, 16); ssq[e] = a_; bsm[e] = b_; }
                if (r32 == 0) {
#pragma unroll
                    for (int e = 0; e < 16; ++e) { const int tok = (e & 3) + 8 * (e >> 2) + 4 * hh; INVN[(size_t)(t0 + tok) * NH + h] = rsqrtf(fmaxf(ssq[e], 1e-24f)); BSUM[(size_t)(t0 + tok) * NH + h] = bsm[e]; } }
            }
            {
                LAS float* dl = (LAS float*)lds;
                const float* pool_w = INP(21) + (size_t)l * 4 * PG * PG; const float ps = INP(22)[l * PW + tid];
                const int c = tid, g = c >> 7, dd = c & 127, win = 2 << g;
                for (int tile = bx; tile < T / 16; tile += G) {
                    const int t0 = tile * 16; const bool first = (t0 % SEQ) == 0;
                    __syncthreads();
                    float p[31];
#pragma unroll
                    for (int j = 0; j < 31; ++j) p[j] = (j >= 15 || !first) ? bf2f(PROJ[(size_t)(t0 - 15 + j) * LDP + RWKV_COLS + c]) : 0.f;
                    float sw = 0.f;
                    for (int j = 1; j <= 16; ++j) sw += (j < win) ? p[15 - j] : 0.f;
                    const float invw = 1.f / (float)win;
#pragma unroll
                    for (int i = 0; i < 16; ++i) {
                        sw += p[15 + i];
                        const float inv = first ? 1.f / (float)min(i + 1, win) : invw;
                        dl[i * 512 + c] = sw * inv - p[15 + i];
                        float drop = 0.f;
#pragma unroll
                        for (int q = 0; q < 4; ++q) { const int w_ = 2 << q; if (g == q) drop = p[15 + i - w_ + 1]; }
                        sw -= drop;
                    }
                    __syncthreads();
                    float acc[16];
#pragma unroll
                    for (int i = 0; i < 16; ++i) acc[i] = 0.f;
#pragma unroll 2
                    for (int cc = 0; cc < PG; cc += 4) {
                        const float* wp = pool_w + ((size_t)g * PG + cc) * PG + dd; const float w0 = wp[0], w1 = wp[PG], w2 = wp[2 * PG], w3 = wp[3 * PG];
#pragma unroll
                        for (int i = 0; i < 16; ++i) { const f32x4 d4 = *(const LAS f32x4*)(dl + i * 512 + g * PG + cc); acc[i] += (d4.x * w0 + d4.y * w1) + (d4.z * w2 + d4.w * w3); } }
#pragma unroll
                    for (int i = 0; i < 16; ++i) MIX[(size_t)(t0 + i) * D + RW + c] = f2bf(acc[i] * ps);
                }
            }
        }
        SEAM(pb + 2);

        if (IN(pb + 3)) { PHASE_IDS
            const bf16* Vl = l == 0 ? V0 : V1;
            const int r32 = lane & 31, hh = lane >> 5;
            if (wave < 6) {
                lbf16* At = (lbf16*)(lds + wave * 23552); lbf16* Bt = At + 2304; lbf16* Kt = Bt + 2304; lbf16* Rt = Kt + 2304; lbf16* Vv = Rt + 2304;
                LAS float* PCs = (LAS float*)(lds + wave * 23552 + 23040);
                for (int item = bx * 6 + wave; item < BATCH * NH * (SEQ / 32); item += G * 6) {
                    const int bh = item >> 7, chunk = item & 127, b = bh >> 3, h = bh & 7; const size_t t0 = (size_t)b * SEQ + chunk * 32;
                    __builtin_amdgcn_wave_barrier(); asm volatile("s_waitcnt lgkmcnt(0)" ::: "memory");
                    { float P = 1.f;
#pragma unroll 16
                      for (int c = 0; c < 32; ++c) { const size_t o = (t0 + c) * RW + h * HS + lane;
                          const float r = bf2f(Rb[o]), kx = bf2f(Kb[o]), v = bf2f(Vl[o]), kkr = bf2f(KKb[o]), br = bf2f(Bb[o]), w = Wd[o], inv = INVN[(t0 + c) * NH + h];
                          const float Pm1 = P; P *= w; const float ip = __builtin_amdgcn_rcpf(P);
                          At[c * 72 + lane] = f2bf(-kkr * inv * Pm1); Rt[c * 72 + lane] = f2bf(r * P); Bt[c * 72 + lane] = f2bf(br * inv * ip); Kt[c * 72 + lane] = f2bf(kx * ip); Vv[c * 72 + lane] = f2bf(v); }
                      PCs[lane] = P; }
                    __builtin_amdgcn_wave_barrier(); asm volatile("s_waitcnt lgkmcnt(0)" ::: "memory");
                    const f32x16 zero16 = {0.f, 0.f, 0.f, 0.f, 0.f, 0.f, 0.f, 0.f, 0.f, 0.f, 0.f, 0.f, 0.f, 0.f, 0.f, 0.f};
                    f32x16 X = zero16, Yt = zero16;
#pragma unroll
                    for (int ks = 0; ks < 4; ++ks) { const bf16x8_t fa = ldrow(At, r32, ks, hh), fb = ldrow(Bt, r32, ks, hh); X = mm32(fa, fb, X); Yt = mm32(fb, fa, Yt); }
#pragma unroll
                    for (int e = 0; e < 16; ++e) { const int ri = rowidx(e, hh); X[e] = (r32 < ri) ? X[e] : 0.f; Yt[e] = (ri < r32) ? Yt[e] : 0.f; }
                    f32x16 TY = Yt;
#pragma unroll
                    for (int e = 0; e < 16; ++e) TY[e] += (rowidx(e, hh) == r32) ? 1.f : 0.f;
#pragma unroll 1
                    for (int it = 0; it < 4; ++it) {
                        const bf16x8_t x0 = accop<0>(X), x1 = accop<1>(X), y0 = accop<0>(Yt), y1 = accop<1>(Yt);
                        f32x16 Xn = mm32(y0, x0, zero16); Xn = mm32(y1, x1, Xn);
                        f32x16 Yn = mm32(x0, y0, zero16); Yn = mm32(x1, y1, Yn);
                        X = Xn; Yt = Yn;
                        const bf16x8_t p0 = accop<0>(X), p1 = accop<1>(X), t0_ = accop<0>(TY), t1_ = accop<1>(TY);
                        TY = mm32(p0, t0_, TY); TY = mm32(p1, t1_, TY);
                    }
                    const bf16x8_t ty0 = accop<0>(TY), ty1 = accop<1>(TY);
                    unsigned char* rec = SCN + (size_t)item * 24576;
                    const bf16x8_t v00 = ldpermcol<0>(Vv, r32, hh), v01 = ldpermcol<1>(Vv, r32, hh), v10 = ldpermcol<0>(Vv, 32 + r32, hh), v11 = ldpermcol<1>(Vv, 32 + r32, hh);
                    f32x16 U0a, U0b;
                    { f32x16 G2T = zero16;
#pragma unroll
                      for (int ks = 0; ks < 4; ++ks) G2T = mm32(ldrow(Kt, r32, ks, hh), ldrow(At, r32, ks, hh), G2T);
#pragma unroll
                      for (int e = 0; e < 16; ++e) G2T[e] = (rowidx(e, hh) < r32) ? G2T[e] : 0.f;
                      const bf16x8_t g0 = accop<0>(G2T), g1 = accop<1>(G2T);
                      f32x16 Za = mm32(g0, v00, zero16); Za = mm32(g1, v01, Za); f32x16 Zb = mm32(g0, v10, zero16); Zb = mm32(g1, v11, Zb);
                      U0a = mm32(ty0, accop<0>(Za), zero16); U0a = mm32(ty1, accop<1>(Za), U0a); U0b = mm32(ty0, accop<0>(Zb), zero16); U0b = mm32(ty1, accop<1>(Zb), U0b); }
                    const bf16x8_t ua0 = accop<0>(U0a), ua1 = accop<1>(U0a), ub0 = accop<0>(U0b), ub1 = accop<1>(U0b);
                    f32x16 G3T = zero16;
                    { f32x16 G4T = zero16;
#pragma unroll
                      for (int ks = 0; ks < 4; ++ks) { const bf16x8_t fr = ldrow(Rt, r32, ks, hh); G3T = mm32(ldrow(Bt, r32, ks, hh), fr, G3T); G4T = mm32(ldrow(Kt, r32, ks, hh), fr, G4T); }
#pragma unroll
                      for (int e = 0; e < 16; ++e) { const bool keep = rowidx(e, hh) <= r32; G3T[e] = keep ? G3T[e] : 0.f; G4T[e] = keep ? G4T[e] : 0.f; }
                      const bf16x8_t g30 = accop<0>(G3T), g31 = accop<1>(G3T), g40 = accop<0>(G4T), g41 = accop<1>(G4T);
                      f32x16 Ya = mm32(g30, ua0, zero16); Ya = mm32(g31, ua1, Ya); Ya = mm32(g40, v00, Ya); Ya = mm32(g41, v01, Ya);
                      f32x16 Yb = mm32(g30, ub0, zero16); Yb = mm32(g31, ub1, Yb); Yb = mm32(g40, v10, Yb); Yb = mm32(g41, v11, Yb);
                      u32x4 o0, o1;
                      o0.x = cvtpk(Ya[0], Ya[1]); o0.y = cvtpk(Ya[2], Ya[3]); o0.z = cvtpk(Ya[4], Ya[5]); o0.w = cvtpk(Ya[6], Ya[7]);
                      o1.x = cvtpk(Ya[8], Ya[9]); o1.y = cvtpk(Ya[10], Ya[11]); o1.z = cvtpk(Ya[12], Ya[13]); o1.w = cvtpk(Ya[14], Ya[15]);
                      *(u32x4*)(rec + 12288 + 4096 + lane * 32) = o0; *(u32x4*)(rec + 12288 + 4096 + lane * 32 + 16) = o1;
                      o0.x = cvtpk(Yb[0], Yb[1]); o0.y = cvtpk(Yb[2], Yb[3]); o0.z = cvtpk(Yb[4], Yb[5]); o0.w = cvtpk(Yb[6], Yb[7]);
                      o1.x = cvtpk(Yb[8], Yb[9]); o1.y = cvtpk(Yb[10], Yb[11]); o1.z = cvtpk(Yb[12], Yb[13]); o1.w = cvtpk(Yb[14], Yb[15]);
                      *(u32x4*)(rec + 12288 + 6144 + 4096 + lane * 32) = o0; *(u32x4*)(rec + 12288 + 6144 + 4096 + lane * 32 + 16) = o1; }
                    f32x16 Wa0 = mm32(ty0, ldpermcol<0>(At, r32, hh), zero16); Wa0 = mm32(ty1, ldpermcol<1>(At, r32, hh), Wa0);
                    f32x16 Wa1 = mm32(ty0, ldpermcol<0>(At, 32 + r32, hh), zero16); Wa1 = mm32(ty1, ldpermcol<1>(At, 32 + r32, hh), Wa1);
                    const bf16x8_t wa00 = accop<0>(Wa0), wa01 = accop<1>(Wa0), wa10 = accop<0>(Wa1), wa11 = accop<1>(Wa1);
                    { const bf16x8_t g30 = accop<0>(G3T), g31 = accop<1>(G3T);
                      f32x16 Ra = mm32(wa00, g30, zero16); Ra = mm32(wa01, g31, Ra); f32x16 Rb_ = mm32(wa10, g30, zero16); Rb_ = mm32(wa11, g31, Rb_);
#pragma unroll
                      for (int e = 0; e < 16; ++e) { const int kr = rowidx(e, hh); Ra[e] += bf2f(Rt[r32 * 72 + kr]); Rb_[e] += bf2f(Rt[r32 * 72 + 32 + kr]); }
                      *(bf16x8_t*)(rec + 8192 + 0 * 1024 + lane * 16) = accop<0>(Ra); *(bf16x8_t*)(rec + 8192 + 1 * 1024 + lane * 16) = accop<1>(Ra);
                      *(bf16x8_t*)(rec + 8192 + 2 * 1024 + lane * 16) = accop<0>(Rb_); *(bf16x8_t*)(rec + 8192 + 3 * 1024 + lane * 16) = accop<1>(Rb_); }
                    const bf16x8_t b00 = ldpermcol<0>(Bt, r32, hh), b01 = ldpermcol<1>(Bt, r32, hh), b10 = ldpermcol<0>(Bt, 32 + r32, hh), b11 = ldpermcol<1>(Bt, 32 + r32, hh);
                    { const float pc0 = PCs[r32], pc1 = PCs[32 + r32];
#pragma unroll
                      for (int ij = 0; ij < 4; ++ij) { const int i = ij >> 1, j = ij & 1;
                          f32x16 M = mm32(i ? wa10 : wa00, j ? b10 : b00, zero16); M = mm32(i ? wa11 : wa01, j ? b11 : b01, M);
#pragma unroll
                          for (int e = 0; e < 16; ++e) { float m = M[e]; if (i == j) m += (rowidx(e, hh) == r32) ? 1.f : 0.f; M[e] = m * (j ? pc1 : pc0); }
                          *(bf16x8_t*)(rec + (ij * 2 + 0) * 1024 + lane * 16) = accop<0>(M); *(bf16x8_t*)(rec + (ij * 2 + 1) * 1024 + lane * 16) = accop<1>(M); } }
                    { const bf16x8_t k00 = ldpermcol<0>(Kt, r32, hh), k01 = ldpermcol<1>(Kt, r32, hh), k10 = ldpermcol<0>(Kt, 32 + r32, hh), k11 = ldpermcol<1>(Kt, 32 + r32, hh);
#pragma unroll
                      for (int ju = 0; ju < 4; ++ju) { const int j = ju >> 1, u = ju & 1;
                          f32x16 Dm = mm32(j ? b10 : b00, u ? ub0 : ua0, zero16); Dm = mm32(j ? b11 : b01, u ? ub1 : ua1, Dm);
                          Dm = mm32(j ? k10 : k00, u ? v10 : v00, Dm); Dm = mm32(j ? k11 : k01, u ? v11 : v01, Dm);
#pragma unroll
                          for (int e = 0; e < 16; ++e) Dm[e] *= PCs[32 * j + rowidx(e, hh)];
                          u32x4 o0, o1;
                          o0.x = cvtpk(Dm[0], Dm[1]); o0.y = cvtpk(Dm[2], Dm[3]); o0.z = cvtpk(Dm[4], Dm[5]); o0.w = cvtpk(Dm[6], Dm[7]);
                          o1.x = cvtpk(Dm[8], Dm[9]); o1.y = cvtpk(Dm[10], Dm[11]); o1.z = cvtpk(Dm[12], Dm[13]); o1.w = cvtpk(Dm[14], Dm[15]);
                          *(u32x4*)(rec + 12288 + u * 6144 + j * 2048 + lane * 32) = o0; *(u32x4*)(rec + 12288 + u * 6144 + j * 2048 + lane * 32 + 16) = o1; } }
                }
            }
        }
        { XcdBarrier xb_ = xbar; asm volatile("" : "+s"(xb_.bar)); xcd_barrier<false>(xb_); }
        if (IN(pb + 3)) { PHASE_IDS
            const int r32 = lane & 31, hh = lane >> 5;
            constexpr int SLOT = 18432, NCH = SEQ / 32, NSL = 7, AHEAD = 6;
            if (G > BATCH * NH * 2) { if (bx >= BATCH * NH * 2) convert_tables_fp8(INP(27), INP(28), U8, V8, USc, VSc, l, (bx - BATCH * NH * 2) * NWAVES + wave, (G - BATCH * NH * 2) * NWAVES, lane); }
            else convert_tables_fp8(INP(27), INP(28), U8, V8, USc, VSc, l, bx * NWAVES + wave, G * NWAVES, lane);
            for (int un = bx; un < BATCH * NH * 2; un += G) {
                const int bh = un >> 1, u = un & 1, b = bh >> 3, h = bh & 7;
                __syncthreads();
                const unsigned char* recs = SCN + (size_t)bh * NCH * 24576;
                const int lw = wave - 2;
#define S2_DMA(chunk_) do { if (wave >= 2) { LAS unsigned char* sl = lds + ((chunk_) % NSL) * SLOT; const unsigned char* rp = recs + (size_t)(chunk_) * 24576 + lane * 16; \
                    _Pragma("unroll") for (int q_ = 0; q_ < 3; ++q_) { const int p_ = lw * 3 + q_; const int so_ = p_ < 12 ? p_ * 1024 : 12288 + u * 6144 + (p_ - 12) * 1024; \
                        __builtin_amdgcn_global_load_lds((const unsigned*)(rp + so_), (LAS unsigned*)(sl + p_ * 1024), 16, 0, 0); } } } while (0)
#pragma unroll 1
                for (int c0 = 0; c0 < AHEAD; ++c0) S2_DMA(c0);
                asm volatile("s_waitcnt vmcnt(15)" ::: "memory");
                __builtin_amdgcn_s_barrier();
                f32x16 X0, X1;
#pragma unroll
                for (int e = 0; e < 16; ++e) { X0[e] = 0.f; X1[e] = 0.f; }
#define S2_FRAG(off) (*(const __attribute__((address_space(3))) bf16x8_t*)(sl + (off) + lane * 16))
#define S2_UNPK(dst, off) do { const u32x4 a0 = *(const LAS u32x4*)(sl + (off) + lane * 32), a1 = *(const LAS u32x4*)(sl + (off) + lane * 32 + 16); const unsigned wv[8] = {a0.x, a0.y, a0.z, a0.w, a1.x, a1.y, a1.z, a1.w}; \
                    _Pragma("unroll") for (int q = 0; q < 8; ++q) { (dst)[2 * q] = __uint_as_float(wv[q] << 16); (dst)[2 * q + 1] = __uint_as_float(wv[q] & 0xffff0000u); } } while (0)
#pragma unroll 1
                for (int n = 0; n < NCH; ++n) {
                    if (n + AHEAD < NCH) S2_DMA(n + AHEAD);
                    if (wave == 0) {
                        const LAS unsigned char* sl = lds + (n % NSL) * SLOT;
                        const bf16x8_t x00 = accop<0>(X0), x01 = accop<1>(X0), x10 = accop<0>(X1), x11 = accop<1>(X1);
                        f32x16 Yc, N0, N1;
                        S2_UNPK(Yc, 12288 + 4096); S2_UNPK(N0, 12288); S2_UNPK(N1, 12288 + 2048);
                        Yc = mm32(S2_FRAG(8192 + 0 * 1024), x00, Yc); Yc = mm32(S2_FRAG(8192 + 1 * 1024), x01, Yc); Yc = mm32(S2_FRAG(8192 + 2 * 1024), x10, Yc); Yc = mm32(S2_FRAG(8192 + 3 * 1024), x11, Yc);
                        N0 = mm32(S2_FRAG((0 * 2 + 0) * 1024), x00, N0); N0 = mm32(S2_FRAG((0 * 2 + 1) * 1024), x01, N0); N0 = mm32(S2_FRAG((2 * 2 + 0) * 1024), x10, N0); N0 = mm32(S2_FRAG((2 * 2 + 1) * 1024), x11, N0);
                        N1 = mm32(S2_FRAG((1 * 2 + 0) * 1024), x00, N1); N1 = mm32(S2_FRAG((1 * 2 + 1) * 1024), x01, N1); N1 = mm32(S2_FRAG((3 * 2 + 0) * 1024), x10, N1); N1 = mm32(S2_FRAG((3 * 2 + 1) * 1024), x11, N1);
                        X0 = N0; X1 = N1;
                        float* yp = Y + ((size_t)b * SEQ + (size_t)n * 32) * RW + h * HS + u * 32 + r32;
#pragma unroll
                        for (int e = 0; e < 16; ++e) yp[(size_t)rowidx(e, hh) * RW] = Yc[e];
                        asm volatile("s_waitcnt lgkmcnt(0)" ::: "memory");
                    } else if (wave >= 2) {
                        const int younger = (NCH - 1 - (n + 1)) < (AHEAD - 1) ? (NCH - 1 - (n + 1)) : (AHEAD - 1);
                        if (younger >= 5) asm volatile("s_waitcnt vmcnt(15)" ::: "memory"); else if (younger == 4) asm volatile("s_waitcnt vmcnt(12)" ::: "memory"); else if (younger == 3) asm volatile("s_waitcnt vmcnt(9)" ::: "memory");
                        else if (younger == 2) asm volatile("s_waitcnt vmcnt(6)" ::: "memory"); else if (younger == 1) asm volatile("s_waitcnt vmcnt(3)" ::: "memory"); else asm volatile("s_waitcnt vmcnt(0)" ::: "memory");
                    }
                    __builtin_amdgcn_s_barrier();
                }
#undef S2_FRAG
#undef S2_UNPK
#undef S2_DMA
            }
        }
        SEAM(pb + 3);

        if (IN(pb + 4)) { PHASE_IDS
            const int c = tid; const float lg = INP(19)[l * RW + c], lb = INP(20)[l * RW + c];
            for (int tile = bx; tile < T / 8; tile += G) {
                float y[8], g[8], bg[8];
#pragma unroll
                for (int i = 0; i < 8; ++i) { const size_t o = (size_t)(tile * 8 + i) * RW + c; y[i] = Y[o]; g[i] = bf2f(Gb[o]); bg[i] = bf2f(BGb[o]) * BSUM[(size_t)(tile * 8 + i) * NH + wave]; }
#pragma unroll
                for (int i = 0; i < 8; ++i) { const float mean = wave_sum(y[i], lane) * (1.f / 64.f); const float d = y[i] - mean; const float var = wave_sum(d * d, lane) * (1.f / 64.f);
                    const float yn = d * rsqrtf(var + GN_EPS) * lg + lb; MIX[(size_t)(tile * 8 + i) * D + c] = f2bf(yn * g[i] + bg[i]); }
            }
        }
        SEAM(pb + 4);
        if (IN(pb + 5)) { PHASE_IDS
            pg8::Gemm g{MIX, WoutT + (size_t)l * D * D, T, D, D}; pg8::StaticOrder S; S.init(T, D, G, bx);
            pg8::EpiResGate E{xin, X, modl + 2 * D};
            pg8::gemm_phase<pg8::EpiResGate, pg8::StaticOrder, true, true>(lds, g, S, E, tid); }
        SEAM(pb + 5);
        if (IN(pb + 6)) { PHASE_IDS const float* gamma = INP(24) + l * D;
            for (int row = gw; row < T; row += NGW) { const int b = row / SEQ; norm_mod_row(X + (size_t)row * D, gamma, modl + (size_t)b * 6 * D + 3 * D, modl + (size_t)b * 6 * D + 4 * D, H + (size_t)row * D, lane); } }
        SEAM(pb + 6);
        if (IN(pb + 7)) { PHASE_IDS
            pg8::Gemm g{H, PqT + (size_t)l * PH * PQ * D, T, PH * PQ, D}; pg8::StaticOrder S; S.init(T, PH * PQ, G, bx);
            pg8::EpiBf16<0> E{Q, PH * PQ, nullptr, 0, 0, 1.f};
            pg8::gemm_phase<pg8::EpiBf16<0>, pg8::StaticOrder, true, true>(lds, g, S, E, tid); }
        SEAM(pb + 7);

        if (IN(pb + 8)) { PHASE_IDS
            const bf16* KEYSl = KEYS + (size_t)l * PH * 2 * NKEYS * PHALF;
            LAS unsigned char* scr = lds + wave * 2048 + lane * 32;
            const int r = lane & 31, hh = lane >> 5;
            for (int it = gw; it < (T / 32) * PH; it += NGW) {
                const int tok = (it >> 3) * 32 + r, h = it & 7;
                unsigned sp0[16], sp1[16];
#pragma unroll
                for (int e = 0; e < 16; ++e) { sp0[e] = 0u; sp1[e] = 0u; }
#pragma unroll 1
                for (int p = 0; p < 2; ++p) {
                    const bf16* qp = Q + (size_t)tok * (PH * PQ) + h * PQ + p * PHALF + 8 * hh;
                    const bf16* kp_ = KEYSl + ((size_t)(h * 2 + p) * NKEYS + r) * PHALF + 8 * hh;
                    bf16x8_t bq[8];
#pragma unroll
                    for (int ks = 0; ks < 8; ++ks) bq[ks] = *(const bf16x8_t*)(qp + ks * 16);
                    unsigned best[16];
#pragma unroll
                    for (int e = 0; e < 16; ++e) best[e] = 0u;
#pragma unroll 1
                    for (int kt = 0; kt < 4; ++kt) {
                        f32x16 acc;
#pragma unroll
                        for (int e = 0; e < 16; ++e) acc[e] = 0.f;
#pragma unroll
                        for (int ks = 0; ks < 8; ++ks) { const bf16x8_t ak = *(const bf16x8_t*)(kp_ + (size_t)kt * 32 * PHALF + ks * 16); acc = __builtin_amdgcn_mfma_f32_32x32x16_bf16(ak, bq[ks], acc, 0, 0, 0); }
                        unsigned g[16];
#pragma unroll
                        for (int e = 0; e < 16; ++e) g[e] = pack_key7(acc[e], kt * 32 + (e & 3) + 8 * (e >> 2) + 4 * hh);
                        sort16_desc(g);
                        merge_top16(best, g);
                    }
                    unsigned ob[16];
#pragma unroll
                    for (int e = 0; e < 16; ++e) ob[e] = shflxu(best[e], lane, 32);
                    merge_top16(best, ob);
#pragma unroll
                    for (int e = 0; e < 16; ++e) { sp0[e] = p == 0 ? best[e] : sp0[e]; sp1[e] = p == 0 ? sp1[e] : best[e]; }
                }
                unsigned c2[32];
                stage2_cands(sp0, sp1, hh, c2);
                sort16_desc(c2); sort16_desc(c2 + 16); merge_top16(c2, c2 + 16);
                { unsigned ob[16];
#pragma unroll
                  for (int e = 0; e < 16; ++e) ob[e] = shflxu(c2[e], lane, 32);
                  merge_top16(c2, ob); }
#pragma unroll
                for (int e = 0; e < 16; e += 4) {
                    *(LAS unsigned*)(scr + e) = (127u - (sp0[e] & 127u)) | ((127u - (sp0[e + 1] & 127u)) << 8) | ((127u - (sp0[e + 2] & 127u)) << 16) | ((127u - (sp0[e + 3] & 127u)) << 24);
                    *(LAS unsigned*)(scr + 16 + e) = (127u - (sp1[e] & 127u)) | ((127u - (sp1[e + 1] & 127u)) << 8) | ((127u - (sp1[e + 2] & 127u)) << 16) | ((127u - (sp1[e + 3] & 127u)) << 24); }
                asm volatile("s_waitcnt lgkmcnt(0)" ::: "memory");
                float sm[16]; int ex[16];
#pragma unroll
                for (int e = 0; e < 16; ++e) { const unsigned key = c2[e]; sm[e] = unpack_key8(key); const int i0 = (key >> 4) & 15, j0 = key & 15; ex[e] = (int)scr[i0] * NKEYS + (int)scr[16 + j0]; }
                float den = 0.f;
#pragma unroll
                for (int e = 0; e < 16; ++e) { sm[e] = expf(sm[e] - unpack_key8(c2[0])); den += sm[e]; }
                const float inv = 1.f / den;
                if (hh == 0) {
                    int* ip = IDX + (size_t)tok * NE + h * TOPK; float* gp = GATE + (size_t)tok * NE + h * TOPK;
#pragma unroll
                    for (int e = 0; e < 16; e += 4) { *(int4*)(ip + e) = make_int4(ex[e], ex[e + 1], ex[e + 2], ex[e + 3]); *(f32x4*)(gp + e) = (f32x4){sm[e] * inv, sm[e + 1] * inv, sm[e + 2] * inv, sm[e + 3] * inv}; }
                }
                asm volatile("s_waitcnt lgkmcnt(0)" ::: "memory");
            }
        }
        SEAM(pb + 8);

        if (IN(pb + 9)) { PHASE_IDS
            const unsigned char* Ul = U8 + (size_t)l * NEXP * D; const unsigned char* Vtl = V8 + (size_t)l * NEXP * D; const float* usl = USc + l * NEXP; const float* vsl = VSc + l * NEXP; const float* lnf = INP(29);
            const bool fin = (l == DEPTH - 1);
            typedef float f32x2_t __attribute__((ext_vector_type(2)));
            const __amdgpu_buffer_rsrc_t ru = __builtin_amdgcn_make_buffer_rsrc((void*)Ul, 0, NEXP * D, 0x00020000), rv = __builtin_amdgcn_make_buffer_rsrc((void*)Vtl, 0, NEXP * D, 0x00020000);
            const int voff = lane * 16;
            LAS float* pl = (LAS float*)(lds + wave * 8704);
            for (int t = gw; t < T; t += NGW) {
                const int b = t / SEQ;
                f32x2_t hf2[8];
                { const u32x4 h0 = *(const u32x4*)(H + (size_t)t * D + lane * 16), h1 = *(const u32x4*)(H + (size_t)t * D + lane * 16 + 8);
                  hf2[0] = (f32x2_t){__uint_as_float(h0.x << 16), __uint_as_float(h0.x & 0xffff0000u)}; hf2[1] = (f32x2_t){__uint_as_float(h0.y << 16), __uint_as_float(h0.y & 0xffff0000u)};
                  hf2[2] = (f32x2_t){__uint_as_float(h0.z << 16), __uint_as_float(h0.z & 0xffff0000u)}; hf2[3] = (f32x2_t){__uint_as_float(h0.w << 16), __uint_as_float(h0.w & 0xffff0000u)};
                  hf2[4] = (f32x2_t){__uint_as_float(h1.x << 16), __uint_as_float(h1.x & 0xffff0000u)}; hf2[5] = (f32x2_t){__uint_as_float(h1.y << 16), __uint_as_float(h1.y & 0xffff0000u)};
                  hf2[6] = (f32x2_t){__uint_as_float(h1.z << 16), __uint_as_float(h1.z & 0xffff0000u)}; hf2[7] = (f32x2_t){__uint_as_float(h1.w << 16), __uint_as_float(h1.w & 0xffff0000u)}; }
                f32x2_t acc2[8];
#pragma unroll
                for (int i = 0; i < 8; ++i) acc2[i] = (f32x2_t){0.f, 0.f};
                int myidx = IDX[(size_t)t * NE + (lane & 31)]; float mygate = GATE[(size_t)t * NE + (lane & 31)];
                float myus = usl[myidx], myvs = vsl[myidx];
#define ROWLD(dst, rs, ix, e) dst = __builtin_amdgcn_raw_buffer_load_b128(rs, voff, __builtin_amdgcn_readlane(ix, (e)) * D, 0)
#define LOADB(buf, rs, ix, e0) do { _Pragma("unroll") for (int j_ = 0; j_ < 4; ++j_) ROWLD((buf)[j_], rs, ix, (e0) + j_); __builtin_amdgcn_sched_barrier(0); } while (0)
#define CVT8(u) const f32x2_t u0 = __builtin_amdgcn_cvt_pk_f32_fp8((int)(u).x, false), u1 = __builtin_amdgcn_cvt_pk_f32_fp8((int)(u).x, true), u2 = __builtin_amdgcn_cvt_pk_f32_fp8((int)(u).y, false), u3 = __builtin_amdgcn_cvt_pk_f32_fp8((int)(u).y, true), \
                        u4 = __builtin_amdgcn_cvt_pk_f32_fp8((int)(u).z, false), u5 = __builtin_amdgcn_cvt_pk_f32_fp8((int)(u).z, true), u6 = __builtin_amdgcn_cvt_pk_f32_fp8((int)(u).w, false), u7 = __builtin_amdgcn_cvt_pk_f32_fp8((int)(u).w, true)
#define DOT1(u, dst) do { CVT8(u); f32x2_t a_ = hf2[0] * u0; a_ += hf2[1] * u1; a_ += hf2[2] * u2; a_ += hf2[3] * u3; a_ += hf2[4] * u4; a_ += hf2[5] * u5; a_ += hf2[6] * u6; a_ += hf2[7] * u7; dst = a_.x + a_.y; } while (0)
#define DOTB(buf, e0) do { _Pragma("unroll") for (int j_ = 0; j_ < 4; ++j_) { float d_; DOT1((buf)[j_], d_); pl[((e0) + j_) * 68 + lane] = d_; } } while (0)
#define AXPYB(buf, e0) do { _Pragma("unroll") for (int j_ = 0; j_ < 4; ++j_) { CVT8((buf)[j_]); const float cf = __int_as_float(__builtin_amdgcn_readlane(__float_as_int(coef), (e0) + j_)); \
                        acc2[0] += cf * u0; acc2[1] += cf * u1; acc2[2] += cf * u2; acc2[3] += cf * u3; acc2[4] += cf * u4; acc2[5] += cf * u5; acc2[6] += cf * u6; acc2[7] += cf * u7; } } while (0)
                u32x4 ba[4], bb_[4];
                LOADB(ba, ru, myidx, 0);
#pragma unroll 1
                for (int q = 0; q < 4; ++q) {
                    int nidx = 0; float ngate = 0.f;
                    if (q < 3) { nidx = IDX[(size_t)t * NE + (q + 1) * 32 + (lane & 31)]; ngate = GATE[(size_t)t * NE + (q + 1) * 32 + (lane & 31)]; }
#pragma unroll
                    for (int e0 = 0; e0 < 32; e0 += 8) {
                        LOADB(bb_, ru, myidx, e0 + 4); DOTB(ba, e0);
                        if (e0 + 8 < 32) LOADB(ba, ru, myidx, e0 + 8); else LOADB(ba, rv, myidx, 0);
                        DOTB(bb_, e0 + 4);
                    }
                    const float nus = usl[nidx], nvs = vsl[nidx];
                    __builtin_amdgcn_wave_barrier(); asm volatile("s_waitcnt lgkmcnt(0)" ::: "memory");
                    float dsum;
                    { const LAS float* rp = pl + (lane & 31) * 68 + (lane >> 5) * 32; f32x4 s4 = *(const LAS f32x4*)rp;
#pragma unroll
                      for (int j = 1; j < 8; ++j) s4 += *(const LAS f32x4*)(rp + j * 4);
                      dsum = (s4.x + s4.y) + (s4.z + s4.w); }
                    dsum += shflx(dsum, lane, 32);
                    __builtin_amdgcn_wave_barrier(); asm volatile("s_waitcnt lgkmcnt(0)" ::: "memory");
                    const float coef = mygate * gelu_erf(dsum * myus) * myvs;
#pragma unroll
                    for (int e0 = 0; e0 < 32; e0 += 8) {
                        LOADB(bb_, rv, myidx, e0 + 4); AXPYB(ba, e0);
                        if (e0 + 8 < 32) LOADB(ba, rv, myidx, e0 + 8); else if (q < 3) LOADB(ba, ru, nidx, 0);
                        AXPYB(bb_, e0 + 4);
                    }
                    myidx = nidx; mygate = ngate; myus = nus; myvs = nvs;
                }
#undef ROWLD
#undef LOADB
#undef CVT8
#undef DOTB
#undef DOT1
#undef AXPYB
                float* xr = X + (size_t)t * D + lane * 16; const float* g2 = modl + (size_t)b * 6 * D + 5 * D + lane * 16;
                f32x4 xv[4]; float ss = 0.f;
#pragma unroll
                for (int q = 0; q < 4; ++q) { const f32x4 xo = *(const f32x4*)(xr + q * 4), gg = *(const f32x4*)(g2 + q * 4);
                    xv[q] = xo + gg * (f32x4){acc2[q * 2].x, acc2[q * 2].y, acc2[q * 2 + 1].x, acc2[q * 2 + 1].y}; ss += (xv[q].x * xv[q].x + xv[q].y * xv[q].y) + (xv[q].z * xv[q].z + xv[q].w * xv[q].w); }
                const float rs = rsqrtf(wave_sum(ss, lane) * (1.f / D) + NORM_EPS);
                if (fin) {
#pragma unroll
                    for (int q = 0; q < 4; ++q) xv[q] = xv[q] * rs * *(const f32x4*)(lnf + lane * 16 + q * 4); }
                else {
                    const float* gam = INP(4) + (l + 1) * D + lane * 16; const float* mn = MOD + (size_t)(l + 1) * BATCH * 6 * D + (size_t)b * 6 * D + lane * 16; u32x4 ho[2];
#pragma unroll
                    for (int q = 0; q < 4; ++q) { const f32x4 y = xv[q] * rs * *(const f32x4*)(gam + q * 4) * (*(const f32x4*)(mn + D + q * 4) + 1.f) + *(const f32x4*)(mn + q * 4);
                        if (q & 1) { ho[q >> 1].z = pk2(y.x, y.y); ho[q >> 1].w = pk2(y.z, y.w); } else { ho[q >> 1].x = pk2(y.x, y.y); ho[q >> 1].y = pk2(y.z, y.w); } }
                    *(u32x4*)(H + (size_t)t * D + lane * 16) = ho[0]; *(u32x4*)(H + (size_t)t * D + lane * 16 + 8) = ho[1]; }
#pragma unroll
                for (int q = 0; q < 4; ++q) *(f32x4*)(xr + q * 4) = xv[q];
            }
        }
    }
#undef modl
#undef xin
#undef IN
#undef SEAM
}
#undef MOD
#undef H
#undef PROJ
#undef Q
#undef MIX
#undef Rb
#undef Kb
#undef V0
#undef V1
#undef KKb
#undef Bb
#undef Gb
#undef BGb
#undef Wd
#undef Y
#undef IDX
#undef GATE
#undef WinT
#undef WoutT
#undef PqT
#undef KEYS
#undef QB
#undef SH
#undef WUPT
#undef AUPT
#undef GUPT
#undef VUPT
#undef INVN
#undef BSUM
#undef SCN
#undef U8
#undef V8
#undef USc
#undef VSc
#undef INP
#undef PHASE_IDS

extern "C" void kernel_launch(void* const* d_in, const int* in_sizes, int n_in, void* d_out, int out_size, void* d_ws, size_t ws_size, hipStream_t stream) {
    if (n_in != 30 || ws_size < WS_END) { fprintf(stderr, "kernel_launch: unexpected n_in %d / ws_size %zu\n", n_in, ws_size); return; }
    static int grid = 0;
    if (grid == 0) {
        int dev = 0, cus = 0, per_cu = 0;
        (void)hipGetDevice(&dev); (void)hipDeviceGetAttribute(&cus, hipDeviceAttributeMultiprocessorCount, dev);
        if (hipFuncSetAttribute((const void*)mega, hipFuncAttributeMaxDynamicSharedMemorySize, LDS_BYTES) != hipSuccess) { fprintf(stderr, "hipFuncSetAttribute failed\n"); grid = -1; return; }
        if (hipOccupancyMaxActiveBlocksPerMultiprocessor(&per_cu, (const void*)mega, NTHR, LDS_BYTES) != hipSuccess || per_cu < 1) { fprintf(stderr, "occupancy query failed (%d)\n", per_cu); per_cu = 1; }
        (void)hipGetLastError();
        grid = (cus > 0 ? cus : 256) * 1;
    }
    if (grid < 0) return;
    Args a{}; for (int i = 0; i < 30; ++i) a.in[i] = (const float*)d_in[i]; a.out = (float*)d_out; a.ws = (unsigned char*)d_ws;
    a.ph_lo = 0; a.ph_hi = NPH;
    if (hipMemsetAsync(d_ws, 0, 65536, stream) != hipSuccess) { fprintf(stderr, "memset failed\n"); return; }
    void* kargs[] = {&a};
    hipError_t e = hipLaunchCooperativeKernel((const void*)mega, dim3(grid), dim3(NTHR), kargs, LDS_BYTES, stream);
    if (e != hipSuccess) fprintf(stderr, "cooperative launch failed: %s (grid %d)\n", hipGetErrorString(e), grid);
}
```

```cpp
#include <hip/hip_runtime.h>
#include <hip/hip_cooperative_groups.h>
namespace cg = cooperative_groups;
#include <cstdio>
#include <cstdint>
#include <cmath>

constexpr int D = 1024, BATCH = 4, SEQ = 4096, T = BATCH * SEQ, DEPTH = 2;
constexpr int RW = 512, HS = 64, NH = 8;
constexpr int DL = 64, AL = 64, MVL = 32, GL = 128;
constexpr int RWKV_COLS = 3 * RW + DL + AL + GL;
constexpr int PW = 512, PG = 128;
constexpr int IN_COLS = RWKV_COLS + PW;
constexpr int LDP = 2560;
constexpr int NKEYS = 128, NEXP = NKEYS * NKEYS, PH = 8, PQ = 256, PHALF = 128, TOPK = 16;
constexpr int NE = PH * TOPK;
constexpr float NORM_EPS = 1e-6f, GN_EPS = 64e-5f;

typedef unsigned short bf16;
__device__ __forceinline__ float bf2f(bf16 u) { return __uint_as_float((unsigned)u << 16); }
__device__ __forceinline__ bf16 f2bf(float f) { unsigned u = __float_as_uint(f); return (bf16)((u + 0x7fffu + ((u >> 16) & 1u)) >> 16); }

constexpr size_t MiB = 1u << 20;
constexpr size_t WS_MOD = 1 * MiB;
constexpr size_t WS_US = 1 * MiB + 256 * 1024;
constexpr size_t WS_VS = 1 * MiB + 512 * 1024;
constexpr size_t WS_H = 2 * MiB;
constexpr size_t WS_PROJ = 34 * MiB;
constexpr size_t WS_Q = WS_PROJ;
constexpr size_t WS_R = 114 * MiB;
constexpr size_t WS_K = 130 * MiB;
constexpr size_t WS_V0 = 146 * MiB;
constexpr size_t WS_V1 = 162 * MiB;
constexpr size_t WS_KK = 178 * MiB;
constexpr size_t WS_B = 194 * MiB;
constexpr size_t WS_G = 210 * MiB;
constexpr size_t WS_BG = 226 * MiB;
constexpr size_t WS_W = 242 * MiB;
constexpr size_t WS_Y = 274 * MiB;
constexpr size_t WS_MIX = 306 * MiB;
constexpr size_t WS_IDX = 338 * MiB;
constexpr size_t WS_GATE = 346 * MiB;
constexpr size_t WS_WIN_T = 354 * MiB;
constexpr size_t WS_WOUT_T = 364 * MiB;
constexpr size_t WS_PQ_T = 368 * MiB;
constexpr size_t WS_KEYS = 376 * MiB;
constexpr size_t WS_U = 378 * MiB;
constexpr size_t WS_V = 442 * MiB;
constexpr size_t WS_QB = 410 * MiB;
constexpr size_t WS_SH = 426 * MiB;
constexpr size_t WS_LORA = 428 * MiB;
constexpr size_t WS_INVN = 430 * MiB;
constexpr size_t WS_BSUM = 431 * MiB;
constexpr size_t WS_SCN = 2 * MiB;
constexpr size_t WS_END = 506 * MiB;

template <int CTRL> __device__ __forceinline__ float dppf(float x) { return __int_as_float(__builtin_amdgcn_update_dpp(0, __float_as_int(x), CTRL, 0xF, 0xF, false)); }
__device__ __forceinline__ float red16(float x) { x += dppf<0xB1>(x); x += dppf<0x4E>(x); x += dppf<0x141>(x); x += dppf<0x140>(x); return x; }
__device__ __forceinline__ float shflx(float v, int lane, int off) { return __int_as_float(__builtin_amdgcn_ds_bpermute((lane ^ off) << 2, __float_as_int(v))); }
__device__ __forceinline__ unsigned shflxu(unsigned v, int lane, int off) { return (unsigned)__builtin_amdgcn_ds_bpermute((lane ^ off) << 2, (int)v); }
__device__ __forceinline__ float wave_sum(float v, int lane) { v = red16(v); v += shflx(v, lane, 16); v += shflx(v, lane, 32); return v; }
__device__ __forceinline__ float sigmoidf_(float x) { return 1.f / (1.f + expf(-x)); }

namespace pg8 {
#define PG8_LAS __attribute__((address_space(3)))
typedef unsigned short bf16_t;
typedef short bf16x8 __attribute__((ext_vector_type(8)));
typedef float f32x4 __attribute__((ext_vector_type(4)));
typedef unsigned u32x4 __attribute__((ext_vector_type(4)));
constexpr int BM = 256, BK = 64, HALF = 128, HTB = HALF * BK * 2  , STAGE_BYTES = 8 * HTB, NXCD = 8, WGM = 8;

__host__ __device__ __forceinline__ int lds_byte(int r, int c) { const int st = (r >> 4) * 2 + (c >> 5), rr = r & 15, cc = c & 31, ob = rr * 64 + cc * 2; return st * 1024 + (ob ^ (((ob >> 9) & 1) << 5)); }
__host__ __device__ __forceinline__ void stage_rc(int b, int& R, int& C) { const int st = b / 1024, sb = b % 1024, swz = sb ^ (((sb >> 9) & 1) << 5); R = (st >> 1) * 16 + swz / 64; C = (st & 1) * 32 + (swz % 64) / 2; }
__host__ __device__ __forceinline__ int perm32(int rho) { const int n = rho >> 4, i = rho & 15; return 8 * (i >> 2) + 4 * n + (i & 3); }

struct Unit { int pm, pn; };
struct Gemm { const bf16_t* A; const bf16_t* Bt; int M, N, K; };

struct StaticOrder {
    int nM, nN, nwg, G, c;
    __host__ __device__ void init(int M, int N, int G_, int c_) { nM = M / BM; nN = N / BM; nwg = nM * nN; G = G_; c = c_; }
    __host__ __device__ bool next(int i, Unit& u) const {
        const long L = (long)i * G + c; if (L >= nwg) return false;
        int wgid = (int)L; { const int q = nwg / NXCD, r = nwg % NXCD, xcd = wgid % NXCD, off = wgid / NXCD; wgid = (xcd < r ? xcd * (q + 1) : r * (q + 1) + (xcd - r) * q) + off; }
        const int nig = WGM * nN, gid = wgid / nig, fm = gid * WGM, gsz = (nM - fm) < WGM ? (nM - fm) : WGM;
        u.pm = fm + ((wgid % nig) % gsz); u.pn = (wgid % nig) / gsz; return true;
    }
    __device__ __forceinline__ void a_ready(const Unit&) const {}
    __device__ __forceinline__ void done(const Unit&) const {}
};

__device__ __forceinline__ unsigned cvt_pk_bf16(float lo, float hi) { unsigned r; asm volatile("v_cvt_pk_bf16_f32 %0, %1, %2" : "=v"(r) : "v"(lo), "v"(hi)); return r; }
typedef float f32x2 __attribute__((ext_vector_type(2)));
__device__ __forceinline__ f32x2 gelu_pk(f32x2 v) {
    const f32x2 av = __builtin_elementwise_abs(v), d = av * 0.2316418882f + 1.0f;
    f32x2 t; t.x = __builtin_amdgcn_rcpf(d.x); t.y = __builtin_amdgcn_rcpf(d.y);
    f32x2 q = t * 0.5307027145f + (-0.7265760135f); q = q * t + 0.7107068705f; q = q * t + (-0.142248368f); q = q * t + 0.127414796f; q = q * t;
    const f32x2 s = (v * v) * (-0.72134752044f);
    f32x2 e; e.x = __builtin_amdgcn_exp2f(s.x); e.y = __builtin_amdgcn_exp2f(s.y);
    const f32x2 m = v * (q * e), r = v - m;
    f32x2 o; o.x = v.x < 0.f ? m.x : r.x; o.y = v.y < 0.f ? m.y : r.y; return o;
}

template <int ACT  > struct EpiBf16 {
    static constexpr bool PERM = true, AFTER_DRAIN = false; static_assert(ACT == 0 || ACT == 1, "EpiBf16: ACT is 0 (none) or 1 (gelu_pk)");
    bf16_t* O; int ldc; const float* bias; int split_cols; size_t split_stride; float scale0;
    __device__ __forceinline__ void operator()(const f32x4 (&acc)[2][2][4][2], const Unit& u, int wr, int wc, int fr, int fq) const {
        const int row0 = u.pm * BM + wr * 64 + fr; int colt = u.pn * BM; bf16_t* base = O;
        float sc = 1.f; if (split_cols) { const int t = colt / split_cols; base += (size_t)t * split_stride; colt -= t * split_cols; if (t == 0) sc = scale0; }
        const int col0 = colt + wc * 32 + 8 * fq, bcol0 = u.pn * BM + wc * 32 + 8 * fq;
        f32x4 bv[2][2];
#pragma unroll
        for (int bj = 0; bj < 2; ++bj)
#pragma unroll
            for (int n = 0; n < 2; ++n) bv[bj][n] = bias ? *(const f32x4*)(bias + bcol0 + bj * HALF + 4 * n) : (f32x4){0.f, 0.f, 0.f, 0.f};
#pragma unroll
        for (int ai = 0; ai < 2; ++ai)
#pragma unroll
            for (int m = 0; m < 4; ++m) { bf16_t* rowp = base + (size_t)(row0 + ai * HALF + m * 16) * ldc + col0;
#pragma unroll
                for (int bj = 0; bj < 2; ++bj) { f32x4 v0 = acc[ai][bj][m][0] + bv[bj][0], v1 = acc[ai][bj][m][1] + bv[bj][1];
                    if (ACT == 1) { f32x2 a = gelu_pk((f32x2){v0[0], v0[1]}), b = gelu_pk((f32x2){v0[2], v0[3]}), c = gelu_pk((f32x2){v1[0], v1[1]}), d = gelu_pk((f32x2){v1[2], v1[3]});
                        v0 = (f32x4){a.x, a.y, b.x, b.y}; v1 = (f32x4){c.x, c.y, d.x, d.y}; }
                    v0 = v0 * sc; v1 = v1 * sc; u32x4 w; w.x = cvt_pk_bf16(v0[0], v0[1]); w.y = cvt_pk_bf16(v0[2], v0[3]); w.z = cvt_pk_bf16(v1[0], v1[1]); w.w = cvt_pk_bf16(v1[2], v1[3]);
                    *(u32x4*)(rowp + bj * HALF) = w; } }
    }
};

struct EpiResGate {
    static constexpr bool PERM = false, AFTER_DRAIN = false;
    const float* xold; float* X; const float* gate;
    __device__ __forceinline__ void operator()(const f32x4 (&acc)[2][2][4][2], const Unit& u, int wr, int wc, int fr, int fq) const {
        const int col0 = u.pn * BM + wc * 32 + 4 * fq; const int b = (u.pm * BM) / SEQ;
        const float* gp = gate + (size_t)b * 6 * D + col0;
#pragma unroll
        for (int bj = 0; bj < 2; ++bj)
#pragma unroll
            for (int n = 0; n < 2; ++n) { const f32x4 gv = *(const f32x4*)(gp + bj * HALF + n * 16);
#pragma unroll
                for (int ai = 0; ai < 2; ++ai)
#pragma unroll
                    for (int m = 0; m < 4; ++m) { const size_t off = (size_t)(u.pm * BM + ai * HALF + wr * 64 + m * 16 + fr) * D + col0 + bj * HALF + n * 16;
                        const f32x4 xo = *(const f32x4*)(xold + off); *(f32x4*)(X + off) = xo + gv * acc[ai][bj][m][n]; } }
    }
};
template <class Epi, class Sched, bool ALIGN_EPI = false, bool SP2 = false>
__device__ __forceinline__ void gemm_phase(PG8_LAS unsigned char* lds, const Gemm g, const Sched& S, const Epi& E, int tid) {
    asm volatile("" : "+v"(tid));
    const int wid = __builtin_amdgcn_readfirstlane(tid >> 6), lane = tid & 63, wr = wid >> 2, wc = wid & 3, fr = lane & 15, fq = lane >> 4;
    const int K = g.K, nt = K / BK;
    unsigned voffA[2], voffB[2];
#pragma unroll
    for (int i = 0; i < 2; ++i) { int R, C; stage_rc(tid * 16 + i * 8192, R, C); const int Rb = Epi::PERM ? ((R & ~31) + perm32(R & 31)) : R;
        voffA[i] = (unsigned)(R * K + C) * 2u; voffB[i] = (unsigned)(Rb * K + C) * 2u; }
    const size_t kstep = (size_t)(BK * 2);
    const size_t hstep = (size_t)HALF * K * 2;
    const size_t tstep = 2 * hstep;
    const unsigned ldsw = (unsigned)wid * 1024u;
    const int aoff = lds_byte(wr * 64 + fr, fq * 8), boff = lds_byte(wc * 32 + fr, fq * 8);
#define PG8_SA(b, h) (((b) * 2 + (h)) * HTB)
#define PG8_SB(b, h) ((4 + (b) * 2 + (h)) * HTB)
#define PG8_STAGE(bufoff, gbase, voff) do { _Pragma("unroll") for (int _i = 0; _i < 2; ++_i) \
        __builtin_amdgcn_global_load_lds((const unsigned*)((const char*)(gbase) + (voff)[_i]), (PG8_LAS unsigned*)(lds + (bufoff) + ldsw + _i * 8192), 16, 0, 0); } while (0)
#define PG8_LDA(dst, b, h) do { _Pragma("unroll") for (int m = 0; m < 4; ++m) _Pragma("unroll") for (int k = 0; k < 2; ++k) dst[m][k] = *(const PG8_LAS bf16x8*)(lds + PG8_SA(b, h) + aoff + m * 2048 + k * 1024); } while (0)
#define PG8_LDB(dst, b, h) do { _Pragma("unroll") for (int n = 0; n < 2; ++n) _Pragma("unroll") for (int k = 0; k < 2; ++k) dst[n][k] = *(const PG8_LAS bf16x8*)(lds + PG8_SB(b, h) + boff + n * 2048 + k * 1024); } while (0)
#define PG8_MMA(ai, bj, At, Bt) do { __builtin_amdgcn_s_setprio(1); _Pragma("unroll") for (int m = 0; m < 4; ++m) _Pragma("unroll") for (int n = 0; n < 2; ++n) _Pragma("unroll") for (int k = 0; k < 2; ++k) \
        acc[ai][bj][m][n] = __builtin_amdgcn_mfma_f32_16x16x32_bf16(Bt[n][k], At[m][k], acc[ai][bj][m][n], 0, 0, 0); __builtin_amdgcn_s_setprio(0); } while (0)
#define PG8_WAIT_V(n) asm volatile("s_waitcnt vmcnt(" #n ")" ::: "memory")
#define PG8_WAIT_L(n) asm volatile("s_waitcnt lgkmcnt(" #n ")" ::: "memory")
#define PG8_BAR __builtin_amdgcn_s_barrier()
#define PG8_SCHED __builtin_amdgcn_sched_barrier(0)
    Unit cur, nxt; int ui = 0;
    if (!S.next(0, cur)) return;
    f32x4 acc[2][2][4][2];
#pragma unroll
    for (int a = 0; a < 2; ++a)
#pragma unroll
        for (int b = 0; b < 2; ++b)
#pragma unroll
            for (int m = 0; m < 4; ++m)
#pragma unroll
                for (int n = 0; n < 2; ++n) acc[a][b][m][n] = (f32x4){0.f, 0.f, 0.f, 0.f};
    bf16x8 At[4][2], B0[2][2], B1[2][2];
    const char* cA = (const char*)g.A + (size_t)cur.pm * tstep; const char* cB = (const char*)g.Bt + (size_t)cur.pn * tstep;
    S.a_ready(cur);
    if constexpr (SP2) {
        PG8_STAGE(PG8_SB(0, 0), cB, voffB); PG8_STAGE(PG8_SB(0, 1), cB + hstep, voffB); PG8_STAGE(PG8_SA(0, 0), cA, voffA); PG8_STAGE(PG8_SA(0, 1), cA + hstep, voffA);
        if (wr == 1) PG8_BAR;
        PG8_WAIT_V(2); PG8_BAR;
        PG8_STAGE(PG8_SB(1, 0), cB + kstep, voffB); PG8_STAGE(PG8_SA(1, 0), cA + kstep, voffA); PG8_STAGE(PG8_SB(1, 1), cB + hstep + kstep, voffB);
        PG8_WAIT_V(6); PG8_BAR;
    } else {
        PG8_STAGE(PG8_SB(0, 0), cB, voffB); PG8_STAGE(PG8_SA(0, 0), cA, voffA); PG8_STAGE(PG8_SB(0, 1), cB + hstep, voffB); PG8_STAGE(PG8_SA(0, 1), cA + hstep, voffA);
        if (wr == 1) PG8_BAR;
        PG8_WAIT_V(4); PG8_BAR;
        PG8_STAGE(PG8_SB(1, 0), cB + kstep, voffB); PG8_STAGE(PG8_SA(1, 0), cA + kstep, voffA); PG8_STAGE(PG8_SB(1, 1), cB + hstep + kstep, voffB);
        PG8_WAIT_V(6); PG8_BAR;
    }
    for (;;) {
        const bool has_next = S.next(ui + 1, nxt);
        const char* nA = has_next ? (const char*)g.A + (size_t)nxt.pm * tstep : cA; const char* nB = has_next ? (const char*)g.Bt + (size_t)nxt.pn * tstep : cB;
        for (int t = 0; t < nt; t += 2) {
            const bool last = (t == nt - 2);
            const char* a1 = cA + (size_t)(t + 1) * kstep;
            const char* a2 = last ? nA : cA + (size_t)(t + 2) * kstep; const char* b2 = last ? nB : cB + (size_t)(t + 2) * kstep;
            const char* a3 = a2 + kstep; const char* b3 = b2 + kstep;
            if (last && has_next) S.a_ready(nxt);
            if constexpr (SP2) {
            PG8_LDB(B0, 0, 0); PG8_LDB(B1, 0, 1); PG8_SCHED; PG8_LDA(At, 0, 0); PG8_STAGE(PG8_SA(1, 1), a1 + hstep, voffA);
            PG8_WAIT_V(8); PG8_WAIT_L(0); PG8_BAR; PG8_MMA(0, 0, At, B0); PG8_MMA(0, 1, At, B1); PG8_BAR; PG8_SCHED;
            PG8_LDA(At, 0, 1); PG8_STAGE(PG8_SB(0, 0), b2, voffB); PG8_STAGE(PG8_SB(0, 1), b2 + hstep, voffB); PG8_STAGE(PG8_SA(0, 0), a2, voffA);
            PG8_WAIT_V(8); PG8_WAIT_L(0); PG8_BAR; PG8_MMA(1, 0, At, B0); PG8_MMA(1, 1, At, B1); PG8_BAR; PG8_SCHED;
            PG8_LDB(B0, 1, 0); PG8_LDB(B1, 1, 1); PG8_SCHED; PG8_LDA(At, 1, 0); PG8_STAGE(PG8_SA(0, 1), a2 + hstep, voffA);
            PG8_WAIT_V(8); PG8_WAIT_L(0); PG8_BAR; PG8_MMA(0, 0, At, B0); PG8_MMA(0, 1, At, B1); PG8_BAR; PG8_SCHED;
            PG8_LDA(At, 1, 1); PG8_STAGE(PG8_SB(1, 0), b3, voffB); PG8_STAGE(PG8_SB(1, 1), b3 + hstep, voffB); PG8_STAGE(PG8_SA(1, 0), a3, voffA);
            PG8_WAIT_V(8); PG8_WAIT_L(0); PG8_BAR; PG8_MMA(1, 0, At, B0); PG8_MMA(1, 1, At, B1); PG8_BAR; PG8_SCHED;
            } else {
            PG8_LDB(B0, 0, 0); PG8_SCHED; PG8_LDA(At, 0, 0); PG8_STAGE(PG8_SA(1, 1), a1 + hstep, voffA);
            PG8_WAIT_L(8); PG8_BAR; PG8_WAIT_L(0); PG8_MMA(0, 0, At, B0); PG8_BAR; PG8_SCHED;
            PG8_LDB(B1, 0, 1); PG8_STAGE(PG8_SB(0, 0), b2, voffB);
            PG8_BAR; PG8_WAIT_L(0); PG8_MMA(0, 1, At, B1); PG8_BAR;
            PG8_LDA(At, 0, 1); PG8_STAGE(PG8_SA(0, 0), a2, voffA);
            PG8_BAR; PG8_WAIT_L(0); PG8_MMA(1, 0, At, B0); PG8_BAR; PG8_SCHED;
            PG8_STAGE(PG8_SB(0, 1), b2 + hstep, voffB);
            PG8_WAIT_V(6); PG8_BAR; PG8_MMA(1, 1, At, B1); PG8_BAR;
            PG8_LDB(B0, 1, 0); PG8_SCHED; PG8_LDA(At, 1, 0); PG8_STAGE(PG8_SA(0, 1), a2 + hstep, voffA);
            PG8_WAIT_L(8); PG8_BAR; PG8_WAIT_L(0); PG8_MMA(0, 0, At, B0); PG8_BAR; PG8_SCHED;
            PG8_LDB(B1, 1, 1); PG8_STAGE(PG8_SB(1, 0), b3, voffB);
            PG8_BAR; PG8_WAIT_L(0); PG8_MMA(0, 1, At, B1); PG8_BAR;
            PG8_LDA(At, 1, 1); PG8_STAGE(PG8_SA(1, 0), a3, voffA);
            PG8_BAR; PG8_WAIT_L(0); PG8_MMA(1, 0, At, B0); PG8_BAR; PG8_SCHED;
            PG8_STAGE(PG8_SB(1, 1), b3 + hstep, voffB);
            PG8_WAIT_V(6); PG8_BAR; PG8_MMA(1, 1, At, B1); PG8_BAR;
            }
        }
        if constexpr (ALIGN_EPI) { if (wr == 0) PG8_BAR; }
        if constexpr (!Epi::AFTER_DRAIN) { E(acc, cur, wr, wc, fr, fq); S.done(cur); }
        if (!has_next) break;
#pragma unroll
        for (int a = 0; a < 2; ++a)
#pragma unroll
            for (int b = 0; b < 2; ++b)
#pragma unroll
                for (int m = 0; m < 4; ++m)
#pragma unroll
                    for (int n = 0; n < 2; ++n) acc[a][b][m][n] = (f32x4){0.f, 0.f, 0.f, 0.f};
        cur = nxt; cA = nA; cB = nB; ++ui;
        if constexpr (ALIGN_EPI) { if (wr == 1) PG8_BAR; }
    }
    PG8_WAIT_V(0);
    if constexpr (!ALIGN_EPI) { if (wr == 0) PG8_BAR; }
    PG8_BAR;
    if constexpr (Epi::AFTER_DRAIN) { E.fused(acc, cur, wr, wc, fr, fq, lds, wid, lane); S.done(cur); }
#undef PG8_SA
#undef PG8_SB
#undef PG8_STAGE
#undef PG8_LDA
#undef PG8_LDB
#undef PG8_MMA
#undef PG8_WAIT_V
#undef PG8_WAIT_L
#undef PG8_BAR
#undef PG8_SCHED
}
}

#define LAS __attribute__((address_space(3)))
constexpr int NWAVES = 8, NTHR = 512;
constexpr int LDS_BYTES = 147456;
constexpr int NPH = 21;
typedef float f32x4 __attribute__((ext_vector_type(4)));
typedef unsigned u32x4 __attribute__((ext_vector_type(4)));

struct Args { const float* in[30]; float* out; unsigned char* ws; int ph_lo, ph_hi; };

__device__ __forceinline__ unsigned pk2(float lo, float hi) { return (unsigned)f2bf(lo) | ((unsigned)f2bf(hi) << 16); }

__device__ __forceinline__ void p0_transpose_item(const float* W, int K, int N, bf16* WT, int row_off, LAS float* scr, int item, int lane) {
    const int nblk = N / 32, kb = item / nblk, nb = item % nblk, k0 = 64 * kb, n0 = 32 * nb;
#pragma unroll 8
    for (int i = 0; i < 32; ++i) { const int kk = 2 * i + (lane >> 5); scr[kk * 33 + (lane & 31)] = W[(size_t)(k0 + kk) * N + n0 + (lane & 31)]; }
    asm volatile("s_waitcnt lgkmcnt(0)" ::: "memory");
    const int c = lane & 7;
#pragma unroll
    for (int j = 0; j < 4; ++j) { const int n = (lane >> 3) + 8 * j; const LAS float* s = scr + (8 * c) * 33 + n;
        u32x4 o; o.x = pk2(s[0 * 33], s[1 * 33]); o.y = pk2(s[2 * 33], s[3 * 33]); o.z = pk2(s[4 * 33], s[5 * 33]); o.w = pk2(s[6 * 33], s[7 * 33]);
        *(u32x4*)(WT + (size_t)(row_off + n0 + n) * K + k0 + 8 * c) = o; }
    asm volatile("s_waitcnt lgkmcnt(0)" ::: "memory");
}

__device__ __forceinline__ void norm_mod_row(const float* xr, const float* gamma, const float* sh, const float* sc, bf16* orow, int lane) {
    f32x4 v[4]; float ss = 0.f;
#pragma unroll
    for (int j = 0; j < 4; ++j) { v[j] = *(const f32x4*)(xr + j * 256 + lane * 4); ss += (v[j].x * v[j].x + v[j].y * v[j].y) + (v[j].z * v[j].z + v[j].w * v[j].w); }
    const float rs = rsqrtf(wave_sum(ss, lane) * (1.f / D) + NORM_EPS);
#pragma unroll
    for (int j = 0; j < 4; ++j) { const int d = j * 256 + lane * 4; const f32x4 g = *(const f32x4*)(gamma + d), a = *(const f32x4*)(sc + d), s = *(const f32x4*)(sh + d);
        const f32x4 y = v[j] * rs * g * (a + 1.f) + s; uint2 o; o.x = pk2(y.x, y.y); o.y = pk2(y.z, y.w); *(uint2*)(orow + d) = o; }
}


#define XB_TMO      128
#define XB_XCNT(j)  (256  + 64 * (j))
#define XB_XSUB(j)  (1280 + 64 * (j))
#define XB_XGEN(j)  (2304 + 64 * (j))
#define XB_TOP      3328
#define XB_TOPGEN   3392
#define XCD_BAR_WORDS 3456
#define XB_SPIN_CAP (1u << 18)

__device__ __forceinline__ unsigned xb_ld(unsigned* p)              { return __hip_atomic_load(p, __ATOMIC_RELAXED, __HIP_MEMORY_SCOPE_AGENT); }
__device__ __forceinline__ unsigned xb_add(unsigned* p, unsigned v) { return __hip_atomic_fetch_add(p, v, __ATOMIC_RELAXED, __HIP_MEMORY_SCOPE_AGENT); }
__device__ __forceinline__ unsigned xb_xcc_id() { return (unsigned)__builtin_amdgcn_s_getreg((3 << 11) | 20) & 0xFu; }
#define XB_SPIN(cond, bar) do { unsigned _sp = 0; while (cond) { __builtin_amdgcn_s_sleep(1); \
    if ((++_sp & 255u) == 0u) { if (xb_ld(&(bar)[XB_TMO])) break; if (_sp > XB_SPIN_CAP) { atomicAdd(&(bar)[XB_TMO], 1u); break; } } } } while (0)

struct XcdBarrier {
    unsigned* bar; unsigned x; int w0;
    volatile __attribute__((address_space(3))) unsigned* st;
};

__device__ __forceinline__ XcdBarrier xcd_barrier_post(unsigned* bar, volatile __attribute__((address_space(3))) unsigned* st) {
    XcdBarrier b; b.bar = bar; b.x = xb_xcc_id(); b.st = st; b.w0 = __builtin_amdgcn_readfirstlane((int)threadIdx.x >> 6);
    if (threadIdx.x == 0) (void)xb_add(&bar[XB_XCNT(b.x)], 1u);
    return b;
}
__device__ __forceinline__ void xcd_barrier_complete(unsigned* bar, unsigned x, unsigned& nloc, unsigned& nx) {
    const unsigned G = gridDim.x * gridDim.y * gridDim.z;
    unsigned sum, cnt, mine, sp = 0u;
    for (;;) {
        sum = 0u; cnt = 0u; mine = 0u;
#pragma unroll
        for (unsigned j = 0; j < 16; ++j) { const unsigned c = xb_ld(&bar[XB_XCNT(j)]); sum += c; cnt += (c > 0u) ? 1u : 0u; }
        mine = xb_ld(&bar[XB_XCNT(x)]);
        if (sum == G) break;
        __builtin_amdgcn_s_sleep(1);
        if ((++sp & 255u) == 0u) { if (xb_ld(&bar[XB_TMO])) break; if (sp > XB_SPIN_CAP) { atomicAdd(&bar[XB_TMO], 1u); break; } }
    }
    nloc = mine > 0u ? mine : 1u; nx = cnt > 0u ? cnt : 1u;
}

template <bool FIRST> __device__ __forceinline__ void xcd_barrier(const XcdBarrier& b) {
    asm volatile("s_waitcnt vmcnt(0)" ::: "memory");
    __syncthreads();
    int lid_; asm volatile("v_mbcnt_lo_u32_b32 %0, -1, 0\n\tv_mbcnt_hi_u32_b32 %0, -1, %0" : "=v"(lid_));
    if (b.w0 == 0 && lid_ == 0) {
        unsigned* bar = b.bar;
        __builtin_amdgcn_s_waitcnt(0);
        unsigned nloc = b.st[0], nx = b.st[1];
        if (FIRST && nloc == 0u) { xcd_barrier_complete(bar, b.x, nloc, nx); b.st[0] = nloc; b.st[1] = nx; }
        const unsigned old = xb_add(&bar[XB_XSUB(b.x)], 1u);
        const unsigned gen = old / nloc;
        if (old + 1u == (gen + 1u) * nloc) {
            __builtin_amdgcn_fence(__ATOMIC_RELEASE, "agent");
            asm volatile("s_waitcnt vmcnt(0)" ::: "memory");
            const unsigned og = xb_add(&bar[XB_TOP], 1u);
            const unsigned tg = og / nx;
            if (og + 1u == (tg + 1u) * nx) xb_add(&bar[XB_TOPGEN], 1u);
            else XB_SPIN(xb_ld(&bar[XB_TOPGEN]) == tg, bar);
            __builtin_amdgcn_fence(__ATOMIC_ACQUIRE, "agent");
            xb_add(&bar[XB_XGEN(b.x)], 1u);
            asm volatile("s_waitcnt vmcnt(0)" ::: "memory");
        } else {
            XB_SPIN(xb_ld(&bar[XB_XGEN(b.x)]) == gen, bar);
            __builtin_amdgcn_fence(__ATOMIC_ACQUIRE, "agent");
            asm volatile("s_waitcnt vmcnt(0)" ::: "memory");
        }
    }
    __syncthreads();
}


__device__ __forceinline__ unsigned mono_u32(float f) { unsigned u = __float_as_uint(f); return (u & 0x80000000u) ? ~u : (u | 0x80000000u); }
__device__ __forceinline__ float demono_u32(unsigned u) { return __uint_as_float((u & 0x80000000u) ? (u & 0x7FFFFFFFu) : ~u); }
__device__ __forceinline__ unsigned pack_key7(float f, int idx) { return (mono_u32(f) & 0xFFFFFF80u) | (unsigned)(127 - idx); }
__device__ __forceinline__ float unpack_key7(unsigned k) { return demono_u32((k & 0xFFFFFF80u) | 0x40u); }
__device__ __forceinline__ float unpack_key8(unsigned k) { return demono_u32((k & 0xFFFFFF00u) | 0x80u); }
__device__ __forceinline__ void ce_desc(unsigned& a, unsigned& b) { const unsigned hi = a > b ? a : b, lo = a > b ? b : a; a = hi; b = lo; }
__device__ __forceinline__ void sort16_desc(unsigned* v) {
#pragma unroll
    for (int k = 2; k <= 16; k <<= 1)
#pragma unroll
        for (int j = k >> 1; j > 0; j >>= 1)
#pragma unroll
            for (int i = 0; i < 16; ++i) { const int l = i ^ j; if (l > i) { if ((i & k) == 0) ce_desc(v[i], v[l]); else ce_desc(v[l], v[i]); } }
}
__device__ __forceinline__ void bmerge16_desc(unsigned* v) {
#pragma unroll
    for (int j = 8; j > 0; j >>= 1)
#pragma unroll
        for (int i = 0; i < 16; ++i) { const int l = i ^ j; if (l > i) ce_desc(v[i], v[l]); }
}
__device__ __forceinline__ void merge_top16(unsigned* a, const unsigned* b) {
#pragma unroll
    for (int i = 0; i < 16; ++i) { const unsigned o = b[15 - i]; a[i] = a[i] > o ? a[i] : o; }
    bmerge16_desc(a);
}
__device__ __forceinline__ void stage2_cands(const unsigned* s0, const unsigned* s1, int hh, unsigned* c) {
    float A[16], B[16];
#pragma unroll
    for (int i = 0; i < 16; ++i) { const float f0 = unpack_key7(s0[i]), f1 = unpack_key7(s1[i]); A[i] = hh ? f1 : f0; B[i] = hh ? f0 : f1; }
    int n = 0;
#pragma unroll
    for (int i = 0; i < 4; ++i)
#pragma unroll
        for (int j = i; j < 16; ++j) { if ((i + 1) * (j + 1) > 16) continue;
            const float val = A[i] + B[j]; const unsigned id = hh ? (unsigned)((j << 4) | i) : (unsigned)((i << 4) | j);
            unsigned key = (mono_u32(val) & 0xFFFFFF00u) | id; if (hh && i == j) key = 0u; c[n++] = key; }
#pragma unroll
    for (; n < 32; ++n) c[n] = 0u;
}

typedef short bf16x8_t __attribute__((ext_vector_type(8)));
typedef float f32x16 __attribute__((ext_vector_type(16)));
__device__ __forceinline__ float gelu_erf(float a) { return 0.5f * a * (1.f + erff(a * 0.70710678118654752f)); }


typedef __attribute__((address_space(3))) bf16 lbf16;
typedef float cvt_f32x2 __attribute__((ext_vector_type(2))); typedef __bf16 cvt_bf16x2 __attribute__((ext_vector_type(2)));
__device__ __forceinline__ unsigned cvtpk(float lo, float hi) { const cvt_f32x2 v = {lo, hi}; const cvt_bf16x2 b = __builtin_convertvector(v, cvt_bf16x2); return __builtin_bit_cast(unsigned, b); }
__device__ __forceinline__ f32x16 mm32(bf16x8_t a, bf16x8_t b, f32x16 c) { return __builtin_amdgcn_mfma_f32_32x32x16_bf16(a, b, c, 0, 0, 0); }
__device__ __forceinline__ bf16x8_t frag_from_u32x4(unsigned x, unsigned y, unsigned z, unsigned w) { typedef unsigned u4 __attribute__((ext_vector_type(4))); u4 t = {x, y, z, w}; return __builtin_bit_cast(bf16x8_t, t); }
template <int S> __device__ __forceinline__ bf16x8_t accop(const f32x16& z) {
    return frag_from_u32x4(cvtpk(z[8 * S], z[8 * S + 1]), cvtpk(z[8 * S + 2], z[8 * S + 3]), cvtpk(z[8 * S + 4], z[8 * S + 5]), cvtpk(z[8 * S + 6], z[8 * S + 7])); }
template <int S> __device__ __forceinline__ bf16x8_t ldpermcol(const lbf16* a, int col, int hh) {
    const lbf16* p = a + (16 * S + 4 * hh) * 72 + col;
    const unsigned e0 = p[0], e1 = p[72], e2 = p[144], e3 = p[216], e4 = p[8 * 72], e5 = p[9 * 72], e6 = p[10 * 72], e7 = p[11 * 72];
    return frag_from_u32x4(e0 | (e1 << 16), e2 | (e3 << 16), e4 | (e5 << 16), e6 | (e7 << 16)); }
__device__ __forceinline__ bf16x8_t ldrow(const lbf16* a, int row, int ks, int hh) { return *(const __attribute__((address_space(3))) bf16x8_t*)(a + row * 72 + ks * 16 + 8 * hh); }
__device__ __forceinline__ int rowidx(int e, int hh) { return (e & 3) + 8 * (e >> 2) + 4 * hh; }

__device__ __forceinline__ void convert_tables_fp8(const float* pu, const float* pv, unsigned char* u8, unsigned char* v8, float* usc, float* vsc, int l, int wv, int nw, int lane) {
    for (int rr0 = wv * 2; rr0 < 2 * NEXP; rr0 += nw * 2) {
        f32x4 v[2][4]; float m[2];
#pragma unroll
        for (int rr = 0; rr < 2; ++rr) { const int q = rr0 + rr; const size_t row = (size_t)l * NEXP + (q < NEXP ? q : q - NEXP); const float* sp_ = (q < NEXP ? pu : pv) + row * D + lane * 16;
#pragma unroll
            for (int k = 0; k < 4; ++k) v[rr][k] = *(const f32x4*)(sp_ + k * 4); }
#pragma unroll
        for (int rr = 0; rr < 2; ++rr) { float mm = 0.f;
#pragma unroll
            for (int k = 0; k < 4; ++k) mm = fmaxf(fmaxf(mm, fmaxf(fabsf(v[rr][k].x), fabsf(v[rr][k].y))), fmaxf(fabsf(v[rr][k].z), fabsf(v[rr][k].w)));
#pragma unroll
            for (int o = 1; o < 64; o <<= 1) mm = fmaxf(mm, shflx(mm, lane, o));
            m[rr] = mm; }
#pragma unroll
        for (int rr = 0; rr < 2; ++rr) { const int q = rr0 + rr; const size_t row = (size_t)l * NEXP + (q < NEXP ? q : q - NEXP); const float sc = m[rr] > 0.f ? 448.f / m[rr] : 1.f;
            u32x4 o; int w;
            w = 0; w = __builtin_amdgcn_cvt_pk_fp8_f32(v[rr][0].x * sc, v[rr][0].y * sc, w, false); w = __builtin_amdgcn_cvt_pk_fp8_f32(v[rr][0].z * sc, v[rr][0].w * sc, w, true); o.x = (unsigned)w;
            w = 0; w = __builtin_amdgcn_cvt_pk_fp8_f32(v[rr][1].x * sc, v[rr][1].y * sc, w, false); w = __builtin_amdgcn_cvt_pk_fp8_f32(v[rr][1].z * sc, v[rr][1].w * sc, w, true); o.y = (unsigned)w;
            w = 0; w = __builtin_amdgcn_cvt_pk_fp8_f32(v[rr][2].x * sc, v[rr][2].y * sc, w, false); w = __builtin_amdgcn_cvt_pk_fp8_f32(v[rr][2].z * sc, v[rr][2].w * sc, w, true); o.z = (unsigned)w;
            w = 0; w = __builtin_amdgcn_cvt_pk_fp8_f32(v[rr][3].x * sc, v[rr][3].y * sc, w, false); w = __builtin_amdgcn_cvt_pk_fp8_f32(v[rr][3].z * sc, v[rr][3].w * sc, w, true); o.w = (unsigned)w;
            *(u32x4*)((q < NEXP ? u8 : v8) + row * D + lane * 16) = o;
            if (lane == 0) (q < NEXP ? usc : vsc)[row] = m[rr] > 0.f ? m[rr] * (1.f / 448.f) : 1.f; }
    }
}

__global__ void __launch_bounds__(NTHR, 2) mega(Args args) {
    extern __shared__ __attribute__((aligned(16))) unsigned char lds_raw[];
    LAS unsigned char* lds = (LAS unsigned char*)lds_raw;
    const int G = gridDim.x, bx = blockIdx.x, NGW = G * NWAVES;
    const int wave0 = __builtin_amdgcn_readfirstlane((int)threadIdx.x >> 6);
    typedef const unsigned char __attribute__((address_space(4))) kbyte;
#define PHASE_IDS int tid; asm volatile("v_mbcnt_lo_u32_b32 %0, -1, 0\n\tv_mbcnt_hi_u32_b32 %0, -1, %0" : "=v"(tid)); tid += wave0 * 64;     const int lane = tid & 63, wave = __builtin_amdgcn_readfirstlane(tid >> 6), gw = bx * NWAVES + wave; (void)lane; (void)gw; \
    kbyte* kp = (kbyte*)__builtin_amdgcn_kernarg_segment_ptr(); asm volatile("" : "+s"(kp)); \
    unsigned char* const ws = (unsigned char*)*(__attribute__((address_space(1))) unsigned char* const __attribute__((address_space(4)))*)(kp + 31 * 8); float* const X = (float*)*(__attribute__((address_space(1))) float* const __attribute__((address_space(4)))*)(kp + 30 * 8); (void)ws; (void)X;
#define INP(i) ((const float*)(*(const __attribute__((address_space(1))) float* const __attribute__((address_space(4)))*)(kp + (i) * 8)))
#define MOD ((float*)(ws + WS_MOD))
#define H ((bf16*)(ws + WS_H))
#define PROJ ((bf16*)(ws + WS_PROJ))
#define Q ((bf16*)(ws + WS_Q))
#define MIX ((bf16*)(ws + WS_MIX))
#define Rb ((bf16*)(ws + WS_R))
#define Kb ((bf16*)(ws + WS_K))
#define V0 ((bf16*)(ws + WS_V0))
#define V1 ((bf16*)(ws + WS_V1))
#define KKb ((bf16*)(ws + WS_KK))
#define Bb ((bf16*)(ws + WS_B))
#define Gb ((bf16*)(ws + WS_G))
#define BGb ((bf16*)(ws + WS_BG))
#define Wd ((float*)(ws + WS_W))
#define Y ((float*)(ws + WS_Y))
#define QB ((float*)(ws + WS_QB))
#define SH ((float*)(ws + WS_SH))
#define WUPT ((bf16*)(ws + WS_LORA))
#define AUPT ((bf16*)(ws + WS_LORA + 131072))
#define GUPT ((bf16*)(ws + WS_LORA + 262144))
#define VUPT ((bf16*)(ws + WS_LORA + 524288))
#define PWT ((bf16*)(ws + WS_LORA + 655360))
#define INVN ((float*)(ws + WS_INVN))
#define BSUM ((float*)(ws + WS_BSUM))
#define SCN ((unsigned char*)(ws + WS_SCN))
#define IDX ((int*)(ws + WS_IDX))
#define GATE ((float*)(ws + WS_GATE))
#define WinT ((bf16*)(ws + WS_WIN_T))
#define WoutT ((bf16*)(ws + WS_WOUT_T))
#define PqT ((bf16*)(ws + WS_PQ_T))
#define KEYS ((bf16*)(ws + WS_KEYS))
#define U8 ((unsigned char*)(ws + WS_U))
#define V8 ((unsigned char*)(ws + WS_V))
#define USc ((float*)(ws + WS_US))
#define VSc ((float*)(ws + WS_VS))
    const int lo = args.ph_lo, hi = args.ph_hi;
    { volatile LAS unsigned* misc = (volatile LAS unsigned*)(lds + LDS_BYTES - 64); if (threadIdx.x < 4) misc[threadIdx.x] = 0u; __syncthreads(); }
    const XcdBarrier xbar = xcd_barrier_post((unsigned*)(args.ws) + 4096, (volatile LAS unsigned*)(lds + LDS_BYTES - 64));
#define IN(k) (lo <= (k) && (k) < hi)
#ifndef REP_PHASE
#define REP_PHASE (-1)
#endif
#define REPS(k) ((k) == REP_PHASE ? 3 : 1)
#define SEAM(k) do { if (IN(k) && IN((k) + 1)) { if ((k) == 0) cg::this_grid().sync(); else { XcdBarrier xb_ = xbar; asm volatile("" : "+s"(xb_.bar)); if ((k) == 1) xcd_barrier<true>(xb_); else xcd_barrier<false>(xb_); } } } while (0)

    if (IN(0)) { PHASE_IDS
        { LAS float* ca = (LAS float*)lds; LAS float* red = (LAS float*)(lds + 16384);
          const float* c = INP(1); const float* ada_w = INP(2); const float* ada_b = INP(3);
          bool have = false;
          for (int it = bx; it < 96; it += G) {
              if (!have) { for (int i = tid; i < BATCH * D; i += NTHR) { const float v = c[i]; ca[i] = v / (1.f + expf(-v)); } have = true; __syncthreads(); }
              const int l = it / 48, n = (it % 48) * 128 + (tid & 127), kq = tid >> 7;
              const float* w = ada_w + (size_t)l * D * 6 * D + (size_t)(kq * 256) * 6 * D + n;
              float a0 = 0.f, a1 = 0.f, a2 = 0.f, a3 = 0.f;
#pragma unroll 32
              for (int k = 0; k < 256; ++k) { const float wv = w[(size_t)k * 6 * D]; const int kk = kq * 256 + k; a0 += ca[kk] * wv; a1 += ca[D + kk] * wv; a2 += ca[2 * D + kk] * wv; a3 += ca[3 * D + kk] * wv; }
              red[(kq * 4 + 0) * 128 + (tid & 127)] = a0; red[(kq * 4 + 1) * 128 + (tid & 127)] = a1; red[(kq * 4 + 2) * 128 + (tid & 127)] = a2; red[(kq * 4 + 3) * 128 + (tid & 127)] = a3;
              __syncthreads();
              { const int b = tid >> 7, col = tid & 127, nn = (it % 48) * 128 + col;
                const float s = red[(0 * 4 + b) * 128 + col] + red[(1 * 4 + b) * 128 + col] + red[(2 * 4 + b) * 128 + col] + red[(3 * 4 + b) * 128 + col];
                MOD[(size_t)l * BATCH * 6 * D + (size_t)b * 6 * D + nn] = s + ada_b[l * 6 * D + nn]; }
              __syncthreads();
          }
          __syncthreads(); }
        { LAS float* scr = (LAS float*)(lds + wave * 16384);
          constexpr int I_IN = (D / 64) * (IN_COLS / 32), I_VR = (D / 64) * (MVL / 32), I_OUT = (D / 64) * (D / 32), I_PQ = (D / 64) * (PH * PQ / 32);
          constexpr int NIT = 2 * I_IN + I_VR + 2 * I_OUT + 2 * I_PQ;
          for (int it = gw; it < NIT; it += NGW) { int r = it;
              if (r < 2 * I_IN) { const int l = r / I_IN; p0_transpose_item(INP(5) + (size_t)l * D * IN_COLS, D, IN_COLS, WinT + (size_t)l * LDP * D, 0, scr, r % I_IN, lane); continue; } r -= 2 * I_IN;
              if (r < I_VR) { p0_transpose_item(INP(12), D, MVL, WinT + (size_t)1 * LDP * D, IN_COLS, scr, r, lane); continue; } r -= I_VR;
              if (r < 2 * I_OUT) { const int l = r / I_OUT; p0_transpose_item(INP(23) + (size_t)l * D * D, D, D, WoutT + (size_t)l * D * D, 0, scr, r % I_OUT, lane); continue; } r -= 2 * I_OUT;
              { const int l = r / I_PQ; p0_transpose_item(INP(25) + (size_t)l * D * PH * PQ, D, PH * PQ, PqT + (size_t)l * PH * PQ * D, 0, scr, r % I_PQ, lane); } }
          for (int it = gw; it < 2 * 16 + 2 * 16 + 2 * 32; it += NGW) { int r = it;
              if (r < 32) { const int l = r / 16; p0_transpose_item(INP(8) + (size_t)l * DL * RW, DL, RW, WUPT + (size_t)l * RW * DL, 0, scr, r % 16, lane); continue; } r -= 32;
              if (r < 32) { const int l = r / 16; p0_transpose_item(INP(10) + (size_t)l * AL * RW, AL, RW, AUPT + (size_t)l * RW * AL, 0, scr, r % 16, lane); continue; } r -= 32;
              { const int l = r / 32; p0_transpose_item(INP(11) + (size_t)l * GL * RW, GL, RW, GUPT + (size_t)l * RW * GL, 0, scr, r % 32, lane); } }
          { const float* vu = INP(15); for (int e = bx * NTHR + tid; e < MVL * RW; e += G * NTHR) { const int n = e >> 5, k = e & 31; VUPT[e] = f2bf(vu[k * RW + n]); } }
          for (int it = gw; it < 8 * 8; it += NGW) p0_transpose_item(INP(21) + (size_t)(it >> 3) * PG * PG, PG, PG, PWT + (size_t)(it >> 3) * PG * PG, 0, scr, it & 7, lane);
        }
        { const size_t gt = (size_t)bx * NTHR + tid, NT = (size_t)G * NTHR;
          constexpr size_t NK8 = (size_t)2 * PH * 2 * NKEYS * PHALF / 8;
          const float* src = INP(26); bf16* dst = KEYS;
          for (size_t i = gt; i < NK8; i += NT) {
              const f32x4 a = *(const f32x4*)(src + i * 8), b = *(const f32x4*)(src + i * 8 + 4);
              u32x4 o; o.x = pk2(a.x, a.y); o.y = pk2(a.z, a.w); o.z = pk2(b.x, b.y); o.w = pk2(b.z, b.w); *(u32x4*)(dst + i * 8) = o; }
        }
    }
    SEAM(0);

#pragma unroll
    for (int l = 0; l < DEPTH; ++l) {
        const int pb = 1 + 10 * l;
#define modl (MOD + (size_t)l * BATCH * 6 * D)
#define xin (l == 0 ? INP(0) : (const float*)X)
        if (l == 0 && IN(pb + 0)) { PHASE_IDS const float* gamma = INP(4) + l * D;
            for (int row = gw; row < T; row += NGW) { const int b = row / SEQ; norm_mod_row(xin + (size_t)row * D, gamma, modl + (size_t)b * 6 * D, modl + (size_t)b * 6 * D + D, H + (size_t)row * D, lane); } }
        SEAM(pb + 0);
        if (IN(pb + 1)) { PHASE_IDS const int N1 = l == 0 ? IN_COLS : LDP;
            pg8::Gemm g{H, WinT + (size_t)l * LDP * D, T, N1, D}; pg8::StaticOrder S; S.init(T, N1, G, bx);
            pg8::EpiBf16<0> E{PROJ, LDP, nullptr, 0, 0, 1.f};
            pg8::gemm_phase<pg8::EpiBf16<0>, pg8::StaticOrder, true, true>(lds, g, S, E, tid); }
        SEAM(pb + 1);

        if (IN(pb + 2)) { PHASE_IDS
            constexpr int LST = 296;
            LAS bf16* lin = (LAS bf16*)lds;
            const float* mu = INP(6) + l * RWKV_COLS; const float* vmu = INP(13);
            const float* w0p = INP(7) + l * RW; const float* a0p = INP(9) + l * RW; const float* kkp = INP(16) + l * RW; const float* kap = INP(17) + l * RW; const float* rkp = INP(18) + l * RW; const float* v0p = INP(14);
            const bf16* wupT = WUPT + (size_t)l * RW * DL; const bf16* aupT = AUPT + (size_t)l * RW * AL; const bf16* gupT = GUPT + (size_t)l * RW * GL; const bf16* vupT = VUPT;
            bf16* Vl = l == 0 ? V0 : V1;
            const int r32 = lane & 31, hh = lane >> 5, h = wave;
            for (int tile = bx; tile < T / 32; tile += G) {
                const int t0 = tile * 32;
                __syncthreads();
#pragma unroll 1
                for (int it0 = 0; it0 < 3; it0 += 2) {
                  u32x4 cu_[2], pv_[2]; f32x4 m0_[2], m1_[2];
#pragma unroll
                  for (int it = 0; it < 2; ++it) { const int c8 = tid + (it0 + it) * NTHR; const bool ok = c8 < 32 * 36; const int tok = ok ? c8 / 36 : 0, jc = ok ? c8 % 36 : 0, t = t0 + tok, sq = t % SEQ;
                      cu_[it] = (u32x4){0u, 0u, 0u, 0u}; pv_[it] = (u32x4){0u, 0u, 0u, 0u}; m0_[it] = (f32x4){0.f, 0.f, 0.f, 0.f}; m1_[it] = m0_[it];
                      if (ok && (jc < 32 || l > 0)) { const int col = jc < 32 ? 3 * RW + jc * 8 : IN_COLS + (jc - 32) * 8;
                          cu_[it] = *(const u32x4*)(PROJ + (size_t)t * LDP + col); if (sq > 0) pv_[it] = *(const u32x4*)(PROJ + (size_t)(t - 1) * LDP + col);
                          const float* mp = jc < 32 ? mu + col : vmu + (jc - 32) * 8; m0_[it] = *(const f32x4*)mp; m1_[it] = *(const f32x4*)(mp + 4); } }
#pragma unroll
                  for (int it = 0; it < 2; ++it) { const int c8 = tid + (it0 + it) * NTHR; if (c8 < 32 * 36) { const int tok = c8 / 36, jc = c8 % 36;
                      u32x4 o = {0u, 0u, 0u, 0u};
                      if (jc < 32 || l > 0) {
                          float x[8]; const unsigned cw[4] = {cu_[it].x, cu_[it].y, cu_[it].z, cu_[it].w}, pw[4] = {pv_[it].x, pv_[it].y, pv_[it].z, pv_[it].w}; const float mm[8] = {m0_[it].x, m0_[it].y, m0_[it].z, m0_[it].w, m1_[it].x, m1_[it].y, m1_[it].z, m1_[it].w};
#pragma unroll
                          for (int i = 0; i < 4; ++i) { const float c0 = __uint_as_float(cw[i] << 16), c1 = __uint_as_float(cw[i] & 0xffff0000u), p0 = __uint_as_float(pw[i] << 16), p1 = __uint_as_float(pw[i] & 0xffff0000u);
                              x[2 * i] = c0 + (p0 - c0) * mm[2 * i]; x[2 * i + 1] = c1 + (p1 - c1) * mm[2 * i + 1]; }
                          if (jc < 8) {
#pragma unroll
                              for (int i = 0; i < 8; ++i) { const float e2 = __expf(-2.f * fabsf(x[i])); const float th = (1.f - e2) * __builtin_amdgcn_rcpf(1.f + e2); x[i] = x[i] < 0.f ? -th : th; } }
                          else if (jc >= 16 && jc < 32) {
#pragma unroll
                              for (int i = 0; i < 8; ++i) x[i] = __builtin_amdgcn_rcpf(1.f + __expf(-x[i])); }
                          o.x = pk2(x[0], x[1]); o.y = pk2(x[2], x[3]); o.z = pk2(x[4], x[5]); o.w = pk2(x[6], x[7]);
                      }
                      *(LAS u32x4*)(lin + tok * LST + jc * 8) = o; } } }
                __syncthreads();
                float ssq[16], bsm[16];
#pragma unroll
                for (int e = 0; e < 16; ++e) { ssq[e] = 0.f; bsm[e] = 0.f; }
                const bool first = (t0 % SEQ) == 0;
#pragma unroll 1
                for (int rt = 0; rt < 2; ++rt) {
                    f32x16 accW, accA, accG, accV;
#pragma unroll
                    for (int e = 0; e < 16; ++e) { accW[e] = 0.f; accA[e] = 0.f; accG[e] = 0.f; accV[e] = 0.f; }
                    int c = h * HS + rt * 32 + r32;
int hh8 = 8 * hh; asm volatile("" : "+v"(c), "+v"(hh8));
                    const LAS bf16* lrow = lin + r32 * LST + 8 * hh;
#pragma unroll
                    for (int ks = 0; ks < 4; ++ks) { const bf16x8_t wv = *(const bf16x8_t*)(wupT + (size_t)c * DL + ks * 16 + hh8); const bf16x8_t xq = *(const LAS bf16x8_t*)(lrow + ks * 16); accW = __builtin_amdgcn_mfma_f32_32x32x16_bf16(xq, wv, accW, 0, 0, 0); }
#pragma unroll
                    for (int ks = 0; ks < 4; ++ks) { const bf16x8_t wv = *(const bf16x8_t*)(aupT + (size_t)c * AL + ks * 16 + hh8); const bf16x8_t xq = *(const LAS bf16x8_t*)(lrow + 64 + ks * 16); accA = __builtin_amdgcn_mfma_f32_32x32x16_bf16(xq, wv, accA, 0, 0, 0); }
#pragma unroll
                    for (int ks = 0; ks < 8; ++ks) { const bf16x8_t wv = *(const bf16x8_t*)(gupT + (size_t)c * GL + ks * 16 + hh8); const bf16x8_t xq = *(const LAS bf16x8_t*)(lrow + 128 + ks * 16); accG = __builtin_amdgcn_mfma_f32_32x32x16_bf16(xq, wv, accG, 0, 0, 0); }
                    if (l > 0) {
#pragma unroll
                        for (int ks = 0; ks < 2; ++ks) { const bf16x8_t wv = *(const bf16x8_t*)(vupT + (size_t)c * MVL + ks * 16 + hh8); const bf16x8_t xq = *(const LAS bf16x8_t*)(lrow + 256 + ks * 16); accV = __builtin_amdgcn_mfma_f32_32x32x16_bf16(xq, wv, accV, 0, 0, 0); } }
                    const float mur = mu[c], muk = mu[RW + c], muv = mu[2 * RW + c], w0c = w0p[c], a0c = a0p[c], kkc = kkp[c], kac = kap[c], rkc = rkp[c];
                    const float v0c = l > 0 ? v0p[c] : 0.f;
#pragma unroll
                    for (int eb = 0; eb < 16; eb += 4) {
                        bf16 lr[4], lk[4], lv[4], lrp[4], lkp[4], lvp[4], lvf[4];
#pragma unroll
                        for (int i = 0; i < 4; ++i) { const int e = eb + i; const int tok = (e & 3) + 8 * (e >> 2) + 4 * hh, t = t0 + tok; const bool hasprev = !(first && tok == 0);
                            const bf16* pr = PROJ + (size_t)t * LDP + c;
                            lr[i] = pr[0]; lk[i] = pr[RW]; lv[i] = pr[2 * RW];
                            lrp[i] = hasprev ? pr[-LDP] : (bf16)0; lkp[i] = hasprev ? pr[RW - LDP] : (bf16)0; lvp[i] = hasprev ? pr[2 * RW - LDP] : (bf16)0;
                            lvf[i] = l > 0 ? V0[(size_t)t * RW + c] : (bf16)0; }
                        __builtin_amdgcn_sched_barrier(0);
#pragma unroll
                        for (int i = 0; i < 4; ++i) { const int e = eb + i; const int tok = (e & 3) + 8 * (e >> 2) + 4 * hh, t = t0 + tok; const size_t o = (size_t)t * RW + c;
                            float r = bf2f(lr[i]), k = bf2f(lk[i]), v = bf2f(lv[i]);
                            r += (bf2f(lrp[i]) - r) * mur; k += (bf2f(lkp[i]) - k) * muk; v += (bf2f(lvp[i]) - v) * muv;
                            const float z = -(w0c + accW[e]); const float sp = fmaxf(z, 0.f) + __logf(1.f + __expf(-fabsf(z)));
                            const float decay = __expf(-__expf(-sp - 0.5f));
                            const float a = __builtin_amdgcn_rcpf(1.f + __expf(-(a0c + accA[e]))); const float g = accG[e];
                            if (l > 0) { const float vfv = bf2f(lvf[i]); v = v + (vfv - v) * __builtin_amdgcn_rcpf(1.f + __expf(-(v0c + accV[e]))); }
                            const float kk = k * kkc; const float k2 = k * (1.f + (a - 1.f) * kac);
                            ssq[e] += kk * kk; bsm[e] += r * k2 * rkc;
                            Rb[o] = f2bf(r); Kb[o] = f2bf(k2); Vl[o] = f2bf(v); KKb[o] = f2bf(kk); Bb[o] = f2bf(kk * a); Gb[o] = f2bf(g); BGb[o] = f2bf(v * g); Wd[o] = decay;
                        }
                    }
                }
#pragma unroll
                for (int e = 0; e < 16; ++e) { float a_ = red16(ssq[e]), b_ = red16(bsm[e]); a_ += shflx(a_, lane, 16); b_ += shflx(b_, lane, 16); ssq[e] = a_; bsm[e] = b_; }
                if (r32 == 0) {
#pragma unroll
                    for (int e = 0; e < 16; ++e) { const int tok = (e & 3) + 8 * (e >> 2) + 4 * hh; INVN[(size_t)(t0 + tok) * NH + h] = rsqrtf(fmaxf(ssq[e], 1e-24f)); BSUM[(size_t)(t0 + tok) * NH + h] = bsm[e]; } }
            }
            {
                constexpr int DST = 520;
                int lane_p; asm volatile("v_mbcnt_lo_u32_b32 %0, -1, 0\n\tv_mbcnt_hi_u32_b32 %0, -1, %0" : "=v"(lane_p)); const int r32 = lane_p & 31, hh = lane_p >> 5;
                lbf16* dlb = (lbf16*)lds;
                const int c = tid, g = c >> 7, win = 2 << g;
                const bf16* pwt = PWT + (size_t)(l * 4 + (wave >> 1)) * PG * PG; const float* psc = INP(22) + l * PW;
                for (int tile = bx; tile < T / 32; tile += G) {
                    const int t0 = tile * 32; const bool first = (t0 % SEQ) == 0;
                    __syncthreads();
                    float p[47];
#pragma unroll
                    for (int j = 0; j < 47; ++j) p[j] = (j >= 15 || !first) ? bf2f(PROJ[(size_t)(t0 - 15 + j) * LDP + RWKV_COLS + c]) : 0.f;
                    float sw = 0.f;
#pragma unroll
                    for (int j = 1; j <= 15; ++j) sw += (j < win) ? p[15 - j] : 0.f;
                    const float invw = 1.f / (float)win;
#pragma unroll
                    for (int i = 0; i < 32; ++i) {
                        sw += p[15 + i];
                        const float inv = (first && i < 15) ? 1.f / (float)min(i + 1, win) : invw;
                        dlb[i * DST + c] = f2bf(sw * inv - p[15 + i]);
                        float drop = 0.f;
#pragma unroll
                        for (int q = 0; q < 4; ++q) { const int w_ = 2 << q; if (g == q) drop = p[15 + i - w_ + 1]; }
                        sw -= drop;
                    }
                    __syncthreads();
                    const int gg = wave >> 1, half = wave & 1;
#pragma unroll
                    for (int ct = 0; ct < 2; ++ct) {
                        const int dd0 = half * 64 + ct * 32;
                        f32x16 acc;
#pragma unroll
                        for (int e = 0; e < 16; ++e) acc[e] = 0.f;
#pragma unroll
                        for (int ks = 0; ks < 8; ++ks) { const bf16x8_t a = *(const __attribute__((address_space(3))) bf16x8_t*)(dlb + r32 * DST + gg * PG + ks * 16 + 8 * hh);
                            const bf16x8_t w = *(const bf16x8_t*)(pwt + (size_t)(dd0 + r32) * PG + ks * 16 + 8 * hh); acc = mm32(a, w, acc); }
                        const int oc = gg * PG + dd0 + r32; const float ps = psc[oc];
#pragma unroll
                        for (int e = 0; e < 16; ++e) MIX[(size_t)(t0 + rowidx(e, hh)) * D + RW + oc] = f2bf(acc[e] * ps);
                    }
                }
            }
        }
        SEAM(pb + 2);

        if (IN(pb + 3)) { PHASE_IDS
            const bf16* Vl = l == 0 ? V0 : V1;
            const int r32 = lane & 31, hh = lane >> 5;
            if (wave < 6) {
                lbf16* At = (lbf16*)(lds + wave * 23552); lbf16* Bt = At + 2304; lbf16* Kt = Bt + 2304; lbf16* Rt = Kt + 2304; lbf16* Vv = Rt + 2304;
                LAS float* PCs = (LAS float*)(lds + wave * 23552 + 23040);
                for (int item = bx * 6 + wave; item < BATCH * NH * (SEQ / 32); item += G * 6) {
                    const int bh = item >> 7, chunk = item & 127, b = bh >> 3, h = bh & 7; const size_t t0 = (size_t)b * SEQ + chunk * 32;
                    __builtin_amdgcn_wave_barrier(); asm volatile("s_waitcnt lgkmcnt(0)" ::: "memory");
                    { float P = 1.f;
#pragma unroll 16
                      for (int c = 0; c < 32; ++c) { const size_t o = (t0 + c) * RW + h * HS + lane;
                          const float r = bf2f(Rb[o]), kx = bf2f(Kb[o]), v = bf2f(Vl[o]), kkr = bf2f(KKb[o]), br = bf2f(Bb[o]), w = Wd[o], inv = INVN[(t0 + c) * NH + h];
                          const float Pm1 = P; P *= w; const float ip = __builtin_amdgcn_rcpf(P);
                          At[c * 72 + lane] = f2bf(-kkr * inv * Pm1); Rt[c * 72 + lane] = f2bf(r * P); Bt[c * 72 + lane] = f2bf(br * inv * ip); Kt[c * 72 + lane] = f2bf(kx * ip); Vv[c * 72 + lane] = f2bf(v); }
                      PCs[lane] = P; }
                    __builtin_amdgcn_wave_barrier(); asm volatile("s_waitcnt lgkmcnt(0)" ::: "memory");
                    const f32x16 zero16 = {0.f, 0.f, 0.f, 0.f, 0.f, 0.f, 0.f, 0.f, 0.f, 0.f, 0.f, 0.f, 0.f, 0.f, 0.f, 0.f};
                    f32x16 X = zero16, Yt = zero16;
#pragma unroll
                    for (int ks = 0; ks < 4; ++ks) { const bf16x8_t fa = ldrow(At, r32, ks, hh), fb = ldrow(Bt, r32, ks, hh); X = mm32(fa, fb, X); Yt = mm32(fb, fa, Yt); }
#pragma unroll
                    for (int e = 0; e < 16; ++e) { const int ri = rowidx(e, hh); X[e] = (r32 < ri) ? X[e] : 0.f; Yt[e] = (ri < r32) ? Yt[e] : 0.f; }
                    f32x16 TY = Yt;
#pragma unroll
                    for (int e = 0; e < 16; ++e) TY[e] += (rowidx(e, hh) == r32) ? 1.f : 0.f;
#pragma unroll 1
                    for (int it = 0; it < 4; ++it) {
                        const bf16x8_t x0 = accop<0>(X), x1 = accop<1>(X), y0 = accop<0>(Yt), y1 = accop<1>(Yt);
                        f32x16 Xn = mm32(y0, x0, zero16); Xn = mm32(y1, x1, Xn);
                        f32x16 Yn = mm32(x0, y0, zero16); Yn = mm32(x1, y1, Yn);
                        X = Xn; Yt = Yn;
                        const bf16x8_t p0 = accop<0>(X), p1 = accop<1>(X), t0_ = accop<0>(TY), t1_ = accop<1>(TY);
                        TY = mm32(p0, t0_, TY); TY = mm32(p1, t1_, TY);
                    }
                    const bf16x8_t ty0 = accop<0>(TY), ty1 = accop<1>(TY);
                    unsigned char* rec = SCN + (size_t)item * 24576;
                    const bf16x8_t v00 = ldpermcol<0>(Vv, r32, hh), v01 = ldpermcol<1>(Vv, r32, hh), v10 = ldpermcol<0>(Vv, 32 + r32, hh), v11 = ldpermcol<1>(Vv, 32 + r32, hh);
                    f32x16 U0a, U0b;
                    { f32x16 G2T = zero16;
#pragma unroll
                      for (int ks = 0; ks < 4; ++ks) G2T = mm32(ldrow(Kt, r32, ks, hh), ldrow(At, r32, ks, hh), G2T);
#pragma unroll
                      for (int e = 0; e < 16; ++e) G2T[e] = (rowidx(e, hh) < r32) ? G2T[e] : 0.f;
                      const bf16x8_t g0 = accop<0>(G2T), g1 = accop<1>(G2T);
                      f32x16 Za = mm32(g0, v00, zero16); Za = mm32(g1, v01, Za); f32x16 Zb = mm32(g0, v10, zero16); Zb = mm32(g1, v11, Zb);
                      U0a = mm32(ty0, accop<0>(Za), zero16); U0a = mm32(ty1, accop<1>(Za), U0a); U0b = mm32(ty0, accop<0>(Zb), zero16); U0b = mm32(ty1, accop<1>(Zb), U0b); }
                    const bf16x8_t ua0 = accop<0>(U0a), ua1 = accop<1>(U0a), ub0 = accop<0>(U0b), ub1 = accop<1>(U0b);
                    f32x16 G3T = zero16;
                    { f32x16 G4T = zero16;
#pragma unroll
                      for (int ks = 0; ks < 4; ++ks) { const bf16x8_t fr = ldrow(Rt, r32, ks, hh); G3T = mm32(ldrow(Bt, r32, ks, hh), fr, G3T); G4T = mm32(ldrow(Kt, r32, ks, hh), fr, G4T); }
#pragma unroll
                      for (int e = 0; e < 16; ++e) { const bool keep = rowidx(e, hh) <= r32; G3T[e] = keep ? G3T[e] : 0.f; G4T[e] = keep ? G4T[e] : 0.f; }
                      const bf16x8_t g30 = accop<0>(G3T), g31 = accop<1>(G3T), g40 = accop<0>(G4T), g41 = accop<1>(G4T);
                      f32x16 Ya = mm32(g30, ua0, zero16); Ya = mm32(g31, ua1, Ya); Ya = mm32(g40, v00, Ya); Ya = mm32(g41, v01, Ya);
                      f32x16 Yb = mm32(g30, ub0, zero16); Yb = mm32(g31, ub1, Yb); Yb = mm32(g40, v10, Yb); Yb = mm32(g41, v11, Yb);
                      u32x4 o0, o1;
                      o0.x = cvtpk(Ya[0], Ya[1]); o0.y = cvtpk(Ya[2], Ya[3]); o0.z = cvtpk(Ya[4], Ya[5]); o0.w = cvtpk(Ya[6], Ya[7]);
                      o1.x = cvtpk(Ya[8], Ya[9]); o1.y = cvtpk(Ya[10], Ya[11]); o1.z = cvtpk(Ya[12], Ya[13]); o1.w = cvtpk(Ya[14], Ya[15]);
                      *(u32x4*)(rec + 12288 + 4096 + lane * 32) = o0; *(u32x4*)(rec + 12288 + 4096 + lane * 32 + 16) = o1;
                      o0.x = cvtpk(Yb[0], Yb[1]); o0.y = cvtpk(Yb[2], Yb[3]); o0.z = cvtpk(Yb[4], Yb[5]); o0.w = cvtpk(Yb[6], Yb[7]);
                      o1.x = cvtpk(Yb[8], Yb[9]); o1.y = cvtpk(Yb[10], Yb[11]); o1.z = cvtpk(Yb[12], Yb[13]); o1.w = cvtpk(Yb[14], Yb[15]);
                      *(u32x4*)(rec + 12288 + 6144 + 4096 + lane * 32) = o0; *(u32x4*)(rec + 12288 + 6144 + 4096 + lane * 32 + 16) = o1; }
                    f32x16 Wa0 = mm32(ty0, ldpermcol<0>(At, r32, hh), zero16); Wa0 = mm32(ty1, ldpermcol<1>(At, r32, hh), Wa0);
                    f32x16 Wa1 = mm32(ty0, ldpermcol<0>(At, 32 + r32, hh), zero16); Wa1 = mm32(ty1, ldpermcol<1>(At, 32 + r32, hh), Wa1);
                    const bf16x8_t wa00 = accop<0>(Wa0), wa01 = accop<1>(Wa0), wa10 = accop<0>(Wa1), wa11 = accop<1>(Wa1);
                    { const bf16x8_t g30 = accop<0>(G3T), g31 = accop<1>(G3T);
                      f32x16 Ra = mm32(wa00, g30, zero16); Ra = mm32(wa01, g31, Ra); f32x16 Rb_ = mm32(wa10, g30, zero16); Rb_ = mm32(wa11, g31, Rb_);
#pragma unroll
                      for (int e = 0; e < 16; ++e) { const int kr = rowidx(e, hh); Ra[e] += bf2f(Rt[r32 * 72 + kr]); Rb_[e] += bf2f(Rt[r32 * 72 + 32 + kr]); }
                      *(bf16x8_t*)(rec + 8192 + 0 * 1024 + lane * 16) = accop<0>(Ra); *(bf16x8_t*)(rec + 8192 + 1 * 1024 + lane * 16) = accop<1>(Ra);
                      *(bf16x8_t*)(rec + 8192 + 2 * 1024 + lane * 16) = accop<0>(Rb_); *(bf16x8_t*)(rec + 8192 + 3 * 1024 + lane * 16) = accop<1>(Rb_); }
                    const bf16x8_t b00 = ldpermcol<0>(Bt, r32, hh), b01 = ldpermcol<1>(Bt, r32, hh), b10 = ldpermcol<0>(Bt, 32 + r32, hh), b11 = ldpermcol<1>(Bt, 32 + r32, hh);
                    { const float pc0 = PCs[r32], pc1 = PCs[32 + r32];
#pragma unroll
                      for (int ij = 0; ij < 4; ++ij) { const int i = ij >> 1, j = ij & 1;
                          f32x16 M = mm32(i ? wa10 : wa00, j ? b10 : b00, zero16); M = mm32(i ? wa11 : wa01, j ? b11 : b01, M);
#pragma unroll
                          for (int e = 0; e < 16; ++e) { float m = M[e]; if (i == j) m += (rowidx(e, hh) == r32) ? 1.f : 0.f; M[e] = m * (j ? pc1 : pc0); }
                          *(bf16x8_t*)(rec + (ij * 2 + 0) * 1024 + lane * 16) = accop<0>(M); *(bf16x8_t*)(rec + (ij * 2 + 1) * 1024 + lane * 16) = accop<1>(M); } }
                    { const bf16x8_t k00 = ldpermcol<0>(Kt, r32, hh), k01 = ldpermcol<1>(Kt, r32, hh), k10 = ldpermcol<0>(Kt, 32 + r32, hh), k11 = ldpermcol<1>(Kt, 32 + r32, hh);
#pragma unroll
                      for (int ju = 0; ju < 4; ++ju) { const int j = ju >> 1, u = ju & 1;
                          f32x16 Dm = mm32(j ? b10 : b00, u ? ub0 : ua0, zero16); Dm = mm32(j ? b11 : b01, u ? ub1 : ua1, Dm);
                          Dm = mm32(j ? k10 : k00, u ? v10 : v00, Dm); Dm = mm32(j ? k11 : k01, u ? v11 : v01, Dm);
#pragma unroll
                          for (int e = 0; e < 16; ++e) Dm[e] *= PCs[32 * j + rowidx(e, hh)];
                          u32x4 o0, o1;
                          o0.x = cvtpk(Dm[0], Dm[1]); o0.y = cvtpk(Dm[2], Dm[3]); o0.z = cvtpk(Dm[4], Dm[5]); o0.w = cvtpk(Dm[6], Dm[7]);
                          o1.x = cvtpk(Dm[8], Dm[9]); o1.y = cvtpk(Dm[10], Dm[11]); o1.z = cvtpk(Dm[12], Dm[13]); o1.w = cvtpk(Dm[14], Dm[15]);
                          *(u32x4*)(rec + 12288 + u * 6144 + j * 2048 + lane * 32) = o0; *(u32x4*)(rec + 12288 + u * 6144 + j * 2048 + lane * 32 + 16) = o1; } }
                }
            }
        }
        { XcdBarrier xb_ = xbar; asm volatile("" : "+s"(xb_.bar)); xcd_barrier<false>(xb_); }
        if (IN(pb + 3)) { PHASE_IDS
            const int r32 = lane & 31, hh = lane >> 5;
            constexpr int SLOT = 18432, NCH = SEQ / 32, NSL = 7, AHEAD = 6;
            if (G > BATCH * NH * 2) { if (bx >= BATCH * NH * 2) convert_tables_fp8(INP(27), INP(28), U8, V8, USc, VSc, l, (bx - BATCH * NH * 2) * NWAVES + wave, (G - BATCH * NH * 2) * NWAVES, lane); }
            else convert_tables_fp8(INP(27), INP(28), U8, V8, USc, VSc, l, bx * NWAVES + wave, G * NWAVES, lane);
            for (int un = bx; un < BATCH * NH * 2; un += G) {
                const int bh = un >> 1, u = un & 1, b = bh >> 3, h = bh & 7;
                __syncthreads();
                const unsigned char* recs = SCN + (size_t)bh * NCH * 24576;
                const int lw = wave - 2;
#define S2_DMA(chunk_) do { if (wave >= 2) { LAS unsigned char* sl = lds + ((chunk_) % NSL) * SLOT; const unsigned char* rp = recs + (size_t)(chunk_) * 24576 + lane * 16; \
                    _Pragma("unroll") for (int q_ = 0; q_ < 3; ++q_) { const int p_ = lw * 3 + q_; const int so_ = p_ < 12 ? p_ * 1024 : 12288 + u * 6144 + (p_ - 12) * 1024; \
                        __builtin_amdgcn_global_load_lds((const unsigned*)(rp + so_), (LAS unsigned*)(sl + p_ * 1024), 16, 0, 0); } } } while (0)
#pragma unroll 1
                for (int c0 = 0; c0 < AHEAD; ++c0) S2_DMA(c0);
                asm volatile("s_waitcnt vmcnt(15)" ::: "memory");
                __builtin_amdgcn_s_barrier();
                f32x16 X0, X1;
#pragma unroll
                for (int e = 0; e < 16; ++e) { X0[e] = 0.f; X1[e] = 0.f; }
#define S2_FRAG(off) (*(const __attribute__((address_space(3))) bf16x8_t*)(sl + (off) + lane * 16))
#define S2_UNPK(dst, off) do { const u32x4 a0 = *(const LAS u32x4*)(sl + (off) + lane * 32), a1 = *(const LAS u32x4*)(sl + (off) + lane * 32 + 16); const unsigned wv[8] = {a0.x, a0.y, a0.z, a0.w, a1.x, a1.y, a1.z, a1.w}; \
                    _Pragma("unroll") for (int q = 0; q < 8; ++q) { (dst)[2 * q] = __uint_as_float(wv[q] << 16); (dst)[2 * q + 1] = __uint_as_float(wv[q] & 0xffff0000u); } } while (0)
#pragma unroll 1
                for (int n = 0; n < NCH; ++n) {
                    if (n + AHEAD < NCH) S2_DMA(n + AHEAD);
                    if (wave == 0) {
                        const LAS unsigned char* sl = lds + (n % NSL) * SLOT;
                        const bf16x8_t x00 = accop<0>(X0), x01 = accop<1>(X0), x10 = accop<0>(X1), x11 = accop<1>(X1);
                        f32x16 Yc, N0, N1;
                        S2_UNPK(Yc, 12288 + 4096); S2_UNPK(N0, 12288); S2_UNPK(N1, 12288 + 2048);
                        Yc = mm32(S2_FRAG(8192 + 0 * 1024), x00, Yc); Yc = mm32(S2_FRAG(8192 + 1 * 1024), x01, Yc); Yc = mm32(S2_FRAG(8192 + 2 * 1024), x10, Yc); Yc = mm32(S2_FRAG(8192 + 3 * 1024), x11, Yc);
                        N0 = mm32(S2_FRAG((0 * 2 + 0) * 1024), x00, N0); N0 = mm32(S2_FRAG((0 * 2 + 1) * 1024), x01, N0); N0 = mm32(S2_FRAG((2 * 2 + 0) * 1024), x10, N0); N0 = mm32(S2_FRAG((2 * 2 + 1) * 1024), x11, N0);
                        N1 = mm32(S2_FRAG((1 * 2 + 0) * 1024), x00, N1); N1 = mm32(S2_FRAG((1 * 2 + 1) * 1024), x01, N1); N1 = mm32(S2_FRAG((3 * 2 + 0) * 1024), x10, N1); N1 = mm32(S2_FRAG((3 * 2 + 1) * 1024), x11, N1);
                        X0 = N0; X1 = N1;
                        float* yp = Y + ((size_t)b * SEQ + (size_t)n * 32) * RW + h * HS + u * 32 + r32;
#pragma unroll
                        for (int e = 0; e < 16; ++e) yp[(size_t)rowidx(e, hh) * RW] = Yc[e];
                        asm volatile("s_waitcnt lgkmcnt(0)" ::: "memory");
                    } else if (wave >= 2) {
                        const int younger = (NCH - 1 - (n + 1)) < (AHEAD - 1) ? (NCH - 1 - (n + 1)) : (AHEAD - 1);
                        if (younger >= 5) asm volatile("s_waitcnt vmcnt(15)" ::: "memory"); else if (younger == 4) asm volatile("s_waitcnt vmcnt(12)" ::: "memory"); else if (younger == 3) asm volatile("s_waitcnt vmcnt(9)" ::: "memory");
                        else if (younger == 2) asm volatile("s_waitcnt vmcnt(6)" ::: "memory"); else if (younger == 1) asm volatile("s_waitcnt vmcnt(3)" ::: "memory"); else asm volatile("s_waitcnt vmcnt(0)" ::: "memory");
                    }
                    __builtin_amdgcn_s_barrier();
                }
#undef S2_FRAG
#undef S2_UNPK
#undef S2_DMA
            }
        }
        SEAM(pb + 3);

        if (IN(pb + 4)) { PHASE_IDS
            const int c = tid; const float lg = INP(19)[l * RW + c], lb = INP(20)[l * RW + c];
            for (int tile = bx; tile < T / 8; tile += G) {
                float y[8], g[8], bg[8];
#pragma unroll
                for (int i = 0; i < 8; ++i) { const size_t o = (size_t)(tile * 8 + i) * RW + c; y[i] = Y[o]; g[i] = bf2f(Gb[o]); bg[i] = bf2f(BGb[o]) * BSUM[(size_t)(tile * 8 + i) * NH + wave]; }
#pragma unroll
                for (int i = 0; i < 8; ++i) { const float mean = wave_sum(y[i], lane) * (1.f / 64.f); const float d = y[i] - mean; const float var = wave_sum(d * d, lane) * (1.f / 64.f);
                    const float yn = d * rsqrtf(var + GN_EPS) * lg + lb; MIX[(size_t)(tile * 8 + i) * D + c] = f2bf(yn * g[i] + bg[i]); }
            }
        }
        SEAM(pb + 4);
        if (IN(pb + 5)) { PHASE_IDS
            pg8::Gemm g{MIX, WoutT + (size_t)l * D * D, T, D, D}; pg8::StaticOrder S; S.init(T, D, G, bx);
            pg8::EpiResGate E{xin, X, modl + 2 * D};
            pg8::gemm_phase<pg8::EpiResGate, pg8::StaticOrder, true, true>(lds, g, S, E, tid); }
        SEAM(pb + 5);
        if (IN(pb + 6)) { PHASE_IDS const float* gamma = INP(24) + l * D;
            for (int row = gw; row < T; row += NGW) { const int b = row / SEQ; norm_mod_row(X + (size_t)row * D, gamma, modl + (size_t)b * 6 * D + 3 * D, modl + (size_t)b * 6 * D + 4 * D, H + (size_t)row * D, lane); } }
        SEAM(pb + 6);
        if (IN(pb + 7)) { PHASE_IDS
            pg8::Gemm g{H, PqT + (size_t)l * PH * PQ * D, T, PH * PQ, D}; pg8::StaticOrder S; S.init(T, PH * PQ, G, bx);
            pg8::EpiBf16<0> E{Q, PH * PQ, nullptr, 0, 0, 1.f};
            pg8::gemm_phase<pg8::EpiBf16<0>, pg8::StaticOrder, true, true>(lds, g, S, E, tid); }
        SEAM(pb + 7);

        if (IN(pb + 8)) { PHASE_IDS
            const bf16* KEYSl = KEYS + (size_t)l * PH * 2 * NKEYS * PHALF;
            LAS unsigned char* scr = lds + wave * 2048 + lane * 32;
            const int r = lane & 31, hh = lane >> 5;
            for (int it = gw; it < (T / 32) * PH; it += NGW) {
                const int tok = (it >> 3) * 32 + r, h = it & 7;
                unsigned sp0[16], sp1[16];
#pragma unroll
                for (int e = 0; e < 16; ++e) { sp0[e] = 0u; sp1[e] = 0u; }
#pragma unroll 1
                for (int p = 0; p < 2; ++p) {
                    const bf16* qp = Q + (size_t)tok * (PH * PQ) + h * PQ + p * PHALF + 8 * hh;
                    const bf16* kp_ = KEYSl + ((size_t)(h * 2 + p) * NKEYS + r) * PHALF + 8 * hh;
                    bf16x8_t bq[8];
#pragma unroll
                    for (int ks = 0; ks < 8; ++ks) bq[ks] = *(const bf16x8_t*)(qp + ks * 16);
                    unsigned best[16];
#pragma unroll
                    for (int e = 0; e < 16; ++e) best[e] = 0u;
#pragma unroll 1
                    for (int kt = 0; kt < 4; ++kt) {
                        f32x16 acc;
#pragma unroll
                        for (int e = 0; e < 16; ++e) acc[e] = 0.f;
#pragma unroll
                        for (int ks = 0; ks < 8; ++ks) { const bf16x8_t ak = *(const bf16x8_t*)(kp_ + (size_t)kt * 32 * PHALF + ks * 16); acc = __builtin_amdgcn_mfma_f32_32x32x16_bf16(ak, bq[ks], acc, 0, 0, 0); }
                        unsigned g[16];
#pragma unroll
                        for (int e = 0; e < 16; ++e) g[e] = pack_key7(acc[e], kt * 32 + (e & 3) + 8 * (e >> 2) + 4 * hh);
                        sort16_desc(g);
                        merge_top16(best, g);
                    }
                    unsigned ob[16];
#pragma unroll
                    for (int e = 0; e < 16; ++e) ob[e] = shflxu(best[e], lane, 32);
                    merge_top16(best, ob);
#pragma unroll
                    for (int e = 0; e < 16; ++e) { sp0[e] = p == 0 ? best[e] : sp0[e]; sp1[e] = p == 0 ? sp1[e] : best[e]; }
                }
                unsigned c2[32];
                stage2_cands(sp0, sp1, hh, c2);
                sort16_desc(c2); sort16_desc(c2 + 16); merge_top16(c2, c2 + 16);
                { unsigned ob[16];
#pragma unroll
                  for (int e = 0; e < 16; ++e) ob[e] = shflxu(c2[e], lane, 32);
                  merge_top16(c2, ob); }
#pragma unroll
                for (int e = 0; e < 16; e += 4) {
                    *(LAS unsigned*)(scr + e) = (127u - (sp0[e] & 127u)) | ((127u - (sp0[e + 1] & 127u)) << 8) | ((127u - (sp0[e + 2] & 127u)) << 16) | ((127u - (sp0[e + 3] & 127u)) << 24);
                    *(LAS unsigned*)(scr + 16 + e) = (127u - (sp1[e] & 127u)) | ((127u - (sp1[e + 1] & 127u)) << 8) | ((127u - (sp1[e + 2] & 127u)) << 16) | ((127u - (sp1[e + 3] & 127u)) << 24); }
                asm volatile("s_waitcnt lgkmcnt(0)" ::: "memory");
                float sm[16]; int ex[16];
#pragma unroll
                for (int e = 0; e < 16; ++e) { const unsigned key = c2[e]; sm[e] = unpack_key8(key); const int i0 = (key >> 4) & 15, j0 = key & 15; ex[e] = (int)scr[i0] * NKEYS + (int)scr[16 + j0]; }
                float den = 0.f;
#pragma unroll
                for (int e = 0; e < 16; ++e) { sm[e] = expf(sm[e] - unpack_key8(c2[0])); den += sm[e]; }
                const float inv = 1.f / den;
                if (hh == 0) {
                    int* ip = IDX + (size_t)tok * NE + h * TOPK; float* gp = GATE + (size_t)tok * NE + h * TOPK;
#pragma unroll
                    for (int e = 0; e < 16; e += 4) { *(int4*)(ip + e) = make_int4(ex[e], ex[e + 1], ex[e + 2], ex[e + 3]); *(f32x4*)(gp + e) = (f32x4){sm[e] * inv, sm[e + 1] * inv, sm[e + 2] * inv, sm[e + 3] * inv}; }
                }
                asm volatile("s_waitcnt lgkmcnt(0)" ::: "memory");
            }
        }
        SEAM(pb + 8);

        if (IN(pb + 9)) { PHASE_IDS
            const unsigned char* Ul = U8 + (size_t)l * NEXP * D; const unsigned char* Vtl = V8 + (size_t)l * NEXP * D; const float* usl = USc + l * NEXP; const float* vsl = VSc + l * NEXP; const float* lnf = INP(29);
            const bool fin = (l == DEPTH - 1);
            typedef float f32x2_t __attribute__((ext_vector_type(2)));
            const __amdgpu_buffer_rsrc_t ru = __builtin_amdgcn_make_buffer_rsrc((void*)Ul, 0, NEXP * D, 0x00020000), rv = __builtin_amdgcn_make_buffer_rsrc((void*)Vtl, 0, NEXP * D, 0x00020000);
            const int voff = lane * 16;
            LAS float* pl = (LAS float*)(lds + wave * 8704);
            for (int t = gw; t < T; t += NGW) {
                const int b = t / SEQ;
                f32x2_t hf2[8];
                { const u32x4 h0 = *(const u32x4*)(H + (size_t)t * D + lane * 16), h1 = *(const u32x4*)(H + (size_t)t * D + lane * 16 + 8);
                  hf2[0] = (f32x2_t){__uint_as_float(h0.x << 16), __uint_as_float(h0.x & 0xffff0000u)}; hf2[1] = (f32x2_t){__uint_as_float(h0.y << 16), __uint_as_float(h0.y & 0xffff0000u)};
                  hf2[2] = (f32x2_t){__uint_as_float(h0.z << 16), __uint_as_float(h0.z & 0xffff0000u)}; hf2[3] = (f32x2_t){__uint_as_float(h0.w << 16), __uint_as_float(h0.w & 0xffff0000u)};
                  hf2[4] = (f32x2_t){__uint_as_float(h1.x << 16), __uint_as_float(h1.x & 0xffff0000u)}; hf2[5] = (f32x2_t){__uint_as_float(h1.y << 16), __uint_as_float(h1.y & 0xffff0000u)};
                  hf2[6] = (f32x2_t){__uint_as_float(h1.z << 16), __uint_as_float(h1.z & 0xffff0000u)}; hf2[7] = (f32x2_t){__uint_as_float(h1.w << 16), __uint_as_float(h1.w & 0xffff0000u)}; }
                f32x2_t acc2[8];
#pragma unroll
                for (int i = 0; i < 8; ++i) acc2[i] = (f32x2_t){0.f, 0.f};
                int myidx = IDX[(size_t)t * NE + (lane & 31)]; float mygate = GATE[(size_t)t * NE + (lane & 31)];
                float myus = usl[myidx], myvs = vsl[myidx];
#define ROWLD(dst, rs, ix, e) dst = __builtin_amdgcn_raw_buffer_load_b128(rs, voff, __builtin_amdgcn_readlane(ix, (e)) * D, 0)
#define LOADB(buf, rs, ix, e0) do { _Pragma("unroll") for (int j_ = 0; j_ < 4; ++j_) ROWLD((buf)[j_], rs, ix, (e0) + j_); __builtin_amdgcn_sched_barrier(0); } while (0)
#define CVT8(u) const f32x2_t u0 = __builtin_amdgcn_cvt_pk_f32_fp8((int)(u).x, false), u1 = __builtin_amdgcn_cvt_pk_f32_fp8((int)(u).x, true), u2 = __builtin_amdgcn_cvt_pk_f32_fp8((int)(u).y, false), u3 = __builtin_amdgcn_cvt_pk_f32_fp8((int)(u).y, true), \
                        u4 = __builtin_amdgcn_cvt_pk_f32_fp8((int)(u).z, false), u5 = __builtin_amdgcn_cvt_pk_f32_fp8((int)(u).z, true), u6 = __builtin_amdgcn_cvt_pk_f32_fp8((int)(u).w, false), u7 = __builtin_amdgcn_cvt_pk_f32_fp8((int)(u).w, true)
#define DOT1(u, dst) do { CVT8(u); f32x2_t a_ = hf2[0] * u0; a_ += hf2[1] * u1; a_ += hf2[2] * u2; a_ += hf2[3] * u3; a_ += hf2[4] * u4; a_ += hf2[5] * u5; a_ += hf2[6] * u6; a_ += hf2[7] * u7; dst = a_.x + a_.y; } while (0)
#define DOTB(buf, e0) do { _Pragma("unroll") for (int j_ = 0; j_ < 4; ++j_) { float d_; DOT1((buf)[j_], d_); pl[((e0) + j_) * 68 + lane] = d_; } } while (0)
#define AXPYB(buf, e0) do { _Pragma("unroll") for (int j_ = 0; j_ < 4; ++j_) { CVT8((buf)[j_]); const float cf = __int_as_float(__builtin_amdgcn_readlane(__float_as_int(coef), (e0) + j_)); \
                        acc2[0] += cf * u0; acc2[1] += cf * u1; acc2[2] += cf * u2; acc2[3] += cf * u3; acc2[4] += cf * u4; acc2[5] += cf * u5; acc2[6] += cf * u6; acc2[7] += cf * u7; } } while (0)
                u32x4 ba[4], bb_[4];
                LOADB(ba, ru, myidx, 0);
#pragma unroll 1
                for (int q = 0; q < 4; ++q) {
                    int nidx = 0; float ngate = 0.f;
                    if (q < 3) { nidx = IDX[(size_t)t * NE + (q + 1) * 32 + (lane & 31)]; ngate = GATE[(size_t)t * NE + (q + 1) * 32 + (lane & 31)]; }
#pragma unroll
                    for (int e0 = 0; e0 < 32; e0 += 8) {
                        LOADB(bb_, ru, myidx, e0 + 4); DOTB(ba, e0);
                        if (e0 + 8 < 32) LOADB(ba, ru, myidx, e0 + 8); else LOADB(ba, rv, myidx, 0);
                        DOTB(bb_, e0 + 4);
                    }
                    const float nus = usl[nidx], nvs = vsl[nidx];
                    __builtin_amdgcn_wave_barrier(); asm volatile("s_waitcnt lgkmcnt(0)" ::: "memory");
                    float dsum;
                    { const LAS float* rp = pl + (lane & 31) * 68 + (lane >> 5) * 32; f32x4 s4 = *(const LAS f32x4*)rp;
#pragma unroll
                      for (int j = 1; j < 8; ++j) s4 += *(const LAS f32x4*)(rp + j * 4);
                      dsum = (s4.x + s4.y) + (s4.z + s4.w); }
                    dsum += shflx(dsum, lane, 32);
                    __builtin_amdgcn_wave_barrier(); asm volatile("s_waitcnt lgkmcnt(0)" ::: "memory");
                    const float coef = mygate * gelu_erf(dsum * myus) * myvs;
#pragma unroll
                    for (int e0 = 0; e0 < 32; e0 += 8) {
                        LOADB(bb_, rv, myidx, e0 + 4); AXPYB(ba, e0);
                        if (e0 + 8 < 32) LOADB(ba, rv, myidx, e0 + 8); else if (q < 3) LOADB(ba, ru, nidx, 0);
                        AXPYB(bb_, e0 + 4);
                    }
                    myidx = nidx; mygate = ngate; myus = nus; myvs = nvs;
                }
#undef ROWLD
#undef LOADB
#undef CVT8
#undef DOTB
#undef DOT1
#undef AXPYB
                float* xr = X + (size_t)t * D + lane * 16; const float* g2 = modl + (size_t)b * 6 * D + 5 * D + lane * 16;
                f32x4 xv[4]; float ss = 0.f;
#pragma unroll
                for (int q = 0; q < 4; ++q) { const f32x4 xo = *(const f32x4*)(xr + q * 4), gg = *(const f32x4*)(g2 + q * 4);
                    xv[q] = xo + gg * (f32x4){acc2[q * 2].x, acc2[q * 2].y, acc2[q * 2 + 1].x, acc2[q * 2 + 1].y}; ss += (xv[q].x * xv[q].x + xv[q].y * xv[q].y) + (xv[q].z * xv[q].z + xv[q].w * xv[q].w); }
                const float rs = rsqrtf(wave_sum(ss, lane) * (1.f / D) + NORM_EPS);
                if (fin) {
#pragma unroll
                    for (int q = 0; q < 4; ++q) xv[q] = xv[q] * rs * *(const f32x4*)(lnf + lane * 16 + q * 4); }
                else {
                    const float* gam = INP(4) + (l + 1) * D + lane * 16; const float* mn = MOD + (size_t)(l + 1) * BATCH * 6 * D + (size_t)b * 6 * D + lane * 16; u32x4 ho[2];
#pragma unroll
                    for (int q = 0; q < 4; ++q) { const f32x4 y = xv[q] * rs * *(const f32x4*)(gam + q * 4) * (*(const f32x4*)(mn + D + q * 4) + 1.f) + *(const f32x4*)(mn + q * 4);
                        if (q & 1) { ho[q >> 1].z = pk2(y.x, y.y); ho[q >> 1].w = pk2(y.z, y.w); } else { ho[q >> 1].x = pk2(y.x, y.y); ho[q >> 1].y = pk2(y.z, y.w); } }
                    *(u32x4*)(H + (size_t)t * D + lane * 16) = ho[0]; *(u32x4*)(H + (size_t)t * D + lane * 16 + 8) = ho[1]; }
#pragma unroll
                for (int q = 0; q < 4; ++q) *(f32x4*)(xr + q * 4) = xv[q];
            }
        }
    }
#undef modl
#undef xin
#undef IN
#undef SEAM
}
#undef MOD
#undef H
#undef PROJ
#undef Q
#undef MIX
#undef Rb
#undef Kb
#undef V0
#undef V1
#undef KKb
#undef Bb
#undef Gb
#undef BGb
#undef Wd
#undef Y
#undef IDX
#undef GATE
#undef WinT
#undef WoutT
#undef PqT
#undef KEYS
#undef QB
#undef SH
#undef WUPT
#undef AUPT
#undef GUPT
#undef VUPT
#undef PWT
#undef INVN
#undef BSUM
#undef SCN
#undef U8
#undef V8
#undef USc
#undef VSc
#undef INP
#undef PHASE_IDS

extern "C" void kernel_launch(void* const* d_in, const int* in_sizes, int n_in, void* d_out, int out_size, void* d_ws, size_t ws_size, hipStream_t stream) {
    if (n_in != 30 || ws_size < WS_END) { fprintf(stderr, "kernel_launch: unexpected n_in %d / ws_size %zu\n", n_in, ws_size); return; }
    static int grid = 0;
    if (grid == 0) {
        int dev = 0, cus = 0, per_cu = 0;
        (void)hipGetDevice(&dev); (void)hipDeviceGetAttribute(&cus, hipDeviceAttributeMultiprocessorCount, dev);
        if (hipFuncSetAttribute((const void*)mega, hipFuncAttributeMaxDynamicSharedMemorySize, LDS_BYTES) != hipSuccess) { fprintf(stderr, "hipFuncSetAttribute failed\n"); grid = -1; return; }
        if (hipOccupancyMaxActiveBlocksPerMultiprocessor(&per_cu, (const void*)mega, NTHR, LDS_BYTES) != hipSuccess || per_cu < 1) { fprintf(stderr, "occupancy query failed (%d)\n", per_cu); per_cu = 1; }
        (void)hipGetLastError();
        grid = (cus > 0 ? cus : 256) * 1;
    }
    if (grid < 0) return;
    Args a{}; for (int i = 0; i < 30; ++i) a.in[i] = (const float*)d_in[i]; a.out = (float*)d_out; a.ws = (unsigned char*)d_ws;
    a.ph_lo = 0; a.ph_hi = NPH;
    if (hipMemsetAsync(d_ws, 0, 65536, stream) != hipSuccess) { fprintf(stderr, "memset failed\n"); return; }
    void* kargs[] = {&a};
    hipError_t e = hipLaunchCooperativeKernel((const void*)mega, dim3(grid), dim3(NTHR), kargs, LDS_BYTES, stream);
    if (e != hipSuccess) fprintf(stderr, "cooperative launch failed: %s (grid %d)\n", hipGetErrorString(e), grid);
}
```

```cpp
#include <hip/hip_runtime.h>
#include <hip/hip_cooperative_groups.h>
namespace cg = cooperative_groups;
#include <cstdio>
#include <cstdint>
#include <cmath>

constexpr int D = 1024, BATCH = 4, SEQ = 4096, T = BATCH * SEQ, DEPTH = 2;
constexpr int RW = 512, HS = 64, NH = 8;
constexpr int DL = 64, AL = 64, MVL = 32, GL = 128;
constexpr int RWKV_COLS = 3 * RW + DL + AL + GL;
constexpr int PW = 512, PG = 128;
constexpr int IN_COLS = RWKV_COLS + PW;
constexpr int LDP = 2560;
constexpr int NKEYS = 128, NEXP = NKEYS * NKEYS, PH = 8, PQ = 256, PHALF = 128, TOPK = 16;
constexpr int NE = PH * TOPK;
constexpr float NORM_EPS = 1e-6f, GN_EPS = 64e-5f;

typedef unsigned short bf16;
__device__ __forceinline__ float bf2f(bf16 u) { return __uint_as_float((unsigned)u << 16); }
__device__ __forceinline__ bf16 f2bf(float f) { unsigned u = __float_as_uint(f); return (bf16)((u + 0x7fffu + ((u >> 16) & 1u)) >> 16); }

constexpr size_t MiB = 1u << 20;
constexpr size_t WS_MOD = 1 * MiB;
constexpr size_t WS_US = 1 * MiB + 256 * 1024;
constexpr size_t WS_VS = 1 * MiB + 512 * 1024;
constexpr size_t WS_H = 2 * MiB;
constexpr size_t WS_PROJ = 34 * MiB;
constexpr size_t WS_Q = WS_PROJ;
constexpr size_t WS_R = 114 * MiB;
constexpr size_t WS_K = 130 * MiB;
constexpr size_t WS_V0 = 146 * MiB;
constexpr size_t WS_V1 = 162 * MiB;
constexpr size_t WS_KK = 178 * MiB;
constexpr size_t WS_B = 194 * MiB;
constexpr size_t WS_G = 210 * MiB;
constexpr size_t WS_BG = 226 * MiB;
constexpr size_t WS_W = 242 * MiB;
constexpr size_t WS_Y = 274 * MiB;
constexpr size_t WS_MIX = 306 * MiB;
constexpr size_t WS_IDX = 338 * MiB;
constexpr size_t WS_GATE = 346 * MiB;
constexpr size_t WS_WIN_T = 354 * MiB;
constexpr size_t WS_WOUT_T = 364 * MiB;
constexpr size_t WS_PQ_T = 368 * MiB;
constexpr size_t WS_KEYS = 376 * MiB;
constexpr size_t WS_U = 378 * MiB;
constexpr size_t WS_V = 442 * MiB;
constexpr size_t WS_QB = 410 * MiB;
constexpr size_t WS_SH = 426 * MiB;
constexpr size_t WS_LORA = 428 * MiB;
constexpr size_t WS_INVN = 430 * MiB;
constexpr size_t WS_BSUM = 431 * MiB;
constexpr size_t WS_SCN = 2 * MiB;
constexpr size_t WS_END = 506 * MiB;

template <int CTRL> __device__ __forceinline__ float dppf(float x) { return __int_as_float(__builtin_amdgcn_update_dpp(0, __float_as_int(x), CTRL, 0xF, 0xF, false)); }
__device__ __forceinline__ float red16(float x) { x += dppf<0xB1>(x); x += dppf<0x4E>(x); x += dppf<0x141>(x); x += dppf<0x140>(x); return x; }
__device__ __forceinline__ float shflx(float v, int lane, int off) { return __int_as_float(__builtin_amdgcn_ds_bpermute((lane ^ off) << 2, __float_as_int(v))); }
__device__ __forceinline__ unsigned shflxu(unsigned v, int lane, int off) { return (unsigned)__builtin_amdgcn_ds_bpermute((lane ^ off) << 2, (int)v); }
__device__ __forceinline__ float wave_sum(float v, int lane) { v = red16(v); v += shflx(v, lane, 16); v += shflx(v, lane, 32); return v; }
__device__ __forceinline__ float sigmoidf_(float x) { return 1.f / (1.f + expf(-x)); }

namespace pg8 {
#define PG8_LAS __attribute__((address_space(3)))
typedef unsigned short bf16_t;
typedef short bf16x8 __attribute__((ext_vector_type(8)));
typedef float f32x4 __attribute__((ext_vector_type(4)));
typedef unsigned u32x4 __attribute__((ext_vector_type(4)));
constexpr int BM = 256, BK = 64, HALF = 128, HTB = HALF * BK * 2  , STAGE_BYTES = 8 * HTB, NXCD = 8, WGM = 8;

__host__ __device__ __forceinline__ int lds_byte(int r, int c) { const int st = (r >> 4) * 2 + (c >> 5), rr = r & 15, cc = c & 31, ob = rr * 64 + cc * 2; return st * 1024 + (ob ^ (((ob >> 9) & 1) << 5)); }
__host__ __device__ __forceinline__ void stage_rc(int b, int& R, int& C) { const int st = b / 1024, sb = b % 1024, swz = sb ^ (((sb >> 9) & 1) << 5); R = (st >> 1) * 16 + swz / 64; C = (st & 1) * 32 + (swz % 64) / 2; }
__host__ __device__ __forceinline__ int perm32(int rho) { const int n = rho >> 4, i = rho & 15; return 8 * (i >> 2) + 4 * n + (i & 3); }

struct Unit { int pm, pn; };
struct Gemm { const bf16_t* A; const bf16_t* Bt; int M, N, K; };

struct StaticOrder {
    int nM, nN, nwg, G, c;
    __host__ __device__ void init(int M, int N, int G_, int c_) { nM = M / BM; nN = N / BM; nwg = nM * nN; G = G_; c = c_; }
    __host__ __device__ bool next(int i, Unit& u) const {
        const long L = (long)i * G + c; if (L >= nwg) return false;
        int wgid = (int)L; { const int q = nwg / NXCD, r = nwg % NXCD, xcd = wgid % NXCD, off = wgid / NXCD; wgid = (xcd < r ? xcd * (q + 1) : r * (q + 1) + (xcd - r) * q) + off; }
        const int nig = WGM * nN, gid = wgid / nig, fm = gid * WGM, gsz = (nM - fm) < WGM ? (nM - fm) : WGM;
        u.pm = fm + ((wgid % nig) % gsz); u.pn = (wgid % nig) / gsz; return true;
    }
    __device__ __forceinline__ void a_ready(const Unit&) const {}
    __device__ __forceinline__ void done(const Unit&) const {}
};

__device__ __forceinline__ unsigned cvt_pk_bf16(float lo, float hi) { unsigned r; asm volatile("v_cvt_pk_bf16_f32 %0, %1, %2" : "=v"(r) : "v"(lo), "v"(hi)); return r; }
typedef float f32x2 __attribute__((ext_vector_type(2)));
__device__ __forceinline__ f32x2 gelu_pk(f32x2 v) {
    const f32x2 av = __builtin_elementwise_abs(v), d = av * 0.2316418882f + 1.0f;
    f32x2 t; t.x = __builtin_amdgcn_rcpf(d.x); t.y = __builtin_amdgcn_rcpf(d.y);
    f32x2 q = t * 0.5307027145f + (-0.7265760135f); q = q * t + 0.7107068705f; q = q * t + (-0.142248368f); q = q * t + 0.127414796f; q = q * t;
    const f32x2 s = (v * v) * (-0.72134752044f);
    f32x2 e; e.x = __builtin_amdgcn_exp2f(s.x); e.y = __builtin_amdgcn_exp2f(s.y);
    const f32x2 m = v * (q * e), r = v - m;
    f32x2 o; o.x = v.x < 0.f ? m.x : r.x; o.y = v.y < 0.f ? m.y : r.y; return o;
}

template <int ACT  > struct EpiBf16 {
    static constexpr bool PERM = true, AFTER_DRAIN = false; static_assert(ACT == 0 || ACT == 1, "EpiBf16: ACT is 0 (none) or 1 (gelu_pk)");
    bf16_t* O; int ldc; const float* bias; int split_cols; size_t split_stride; float scale0;
    __device__ __forceinline__ void operator()(const f32x4 (&acc)[2][2][4][2], const Unit& u, int wr, int wc, int fr, int fq) const {
        const int row0 = u.pm * BM + wr * 64 + fr; int colt = u.pn * BM; bf16_t* base = O;
        float sc = 1.f; if (split_cols) { const int t = colt / split_cols; base += (size_t)t * split_stride; colt -= t * split_cols; if (t == 0) sc = scale0; }
        const int col0 = colt + wc * 32 + 8 * fq, bcol0 = u.pn * BM + wc * 32 + 8 * fq;
        f32x4 bv[2][2];
#pragma unroll
        for (int bj = 0; bj < 2; ++bj)
#pragma unroll
            for (int n = 0; n < 2; ++n) bv[bj][n] = bias ? *(const f32x4*)(bias + bcol0 + bj * HALF + 4 * n) : (f32x4){0.f, 0.f, 0.f, 0.f};
#pragma unroll
        for (int ai = 0; ai < 2; ++ai)
#pragma unroll
            for (int m = 0; m < 4; ++m) { bf16_t* rowp = base + (size_t)(row0 + ai * HALF + m * 16) * ldc + col0;
#pragma unroll
                for (int bj = 0; bj < 2; ++bj) { f32x4 v0 = acc[ai][bj][m][0] + bv[bj][0], v1 = acc[ai][bj][m][1] + bv[bj][1];
                    if (ACT == 1) { f32x2 a = gelu_pk((f32x2){v0[0], v0[1]}), b = gelu_pk((f32x2){v0[2], v0[3]}), c = gelu_pk((f32x2){v1[0], v1[1]}), d = gelu_pk((f32x2){v1[2], v1[3]});
                        v0 = (f32x4){a.x, a.y, b.x, b.y}; v1 = (f32x4){c.x, c.y, d.x, d.y}; }
                    v0 = v0 * sc; v1 = v1 * sc; u32x4 w; w.x = cvt_pk_bf16(v0[0], v0[1]); w.y = cvt_pk_bf16(v0[2], v0[3]); w.z = cvt_pk_bf16(v1[0], v1[1]); w.w = cvt_pk_bf16(v1[2], v1[3]);
                    *(u32x4*)(rowp + bj * HALF) = w; } }
    }
};

struct EpiResGate {
    static constexpr bool PERM = false, AFTER_DRAIN = false;
    const float* xold; float* X; const float* gate;
    __device__ __forceinline__ void operator()(const f32x4 (&acc)[2][2][4][2], const Unit& u, int wr, int wc, int fr, int fq) const {
        const int col0 = u.pn * BM + wc * 32 + 4 * fq; const int b = (u.pm * BM) / SEQ;
        const float* gp = gate + (size_t)b * 6 * D + col0;
#pragma unroll
        for (int bj = 0; bj < 2; ++bj)
#pragma unroll
            for (int n = 0; n < 2; ++n) { const f32x4 gv = *(const f32x4*)(gp + bj * HALF + n * 16);
#pragma unroll
                for (int ai = 0; ai < 2; ++ai)
#pragma unroll
                    for (int m = 0; m < 4; ++m) { const size_t off = (size_t)(u.pm * BM + ai * HALF + wr * 64 + m * 16 + fr) * D + col0 + bj * HALF + n * 16;
                        const f32x4 xo = *(const f32x4*)(xold + off); *(f32x4*)(X + off) = xo + gv * acc[ai][bj][m][n]; } }
    }
};
template <class Epi, class Sched, bool ALIGN_EPI = false, bool SP2 = false>
__device__ __forceinline__ void gemm_phase(PG8_LAS unsigned char* lds, const Gemm g, const Sched& S, const Epi& E, int tid) {
    asm volatile("" : "+v"(tid));
    const int wid = __builtin_amdgcn_readfirstlane(tid >> 6), lane = tid & 63, wr = wid >> 2, wc = wid & 3, fr = lane & 15, fq = lane >> 4;
    const int K = g.K, nt = K / BK;
    unsigned voffA[2], voffB[2];
#pragma unroll
    for (int i = 0; i < 2; ++i) { int R, C; stage_rc(tid * 16 + i * 8192, R, C); const int Rb = Epi::PERM ? ((R & ~31) + perm32(R & 31)) : R;
        voffA[i] = (unsigned)(R * K + C) * 2u; voffB[i] = (unsigned)(Rb * K + C) * 2u; }
    const size_t kstep = (size_t)(BK * 2);
    const size_t hstep = (size_t)HALF * K * 2;
    const size_t tstep = 2 * hstep;
    const unsigned ldsw = (unsigned)wid * 1024u;
    const int aoff = lds_byte(wr * 64 + fr, fq * 8), boff = lds_byte(wc * 32 + fr, fq * 8);
#define PG8_SA(b, h) (((b) * 2 + (h)) * HTB)
#define PG8_SB(b, h) ((4 + (b) * 2 + (h)) * HTB)
#define PG8_STAGE(bufoff, gbase, voff) do { _Pragma("unroll") for (int _i = 0; _i < 2; ++_i) \
        __builtin_amdgcn_global_load_lds((const unsigned*)((const char*)(gbase) + (voff)[_i]), (PG8_LAS unsigned*)(lds + (bufoff) + ldsw + _i * 8192), 16, 0, 0); } while (0)
#define PG8_LDA(dst, b, h) do { _Pragma("unroll") for (int m = 0; m < 4; ++m) _Pragma("unroll") for (int k = 0; k < 2; ++k) dst[m][k] = *(const PG8_LAS bf16x8*)(lds + PG8_SA(b, h) + aoff + m * 2048 + k * 1024); } while (0)
#define PG8_LDB(dst, b, h) do { _Pragma("unroll") for (int n = 0; n < 2; ++n) _Pragma("unroll") for (int k = 0; k < 2; ++k) dst[n][k] = *(const PG8_LAS bf16x8*)(lds + PG8_SB(b, h) + boff + n * 2048 + k * 1024); } while (0)
#define PG8_MMA(ai, bj, At, Bt) do { __builtin_amdgcn_s_setprio(1); _Pragma("unroll") for (int m = 0; m < 4; ++m) _Pragma("unroll") for (int n = 0; n < 2; ++n) _Pragma("unroll") for (int k = 0; k < 2; ++k) \
        acc[ai][bj][m][n] = __builtin_amdgcn_mfma_f32_16x16x32_bf16(Bt[n][k], At[m][k], acc[ai][bj][m][n], 0, 0, 0); __builtin_amdgcn_s_setprio(0); } while (0)
#define PG8_WAIT_V(n) asm volatile("s_waitcnt vmcnt(" #n ")" ::: "memory")
#define PG8_WAIT_L(n) asm volatile("s_waitcnt lgkmcnt(" #n ")" ::: "memory")
#define PG8_BAR __builtin_amdgcn_s_barrier()
#define PG8_SCHED __builtin_amdgcn_sched_barrier(0)
    Unit cur, nxt; int ui = 0;
    if (!S.next(0, cur)) return;
    f32x4 acc[2][2][4][2];
#pragma unroll
    for (int a = 0; a < 2; ++a)
#pragma unroll
        for (int b = 0; b < 2; ++b)
#pragma unroll
            for (int m = 0; m < 4; ++m)
#pragma unroll
                for (int n = 0; n < 2; ++n) acc[a][b][m][n] = (f32x4){0.f, 0.f, 0.f, 0.f};
    bf16x8 At[4][2], B0[2][2], B1[2][2];
    const char* cA = (const char*)g.A + (size_t)cur.pm * tstep; const char* cB = (const char*)g.Bt + (size_t)cur.pn * tstep;
    S.a_ready(cur);
    if constexpr (SP2) {
        PG8_STAGE(PG8_SB(0, 0), cB, voffB); PG8_STAGE(PG8_SB(0, 1), cB + hstep, voffB); PG8_STAGE(PG8_SA(0, 0), cA, voffA); PG8_STAGE(PG8_SA(0, 1), cA + hstep, voffA);
        if (wr == 1) PG8_BAR;
        PG8_WAIT_V(2); PG8_BAR;
        PG8_STAGE(PG8_SB(1, 0), cB + kstep, voffB); PG8_STAGE(PG8_SA(1, 0), cA + kstep, voffA); PG8_STAGE(PG8_SB(1, 1), cB + hstep + kstep, voffB);
        PG8_WAIT_V(6); PG8_BAR;
    } else {
        PG8_STAGE(PG8_SB(0, 0), cB, voffB); PG8_STAGE(PG8_SA(0, 0), cA, voffA); PG8_STAGE(PG8_SB(0, 1), cB + hstep, voffB); PG8_STAGE(PG8_SA(0, 1), cA + hstep, voffA);
        if (wr == 1) PG8_BAR;
        PG8_WAIT_V(4); PG8_BAR;
        PG8_STAGE(PG8_SB(1, 0), cB + kstep, voffB); PG8_STAGE(PG8_SA(1, 0), cA + kstep, voffA); PG8_STAGE(PG8_SB(1, 1), cB + hstep + kstep, voffB);
        PG8_WAIT_V(6); PG8_BAR;
    }
    for (;;) {
        const bool has_next = S.next(ui + 1, nxt);
        const char* nA = has_next ? (const char*)g.A + (size_t)nxt.pm * tstep : cA; const char* nB = has_next ? (const char*)g.Bt + (size_t)nxt.pn * tstep : cB;
        for (int t = 0; t < nt; t += 2) {
            const bool last = (t == nt - 2);
            const char* a1 = cA + (size_t)(t + 1) * kstep;
            const char* a2 = last ? nA : cA + (size_t)(t + 2) * kstep; const char* b2 = last ? nB : cB + (size_t)(t + 2) * kstep;
            const char* a3 = a2 + kstep; const char* b3 = b2 + kstep;
            if (last && has_next) S.a_ready(nxt);
            if constexpr (SP2) {
            PG8_LDB(B0, 0, 0); PG8_LDB(B1, 0, 1); PG8_SCHED; PG8_LDA(At, 0, 0); PG8_STAGE(PG8_SA(1, 1), a1 + hstep, voffA);
            PG8_WAIT_V(8); PG8_WAIT_L(0); PG8_BAR; PG8_MMA(0, 0, At, B0); PG8_MMA(0, 1, At, B1); PG8_BAR; PG8_SCHED;
            PG8_LDA(At, 0, 1); PG8_STAGE(PG8_SB(0, 0), b2, voffB); PG8_STAGE(PG8_SB(0, 1), b2 + hstep, voffB); PG8_STAGE(PG8_SA(0, 0), a2, voffA);
            PG8_WAIT_V(8); PG8_WAIT_L(0); PG8_BAR; PG8_MMA(1, 0, At, B0); PG8_MMA(1, 1, At, B1); PG8_BAR; PG8_SCHED;
            PG8_LDB(B0, 1, 0); PG8_LDB(B1, 1, 1); PG8_SCHED; PG8_LDA(At, 1, 0); PG8_STAGE(PG8_SA(0, 1), a2 + hstep, voffA);
            PG8_WAIT_V(8); PG8_WAIT_L(0); PG8_BAR; PG8_MMA(0, 0, At, B0); PG8_MMA(0, 1, At, B1); PG8_BAR; PG8_SCHED;
            PG8_LDA(At, 1, 1); PG8_STAGE(PG8_SB(1, 0), b3, voffB); PG8_STAGE(PG8_SB(1, 1), b3 + hstep, voffB); PG8_STAGE(PG8_SA(1, 0), a3, voffA);
            PG8_WAIT_V(8); PG8_WAIT_L(0); PG8_BAR; PG8_MMA(1, 0, At, B0); PG8_MMA(1, 1, At, B1); PG8_BAR; PG8_SCHED;
            } else {
            PG8_LDB(B0, 0, 0); PG8_SCHED; PG8_LDA(At, 0, 0); PG8_STAGE(PG8_SA(1, 1), a1 + hstep, voffA);
            PG8_WAIT_L(8); PG8_BAR; PG8_WAIT_L(0); PG8_MMA(0, 0, At, B0); PG8_BAR; PG8_SCHED;
            PG8_LDB(B1, 0, 1); PG8_STAGE(PG8_SB(0, 0), b2, voffB);
            PG8_BAR; PG8_WAIT_L(0); PG8_MMA(0, 1, At, B1); PG8_BAR;
            PG8_LDA(At, 0, 1); PG8_STAGE(PG8_SA(0, 0), a2, voffA);
            PG8_BAR; PG8_WAIT_L(0); PG8_MMA(1, 0, At, B0); PG8_BAR; PG8_SCHED;
            PG8_STAGE(PG8_SB(0, 1), b2 + hstep, voffB);
            PG8_WAIT_V(6); PG8_BAR; PG8_MMA(1, 1, At, B1); PG8_BAR;
            PG8_LDB(B0, 1, 0); PG8_SCHED; PG8_LDA(At, 1, 0); PG8_STAGE(PG8_SA(0, 1), a2 + hstep, voffA);
            PG8_WAIT_L(8); PG8_BAR; PG8_WAIT_L(0); PG8_MMA(0, 0, At, B0); PG8_BAR; PG8_SCHED;
            PG8_LDB(B1, 1, 1); PG8_STAGE(PG8_SB(1, 0), b3, voffB);
            PG8_BAR; PG8_WAIT_L(0); PG8_MMA(0, 1, At, B1); PG8_BAR;
            PG8_LDA(At, 1, 1); PG8_STAGE(PG8_SA(1, 0), a3, voffA);
            PG8_BAR; PG8_WAIT_L(0); PG8_MMA(1, 0, At, B0); PG8_BAR; PG8_SCHED;
            PG8_STAGE(PG8_SB(1, 1), b3 + hstep, voffB);
            PG8_WAIT_V(6); PG8_BAR; PG8_MMA(1, 1, At, B1); PG8_BAR;
            }
        }
        if constexpr (ALIGN_EPI) { if (wr == 0) PG8_BAR; }
        if constexpr (!Epi::AFTER_DRAIN) { int le_; asm volatile("v_mbcnt_lo_u32_b32 %0, -1, 0\n\tv_mbcnt_hi_u32_b32 %0, -1, %0" : "=v"(le_)); E(acc, cur, wr, wc, le_ & 15, le_ >> 4); S.done(cur); }
        if (!has_next) break;
#pragma unroll
        for (int a = 0; a < 2; ++a)
#pragma unroll
            for (int b = 0; b < 2; ++b)
#pragma unroll
                for (int m = 0; m < 4; ++m)
#pragma unroll
                    for (int n = 0; n < 2; ++n) acc[a][b][m][n] = (f32x4){0.f, 0.f, 0.f, 0.f};
        cur = nxt; cA = nA; cB = nB; ++ui;
        if constexpr (ALIGN_EPI) { if (wr == 1) PG8_BAR; }
    }
    PG8_WAIT_V(0);
    if constexpr (!ALIGN_EPI) { if (wr == 0) PG8_BAR; }
    PG8_BAR;
    if constexpr (Epi::AFTER_DRAIN) { E.fused(acc, cur, wr, wc, fr, fq, lds, wid, lane); S.done(cur); }
#undef PG8_SA
#undef PG8_SB
#undef PG8_STAGE
#undef PG8_LDA
#undef PG8_LDB
#undef PG8_MMA
#undef PG8_WAIT_V
#undef PG8_WAIT_L
#undef PG8_BAR
#undef PG8_SCHED
}
}

#define LAS __attribute__((address_space(3)))
constexpr int NWAVES = 8, NTHR = 512;
constexpr int LDS_BYTES = 147456;
constexpr int NPH = 21;
typedef float f32x4 __attribute__((ext_vector_type(4)));
typedef unsigned u32x4 __attribute__((ext_vector_type(4)));

struct Args { const float* in[30]; float* out; unsigned char* ws; int ph_lo, ph_hi; };

__device__ __forceinline__ unsigned pk2(float lo, float hi) { return (unsigned)f2bf(lo) | ((unsigned)f2bf(hi) << 16); }

__device__ __forceinline__ void p0_transpose_item(const float* W, int K, int N, bf16* WT, int row_off, LAS float* scr, int item, int lane) {
    const int nblk = N / 32, kb = item / nblk, nb = item % nblk, k0 = 64 * kb, n0 = 32 * nb;
#pragma unroll 8
    for (int i = 0; i < 32; ++i) { const int kk = 2 * i + (lane >> 5); scr[kk * 33 + (lane & 31)] = W[(size_t)(k0 + kk) * N + n0 + (lane & 31)]; }
    asm volatile("s_waitcnt lgkmcnt(0)" ::: "memory");
    const int c = lane & 7;
#pragma unroll
    for (int j = 0; j < 4; ++j) { const int n = (lane >> 3) + 8 * j; const LAS float* s = scr + (8 * c) * 33 + n;
        u32x4 o; o.x = pk2(s[0 * 33], s[1 * 33]); o.y = pk2(s[2 * 33], s[3 * 33]); o.z = pk2(s[4 * 33], s[5 * 33]); o.w = pk2(s[6 * 33], s[7 * 33]);
        *(u32x4*)(WT + (size_t)(row_off + n0 + n) * K + k0 + 8 * c) = o; }
    asm volatile("s_waitcnt lgkmcnt(0)" ::: "memory");
}

__device__ __forceinline__ void norm_mod_row(const float* xr, const float* gamma, const float* sh, const float* sc, bf16* orow, int lane) {
    f32x4 v[4]; float ss = 0.f;
#pragma unroll
    for (int j = 0; j < 4; ++j) { v[j] = *(const f32x4*)(xr + j * 256 + lane * 4); ss += (v[j].x * v[j].x + v[j].y * v[j].y) + (v[j].z * v[j].z + v[j].w * v[j].w); }
    const float rs = rsqrtf(wave_sum(ss, lane) * (1.f / D) + NORM_EPS);
#pragma unroll
    for (int j = 0; j < 4; ++j) { const int d = j * 256 + lane * 4; const f32x4 g = *(const f32x4*)(gamma + d), a = *(const f32x4*)(sc + d), s = *(const f32x4*)(sh + d);
        const f32x4 y = v[j] * rs * g * (a + 1.f) + s; uint2 o; o.x = pk2(y.x, y.y); o.y = pk2(y.z, y.w); *(uint2*)(orow + d) = o; }
}


#define XB_TMO      128
#define XB_XCNT(j)  (256  + 64 * (j))
#define XB_XSUB(j)  (1280 + 64 * (j))
#define XB_XGEN(j)  (2304 + 64 * (j))
#define XB_TOP      3328
#define XB_TOPGEN   3392
#define XCD_BAR_WORDS 3456
#define XB_SPIN_CAP (1u << 18)

__device__ __forceinline__ unsigned xb_ld(unsigned* p)              { return __hip_atomic_load(p, __ATOMIC_RELAXED, __HIP_MEMORY_SCOPE_AGENT); }
__device__ __forceinline__ unsigned xb_add(unsigned* p, unsigned v) { return __hip_atomic_fetch_add(p, v, __ATOMIC_RELAXED, __HIP_MEMORY_SCOPE_AGENT); }
__device__ __forceinline__ unsigned xb_xcc_id() { return (unsigned)__builtin_amdgcn_s_getreg((3 << 11) | 20) & 0xFu; }
#define XB_SPIN(cond, bar) do { unsigned _sp = 0; while (cond) { __builtin_amdgcn_s_sleep(1); \
    if ((++_sp & 255u) == 0u) { if (xb_ld(&(bar)[XB_TMO])) break; if (_sp > XB_SPIN_CAP) { atomicAdd(&(bar)[XB_TMO], 1u); break; } } } } while (0)

struct XcdBarrier {
    unsigned* bar; unsigned x; int w0;
    volatile __attribute__((address_space(3))) unsigned* st;
};

__device__ __forceinline__ XcdBarrier xcd_barrier_post(unsigned* bar, volatile __attribute__((address_space(3))) unsigned* st) {
    XcdBarrier b; b.bar = bar; b.x = xb_xcc_id(); b.st = st; b.w0 = __builtin_amdgcn_readfirstlane((int)threadIdx.x >> 6);
    if (threadIdx.x == 0) (void)xb_add(&bar[XB_XCNT(b.x)], 1u);
    return b;
}
__device__ __forceinline__ void xcd_barrier_complete(unsigned* bar, unsigned x, unsigned& nloc, unsigned& nx) {
    const unsigned G = gridDim.x * gridDim.y * gridDim.z;
    unsigned sum, cnt, mine, sp = 0u;
    for (;;) {
        sum = 0u; cnt = 0u; mine = 0u;
#pragma unroll
        for (unsigned j = 0; j < 16; ++j) { const unsigned c = xb_ld(&bar[XB_XCNT(j)]); sum += c; cnt += (c > 0u) ? 1u : 0u; }
        mine = xb_ld(&bar[XB_XCNT(x)]);
        if (sum == G) break;
        __builtin_amdgcn_s_sleep(1);
        if ((++sp & 255u) == 0u) { if (xb_ld(&bar[XB_TMO])) break; if (sp > XB_SPIN_CAP) { atomicAdd(&bar[XB_TMO], 1u); break; } }
    }
    nloc = mine > 0u ? mine : 1u; nx = cnt > 0u ? cnt : 1u;
}

template <bool FIRST> __device__ __forceinline__ void xcd_barrier(const XcdBarrier& b) {
    asm volatile("s_waitcnt vmcnt(0)" ::: "memory");
    __syncthreads();
    int lid_; asm volatile("v_mbcnt_lo_u32_b32 %0, -1, 0\n\tv_mbcnt_hi_u32_b32 %0, -1, %0" : "=v"(lid_));
    if (b.w0 == 0 && lid_ == 0) {
        unsigned* bar = b.bar;
        __builtin_amdgcn_s_waitcnt(0);
        unsigned nloc = b.st[0], nx = b.st[1];
        if (FIRST && nloc == 0u) { xcd_barrier_complete(bar, b.x, nloc, nx); b.st[0] = nloc; b.st[1] = nx; }
        const unsigned old = xb_add(&bar[XB_XSUB(b.x)], 1u);
        const unsigned gen = old / nloc;
        if (old + 1u == (gen + 1u) * nloc) {
            __builtin_amdgcn_fence(__ATOMIC_RELEASE, "agent");
            asm volatile("s_waitcnt vmcnt(0)" ::: "memory");
            const unsigned og = xb_add(&bar[XB_TOP], 1u);
            const unsigned tg = og / nx;
            if (og + 1u == (tg + 1u) * nx) xb_add(&bar[XB_TOPGEN], 1u);
            else XB_SPIN(xb_ld(&bar[XB_TOPGEN]) == tg, bar);
            __builtin_amdgcn_fence(__ATOMIC_ACQUIRE, "agent");
            xb_add(&bar[XB_XGEN(b.x)], 1u);
            asm volatile("s_waitcnt vmcnt(0)" ::: "memory");
        } else {
            XB_SPIN(xb_ld(&bar[XB_XGEN(b.x)]) == gen, bar);
            __builtin_amdgcn_fence(__ATOMIC_ACQUIRE, "agent");
            asm volatile("s_waitcnt vmcnt(0)" ::: "memory");
        }
    }
    __syncthreads();
}


__device__ __forceinline__ unsigned mono_u32(float f) { unsigned u = __float_as_uint(f); return (u & 0x80000000u) ? ~u : (u | 0x80000000u); }
__device__ __forceinline__ float demono_u32(unsigned u) { return __uint_as_float((u & 0x80000000u) ? (u & 0x7FFFFFFFu) : ~u); }
__device__ __forceinline__ unsigned pack_key7(float f, int idx) { return (mono_u32(f) & 0xFFFFFF80u) | (unsigned)(127 - idx); }
__device__ __forceinline__ float unpack_key7(unsigned k) { return demono_u32((k & 0xFFFFFF80u) | 0x40u); }
__device__ __forceinline__ float unpack_key8(unsigned k) { return demono_u32((k & 0xFFFFFF00u) | 0x80u); }
__device__ __forceinline__ void ce_desc(unsigned& a, unsigned& b) { const unsigned hi = a > b ? a : b, lo = a > b ? b : a; a = hi; b = lo; }
__device__ __forceinline__ void sort16_desc(unsigned* v) {
#pragma unroll
    for (int k = 2; k <= 16; k <<= 1)
#pragma unroll
        for (int j = k >> 1; j > 0; j >>= 1)
#pragma unroll
            for (int i = 0; i < 16; ++i) { const int l = i ^ j; if (l > i) { if ((i & k) == 0) ce_desc(v[i], v[l]); else ce_desc(v[l], v[i]); } }
}
__device__ __forceinline__ void bmerge16_desc(unsigned* v) {
#pragma unroll
    for (int j = 8; j > 0; j >>= 1)
#pragma unroll
        for (int i = 0; i < 16; ++i) { const int l = i ^ j; if (l > i) ce_desc(v[i], v[l]); }
}
__device__ __forceinline__ void merge_top16(unsigned* a, const unsigned* b) {
#pragma unroll
    for (int i = 0; i < 16; ++i) { const unsigned o = b[15 - i]; a[i] = a[i] > o ? a[i] : o; }
    bmerge16_desc(a);
}
__device__ __forceinline__ void stage2_cands(const unsigned* s0, const unsigned* s1, int hh, unsigned* c) {
    float A[16], B[16];
#pragma unroll
    for (int i = 0; i < 16; ++i) { const float f0 = unpack_key7(s0[i]), f1 = unpack_key7(s1[i]); A[i] = hh ? f1 : f0; B[i] = hh ? f0 : f1; }
    int n = 0;
#pragma unroll
    for (int i = 0; i < 4; ++i)
#pragma unroll
        for (int j = i; j < 16; ++j) { if ((i + 1) * (j + 1) > 16) continue;
            const float val = A[i] + B[j]; const unsigned id = hh ? (unsigned)((j << 4) | i) : (unsigned)((i << 4) | j);
            unsigned key = (mono_u32(val) & 0xFFFFFF00u) | id; if (hh && i == j) key = 0u; c[n++] = key; }
#pragma unroll
    for (; n < 32; ++n) c[n] = 0u;
}

typedef short bf16x8_t __attribute__((ext_vector_type(8)));
typedef float f32x16 __attribute__((ext_vector_type(16)));
__device__ __forceinline__ float gelu_erf(float a) { return 0.5f * a * (1.f + erff(a * 0.70710678118654752f)); }


typedef __attribute__((address_space(3))) bf16 lbf16;
typedef float cvt_f32x2 __attribute__((ext_vector_type(2))); typedef __bf16 cvt_bf16x2 __attribute__((ext_vector_type(2)));
__device__ __forceinline__ unsigned cvtpk(float lo, float hi) { const cvt_f32x2 v = {lo, hi}; const cvt_bf16x2 b = __builtin_convertvector(v, cvt_bf16x2); return __builtin_bit_cast(unsigned, b); }
__device__ __forceinline__ f32x16 mm32(bf16x8_t a, bf16x8_t b, f32x16 c) { return __builtin_amdgcn_mfma_f32_32x32x16_bf16(a, b, c, 0, 0, 0); }
__device__ __forceinline__ bf16x8_t frag_from_u32x4(unsigned x, unsigned y, unsigned z, unsigned w) { typedef unsigned u4 __attribute__((ext_vector_type(4))); u4 t = {x, y, z, w}; return __builtin_bit_cast(bf16x8_t, t); }
template <int S> __device__ __forceinline__ bf16x8_t accop(const f32x16& z) {
    return frag_from_u32x4(cvtpk(z[8 * S], z[8 * S + 1]), cvtpk(z[8 * S + 2], z[8 * S + 3]), cvtpk(z[8 * S + 4], z[8 * S + 5]), cvtpk(z[8 * S + 6], z[8 * S + 7])); }
template <int S> __device__ __forceinline__ bf16x8_t ldpermcol(const lbf16* a, int col, int hh) {
    const lbf16* p = a + (16 * S + 4 * hh) * 72 + col;
    const unsigned e0 = p[0], e1 = p[72], e2 = p[144], e3 = p[216], e4 = p[8 * 72], e5 = p[9 * 72], e6 = p[10 * 72], e7 = p[11 * 72];
    return frag_from_u32x4(e0 | (e1 << 16), e2 | (e3 << 16), e4 | (e5 << 16), e6 | (e7 << 16)); }
__device__ __forceinline__ bf16x8_t ldrow(const lbf16* a, int row, int ks, int hh) { return *(const __attribute__((address_space(3))) bf16x8_t*)(a + row * 72 + ks * 16 + 8 * hh); }
__device__ __forceinline__ int rowidx(int e, int hh) { return (e & 3) + 8 * (e >> 2) + 4 * hh; }

__device__ __forceinline__ void convert_tables_fp8(const float* pu, const float* pv, unsigned char* u8, unsigned char* v8, float* usc, float* vsc, int l, int wv, int nw, int lane) {
    for (int rr0 = wv * 2; rr0 < 2 * NEXP; rr0 += nw * 2) {
        f32x4 v[2][4]; float m[2];
#pragma unroll
        for (int rr = 0; rr < 2; ++rr) { const int q = rr0 + rr; const size_t row = (size_t)l * NEXP + (q < NEXP ? q : q - NEXP); const float* sp_ = (q < NEXP ? pu : pv) + row * D + lane * 16;
#pragma unroll
            for (int k = 0; k < 4; ++k) v[rr][k] = *(const f32x4*)(sp_ + k * 4); }
#pragma unroll
        for (int rr = 0; rr < 2; ++rr) { float mm = 0.f;
#pragma unroll
            for (int k = 0; k < 4; ++k) mm = fmaxf(fmaxf(mm, fmaxf(fabsf(v[rr][k].x), fabsf(v[rr][k].y))), fmaxf(fabsf(v[rr][k].z), fabsf(v[rr][k].w)));
#pragma unroll
            for (int o = 1; o < 64; o <<= 1) mm = fmaxf(mm, shflx(mm, lane, o));
            m[rr] = mm; }
#pragma unroll
        for (int rr = 0; rr < 2; ++rr) { const int q = rr0 + rr; const size_t row = (size_t)l * NEXP + (q < NEXP ? q : q - NEXP); const float sc = m[rr] > 0.f ? 448.f / m[rr] : 1.f;
            u32x4 o; int w;
            w = 0; w = __builtin_amdgcn_cvt_pk_fp8_f32(v[rr][0].x * sc, v[rr][0].y * sc, w, false); w = __builtin_amdgcn_cvt_pk_fp8_f32(v[rr][0].z * sc, v[rr][0].w * sc, w, true); o.x = (unsigned)w;
            w = 0; w = __builtin_amdgcn_cvt_pk_fp8_f32(v[rr][1].x * sc, v[rr][1].y * sc, w, false); w = __builtin_amdgcn_cvt_pk_fp8_f32(v[rr][1].z * sc, v[rr][1].w * sc, w, true); o.y = (unsigned)w;
            w = 0; w = __builtin_amdgcn_cvt_pk_fp8_f32(v[rr][2].x * sc, v[rr][2].y * sc, w, false); w = __builtin_amdgcn_cvt_pk_fp8_f32(v[rr][2].z * sc, v[rr][2].w * sc, w, true); o.z = (unsigned)w;
            w = 0; w = __builtin_amdgcn_cvt_pk_fp8_f32(v[rr][3].x * sc, v[rr][3].y * sc, w, false); w = __builtin_amdgcn_cvt_pk_fp8_f32(v[rr][3].z * sc, v[rr][3].w * sc, w, true); o.w = (unsigned)w;
            *(u32x4*)((q < NEXP ? u8 : v8) + row * D + lane * 16) = o;
            if (lane == 0) (q < NEXP ? usc : vsc)[row] = m[rr] > 0.f ? m[rr] * (1.f / 448.f) : 1.f; }
    }
}

__global__ void __launch_bounds__(NTHR, 2) mega(Args args) {
    extern __shared__ __attribute__((aligned(16))) unsigned char lds_raw[];
    LAS unsigned char* lds = (LAS unsigned char*)lds_raw;
    const int G = gridDim.x, bx = blockIdx.x, NGW = G * NWAVES;
    const int wave0 = __builtin_amdgcn_readfirstlane((int)threadIdx.x >> 6);
    typedef const unsigned char __attribute__((address_space(4))) kbyte;
#define PHASE_IDS int tid; asm volatile("v_mbcnt_lo_u32_b32 %0, -1, 0\n\tv_mbcnt_hi_u32_b32 %0, -1, %0" : "=v"(tid)); tid += wave0 * 64;     const int lane = tid & 63, wave = __builtin_amdgcn_readfirstlane(tid >> 6), gw = bx * NWAVES + wave; (void)lane; (void)gw; \
    kbyte* kp = (kbyte*)__builtin_amdgcn_kernarg_segment_ptr(); asm volatile("" : "+s"(kp)); \
    unsigned char* const ws = (unsigned char*)*(__attribute__((address_space(1))) unsigned char* const __attribute__((address_space(4)))*)(kp + 31 * 8); float* const X = (float*)*(__attribute__((address_space(1))) float* const __attribute__((address_space(4)))*)(kp + 30 * 8); (void)ws; (void)X;
#define INP(i) ((const float*)(*(const __attribute__((address_space(1))) float* const __attribute__((address_space(4)))*)(kp + (i) * 8)))
#define MOD ((float*)(ws + WS_MOD))
#define H ((bf16*)(ws + WS_H))
#define PROJ ((bf16*)(ws + WS_PROJ))
#define Q ((bf16*)(ws + WS_Q))
#define MIX ((bf16*)(ws + WS_MIX))
#define Rb ((bf16*)(ws + WS_R))
#define Kb ((bf16*)(ws + WS_K))
#define V0 ((bf16*)(ws + WS_V0))
#define V1 ((bf16*)(ws + WS_V1))
#define KKb ((bf16*)(ws + WS_KK))
#define Bb ((bf16*)(ws + WS_B))
#define Gb ((bf16*)(ws + WS_G))
#define BGb ((bf16*)(ws + WS_BG))
#define Wd ((float*)(ws + WS_W))
#define Y ((float*)(ws + WS_Y))
#define QB ((float*)(ws + WS_QB))
#define SH ((float*)(ws + WS_SH))
#define WUPT ((bf16*)(ws + WS_LORA))
#define AUPT ((bf16*)(ws + WS_LORA + 131072))
#define GUPT ((bf16*)(ws + WS_LORA + 262144))
#define VUPT ((bf16*)(ws + WS_LORA + 524288))
#define PWT ((bf16*)(ws + WS_LORA + 655360))
#define INVN ((float*)(ws + WS_INVN))
#define BSUM ((float*)(ws + WS_BSUM))
#define SCN ((unsigned char*)(ws + WS_SCN))
#define IDX ((int*)(ws + WS_IDX))
#define GATE ((float*)(ws + WS_GATE))
#define WinT ((bf16*)(ws + WS_WIN_T))
#define WoutT ((bf16*)(ws + WS_WOUT_T))
#define PqT ((bf16*)(ws + WS_PQ_T))
#define KEYS ((bf16*)(ws + WS_KEYS))
#define U8 ((unsigned char*)(ws + WS_U))
#define V8 ((unsigned char*)(ws + WS_V))
#define USc ((float*)(ws + WS_US))
#define VSc ((float*)(ws + WS_VS))
    const int lo = args.ph_lo, hi = args.ph_hi;
    { volatile LAS unsigned* misc = (volatile LAS unsigned*)(lds + LDS_BYTES - 64); if (threadIdx.x < 4) misc[threadIdx.x] = 0u; __syncthreads(); }
    const XcdBarrier xbar = xcd_barrier_post((unsigned*)(args.ws) + 4096, (volatile LAS unsigned*)(lds + LDS_BYTES - 64));
#define IN(k) (lo <= (k) && (k) < hi)
#ifndef REP_PHASE
#define REP_PHASE (-1)
#endif
#define REPS(k) ((k) == REP_PHASE ? 3 : 1)
#define SEAM(k) do { if (IN(k) && IN((k) + 1)) { if ((k) == 0) cg::this_grid().sync(); else { XcdBarrier xb_ = xbar; asm volatile("" : "+s"(xb_.bar)); if ((k) == 1) xcd_barrier<true>(xb_); else xcd_barrier<false>(xb_); } } } while (0)

    if (IN(0)) { PHASE_IDS
        { LAS float* ca = (LAS float*)lds; LAS float* red = (LAS float*)(lds + 16384);
          const float* c = INP(1); const float* ada_w = INP(2); const float* ada_b = INP(3);
          bool have = false;
          for (int it = bx; it < 96; it += G) {
              if (!have) { for (int i = tid; i < BATCH * D; i += NTHR) { const float v = c[i]; ca[i] = v / (1.f + expf(-v)); } have = true; __syncthreads(); }
              const int l = it / 48, n = (it % 48) * 128 + (tid & 127), kq = tid >> 7;
              const float* w = ada_w + (size_t)l * D * 6 * D + (size_t)(kq * 256) * 6 * D + n;
              float a0 = 0.f, a1 = 0.f, a2 = 0.f, a3 = 0.f;
#pragma unroll 32
              for (int k = 0; k < 256; ++k) { const float wv = w[(size_t)k * 6 * D]; const int kk = kq * 256 + k; a0 += ca[kk] * wv; a1 += ca[D + kk] * wv; a2 += ca[2 * D + kk] * wv; a3 += ca[3 * D + kk] * wv; }
              red[(kq * 4 + 0) * 128 + (tid & 127)] = a0; red[(kq * 4 + 1) * 128 + (tid & 127)] = a1; red[(kq * 4 + 2) * 128 + (tid & 127)] = a2; red[(kq * 4 + 3) * 128 + (tid & 127)] = a3;
              __syncthreads();
              { const int b = tid >> 7, col = tid & 127, nn = (it % 48) * 128 + col;
                const float s = red[(0 * 4 + b) * 128 + col] + red[(1 * 4 + b) * 128 + col] + red[(2 * 4 + b) * 128 + col] + red[(3 * 4 + b) * 128 + col];
                MOD[(size_t)l * BATCH * 6 * D + (size_t)b * 6 * D + nn] = s + ada_b[l * 6 * D + nn]; }
              __syncthreads();
          }
          __syncthreads(); }
        { LAS float* scr = (LAS float*)(lds + wave * 16384);
          constexpr int I_IN = (D / 64) * (IN_COLS / 32), I_VR = (D / 64) * (MVL / 32), I_OUT = (D / 64) * (D / 32), I_PQ = (D / 64) * (PH * PQ / 32);
          constexpr int NIT = 2 * I_IN + I_VR + 2 * I_OUT + 2 * I_PQ;
          for (int it = gw; it < NIT; it += NGW) { int r = it;
              if (r < 2 * I_IN) { const int l = r / I_IN; p0_transpose_item(INP(5) + (size_t)l * D * IN_COLS, D, IN_COLS, WinT + (size_t)l * LDP * D, 0, scr, r % I_IN, lane); continue; } r -= 2 * I_IN;
              if (r < I_VR) { p0_transpose_item(INP(12), D, MVL, WinT + (size_t)1 * LDP * D, IN_COLS, scr, r, lane); continue; } r -= I_VR;
              if (r < 2 * I_OUT) { const int l = r / I_OUT; p0_transpose_item(INP(23) + (size_t)l * D * D, D, D, WoutT + (size_t)l * D * D, 0, scr, r % I_OUT, lane); continue; } r -= 2 * I_OUT;
              { const int l = r / I_PQ; p0_transpose_item(INP(25) + (size_t)l * D * PH * PQ, D, PH * PQ, PqT + (size_t)l * PH * PQ * D, 0, scr, r % I_PQ, lane); } }
          for (int it = gw; it < 2 * 16 + 2 * 16 + 2 * 32; it += NGW) { int r = it;
              if (r < 32) { const int l = r / 16; p0_transpose_item(INP(8) + (size_t)l * DL * RW, DL, RW, WUPT + (size_t)l * RW * DL, 0, scr, r % 16, lane); continue; } r -= 32;
              if (r < 32) { const int l = r / 16; p0_transpose_item(INP(10) + (size_t)l * AL * RW, AL, RW, AUPT + (size_t)l * RW * AL, 0, scr, r % 16, lane); continue; } r -= 32;
              { const int l = r / 32; p0_transpose_item(INP(11) + (size_t)l * GL * RW, GL, RW, GUPT + (size_t)l * RW * GL, 0, scr, r % 32, lane); } }
          { const float* vu = INP(15); for (int e = bx * NTHR + tid; e < MVL * RW; e += G * NTHR) { const int n = e >> 5, k = e & 31; VUPT[e] = f2bf(vu[k * RW + n]); } }
          for (int it = gw; it < 8 * 8; it += NGW) p0_transpose_item(INP(21) + (size_t)(it >> 3) * PG * PG, PG, PG, PWT + (size_t)(it >> 3) * PG * PG, 0, scr, it & 7, lane);
        }
        { const size_t gt = (size_t)bx * NTHR + tid, NT = (size_t)G * NTHR;
          constexpr size_t NK8 = (size_t)2 * PH * 2 * NKEYS * PHALF / 8;
          const float* src = INP(26); bf16* dst = KEYS;
          for (size_t i = gt; i < NK8; i += NT) {
              const f32x4 a = *(const f32x4*)(src + i * 8), b = *(const f32x4*)(src + i * 8 + 4);
              u32x4 o; o.x = pk2(a.x, a.y); o.y = pk2(a.z, a.w); o.z = pk2(b.x, b.y); o.w = pk2(b.z, b.w); *(u32x4*)(dst + i * 8) = o; }
        }
    }
    SEAM(0);

#pragma unroll
    for (int l = 0; l < DEPTH; ++l) {
        const int pb = 1 + 10 * l;
#define modl (MOD + (size_t)l * BATCH * 6 * D)
#define xin (l == 0 ? INP(0) : (const float*)X)
        if (l == 0 && IN(pb + 0)) { PHASE_IDS const float* gamma = INP(4) + l * D;
            for (int row = gw; row < T; row += NGW) { const int b = row / SEQ; norm_mod_row(xin + (size_t)row * D, gamma, modl + (size_t)b * 6 * D, modl + (size_t)b * 6 * D + D, H + (size_t)row * D, lane); } }
        SEAM(pb + 0);
        if (IN(pb + 1)) { PHASE_IDS const int N1 = l == 0 ? IN_COLS : LDP;
            pg8::Gemm g{H, WinT + (size_t)l * LDP * D, T, N1, D}; pg8::StaticOrder S; S.init(T, N1, G, bx);
            pg8::EpiBf16<0> E{PROJ, LDP, nullptr, 0, 0, 1.f};
            pg8::gemm_phase<pg8::EpiBf16<0>, pg8::StaticOrder, true, true>(lds, g, S, E, tid); }
        SEAM(pb + 1);

        if (IN(pb + 2)) { PHASE_IDS
            constexpr int LST = 296;
            LAS bf16* lin = (LAS bf16*)lds;
            const float* mu = INP(6) + l * RWKV_COLS; const float* vmu = INP(13);
            const float* w0p = INP(7) + l * RW; const float* a0p = INP(9) + l * RW; const float* kkp = INP(16) + l * RW; const float* kap = INP(17) + l * RW; const float* rkp = INP(18) + l * RW; const float* v0p = INP(14);
            const bf16* wupT = WUPT + (size_t)l * RW * DL; const bf16* aupT = AUPT + (size_t)l * RW * AL; const bf16* gupT = GUPT + (size_t)l * RW * GL; const bf16* vupT = VUPT;
            bf16* Vl = l == 0 ? V0 : V1;
            const int r32 = lane & 31, hh = lane >> 5, h = wave;
            for (int tile = bx; tile < T / 32; tile += G) {
                const int t0 = tile * 32;
                __syncthreads();
#pragma unroll 1
                for (int it0 = 0; it0 < 3; it0 += 2) {
                  u32x4 cu_[2], pv_[2]; f32x4 m0_[2], m1_[2];
#pragma unroll
                  for (int it = 0; it < 2; ++it) { const int c8 = tid + (it0 + it) * NTHR; const bool ok = c8 < 32 * 36; const int tok = ok ? c8 / 36 : 0, jc = ok ? c8 % 36 : 0, t = t0 + tok, sq = t % SEQ;
                      cu_[it] = (u32x4){0u, 0u, 0u, 0u}; pv_[it] = (u32x4){0u, 0u, 0u, 0u}; m0_[it] = (f32x4){0.f, 0.f, 0.f, 0.f}; m1_[it] = m0_[it];
                      if (ok && (jc < 32 || l > 0)) { const int col = jc < 32 ? 3 * RW + jc * 8 : IN_COLS + (jc - 32) * 8;
                          cu_[it] = *(const u32x4*)(PROJ + (size_t)t * LDP + col); if (sq > 0) pv_[it] = *(const u32x4*)(PROJ + (size_t)(t - 1) * LDP + col);
                          const float* mp = jc < 32 ? mu + col : vmu + (jc - 32) * 8; m0_[it] = *(const f32x4*)mp; m1_[it] = *(const f32x4*)(mp + 4); } }
#pragma unroll
                  for (int it = 0; it < 2; ++it) { const int c8 = tid + (it0 + it) * NTHR; if (c8 < 32 * 36) { const int tok = c8 / 36, jc = c8 % 36;
                      u32x4 o = {0u, 0u, 0u, 0u};
                      if (jc < 32 || l > 0) {
                          float x[8]; const unsigned cw[4] = {cu_[it].x, cu_[it].y, cu_[it].z, cu_[it].w}, pw[4] = {pv_[it].x, pv_[it].y, pv_[it].z, pv_[it].w}; const float mm[8] = {m0_[it].x, m0_[it].y, m0_[it].z, m0_[it].w, m1_[it].x, m1_[it].y, m1_[it].z, m1_[it].w};
#pragma unroll
                          for (int i = 0; i < 4; ++i) { const float c0 = __uint_as_float(cw[i] << 16), c1 = __uint_as_float(cw[i] & 0xffff0000u), p0 = __uint_as_float(pw[i] << 16), p1 = __uint_as_float(pw[i] & 0xffff0000u);
                              x[2 * i] = c0 + (p0 - c0) * mm[2 * i]; x[2 * i + 1] = c1 + (p1 - c1) * mm[2 * i + 1]; }
                          if (jc < 8) {
#pragma unroll
                              for (int i = 0; i < 8; ++i) { const float e2 = __expf(-2.f * fabsf(x[i])); const float th = (1.f - e2) * __builtin_amdgcn_rcpf(1.f + e2); x[i] = x[i] < 0.f ? -th : th; } }
                          else if (jc >= 16 && jc < 32) {
#pragma unroll
                              for (int i = 0; i < 8; ++i) x[i] = __builtin_amdgcn_rcpf(1.f + __expf(-x[i])); }
                          o.x = pk2(x[0], x[1]); o.y = pk2(x[2], x[3]); o.z = pk2(x[4], x[5]); o.w = pk2(x[6], x[7]);
                      }
                      *(LAS u32x4*)(lin + tok * LST + jc * 8) = o; } } }
                __syncthreads();
                float ssq[16], bsm[16];
#pragma unroll
                for (int e = 0; e < 16; ++e) { ssq[e] = 0.f; bsm[e] = 0.f; }
                const bool first = (t0 % SEQ) == 0;
#pragma unroll 1
                for (int rt = 0; rt < 2; ++rt) {
                    f32x16 accW, accA, accG, accV;
#pragma unroll
                    for (int e = 0; e < 16; ++e) { accW[e] = 0.f; accA[e] = 0.f; accG[e] = 0.f; accV[e] = 0.f; }
                    int c = h * HS + rt * 32 + r32;
int hh8 = 8 * hh; asm volatile("" : "+v"(c), "+v"(hh8));
                    const LAS bf16* lrow = lin + r32 * LST + 8 * hh;
#pragma unroll
                    for (int ks = 0; ks < 4; ++ks) { const bf16x8_t wv = *(const bf16x8_t*)(wupT + (size_t)c * DL + ks * 16 + hh8); const bf16x8_t xq = *(const LAS bf16x8_t*)(lrow + ks * 16); accW = __builtin_amdgcn_mfma_f32_32x32x16_bf16(xq, wv, accW, 0, 0, 0); }
#pragma unroll
                    for (int ks = 0; ks < 4; ++ks) { const bf16x8_t wv = *(const bf16x8_t*)(aupT + (size_t)c * AL + ks * 16 + hh8); const bf16x8_t xq = *(const LAS bf16x8_t*)(lrow + 64 + ks * 16); accA = __builtin_amdgcn_mfma_f32_32x32x16_bf16(xq, wv, accA, 0, 0, 0); }
#pragma unroll
                    for (int ks = 0; ks < 8; ++ks) { const bf16x8_t wv = *(const bf16x8_t*)(gupT + (size_t)c * GL + ks * 16 + hh8); const bf16x8_t xq = *(const LAS bf16x8_t*)(lrow + 128 + ks * 16); accG = __builtin_amdgcn_mfma_f32_32x32x16_bf16(xq, wv, accG, 0, 0, 0); }
                    if (l > 0) {
#pragma unroll
                        for (int ks = 0; ks < 2; ++ks) { const bf16x8_t wv = *(const bf16x8_t*)(vupT + (size_t)c * MVL + ks * 16 + hh8); const bf16x8_t xq = *(const LAS bf16x8_t*)(lrow + 256 + ks * 16); accV = __builtin_amdgcn_mfma_f32_32x32x16_bf16(xq, wv, accV, 0, 0, 0); } }
                    const float mur = mu[c], muk = mu[RW + c], muv = mu[2 * RW + c], w0c = w0p[c], a0c = a0p[c], kkc = kkp[c], kac = kap[c], rkc = rkp[c];
                    const float v0c = l > 0 ? v0p[c] : 0.f;
#pragma unroll
                    for (int eb = 0; eb < 16; eb += 4) {
                        bf16 lr[4], lk[4], lv[4], lrp[4], lkp[4], lvp[4], lvf[4];
#pragma unroll
                        for (int i = 0; i < 4; ++i) { const int e = eb + i; const int tok = (e & 3) + 8 * (e >> 2) + 4 * hh, t = t0 + tok; const bool hasprev = !(first && tok == 0);
                            const bf16* pr = PROJ + (size_t)t * LDP + c;
                            lr[i] = pr[0]; lk[i] = pr[RW]; lv[i] = pr[2 * RW];
                            lrp[i] = hasprev ? pr[-LDP] : (bf16)0; lkp[i] = hasprev ? pr[RW - LDP] : (bf16)0; lvp[i] = hasprev ? pr[2 * RW - LDP] : (bf16)0;
                            lvf[i] = l > 0 ? V0[(size_t)t * RW + c] : (bf16)0; }
                        __builtin_amdgcn_sched_barrier(0);
#pragma unroll
                        for (int i = 0; i < 4; ++i) { const int e = eb + i; const int tok = (e & 3) + 8 * (e >> 2) + 4 * hh, t = t0 + tok; const size_t o = (size_t)t * RW + c;
                            float r = bf2f(lr[i]), k = bf2f(lk[i]), v = bf2f(lv[i]);
                            r += (bf2f(lrp[i]) - r) * mur; k += (bf2f(lkp[i]) - k) * muk; v += (bf2f(lvp[i]) - v) * muv;
                            const float z = -(w0c + accW[e]); const float sp = fmaxf(z, 0.f) + __logf(1.f + __expf(-fabsf(z)));
                            const float decay = __expf(-__expf(-sp - 0.5f));
                            const float a = __builtin_amdgcn_rcpf(1.f + __expf(-(a0c + accA[e]))); const float g = accG[e];
                            if (l > 0) { const float vfv = bf2f(lvf[i]); v = v + (vfv - v) * __builtin_amdgcn_rcpf(1.f + __expf(-(v0c + accV[e]))); }
                            const float kk = k * kkc; const float k2 = k * (1.f + (a - 1.f) * kac);
                            ssq[e] += kk * kk; bsm[e] += r * k2 * rkc;
                            Rb[o] = f2bf(r); Kb[o] = f2bf(k2); Vl[o] = f2bf(v); KKb[o] = f2bf(kk); Bb[o] = f2bf(kk * a); Gb[o] = f2bf(g); BGb[o] = f2bf(v * g); Wd[o] = decay;
                        }
                    }
                }
#pragma unroll
                for (int e = 0; e < 16; ++e) { float a_ = red16(ssq[e]), b_ = red16(bsm[e]); a_ += shflx(a_, lane, 16); b_ += shflx(b_, lane, 16); ssq[e] = a_; bsm[e] = b_; }
                if (r32 == 0) {
#pragma unroll
                    for (int e = 0; e < 16; ++e) { const int tok = (e & 3) + 8 * (e >> 2) + 4 * hh; INVN[(size_t)(t0 + tok) * NH + h] = rsqrtf(fmaxf(ssq[e], 1e-24f)); BSUM[(size_t)(t0 + tok) * NH + h] = bsm[e]; } }
            }
            {
                constexpr int DST = 520;
                int lane_p; asm volatile("v_mbcnt_lo_u32_b32 %0, -1, 0\n\tv_mbcnt_hi_u32_b32 %0, -1, %0" : "=v"(lane_p)); const int r32 = lane_p & 31, hh = lane_p >> 5;
                lbf16* dlb = (lbf16*)lds;
                const int c = tid, g = c >> 7, win = 2 << g;
                const bf16* pwt = PWT + (size_t)(l * 4 + (wave >> 1)) * PG * PG; const float* psc = INP(22) + l * PW;
                for (int tile = bx; tile < T / 32; tile += G) {
                    const int t0 = tile * 32; const bool first = (t0 % SEQ) == 0;
                    __syncthreads();
                    float p[47];
#pragma unroll
                    for (int j = 0; j < 47; ++j) p[j] = (j >= 15 || !first) ? bf2f(PROJ[(size_t)(t0 - 15 + j) * LDP + RWKV_COLS + c]) : 0.f;
                    float sw = 0.f;
#pragma unroll
                    for (int j = 1; j <= 15; ++j) sw += (j < win) ? p[15 - j] : 0.f;
                    const float invw = 1.f / (float)win;
#pragma unroll
                    for (int i = 0; i < 32; ++i) {
                        sw += p[15 + i];
                        const float inv = (first && i < 15) ? 1.f / (float)min(i + 1, win) : invw;
                        dlb[i * DST + c] = f2bf(sw * inv - p[15 + i]);
                        float drop = 0.f;
#pragma unroll
                        for (int q = 0; q < 4; ++q) { const int w_ = 2 << q; if (g == q) drop = p[15 + i - w_ + 1]; }
                        sw -= drop;
                    }
                    __syncthreads();
                    const int gg = wave >> 1, half = wave & 1;
#pragma unroll
                    for (int ct = 0; ct < 2; ++ct) {
                        const int dd0 = half * 64 + ct * 32;
                        f32x16 acc;
#pragma unroll
                        for (int e = 0; e < 16; ++e) acc[e] = 0.f;
#pragma unroll
                        for (int ks = 0; ks < 8; ++ks) { const bf16x8_t a = *(const __attribute__((address_space(3))) bf16x8_t*)(dlb + r32 * DST + gg * PG + ks * 16 + 8 * hh);
                            const bf16x8_t w = *(const bf16x8_t*)(pwt + (size_t)(dd0 + r32) * PG + ks * 16 + 8 * hh); acc = mm32(a, w, acc); }
                        const int oc = gg * PG + dd0 + r32; const float ps = psc[oc];
#pragma unroll
                        for (int e = 0; e < 16; ++e) MIX[(size_t)(t0 + rowidx(e, hh)) * D + RW + oc] = f2bf(acc[e] * ps);
                    }
                }
            }
        }
        SEAM(pb + 2);

        if (IN(pb + 3)) { PHASE_IDS
            const bf16* Vl = l == 0 ? V0 : V1;
            const int r32 = lane & 31, hh = lane >> 5;
            if (wave < 6) {
                lbf16* At = (lbf16*)(lds + wave * 23552); lbf16* Bt = At + 2304; lbf16* Kt = Bt + 2304; lbf16* Rt = Kt + 2304; lbf16* Vv = Rt + 2304;
                LAS float* PCs = (LAS float*)(lds + wave * 23552 + 23040);
                for (int item = bx * 6 + wave; item < BATCH * NH * (SEQ / 32); item += G * 6) {
                    const int bh = item >> 7, chunk = item & 127, b = bh >> 3, h = bh & 7; const size_t t0 = (size_t)b * SEQ + chunk * 32;
                    __builtin_amdgcn_wave_barrier(); asm volatile("s_waitcnt lgkmcnt(0)" ::: "memory");
                    {
                      const int tk = lane >> 3, part = lane & 7;
                      u32x4 qr[4], qk[4], qv[4], qkk[4], qb[4]; f32x4 qw0[4], qw1[4]; float qin[4];
#pragma unroll
                      for (int p4 = 0; p4 < 4; ++p4) { const size_t o = (t0 + p4 * 8 + tk) * RW + h * HS + part * 8;
                          qr[p4] = *(const u32x4*)(Rb + o); qk[p4] = *(const u32x4*)(Kb + o); qv[p4] = *(const u32x4*)(Vl + o); qkk[p4] = *(const u32x4*)(KKb + o); qb[p4] = *(const u32x4*)(Bb + o);
                          qw0[p4] = *(const f32x4*)(Wd + o); qw1[p4] = *(const f32x4*)(Wd + o + 4); qin[p4] = INVN[(t0 + p4 * 8 + tk) * NH + h]; }
                      LAS float* Pl = (LAS float*)At;
#pragma unroll
                      for (int p4 = 0; p4 < 4; ++p4) { *(LAS f32x4*)(Pl + (p4 * 8 + tk) * 64 + part * 8) = qw0[p4]; *(LAS f32x4*)(Pl + (p4 * 8 + tk) * 64 + part * 8 + 4) = qw1[p4]; }
                      __builtin_amdgcn_wave_barrier(); asm volatile("s_waitcnt lgkmcnt(0)" ::: "memory");
                      { float P = 1.f;
#pragma unroll 8
                        for (int c = 0; c < 32; ++c) { P *= Pl[c * 64 + lane]; Pl[c * 64 + lane] = P; }
                        PCs[lane] = P; }
                      __builtin_amdgcn_wave_barrier(); asm volatile("s_waitcnt lgkmcnt(0)" ::: "memory");
                      u32x4 oa[4], orr[4], ob_[4], ok_[4];
#pragma unroll
                      for (int p4 = 0; p4 < 4; ++p4) { const int c = p4 * 8 + tk;
                          const f32x4 pa = *(const LAS f32x4*)(Pl + c * 64 + part * 8), pb2 = *(const LAS f32x4*)(Pl + c * 64 + part * 8 + 4);
                          f32x4 ma = {1.f, 1.f, 1.f, 1.f}, mb = ma; if (c > 0) { ma = *(const LAS f32x4*)(Pl + (c - 1) * 64 + part * 8); mb = *(const LAS f32x4*)(Pl + (c - 1) * 64 + part * 8 + 4); }
                          const float Pc[8] = {pa.x, pa.y, pa.z, pa.w, pb2.x, pb2.y, pb2.z, pb2.w}, Pm[8] = {ma.x, ma.y, ma.z, ma.w, mb.x, mb.y, mb.z, mb.w};
                          const unsigned rw_[4] = {qr[p4].x, qr[p4].y, qr[p4].z, qr[p4].w}, kw_[4] = {qk[p4].x, qk[p4].y, qk[p4].z, qk[p4].w}, kkw[4] = {qkk[p4].x, qkk[p4].y, qkk[p4].z, qkk[p4].w}, bw_[4] = {qb[p4].x, qb[p4].y, qb[p4].z, qb[p4].w};
                          unsigned xa[4], xr[4], xb[4], xk[4]; const float inv = qin[p4];
#pragma unroll
                          for (int i = 0; i < 4; ++i) { const float ip0 = __builtin_amdgcn_rcpf(Pc[2 * i]), ip1 = __builtin_amdgcn_rcpf(Pc[2 * i + 1]);
                              xa[i] = pk2(-__uint_as_float(kkw[i] << 16) * inv * Pm[2 * i], -__uint_as_float(kkw[i] & 0xffff0000u) * inv * Pm[2 * i + 1]);
                              xr[i] = pk2(__uint_as_float(rw_[i] << 16) * Pc[2 * i], __uint_as_float(rw_[i] & 0xffff0000u) * Pc[2 * i + 1]);
                              xb[i] = pk2(__uint_as_float(bw_[i] << 16) * inv * ip0, __uint_as_float(bw_[i] & 0xffff0000u) * inv * ip1);
                              xk[i] = pk2(__uint_as_float(kw_[i] << 16) * ip0, __uint_as_float(kw_[i] & 0xffff0000u) * ip1); }
                          oa[p4] = (u32x4){xa[0], xa[1], xa[2], xa[3]}; orr[p4] = (u32x4){xr[0], xr[1], xr[2], xr[3]}; ob_[p4] = (u32x4){xb[0], xb[1], xb[2], xb[3]}; ok_[p4] = (u32x4){xk[0], xk[1], xk[2], xk[3]}; }
                      __builtin_amdgcn_wave_barrier(); asm volatile("s_waitcnt lgkmcnt(0)" ::: "memory");
#pragma unroll
                      for (int p4 = 0; p4 < 4; ++p4) { const int c = p4 * 8 + tk, o = c * 72 + part * 8;
                          *(__attribute__((address_space(3))) u32x4*)(At + o) = oa[p4]; *(__attribute__((address_space(3))) u32x4*)(Rt + o) = orr[p4]; *(__attribute__((address_space(3))) u32x4*)(Bt + o) = ob_[p4];
                          *(__attribute__((address_space(3))) u32x4*)(Kt + o) = ok_[p4]; *(__attribute__((address_space(3))) u32x4*)(Vv + o) = qv[p4]; } }
                    __builtin_amdgcn_wave_barrier(); asm volatile("s_waitcnt lgkmcnt(0)" ::: "memory");
                    const f32x16 zero16 = {0.f, 0.f, 0.f, 0.f, 0.f, 0.f, 0.f, 0.f, 0.f, 0.f, 0.f, 0.f, 0.f, 0.f, 0.f, 0.f};
                    f32x16 X = zero16, Yt = zero16;
#pragma unroll
                    for (int ks = 0; ks < 4; ++ks) { const bf16x8_t fa = ldrow(At, r32, ks, hh), fb = ldrow(Bt, r32, ks, hh); X = mm32(fa, fb, X); Yt = mm32(fb, fa, Yt); }
#pragma unroll
                    for (int e = 0; e < 16; ++e) { const int ri = rowidx(e, hh); X[e] = (r32 < ri) ? X[e] : 0.f; Yt[e] = (ri < r32) ? Yt[e] : 0.f; }
                    f32x16 TY = Yt;
#pragma unroll
                    for (int e = 0; e < 16; ++e) TY[e] += (rowidx(e, hh) == r32) ? 1.f : 0.f;
#pragma unroll 1
                    for (int it = 0; it < 4; ++it) {
                        const bf16x8_t x0 = accop<0>(X), x1 = accop<1>(X), y0 = accop<0>(Yt), y1 = accop<1>(Yt);
                        f32x16 Xn = mm32(y0, x0, zero16); Xn = mm32(y1, x1, Xn);
                        f32x16 Yn = mm32(x0, y0, zero16); Yn = mm32(x1, y1, Yn);
                        X = Xn; Yt = Yn;
                        const bf16x8_t p0 = accop<0>(X), p1 = accop<1>(X), t0_ = accop<0>(TY), t1_ = accop<1>(TY);
                        TY = mm32(p0, t0_, TY); TY = mm32(p1, t1_, TY);
                    }
                    const bf16x8_t ty0 = accop<0>(TY), ty1 = accop<1>(TY);
                    unsigned char* rec = SCN + (size_t)item * 24576;
                    const bf16x8_t v00 = ldpermcol<0>(Vv, r32, hh), v01 = ldpermcol<1>(Vv, r32, hh), v10 = ldpermcol<0>(Vv, 32 + r32, hh), v11 = ldpermcol<1>(Vv, 32 + r32, hh);
                    f32x16 U0a, U0b;
                    { f32x16 G2T = zero16;
#pragma unroll
                      for (int ks = 0; ks < 4; ++ks) G2T = mm32(ldrow(Kt, r32, ks, hh), ldrow(At, r32, ks, hh), G2T);
#pragma unroll
                      for (int e = 0; e < 16; ++e) G2T[e] = (rowidx(e, hh) < r32) ? G2T[e] : 0.f;
                      const bf16x8_t g0 = accop<0>(G2T), g1 = accop<1>(G2T);
                      f32x16 Za = mm32(g0, v00, zero16); Za = mm32(g1, v01, Za); f32x16 Zb = mm32(g0, v10, zero16); Zb = mm32(g1, v11, Zb);
                      U0a = mm32(ty0, accop<0>(Za), zero16); U0a = mm32(ty1, accop<1>(Za), U0a); U0b = mm32(ty0, accop<0>(Zb), zero16); U0b = mm32(ty1, accop<1>(Zb), U0b); }
                    const bf16x8_t ua0 = accop<0>(U0a), ua1 = accop<1>(U0a), ub0 = accop<0>(U0b), ub1 = accop<1>(U0b);
                    f32x16 G3T = zero16;
                    { f32x16 G4T = zero16;
#pragma unroll
                      for (int ks = 0; ks < 4; ++ks) { const bf16x8_t fr = ldrow(Rt, r32, ks, hh); G3T = mm32(ldrow(Bt, r32, ks, hh), fr, G3T); G4T = mm32(ldrow(Kt, r32, ks, hh), fr, G4T); }
#pragma unroll
                      for (int e = 0; e < 16; ++e) { const bool keep = rowidx(e, hh) <= r32; G3T[e] = keep ? G3T[e] : 0.f; G4T[e] = keep ? G4T[e] : 0.f; }
                      const bf16x8_t g30 = accop<0>(G3T), g31 = accop<1>(G3T), g40 = accop<0>(G4T), g41 = accop<1>(G4T);
                      f32x16 Ya = mm32(g30, ua0, zero16); Ya = mm32(g31, ua1, Ya); Ya = mm32(g40, v00, Ya); Ya = mm32(g41, v01, Ya);
                      f32x16 Yb = mm32(g30, ub0, zero16); Yb = mm32(g31, ub1, Yb); Yb = mm32(g40, v10, Yb); Yb = mm32(g41, v11, Yb);
                      u32x4 o0, o1;
                      o0.x = cvtpk(Ya[0], Ya[1]); o0.y = cvtpk(Ya[2], Ya[3]); o0.z = cvtpk(Ya[4], Ya[5]); o0.w = cvtpk(Ya[6], Ya[7]);
                      o1.x = cvtpk(Ya[8], Ya[9]); o1.y = cvtpk(Ya[10], Ya[11]); o1.z = cvtpk(Ya[12], Ya[13]); o1.w = cvtpk(Ya[14], Ya[15]);
                      *(u32x4*)(rec + 12288 + 4096 + lane * 32) = o0; *(u32x4*)(rec + 12288 + 4096 + lane * 32 + 16) = o1;
                      o0.x = cvtpk(Yb[0], Yb[1]); o0.y = cvtpk(Yb[2], Yb[3]); o0.z = cvtpk(Yb[4], Yb[5]); o0.w = cvtpk(Yb[6], Yb[7]);
                      o1.x = cvtpk(Yb[8], Yb[9]); o1.y = cvtpk(Yb[10], Yb[11]); o1.z = cvtpk(Yb[12], Yb[13]); o1.w = cvtpk(Yb[14], Yb[15]);
                      *(u32x4*)(rec + 12288 + 6144 + 4096 + lane * 32) = o0; *(u32x4*)(rec + 12288 + 6144 + 4096 + lane * 32 + 16) = o1; }
                    f32x16 Wa0 = mm32(ty0, ldpermcol<0>(At, r32, hh), zero16); Wa0 = mm32(ty1, ldpermcol<1>(At, r32, hh), Wa0);
                    f32x16 Wa1 = mm32(ty0, ldpermcol<0>(At, 32 + r32, hh), zero16); Wa1 = mm32(ty1, ldpermcol<1>(At, 32 + r32, hh), Wa1);
                    const bf16x8_t wa00 = accop<0>(Wa0), wa01 = accop<1>(Wa0), wa10 = accop<0>(Wa1), wa11 = accop<1>(Wa1);
                    { const bf16x8_t g30 = accop<0>(G3T), g31 = accop<1>(G3T);
                      f32x16 Ra = mm32(wa00, g30, zero16); Ra = mm32(wa01, g31, Ra); f32x16 Rb_ = mm32(wa10, g30, zero16); Rb_ = mm32(wa11, g31, Rb_);
#pragma unroll
                      for (int e = 0; e < 16; ++e) { const int kr = rowidx(e, hh); Ra[e] += bf2f(Rt[r32 * 72 + kr]); Rb_[e] += bf2f(Rt[r32 * 72 + 32 + kr]); }
                      *(bf16x8_t*)(rec + 8192 + 0 * 1024 + lane * 16) = accop<0>(Ra); *(bf16x8_t*)(rec + 8192 + 1 * 1024 + lane * 16) = accop<1>(Ra);
                      *(bf16x8_t*)(rec + 8192 + 2 * 1024 + lane * 16) = accop<0>(Rb_); *(bf16x8_t*)(rec + 8192 + 3 * 1024 + lane * 16) = accop<1>(Rb_); }
                    const bf16x8_t b00 = ldpermcol<0>(Bt, r32, hh), b01 = ldpermcol<1>(Bt, r32, hh), b10 = ldpermcol<0>(Bt, 32 + r32, hh), b11 = ldpermcol<1>(Bt, 32 + r32, hh);
                    { const float pc0 = PCs[r32], pc1 = PCs[32 + r32];
#pragma unroll
                      for (int ij = 0; ij < 4; ++ij) { const int i = ij >> 1, j = ij & 1;
                          f32x16 M = mm32(i ? wa10 : wa00, j ? b10 : b00, zero16); M = mm32(i ? wa11 : wa01, j ? b11 : b01, M);
#pragma unroll
                          for (int e = 0; e < 16; ++e) { float m = M[e]; if (i == j) m += (rowidx(e, hh) == r32) ? 1.f : 0.f; M[e] = m * (j ? pc1 : pc0); }
                          *(bf16x8_t*)(rec + (ij * 2 + 0) * 1024 + lane * 16) = accop<0>(M); *(bf16x8_t*)(rec + (ij * 2 + 1) * 1024 + lane * 16) = accop<1>(M); } }
                    { const bf16x8_t k00 = ldpermcol<0>(Kt, r32, hh), k01 = ldpermcol<1>(Kt, r32, hh), k10 = ldpermcol<0>(Kt, 32 + r32, hh), k11 = ldpermcol<1>(Kt, 32 + r32, hh);
#pragma unroll
                      for (int ju = 0; ju < 4; ++ju) { const int j = ju >> 1, u = ju & 1;
                          f32x16 Dm = mm32(j ? b10 : b00, u ? ub0 : ua0, zero16); Dm = mm32(j ? b11 : b01, u ? ub1 : ua1, Dm);
                          Dm = mm32(j ? k10 : k00, u ? v10 : v00, Dm); Dm = mm32(j ? k11 : k01, u ? v11 : v01, Dm);
#pragma unroll
                          for (int e = 0; e < 16; ++e) Dm[e] *= PCs[32 * j + rowidx(e, hh)];
                          u32x4 o0, o1;
                          o0.x = cvtpk(Dm[0], Dm[1]); o0.y = cvtpk(Dm[2], Dm[3]); o0.z = cvtpk(Dm[4], Dm[5]); o0.w = cvtpk(Dm[6], Dm[7]);
                          o1.x = cvtpk(Dm[8], Dm[9]); o1.y = cvtpk(Dm[10], Dm[11]); o1.z = cvtpk(Dm[12], Dm[13]); o1.w = cvtpk(Dm[14], Dm[15]);
                          *(u32x4*)(rec + 12288 + u * 6144 + j * 2048 + lane * 32) = o0; *(u32x4*)(rec + 12288 + u * 6144 + j * 2048 + lane * 32 + 16) = o1; } }
                }
            }
        }
        { XcdBarrier xb_ = xbar; asm volatile("" : "+s"(xb_.bar)); xcd_barrier<false>(xb_); }
        if (IN(pb + 3)) { PHASE_IDS
            const int r32 = lane & 31, hh = lane >> 5;
            constexpr int SLOT = 18432, NCH = SEQ / 32, NSL = 7, AHEAD = 6;
            if (G > BATCH * NH * 2) { if (bx >= BATCH * NH * 2) convert_tables_fp8(INP(27), INP(28), U8, V8, USc, VSc, l, (bx - BATCH * NH * 2) * NWAVES + wave, (G - BATCH * NH * 2) * NWAVES, lane); }
            else convert_tables_fp8(INP(27), INP(28), U8, V8, USc, VSc, l, bx * NWAVES + wave, G * NWAVES, lane);
            for (int un = bx; un < BATCH * NH * 2; un += G) {
                const int bh = un >> 1, u = un & 1, b = bh >> 3, h = bh & 7;
                __syncthreads();
                const unsigned char* recs = SCN + (size_t)bh * NCH * 24576;
                const int lw = wave - 2;
#define S2_DMA(chunk_) do { if (wave >= 2) { LAS unsigned char* sl = lds + ((chunk_) % NSL) * SLOT; const unsigned char* rp = recs + (size_t)(chunk_) * 24576 + lane * 16; \
                    _Pragma("unroll") for (int q_ = 0; q_ < 3; ++q_) { const int p_ = lw * 3 + q_; const int so_ = p_ < 12 ? p_ * 1024 : 12288 + u * 6144 + (p_ - 12) * 1024; \
                        __builtin_amdgcn_global_load_lds((const unsigned*)(rp + so_), (LAS unsigned*)(sl + p_ * 1024), 16, 0, 0); } } } while (0)
#pragma unroll 1
                for (int c0 = 0; c0 < AHEAD; ++c0) S2_DMA(c0);
                asm volatile("s_waitcnt vmcnt(15)" ::: "memory");
                __builtin_amdgcn_s_barrier();
                f32x16 X0, X1;
#pragma unroll
                for (int e = 0; e < 16; ++e) { X0[e] = 0.f; X1[e] = 0.f; }
#define S2_FRAG(off) (*(const __attribute__((address_space(3))) bf16x8_t*)(sl + (off) + lane * 16))
#define S2_UNPK(dst, off) do { const u32x4 a0 = *(const LAS u32x4*)(sl + (off) + lane * 32), a1 = *(const LAS u32x4*)(sl + (off) + lane * 32 + 16); const unsigned wv[8] = {a0.x, a0.y, a0.z, a0.w, a1.x, a1.y, a1.z, a1.w}; \
                    _Pragma("unroll") for (int q = 0; q < 8; ++q) { (dst)[2 * q] = __uint_as_float(wv[q] << 16); (dst)[2 * q + 1] = __uint_as_float(wv[q] & 0xffff0000u); } } while (0)
#pragma unroll 1
                for (int n = 0; n < NCH; ++n) {
                    if (n + AHEAD < NCH) S2_DMA(n + AHEAD);
                    if (wave == 0) {
                        const LAS unsigned char* sl = lds + (n % NSL) * SLOT;
                        const bf16x8_t x00 = accop<0>(X0), x01 = accop<1>(X0), x10 = accop<0>(X1), x11 = accop<1>(X1);
                        f32x16 Yc, N0, N1;
                        S2_UNPK(Yc, 12288 + 4096); S2_UNPK(N0, 12288); S2_UNPK(N1, 12288 + 2048);
                        Yc = mm32(S2_FRAG(8192 + 0 * 1024), x00, Yc); Yc = mm32(S2_FRAG(8192 + 1 * 1024), x01, Yc); Yc = mm32(S2_FRAG(8192 + 2 * 1024), x10, Yc); Yc = mm32(S2_FRAG(8192 + 3 * 1024), x11, Yc);
                        N0 = mm32(S2_FRAG((0 * 2 + 0) * 1024), x00, N0); N0 = mm32(S2_FRAG((0 * 2 + 1) * 1024), x01, N0); N0 = mm32(S2_FRAG((2 * 2 + 0) * 1024), x10, N0); N0 = mm32(S2_FRAG((2 * 2 + 1) * 1024), x11, N0);
                        N1 = mm32(S2_FRAG((1 * 2 + 0) * 1024), x00, N1); N1 = mm32(S2_FRAG((1 * 2 + 1) * 1024), x01, N1); N1 = mm32(S2_FRAG((3 * 2 + 0) * 1024), x10, N1); N1 = mm32(S2_FRAG((3 * 2 + 1) * 1024), x11, N1);
                        X0 = N0; X1 = N1;
                        float* yp = Y + ((size_t)b * SEQ + (size_t)n * 32) * RW + h * HS + u * 32 + r32;
#pragma unroll
                        for (int e = 0; e < 16; ++e) yp[(size_t)rowidx(e, hh) * RW] = Yc[e];
                        asm volatile("s_waitcnt lgkmcnt(0)" ::: "memory");
                    } else if (wave >= 2) {
                        const int younger = (NCH - 1 - (n + 1)) < (AHEAD - 1) ? (NCH - 1 - (n + 1)) : (AHEAD - 1);
                        if (younger >= 5) asm volatile("s_waitcnt vmcnt(15)" ::: "memory"); else if (younger == 4) asm volatile("s_waitcnt vmcnt(12)" ::: "memory"); else if (younger == 3) asm volatile("s_waitcnt vmcnt(9)" ::: "memory");
                        else if (younger == 2) asm volatile("s_waitcnt vmcnt(6)" ::: "memory"); else if (younger == 1) asm volatile("s_waitcnt vmcnt(3)" ::: "memory"); else asm volatile("s_waitcnt vmcnt(0)" ::: "memory");
                    }
                    __builtin_amdgcn_s_barrier();
                }
#undef S2_FRAG
#undef S2_UNPK
#undef S2_DMA
            }
        }
        SEAM(pb + 3);

        if (IN(pb + 4)) { PHASE_IDS
            const int c = tid; const float lg = INP(19)[l * RW + c], lb = INP(20)[l * RW + c];
            for (int tile = bx; tile < T / 8; tile += G) {
                float y[8], g[8], bg[8];
#pragma unroll
                for (int i = 0; i < 8; ++i) { const size_t o = (size_t)(tile * 8 + i) * RW + c; y[i] = Y[o]; g[i] = bf2f(Gb[o]); bg[i] = bf2f(BGb[o]) * BSUM[(size_t)(tile * 8 + i) * NH + wave]; }
#pragma unroll
                for (int i = 0; i < 8; ++i) { const float mean = wave_sum(y[i], lane) * (1.f / 64.f); const float d = y[i] - mean; const float var = wave_sum(d * d, lane) * (1.f / 64.f);
                    const float yn = d * rsqrtf(var + GN_EPS) * lg + lb; MIX[(size_t)(tile * 8 + i) * D + c] = f2bf(yn * g[i] + bg[i]); }
            }
        }
        SEAM(pb + 4);
        if (IN(pb + 5)) { PHASE_IDS
            pg8::Gemm g{MIX, WoutT + (size_t)l * D * D, T, D, D}; pg8::StaticOrder S; S.init(T, D, G, bx);
            pg8::EpiResGate E{xin, X, modl + 2 * D};
            pg8::gemm_phase<pg8::EpiResGate, pg8::StaticOrder, true, true>(lds, g, S, E, tid); }
        SEAM(pb + 5);
        if (IN(pb + 6)) { PHASE_IDS const float* gamma = INP(24) + l * D;
            for (int row = gw; row < T; row += NGW) { const int b = row / SEQ; norm_mod_row(X + (size_t)row * D, gamma, modl + (size_t)b * 6 * D + 3 * D, modl + (size_t)b * 6 * D + 4 * D, H + (size_t)row * D, lane); } }
        SEAM(pb + 6);
        if (IN(pb + 7)) { PHASE_IDS
            pg8::Gemm g{H, PqT + (size_t)l * PH * PQ * D, T, PH * PQ, D}; pg8::StaticOrder S; S.init(T, PH * PQ, G, bx);
            pg8::EpiBf16<0> E{Q, PH * PQ, nullptr, 0, 0, 1.f};
            pg8::gemm_phase<pg8::EpiBf16<0>, pg8::StaticOrder, true, true>(lds, g, S, E, tid); }
        SEAM(pb + 7);

        if (IN(pb + 8)) { PHASE_IDS
            const bf16* KEYSl = KEYS + (size_t)l * PH * 2 * NKEYS * PHALF;
            LAS unsigned char* scr = lds + wave * 2048 + lane * 32;
            LAS unsigned* spl = (LAS unsigned*)(lds + 16384 + wave * 8192);
            const int r = lane & 31, hh = lane >> 5;
            for (int it = gw; it < (T / 32) * PH; it += NGW) {
                const int tok = (it >> 3) * 32 + r, h = it & 7;
                unsigned sp0[16], sp1[16];
#pragma unroll 1
                for (int p = 0; p < 2; ++p) {
                    const bf16* qp = Q + (size_t)tok * (PH * PQ) + h * PQ + p * PHALF + 8 * hh;
                    const bf16* kp_ = KEYSl + ((size_t)(h * 2 + p) * NKEYS + r) * PHALF + 8 * hh;
                    bf16x8_t bq[8];
#pragma unroll
                    for (int ks = 0; ks < 8; ++ks) bq[ks] = *(const bf16x8_t*)(qp + ks * 16);
                    unsigned best[16];
#pragma unroll
                    for (int e = 0; e < 16; ++e) best[e] = 0u;
                    bf16x8_t akn[4];
#pragma unroll
                    for (int ks = 0; ks < 4; ++ks) akn[ks] = *(const bf16x8_t*)(kp_ + ks * 16);
#pragma unroll 1
                    for (int kt = 0; kt < 4; ++kt) {
                        f32x16 acc;
#pragma unroll
                        for (int e = 0; e < 16; ++e) acc[e] = 0.f;
                        bf16x8_t akh[4];
#pragma unroll
                        for (int ks = 0; ks < 4; ++ks) akh[ks] = *(const bf16x8_t*)(kp_ + (size_t)kt * 32 * PHALF + (4 + ks) * 16);
#pragma unroll
                        for (int ks = 0; ks < 4; ++ks) acc = __builtin_amdgcn_mfma_f32_32x32x16_bf16(akn[ks], bq[ks], acc, 0, 0, 0);
#pragma unroll
                        for (int ks = 0; ks < 4; ++ks) acc = __builtin_amdgcn_mfma_f32_32x32x16_bf16(akh[ks], bq[4 + ks], acc, 0, 0, 0);
                        if (kt < 3) {
#pragma unroll
                            for (int ks = 0; ks < 4; ++ks) akn[ks] = *(const bf16x8_t*)(kp_ + (size_t)(kt + 1) * 32 * PHALF + ks * 16); }
                        unsigned g[16];
#pragma unroll
                        for (int e = 0; e < 16; ++e) g[e] = pack_key7(acc[e], kt * 32 + (e & 3) + 8 * (e >> 2) + 4 * hh);
                        sort16_desc(g);
                        merge_top16(best, g);
                    }
                    unsigned ob[16];
#pragma unroll
                    for (int e = 0; e < 16; ++e) ob[e] = shflxu(best[e], lane, 32);
                    merge_top16(best, ob);
#pragma unroll
                    for (int e = 0; e < 16; ++e) spl[(p * 16 + e) * 64 + lane] = best[e];
                }
                asm volatile("s_waitcnt lgkmcnt(0)" ::: "memory");
#pragma unroll
                for (int e = 0; e < 16; ++e) { sp0[e] = spl[e * 64 + lane]; sp1[e] = spl[(16 + e) * 64 + lane]; }
                unsigned c2[32];
                stage2_cands(sp0, sp1, hh, c2);
                sort16_desc(c2); sort16_desc(c2 + 16); merge_top16(c2, c2 + 16);
                { unsigned ob[16];
#pragma unroll
                  for (int e = 0; e < 16; ++e) ob[e] = shflxu(c2[e], lane, 32);
                  merge_top16(c2, ob); }
#pragma unroll
                for (int e = 0; e < 16; e += 4) {
                    *(LAS unsigned*)(scr + e) = (127u - (sp0[e] & 127u)) | ((127u - (sp0[e + 1] & 127u)) << 8) | ((127u - (sp0[e + 2] & 127u)) << 16) | ((127u - (sp0[e + 3] & 127u)) << 24);
                    *(LAS unsigned*)(scr + 16 + e) = (127u - (sp1[e] & 127u)) | ((127u - (sp1[e + 1] & 127u)) << 8) | ((127u - (sp1[e + 2] & 127u)) << 16) | ((127u - (sp1[e + 3] & 127u)) << 24); }
                asm volatile("s_waitcnt lgkmcnt(0)" ::: "memory");
                float sm[16]; int ex[16];
#pragma unroll
                for (int e = 0; e < 16; ++e) { const unsigned key = c2[e]; sm[e] = unpack_key8(key); const int i0 = (key >> 4) & 15, j0 = key & 15; ex[e] = (int)scr[i0] * NKEYS + (int)scr[16 + j0]; }
                float den = 0.f;
#pragma unroll
                for (int e = 0; e < 16; ++e) { sm[e] = expf(sm[e] - unpack_key8(c2[0])); den += sm[e]; }
                const float inv = 1.f / den;
                if (hh == 0) {
                    int* ip = IDX + (size_t)tok * NE + h * TOPK; float* gp = GATE + (size_t)tok * NE + h * TOPK;
#pragma unroll
                    for (int e = 0; e < 16; e += 4) { *(int4*)(ip + e) = make_int4(ex[e], ex[e + 1], ex[e + 2], ex[e + 3]); *(f32x4*)(gp + e) = (f32x4){sm[e] * inv, sm[e + 1] * inv, sm[e + 2] * inv, sm[e + 3] * inv}; }
                }
                asm volatile("s_waitcnt lgkmcnt(0)" ::: "memory");
            }
        }
        SEAM(pb + 8);

        if (IN(pb + 9)) { PHASE_IDS
            const unsigned char* Ul = U8 + (size_t)l * NEXP * D; const unsigned char* Vtl = V8 + (size_t)l * NEXP * D; const float* usl = USc + l * NEXP; const float* vsl = VSc + l * NEXP; const float* lnf = INP(29);
            const bool fin = (l == DEPTH - 1);
            typedef float f32x2_t __attribute__((ext_vector_type(2)));
            const __amdgpu_buffer_rsrc_t ru = __builtin_amdgcn_make_buffer_rsrc((void*)Ul, 0, NEXP * D, 0x00020000), rv = __builtin_amdgcn_make_buffer_rsrc((void*)Vtl, 0, NEXP * D, 0x00020000);
            const int voff = lane * 16;
            LAS float* pl = (LAS float*)(lds + wave * 8704);
            for (int t = gw; t < T; t += NGW) {
                const int b = t / SEQ;
                f32x2_t hf2[8];
                { const u32x4 h0 = *(const u32x4*)(H + (size_t)t * D + lane * 16), h1 = *(const u32x4*)(H + (size_t)t * D + lane * 16 + 8);
                  hf2[0] = (f32x2_t){__uint_as_float(h0.x << 16), __uint_as_float(h0.x & 0xffff0000u)}; hf2[1] = (f32x2_t){__uint_as_float(h0.y << 16), __uint_as_float(h0.y & 0xffff0000u)};
                  hf2[2] = (f32x2_t){__uint_as_float(h0.z << 16), __uint_as_float(h0.z & 0xffff0000u)}; hf2[3] = (f32x2_t){__uint_as_float(h0.w << 16), __uint_as_float(h0.w & 0xffff0000u)};
                  hf2[4] = (f32x2_t){__uint_as_float(h1.x << 16), __uint_as_float(h1.x & 0xffff0000u)}; hf2[5] = (f32x2_t){__uint_as_float(h1.y << 16), __uint_as_float(h1.y & 0xffff0000u)};
                  hf2[6] = (f32x2_t){__uint_as_float(h1.z << 16), __uint_as_float(h1.z & 0xffff0000u)}; hf2[7] = (f32x2_t){__uint_as_float(h1.w << 16), __uint_as_float(h1.w & 0xffff0000u)}; }
                f32x2_t acc2[8];
#pragma unroll
                for (int i = 0; i < 8; ++i) acc2[i] = (f32x2_t){0.f, 0.f};
                int myidx = IDX[(size_t)t * NE + (lane & 31)]; float mygate = GATE[(size_t)t * NE + (lane & 31)];
                float myus = usl[myidx], myvs = vsl[myidx];
#define ROWLD(dst, rs, ix, e) dst = __builtin_amdgcn_raw_buffer_load_b128(rs, voff, __builtin_amdgcn_readlane(ix, (e)) * D, 0)
#define LOADB(buf, rs, ix, e0) do { _Pragma("unroll") for (int j_ = 0; j_ < 4; ++j_) ROWLD((buf)[j_], rs, ix, (e0) + j_); __builtin_amdgcn_sched_barrier(0); } while (0)
#define CVT8(u) const f32x2_t u0 = __builtin_amdgcn_cvt_pk_f32_fp8((int)(u).x, false), u1 = __builtin_amdgcn_cvt_pk_f32_fp8((int)(u).x, true), u2 = __builtin_amdgcn_cvt_pk_f32_fp8((int)(u).y, false), u3 = __builtin_amdgcn_cvt_pk_f32_fp8((int)(u).y, true), \
                        u4 = __builtin_amdgcn_cvt_pk_f32_fp8((int)(u).z, false), u5 = __builtin_amdgcn_cvt_pk_f32_fp8((int)(u).z, true), u6 = __builtin_amdgcn_cvt_pk_f32_fp8((int)(u).w, false), u7 = __builtin_amdgcn_cvt_pk_f32_fp8((int)(u).w, true)
#define DOT1(u, dst) do { CVT8(u); f32x2_t a_ = hf2[0] * u0; a_ += hf2[1] * u1; a_ += hf2[2] * u2; a_ += hf2[3] * u3; a_ += hf2[4] * u4; a_ += hf2[5] * u5; a_ += hf2[6] * u6; a_ += hf2[7] * u7; dst = a_.x + a_.y; } while (0)
#define DOTB(buf, e0) do { _Pragma("unroll") for (int j_ = 0; j_ < 4; ++j_) { float d_; DOT1((buf)[j_], d_); pl[((e0) + j_) * 68 + lane] = d_; } } while (0)
#define AXPYB(buf, e0) do { _Pragma("unroll") for (int j_ = 0; j_ < 4; ++j_) { CVT8((buf)[j_]); const float cf = __int_as_float(__builtin_amdgcn_readlane(__float_as_int(coef), (e0) + j_)); \
                        acc2[0] += cf * u0; acc2[1] += cf * u1; acc2[2] += cf * u2; acc2[3] += cf * u3; acc2[4] += cf * u4; acc2[5] += cf * u5; acc2[6] += cf * u6; acc2[7] += cf * u7; } } while (0)
                u32x4 ba[4], bb_[4];
                LOADB(ba, ru, myidx, 0);
#pragma unroll 1
                for (int q = 0; q < 4; ++q) {
                    int nidx = 0; float ngate = 0.f;
                    if (q < 3) { nidx = IDX[(size_t)t * NE + (q + 1) * 32 + (lane & 31)]; ngate = GATE[(size_t)t * NE + (q + 1) * 32 + (lane & 31)]; }
#pragma unroll
                    for (int e0 = 0; e0 < 32; e0 += 8) {
                        LOADB(bb_, ru, myidx, e0 + 4); DOTB(ba, e0);
                        if (e0 + 8 < 32) LOADB(ba, ru, myidx, e0 + 8); else LOADB(ba, rv, myidx, 0);
                        DOTB(bb_, e0 + 4);
                    }
                    const float nus = usl[nidx], nvs = vsl[nidx];
                    __builtin_amdgcn_wave_barrier(); asm volatile("s_waitcnt lgkmcnt(0)" ::: "memory");
                    float dsum;
                    { const LAS float* rp = pl + (lane & 31) * 68 + (lane >> 5) * 32; f32x4 s4 = *(const LAS f32x4*)rp;
#pragma unroll
                      for (int j = 1; j < 8; ++j) s4 += *(const LAS f32x4*)(rp + j * 4);
                      dsum = (s4.x + s4.y) + (s4.z + s4.w); }
                    dsum += shflx(dsum, lane, 32);
                    __builtin_amdgcn_wave_barrier(); asm volatile("s_waitcnt lgkmcnt(0)" ::: "memory");
                    const float coef = mygate * gelu_erf(dsum * myus) * myvs;
#pragma unroll
                    for (int e0 = 0; e0 < 32; e0 += 8) {
                        LOADB(bb_, rv, myidx, e0 + 4); AXPYB(ba, e0);
                        if (e0 + 8 < 32) LOADB(ba, rv, myidx, e0 + 8); else if (q < 3) LOADB(ba, ru, nidx, 0);
                        AXPYB(bb_, e0 + 4);
                    }
                    myidx = nidx; mygate = ngate; myus = nus; myvs = nvs;
                }
#undef ROWLD
#undef LOADB
#undef CVT8
#undef DOTB
#undef DOT1
#undef AXPYB
                float* xr = X + (size_t)t * D + lane * 16; const float* g2 = modl + (size_t)b * 6 * D + 5 * D + lane * 16;
                f32x4 xv[4]; float ss = 0.f;
#pragma unroll
                for (int q = 0; q < 4; ++q) { const f32x4 xo = *(const f32x4*)(xr + q * 4), gg = *(const f32x4*)(g2 + q * 4);
                    xv[q] = xo + gg * (f32x4){acc2[q * 2].x, acc2[q * 2].y, acc2[q * 2 + 1].x, acc2[q * 2 + 1].y}; ss += (xv[q].x * xv[q].x + xv[q].y * xv[q].y) + (xv[q].z * xv[q].z + xv[q].w * xv[q].w); }
                const float rs = rsqrtf(wave_sum(ss, lane) * (1.f / D) + NORM_EPS);
                if (fin) {
#pragma unroll
                    for (int q = 0; q < 4; ++q) xv[q] = xv[q] * rs * *(const f32x4*)(lnf + lane * 16 + q * 4); }
                else {
                    const float* gam = INP(4) + (l + 1) * D + lane * 16; const float* mn = MOD + (size_t)(l + 1) * BATCH * 6 * D + (size_t)b * 6 * D + lane * 16; u32x4 ho[2];
#pragma unroll
                    for (int q = 0; q < 4; ++q) { const f32x4 y = xv[q] * rs * *(const f32x4*)(gam + q * 4) * (*(const f32x4*)(mn + D + q * 4) + 1.f) + *(const f32x4*)(mn + q * 4);
                        if (q & 1) { ho[q >> 1].z = pk2(y.x, y.y); ho[q >> 1].w = pk2(y.z, y.w); } else { ho[q >> 1].x = pk2(y.x, y.y); ho[q >> 1].y = pk2(y.z, y.w); } }
                    *(u32x4*)(H + (size_t)t * D + lane * 16) = ho[0]; *(u32x4*)(H + (size_t)t * D + lane * 16 + 8) = ho[1]; }
#pragma unroll
                for (int q = 0; q < 4; ++q) *(f32x4*)(xr + q * 4) = xv[q];
            }
        }
    }
#undef modl
#undef xin
#undef IN
#undef SEAM
}
#undef MOD
#undef H
#undef PROJ
#undef Q
#undef MIX
#undef Rb
#undef Kb
#undef V0
#undef V1
#undef KKb
#undef Bb
#undef Gb
#undef BGb
#undef Wd
#undef Y
#undef IDX
#undef GATE
#undef WinT
#undef WoutT
#undef PqT
#undef KEYS
#undef QB
#undef SH
#undef WUPT
#undef AUPT
#undef GUPT
#undef VUPT
#undef PWT
#undef INVN
#undef BSUM
#undef SCN
#undef U8
#undef V8
#undef USc
#undef VSc
#undef INP
#undef PHASE_IDS

extern "C" void kernel_launch(void* const* d_in, const int* in_sizes, int n_in, void* d_out, int out_size, void* d_ws, size_t ws_size, hipStream_t stream) {
    if (n_in != 30 || ws_size < WS_END) { fprintf(stderr, "kernel_launch: unexpected n_in %d / ws_size %zu\n", n_in, ws_size); return; }
    static int grid = 0;
    if (grid == 0) {
        int dev = 0, cus = 0, per_cu = 0;
        (void)hipGetDevice(&dev); (void)hipDeviceGetAttribute(&cus, hipDeviceAttributeMultiprocessorCount, dev);
        if (hipFuncSetAttribute((const void*)mega, hipFuncAttributeMaxDynamicSharedMemorySize, LDS_BYTES) != hipSuccess) { fprintf(stderr, "hipFuncSetAttribute failed\n"); grid = -1; return; }
        if (hipOccupancyMaxActiveBlocksPerMultiprocessor(&per_cu, (const void*)mega, NTHR, LDS_BYTES) != hipSuccess || per_cu < 1) { fprintf(stderr, "occupancy query failed (%d)\n", per_cu); per_cu = 1; }
        (void)hipGetLastError();
        grid = (cus > 0 ? cus : 256) * 1;
    }
    if (grid < 0) return;
    Args a{}; for (int i = 0; i < 30; ++i) a.in[i] = (const float*)d_in[i]; a.out = (float*)d_out; a.ws = (unsigned char*)d_ws;
    a.ph_lo = 0; a.ph_hi = NPH;
    if (hipMemsetAsync(d_ws, 0, 65536, stream) != hipSuccess) { fprintf(stderr, "memset failed\n"); return; }
    void* kargs[] = {&a};
    hipError_t e = hipLaunchCooperativeKernel((const void*)mega, dim3(grid), dim3(NTHR), kargs, LDS_BYTES, stream);
    if (e != hipSuccess) fprintf(stderr, "cooperative launch failed: %s (grid %d)\n", hipGetErrorString(e), grid);
}
```

```cpp
#include <hip/hip_runtime.h>
#include <hip/hip_cooperative_groups.h>
namespace cg = cooperative_groups;
#include <cstdio>
#include <cstdint>
#include <cmath>

constexpr int D = 1024, BATCH = 4, SEQ = 4096, T = BATCH * SEQ, DEPTH = 2;
constexpr int RW = 512, HS = 64, NH = 8;
constexpr int DL = 64, AL = 64, MVL = 32, GL = 128;
constexpr int RWKV_COLS = 3 * RW + DL + AL + GL;
constexpr int PW = 512, PG = 128;
constexpr int IN_COLS = RWKV_COLS + PW;
constexpr int LDP = 2560;
constexpr int NKEYS = 128, NEXP = NKEYS * NKEYS, PH = 8, PQ = 256, PHALF = 128, TOPK = 16;
constexpr int NE = PH * TOPK;
constexpr float NORM_EPS = 1e-6f, GN_EPS = 64e-5f;

typedef unsigned short bf16;
__device__ __forceinline__ float bf2f(bf16 u) { return __uint_as_float((unsigned)u << 16); }
typedef float cvt_f32x2 __attribute__((ext_vector_type(2))); typedef __bf16 cvt_bf16x2 __attribute__((ext_vector_type(2)));
__device__ __forceinline__ unsigned cvtpk(float lo, float hi) { const cvt_f32x2 v = {lo, hi}; const cvt_bf16x2 b = __builtin_convertvector(v, cvt_bf16x2); return __builtin_bit_cast(unsigned, b); }
__device__ __forceinline__ bf16 f2bf(float f) { return (bf16)cvtpk(f, 0.f); }

constexpr size_t MiB = 1u << 20;
constexpr size_t WS_MOD = 1 * MiB;
constexpr size_t WS_US = 1 * MiB + 256 * 1024;
constexpr size_t WS_VS = 1 * MiB + 512 * 1024;
constexpr size_t WS_H = 2 * MiB;
constexpr size_t WS_PROJ = 34 * MiB;
constexpr size_t WS_Q = WS_PROJ;
constexpr size_t WS_R = 114 * MiB;
constexpr size_t WS_K = 130 * MiB;
constexpr size_t WS_V0 = 146 * MiB;
constexpr size_t WS_V1 = 162 * MiB;
constexpr size_t WS_KK = 178 * MiB;
constexpr size_t WS_B = 194 * MiB;
constexpr size_t WS_G = 210 * MiB;
constexpr size_t WS_BG = 226 * MiB;
constexpr size_t WS_W = 242 * MiB;
constexpr size_t WS_Y = 274 * MiB;
constexpr size_t WS_MIX = 306 * MiB;
constexpr size_t WS_IDX = 338 * MiB;
constexpr size_t WS_GATE = 346 * MiB;
constexpr size_t WS_WIN_T = 354 * MiB;
constexpr size_t WS_WOUT_T = 364 * MiB;
constexpr size_t WS_PQ_T = 368 * MiB;
constexpr size_t WS_KEYS = 376 * MiB;
constexpr size_t WS_U = 378 * MiB;
constexpr size_t WS_V = 442 * MiB;
constexpr size_t WS_QB = 410 * MiB;
constexpr size_t WS_SH = 426 * MiB;
constexpr size_t WS_LORA = 428 * MiB;
constexpr size_t WS_INVN = 430 * MiB;
constexpr size_t WS_BSUM = 431 * MiB;
constexpr size_t WS_SCN = 2 * MiB;
constexpr size_t WS_END = 506 * MiB;

template <int CTRL> __device__ __forceinline__ float dppf(float x) { return __int_as_float(__builtin_amdgcn_update_dpp(0, __float_as_int(x), CTRL, 0xF, 0xF, false)); }
__device__ __forceinline__ float red16(float x) { x += dppf<0xB1>(x); x += dppf<0x4E>(x); x += dppf<0x141>(x); x += dppf<0x140>(x); return x; }
__device__ __forceinline__ float shflx(float v, int lane, int off) { return __int_as_float(__builtin_amdgcn_ds_bpermute((lane ^ off) << 2, __float_as_int(v))); }
__device__ __forceinline__ unsigned shflxu(unsigned v, int lane, int off) { return (unsigned)__builtin_amdgcn_ds_bpermute((lane ^ off) << 2, (int)v); }
__device__ __forceinline__ float wave_sum(float v, int lane) { v = red16(v); v += shflx(v, lane, 16); v += shflx(v, lane, 32); return v; }
__device__ __forceinline__ float sigmoidf_(float x) { return 1.f / (1.f + expf(-x)); }

namespace pg8 {
#define PG8_LAS __attribute__((address_space(3)))
typedef unsigned short bf16_t;
typedef short bf16x8 __attribute__((ext_vector_type(8)));
typedef float f32x4 __attribute__((ext_vector_type(4)));
typedef unsigned u32x4 __attribute__((ext_vector_type(4)));
constexpr int BM = 256, BK = 64, HALF = 128, HTB = HALF * BK * 2  , STAGE_BYTES = 8 * HTB, NXCD = 8, WGM = 8;

__host__ __device__ __forceinline__ int lds_byte(int r, int c) { const int st = (r >> 4) * 2 + (c >> 5), rr = r & 15, cc = c & 31, ob = rr * 64 + cc * 2; return st * 1024 + (ob ^ (((ob >> 9) & 1) << 5)); }
__host__ __device__ __forceinline__ void stage_rc(int b, int& R, int& C) { const int st = b / 1024, sb = b % 1024, swz = sb ^ (((sb >> 9) & 1) << 5); R = (st >> 1) * 16 + swz / 64; C = (st & 1) * 32 + (swz % 64) / 2; }
__host__ __device__ __forceinline__ int perm32(int rho) { const int n = rho >> 4, i = rho & 15; return 8 * (i >> 2) + 4 * n + (i & 3); }

struct Unit { int pm, pn; };
struct Gemm { const bf16_t* A; const bf16_t* Bt; int M, N, K; };

struct StaticOrder {
    int nM, nN, nwg, G, c;
    __host__ __device__ void init(int M, int N, int G_, int c_) { nM = M / BM; nN = N / BM; nwg = nM * nN; G = G_; c = c_; }
    __host__ __device__ bool next(int i, Unit& u) const {
        const long L = (long)i * G + c; if (L >= nwg) return false;
        int wgid = (int)L; { const int q = nwg / NXCD, r = nwg % NXCD, xcd = wgid % NXCD, off = wgid / NXCD; wgid = (xcd < r ? xcd * (q + 1) : r * (q + 1) + (xcd - r) * q) + off; }
        const int nig = WGM * nN, gid = wgid / nig, fm = gid * WGM, gsz = (nM - fm) < WGM ? (nM - fm) : WGM;
        u.pm = fm + ((wgid % nig) % gsz); u.pn = (wgid % nig) / gsz; return true;
    }
    __device__ __forceinline__ void a_ready(const Unit&) const {}
    __device__ __forceinline__ void done(const Unit&) const {}
};

__device__ __forceinline__ unsigned cvt_pk_bf16(float lo, float hi) { unsigned r; asm volatile("v_cvt_pk_bf16_f32 %0, %1, %2" : "=v"(r) : "v"(lo), "v"(hi)); return r; }
typedef float f32x2 __attribute__((ext_vector_type(2)));
__device__ __forceinline__ f32x2 gelu_pk(f32x2 v) {
    const f32x2 av = __builtin_elementwise_abs(v), d = av * 0.2316418882f + 1.0f;
    f32x2 t; t.x = __builtin_amdgcn_rcpf(d.x); t.y = __builtin_amdgcn_rcpf(d.y);
    f32x2 q = t * 0.5307027145f + (-0.7265760135f); q = q * t + 0.7107068705f; q = q * t + (-0.142248368f); q = q * t + 0.127414796f; q = q * t;
    const f32x2 s = (v * v) * (-0.72134752044f);
    f32x2 e; e.x = __builtin_amdgcn_exp2f(s.x); e.y = __builtin_amdgcn_exp2f(s.y);
    const f32x2 m = v * (q * e), r = v - m;
    f32x2 o; o.x = v.x < 0.f ? m.x : r.x; o.y = v.y < 0.f ? m.y : r.y; return o;
}

template <int ACT  > struct EpiBf16 {
    static constexpr bool PERM = true, AFTER_DRAIN = false; static_assert(ACT == 0 || ACT == 1, "EpiBf16: ACT is 0 (none) or 1 (gelu_pk)");
    bf16_t* O; int ldc; const float* bias; int split_cols; size_t split_stride; float scale0;
    __device__ __forceinline__ void operator()(const f32x4 (&acc)[2][2][4][2], const Unit& u, int wr, int wc, int fr, int fq) const {
        const int row0 = u.pm * BM + wr * 64 + fr; int colt = u.pn * BM; bf16_t* base = O;
        float sc = 1.f; if (split_cols) { const int t = colt / split_cols; base += (size_t)t * split_stride; colt -= t * split_cols; if (t == 0) sc = scale0; }
        const int col0 = colt + wc * 32 + 8 * fq, bcol0 = u.pn * BM + wc * 32 + 8 * fq;
        f32x4 bv[2][2];
#pragma unroll
        for (int bj = 0; bj < 2; ++bj)
#pragma unroll
            for (int n = 0; n < 2; ++n) bv[bj][n] = bias ? *(const f32x4*)(bias + bcol0 + bj * HALF + 4 * n) : (f32x4){0.f, 0.f, 0.f, 0.f};
#pragma unroll
        for (int ai = 0; ai < 2; ++ai)
#pragma unroll
            for (int m = 0; m < 4; ++m) { bf16_t* rowp = base + (size_t)(row0 + ai * HALF + m * 16) * ldc + col0;
#pragma unroll
                for (int bj = 0; bj < 2; ++bj) { f32x4 v0 = acc[ai][bj][m][0] + bv[bj][0], v1 = acc[ai][bj][m][1] + bv[bj][1];
                    if (ACT == 1) { f32x2 a = gelu_pk((f32x2){v0[0], v0[1]}), b = gelu_pk((f32x2){v0[2], v0[3]}), c = gelu_pk((f32x2){v1[0], v1[1]}), d = gelu_pk((f32x2){v1[2], v1[3]});
                        v0 = (f32x4){a.x, a.y, b.x, b.y}; v1 = (f32x4){c.x, c.y, d.x, d.y}; }
                    v0 = v0 * sc; v1 = v1 * sc; u32x4 w; w.x = cvt_pk_bf16(v0[0], v0[1]); w.y = cvt_pk_bf16(v0[2], v0[3]); w.z = cvt_pk_bf16(v1[0], v1[1]); w.w = cvt_pk_bf16(v1[2], v1[3]);
                    *(u32x4*)(rowp + bj * HALF) = w; } }
    }
};

struct EpiResGate {
    static constexpr bool PERM = false, AFTER_DRAIN = false;
    const float* xold; float* X; const float* gate;
    __device__ __forceinline__ void operator()(const f32x4 (&acc)[2][2][4][2], const Unit& u, int wr, int wc, int fr, int fq) const {
        const int col0 = u.pn * BM + wc * 32 + 4 * fq; const int b = (u.pm * BM) / SEQ;
        const float* gp = gate + (size_t)b * 6 * D + col0;
#pragma unroll
        for (int bj = 0; bj < 2; ++bj)
#pragma unroll
            for (int n = 0; n < 2; ++n) { const f32x4 gv = *(const f32x4*)(gp + bj * HALF + n * 16);
#pragma unroll
                for (int ai = 0; ai < 2; ++ai)
#pragma unroll
                    for (int m = 0; m < 4; ++m) { const size_t off = (size_t)(u.pm * BM + ai * HALF + wr * 64 + m * 16 + fr) * D + col0 + bj * HALF + n * 16;
                        const f32x4 xo = *(const f32x4*)(xold + off); *(f32x4*)(X + off) = xo + gv * acc[ai][bj][m][n]; } }
    }
};
template <class Epi, class Sched, bool ALIGN_EPI = false, bool SP2 = false>
__device__ __forceinline__ void gemm_phase(PG8_LAS unsigned char* lds, const Gemm g, const Sched& S, const Epi& E, int tid) {
    asm volatile("" : "+v"(tid));
    const int wid = __builtin_amdgcn_readfirstlane(tid >> 6), lane = tid & 63, wr = wid >> 2, wc = wid & 3, fr = lane & 15, fq = lane >> 4;
    const int K = g.K, nt = K / BK;
    unsigned voffA[2], voffB[2];
#pragma unroll
    for (int i = 0; i < 2; ++i) { int R, C; stage_rc(tid * 16 + i * 8192, R, C); const int Rb = Epi::PERM ? ((R & ~31) + perm32(R & 31)) : R;
        voffA[i] = (unsigned)(R * K + C) * 2u; voffB[i] = (unsigned)(Rb * K + C) * 2u; }
    const size_t kstep = (size_t)(BK * 2);
    const size_t hstep = (size_t)HALF * K * 2;
    const size_t tstep = 2 * hstep;
    const unsigned ldsw = (unsigned)wid * 1024u;
    const int aoff = lds_byte(wr * 64 + fr, fq * 8), boff = lds_byte(wc * 32 + fr, fq * 8);
#define PG8_SA(b, h) (((b) * 2 + (h)) * HTB)
#define PG8_SB(b, h) ((4 + (b) * 2 + (h)) * HTB)
#define PG8_STAGE(bufoff, gbase, voff) do { _Pragma("unroll") for (int _i = 0; _i < 2; ++_i) \
        __builtin_amdgcn_global_load_lds((const unsigned*)((const char*)(gbase) + (voff)[_i]), (PG8_LAS unsigned*)(lds + (bufoff) + ldsw + _i * 8192), 16, 0, 0); } while (0)
#define PG8_LDA(dst, b, h) do { _Pragma("unroll") for (int m = 0; m < 4; ++m) _Pragma("unroll") for (int k = 0; k < 2; ++k) dst[m][k] = *(const PG8_LAS bf16x8*)(lds + PG8_SA(b, h) + aoff + m * 2048 + k * 1024); } while (0)
#define PG8_LDB(dst, b, h) do { _Pragma("unroll") for (int n = 0; n < 2; ++n) _Pragma("unroll") for (int k = 0; k < 2; ++k) dst[n][k] = *(const PG8_LAS bf16x8*)(lds + PG8_SB(b, h) + boff + n * 2048 + k * 1024); } while (0)
#define PG8_MMA(ai, bj, At, Bt) do { __builtin_amdgcn_s_setprio(1); _Pragma("unroll") for (int m = 0; m < 4; ++m) _Pragma("unroll") for (int n = 0; n < 2; ++n) _Pragma("unroll") for (int k = 0; k < 2; ++k) \
        acc[ai][bj][m][n] = __builtin_amdgcn_mfma_f32_16x16x32_bf16(Bt[n][k], At[m][k], acc[ai][bj][m][n], 0, 0, 0); __builtin_amdgcn_s_setprio(0); } while (0)
#define PG8_WAIT_V(n) asm volatile("s_waitcnt vmcnt(" #n ")" ::: "memory")
#define PG8_WAIT_L(n) asm volatile("s_waitcnt lgkmcnt(" #n ")" ::: "memory")
#define PG8_BAR __builtin_amdgcn_s_barrier()
#define PG8_SCHED __builtin_amdgcn_sched_barrier(0)
    Unit cur, nxt; int ui = 0;
    if (!S.next(0, cur)) return;
    f32x4 acc[2][2][4][2];
#pragma unroll
    for (int a = 0; a < 2; ++a)
#pragma unroll
        for (int b = 0; b < 2; ++b)
#pragma unroll
            for (int m = 0; m < 4; ++m)
#pragma unroll
                for (int n = 0; n < 2; ++n) acc[a][b][m][n] = (f32x4){0.f, 0.f, 0.f, 0.f};
    bf16x8 At[4][2], B0[2][2], B1[2][2];
    const char* cA = (const char*)g.A + (size_t)cur.pm * tstep; const char* cB = (const char*)g.Bt + (size_t)cur.pn * tstep;
    S.a_ready(cur);
    if constexpr (SP2) {
        PG8_STAGE(PG8_SB(0, 0), cB, voffB); PG8_STAGE(PG8_SB(0, 1), cB + hstep, voffB); PG8_STAGE(PG8_SA(0, 0), cA, voffA); PG8_STAGE(PG8_SA(0, 1), cA + hstep, voffA);
        if (wr == 1) PG8_BAR;
        PG8_WAIT_V(2); PG8_BAR;
        PG8_STAGE(PG8_SB(1, 0), cB + kstep, voffB); PG8_STAGE(PG8_SA(1, 0), cA + kstep, voffA); PG8_STAGE(PG8_SB(1, 1), cB + hstep + kstep, voffB);
        PG8_WAIT_V(6); PG8_BAR;
    } else {
        PG8_STAGE(PG8_SB(0, 0), cB, voffB); PG8_STAGE(PG8_SA(0, 0), cA, voffA); PG8_STAGE(PG8_SB(0, 1), cB + hstep, voffB); PG8_STAGE(PG8_SA(0, 1), cA + hstep, voffA);
        if (wr == 1) PG8_BAR;
        PG8_WAIT_V(4); PG8_BAR;
        PG8_STAGE(PG8_SB(1, 0), cB + kstep, voffB); PG8_STAGE(PG8_SA(1, 0), cA + kstep, voffA); PG8_STAGE(PG8_SB(1, 1), cB + hstep + kstep, voffB);
        PG8_WAIT_V(6); PG8_BAR;
    }
    for (;;) {
        const bool has_next = S.next(ui + 1, nxt);
        const char* nA = has_next ? (const char*)g.A + (size_t)nxt.pm * tstep : cA; const char* nB = has_next ? (const char*)g.Bt + (size_t)nxt.pn * tstep : cB;
        for (int t = 0; t < nt; t += 2) {
            const bool last = (t == nt - 2);
            const char* a1 = cA + (size_t)(t + 1) * kstep;
            const char* a2 = last ? nA : cA + (size_t)(t + 2) * kstep; const char* b2 = last ? nB : cB + (size_t)(t + 2) * kstep;
            const char* a3 = a2 + kstep; const char* b3 = b2 + kstep;
            if (last && has_next) S.a_ready(nxt);
            if constexpr (SP2) {
            PG8_LDB(B0, 0, 0); PG8_LDB(B1, 0, 1); PG8_SCHED; PG8_LDA(At, 0, 0); PG8_STAGE(PG8_SA(1, 1), a1 + hstep, voffA);
            PG8_WAIT_V(8); PG8_WAIT_L(0); PG8_BAR; PG8_MMA(0, 0, At, B0); PG8_MMA(0, 1, At, B1); PG8_BAR; PG8_SCHED;
            PG8_LDA(At, 0, 1); PG8_STAGE(PG8_SB(0, 0), b2, voffB); PG8_STAGE(PG8_SB(0, 1), b2 + hstep, voffB); PG8_STAGE(PG8_SA(0, 0), a2, voffA);
            PG8_WAIT_V(8); PG8_WAIT_L(0); PG8_BAR; PG8_MMA(1, 0, At, B0); PG8_MMA(1, 1, At, B1); PG8_BAR; PG8_SCHED;
            PG8_LDB(B0, 1, 0); PG8_LDB(B1, 1, 1); PG8_SCHED; PG8_LDA(At, 1, 0); PG8_STAGE(PG8_SA(0, 1), a2 + hstep, voffA);
            PG8_WAIT_V(8); PG8_WAIT_L(0); PG8_BAR; PG8_MMA(0, 0, At, B0); PG8_MMA(0, 1, At, B1); PG8_BAR; PG8_SCHED;
            PG8_LDA(At, 1, 1); PG8_STAGE(PG8_SB(1, 0), b3, voffB); PG8_STAGE(PG8_SB(1, 1), b3 + hstep, voffB); PG8_STAGE(PG8_SA(1, 0), a3, voffA);
            PG8_WAIT_V(8); PG8_WAIT_L(0); PG8_BAR; PG8_MMA(1, 0, At, B0); PG8_MMA(1, 1, At, B1); PG8_BAR; PG8_SCHED;
            } else {
            PG8_LDB(B0, 0, 0); PG8_SCHED; PG8_LDA(At, 0, 0); PG8_STAGE(PG8_SA(1, 1), a1 + hstep, voffA);
            PG8_WAIT_L(8); PG8_BAR; PG8_WAIT_L(0); PG8_MMA(0, 0, At, B0); PG8_BAR; PG8_SCHED;
            PG8_LDB(B1, 0, 1); PG8_STAGE(PG8_SB(0, 0), b2, voffB);
            PG8_BAR; PG8_WAIT_L(0); PG8_MMA(0, 1, At, B1); PG8_BAR;
            PG8_LDA(At, 0, 1); PG8_STAGE(PG8_SA(0, 0), a2, voffA);
            PG8_BAR; PG8_WAIT_L(0); PG8_MMA(1, 0, At, B0); PG8_BAR; PG8_SCHED;
            PG8_STAGE(PG8_SB(0, 1), b2 + hstep, voffB);
            PG8_WAIT_V(6); PG8_BAR; PG8_MMA(1, 1, At, B1); PG8_BAR;
            PG8_LDB(B0, 1, 0); PG8_SCHED; PG8_LDA(At, 1, 0); PG8_STAGE(PG8_SA(0, 1), a2 + hstep, voffA);
            PG8_WAIT_L(8); PG8_BAR; PG8_WAIT_L(0); PG8_MMA(0, 0, At, B0); PG8_BAR; PG8_SCHED;
            PG8_LDB(B1, 1, 1); PG8_STAGE(PG8_SB(1, 0), b3, voffB);
            PG8_BAR; PG8_WAIT_L(0); PG8_MMA(0, 1, At, B1); PG8_BAR;
            PG8_LDA(At, 1, 1); PG8_STAGE(PG8_SA(1, 0), a3, voffA);
            PG8_BAR; PG8_WAIT_L(0); PG8_MMA(1, 0, At, B0); PG8_BAR; PG8_SCHED;
            PG8_STAGE(PG8_SB(1, 1), b3 + hstep, voffB);
            PG8_WAIT_V(6); PG8_BAR; PG8_MMA(1, 1, At, B1); PG8_BAR;
            }
        }
        if constexpr (ALIGN_EPI) { if (wr == 0) PG8_BAR; }
        if constexpr (!Epi::AFTER_DRAIN) { int le_; asm volatile("v_mbcnt_lo_u32_b32 %0, -1, 0\n\tv_mbcnt_hi_u32_b32 %0, -1, %0" : "=v"(le_)); E(acc, cur, wr, wc, le_ & 15, le_ >> 4); S.done(cur); }
        if (!has_next) break;
#pragma unroll
        for (int a = 0; a < 2; ++a)
#pragma unroll
            for (int b = 0; b < 2; ++b)
#pragma unroll
                for (int m = 0; m < 4; ++m)
#pragma unroll
                    for (int n = 0; n < 2; ++n) acc[a][b][m][n] = (f32x4){0.f, 0.f, 0.f, 0.f};
        cur = nxt; cA = nA; cB = nB; ++ui;
        if constexpr (ALIGN_EPI) { if (wr == 1) PG8_BAR; }
    }
    PG8_WAIT_V(0);
    if constexpr (!ALIGN_EPI) { if (wr == 0) PG8_BAR; }
    PG8_BAR;
    if constexpr (Epi::AFTER_DRAIN) { E.fused(acc, cur, wr, wc, fr, fq, lds, wid, lane); S.done(cur); }
#undef PG8_SA
#undef PG8_SB
#undef PG8_STAGE
#undef PG8_LDA
#undef PG8_LDB
#undef PG8_MMA
#undef PG8_WAIT_V
#undef PG8_WAIT_L
#undef PG8_BAR
#undef PG8_SCHED
}
}

#define LAS __attribute__((address_space(3)))
constexpr int NWAVES = 8, NTHR = 512;
constexpr int LDS_BYTES = 147456;
constexpr int NPH = 21;
typedef float f32x4 __attribute__((ext_vector_type(4)));
typedef unsigned u32x4 __attribute__((ext_vector_type(4)));

struct Args { const float* in[30]; float* out; unsigned char* ws; int ph_lo, ph_hi; };

__device__ __forceinline__ unsigned pk2(float lo, float hi) { return cvtpk(lo, hi); }

__device__ __forceinline__ void p0_transpose_item(const float* W, int K, int N, bf16* WT, int row_off, LAS float* scr, int item, int lane) {
    const int nblk = N / 32, kb = item / nblk, nb = item % nblk, k0 = 64 * kb, n0 = 32 * nb;
#pragma unroll 8
    for (int i = 0; i < 32; ++i) { const int kk = 2 * i + (lane >> 5); scr[kk * 33 + (lane & 31)] = W[(size_t)(k0 + kk) * N + n0 + (lane & 31)]; }
    asm volatile("s_waitcnt lgkmcnt(0)" ::: "memory");
    const int c = lane & 7;
#pragma unroll
    for (int j = 0; j < 4; ++j) { const int n = (lane >> 3) + 8 * j; const LAS float* s = scr + (8 * c) * 33 + n;
        u32x4 o; o.x = pk2(s[0 * 33], s[1 * 33]); o.y = pk2(s[2 * 33], s[3 * 33]); o.z = pk2(s[4 * 33], s[5 * 33]); o.w = pk2(s[6 * 33], s[7 * 33]);
        *(u32x4*)(WT + (size_t)(row_off + n0 + n) * K + k0 + 8 * c) = o; }
    asm volatile("s_waitcnt lgkmcnt(0)" ::: "memory");
}

__device__ __forceinline__ void norm_mod_row(const float* xr, const float* gamma, const float* sh, const float* sc, bf16* orow, int lane) {
    f32x4 v[4]; float ss = 0.f;
#pragma unroll
    for (int j = 0; j < 4; ++j) { v[j] = *(const f32x4*)(xr + j * 256 + lane * 4); ss += (v[j].x * v[j].x + v[j].y * v[j].y) + (v[j].z * v[j].z + v[j].w * v[j].w); }
    const float rs = rsqrtf(wave_sum(ss, lane) * (1.f / D) + NORM_EPS);
#pragma unroll
    for (int j = 0; j < 4; ++j) { const int d = j * 256 + lane * 4; const f32x4 g = *(const f32x4*)(gamma + d), a = *(const f32x4*)(sc + d), s = *(const f32x4*)(sh + d);
        const f32x4 y = v[j] * rs * g * (a + 1.f) + s; uint2 o; o.x = pk2(y.x, y.y); o.y = pk2(y.z, y.w); *(uint2*)(orow + d) = o; }
}


#define XB_TMO      128
#define XB_XCNT(j)  (256  + 64 * (j))
#define XB_XSUB(j)  (1280 + 64 * (j))
#define XB_XGEN(j)  (2304 + 64 * (j))
#define XB_TOP      3328
#define XB_TOPGEN   3392
#define XCD_BAR_WORDS 3456
#define XB_SPIN_CAP (1u << 18)

__device__ __forceinline__ unsigned xb_ld(unsigned* p)              { return __hip_atomic_load(p, __ATOMIC_RELAXED, __HIP_MEMORY_SCOPE_AGENT); }
__device__ __forceinline__ unsigned xb_add(unsigned* p, unsigned v) { return __hip_atomic_fetch_add(p, v, __ATOMIC_RELAXED, __HIP_MEMORY_SCOPE_AGENT); }
__device__ __forceinline__ unsigned xb_xcc_id() { return (unsigned)__builtin_amdgcn_s_getreg((3 << 11) | 20) & 0xFu; }
#define XB_SPIN(cond, bar) do { unsigned _sp = 0; while (cond) { __builtin_amdgcn_s_sleep(1); \
    if ((++_sp & 255u) == 0u) { if (xb_ld(&(bar)[XB_TMO])) break; if (_sp > XB_SPIN_CAP) { atomicAdd(&(bar)[XB_TMO], 1u); break; } } } } while (0)

struct XcdBarrier {
    unsigned* bar; unsigned x; int w0;
    volatile __attribute__((address_space(3))) unsigned* st;
};

__device__ __forceinline__ XcdBarrier xcd_barrier_post(unsigned* bar, volatile __attribute__((address_space(3))) unsigned* st) {
    XcdBarrier b; b.bar = bar; b.x = xb_xcc_id(); b.st = st; b.w0 = __builtin_amdgcn_readfirstlane((int)threadIdx.x >> 6);
    if (threadIdx.x == 0) (void)xb_add(&bar[XB_XCNT(b.x)], 1u);
    return b;
}
__device__ __forceinline__ void xcd_barrier_complete(unsigned* bar, unsigned x, unsigned& nloc, unsigned& nx) {
    const unsigned G = gridDim.x * gridDim.y * gridDim.z;
    unsigned sum, cnt, mine, sp = 0u;
    for (;;) {
        sum = 0u; cnt = 0u; mine = 0u;
#pragma unroll
        for (unsigned j = 0; j < 16; ++j) { const unsigned c = xb_ld(&bar[XB_XCNT(j)]); sum += c; cnt += (c > 0u) ? 1u : 0u; }
        mine = xb_ld(&bar[XB_XCNT(x)]);
        if (sum == G) break;
        __builtin_amdgcn_s_sleep(1);
        if ((++sp & 255u) == 0u) { if (xb_ld(&bar[XB_TMO])) break; if (sp > XB_SPIN_CAP) { atomicAdd(&bar[XB_TMO], 1u); break; } }
    }
    nloc = mine > 0u ? mine : 1u; nx = cnt > 0u ? cnt : 1u;
}

template <bool FIRST> __device__ __forceinline__ void xcd_barrier(const XcdBarrier& b) {
    asm volatile("s_waitcnt vmcnt(0)" ::: "memory");
    __syncthreads();
    int lid_; asm volatile("v_mbcnt_lo_u32_b32 %0, -1, 0\n\tv_mbcnt_hi_u32_b32 %0, -1, %0" : "=v"(lid_));
    if (b.w0 == 0 && lid_ == 0) {
        unsigned* bar = b.bar;
        __builtin_amdgcn_s_waitcnt(0);
        unsigned nloc = b.st[0], nx = b.st[1];
        if (FIRST && nloc == 0u) { xcd_barrier_complete(bar, b.x, nloc, nx); b.st[0] = nloc; b.st[1] = nx; }
        const unsigned old = xb_add(&bar[XB_XSUB(b.x)], 1u);
        const unsigned gen = old / nloc;
        if (old + 1u == (gen + 1u) * nloc) {
            __builtin_amdgcn_fence(__ATOMIC_RELEASE, "agent");
            asm volatile("s_waitcnt vmcnt(0)" ::: "memory");
            const unsigned og = xb_add(&bar[XB_TOP], 1u);
            const unsigned tg = og / nx;
            if (og + 1u == (tg + 1u) * nx) xb_add(&bar[XB_TOPGEN], 1u);
            else XB_SPIN(xb_ld(&bar[XB_TOPGEN]) == tg, bar);
            __builtin_amdgcn_fence(__ATOMIC_ACQUIRE, "agent");
            xb_add(&bar[XB_XGEN(b.x)], 1u);
            asm volatile("s_waitcnt vmcnt(0)" ::: "memory");
        } else {
            XB_SPIN(xb_ld(&bar[XB_XGEN(b.x)]) == gen, bar);
            __builtin_amdgcn_fence(__ATOMIC_ACQUIRE, "agent");
            asm volatile("s_waitcnt vmcnt(0)" ::: "memory");
        }
    }
    __syncthreads();
}


__device__ __forceinline__ unsigned mono_u32(float f) { unsigned u = __float_as_uint(f); return (u & 0x80000000u) ? ~u : (u | 0x80000000u); }
__device__ __forceinline__ float demono_u32(unsigned u) { return __uint_as_float((u & 0x80000000u) ? (u & 0x7FFFFFFFu) : ~u); }
__device__ __forceinline__ unsigned pack_key7(float f, int idx) { return (mono_u32(f) & 0xFFFFFF80u) | (unsigned)(127 - idx); }
__device__ __forceinline__ float unpack_key7(unsigned k) { return demono_u32((k & 0xFFFFFF80u) | 0x40u); }
__device__ __forceinline__ float unpack_key8(unsigned k) { return demono_u32((k & 0xFFFFFF00u) | 0x80u); }
__device__ __forceinline__ void ce_desc(unsigned& a, unsigned& b) { const unsigned hi = a > b ? a : b, lo = a > b ? b : a; a = hi; b = lo; }
__device__ __forceinline__ void sort16_desc(unsigned* v) {
#pragma unroll
    for (int k = 2; k <= 16; k <<= 1)
#pragma unroll
        for (int j = k >> 1; j > 0; j >>= 1)
#pragma unroll
            for (int i = 0; i < 16; ++i) { const int l = i ^ j; if (l > i) { if ((i & k) == 0) ce_desc(v[i], v[l]); else ce_desc(v[l], v[i]); } }
}
__device__ __forceinline__ void bmerge16_desc(unsigned* v) {
#pragma unroll
    for (int j = 8; j > 0; j >>= 1)
#pragma unroll
        for (int i = 0; i < 16; ++i) { const int l = i ^ j; if (l > i) ce_desc(v[i], v[l]); }
}
__device__ __forceinline__ void merge_top16(unsigned* a, const unsigned* b) {
#pragma unroll
    for (int i = 0; i < 16; ++i) { const unsigned o = b[15 - i]; a[i] = a[i] > o ? a[i] : o; }
    bmerge16_desc(a);
}
__device__ __forceinline__ void stage2_cands(const unsigned* s0, const unsigned* s1, int hh, unsigned* c) {
    float A[16], B[16];
#pragma unroll
    for (int i = 0; i < 16; ++i) { const float f0 = unpack_key7(s0[i]), f1 = unpack_key7(s1[i]); A[i] = hh ? f1 : f0; B[i] = hh ? f0 : f1; }
    int n = 0;
#pragma unroll
    for (int i = 0; i < 4; ++i)
#pragma unroll
        for (int j = i; j < 16; ++j) { if ((i + 1) * (j + 1) > 16) continue;
            const float val = A[i] + B[j]; const unsigned id = hh ? (unsigned)((j << 4) | i) : (unsigned)((i << 4) | j);
            unsigned key = (mono_u32(val) & 0xFFFFFF00u) | id; if (hh && i == j) key = 0u; c[n++] = key; }
#pragma unroll
    for (; n < 32; ++n) c[n] = 0u;
}

typedef short bf16x8_t __attribute__((ext_vector_type(8)));
typedef float f32x16 __attribute__((ext_vector_type(16)));
__device__ __forceinline__ float gelu_erf(float a) { return 0.5f * a * (1.f + erff(a * 0.70710678118654752f)); }


typedef __attribute__((address_space(3))) bf16 lbf16;

__device__ __forceinline__ f32x16 mm32(bf16x8_t a, bf16x8_t b, f32x16 c) { return __builtin_amdgcn_mfma_f32_32x32x16_bf16(a, b, c, 0, 0, 0); }
__device__ __forceinline__ bf16x8_t frag_from_u32x4(unsigned x, unsigned y, unsigned z, unsigned w) { typedef unsigned u4 __attribute__((ext_vector_type(4))); u4 t = {x, y, z, w}; return __builtin_bit_cast(bf16x8_t, t); }
template <int S> __device__ __forceinline__ bf16x8_t accop(const f32x16& z) {
    return frag_from_u32x4(cvtpk(z[8 * S], z[8 * S + 1]), cvtpk(z[8 * S + 2], z[8 * S + 3]), cvtpk(z[8 * S + 4], z[8 * S + 5]), cvtpk(z[8 * S + 6], z[8 * S + 7])); }
template <int S> __device__ __forceinline__ bf16x8_t ldpermcol(const lbf16* a, int col, int hh) {
    const lbf16* p = a + (16 * S + 4 * hh) * 72 + col;
    const unsigned e0 = p[0], e1 = p[72], e2 = p[144], e3 = p[216], e4 = p[8 * 72], e5 = p[9 * 72], e6 = p[10 * 72], e7 = p[11 * 72];
    return frag_from_u32x4(e0 | (e1 << 16), e2 | (e3 << 16), e4 | (e5 << 16), e6 | (e7 << 16)); }
__device__ __forceinline__ bf16x8_t ldrow(const lbf16* a, int row, int ks, int hh) { return *(const __attribute__((address_space(3))) bf16x8_t*)(a + row * 72 + ks * 16 + 8 * hh); }
__device__ __forceinline__ int rowidx(int e, int hh) { return (e & 3) + 8 * (e >> 2) + 4 * hh; }

__device__ __forceinline__ void convert_tables_fp8(const float* pu, const float* pv, unsigned char* u8, unsigned char* v8, float* usc, float* vsc, int l, int wv, int nw, int lane) {
    for (int rr0 = wv * 2; rr0 < 2 * NEXP; rr0 += nw * 2) {
        f32x4 v[2][4]; float m[2];
#pragma unroll
        for (int rr = 0; rr < 2; ++rr) { const int q = rr0 + rr; const size_t row = (size_t)l * NEXP + (q < NEXP ? q : q - NEXP); const float* sp_ = (q < NEXP ? pu : pv) + row * D + lane * 16;
#pragma unroll
            for (int k = 0; k < 4; ++k) v[rr][k] = *(const f32x4*)(sp_ + k * 4); }
#pragma unroll
        for (int rr = 0; rr < 2; ++rr) { float mm = 0.f;
#pragma unroll
            for (int k = 0; k < 4; ++k) mm = fmaxf(fmaxf(mm, fmaxf(fabsf(v[rr][k].x), fabsf(v[rr][k].y))), fmaxf(fabsf(v[rr][k].z), fabsf(v[rr][k].w)));
#pragma unroll
            for (int o = 1; o < 64; o <<= 1) mm = fmaxf(mm, shflx(mm, lane, o));
            m[rr] = mm; }
#pragma unroll
        for (int rr = 0; rr < 2; ++rr) { const int q = rr0 + rr; const size_t row = (size_t)l * NEXP + (q < NEXP ? q : q - NEXP); const float sc = m[rr] > 0.f ? 448.f / m[rr] : 1.f;
            u32x4 o; int w;
            w = 0; w = __builtin_amdgcn_cvt_pk_fp8_f32(v[rr][0].x * sc, v[rr][0].y * sc, w, false); w = __builtin_amdgcn_cvt_pk_fp8_f32(v[rr][0].z * sc, v[rr][0].w * sc, w, true); o.x = (unsigned)w;
            w = 0; w = __builtin_amdgcn_cvt_pk_fp8_f32(v[rr][1].x * sc, v[rr][1].y * sc, w, false); w = __builtin_amdgcn_cvt_pk_fp8_f32(v[rr][1].z * sc, v[rr][1].w * sc, w, true); o.y = (unsigned)w;
            w = 0; w = __builtin_amdgcn_cvt_pk_fp8_f32(v[rr][2].x * sc, v[rr][2].y * sc, w, false); w = __builtin_amdgcn_cvt_pk_fp8_f32(v[rr][2].z * sc, v[rr][2].w * sc, w, true); o.z = (unsigned)w;
            w = 0; w = __builtin_amdgcn_cvt_pk_fp8_f32(v[rr][3].x * sc, v[rr][3].y * sc, w, false); w = __builtin_amdgcn_cvt_pk_fp8_f32(v[rr][3].z * sc, v[rr][3].w * sc, w, true); o.w = (unsigned)w;
            *(u32x4*)((q < NEXP ? u8 : v8) + row * D + lane * 16) = o;
            if (lane == 0) (q < NEXP ? usc : vsc)[row] = m[rr] > 0.f ? m[rr] * (1.f / 448.f) : 1.f; }
    }
}

__global__ void __launch_bounds__(NTHR, 2) mega(Args args) {
    extern __shared__ __attribute__((aligned(16))) unsigned char lds_raw[];
    LAS unsigned char* lds = (LAS unsigned char*)lds_raw;
    const int G = gridDim.x, bx = blockIdx.x, NGW = G * NWAVES;
    const int wave0 = __builtin_amdgcn_readfirstlane((int)threadIdx.x >> 6);
    typedef const unsigned char __attribute__((address_space(4))) kbyte;
#define PHASE_IDS int tid; asm volatile("v_mbcnt_lo_u32_b32 %0, -1, 0\n\tv_mbcnt_hi_u32_b32 %0, -1, %0" : "=v"(tid)); tid += wave0 * 64;     const int lane = tid & 63, wave = __builtin_amdgcn_readfirstlane(tid >> 6), gw = bx * NWAVES + wave; (void)lane; (void)gw; \
    kbyte* kp = (kbyte*)__builtin_amdgcn_kernarg_segment_ptr(); asm volatile("" : "+s"(kp)); \
    unsigned char* const ws = (unsigned char*)*(__attribute__((address_space(1))) unsigned char* const __attribute__((address_space(4)))*)(kp + 31 * 8); float* const X = (float*)*(__attribute__((address_space(1))) float* const __attribute__((address_space(4)))*)(kp + 30 * 8); (void)ws; (void)X;
#define INP(i) ((const float*)(*(const __attribute__((address_space(1))) float* const __attribute__((address_space(4)))*)(kp + (i) * 8)))
#define MOD ((float*)(ws + WS_MOD))
#define H ((bf16*)(ws + WS_H))
#define PROJ ((bf16*)(ws + WS_PROJ))
#define Q ((bf16*)(ws + WS_Q))
#define MIX ((bf16*)(ws + WS_MIX))
#define Rb ((bf16*)(ws + WS_R))
#define Kb ((bf16*)(ws + WS_K))
#define V0 ((bf16*)(ws + WS_V0))
#define V1 ((bf16*)(ws + WS_V1))
#define KKb ((bf16*)(ws + WS_KK))
#define Bb ((bf16*)(ws + WS_B))
#define Gb ((bf16*)(ws + WS_G))
#define BGb ((bf16*)(ws + WS_BG))
#define Wd ((float*)(ws + WS_W))
#define Y ((float*)(ws + WS_Y))
#define QB ((float*)(ws + WS_QB))
#define SH ((float*)(ws + WS_SH))
#define WUPT ((bf16*)(ws + WS_LORA))
#define AUPT ((bf16*)(ws + WS_LORA + 131072))
#define GUPT ((bf16*)(ws + WS_LORA + 262144))
#define VUPT ((bf16*)(ws + WS_LORA + 524288))
#define PWT ((bf16*)(ws + WS_LORA + 655360))
#define INVN ((float*)(ws + WS_INVN))
#define BSUM ((float*)(ws + WS_BSUM))
#define SCN ((unsigned char*)(ws + WS_SCN))
#define IDX ((int*)(ws + WS_IDX))
#define GATE ((float*)(ws + WS_GATE))
#define WinT ((bf16*)(ws + WS_WIN_T))
#define WoutT ((bf16*)(ws + WS_WOUT_T))
#define PqT ((bf16*)(ws + WS_PQ_T))
#define KEYS ((bf16*)(ws + WS_KEYS))
#define U8 ((unsigned char*)(ws + WS_U))
#define V8 ((unsigned char*)(ws + WS_V))
#define USc ((float*)(ws + WS_US))
#define VSc ((float*)(ws + WS_VS))
    const int lo = args.ph_lo, hi = args.ph_hi;
    { volatile LAS unsigned* misc = (volatile LAS unsigned*)(lds + LDS_BYTES - 64); if (threadIdx.x < 4) misc[threadIdx.x] = 0u; __syncthreads(); }
    const XcdBarrier xbar = xcd_barrier_post((unsigned*)(args.ws) + 4096, (volatile LAS unsigned*)(lds + LDS_BYTES - 64));
#define IN(k) (lo <= (k) && (k) < hi)
#ifndef REP_PHASE
#define REP_PHASE (-1)
#endif
#define REPS(k) ((k) == REP_PHASE ? 3 : 1)
#define SEAM(k) do { if (IN(k) && IN((k) + 1)) { if ((k) == 0) cg::this_grid().sync(); else { XcdBarrier xb_ = xbar; asm volatile("" : "+s"(xb_.bar)); if ((k) == 1) xcd_barrier<true>(xb_); else xcd_barrier<false>(xb_); } } } while (0)

    if (IN(0)) { PHASE_IDS
        { LAS float* ca = (LAS float*)lds; LAS float* red = (LAS float*)(lds + 16384);
          const float* c = INP(1); const float* ada_w = INP(2); const float* ada_b = INP(3);
          bool have = false;
          for (int it = bx; it < 96; it += G) {
              if (!have) { for (int i = tid; i < BATCH * D; i += NTHR) { const float v = c[i]; ca[i] = v / (1.f + expf(-v)); } have = true; __syncthreads(); }
              const int l = it / 48, n = (it % 48) * 128 + (tid & 127), kq = tid >> 7;
              const float* w = ada_w + (size_t)l * D * 6 * D + (size_t)(kq * 256) * 6 * D + n;
              float a0 = 0.f, a1 = 0.f, a2 = 0.f, a3 = 0.f;
#pragma unroll 32
              for (int k = 0; k < 256; ++k) { const float wv = w[(size_t)k * 6 * D]; const int kk = kq * 256 + k; a0 += ca[kk] * wv; a1 += ca[D + kk] * wv; a2 += ca[2 * D + kk] * wv; a3 += ca[3 * D + kk] * wv; }
              red[(kq * 4 + 0) * 128 + (tid & 127)] = a0; red[(kq * 4 + 1) * 128 + (tid & 127)] = a1; red[(kq * 4 + 2) * 128 + (tid & 127)] = a2; red[(kq * 4 + 3) * 128 + (tid & 127)] = a3;
              __syncthreads();
              { const int b = tid >> 7, col = tid & 127, nn = (it % 48) * 128 + col;
                const float s = red[(0 * 4 + b) * 128 + col] + red[(1 * 4 + b) * 128 + col] + red[(2 * 4 + b) * 128 + col] + red[(3 * 4 + b) * 128 + col];
                MOD[(size_t)l * BATCH * 6 * D + (size_t)b * 6 * D + nn] = s + ada_b[l * 6 * D + nn]; }
              __syncthreads();
          }
          __syncthreads(); }
        { LAS float* scr = (LAS float*)(lds + wave * 16384);
          constexpr int I_IN = (D / 64) * (IN_COLS / 32), I_VR = (D / 64) * (MVL / 32), I_OUT = (D / 64) * (D / 32), I_PQ = (D / 64) * (PH * PQ / 32);
          constexpr int NIT = 2 * I_IN + I_VR + 2 * I_OUT + 2 * I_PQ;
          for (int it = gw; it < NIT; it += NGW) { int r = it;
              if (r < 2 * I_IN) { const int l = r / I_IN; p0_transpose_item(INP(5) + (size_t)l * D * IN_COLS, D, IN_COLS, WinT + (size_t)l * LDP * D, 0, scr, r % I_IN, lane); continue; } r -= 2 * I_IN;
              if (r < I_VR) { p0_transpose_item(INP(12), D, MVL, WinT + (size_t)1 * LDP * D, IN_COLS, scr, r, lane); continue; } r -= I_VR;
              if (r < 2 * I_OUT) { const int l = r / I_OUT; p0_transpose_item(INP(23) + (size_t)l * D * D, D, D, WoutT + (size_t)l * D * D, 0, scr, r % I_OUT, lane); continue; } r -= 2 * I_OUT;
              { const int l = r / I_PQ; p0_transpose_item(INP(25) + (size_t)l * D * PH * PQ, D, PH * PQ, PqT + (size_t)l * PH * PQ * D, 0, scr, r % I_PQ, lane); } }
          for (int it = gw; it < 2 * 16 + 2 * 16 + 2 * 32; it += NGW) { int r = it;
              if (r < 32) { const int l = r / 16; p0_transpose_item(INP(8) + (size_t)l * DL * RW, DL, RW, WUPT + (size_t)l * RW * DL, 0, scr, r % 16, lane); continue; } r -= 32;
              if (r < 32) { const int l = r / 16; p0_transpose_item(INP(10) + (size_t)l * AL * RW, AL, RW, AUPT + (size_t)l * RW * AL, 0, scr, r % 16, lane); continue; } r -= 32;
              { const int l = r / 32; p0_transpose_item(INP(11) + (size_t)l * GL * RW, GL, RW, GUPT + (size_t)l * RW * GL, 0, scr, r % 32, lane); } }
          { const float* vu = INP(15); for (int e = bx * NTHR + tid; e < MVL * RW; e += G * NTHR) { const int n = e >> 5, k = e & 31; VUPT[e] = f2bf(vu[k * RW + n]); } }
          for (int it = gw; it < 8 * 8; it += NGW) p0_transpose_item(INP(21) + (size_t)(it >> 3) * PG * PG, PG, PG, PWT + (size_t)(it >> 3) * PG * PG, 0, scr, it & 7, lane);
        }
        { const size_t gt = (size_t)bx * NTHR + tid, NT = (size_t)G * NTHR;
          constexpr size_t NK8 = (size_t)2 * PH * 2 * NKEYS * PHALF / 8;
          const float* src = INP(26); bf16* dst = KEYS;
          for (size_t i = gt; i < NK8; i += NT) {
              const f32x4 a = *(const f32x4*)(src + i * 8), b = *(const f32x4*)(src + i * 8 + 4);
              u32x4 o; o.x = pk2(a.x, a.y); o.y = pk2(a.z, a.w); o.z = pk2(b.x, b.y); o.w = pk2(b.z, b.w); *(u32x4*)(dst + i * 8) = o; }
        }
    }
    SEAM(0);

#pragma unroll
    for (int l = 0; l < DEPTH; ++l) {
        const int pb = 1 + 10 * l;
#define modl (MOD + (size_t)l * BATCH * 6 * D)
#define xin (l == 0 ? INP(0) : (const float*)X)
        if (l == 0 && IN(pb + 0)) { PHASE_IDS const float* gamma = INP(4) + l * D;
            for (int row = gw; row < T; row += NGW) { const int b = row / SEQ; norm_mod_row(xin + (size_t)row * D, gamma, modl + (size_t)b * 6 * D, modl + (size_t)b * 6 * D + D, H + (size_t)row * D, lane); } }
        SEAM(pb + 0);
        if (IN(pb + 1)) { PHASE_IDS const int N1 = l == 0 ? IN_COLS : LDP;
            pg8::Gemm g{H, WinT + (size_t)l * LDP * D, T, N1, D}; pg8::StaticOrder S; S.init(T, N1, G, bx);
            pg8::EpiBf16<0> E{PROJ, LDP, nullptr, 0, 0, 1.f};
            pg8::gemm_phase<pg8::EpiBf16<0>, pg8::StaticOrder, true, true>(lds, g, S, E, tid); }
        SEAM(pb + 1);

        if (IN(pb + 2)) { PHASE_IDS
            constexpr int LST = 296;
            LAS bf16* lin = (LAS bf16*)lds;
            const float* mu = INP(6) + l * RWKV_COLS; const float* vmu = INP(13);
            const float* w0p = INP(7) + l * RW; const float* a0p = INP(9) + l * RW; const float* kkp = INP(16) + l * RW; const float* kap = INP(17) + l * RW; const float* rkp = INP(18) + l * RW; const float* v0p = INP(14);
            const bf16* wupT = WUPT + (size_t)l * RW * DL; const bf16* aupT = AUPT + (size_t)l * RW * AL; const bf16* gupT = GUPT + (size_t)l * RW * GL; const bf16* vupT = VUPT;
            bf16* Vl = l == 0 ? V0 : V1;
            const int r32 = lane & 31, hh = lane >> 5, h = wave;
            for (int tile = bx; tile < T / 32; tile += G) {
                const int t0 = tile * 32;
                __syncthreads();
#pragma unroll 1
                for (int it0 = 0; it0 < 3; it0 += 2) {
                  u32x4 cu_[2], pv_[2]; f32x4 m0_[2], m1_[2];
#pragma unroll
                  for (int it = 0; it < 2; ++it) { const int c8 = tid + (it0 + it) * NTHR; const bool ok = c8 < 32 * 36; const int tok = ok ? c8 / 36 : 0, jc = ok ? c8 % 36 : 0, t = t0 + tok, sq = t % SEQ;
                      cu_[it] = (u32x4){0u, 0u, 0u, 0u}; pv_[it] = (u32x4){0u, 0u, 0u, 0u}; m0_[it] = (f32x4){0.f, 0.f, 0.f, 0.f}; m1_[it] = m0_[it];
                      if (ok && (jc < 32 || l > 0)) { const int col = jc < 32 ? 3 * RW + jc * 8 : IN_COLS + (jc - 32) * 8;
                          cu_[it] = *(const u32x4*)(PROJ + (size_t)t * LDP + col); if (sq > 0) pv_[it] = *(const u32x4*)(PROJ + (size_t)(t - 1) * LDP + col);
                          const float* mp = jc < 32 ? mu + col : vmu + (jc - 32) * 8; m0_[it] = *(const f32x4*)mp; m1_[it] = *(const f32x4*)(mp + 4); } }
#pragma unroll
                  for (int it = 0; it < 2; ++it) { const int c8 = tid + (it0 + it) * NTHR; if (c8 < 32 * 36) { const int tok = c8 / 36, jc = c8 % 36;
                      u32x4 o = {0u, 0u, 0u, 0u};
                      if (jc < 32 || l > 0) {
                          float x[8]; const unsigned cw[4] = {cu_[it].x, cu_[it].y, cu_[it].z, cu_[it].w}, pw[4] = {pv_[it].x, pv_[it].y, pv_[it].z, pv_[it].w}; const float mm[8] = {m0_[it].x, m0_[it].y, m0_[it].z, m0_[it].w, m1_[it].x, m1_[it].y, m1_[it].z, m1_[it].w};
#pragma unroll
                          for (int i = 0; i < 4; ++i) { const float c0 = __uint_as_float(cw[i] << 16), c1 = __uint_as_float(cw[i] & 0xffff0000u), p0 = __uint_as_float(pw[i] << 16), p1 = __uint_as_float(pw[i] & 0xffff0000u);
                              x[2 * i] = c0 + (p0 - c0) * mm[2 * i]; x[2 * i + 1] = c1 + (p1 - c1) * mm[2 * i + 1]; }
                          if (jc < 8) {
#pragma unroll
                              for (int i = 0; i < 8; ++i) { const float e2 = __expf(-2.f * fabsf(x[i])); const float th = (1.f - e2) * __builtin_amdgcn_rcpf(1.f + e2); x[i] = x[i] < 0.f ? -th : th; } }
                          else if (jc >= 16 && jc < 32) {
#pragma unroll
                              for (int i = 0; i < 8; ++i) x[i] = __builtin_amdgcn_rcpf(1.f + __expf(-x[i])); }
                          o.x = pk2(x[0], x[1]); o.y = pk2(x[2], x[3]); o.z = pk2(x[4], x[5]); o.w = pk2(x[6], x[7]);
                      }
                      *(LAS u32x4*)(lin + tok * LST + jc * 8) = o; } } }
                __syncthreads();
                const bool first = (t0 % SEQ) == 0;
                lbf16* tin = (lbf16*)(lds + 19456 + wave * 14336);
                { u32x4 iq[13]; int ql_; asm volatile("v_mbcnt_lo_u32_b32 %0, -1, 0\n\tv_mbcnt_hi_u32_b32 %0, -1, %0" : "=v"(ql_));
#pragma unroll
                  for (int i = 0; i < 13; ++i) { const int q = ql_ + 64 * i; iq[i] = (u32x4){0u, 0u, 0u, 0u};
                      if (q < 792) { const int arr = q / 264, rem = q - arr * 264, row = rem >> 3, cc = rem & 7;
                          if (!(first && row == 0)) iq[i] = *(const u32x4*)(PROJ + (size_t)(t0 - 1 + row) * LDP + arr * RW + h * HS + cc * 8); } }
#pragma unroll
                  for (int i = 0; i < 13; ++i) { const int q = ql_ + 64 * i; if (q < 792) { const int arr = q / 264, rem = q - arr * 264, row = rem >> 3, cc = rem & 7;
                      *(__attribute__((address_space(3))) u32x4*)(tin + arr * 2376 + row * 72 + cc * 8) = iq[i]; } } }
                __builtin_amdgcn_wave_barrier(); asm volatile("s_waitcnt lgkmcnt(0)" ::: "memory");
                float ssq[16], bsm[16];
#pragma unroll
                for (int e = 0; e < 16; ++e) { ssq[e] = 0.f; bsm[e] = 0.f; }
#pragma unroll 1
                for (int rt = 0; rt < 2; ++rt) {
                    f32x16 accW, accA, accG, accV;
#pragma unroll
                    for (int e = 0; e < 16; ++e) { accW[e] = 0.f; accA[e] = 0.f; accG[e] = 0.f; accV[e] = 0.f; }
                    int c = h * HS + rt * 32 + r32;
int hh8 = 8 * hh; asm volatile("" : "+v"(c), "+v"(hh8));
                    const LAS bf16* lrow = lin + r32 * LST + 8 * hh;
                    { bf16x8_t wf[18];
#pragma unroll
                      for (int ks = 0; ks < 4; ++ks) { wf[ks] = *(const bf16x8_t*)(wupT + (size_t)c * DL + ks * 16 + hh8); wf[4 + ks] = *(const bf16x8_t*)(aupT + (size_t)c * AL + ks * 16 + hh8); }
#pragma unroll
                      for (int ks = 0; ks < 8; ++ks) wf[8 + ks] = *(const bf16x8_t*)(gupT + (size_t)c * GL + ks * 16 + hh8);
                      if (l > 0) { wf[16] = *(const bf16x8_t*)(vupT + (size_t)c * MVL + hh8); wf[17] = *(const bf16x8_t*)(vupT + (size_t)c * MVL + 16 + hh8); }
#pragma unroll
                      for (int ks = 0; ks < 4; ++ks) { accW = __builtin_amdgcn_mfma_f32_32x32x16_bf16(*(const LAS bf16x8_t*)(lrow + ks * 16), wf[ks], accW, 0, 0, 0);
                                                       accA = __builtin_amdgcn_mfma_f32_32x32x16_bf16(*(const LAS bf16x8_t*)(lrow + 64 + ks * 16), wf[4 + ks], accA, 0, 0, 0); }
#pragma unroll
                      for (int ks = 0; ks < 8; ++ks) accG = __builtin_amdgcn_mfma_f32_32x32x16_bf16(*(const LAS bf16x8_t*)(lrow + 128 + ks * 16), wf[8 + ks], accG, 0, 0, 0);
                      if (l > 0) {
#pragma unroll
                          for (int ks = 0; ks < 2; ++ks) accV = __builtin_amdgcn_mfma_f32_32x32x16_bf16(*(const LAS bf16x8_t*)(lrow + 256 + ks * 16), wf[16 + ks], accV, 0, 0, 0); } }
                    const float mur = mu[c], muk = mu[RW + c], muv = mu[2 * RW + c], w0c = w0p[c], a0c = a0p[c], kkc = kkp[c], kac = kap[c], rkc = rkp[c];
                    const float v0c = l > 0 ? v0p[c] : 0.f;
#pragma unroll
                    for (int eb = 0; eb < 16; eb += 4) {
                        bf16 lr[4], lk[4], lv[4], lrp[4], lkp[4], lvp[4], lvf[4];
#pragma unroll
                        for (int i = 0; i < 4; ++i) { const int e = eb + i; const int tok = (e & 3) + 8 * (e >> 2) + 4 * hh, t = t0 + tok; const int ci = rt * 32 + r32;
                            lr[i] = tin[(tok + 1) * 72 + ci]; lk[i] = tin[2376 + (tok + 1) * 72 + ci]; lv[i] = tin[2 * 2376 + (tok + 1) * 72 + ci];
                            lrp[i] = tin[tok * 72 + ci]; lkp[i] = tin[2376 + tok * 72 + ci]; lvp[i] = tin[2 * 2376 + tok * 72 + ci];
                            lvf[i] = l > 0 ? V0[(size_t)t * RW + c] : (bf16)0; }
                        __builtin_amdgcn_sched_barrier(0);
#pragma unroll
                        for (int i = 0; i < 4; ++i) { const int e = eb + i; const int tok = (e & 3) + 8 * (e >> 2) + 4 * hh, t = t0 + tok; const size_t o = (size_t)t * RW + c;
                            float r = bf2f(lr[i]), k = bf2f(lk[i]), v = bf2f(lv[i]);
                            r += (bf2f(lrp[i]) - r) * mur; k += (bf2f(lkp[i]) - k) * muk; v += (bf2f(lvp[i]) - v) * muv;
                            const float z = -(w0c + accW[e]); const float sp = fmaxf(z, 0.f) + __logf(1.f + __expf(-fabsf(z)));
                            const float decay = __expf(-__expf(-sp - 0.5f));
                            const float a = __builtin_amdgcn_rcpf(1.f + __expf(-(a0c + accA[e]))); const float g = accG[e];
                            if (l > 0) { const float vfv = bf2f(lvf[i]); v = v + (vfv - v) * __builtin_amdgcn_rcpf(1.f + __expf(-(v0c + accV[e]))); }
                            const float kk = k * kkc; const float k2 = k * (1.f + (a - 1.f) * kac);
                            ssq[e] += kk * kk; bsm[e] += r * k2 * rkc;
                            { const unsigned p0_ = cvtpk(r, k2), p1_ = cvtpk(v, kk), p2_ = cvtpk(kk * a, g), p3_ = cvtpk(v * g, 0.f);
                              Rb[o] = (bf16)p0_; Kb[o] = (bf16)(p0_ >> 16); Vl[o] = (bf16)p1_; KKb[o] = (bf16)(p1_ >> 16); Bb[o] = (bf16)p2_; Gb[o] = (bf16)(p2_ >> 16); BGb[o] = (bf16)p3_; Wd[o] = decay; }
                        }
                    }
                }
#pragma unroll
                for (int e = 0; e < 16; ++e) { const int ln_ = r32 | (hh << 5); float a_ = red16(ssq[e]), b_ = red16(bsm[e]); a_ += shflx(a_, ln_, 16); b_ += shflx(b_, ln_, 16); ssq[e] = a_; bsm[e] = b_; }
                if (r32 == 0) {
#pragma unroll
                    for (int e = 0; e < 16; ++e) { const int tok = (e & 3) + 8 * (e >> 2) + 4 * hh; INVN[(size_t)(t0 + tok) * NH + h] = rsqrtf(fmaxf(ssq[e], 1e-24f)); BSUM[(size_t)(t0 + tok) * NH + h] = bsm[e]; } }
            }
            {
                constexpr int DST = 520;
                int lane_p; asm volatile("v_mbcnt_lo_u32_b32 %0, -1, 0\n\tv_mbcnt_hi_u32_b32 %0, -1, %0" : "=v"(lane_p)); const int r32 = lane_p & 31, hh = lane_p >> 5, tidp = wave0 * 64 + lane_p;
                lbf16* dlb = (lbf16*)lds;
                lbf16* pin = (lbf16*)(lds + 33280);
                const int c = tidp, g = c >> 7, win = 2 << g;
                const bf16* pwt = PWT + (size_t)(l * 4 + (wave >> 1)) * PG * PG; const float* psc = INP(22) + l * PW;
                for (int tile = bx; tile < T / 32; tile += G) {
                    const int t0 = tile * 32; const bool first = (t0 % SEQ) == 0;
                    __syncthreads();
                    { u32x4 pq[6];
#pragma unroll
                      for (int q = 0; q < 6; ++q) { const int ch = tidp + q * NTHR, row = ch >> 6, cc = ch & 63; pq[q] = (u32x4){0u, 0u, 0u, 0u};
                          if (ch < 47 * 64 && (row >= 15 || !first)) pq[q] = *(const u32x4*)(PROJ + (size_t)(t0 - 15 + row) * LDP + RWKV_COLS + cc * 8); }
#pragma unroll
                      for (int q = 0; q < 6; ++q) { const int ch = tidp + q * NTHR, row = ch >> 6, cc = ch & 63; if (ch < 47 * 64) *(__attribute__((address_space(3))) u32x4*)(pin + row * 520 + cc * 8) = pq[q]; } }
                    __syncthreads();
                    const lbf16* pc = pin + c;
                    float sw = 0.f;
#pragma unroll
                    for (int j = 1; j <= 15; ++j) sw += (j < win) ? bf2f(pc[(15 - j) * 520]) : 0.f;
                    const float invw = 1.f / (float)win;
#pragma unroll 8
                    for (int i = 0; i < 32; ++i) {
                        const float cur = bf2f(pc[(15 + i) * 520]);
                        sw += cur;
                        const float inv = (first && i < 15) ? 1.f / (float)min(i + 1, win) : invw;
                        dlb[i * DST + c] = f2bf(sw * inv - cur);
                        sw -= bf2f(pc[(15 + i - win + 1) * 520]);
                    }
                    __syncthreads();
                    const int gg = wave >> 1, half = wave & 1;
#pragma unroll
                    for (int ct = 0; ct < 2; ++ct) {
                        const int dd0 = half * 64 + ct * 32;
                        f32x16 acc;
#pragma unroll
                        for (int e = 0; e < 16; ++e) acc[e] = 0.f;
#pragma unroll
                        for (int ks = 0; ks < 8; ++ks) { const bf16x8_t a = *(const __attribute__((address_space(3))) bf16x8_t*)(dlb + r32 * DST + gg * PG + ks * 16 + 8 * hh);
                            const bf16x8_t w = *(const bf16x8_t*)(pwt + (size_t)(dd0 + r32) * PG + ks * 16 + 8 * hh); acc = mm32(a, w, acc); }
                        const int oc = gg * PG + dd0 + r32; const float ps = psc[oc];
#pragma unroll
                        for (int e = 0; e < 16; ++e) MIX[(size_t)(t0 + rowidx(e, hh)) * D + RW + oc] = f2bf(acc[e] * ps);
                    }
                }
            }
        }
        SEAM(pb + 2);

        if (IN(pb + 3)) { PHASE_IDS
            const bf16* Vl = l == 0 ? V0 : V1;
            const int r32 = lane & 31, hh = lane >> 5;
            if (wave < 6) {
                lbf16* At = (lbf16*)(lds + wave * 23552); lbf16* Bt = At + 2304; lbf16* Kt = Bt + 2304; lbf16* Rt = Kt + 2304; lbf16* Vv = Rt + 2304;
                LAS float* PCs = (LAS float*)(lds + wave * 23552 + 23040);
                for (int item = bx * 6 + wave; item < BATCH * NH * (SEQ / 32); item += G * 6) {
                    const int bh = item >> 7, chunk = item & 127, b = bh >> 3, h = bh & 7; const size_t t0 = (size_t)b * SEQ + chunk * 32;
                    __builtin_amdgcn_wave_barrier(); asm volatile("s_waitcnt lgkmcnt(0)" ::: "memory");
                    {
                      const int tk = lane >> 3, part = lane & 7;
                      u32x4 qr[4], qk[4], qv[4], qkk[4], qb[4]; f32x4 qw0[4], qw1[4]; float qin[4];
#pragma unroll
                      for (int p4 = 0; p4 < 4; ++p4) { const size_t o = (t0 + p4 * 8 + tk) * RW + h * HS + part * 8;
                          qr[p4] = *(const u32x4*)(Rb + o); qk[p4] = *(const u32x4*)(Kb + o); qv[p4] = *(const u32x4*)(Vl + o); qkk[p4] = *(const u32x4*)(KKb + o); qb[p4] = *(const u32x4*)(Bb + o);
                          qw0[p4] = *(const f32x4*)(Wd + o); qw1[p4] = *(const f32x4*)(Wd + o + 4); qin[p4] = INVN[(t0 + p4 * 8 + tk) * NH + h]; }
                      LAS float* Pl = (LAS float*)At;
#pragma unroll
                      for (int p4 = 0; p4 < 4; ++p4) { *(LAS f32x4*)(Pl + (p4 * 8 + tk) * 64 + part * 8) = qw0[p4]; *(LAS f32x4*)(Pl + (p4 * 8 + tk) * 64 + part * 8 + 4) = qw1[p4]; }
                      __builtin_amdgcn_wave_barrier(); asm volatile("s_waitcnt lgkmcnt(0)" ::: "memory");
                      { float P = 1.f;
#pragma unroll 8
                        for (int c = 0; c < 32; ++c) { P *= Pl[c * 64 + lane]; Pl[c * 64 + lane] = P; }
                        PCs[lane] = P; }
                      __builtin_amdgcn_wave_barrier(); asm volatile("s_waitcnt lgkmcnt(0)" ::: "memory");
                      u32x4 oa[4], orr[4], ob_[4], ok_[4];
#pragma unroll
                      for (int p4 = 0; p4 < 4; ++p4) { const int c = p4 * 8 + tk;
                          const f32x4 pa = *(const LAS f32x4*)(Pl + c * 64 + part * 8), pb2 = *(const LAS f32x4*)(Pl + c * 64 + part * 8 + 4);
                          f32x4 ma = {1.f, 1.f, 1.f, 1.f}, mb = ma; if (c > 0) { ma = *(const LAS f32x4*)(Pl + (c - 1) * 64 + part * 8); mb = *(const LAS f32x4*)(Pl + (c - 1) * 64 + part * 8 + 4); }
                          const float Pc[8] = {pa.x, pa.y, pa.z, pa.w, pb2.x, pb2.y, pb2.z, pb2.w}, Pm[8] = {ma.x, ma.y, ma.z, ma.w, mb.x, mb.y, mb.z, mb.w};
                          const unsigned rw_[4] = {qr[p4].x, qr[p4].y, qr[p4].z, qr[p4].w}, kw_[4] = {qk[p4].x, qk[p4].y, qk[p4].z, qk[p4].w}, kkw[4] = {qkk[p4].x, qkk[p4].y, qkk[p4].z, qkk[p4].w}, bw_[4] = {qb[p4].x, qb[p4].y, qb[p4].z, qb[p4].w};
                          unsigned xa[4], xr[4], xb[4], xk[4]; const float inv = qin[p4];
#pragma unroll
                          for (int i = 0; i < 4; ++i) { const float ip0 = __builtin_amdgcn_rcpf(Pc[2 * i]), ip1 = __builtin_amdgcn_rcpf(Pc[2 * i + 1]);
                              xa[i] = pk2(-__uint_as_float(kkw[i] << 16) * inv * Pm[2 * i], -__uint_as_float(kkw[i] & 0xffff0000u) * inv * Pm[2 * i + 1]);
                              xr[i] = pk2(__uint_as_float(rw_[i] << 16) * Pc[2 * i], __uint_as_float(rw_[i] & 0xffff0000u) * Pc[2 * i + 1]);
                              xb[i] = pk2(__uint_as_float(bw_[i] << 16) * inv * ip0, __uint_as_float(bw_[i] & 0xffff0000u) * inv * ip1);
                              xk[i] = pk2(__uint_as_float(kw_[i] << 16) * ip0, __uint_as_float(kw_[i] & 0xffff0000u) * ip1); }
                          oa[p4] = (u32x4){xa[0], xa[1], xa[2], xa[3]}; orr[p4] = (u32x4){xr[0], xr[1], xr[2], xr[3]}; ob_[p4] = (u32x4){xb[0], xb[1], xb[2], xb[3]}; ok_[p4] = (u32x4){xk[0], xk[1], xk[2], xk[3]}; }
                      __builtin_amdgcn_wave_barrier(); asm volatile("s_waitcnt lgkmcnt(0)" ::: "memory");
#pragma unroll
                      for (int p4 = 0; p4 < 4; ++p4) { const int c = p4 * 8 + tk, o = c * 72 + part * 8;
                          *(__attribute__((address_space(3))) u32x4*)(At + o) = oa[p4]; *(__attribute__((address_space(3))) u32x4*)(Rt + o) = orr[p4]; *(__attribute__((address_space(3))) u32x4*)(Bt + o) = ob_[p4];
                          *(__attribute__((address_space(3))) u32x4*)(Kt + o) = ok_[p4]; *(__attribute__((address_space(3))) u32x4*)(Vv + o) = qv[p4]; } }
                    __builtin_amdgcn_wave_barrier(); asm volatile("s_waitcnt lgkmcnt(0)" ::: "memory");
                    const f32x16 zero16 = {0.f, 0.f, 0.f, 0.f, 0.f, 0.f, 0.f, 0.f, 0.f, 0.f, 0.f, 0.f, 0.f, 0.f, 0.f, 0.f};
                    f32x16 X = zero16, Yt = zero16;
#pragma unroll
                    for (int ks = 0; ks < 4; ++ks) { const bf16x8_t fa = ldrow(At, r32, ks, hh), fb = ldrow(Bt, r32, ks, hh); X = mm32(fa, fb, X); Yt = mm32(fb, fa, Yt); }
#pragma unroll
                    for (int e = 0; e < 16; ++e) { const int ri = rowidx(e, hh); X[e] = (r32 < ri) ? X[e] : 0.f; Yt[e] = (ri < r32) ? Yt[e] : 0.f; }
                    f32x16 TY = Yt;
#pragma unroll
                    for (int e = 0; e < 16; ++e) TY[e] += (rowidx(e, hh) == r32) ? 1.f : 0.f;
#pragma unroll 1
                    for (int it = 0; it < 4; ++it) {
                        const bf16x8_t x0 = accop<0>(X), x1 = accop<1>(X), y0 = accop<0>(Yt), y1 = accop<1>(Yt);
                        f32x16 Xn = mm32(y0, x0, zero16); Xn = mm32(y1, x1, Xn);
                        f32x16 Yn = mm32(x0, y0, zero16); Yn = mm32(x1, y1, Yn);
                        X = Xn; Yt = Yn;
                        const bf16x8_t p0 = accop<0>(X), p1 = accop<1>(X), t0_ = accop<0>(TY), t1_ = accop<1>(TY);
                        TY = mm32(p0, t0_, TY); TY = mm32(p1, t1_, TY);
                    }
                    const bf16x8_t ty0 = accop<0>(TY), ty1 = accop<1>(TY);
                    unsigned char* rec = SCN + (size_t)item * 24576;
                    const bf16x8_t v00 = ldpermcol<0>(Vv, r32, hh), v01 = ldpermcol<1>(Vv, r32, hh), v10 = ldpermcol<0>(Vv, 32 + r32, hh), v11 = ldpermcol<1>(Vv, 32 + r32, hh);
                    f32x16 U0a, U0b;
                    { f32x16 G2T = zero16;
#pragma unroll
                      for (int ks = 0; ks < 4; ++ks) G2T = mm32(ldrow(Kt, r32, ks, hh), ldrow(At, r32, ks, hh), G2T);
#pragma unroll
                      for (int e = 0; e < 16; ++e) G2T[e] = (rowidx(e, hh) < r32) ? G2T[e] : 0.f;
                      const bf16x8_t g0 = accop<0>(G2T), g1 = accop<1>(G2T);
                      f32x16 Za = mm32(g0, v00, zero16); Za = mm32(g1, v01, Za); f32x16 Zb = mm32(g0, v10, zero16); Zb = mm32(g1, v11, Zb);
                      U0a = mm32(ty0, accop<0>(Za), zero16); U0a = mm32(ty1, accop<1>(Za), U0a); U0b = mm32(ty0, accop<0>(Zb), zero16); U0b = mm32(ty1, accop<1>(Zb), U0b); }
                    const bf16x8_t ua0 = accop<0>(U0a), ua1 = accop<1>(U0a), ub0 = accop<0>(U0b), ub1 = accop<1>(U0b);
                    f32x16 G3T = zero16;
                    { f32x16 G4T = zero16;
#pragma unroll
                      for (int ks = 0; ks < 4; ++ks) { const bf16x8_t fr = ldrow(Rt, r32, ks, hh); G3T = mm32(ldrow(Bt, r32, ks, hh), fr, G3T); G4T = mm32(ldrow(Kt, r32, ks, hh), fr, G4T); }
#pragma unroll
                      for (int e = 0; e < 16; ++e) { const bool keep = rowidx(e, hh) <= r32; G3T[e] = keep ? G3T[e] : 0.f; G4T[e] = keep ? G4T[e] : 0.f; }
                      const bf16x8_t g30 = accop<0>(G3T), g31 = accop<1>(G3T), g40 = accop<0>(G4T), g41 = accop<1>(G4T);
                      f32x16 Ya = mm32(g30, ua0, zero16); Ya = mm32(g31, ua1, Ya); Ya = mm32(g40, v00, Ya); Ya = mm32(g41, v01, Ya);
                      f32x16 Yb = mm32(g30, ub0, zero16); Yb = mm32(g31, ub1, Yb); Yb = mm32(g40, v10, Yb); Yb = mm32(g41, v11, Yb);
                      u32x4 o0, o1;
                      o0.x = cvtpk(Ya[0], Ya[1]); o0.y = cvtpk(Ya[2], Ya[3]); o0.z = cvtpk(Ya[4], Ya[5]); o0.w = cvtpk(Ya[6], Ya[7]);
                      o1.x = cvtpk(Ya[8], Ya[9]); o1.y = cvtpk(Ya[10], Ya[11]); o1.z = cvtpk(Ya[12], Ya[13]); o1.w = cvtpk(Ya[14], Ya[15]);
                      *(u32x4*)(rec + 12288 + 4096 + lane * 32) = o0; *(u32x4*)(rec + 12288 + 4096 + lane * 32 + 16) = o1;
                      o0.x = cvtpk(Yb[0], Yb[1]); o0.y = cvtpk(Yb[2], Yb[3]); o0.z = cvtpk(Yb[4], Yb[5]); o0.w = cvtpk(Yb[6], Yb[7]);
                      o1.x = cvtpk(Yb[8], Yb[9]); o1.y = cvtpk(Yb[10], Yb[11]); o1.z = cvtpk(Yb[12], Yb[13]); o1.w = cvtpk(Yb[14], Yb[15]);
                      *(u32x4*)(rec + 12288 + 6144 + 4096 + lane * 32) = o0; *(u32x4*)(rec + 12288 + 6144 + 4096 + lane * 32 + 16) = o1; }
                    f32x16 Wa0 = mm32(ty0, ldpermcol<0>(At, r32, hh), zero16); Wa0 = mm32(ty1, ldpermcol<1>(At, r32, hh), Wa0);
                    f32x16 Wa1 = mm32(ty0, ldpermcol<0>(At, 32 + r32, hh), zero16); Wa1 = mm32(ty1, ldpermcol<1>(At, 32 + r32, hh), Wa1);
                    const bf16x8_t wa00 = accop<0>(Wa0), wa01 = accop<1>(Wa0), wa10 = accop<0>(Wa1), wa11 = accop<1>(Wa1);
                    { const bf16x8_t g30 = accop<0>(G3T), g31 = accop<1>(G3T);
                      f32x16 Ra = mm32(wa00, g30, zero16); Ra = mm32(wa01, g31, Ra); f32x16 Rb_ = mm32(wa10, g30, zero16); Rb_ = mm32(wa11, g31, Rb_);
#pragma unroll
                      for (int e = 0; e < 16; ++e) { const int kr = rowidx(e, hh); Ra[e] += bf2f(Rt[r32 * 72 + kr]); Rb_[e] += bf2f(Rt[r32 * 72 + 32 + kr]); }
                      *(bf16x8_t*)(rec + 8192 + 0 * 1024 + lane * 16) = accop<0>(Ra); *(bf16x8_t*)(rec + 8192 + 1 * 1024 + lane * 16) = accop<1>(Ra);
                      *(bf16x8_t*)(rec + 8192 + 2 * 1024 + lane * 16) = accop<0>(Rb_); *(bf16x8_t*)(rec + 8192 + 3 * 1024 + lane * 16) = accop<1>(Rb_); }
                    const bf16x8_t b00 = ldpermcol<0>(Bt, r32, hh), b01 = ldpermcol<1>(Bt, r32, hh), b10 = ldpermcol<0>(Bt, 32 + r32, hh), b11 = ldpermcol<1>(Bt, 32 + r32, hh);
                    { const float pc0 = PCs[r32], pc1 = PCs[32 + r32];
#pragma unroll
                      for (int ij = 0; ij < 4; ++ij) { const int i = ij >> 1, j = ij & 1;
                          f32x16 M = mm32(i ? wa10 : wa00, j ? b10 : b00, zero16); M = mm32(i ? wa11 : wa01, j ? b11 : b01, M);
#pragma unroll
                          for (int e = 0; e < 16; ++e) { float m = M[e]; if (i == j) m += (rowidx(e, hh) == r32) ? 1.f : 0.f; M[e] = m * (j ? pc1 : pc0); }
                          *(bf16x8_t*)(rec + (ij * 2 + 0) * 1024 + lane * 16) = accop<0>(M); *(bf16x8_t*)(rec + (ij * 2 + 1) * 1024 + lane * 16) = accop<1>(M); } }
                    { const bf16x8_t k00 = ldpermcol<0>(Kt, r32, hh), k01 = ldpermcol<1>(Kt, r32, hh), k10 = ldpermcol<0>(Kt, 32 + r32, hh), k11 = ldpermcol<1>(Kt, 32 + r32, hh);
#pragma unroll
                      for (int ju = 0; ju < 4; ++ju) { const int j = ju >> 1, u = ju & 1;
                          f32x16 Dm = mm32(j ? b10 : b00, u ? ub0 : ua0, zero16); Dm = mm32(j ? b11 : b01, u ? ub1 : ua1, Dm);
                          Dm = mm32(j ? k10 : k00, u ? v10 : v00, Dm); Dm = mm32(j ? k11 : k01, u ? v11 : v01, Dm);
#pragma unroll
                          for (int e = 0; e < 16; ++e) Dm[e] *= PCs[32 * j + rowidx(e, hh)];
                          u32x4 o0, o1;
                          o0.x = cvtpk(Dm[0], Dm[1]); o0.y = cvtpk(Dm[2], Dm[3]); o0.z = cvtpk(Dm[4], Dm[5]); o0.w = cvtpk(Dm[6], Dm[7]);
                          o1.x = cvtpk(Dm[8], Dm[9]); o1.y = cvtpk(Dm[10], Dm[11]); o1.z = cvtpk(Dm[12], Dm[13]); o1.w = cvtpk(Dm[14], Dm[15]);
                          *(u32x4*)(rec + 12288 + u * 6144 + j * 2048 + lane * 32) = o0; *(u32x4*)(rec + 12288 + u * 6144 + j * 2048 + lane * 32 + 16) = o1; } }
                }
            }
        }
        { XcdBarrier xb_ = xbar; asm volatile("" : "+s"(xb_.bar)); xcd_barrier<false>(xb_); }
        if (IN(pb + 3)) { PHASE_IDS
            const int r32 = lane & 31, hh = lane >> 5;
            constexpr int SLOT = 18432, NCH = SEQ / 32, NSL = 7, AHEAD = 6;
            if (G > BATCH * NH * 2) { if (bx >= BATCH * NH * 2) convert_tables_fp8(INP(27), INP(28), U8, V8, USc, VSc, l, (bx - BATCH * NH * 2) * NWAVES + wave, (G - BATCH * NH * 2) * NWAVES, lane); }
            else convert_tables_fp8(INP(27), INP(28), U8, V8, USc, VSc, l, bx * NWAVES + wave, G * NWAVES, lane);
            for (int un = bx; un < BATCH * NH * 2; un += G) {
                const int bh = un >> 1, u = un & 1, b = bh >> 3, h = bh & 7;
                __syncthreads();
                const unsigned char* recs = SCN + (size_t)bh * NCH * 24576;
                const int lw = wave - 2;
#define S2_DMA(chunk_) do { if (wave >= 2) { LAS unsigned char* sl = lds + ((chunk_) % NSL) * SLOT; const unsigned char* rp = recs + (size_t)(chunk_) * 24576 + lane * 16; \
                    _Pragma("unroll") for (int q_ = 0; q_ < 3; ++q_) { const int p_ = lw * 3 + q_; const int so_ = p_ < 12 ? p_ * 1024 : 12288 + u * 6144 + (p_ - 12) * 1024; \
                        __builtin_amdgcn_global_load_lds((const unsigned*)(rp + so_), (LAS unsigned*)(sl + p_ * 1024), 16, 0, 0); } } } while (0)
#pragma unroll 1
                for (int c0 = 0; c0 < AHEAD; ++c0) S2_DMA(c0);
                asm volatile("s_waitcnt vmcnt(15)" ::: "memory");
                __builtin_amdgcn_s_barrier();
                f32x16 X0, X1;
#pragma unroll
                for (int e = 0; e < 16; ++e) { X0[e] = 0.f; X1[e] = 0.f; }
#define S2_FRAG(off) (*(const __attribute__((address_space(3))) bf16x8_t*)(sl + (off) + lane * 16))
#define S2_UNPK(dst, off) do { const u32x4 a0 = *(const LAS u32x4*)(sl + (off) + lane * 32), a1 = *(const LAS u32x4*)(sl + (off) + lane * 32 + 16); const unsigned wv[8] = {a0.x, a0.y, a0.z, a0.w, a1.x, a1.y, a1.z, a1.w}; \
                    _Pragma("unroll") for (int q = 0; q < 8; ++q) { (dst)[2 * q] = __uint_as_float(wv[q] << 16); (dst)[2 * q + 1] = __uint_as_float(wv[q] & 0xffff0000u); } } while (0)
#pragma unroll 1
                for (int n = 0; n < NCH; ++n) {
                    if (n + AHEAD < NCH) S2_DMA(n + AHEAD);
                    if (wave == 0) {
                        const LAS unsigned char* sl = lds + (n % NSL) * SLOT;
                        const bf16x8_t x00 = accop<0>(X0), x01 = accop<1>(X0), x10 = accop<0>(X1), x11 = accop<1>(X1);
                        f32x16 Yc, N0, N1;
                        S2_UNPK(Yc, 12288 + 4096); S2_UNPK(N0, 12288); S2_UNPK(N1, 12288 + 2048);
                        Yc = mm32(S2_FRAG(8192 + 0 * 1024), x00, Yc); Yc = mm32(S2_FRAG(8192 + 1 * 1024), x01, Yc); Yc = mm32(S2_FRAG(8192 + 2 * 1024), x10, Yc); Yc = mm32(S2_FRAG(8192 + 3 * 1024), x11, Yc);
                        N0 = mm32(S2_FRAG((0 * 2 + 0) * 1024), x00, N0); N0 = mm32(S2_FRAG((0 * 2 + 1) * 1024), x01, N0); N0 = mm32(S2_FRAG((2 * 2 + 0) * 1024), x10, N0); N0 = mm32(S2_FRAG((2 * 2 + 1) * 1024), x11, N0);
                        N1 = mm32(S2_FRAG((1 * 2 + 0) * 1024), x00, N1); N1 = mm32(S2_FRAG((1 * 2 + 1) * 1024), x01, N1); N1 = mm32(S2_FRAG((3 * 2 + 0) * 1024), x10, N1); N1 = mm32(S2_FRAG((3 * 2 + 1) * 1024), x11, N1);
                        X0 = N0; X1 = N1;
                        float* yp = Y + ((size_t)b * SEQ + (size_t)n * 32) * RW + h * HS + u * 32 + r32;
#pragma unroll
                        for (int e = 0; e < 16; ++e) yp[(size_t)rowidx(e, hh) * RW] = Yc[e];
                        asm volatile("s_waitcnt lgkmcnt(0)" ::: "memory");
                    } else if (wave >= 2) {
                        const int younger = (NCH - 1 - (n + 1)) < (AHEAD - 1) ? (NCH - 1 - (n + 1)) : (AHEAD - 1);
                        if (younger >= 5) asm volatile("s_waitcnt vmcnt(15)" ::: "memory"); else if (younger == 4) asm volatile("s_waitcnt vmcnt(12)" ::: "memory"); else if (younger == 3) asm volatile("s_waitcnt vmcnt(9)" ::: "memory");
                        else if (younger == 2) asm volatile("s_waitcnt vmcnt(6)" ::: "memory"); else if (younger == 1) asm volatile("s_waitcnt vmcnt(3)" ::: "memory"); else asm volatile("s_waitcnt vmcnt(0)" ::: "memory");
                    }
                    __builtin_amdgcn_s_barrier();
                }
#undef S2_FRAG
#undef S2_UNPK
#undef S2_DMA
            }
        }
        SEAM(pb + 3);

        if (IN(pb + 4)) { PHASE_IDS
            const int c8 = (tid & 63) * 8, hd = (tid & 63) >> 3, tsub = tid >> 6;
            const f32x4 lg0 = *(const f32x4*)(INP(19) + l * RW + c8), lg1 = *(const f32x4*)(INP(19) + l * RW + c8 + 4), lb0 = *(const f32x4*)(INP(20) + l * RW + c8), lb1 = *(const f32x4*)(INP(20) + l * RW + c8 + 4);
            for (int tile = bx; tile < T / 8; tile += G) {
                const int t = tile * 8 + tsub; const size_t o = (size_t)t * RW + c8;
                const f32x4 y0 = *(const f32x4*)(Y + o), y1 = *(const f32x4*)(Y + o + 4); const u32x4 gq = *(const u32x4*)(Gb + o), vq = *(const u32x4*)(BGb + o); const float bsum = BSUM[(size_t)t * NH + hd];
                float sm = (y0.x + y0.y) + (y0.z + y0.w) + (y1.x + y1.y) + (y1.z + y1.w);
                sm += dppf<0xB1>(sm); sm += dppf<0x4E>(sm); sm += dppf<0x141>(sm);
                const float mean = sm * (1.f / 64.f);
                const f32x4 d0 = y0 - mean, d1 = y1 - mean;
                float sq = (d0.x * d0.x + d0.y * d0.y) + (d0.z * d0.z + d0.w * d0.w) + (d1.x * d1.x + d1.y * d1.y) + (d1.z * d1.z + d1.w * d1.w);
                sq += dppf<0xB1>(sq); sq += dppf<0x4E>(sq); sq += dppf<0x141>(sq);
                const float rs = rsqrtf(sq * (1.f / 64.f) + GN_EPS);
                const f32x4 n0 = d0 * rs * lg0 + lb0, n1 = d1 * rs * lg1 + lb1;
                const unsigned gw_[4] = {gq.x, gq.y, gq.z, gq.w}, vw_[4] = {vq.x, vq.y, vq.z, vq.w}; const float nn[8] = {n0.x, n0.y, n0.z, n0.w, n1.x, n1.y, n1.z, n1.w}; unsigned ow[4];
#pragma unroll
                for (int i = 0; i < 4; ++i) { const float g0 = __uint_as_float(gw_[i] << 16), g1 = __uint_as_float(gw_[i] & 0xffff0000u), v0 = __uint_as_float(vw_[i] << 16), v1 = __uint_as_float(vw_[i] & 0xffff0000u);
                    ow[i] = pk2(nn[2 * i] * g0 + v0 * bsum, nn[2 * i + 1] * g1 + v1 * bsum); }
                *(u32x4*)(MIX + (size_t)t * D + c8) = (u32x4){ow[0], ow[1], ow[2], ow[3]};
            }
        }
        SEAM(pb + 4);
        if (IN(pb + 5)) { PHASE_IDS
            pg8::Gemm g{MIX, WoutT + (size_t)l * D * D, T, D, D}; pg8::StaticOrder S; S.init(T, D, G, bx);
            pg8::EpiResGate E{xin, X, modl + 2 * D};
            pg8::gemm_phase<pg8::EpiResGate, pg8::StaticOrder, true, true>(lds, g, S, E, tid); }
        SEAM(pb + 5);
        if (IN(pb + 6)) { PHASE_IDS const float* gamma = INP(24) + l * D;
            for (int row = gw; row < T; row += NGW) { const int b = row / SEQ; norm_mod_row(X + (size_t)row * D, gamma, modl + (size_t)b * 6 * D + 3 * D, modl + (size_t)b * 6 * D + 4 * D, H + (size_t)row * D, lane); } }
        SEAM(pb + 6);
        if (IN(pb + 7)) { PHASE_IDS
            pg8::Gemm g{H, PqT + (size_t)l * PH * PQ * D, T, PH * PQ, D}; pg8::StaticOrder S; S.init(T, PH * PQ, G, bx);
            pg8::EpiBf16<0> E{Q, PH * PQ, nullptr, 0, 0, 1.f};
            pg8::gemm_phase<pg8::EpiBf16<0>, pg8::StaticOrder, true, true>(lds, g, S, E, tid); }
        SEAM(pb + 7);

        if (IN(pb + 8)) { PHASE_IDS
            const bf16* KEYSl = KEYS + (size_t)l * PH * 2 * NKEYS * PHALF;
            LAS unsigned char* scr = lds + wave * 2048 + lane * 32;
            constexpr int KST = 136;
            lbf16* kl = (lbf16*)(lds + 16384);
            const int r = lane & 31, hh = lane >> 5;
            for (int item = bx; item < (T / 256) * PH; item += G) {
                const int h = item & 7, tok = (item >> 3) * 256 + wave * 32 + r;
                __syncthreads();
                { u32x4 kq[8];
#pragma unroll
                  for (int q = 0; q < 8; ++q) { const int ch = tid + q * NTHR; kq[q] = *(const u32x4*)(KEYSl + (size_t)(h * 2) * NKEYS * PHALF + (size_t)ch * 8); }
#pragma unroll
                  for (int q = 0; q < 8; ++q) { const int ch = tid + q * NTHR, row = ch >> 4, cc = ch & 15; *(__attribute__((address_space(3))) u32x4*)(kl + row * KST + cc * 8) = kq[q]; } }
                __syncthreads();
                unsigned sp0[16], sp1[16];
#pragma unroll
                for (int e = 0; e < 16; ++e) { sp0[e] = 0u; sp1[e] = 0u; }
#pragma unroll 1
                for (int p = 0; p < 2; ++p) {
                    const bf16* qp = Q + (size_t)tok * (PH * PQ) + h * PQ + p * PHALF + 8 * hh;
                    const lbf16* kp_ = kl + (p * NKEYS + r) * KST + 8 * hh;
                    bf16x8_t bq[8];
#pragma unroll
                    for (int ks = 0; ks < 8; ++ks) bq[ks] = *(const bf16x8_t*)(qp + ks * 16);
                    unsigned best[16];
#pragma unroll
                    for (int e = 0; e < 16; ++e) best[e] = 0u;
#pragma unroll 1
                    for (int kt = 0; kt < 4; ++kt) {
                        f32x16 acc;
#pragma unroll
                        for (int e = 0; e < 16; ++e) acc[e] = 0.f;
#pragma unroll
                        for (int ks = 0; ks < 8; ++ks) { const bf16x8_t ak = *(const __attribute__((address_space(3))) bf16x8_t*)(kp_ + kt * 32 * KST + ks * 16); acc = __builtin_amdgcn_mfma_f32_32x32x16_bf16(ak, bq[ks], acc, 0, 0, 0); }
                        unsigned g[16];
#pragma unroll
                        for (int e = 0; e < 16; ++e) g[e] = pack_key7(acc[e], kt * 32 + (e & 3) + 8 * (e >> 2) + 4 * hh);
                        sort16_desc(g);
                        merge_top16(best, g);
                    }
                    unsigned ob[16];
#pragma unroll
                    for (int e = 0; e < 16; ++e) ob[e] = shflxu(best[e], lane, 32);
                    merge_top16(best, ob);
#pragma unroll
                    for (int e = 0; e < 16; ++e) { sp0[e] = p == 0 ? best[e] : sp0[e]; sp1[e] = p == 0 ? sp1[e] : best[e]; }
                }
                unsigned c2[32];
                stage2_cands(sp0, sp1, hh, c2);
                sort16_desc(c2); sort16_desc(c2 + 16); merge_top16(c2, c2 + 16);
                { unsigned ob[16];
#pragma unroll
                  for (int e = 0; e < 16; ++e) ob[e] = shflxu(c2[e], lane, 32);
                  merge_top16(c2, ob); }
#pragma unroll
                for (int e = 0; e < 16; e += 4) {
                    *(LAS unsigned*)(scr + e) = (127u - (sp0[e] & 127u)) | ((127u - (sp0[e + 1] & 127u)) << 8) | ((127u - (sp0[e + 2] & 127u)) << 16) | ((127u - (sp0[e + 3] & 127u)) << 24);
                    *(LAS unsigned*)(scr + 16 + e) = (127u - (sp1[e] & 127u)) | ((127u - (sp1[e + 1] & 127u)) << 8) | ((127u - (sp1[e + 2] & 127u)) << 16) | ((127u - (sp1[e + 3] & 127u)) << 24); }
                asm volatile("s_waitcnt lgkmcnt(0)" ::: "memory");
                float sm[16]; int ex[16];
#pragma unroll
                for (int e = 0; e < 16; ++e) { const unsigned key = c2[e]; sm[e] = unpack_key8(key); const int i0 = (key >> 4) & 15, j0 = key & 15; ex[e] = (int)scr[i0] * NKEYS + (int)scr[16 + j0]; }
                float den = 0.f;
#pragma unroll
                for (int e = 0; e < 16; ++e) { sm[e] = expf(sm[e] - unpack_key8(c2[0])); den += sm[e]; }
                const float inv = 1.f / den;
                if (hh == 0) {
                    int* ip = IDX + (size_t)tok * NE + h * TOPK; float* gp = GATE + (size_t)tok * NE + h * TOPK;
#pragma unroll
                    for (int e = 0; e < 16; e += 4) { *(int4*)(ip + e) = make_int4(ex[e], ex[e + 1], ex[e + 2], ex[e + 3]); *(f32x4*)(gp + e) = (f32x4){sm[e] * inv, sm[e + 1] * inv, sm[e + 2] * inv, sm[e + 3] * inv}; }
                }
                asm volatile("s_waitcnt lgkmcnt(0)" ::: "memory");
            }
        }
        SEAM(pb + 8);

        if (IN(pb + 9)) { PHASE_IDS
            const unsigned char* Ul = U8 + (size_t)l * NEXP * D; const unsigned char* Vtl = V8 + (size_t)l * NEXP * D; const float* usl = USc + l * NEXP; const float* vsl = VSc + l * NEXP; const float* lnf = INP(29);
            const bool fin = (l == DEPTH - 1);
            typedef float f32x2_t __attribute__((ext_vector_type(2)));
            const __amdgpu_buffer_rsrc_t ru = __builtin_amdgcn_make_buffer_rsrc((void*)Ul, 0, NEXP * D, 0x00020000), rv = __builtin_amdgcn_make_buffer_rsrc((void*)Vtl, 0, NEXP * D, 0x00020000);
            const int voff = lane * 16;
            LAS float* pl = (LAS float*)(lds + wave * 8704);
            for (int t = gw; t < T; t += NGW) {
                const int b = t / SEQ;
                f32x2_t hf2[8];
                { const u32x4 h0 = *(const u32x4*)(H + (size_t)t * D + lane * 16), h1 = *(const u32x4*)(H + (size_t)t * D + lane * 16 + 8);
                  hf2[0] = (f32x2_t){__uint_as_float(h0.x << 16), __uint_as_float(h0.x & 0xffff0000u)}; hf2[1] = (f32x2_t){__uint_as_float(h0.y << 16), __uint_as_float(h0.y & 0xffff0000u)};
                  hf2[2] = (f32x2_t){__uint_as_float(h0.z << 16), __uint_as_float(h0.z & 0xffff0000u)}; hf2[3] = (f32x2_t){__uint_as_float(h0.w << 16), __uint_as_float(h0.w & 0xffff0000u)};
                  hf2[4] = (f32x2_t){__uint_as_float(h1.x << 16), __uint_as_float(h1.x & 0xffff0000u)}; hf2[5] = (f32x2_t){__uint_as_float(h1.y << 16), __uint_as_float(h1.y & 0xffff0000u)};
                  hf2[6] = (f32x2_t){__uint_as_float(h1.z << 16), __uint_as_float(h1.z & 0xffff0000u)}; hf2[7] = (f32x2_t){__uint_as_float(h1.w << 16), __uint_as_float(h1.w & 0xffff0000u)}; }
                f32x2_t acc2[8];
#pragma unroll
                for (int i = 0; i < 8; ++i) acc2[i] = (f32x2_t){0.f, 0.f};
                int myidx = IDX[(size_t)t * NE + (lane & 31)]; float mygate = GATE[(size_t)t * NE + (lane & 31)];
                float myus = usl[myidx], myvs = vsl[myidx];
#define ROWLD(dst, rs, ix, e) dst = __builtin_amdgcn_raw_buffer_load_b128(rs, voff, __builtin_amdgcn_readlane(ix, (e)) * D, 0)
#define LOADB(buf, rs, ix, e0) do { _Pragma("unroll") for (int j_ = 0; j_ < 4; ++j_) ROWLD((buf)[j_], rs, ix, (e0) + j_); __builtin_amdgcn_sched_barrier(0); } while (0)
#define CVT8(u) const f32x2_t u0 = __builtin_amdgcn_cvt_pk_f32_fp8((int)(u).x, false), u1 = __builtin_amdgcn_cvt_pk_f32_fp8((int)(u).x, true), u2 = __builtin_amdgcn_cvt_pk_f32_fp8((int)(u).y, false), u3 = __builtin_amdgcn_cvt_pk_f32_fp8((int)(u).y, true), \
                        u4 = __builtin_amdgcn_cvt_pk_f32_fp8((int)(u).z, false), u5 = __builtin_amdgcn_cvt_pk_f32_fp8((int)(u).z, true), u6 = __builtin_amdgcn_cvt_pk_f32_fp8((int)(u).w, false), u7 = __builtin_amdgcn_cvt_pk_f32_fp8((int)(u).w, true)
#define DOT1(u, dst) do { CVT8(u); f32x2_t a_ = hf2[0] * u0; a_ += hf2[1] * u1; a_ += hf2[2] * u2; a_ += hf2[3] * u3; a_ += hf2[4] * u4; a_ += hf2[5] * u5; a_ += hf2[6] * u6; a_ += hf2[7] * u7; dst = a_.x + a_.y; } while (0)
#define DOTB(buf, e0) do { _Pragma("unroll") for (int j_ = 0; j_ < 4; ++j_) { float d_; DOT1((buf)[j_], d_); pl[((e0) + j_) * 68 + lane] = d_; } } while (0)
#define AXPYB(buf, e0) do { _Pragma("unroll") for (int j_ = 0; j_ < 4; ++j_) { CVT8((buf)[j_]); const float cf = __int_as_float(__builtin_amdgcn_readlane(__float_as_int(coef), (e0) + j_)); \
                        acc2[0] += cf * u0; acc2[1] += cf * u1; acc2[2] += cf * u2; acc2[3] += cf * u3; acc2[4] += cf * u4; acc2[5] += cf * u5; acc2[6] += cf * u6; acc2[7] += cf * u7; } } while (0)
                u32x4 ba[4], bb_[4];
                LOADB(ba, ru, myidx, 0);
#pragma unroll 1
                for (int q = 0; q < 4; ++q) {
                    int nidx = 0; float ngate = 0.f;
                    if (q < 3) { nidx = IDX[(size_t)t * NE + (q + 1) * 32 + (lane & 31)]; ngate = GATE[(size_t)t * NE + (q + 1) * 32 + (lane & 31)]; }
#pragma unroll
                    for (int e0 = 0; e0 < 32; e0 += 8) {
                        LOADB(bb_, ru, myidx, e0 + 4); DOTB(ba, e0);
                        if (e0 + 8 < 32) LOADB(ba, ru, myidx, e0 + 8); else LOADB(ba, rv, myidx, 0);
                        DOTB(bb_, e0 + 4);
                    }
                    const float nus = usl[nidx], nvs = vsl[nidx];
                    __builtin_amdgcn_wave_barrier(); asm volatile("s_waitcnt lgkmcnt(0)" ::: "memory");
                    float dsum;
                    { const LAS float* rp = pl + (lane & 31) * 68 + (lane >> 5) * 32; f32x4 s4 = *(const LAS f32x4*)rp;
#pragma unroll
                      for (int j = 1; j < 8; ++j) s4 += *(const LAS f32x4*)(rp + j * 4);
                      dsum = (s4.x + s4.y) + (s4.z + s4.w); }
                    dsum += shflx(dsum, lane, 32);
                    __builtin_amdgcn_wave_barrier(); asm volatile("s_waitcnt lgkmcnt(0)" ::: "memory");
                    const float coef = mygate * gelu_erf(dsum * myus) * myvs;
#pragma unroll
                    for (int e0 = 0; e0 < 32; e0 += 8) {
                        LOADB(bb_, rv, myidx, e0 + 4); AXPYB(ba, e0);
                        if (e0 + 8 < 32) LOADB(ba, rv, myidx, e0 + 8); else if (q < 3) LOADB(ba, ru, nidx, 0);
                        AXPYB(bb_, e0 + 4);
                    }
                    myidx = nidx; mygate = ngate; myus = nus; myvs = nvs;
                }
#undef ROWLD
#undef LOADB
#undef CVT8
#undef DOTB
#undef DOT1
#undef AXPYB
                float* xr = X + (size_t)t * D + lane * 16; const float* g2 = modl + (size_t)b * 6 * D + 5 * D + lane * 16;
                f32x4 xv[4]; float ss = 0.f;
#pragma unroll
                for (int q = 0; q < 4; ++q) { const f32x4 xo = *(const f32x4*)(xr + q * 4), gg = *(const f32x4*)(g2 + q * 4);
                    xv[q] = xo + gg * (f32x4){acc2[q * 2].x, acc2[q * 2].y, acc2[q * 2 + 1].x, acc2[q * 2 + 1].y}; ss += (xv[q].x * xv[q].x + xv[q].y * xv[q].y) + (xv[q].z * xv[q].z + xv[q].w * xv[q].w); }
                const float rs = rsqrtf(wave_sum(ss, lane) * (1.f / D) + NORM_EPS);
                if (fin) {
#pragma unroll
                    for (int q = 0; q < 4; ++q) xv[q] = xv[q] * rs * *(const f32x4*)(lnf + lane * 16 + q * 4); }
                else {
                    const float* gam = INP(4) + (l + 1) * D + lane * 16; const float* mn = MOD + (size_t)(l + 1) * BATCH * 6 * D + (size_t)b * 6 * D + lane * 16; u32x4 ho[2];
#pragma unroll
                    for (int q = 0; q < 4; ++q) { const f32x4 y = xv[q] * rs * *(const f32x4*)(gam + q * 4) * (*(const f32x4*)(mn + D + q * 4) + 1.f) + *(const f32x4*)(mn + q * 4);
                        if (q & 1) { ho[q >> 1].z = pk2(y.x, y.y); ho[q >> 1].w = pk2(y.z, y.w); } else { ho[q >> 1].x = pk2(y.x, y.y); ho[q >> 1].y = pk2(y.z, y.w); } }
                    *(u32x4*)(H + (size_t)t * D + lane * 16) = ho[0]; *(u32x4*)(H + (size_t)t * D + lane * 16 + 8) = ho[1]; }
#pragma unroll
                for (int q = 0; q < 4; ++q) *(f32x4*)(xr + q * 4) = xv[q];
            }
        }
    }
#undef modl
#undef xin
#undef IN
#undef SEAM
}
#undef MOD
#undef H
#undef PROJ
#undef Q
#undef MIX
#undef Rb
#undef Kb
#undef V0
#undef V1
#undef KKb
#undef Bb
#undef Gb
#undef BGb
#undef Wd
#undef Y
#undef IDX
#undef GATE
#undef WinT
#undef WoutT
#undef PqT
#undef KEYS
#undef QB
#undef SH
#undef WUPT
#undef AUPT
#undef GUPT
#undef VUPT
#undef PWT
#undef INVN
#undef BSUM
#undef SCN
#undef U8
#undef V8
#undef USc
#undef VSc
#undef INP
#undef PHASE_IDS

extern "C" void kernel_launch(void* const* d_in, const int* in_sizes, int n_in, void* d_out, int out_size, void* d_ws, size_t ws_size, hipStream_t stream) {
    if (n_in != 30 || ws_size < WS_END) { fprintf(stderr, "kernel_launch: unexpected n_in %d / ws_size %zu\n", n_in, ws_size); return; }
    static int grid = 0;
    if (grid == 0) {
        int dev = 0, cus = 0, per_cu = 0;
        (void)hipGetDevice(&dev); (void)hipDeviceGetAttribute(&cus, hipDeviceAttributeMultiprocessorCount, dev);
        if (hipFuncSetAttribute((const void*)mega, hipFuncAttributeMaxDynamicSharedMemorySize, LDS_BYTES) != hipSuccess) { fprintf(stderr, "hipFuncSetAttribute failed\n"); grid = -1; return; }
        if (hipOccupancyMaxActiveBlocksPerMultiprocessor(&per_cu, (const void*)mega, NTHR, LDS_BYTES) != hipSuccess || per_cu < 1) { fprintf(stderr, "occupancy query failed (%d)\n", per_cu); per_cu = 1; }
        (void)hipGetLastError();
        grid = (cus > 0 ? cus : 256) * 1;
    }
    if (grid < 0) return;
    Args a{}; for (int i = 0; i < 30; ++i) a.in[i] = (const float*)d_in[i]; a.out = (float*)d_out; a.ws = (unsigned char*)d_ws;
    a.ph_lo = 0; a.ph_hi = NPH;
    if (hipMemsetAsync(d_ws, 0, 65536, stream) != hipSuccess) { fprintf(stderr, "memset failed\n"); return; }
    void* kargs[] = {&a};
    hipError_t e = hipLaunchCooperativeKernel((const void*)mega, dim3(grid), dim3(NTHR), kargs, LDS_BYTES, stream);
    if (e != hipSuccess) fprintf(stderr, "cooperative launch failed: %s (grid %d)\n", hipGetErrorString(e), grid);
}
```

```cpp
#include <hip/hip_runtime.h>
#include <hip/hip_cooperative_groups.h>
namespace cg = cooperative_groups;
#include <cstdio>
#include <cstdint>
#include <cmath>

constexpr int D = 1024, BATCH = 4, SEQ = 4096, T = BATCH * SEQ, DEPTH = 2;
constexpr int RW = 512, HS = 64, NH = 8;
constexpr int DL = 64, AL = 64, MVL = 32, GL = 128;
constexpr int RWKV_COLS = 3 * RW + DL + AL + GL;
constexpr int PW = 512, PG = 128;
constexpr int IN_COLS = RWKV_COLS + PW;
constexpr int LDP = 2560;
constexpr int NKEYS = 128, NEXP = NKEYS * NKEYS, PH = 8, PQ = 256, PHALF = 128, TOPK = 16;
constexpr int NE = PH * TOPK;
constexpr float NORM_EPS = 1e-6f, GN_EPS = 64e-5f;

typedef unsigned short bf16;
__device__ __forceinline__ float bf2f(bf16 u) { return __uint_as_float((unsigned)u << 16); }
typedef float cvt_f32x2 __attribute__((ext_vector_type(2))); typedef __bf16 cvt_bf16x2 __attribute__((ext_vector_type(2)));
__device__ __forceinline__ unsigned cvtpk(float lo, float hi) { const cvt_f32x2 v = {lo, hi}; const cvt_bf16x2 b = __builtin_convertvector(v, cvt_bf16x2); return __builtin_bit_cast(unsigned, b); }
__device__ __forceinline__ bf16 f2bf(float f) { return (bf16)cvtpk(f, 0.f); }

constexpr size_t MiB = 1u << 20;
constexpr size_t WS_MOD = 1 * MiB;
constexpr size_t WS_US = 1 * MiB + 256 * 1024;
constexpr size_t WS_VS = 1 * MiB + 512 * 1024;
constexpr size_t WS_H = 2 * MiB;
constexpr size_t WS_PROJ = 34 * MiB;
constexpr size_t WS_Q = WS_PROJ;
constexpr size_t WS_R = 114 * MiB;
constexpr size_t WS_K = 130 * MiB;
constexpr size_t WS_V0 = 146 * MiB;
constexpr size_t WS_V1 = 162 * MiB;
constexpr size_t WS_KK = 178 * MiB;
constexpr size_t WS_B = 194 * MiB;
constexpr size_t WS_G = 210 * MiB;
constexpr size_t WS_BG = 226 * MiB;
constexpr size_t WS_W = 242 * MiB;
constexpr size_t WS_Y = 274 * MiB;
constexpr size_t WS_MIX = 306 * MiB;
constexpr size_t WS_IDX = 338 * MiB;
constexpr size_t WS_GATE = 346 * MiB;
constexpr size_t WS_WIN_T = 354 * MiB;
constexpr size_t WS_WOUT_T = 364 * MiB;
constexpr size_t WS_PQ_T = 368 * MiB;
constexpr size_t WS_KEYS = 376 * MiB;
constexpr size_t WS_U = 378 * MiB;
constexpr size_t WS_V = 442 * MiB;
constexpr size_t WS_QB = 410 * MiB;
constexpr size_t WS_SH = 426 * MiB;
constexpr size_t WS_LORA = 428 * MiB;
constexpr size_t WS_INVN = 430 * MiB;
constexpr size_t WS_BSUM = 431 * MiB;
constexpr size_t WS_SCN = 2 * MiB;
constexpr size_t WS_END = 506 * MiB;

template <int CTRL> __device__ __forceinline__ float dppf(float x) { return __int_as_float(__builtin_amdgcn_update_dpp(0, __float_as_int(x), CTRL, 0xF, 0xF, false)); }
__device__ __forceinline__ float red16(float x) { x += dppf<0xB1>(x); x += dppf<0x4E>(x); x += dppf<0x141>(x); x += dppf<0x140>(x); return x; }
__device__ __forceinline__ float shflx(float v, int lane, int off) { return __int_as_float(__builtin_amdgcn_ds_bpermute((lane ^ off) << 2, __float_as_int(v))); }
__device__ __forceinline__ unsigned shflxu(unsigned v, int lane, int off) { return (unsigned)__builtin_amdgcn_ds_bpermute((lane ^ off) << 2, (int)v); }
__device__ __forceinline__ float wave_sum(float v, int lane) { v = red16(v); v += shflx(v, lane, 16); v += shflx(v, lane, 32); return v; }
__device__ __forceinline__ float sigmoidf_(float x) { return 1.f / (1.f + expf(-x)); }

namespace pg8 {
#define PG8_LAS __attribute__((address_space(3)))
typedef unsigned short bf16_t;
typedef short bf16x8 __attribute__((ext_vector_type(8)));
typedef float f32x4 __attribute__((ext_vector_type(4)));
typedef unsigned u32x4 __attribute__((ext_vector_type(4)));
constexpr int BM = 256, BK = 64, HALF = 128, HTB = HALF * BK * 2  , STAGE_BYTES = 8 * HTB, NXCD = 8, WGM = 8;

__host__ __device__ __forceinline__ int lds_byte(int r, int c) { const int st = (r >> 4) * 2 + (c >> 5), rr = r & 15, cc = c & 31, ob = rr * 64 + cc * 2; return st * 1024 + (ob ^ (((ob >> 9) & 1) << 5)); }
__host__ __device__ __forceinline__ void stage_rc(int b, int& R, int& C) { const int st = b / 1024, sb = b % 1024, swz = sb ^ (((sb >> 9) & 1) << 5); R = (st >> 1) * 16 + swz / 64; C = (st & 1) * 32 + (swz % 64) / 2; }
__host__ __device__ __forceinline__ int perm32(int rho) { const int n = rho >> 4, i = rho & 15; return 8 * (i >> 2) + 4 * n + (i & 3); }

struct Unit { int pm, pn; };
struct Gemm { const bf16_t* A; const bf16_t* Bt; int M, N, K; };

struct StaticOrder {
    int nM, nN, nwg, G, c;
    __host__ __device__ void init(int M, int N, int G_, int c_) { nM = M / BM; nN = N / BM; nwg = nM * nN; G = G_; c = c_; }
    __host__ __device__ bool next(int i, Unit& u) const {
        const long L = (long)i * G + c; if (L >= nwg) return false;
        int wgid = (int)L; { const int q = nwg / NXCD, r = nwg % NXCD, xcd = wgid % NXCD, off = wgid / NXCD; wgid = (xcd < r ? xcd * (q + 1) : r * (q + 1) + (xcd - r) * q) + off; }
        const int nig = WGM * nN, gid = wgid / nig, fm = gid * WGM, gsz = (nM - fm) < WGM ? (nM - fm) : WGM;
        u.pm = fm + ((wgid % nig) % gsz); u.pn = (wgid % nig) / gsz; return true;
    }
    __device__ __forceinline__ void a_ready(const Unit&) const {}
    __device__ __forceinline__ void done(const Unit&) const {}
};

__device__ __forceinline__ unsigned cvt_pk_bf16(float lo, float hi) { unsigned r; asm volatile("v_cvt_pk_bf16_f32 %0, %1, %2" : "=v"(r) : "v"(lo), "v"(hi)); return r; }
typedef float f32x2 __attribute__((ext_vector_type(2)));
__device__ __forceinline__ f32x2 gelu_pk(f32x2 v) {
    const f32x2 av = __builtin_elementwise_abs(v), d = av * 0.2316418882f + 1.0f;
    f32x2 t; t.x = __builtin_amdgcn_rcpf(d.x); t.y = __builtin_amdgcn_rcpf(d.y);
    f32x2 q = t * 0.5307027145f + (-0.7265760135f); q = q * t + 0.7107068705f; q = q * t + (-0.142248368f); q = q * t + 0.127414796f; q = q * t;
    const f32x2 s = (v * v) * (-0.72134752044f);
    f32x2 e; e.x = __builtin_amdgcn_exp2f(s.x); e.y = __builtin_amdgcn_exp2f(s.y);
    const f32x2 m = v * (q * e), r = v - m;
    f32x2 o; o.x = v.x < 0.f ? m.x : r.x; o.y = v.y < 0.f ? m.y : r.y; return o;
}

template <int ACT  > struct EpiBf16 {
    static constexpr bool PERM = true, AFTER_DRAIN = false; static_assert(ACT == 0 || ACT == 1, "EpiBf16: ACT is 0 (none) or 1 (gelu_pk)");
    bf16_t* O; int ldc; const float* bias; int split_cols; size_t split_stride; float scale0;
    __device__ __forceinline__ void operator()(const f32x4 (&acc)[2][2][4][2], const Unit& u, int wr, int wc, int fr, int fq) const {
        const int row0 = u.pm * BM + wr * 64 + fr; int colt = u.pn * BM; bf16_t* base = O;
        float sc = 1.f; if (split_cols) { const int t = colt / split_cols; base += (size_t)t * split_stride; colt -= t * split_cols; if (t == 0) sc = scale0; }
        const int col0 = colt + wc * 32 + 8 * fq, bcol0 = u.pn * BM + wc * 32 + 8 * fq;
        f32x4 bv[2][2];
#pragma unroll
        for (int bj = 0; bj < 2; ++bj)
#pragma unroll
            for (int n = 0; n < 2; ++n) bv[bj][n] = bias ? *(const f32x4*)(bias + bcol0 + bj * HALF + 4 * n) : (f32x4){0.f, 0.f, 0.f, 0.f};
#pragma unroll
        for (int ai = 0; ai < 2; ++ai)
#pragma unroll
            for (int m = 0; m < 4; ++m) { bf16_t* rowp = base + (size_t)(row0 + ai * HALF + m * 16) * ldc + col0;
#pragma unroll
                for (int bj = 0; bj < 2; ++bj) { f32x4 v0 = acc[ai][bj][m][0] + bv[bj][0], v1 = acc[ai][bj][m][1] + bv[bj][1];
                    if (ACT == 1) { f32x2 a = gelu_pk((f32x2){v0[0], v0[1]}), b = gelu_pk((f32x2){v0[2], v0[3]}), c = gelu_pk((f32x2){v1[0], v1[1]}), d = gelu_pk((f32x2){v1[2], v1[3]});
                        v0 = (f32x4){a.x, a.y, b.x, b.y}; v1 = (f32x4){c.x, c.y, d.x, d.y}; }
                    v0 = v0 * sc; v1 = v1 * sc; u32x4 w; w.x = cvt_pk_bf16(v0[0], v0[1]); w.y = cvt_pk_bf16(v0[2], v0[3]); w.z = cvt_pk_bf16(v1[0], v1[1]); w.w = cvt_pk_bf16(v1[2], v1[3]);
                    *(u32x4*)(rowp + bj * HALF) = w; } }
    }
};

struct EpiResGate {
    static constexpr bool PERM = false, AFTER_DRAIN = false;
    const float* xold; float* X; const float* gate;
    __device__ __forceinline__ void operator()(const f32x4 (&acc)[2][2][4][2], const Unit& u, int wr, int wc, int fr, int fq) const {
        const int col0 = u.pn * BM + wc * 32 + 4 * fq; const int b = (u.pm * BM) / SEQ;
        const float* gp = gate + (size_t)b * 6 * D + col0;
#pragma unroll
        for (int bj = 0; bj < 2; ++bj)
#pragma unroll
            for (int n = 0; n < 2; ++n) { const f32x4 gv = *(const f32x4*)(gp + bj * HALF + n * 16);
#pragma unroll
                for (int ai = 0; ai < 2; ++ai)
#pragma unroll
                    for (int m = 0; m < 4; ++m) { const size_t off = (size_t)(u.pm * BM + ai * HALF + wr * 64 + m * 16 + fr) * D + col0 + bj * HALF + n * 16;
                        const f32x4 xo = *(const f32x4*)(xold + off); *(f32x4*)(X + off) = xo + gv * acc[ai][bj][m][n]; } }
    }
};
template <class Epi, class Sched, bool ALIGN_EPI = false, bool SP2 = false>
__device__ __forceinline__ void gemm_phase(PG8_LAS unsigned char* lds, const Gemm g, const Sched& S, const Epi& E, int tid) {
    asm volatile("" : "+v"(tid));
    const int wid = __builtin_amdgcn_readfirstlane(tid >> 6), lane = tid & 63, wr = wid >> 2, wc = wid & 3, fr = lane & 15, fq = lane >> 4;
    const int K = g.K, nt = K / BK;
    unsigned voffA[2], voffB[2];
#pragma unroll
    for (int i = 0; i < 2; ++i) { int R, C; stage_rc(tid * 16 + i * 8192, R, C); const int Rb = Epi::PERM ? ((R & ~31) + perm32(R & 31)) : R;
        voffA[i] = (unsigned)(R * K + C) * 2u; voffB[i] = (unsigned)(Rb * K + C) * 2u; }
    const size_t kstep = (size_t)(BK * 2);
    const size_t hstep = (size_t)HALF * K * 2;
    const size_t tstep = 2 * hstep;
    const unsigned ldsw = (unsigned)wid * 1024u;
    const int aoff = lds_byte(wr * 64 + fr, fq * 8), boff = lds_byte(wc * 32 + fr, fq * 8);
#define PG8_SA(b, h) (((b) * 2 + (h)) * HTB)
#define PG8_SB(b, h) ((4 + (b) * 2 + (h)) * HTB)
#define PG8_STAGE(bufoff, gbase, voff) do { _Pragma("unroll") for (int _i = 0; _i < 2; ++_i) \
        __builtin_amdgcn_global_load_lds((const unsigned*)((const char*)(gbase) + (voff)[_i]), (PG8_LAS unsigned*)(lds + (bufoff) + ldsw + _i * 8192), 16, 0, 0); } while (0)
#define PG8_LDA(dst, b, h) do { _Pragma("unroll") for (int m = 0; m < 4; ++m) _Pragma("unroll") for (int k = 0; k < 2; ++k) dst[m][k] = *(const PG8_LAS bf16x8*)(lds + PG8_SA(b, h) + aoff + m * 2048 + k * 1024); } while (0)
#define PG8_LDB(dst, b, h) do { _Pragma("unroll") for (int n = 0; n < 2; ++n) _Pragma("unroll") for (int k = 0; k < 2; ++k) dst[n][k] = *(const PG8_LAS bf16x8*)(lds + PG8_SB(b, h) + boff + n * 2048 + k * 1024); } while (0)
#define PG8_MMA(ai, bj, At, Bt) do { __builtin_amdgcn_s_setprio(1); _Pragma("unroll") for (int m = 0; m < 4; ++m) _Pragma("unroll") for (int n = 0; n < 2; ++n) _Pragma("unroll") for (int k = 0; k < 2; ++k) \
        acc[ai][bj][m][n] = __builtin_amdgcn_mfma_f32_16x16x32_bf16(Bt[n][k], At[m][k], acc[ai][bj][m][n], 0, 0, 0); __builtin_amdgcn_s_setprio(0); } while (0)
#define PG8_WAIT_V(n) asm volatile("s_waitcnt vmcnt(" #n ")" ::: "memory")
#define PG8_WAIT_L(n) asm volatile("s_waitcnt lgkmcnt(" #n ")" ::: "memory")
#define PG8_BAR __builtin_amdgcn_s_barrier()
#define PG8_SCHED __builtin_amdgcn_sched_barrier(0)
    Unit cur, nxt; int ui = 0;
    if (!S.next(0, cur)) return;
    f32x4 acc[2][2][4][2];
#pragma unroll
    for (int a = 0; a < 2; ++a)
#pragma unroll
        for (int b = 0; b < 2; ++b)
#pragma unroll
            for (int m = 0; m < 4; ++m)
#pragma unroll
                for (int n = 0; n < 2; ++n) acc[a][b][m][n] = (f32x4){0.f, 0.f, 0.f, 0.f};
    bf16x8 At[4][2], B0[2][2], B1[2][2];
    const char* cA = (const char*)g.A + (size_t)cur.pm * tstep; const char* cB = (const char*)g.Bt + (size_t)cur.pn * tstep;
    S.a_ready(cur);
    if constexpr (SP2) {
        PG8_STAGE(PG8_SB(0, 0), cB, voffB); PG8_STAGE(PG8_SB(0, 1), cB + hstep, voffB); PG8_STAGE(PG8_SA(0, 0), cA, voffA); PG8_STAGE(PG8_SA(0, 1), cA + hstep, voffA);
        if (wr == 1) PG8_BAR;
        PG8_WAIT_V(2); PG8_BAR;
        PG8_STAGE(PG8_SB(1, 0), cB + kstep, voffB); PG8_STAGE(PG8_SA(1, 0), cA + kstep, voffA); PG8_STAGE(PG8_SB(1, 1), cB + hstep + kstep, voffB);
        PG8_WAIT_V(6); PG8_BAR;
    } else {
        PG8_STAGE(PG8_SB(0, 0), cB, voffB); PG8_STAGE(PG8_SA(0, 0), cA, voffA); PG8_STAGE(PG8_SB(0, 1), cB + hstep, voffB); PG8_STAGE(PG8_SA(0, 1), cA + hstep, voffA);
        if (wr == 1) PG8_BAR;
        PG8_WAIT_V(4); PG8_BAR;
        PG8_STAGE(PG8_SB(1, 0), cB + kstep, voffB); PG8_STAGE(PG8_SA(1, 0), cA + kstep, voffA); PG8_STAGE(PG8_SB(1, 1), cB + hstep + kstep, voffB);
        PG8_WAIT_V(6); PG8_BAR;
    }
    for (;;) {
        const bool has_next = S.next(ui + 1, nxt);
        const char* nA = has_next ? (const char*)g.A + (size_t)nxt.pm * tstep : cA; const char* nB = has_next ? (const char*)g.Bt + (size_t)nxt.pn * tstep : cB;
        for (int t = 0; t < nt; t += 2) {
            const bool last = (t == nt - 2);
            const char* a1 = cA + (size_t)(t + 1) * kstep;
            const char* a2 = last ? nA : cA + (size_t)(t + 2) * kstep; const char* b2 = last ? nB : cB + (size_t)(t + 2) * kstep;
            const char* a3 = a2 + kstep; const char* b3 = b2 + kstep;
            if (last && has_next) S.a_ready(nxt);
            if constexpr (SP2) {
            PG8_LDB(B0, 0, 0); PG8_LDB(B1, 0, 1); PG8_SCHED; PG8_LDA(At, 0, 0); PG8_STAGE(PG8_SA(1, 1), a1 + hstep, voffA);
            PG8_WAIT_V(8); PG8_WAIT_L(0); PG8_BAR; PG8_MMA(0, 0, At, B0); PG8_MMA(0, 1, At, B1); PG8_BAR; PG8_SCHED;
            PG8_LDA(At, 0, 1); PG8_STAGE(PG8_SB(0, 0), b2, voffB); PG8_STAGE(PG8_SB(0, 1), b2 + hstep, voffB); PG8_STAGE(PG8_SA(0, 0), a2, voffA);
            PG8_WAIT_V(8); PG8_WAIT_L(0); PG8_BAR; PG8_MMA(1, 0, At, B0); PG8_MMA(1, 1, At, B1); PG8_BAR; PG8_SCHED;
            PG8_LDB(B0, 1, 0); PG8_LDB(B1, 1, 1); PG8_SCHED; PG8_LDA(At, 1, 0); PG8_STAGE(PG8_SA(0, 1), a2 + hstep, voffA);
            PG8_WAIT_V(8); PG8_WAIT_L(0); PG8_BAR; PG8_MMA(0, 0, At, B0); PG8_MMA(0, 1, At, B1); PG8_BAR; PG8_SCHED;
            PG8_LDA(At, 1, 1); PG8_STAGE(PG8_SB(1, 0), b3, voffB); PG8_STAGE(PG8_SB(1, 1), b3 + hstep, voffB); PG8_STAGE(PG8_SA(1, 0), a3, voffA);
            PG8_WAIT_V(8); PG8_WAIT_L(0); PG8_BAR; PG8_MMA(1, 0, At, B0); PG8_MMA(1, 1, At, B1); PG8_BAR; PG8_SCHED;
            } else {
            PG8_LDB(B0, 0, 0); PG8_SCHED; PG8_LDA(At, 0, 0); PG8_STAGE(PG8_SA(1, 1), a1 + hstep, voffA);
            PG8_WAIT_L(8); PG8_BAR; PG8_WAIT_L(0); PG8_MMA(0, 0, At, B0); PG8_BAR; PG8_SCHED;
            PG8_LDB(B1, 0, 1); PG8_STAGE(PG8_SB(0, 0), b2, voffB);
            PG8_BAR; PG8_WAIT_L(0); PG8_MMA(0, 1, At, B1); PG8_BAR;
            PG8_LDA(At, 0, 1); PG8_STAGE(PG8_SA(0, 0), a2, voffA);
            PG8_BAR; PG8_WAIT_L(0); PG8_MMA(1, 0, At, B0); PG8_BAR; PG8_SCHED;
            PG8_STAGE(PG8_SB(0, 1), b2 + hstep, voffB);
            PG8_WAIT_V(6); PG8_BAR; PG8_MMA(1, 1, At, B1); PG8_BAR;
            PG8_LDB(B0, 1, 0); PG8_SCHED; PG8_LDA(At, 1, 0); PG8_STAGE(PG8_SA(0, 1), a2 + hstep, voffA);
            PG8_WAIT_L(8); PG8_BAR; PG8_WAIT_L(0); PG8_MMA(0, 0, At, B0); PG8_BAR; PG8_SCHED;
            PG8_LDB(B1, 1, 1); PG8_STAGE(PG8_SB(1, 0), b3, voffB);
            PG8_BAR; PG8_WAIT_L(0); PG8_MMA(0, 1, At, B1); PG8_BAR;
            PG8_LDA(At, 1, 1); PG8_STAGE(PG8_SA(1, 0), a3, voffA);
            PG8_BAR; PG8_WAIT_L(0); PG8_MMA(1, 0, At, B0); PG8_BAR; PG8_SCHED;
            PG8_STAGE(PG8_SB(1, 1), b3 + hstep, voffB);
            PG8_WAIT_V(6); PG8_BAR; PG8_MMA(1, 1, At, B1); PG8_BAR;
            }
        }
        if constexpr (ALIGN_EPI) { if (wr == 0) PG8_BAR; }
        if constexpr (!Epi::AFTER_DRAIN) { int le_; asm volatile("v_mbcnt_lo_u32_b32 %0, -1, 0\n\tv_mbcnt_hi_u32_b32 %0, -1, %0" : "=v"(le_)); E(acc, cur, wr, wc, le_ & 15, le_ >> 4); S.done(cur); }
        if (!has_next) break;
#pragma unroll
        for (int a = 0; a < 2; ++a)
#pragma unroll
            for (int b = 0; b < 2; ++b)
#pragma unroll
                for (int m = 0; m < 4; ++m)
#pragma unroll
                    for (int n = 0; n < 2; ++n) acc[a][b][m][n] = (f32x4){0.f, 0.f, 0.f, 0.f};
        cur = nxt; cA = nA; cB = nB; ++ui;
        if constexpr (ALIGN_EPI) { if (wr == 1) PG8_BAR; }
    }
    PG8_WAIT_V(0);
    if constexpr (!ALIGN_EPI) { if (wr == 0) PG8_BAR; }
    PG8_BAR;
    if constexpr (Epi::AFTER_DRAIN) { E.fused(acc, cur, wr, wc, fr, fq, lds, wid, lane); S.done(cur); }
#undef PG8_SA
#undef PG8_SB
#undef PG8_STAGE
#undef PG8_LDA
#undef PG8_LDB
#undef PG8_MMA
#undef PG8_WAIT_V
#undef PG8_WAIT_L
#undef PG8_BAR
#undef PG8_SCHED
}
}

#define LAS __attribute__((address_space(3)))
constexpr int NWAVES = 8, NTHR = 512;
constexpr int LDS_BYTES = 147456;
constexpr int NPH = 21;
typedef float f32x4 __attribute__((ext_vector_type(4)));
typedef unsigned u32x4 __attribute__((ext_vector_type(4)));

struct Args { const float* in[30]; float* out; unsigned char* ws; int ph_lo, ph_hi; };

__device__ __forceinline__ unsigned pk2(float lo, float hi) { return cvtpk(lo, hi); }

__device__ __forceinline__ void p0_transpose_item(const float* W, int K, int N, bf16* WT, int row_off, LAS float* scr, int item, int lane) {
    const int nblk = N / 32, kb = item / nblk, nb = item % nblk, k0 = 64 * kb, n0 = 32 * nb;
#pragma unroll 8
    for (int i = 0; i < 32; ++i) { const int kk = 2 * i + (lane >> 5); scr[kk * 33 + (lane & 31)] = W[(size_t)(k0 + kk) * N + n0 + (lane & 31)]; }
    asm volatile("s_waitcnt lgkmcnt(0)" ::: "memory");
    const int c = lane & 7;
#pragma unroll
    for (int j = 0; j < 4; ++j) { const int n = (lane >> 3) + 8 * j; const LAS float* s = scr + (8 * c) * 33 + n;
        u32x4 o; o.x = pk2(s[0 * 33], s[1 * 33]); o.y = pk2(s[2 * 33], s[3 * 33]); o.z = pk2(s[4 * 33], s[5 * 33]); o.w = pk2(s[6 * 33], s[7 * 33]);
        *(u32x4*)(WT + (size_t)(row_off + n0 + n) * K + k0 + 8 * c) = o; }
    asm volatile("s_waitcnt lgkmcnt(0)" ::: "memory");
}

__device__ __forceinline__ void norm_mod_row(const float* xr, const float* gamma, const float* sh, const float* sc, bf16* orow, int lane) {
    f32x4 v[4]; float ss = 0.f;
#pragma unroll
    for (int j = 0; j < 4; ++j) { v[j] = *(const f32x4*)(xr + j * 256 + lane * 4); ss += (v[j].x * v[j].x + v[j].y * v[j].y) + (v[j].z * v[j].z + v[j].w * v[j].w); }
    const float rs = rsqrtf(wave_sum(ss, lane) * (1.f / D) + NORM_EPS);
#pragma unroll
    for (int j = 0; j < 4; ++j) { const int d = j * 256 + lane * 4; const f32x4 g = *(const f32x4*)(gamma + d), a = *(const f32x4*)(sc + d), s = *(const f32x4*)(sh + d);
        const f32x4 y = v[j] * rs * g * (a + 1.f) + s; uint2 o; o.x = pk2(y.x, y.y); o.y = pk2(y.z, y.w); *(uint2*)(orow + d) = o; }
}


#define XB_TMO      128
#define XB_XCNT(j)  (256  + 64 * (j))
#define XB_XSUB(j)  (1280 + 64 * (j))
#define XB_XGEN(j)  (2304 + 64 * (j))
#define XB_TOP      3328
#define XB_TOPGEN   3392
#define XCD_BAR_WORDS 3456
#define XB_SPIN_CAP (1u << 18)

__device__ __forceinline__ unsigned xb_ld(unsigned* p)              { return __hip_atomic_load(p, __ATOMIC_RELAXED, __HIP_MEMORY_SCOPE_AGENT); }
__device__ __forceinline__ unsigned xb_add(unsigned* p, unsigned v) { return __hip_atomic_fetch_add(p, v, __ATOMIC_RELAXED, __HIP_MEMORY_SCOPE_AGENT); }
__device__ __forceinline__ unsigned xb_xcc_id() { return (unsigned)__builtin_amdgcn_s_getreg((3 << 11) | 20) & 0xFu; }
#define XB_SPIN(cond, bar) do { unsigned _sp = 0; while (cond) { __builtin_amdgcn_s_sleep(1); \
    if ((++_sp & 255u) == 0u) { if (xb_ld(&(bar)[XB_TMO])) break; if (_sp > XB_SPIN_CAP) { atomicAdd(&(bar)[XB_TMO], 1u); break; } } } } while (0)

struct XcdBarrier {
    unsigned* bar; unsigned x; int w0;
    volatile __attribute__((address_space(3))) unsigned* st;
};

__device__ __forceinline__ XcdBarrier xcd_barrier_post(unsigned* bar, volatile __attribute__((address_space(3))) unsigned* st) {
    XcdBarrier b; b.bar = bar; b.x = xb_xcc_id(); b.st = st; b.w0 = __builtin_amdgcn_readfirstlane((int)threadIdx.x >> 6);
    if (threadIdx.x == 0) (void)xb_add(&bar[XB_XCNT(b.x)], 1u);
    return b;
}
__device__ __forceinline__ void xcd_barrier_complete(unsigned* bar, unsigned x, unsigned& nloc, unsigned& nx) {
    const unsigned G = gridDim.x * gridDim.y * gridDim.z;
    unsigned sum, cnt, mine, sp = 0u;
    for (;;) {
        sum = 0u; cnt = 0u; mine = 0u;
#pragma unroll
        for (unsigned j = 0; j < 16; ++j) { const unsigned c = xb_ld(&bar[XB_XCNT(j)]); sum += c; cnt += (c > 0u) ? 1u : 0u; }
        mine = xb_ld(&bar[XB_XCNT(x)]);
        if (sum == G) break;
        __builtin_amdgcn_s_sleep(1);
        if ((++sp & 255u) == 0u) { if (xb_ld(&bar[XB_TMO])) break; if (sp > XB_SPIN_CAP) { atomicAdd(&bar[XB_TMO], 1u); break; } }
    }
    nloc = mine > 0u ? mine : 1u; nx = cnt > 0u ? cnt : 1u;
}

template <bool FIRST> __device__ __forceinline__ void xcd_barrier(const XcdBarrier& b) {
    asm volatile("s_waitcnt vmcnt(0)" ::: "memory");
    __syncthreads();
    int lid_; asm volatile("v_mbcnt_lo_u32_b32 %0, -1, 0\n\tv_mbcnt_hi_u32_b32 %0, -1, %0" : "=v"(lid_));
    if (b.w0 == 0 && lid_ == 0) {
        unsigned* bar = b.bar;
        __builtin_amdgcn_s_waitcnt(0);
        unsigned nloc = b.st[0], nx = b.st[1];
        if (FIRST && nloc == 0u) { xcd_barrier_complete(bar, b.x, nloc, nx); b.st[0] = nloc; b.st[1] = nx; }
        const unsigned old = xb_add(&bar[XB_XSUB(b.x)], 1u);
        const unsigned gen = old / nloc;
        if (old + 1u == (gen + 1u) * nloc) {
            __builtin_amdgcn_fence(__ATOMIC_RELEASE, "agent");
            asm volatile("s_waitcnt vmcnt(0)" ::: "memory");
            const unsigned og = xb_add(&bar[XB_TOP], 1u);
            const unsigned tg = og / nx;
            if (og + 1u == (tg + 1u) * nx) xb_add(&bar[XB_TOPGEN], 1u);
            else XB_SPIN(xb_ld(&bar[XB_TOPGEN]) == tg, bar);
            __builtin_amdgcn_fence(__ATOMIC_ACQUIRE, "agent");
            xb_add(&bar[XB_XGEN(b.x)], 1u);
            asm volatile("s_waitcnt vmcnt(0)" ::: "memory");
        } else {
            XB_SPIN(xb_ld(&bar[XB_XGEN(b.x)]) == gen, bar);
            __builtin_amdgcn_fence(__ATOMIC_ACQUIRE, "agent");
            asm volatile("s_waitcnt vmcnt(0)" ::: "memory");
        }
    }
    __syncthreads();
}


__device__ __forceinline__ unsigned mono_u32(float f) { unsigned u = __float_as_uint(f); return (u & 0x80000000u) ? ~u : (u | 0x80000000u); }
__device__ __forceinline__ float demono_u32(unsigned u) { return __uint_as_float((u & 0x80000000u) ? (u & 0x7FFFFFFFu) : ~u); }
__device__ __forceinline__ unsigned pack_key7(float f, int idx) { return (mono_u32(f) & 0xFFFFFF80u) | (unsigned)(127 - idx); }
__device__ __forceinline__ float unpack_key7(unsigned k) { return demono_u32((k & 0xFFFFFF80u) | 0x40u); }
__device__ __forceinline__ float unpack_key8(unsigned k) { return demono_u32((k & 0xFFFFFF00u) | 0x80u); }
__device__ __forceinline__ void ce_desc(unsigned& a, unsigned& b) { const unsigned hi = a > b ? a : b, lo = a > b ? b : a; a = hi; b = lo; }
__device__ __forceinline__ void sort16_desc(unsigned* v) {
#pragma unroll
    for (int k = 2; k <= 16; k <<= 1)
#pragma unroll
        for (int j = k >> 1; j > 0; j >>= 1)
#pragma unroll
            for (int i = 0; i < 16; ++i) { const int l = i ^ j; if (l > i) { if ((i & k) == 0) ce_desc(v[i], v[l]); else ce_desc(v[l], v[i]); } }
}
__device__ __forceinline__ void bmerge16_desc(unsigned* v) {
#pragma unroll
    for (int j = 8; j > 0; j >>= 1)
#pragma unroll
        for (int i = 0; i < 16; ++i) { const int l = i ^ j; if (l > i) ce_desc(v[i], v[l]); }
}
__device__ __forceinline__ void merge_top16(unsigned* a, const unsigned* b) {
#pragma unroll
    for (int i = 0; i < 16; ++i) { const unsigned o = b[15 - i]; a[i] = a[i] > o ? a[i] : o; }
    bmerge16_desc(a);
}
__device__ __forceinline__ void stage2_cands(const unsigned* s0, const unsigned* s1, int hh, unsigned* c) {
    float A[16], B[16];
#pragma unroll
    for (int i = 0; i < 16; ++i) { const float f0 = unpack_key7(s0[i]), f1 = unpack_key7(s1[i]); A[i] = hh ? f1 : f0; B[i] = hh ? f0 : f1; }
    int n = 0;
#pragma unroll
    for (int i = 0; i < 4; ++i)
#pragma unroll
        for (int j = i; j < 16; ++j) { if ((i + 1) * (j + 1) > 16) continue;
            const float val = A[i] + B[j]; const unsigned id = hh ? (unsigned)((j << 4) | i) : (unsigned)((i << 4) | j);
            unsigned key = (mono_u32(val) & 0xFFFFFF00u) | id; if (hh && i == j) key = 0u; c[n++] = key; }
#pragma unroll
    for (; n < 32; ++n) c[n] = 0u;
}

typedef short bf16x8_t __attribute__((ext_vector_type(8)));
typedef float f32x16 __attribute__((ext_vector_type(16)));
__device__ __forceinline__ float gelu_erf(float a) { return 0.5f * a * (1.f + erff(a * 0.70710678118654752f)); }


typedef __attribute__((address_space(3))) bf16 lbf16;

__device__ __forceinline__ f32x16 mm32(bf16x8_t a, bf16x8_t b, f32x16 c) { return __builtin_amdgcn_mfma_f32_32x32x16_bf16(a, b, c, 0, 0, 0); }
__device__ __forceinline__ bf16x8_t frag_from_u32x4(unsigned x, unsigned y, unsigned z, unsigned w) { typedef unsigned u4 __attribute__((ext_vector_type(4))); u4 t = {x, y, z, w}; return __builtin_bit_cast(bf16x8_t, t); }
template <int S> __device__ __forceinline__ bf16x8_t accop(const f32x16& z) {
    return frag_from_u32x4(cvtpk(z[8 * S], z[8 * S + 1]), cvtpk(z[8 * S + 2], z[8 * S + 3]), cvtpk(z[8 * S + 4], z[8 * S + 5]), cvtpk(z[8 * S + 6], z[8 * S + 7])); }
template <int S> __device__ __forceinline__ bf16x8_t ldpermcol(const lbf16* a, int col, int hh) {
    const lbf16* p = a + (16 * S + 4 * hh) * 72 + col;
    const unsigned e0 = p[0], e1 = p[72], e2 = p[144], e3 = p[216], e4 = p[8 * 72], e5 = p[9 * 72], e6 = p[10 * 72], e7 = p[11 * 72];
    return frag_from_u32x4(e0 | (e1 << 16), e2 | (e3 << 16), e4 | (e5 << 16), e6 | (e7 << 16)); }
__device__ __forceinline__ bf16x8_t ldrow(const lbf16* a, int row, int ks, int hh) { return *(const __attribute__((address_space(3))) bf16x8_t*)(a + row * 72 + ks * 16 + 8 * hh); }
__device__ __forceinline__ int rowidx(int e, int hh) { return (e & 3) + 8 * (e >> 2) + 4 * hh; }

constexpr int ROWB = 768;
__device__ __forceinline__ unsigned fp6code(float x, float sc) {
    const float t = fabsf(x) * sc;
    const float r = t < 16.f ? __builtin_rintf(t) : (t < 32.f ? 8.f + __builtin_rintf(t * 0.5f) : 16.f + __builtin_rintf(t * 0.25f));
    unsigned c = (unsigned)r; c = c > 31u ? 31u : c;
    return c | (x < 0.f ? 32u : 0u);
}
__device__ __forceinline__ void convert_tables_fp6(const float* pu, const float* pv, unsigned char* u8, unsigned char* v8, float* usc, float* vsc, int l, int wv, int nw, int lane) {
    for (int rr0 = wv * 2; rr0 < 2 * NEXP; rr0 += nw * 2) {
        f32x4 v[2][4]; float m[2];
#pragma unroll
        for (int rr = 0; rr < 2; ++rr) { const int q = rr0 + rr; const size_t row = (size_t)l * NEXP + (q < NEXP ? q : q - NEXP); const float* sp_ = (q < NEXP ? pu : pv) + row * D + lane * 16;
#pragma unroll
            for (int k = 0; k < 4; ++k) v[rr][k] = *(const f32x4*)(sp_ + k * 4); }
#pragma unroll
        for (int rr = 0; rr < 2; ++rr) { float mm = 0.f;
#pragma unroll
            for (int k = 0; k < 4; ++k) mm = fmaxf(fmaxf(mm, fmaxf(fabsf(v[rr][k].x), fabsf(v[rr][k].y))), fmaxf(fabsf(v[rr][k].z), fabsf(v[rr][k].w)));
#pragma unroll
            for (int o = 1; o < 64; o <<= 1) mm = fmaxf(mm, shflx(mm, lane, o));
            m[rr] = mm; }
#pragma unroll
        for (int rr = 0; rr < 2; ++rr) { const int q = rr0 + rr; const size_t row = (size_t)l * NEXP + (q < NEXP ? q : q - NEXP); const float sc = m[rr] > 0.f ? 60.f / m[rr] : 1.f;
            unsigned c[16];
#pragma unroll
            for (int k = 0; k < 4; ++k) { c[k * 4] = fp6code(v[rr][k].x, sc); c[k * 4 + 1] = fp6code(v[rr][k].y, sc); c[k * 4 + 2] = fp6code(v[rr][k].z, sc); c[k * 4 + 3] = fp6code(v[rr][k].w, sc); }
            const unsigned o0 = c[0] | (c[1] << 6) | (c[2] << 12) | (c[3] << 18) | (c[4] << 24) | (c[5] << 30);
            const unsigned o1 = (c[5] >> 2) | (c[6] << 4) | (c[7] << 10) | (c[8] << 16) | (c[9] << 22) | (c[10] << 28);
            const unsigned o2 = (c[10] >> 4) | (c[11] << 2) | (c[12] << 8) | (c[13] << 14) | (c[14] << 20) | (c[15] << 26);
            unsigned* op = (unsigned*)((q < NEXP ? u8 : v8) + row * ROWB + lane * 12);
            op[0] = o0; op[1] = o1; op[2] = o2;
            if (lane == 0) (q < NEXP ? usc : vsc)[row] = m[rr] > 0.f ? m[rr] * (1.f / 7.5f) : 1.f; }
    }
}

__global__ void __launch_bounds__(NTHR, 2) mega(Args args) {
    extern __shared__ __attribute__((aligned(16))) unsigned char lds_raw[];
    LAS unsigned char* lds = (LAS unsigned char*)lds_raw;
    const int G = gridDim.x, bx = blockIdx.x, NGW = G * NWAVES;
    const int wave0 = __builtin_amdgcn_readfirstlane((int)threadIdx.x >> 6);
    typedef const unsigned char __attribute__((address_space(4))) kbyte;
#define PHASE_IDS int tid; asm volatile("v_mbcnt_lo_u32_b32 %0, -1, 0\n\tv_mbcnt_hi_u32_b32 %0, -1, %0" : "=v"(tid)); tid += wave0 * 64;     const int lane = tid & 63, wave = __builtin_amdgcn_readfirstlane(tid >> 6), gw = bx * NWAVES + wave; (void)lane; (void)gw; \
    kbyte* kp = (kbyte*)__builtin_amdgcn_kernarg_segment_ptr(); asm volatile("" : "+s"(kp)); \
    unsigned char* const ws = (unsigned char*)*(__attribute__((address_space(1))) unsigned char* const __attribute__((address_space(4)))*)(kp + 31 * 8); float* const X = (float*)*(__attribute__((address_space(1))) float* const __attribute__((address_space(4)))*)(kp + 30 * 8); (void)ws; (void)X;
#define INP(i) ((const float*)(*(const __attribute__((address_space(1))) float* const __attribute__((address_space(4)))*)(kp + (i) * 8)))
#define MOD ((float*)(ws + WS_MOD))
#define H ((bf16*)(ws + WS_H))
#define PROJ ((bf16*)(ws + WS_PROJ))
#define Q ((bf16*)(ws + WS_Q))
#define MIX ((bf16*)(ws + WS_MIX))
#define Rb ((bf16*)(ws + WS_R))
#define Kb ((bf16*)(ws + WS_K))
#define V0 ((bf16*)(ws + WS_V0))
#define V1 ((bf16*)(ws + WS_V1))
#define KKb ((bf16*)(ws + WS_KK))
#define Bb ((bf16*)(ws + WS_B))
#define Gb ((bf16*)(ws + WS_G))
#define BGb ((bf16*)(ws + WS_BG))
#define Wd ((float*)(ws + WS_W))
#define Y ((float*)(ws + WS_Y))
#define QB ((float*)(ws + WS_QB))
#define SH ((float*)(ws + WS_SH))
#define WUPT ((bf16*)(ws + WS_LORA))
#define AUPT ((bf16*)(ws + WS_LORA + 131072))
#define GUPT ((bf16*)(ws + WS_LORA + 262144))
#define VUPT ((bf16*)(ws + WS_LORA + 524288))
#define PWT ((bf16*)(ws + WS_LORA + 655360))
#define INVN ((float*)(ws + WS_INVN))
#define BSUM ((float*)(ws + WS_BSUM))
#define SCN ((unsigned char*)(ws + WS_SCN))
#define IDX ((int*)(ws + WS_IDX))
#define GATE ((float*)(ws + WS_GATE))
#define WinT ((bf16*)(ws + WS_WIN_T))
#define WoutT ((bf16*)(ws + WS_WOUT_T))
#define PqT ((bf16*)(ws + WS_PQ_T))
#define KEYS ((bf16*)(ws + WS_KEYS))
#define U8 ((unsigned char*)(ws + WS_U))
#define V8 ((unsigned char*)(ws + WS_V))
#define USc ((float*)(ws + WS_US))
#define VSc ((float*)(ws + WS_VS))
    const int lo = args.ph_lo, hi = args.ph_hi;
    { volatile LAS unsigned* misc = (volatile LAS unsigned*)(lds + LDS_BYTES - 64); if (threadIdx.x < 4) misc[threadIdx.x] = 0u; __syncthreads(); }
    const XcdBarrier xbar = xcd_barrier_post((unsigned*)(args.ws) + 4096, (volatile LAS unsigned*)(lds + LDS_BYTES - 64));
#define IN(k) (lo <= (k) && (k) < hi)
#ifndef REP_PHASE
#define REP_PHASE (-1)
#endif
#define REPS(k) ((k) == REP_PHASE ? 3 : 1)
#define SEAM(k) do { if (IN(k) && IN((k) + 1)) { if ((k) == 0) cg::this_grid().sync(); else { XcdBarrier xb_ = xbar; asm volatile("" : "+s"(xb_.bar)); if ((k) == 1) xcd_barrier<true>(xb_); else xcd_barrier<false>(xb_); } } } while (0)

    if (IN(0)) { PHASE_IDS
        { LAS float* ca = (LAS float*)lds; LAS float* red = (LAS float*)(lds + 16384);
          const float* c = INP(1); const float* ada_w = INP(2); const float* ada_b = INP(3);
          bool have = false;
          for (int it = bx; it < 96; it += G) {
              if (!have) { for (int i = tid; i < BATCH * D; i += NTHR) { const float v = c[i]; ca[i] = v / (1.f + expf(-v)); } have = true; __syncthreads(); }
              const int l = it / 48, n = (it % 48) * 128 + (tid & 127), kq = tid >> 7;
              const float* w = ada_w + (size_t)l * D * 6 * D + (size_t)(kq * 256) * 6 * D + n;
              float a0 = 0.f, a1 = 0.f, a2 = 0.f, a3 = 0.f;
#pragma unroll 32
              for (int k = 0; k < 256; ++k) { const float wv = w[(size_t)k * 6 * D]; const int kk = kq * 256 + k; a0 += ca[kk] * wv; a1 += ca[D + kk] * wv; a2 += ca[2 * D + kk] * wv; a3 += ca[3 * D + kk] * wv; }
              red[(kq * 4 + 0) * 128 + (tid & 127)] = a0; red[(kq * 4 + 1) * 128 + (tid & 127)] = a1; red[(kq * 4 + 2) * 128 + (tid & 127)] = a2; red[(kq * 4 + 3) * 128 + (tid & 127)] = a3;
              __syncthreads();
              { const int b = tid >> 7, col = tid & 127, nn = (it % 48) * 128 + col;
                const float s = red[(0 * 4 + b) * 128 + col] + red[(1 * 4 + b) * 128 + col] + red[(2 * 4 + b) * 128 + col] + red[(3 * 4 + b) * 128 + col];
                MOD[(size_t)l * BATCH * 6 * D + (size_t)b * 6 * D + nn] = s + ada_b[l * 6 * D + nn]; }
              __syncthreads();
          }
          __syncthreads(); }
        { LAS float* scr = (LAS float*)(lds + wave * 16384);
          constexpr int I_IN = (D / 64) * (IN_COLS / 32), I_VR = (D / 64) * (MVL / 32), I_OUT = (D / 64) * (D / 32), I_PQ = (D / 64) * (PH * PQ / 32);
          constexpr int NIT = 2 * I_IN + I_VR + 2 * I_OUT + 2 * I_PQ;
          for (int it = gw; it < NIT; it += NGW) { int r = it;
              if (r < 2 * I_IN) { const int l = r / I_IN; p0_transpose_item(INP(5) + (size_t)l * D * IN_COLS, D, IN_COLS, WinT + (size_t)l * LDP * D, 0, scr, r % I_IN, lane); continue; } r -= 2 * I_IN;
              if (r < I_VR) { p0_transpose_item(INP(12), D, MVL, WinT + (size_t)1 * LDP * D, IN_COLS, scr, r, lane); continue; } r -= I_VR;
              if (r < 2 * I_OUT) { const int l = r / I_OUT; p0_transpose_item(INP(23) + (size_t)l * D * D, D, D, WoutT + (size_t)l * D * D, 0, scr, r % I_OUT, lane); continue; } r -= 2 * I_OUT;
              { const int l = r / I_PQ; p0_transpose_item(INP(25) + (size_t)l * D * PH * PQ, D, PH * PQ, PqT + (size_t)l * PH * PQ * D, 0, scr, r % I_PQ, lane); } }
          for (int it = gw; it < 2 * 16 + 2 * 16 + 2 * 32; it += NGW) { int r = it;
              if (r < 32) { const int l = r / 16; p0_transpose_item(INP(8) + (size_t)l * DL * RW, DL, RW, WUPT + (size_t)l * RW * DL, 0, scr, r % 16, lane); continue; } r -= 32;
              if (r < 32) { const int l = r / 16; p0_transpose_item(INP(10) + (size_t)l * AL * RW, AL, RW, AUPT + (size_t)l * RW * AL, 0, scr, r % 16, lane); continue; } r -= 32;
              { const int l = r / 32; p0_transpose_item(INP(11) + (size_t)l * GL * RW, GL, RW, GUPT + (size_t)l * RW * GL, 0, scr, r % 32, lane); } }
          { const float* vu = INP(15); for (int e = bx * NTHR + tid; e < MVL * RW; e += G * NTHR) { const int n = e >> 5, k = e & 31; VUPT[e] = f2bf(vu[k * RW + n]); } }
          for (int it = gw; it < 8 * 8; it += NGW) p0_transpose_item(INP(21) + (size_t)(it >> 3) * PG * PG, PG, PG, PWT + (size_t)(it >> 3) * PG * PG, 0, scr, it & 7, lane);
        }
        { const size_t gt = (size_t)bx * NTHR + tid, NT = (size_t)G * NTHR;
          constexpr size_t NK8 = (size_t)2 * PH * 2 * NKEYS * PHALF / 8;
          const float* src = INP(26); bf16* dst = KEYS;
          for (size_t i = gt; i < NK8; i += NT) {
              const f32x4 a = *(const f32x4*)(src + i * 8), b = *(const f32x4*)(src + i * 8 + 4);
              u32x4 o; o.x = pk2(a.x, a.y); o.y = pk2(a.z, a.w); o.z = pk2(b.x, b.y); o.w = pk2(b.z, b.w); *(u32x4*)(dst + i * 8) = o; }
        }
    }
    SEAM(0);

#pragma unroll
    for (int l = 0; l < DEPTH; ++l) {
        const int pb = 1 + 10 * l;
#define modl (MOD + (size_t)l * BATCH * 6 * D)
#define xin (l == 0 ? INP(0) : (const float*)X)
        if (l == 0 && IN(pb + 0)) { PHASE_IDS const float* gamma = INP(4) + l * D;
            for (int row = gw; row < T; row += NGW) { const int b = row / SEQ; norm_mod_row(xin + (size_t)row * D, gamma, modl + (size_t)b * 6 * D, modl + (size_t)b * 6 * D + D, H + (size_t)row * D, lane); } }
        SEAM(pb + 0);
        if (IN(pb + 1)) { PHASE_IDS const int N1 = l == 0 ? IN_COLS : LDP;
            pg8::Gemm g{H, WinT + (size_t)l * LDP * D, T, N1, D}; pg8::StaticOrder S; S.init(T, N1, G, bx);
            pg8::EpiBf16<0> E{PROJ, LDP, nullptr, 0, 0, 1.f};
            pg8::gemm_phase<pg8::EpiBf16<0>, pg8::StaticOrder, true, true>(lds, g, S, E, tid); }
        SEAM(pb + 1);

        if (IN(pb + 2)) { PHASE_IDS
            constexpr int LST = 296;
            LAS bf16* lin = (LAS bf16*)lds;
            const float* mu = INP(6) + l * RWKV_COLS; const float* vmu = INP(13);
            const float* w0p = INP(7) + l * RW; const float* a0p = INP(9) + l * RW; const float* kkp = INP(16) + l * RW; const float* kap = INP(17) + l * RW; const float* rkp = INP(18) + l * RW; const float* v0p = INP(14);
            const bf16* wupT = WUPT + (size_t)l * RW * DL; const bf16* aupT = AUPT + (size_t)l * RW * AL; const bf16* gupT = GUPT + (size_t)l * RW * GL; const bf16* vupT = VUPT;
            bf16* Vl = l == 0 ? V0 : V1;
            const int r32 = lane & 31, hh = lane >> 5, h = wave;
            for (int tile = bx; tile < T / 32; tile += G) {
                const int t0 = tile * 32;
                __syncthreads();
#pragma unroll 1
                for (int it0 = 0; it0 < 3; it0 += 2) {
                  u32x4 cu_[2], pv_[2]; f32x4 m0_[2], m1_[2];
#pragma unroll
                  for (int it = 0; it < 2; ++it) { const int c8 = tid + (it0 + it) * NTHR; const bool ok = c8 < 32 * 36; const int tok = ok ? c8 / 36 : 0, jc = ok ? c8 % 36 : 0, t = t0 + tok, sq = t % SEQ;
                      cu_[it] = (u32x4){0u, 0u, 0u, 0u}; pv_[it] = (u32x4){0u, 0u, 0u, 0u}; m0_[it] = (f32x4){0.f, 0.f, 0.f, 0.f}; m1_[it] = m0_[it];
                      if (ok && (jc < 32 || l > 0)) { const int col = jc < 32 ? 3 * RW + jc * 8 : IN_COLS + (jc - 32) * 8;
                          cu_[it] = *(const u32x4*)(PROJ + (size_t)t * LDP + col); if (sq > 0) pv_[it] = *(const u32x4*)(PROJ + (size_t)(t - 1) * LDP + col);
                          const float* mp = jc < 32 ? mu + col : vmu + (jc - 32) * 8; m0_[it] = *(const f32x4*)mp; m1_[it] = *(const f32x4*)(mp + 4); } }
#pragma unroll
                  for (int it = 0; it < 2; ++it) { const int c8 = tid + (it0 + it) * NTHR; if (c8 < 32 * 36) { const int tok = c8 / 36, jc = c8 % 36;
                      u32x4 o = {0u, 0u, 0u, 0u};
                      if (jc < 32 || l > 0) {
                          float x[8]; const unsigned cw[4] = {cu_[it].x, cu_[it].y, cu_[it].z, cu_[it].w}, pw[4] = {pv_[it].x, pv_[it].y, pv_[it].z, pv_[it].w}; const float mm[8] = {m0_[it].x, m0_[it].y, m0_[it].z, m0_[it].w, m1_[it].x, m1_[it].y, m1_[it].z, m1_[it].w};
#pragma unroll
                          for (int i = 0; i < 4; ++i) { const float c0 = __uint_as_float(cw[i] << 16), c1 = __uint_as_float(cw[i] & 0xffff0000u), p0 = __uint_as_float(pw[i] << 16), p1 = __uint_as_float(pw[i] & 0xffff0000u);
                              x[2 * i] = c0 + (p0 - c0) * mm[2 * i]; x[2 * i + 1] = c1 + (p1 - c1) * mm[2 * i + 1]; }
                          if (jc < 8) {
#pragma unroll
                              for (int i = 0; i < 8; ++i) { const float e2 = __expf(-2.f * fabsf(x[i])); const float th = (1.f - e2) * __builtin_amdgcn_rcpf(1.f + e2); x[i] = x[i] < 0.f ? -th : th; } }
                          else if (jc >= 16 && jc < 32) {
#pragma unroll
                              for (int i = 0; i < 8; ++i) x[i] = __builtin_amdgcn_rcpf(1.f + __expf(-x[i])); }
                          o.x = pk2(x[0], x[1]); o.y = pk2(x[2], x[3]); o.z = pk2(x[4], x[5]); o.w = pk2(x[6], x[7]);
                      }
                      *(LAS u32x4*)(lin + tok * LST + jc * 8) = o; } } }
                __syncthreads();
                const bool first = (t0 % SEQ) == 0;
                lbf16* tin = (lbf16*)(lds + 19456 + wave * 14336);
                { u32x4 iq[13]; int ql_; asm volatile("v_mbcnt_lo_u32_b32 %0, -1, 0\n\tv_mbcnt_hi_u32_b32 %0, -1, %0" : "=v"(ql_));
#pragma unroll
                  for (int i = 0; i < 13; ++i) { const int q = ql_ + 64 * i; iq[i] = (u32x4){0u, 0u, 0u, 0u};
                      if (q < 792) { const int arr = q / 264, rem = q - arr * 264, row = rem >> 3, cc = rem & 7;
                          if (!(first && row == 0)) iq[i] = *(const u32x4*)(PROJ + (size_t)(t0 - 1 + row) * LDP + arr * RW + h * HS + cc * 8); } }
#pragma unroll
                  for (int i = 0; i < 13; ++i) { const int q = ql_ + 64 * i; if (q < 792) { const int arr = q / 264, rem = q - arr * 264, row = rem >> 3, cc = rem & 7;
                      *(__attribute__((address_space(3))) u32x4*)(tin + arr * 2376 + row * 72 + cc * 8) = iq[i]; } } }
                __builtin_amdgcn_wave_barrier(); asm volatile("s_waitcnt lgkmcnt(0)" ::: "memory");
                float ssq[16], bsm[16];
#pragma unroll
                for (int e = 0; e < 16; ++e) { ssq[e] = 0.f; bsm[e] = 0.f; }
#pragma unroll 1
                for (int rt = 0; rt < 2; ++rt) {
                    f32x16 accW, accA, accG, accV;
#pragma unroll
                    for (int e = 0; e < 16; ++e) { accW[e] = 0.f; accA[e] = 0.f; accG[e] = 0.f; accV[e] = 0.f; }
                    int c = h * HS + rt * 32 + r32;
int hh8 = 8 * hh; asm volatile("" : "+v"(c), "+v"(hh8));
                    const LAS bf16* lrow = lin + r32 * LST + 8 * hh;
                    { bf16x8_t wf[18];
#pragma unroll
                      for (int ks = 0; ks < 4; ++ks) { wf[ks] = *(const bf16x8_t*)(wupT + (size_t)c * DL + ks * 16 + hh8); wf[4 + ks] = *(const bf16x8_t*)(aupT + (size_t)c * AL + ks * 16 + hh8); }
#pragma unroll
                      for (int ks = 0; ks < 8; ++ks) wf[8 + ks] = *(const bf16x8_t*)(gupT + (size_t)c * GL + ks * 16 + hh8);
                      if (l > 0) { wf[16] = *(const bf16x8_t*)(vupT + (size_t)c * MVL + hh8); wf[17] = *(const bf16x8_t*)(vupT + (size_t)c * MVL + 16 + hh8); }
#pragma unroll
                      for (int ks = 0; ks < 4; ++ks) { accW = __builtin_amdgcn_mfma_f32_32x32x16_bf16(*(const LAS bf16x8_t*)(lrow + ks * 16), wf[ks], accW, 0, 0, 0);
                                                       accA = __builtin_amdgcn_mfma_f32_32x32x16_bf16(*(const LAS bf16x8_t*)(lrow + 64 + ks * 16), wf[4 + ks], accA, 0, 0, 0); }
#pragma unroll
                      for (int ks = 0; ks < 8; ++ks) accG = __builtin_amdgcn_mfma_f32_32x32x16_bf16(*(const LAS bf16x8_t*)(lrow + 128 + ks * 16), wf[8 + ks], accG, 0, 0, 0);
                      if (l > 0) {
#pragma unroll
                          for (int ks = 0; ks < 2; ++ks) accV = __builtin_amdgcn_mfma_f32_32x32x16_bf16(*(const LAS bf16x8_t*)(lrow + 256 + ks * 16), wf[16 + ks], accV, 0, 0, 0); } }
                    const float mur = mu[c], muk = mu[RW + c], muv = mu[2 * RW + c], w0c = w0p[c], a0c = a0p[c], kkc = kkp[c], kac = kap[c], rkc = rkp[c];
                    const float v0c = l > 0 ? v0p[c] : 0.f;
#pragma unroll
                    for (int eb = 0; eb < 16; eb += 4) {
                        bf16 lr[4], lk[4], lv[4], lrp[4], lkp[4], lvp[4], lvf[4];
#pragma unroll
                        for (int i = 0; i < 4; ++i) { const int e = eb + i; const int tok = (e & 3) + 8 * (e >> 2) + 4 * hh, t = t0 + tok; const int ci = rt * 32 + r32;
                            lr[i] = tin[(tok + 1) * 72 + ci]; lk[i] = tin[2376 + (tok + 1) * 72 + ci]; lv[i] = tin[2 * 2376 + (tok + 1) * 72 + ci];
                            lrp[i] = tin[tok * 72 + ci]; lkp[i] = tin[2376 + tok * 72 + ci]; lvp[i] = tin[2 * 2376 + tok * 72 + ci];
                            lvf[i] = l > 0 ? V0[(size_t)t * RW + c] : (bf16)0; }
                        __builtin_amdgcn_sched_barrier(0);
#pragma unroll
                        for (int i = 0; i < 4; ++i) { const int e = eb + i; const int tok = (e & 3) + 8 * (e >> 2) + 4 * hh, t = t0 + tok; const size_t o = (size_t)t * RW + c;
                            float r = bf2f(lr[i]), k = bf2f(lk[i]), v = bf2f(lv[i]);
                            r += (bf2f(lrp[i]) - r) * mur; k += (bf2f(lkp[i]) - k) * muk; v += (bf2f(lvp[i]) - v) * muv;
                            const float z = -(w0c + accW[e]); const float sp = fmaxf(z, 0.f) + __logf(1.f + __expf(-fabsf(z)));
                            const float decay = __expf(-__expf(-sp - 0.5f));
                            const float a = __builtin_amdgcn_rcpf(1.f + __expf(-(a0c + accA[e]))); const float g = accG[e];
                            if (l > 0) { const float vfv = bf2f(lvf[i]); v = v + (vfv - v) * __builtin_amdgcn_rcpf(1.f + __expf(-(v0c + accV[e]))); }
                            const float kk = k * kkc; const float k2 = k * (1.f + (a - 1.f) * kac);
                            ssq[e] += kk * kk; bsm[e] += r * k2 * rkc;
                            { const unsigned p0_ = cvtpk(r, k2), p1_ = cvtpk(v, kk), p2_ = cvtpk(kk * a, g), p3_ = cvtpk(v * g, 0.f);
                              Rb[o] = (bf16)p0_; Kb[o] = (bf16)(p0_ >> 16); Vl[o] = (bf16)p1_; KKb[o] = (bf16)(p1_ >> 16); Bb[o] = (bf16)p2_; Gb[o] = (bf16)(p2_ >> 16); BGb[o] = (bf16)p3_; Wd[o] = decay; }
                        }
                    }
                }
#pragma unroll
                for (int e = 0; e < 16; ++e) { const int ln_ = r32 | (hh << 5); float a_ = red16(ssq[e]), b_ = red16(bsm[e]); a_ += shflx(a_, ln_, 16); b_ += shflx(b_, ln_, 16); ssq[e] = a_; bsm[e] = b_; }
                if (r32 == 0) {
#pragma unroll
                    for (int e = 0; e < 16; ++e) { const int tok = (e & 3) + 8 * (e >> 2) + 4 * hh; INVN[(size_t)(t0 + tok) * NH + h] = rsqrtf(fmaxf(ssq[e], 1e-24f)); BSUM[(size_t)(t0 + tok) * NH + h] = bsm[e]; } }
            }
            {
                constexpr int DST = 520;
                int lane_p; asm volatile("v_mbcnt_lo_u32_b32 %0, -1, 0\n\tv_mbcnt_hi_u32_b32 %0, -1, %0" : "=v"(lane_p)); const int r32 = lane_p & 31, hh = lane_p >> 5, tidp = wave0 * 64 + lane_p;
                lbf16* dlb = (lbf16*)lds;
                lbf16* pin = (lbf16*)(lds + 33280);
                const int c = tidp, g = c >> 7, win = 2 << g;
                const bf16* pwt = PWT + (size_t)(l * 4 + (wave >> 1)) * PG * PG; const float* psc = INP(22) + l * PW;
                for (int tile = bx; tile < T / 32; tile += G) {
                    const int t0 = tile * 32; const bool first = (t0 % SEQ) == 0;
                    __syncthreads();
                    { u32x4 pq[6];
#pragma unroll
                      for (int q = 0; q < 6; ++q) { const int ch = tidp + q * NTHR, row = ch >> 6, cc = ch & 63; pq[q] = (u32x4){0u, 0u, 0u, 0u};
                          if (ch < 47 * 64 && (row >= 15 || !first)) pq[q] = *(const u32x4*)(PROJ + (size_t)(t0 - 15 + row) * LDP + RWKV_COLS + cc * 8); }
#pragma unroll
                      for (int q = 0; q < 6; ++q) { const int ch = tidp + q * NTHR, row = ch >> 6, cc = ch & 63; if (ch < 47 * 64) *(__attribute__((address_space(3))) u32x4*)(pin + row * 520 + cc * 8) = pq[q]; } }
                    __syncthreads();
                    const lbf16* pc = pin + c;
                    float sw = 0.f;
#pragma unroll
                    for (int j = 1; j <= 15; ++j) sw += (j < win) ? bf2f(pc[(15 - j) * 520]) : 0.f;
                    const float invw = 1.f / (float)win;
#pragma unroll 8
                    for (int i = 0; i < 32; ++i) {
                        const float cur = bf2f(pc[(15 + i) * 520]);
                        sw += cur;
                        const float inv = (first && i < 15) ? 1.f / (float)min(i + 1, win) : invw;
                        dlb[i * DST + c] = f2bf(sw * inv - cur);
                        sw -= bf2f(pc[(15 + i - win + 1) * 520]);
                    }
                    __syncthreads();
                    const int gg = wave >> 1, half = wave & 1;
#pragma unroll
                    for (int ct = 0; ct < 2; ++ct) {
                        const int dd0 = half * 64 + ct * 32;
                        f32x16 acc;
#pragma unroll
                        for (int e = 0; e < 16; ++e) acc[e] = 0.f;
#pragma unroll
                        for (int ks = 0; ks < 8; ++ks) { const bf16x8_t a = *(const __attribute__((address_space(3))) bf16x8_t*)(dlb + r32 * DST + gg * PG + ks * 16 + 8 * hh);
                            const bf16x8_t w = *(const bf16x8_t*)(pwt + (size_t)(dd0 + r32) * PG + ks * 16 + 8 * hh); acc = mm32(a, w, acc); }
                        const int oc = gg * PG + dd0 + r32; const float ps = psc[oc];
#pragma unroll
                        for (int e = 0; e < 16; ++e) MIX[(size_t)(t0 + rowidx(e, hh)) * D + RW + oc] = f2bf(acc[e] * ps);
                    }
                }
            }
        }
        SEAM(pb + 2);

        if (IN(pb + 3)) { PHASE_IDS
            const bf16* Vl = l == 0 ? V0 : V1;
            const int r32 = lane & 31, hh = lane >> 5;
            if (wave < 6) {
                lbf16* At = (lbf16*)(lds + wave * 23552); lbf16* Bt = At + 2304; lbf16* Kt = Bt + 2304; lbf16* Rt = Kt + 2304; lbf16* Vv = Rt + 2304;
                LAS float* PCs = (LAS float*)(lds + wave * 23552 + 23040);
                for (int item = bx * 6 + wave; item < BATCH * NH * (SEQ / 32); item += G * 6) {
                    const int bh = item >> 7, chunk = item & 127, b = bh >> 3, h = bh & 7; const size_t t0 = (size_t)b * SEQ + chunk * 32;
                    __builtin_amdgcn_wave_barrier(); asm volatile("s_waitcnt lgkmcnt(0)" ::: "memory");
                    {
                      const int tk = lane >> 3, part = lane & 7;
                      u32x4 qr[4], qk[4], qv[4], qkk[4], qb[4]; f32x4 qw0[4], qw1[4]; float qin[4];
#pragma unroll
                      for (int p4 = 0; p4 < 4; ++p4) { const size_t o = (t0 + p4 * 8 + tk) * RW + h * HS + part * 8;
                          qr[p4] = *(const u32x4*)(Rb + o); qk[p4] = *(const u32x4*)(Kb + o); qv[p4] = *(const u32x4*)(Vl + o); qkk[p4] = *(const u32x4*)(KKb + o); qb[p4] = *(const u32x4*)(Bb + o);
                          qw0[p4] = *(const f32x4*)(Wd + o); qw1[p4] = *(const f32x4*)(Wd + o + 4); qin[p4] = INVN[(t0 + p4 * 8 + tk) * NH + h]; }
                      LAS float* Pl = (LAS float*)At;
#pragma unroll
                      for (int p4 = 0; p4 < 4; ++p4) { *(LAS f32x4*)(Pl + (p4 * 8 + tk) * 64 + part * 8) = qw0[p4]; *(LAS f32x4*)(Pl + (p4 * 8 + tk) * 64 + part * 8 + 4) = qw1[p4]; }
                      __builtin_amdgcn_wave_barrier(); asm volatile("s_waitcnt lgkmcnt(0)" ::: "memory");
                      { float P = 1.f;
#pragma unroll 8
                        for (int c = 0; c < 32; ++c) { P *= Pl[c * 64 + lane]; Pl[c * 64 + lane] = P; }
                        PCs[lane] = P; }
                      __builtin_amdgcn_wave_barrier(); asm volatile("s_waitcnt lgkmcnt(0)" ::: "memory");
                      u32x4 oa[4], orr[4], ob_[4], ok_[4];
#pragma unroll
                      for (int p4 = 0; p4 < 4; ++p4) { const int c = p4 * 8 + tk;
                          const f32x4 pa = *(const LAS f32x4*)(Pl + c * 64 + part * 8), pb2 = *(const LAS f32x4*)(Pl + c * 64 + part * 8 + 4);
                          f32x4 ma = {1.f, 1.f, 1.f, 1.f}, mb = ma; if (c > 0) { ma = *(const LAS f32x4*)(Pl + (c - 1) * 64 + part * 8); mb = *(const LAS f32x4*)(Pl + (c - 1) * 64 + part * 8 + 4); }
                          const float Pc[8] = {pa.x, pa.y, pa.z, pa.w, pb2.x, pb2.y, pb2.z, pb2.w}, Pm[8] = {ma.x, ma.y, ma.z, ma.w, mb.x, mb.y, mb.z, mb.w};
                          const unsigned rw_[4] = {qr[p4].x, qr[p4].y, qr[p4].z, qr[p4].w}, kw_[4] = {qk[p4].x, qk[p4].y, qk[p4].z, qk[p4].w}, kkw[4] = {qkk[p4].x, qkk[p4].y, qkk[p4].z, qkk[p4].w}, bw_[4] = {qb[p4].x, qb[p4].y, qb[p4].z, qb[p4].w};
                          unsigned xa[4], xr[4], xb[4], xk[4]; const float inv = qin[p4];
#pragma unroll
                          for (int i = 0; i < 4; ++i) { const float ip0 = __builtin_amdgcn_rcpf(Pc[2 * i]), ip1 = __builtin_amdgcn_rcpf(Pc[2 * i + 1]);
                              xa[i] = pk2(-__uint_as_float(kkw[i] << 16) * inv * Pm[2 * i], -__uint_as_float(kkw[i] & 0xffff0000u) * inv * Pm[2 * i + 1]);
                              xr[i] = pk2(__uint_as_float(rw_[i] << 16) * Pc[2 * i], __uint_as_float(rw_[i] & 0xffff0000u) * Pc[2 * i + 1]);
                              xb[i] = pk2(__uint_as_float(bw_[i] << 16) * inv * ip0, __uint_as_float(bw_[i] & 0xffff0000u) * inv * ip1);
                              xk[i] = pk2(__uint_as_float(kw_[i] << 16) * ip0, __uint_as_float(kw_[i] & 0xffff0000u) * ip1); }
                          oa[p4] = (u32x4){xa[0], xa[1], xa[2], xa[3]}; orr[p4] = (u32x4){xr[0], xr[1], xr[2], xr[3]}; ob_[p4] = (u32x4){xb[0], xb[1], xb[2], xb[3]}; ok_[p4] = (u32x4){xk[0], xk[1], xk[2], xk[3]}; }
                      __builtin_amdgcn_wave_barrier(); asm volatile("s_waitcnt lgkmcnt(0)" ::: "memory");
#pragma unroll
                      for (int p4 = 0; p4 < 4; ++p4) { const int c = p4 * 8 + tk, o = c * 72 + part * 8;
                          *(__attribute__((address_space(3))) u32x4*)(At + o) = oa[p4]; *(__attribute__((address_space(3))) u32x4*)(Rt + o) = orr[p4]; *(__attribute__((address_space(3))) u32x4*)(Bt + o) = ob_[p4];
                          *(__attribute__((address_space(3))) u32x4*)(Kt + o) = ok_[p4]; *(__attribute__((address_space(3))) u32x4*)(Vv + o) = qv[p4]; } }
                    __builtin_amdgcn_wave_barrier(); asm volatile("s_waitcnt lgkmcnt(0)" ::: "memory");
                    const f32x16 zero16 = {0.f, 0.f, 0.f, 0.f, 0.f, 0.f, 0.f, 0.f, 0.f, 0.f, 0.f, 0.f, 0.f, 0.f, 0.f, 0.f};
                    f32x16 X = zero16, Yt = zero16;
#pragma unroll
                    for (int ks = 0; ks < 4; ++ks) { const bf16x8_t fa = ldrow(At, r32, ks, hh), fb = ldrow(Bt, r32, ks, hh); X = mm32(fa, fb, X); Yt = mm32(fb, fa, Yt); }
#pragma unroll
                    for (int e = 0; e < 16; ++e) { const int ri = rowidx(e, hh); X[e] = (r32 < ri) ? X[e] : 0.f; Yt[e] = (ri < r32) ? Yt[e] : 0.f; }
                    f32x16 TY = Yt;
#pragma unroll
                    for (int e = 0; e < 16; ++e) TY[e] += (rowidx(e, hh) == r32) ? 1.f : 0.f;
#pragma unroll 1
                    for (int it = 0; it < 4; ++it) {
                        const bf16x8_t x0 = accop<0>(X), x1 = accop<1>(X), y0 = accop<0>(Yt), y1 = accop<1>(Yt);
                        f32x16 Xn = mm32(y0, x0, zero16); Xn = mm32(y1, x1, Xn);
                        f32x16 Yn = mm32(x0, y0, zero16); Yn = mm32(x1, y1, Yn);
                        X = Xn; Yt = Yn;
                        const bf16x8_t p0 = accop<0>(X), p1 = accop<1>(X), t0_ = accop<0>(TY), t1_ = accop<1>(TY);
                        TY = mm32(p0, t0_, TY); TY = mm32(p1, t1_, TY);
                    }
                    const bf16x8_t ty0 = accop<0>(TY), ty1 = accop<1>(TY);
                    unsigned char* rec = SCN + (size_t)item * 24576;
                    const bf16x8_t v00 = ldpermcol<0>(Vv, r32, hh), v01 = ldpermcol<1>(Vv, r32, hh), v10 = ldpermcol<0>(Vv, 32 + r32, hh), v11 = ldpermcol<1>(Vv, 32 + r32, hh);
                    f32x16 U0a, U0b;
                    { f32x16 G2T = zero16;
#pragma unroll
                      for (int ks = 0; ks < 4; ++ks) G2T = mm32(ldrow(Kt, r32, ks, hh), ldrow(At, r32, ks, hh), G2T);
#pragma unroll
                      for (int e = 0; e < 16; ++e) G2T[e] = (rowidx(e, hh) < r32) ? G2T[e] : 0.f;
                      const bf16x8_t g0 = accop<0>(G2T), g1 = accop<1>(G2T);
                      f32x16 Za = mm32(g0, v00, zero16); Za = mm32(g1, v01, Za); f32x16 Zb = mm32(g0, v10, zero16); Zb = mm32(g1, v11, Zb);
                      U0a = mm32(ty0, accop<0>(Za), zero16); U0a = mm32(ty1, accop<1>(Za), U0a); U0b = mm32(ty0, accop<0>(Zb), zero16); U0b = mm32(ty1, accop<1>(Zb), U0b); }
                    const bf16x8_t ua0 = accop<0>(U0a), ua1 = accop<1>(U0a), ub0 = accop<0>(U0b), ub1 = accop<1>(U0b);
                    f32x16 G3T = zero16;
                    { f32x16 G4T = zero16;
#pragma unroll
                      for (int ks = 0; ks < 4; ++ks) { const bf16x8_t fr = ldrow(Rt, r32, ks, hh); G3T = mm32(ldrow(Bt, r32, ks, hh), fr, G3T); G4T = mm32(ldrow(Kt, r32, ks, hh), fr, G4T); }
#pragma unroll
                      for (int e = 0; e < 16; ++e) { const bool keep = rowidx(e, hh) <= r32; G3T[e] = keep ? G3T[e] : 0.f; G4T[e] = keep ? G4T[e] : 0.f; }
                      const bf16x8_t g30 = accop<0>(G3T), g31 = accop<1>(G3T), g40 = accop<0>(G4T), g41 = accop<1>(G4T);
                      f32x16 Ya = mm32(g30, ua0, zero16); Ya = mm32(g31, ua1, Ya); Ya = mm32(g40, v00, Ya); Ya = mm32(g41, v01, Ya);
                      f32x16 Yb = mm32(g30, ub0, zero16); Yb = mm32(g31, ub1, Yb); Yb = mm32(g40, v10, Yb); Yb = mm32(g41, v11, Yb);
                      u32x4 o0, o1;
                      o0.x = cvtpk(Ya[0], Ya[1]); o0.y = cvtpk(Ya[2], Ya[3]); o0.z = cvtpk(Ya[4], Ya[5]); o0.w = cvtpk(Ya[6], Ya[7]);
                      o1.x = cvtpk(Ya[8], Ya[9]); o1.y = cvtpk(Ya[10], Ya[11]); o1.z = cvtpk(Ya[12], Ya[13]); o1.w = cvtpk(Ya[14], Ya[15]);
                      *(u32x4*)(rec + 12288 + 4096 + lane * 32) = o0; *(u32x4*)(rec + 12288 + 4096 + lane * 32 + 16) = o1;
                      o0.x = cvtpk(Yb[0], Yb[1]); o0.y = cvtpk(Yb[2], Yb[3]); o0.z = cvtpk(Yb[4], Yb[5]); o0.w = cvtpk(Yb[6], Yb[7]);
                      o1.x = cvtpk(Yb[8], Yb[9]); o1.y = cvtpk(Yb[10], Yb[11]); o1.z = cvtpk(Yb[12], Yb[13]); o1.w = cvtpk(Yb[14], Yb[15]);
                      *(u32x4*)(rec + 12288 + 6144 + 4096 + lane * 32) = o0; *(u32x4*)(rec + 12288 + 6144 + 4096 + lane * 32 + 16) = o1; }
                    f32x16 Wa0 = mm32(ty0, ldpermcol<0>(At, r32, hh), zero16); Wa0 = mm32(ty1, ldpermcol<1>(At, r32, hh), Wa0);
                    f32x16 Wa1 = mm32(ty0, ldpermcol<0>(At, 32 + r32, hh), zero16); Wa1 = mm32(ty1, ldpermcol<1>(At, 32 + r32, hh), Wa1);
                    const bf16x8_t wa00 = accop<0>(Wa0), wa01 = accop<1>(Wa0), wa10 = accop<0>(Wa1), wa11 = accop<1>(Wa1);
                    { const bf16x8_t g30 = accop<0>(G3T), g31 = accop<1>(G3T);
                      f32x16 Ra = mm32(wa00, g30, zero16); Ra = mm32(wa01, g31, Ra); f32x16 Rb_ = mm32(wa10, g30, zero16); Rb_ = mm32(wa11, g31, Rb_);
#pragma unroll
                      for (int e = 0; e < 16; ++e) { const int kr = rowidx(e, hh); Ra[e] += bf2f(Rt[r32 * 72 + kr]); Rb_[e] += bf2f(Rt[r32 * 72 + 32 + kr]); }
                      *(bf16x8_t*)(rec + 8192 + 0 * 1024 + lane * 16) = accop<0>(Ra); *(bf16x8_t*)(rec + 8192 + 1 * 1024 + lane * 16) = accop<1>(Ra);
                      *(bf16x8_t*)(rec + 8192 + 2 * 1024 + lane * 16) = accop<0>(Rb_); *(bf16x8_t*)(rec + 8192 + 3 * 1024 + lane * 16) = accop<1>(Rb_); }
                    const bf16x8_t b00 = ldpermcol<0>(Bt, r32, hh), b01 = ldpermcol<1>(Bt, r32, hh), b10 = ldpermcol<0>(Bt, 32 + r32, hh), b11 = ldpermcol<1>(Bt, 32 + r32, hh);
                    { const float pc0 = PCs[r32], pc1 = PCs[32 + r32];
#pragma unroll
                      for (int ij = 0; ij < 4; ++ij) { const int i = ij >> 1, j = ij & 1;
                          f32x16 M = mm32(i ? wa10 : wa00, j ? b10 : b00, zero16); M = mm32(i ? wa11 : wa01, j ? b11 : b01, M);
#pragma unroll
                          for (int e = 0; e < 16; ++e) { float m = M[e]; if (i == j) m += (rowidx(e, hh) == r32) ? 1.f : 0.f; M[e] = m * (j ? pc1 : pc0); }
                          *(bf16x8_t*)(rec + (ij * 2 + 0) * 1024 + lane * 16) = accop<0>(M); *(bf16x8_t*)(rec + (ij * 2 + 1) * 1024 + lane * 16) = accop<1>(M); } }
                    { const bf16x8_t k00 = ldpermcol<0>(Kt, r32, hh), k01 = ldpermcol<1>(Kt, r32, hh), k10 = ldpermcol<0>(Kt, 32 + r32, hh), k11 = ldpermcol<1>(Kt, 32 + r32, hh);
#pragma unroll
                      for (int ju = 0; ju < 4; ++ju) { const int j = ju >> 1, u = ju & 1;
                          f32x16 Dm = mm32(j ? b10 : b00, u ? ub0 : ua0, zero16); Dm = mm32(j ? b11 : b01, u ? ub1 : ua1, Dm);
                          Dm = mm32(j ? k10 : k00, u ? v10 : v00, Dm); Dm = mm32(j ? k11 : k01, u ? v11 : v01, Dm);
#pragma unroll
                          for (int e = 0; e < 16; ++e) Dm[e] *= PCs[32 * j + rowidx(e, hh)];
                          u32x4 o0, o1;
                          o0.x = cvtpk(Dm[0], Dm[1]); o0.y = cvtpk(Dm[2], Dm[3]); o0.z = cvtpk(Dm[4], Dm[5]); o0.w = cvtpk(Dm[6], Dm[7]);
                          o1.x = cvtpk(Dm[8], Dm[9]); o1.y = cvtpk(Dm[10], Dm[11]); o1.z = cvtpk(Dm[12], Dm[13]); o1.w = cvtpk(Dm[14], Dm[15]);
                          *(u32x4*)(rec + 12288 + u * 6144 + j * 2048 + lane * 32) = o0; *(u32x4*)(rec + 12288 + u * 6144 + j * 2048 + lane * 32 + 16) = o1; } }
                }
            }
        }
        { XcdBarrier xb_ = xbar; asm volatile("" : "+s"(xb_.bar)); xcd_barrier<false>(xb_); }
        if (IN(pb + 3)) { PHASE_IDS
            const int r32 = lane & 31, hh = lane >> 5;
            constexpr int SLOT = 18432, NCH = SEQ / 32, NSL = 7, AHEAD = 6;
            if (G > BATCH * NH * 2) { if (bx >= BATCH * NH * 2) convert_tables_fp6(INP(27), INP(28), U8, V8, USc, VSc, l, (bx - BATCH * NH * 2) * NWAVES + wave, (G - BATCH * NH * 2) * NWAVES, lane); }
            else convert_tables_fp6(INP(27), INP(28), U8, V8, USc, VSc, l, bx * NWAVES + wave, G * NWAVES, lane);
            for (int un = bx; un < BATCH * NH * 2; un += G) {
                const int bh = un >> 1, u = un & 1, b = bh >> 3, h = bh & 7;
                __syncthreads();
                const unsigned char* recs = SCN + (size_t)bh * NCH * 24576;
                const int lw = wave - 2;
#define S2_DMA(chunk_) do { if (wave >= 2) { LAS unsigned char* sl = lds + ((chunk_) % NSL) * SLOT; const unsigned char* rp = recs + (size_t)(chunk_) * 24576 + lane * 16; \
                    _Pragma("unroll") for (int q_ = 0; q_ < 3; ++q_) { const int p_ = lw * 3 + q_; const int so_ = p_ < 12 ? p_ * 1024 : 12288 + u * 6144 + (p_ - 12) * 1024; \
                        __builtin_amdgcn_global_load_lds((const unsigned*)(rp + so_), (LAS unsigned*)(sl + p_ * 1024), 16, 0, 0); } } } while (0)
#pragma unroll 1
                for (int c0 = 0; c0 < AHEAD; ++c0) S2_DMA(c0);
                asm volatile("s_waitcnt vmcnt(15)" ::: "memory");
                __builtin_amdgcn_s_barrier();
                f32x16 X0, X1;
#pragma unroll
                for (int e = 0; e < 16; ++e) { X0[e] = 0.f; X1[e] = 0.f; }
#define S2_FRAG(off) (*(const __attribute__((address_space(3))) bf16x8_t*)(sl + (off) + lane * 16))
#define S2_UNPK(dst, off) do { const u32x4 a0 = *(const LAS u32x4*)(sl + (off) + lane * 32), a1 = *(const LAS u32x4*)(sl + (off) + lane * 32 + 16); const unsigned wv[8] = {a0.x, a0.y, a0.z, a0.w, a1.x, a1.y, a1.z, a1.w}; \
                    _Pragma("unroll") for (int q = 0; q < 8; ++q) { (dst)[2 * q] = __uint_as_float(wv[q] << 16); (dst)[2 * q + 1] = __uint_as_float(wv[q] & 0xffff0000u); } } while (0)
#pragma unroll 1
                for (int n = 0; n < NCH; ++n) {
                    if (n + AHEAD < NCH) S2_DMA(n + AHEAD);
                    if (wave == 0) {
                        const LAS unsigned char* sl = lds + (n % NSL) * SLOT;
                        const bf16x8_t x00 = accop<0>(X0), x01 = accop<1>(X0), x10 = accop<0>(X1), x11 = accop<1>(X1);
                        f32x16 Yc, N0, N1;
                        S2_UNPK(Yc, 12288 + 4096); S2_UNPK(N0, 12288); S2_UNPK(N1, 12288 + 2048);
                        Yc = mm32(S2_FRAG(8192 + 0 * 1024), x00, Yc); Yc = mm32(S2_FRAG(8192 + 1 * 1024), x01, Yc); Yc = mm32(S2_FRAG(8192 + 2 * 1024), x10, Yc); Yc = mm32(S2_FRAG(8192 + 3 * 1024), x11, Yc);
                        N0 = mm32(S2_FRAG((0 * 2 + 0) * 1024), x00, N0); N0 = mm32(S2_FRAG((0 * 2 + 1) * 1024), x01, N0); N0 = mm32(S2_FRAG((2 * 2 + 0) * 1024), x10, N0); N0 = mm32(S2_FRAG((2 * 2 + 1) * 1024), x11, N0);
                        N1 = mm32(S2_FRAG((1 * 2 + 0) * 1024), x00, N1); N1 = mm32(S2_FRAG((1 * 2 + 1) * 1024), x01, N1); N1 = mm32(S2_FRAG((3 * 2 + 0) * 1024), x10, N1); N1 = mm32(S2_FRAG((3 * 2 + 1) * 1024), x11, N1);
                        X0 = N0; X1 = N1;
                        float* yp = Y + ((size_t)b * SEQ + (size_t)n * 32) * RW + h * HS + u * 32 + r32;
#pragma unroll
                        for (int e = 0; e < 16; ++e) yp[(size_t)rowidx(e, hh) * RW] = Yc[e];
                        asm volatile("s_waitcnt lgkmcnt(0)" ::: "memory");
                    } else if (wave >= 2) {
                        const int younger = (NCH - 1 - (n + 1)) < (AHEAD - 1) ? (NCH - 1 - (n + 1)) : (AHEAD - 1);
                        if (younger >= 5) asm volatile("s_waitcnt vmcnt(15)" ::: "memory"); else if (younger == 4) asm volatile("s_waitcnt vmcnt(12)" ::: "memory"); else if (younger == 3) asm volatile("s_waitcnt vmcnt(9)" ::: "memory");
                        else if (younger == 2) asm volatile("s_waitcnt vmcnt(6)" ::: "memory"); else if (younger == 1) asm volatile("s_waitcnt vmcnt(3)" ::: "memory"); else asm volatile("s_waitcnt vmcnt(0)" ::: "memory");
                    }
                    __builtin_amdgcn_s_barrier();
                }
#undef S2_FRAG
#undef S2_UNPK
#undef S2_DMA
            }
        }
        SEAM(pb + 3);

        if (IN(pb + 4)) { PHASE_IDS
            const int c8 = (tid & 63) * 8, hd = (tid & 63) >> 3, tsub = tid >> 6;
            const f32x4 lg0 = *(const f32x4*)(INP(19) + l * RW + c8), lg1 = *(const f32x4*)(INP(19) + l * RW + c8 + 4), lb0 = *(const f32x4*)(INP(20) + l * RW + c8), lb1 = *(const f32x4*)(INP(20) + l * RW + c8 + 4);
            for (int tile = bx; tile < T / 8; tile += G) {
                const int t = tile * 8 + tsub; const size_t o = (size_t)t * RW + c8;
                const f32x4 y0 = *(const f32x4*)(Y + o), y1 = *(const f32x4*)(Y + o + 4); const u32x4 gq = *(const u32x4*)(Gb + o), vq = *(const u32x4*)(BGb + o); const float bsum = BSUM[(size_t)t * NH + hd];
                float sm = (y0.x + y0.y) + (y0.z + y0.w) + (y1.x + y1.y) + (y1.z + y1.w);
                sm += dppf<0xB1>(sm); sm += dppf<0x4E>(sm); sm += dppf<0x141>(sm);
                const float mean = sm * (1.f / 64.f);
                const f32x4 d0 = y0 - mean, d1 = y1 - mean;
                float sq = (d0.x * d0.x + d0.y * d0.y) + (d0.z * d0.z + d0.w * d0.w) + (d1.x * d1.x + d1.y * d1.y) + (d1.z * d1.z + d1.w * d1.w);
                sq += dppf<0xB1>(sq); sq += dppf<0x4E>(sq); sq += dppf<0x141>(sq);
                const float rs = rsqrtf(sq * (1.f / 64.f) + GN_EPS);
                const f32x4 n0 = d0 * rs * lg0 + lb0, n1 = d1 * rs * lg1 + lb1;
                const unsigned gw_[4] = {gq.x, gq.y, gq.z, gq.w}, vw_[4] = {vq.x, vq.y, vq.z, vq.w}; const float nn[8] = {n0.x, n0.y, n0.z, n0.w, n1.x, n1.y, n1.z, n1.w}; unsigned ow[4];
#pragma unroll
                for (int i = 0; i < 4; ++i) { const float g0 = __uint_as_float(gw_[i] << 16), g1 = __uint_as_float(gw_[i] & 0xffff0000u), v0 = __uint_as_float(vw_[i] << 16), v1 = __uint_as_float(vw_[i] & 0xffff0000u);
                    ow[i] = pk2(nn[2 * i] * g0 + v0 * bsum, nn[2 * i + 1] * g1 + v1 * bsum); }
                *(u32x4*)(MIX + (size_t)t * D + c8) = (u32x4){ow[0], ow[1], ow[2], ow[3]};
            }
        }
        SEAM(pb + 4);
        if (IN(pb + 5)) { PHASE_IDS
            pg8::Gemm g{MIX, WoutT + (size_t)l * D * D, T, D, D}; pg8::StaticOrder S; S.init(T, D, G, bx);
            pg8::EpiResGate E{xin, X, modl + 2 * D};
            pg8::gemm_phase<pg8::EpiResGate, pg8::StaticOrder, true, true>(lds, g, S, E, tid); }
        SEAM(pb + 5);
        if (IN(pb + 6)) { PHASE_IDS const float* gamma = INP(24) + l * D;
            for (int row = gw; row < T; row += NGW) { const int b = row / SEQ; norm_mod_row(X + (size_t)row * D, gamma, modl + (size_t)b * 6 * D + 3 * D, modl + (size_t)b * 6 * D + 4 * D, H + (size_t)row * D, lane); } }
        SEAM(pb + 6);
        if (IN(pb + 7)) { PHASE_IDS
            pg8::Gemm g{H, PqT + (size_t)l * PH * PQ * D, T, PH * PQ, D}; pg8::StaticOrder S; S.init(T, PH * PQ, G, bx);
            pg8::EpiBf16<0> E{Q, PH * PQ, nullptr, 0, 0, 1.f};
            pg8::gemm_phase<pg8::EpiBf16<0>, pg8::StaticOrder, true, true>(lds, g, S, E, tid); }
        SEAM(pb + 7);

        if (IN(pb + 8)) { PHASE_IDS
            const bf16* KEYSl = KEYS + (size_t)l * PH * 2 * NKEYS * PHALF;
            LAS unsigned char* scr = lds + wave * 2048 + lane * 32;
            constexpr int KST = 136;
            lbf16* kl = (lbf16*)(lds + 16384);
            const int r = lane & 31, hh = lane >> 5;
            for (int item = bx; item < (T / 256) * PH; item += G) {
                const int h = item & 7, tok = (item >> 3) * 256 + wave * 32 + r;
                __syncthreads();
                { u32x4 kq[8];
#pragma unroll
                  for (int q = 0; q < 8; ++q) { const int ch = tid + q * NTHR; kq[q] = *(const u32x4*)(KEYSl + (size_t)(h * 2) * NKEYS * PHALF + (size_t)ch * 8); }
#pragma unroll
                  for (int q = 0; q < 8; ++q) { const int ch = tid + q * NTHR, row = ch >> 4, cc = ch & 15; *(__attribute__((address_space(3))) u32x4*)(kl + row * KST + cc * 8) = kq[q]; } }
                __syncthreads();
                unsigned sp0[16], sp1[16];
#pragma unroll
                for (int e = 0; e < 16; ++e) { sp0[e] = 0u; sp1[e] = 0u; }
#pragma unroll 1
                for (int p = 0; p < 2; ++p) {
                    const bf16* qp = Q + (size_t)tok * (PH * PQ) + h * PQ + p * PHALF + 8 * hh;
                    const lbf16* kp_ = kl + (p * NKEYS + r) * KST + 8 * hh;
                    bf16x8_t bq[8];
#pragma unroll
                    for (int ks = 0; ks < 8; ++ks) bq[ks] = *(const bf16x8_t*)(qp + ks * 16);
                    unsigned best[16];
#pragma unroll
                    for (int e = 0; e < 16; ++e) best[e] = 0u;
#pragma unroll 1
                    for (int kt = 0; kt < 4; ++kt) {
                        f32x16 acc;
#pragma unroll
                        for (int e = 0; e < 16; ++e) acc[e] = 0.f;
#pragma unroll
                        for (int ks = 0; ks < 8; ++ks) { const bf16x8_t ak = *(const __attribute__((address_space(3))) bf16x8_t*)(kp_ + kt * 32 * KST + ks * 16); acc = __builtin_amdgcn_mfma_f32_32x32x16_bf16(ak, bq[ks], acc, 0, 0, 0); }
                        unsigned g[16];
#pragma unroll
                        for (int e = 0; e < 16; ++e) g[e] = pack_key7(acc[e], kt * 32 + (e & 3) + 8 * (e >> 2) + 4 * hh);
                        sort16_desc(g);
                        merge_top16(best, g);
                    }
                    unsigned ob[16];
#pragma unroll
                    for (int e = 0; e < 16; ++e) ob[e] = shflxu(best[e], lane, 32);
                    merge_top16(best, ob);
#pragma unroll
                    for (int e = 0; e < 16; ++e) { sp0[e] = p == 0 ? best[e] : sp0[e]; sp1[e] = p == 0 ? sp1[e] : best[e]; }
                }
                unsigned c2[32];
                stage2_cands(sp0, sp1, hh, c2);
                sort16_desc(c2); sort16_desc(c2 + 16); merge_top16(c2, c2 + 16);
                { unsigned ob[16];
#pragma unroll
                  for (int e = 0; e < 16; ++e) ob[e] = shflxu(c2[e], lane, 32);
                  merge_top16(c2, ob); }
#pragma unroll
                for (int e = 0; e < 16; e += 4) {
                    *(LAS unsigned*)(scr + e) = (127u - (sp0[e] & 127u)) | ((127u - (sp0[e + 1] & 127u)) << 8) | ((127u - (sp0[e + 2] & 127u)) << 16) | ((127u - (sp0[e + 3] & 127u)) << 24);
                    *(LAS unsigned*)(scr + 16 + e) = (127u - (sp1[e] & 127u)) | ((127u - (sp1[e + 1] & 127u)) << 8) | ((127u - (sp1[e + 2] & 127u)) << 16) | ((127u - (sp1[e + 3] & 127u)) << 24); }
                asm volatile("s_waitcnt lgkmcnt(0)" ::: "memory");
                float sm[16]; int ex[16];
#pragma unroll
                for (int e = 0; e < 16; ++e) { const unsigned key = c2[e]; sm[e] = unpack_key8(key); const int i0 = (key >> 4) & 15, j0 = key & 15; ex[e] = (int)scr[i0] * NKEYS + (int)scr[16 + j0]; }
                float den = 0.f;
#pragma unroll
                for (int e = 0; e < 16; ++e) { sm[e] = expf(sm[e] - unpack_key8(c2[0])); den += sm[e]; }
                const float inv = 1.f / den;
                if (hh == 0) {
                    int* ip = IDX + (size_t)tok * NE + h * TOPK; float* gp = GATE + (size_t)tok * NE + h * TOPK;
#pragma unroll
                    for (int e = 0; e < 16; e += 4) { *(int4*)(ip + e) = make_int4(ex[e], ex[e + 1], ex[e + 2], ex[e + 3]); *(f32x4*)(gp + e) = (f32x4){sm[e] * inv, sm[e + 1] * inv, sm[e + 2] * inv, sm[e + 3] * inv}; }
                }
                asm volatile("s_waitcnt lgkmcnt(0)" ::: "memory");
            }
        }
        SEAM(pb + 8);

        if (IN(pb + 9)) { PHASE_IDS
            const unsigned char* Ul = U8 + (size_t)l * NEXP * ROWB; const unsigned char* Vtl = V8 + (size_t)l * NEXP * ROWB; const float* usl = USc + l * NEXP; const float* vsl = VSc + l * NEXP; const float* lnf = INP(29);
            const bool fin = (l == DEPTH - 1);
            typedef float f32x2_t __attribute__((ext_vector_type(2)));
            const __amdgpu_buffer_rsrc_t ru = __builtin_amdgcn_make_buffer_rsrc((void*)Ul, 0, NEXP * ROWB, 0x00020000), rv = __builtin_amdgcn_make_buffer_rsrc((void*)Vtl, 0, NEXP * ROWB, 0x00020000);
            const int voff = lane * 12;
            typedef float f32x32_t __attribute__((ext_vector_type(32))); typedef unsigned u32x3_t __attribute__((ext_vector_type(3))); typedef unsigned u32x6_t __attribute__((ext_vector_type(6)));
            LAS float* pl = (LAS float*)(lds + wave * 8704);
            for (int t = gw; t < T; t += NGW) {
                const int b = t / SEQ;
                f32x2_t hf2[8];
                { const u32x4 h0 = *(const u32x4*)(H + (size_t)t * D + lane * 16), h1 = *(const u32x4*)(H + (size_t)t * D + lane * 16 + 8);
                  hf2[0] = (f32x2_t){__uint_as_float(h0.x << 16), __uint_as_float(h0.x & 0xffff0000u)}; hf2[1] = (f32x2_t){__uint_as_float(h0.y << 16), __uint_as_float(h0.y & 0xffff0000u)};
                  hf2[2] = (f32x2_t){__uint_as_float(h0.z << 16), __uint_as_float(h0.z & 0xffff0000u)}; hf2[3] = (f32x2_t){__uint_as_float(h0.w << 16), __uint_as_float(h0.w & 0xffff0000u)};
                  hf2[4] = (f32x2_t){__uint_as_float(h1.x << 16), __uint_as_float(h1.x & 0xffff0000u)}; hf2[5] = (f32x2_t){__uint_as_float(h1.y << 16), __uint_as_float(h1.y & 0xffff0000u)};
                  hf2[6] = (f32x2_t){__uint_as_float(h1.z << 16), __uint_as_float(h1.z & 0xffff0000u)}; hf2[7] = (f32x2_t){__uint_as_float(h1.w << 16), __uint_as_float(h1.w & 0xffff0000u)}; }
                f32x2_t acc2[8];
#pragma unroll
                for (int i = 0; i < 8; ++i) acc2[i] = (f32x2_t){0.f, 0.f};
                int myidx = IDX[(size_t)t * NE + (lane & 31)]; float mygate = GATE[(size_t)t * NE + (lane & 31)];
                float myus = usl[myidx], myvs = vsl[myidx];
#define ROWLD(dst, rs, ix, e) dst = __builtin_amdgcn_raw_buffer_load_b96(rs, voff, __builtin_amdgcn_readlane(ix, (e)) * ROWB, 0)
#define LOADB(buf, rs, ix, e0) do { _Pragma("unroll") for (int j_ = 0; j_ < 4; ++j_) ROWLD((buf)[j_], rs, ix, (e0) + j_); __builtin_amdgcn_sched_barrier(0); } while (0)
#define CVT2(a, b) const f32x32_t f_ = __builtin_amdgcn_cvt_scalef32_pk32_f32_fp6((u32x6_t){(a).x, (a).y, (a).z, (b).x, (b).y, (b).z}, 1.0f)
#define PR(i) __builtin_shufflevector(f_, f_, 2 * (i), 2 * (i) + 1)
#define DOTB(buf, e0) do { _Pragma("unroll") for (int j_ = 0; j_ < 4; j_ += 2) { CVT2((buf)[j_], (buf)[j_ + 1]); \
                        f32x2_t a_ = hf2[0] * PR(0), b_ = hf2[0] * PR(8); a_ += hf2[1] * PR(1); b_ += hf2[1] * PR(9); a_ += hf2[2] * PR(2); b_ += hf2[2] * PR(10); a_ += hf2[3] * PR(3); b_ += hf2[3] * PR(11); \
                        a_ += hf2[4] * PR(4); b_ += hf2[4] * PR(12); a_ += hf2[5] * PR(5); b_ += hf2[5] * PR(13); a_ += hf2[6] * PR(6); b_ += hf2[6] * PR(14); a_ += hf2[7] * PR(7); b_ += hf2[7] * PR(15); \
                        pl[((e0) + j_) * 68 + lane] = a_.x + a_.y; pl[((e0) + j_ + 1) * 68 + lane] = b_.x + b_.y; } } while (0)
#define AXPYB(buf, e0) do { _Pragma("unroll") for (int j_ = 0; j_ < 4; j_ += 2) { CVT2((buf)[j_], (buf)[j_ + 1]); \
                        const float ca = __int_as_float(__builtin_amdgcn_readlane(__float_as_int(coef), (e0) + j_)), cb = __int_as_float(__builtin_amdgcn_readlane(__float_as_int(coef), (e0) + j_ + 1)); \
                        acc2[0] += ca * PR(0); acc2[1] += ca * PR(1); acc2[2] += ca * PR(2); acc2[3] += ca * PR(3); acc2[4] += ca * PR(4); acc2[5] += ca * PR(5); acc2[6] += ca * PR(6); acc2[7] += ca * PR(7); \
                        acc2[0] += cb * PR(8); acc2[1] += cb * PR(9); acc2[2] += cb * PR(10); acc2[3] += cb * PR(11); acc2[4] += cb * PR(12); acc2[5] += cb * PR(13); acc2[6] += cb * PR(14); acc2[7] += cb * PR(15); } } while (0)
                u32x3_t ba[4], bb_[4];
                LOADB(ba, ru, myidx, 0);
#pragma unroll 1
                for (int q = 0; q < 4; ++q) {
                    int nidx = 0; float ngate = 0.f;
                    if (q < 3) { nidx = IDX[(size_t)t * NE + (q + 1) * 32 + (lane & 31)]; ngate = GATE[(size_t)t * NE + (q + 1) * 32 + (lane & 31)]; }
#pragma unroll
                    for (int e0 = 0; e0 < 32; e0 += 8) {
                        LOADB(bb_, ru, myidx, e0 + 4); DOTB(ba, e0);
                        if (e0 + 8 < 32) LOADB(ba, ru, myidx, e0 + 8); else LOADB(ba, rv, myidx, 0);
                        DOTB(bb_, e0 + 4);
                    }
                    const float nus = usl[nidx], nvs = vsl[nidx];
                    __builtin_amdgcn_wave_barrier(); asm volatile("s_waitcnt lgkmcnt(0)" ::: "memory");
                    float dsum;
                    { const LAS float* rp = pl + (lane & 31) * 68 + (lane >> 5) * 32; f32x4 s4 = *(const LAS f32x4*)rp;
#pragma unroll
                      for (int j = 1; j < 8; ++j) s4 += *(const LAS f32x4*)(rp + j * 4);
                      dsum = (s4.x + s4.y) + (s4.z + s4.w); }
                    dsum += shflx(dsum, lane, 32);
                    __builtin_amdgcn_wave_barrier(); asm volatile("s_waitcnt lgkmcnt(0)" ::: "memory");
                    const float coef = mygate * gelu_erf(dsum * myus) * myvs;
#pragma unroll
                    for (int e0 = 0; e0 < 32; e0 += 8) {
                        LOADB(bb_, rv, myidx, e0 + 4); AXPYB(ba, e0);
                        if (e0 + 8 < 32) LOADB(ba, rv, myidx, e0 + 8); else if (q < 3) LOADB(ba, ru, nidx, 0);
                        AXPYB(bb_, e0 + 4);
                    }
                    myidx = nidx; mygate = ngate; myus = nus; myvs = nvs;
                }
#undef ROWLD
#undef LOADB
#undef CVT2
#undef PR
#undef DOTB
#undef AXPYB
                float* xr = X + (size_t)t * D + lane * 16; const float* g2 = modl + (size_t)b * 6 * D + 5 * D + lane * 16;
                f32x4 xv[4]; float ss = 0.f;
#pragma unroll
                for (int q = 0; q < 4; ++q) { const f32x4 xo = *(const f32x4*)(xr + q * 4), gg = *(const f32x4*)(g2 + q * 4);
                    xv[q] = xo + gg * (f32x4){acc2[q * 2].x, acc2[q * 2].y, acc2[q * 2 + 1].x, acc2[q * 2 + 1].y}; ss += (xv[q].x * xv[q].x + xv[q].y * xv[q].y) + (xv[q].z * xv[q].z + xv[q].w * xv[q].w); }
                const float rs = rsqrtf(wave_sum(ss, lane) * (1.f / D) + NORM_EPS);
                if (fin) {
#pragma unroll
                    for (int q = 0; q < 4; ++q) xv[q] = xv[q] * rs * *(const f32x4*)(lnf + lane * 16 + q * 4); }
                else {
                    const float* gam = INP(4) + (l + 1) * D + lane * 16; const float* mn = MOD + (size_t)(l + 1) * BATCH * 6 * D + (size_t)b * 6 * D + lane * 16; u32x4 ho[2];
#pragma unroll
                    for (int q = 0; q < 4; ++q) { const f32x4 y = xv[q] * rs * *(const f32x4*)(gam + q * 4) * (*(const f32x4*)(mn + D + q * 4) + 1.f) + *(const f32x4*)(mn + q * 4);
                        if (q & 1) { ho[q >> 1].z = pk2(y.x, y.y); ho[q >> 1].w = pk2(y.z, y.w); } else { ho[q >> 1].x = pk2(y.x, y.y); ho[q >> 1].y = pk2(y.z, y.w); } }
                    *(u32x4*)(H + (size_t)t * D + lane * 16) = ho[0]; *(u32x4*)(H + (size_t)t * D + lane * 16 + 8) = ho[1]; }
#pragma unroll
                for (int q = 0; q < 4; ++q) *(f32x4*)(xr + q * 4) = xv[q];
            }
        }
    }
#undef modl
#undef xin
#undef IN
#undef SEAM
}
#undef MOD
#undef H
#undef PROJ
#undef Q
#undef MIX
#undef Rb
#undef Kb
#undef V0
#undef V1
#undef KKb
#undef Bb
#undef Gb
#undef BGb
#undef Wd
#undef Y
#undef IDX
#undef GATE
#undef WinT
#undef WoutT
#undef PqT
#undef KEYS
#undef QB
#undef SH
#undef WUPT
#undef AUPT
#undef GUPT
#undef VUPT
#undef PWT
#undef INVN
#undef BSUM
#undef SCN
#undef U8
#undef V8
#undef USc
#undef VSc
#undef INP
#undef PHASE_IDS

extern "C" void kernel_launch(void* const* d_in, const int* in_sizes, int n_in, void* d_out, int out_size, void* d_ws, size_t ws_size, hipStream_t stream) {
    if (n_in != 30 || ws_size < WS_END) { fprintf(stderr, "kernel_launch: unexpected n_in %d / ws_size %zu\n", n_in, ws_size); return; }
    static int grid = 0;
    if (grid == 0) {
        int dev = 0, cus = 0, per_cu = 0;
        (void)hipGetDevice(&dev); (void)hipDeviceGetAttribute(&cus, hipDeviceAttributeMultiprocessorCount, dev);
        if (hipFuncSetAttribute((const void*)mega, hipFuncAttributeMaxDynamicSharedMemorySize, LDS_BYTES) != hipSuccess) { fprintf(stderr, "hipFuncSetAttribute failed\n"); grid = -1; return; }
        if (hipOccupancyMaxActiveBlocksPerMultiprocessor(&per_cu, (const void*)mega, NTHR, LDS_BYTES) != hipSuccess || per_cu < 1) { fprintf(stderr, "occupancy query failed (%d)\n", per_cu); per_cu = 1; }
        (void)hipGetLastError();
        grid = (cus > 0 ? cus : 256) * 1;
    }
    if (grid < 0) return;
    Args a{}; for (int i = 0; i < 30; ++i) a.in[i] = (const float*)d_in[i]; a.out = (float*)d_out; a.ws = (unsigned char*)d_ws;
    a.ph_lo = 0; a.ph_hi = NPH;
    if (hipMemsetAsync(d_ws, 0, 65536, stream) != hipSuccess) { fprintf(stderr, "memset failed\n"); return; }
    void* kargs[] = {&a};
    hipError_t e = hipLaunchCooperativeKernel((const void*)mega, dim3(grid), dim3(NTHR), kargs, LDS_BYTES, stream);
    if (e != hipSuccess) fprintf(stderr, "cooperative launch failed: %s (grid %d)\n", hipGetErrorString(e), grid);
}
```

```cpp
#include <hip/hip_runtime.h>
#include <hip/hip_cooperative_groups.h>
namespace cg = cooperative_groups;
#include <cstdio>
#include <cstdint>
#include <cmath>

constexpr int D = 1024, BATCH = 4, SEQ = 4096, T = BATCH * SEQ, DEPTH = 2;
constexpr int RW = 512, HS = 64, NH = 8;
constexpr int DL = 64, AL = 64, MVL = 32, GL = 128;
constexpr int RWKV_COLS = 3 * RW + DL + AL + GL;
constexpr int PW = 512, PG = 128;
constexpr int IN_COLS = RWKV_COLS + PW;
constexpr int LDP = 2560;
constexpr int NKEYS = 128, NEXP = NKEYS * NKEYS, PH = 8, PQ = 256, PHALF = 128, TOPK = 16;
constexpr int NE = PH * TOPK;
constexpr float NORM_EPS = 1e-6f, GN_EPS = 64e-5f;

typedef unsigned short bf16;
__device__ __forceinline__ float bf2f(bf16 u) { return __uint_as_float((unsigned)u << 16); }
typedef float cvt_f32x2 __attribute__((ext_vector_type(2))); typedef __bf16 cvt_bf16x2 __attribute__((ext_vector_type(2)));
__device__ __forceinline__ unsigned cvtpk(float lo, float hi) { const cvt_f32x2 v = {lo, hi}; const cvt_bf16x2 b = __builtin_convertvector(v, cvt_bf16x2); return __builtin_bit_cast(unsigned, b); }
__device__ __forceinline__ bf16 f2bf(float f) { return (bf16)cvtpk(f, 0.f); }

constexpr size_t MiB = 1u << 20;
constexpr size_t WS_MOD = 1 * MiB;
constexpr size_t WS_US = 1 * MiB + 256 * 1024;
constexpr size_t WS_VS = 1 * MiB + 512 * 1024;
constexpr size_t WS_H = 2 * MiB;
constexpr size_t WS_PROJ = 34 * MiB;
constexpr size_t WS_Q = WS_PROJ;
constexpr size_t WS_R = 114 * MiB;
constexpr size_t WS_K = 130 * MiB;
constexpr size_t WS_V0 = 146 * MiB;
constexpr size_t WS_V1 = 162 * MiB;
constexpr size_t WS_KK = 178 * MiB;
constexpr size_t WS_B = 194 * MiB;
constexpr size_t WS_G = 210 * MiB;
constexpr size_t WS_BG = 226 * MiB;
constexpr size_t WS_W = 242 * MiB;
constexpr size_t WS_Y = 274 * MiB;
constexpr size_t WS_MIX = 306 * MiB;
constexpr size_t WS_IDX = 338 * MiB;
constexpr size_t WS_GATE = 346 * MiB;
constexpr size_t WS_WIN_T = 354 * MiB;
constexpr size_t WS_WOUT_T = 364 * MiB;
constexpr size_t WS_PQ_T = 368 * MiB;
constexpr size_t WS_KEYS = 376 * MiB;
constexpr size_t WS_U = 378 * MiB;
constexpr size_t WS_V = 442 * MiB;
constexpr size_t WS_QB = 410 * MiB;
constexpr size_t WS_SH = 426 * MiB;
constexpr size_t WS_LORA = 428 * MiB;
constexpr size_t WS_INVN = 430 * MiB;
constexpr size_t WS_BSUM = 431 * MiB;
constexpr size_t WS_SCN = 2 * MiB;
constexpr size_t WS_END = 506 * MiB;

template <int CTRL> __device__ __forceinline__ float dppf(float x) { return __int_as_float(__builtin_amdgcn_update_dpp(0, __float_as_int(x), CTRL, 0xF, 0xF, false)); }
__device__ __forceinline__ float red16(float x) { x += dppf<0xB1>(x); x += dppf<0x4E>(x); x += dppf<0x141>(x); x += dppf<0x140>(x); return x; }
__device__ __forceinline__ float shflx(float v, int lane, int off) { return __int_as_float(__builtin_amdgcn_ds_bpermute((lane ^ off) << 2, __float_as_int(v))); }
__device__ __forceinline__ unsigned shflxu(unsigned v, int lane, int off) { return (unsigned)__builtin_amdgcn_ds_bpermute((lane ^ off) << 2, (int)v); }
__device__ __forceinline__ void sort128(unsigned& k0, unsigned& k1, int lane) {
#pragma unroll
    for (int k = 2; k <= 128; k <<= 1) {
#pragma unroll
        for (int j = k >> 1; j > 0; j >>= 1) {
            if (j == 64) { const unsigned lo = k0 < k1 ? k0 : k1, hi = k0 < k1 ? k1 : k0; k0 = lo; k1 = hi; }
            else {
                const unsigned p0 = shflxu(k0, lane, j), p1 = shflxu(k1, lane, j);
                const bool lower = (lane & j) == 0, up0 = (lane & k) == 0, up1 = ((lane + 64) & k) == 0;
                const unsigned mn0 = k0 < p0 ? k0 : p0, mx0 = k0 < p0 ? p0 : k0, mn1 = k1 < p1 ? k1 : p1, mx1 = k1 < p1 ? p1 : k1;
                k0 = (lower == up0) ? mn0 : mx0; k1 = (lower == up1) ? mn1 : mx1;
            }
        }
    }
}
__device__ __forceinline__ float wave_sum(float v, int lane) { v = red16(v); v += shflx(v, lane, 16); v += shflx(v, lane, 32); return v; }
__device__ __forceinline__ float sigmoidf_(float x) { return 1.f / (1.f + expf(-x)); }

namespace pg8 {
#define PG8_LAS __attribute__((address_space(3)))
typedef unsigned short bf16_t;
typedef short bf16x8 __attribute__((ext_vector_type(8)));
typedef float f32x4 __attribute__((ext_vector_type(4)));
typedef unsigned u32x4 __attribute__((ext_vector_type(4)));
constexpr int BM = 256, BK = 64, HALF = 128, HTB = HALF * BK * 2  , STAGE_BYTES = 8 * HTB, NXCD = 8, WGM = 8;

__host__ __device__ __forceinline__ int lds_byte(int r, int c) { const int st = (r >> 4) * 2 + (c >> 5), rr = r & 15, cc = c & 31, ob = rr * 64 + cc * 2; return st * 1024 + (ob ^ (((ob >> 9) & 1) << 5)); }
__host__ __device__ __forceinline__ void stage_rc(int b, int& R, int& C) { const int st = b / 1024, sb = b % 1024, swz = sb ^ (((sb >> 9) & 1) << 5); R = (st >> 1) * 16 + swz / 64; C = (st & 1) * 32 + (swz % 64) / 2; }
__host__ __device__ __forceinline__ int perm32(int rho) { const int n = rho >> 4, i = rho & 15; return 8 * (i >> 2) + 4 * n + (i & 3); }

struct Unit { int pm, pn; };
struct Gemm { const bf16_t* A; const bf16_t* Bt; int M, N, K; };

struct StaticOrder {
    int nM, nN, nwg, G, c;
    __host__ __device__ void init(int M, int N, int G_, int c_) { nM = M / BM; nN = N / BM; nwg = nM * nN; G = G_; c = c_; }
    __host__ __device__ bool next(int i, Unit& u) const {
        const long L = (long)i * G + c; if (L >= nwg) return false;
        int wgid = (int)L; { const int q = nwg / NXCD, r = nwg % NXCD, xcd = wgid % NXCD, off = wgid / NXCD; wgid = (xcd < r ? xcd * (q + 1) : r * (q + 1) + (xcd - r) * q) + off; }
        const int nig = WGM * nN, gid = wgid / nig, fm = gid * WGM, gsz = (nM - fm) < WGM ? (nM - fm) : WGM;
        u.pm = fm + ((wgid % nig) % gsz); u.pn = (wgid % nig) / gsz; return true;
    }
    __device__ __forceinline__ void a_ready(const Unit&) const {}
    __device__ __forceinline__ void done(const Unit&) const {}
};

__device__ __forceinline__ unsigned cvt_pk_bf16(float lo, float hi) { unsigned r; asm volatile("v_cvt_pk_bf16_f32 %0, %1, %2" : "=v"(r) : "v"(lo), "v"(hi)); return r; }
typedef float f32x2 __attribute__((ext_vector_type(2)));
__device__ __forceinline__ f32x2 gelu_pk(f32x2 v) {
    const f32x2 av = __builtin_elementwise_abs(v), d = av * 0.2316418882f + 1.0f;
    f32x2 t; t.x = __builtin_amdgcn_rcpf(d.x); t.y = __builtin_amdgcn_rcpf(d.y);
    f32x2 q = t * 0.5307027145f + (-0.7265760135f); q = q * t + 0.7107068705f; q = q * t + (-0.142248368f); q = q * t + 0.127414796f; q = q * t;
    const f32x2 s = (v * v) * (-0.72134752044f);
    f32x2 e; e.x = __builtin_amdgcn_exp2f(s.x); e.y = __builtin_amdgcn_exp2f(s.y);
    const f32x2 m = v * (q * e), r = v - m;
    f32x2 o; o.x = v.x < 0.f ? m.x : r.x; o.y = v.y < 0.f ? m.y : r.y; return o;
}

template <int ACT  > struct EpiBf16 {
    static constexpr bool PERM = true, AFTER_DRAIN = false; static_assert(ACT == 0 || ACT == 1, "EpiBf16: ACT is 0 (none) or 1 (gelu_pk)");
    bf16_t* O; int ldc; const float* bias; int split_cols; size_t split_stride; float scale0;
    __device__ __forceinline__ void operator()(const f32x4 (&acc)[2][2][4][2], const Unit& u, int wr, int wc, int fr, int fq) const {
        const int row0 = u.pm * BM + wr * 64 + fr; int colt = u.pn * BM; bf16_t* base = O;
        float sc = 1.f; if (split_cols) { const int t = colt / split_cols; base += (size_t)t * split_stride; colt -= t * split_cols; if (t == 0) sc = scale0; }
        const int col0 = colt + wc * 32 + 8 * fq, bcol0 = u.pn * BM + wc * 32 + 8 * fq;
        f32x4 bv[2][2];
#pragma unroll
        for (int bj = 0; bj < 2; ++bj)
#pragma unroll
            for (int n = 0; n < 2; ++n) bv[bj][n] = bias ? *(const f32x4*)(bias + bcol0 + bj * HALF + 4 * n) : (f32x4){0.f, 0.f, 0.f, 0.f};
#pragma unroll
        for (int ai = 0; ai < 2; ++ai)
#pragma unroll
            for (int m = 0; m < 4; ++m) { bf16_t* rowp = base + (size_t)(row0 + ai * HALF + m * 16) * ldc + col0;
#pragma unroll
                for (int bj = 0; bj < 2; ++bj) { f32x4 v0 = acc[ai][bj][m][0] + bv[bj][0], v1 = acc[ai][bj][m][1] + bv[bj][1];
                    if (ACT == 1) { f32x2 a = gelu_pk((f32x2){v0[0], v0[1]}), b = gelu_pk((f32x2){v0[2], v0[3]}), c = gelu_pk((f32x2){v1[0], v1[1]}), d = gelu_pk((f32x2){v1[2], v1[3]});
                        v0 = (f32x4){a.x, a.y, b.x, b.y}; v1 = (f32x4){c.x, c.y, d.x, d.y}; }
                    v0 = v0 * sc; v1 = v1 * sc; u32x4 w; w.x = cvt_pk_bf16(v0[0], v0[1]); w.y = cvt_pk_bf16(v0[2], v0[3]); w.z = cvt_pk_bf16(v1[0], v1[1]); w.w = cvt_pk_bf16(v1[2], v1[3]);
                    *(u32x4*)(rowp + bj * HALF) = w; } }
    }
};

struct EpiResGate {
    static constexpr bool PERM = false, AFTER_DRAIN = false;
    const float* xold; float* X; const float* gate;
    __device__ __forceinline__ void operator()(const f32x4 (&acc)[2][2][4][2], const Unit& u, int wr, int wc, int fr, int fq) const {
        const int col0 = u.pn * BM + wc * 32 + 4 * fq; const int b = (u.pm * BM) / SEQ;
        const float* gp = gate + (size_t)b * 6 * D + col0;
#pragma unroll
        for (int bj = 0; bj < 2; ++bj)
#pragma unroll
            for (int n = 0; n < 2; ++n) { const f32x4 gv = *(const f32x4*)(gp + bj * HALF + n * 16);
#pragma unroll
                for (int ai = 0; ai < 2; ++ai)
#pragma unroll
                    for (int m = 0; m < 4; ++m) { const size_t off = (size_t)(u.pm * BM + ai * HALF + wr * 64 + m * 16 + fr) * D + col0 + bj * HALF + n * 16;
                        const f32x4 xo = *(const f32x4*)(xold + off); *(f32x4*)(X + off) = xo + gv * acc[ai][bj][m][n]; } }
    }
};
template <class Epi, class Sched, bool ALIGN_EPI = false, bool SP2 = false>
__device__ __forceinline__ void gemm_phase(PG8_LAS unsigned char* lds, const Gemm g, const Sched& S, const Epi& E, int tid) {
    asm volatile("" : "+v"(tid));
    const int wid = __builtin_amdgcn_readfirstlane(tid >> 6), lane = tid & 63, wr = wid >> 2, wc = wid & 3, fr = lane & 15, fq = lane >> 4;
    const int K = g.K, nt = K / BK;
    unsigned voffA[2], voffB[2];
#pragma unroll
    for (int i = 0; i < 2; ++i) { int R, C; stage_rc(tid * 16 + i * 8192, R, C); const int Rb = Epi::PERM ? ((R & ~31) + perm32(R & 31)) : R;
        voffA[i] = (unsigned)(R * K + C) * 2u; voffB[i] = (unsigned)(Rb * K + C) * 2u; }
    const size_t kstep = (size_t)(BK * 2);
    const size_t hstep = (size_t)HALF * K * 2;
    const size_t tstep = 2 * hstep;
    const unsigned ldsw = (unsigned)wid * 1024u;
    const int aoff = lds_byte(wr * 64 + fr, fq * 8), boff = lds_byte(wc * 32 + fr, fq * 8);
#define PG8_SA(b, h) (((b) * 2 + (h)) * HTB)
#define PG8_SB(b, h) ((4 + (b) * 2 + (h)) * HTB)
#define PG8_STAGE(bufoff, gbase, voff) do { _Pragma("unroll") for (int _i = 0; _i < 2; ++_i) \
        __builtin_amdgcn_global_load_lds((const unsigned*)((const char*)(gbase) + (voff)[_i]), (PG8_LAS unsigned*)(lds + (bufoff) + ldsw + _i * 8192), 16, 0, 0); } while (0)
#define PG8_LDA(dst, b, h) do { _Pragma("unroll") for (int m = 0; m < 4; ++m) _Pragma("unroll") for (int k = 0; k < 2; ++k) dst[m][k] = *(const PG8_LAS bf16x8*)(lds + PG8_SA(b, h) + aoff + m * 2048 + k * 1024); } while (0)
#define PG8_LDB(dst, b, h) do { _Pragma("unroll") for (int n = 0; n < 2; ++n) _Pragma("unroll") for (int k = 0; k < 2; ++k) dst[n][k] = *(const PG8_LAS bf16x8*)(lds + PG8_SB(b, h) + boff + n * 2048 + k * 1024); } while (0)
#define PG8_MMA(ai, bj, At, Bt) do { __builtin_amdgcn_s_setprio(1); _Pragma("unroll") for (int m = 0; m < 4; ++m) _Pragma("unroll") for (int n = 0; n < 2; ++n) _Pragma("unroll") for (int k = 0; k < 2; ++k) \
        acc[ai][bj][m][n] = __builtin_amdgcn_mfma_f32_16x16x32_bf16(Bt[n][k], At[m][k], acc[ai][bj][m][n], 0, 0, 0); __builtin_amdgcn_s_setprio(0); } while (0)
#define PG8_WAIT_V(n) asm volatile("s_waitcnt vmcnt(" #n ")" ::: "memory")
#define PG8_WAIT_L(n) asm volatile("s_waitcnt lgkmcnt(" #n ")" ::: "memory")
#define PG8_BAR __builtin_amdgcn_s_barrier()
#define PG8_SCHED __builtin_amdgcn_sched_barrier(0)
    Unit cur, nxt; int ui = 0;
    if (!S.next(0, cur)) return;
    f32x4 acc[2][2][4][2];
#pragma unroll
    for (int a = 0; a < 2; ++a)
#pragma unroll
        for (int b = 0; b < 2; ++b)
#pragma unroll
            for (int m = 0; m < 4; ++m)
#pragma unroll
                for (int n = 0; n < 2; ++n) acc[a][b][m][n] = (f32x4){0.f, 0.f, 0.f, 0.f};
    bf16x8 At[4][2], B0[2][2], B1[2][2];
    const char* cA = (const char*)g.A + (size_t)cur.pm * tstep; const char* cB = (const char*)g.Bt + (size_t)cur.pn * tstep;
    S.a_ready(cur);
    if constexpr (SP2) {
        PG8_STAGE(PG8_SB(0, 0), cB, voffB); PG8_STAGE(PG8_SB(0, 1), cB + hstep, voffB); PG8_STAGE(PG8_SA(0, 0), cA, voffA); PG8_STAGE(PG8_SA(0, 1), cA + hstep, voffA);
        if (wr == 1) PG8_BAR;
        PG8_WAIT_V(2); PG8_BAR;
        PG8_STAGE(PG8_SB(1, 0), cB + kstep, voffB); PG8_STAGE(PG8_SA(1, 0), cA + kstep, voffA); PG8_STAGE(PG8_SB(1, 1), cB + hstep + kstep, voffB);
        PG8_WAIT_V(6); PG8_BAR;
    } else {
        PG8_STAGE(PG8_SB(0, 0), cB, voffB); PG8_STAGE(PG8_SA(0, 0), cA, voffA); PG8_STAGE(PG8_SB(0, 1), cB + hstep, voffB); PG8_STAGE(PG8_SA(0, 1), cA + hstep, voffA);
        if (wr == 1) PG8_BAR;
        PG8_WAIT_V(4); PG8_BAR;
        PG8_STAGE(PG8_SB(1, 0), cB + kstep, voffB); PG8_STAGE(PG8_SA(1, 0), cA + kstep, voffA); PG8_STAGE(PG8_SB(1, 1), cB + hstep + kstep, voffB);
        PG8_WAIT_V(6); PG8_BAR;
    }
    for (;;) {
        const bool has_next = S.next(ui + 1, nxt);
        const char* nA = has_next ? (const char*)g.A + (size_t)nxt.pm * tstep : cA; const char* nB = has_next ? (const char*)g.Bt + (size_t)nxt.pn * tstep : cB;
        for (int t = 0; t < nt; t += 2) {
            const bool last = (t == nt - 2);
            const char* a1 = cA + (size_t)(t + 1) * kstep;
            const char* a2 = last ? nA : cA + (size_t)(t + 2) * kstep; const char* b2 = last ? nB : cB + (size_t)(t + 2) * kstep;
            const char* a3 = a2 + kstep; const char* b3 = b2 + kstep;
            if (last && has_next) S.a_ready(nxt);
            if constexpr (SP2) {
            PG8_LDB(B0, 0, 0); PG8_LDB(B1, 0, 1); PG8_SCHED; PG8_LDA(At, 0, 0); PG8_STAGE(PG8_SA(1, 1), a1 + hstep, voffA);
            PG8_WAIT_V(8); PG8_WAIT_L(0); PG8_BAR; PG8_MMA(0, 0, At, B0); PG8_MMA(0, 1, At, B1); PG8_BAR; PG8_SCHED;
            PG8_LDA(At, 0, 1); PG8_STAGE(PG8_SB(0, 0), b2, voffB); PG8_STAGE(PG8_SB(0, 1), b2 + hstep, voffB); PG8_STAGE(PG8_SA(0, 0), a2, voffA);
            PG8_WAIT_V(8); PG8_WAIT_L(0); PG8_BAR; PG8_MMA(1, 0, At, B0); PG8_MMA(1, 1, At, B1); PG8_BAR; PG8_SCHED;
            PG8_LDB(B0, 1, 0); PG8_LDB(B1, 1, 1); PG8_SCHED; PG8_LDA(At, 1, 0); PG8_STAGE(PG8_SA(0, 1), a2 + hstep, voffA);
            PG8_WAIT_V(8); PG8_WAIT_L(0); PG8_BAR; PG8_MMA(0, 0, At, B0); PG8_MMA(0, 1, At, B1); PG8_BAR; PG8_SCHED;
            PG8_LDA(At, 1, 1); PG8_STAGE(PG8_SB(1, 0), b3, voffB); PG8_STAGE(PG8_SB(1, 1), b3 + hstep, voffB); PG8_STAGE(PG8_SA(1, 0), a3, voffA);
            PG8_WAIT_V(8); PG8_WAIT_L(0); PG8_BAR; PG8_MMA(1, 0, At, B0); PG8_MMA(1, 1, At, B1); PG8_BAR; PG8_SCHED;
            } else {
            PG8_LDB(B0, 0, 0); PG8_SCHED; PG8_LDA(At, 0, 0); PG8_STAGE(PG8_SA(1, 1), a1 + hstep, voffA);
            PG8_WAIT_L(8); PG8_BAR; PG8_WAIT_L(0); PG8_MMA(0, 0, At, B0); PG8_BAR; PG8_SCHED;
            PG8_LDB(B1, 0, 1); PG8_STAGE(PG8_SB(0, 0), b2, voffB);
            PG8_BAR; PG8_WAIT_L(0); PG8_MMA(0, 1, At, B1); PG8_BAR;
            PG8_LDA(At, 0, 1); PG8_STAGE(PG8_SA(0, 0), a2, voffA);
            PG8_BAR; PG8_WAIT_L(0); PG8_MMA(1, 0, At, B0); PG8_BAR; PG8_SCHED;
            PG8_STAGE(PG8_SB(0, 1), b2 + hstep, voffB);
            PG8_WAIT_V(6); PG8_BAR; PG8_MMA(1, 1, At, B1); PG8_BAR;
            PG8_LDB(B0, 1, 0); PG8_SCHED; PG8_LDA(At, 1, 0); PG8_STAGE(PG8_SA(0, 1), a2 + hstep, voffA);
            PG8_WAIT_L(8); PG8_BAR; PG8_WAIT_L(0); PG8_MMA(0, 0, At, B0); PG8_BAR; PG8_SCHED;
            PG8_LDB(B1, 1, 1); PG8_STAGE(PG8_SB(1, 0), b3, voffB);
            PG8_BAR; PG8_WAIT_L(0); PG8_MMA(0, 1, At, B1); PG8_BAR;
            PG8_LDA(At, 1, 1); PG8_STAGE(PG8_SA(1, 0), a3, voffA);
            PG8_BAR; PG8_WAIT_L(0); PG8_MMA(1, 0, At, B0); PG8_BAR; PG8_SCHED;
            PG8_STAGE(PG8_SB(1, 1), b3 + hstep, voffB);
            PG8_WAIT_V(6); PG8_BAR; PG8_MMA(1, 1, At, B1); PG8_BAR;
            }
        }
        if constexpr (ALIGN_EPI) { if (wr == 0) PG8_BAR; }
        if constexpr (!Epi::AFTER_DRAIN) { int le_; asm volatile("v_mbcnt_lo_u32_b32 %0, -1, 0\n\tv_mbcnt_hi_u32_b32 %0, -1, %0" : "=v"(le_)); E(acc, cur, wr, wc, le_ & 15, le_ >> 4); S.done(cur); }
        if (!has_next) break;
#pragma unroll
        for (int a = 0; a < 2; ++a)
#pragma unroll
            for (int b = 0; b < 2; ++b)
#pragma unroll
                for (int m = 0; m < 4; ++m)
#pragma unroll
                    for (int n = 0; n < 2; ++n) acc[a][b][m][n] = (f32x4){0.f, 0.f, 0.f, 0.f};
        cur = nxt; cA = nA; cB = nB; ++ui;
        if constexpr (ALIGN_EPI) { if (wr == 1) PG8_BAR; }
    }
    PG8_WAIT_V(0);
    if constexpr (!ALIGN_EPI) { if (wr == 0) PG8_BAR; }
    PG8_BAR;
    if constexpr (Epi::AFTER_DRAIN) { E.fused(acc, cur, wr, wc, fr, fq, lds, wid, lane); S.done(cur); }
#undef PG8_SA
#undef PG8_SB
#undef PG8_STAGE
#undef PG8_LDA
#undef PG8_LDB
#undef PG8_MMA
#undef PG8_WAIT_V
#undef PG8_WAIT_L
#undef PG8_BAR
#undef PG8_SCHED
}
}

#define LAS __attribute__((address_space(3)))
constexpr int NWAVES = 8, NTHR = 512;
constexpr int LDS_BYTES = 147456;
constexpr int NPH = 21;
typedef float f32x4 __attribute__((ext_vector_type(4)));
typedef unsigned u32x4 __attribute__((ext_vector_type(4)));

struct Args { const float* in[30]; float* out; unsigned char* ws; int ph_lo, ph_hi; };

__device__ __forceinline__ unsigned pk2(float lo, float hi) { return cvtpk(lo, hi); }

__device__ __forceinline__ void p0_transpose_item(const float* W, int K, int N, bf16* WT, int row_off, LAS float* scr, int item, int lane) {
    const int nblk = N / 32, kb = item / nblk, nb = item % nblk, k0 = 64 * kb, n0 = 32 * nb;
#pragma unroll 8
    for (int i = 0; i < 32; ++i) { const int kk = 2 * i + (lane >> 5); scr[kk * 33 + (lane & 31)] = W[(size_t)(k0 + kk) * N + n0 + (lane & 31)]; }
    asm volatile("s_waitcnt lgkmcnt(0)" ::: "memory");
    const int c = lane & 7;
#pragma unroll
    for (int j = 0; j < 4; ++j) { const int n = (lane >> 3) + 8 * j; const LAS float* s = scr + (8 * c) * 33 + n;
        u32x4 o; o.x = pk2(s[0 * 33], s[1 * 33]); o.y = pk2(s[2 * 33], s[3 * 33]); o.z = pk2(s[4 * 33], s[5 * 33]); o.w = pk2(s[6 * 33], s[7 * 33]);
        *(u32x4*)(WT + (size_t)(row_off + n0 + n) * K + k0 + 8 * c) = o; }
    asm volatile("s_waitcnt lgkmcnt(0)" ::: "memory");
}

__device__ __forceinline__ void norm_mod_row(const float* xr, const float* gamma, const float* sh, const float* sc, bf16* orow, int lane) {
    f32x4 v[4]; float ss = 0.f;
#pragma unroll
    for (int j = 0; j < 4; ++j) { v[j] = *(const f32x4*)(xr + j * 256 + lane * 4); ss += (v[j].x * v[j].x + v[j].y * v[j].y) + (v[j].z * v[j].z + v[j].w * v[j].w); }
    const float rs = rsqrtf(wave_sum(ss, lane) * (1.f / D) + NORM_EPS);
#pragma unroll
    for (int j = 0; j < 4; ++j) { const int d = j * 256 + lane * 4; const f32x4 g = *(const f32x4*)(gamma + d), a = *(const f32x4*)(sc + d), s = *(const f32x4*)(sh + d);
        const f32x4 y = v[j] * rs * g * (a + 1.f) + s; uint2 o; o.x = pk2(y.x, y.y); o.y = pk2(y.z, y.w); *(uint2*)(orow + d) = o; }
}


#define XB_TMO      128
#define XB_XCNT(j)  (256  + 64 * (j))
#define XB_XSUB(j)  (1280 + 64 * (j))
#define XB_XGEN(j)  (2304 + 64 * (j))
#define XB_TOP      3328
#define XB_TOPGEN   3392
#define XCD_BAR_WORDS 3456
#define XB_SPIN_CAP (1u << 18)

__device__ __forceinline__ unsigned xb_ld(unsigned* p)              { return __hip_atomic_load(p, __ATOMIC_RELAXED, __HIP_MEMORY_SCOPE_AGENT); }
__device__ __forceinline__ unsigned xb_add(unsigned* p, unsigned v) { return __hip_atomic_fetch_add(p, v, __ATOMIC_RELAXED, __HIP_MEMORY_SCOPE_AGENT); }
__device__ __forceinline__ unsigned xb_xcc_id() { return (unsigned)__builtin_amdgcn_s_getreg((3 << 11) | 20) & 0xFu; }
#define XB_SPIN(cond, bar) do { unsigned _sp = 0; while (cond) { __builtin_amdgcn_s_sleep(1); \
    if ((++_sp & 255u) == 0u) { if (xb_ld(&(bar)[XB_TMO])) break; if (_sp > XB_SPIN_CAP) { atomicAdd(&(bar)[XB_TMO], 1u); break; } } } } while (0)

struct XcdBarrier {
    unsigned* bar; unsigned x; int w0;
    volatile __attribute__((address_space(3))) unsigned* st;
};

__device__ __forceinline__ XcdBarrier xcd_barrier_post(unsigned* bar, volatile __attribute__((address_space(3))) unsigned* st) {
    XcdBarrier b; b.bar = bar; b.x = xb_xcc_id(); b.st = st; b.w0 = __builtin_amdgcn_readfirstlane((int)threadIdx.x >> 6);
    if (threadIdx.x == 0) (void)xb_add(&bar[XB_XCNT(b.x)], 1u);
    return b;
}
__device__ __forceinline__ void xcd_barrier_complete(unsigned* bar, unsigned x, unsigned& nloc, unsigned& nx) {
    const unsigned G = gridDim.x * gridDim.y * gridDim.z;
    unsigned sum, cnt, mine, sp = 0u;
    for (;;) {
        sum = 0u; cnt = 0u; mine = 0u;
#pragma unroll
        for (unsigned j = 0; j < 16; ++j) { const unsigned c = xb_ld(&bar[XB_XCNT(j)]); sum += c; cnt += (c > 0u) ? 1u : 0u; }
        mine = xb_ld(&bar[XB_XCNT(x)]);
        if (sum == G) break;
        __builtin_amdgcn_s_sleep(1);
        if ((++sp & 255u) == 0u) { if (xb_ld(&bar[XB_TMO])) break; if (sp > XB_SPIN_CAP) { atomicAdd(&bar[XB_TMO], 1u); break; } }
    }
    nloc = mine > 0u ? mine : 1u; nx = cnt > 0u ? cnt : 1u;
}

template <bool FIRST> __device__ __forceinline__ void xcd_barrier(const XcdBarrier& b) {
    asm volatile("s_waitcnt vmcnt(0)" ::: "memory");
    __syncthreads();
    int lid_; asm volatile("v_mbcnt_lo_u32_b32 %0, -1, 0\n\tv_mbcnt_hi_u32_b32 %0, -1, %0" : "=v"(lid_));
    if (b.w0 == 0 && lid_ == 0) {
        unsigned* bar = b.bar;
        __builtin_amdgcn_s_waitcnt(0);
        unsigned nloc = b.st[0], nx = b.st[1];
        if (FIRST && nloc == 0u) { xcd_barrier_complete(bar, b.x, nloc, nx); b.st[0] = nloc; b.st[1] = nx; }
        const unsigned old = xb_add(&bar[XB_XSUB(b.x)], 1u);
        const unsigned gen = old / nloc;
        if (old + 1u == (gen + 1u) * nloc) {
            __builtin_amdgcn_fence(__ATOMIC_RELEASE, "agent");
            asm volatile("s_waitcnt vmcnt(0)" ::: "memory");
            const unsigned og = xb_add(&bar[XB_TOP], 1u);
            const unsigned tg = og / nx;
            if (og + 1u == (tg + 1u) * nx) xb_add(&bar[XB_TOPGEN], 1u);
            else XB_SPIN(xb_ld(&bar[XB_TOPGEN]) == tg, bar);
            __builtin_amdgcn_fence(__ATOMIC_ACQUIRE, "agent");
            xb_add(&bar[XB_XGEN(b.x)], 1u);
            asm volatile("s_waitcnt vmcnt(0)" ::: "memory");
        } else {
            XB_SPIN(xb_ld(&bar[XB_XGEN(b.x)]) == gen, bar);
            __builtin_amdgcn_fence(__ATOMIC_ACQUIRE, "agent");
            asm volatile("s_waitcnt vmcnt(0)" ::: "memory");
        }
    }
    __syncthreads();
}


__device__ __forceinline__ unsigned mono_u32(float f) { unsigned u = __float_as_uint(f); return (u & 0x80000000u) ? ~u : (u | 0x80000000u); }
__device__ __forceinline__ float demono_u32(unsigned u) { return __uint_as_float((u & 0x80000000u) ? (u & 0x7FFFFFFFu) : ~u); }
__device__ __forceinline__ unsigned pack_key7(float f, int idx) { return (mono_u32(f) & 0xFFFFFF80u) | (unsigned)(127 - idx); }
__device__ __forceinline__ float unpack_key7(unsigned k) { return demono_u32((k & 0xFFFFFF80u) | 0x40u); }
__device__ __forceinline__ float unpack_key8(unsigned k) { return demono_u32((k & 0xFFFFFF00u) | 0x80u); }
__device__ __forceinline__ void ce_desc(unsigned& a, unsigned& b) { const unsigned hi = a > b ? a : b, lo = a > b ? b : a; a = hi; b = lo; }
__device__ __forceinline__ void sort16_desc(unsigned* v) {
#pragma unroll
    for (int k = 2; k <= 16; k <<= 1)
#pragma unroll
        for (int j = k >> 1; j > 0; j >>= 1)
#pragma unroll
            for (int i = 0; i < 16; ++i) { const int l = i ^ j; if (l > i) { if ((i & k) == 0) ce_desc(v[i], v[l]); else ce_desc(v[l], v[i]); } }
}
__device__ __forceinline__ void bmerge16_desc(unsigned* v) {
#pragma unroll
    for (int j = 8; j > 0; j >>= 1)
#pragma unroll
        for (int i = 0; i < 16; ++i) { const int l = i ^ j; if (l > i) ce_desc(v[i], v[l]); }
}
__device__ __forceinline__ void merge_top16(unsigned* a, const unsigned* b) {
#pragma unroll
    for (int i = 0; i < 16; ++i) { const unsigned o = b[15 - i]; a[i] = a[i] > o ? a[i] : o; }
    bmerge16_desc(a);
}
__device__ __forceinline__ void stage2_cands(const unsigned* s0, const unsigned* s1, int hh, unsigned* c) {
    float A[16], B[16];
#pragma unroll
    for (int i = 0; i < 16; ++i) { const float f0 = unpack_key7(s0[i]), f1 = unpack_key7(s1[i]); A[i] = hh ? f1 : f0; B[i] = hh ? f0 : f1; }
    int n = 0;
#pragma unroll
    for (int i = 0; i < 4; ++i)
#pragma unroll
        for (int j = i; j < 16; ++j) { if ((i + 1) * (j + 1) > 16) continue;
            const float val = A[i] + B[j]; const unsigned id = hh ? (unsigned)((j << 4) | i) : (unsigned)((i << 4) | j);
            unsigned key = (mono_u32(val) & 0xFFFFFF00u) | id; if (hh && i == j) key = 0u; c[n++] = key; }
#pragma unroll
    for (; n < 32; ++n) c[n] = 0u;
}

typedef short bf16x8_t __attribute__((ext_vector_type(8)));
typedef float f32x16 __attribute__((ext_vector_type(16)));
__device__ __forceinline__ float gelu_erf(float a) { return 0.5f * a * (1.f + erff(a * 0.70710678118654752f)); }


typedef __attribute__((address_space(3))) bf16 lbf16;

__device__ __forceinline__ f32x16 mm32(bf16x8_t a, bf16x8_t b, f32x16 c) { return __builtin_amdgcn_mfma_f32_32x32x16_bf16(a, b, c, 0, 0, 0); }
__device__ __forceinline__ bf16x8_t frag_from_u32x4(unsigned x, unsigned y, unsigned z, unsigned w) { typedef unsigned u4 __attribute__((ext_vector_type(4))); u4 t = {x, y, z, w}; return __builtin_bit_cast(bf16x8_t, t); }
template <int S> __device__ __forceinline__ bf16x8_t accop(const f32x16& z) {
    return frag_from_u32x4(cvtpk(z[8 * S], z[8 * S + 1]), cvtpk(z[8 * S + 2], z[8 * S + 3]), cvtpk(z[8 * S + 4], z[8 * S + 5]), cvtpk(z[8 * S + 6], z[8 * S + 7])); }
template <int S> __device__ __forceinline__ bf16x8_t ldpermcol(const lbf16* a, int col, int hh) {
    const lbf16* p = a + (16 * S + 4 * hh) * 72 + col;
    const unsigned e0 = p[0], e1 = p[72], e2 = p[144], e3 = p[216], e4 = p[8 * 72], e5 = p[9 * 72], e6 = p[10 * 72], e7 = p[11 * 72];
    return frag_from_u32x4(e0 | (e1 << 16), e2 | (e3 << 16), e4 | (e5 << 16), e6 | (e7 << 16)); }
__device__ __forceinline__ bf16x8_t ldrow(const lbf16* a, int row, int ks, int hh) { return *(const __attribute__((address_space(3))) bf16x8_t*)(a + row * 72 + ks * 16 + 8 * hh); }
__device__ __forceinline__ int rowidx(int e, int hh) { return (e & 3) + 8 * (e >> 2) + 4 * hh; }

constexpr int ROWB = 768;
__device__ __forceinline__ unsigned fp6code(float x, float sc) {
    const float t = fabsf(x) * sc;
    const float r = t < 16.f ? __builtin_rintf(t) : (t < 32.f ? 8.f + __builtin_rintf(t * 0.5f) : 16.f + __builtin_rintf(t * 0.25f));
    unsigned c = (unsigned)r; c = c > 31u ? 31u : c;
    return c | (x < 0.f ? 32u : 0u);
}
__device__ __forceinline__ void convert_tables_fp6(const float* pu, const float* pv, unsigned char* u8, unsigned char* v8, float* usc, float* vsc, int l, int wv, int nw, int lane) {
    for (int rr0 = wv * 2; rr0 < 2 * NEXP; rr0 += nw * 2) {
        f32x4 v[2][4]; float m[2];
#pragma unroll
        for (int rr = 0; rr < 2; ++rr) { const int q = rr0 + rr; const size_t row = (size_t)l * NEXP + (q < NEXP ? q : q - NEXP); const float* sp_ = (q < NEXP ? pu : pv) + row * D + lane * 16;
#pragma unroll
            for (int k = 0; k < 4; ++k) v[rr][k] = *(const f32x4*)(sp_ + k * 4); }
#pragma unroll
        for (int rr = 0; rr < 2; ++rr) { float mm = 0.f;
#pragma unroll
            for (int k = 0; k < 4; ++k) mm = fmaxf(fmaxf(mm, fmaxf(fabsf(v[rr][k].x), fabsf(v[rr][k].y))), fmaxf(fabsf(v[rr][k].z), fabsf(v[rr][k].w)));
#pragma unroll
            for (int o = 1; o < 64; o <<= 1) mm = fmaxf(mm, shflx(mm, lane, o));
            m[rr] = mm; }
#pragma unroll
        for (int rr = 0; rr < 2; ++rr) { const int q = rr0 + rr; const size_t row = (size_t)l * NEXP + (q < NEXP ? q : q - NEXP); const float sc = m[rr] > 0.f ? 60.f / m[rr] : 1.f;
            unsigned c[16];
#pragma unroll
            for (int k = 0; k < 4; ++k) { c[k * 4] = fp6code(v[rr][k].x, sc); c[k * 4 + 1] = fp6code(v[rr][k].y, sc); c[k * 4 + 2] = fp6code(v[rr][k].z, sc); c[k * 4 + 3] = fp6code(v[rr][k].w, sc); }
            const unsigned o0 = c[0] | (c[1] << 6) | (c[2] << 12) | (c[3] << 18) | (c[4] << 24) | (c[5] << 30);
            const unsigned o1 = (c[5] >> 2) | (c[6] << 4) | (c[7] << 10) | (c[8] << 16) | (c[9] << 22) | (c[10] << 28);
            const unsigned o2 = (c[10] >> 4) | (c[11] << 2) | (c[12] << 8) | (c[13] << 14) | (c[14] << 20) | (c[15] << 26);
            unsigned* op = (unsigned*)((q < NEXP ? u8 : v8) + row * ROWB + lane * 12);
            op[0] = o0; op[1] = o1; op[2] = o2;
            if (lane == 0) (q < NEXP ? usc : vsc)[row] = m[rr] > 0.f ? m[rr] * (1.f / 7.5f) : 1.f; }
    }
}

__global__ void __launch_bounds__(NTHR, 2) mega(Args args) {
    extern __shared__ __attribute__((aligned(16))) unsigned char lds_raw[];
    LAS unsigned char* lds = (LAS unsigned char*)lds_raw;
    const int G = gridDim.x, bx = blockIdx.x, NGW = G * NWAVES;
    const int wave0 = __builtin_amdgcn_readfirstlane((int)threadIdx.x >> 6);
    typedef const unsigned char __attribute__((address_space(4))) kbyte;
#define PHASE_IDS int tid; asm volatile("v_mbcnt_lo_u32_b32 %0, -1, 0\n\tv_mbcnt_hi_u32_b32 %0, -1, %0" : "=v"(tid)); tid += wave0 * 64;     const int lane = tid & 63, wave = __builtin_amdgcn_readfirstlane(tid >> 6), gw = bx * NWAVES + wave; (void)lane; (void)gw; \
    kbyte* kp = (kbyte*)__builtin_amdgcn_kernarg_segment_ptr(); asm volatile("" : "+s"(kp)); \
    unsigned char* const ws = (unsigned char*)*(__attribute__((address_space(1))) unsigned char* const __attribute__((address_space(4)))*)(kp + 31 * 8); float* const X = (float*)*(__attribute__((address_space(1))) float* const __attribute__((address_space(4)))*)(kp + 30 * 8); (void)ws; (void)X;
#define INP(i) ((const float*)(*(const __attribute__((address_space(1))) float* const __attribute__((address_space(4)))*)(kp + (i) * 8)))
#define MOD ((float*)(ws + WS_MOD))
#define H ((bf16*)(ws + WS_H))
#define PROJ ((bf16*)(ws + WS_PROJ))
#define Q ((bf16*)(ws + WS_Q))
#define MIX ((bf16*)(ws + WS_MIX))
#define Rb ((bf16*)(ws + WS_R))
#define Kb ((bf16*)(ws + WS_K))
#define V0 ((bf16*)(ws + WS_V0))
#define V1 ((bf16*)(ws + WS_V1))
#define KKb ((bf16*)(ws + WS_KK))
#define Bb ((bf16*)(ws + WS_B))
#define Gb ((bf16*)(ws + WS_G))
#define BGb ((bf16*)(ws + WS_BG))
#define Wd ((float*)(ws + WS_W))
#define Y ((float*)(ws + WS_Y))
#define QB ((float*)(ws + WS_QB))
#define SH ((float*)(ws + WS_SH))
#define WUPT ((bf16*)(ws + WS_LORA))
#define AUPT ((bf16*)(ws + WS_LORA + 131072))
#define GUPT ((bf16*)(ws + WS_LORA + 262144))
#define VUPT ((bf16*)(ws + WS_LORA + 524288))
#define PWT ((bf16*)(ws + WS_LORA + 655360))
#define INVN ((float*)(ws + WS_INVN))
#define BSUM ((float*)(ws + WS_BSUM))
#define SCN ((unsigned char*)(ws + WS_SCN))
#define IDX ((int*)(ws + WS_IDX))
#define GATE ((float*)(ws + WS_GATE))
#define WinT ((bf16*)(ws + WS_WIN_T))
#define WoutT ((bf16*)(ws + WS_WOUT_T))
#define PqT ((bf16*)(ws + WS_PQ_T))
#define KEYS ((bf16*)(ws + WS_KEYS))
#define U8 ((unsigned char*)(ws + WS_U))
#define V8 ((unsigned char*)(ws + WS_V))
#define USc ((float*)(ws + WS_US))
#define VSc ((float*)(ws + WS_VS))
    const int lo = args.ph_lo, hi = args.ph_hi;
    { volatile LAS unsigned* misc = (volatile LAS unsigned*)(lds + LDS_BYTES - 64); if (threadIdx.x < 4) misc[threadIdx.x] = 0u; __syncthreads(); }
    const XcdBarrier xbar = xcd_barrier_post((unsigned*)(args.ws) + 4096, (volatile LAS unsigned*)(lds + LDS_BYTES - 64));
#define IN(k) (lo <= (k) && (k) < hi)
#ifndef REP_PHASE
#define REP_PHASE (-1)
#endif
#define REPS(k) ((k) == REP_PHASE ? 3 : 1)
#define SEAM(k) do { if (IN(k) && IN((k) + 1)) { if ((k) == 0) cg::this_grid().sync(); else { XcdBarrier xb_ = xbar; asm volatile("" : "+s"(xb_.bar)); if ((k) == 1) xcd_barrier<true>(xb_); else xcd_barrier<false>(xb_); } } } while (0)

    if (IN(0)) { PHASE_IDS
        { LAS float* ca = (LAS float*)lds; LAS float* red = (LAS float*)(lds + 16384);
          const float* c = INP(1); const float* ada_w = INP(2); const float* ada_b = INP(3);
          bool have = false;
          for (int it = bx; it < 96; it += G) {
              if (!have) { for (int i = tid; i < BATCH * D; i += NTHR) { const float v = c[i]; ca[i] = v / (1.f + expf(-v)); } have = true; __syncthreads(); }
              const int l = it / 48, n = (it % 48) * 128 + (tid & 127), kq = tid >> 7;
              const float* w = ada_w + (size_t)l * D * 6 * D + (size_t)(kq * 256) * 6 * D + n;
              float a0 = 0.f, a1 = 0.f, a2 = 0.f, a3 = 0.f;
#pragma unroll 32
              for (int k = 0; k < 256; ++k) { const float wv = w[(size_t)k * 6 * D]; const int kk = kq * 256 + k; a0 += ca[kk] * wv; a1 += ca[D + kk] * wv; a2 += ca[2 * D + kk] * wv; a3 += ca[3 * D + kk] * wv; }
              red[(kq * 4 + 0) * 128 + (tid & 127)] = a0; red[(kq * 4 + 1) * 128 + (tid & 127)] = a1; red[(kq * 4 + 2) * 128 + (tid & 127)] = a2; red[(kq * 4 + 3) * 128 + (tid & 127)] = a3;
              __syncthreads();
              { const int b = tid >> 7, col = tid & 127, nn = (it % 48) * 128 + col;
                const float s = red[(0 * 4 + b) * 128 + col] + red[(1 * 4 + b) * 128 + col] + red[(2 * 4 + b) * 128 + col] + red[(3 * 4 + b) * 128 + col];
                MOD[(size_t)l * BATCH * 6 * D + (size_t)b * 6 * D + nn] = s + ada_b[l * 6 * D + nn]; }
              __syncthreads();
          }
          __syncthreads(); }
        { LAS float* scr = (LAS float*)(lds + wave * 16384);
          constexpr int I_IN = (D / 64) * (IN_COLS / 32), I_VR = (D / 64) * (MVL / 32), I_OUT = (D / 64) * (D / 32), I_PQ = (D / 64) * (PH * PQ / 32);
          constexpr int NIT = 2 * I_IN + I_VR + 2 * I_OUT + 2 * I_PQ;
          for (int it = gw; it < NIT; it += NGW) { int r = it;
              if (r < 2 * I_IN) { const int l = r / I_IN; p0_transpose_item(INP(5) + (size_t)l * D * IN_COLS, D, IN_COLS, WinT + (size_t)l * LDP * D, 0, scr, r % I_IN, lane); continue; } r -= 2 * I_IN;
              if (r < I_VR) { p0_transpose_item(INP(12), D, MVL, WinT + (size_t)1 * LDP * D, IN_COLS, scr, r, lane); continue; } r -= I_VR;
              if (r < 2 * I_OUT) { const int l = r / I_OUT; p0_transpose_item(INP(23) + (size_t)l * D * D, D, D, WoutT + (size_t)l * D * D, 0, scr, r % I_OUT, lane); continue; } r -= 2 * I_OUT;
              { const int l = r / I_PQ; p0_transpose_item(INP(25) + (size_t)l * D * PH * PQ, D, PH * PQ, PqT + (size_t)l * PH * PQ * D, 0, scr, r % I_PQ, lane); } }
          for (int it = gw; it < 2 * 16 + 2 * 16 + 2 * 32; it += NGW) { int r = it;
              if (r < 32) { const int l = r / 16; p0_transpose_item(INP(8) + (size_t)l * DL * RW, DL, RW, WUPT + (size_t)l * RW * DL, 0, scr, r % 16, lane); continue; } r -= 32;
              if (r < 32) { const int l = r / 16; p0_transpose_item(INP(10) + (size_t)l * AL * RW, AL, RW, AUPT + (size_t)l * RW * AL, 0, scr, r % 16, lane); continue; } r -= 32;
              { const int l = r / 32; p0_transpose_item(INP(11) + (size_t)l * GL * RW, GL, RW, GUPT + (size_t)l * RW * GL, 0, scr, r % 32, lane); } }
          { const float* vu = INP(15); for (int e = bx * NTHR + tid; e < MVL * RW; e += G * NTHR) { const int n = e >> 5, k = e & 31; VUPT[e] = f2bf(vu[k * RW + n]); } }
          for (int it = gw; it < 8 * 8; it += NGW) p0_transpose_item(INP(21) + (size_t)(it >> 3) * PG * PG, PG, PG, PWT + (size_t)(it >> 3) * PG * PG, 0, scr, it & 7, lane);
        }
        { const size_t gt = (size_t)bx * NTHR + tid, NT = (size_t)G * NTHR;
          constexpr size_t NK8 = (size_t)2 * PH * 2 * NKEYS * PHALF / 8;
          const float* src = INP(26); bf16* dst = KEYS;
          for (size_t i = gt; i < NK8; i += NT) {
              const f32x4 a = *(const f32x4*)(src + i * 8), b = *(const f32x4*)(src + i * 8 + 4);
              u32x4 o; o.x = pk2(a.x, a.y); o.y = pk2(a.z, a.w); o.z = pk2(b.x, b.y); o.w = pk2(b.z, b.w); *(u32x4*)(dst + i * 8) = o; }
        }
    }
    SEAM(0);

#pragma unroll
    for (int l = 0; l < DEPTH; ++l) {
        const int pb = 1 + 10 * l;
#define modl (MOD + (size_t)l * BATCH * 6 * D)
#define xin (l == 0 ? INP(0) : (const float*)X)
        if (l == 0 && IN(pb + 0)) { PHASE_IDS const float* gamma = INP(4) + l * D;
            for (int row = gw; row < T; row += NGW) { const int b = row / SEQ; norm_mod_row(xin + (size_t)row * D, gamma, modl + (size_t)b * 6 * D, modl + (size_t)b * 6 * D + D, H + (size_t)row * D, lane); } }
        SEAM(pb + 0);
        if (IN(pb + 1)) { PHASE_IDS const int N1 = l == 0 ? IN_COLS : LDP;
            pg8::Gemm g{H, WinT + (size_t)l * LDP * D, T, N1, D}; pg8::StaticOrder S; S.init(T, N1, G, bx);
            pg8::EpiBf16<0> E{PROJ, LDP, nullptr, 0, 0, 1.f};
            pg8::gemm_phase<pg8::EpiBf16<0>, pg8::StaticOrder, true, true>(lds, g, S, E, tid); }
        SEAM(pb + 1);

        if (IN(pb + 2)) { PHASE_IDS
            constexpr int LST = 296;
            LAS bf16* lin = (LAS bf16*)lds;
            const float* mu = INP(6) + l * RWKV_COLS; const float* vmu = INP(13);
            const float* w0p = INP(7) + l * RW; const float* a0p = INP(9) + l * RW; const float* kkp = INP(16) + l * RW; const float* kap = INP(17) + l * RW; const float* rkp = INP(18) + l * RW; const float* v0p = INP(14);
            const bf16* wupT = WUPT + (size_t)l * RW * DL; const bf16* aupT = AUPT + (size_t)l * RW * AL; const bf16* gupT = GUPT + (size_t)l * RW * GL; const bf16* vupT = VUPT;
            bf16* Vl = l == 0 ? V0 : V1;
            const int r32 = lane & 31, hh = lane >> 5, h = wave;
            for (int tile = bx; tile < T / 32; tile += G) {
                const int t0 = tile * 32;
                __syncthreads();
#pragma unroll 1
                for (int it0 = 0; it0 < 3; it0 += 2) {
                  u32x4 cu_[2], pv_[2]; f32x4 m0_[2], m1_[2];
#pragma unroll
                  for (int it = 0; it < 2; ++it) { const int c8 = tid + (it0 + it) * NTHR; const bool ok = c8 < 32 * 36; const int tok = ok ? c8 / 36 : 0, jc = ok ? c8 % 36 : 0, t = t0 + tok, sq = t % SEQ;
                      cu_[it] = (u32x4){0u, 0u, 0u, 0u}; pv_[it] = (u32x4){0u, 0u, 0u, 0u}; m0_[it] = (f32x4){0.f, 0.f, 0.f, 0.f}; m1_[it] = m0_[it];
                      if (ok && (jc < 32 || l > 0)) { const int col = jc < 32 ? 3 * RW + jc * 8 : IN_COLS + (jc - 32) * 8;
                          cu_[it] = *(const u32x4*)(PROJ + (size_t)t * LDP + col); if (sq > 0) pv_[it] = *(const u32x4*)(PROJ + (size_t)(t - 1) * LDP + col);
                          const float* mp = jc < 32 ? mu + col : vmu + (jc - 32) * 8; m0_[it] = *(const f32x4*)mp; m1_[it] = *(const f32x4*)(mp + 4); } }
#pragma unroll
                  for (int it = 0; it < 2; ++it) { const int c8 = tid + (it0 + it) * NTHR; if (c8 < 32 * 36) { const int tok = c8 / 36, jc = c8 % 36;
                      u32x4 o = {0u, 0u, 0u, 0u};
                      if (jc < 32 || l > 0) {
                          float x[8]; const unsigned cw[4] = {cu_[it].x, cu_[it].y, cu_[it].z, cu_[it].w}, pw[4] = {pv_[it].x, pv_[it].y, pv_[it].z, pv_[it].w}; const float mm[8] = {m0_[it].x, m0_[it].y, m0_[it].z, m0_[it].w, m1_[it].x, m1_[it].y, m1_[it].z, m1_[it].w};
#pragma unroll
                          for (int i = 0; i < 4; ++i) { const float c0 = __uint_as_float(cw[i] << 16), c1 = __uint_as_float(cw[i] & 0xffff0000u), p0 = __uint_as_float(pw[i] << 16), p1 = __uint_as_float(pw[i] & 0xffff0000u);
                              x[2 * i] = c0 + (p0 - c0) * mm[2 * i]; x[2 * i + 1] = c1 + (p1 - c1) * mm[2 * i + 1]; }
                          if (jc < 8) {
#pragma unroll
                              for (int i = 0; i < 8; ++i) { const float e2 = __expf(-2.f * fabsf(x[i])); const float th = (1.f - e2) * __builtin_amdgcn_rcpf(1.f + e2); x[i] = x[i] < 0.f ? -th : th; } }
                          else if (jc >= 16 && jc < 32) {
#pragma unroll
                              for (int i = 0; i < 8; ++i) x[i] = __builtin_amdgcn_rcpf(1.f + __expf(-x[i])); }
                          o.x = pk2(x[0], x[1]); o.y = pk2(x[2], x[3]); o.z = pk2(x[4], x[5]); o.w = pk2(x[6], x[7]);
                      }
                      *(LAS u32x4*)(lin + tok * LST + jc * 8) = o; } } }
                __syncthreads();
                const bool first = (t0 % SEQ) == 0;
                lbf16* tin = (lbf16*)(lds + 19456 + wave * 14336);
                { u32x4 iq[13]; int ql_; asm volatile("v_mbcnt_lo_u32_b32 %0, -1, 0\n\tv_mbcnt_hi_u32_b32 %0, -1, %0" : "=v"(ql_));
#pragma unroll
                  for (int i = 0; i < 13; ++i) { const int q = ql_ + 64 * i; iq[i] = (u32x4){0u, 0u, 0u, 0u};
                      if (q < 792) { const int arr = q / 264, rem = q - arr * 264, row = rem >> 3, cc = rem & 7;
                          if (!(first && row == 0)) iq[i] = *(const u32x4*)(PROJ + (size_t)(t0 - 1 + row) * LDP + arr * RW + h * HS + cc * 8); } }
#pragma unroll
                  for (int i = 0; i < 13; ++i) { const int q = ql_ + 64 * i; if (q < 792) { const int arr = q / 264, rem = q - arr * 264, row = rem >> 3, cc = rem & 7;
                      *(__attribute__((address_space(3))) u32x4*)(tin + arr * 2376 + row * 72 + cc * 8) = iq[i]; } } }
                __builtin_amdgcn_wave_barrier(); asm volatile("s_waitcnt lgkmcnt(0)" ::: "memory");
                float ssq[16], bsm[16];
#pragma unroll
                for (int e = 0; e < 16; ++e) { ssq[e] = 0.f; bsm[e] = 0.f; }
#pragma unroll 1
                for (int rt = 0; rt < 2; ++rt) {
                    f32x16 accW, accA, accG, accV;
#pragma unroll
                    for (int e = 0; e < 16; ++e) { accW[e] = 0.f; accA[e] = 0.f; accG[e] = 0.f; accV[e] = 0.f; }
                    int c = h * HS + rt * 32 + r32;
int hh8 = 8 * hh; asm volatile("" : "+v"(c), "+v"(hh8));
                    const LAS bf16* lrow = lin + r32 * LST + 8 * hh;
                    { bf16x8_t wf[18];
#pragma unroll
                      for (int ks = 0; ks < 4; ++ks) { wf[ks] = *(const bf16x8_t*)(wupT + (size_t)c * DL + ks * 16 + hh8); wf[4 + ks] = *(const bf16x8_t*)(aupT + (size_t)c * AL + ks * 16 + hh8); }
#pragma unroll
                      for (int ks = 0; ks < 8; ++ks) wf[8 + ks] = *(const bf16x8_t*)(gupT + (size_t)c * GL + ks * 16 + hh8);
                      if (l > 0) { wf[16] = *(const bf16x8_t*)(vupT + (size_t)c * MVL + hh8); wf[17] = *(const bf16x8_t*)(vupT + (size_t)c * MVL + 16 + hh8); }
#pragma unroll
                      for (int ks = 0; ks < 4; ++ks) { accW = __builtin_amdgcn_mfma_f32_32x32x16_bf16(*(const LAS bf16x8_t*)(lrow + ks * 16), wf[ks], accW, 0, 0, 0);
                                                       accA = __builtin_amdgcn_mfma_f32_32x32x16_bf16(*(const LAS bf16x8_t*)(lrow + 64 + ks * 16), wf[4 + ks], accA, 0, 0, 0); }
#pragma unroll
                      for (int ks = 0; ks < 8; ++ks) accG = __builtin_amdgcn_mfma_f32_32x32x16_bf16(*(const LAS bf16x8_t*)(lrow + 128 + ks * 16), wf[8 + ks], accG, 0, 0, 0);
                      if (l > 0) {
#pragma unroll
                          for (int ks = 0; ks < 2; ++ks) accV = __builtin_amdgcn_mfma_f32_32x32x16_bf16(*(const LAS bf16x8_t*)(lrow + 256 + ks * 16), wf[16 + ks], accV, 0, 0, 0); } }
                    const float mur = mu[c], muk = mu[RW + c], muv = mu[2 * RW + c], w0c = w0p[c], a0c = a0p[c], kkc = kkp[c], kac = kap[c], rkc = rkp[c];
                    const float v0c = l > 0 ? v0p[c] : 0.f;
#pragma unroll
                    for (int eb = 0; eb < 16; eb += 4) {
                        bf16 lr[4], lk[4], lv[4], lrp[4], lkp[4], lvp[4], lvf[4];
#pragma unroll
                        for (int i = 0; i < 4; ++i) { const int e = eb + i; const int tok = (e & 3) + 8 * (e >> 2) + 4 * hh, t = t0 + tok; const int ci = rt * 32 + r32;
                            lr[i] = tin[(tok + 1) * 72 + ci]; lk[i] = tin[2376 + (tok + 1) * 72 + ci]; lv[i] = tin[2 * 2376 + (tok + 1) * 72 + ci];
                            lrp[i] = tin[tok * 72 + ci]; lkp[i] = tin[2376 + tok * 72 + ci]; lvp[i] = tin[2 * 2376 + tok * 72 + ci];
                            lvf[i] = l > 0 ? V0[(size_t)t * RW + c] : (bf16)0; }
                        __builtin_amdgcn_sched_barrier(0);
#pragma unroll
                        for (int i = 0; i < 4; ++i) { const int e = eb + i; const int tok = (e & 3) + 8 * (e >> 2) + 4 * hh, t = t0 + tok; const size_t o = (size_t)t * RW + c;
                            float r = bf2f(lr[i]), k = bf2f(lk[i]), v = bf2f(lv[i]);
                            r += (bf2f(lrp[i]) - r) * mur; k += (bf2f(lkp[i]) - k) * muk; v += (bf2f(lvp[i]) - v) * muv;
                            const float z = -(w0c + accW[e]); const float sp = fmaxf(z, 0.f) + __logf(1.f + __expf(-fabsf(z)));
                            const float decay = __expf(-__expf(-sp - 0.5f));
                            const float a = __builtin_amdgcn_rcpf(1.f + __expf(-(a0c + accA[e]))); const float g = accG[e];
                            if (l > 0) { const float vfv = bf2f(lvf[i]); v = v + (vfv - v) * __builtin_amdgcn_rcpf(1.f + __expf(-(v0c + accV[e]))); }
                            const float kk = k * kkc; const float k2 = k * (1.f + (a - 1.f) * kac);
                            ssq[e] += kk * kk; bsm[e] += r * k2 * rkc;
                            { const unsigned p0_ = cvtpk(r, k2), p1_ = cvtpk(v, kk), p2_ = cvtpk(kk * a, g), p3_ = cvtpk(v * g, 0.f);
                              Rb[o] = (bf16)p0_; Kb[o] = (bf16)(p0_ >> 16); Vl[o] = (bf16)p1_; KKb[o] = (bf16)(p1_ >> 16); Bb[o] = (bf16)p2_; Gb[o] = (bf16)(p2_ >> 16); BGb[o] = (bf16)p3_; Wd[o] = decay; }
                        }
                    }
                }
#pragma unroll
                for (int e = 0; e < 16; ++e) { const int ln_ = r32 | (hh << 5); float a_ = red16(ssq[e]), b_ = red16(bsm[e]); a_ += shflx(a_, ln_, 16); b_ += shflx(b_, ln_, 16); ssq[e] = a_; bsm[e] = b_; }
                if (r32 == 0) {
#pragma unroll
                    for (int e = 0; e < 16; ++e) { const int tok = (e & 3) + 8 * (e >> 2) + 4 * hh; INVN[(size_t)(t0 + tok) * NH + h] = rsqrtf(fmaxf(ssq[e], 1e-24f)); BSUM[(size_t)(t0 + tok) * NH + h] = bsm[e]; } }
            }
            {
                constexpr int DST = 520;
                int lane_p; asm volatile("v_mbcnt_lo_u32_b32 %0, -1, 0\n\tv_mbcnt_hi_u32_b32 %0, -1, %0" : "=v"(lane_p)); const int r32 = lane_p & 31, hh = lane_p >> 5, tidp = wave0 * 64 + lane_p;
                lbf16* dlb = (lbf16*)lds;
                lbf16* pin = (lbf16*)(lds + 33280);
                const int c = tidp, g = c >> 7, win = 2 << g;
                const bf16* pwt = PWT + (size_t)(l * 4 + (wave >> 1)) * PG * PG; const float* psc = INP(22) + l * PW;
                for (int tile = bx; tile < T / 32; tile += G) {
                    const int t0 = tile * 32; const bool first = (t0 % SEQ) == 0;
                    __syncthreads();
                    { u32x4 pq[6];
#pragma unroll
                      for (int q = 0; q < 6; ++q) { const int ch = tidp + q * NTHR, row = ch >> 6, cc = ch & 63; pq[q] = (u32x4){0u, 0u, 0u, 0u};
                          if (ch < 47 * 64 && (row >= 15 || !first)) pq[q] = *(const u32x4*)(PROJ + (size_t)(t0 - 15 + row) * LDP + RWKV_COLS + cc * 8); }
#pragma unroll
                      for (int q = 0; q < 6; ++q) { const int ch = tidp + q * NTHR, row = ch >> 6, cc = ch & 63; if (ch < 47 * 64) *(__attribute__((address_space(3))) u32x4*)(pin + row * 520 + cc * 8) = pq[q]; } }
                    __syncthreads();
                    const lbf16* pc = pin + c;
                    float sw = 0.f;
#pragma unroll
                    for (int j = 1; j <= 15; ++j) sw += (j < win) ? bf2f(pc[(15 - j) * 520]) : 0.f;
                    const float invw = 1.f / (float)win;
#pragma unroll 8
                    for (int i = 0; i < 32; ++i) {
                        const float cur = bf2f(pc[(15 + i) * 520]);
                        sw += cur;
                        const float inv = (first && i < 15) ? 1.f / (float)min(i + 1, win) : invw;
                        dlb[i * DST + c] = f2bf(sw * inv - cur);
                        sw -= bf2f(pc[(15 + i - win + 1) * 520]);
                    }
                    __syncthreads();
                    const int gg = wave >> 1, half = wave & 1;
#pragma unroll
                    for (int ct = 0; ct < 2; ++ct) {
                        const int dd0 = half * 64 + ct * 32;
                        f32x16 acc;
#pragma unroll
                        for (int e = 0; e < 16; ++e) acc[e] = 0.f;
#pragma unroll
                        for (int ks = 0; ks < 8; ++ks) { const bf16x8_t a = *(const __attribute__((address_space(3))) bf16x8_t*)(dlb + r32 * DST + gg * PG + ks * 16 + 8 * hh);
                            const bf16x8_t w = *(const bf16x8_t*)(pwt + (size_t)(dd0 + r32) * PG + ks * 16 + 8 * hh); acc = mm32(a, w, acc); }
                        const int oc = gg * PG + dd0 + r32; const float ps = psc[oc];
#pragma unroll
                        for (int e = 0; e < 16; ++e) MIX[(size_t)(t0 + rowidx(e, hh)) * D + RW + oc] = f2bf(acc[e] * ps);
                    }
                }
            }
        }
        SEAM(pb + 2);

        if (IN(pb + 3)) { PHASE_IDS
            const bf16* Vl = l == 0 ? V0 : V1;
            const int r32 = lane & 31, hh = lane >> 5;
            if (wave < 6) {
                lbf16* At = (lbf16*)(lds + wave * 23552); lbf16* Bt = At + 2304; lbf16* Kt = Bt + 2304; lbf16* Rt = Kt + 2304; lbf16* Vv = Rt + 2304;
                LAS float* PCs = (LAS float*)(lds + wave * 23552 + 23040);
                for (int item = bx * 6 + wave; item < BATCH * NH * (SEQ / 32); item += G * 6) {
                    const int bh = item >> 7, chunk = item & 127, b = bh >> 3, h = bh & 7; const size_t t0 = (size_t)b * SEQ + chunk * 32;
                    __builtin_amdgcn_wave_barrier(); asm volatile("s_waitcnt lgkmcnt(0)" ::: "memory");
                    {
                      const int tk = lane >> 3, part = lane & 7;
                      u32x4 qr[4], qk[4], qv[4], qkk[4], qb[4]; f32x4 qw0[4], qw1[4]; float qin[4];
#pragma unroll
                      for (int p4 = 0; p4 < 4; ++p4) { const size_t o = (t0 + p4 * 8 + tk) * RW + h * HS + part * 8;
                          qr[p4] = *(const u32x4*)(Rb + o); qk[p4] = *(const u32x4*)(Kb + o); qv[p4] = *(const u32x4*)(Vl + o); qkk[p4] = *(const u32x4*)(KKb + o); qb[p4] = *(const u32x4*)(Bb + o);
                          qw0[p4] = *(const f32x4*)(Wd + o); qw1[p4] = *(const f32x4*)(Wd + o + 4); qin[p4] = INVN[(t0 + p4 * 8 + tk) * NH + h]; }
                      LAS float* Pl = (LAS float*)At;
#pragma unroll
                      for (int p4 = 0; p4 < 4; ++p4) { *(LAS f32x4*)(Pl + (p4 * 8 + tk) * 64 + part * 8) = qw0[p4]; *(LAS f32x4*)(Pl + (p4 * 8 + tk) * 64 + part * 8 + 4) = qw1[p4]; }
                      __builtin_amdgcn_wave_barrier(); asm volatile("s_waitcnt lgkmcnt(0)" ::: "memory");
                      { float P = 1.f;
#pragma unroll 8
                        for (int c = 0; c < 32; ++c) { P *= Pl[c * 64 + lane]; Pl[c * 64 + lane] = P; }
                        PCs[lane] = P; }
                      __builtin_amdgcn_wave_barrier(); asm volatile("s_waitcnt lgkmcnt(0)" ::: "memory");
                      u32x4 oa[4], orr[4], ob_[4], ok_[4];
#pragma unroll
                      for (int p4 = 0; p4 < 4; ++p4) { const int c = p4 * 8 + tk;
                          const f32x4 pa = *(const LAS f32x4*)(Pl + c * 64 + part * 8), pb2 = *(const LAS f32x4*)(Pl + c * 64 + part * 8 + 4);
                          f32x4 ma = {1.f, 1.f, 1.f, 1.f}, mb = ma; if (c > 0) { ma = *(const LAS f32x4*)(Pl + (c - 1) * 64 + part * 8); mb = *(const LAS f32x4*)(Pl + (c - 1) * 64 + part * 8 + 4); }
                          const float Pc[8] = {pa.x, pa.y, pa.z, pa.w, pb2.x, pb2.y, pb2.z, pb2.w}, Pm[8] = {ma.x, ma.y, ma.z, ma.w, mb.x, mb.y, mb.z, mb.w};
                          const unsigned rw_[4] = {qr[p4].x, qr[p4].y, qr[p4].z, qr[p4].w}, kw_[4] = {qk[p4].x, qk[p4].y, qk[p4].z, qk[p4].w}, kkw[4] = {qkk[p4].x, qkk[p4].y, qkk[p4].z, qkk[p4].w}, bw_[4] = {qb[p4].x, qb[p4].y, qb[p4].z, qb[p4].w};
                          unsigned xa[4], xr[4], xb[4], xk[4]; const float inv = qin[p4];
#pragma unroll
                          for (int i = 0; i < 4; ++i) { const float ip0 = __builtin_amdgcn_rcpf(Pc[2 * i]), ip1 = __builtin_amdgcn_rcpf(Pc[2 * i + 1]);
                              xa[i] = pk2(-__uint_as_float(kkw[i] << 16) * inv * Pm[2 * i], -__uint_as_float(kkw[i] & 0xffff0000u) * inv * Pm[2 * i + 1]);
                              xr[i] = pk2(__uint_as_float(rw_[i] << 16) * Pc[2 * i], __uint_as_float(rw_[i] & 0xffff0000u) * Pc[2 * i + 1]);
                              xb[i] = pk2(__uint_as_float(bw_[i] << 16) * inv * ip0, __uint_as_float(bw_[i] & 0xffff0000u) * inv * ip1);
                              xk[i] = pk2(__uint_as_float(kw_[i] << 16) * ip0, __uint_as_float(kw_[i] & 0xffff0000u) * ip1); }
                          oa[p4] = (u32x4){xa[0], xa[1], xa[2], xa[3]}; orr[p4] = (u32x4){xr[0], xr[1], xr[2], xr[3]}; ob_[p4] = (u32x4){xb[0], xb[1], xb[2], xb[3]}; ok_[p4] = (u32x4){xk[0], xk[1], xk[2], xk[3]}; }
                      __builtin_amdgcn_wave_barrier(); asm volatile("s_waitcnt lgkmcnt(0)" ::: "memory");
#pragma unroll
                      for (int p4 = 0; p4 < 4; ++p4) { const int c = p4 * 8 + tk, o = c * 72 + part * 8;
                          *(__attribute__((address_space(3))) u32x4*)(At + o) = oa[p4]; *(__attribute__((address_space(3))) u32x4*)(Rt + o) = orr[p4]; *(__attribute__((address_space(3))) u32x4*)(Bt + o) = ob_[p4];
                          *(__attribute__((address_space(3))) u32x4*)(Kt + o) = ok_[p4]; *(__attribute__((address_space(3))) u32x4*)(Vv + o) = qv[p4]; } }
                    __builtin_amdgcn_wave_barrier(); asm volatile("s_waitcnt lgkmcnt(0)" ::: "memory");
                    const f32x16 zero16 = {0.f, 0.f, 0.f, 0.f, 0.f, 0.f, 0.f, 0.f, 0.f, 0.f, 0.f, 0.f, 0.f, 0.f, 0.f, 0.f};
                    f32x16 X = zero16, Yt = zero16;
#pragma unroll
                    for (int ks = 0; ks < 4; ++ks) { const bf16x8_t fa = ldrow(At, r32, ks, hh), fb = ldrow(Bt, r32, ks, hh); X = mm32(fa, fb, X); Yt = mm32(fb, fa, Yt); }
#pragma unroll
                    for (int e = 0; e < 16; ++e) { const int ri = rowidx(e, hh); X[e] = (r32 < ri) ? X[e] : 0.f; Yt[e] = (ri < r32) ? Yt[e] : 0.f; }
                    f32x16 TY = Yt;
#pragma unroll
                    for (int e = 0; e < 16; ++e) TY[e] += (rowidx(e, hh) == r32) ? 1.f : 0.f;
#pragma unroll 1
                    for (int it = 0; it < 4; ++it) {
                        const bf16x8_t x0 = accop<0>(X), x1 = accop<1>(X), y0 = accop<0>(Yt), y1 = accop<1>(Yt);
                        f32x16 Xn = mm32(y0, x0, zero16); Xn = mm32(y1, x1, Xn);
                        f32x16 Yn = mm32(x0, y0, zero16); Yn = mm32(x1, y1, Yn);
                        X = Xn; Yt = Yn;
                        const bf16x8_t p0 = accop<0>(X), p1 = accop<1>(X), t0_ = accop<0>(TY), t1_ = accop<1>(TY);
                        TY = mm32(p0, t0_, TY); TY = mm32(p1, t1_, TY);
                    }
                    const bf16x8_t ty0 = accop<0>(TY), ty1 = accop<1>(TY);
                    unsigned char* rec = SCN + (size_t)item * 24576;
                    const bf16x8_t v00 = ldpermcol<0>(Vv, r32, hh), v01 = ldpermcol<1>(Vv, r32, hh), v10 = ldpermcol<0>(Vv, 32 + r32, hh), v11 = ldpermcol<1>(Vv, 32 + r32, hh);
                    f32x16 U0a, U0b;
                    { f32x16 G2T = zero16;
#pragma unroll
                      for (int ks = 0; ks < 4; ++ks) G2T = mm32(ldrow(Kt, r32, ks, hh), ldrow(At, r32, ks, hh), G2T);
#pragma unroll
                      for (int e = 0; e < 16; ++e) G2T[e] = (rowidx(e, hh) < r32) ? G2T[e] : 0.f;
                      const bf16x8_t g0 = accop<0>(G2T), g1 = accop<1>(G2T);
                      f32x16 Za = mm32(g0, v00, zero16); Za = mm32(g1, v01, Za); f32x16 Zb = mm32(g0, v10, zero16); Zb = mm32(g1, v11, Zb);
                      U0a = mm32(ty0, accop<0>(Za), zero16); U0a = mm32(ty1, accop<1>(Za), U0a); U0b = mm32(ty0, accop<0>(Zb), zero16); U0b = mm32(ty1, accop<1>(Zb), U0b); }
                    const bf16x8_t ua0 = accop<0>(U0a), ua1 = accop<1>(U0a), ub0 = accop<0>(U0b), ub1 = accop<1>(U0b);
                    f32x16 G3T = zero16;
                    { f32x16 G4T = zero16;
#pragma unroll
                      for (int ks = 0; ks < 4; ++ks) { const bf16x8_t fr = ldrow(Rt, r32, ks, hh); G3T = mm32(ldrow(Bt, r32, ks, hh), fr, G3T); G4T = mm32(ldrow(Kt, r32, ks, hh), fr, G4T); }
#pragma unroll
                      for (int e = 0; e < 16; ++e) { const bool keep = rowidx(e, hh) <= r32; G3T[e] = keep ? G3T[e] : 0.f; G4T[e] = keep ? G4T[e] : 0.f; }
                      const bf16x8_t g30 = accop<0>(G3T), g31 = accop<1>(G3T), g40 = accop<0>(G4T), g41 = accop<1>(G4T);
                      f32x16 Ya = mm32(g30, ua0, zero16); Ya = mm32(g31, ua1, Ya); Ya = mm32(g40, v00, Ya); Ya = mm32(g41, v01, Ya);
                      f32x16 Yb = mm32(g30, ub0, zero16); Yb = mm32(g31, ub1, Yb); Yb = mm32(g40, v10, Yb); Yb = mm32(g41, v11, Yb);
                      u32x4 o0, o1;
                      o0.x = cvtpk(Ya[0], Ya[1]); o0.y = cvtpk(Ya[2], Ya[3]); o0.z = cvtpk(Ya[4], Ya[5]); o0.w = cvtpk(Ya[6], Ya[7]);
                      o1.x = cvtpk(Ya[8], Ya[9]); o1.y = cvtpk(Ya[10], Ya[11]); o1.z = cvtpk(Ya[12], Ya[13]); o1.w = cvtpk(Ya[14], Ya[15]);
                      *(u32x4*)(rec + 12288 + 4096 + lane * 32) = o0; *(u32x4*)(rec + 12288 + 4096 + lane * 32 + 16) = o1;
                      o0.x = cvtpk(Yb[0], Yb[1]); o0.y = cvtpk(Yb[2], Yb[3]); o0.z = cvtpk(Yb[4], Yb[5]); o0.w = cvtpk(Yb[6], Yb[7]);
                      o1.x = cvtpk(Yb[8], Yb[9]); o1.y = cvtpk(Yb[10], Yb[11]); o1.z = cvtpk(Yb[12], Yb[13]); o1.w = cvtpk(Yb[14], Yb[15]);
                      *(u32x4*)(rec + 12288 + 6144 + 4096 + lane * 32) = o0; *(u32x4*)(rec + 12288 + 6144 + 4096 + lane * 32 + 16) = o1; }
                    f32x16 Wa0 = mm32(ty0, ldpermcol<0>(At, r32, hh), zero16); Wa0 = mm32(ty1, ldpermcol<1>(At, r32, hh), Wa0);
                    f32x16 Wa1 = mm32(ty0, ldpermcol<0>(At, 32 + r32, hh), zero16); Wa1 = mm32(ty1, ldpermcol<1>(At, 32 + r32, hh), Wa1);
                    const bf16x8_t wa00 = accop<0>(Wa0), wa01 = accop<1>(Wa0), wa10 = accop<0>(Wa1), wa11 = accop<1>(Wa1);
                    { const bf16x8_t g30 = accop<0>(G3T), g31 = accop<1>(G3T);
                      f32x16 Ra = mm32(wa00, g30, zero16); Ra = mm32(wa01, g31, Ra); f32x16 Rb_ = mm32(wa10, g30, zero16); Rb_ = mm32(wa11, g31, Rb_);
#pragma unroll
                      for (int e = 0; e < 16; ++e) { const int kr = rowidx(e, hh); Ra[e] += bf2f(Rt[r32 * 72 + kr]); Rb_[e] += bf2f(Rt[r32 * 72 + 32 + kr]); }
                      *(bf16x8_t*)(rec + 8192 + 0 * 1024 + lane * 16) = accop<0>(Ra); *(bf16x8_t*)(rec + 8192 + 1 * 1024 + lane * 16) = accop<1>(Ra);
                      *(bf16x8_t*)(rec + 8192 + 2 * 1024 + lane * 16) = accop<0>(Rb_); *(bf16x8_t*)(rec + 8192 + 3 * 1024 + lane * 16) = accop<1>(Rb_); }
                    const bf16x8_t b00 = ldpermcol<0>(Bt, r32, hh), b01 = ldpermcol<1>(Bt, r32, hh), b10 = ldpermcol<0>(Bt, 32 + r32, hh), b11 = ldpermcol<1>(Bt, 32 + r32, hh);
                    { const float pc0 = PCs[r32], pc1 = PCs[32 + r32];
#pragma unroll
                      for (int ij = 0; ij < 4; ++ij) { const int i = ij >> 1, j = ij & 1;
                          f32x16 M = mm32(i ? wa10 : wa00, j ? b10 : b00, zero16); M = mm32(i ? wa11 : wa01, j ? b11 : b01, M);
#pragma unroll
                          for (int e = 0; e < 16; ++e) { float m = M[e]; if (i == j) m += (rowidx(e, hh) == r32) ? 1.f : 0.f; M[e] = m * (j ? pc1 : pc0); }
                          *(bf16x8_t*)(rec + (ij * 2 + 0) * 1024 + lane * 16) = accop<0>(M); *(bf16x8_t*)(rec + (ij * 2 + 1) * 1024 + lane * 16) = accop<1>(M); } }
                    { const bf16x8_t k00 = ldpermcol<0>(Kt, r32, hh), k01 = ldpermcol<1>(Kt, r32, hh), k10 = ldpermcol<0>(Kt, 32 + r32, hh), k11 = ldpermcol<1>(Kt, 32 + r32, hh);
#pragma unroll
                      for (int ju = 0; ju < 4; ++ju) { const int j = ju >> 1, u = ju & 1;
                          f32x16 Dm = mm32(j ? b10 : b00, u ? ub0 : ua0, zero16); Dm = mm32(j ? b11 : b01, u ? ub1 : ua1, Dm);
                          Dm = mm32(j ? k10 : k00, u ? v10 : v00, Dm); Dm = mm32(j ? k11 : k01, u ? v11 : v01, Dm);
#pragma unroll
                          for (int e = 0; e < 16; ++e) Dm[e] *= PCs[32 * j + rowidx(e, hh)];
                          u32x4 o0, o1;
                          o0.x = cvtpk(Dm[0], Dm[1]); o0.y = cvtpk(Dm[2], Dm[3]); o0.z = cvtpk(Dm[4], Dm[5]); o0.w = cvtpk(Dm[6], Dm[7]);
                          o1.x = cvtpk(Dm[8], Dm[9]); o1.y = cvtpk(Dm[10], Dm[11]); o1.z = cvtpk(Dm[12], Dm[13]); o1.w = cvtpk(Dm[14], Dm[15]);
                          *(u32x4*)(rec + 12288 + u * 6144 + j * 2048 + lane * 32) = o0; *(u32x4*)(rec + 12288 + u * 6144 + j * 2048 + lane * 32 + 16) = o1; } }
                }
            }
        }
        { XcdBarrier xb_ = xbar; asm volatile("" : "+s"(xb_.bar)); xcd_barrier<false>(xb_); }
        if (IN(pb + 3)) { PHASE_IDS
            const int r32 = lane & 31, hh = lane >> 5;
            constexpr int SLOT = 18432, NCH = SEQ / 32, NSL = 7, AHEAD = 6;
            if (G > BATCH * NH * 2) { if (bx >= BATCH * NH * 2) convert_tables_fp6(INP(27), INP(28), U8, V8, USc, VSc, l, (bx - BATCH * NH * 2) * NWAVES + wave, (G - BATCH * NH * 2) * NWAVES, lane); }
            else convert_tables_fp6(INP(27), INP(28), U8, V8, USc, VSc, l, bx * NWAVES + wave, G * NWAVES, lane);
            for (int un = bx; un < BATCH * NH * 2; un += G) {
                const int bh = un >> 1, u = un & 1, b = bh >> 3, h = bh & 7;
                __syncthreads();
                const unsigned char* recs = SCN + (size_t)bh * NCH * 24576;
                const int lw = wave - 2;
#define S2_DMA(chunk_) do { if (wave >= 2) { LAS unsigned char* sl = lds + ((chunk_) % NSL) * SLOT; const unsigned char* rp = recs + (size_t)(chunk_) * 24576 + lane * 16; \
                    _Pragma("unroll") for (int q_ = 0; q_ < 3; ++q_) { const int p_ = lw * 3 + q_; const int so_ = p_ < 12 ? p_ * 1024 : 12288 + u * 6144 + (p_ - 12) * 1024; \
                        __builtin_amdgcn_global_load_lds((const unsigned*)(rp + so_), (LAS unsigned*)(sl + p_ * 1024), 16, 0, 0); } } } while (0)
#pragma unroll 1
                for (int c0 = 0; c0 < AHEAD; ++c0) S2_DMA(c0);
                asm volatile("s_waitcnt vmcnt(15)" ::: "memory");
                __builtin_amdgcn_s_barrier();
                f32x16 X0, X1;
#pragma unroll
                for (int e = 0; e < 16; ++e) { X0[e] = 0.f; X1[e] = 0.f; }
#define S2_FRAG(off) (*(const __attribute__((address_space(3))) bf16x8_t*)(sl + (off) + lane * 16))
#define S2_UNPK(dst, off) do { const u32x4 a0 = *(const LAS u32x4*)(sl + (off) + lane * 32), a1 = *(const LAS u32x4*)(sl + (off) + lane * 32 + 16); const unsigned wv[8] = {a0.x, a0.y, a0.z, a0.w, a1.x, a1.y, a1.z, a1.w}; \
                    _Pragma("unroll") for (int q = 0; q < 8; ++q) { (dst)[2 * q] = __uint_as_float(wv[q] << 16); (dst)[2 * q + 1] = __uint_as_float(wv[q] & 0xffff0000u); } } while (0)
#pragma unroll 1
                for (int n = 0; n < NCH; ++n) {
                    if (n + AHEAD < NCH) S2_DMA(n + AHEAD);
                    if (wave == 0) {
                        const LAS unsigned char* sl = lds + (n % NSL) * SLOT;
                        const bf16x8_t x00 = accop<0>(X0), x01 = accop<1>(X0), x10 = accop<0>(X1), x11 = accop<1>(X1);
                        f32x16 Yc, N0, N1;
                        S2_UNPK(Yc, 12288 + 4096); S2_UNPK(N0, 12288); S2_UNPK(N1, 12288 + 2048);
                        Yc = mm32(S2_FRAG(8192 + 0 * 1024), x00, Yc); Yc = mm32(S2_FRAG(8192 + 1 * 1024), x01, Yc); Yc = mm32(S2_FRAG(8192 + 2 * 1024), x10, Yc); Yc = mm32(S2_FRAG(8192 + 3 * 1024), x11, Yc);
                        N0 = mm32(S2_FRAG((0 * 2 + 0) * 1024), x00, N0); N0 = mm32(S2_FRAG((0 * 2 + 1) * 1024), x01, N0); N0 = mm32(S2_FRAG((2 * 2 + 0) * 1024), x10, N0); N0 = mm32(S2_FRAG((2 * 2 + 1) * 1024), x11, N0);
                        N1 = mm32(S2_FRAG((1 * 2 + 0) * 1024), x00, N1); N1 = mm32(S2_FRAG((1 * 2 + 1) * 1024), x01, N1); N1 = mm32(S2_FRAG((3 * 2 + 0) * 1024), x10, N1); N1 = mm32(S2_FRAG((3 * 2 + 1) * 1024), x11, N1);
                        X0 = N0; X1 = N1;
                        float* yp = Y + ((size_t)b * SEQ + (size_t)n * 32) * RW + h * HS + u * 32 + r32;
#pragma unroll
                        for (int e = 0; e < 16; ++e) yp[(size_t)rowidx(e, hh) * RW] = Yc[e];
                        asm volatile("s_waitcnt lgkmcnt(0)" ::: "memory");
                    } else if (wave >= 2) {
                        const int younger = (NCH - 1 - (n + 1)) < (AHEAD - 1) ? (NCH - 1 - (n + 1)) : (AHEAD - 1);
                        if (younger >= 5) asm volatile("s_waitcnt vmcnt(15)" ::: "memory"); else if (younger == 4) asm volatile("s_waitcnt vmcnt(12)" ::: "memory"); else if (younger == 3) asm volatile("s_waitcnt vmcnt(9)" ::: "memory");
                        else if (younger == 2) asm volatile("s_waitcnt vmcnt(6)" ::: "memory"); else if (younger == 1) asm volatile("s_waitcnt vmcnt(3)" ::: "memory"); else asm volatile("s_waitcnt vmcnt(0)" ::: "memory");
                    }
                    __builtin_amdgcn_s_barrier();
                }
#undef S2_FRAG
#undef S2_UNPK
#undef S2_DMA
            }
        }
        SEAM(pb + 3);

        if (IN(pb + 4)) { PHASE_IDS
            const int c8 = (tid & 63) * 8, hd = (tid & 63) >> 3, tsub = tid >> 6;
            const f32x4 lg0 = *(const f32x4*)(INP(19) + l * RW + c8), lg1 = *(const f32x4*)(INP(19) + l * RW + c8 + 4), lb0 = *(const f32x4*)(INP(20) + l * RW + c8), lb1 = *(const f32x4*)(INP(20) + l * RW + c8 + 4);
            for (int tile = bx; tile < T / 8; tile += G) {
                const int t = tile * 8 + tsub; const size_t o = (size_t)t * RW + c8;
                const f32x4 y0 = *(const f32x4*)(Y + o), y1 = *(const f32x4*)(Y + o + 4); const u32x4 gq = *(const u32x4*)(Gb + o), vq = *(const u32x4*)(BGb + o); const float bsum = BSUM[(size_t)t * NH + hd];
                float sm = (y0.x + y0.y) + (y0.z + y0.w) + (y1.x + y1.y) + (y1.z + y1.w);
                sm += dppf<0xB1>(sm); sm += dppf<0x4E>(sm); sm += dppf<0x141>(sm);
                const float mean = sm * (1.f / 64.f);
                const f32x4 d0 = y0 - mean, d1 = y1 - mean;
                float sq = (d0.x * d0.x + d0.y * d0.y) + (d0.z * d0.z + d0.w * d0.w) + (d1.x * d1.x + d1.y * d1.y) + (d1.z * d1.z + d1.w * d1.w);
                sq += dppf<0xB1>(sq); sq += dppf<0x4E>(sq); sq += dppf<0x141>(sq);
                const float rs = rsqrtf(sq * (1.f / 64.f) + GN_EPS);
                const f32x4 n0 = d0 * rs * lg0 + lb0, n1 = d1 * rs * lg1 + lb1;
                const unsigned gw_[4] = {gq.x, gq.y, gq.z, gq.w}, vw_[4] = {vq.x, vq.y, vq.z, vq.w}; const float nn[8] = {n0.x, n0.y, n0.z, n0.w, n1.x, n1.y, n1.z, n1.w}; unsigned ow[4];
#pragma unroll
                for (int i = 0; i < 4; ++i) { const float g0 = __uint_as_float(gw_[i] << 16), g1 = __uint_as_float(gw_[i] & 0xffff0000u), v0 = __uint_as_float(vw_[i] << 16), v1 = __uint_as_float(vw_[i] & 0xffff0000u);
                    ow[i] = pk2(nn[2 * i] * g0 + v0 * bsum, nn[2 * i + 1] * g1 + v1 * bsum); }
                *(u32x4*)(MIX + (size_t)t * D + c8) = (u32x4){ow[0], ow[1], ow[2], ow[3]};
            }
        }
        SEAM(pb + 4);
        if (IN(pb + 5)) { PHASE_IDS
            pg8::Gemm g{MIX, WoutT + (size_t)l * D * D, T, D, D}; pg8::StaticOrder S; S.init(T, D, G, bx);
            pg8::EpiResGate E{xin, X, modl + 2 * D};
            pg8::gemm_phase<pg8::EpiResGate, pg8::StaticOrder, true, true>(lds, g, S, E, tid); }
        SEAM(pb + 5);
        if (IN(pb + 6)) { PHASE_IDS const float* gamma = INP(24) + l * D;
            for (int row = gw; row < T; row += NGW) { const int b = row / SEQ; norm_mod_row(X + (size_t)row * D, gamma, modl + (size_t)b * 6 * D + 3 * D, modl + (size_t)b * 6 * D + 4 * D, H + (size_t)row * D, lane); } }
        SEAM(pb + 6);
        if (IN(pb + 7)) { PHASE_IDS
            pg8::Gemm g{H, PqT + (size_t)l * PH * PQ * D, T, PH * PQ, D}; pg8::StaticOrder S; S.init(T, PH * PQ, G, bx);
            pg8::EpiBf16<0> E{Q, PH * PQ, nullptr, 0, 0, 1.f};
            pg8::gemm_phase<pg8::EpiBf16<0>, pg8::StaticOrder, true, true>(lds, g, S, E, tid); }
        SEAM(pb + 7);

        if (IN(pb + 8)) { PHASE_IDS
            const bf16* KEYSl = KEYS + (size_t)l * PH * 2 * NKEYS * PHALF;
            LAS unsigned char* scr = lds + wave * 2048 + lane * 32;
            constexpr int KST = 136;
            lbf16* kl = (lbf16*)(lds + 16384);
            const int r = lane & 31, hh = lane >> 5;
            for (int item = bx; item < (T / 256) * PH; item += G) {
                const int h = item & 7, tok = (item >> 3) * 256 + wave * 32 + r;
                __syncthreads();
                { u32x4 kq[8];
#pragma unroll
                  for (int q = 0; q < 8; ++q) { const int ch = tid + q * NTHR; kq[q] = *(const u32x4*)(KEYSl + (size_t)(h * 2) * NKEYS * PHALF + (size_t)ch * 8); }
#pragma unroll
                  for (int q = 0; q < 8; ++q) { const int ch = tid + q * NTHR, row = ch >> 4, cc = ch & 15; *(__attribute__((address_space(3))) u32x4*)(kl + row * KST + cc * 8) = kq[q]; } }
                __syncthreads();
                unsigned sp0[16], sp1[16];
#pragma unroll
                for (int e = 0; e < 16; ++e) { sp0[e] = 0u; sp1[e] = 0u; }
#pragma unroll 1
                for (int p = 0; p < 2; ++p) {
                    const bf16* qp = Q + (size_t)tok * (PH * PQ) + h * PQ + p * PHALF + 8 * hh;
                    const lbf16* kp_ = kl + (p * NKEYS + r) * KST + 8 * hh;
                    bf16x8_t bq[8];
#pragma unroll
                    for (int ks = 0; ks < 8; ++ks) bq[ks] = *(const bf16x8_t*)(qp + ks * 16);
                    unsigned best[16];
#pragma unroll
                    for (int e = 0; e < 16; ++e) best[e] = 0u;
#pragma unroll 1
                    for (int kt = 0; kt < 4; ++kt) {
                        f32x16 acc;
#pragma unroll
                        for (int e = 0; e < 16; ++e) acc[e] = 0.f;
#pragma unroll
                        for (int ks = 0; ks < 8; ++ks) { const bf16x8_t ak = *(const __attribute__((address_space(3))) bf16x8_t*)(kp_ + kt * 32 * KST + ks * 16); acc = __builtin_amdgcn_mfma_f32_32x32x16_bf16(ak, bq[ks], acc, 0, 0, 0); }
                        unsigned g[16];
#pragma unroll
                        for (int e = 0; e < 16; ++e) g[e] = pack_key7(acc[e], kt * 32 + (e & 3) + 8 * (e >> 2) + 4 * hh);
                        sort16_desc(g);
                        merge_top16(best, g);
                    }
                    unsigned ob[16];
#pragma unroll
                    for (int e = 0; e < 16; ++e) ob[e] = shflxu(best[e], lane, 32);
                    merge_top16(best, ob);
#pragma unroll
                    for (int e = 0; e < 16; ++e) { sp0[e] = p == 0 ? best[e] : sp0[e]; sp1[e] = p == 0 ? sp1[e] : best[e]; }
                }
                unsigned c2[32];
                stage2_cands(sp0, sp1, hh, c2);
                sort16_desc(c2); sort16_desc(c2 + 16); merge_top16(c2, c2 + 16);
                { unsigned ob[16];
#pragma unroll
                  for (int e = 0; e < 16; ++e) ob[e] = shflxu(c2[e], lane, 32);
                  merge_top16(c2, ob); }
#pragma unroll
                for (int e = 0; e < 16; e += 4) {
                    *(LAS unsigned*)(scr + e) = (127u - (sp0[e] & 127u)) | ((127u - (sp0[e + 1] & 127u)) << 8) | ((127u - (sp0[e + 2] & 127u)) << 16) | ((127u - (sp0[e + 3] & 127u)) << 24);
                    *(LAS unsigned*)(scr + 16 + e) = (127u - (sp1[e] & 127u)) | ((127u - (sp1[e + 1] & 127u)) << 8) | ((127u - (sp1[e + 2] & 127u)) << 16) | ((127u - (sp1[e + 3] & 127u)) << 24); }
                asm volatile("s_waitcnt lgkmcnt(0)" ::: "memory");
                float sm[16]; int ex[16];
#pragma unroll
                for (int e = 0; e < 16; ++e) { const unsigned key = c2[e]; sm[e] = unpack_key8(key); const int i0 = (key >> 4) & 15, j0 = key & 15; ex[e] = (int)scr[i0] * NKEYS + (int)scr[16 + j0]; }
                float den = 0.f;
#pragma unroll
                for (int e = 0; e < 16; ++e) { sm[e] = expf(sm[e] - unpack_key8(c2[0])); den += sm[e]; }
                const float inv = 1.f / den;
                if (hh == 0) {
                    int* ip = IDX + (size_t)tok * NE + h * TOPK; float* gp = GATE + (size_t)tok * NE + h * TOPK;
#pragma unroll
                    for (int e = 0; e < 16; e += 4) { *(int4*)(ip + e) = make_int4(ex[e], ex[e + 1], ex[e + 2], ex[e + 3]); *(f32x4*)(gp + e) = (f32x4){sm[e] * inv, sm[e + 1] * inv, sm[e + 2] * inv, sm[e + 3] * inv}; }
                }
                asm volatile("s_waitcnt lgkmcnt(0)" ::: "memory");
            }
        }
        SEAM(pb + 8);

        if (IN(pb + 9)) { PHASE_IDS
            const unsigned char* Ul = U8 + (size_t)l * NEXP * ROWB; const unsigned char* Vtl = V8 + (size_t)l * NEXP * ROWB; const float* usl = USc + l * NEXP; const float* vsl = VSc + l * NEXP; const float* lnf = INP(29);
            const bool fin = (l == DEPTH - 1);
            typedef float f32x2_t __attribute__((ext_vector_type(2)));
            const __amdgpu_buffer_rsrc_t ru = __builtin_amdgcn_make_buffer_rsrc((void*)Ul, 0, NEXP * ROWB, 0x00020000), rv = __builtin_amdgcn_make_buffer_rsrc((void*)Vtl, 0, NEXP * ROWB, 0x00020000);
            const int voff = lane * 12;
            typedef float f32x32_t __attribute__((ext_vector_type(32))); typedef unsigned u32x3_t __attribute__((ext_vector_type(3))); typedef unsigned u32x6_t __attribute__((ext_vector_type(6)));
            LAS float* pl = (LAS float*)(lds + wave * 8704);
            for (int t = gw; t < T; t += NGW) {
                const int b = t / SEQ;
                f32x2_t hf2[8];
                { const u32x4 h0 = *(const u32x4*)(H + (size_t)t * D + lane * 16), h1 = *(const u32x4*)(H + (size_t)t * D + lane * 16 + 8);
                  hf2[0] = (f32x2_t){__uint_as_float(h0.x << 16), __uint_as_float(h0.x & 0xffff0000u)}; hf2[1] = (f32x2_t){__uint_as_float(h0.y << 16), __uint_as_float(h0.y & 0xffff0000u)};
                  hf2[2] = (f32x2_t){__uint_as_float(h0.z << 16), __uint_as_float(h0.z & 0xffff0000u)}; hf2[3] = (f32x2_t){__uint_as_float(h0.w << 16), __uint_as_float(h0.w & 0xffff0000u)};
                  hf2[4] = (f32x2_t){__uint_as_float(h1.x << 16), __uint_as_float(h1.x & 0xffff0000u)}; hf2[5] = (f32x2_t){__uint_as_float(h1.y << 16), __uint_as_float(h1.y & 0xffff0000u)};
                  hf2[6] = (f32x2_t){__uint_as_float(h1.z << 16), __uint_as_float(h1.z & 0xffff0000u)}; hf2[7] = (f32x2_t){__uint_as_float(h1.w << 16), __uint_as_float(h1.w & 0xffff0000u)}; }
                f32x2_t acc2[8];
#pragma unroll
                for (int i = 0; i < 8; ++i) acc2[i] = (f32x2_t){0.f, 0.f};
                unsigned sk0, sk1; float sg0, sg1;
                { const int i0 = IDX[(size_t)t * NE + lane], i1 = IDX[(size_t)t * NE + 64 + lane]; const float g0 = GATE[(size_t)t * NE + lane], g1 = GATE[(size_t)t * NE + 64 + lane];
                  sk0 = ((unsigned)i0 << 7) | (unsigned)lane; sk1 = ((unsigned)i1 << 7) | (unsigned)(64 + lane);
                  sort128(sk0, sk1, lane);
                  const int a0 = (int)(sk0 & 63u) << 2, a1 = (int)(sk1 & 63u) << 2;
                  const int ga0 = __builtin_amdgcn_ds_bpermute(a0, __float_as_int(g0)), gb0 = __builtin_amdgcn_ds_bpermute(a0, __float_as_int(g1)), ga1 = __builtin_amdgcn_ds_bpermute(a1, __float_as_int(g0)), gb1 = __builtin_amdgcn_ds_bpermute(a1, __float_as_int(g1));
                  sg0 = __int_as_float((sk0 & 64u) ? gb0 : ga0); sg1 = __int_as_float((sk1 & 64u) ? gb1 : ga1); sk0 >>= 7; sk1 >>= 7; }
#define QSEL(q_, ix_, gt_) do { const int qa_ = ((((q_) & 1) << 5) | (lane & 31)) << 2; ix_ = __builtin_amdgcn_ds_bpermute(qa_, (int)(((q_) >> 1) ? sk1 : sk0)); gt_ = __int_as_float(__builtin_amdgcn_ds_bpermute(qa_, __float_as_int(((q_) >> 1) ? sg1 : sg0))); } while (0)
                int myidx; float mygate; QSEL(0, myidx, mygate);
                float myus = usl[myidx], myvs = vsl[myidx];
#define ROWLD(dst, rs, ix, e) dst = __builtin_amdgcn_raw_buffer_load_b96(rs, voff, __builtin_amdgcn_readlane(ix, (e)) * ROWB, 0)
#define LOADB(buf, rs, ix, e0) do { _Pragma("unroll") for (int j_ = 0; j_ < 4; ++j_) ROWLD((buf)[j_], rs, ix, (e0) + j_); __builtin_amdgcn_sched_barrier(0); } while (0)
#define CVT2(a, b) const f32x32_t f_ = __builtin_amdgcn_cvt_scalef32_pk32_f32_fp6((u32x6_t){(a).x, (a).y, (a).z, (b).x, (b).y, (b).z}, 1.0f)
#define PR(i) __builtin_shufflevector(f_, f_, 2 * (i), 2 * (i) + 1)
#define DOTB(buf, e0) do { _Pragma("unroll") for (int j_ = 0; j_ < 4; j_ += 2) { CVT2((buf)[j_], (buf)[j_ + 1]); \
                        f32x2_t a_ = hf2[0] * PR(0), b_ = hf2[0] * PR(8); a_ += hf2[1] * PR(1); b_ += hf2[1] * PR(9); a_ += hf2[2] * PR(2); b_ += hf2[2] * PR(10); a_ += hf2[3] * PR(3); b_ += hf2[3] * PR(11); \
                        a_ += hf2[4] * PR(4); b_ += hf2[4] * PR(12); a_ += hf2[5] * PR(5); b_ += hf2[5] * PR(13); a_ += hf2[6] * PR(6); b_ += hf2[6] * PR(14); a_ += hf2[7] * PR(7); b_ += hf2[7] * PR(15); \
                        pl[((e0) + j_) * 68 + lane] = a_.x + a_.y; pl[((e0) + j_ + 1) * 68 + lane] = b_.x + b_.y; } } while (0)
#define AXPYB(buf, e0) do { _Pragma("unroll") for (int j_ = 0; j_ < 4; j_ += 2) { CVT2((buf)[j_], (buf)[j_ + 1]); \
                        const float ca = __int_as_float(__builtin_amdgcn_readlane(__float_as_int(coef), (e0) + j_)), cb = __int_as_float(__builtin_amdgcn_readlane(__float_as_int(coef), (e0) + j_ + 1)); \
                        acc2[0] += ca * PR(0); acc2[1] += ca * PR(1); acc2[2] += ca * PR(2); acc2[3] += ca * PR(3); acc2[4] += ca * PR(4); acc2[5] += ca * PR(5); acc2[6] += ca * PR(6); acc2[7] += ca * PR(7); \
                        acc2[0] += cb * PR(8); acc2[1] += cb * PR(9); acc2[2] += cb * PR(10); acc2[3] += cb * PR(11); acc2[4] += cb * PR(12); acc2[5] += cb * PR(13); acc2[6] += cb * PR(14); acc2[7] += cb * PR(15); } } while (0)
                u32x3_t ba[4], bb_[4];
                LOADB(ba, ru, myidx, 0);
#pragma unroll 1
                for (int q = 0; q < 4; ++q) {
                    int nidx = 0; float ngate = 0.f;
                    if (q < 3) QSEL(q + 1, nidx, ngate);
#pragma unroll
                    for (int e0 = 0; e0 < 32; e0 += 8) {
                        LOADB(bb_, ru, myidx, e0 + 4); DOTB(ba, e0);
                        if (e0 + 8 < 32) LOADB(ba, ru, myidx, e0 + 8); else LOADB(ba, rv, myidx, 0);
                        DOTB(bb_, e0 + 4);
                    }
                    const float nus = usl[nidx], nvs = vsl[nidx];
                    __builtin_amdgcn_wave_barrier(); asm volatile("s_waitcnt lgkmcnt(0)" ::: "memory");
                    float dsum;
                    { const LAS float* rp = pl + (lane & 31) * 68 + (lane >> 5) * 32; f32x4 s4 = *(const LAS f32x4*)rp;
#pragma unroll
                      for (int j = 1; j < 8; ++j) s4 += *(const LAS f32x4*)(rp + j * 4);
                      dsum = (s4.x + s4.y) + (s4.z + s4.w); }
                    dsum += shflx(dsum, lane, 32);
                    __builtin_amdgcn_wave_barrier(); asm volatile("s_waitcnt lgkmcnt(0)" ::: "memory");
                    const float coef = mygate * gelu_erf(dsum * myus) * myvs;
#pragma unroll
                    for (int e0 = 0; e0 < 32; e0 += 8) {
                        LOADB(bb_, rv, myidx, e0 + 4); AXPYB(ba, e0);
                        if (e0 + 8 < 32) LOADB(ba, rv, myidx, e0 + 8); else if (q < 3) LOADB(ba, ru, nidx, 0);
                        AXPYB(bb_, e0 + 4);
                    }
                    myidx = nidx; mygate = ngate; myus = nus; myvs = nvs;
                }
#undef ROWLD
#undef QSEL
#undef LOADB
#undef CVT2
#undef PR
#undef DOTB
#undef AXPYB
                float* xr = X + (size_t)t * D + lane * 16; const float* g2 = modl + (size_t)b * 6 * D + 5 * D + lane * 16;
                f32x4 xv[4]; float ss = 0.f;
#pragma unroll
                for (int q = 0; q < 4; ++q) { const f32x4 xo = *(const f32x4*)(xr + q * 4), gg = *(const f32x4*)(g2 + q * 4);
                    xv[q] = xo + gg * (f32x4){acc2[q * 2].x, acc2[q * 2].y, acc2[q * 2 + 1].x, acc2[q * 2 + 1].y}; ss += (xv[q].x * xv[q].x + xv[q].y * xv[q].y) + (xv[q].z * xv[q].z + xv[q].w * xv[q].w); }
                const float rs = rsqrtf(wave_sum(ss, lane) * (1.f / D) + NORM_EPS);
                if (fin) {
#pragma unroll
                    for (int q = 0; q < 4; ++q) xv[q] = xv[q] * rs * *(const f32x4*)(lnf + lane * 16 + q * 4); }
                else {
                    const float* gam = INP(4) + (l + 1) * D + lane * 16; const float* mn = MOD + (size_t)(l + 1) * BATCH * 6 * D + (size_t)b * 6 * D + lane * 16; u32x4 ho[2];
#pragma unroll
                    for (int q = 0; q < 4; ++q) { const f32x4 y = xv[q] * rs * *(const f32x4*)(gam + q * 4) * (*(const f32x4*)(mn + D + q * 4) + 1.f) + *(const f32x4*)(mn + q * 4);
                        if (q & 1) { ho[q >> 1].z = pk2(y.x, y.y); ho[q >> 1].w = pk2(y.z, y.w); } else { ho[q >> 1].x = pk2(y.x, y.y); ho[q >> 1].y = pk2(y.z, y.w); } }
                    *(u32x4*)(H + (size_t)t * D + lane * 16) = ho[0]; *(u32x4*)(H + (size_t)t * D + lane * 16 + 8) = ho[1]; }
#pragma unroll
                for (int q = 0; q < 4; ++q) *(f32x4*)(xr + q * 4) = xv[q];
            }
        }
    }
#undef modl
#undef xin
#undef IN
#undef SEAM
}
#undef MOD
#undef H
#undef PROJ
#undef Q
#undef MIX
#undef Rb
#undef Kb
#undef V0
#undef V1
#undef KKb
#undef Bb
#undef Gb
#undef BGb
#undef Wd
#undef Y
#undef IDX
#undef GATE
#undef WinT
#undef WoutT
#undef PqT
#undef KEYS
#undef QB
#undef SH
#undef WUPT
#undef AUPT
#undef GUPT
#undef VUPT
#undef PWT
#undef INVN
#undef BSUM
#undef SCN
#undef U8
#undef V8
#undef USc
#undef VSc
#undef INP
#undef PHASE_IDS

extern "C" void kernel_launch(void* const* d_in, const int* in_sizes, int n_in, void* d_out, int out_size, void* d_ws, size_t ws_size, hipStream_t stream) {
    if (n_in != 30 || ws_size < WS_END) { fprintf(stderr, "kernel_launch: unexpected n_in %d / ws_size %zu\n", n_in, ws_size); return; }
    static int grid = 0;
    if (grid == 0) {
        int dev = 0, cus = 0, per_cu = 0;
        (void)hipGetDevice(&dev); (void)hipDeviceGetAttribute(&cus, hipDeviceAttributeMultiprocessorCount, dev);
        if (hipFuncSetAttribute((const void*)mega, hipFuncAttributeMaxDynamicSharedMemorySize, LDS_BYTES) != hipSuccess) { fprintf(stderr, "hipFuncSetAttribute failed\n"); grid = -1; return; }
        if (hipOccupancyMaxActiveBlocksPerMultiprocessor(&per_cu, (const void*)mega, NTHR, LDS_BYTES) != hipSuccess || per_cu < 1) { fprintf(stderr, "occupancy query failed (%d)\n", per_cu); per_cu = 1; }
        (void)hipGetLastError();
        grid = (cus > 0 ? cus : 256) * 1;
    }
    if (grid < 0) return;
    Args a{}; for (int i = 0; i < 30; ++i) a.in[i] = (const float*)d_in[i]; a.out = (float*)d_out; a.ws = (unsigned char*)d_ws;
    a.ph_lo = 0; a.ph_hi = NPH;
    if (hipMemsetAsync(d_ws, 0, 65536, stream) != hipSuccess) { fprintf(stderr, "memset failed\n"); return; }
    void* kargs[] = {&a};
    hipError_t e = hipLaunchCooperativeKernel((const void*)mega, dim3(grid), dim3(NTHR), kargs, LDS_BYTES, stream);
    if (e != hipSuccess) fprintf(stderr, "cooperative launch failed: %s (grid %d)\n", hipGetErrorString(e), grid);
}
```

```cpp
#include <hip/hip_runtime.h>
#include <hip/hip_cooperative_groups.h>
namespace cg = cooperative_groups;
#include <cstdio>
#include <cstdint>
#include <cmath>

constexpr int D = 1024, BATCH = 4, SEQ = 4096, T = BATCH * SEQ, DEPTH = 2;
constexpr int RW = 512, HS = 64, NH = 8;
constexpr int DL = 64, AL = 64, MVL = 32, GL = 128;
constexpr int RWKV_COLS = 3 * RW + DL + AL + GL;
constexpr int PW = 512, PG = 128;
constexpr int IN_COLS = RWKV_COLS + PW;
constexpr int LDP = 2560;
constexpr int NKEYS = 128, NEXP = NKEYS * NKEYS, PH = 8, PQ = 256, PHALF = 128, TOPK = 16;
constexpr int NE = PH * TOPK;
constexpr float NORM_EPS = 1e-6f, GN_EPS = 64e-5f;

typedef unsigned short bf16;
__device__ __forceinline__ float bf2f(bf16 u) { return __uint_as_float((unsigned)u << 16); }
typedef float cvt_f32x2 __attribute__((ext_vector_type(2))); typedef __bf16 cvt_bf16x2 __attribute__((ext_vector_type(2)));
__device__ __forceinline__ unsigned cvtpk(float lo, float hi) { const cvt_f32x2 v = {lo, hi}; const cvt_bf16x2 b = __builtin_convertvector(v, cvt_bf16x2); return __builtin_bit_cast(unsigned, b); }
__device__ __forceinline__ bf16 f2bf(float f) { return (bf16)cvtpk(f, 0.f); }

constexpr size_t MiB = 1u << 20;
constexpr size_t WS_MOD = 1 * MiB;
constexpr size_t WS_US = 1 * MiB + 256 * 1024;
constexpr size_t WS_VS = 1 * MiB + 512 * 1024;
constexpr size_t WS_H = 2 * MiB;
constexpr size_t WS_PROJ = 34 * MiB;
constexpr size_t WS_Q = WS_PROJ;
constexpr size_t WS_R = 114 * MiB;
constexpr size_t WS_K = 130 * MiB;
constexpr size_t WS_V0 = 146 * MiB;
constexpr size_t WS_V1 = 162 * MiB;
constexpr size_t WS_KK = 178 * MiB;
constexpr size_t WS_B = 194 * MiB;
constexpr size_t WS_G = 210 * MiB;
constexpr size_t WS_BG = 226 * MiB;
constexpr size_t WS_W = 242 * MiB;
constexpr size_t WS_Y = 274 * MiB;
constexpr size_t WS_MIX = 306 * MiB;
constexpr size_t WS_IDX = 338 * MiB;
constexpr size_t WS_GATE = 346 * MiB;
constexpr size_t WS_WIN_T = 354 * MiB;
constexpr size_t WS_WOUT_T = 364 * MiB;
constexpr size_t WS_PQ_T = 368 * MiB;
constexpr size_t WS_KEYS = 376 * MiB;
constexpr size_t WS_U = 378 * MiB;
constexpr size_t WS_V = 442 * MiB;
constexpr size_t WS_QB = 410 * MiB;
constexpr size_t WS_SH = 426 * MiB;
constexpr size_t WS_LORA = 428 * MiB;
constexpr size_t WS_INVN = 430 * MiB;
constexpr size_t WS_BSUM = 431 * MiB;
constexpr size_t WS_SCN = 2 * MiB;
constexpr size_t WS_END = 506 * MiB;

template <int CTRL> __device__ __forceinline__ float dppf(float x) { return __int_as_float(__builtin_amdgcn_update_dpp(0, __float_as_int(x), CTRL, 0xF, 0xF, false)); }
__device__ __forceinline__ float red16(float x) { x += dppf<0xB1>(x); x += dppf<0x4E>(x); x += dppf<0x141>(x); x += dppf<0x140>(x); return x; }
__device__ __forceinline__ float shflx(float v, int lane, int off) { return __int_as_float(__builtin_amdgcn_ds_bpermute((lane ^ off) << 2, __float_as_int(v))); }
__device__ __forceinline__ unsigned shflxu(unsigned v, int lane, int off) { return (unsigned)__builtin_amdgcn_ds_bpermute((lane ^ off) << 2, (int)v); }
__device__ __forceinline__ void sort128(unsigned& k0, unsigned& k1, int lane) {
#pragma unroll
    for (int k = 2; k <= 128; k <<= 1) {
#pragma unroll
        for (int j = k >> 1; j > 0; j >>= 1) {
            if (j == 64) { const unsigned lo = k0 < k1 ? k0 : k1, hi = k0 < k1 ? k1 : k0; k0 = lo; k1 = hi; }
            else {
                const unsigned p0 = shflxu(k0, lane, j), p1 = shflxu(k1, lane, j);
                const bool lower = (lane & j) == 0, up0 = (lane & k) == 0, up1 = ((lane + 64) & k) == 0;
                const unsigned mn0 = k0 < p0 ? k0 : p0, mx0 = k0 < p0 ? p0 : k0, mn1 = k1 < p1 ? k1 : p1, mx1 = k1 < p1 ? p1 : k1;
                k0 = (lower == up0) ? mn0 : mx0; k1 = (lower == up1) ? mn1 : mx1;
            }
        }
    }
}
__device__ __forceinline__ float wave_sum(float v, int lane) { v = red16(v); v += shflx(v, lane, 16); v += shflx(v, lane, 32); return v; }
__device__ __forceinline__ float sigmoidf_(float x) { return 1.f / (1.f + expf(-x)); }

namespace pg8 {
#define PG8_LAS __attribute__((address_space(3)))
typedef unsigned short bf16_t;
typedef short bf16x8 __attribute__((ext_vector_type(8)));
typedef float f32x4 __attribute__((ext_vector_type(4)));
typedef unsigned u32x4 __attribute__((ext_vector_type(4)));
constexpr int BM = 256, BK = 64, HALF = 128, HTB = HALF * BK * 2  , STAGE_BYTES = 8 * HTB, NXCD = 8, WGM = 8;

__host__ __device__ __forceinline__ int lds_byte(int r, int c) { const int st = (r >> 4) * 2 + (c >> 5), rr = r & 15, cc = c & 31, ob = rr * 64 + cc * 2; return st * 1024 + (ob ^ (((ob >> 9) & 1) << 5)); }
__host__ __device__ __forceinline__ void stage_rc(int b, int& R, int& C) { const int st = b / 1024, sb = b % 1024, swz = sb ^ (((sb >> 9) & 1) << 5); R = (st >> 1) * 16 + swz / 64; C = (st & 1) * 32 + (swz % 64) / 2; }
__host__ __device__ __forceinline__ int perm32(int rho) { const int n = rho >> 4, i = rho & 15; return 8 * (i >> 2) + 4 * n + (i & 3); }

struct Unit { int pm, pn; };
struct Gemm { const bf16_t* A; const bf16_t* Bt; int M, N, K; };

struct StaticOrder {
    int nM, nN, nwg, G, c;
    __host__ __device__ void init(int M, int N, int G_, int c_) { nM = M / BM; nN = N / BM; nwg = nM * nN; G = G_; c = c_; }
    __host__ __device__ bool next(int i, Unit& u) const {
        const long L = (long)i * G + c; if (L >= nwg) return false;
        int wgid = (int)L; { const int q = nwg / NXCD, r = nwg % NXCD, xcd = wgid % NXCD, off = wgid / NXCD; wgid = (xcd < r ? xcd * (q + 1) : r * (q + 1) + (xcd - r) * q) + off; }
        const int nig = WGM * nN, gid = wgid / nig, fm = gid * WGM, gsz = (nM - fm) < WGM ? (nM - fm) : WGM;
        u.pm = fm + ((wgid % nig) % gsz); u.pn = (wgid % nig) / gsz; return true;
    }
    __device__ __forceinline__ void a_ready(const Unit&) const {}
    __device__ __forceinline__ void done(const Unit&) const {}
};

__device__ __forceinline__ unsigned cvt_pk_bf16(float lo, float hi) { unsigned r; asm volatile("v_cvt_pk_bf16_f32 %0, %1, %2" : "=v"(r) : "v"(lo), "v"(hi)); return r; }
typedef float f32x2 __attribute__((ext_vector_type(2)));
__device__ __forceinline__ f32x2 gelu_pk(f32x2 v) {
    const f32x2 av = __builtin_elementwise_abs(v), d = av * 0.2316418882f + 1.0f;
    f32x2 t; t.x = __builtin_amdgcn_rcpf(d.x); t.y = __builtin_amdgcn_rcpf(d.y);
    f32x2 q = t * 0.5307027145f + (-0.7265760135f); q = q * t + 0.7107068705f; q = q * t + (-0.142248368f); q = q * t + 0.127414796f; q = q * t;
    const f32x2 s = (v * v) * (-0.72134752044f);
    f32x2 e; e.x = __builtin_amdgcn_exp2f(s.x); e.y = __builtin_amdgcn_exp2f(s.y);
    const f32x2 m = v * (q * e), r = v - m;
    f32x2 o; o.x = v.x < 0.f ? m.x : r.x; o.y = v.y < 0.f ? m.y : r.y; return o;
}

template <int ACT  > struct EpiBf16 {
    static constexpr bool PERM = true, AFTER_DRAIN = false; static_assert(ACT == 0 || ACT == 1, "EpiBf16: ACT is 0 (none) or 1 (gelu_pk)");
    bf16_t* O; int ldc; const float* bias; int split_cols; size_t split_stride; float scale0;
    __device__ __forceinline__ void operator()(const f32x4 (&acc)[2][2][4][2], const Unit& u, int wr, int wc, int fr, int fq) const {
        const int row0 = u.pm * BM + wr * 64 + fr; int colt = u.pn * BM; bf16_t* base = O;
        float sc = 1.f; if (split_cols) { const int t = colt / split_cols; base += (size_t)t * split_stride; colt -= t * split_cols; if (t == 0) sc = scale0; }
        const int col0 = colt + wc * 32 + 8 * fq, bcol0 = u.pn * BM + wc * 32 + 8 * fq;
        f32x4 bv[2][2];
#pragma unroll
        for (int bj = 0; bj < 2; ++bj)
#pragma unroll
            for (int n = 0; n < 2; ++n) bv[bj][n] = bias ? *(const f32x4*)(bias + bcol0 + bj * HALF + 4 * n) : (f32x4){0.f, 0.f, 0.f, 0.f};
#pragma unroll
        for (int ai = 0; ai < 2; ++ai)
#pragma unroll
            for (int m = 0; m < 4; ++m) { bf16_t* rowp = base + (size_t)(row0 + ai * HALF + m * 16) * ldc + col0;
#pragma unroll
                for (int bj = 0; bj < 2; ++bj) { f32x4 v0 = acc[ai][bj][m][0] + bv[bj][0], v1 = acc[ai][bj][m][1] + bv[bj][1];
                    if (ACT == 1) { f32x2 a = gelu_pk((f32x2){v0[0], v0[1]}), b = gelu_pk((f32x2){v0[2], v0[3]}), c = gelu_pk((f32x2){v1[0], v1[1]}), d = gelu_pk((f32x2){v1[2], v1[3]});
                        v0 = (f32x4){a.x, a.y, b.x, b.y}; v1 = (f32x4){c.x, c.y, d.x, d.y}; }
                    v0 = v0 * sc; v1 = v1 * sc; u32x4 w; w.x = cvt_pk_bf16(v0[0], v0[1]); w.y = cvt_pk_bf16(v0[2], v0[3]); w.z = cvt_pk_bf16(v1[0], v1[1]); w.w = cvt_pk_bf16(v1[2], v1[3]);
                    *(u32x4*)(rowp + bj * HALF) = w; } }
    }
};

struct EpiResGate {
    static constexpr bool PERM = false, AFTER_DRAIN = false;
    const float* xold; float* X; const float* gate;
    __device__ __forceinline__ void operator()(const f32x4 (&acc)[2][2][4][2], const Unit& u, int wr, int wc, int fr, int fq) const {
        const int col0 = u.pn * BM + wc * 32 + 4 * fq; const int b = (u.pm * BM) / SEQ;
        const float* gp = gate + (size_t)b * 6 * D + col0;
#pragma unroll
        for (int bj = 0; bj < 2; ++bj)
#pragma unroll
            for (int n = 0; n < 2; ++n) { const f32x4 gv = *(const f32x4*)(gp + bj * HALF + n * 16);
#pragma unroll
                for (int ai = 0; ai < 2; ++ai)
#pragma unroll
                    for (int m = 0; m < 4; ++m) { const size_t off = (size_t)(u.pm * BM + ai * HALF + wr * 64 + m * 16 + fr) * D + col0 + bj * HALF + n * 16;
                        const f32x4 xo = *(const f32x4*)(xold + off); *(f32x4*)(X + off) = xo + gv * acc[ai][bj][m][n]; } }
    }
};
template <class Epi, class Sched, bool ALIGN_EPI = false, bool SP2 = false>
__device__ __forceinline__ void gemm_phase(PG8_LAS unsigned char* lds, const Gemm g, const Sched& S, const Epi& E, int tid) {
    asm volatile("" : "+v"(tid));
    const int wid = __builtin_amdgcn_readfirstlane(tid >> 6), lane = tid & 63, wr = wid >> 2, wc = wid & 3, fr = lane & 15, fq = lane >> 4;
    const int K = g.K, nt = K / BK;
    unsigned voffA[2], voffB[2];
#pragma unroll
    for (int i = 0; i < 2; ++i) { int R, C; stage_rc(tid * 16 + i * 8192, R, C); const int Rb = Epi::PERM ? ((R & ~31) + perm32(R & 31)) : R;
        voffA[i] = (unsigned)(R * K + C) * 2u; voffB[i] = (unsigned)(Rb * K + C) * 2u; }
    const size_t kstep = (size_t)(BK * 2);
    const size_t hstep = (size_t)HALF * K * 2;
    const size_t tstep = 2 * hstep;
    const unsigned ldsw = (unsigned)wid * 1024u;
    const int aoff = lds_byte(wr * 64 + fr, fq * 8), boff = lds_byte(wc * 32 + fr, fq * 8);
#define PG8_SA(b, h) (((b) * 2 + (h)) * HTB)
#define PG8_SB(b, h) ((4 + (b) * 2 + (h)) * HTB)
#define PG8_STAGE(bufoff, gbase, voff) do { _Pragma("unroll") for (int _i = 0; _i < 2; ++_i) \
        __builtin_amdgcn_global_load_lds((const unsigned*)((const char*)(gbase) + (voff)[_i]), (PG8_LAS unsigned*)(lds + (bufoff) + ldsw + _i * 8192), 16, 0, 0); } while (0)
#define PG8_LDA(dst, b, h) do { _Pragma("unroll") for (int m = 0; m < 4; ++m) _Pragma("unroll") for (int k = 0; k < 2; ++k) dst[m][k] = *(const PG8_LAS bf16x8*)(lds + PG8_SA(b, h) + aoff + m * 2048 + k * 1024); } while (0)
#define PG8_LDB(dst, b, h) do { _Pragma("unroll") for (int n = 0; n < 2; ++n) _Pragma("unroll") for (int k = 0; k < 2; ++k) dst[n][k] = *(const PG8_LAS bf16x8*)(lds + PG8_SB(b, h) + boff + n * 2048 + k * 1024); } while (0)
#define PG8_MMA(ai, bj, At, Bt) do { __builtin_amdgcn_s_setprio(1); _Pragma("unroll") for (int m = 0; m < 4; ++m) _Pragma("unroll") for (int n = 0; n < 2; ++n) _Pragma("unroll") for (int k = 0; k < 2; ++k) \
        acc[ai][bj][m][n] = __builtin_amdgcn_mfma_f32_16x16x32_bf16(Bt[n][k], At[m][k], acc[ai][bj][m][n], 0, 0, 0); __builtin_amdgcn_s_setprio(0); } while (0)
#define PG8_WAIT_V(n) asm volatile("s_waitcnt vmcnt(" #n ")" ::: "memory")
#define PG8_WAIT_L(n) asm volatile("s_waitcnt lgkmcnt(" #n ")" ::: "memory")
#define PG8_BAR __builtin_amdgcn_s_barrier()
#define PG8_SCHED __builtin_amdgcn_sched_barrier(0)
    Unit cur, nxt; int ui = 0;
    if (!S.next(0, cur)) return;
    f32x4 acc[2][2][4][2];
#pragma unroll
    for (int a = 0; a < 2; ++a)
#pragma unroll
        for (int b = 0; b < 2; ++b)
#pragma unroll
            for (int m = 0; m < 4; ++m)
#pragma unroll
                for (int n = 0; n < 2; ++n) acc[a][b][m][n] = (f32x4){0.f, 0.f, 0.f, 0.f};
    bf16x8 At[4][2], B0[2][2], B1[2][2];
    const char* cA = (const char*)g.A + (size_t)cur.pm * tstep; const char* cB = (const char*)g.Bt + (size_t)cur.pn * tstep;
    S.a_ready(cur);
    if constexpr (SP2) {
        PG8_STAGE(PG8_SB(0, 0), cB, voffB); PG8_STAGE(PG8_SB(0, 1), cB + hstep, voffB); PG8_STAGE(PG8_SA(0, 0), cA, voffA); PG8_STAGE(PG8_SA(0, 1), cA + hstep, voffA);
        if (wr == 1) PG8_BAR;
        PG8_WAIT_V(2); PG8_BAR;
        PG8_STAGE(PG8_SB(1, 0), cB + kstep, voffB); PG8_STAGE(PG8_SA(1, 0), cA + kstep, voffA); PG8_STAGE(PG8_SB(1, 1), cB + hstep + kstep, voffB);
        PG8_WAIT_V(6); PG8_BAR;
    } else {
        PG8_STAGE(PG8_SB(0, 0), cB, voffB); PG8_STAGE(PG8_SA(0, 0), cA, voffA); PG8_STAGE(PG8_SB(0, 1), cB + hstep, voffB); PG8_STAGE(PG8_SA(0, 1), cA + hstep, voffA);
        if (wr == 1) PG8_BAR;
        PG8_WAIT_V(4); PG8_BAR;
        PG8_STAGE(PG8_SB(1, 0), cB + kstep, voffB); PG8_STAGE(PG8_SA(1, 0), cA + kstep, voffA); PG8_STAGE(PG8_SB(1, 1), cB + hstep + kstep, voffB);
        PG8_WAIT_V(6); PG8_BAR;
    }
    for (;;) {
        const bool has_next = S.next(ui + 1, nxt);
        const char* nA = has_next ? (const char*)g.A + (size_t)nxt.pm * tstep : cA; const char* nB = has_next ? (const char*)g.Bt + (size_t)nxt.pn * tstep : cB;
        for (int t = 0; t < nt; t += 2) {
            const bool last = (t == nt - 2);
            const char* a1 = cA + (size_t)(t + 1) * kstep;
            const char* a2 = last ? nA : cA + (size_t)(t + 2) * kstep; const char* b2 = last ? nB : cB + (size_t)(t + 2) * kstep;
            const char* a3 = a2 + kstep; const char* b3 = b2 + kstep;
            if (last && has_next) S.a_ready(nxt);
            if constexpr (SP2) {
            PG8_LDB(B0, 0, 0); PG8_LDB(B1, 0, 1); PG8_SCHED; PG8_LDA(At, 0, 0); PG8_STAGE(PG8_SA(1, 1), a1 + hstep, voffA);
            PG8_WAIT_V(8); PG8_WAIT_L(0); PG8_BAR; PG8_MMA(0, 0, At, B0); PG8_MMA(0, 1, At, B1); PG8_BAR; PG8_SCHED;
            PG8_LDA(At, 0, 1); PG8_STAGE(PG8_SB(0, 0), b2, voffB); PG8_STAGE(PG8_SB(0, 1), b2 + hstep, voffB); PG8_STAGE(PG8_SA(0, 0), a2, voffA);
            PG8_WAIT_V(8); PG8_WAIT_L(0); PG8_BAR; PG8_MMA(1, 0, At, B0); PG8_MMA(1, 1, At, B1); PG8_BAR; PG8_SCHED;
            PG8_LDB(B0, 1, 0); PG8_LDB(B1, 1, 1); PG8_SCHED; PG8_LDA(At, 1, 0); PG8_STAGE(PG8_SA(0, 1), a2 + hstep, voffA);
            PG8_WAIT_V(8); PG8_WAIT_L(0); PG8_BAR; PG8_MMA(0, 0, At, B0); PG8_MMA(0, 1, At, B1); PG8_BAR; PG8_SCHED;
            PG8_LDA(At, 1, 1); PG8_STAGE(PG8_SB(1, 0), b3, voffB); PG8_STAGE(PG8_SB(1, 1), b3 + hstep, voffB); PG8_STAGE(PG8_SA(1, 0), a3, voffA);
            PG8_WAIT_V(8); PG8_WAIT_L(0); PG8_BAR; PG8_MMA(1, 0, At, B0); PG8_MMA(1, 1, At, B1); PG8_BAR; PG8_SCHED;
            } else {
            PG8_LDB(B0, 0, 0); PG8_SCHED; PG8_LDA(At, 0, 0); PG8_STAGE(PG8_SA(1, 1), a1 + hstep, voffA);
            PG8_WAIT_L(8); PG8_BAR; PG8_WAIT_L(0); PG8_MMA(0, 0, At, B0); PG8_BAR; PG8_SCHED;
            PG8_LDB(B1, 0, 1); PG8_STAGE(PG8_SB(0, 0), b2, voffB);
            PG8_BAR; PG8_WAIT_L(0); PG8_MMA(0, 1, At, B1); PG8_BAR;
            PG8_LDA(At, 0, 1); PG8_STAGE(PG8_SA(0, 0), a2, voffA);
            PG8_BAR; PG8_WAIT_L(0); PG8_MMA(1, 0, At, B0); PG8_BAR; PG8_SCHED;
            PG8_STAGE(PG8_SB(0, 1), b2 + hstep, voffB);
            PG8_WAIT_V(6); PG8_BAR; PG8_MMA(1, 1, At, B1); PG8_BAR;
            PG8_LDB(B0, 1, 0); PG8_SCHED; PG8_LDA(At, 1, 0); PG8_STAGE(PG8_SA(0, 1), a2 + hstep, voffA);
            PG8_WAIT_L(8); PG8_BAR; PG8_WAIT_L(0); PG8_MMA(0, 0, At, B0); PG8_BAR; PG8_SCHED;
            PG8_LDB(B1, 1, 1); PG8_STAGE(PG8_SB(1, 0), b3, voffB);
            PG8_BAR; PG8_WAIT_L(0); PG8_MMA(0, 1, At, B1); PG8_BAR;
            PG8_LDA(At, 1, 1); PG8_STAGE(PG8_SA(1, 0), a3, voffA);
            PG8_BAR; PG8_WAIT_L(0); PG8_MMA(1, 0, At, B0); PG8_BAR; PG8_SCHED;
            PG8_STAGE(PG8_SB(1, 1), b3 + hstep, voffB);
            PG8_WAIT_V(6); PG8_BAR; PG8_MMA(1, 1, At, B1); PG8_BAR;
            }
        }
        if constexpr (ALIGN_EPI) { if (wr == 0) PG8_BAR; }
        if constexpr (!Epi::AFTER_DRAIN) { int le_; asm volatile("v_mbcnt_lo_u32_b32 %0, -1, 0\n\tv_mbcnt_hi_u32_b32 %0, -1, %0" : "=v"(le_)); E(acc, cur, wr, wc, le_ & 15, le_ >> 4); S.done(cur); }
        if (!has_next) break;
#pragma unroll
        for (int a = 0; a < 2; ++a)
#pragma unroll
            for (int b = 0; b < 2; ++b)
#pragma unroll
                for (int m = 0; m < 4; ++m)
#pragma unroll
                    for (int n = 0; n < 2; ++n) acc[a][b][m][n] = (f32x4){0.f, 0.f, 0.f, 0.f};
        cur = nxt; cA = nA; cB = nB; ++ui;
        if constexpr (ALIGN_EPI) { if (wr == 1) PG8_BAR; }
    }
    PG8_WAIT_V(0);
    if constexpr (!ALIGN_EPI) { if (wr == 0) PG8_BAR; }
    PG8_BAR;
    if constexpr (Epi::AFTER_DRAIN) { E.fused(acc, cur, wr, wc, fr, fq, lds, wid, lane); S.done(cur); }
#undef PG8_SA
#undef PG8_SB
#undef PG8_STAGE
#undef PG8_LDA
#undef PG8_LDB
#undef PG8_MMA
#undef PG8_WAIT_V
#undef PG8_WAIT_L
#undef PG8_BAR
#undef PG8_SCHED
}
}

#define LAS __attribute__((address_space(3)))
constexpr int NWAVES = 8, NTHR = 512;
constexpr int LDS_BYTES = 147456;
constexpr int NPH = 21;
typedef float f32x4 __attribute__((ext_vector_type(4)));
typedef unsigned u32x4 __attribute__((ext_vector_type(4)));

struct Args { const float* in[30]; float* out; unsigned char* ws; int ph_lo, ph_hi; };

__device__ __forceinline__ unsigned pk2(float lo, float hi) { return cvtpk(lo, hi); }

__device__ __forceinline__ void p0_transpose_item(const float* W, int K, int N, bf16* WT, int row_off, LAS float* scr, int item, int lane) {
    const int nblk = N / 32, kb = item / nblk, nb = item % nblk, k0 = 64 * kb, n0 = 32 * nb;
#pragma unroll 8
    for (int i = 0; i < 32; ++i) { const int kk = 2 * i + (lane >> 5); scr[kk * 33 + (lane & 31)] = W[(size_t)(k0 + kk) * N + n0 + (lane & 31)]; }
    asm volatile("s_waitcnt lgkmcnt(0)" ::: "memory");
    const int c = lane & 7;
#pragma unroll
    for (int j = 0; j < 4; ++j) { const int n = (lane >> 3) + 8 * j; const LAS float* s = scr + (8 * c) * 33 + n;
        u32x4 o; o.x = pk2(s[0 * 33], s[1 * 33]); o.y = pk2(s[2 * 33], s[3 * 33]); o.z = pk2(s[4 * 33], s[5 * 33]); o.w = pk2(s[6 * 33], s[7 * 33]);
        *(u32x4*)(WT + (size_t)(row_off + n0 + n) * K + k0 + 8 * c) = o; }
    asm volatile("s_waitcnt lgkmcnt(0)" ::: "memory");
}

__device__ __forceinline__ void norm_mod_row(const float* xr, const float* gamma, const float* sh, const float* sc, bf16* orow, int lane) {
    f32x4 v[4]; float ss = 0.f;
#pragma unroll
    for (int j = 0; j < 4; ++j) { v[j] = *(const f32x4*)(xr + j * 256 + lane * 4); ss += (v[j].x * v[j].x + v[j].y * v[j].y) + (v[j].z * v[j].z + v[j].w * v[j].w); }
    const float rs = rsqrtf(wave_sum(ss, lane) * (1.f / D) + NORM_EPS);
#pragma unroll
    for (int j = 0; j < 4; ++j) { const int d = j * 256 + lane * 4; const f32x4 g = *(const f32x4*)(gamma + d), a = *(const f32x4*)(sc + d), s = *(const f32x4*)(sh + d);
        const f32x4 y = v[j] * rs * g * (a + 1.f) + s; uint2 o; o.x = pk2(y.x, y.y); o.y = pk2(y.z, y.w); *(uint2*)(orow + d) = o; }
}


#define XB_TMO      128
#define XB_XCNT(j)  (256  + 64 * (j))
#define XB_XSUB(j)  (1280 + 64 * (j))
#define XB_XGEN(j)  (2304 + 64 * (j))
#define XB_TOP      3328
#define XB_TOPGEN   3392
#define XCD_BAR_WORDS 3456
#define XB_SPIN_CAP (1u << 18)

__device__ __forceinline__ unsigned xb_ld(unsigned* p)              { return __hip_atomic_load(p, __ATOMIC_RELAXED, __HIP_MEMORY_SCOPE_AGENT); }
__device__ __forceinline__ unsigned xb_add(unsigned* p, unsigned v) { return __hip_atomic_fetch_add(p, v, __ATOMIC_RELAXED, __HIP_MEMORY_SCOPE_AGENT); }
__device__ __forceinline__ unsigned xb_xcc_id() { return (unsigned)__builtin_amdgcn_s_getreg((3 << 11) | 20) & 0xFu; }
#define XB_SPIN(cond, bar) do { unsigned _sp = 0; while (cond) { __builtin_amdgcn_s_sleep(1); \
    if ((++_sp & 255u) == 0u) { if (xb_ld(&(bar)[XB_TMO])) break; if (_sp > XB_SPIN_CAP) { atomicAdd(&(bar)[XB_TMO], 1u); break; } } } } while (0)

struct XcdBarrier {
    unsigned* bar; unsigned x; int w0;
    volatile __attribute__((address_space(3))) unsigned* st;
};

__device__ __forceinline__ XcdBarrier xcd_barrier_post(unsigned* bar, volatile __attribute__((address_space(3))) unsigned* st) {
    XcdBarrier b; b.bar = bar; b.x = xb_xcc_id(); b.st = st; b.w0 = __builtin_amdgcn_readfirstlane((int)threadIdx.x >> 6);
    if (threadIdx.x == 0) (void)xb_add(&bar[XB_XCNT(b.x)], 1u);
    return b;
}
__device__ __forceinline__ void xcd_barrier_complete(unsigned* bar, unsigned x, unsigned& nloc, unsigned& nx) {
    const unsigned G = gridDim.x * gridDim.y * gridDim.z;
    unsigned sum, cnt, mine, sp = 0u;
    for (;;) {
        sum = 0u; cnt = 0u; mine = 0u;
#pragma unroll
        for (unsigned j = 0; j < 16; ++j) { const unsigned c = xb_ld(&bar[XB_XCNT(j)]); sum += c; cnt += (c > 0u) ? 1u : 0u; }
        mine = xb_ld(&bar[XB_XCNT(x)]);
        if (sum == G) break;
        __builtin_amdgcn_s_sleep(1);
        if ((++sp & 255u) == 0u) { if (xb_ld(&bar[XB_TMO])) break; if (sp > XB_SPIN_CAP) { atomicAdd(&bar[XB_TMO], 1u); break; } }
    }
    nloc = mine > 0u ? mine : 1u; nx = cnt > 0u ? cnt : 1u;
}

template <bool FIRST> __device__ __forceinline__ void xcd_barrier(const XcdBarrier& b) {
    asm volatile("s_waitcnt vmcnt(0)" ::: "memory");
    __syncthreads();
    int lid_; asm volatile("v_mbcnt_lo_u32_b32 %0, -1, 0\n\tv_mbcnt_hi_u32_b32 %0, -1, %0" : "=v"(lid_));
    if (b.w0 == 0 && lid_ == 0) {
        unsigned* bar = b.bar;
        __builtin_amdgcn_s_waitcnt(0);
        unsigned nloc = b.st[0], nx = b.st[1];
        if (FIRST && nloc == 0u) { xcd_barrier_complete(bar, b.x, nloc, nx); b.st[0] = nloc; b.st[1] = nx; }
        const unsigned old = xb_add(&bar[XB_XSUB(b.x)], 1u);
        const unsigned gen = old / nloc;
        if (old + 1u == (gen + 1u) * nloc) {
            __builtin_amdgcn_fence(__ATOMIC_RELEASE, "agent");
            asm volatile("s_waitcnt vmcnt(0)" ::: "memory");
            const unsigned og = xb_add(&bar[XB_TOP], 1u);
            const unsigned tg = og / nx;
            if (og + 1u == (tg + 1u) * nx) xb_add(&bar[XB_TOPGEN], 1u);
            else XB_SPIN(xb_ld(&bar[XB_TOPGEN]) == tg, bar);
            __builtin_amdgcn_fence(__ATOMIC_ACQUIRE, "agent");
            xb_add(&bar[XB_XGEN(b.x)], 1u);
            asm volatile("s_waitcnt vmcnt(0)" ::: "memory");
        } else {
            XB_SPIN(xb_ld(&bar[XB_XGEN(b.x)]) == gen, bar);
            __builtin_amdgcn_fence(__ATOMIC_ACQUIRE, "agent");
            asm volatile("s_waitcnt vmcnt(0)" ::: "memory");
        }
    }
    __syncthreads();
}


__device__ __forceinline__ unsigned mono_u32(float f) { unsigned u = __float_as_uint(f); return (u & 0x80000000u) ? ~u : (u | 0x80000000u); }
__device__ __forceinline__ float demono_u32(unsigned u) { return __uint_as_float((u & 0x80000000u) ? (u & 0x7FFFFFFFu) : ~u); }
__device__ __forceinline__ unsigned pack_key7(float f, int idx) { return (mono_u32(f) & 0xFFFFFF80u) | (unsigned)(127 - idx); }
__device__ __forceinline__ float unpack_key7(unsigned k) { return demono_u32((k & 0xFFFFFF80u) | 0x40u); }
__device__ __forceinline__ float unpack_key8(unsigned k) { return demono_u32((k & 0xFFFFFF00u) | 0x80u); }
__device__ __forceinline__ void ce_desc(unsigned& a, unsigned& b) { const unsigned hi = a > b ? a : b, lo = a > b ? b : a; a = hi; b = lo; }
__device__ __forceinline__ void sort16_desc(unsigned* v) {
#pragma unroll
    for (int k = 2; k <= 16; k <<= 1)
#pragma unroll
        for (int j = k >> 1; j > 0; j >>= 1)
#pragma unroll
            for (int i = 0; i < 16; ++i) { const int l = i ^ j; if (l > i) { if ((i & k) == 0) ce_desc(v[i], v[l]); else ce_desc(v[l], v[i]); } }
}
__device__ __forceinline__ void bmerge16_desc(unsigned* v) {
#pragma unroll
    for (int j = 8; j > 0; j >>= 1)
#pragma unroll
        for (int i = 0; i < 16; ++i) { const int l = i ^ j; if (l > i) ce_desc(v[i], v[l]); }
}
__device__ __forceinline__ void merge_top16(unsigned* a, const unsigned* b) {
#pragma unroll
    for (int i = 0; i < 16; ++i) { const unsigned o = b[15 - i]; a[i] = a[i] > o ? a[i] : o; }
    bmerge16_desc(a);
}
__device__ __forceinline__ void stage2_cands(const unsigned* s0, const unsigned* s1, int hh, unsigned* c) {
    float A[16], B[16];
#pragma unroll
    for (int i = 0; i < 16; ++i) { const float f0 = unpack_key7(s0[i]), f1 = unpack_key7(s1[i]); A[i] = hh ? f1 : f0; B[i] = hh ? f0 : f1; }
    int n = 0;
#pragma unroll
    for (int i = 0; i < 4; ++i)
#pragma unroll
        for (int j = i; j < 16; ++j) { if ((i + 1) * (j + 1) > 16) continue;
            const float val = A[i] + B[j]; const unsigned id = hh ? (unsigned)((j << 4) | i) : (unsigned)((i << 4) | j);
            unsigned key = (mono_u32(val) & 0xFFFFFF00u) | id; if (hh && i == j) key = 0u; c[n++] = key; }
#pragma unroll
    for (; n < 32; ++n) c[n] = 0u;
}

typedef short bf16x8_t __attribute__((ext_vector_type(8)));
typedef float f32x16 __attribute__((ext_vector_type(16)));
__device__ __forceinline__ float gelu_erf(float a) { return 0.5f * a * (1.f + erff(a * 0.70710678118654752f)); }


typedef __attribute__((address_space(3))) bf16 lbf16;

__device__ __forceinline__ f32x16 mm32(bf16x8_t a, bf16x8_t b, f32x16 c) { return __builtin_amdgcn_mfma_f32_32x32x16_bf16(a, b, c, 0, 0, 0); }
__device__ __forceinline__ bf16x8_t frag_from_u32x4(unsigned x, unsigned y, unsigned z, unsigned w) { typedef unsigned u4 __attribute__((ext_vector_type(4))); u4 t = {x, y, z, w}; return __builtin_bit_cast(bf16x8_t, t); }
template <int S> __device__ __forceinline__ bf16x8_t accop(const f32x16& z) {
    return frag_from_u32x4(cvtpk(z[8 * S], z[8 * S + 1]), cvtpk(z[8 * S + 2], z[8 * S + 3]), cvtpk(z[8 * S + 4], z[8 * S + 5]), cvtpk(z[8 * S + 6], z[8 * S + 7])); }
template <int S> __device__ __forceinline__ bf16x8_t ldpermcol(const lbf16* a, int col, int hh) {
    const lbf16* p = a + (16 * S + 4 * hh) * 72 + col;
    const unsigned e0 = p[0], e1 = p[72], e2 = p[144], e3 = p[216], e4 = p[8 * 72], e5 = p[9 * 72], e6 = p[10 * 72], e7 = p[11 * 72];
    return frag_from_u32x4(e0 | (e1 << 16), e2 | (e3 << 16), e4 | (e5 << 16), e6 | (e7 << 16)); }
__device__ __forceinline__ bf16x8_t ldrow(const lbf16* a, int row, int ks, int hh) { return *(const __attribute__((address_space(3))) bf16x8_t*)(a + row * 72 + ks * 16 + 8 * hh); }
__device__ __forceinline__ int rowidx(int e, int hh) { return (e & 3) + 8 * (e >> 2) + 4 * hh; }

constexpr int ROWB = 768;
__device__ __forceinline__ unsigned fp6code(float x, float sc) {
    const float t = fabsf(x) * sc;
    const float r = t < 16.f ? __builtin_rintf(t) : (t < 32.f ? 8.f + __builtin_rintf(t * 0.5f) : 16.f + __builtin_rintf(t * 0.25f));
    unsigned c = (unsigned)r; c = c > 31u ? 31u : c;
    return c | (x < 0.f ? 32u : 0u);
}
__device__ __forceinline__ void convert_tables_fp6(const float* pu, const float* pv, unsigned char* u8, unsigned char* v8, float* usc, float* vsc, int l, int wv, int nw, int lane) {
    for (int rr0 = wv * 2; rr0 < 2 * NEXP; rr0 += nw * 2) {
        f32x4 v[2][4]; float m[2];
#pragma unroll
        for (int rr = 0; rr < 2; ++rr) { const int q = rr0 + rr; const size_t row = (size_t)l * NEXP + (q < NEXP ? q : q - NEXP); const float* sp_ = (q < NEXP ? pu : pv) + row * D + lane * 16;
#pragma unroll
            for (int k = 0; k < 4; ++k) v[rr][k] = *(const f32x4*)(sp_ + k * 4); }
#pragma unroll
        for (int rr = 0; rr < 2; ++rr) { float mm = 0.f;
#pragma unroll
            for (int k = 0; k < 4; ++k) mm = fmaxf(fmaxf(mm, fmaxf(fabsf(v[rr][k].x), fabsf(v[rr][k].y))), fmaxf(fabsf(v[rr][k].z), fabsf(v[rr][k].w)));
#pragma unroll
            for (int o = 1; o < 64; o <<= 1) mm = fmaxf(mm, shflx(mm, lane, o));
            m[rr] = mm; }
#pragma unroll
        for (int rr = 0; rr < 2; ++rr) { const int q = rr0 + rr; const size_t row = (size_t)l * NEXP + (q < NEXP ? q : q - NEXP); const float sc = m[rr] > 0.f ? 60.f / m[rr] : 1.f;
            unsigned c[16];
#pragma unroll
            for (int k = 0; k < 4; ++k) { c[k * 4] = fp6code(v[rr][k].x, sc); c[k * 4 + 1] = fp6code(v[rr][k].y, sc); c[k * 4 + 2] = fp6code(v[rr][k].z, sc); c[k * 4 + 3] = fp6code(v[rr][k].w, sc); }
            const unsigned o0 = c[0] | (c[1] << 6) | (c[2] << 12) | (c[3] << 18) | (c[4] << 24) | (c[5] << 30);
            const unsigned o1 = (c[5] >> 2) | (c[6] << 4) | (c[7] << 10) | (c[8] << 16) | (c[9] << 22) | (c[10] << 28);
            const unsigned o2 = (c[10] >> 4) | (c[11] << 2) | (c[12] << 8) | (c[13] << 14) | (c[14] << 20) | (c[15] << 26);
            unsigned* op = (unsigned*)((q < NEXP ? u8 : v8) + row * ROWB + lane * 12);
            op[0] = o0; op[1] = o1; op[2] = o2;
            if (lane == 0) (q < NEXP ? usc : vsc)[row] = m[rr] > 0.f ? m[rr] * (1.f / 7.5f) : 1.f; }
    }
}

__global__ void __launch_bounds__(NTHR, 2) mega(Args args) {
    extern __shared__ __attribute__((aligned(16))) unsigned char lds_raw[];
    LAS unsigned char* lds = (LAS unsigned char*)lds_raw;
    const int G = gridDim.x, bx = blockIdx.x, NGW = G * NWAVES;
    const int wave0 = __builtin_amdgcn_readfirstlane((int)threadIdx.x >> 6);
    typedef const unsigned char __attribute__((address_space(4))) kbyte;
#define PHASE_IDS int tid; asm volatile("v_mbcnt_lo_u32_b32 %0, -1, 0\n\tv_mbcnt_hi_u32_b32 %0, -1, %0" : "=v"(tid)); tid += wave0 * 64;     const int lane = tid & 63, wave = __builtin_amdgcn_readfirstlane(tid >> 6), gw = bx * NWAVES + wave; (void)lane; (void)gw; \
    kbyte* kp = (kbyte*)__builtin_amdgcn_kernarg_segment_ptr(); asm volatile("" : "+s"(kp)); \
    unsigned char* const ws = (unsigned char*)*(__attribute__((address_space(1))) unsigned char* const __attribute__((address_space(4)))*)(kp + 31 * 8); float* const X = (float*)*(__attribute__((address_space(1))) float* const __attribute__((address_space(4)))*)(kp + 30 * 8); (void)ws; (void)X;
#define INP(i) ((const float*)(*(const __attribute__((address_space(1))) float* const __attribute__((address_space(4)))*)(kp + (i) * 8)))
#define MOD ((float*)(ws + WS_MOD))
#define H ((bf16*)(ws + WS_H))
#define PROJ ((bf16*)(ws + WS_PROJ))
#define Q ((bf16*)(ws + WS_Q))
#define MIX ((bf16*)(ws + WS_MIX))
#define Rb ((bf16*)(ws + WS_R))
#define Kb ((bf16*)(ws + WS_K))
#define V0 ((bf16*)(ws + WS_V0))
#define V1 ((bf16*)(ws + WS_V1))
#define KKb ((bf16*)(ws + WS_KK))
#define Bb ((bf16*)(ws + WS_B))
#define Gb ((bf16*)(ws + WS_G))
#define BGb ((bf16*)(ws + WS_BG))
#define Wd ((float*)(ws + WS_W))
#define Y ((float*)(ws + WS_Y))
#define QB ((float*)(ws + WS_QB))
#define SH ((float*)(ws + WS_SH))
#define WUPT ((bf16*)(ws + WS_LORA))
#define AUPT ((bf16*)(ws + WS_LORA + 131072))
#define GUPT ((bf16*)(ws + WS_LORA + 262144))
#define VUPT ((bf16*)(ws + WS_LORA + 524288))
#define PWT ((bf16*)(ws + WS_LORA + 655360))
#define INVN ((float*)(ws + WS_INVN))
#define BSUM ((float*)(ws + WS_BSUM))
#define SCN ((unsigned char*)(ws + WS_SCN))
#define IDX ((int*)(ws + WS_IDX))
#define GATE ((float*)(ws + WS_GATE))
#define WinT ((bf16*)(ws + WS_WIN_T))
#define WoutT ((bf16*)(ws + WS_WOUT_T))
#define PqT ((bf16*)(ws + WS_PQ_T))
#define KEYS ((bf16*)(ws + WS_KEYS))
#define U8 ((unsigned char*)(ws + WS_U))
#define V8 ((unsigned char*)(ws + WS_V))
#define USc ((float*)(ws + WS_US))
#define VSc ((float*)(ws + WS_VS))
    const int lo = args.ph_lo, hi = args.ph_hi;
    { volatile LAS unsigned* misc = (volatile LAS unsigned*)(lds + LDS_BYTES - 64); if (threadIdx.x < 4) misc[threadIdx.x] = 0u; __syncthreads(); }
    const XcdBarrier xbar = xcd_barrier_post((unsigned*)(args.ws) + 4096, (volatile LAS unsigned*)(lds + LDS_BYTES - 64));
#define IN(k) (lo <= (k) && (k) < hi)
#ifndef REP_PHASE
#define REP_PHASE (-1)
#endif
#define REPS(k) ((k) == REP_PHASE ? 3 : 1)
#define SEAM(k) do { if (IN(k) && IN((k) + 1)) { if ((k) == 0) cg::this_grid().sync(); else { XcdBarrier xb_ = xbar; asm volatile("" : "+s"(xb_.bar)); if ((k) == 1) xcd_barrier<true>(xb_); else xcd_barrier<false>(xb_); } } } while (0)

    if (IN(0)) { PHASE_IDS
        { LAS float* ca = (LAS float*)lds; LAS float* red = (LAS float*)(lds + 16384);
          const float* c = INP(1); const float* ada_w = INP(2); const float* ada_b = INP(3);
          bool have = false;
          for (int it = bx; it < 96; it += G) {
              if (!have) { for (int i = tid; i < BATCH * D; i += NTHR) { const float v = c[i]; ca[i] = v / (1.f + expf(-v)); } have = true; __syncthreads(); }
              const int l = it / 48, n = (it % 48) * 128 + (tid & 127), kq = tid >> 7;
              const float* w = ada_w + (size_t)l * D * 6 * D + (size_t)(kq * 256) * 6 * D + n;
              float a0 = 0.f, a1 = 0.f, a2 = 0.f, a3 = 0.f;
#pragma unroll 32
              for (int k = 0; k < 256; ++k) { const float wv = w[(size_t)k * 6 * D]; const int kk = kq * 256 + k; a0 += ca[kk] * wv; a1 += ca[D + kk] * wv; a2 += ca[2 * D + kk] * wv; a3 += ca[3 * D + kk] * wv; }
              red[(kq * 4 + 0) * 128 + (tid & 127)] = a0; red[(kq * 4 + 1) * 128 + (tid & 127)] = a1; red[(kq * 4 + 2) * 128 + (tid & 127)] = a2; red[(kq * 4 + 3) * 128 + (tid & 127)] = a3;
              __syncthreads();
              { const int b = tid >> 7, col = tid & 127, nn = (it % 48) * 128 + col;
                const float s = red[(0 * 4 + b) * 128 + col] + red[(1 * 4 + b) * 128 + col] + red[(2 * 4 + b) * 128 + col] + red[(3 * 4 + b) * 128 + col];
                MOD[(size_t)l * BATCH * 6 * D + (size_t)b * 6 * D + nn] = s + ada_b[l * 6 * D + nn]; }
              __syncthreads();
          }
          __syncthreads(); }
        { LAS float* scr = (LAS float*)(lds + wave * 16384);
          constexpr int I_IN = (D / 64) * (IN_COLS / 32), I_VR = (D / 64) * (MVL / 32), I_OUT = (D / 64) * (D / 32), I_PQ = (D / 64) * (PH * PQ / 32);
          constexpr int NIT = 2 * I_IN + I_VR + 2 * I_OUT + 2 * I_PQ;
          for (int it = gw; it < NIT; it += NGW) { int r = it;
              if (r < 2 * I_IN) { const int l = r / I_IN; p0_transpose_item(INP(5) + (size_t)l * D * IN_COLS, D, IN_COLS, WinT + (size_t)l * LDP * D, 0, scr, r % I_IN, lane); continue; } r -= 2 * I_IN;
              if (r < I_VR) { p0_transpose_item(INP(12), D, MVL, WinT + (size_t)1 * LDP * D, IN_COLS, scr, r, lane); continue; } r -= I_VR;
              if (r < 2 * I_OUT) { const int l = r / I_OUT; p0_transpose_item(INP(23) + (size_t)l * D * D, D, D, WoutT + (size_t)l * D * D, 0, scr, r % I_OUT, lane); continue; } r -= 2 * I_OUT;
              { const int l = r / I_PQ; p0_transpose_item(INP(25) + (size_t)l * D * PH * PQ, D, PH * PQ, PqT + (size_t)l * PH * PQ * D, 0, scr, r % I_PQ, lane); } }
          for (int it = gw; it < 2 * 16 + 2 * 16 + 2 * 32; it += NGW) { int r = it;
              if (r < 32) { const int l = r / 16; p0_transpose_item(INP(8) + (size_t)l * DL * RW, DL, RW, WUPT + (size_t)l * RW * DL, 0, scr, r % 16, lane); continue; } r -= 32;
              if (r < 32) { const int l = r / 16; p0_transpose_item(INP(10) + (size_t)l * AL * RW, AL, RW, AUPT + (size_t)l * RW * AL, 0, scr, r % 16, lane); continue; } r -= 32;
              { const int l = r / 32; p0_transpose_item(INP(11) + (size_t)l * GL * RW, GL, RW, GUPT + (size_t)l * RW * GL, 0, scr, r % 32, lane); } }
          { const float* vu = INP(15); for (int e = bx * NTHR + tid; e < MVL * RW; e += G * NTHR) { const int n = e >> 5, k = e & 31; VUPT[e] = f2bf(vu[k * RW + n]); } }
          for (int it = gw; it < 8 * 8; it += NGW) p0_transpose_item(INP(21) + (size_t)(it >> 3) * PG * PG, PG, PG, PWT + (size_t)(it >> 3) * PG * PG, 0, scr, it & 7, lane);
        }
        { const size_t gt = (size_t)bx * NTHR + tid, NT = (size_t)G * NTHR;
          constexpr size_t NK8 = (size_t)2 * PH * 2 * NKEYS * PHALF / 8;
          const float* src = INP(26); bf16* dst = KEYS;
          for (size_t i = gt; i < NK8; i += NT) {
              const f32x4 a = *(const f32x4*)(src + i * 8), b = *(const f32x4*)(src + i * 8 + 4);
              u32x4 o; o.x = pk2(a.x, a.y); o.y = pk2(a.z, a.w); o.z = pk2(b.x, b.y); o.w = pk2(b.z, b.w); *(u32x4*)(dst + i * 8) = o; }
        }
    }
    SEAM(0);

#pragma unroll
    for (int l = 0; l < DEPTH; ++l) {
        const int pb = 1 + 10 * l;
#define modl (MOD + (size_t)l * BATCH * 6 * D)
#define xin (l == 0 ? INP(0) : (const float*)X)
        if (l == 0 && IN(pb + 0)) { PHASE_IDS const float* gamma = INP(4) + l * D;
            for (int row = gw; row < T; row += NGW) { const int b = row / SEQ; norm_mod_row(xin + (size_t)row * D, gamma, modl + (size_t)b * 6 * D, modl + (size_t)b * 6 * D + D, H + (size_t)row * D, lane); } }
        SEAM(pb + 0);
        if (IN(pb + 1)) { PHASE_IDS const int N1 = l == 0 ? IN_COLS : LDP;
            pg8::Gemm g{H, WinT + (size_t)l * LDP * D, T, N1, D}; pg8::StaticOrder S; S.init(T, N1, G, bx);
            pg8::EpiBf16<0> E{PROJ, LDP, nullptr, 0, 0, 1.f};
            pg8::gemm_phase<pg8::EpiBf16<0>, pg8::StaticOrder, true, true>(lds, g, S, E, tid); }
        SEAM(pb + 1);

        if (IN(pb + 2)) { PHASE_IDS
            constexpr int LST = 296;
            LAS bf16* lin = (LAS bf16*)lds;
            const float* mu = INP(6) + l * RWKV_COLS; const float* vmu = INP(13);
            const float* w0p = INP(7) + l * RW; const float* a0p = INP(9) + l * RW; const float* kkp = INP(16) + l * RW; const float* kap = INP(17) + l * RW; const float* rkp = INP(18) + l * RW; const float* v0p = INP(14);
            const bf16* wupT = WUPT + (size_t)l * RW * DL; const bf16* aupT = AUPT + (size_t)l * RW * AL; const bf16* gupT = GUPT + (size_t)l * RW * GL; const bf16* vupT = VUPT;
            bf16* Vl = l == 0 ? V0 : V1;
            const int r32 = lane & 31, hh = lane >> 5, h = wave;
            for (int tile = bx; tile < T / 32; tile += G) {
                const int t0 = tile * 32;
                __syncthreads();
#pragma unroll 1
                for (int it0 = 0; it0 < 3; it0 += 2) {
                  u32x4 cu_[2], pv_[2]; f32x4 m0_[2], m1_[2];
#pragma unroll
                  for (int it = 0; it < 2; ++it) { const int c8 = tid + (it0 + it) * NTHR; const bool ok = c8 < 32 * 36; const int tok = ok ? c8 / 36 : 0, jc = ok ? c8 % 36 : 0, t = t0 + tok, sq = t % SEQ;
                      cu_[it] = (u32x4){0u, 0u, 0u, 0u}; pv_[it] = (u32x4){0u, 0u, 0u, 0u}; m0_[it] = (f32x4){0.f, 0.f, 0.f, 0.f}; m1_[it] = m0_[it];
                      if (ok && (jc < 32 || l > 0)) { const int col = jc < 32 ? 3 * RW + jc * 8 : IN_COLS + (jc - 32) * 8;
                          cu_[it] = *(const u32x4*)(PROJ + (size_t)t * LDP + col); if (sq > 0) pv_[it] = *(const u32x4*)(PROJ + (size_t)(t - 1) * LDP + col);
                          const float* mp = jc < 32 ? mu + col : vmu + (jc - 32) * 8; m0_[it] = *(const f32x4*)mp; m1_[it] = *(const f32x4*)(mp + 4); } }
#pragma unroll
                  for (int it = 0; it < 2; ++it) { const int c8 = tid + (it0 + it) * NTHR; if (c8 < 32 * 36) { const int tok = c8 / 36, jc = c8 % 36;
                      u32x4 o = {0u, 0u, 0u, 0u};
                      if (jc < 32 || l > 0) {
                          float x[8]; const unsigned cw[4] = {cu_[it].x, cu_[it].y, cu_[it].z, cu_[it].w}, pw[4] = {pv_[it].x, pv_[it].y, pv_[it].z, pv_[it].w}; const float mm[8] = {m0_[it].x, m0_[it].y, m0_[it].z, m0_[it].w, m1_[it].x, m1_[it].y, m1_[it].z, m1_[it].w};
#pragma unroll
                          for (int i = 0; i < 4; ++i) { const float c0 = __uint_as_float(cw[i] << 16), c1 = __uint_as_float(cw[i] & 0xffff0000u), p0 = __uint_as_float(pw[i] << 16), p1 = __uint_as_float(pw[i] & 0xffff0000u);
                              x[2 * i] = c0 + (p0 - c0) * mm[2 * i]; x[2 * i + 1] = c1 + (p1 - c1) * mm[2 * i + 1]; }
                          if (jc < 8) {
#pragma unroll
                              for (int i = 0; i < 8; ++i) { const float e2 = __expf(-2.f * fabsf(x[i])); const float th = (1.f - e2) * __builtin_amdgcn_rcpf(1.f + e2); x[i] = x[i] < 0.f ? -th : th; } }
                          else if (jc >= 16 && jc < 32) {
#pragma unroll
                              for (int i = 0; i < 8; ++i) x[i] = __builtin_amdgcn_rcpf(1.f + __expf(-x[i])); }
                          o.x = pk2(x[0], x[1]); o.y = pk2(x[2], x[3]); o.z = pk2(x[4], x[5]); o.w = pk2(x[6], x[7]);
                      }
                      *(LAS u32x4*)(lin + tok * LST + jc * 8) = o; } } }
                __syncthreads();
                const bool first = (t0 % SEQ) == 0;
                lbf16* tin = (lbf16*)(lds + 19456 + wave * 14336);
                { u32x4 iq[13]; int ql_; asm volatile("v_mbcnt_lo_u32_b32 %0, -1, 0\n\tv_mbcnt_hi_u32_b32 %0, -1, %0" : "=v"(ql_));
#pragma unroll
                  for (int i = 0; i < 13; ++i) { const int q = ql_ + 64 * i; iq[i] = (u32x4){0u, 0u, 0u, 0u};
                      if (q < 792) { const int arr = q / 264, rem = q - arr * 264, row = rem >> 3, cc = rem & 7;
                          if (!(first && row == 0)) iq[i] = *(const u32x4*)(PROJ + (size_t)(t0 - 1 + row) * LDP + arr * RW + h * HS + cc * 8); } }
#pragma unroll
                  for (int i = 0; i < 13; ++i) { const int q = ql_ + 64 * i; if (q < 792) { const int arr = q / 264, rem = q - arr * 264, row = rem >> 3, cc = rem & 7;
                      *(__attribute__((address_space(3))) u32x4*)(tin + arr * 2376 + row * 72 + cc * 8) = iq[i]; } } }
                __builtin_amdgcn_wave_barrier(); asm volatile("s_waitcnt lgkmcnt(0)" ::: "memory");
                float ssq[16], bsm[16];
#pragma unroll
                for (int e = 0; e < 16; ++e) { ssq[e] = 0.f; bsm[e] = 0.f; }
#pragma unroll 1
                for (int rt = 0; rt < 2; ++rt) {
                    f32x16 accW, accA, accG, accV;
#pragma unroll
                    for (int e = 0; e < 16; ++e) { accW[e] = 0.f; accA[e] = 0.f; accG[e] = 0.f; accV[e] = 0.f; }
                    int c = h * HS + rt * 32 + r32;
int hh8 = 8 * hh; asm volatile("" : "+v"(c), "+v"(hh8));
                    const LAS bf16* lrow = lin + r32 * LST + 8 * hh;
                    { bf16x8_t wf[18];
#pragma unroll
                      for (int ks = 0; ks < 4; ++ks) { wf[ks] = *(const bf16x8_t*)(wupT + (size_t)c * DL + ks * 16 + hh8); wf[4 + ks] = *(const bf16x8_t*)(aupT + (size_t)c * AL + ks * 16 + hh8); }
#pragma unroll
                      for (int ks = 0; ks < 8; ++ks) wf[8 + ks] = *(const bf16x8_t*)(gupT + (size_t)c * GL + ks * 16 + hh8);
                      if (l > 0) { wf[16] = *(const bf16x8_t*)(vupT + (size_t)c * MVL + hh8); wf[17] = *(const bf16x8_t*)(vupT + (size_t)c * MVL + 16 + hh8); }
#pragma unroll
                      for (int ks = 0; ks < 4; ++ks) { accW = __builtin_amdgcn_mfma_f32_32x32x16_bf16(*(const LAS bf16x8_t*)(lrow + ks * 16), wf[ks], accW, 0, 0, 0);
                                                       accA = __builtin_amdgcn_mfma_f32_32x32x16_bf16(*(const LAS bf16x8_t*)(lrow + 64 + ks * 16), wf[4 + ks], accA, 0, 0, 0); }
#pragma unroll
                      for (int ks = 0; ks < 8; ++ks) accG = __builtin_amdgcn_mfma_f32_32x32x16_bf16(*(const LAS bf16x8_t*)(lrow + 128 + ks * 16), wf[8 + ks], accG, 0, 0, 0);
                      if (l > 0) {
#pragma unroll
                          for (int ks = 0; ks < 2; ++ks) accV = __builtin_amdgcn_mfma_f32_32x32x16_bf16(*(const LAS bf16x8_t*)(lrow + 256 + ks * 16), wf[16 + ks], accV, 0, 0, 0); } }
                    const float mur = mu[c], muk = mu[RW + c], muv = mu[2 * RW + c], w0c = w0p[c], a0c = a0p[c], kkc = kkp[c], kac = kap[c], rkc = rkp[c];
                    const float v0c = l > 0 ? v0p[c] : 0.f;
#pragma unroll
                    for (int eb = 0; eb < 16; eb += 4) {
                        bf16 lr[4], lk[4], lv[4], lrp[4], lkp[4], lvp[4], lvf[4];
#pragma unroll
                        for (int i = 0; i < 4; ++i) { const int e = eb + i; const int tok = (e & 3) + 8 * (e >> 2) + 4 * hh, t = t0 + tok; const int ci = rt * 32 + r32;
                            lr[i] = tin[(tok + 1) * 72 + ci]; lk[i] = tin[2376 + (tok + 1) * 72 + ci]; lv[i] = tin[2 * 2376 + (tok + 1) * 72 + ci];
                            lrp[i] = tin[tok * 72 + ci]; lkp[i] = tin[2376 + tok * 72 + ci]; lvp[i] = tin[2 * 2376 + tok * 72 + ci];
                            lvf[i] = l > 0 ? V0[(size_t)t * RW + c] : (bf16)0; }
                        __builtin_amdgcn_sched_barrier(0);
#pragma unroll
                        for (int i = 0; i < 4; ++i) { const int e = eb + i; const int tok = (e & 3) + 8 * (e >> 2) + 4 * hh, t = t0 + tok; const size_t o = (size_t)t * RW + c;
                            float r = bf2f(lr[i]), k = bf2f(lk[i]), v = bf2f(lv[i]);
                            r += (bf2f(lrp[i]) - r) * mur; k += (bf2f(lkp[i]) - k) * muk; v += (bf2f(lvp[i]) - v) * muv;
                            const float z = -(w0c + accW[e]); const float sp = fmaxf(z, 0.f) + __logf(1.f + __expf(-fabsf(z)));
                            const float decay = __expf(-__expf(-sp - 0.5f));
                            const float a = __builtin_amdgcn_rcpf(1.f + __expf(-(a0c + accA[e]))); const float g = accG[e];
                            if (l > 0) { const float vfv = bf2f(lvf[i]); v = v + (vfv - v) * __builtin_amdgcn_rcpf(1.f + __expf(-(v0c + accV[e]))); }
                            const float kk = k * kkc; const float k2 = k * (1.f + (a - 1.f) * kac);
                            ssq[e] += kk * kk; bsm[e] += r * k2 * rkc;
                            { const unsigned p0_ = cvtpk(r, k2), p1_ = cvtpk(v, kk), p2_ = cvtpk(kk * a, g), p3_ = cvtpk(v * g, 0.f);
                              Rb[o] = (bf16)p0_; Kb[o] = (bf16)(p0_ >> 16); Vl[o] = (bf16)p1_; KKb[o] = (bf16)(p1_ >> 16); Bb[o] = (bf16)p2_; Gb[o] = (bf16)(p2_ >> 16); BGb[o] = (bf16)p3_; Wd[o] = decay; }
                        }
                    }
                }
#pragma unroll
                for (int e = 0; e < 16; ++e) { const int ln_ = r32 | (hh << 5); float a_ = red16(ssq[e]), b_ = red16(bsm[e]); a_ += shflx(a_, ln_, 16); b_ += shflx(b_, ln_, 16); ssq[e] = a_; bsm[e] = b_; }
                if (r32 == 0) {
#pragma unroll
                    for (int e = 0; e < 16; ++e) { const int tok = (e & 3) + 8 * (e >> 2) + 4 * hh; INVN[(size_t)(t0 + tok) * NH + h] = rsqrtf(fmaxf(ssq[e], 1e-24f)); BSUM[(size_t)(t0 + tok) * NH + h] = bsm[e]; } }
            }
            {
                constexpr int DST = 520;
                int lane_p; asm volatile("v_mbcnt_lo_u32_b32 %0, -1, 0\n\tv_mbcnt_hi_u32_b32 %0, -1, %0" : "=v"(lane_p)); const int r32 = lane_p & 31, hh = lane_p >> 5, tidp = wave0 * 64 + lane_p;
                lbf16* dlb = (lbf16*)lds;
                lbf16* pin = (lbf16*)(lds + 33280);
                const int c = tidp, g = c >> 7, win = 2 << g;
                const bf16* pwt = PWT + (size_t)(l * 4 + (wave >> 1)) * PG * PG; const float* psc = INP(22) + l * PW;
                for (int tile = bx; tile < T / 32; tile += G) {
                    const int t0 = tile * 32; const bool first = (t0 % SEQ) == 0;
                    __syncthreads();
                    { u32x4 pq[6];
#pragma unroll
                      for (int q = 0; q < 6; ++q) { const int ch = tidp + q * NTHR, row = ch >> 6, cc = ch & 63; pq[q] = (u32x4){0u, 0u, 0u, 0u};
                          if (ch < 47 * 64 && (row >= 15 || !first)) pq[q] = *(const u32x4*)(PROJ + (size_t)(t0 - 15 + row) * LDP + RWKV_COLS + cc * 8); }
#pragma unroll
                      for (int q = 0; q < 6; ++q) { const int ch = tidp + q * NTHR, row = ch >> 6, cc = ch & 63; if (ch < 47 * 64) *(__attribute__((address_space(3))) u32x4*)(pin + row * 520 + cc * 8) = pq[q]; } }
                    __syncthreads();
                    const lbf16* pc = pin + c;
                    float sw = 0.f;
#pragma unroll
                    for (int j = 1; j <= 15; ++j) sw += (j < win) ? bf2f(pc[(15 - j) * 520]) : 0.f;
                    const float invw = 1.f / (float)win;
#pragma unroll 8
                    for (int i = 0; i < 32; ++i) {
                        const float cur = bf2f(pc[(15 + i) * 520]);
                        sw += cur;
                        const float inv = (first && i < 15) ? 1.f / (float)min(i + 1, win) : invw;
                        dlb[i * DST + c] = f2bf(sw * inv - cur);
                        sw -= bf2f(pc[(15 + i - win + 1) * 520]);
                    }
                    __syncthreads();
                    const int gg = wave >> 1, half = wave & 1;
#pragma unroll
                    for (int ct = 0; ct < 2; ++ct) {
                        const int dd0 = half * 64 + ct * 32;
                        f32x16 acc;
#pragma unroll
                        for (int e = 0; e < 16; ++e) acc[e] = 0.f;
#pragma unroll
                        for (int ks = 0; ks < 8; ++ks) { const bf16x8_t a = *(const __attribute__((address_space(3))) bf16x8_t*)(dlb + r32 * DST + gg * PG + ks * 16 + 8 * hh);
                            const bf16x8_t w = *(const bf16x8_t*)(pwt + (size_t)(dd0 + r32) * PG + ks * 16 + 8 * hh); acc = mm32(a, w, acc); }
                        const int oc = gg * PG + dd0 + r32; const float ps = psc[oc];
#pragma unroll
                        for (int e = 0; e < 16; ++e) MIX[(size_t)(t0 + rowidx(e, hh)) * D + RW + oc] = f2bf(acc[e] * ps);
                    }
                }
            }
        }
        SEAM(pb + 2);

        if (IN(pb + 3)) { PHASE_IDS
            const bf16* Vl = l == 0 ? V0 : V1;
            const int r32 = lane & 31, hh = lane >> 5;
            if (wave < 6) {
                lbf16* At = (lbf16*)(lds + wave * 23552); lbf16* Bt = At + 2304; lbf16* Kt = Bt + 2304; lbf16* Rt = Kt + 2304; lbf16* Vv = Rt + 2304;
                LAS float* PCs = (LAS float*)(lds + wave * 23552 + 23040);
                for (int item = bx * 6 + wave; item < BATCH * NH * (SEQ / 32); item += G * 6) {
                    const int bh = item >> 7, chunk = item & 127, b = bh >> 3, h = bh & 7; const size_t t0 = (size_t)b * SEQ + chunk * 32;
                    __builtin_amdgcn_wave_barrier(); asm volatile("s_waitcnt lgkmcnt(0)" ::: "memory");
                    {
                      const int tk = lane >> 3, part = lane & 7;
                      u32x4 qr[4], qk[4], qv[4], qkk[4], qb[4]; f32x4 qw0[4], qw1[4]; float qin[4];
#pragma unroll
                      for (int p4 = 0; p4 < 4; ++p4) { const size_t o = (t0 + p4 * 8 + tk) * RW + h * HS + part * 8;
                          qr[p4] = *(const u32x4*)(Rb + o); qk[p4] = *(const u32x4*)(Kb + o); qv[p4] = *(const u32x4*)(Vl + o); qkk[p4] = *(const u32x4*)(KKb + o); qb[p4] = *(const u32x4*)(Bb + o);
                          qw0[p4] = *(const f32x4*)(Wd + o); qw1[p4] = *(const f32x4*)(Wd + o + 4); qin[p4] = INVN[(t0 + p4 * 8 + tk) * NH + h]; }
                      LAS float* Pl = (LAS float*)At;
#pragma unroll
                      for (int p4 = 0; p4 < 4; ++p4) { *(LAS f32x4*)(Pl + (p4 * 8 + tk) * 64 + part * 8) = qw0[p4]; *(LAS f32x4*)(Pl + (p4 * 8 + tk) * 64 + part * 8 + 4) = qw1[p4]; }
                      __builtin_amdgcn_wave_barrier(); asm volatile("s_waitcnt lgkmcnt(0)" ::: "memory");
                      { float P = 1.f;
#pragma unroll 8
                        for (int c = 0; c < 32; ++c) { P *= Pl[c * 64 + lane]; Pl[c * 64 + lane] = P; }
                        PCs[lane] = P; }
                      __builtin_amdgcn_wave_barrier(); asm volatile("s_waitcnt lgkmcnt(0)" ::: "memory");
                      u32x4 oa[4], orr[4], ob_[4], ok_[4];
#pragma unroll
                      for (int p4 = 0; p4 < 4; ++p4) { const int c = p4 * 8 + tk;
                          const f32x4 pa = *(const LAS f32x4*)(Pl + c * 64 + part * 8), pb2 = *(const LAS f32x4*)(Pl + c * 64 + part * 8 + 4);
                          f32x4 ma = {1.f, 1.f, 1.f, 1.f}, mb = ma; if (c > 0) { ma = *(const LAS f32x4*)(Pl + (c - 1) * 64 + part * 8); mb = *(const LAS f32x4*)(Pl + (c - 1) * 64 + part * 8 + 4); }
                          const float Pc[8] = {pa.x, pa.y, pa.z, pa.w, pb2.x, pb2.y, pb2.z, pb2.w}, Pm[8] = {ma.x, ma.y, ma.z, ma.w, mb.x, mb.y, mb.z, mb.w};
                          const unsigned rw_[4] = {qr[p4].x, qr[p4].y, qr[p4].z, qr[p4].w}, kw_[4] = {qk[p4].x, qk[p4].y, qk[p4].z, qk[p4].w}, kkw[4] = {qkk[p4].x, qkk[p4].y, qkk[p4].z, qkk[p4].w}, bw_[4] = {qb[p4].x, qb[p4].y, qb[p4].z, qb[p4].w};
                          unsigned xa[4], xr[4], xb[4], xk[4]; const float inv = qin[p4];
#pragma unroll
                          for (int i = 0; i < 4; ++i) { const float ip0 = __builtin_amdgcn_rcpf(Pc[2 * i]), ip1 = __builtin_amdgcn_rcpf(Pc[2 * i + 1]);
                              xa[i] = pk2(-__uint_as_float(kkw[i] << 16) * inv * Pm[2 * i], -__uint_as_float(kkw[i] & 0xffff0000u) * inv * Pm[2 * i + 1]);
                              xr[i] = pk2(__uint_as_float(rw_[i] << 16) * Pc[2 * i], __uint_as_float(rw_[i] & 0xffff0000u) * Pc[2 * i + 1]);
                              xb[i] = pk2(__uint_as_float(bw_[i] << 16) * inv * ip0, __uint_as_float(bw_[i] & 0xffff0000u) * inv * ip1);
                              xk[i] = pk2(__uint_as_float(kw_[i] << 16) * ip0, __uint_as_float(kw_[i] & 0xffff0000u) * ip1); }
                          oa[p4] = (u32x4){xa[0], xa[1], xa[2], xa[3]}; orr[p4] = (u32x4){xr[0], xr[1], xr[2], xr[3]}; ob_[p4] = (u32x4){xb[0], xb[1], xb[2], xb[3]}; ok_[p4] = (u32x4){xk[0], xk[1], xk[2], xk[3]}; }
                      __builtin_amdgcn_wave_barrier(); asm volatile("s_waitcnt lgkmcnt(0)" ::: "memory");
#pragma unroll
                      for (int p4 = 0; p4 < 4; ++p4) { const int c = p4 * 8 + tk, o = c * 72 + part * 8;
                          *(__attribute__((address_space(3))) u32x4*)(At + o) = oa[p4]; *(__attribute__((address_space(3))) u32x4*)(Rt + o) = orr[p4]; *(__attribute__((address_space(3))) u32x4*)(Bt + o) = ob_[p4];
                          *(__attribute__((address_space(3))) u32x4*)(Kt + o) = ok_[p4]; *(__attribute__((address_space(3))) u32x4*)(Vv + o) = qv[p4]; } }
                    __builtin_amdgcn_wave_barrier(); asm volatile("s_waitcnt lgkmcnt(0)" ::: "memory");
                    const f32x16 zero16 = {0.f, 0.f, 0.f, 0.f, 0.f, 0.f, 0.f, 0.f, 0.f, 0.f, 0.f, 0.f, 0.f, 0.f, 0.f, 0.f};
                    f32x16 X = zero16, Yt = zero16;
#pragma unroll
                    for (int ks = 0; ks < 4; ++ks) { const bf16x8_t fa = ldrow(At, r32, ks, hh), fb = ldrow(Bt, r32, ks, hh); X = mm32(fa, fb, X); Yt = mm32(fb, fa, Yt); }
#pragma unroll
                    for (int e = 0; e < 16; ++e) { const int ri = rowidx(e, hh); X[e] = (r32 < ri) ? X[e] : 0.f; Yt[e] = (ri < r32) ? Yt[e] : 0.f; }
                    f32x16 TY = Yt;
#pragma unroll
                    for (int e = 0; e < 16; ++e) TY[e] += (rowidx(e, hh) == r32) ? 1.f : 0.f;
#pragma unroll 1
                    for (int it = 0; it < 4; ++it) {
                        const bf16x8_t x0 = accop<0>(X), x1 = accop<1>(X), y0 = accop<0>(Yt), y1 = accop<1>(Yt);
                        f32x16 Xn = mm32(y0, x0, zero16); Xn = mm32(y1, x1, Xn);
                        f32x16 Yn = mm32(x0, y0, zero16); Yn = mm32(x1, y1, Yn);
                        X = Xn; Yt = Yn;
                        const bf16x8_t p0 = accop<0>(X), p1 = accop<1>(X), t0_ = accop<0>(TY), t1_ = accop<1>(TY);
                        TY = mm32(p0, t0_, TY); TY = mm32(p1, t1_, TY);
                    }
                    const bf16x8_t ty0 = accop<0>(TY), ty1 = accop<1>(TY);
                    unsigned char* rec = SCN + (size_t)item * 24576;
                    const bf16x8_t v00 = ldpermcol<0>(Vv, r32, hh), v01 = ldpermcol<1>(Vv, r32, hh), v10 = ldpermcol<0>(Vv, 32 + r32, hh), v11 = ldpermcol<1>(Vv, 32 + r32, hh);
                    f32x16 U0a, U0b;
                    { f32x16 G2T = zero16;
#pragma unroll
                      for (int ks = 0; ks < 4; ++ks) G2T = mm32(ldrow(Kt, r32, ks, hh), ldrow(At, r32, ks, hh), G2T);
#pragma unroll
                      for (int e = 0; e < 16; ++e) G2T[e] = (rowidx(e, hh) < r32) ? G2T[e] : 0.f;
                      const bf16x8_t g0 = accop<0>(G2T), g1 = accop<1>(G2T);
                      f32x16 Za = mm32(g0, v00, zero16); Za = mm32(g1, v01, Za); f32x16 Zb = mm32(g0, v10, zero16); Zb = mm32(g1, v11, Zb);
                      U0a = mm32(ty0, accop<0>(Za), zero16); U0a = mm32(ty1, accop<1>(Za), U0a); U0b = mm32(ty0, accop<0>(Zb), zero16); U0b = mm32(ty1, accop<1>(Zb), U0b); }
                    const bf16x8_t ua0 = accop<0>(U0a), ua1 = accop<1>(U0a), ub0 = accop<0>(U0b), ub1 = accop<1>(U0b);
                    f32x16 G3T = zero16;
                    { f32x16 G4T = zero16;
#pragma unroll
                      for (int ks = 0; ks < 4; ++ks) { const bf16x8_t fr = ldrow(Rt, r32, ks, hh); G3T = mm32(ldrow(Bt, r32, ks, hh), fr, G3T); G4T = mm32(ldrow(Kt, r32, ks, hh), fr, G4T); }
#pragma unroll
                      for (int e = 0; e < 16; ++e) { const bool keep = rowidx(e, hh) <= r32; G3T[e] = keep ? G3T[e] : 0.f; G4T[e] = keep ? G4T[e] : 0.f; }
                      const bf16x8_t g30 = accop<0>(G3T), g31 = accop<1>(G3T), g40 = accop<0>(G4T), g41 = accop<1>(G4T);
                      f32x16 Ya = mm32(g30, ua0, zero16); Ya = mm32(g31, ua1, Ya); Ya = mm32(g40, v00, Ya); Ya = mm32(g41, v01, Ya);
                      f32x16 Yb = mm32(g30, ub0, zero16); Yb = mm32(g31, ub1, Yb); Yb = mm32(g40, v10, Yb); Yb = mm32(g41, v11, Yb);
                      u32x4 o0, o1;
                      o0.x = cvtpk(Ya[0], Ya[1]); o0.y = cvtpk(Ya[2], Ya[3]); o0.z = cvtpk(Ya[4], Ya[5]); o0.w = cvtpk(Ya[6], Ya[7]);
                      o1.x = cvtpk(Ya[8], Ya[9]); o1.y = cvtpk(Ya[10], Ya[11]); o1.z = cvtpk(Ya[12], Ya[13]); o1.w = cvtpk(Ya[14], Ya[15]);
                      *(u32x4*)(rec + 12288 + 4096 + lane * 32) = o0; *(u32x4*)(rec + 12288 + 4096 + lane * 32 + 16) = o1;
                      o0.x = cvtpk(Yb[0], Yb[1]); o0.y = cvtpk(Yb[2], Yb[3]); o0.z = cvtpk(Yb[4], Yb[5]); o0.w = cvtpk(Yb[6], Yb[7]);
                      o1.x = cvtpk(Yb[8], Yb[9]); o1.y = cvtpk(Yb[10], Yb[11]); o1.z = cvtpk(Yb[12], Yb[13]); o1.w = cvtpk(Yb[14], Yb[15]);
                      *(u32x4*)(rec + 12288 + 6144 + 4096 + lane * 32) = o0; *(u32x4*)(rec + 12288 + 6144 + 4096 + lane * 32 + 16) = o1; }
                    f32x16 Wa0 = mm32(ty0, ldpermcol<0>(At, r32, hh), zero16); Wa0 = mm32(ty1, ldpermcol<1>(At, r32, hh), Wa0);
                    f32x16 Wa1 = mm32(ty0, ldpermcol<0>(At, 32 + r32, hh), zero16); Wa1 = mm32(ty1, ldpermcol<1>(At, 32 + r32, hh), Wa1);
                    const bf16x8_t wa00 = accop<0>(Wa0), wa01 = accop<1>(Wa0), wa10 = accop<0>(Wa1), wa11 = accop<1>(Wa1);
                    { const bf16x8_t g30 = accop<0>(G3T), g31 = accop<1>(G3T);
                      f32x16 Ra = mm32(wa00, g30, zero16); Ra = mm32(wa01, g31, Ra); f32x16 Rb_ = mm32(wa10, g30, zero16); Rb_ = mm32(wa11, g31, Rb_);
#pragma unroll
                      for (int e = 0; e < 16; ++e) { const int kr = rowidx(e, hh); Ra[e] += bf2f(Rt[r32 * 72 + kr]); Rb_[e] += bf2f(Rt[r32 * 72 + 32 + kr]); }
                      *(bf16x8_t*)(rec + 8192 + 0 * 1024 + lane * 16) = accop<0>(Ra); *(bf16x8_t*)(rec + 8192 + 1 * 1024 + lane * 16) = accop<1>(Ra);
                      *(bf16x8_t*)(rec + 8192 + 2 * 1024 + lane * 16) = accop<0>(Rb_); *(bf16x8_t*)(rec + 8192 + 3 * 1024 + lane * 16) = accop<1>(Rb_); }
                    const bf16x8_t b00 = ldpermcol<0>(Bt, r32, hh), b01 = ldpermcol<1>(Bt, r32, hh), b10 = ldpermcol<0>(Bt, 32 + r32, hh), b11 = ldpermcol<1>(Bt, 32 + r32, hh);
                    { const float pc0 = PCs[r32], pc1 = PCs[32 + r32];
#pragma unroll
                      for (int ij = 0; ij < 4; ++ij) { const int i = ij >> 1, j = ij & 1;
                          f32x16 M = mm32(i ? wa10 : wa00, j ? b10 : b00, zero16); M = mm32(i ? wa11 : wa01, j ? b11 : b01, M);
#pragma unroll
                          for (int e = 0; e < 16; ++e) { float m = M[e]; if (i == j) m += (rowidx(e, hh) == r32) ? 1.f : 0.f; M[e] = m * (j ? pc1 : pc0); }
                          *(bf16x8_t*)(rec + (ij * 2 + 0) * 1024 + lane * 16) = accop<0>(M); *(bf16x8_t*)(rec + (ij * 2 + 1) * 1024 + lane * 16) = accop<1>(M); } }
                    { const bf16x8_t k00 = ldpermcol<0>(Kt, r32, hh), k01 = ldpermcol<1>(Kt, r32, hh), k10 = ldpermcol<0>(Kt, 32 + r32, hh), k11 = ldpermcol<1>(Kt, 32 + r32, hh);
#pragma unroll
                      for (int ju = 0; ju < 4; ++ju) { const int j = ju >> 1, u = ju & 1;
                          f32x16 Dm = mm32(j ? b10 : b00, u ? ub0 : ua0, zero16); Dm = mm32(j ? b11 : b01, u ? ub1 : ua1, Dm);
                          Dm = mm32(j ? k10 : k00, u ? v10 : v00, Dm); Dm = mm32(j ? k11 : k01, u ? v11 : v01, Dm);
#pragma unroll
                          for (int e = 0; e < 16; ++e) Dm[e] *= PCs[32 * j + rowidx(e, hh)];
                          u32x4 o0, o1;
                          o0.x = cvtpk(Dm[0], Dm[1]); o0.y = cvtpk(Dm[2], Dm[3]); o0.z = cvtpk(Dm[4], Dm[5]); o0.w = cvtpk(Dm[6], Dm[7]);
                          o1.x = cvtpk(Dm[8], Dm[9]); o1.y = cvtpk(Dm[10], Dm[11]); o1.z = cvtpk(Dm[12], Dm[13]); o1.w = cvtpk(Dm[14], Dm[15]);
                          *(u32x4*)(rec + 12288 + u * 6144 + j * 2048 + lane * 32) = o0; *(u32x4*)(rec + 12288 + u * 6144 + j * 2048 + lane * 32 + 16) = o1; } }
                }
            }
        }
        { XcdBarrier xb_ = xbar; asm volatile("" : "+s"(xb_.bar)); xcd_barrier<false>(xb_); }
        if (IN(pb + 3)) { PHASE_IDS
            const int r32 = lane & 31, hh = lane >> 5;
            constexpr int SLOT = 18432, NCH = SEQ / 32, NSL = 7, AHEAD = 6;
            if (G > BATCH * NH * 2) { if (bx >= BATCH * NH * 2) convert_tables_fp6(INP(27), INP(28), U8, V8, USc, VSc, l, (bx - BATCH * NH * 2) * NWAVES + wave, (G - BATCH * NH * 2) * NWAVES, lane); }
            else convert_tables_fp6(INP(27), INP(28), U8, V8, USc, VSc, l, bx * NWAVES + wave, G * NWAVES, lane);
            for (int un = bx; un < BATCH * NH * 2; un += G) {
                const int bh = un >> 1, u = un & 1, b = bh >> 3, h = bh & 7;
                __syncthreads();
                const unsigned char* recs = SCN + (size_t)bh * NCH * 24576;
                const int lw = wave - 2;
#define S2_DMA(chunk_) do { if (wave >= 2) { LAS unsigned char* sl = lds + ((chunk_) % NSL) * SLOT; const unsigned char* rp = recs + (size_t)(chunk_) * 24576 + lane * 16; \
                    _Pragma("unroll") for (int q_ = 0; q_ < 3; ++q_) { const int p_ = lw * 3 + q_; const int so_ = p_ < 12 ? p_ * 1024 : 12288 + u * 6144 + (p_ - 12) * 1024; \
                        __builtin_amdgcn_global_load_lds((const unsigned*)(rp + so_), (LAS unsigned*)(sl + p_ * 1024), 16, 0, 0); } } } while (0)
#pragma unroll 1
                for (int c0 = 0; c0 < AHEAD; ++c0) S2_DMA(c0);
                asm volatile("s_waitcnt vmcnt(15)" ::: "memory");
                __builtin_amdgcn_s_barrier();
                f32x16 X0, X1;
#pragma unroll
                for (int e = 0; e < 16; ++e) { X0[e] = 0.f; X1[e] = 0.f; }
#define S2_FRAG(off) (*(const __attribute__((address_space(3))) bf16x8_t*)(sl + (off) + lane * 16))
#define S2_UNPK(dst, off) do { const u32x4 a0 = *(const LAS u32x4*)(sl + (off) + lane * 32), a1 = *(const LAS u32x4*)(sl + (off) + lane * 32 + 16); const unsigned wv[8] = {a0.x, a0.y, a0.z, a0.w, a1.x, a1.y, a1.z, a1.w}; \
                    _Pragma("unroll") for (int q = 0; q < 8; ++q) { (dst)[2 * q] = __uint_as_float(wv[q] << 16); (dst)[2 * q + 1] = __uint_as_float(wv[q] & 0xffff0000u); } } while (0)
#pragma unroll 1
                for (int n = 0; n < NCH; ++n) {
                    if (n + AHEAD < NCH) S2_DMA(n + AHEAD);
                    if (wave == 0) {
                        const LAS unsigned char* sl = lds + (n % NSL) * SLOT;
                        const bf16x8_t x00 = accop<0>(X0), x01 = accop<1>(X0), x10 = accop<0>(X1), x11 = accop<1>(X1);
                        f32x16 Yc, N0, N1;
                        S2_UNPK(Yc, 12288 + 4096); S2_UNPK(N0, 12288); S2_UNPK(N1, 12288 + 2048);
                        Yc = mm32(S2_FRAG(8192 + 0 * 1024), x00, Yc); Yc = mm32(S2_FRAG(8192 + 1 * 1024), x01, Yc); Yc = mm32(S2_FRAG(8192 + 2 * 1024), x10, Yc); Yc = mm32(S2_FRAG(8192 + 3 * 1024), x11, Yc);
                        N0 = mm32(S2_FRAG((0 * 2 + 0) * 1024), x00, N0); N0 = mm32(S2_FRAG((0 * 2 + 1) * 1024), x01, N0); N0 = mm32(S2_FRAG((2 * 2 + 0) * 1024), x10, N0); N0 = mm32(S2_FRAG((2 * 2 + 1) * 1024), x11, N0);
                        N1 = mm32(S2_FRAG((1 * 2 + 0) * 1024), x00, N1); N1 = mm32(S2_FRAG((1 * 2 + 1) * 1024), x01, N1); N1 = mm32(S2_FRAG((3 * 2 + 0) * 1024), x10, N1); N1 = mm32(S2_FRAG((3 * 2 + 1) * 1024), x11, N1);
                        X0 = N0; X1 = N1;
                        float* yp = Y + ((size_t)b * SEQ + (size_t)n * 32) * RW + h * HS + u * 32 + r32;
#pragma unroll
                        for (int e = 0; e < 16; ++e) yp[(size_t)rowidx(e, hh) * RW] = Yc[e];
                        asm volatile("s_waitcnt lgkmcnt(0)" ::: "memory");
                    } else if (wave >= 2) {
                        const int younger = (NCH - 1 - (n + 1)) < (AHEAD - 1) ? (NCH - 1 - (n + 1)) : (AHEAD - 1);
                        if (younger >= 5) asm volatile("s_waitcnt vmcnt(15)" ::: "memory"); else if (younger == 4) asm volatile("s_waitcnt vmcnt(12)" ::: "memory"); else if (younger == 3) asm volatile("s_waitcnt vmcnt(9)" ::: "memory");
                        else if (younger == 2) asm volatile("s_waitcnt vmcnt(6)" ::: "memory"); else if (younger == 1) asm volatile("s_waitcnt vmcnt(3)" ::: "memory"); else asm volatile("s_waitcnt vmcnt(0)" ::: "memory");
                    }
                    __builtin_amdgcn_s_barrier();
                }
#undef S2_FRAG
#undef S2_UNPK
#undef S2_DMA
            }
        }
        SEAM(pb + 3);

        if (IN(pb + 4)) { PHASE_IDS
            const int c8 = (tid & 63) * 8, hd = (tid & 63) >> 3, tsub = tid >> 6;
            const f32x4 lg0 = *(const f32x4*)(INP(19) + l * RW + c8), lg1 = *(const f32x4*)(INP(19) + l * RW + c8 + 4), lb0 = *(const f32x4*)(INP(20) + l * RW + c8), lb1 = *(const f32x4*)(INP(20) + l * RW + c8 + 4);
            for (int tile = bx; tile < T / 8; tile += G) {
                const int t = tile * 8 + tsub; const size_t o = (size_t)t * RW + c8;
                const f32x4 y0 = *(const f32x4*)(Y + o), y1 = *(const f32x4*)(Y + o + 4); const u32x4 gq = *(const u32x4*)(Gb + o), vq = *(const u32x4*)(BGb + o); const float bsum = BSUM[(size_t)t * NH + hd];
                float sm = (y0.x + y0.y) + (y0.z + y0.w) + (y1.x + y1.y) + (y1.z + y1.w);
                sm += dppf<0xB1>(sm); sm += dppf<0x4E>(sm); sm += dppf<0x141>(sm);
                const float mean = sm * (1.f / 64.f);
                const f32x4 d0 = y0 - mean, d1 = y1 - mean;
                float sq = (d0.x * d0.x + d0.y * d0.y) + (d0.z * d0.z + d0.w * d0.w) + (d1.x * d1.x + d1.y * d1.y) + (d1.z * d1.z + d1.w * d1.w);
                sq += dppf<0xB1>(sq); sq += dppf<0x4E>(sq); sq += dppf<0x141>(sq);
                const float rs = rsqrtf(sq * (1.f / 64.f) + GN_EPS);
                const f32x4 n0 = d0 * rs * lg0 + lb0, n1 = d1 * rs * lg1 + lb1;
                const unsigned gw_[4] = {gq.x, gq.y, gq.z, gq.w}, vw_[4] = {vq.x, vq.y, vq.z, vq.w}; const float nn[8] = {n0.x, n0.y, n0.z, n0.w, n1.x, n1.y, n1.z, n1.w}; unsigned ow[4];
#pragma unroll
                for (int i = 0; i < 4; ++i) { const float g0 = __uint_as_float(gw_[i] << 16), g1 = __uint_as_float(gw_[i] & 0xffff0000u), v0 = __uint_as_float(vw_[i] << 16), v1 = __uint_as_float(vw_[i] & 0xffff0000u);
                    ow[i] = pk2(nn[2 * i] * g0 + v0 * bsum, nn[2 * i + 1] * g1 + v1 * bsum); }
                *(u32x4*)(MIX + (size_t)t * D + c8) = (u32x4){ow[0], ow[1], ow[2], ow[3]};
            }
        }
        SEAM(pb + 4);
        if (IN(pb + 5)) { PHASE_IDS
            pg8::Gemm g{MIX, WoutT + (size_t)l * D * D, T, D, D}; pg8::StaticOrder S; S.init(T, D, G, bx);
            pg8::EpiResGate E{xin, X, modl + 2 * D};
            pg8::gemm_phase<pg8::EpiResGate, pg8::StaticOrder, true, true>(lds, g, S, E, tid); }
        SEAM(pb + 5);
        if (IN(pb + 6)) { PHASE_IDS const float* gamma = INP(24) + l * D;
            for (int row = gw; row < T; row += NGW) { const int b = row / SEQ; norm_mod_row(X + (size_t)row * D, gamma, modl + (size_t)b * 6 * D + 3 * D, modl + (size_t)b * 6 * D + 4 * D, H + (size_t)row * D, lane); } }
        SEAM(pb + 6);
        if (IN(pb + 7)) { PHASE_IDS
            pg8::Gemm g{H, PqT + (size_t)l * PH * PQ * D, T, PH * PQ, D}; pg8::StaticOrder S; S.init(T, PH * PQ, G, bx);
            pg8::EpiBf16<0> E{Q, PH * PQ, nullptr, 0, 0, 1.f};
            pg8::gemm_phase<pg8::EpiBf16<0>, pg8::StaticOrder, true, true>(lds, g, S, E, tid); }
        SEAM(pb + 7);

        if (IN(pb + 8)) { PHASE_IDS
            const bf16* KEYSl = KEYS + (size_t)l * PH * 2 * NKEYS * PHALF;
            LAS unsigned char* scr = lds + wave * 2048 + lane * 32;
            constexpr int KST = 136;
            lbf16* kl = (lbf16*)(lds + 16384);
            const int r = lane & 31, hh = lane >> 5;
            for (int item = bx; item < (T / 256) * PH; item += G) {
                const int h = item & 7, tok = (item >> 3) * 256 + wave * 32 + r;
                __syncthreads();
                { u32x4 kq[8];
#pragma unroll
                  for (int q = 0; q < 8; ++q) { const int ch = tid + q * NTHR; kq[q] = *(const u32x4*)(KEYSl + (size_t)(h * 2) * NKEYS * PHALF + (size_t)ch * 8); }
#pragma unroll
                  for (int q = 0; q < 8; ++q) { const int ch = tid + q * NTHR, row = ch >> 4, cc = ch & 15; *(__attribute__((address_space(3))) u32x4*)(kl + row * KST + cc * 8) = kq[q]; } }
                __syncthreads();
                unsigned sp0[16], sp1[16];
#pragma unroll
                for (int e = 0; e < 16; ++e) { sp0[e] = 0u; sp1[e] = 0u; }
#pragma unroll 1
                for (int p = 0; p < 2; ++p) {
                    const bf16* qp = Q + (size_t)tok * (PH * PQ) + h * PQ + p * PHALF + 8 * hh;
                    const lbf16* kp_ = kl + (p * NKEYS + r) * KST + 8 * hh;
                    bf16x8_t bq[8];
#pragma unroll
                    for (int ks = 0; ks < 8; ++ks) bq[ks] = *(const bf16x8_t*)(qp + ks * 16);
                    unsigned best[16];
#pragma unroll
                    for (int e = 0; e < 16; ++e) best[e] = 0u;
#pragma unroll 1
                    for (int kt = 0; kt < 4; ++kt) {
                        f32x16 acc;
#pragma unroll
                        for (int e = 0; e < 16; ++e) acc[e] = 0.f;
#pragma unroll
                        for (int ks = 0; ks < 8; ++ks) { const bf16x8_t ak = *(const __attribute__((address_space(3))) bf16x8_t*)(kp_ + kt * 32 * KST + ks * 16); acc = __builtin_amdgcn_mfma_f32_32x32x16_bf16(ak, bq[ks], acc, 0, 0, 0); }
                        unsigned g[16];
#pragma unroll
                        for (int e = 0; e < 16; ++e) g[e] = pack_key7(acc[e], kt * 32 + (e & 3) + 8 * (e >> 2) + 4 * hh);
                        sort16_desc(g);
                        merge_top16(best, g);
                    }
                    unsigned ob[16];
#pragma unroll
                    for (int e = 0; e < 16; ++e) ob[e] = shflxu(best[e], lane, 32);
                    merge_top16(best, ob);
#pragma unroll
                    for (int e = 0; e < 16; ++e) { sp0[e] = p == 0 ? best[e] : sp0[e]; sp1[e] = p == 0 ? sp1[e] : best[e]; }
                }
                unsigned c2[32];
                stage2_cands(sp0, sp1, hh, c2);
                sort16_desc(c2); sort16_desc(c2 + 16); merge_top16(c2, c2 + 16);
                { unsigned ob[16];
#pragma unroll
                  for (int e = 0; e < 16; ++e) ob[e] = shflxu(c2[e], lane, 32);
                  merge_top16(c2, ob); }
#pragma unroll
                for (int e = 0; e < 16; e += 4) {
                    *(LAS unsigned*)(scr + e) = (127u - (sp0[e] & 127u)) | ((127u - (sp0[e + 1] & 127u)) << 8) | ((127u - (sp0[e + 2] & 127u)) << 16) | ((127u - (sp0[e + 3] & 127u)) << 24);
                    *(LAS unsigned*)(scr + 16 + e) = (127u - (sp1[e] & 127u)) | ((127u - (sp1[e + 1] & 127u)) << 8) | ((127u - (sp1[e + 2] & 127u)) << 16) | ((127u - (sp1[e + 3] & 127u)) << 24); }
                asm volatile("s_waitcnt lgkmcnt(0)" ::: "memory");
                float sm[16]; int ex[16];
#pragma unroll
                for (int e = 0; e < 16; ++e) { const unsigned key = c2[e]; sm[e] = unpack_key8(key); const int i0 = (key >> 4) & 15, j0 = key & 15; ex[e] = (int)scr[i0] * NKEYS + (int)scr[16 + j0]; }
                float den = 0.f;
#pragma unroll
                for (int e = 0; e < 16; ++e) { sm[e] = expf(sm[e] - unpack_key8(c2[0])); den += sm[e]; }
                const float inv = 1.f / den;
                if (hh == 0) {
                    int* ip = IDX + (size_t)tok * NE + h * TOPK; float* gp = GATE + (size_t)tok * NE + h * TOPK;
#pragma unroll
                    for (int e = 0; e < 16; e += 4) { *(int4*)(ip + e) = make_int4(ex[e], ex[e + 1], ex[e + 2], ex[e + 3]); *(f32x4*)(gp + e) = (f32x4){sm[e] * inv, sm[e + 1] * inv, sm[e + 2] * inv, sm[e + 3] * inv}; }
                }
                asm volatile("s_waitcnt lgkmcnt(0)" ::: "memory");
            }
        }
        SEAM(pb + 8);

        if (IN(pb + 9)) { PHASE_IDS
            const unsigned char* Ul = U8 + (size_t)l * NEXP * ROWB; const unsigned char* Vtl = V8 + (size_t)l * NEXP * ROWB; const float* usl = USc + l * NEXP; const float* vsl = VSc + l * NEXP; const float* lnf = INP(29);
            const bool fin = (l == DEPTH - 1);
            typedef float f32x2_t __attribute__((ext_vector_type(2)));
            const __amdgpu_buffer_rsrc_t ru = __builtin_amdgcn_make_buffer_rsrc((void*)Ul, 0, NEXP * ROWB, 0x00020000), rv = __builtin_amdgcn_make_buffer_rsrc((void*)Vtl, 0, NEXP * ROWB, 0x00020000);
            typedef float f32x32_t __attribute__((ext_vector_type(32))); typedef unsigned u32x3_t __attribute__((ext_vector_type(3))); typedef unsigned u32x6_t __attribute__((ext_vector_type(6)));
            LAS float* pl = (LAS float*)(lds + wave * 18432);
            constexpr int TW = 4;
            for (int tb = gw; tb < T; tb += TW * NGW) {
#define TOKV(k) (tb + (k) * NGW < T)
#define TOK(k) (TOKV(k) ? tb + (k) * NGW : tb)
                unsigned si[TW][2]; float sus[TW][2], sgv[TW][2]; u32x4 hp[TW][2];
                { float g0[TW], g1[TW]; int lane_s; asm volatile("v_mbcnt_lo_u32_b32 %0, -1, 0\n\tv_mbcnt_hi_u32_b32 %0, -1, %0" : "=v"(lane_s));
#pragma unroll
                  for (int k = 0; k < TW; ++k) { const size_t o = (size_t)TOK(k) * NE + lane_s; si[k][0] = ((unsigned)IDX[o] << 7) | (unsigned)lane_s; si[k][1] = ((unsigned)IDX[o + 64] << 7) | (unsigned)(64 + lane_s); g0[k] = GATE[o]; g1[k] = GATE[o + 64]; }
#pragma unroll
                  for (int kk = 2; kk <= 128; kk <<= 1) {
#pragma unroll
                      for (int j = kk >> 1; j > 0; j >>= 1) {
                          if (j == 64) {
#pragma unroll
                              for (int k = 0; k < TW; ++k) { const unsigned a = si[k][0], b = si[k][1]; si[k][0] = a < b ? a : b; si[k][1] = a < b ? b : a; } }
                          else { const bool lower = (lane_s & j) == 0, tm0 = lower == ((lane_s & kk) == 0), tm1 = lower == (((lane_s + 64) & kk) == 0); const int pa = (lane_s ^ j) << 2;
#pragma unroll
                              for (int k = 0; k < TW; ++k) { const unsigned a = si[k][0], b = si[k][1], p0 = (unsigned)__builtin_amdgcn_ds_bpermute(pa, (int)a), p1 = (unsigned)__builtin_amdgcn_ds_bpermute(pa, (int)b);
                                  si[k][0] = tm0 ? (a < p0 ? a : p0) : (a < p0 ? p0 : a); si[k][1] = tm1 ? (b < p1 ? b : p1) : (b < p1 ? p1 : b); } }
                          __builtin_amdgcn_sched_barrier(0);
                      } }
#pragma unroll
                  for (int k = 0; k < TW; ++k) {
#pragma unroll
                      for (int r = 0; r < 2; ++r) { const unsigned key = si[k][r]; const int a = (int)(key & 63u) << 2; const int ga = __builtin_amdgcn_ds_bpermute(a, __float_as_int(g0[k])), gb = __builtin_amdgcn_ds_bpermute(a, __float_as_int(g1[k]));
                          const unsigned ix = key >> 7; si[k][r] = ix; sus[k][r] = usl[ix]; sgv[k][r] = __int_as_float((key & 64u) ? gb : ga) * vsl[ix]; } }
#pragma unroll
                  for (int k = 0; k < TW; ++k) { const bf16* hr = H + (size_t)TOK(k) * D + lane_s * 16; hp[k][0] = *(const u32x4*)hr; hp[k][1] = *(const u32x4*)(hr + 8); }
                }
                __builtin_amdgcn_sched_barrier(0);
#define ROWLD(dst, rs, ixv, ln) dst = __builtin_amdgcn_raw_buffer_load_b96(rs, voff, __builtin_amdgcn_readlane((int)(ixv), (ln)) * ROWB, 0)
#define LOADQ(buf, rs, ixv, ln0) do { _Pragma("unroll") for (int j_ = 0; j_ < 4; ++j_) ROWLD((buf)[j_], rs, ixv, (ln0) + j_); __builtin_amdgcn_sched_barrier(0); } while (0)
#define CVT2(a, b) const f32x32_t f_ = __builtin_amdgcn_cvt_scalef32_pk32_f32_fp6((u32x6_t){(a).x, (a).y, (a).z, (b).x, (b).y, (b).z}, 1.0f)
#define PR(i) __builtin_shufflevector(f_, f_, 2 * (i), 2 * (i) + 1)
#define DOTQ(buf, e0) do { _Pragma("unroll") for (int j_ = 0; j_ < 4; j_ += 2) { CVT2((buf)[j_], (buf)[j_ + 1]); \
                        f32x2_t a_ = hf2[0] * PR(0), b_ = hf2[0] * PR(8); a_ += hf2[1] * PR(1); b_ += hf2[1] * PR(9); a_ += hf2[2] * PR(2); b_ += hf2[2] * PR(10); a_ += hf2[3] * PR(3); b_ += hf2[3] * PR(11); \
                        a_ += hf2[4] * PR(4); b_ += hf2[4] * PR(12); a_ += hf2[5] * PR(5); b_ += hf2[5] * PR(13); a_ += hf2[6] * PR(6); b_ += hf2[6] * PR(14); a_ += hf2[7] * PR(7); b_ += hf2[7] * PR(15); \
                        pl[((e0) + j_) * 68 + lane_u] = a_.x + a_.y; pl[((e0) + j_ + 1) * 68 + lane_u] = b_.x + b_.y; } __builtin_amdgcn_sched_barrier(0); } while (0)
#define AXPYQ(buf, k, cfv, ln0) do { _Pragma("unroll") for (int j_ = 0; j_ < 4; j_ += 2) { CVT2((buf)[j_], (buf)[j_ + 1]); \
                        const float ca = __int_as_float(__builtin_amdgcn_readlane(__float_as_int(cfv), (ln0) + j_)), cb = __int_as_float(__builtin_amdgcn_readlane(__float_as_int(cfv), (ln0) + j_ + 1)); \
                        acc2[k][0] += ca * PR(0); acc2[k][1] += ca * PR(1); acc2[k][2] += ca * PR(2); acc2[k][3] += ca * PR(3); acc2[k][4] += ca * PR(4); acc2[k][5] += ca * PR(5); acc2[k][6] += ca * PR(6); acc2[k][7] += ca * PR(7); \
                        acc2[k][0] += cb * PR(8); acc2[k][1] += cb * PR(9); acc2[k][2] += cb * PR(10); acc2[k][3] += cb * PR(11); acc2[k][4] += cb * PR(12); acc2[k][5] += cb * PR(13); acc2[k][6] += cb * PR(14); acc2[k][7] += cb * PR(15); } __builtin_amdgcn_sched_barrier(0); } while (0)
                u32x3_t ba[4], bb_[4];
                int lane_u; asm volatile("v_mbcnt_lo_u32_b32 %0, -1, 0\n\tv_mbcnt_hi_u32_b32 %0, -1, %0" : "=v"(lane_u)); const int voff = lane_u * 12;
                LOADQ(ba, ru, si[0][0], 0);
#pragma unroll 1
                for (int c = 0; c < 16; ++c) {
                    const int lb = (c & 7) * 8; const bool r1 = c >= 8;
#pragma unroll
                    for (int half = 0; half < TW / 4; ++half) {
#pragma unroll
                        for (int ts = 0; ts < 4; ++ts) { const int k = half * 4 + ts;
                            f32x2_t hf2[8];
                            { const u32x4 h0 = hp[k][0], h1 = hp[k][1];
                              hf2[0] = (f32x2_t){__uint_as_float(h0.x << 16), __uint_as_float(h0.x & 0xffff0000u)}; hf2[1] = (f32x2_t){__uint_as_float(h0.y << 16), __uint_as_float(h0.y & 0xffff0000u)};
                              hf2[2] = (f32x2_t){__uint_as_float(h0.z << 16), __uint_as_float(h0.z & 0xffff0000u)}; hf2[3] = (f32x2_t){__uint_as_float(h0.w << 16), __uint_as_float(h0.w & 0xffff0000u)};
                              hf2[4] = (f32x2_t){__uint_as_float(h1.x << 16), __uint_as_float(h1.x & 0xffff0000u)}; hf2[5] = (f32x2_t){__uint_as_float(h1.y << 16), __uint_as_float(h1.y & 0xffff0000u)};
                              hf2[6] = (f32x2_t){__uint_as_float(h1.z << 16), __uint_as_float(h1.z & 0xffff0000u)}; hf2[7] = (f32x2_t){__uint_as_float(h1.w << 16), __uint_as_float(h1.w & 0xffff0000u)}; }
                            const unsigned ixk = r1 ? si[k][1] : si[k][0];
                            LOADQ(bb_, ru, ixk, lb + 4); DOTQ(ba, ts * 8);
                            if (k < TW - 1) { const unsigned ixn = r1 ? si[k + 1][1] : si[k + 1][0]; LOADQ(ba, ru, ixn, lb); }
                            else if (c < 15) { const unsigned ixn = (c + 1 >= 8) ? si[0][1] : si[0][0]; LOADQ(ba, ru, ixn, ((c + 1) & 7) * 8); }
                            else LOADQ(ba, rv, si[0][0], 0);
                            DOTQ(bb_, ts * 8 + 4);
                        }
                        __builtin_amdgcn_wave_barrier(); asm volatile("s_waitcnt lgkmcnt(0)" ::: "memory");
                        float dsum;
                        { const LAS float* rp = pl + (lane_u & 31) * 68 + (lane_u >> 5) * 32; f32x4 s4 = *(const LAS f32x4*)rp;
#pragma unroll
                          for (int j = 1; j < 8; ++j) s4 += *(const LAS f32x4*)(rp + j * 4);
                          dsum = (s4.x + s4.y) + (s4.z + s4.w); }
                        dsum += shflx(dsum, lane_u, 32);
                        __builtin_amdgcn_wave_barrier(); asm volatile("s_waitcnt lgkmcnt(0)" ::: "memory");
                        const bool home = (lane_u >> 3) == (c & 7);
#pragma unroll
                        for (int ts = 0; ts < 4; ++ts) { const int k = half * 4 + ts;
                            const float dv = __int_as_float(__builtin_amdgcn_ds_bpermute((ts * 8 + (lane_u & 7)) << 2, __float_as_int(dsum)));
                            const float cf = (r1 ? sgv[k][1] : sgv[k][0]) * gelu_erf(dv * (r1 ? sus[k][1] : sus[k][0]));
                            if (r1) sgv[k][1] = home ? cf : sgv[k][1]; else sgv[k][0] = home ? cf : sgv[k][0]; }
                        __builtin_amdgcn_sched_barrier(0);
                    }
                }
                f32x2_t acc2[TW][8];
#pragma unroll
                for (int k = 0; k < TW; ++k) {
#pragma unroll
                    for (int i = 0; i < 8; ++i) acc2[k][i] = (f32x2_t){0.f, 0.f}; }
#pragma unroll 1
                for (int c = 0; c < 16; ++c) {
                    const int lb = (c & 7) * 8; const bool r1 = c >= 8;
#pragma unroll
                    for (int k = 0; k < TW; ++k) {
                        const unsigned ixk = r1 ? si[k][1] : si[k][0]; const float cfk = r1 ? sgv[k][1] : sgv[k][0];
                        LOADQ(bb_, rv, ixk, lb + 4); AXPYQ(ba, k, cfk, lb);
                        if (k < TW - 1) { const unsigned ixn = r1 ? si[k + 1][1] : si[k + 1][0]; LOADQ(ba, rv, ixn, lb); }
                        else if (c < 15) { const unsigned ixn = (c + 1 >= 8) ? si[0][1] : si[0][0]; LOADQ(ba, rv, ixn, ((c + 1) & 7) * 8); }
                        AXPYQ(bb_, k, cfk, lb + 4);
                    }
                }
#undef ROWLD
#undef LOADQ
#undef CVT2
#undef PR
#undef DOTQ
#undef AXPYQ
                { int ln; asm volatile("v_mbcnt_lo_u32_b32 %0, -1, 0\n\tv_mbcnt_hi_u32_b32 %0, -1, %0" : "=v"(ln));
                  LAS f32x4* al = (LAS f32x4*)pl + ln;
#pragma unroll
                  for (int k = 0; k < TW; ++k) {
#pragma unroll
                      for (int q = 0; q < 4; ++q) al[(k * 4 + q) * 64] = (f32x4){acc2[k][q * 2].x, acc2[k][q * 2].y, acc2[k][q * 2 + 1].x, acc2[k][q * 2 + 1].y}; }
                  asm volatile("s_waitcnt lgkmcnt(0)" ::: "memory"); __builtin_amdgcn_sched_barrier(0);
#pragma unroll 1
                  for (int k = 0; k < TW; ++k) { const int t = tb + k * NGW; if (t >= T) break; const int b = t / SEQ;
                    float* xr = X + (size_t)t * D + ln * 16; const float* g2 = modl + (size_t)b * 6 * D + 5 * D + ln * 16;
                    f32x4 xv[4]; float ss = 0.f;
#pragma unroll
                    for (int q = 0; q < 4; ++q) { const f32x4 xo = *(const f32x4*)(xr + q * 4), gg = *(const f32x4*)(g2 + q * 4);
                        xv[q] = xo + gg * al[(k * 4 + q) * 64]; ss += (xv[q].x * xv[q].x + xv[q].y * xv[q].y) + (xv[q].z * xv[q].z + xv[q].w * xv[q].w); }
                    const float rs = rsqrtf(wave_sum(ss, ln) * (1.f / D) + NORM_EPS);
                    if (fin) {
#pragma unroll
                        for (int q = 0; q < 4; ++q) *(f32x4*)(xr + q * 4) = xv[q] * rs * *(const f32x4*)(lnf + ln * 16 + q * 4); }
                    else {
                        const float* gam = INP(4) + (l + 1) * D + ln * 16; const float* mn = MOD + (size_t)(l + 1) * BATCH * 6 * D + (size_t)b * 6 * D + ln * 16; u32x4 ho[2];
#pragma unroll
                        for (int q = 0; q < 4; ++q) { *(f32x4*)(xr + q * 4) = xv[q];
                            const f32x4 y = xv[q] * rs * *(const f32x4*)(gam + q * 4) * (*(const f32x4*)(mn + D + q * 4) + 1.f) + *(const f32x4*)(mn + q * 4);
                            if (q & 1) { ho[q >> 1].z = pk2(y.x, y.y); ho[q >> 1].w = pk2(y.z, y.w); } else { ho[q >> 1].x = pk2(y.x, y.y); ho[q >> 1].y = pk2(y.z, y.w); } }
                        *(u32x4*)(H + (size_t)t * D + ln * 16) = ho[0]; *(u32x4*)(H + (size_t)t * D + ln * 16 + 8) = ho[1]; }
                  }
                  asm volatile("s_waitcnt lgkmcnt(0)" ::: "memory"); __builtin_amdgcn_wave_barrier();
                }
#undef TOK
#undef TOKV
            }
        }
    }
#undef modl
#undef xin
#undef IN
#undef SEAM
}
#undef MOD
#undef H
#undef PROJ
#undef Q
#undef MIX
#undef Rb
#undef Kb
#undef V0
#undef V1
#undef KKb
#undef Bb
#undef Gb
#undef BGb
#undef Wd
#undef Y
#undef IDX
#undef GATE
#undef WinT
#undef WoutT
#undef PqT
#undef KEYS
#undef QB
#undef SH
#undef WUPT
#undef AUPT
#undef GUPT
#undef VUPT
#undef PWT
#undef INVN
#undef BSUM
#undef SCN
#undef U8
#undef V8
#undef USc
#undef VSc
#undef INP
#undef PHASE_IDS

extern "C" void kernel_launch(void* const* d_in, const int* in_sizes, int n_in, void* d_out, int out_size, void* d_ws, size_t ws_size, hipStream_t stream) {
    if (n_in != 30 || ws_size < WS_END) { fprintf(stderr, "kernel_launch: unexpected n_in %d / ws_size %zu\n", n_in, ws_size); return; }
    static int grid = 0;
    if (grid == 0) {
        int dev = 0, cus = 0, per_cu = 0;
        (void)hipGetDevice(&dev); (void)hipDeviceGetAttribute(&cus, hipDeviceAttributeMultiprocessorCount, dev);
        if (hipFuncSetAttribute((const void*)mega, hipFuncAttributeMaxDynamicSharedMemorySize, LDS_BYTES) != hipSuccess) { fprintf(stderr, "hipFuncSetAttribute failed\n"); grid = -1; return; }
        if (hipOccupancyMaxActiveBlocksPerMultiprocessor(&per_cu, (const void*)mega, NTHR, LDS_BYTES) != hipSuccess || per_cu < 1) { fprintf(stderr, "occupancy query failed (%d)\n", per_cu); per_cu = 1; }
        (void)hipGetLastError();
        grid = (cus > 0 ? cus : 256) * 1;
    }
    if (grid < 0) return;
    Args a{}; for (int i = 0; i < 30; ++i) a.in[i] = (const float*)d_in[i]; a.out = (float*)d_out; a.ws = (unsigned char*)d_ws;
    a.ph_lo = 0; a.ph_hi = NPH;
    if (hipMemsetAsync(d_ws, 0, 65536, stream) != hipSuccess) { fprintf(stderr, "memset failed\n"); return; }
    void* kargs[] = {&a};
    hipError_t e = hipLaunchCooperativeKernel((const void*)mega, dim3(grid), dim3(NTHR), kargs, LDS_BYTES, stream);
    if (e != hipSuccess) fprintf(stderr, "cooperative launch failed: %s (grid %d)\n", hipGetErrorString(e), grid);
}
```

```cpp
#include <hip/hip_runtime.h>
#include <hip/hip_cooperative_groups.h>
namespace cg = cooperative_groups;
#include <cstdio>
#include <cstdint>
#include <cmath>

constexpr int D = 1024, BATCH = 4, SEQ = 4096, T = BATCH * SEQ, DEPTH = 2;
constexpr int RW = 512, HS = 64, NH = 8;
constexpr int DL = 64, AL = 64, MVL = 32, GL = 128;
constexpr int RWKV_COLS = 3 * RW + DL + AL + GL;
constexpr int PW = 512, PG = 128;
constexpr int IN_COLS = RWKV_COLS + PW;
constexpr int LDP = 2560;
constexpr int NKEYS = 128, NEXP = NKEYS * NKEYS, PH = 8, PQ = 256, PHALF = 128, TOPK = 16;
constexpr int NE = PH * TOPK;
constexpr float NORM_EPS = 1e-6f, GN_EPS = 64e-5f;

typedef unsigned short bf16;
__device__ __forceinline__ float bf2f(bf16 u) { return __uint_as_float((unsigned)u << 16); }
typedef float cvt_f32x2 __attribute__((ext_vector_type(2))); typedef __bf16 cvt_bf16x2 __attribute__((ext_vector_type(2)));
__device__ __forceinline__ unsigned cvtpk(float lo, float hi) { const cvt_f32x2 v = {lo, hi}; const cvt_bf16x2 b = __builtin_convertvector(v, cvt_bf16x2); return __builtin_bit_cast(unsigned, b); }
__device__ __forceinline__ bf16 f2bf(float f) { return (bf16)cvtpk(f, 0.f); }

constexpr size_t MiB = 1u << 20;
constexpr size_t WS_MOD = 1 * MiB;
constexpr size_t WS_US = 1 * MiB + 256 * 1024;
constexpr size_t WS_VS = 1 * MiB + 512 * 1024;
constexpr size_t WS_H = 2 * MiB;
constexpr size_t WS_PROJ = 34 * MiB;
constexpr size_t WS_Q = WS_PROJ;
constexpr size_t WS_R = 114 * MiB;
constexpr size_t WS_K = 130 * MiB;
constexpr size_t WS_V0 = 146 * MiB;
constexpr size_t WS_V1 = 162 * MiB;
constexpr size_t WS_KK = 178 * MiB;
constexpr size_t WS_B = 194 * MiB;
constexpr size_t WS_G = 210 * MiB;
constexpr size_t WS_BG = 226 * MiB;
constexpr size_t WS_W = 242 * MiB;
constexpr size_t WS_Y = 274 * MiB;
constexpr size_t WS_MIX = 306 * MiB;
constexpr size_t WS_IDX = 338 * MiB;
constexpr size_t WS_GATE = 346 * MiB;
constexpr size_t WS_WIN_T = 354 * MiB;
constexpr size_t WS_WOUT_T = 364 * MiB;
constexpr size_t WS_PQ_T = 368 * MiB;
constexpr size_t WS_KEYS = 376 * MiB;
constexpr size_t WS_U = 378 * MiB;
constexpr size_t WS_V = 442 * MiB;
constexpr size_t WS_QB = 410 * MiB;
constexpr size_t WS_SH = 426 * MiB;
constexpr size_t WS_LORA = 428 * MiB;
constexpr size_t WS_INVN = 430 * MiB;
constexpr size_t WS_BSUM = 431 * MiB;
constexpr size_t WS_SCN = 2 * MiB;
constexpr size_t WS_END = 506 * MiB;

template <int CTRL> __device__ __forceinline__ float dppf(float x) { return __int_as_float(__builtin_amdgcn_update_dpp(0, __float_as_int(x), CTRL, 0xF, 0xF, false)); }
__device__ __forceinline__ float red16(float x) { x += dppf<0xB1>(x); x += dppf<0x4E>(x); x += dppf<0x141>(x); x += dppf<0x140>(x); return x; }
__device__ __forceinline__ float shflx(float v, int lane, int off) { return __int_as_float(__builtin_amdgcn_ds_bpermute((lane ^ off) << 2, __float_as_int(v))); }
__device__ __forceinline__ unsigned shflxu(unsigned v, int lane, int off) { return (unsigned)__builtin_amdgcn_ds_bpermute((lane ^ off) << 2, (int)v); }
__device__ __forceinline__ void sort128(unsigned& k0, unsigned& k1, int lane) {
#pragma unroll
    for (int k = 2; k <= 128; k <<= 1) {
#pragma unroll
        for (int j = k >> 1; j > 0; j >>= 1) {
            if (j == 64) { const unsigned lo = k0 < k1 ? k0 : k1, hi = k0 < k1 ? k1 : k0; k0 = lo; k1 = hi; }
            else {
                const unsigned p0 = shflxu(k0, lane, j), p1 = shflxu(k1, lane, j);
                const bool lower = (lane & j) == 0, up0 = (lane & k) == 0, up1 = ((lane + 64) & k) == 0;
                const unsigned mn0 = k0 < p0 ? k0 : p0, mx0 = k0 < p0 ? p0 : k0, mn1 = k1 < p1 ? k1 : p1, mx1 = k1 < p1 ? p1 : k1;
                k0 = (lower == up0) ? mn0 : mx0; k1 = (lower == up1) ? mn1 : mx1;
            }
        }
    }
}
__device__ __forceinline__ float wave_sum(float v, int lane) { v = red16(v); v += shflx(v, lane, 16); v += shflx(v, lane, 32); return v; }
__device__ __forceinline__ float sigmoidf_(float x) { return 1.f / (1.f + expf(-x)); }

namespace pg8 {
#define PG8_LAS __attribute__((address_space(3)))
typedef unsigned short bf16_t;
typedef short bf16x8 __attribute__((ext_vector_type(8)));
typedef float f32x4 __attribute__((ext_vector_type(4)));
typedef unsigned u32x4 __attribute__((ext_vector_type(4)));
constexpr int BM = 256, BK = 64, HALF = 128, HTB = HALF * BK * 2  , STAGE_BYTES = 8 * HTB, NXCD = 8, WGM = 8;

__host__ __device__ __forceinline__ int lds_byte(int r, int c) { const int st = (r >> 4) * 2 + (c >> 5), rr = r & 15, cc = c & 31, ob = rr * 64 + cc * 2; return st * 1024 + (ob ^ (((ob >> 9) & 1) << 5)); }
__host__ __device__ __forceinline__ void stage_rc(int b, int& R, int& C) { const int st = b / 1024, sb = b % 1024, swz = sb ^ (((sb >> 9) & 1) << 5); R = (st >> 1) * 16 + swz / 64; C = (st & 1) * 32 + (swz % 64) / 2; }
__host__ __device__ __forceinline__ int perm32(int rho) { const int n = rho >> 4, i = rho & 15; return 8 * (i >> 2) + 4 * n + (i & 3); }

struct Unit { int pm, pn; };
struct Gemm { const bf16_t* A; const bf16_t* Bt; int M, N, K; };

struct StaticOrder {
    int nM, nN, nwg, G, c;
    __host__ __device__ void init(int M, int N, int G_, int c_) { nM = M / BM; nN = N / BM; nwg = nM * nN; G = G_; c = c_; }
    __host__ __device__ bool next(int i, Unit& u) const {
        const long L = (long)i * G + c; if (L >= nwg) return false;
        int wgid = (int)L; { const int q = nwg / NXCD, r = nwg % NXCD, xcd = wgid % NXCD, off = wgid / NXCD; wgid = (xcd < r ? xcd * (q + 1) : r * (q + 1) + (xcd - r) * q) + off; }
        const int nig = WGM * nN, gid = wgid / nig, fm = gid * WGM, gsz = (nM - fm) < WGM ? (nM - fm) : WGM;
        u.pm = fm + ((wgid % nig) % gsz); u.pn = (wgid % nig) / gsz; return true;
    }
    __device__ __forceinline__ void a_ready(const Unit&) const {}
    __device__ __forceinline__ void done(const Unit&) const {}
};

__device__ __forceinline__ unsigned cvt_pk_bf16(float lo, float hi) { unsigned r; asm volatile("v_cvt_pk_bf16_f32 %0, %1, %2" : "=v"(r) : "v"(lo), "v"(hi)); return r; }
typedef float f32x2 __attribute__((ext_vector_type(2)));
__device__ __forceinline__ f32x2 gelu_pk(f32x2 v) {
    const f32x2 av = __builtin_elementwise_abs(v), d = av * 0.2316418882f + 1.0f;
    f32x2 t; t.x = __builtin_amdgcn_rcpf(d.x); t.y = __builtin_amdgcn_rcpf(d.y);
    f32x2 q = t * 0.5307027145f + (-0.7265760135f); q = q * t + 0.7107068705f; q = q * t + (-0.142248368f); q = q * t + 0.127414796f; q = q * t;
    const f32x2 s = (v * v) * (-0.72134752044f);
    f32x2 e; e.x = __builtin_amdgcn_exp2f(s.x); e.y = __builtin_amdgcn_exp2f(s.y);
    const f32x2 m = v * (q * e), r = v - m;
    f32x2 o; o.x = v.x < 0.f ? m.x : r.x; o.y = v.y < 0.f ? m.y : r.y; return o;
}

template <int ACT  > struct EpiBf16 {
    static constexpr bool PERM = true, AFTER_DRAIN = false; static_assert(ACT == 0 || ACT == 1, "EpiBf16: ACT is 0 (none) or 1 (gelu_pk)");
    bf16_t* O; int ldc; const float* bias; int split_cols; size_t split_stride; float scale0;
    __device__ __forceinline__ void operator()(const f32x4 (&acc)[2][2][4][2], const Unit& u, int wr, int wc, int fr, int fq) const {
        const int row0 = u.pm * BM + wr * 64 + fr; int colt = u.pn * BM; bf16_t* base = O;
        float sc = 1.f; if (split_cols) { const int t = colt / split_cols; base += (size_t)t * split_stride; colt -= t * split_cols; if (t == 0) sc = scale0; }
        const int col0 = colt + wc * 32 + 8 * fq, bcol0 = u.pn * BM + wc * 32 + 8 * fq;
        f32x4 bv[2][2];
#pragma unroll
        for (int bj = 0; bj < 2; ++bj)
#pragma unroll
            for (int n = 0; n < 2; ++n) bv[bj][n] = bias ? *(const f32x4*)(bias + bcol0 + bj * HALF + 4 * n) : (f32x4){0.f, 0.f, 0.f, 0.f};
#pragma unroll
        for (int ai = 0; ai < 2; ++ai)
#pragma unroll
            for (int m = 0; m < 4; ++m) { bf16_t* rowp = base + (size_t)(row0 + ai * HALF + m * 16) * ldc + col0;
#pragma unroll
                for (int bj = 0; bj < 2; ++bj) { f32x4 v0 = acc[ai][bj][m][0] + bv[bj][0], v1 = acc[ai][bj][m][1] + bv[bj][1];
                    if (ACT == 1) { f32x2 a = gelu_pk((f32x2){v0[0], v0[1]}), b = gelu_pk((f32x2){v0[2], v0[3]}), c = gelu_pk((f32x2){v1[0], v1[1]}), d = gelu_pk((f32x2){v1[2], v1[3]});
                        v0 = (f32x4){a.x, a.y, b.x, b.y}; v1 = (f32x4){c.x, c.y, d.x, d.y}; }
                    v0 = v0 * sc; v1 = v1 * sc; u32x4 w; w.x = cvt_pk_bf16(v0[0], v0[1]); w.y = cvt_pk_bf16(v0[2], v0[3]); w.z = cvt_pk_bf16(v1[0], v1[1]); w.w = cvt_pk_bf16(v1[2], v1[3]);
                    *(u32x4*)(rowp + bj * HALF) = w; } }
    }
};

struct EpiResGate {
    static constexpr bool PERM = false, AFTER_DRAIN = false;
    const float* xold; float* X; const float* gate;
    __device__ __forceinline__ void operator()(const f32x4 (&acc)[2][2][4][2], const Unit& u, int wr, int wc, int fr, int fq) const {
        const int col0 = u.pn * BM + wc * 32 + 4 * fq; const int b = (u.pm * BM) / SEQ;
        const float* gp = gate + (size_t)b * 6 * D + col0;
#pragma unroll
        for (int bj = 0; bj < 2; ++bj)
#pragma unroll
            for (int n = 0; n < 2; ++n) { const f32x4 gv = *(const f32x4*)(gp + bj * HALF + n * 16);
#pragma unroll
                for (int ai = 0; ai < 2; ++ai)
#pragma unroll
                    for (int m = 0; m < 4; ++m) { const size_t off = (size_t)(u.pm * BM + ai * HALF + wr * 64 + m * 16 + fr) * D + col0 + bj * HALF + n * 16;
                        const f32x4 xo = *(const f32x4*)(xold + off); *(f32x4*)(X + off) = xo + gv * acc[ai][bj][m][n]; } }
    }
};
template <class Epi, class Sched, bool ALIGN_EPI = false, bool SP2 = false>
__device__ __forceinline__ void gemm_phase(PG8_LAS unsigned char* lds, const Gemm g, const Sched& S, const Epi& E, int tid) {
    asm volatile("" : "+v"(tid));
    const int wid = __builtin_amdgcn_readfirstlane(tid >> 6), lane = tid & 63, wr = wid >> 2, wc = wid & 3, fr = lane & 15, fq = lane >> 4;
    const int K = g.K, nt = K / BK;
    unsigned voffA[2], voffB[2];
#pragma unroll
    for (int i = 0; i < 2; ++i) { int R, C; stage_rc(tid * 16 + i * 8192, R, C); const int Rb = Epi::PERM ? ((R & ~31) + perm32(R & 31)) : R;
        voffA[i] = (unsigned)(R * K + C) * 2u; voffB[i] = (unsigned)(Rb * K + C) * 2u; }
    const size_t kstep = (size_t)(BK * 2);
    const size_t hstep = (size_t)HALF * K * 2;
    const size_t tstep = 2 * hstep;
    const unsigned ldsw = (unsigned)wid * 1024u;
    const int aoff = lds_byte(wr * 64 + fr, fq * 8), boff = lds_byte(wc * 32 + fr, fq * 8);
#define PG8_SA(b, h) (((b) * 2 + (h)) * HTB)
#define PG8_SB(b, h) ((4 + (b) * 2 + (h)) * HTB)
#define PG8_STAGE(bufoff, gbase, voff) do { _Pragma("unroll") for (int _i = 0; _i < 2; ++_i) \
        __builtin_amdgcn_global_load_lds((const unsigned*)((const char*)(gbase) + (voff)[_i]), (PG8_LAS unsigned*)(lds + (bufoff) + ldsw + _i * 8192), 16, 0, 0); } while (0)
#define PG8_LDA(dst, b, h) do { _Pragma("unroll") for (int m = 0; m < 4; ++m) _Pragma("unroll") for (int k = 0; k < 2; ++k) dst[m][k] = *(const PG8_LAS bf16x8*)(lds + PG8_SA(b, h) + aoff + m * 2048 + k * 1024); } while (0)
#define PG8_LDB(dst, b, h) do { _Pragma("unroll") for (int n = 0; n < 2; ++n) _Pragma("unroll") for (int k = 0; k < 2; ++k) dst[n][k] = *(const PG8_LAS bf16x8*)(lds + PG8_SB(b, h) + boff + n * 2048 + k * 1024); } while (0)
#define PG8_MMA(ai, bj, At, Bt) do { __builtin_amdgcn_s_setprio(1); _Pragma("unroll") for (int m = 0; m < 4; ++m) _Pragma("unroll") for (int n = 0; n < 2; ++n) _Pragma("unroll") for (int k = 0; k < 2; ++k) \
        acc[ai][bj][m][n] = __builtin_amdgcn_mfma_f32_16x16x32_bf16(Bt[n][k], At[m][k], acc[ai][bj][m][n], 0, 0, 0); __builtin_amdgcn_s_setprio(0); } while (0)
#define PG8_WAIT_V(n) asm volatile("s_waitcnt vmcnt(" #n ")" ::: "memory")
#define PG8_WAIT_L(n) asm volatile("s_waitcnt lgkmcnt(" #n ")" ::: "memory")
#define PG8_BAR __builtin_amdgcn_s_barrier()
#define PG8_SCHED __builtin_amdgcn_sched_barrier(0)
    Unit cur, nxt; int ui = 0;
    if (!S.next(0, cur)) return;
    f32x4 acc[2][2][4][2];
#pragma unroll
    for (int a = 0; a < 2; ++a)
#pragma unroll
        for (int b = 0; b < 2; ++b)
#pragma unroll
            for (int m = 0; m < 4; ++m)
#pragma unroll
                for (int n = 0; n < 2; ++n) acc[a][b][m][n] = (f32x4){0.f, 0.f, 0.f, 0.f};
    bf16x8 At[4][2], B0[2][2], B1[2][2];
    const char* cA = (const char*)g.A + (size_t)cur.pm * tstep; const char* cB = (const char*)g.Bt + (size_t)cur.pn * tstep;
    S.a_ready(cur);
    if constexpr (SP2) {
        PG8_STAGE(PG8_SB(0, 0), cB, voffB); PG8_STAGE(PG8_SB(0, 1), cB + hstep, voffB); PG8_STAGE(PG8_SA(0, 0), cA, voffA); PG8_STAGE(PG8_SA(0, 1), cA + hstep, voffA);
        if (wr == 1) PG8_BAR;
        PG8_WAIT_V(2); PG8_BAR;
        PG8_STAGE(PG8_SB(1, 0), cB + kstep, voffB); PG8_STAGE(PG8_SA(1, 0), cA + kstep, voffA); PG8_STAGE(PG8_SB(1, 1), cB + hstep + kstep, voffB);
        PG8_WAIT_V(6); PG8_BAR;
    } else {
        PG8_STAGE(PG8_SB(0, 0), cB, voffB); PG8_STAGE(PG8_SA(0, 0), cA, voffA); PG8_STAGE(PG8_SB(0, 1), cB + hstep, voffB); PG8_STAGE(PG8_SA(0, 1), cA + hstep, voffA);
        if (wr == 1) PG8_BAR;
        PG8_WAIT_V(4); PG8_BAR;
        PG8_STAGE(PG8_SB(1, 0), cB + kstep, voffB); PG8_STAGE(PG8_SA(1, 0), cA + kstep, voffA); PG8_STAGE(PG8_SB(1, 1), cB + hstep + kstep, voffB);
        PG8_WAIT_V(6); PG8_BAR;
    }
    for (;;) {
        const bool has_next = S.next(ui + 1, nxt);
        const char* nA = has_next ? (const char*)g.A + (size_t)nxt.pm * tstep : cA; const char* nB = has_next ? (const char*)g.Bt + (size_t)nxt.pn * tstep : cB;
        for (int t = 0; t < nt; t += 2) {
            const bool last = (t == nt - 2);
            const char* a1 = cA + (size_t)(t + 1) * kstep;
            const char* a2 = last ? nA : cA + (size_t)(t + 2) * kstep; const char* b2 = last ? nB : cB + (size_t)(t + 2) * kstep;
            const char* a3 = a2 + kstep; const char* b3 = b2 + kstep;
            if (last && has_next) S.a_ready(nxt);
            if constexpr (SP2) {
            PG8_LDB(B0, 0, 0); PG8_LDB(B1, 0, 1); PG8_SCHED; PG8_LDA(At, 0, 0); PG8_STAGE(PG8_SA(1, 1), a1 + hstep, voffA);
            PG8_WAIT_V(8); PG8_WAIT_L(0); PG8_BAR; PG8_MMA(0, 0, At, B0); PG8_MMA(0, 1, At, B1); PG8_BAR; PG8_SCHED;
            PG8_LDA(At, 0, 1); PG8_STAGE(PG8_SB(0, 0), b2, voffB); PG8_STAGE(PG8_SB(0, 1), b2 + hstep, voffB); PG8_STAGE(PG8_SA(0, 0), a2, voffA);
            PG8_WAIT_V(8); PG8_WAIT_L(0); PG8_BAR; PG8_MMA(1, 0, At, B0); PG8_MMA(1, 1, At, B1); PG8_BAR; PG8_SCHED;
            PG8_LDB(B0, 1, 0); PG8_LDB(B1, 1, 1); PG8_SCHED; PG8_LDA(At, 1, 0); PG8_STAGE(PG8_SA(0, 1), a2 + hstep, voffA);
            PG8_WAIT_V(8); PG8_WAIT_L(0); PG8_BAR; PG8_MMA(0, 0, At, B0); PG8_MMA(0, 1, At, B1); PG8_BAR; PG8_SCHED;
            PG8_LDA(At, 1, 1); PG8_STAGE(PG8_SB(1, 0), b3, voffB); PG8_STAGE(PG8_SB(1, 1), b3 + hstep, voffB); PG8_STAGE(PG8_SA(1, 0), a3, voffA);
            PG8_WAIT_V(8); PG8_WAIT_L(0); PG8_BAR; PG8_MMA(1, 0, At, B0); PG8_MMA(1, 1, At, B1); PG8_BAR; PG8_SCHED;
            } else {
            PG8_LDB(B0, 0, 0); PG8_SCHED; PG8_LDA(At, 0, 0); PG8_STAGE(PG8_SA(1, 1), a1 + hstep, voffA);
            PG8_WAIT_L(8); PG8_BAR; PG8_WAIT_L(0); PG8_MMA(0, 0, At, B0); PG8_BAR; PG8_SCHED;
            PG8_LDB(B1, 0, 1); PG8_STAGE(PG8_SB(0, 0), b2, voffB);
            PG8_BAR; PG8_WAIT_L(0); PG8_MMA(0, 1, At, B1); PG8_BAR;
            PG8_LDA(At, 0, 1); PG8_STAGE(PG8_SA(0, 0), a2, voffA);
            PG8_BAR; PG8_WAIT_L(0); PG8_MMA(1, 0, At, B0); PG8_BAR; PG8_SCHED;
            PG8_STAGE(PG8_SB(0, 1), b2 + hstep, voffB);
            PG8_WAIT_V(6); PG8_BAR; PG8_MMA(1, 1, At, B1); PG8_BAR;
            PG8_LDB(B0, 1, 0); PG8_SCHED; PG8_LDA(At, 1, 0); PG8_STAGE(PG8_SA(0, 1), a2 + hstep, voffA);
            PG8_WAIT_L(8); PG8_BAR; PG8_WAIT_L(0); PG8_MMA(0, 0, At, B0); PG8_BAR; PG8_SCHED;
            PG8_LDB(B1, 1, 1); PG8_STAGE(PG8_SB(1, 0), b3, voffB);
            PG8_BAR; PG8_WAIT_L(0); PG8_MMA(0, 1, At, B1); PG8_BAR;
            PG8_LDA(At, 1, 1); PG8_STAGE(PG8_SA(1, 0), a3, voffA);
            PG8_BAR; PG8_WAIT_L(0); PG8_MMA(1, 0, At, B0); PG8_BAR; PG8_SCHED;
            PG8_STAGE(PG8_SB(1, 1), b3 + hstep, voffB);
            PG8_WAIT_V(6); PG8_BAR; PG8_MMA(1, 1, At, B1); PG8_BAR;
            }
        }
        if constexpr (ALIGN_EPI) { if (wr == 0) PG8_BAR; }
        if constexpr (!Epi::AFTER_DRAIN) { int le_; asm volatile("v_mbcnt_lo_u32_b32 %0, -1, 0\n\tv_mbcnt_hi_u32_b32 %0, -1, %0" : "=v"(le_)); E(acc, cur, wr, wc, le_ & 15, le_ >> 4); S.done(cur); }
        if (!has_next) break;
#pragma unroll
        for (int a = 0; a < 2; ++a)
#pragma unroll
            for (int b = 0; b < 2; ++b)
#pragma unroll
                for (int m = 0; m < 4; ++m)
#pragma unroll
                    for (int n = 0; n < 2; ++n) acc[a][b][m][n] = (f32x4){0.f, 0.f, 0.f, 0.f};
        cur = nxt; cA = nA; cB = nB; ++ui;
        if constexpr (ALIGN_EPI) { if (wr == 1) PG8_BAR; }
    }
    PG8_WAIT_V(0);
    if constexpr (!ALIGN_EPI) { if (wr == 0) PG8_BAR; }
    PG8_BAR;
    if constexpr (Epi::AFTER_DRAIN) { E.fused(acc, cur, wr, wc, fr, fq, lds, wid, lane); S.done(cur); }
#undef PG8_SA
#undef PG8_SB
#undef PG8_STAGE
#undef PG8_LDA
#undef PG8_LDB
#undef PG8_MMA
#undef PG8_WAIT_V
#undef PG8_WAIT_L
#undef PG8_BAR
#undef PG8_SCHED
}
}

#define LAS __attribute__((address_space(3)))
constexpr int NWAVES = 8, NTHR = 512;
constexpr int LDS_BYTES = 147456;
constexpr int NPH = 21;
typedef float f32x4 __attribute__((ext_vector_type(4)));
typedef unsigned u32x4 __attribute__((ext_vector_type(4)));

struct Args { const float* in[30]; float* out; unsigned char* ws; int ph_lo, ph_hi; };

__device__ __forceinline__ unsigned pk2(float lo, float hi) { return cvtpk(lo, hi); }

__device__ __forceinline__ void p0_transpose_item(const float* W, int K, int N, bf16* WT, int row_off, LAS float* scr, int item, int lane) {
    const int nblk = N / 32, kb = item / nblk, nb = item % nblk, k0 = 64 * kb, n0 = 32 * nb;
#pragma unroll 8
    for (int i = 0; i < 32; ++i) { const int kk = 2 * i + (lane >> 5); scr[kk * 33 + (lane & 31)] = W[(size_t)(k0 + kk) * N + n0 + (lane & 31)]; }
    asm volatile("s_waitcnt lgkmcnt(0)" ::: "memory");
    const int c = lane & 7;
#pragma unroll
    for (int j = 0; j < 4; ++j) { const int n = (lane >> 3) + 8 * j; const LAS float* s = scr + (8 * c) * 33 + n;
        u32x4 o; o.x = pk2(s[0 * 33], s[1 * 33]); o.y = pk2(s[2 * 33], s[3 * 33]); o.z = pk2(s[4 * 33], s[5 * 33]); o.w = pk2(s[6 * 33], s[7 * 33]);
        *(u32x4*)(WT + (size_t)(row_off + n0 + n) * K + k0 + 8 * c) = o; }
    asm volatile("s_waitcnt lgkmcnt(0)" ::: "memory");
}

__device__ __forceinline__ void norm_mod_row(const float* xr, const float* gamma, const float* sh, const float* sc, bf16* orow, int lane) {
    f32x4 v[4]; float ss = 0.f;
#pragma unroll
    for (int j = 0; j < 4; ++j) { v[j] = *(const f32x4*)(xr + j * 256 + lane * 4); ss += (v[j].x * v[j].x + v[j].y * v[j].y) + (v[j].z * v[j].z + v[j].w * v[j].w); }
    const float rs = rsqrtf(wave_sum(ss, lane) * (1.f / D) + NORM_EPS);
#pragma unroll
    for (int j = 0; j < 4; ++j) { const int d = j * 256 + lane * 4; const f32x4 g = *(const f32x4*)(gamma + d), a = *(const f32x4*)(sc + d), s = *(const f32x4*)(sh + d);
        const f32x4 y = v[j] * rs * g * (a + 1.f) + s; uint2 o; o.x = pk2(y.x, y.y); o.y = pk2(y.z, y.w); *(uint2*)(orow + d) = o; }
}


#define XB_TMO      128
#define XB_XCNT(j)  (256  + 64 * (j))
#define XB_XSUB(j)  (1280 + 64 * (j))
#define XB_XGEN(j)  (2304 + 64 * (j))
#define XB_TOP      3328
#define XB_TOPGEN   3392
#define XCD_BAR_WORDS 3456
#define XB_SPIN_CAP (1u << 18)

__device__ __forceinline__ unsigned xb_ld(unsigned* p)              { return __hip_atomic_load(p, __ATOMIC_RELAXED, __HIP_MEMORY_SCOPE_AGENT); }
__device__ __forceinline__ unsigned xb_add(unsigned* p, unsigned v) { return __hip_atomic_fetch_add(p, v, __ATOMIC_RELAXED, __HIP_MEMORY_SCOPE_AGENT); }
__device__ __forceinline__ unsigned xb_xcc_id() { return (unsigned)__builtin_amdgcn_s_getreg((3 << 11) | 20) & 0xFu; }
#define XB_SPIN(cond, bar) do { unsigned _sp = 0; while (cond) { __builtin_amdgcn_s_sleep(1); \
    if ((++_sp & 255u) == 0u) { if (xb_ld(&(bar)[XB_TMO])) break; if (_sp > XB_SPIN_CAP) { atomicAdd(&(bar)[XB_TMO], 1u); break; } } } } while (0)

struct XcdBarrier {
    unsigned* bar; unsigned x; int w0;
    volatile __attribute__((address_space(3))) unsigned* st;
};

__device__ __forceinline__ XcdBarrier xcd_barrier_post(unsigned* bar, volatile __attribute__((address_space(3))) unsigned* st) {
    XcdBarrier b; b.bar = bar; b.x = xb_xcc_id(); b.st = st; b.w0 = __builtin_amdgcn_readfirstlane((int)threadIdx.x >> 6);
    if (threadIdx.x == 0) (void)xb_add(&bar[XB_XCNT(b.x)], 1u);
    return b;
}
__device__ __forceinline__ void xcd_barrier_complete(unsigned* bar, unsigned x, unsigned& nloc, unsigned& nx) {
    const unsigned G = gridDim.x * gridDim.y * gridDim.z;
    unsigned sum, cnt, mine, sp = 0u;
    for (;;) {
        sum = 0u; cnt = 0u; mine = 0u;
#pragma unroll
        for (unsigned j = 0; j < 16; ++j) { const unsigned c = xb_ld(&bar[XB_XCNT(j)]); sum += c; cnt += (c > 0u) ? 1u : 0u; }
        mine = xb_ld(&bar[XB_XCNT(x)]);
        if (sum == G) break;
        __builtin_amdgcn_s_sleep(1);
        if ((++sp & 255u) == 0u) { if (xb_ld(&bar[XB_TMO])) break; if (sp > XB_SPIN_CAP) { atomicAdd(&bar[XB_TMO], 1u); break; } }
    }
    nloc = mine > 0u ? mine : 1u; nx = cnt > 0u ? cnt : 1u;
}

template <bool FIRST> __device__ __forceinline__ void xcd_barrier(const XcdBarrier& b) {
    asm volatile("s_waitcnt vmcnt(0)" ::: "memory");
    __syncthreads();
    int lid_; asm volatile("v_mbcnt_lo_u32_b32 %0, -1, 0\n\tv_mbcnt_hi_u32_b32 %0, -1, %0" : "=v"(lid_));
    if (b.w0 == 0 && lid_ == 0) {
        unsigned* bar = b.bar;
        __builtin_amdgcn_s_waitcnt(0);
        unsigned nloc = b.st[0], nx = b.st[1];
        if (FIRST && nloc == 0u) { xcd_barrier_complete(bar, b.x, nloc, nx); b.st[0] = nloc; b.st[1] = nx; }
        const unsigned old = xb_add(&bar[XB_XSUB(b.x)], 1u);
        const unsigned gen = old / nloc;
        if (old + 1u == (gen + 1u) * nloc) {
            __builtin_amdgcn_fence(__ATOMIC_RELEASE, "agent");
            asm volatile("s_waitcnt vmcnt(0)" ::: "memory");
            const unsigned og = xb_add(&bar[XB_TOP], 1u);
            const unsigned tg = og / nx;
            if (og + 1u == (tg + 1u) * nx) xb_add(&bar[XB_TOPGEN], 1u);
            else XB_SPIN(xb_ld(&bar[XB_TOPGEN]) == tg, bar);
            __builtin_amdgcn_fence(__ATOMIC_ACQUIRE, "agent");
            xb_add(&bar[XB_XGEN(b.x)], 1u);
            asm volatile("s_waitcnt vmcnt(0)" ::: "memory");
        } else {
            XB_SPIN(xb_ld(&bar[XB_XGEN(b.x)]) == gen, bar);
            __builtin_amdgcn_fence(__ATOMIC_ACQUIRE, "agent");
            asm volatile("s_waitcnt vmcnt(0)" ::: "memory");
        }
    }
    __syncthreads();
}


__device__ __forceinline__ unsigned mono_u32(float f) { unsigned u = __float_as_uint(f); return (u & 0x80000000u) ? ~u : (u | 0x80000000u); }
__device__ __forceinline__ float demono_u32(unsigned u) { return __uint_as_float((u & 0x80000000u) ? (u & 0x7FFFFFFFu) : ~u); }
__device__ __forceinline__ unsigned pack_key7(float f, int idx) { return (mono_u32(f) & 0xFFFFFF80u) | (unsigned)(127 - idx); }
__device__ __forceinline__ float unpack_key7(unsigned k) { return demono_u32((k & 0xFFFFFF80u) | 0x40u); }
__device__ __forceinline__ float unpack_key8(unsigned k) { return demono_u32((k & 0xFFFFFF00u) | 0x80u); }
__device__ __forceinline__ void ce_desc(unsigned& a, unsigned& b) { const unsigned hi = a > b ? a : b, lo = a > b ? b : a; a = hi; b = lo; }
__device__ __forceinline__ void sort16_desc(unsigned* v) {
#pragma unroll
    for (int k = 2; k <= 16; k <<= 1)
#pragma unroll
        for (int j = k >> 1; j > 0; j >>= 1)
#pragma unroll
            for (int i = 0; i < 16; ++i) { const int l = i ^ j; if (l > i) { if ((i & k) == 0) ce_desc(v[i], v[l]); else ce_desc(v[l], v[i]); } }
}
__device__ __forceinline__ void bmerge16_desc(unsigned* v) {
#pragma unroll
    for (int j = 8; j > 0; j >>= 1)
#pragma unroll
        for (int i = 0; i < 16; ++i) { const int l = i ^ j; if (l > i) ce_desc(v[i], v[l]); }
}
__device__ __forceinline__ void merge_top16(unsigned* a, const unsigned* b) {
#pragma unroll
    for (int i = 0; i < 16; ++i) { const unsigned o = b[15 - i]; a[i] = a[i] > o ? a[i] : o; }
    bmerge16_desc(a);
}
__device__ __forceinline__ void stage2_cands(const unsigned* s0, const unsigned* s1, int hh, unsigned* c) {
    float A[16], B[16];
#pragma unroll
    for (int i = 0; i < 16; ++i) { const float f0 = unpack_key7(s0[i]), f1 = unpack_key7(s1[i]); A[i] = hh ? f1 : f0; B[i] = hh ? f0 : f1; }
    int n = 0;
#pragma unroll
    for (int i = 0; i < 4; ++i)
#pragma unroll
        for (int j = i; j < 16; ++j) { if ((i + 1) * (j + 1) > 16) continue;
            const float val = A[i] + B[j]; const unsigned id = hh ? (unsigned)((j << 4) | i) : (unsigned)((i << 4) | j);
            unsigned key = (mono_u32(val) & 0xFFFFFF00u) | id; if (hh && i == j) key = 0u; c[n++] = key; }
#pragma unroll
    for (; n < 32; ++n) c[n] = 0u;
}

typedef short bf16x8_t __attribute__((ext_vector_type(8)));
typedef float f32x16 __attribute__((ext_vector_type(16)));
__device__ __forceinline__ float gelu_erf(float a) { return 0.5f * a * (1.f + erff(a * 0.70710678118654752f)); }


typedef __attribute__((address_space(3))) bf16 lbf16;

__device__ __forceinline__ f32x16 mm32(bf16x8_t a, bf16x8_t b, f32x16 c) { return __builtin_amdgcn_mfma_f32_32x32x16_bf16(a, b, c, 0, 0, 0); }
__device__ __forceinline__ bf16x8_t frag_from_u32x4(unsigned x, unsigned y, unsigned z, unsigned w) { typedef unsigned u4 __attribute__((ext_vector_type(4))); u4 t = {x, y, z, w}; return __builtin_bit_cast(bf16x8_t, t); }
template <int S> __device__ __forceinline__ bf16x8_t accop(const f32x16& z) {
    return frag_from_u32x4(cvtpk(z[8 * S], z[8 * S + 1]), cvtpk(z[8 * S + 2], z[8 * S + 3]), cvtpk(z[8 * S + 4], z[8 * S + 5]), cvtpk(z[8 * S + 6], z[8 * S + 7])); }
template <int S> __device__ __forceinline__ bf16x8_t ldpermcol(const lbf16* a, int col, int hh) {
    const lbf16* p = a + (16 * S + 4 * hh) * 72 + col;
    const unsigned e0 = p[0], e1 = p[72], e2 = p[144], e3 = p[216], e4 = p[8 * 72], e5 = p[9 * 72], e6 = p[10 * 72], e7 = p[11 * 72];
    return frag_from_u32x4(e0 | (e1 << 16), e2 | (e3 << 16), e4 | (e5 << 16), e6 | (e7 << 16)); }
__device__ __forceinline__ bf16x8_t ldrow(const lbf16* a, int row, int ks, int hh) { return *(const __attribute__((address_space(3))) bf16x8_t*)(a + row * 72 + ks * 16 + 8 * hh); }
__device__ __forceinline__ int rowidx(int e, int hh) { return (e & 3) + 8 * (e >> 2) + 4 * hh; }

constexpr int ROWB = 768;
__device__ __forceinline__ unsigned fp6code(float x, float sc) {
    const float t = fabsf(x) * sc;
    const float r = t < 16.f ? __builtin_rintf(t) : (t < 32.f ? 8.f + __builtin_rintf(t * 0.5f) : 16.f + __builtin_rintf(t * 0.25f));
    unsigned c = (unsigned)r; c = c > 31u ? 31u : c;
    return c | (x < 0.f ? 32u : 0u);
}
__device__ __forceinline__ void convert_tables_fp6(const float* pu, const float* pv, unsigned char* u8, unsigned char* v8, float* usc, float* vsc, int l, int wv, int nw, int lane) {
    for (int rr0 = wv * 2; rr0 < 2 * NEXP; rr0 += nw * 2) {
        f32x4 v[2][4]; float m[2];
#pragma unroll
        for (int rr = 0; rr < 2; ++rr) { const int q = rr0 + rr; const size_t row = (size_t)l * NEXP + (q < NEXP ? q : q - NEXP); const float* sp_ = (q < NEXP ? pu : pv) + row * D + lane * 16;
#pragma unroll
            for (int k = 0; k < 4; ++k) v[rr][k] = *(const f32x4*)(sp_ + k * 4); }
#pragma unroll
        for (int rr = 0; rr < 2; ++rr) { float mm = 0.f;
#pragma unroll
            for (int k = 0; k < 4; ++k) mm = fmaxf(fmaxf(mm, fmaxf(fabsf(v[rr][k].x), fabsf(v[rr][k].y))), fmaxf(fabsf(v[rr][k].z), fabsf(v[rr][k].w)));
#pragma unroll
            for (int o = 1; o < 64; o <<= 1) mm = fmaxf(mm, shflx(mm, lane, o));
            m[rr] = mm; }
#pragma unroll
        for (int rr = 0; rr < 2; ++rr) { const int q = rr0 + rr; const size_t row = (size_t)l * NEXP + (q < NEXP ? q : q - NEXP); const float sc = m[rr] > 0.f ? 60.f / m[rr] : 1.f;
            unsigned c[16];
#pragma unroll
            for (int k = 0; k < 4; ++k) { c[k * 4] = fp6code(v[rr][k].x, sc); c[k * 4 + 1] = fp6code(v[rr][k].y, sc); c[k * 4 + 2] = fp6code(v[rr][k].z, sc); c[k * 4 + 3] = fp6code(v[rr][k].w, sc); }
            const unsigned o0 = c[0] | (c[1] << 6) | (c[2] << 12) | (c[3] << 18) | (c[4] << 24) | (c[5] << 30);
            const unsigned o1 = (c[5] >> 2) | (c[6] << 4) | (c[7] << 10) | (c[8] << 16) | (c[9] << 22) | (c[10] << 28);
            const unsigned o2 = (c[10] >> 4) | (c[11] << 2) | (c[12] << 8) | (c[13] << 14) | (c[14] << 20) | (c[15] << 26);
            unsigned* op = (unsigned*)((q < NEXP ? u8 : v8) + row * ROWB + lane * 12);
            op[0] = o0; op[1] = o1; op[2] = o2;
            if (lane == 0) (q < NEXP ? usc : vsc)[row] = m[rr] > 0.f ? m[rr] * (1.f / 7.5f) : 1.f; }
    }
}

__global__ void __launch_bounds__(NTHR, 2) mega(Args args) {
    extern __shared__ __attribute__((aligned(16))) unsigned char lds_raw[];
    LAS unsigned char* lds = (LAS unsigned char*)lds_raw;
    const int G = gridDim.x, bx = blockIdx.x, NGW = G * NWAVES;
    const int wave0 = __builtin_amdgcn_readfirstlane((int)threadIdx.x >> 6);
    typedef const unsigned char __attribute__((address_space(4))) kbyte;
#define PHASE_IDS int tid; asm volatile("v_mbcnt_lo_u32_b32 %0, -1, 0\n\tv_mbcnt_hi_u32_b32 %0, -1, %0" : "=v"(tid)); tid += wave0 * 64;     const int lane = tid & 63, wave = __builtin_amdgcn_readfirstlane(tid >> 6), gw = bx * NWAVES + wave; (void)lane; (void)gw; \
    kbyte* kp = (kbyte*)__builtin_amdgcn_kernarg_segment_ptr(); asm volatile("" : "+s"(kp)); \
    unsigned char* const ws = (unsigned char*)*(__attribute__((address_space(1))) unsigned char* const __attribute__((address_space(4)))*)(kp + 31 * 8); float* const X = (float*)*(__attribute__((address_space(1))) float* const __attribute__((address_space(4)))*)(kp + 30 * 8); (void)ws; (void)X;
#define INP(i) ((const float*)(*(const __attribute__((address_space(1))) float* const __attribute__((address_space(4)))*)(kp + (i) * 8)))
#define MOD ((float*)(ws + WS_MOD))
#define H ((bf16*)(ws + WS_H))
#define PROJ ((bf16*)(ws + WS_PROJ))
#define Q ((bf16*)(ws + WS_Q))
#define MIX ((bf16*)(ws + WS_MIX))
#define Rb ((bf16*)(ws + WS_R))
#define Kb ((bf16*)(ws + WS_K))
#define V0 ((bf16*)(ws + WS_V0))
#define V1 ((bf16*)(ws + WS_V1))
#define KKb ((bf16*)(ws + WS_KK))
#define Bb ((bf16*)(ws + WS_B))
#define Gb ((bf16*)(ws + WS_G))
#define BGb ((bf16*)(ws + WS_BG))
#define Wd ((float*)(ws + WS_W))
#define Y ((float*)(ws + WS_Y))
#define QB ((float*)(ws + WS_QB))
#define SH ((float*)(ws + WS_SH))
#define WUPT ((bf16*)(ws + WS_LORA))
#define AUPT ((bf16*)(ws + WS_LORA + 131072))
#define GUPT ((bf16*)(ws + WS_LORA + 262144))
#define VUPT ((bf16*)(ws + WS_LORA + 524288))
#define PWT ((bf16*)(ws + WS_LORA + 655360))
#define INVN ((float*)(ws + WS_INVN))
#define BSUM ((float*)(ws + WS_BSUM))
#define SCN ((unsigned char*)(ws + WS_SCN))
#define IDX ((int*)(ws + WS_IDX))
#define GATE ((float*)(ws + WS_GATE))
#define WinT ((bf16*)(ws + WS_WIN_T))
#define WoutT ((bf16*)(ws + WS_WOUT_T))
#define PqT ((bf16*)(ws + WS_PQ_T))
#define KEYS ((bf16*)(ws + WS_KEYS))
#define U8 ((unsigned char*)(ws + WS_U))
#define V8 ((unsigned char*)(ws + WS_V))
#define USc ((float*)(ws + WS_US))
#define VSc ((float*)(ws + WS_VS))
    const int lo = args.ph_lo, hi = args.ph_hi;
    { volatile LAS unsigned* misc = (volatile LAS unsigned*)(lds + LDS_BYTES - 64); if (threadIdx.x < 4) misc[threadIdx.x] = 0u; __syncthreads(); }
    const XcdBarrier xbar = xcd_barrier_post((unsigned*)(args.ws) + 4096, (volatile LAS unsigned*)(lds + LDS_BYTES - 64));
#define IN(k) (lo <= (k) && (k) < hi)
#ifndef REP_PHASE
#define REP_PHASE (-1)
#endif
#define REPS(k) ((k) == REP_PHASE ? 3 : 1)
#define SEAM(k) do { if (IN(k) && IN((k) + 1)) { if ((k) == 0) cg::this_grid().sync(); else { XcdBarrier xb_ = xbar; asm volatile("" : "+s"(xb_.bar)); if ((k) == 1) xcd_barrier<true>(xb_); else xcd_barrier<false>(xb_); } } } while (0)

    if (IN(0)) { PHASE_IDS
        { LAS float* ca = (LAS float*)lds; LAS float* red = (LAS float*)(lds + 16384);
          const float* c = INP(1); const float* ada_w = INP(2); const float* ada_b = INP(3);
          bool have = false;
          for (int it = bx; it < 96; it += G) {
              if (!have) { for (int i = tid; i < BATCH * D; i += NTHR) { const float v = c[i]; ca[i] = v / (1.f + expf(-v)); } have = true; __syncthreads(); }
              const int l = it / 48, n = (it % 48) * 128 + (tid & 127), kq = tid >> 7;
              const float* w = ada_w + (size_t)l * D * 6 * D + (size_t)(kq * 256) * 6 * D + n;
              float a0 = 0.f, a1 = 0.f, a2 = 0.f, a3 = 0.f;
#pragma unroll 32
              for (int k = 0; k < 256; ++k) { const float wv = w[(size_t)k * 6 * D]; const int kk = kq * 256 + k; a0 += ca[kk] * wv; a1 += ca[D + kk] * wv; a2 += ca[2 * D + kk] * wv; a3 += ca[3 * D + kk] * wv; }
              red[(kq * 4 + 0) * 128 + (tid & 127)] = a0; red[(kq * 4 + 1) * 128 + (tid & 127)] = a1; red[(kq * 4 + 2) * 128 + (tid & 127)] = a2; red[(kq * 4 + 3) * 128 + (tid & 127)] = a3;
              __syncthreads();
              { const int b = tid >> 7, col = tid & 127, nn = (it % 48) * 128 + col;
                const float s = red[(0 * 4 + b) * 128 + col] + red[(1 * 4 + b) * 128 + col] + red[(2 * 4 + b) * 128 + col] + red[(3 * 4 + b) * 128 + col];
                MOD[(size_t)l * BATCH * 6 * D + (size_t)b * 6 * D + nn] = s + ada_b[l * 6 * D + nn]; }
              __syncthreads();
          }
          __syncthreads(); }
        { LAS float* scr = (LAS float*)(lds + wave * 16384);
          constexpr int I_IN = (D / 64) * (IN_COLS / 32), I_VR = (D / 64) * (MVL / 32), I_OUT = (D / 64) * (D / 32), I_PQ = (D / 64) * (PH * PQ / 32);
          constexpr int NIT = 2 * I_IN + I_VR + 2 * I_OUT + 2 * I_PQ;
          for (int it = gw; it < NIT; it += NGW) { int r = it;
              if (r < 2 * I_IN) { const int l = r / I_IN; p0_transpose_item(INP(5) + (size_t)l * D * IN_COLS, D, IN_COLS, WinT + (size_t)l * LDP * D, 0, scr, r % I_IN, lane); continue; } r -= 2 * I_IN;
              if (r < I_VR) { p0_transpose_item(INP(12), D, MVL, WinT + (size_t)1 * LDP * D, IN_COLS, scr, r, lane); continue; } r -= I_VR;
              if (r < 2 * I_OUT) { const int l = r / I_OUT; p0_transpose_item(INP(23) + (size_t)l * D * D, D, D, WoutT + (size_t)l * D * D, 0, scr, r % I_OUT, lane); continue; } r -= 2 * I_OUT;
              { const int l = r / I_PQ; p0_transpose_item(INP(25) + (size_t)l * D * PH * PQ, D, PH * PQ, PqT + (size_t)l * PH * PQ * D, 0, scr, r % I_PQ, lane); } }
          for (int it = gw; it < 2 * 16 + 2 * 16 + 2 * 32; it += NGW) { int r = it;
              if (r < 32) { const int l = r / 16; p0_transpose_item(INP(8) + (size_t)l * DL * RW, DL, RW, WUPT + (size_t)l * RW * DL, 0, scr, r % 16, lane); continue; } r -= 32;
              if (r < 32) { const int l = r / 16; p0_transpose_item(INP(10) + (size_t)l * AL * RW, AL, RW, AUPT + (size_t)l * RW * AL, 0, scr, r % 16, lane); continue; } r -= 32;
              { const int l = r / 32; p0_transpose_item(INP(11) + (size_t)l * GL * RW, GL, RW, GUPT + (size_t)l * RW * GL, 0, scr, r % 32, lane); } }
          { const float* vu = INP(15); for (int e = bx * NTHR + tid; e < MVL * RW; e += G * NTHR) { const int n = e >> 5, k = e & 31; VUPT[e] = f2bf(vu[k * RW + n]); } }
          for (int it = gw; it < 8 * 8; it += NGW) p0_transpose_item(INP(21) + (size_t)(it >> 3) * PG * PG, PG, PG, PWT + (size_t)(it >> 3) * PG * PG, 0, scr, it & 7, lane);
        }
        { const size_t gt = (size_t)bx * NTHR + tid, NT = (size_t)G * NTHR;
          constexpr size_t NK8 = (size_t)2 * PH * 2 * NKEYS * PHALF / 8;
          const float* src = INP(26); bf16* dst = KEYS;
          for (size_t i = gt; i < NK8; i += NT) {
              const f32x4 a = *(const f32x4*)(src + i * 8), b = *(const f32x4*)(src + i * 8 + 4);
              u32x4 o; o.x = pk2(a.x, a.y); o.y = pk2(a.z, a.w); o.z = pk2(b.x, b.y); o.w = pk2(b.z, b.w); *(u32x4*)(dst + i * 8) = o; }
        }
    }
    SEAM(0);

#pragma unroll
    for (int l = 0; l < DEPTH; ++l) {
        const int pb = 1 + 10 * l;
#define modl (MOD + (size_t)l * BATCH * 6 * D)
#define xin (l == 0 ? INP(0) : (const float*)X)
        if (l == 0 && IN(pb + 0)) { PHASE_IDS const float* gamma = INP(4) + l * D;
            for (int row = gw; row < T; row += NGW) { const int b = row / SEQ; norm_mod_row(xin + (size_t)row * D, gamma, modl + (size_t)b * 6 * D, modl + (size_t)b * 6 * D + D, H + (size_t)row * D, lane); } }
        SEAM(pb + 0);
        if (IN(pb + 1)) { PHASE_IDS const int N1 = l == 0 ? IN_COLS : LDP;
            pg8::Gemm g{H, WinT + (size_t)l * LDP * D, T, N1, D}; pg8::StaticOrder S; S.init(T, N1, G, bx);
            pg8::EpiBf16<0> E{PROJ, LDP, nullptr, 0, 0, 1.f};
            pg8::gemm_phase<pg8::EpiBf16<0>, pg8::StaticOrder, true, true>(lds, g, S, E, tid); }
        SEAM(pb + 1);

        if (IN(pb + 2)) { PHASE_IDS
            constexpr int LST = 296;
            LAS bf16* lin = (LAS bf16*)lds;
            const float* mu = INP(6) + l * RWKV_COLS; const float* vmu = INP(13);
            const float* w0p = INP(7) + l * RW; const float* a0p = INP(9) + l * RW; const float* kkp = INP(16) + l * RW; const float* kap = INP(17) + l * RW; const float* rkp = INP(18) + l * RW; const float* v0p = INP(14);
            const bf16* wupT = WUPT + (size_t)l * RW * DL; const bf16* aupT = AUPT + (size_t)l * RW * AL; const bf16* gupT = GUPT + (size_t)l * RW * GL; const bf16* vupT = VUPT;
            bf16* Vl = l == 0 ? V0 : V1;
            const int r32 = lane & 31, hh = lane >> 5, h = wave;
            for (int tile = bx; tile < T / 32; tile += G) {
                const int t0 = tile * 32;
                __syncthreads();
#pragma unroll 1
                for (int it0 = 0; it0 < 3; it0 += 2) {
                  u32x4 cu_[2], pv_[2]; f32x4 m0_[2], m1_[2];
#pragma unroll
                  for (int it = 0; it < 2; ++it) { const int c8 = tid + (it0 + it) * NTHR; const bool ok = c8 < 32 * 36; const int tok = ok ? c8 / 36 : 0, jc = ok ? c8 % 36 : 0, t = t0 + tok, sq = t % SEQ;
                      cu_[it] = (u32x4){0u, 0u, 0u, 0u}; pv_[it] = (u32x4){0u, 0u, 0u, 0u}; m0_[it] = (f32x4){0.f, 0.f, 0.f, 0.f}; m1_[it] = m0_[it];
                      if (ok && (jc < 32 || l > 0)) { const int col = jc < 32 ? 3 * RW + jc * 8 : IN_COLS + (jc - 32) * 8;
                          cu_[it] = *(const u32x4*)(PROJ + (size_t)t * LDP + col); if (sq > 0) pv_[it] = *(const u32x4*)(PROJ + (size_t)(t - 1) * LDP + col);
                          const float* mp = jc < 32 ? mu + col : vmu + (jc - 32) * 8; m0_[it] = *(const f32x4*)mp; m1_[it] = *(const f32x4*)(mp + 4); } }
#pragma unroll
                  for (int it = 0; it < 2; ++it) { const int c8 = tid + (it0 + it) * NTHR; if (c8 < 32 * 36) { const int tok = c8 / 36, jc = c8 % 36;
                      u32x4 o = {0u, 0u, 0u, 0u};
                      if (jc < 32 || l > 0) {
                          float x[8]; const unsigned cw[4] = {cu_[it].x, cu_[it].y, cu_[it].z, cu_[it].w}, pw[4] = {pv_[it].x, pv_[it].y, pv_[it].z, pv_[it].w}; const float mm[8] = {m0_[it].x, m0_[it].y, m0_[it].z, m0_[it].w, m1_[it].x, m1_[it].y, m1_[it].z, m1_[it].w};
#pragma unroll
                          for (int i = 0; i < 4; ++i) { const float c0 = __uint_as_float(cw[i] << 16), c1 = __uint_as_float(cw[i] & 0xffff0000u), p0 = __uint_as_float(pw[i] << 16), p1 = __uint_as_float(pw[i] & 0xffff0000u);
                              x[2 * i] = c0 + (p0 - c0) * mm[2 * i]; x[2 * i + 1] = c1 + (p1 - c1) * mm[2 * i + 1]; }
                          if (jc < 8) {
#pragma unroll
                              for (int i = 0; i < 8; ++i) { const float e2 = __expf(-2.f * fabsf(x[i])); const float th = (1.f - e2) * __builtin_amdgcn_rcpf(1.f + e2); x[i] = x[i] < 0.f ? -th : th; } }
                          else if (jc >= 16 && jc < 32) {
#pragma unroll
                              for (int i = 0; i < 8; ++i) x[i] = __builtin_amdgcn_rcpf(1.f + __expf(-x[i])); }
                          o.x = pk2(x[0], x[1]); o.y = pk2(x[2], x[3]); o.z = pk2(x[4], x[5]); o.w = pk2(x[6], x[7]);
                      }
                      *(LAS u32x4*)(lin + tok * LST + jc * 8) = o; } } }
                __syncthreads();
                const bool first = (t0 % SEQ) == 0;
                lbf16* tin = (lbf16*)(lds + 19456 + wave * 14336);
                { u32x4 iq[13]; int ql_; asm volatile("v_mbcnt_lo_u32_b32 %0, -1, 0\n\tv_mbcnt_hi_u32_b32 %0, -1, %0" : "=v"(ql_));
#pragma unroll
                  for (int i = 0; i < 13; ++i) { const int q = ql_ + 64 * i; iq[i] = (u32x4){0u, 0u, 0u, 0u};
                      if (q < 792) { const int arr = q / 264, rem = q - arr * 264, row = rem >> 3, cc = rem & 7;
                          if (!(first && row == 0)) iq[i] = *(const u32x4*)(PROJ + (size_t)(t0 - 1 + row) * LDP + arr * RW + h * HS + cc * 8); } }
#pragma unroll
                  for (int i = 0; i < 13; ++i) { const int q = ql_ + 64 * i; if (q < 792) { const int arr = q / 264, rem = q - arr * 264, row = rem >> 3, cc = rem & 7;
                      *(__attribute__((address_space(3))) u32x4*)(tin + arr * 2376 + row * 72 + cc * 8) = iq[i]; } } }
                __builtin_amdgcn_wave_barrier(); asm volatile("s_waitcnt lgkmcnt(0)" ::: "memory");
                float ssq[16], bsm[16];
#pragma unroll
                for (int e = 0; e < 16; ++e) { ssq[e] = 0.f; bsm[e] = 0.f; }
#pragma unroll 1
                for (int rt = 0; rt < 2; ++rt) {
                    f32x16 accW, accA, accG, accV;
#pragma unroll
                    for (int e = 0; e < 16; ++e) { accW[e] = 0.f; accA[e] = 0.f; accG[e] = 0.f; accV[e] = 0.f; }
                    int c = h * HS + rt * 32 + r32;
int hh8 = 8 * hh; asm volatile("" : "+v"(c), "+v"(hh8));
                    const LAS bf16* lrow = lin + r32 * LST + 8 * hh;
                    { bf16x8_t wf[18];
#pragma unroll
                      for (int ks = 0; ks < 4; ++ks) { wf[ks] = *(const bf16x8_t*)(wupT + (size_t)c * DL + ks * 16 + hh8); wf[4 + ks] = *(const bf16x8_t*)(aupT + (size_t)c * AL + ks * 16 + hh8); }
#pragma unroll
                      for (int ks = 0; ks < 8; ++ks) wf[8 + ks] = *(const bf16x8_t*)(gupT + (size_t)c * GL + ks * 16 + hh8);
                      wf[16] = bf16x8_t{}; wf[17] = bf16x8_t{};
                      if (l > 0) { wf[16] = *(const bf16x8_t*)(vupT + (size_t)c * MVL + hh8); wf[17] = *(const bf16x8_t*)(vupT + (size_t)c * MVL + 16 + hh8); }
#pragma unroll
                      for (int ks = 0; ks < 4; ++ks) { accW = __builtin_amdgcn_mfma_f32_32x32x16_bf16(*(const LAS bf16x8_t*)(lrow + ks * 16), wf[ks], accW, 0, 0, 0);
                                                       accA = __builtin_amdgcn_mfma_f32_32x32x16_bf16(*(const LAS bf16x8_t*)(lrow + 64 + ks * 16), wf[4 + ks], accA, 0, 0, 0); }
#pragma unroll
                      for (int ks = 0; ks < 8; ++ks) accG = __builtin_amdgcn_mfma_f32_32x32x16_bf16(*(const LAS bf16x8_t*)(lrow + 128 + ks * 16), wf[8 + ks], accG, 0, 0, 0);
                      if (l > 0) {
#pragma unroll
                          for (int ks = 0; ks < 2; ++ks) accV = __builtin_amdgcn_mfma_f32_32x32x16_bf16(*(const LAS bf16x8_t*)(lrow + 256 + ks * 16), wf[16 + ks], accV, 0, 0, 0); } }
                    const float mur = mu[c], muk = mu[RW + c], muv = mu[2 * RW + c], w0c = w0p[c], a0c = a0p[c], kkc = kkp[c], kac = kap[c], rkc = rkp[c];
                    const float v0c = l > 0 ? v0p[c] : 0.f;
#pragma unroll
                    for (int eb = 0; eb < 16; eb += 4) {
                        bf16 lr[4], lk[4], lv[4], lrp[4], lkp[4], lvp[4], lvf[4];
#pragma unroll
                        for (int i = 0; i < 4; ++i) { const int e = eb + i; const int tok = (e & 3) + 8 * (e >> 2) + 4 * hh, t = t0 + tok; const int ci = rt * 32 + r32;
                            lr[i] = tin[(tok + 1) * 72 + ci]; lk[i] = tin[2376 + (tok + 1) * 72 + ci]; lv[i] = tin[2 * 2376 + (tok + 1) * 72 + ci];
                            lrp[i] = tin[tok * 72 + ci]; lkp[i] = tin[2376 + tok * 72 + ci]; lvp[i] = tin[2 * 2376 + tok * 72 + ci];
                            lvf[i] = l > 0 ? V0[(size_t)t * RW + c] : (bf16)0; }
                        __builtin_amdgcn_sched_barrier(0);
#pragma unroll
                        for (int i = 0; i < 4; ++i) { const int e = eb + i; const int tok = (e & 3) + 8 * (e >> 2) + 4 * hh, t = t0 + tok; const size_t o = (size_t)t * RW + c;
                            float r = bf2f(lr[i]), k = bf2f(lk[i]), v = bf2f(lv[i]);
                            r += (bf2f(lrp[i]) - r) * mur; k += (bf2f(lkp[i]) - k) * muk; v += (bf2f(lvp[i]) - v) * muv;
                            const float z = -(w0c + accW[e]); const float sp = fmaxf(z, 0.f) + __logf(1.f + __expf(-fabsf(z)));
                            const float decay = __expf(-__expf(-sp - 0.5f));
                            const float a = __builtin_amdgcn_rcpf(1.f + __expf(-(a0c + accA[e]))); const float g = accG[e];
                            if (l > 0) { const float vfv = bf2f(lvf[i]); v = v + (vfv - v) * __builtin_amdgcn_rcpf(1.f + __expf(-(v0c + accV[e]))); }
                            const float kk = k * kkc; const float k2 = k * (1.f + (a - 1.f) * kac);
                            ssq[e] += kk * kk; bsm[e] += r * k2 * rkc;
                            { const unsigned p0_ = cvtpk(r, k2), p1_ = cvtpk(v, kk), p2_ = cvtpk(kk * a, g), p3_ = cvtpk(v * g, 0.f);
                              Rb[o] = (bf16)p0_; Kb[o] = (bf16)(p0_ >> 16); Vl[o] = (bf16)p1_; KKb[o] = (bf16)(p1_ >> 16); Bb[o] = (bf16)p2_; Gb[o] = (bf16)(p2_ >> 16); BGb[o] = (bf16)p3_; Wd[o] = decay; }
                        }
                    }
                }
#pragma unroll
                for (int e = 0; e < 16; ++e) { const int ln_ = r32 | (hh << 5); float a_ = red16(ssq[e]), b_ = red16(bsm[e]); a_ += shflx(a_, ln_, 16); b_ += shflx(b_, ln_, 16); ssq[e] = a_; bsm[e] = b_; }
                if (r32 == 0) {
#pragma unroll
                    for (int e = 0; e < 16; ++e) { const int tok = (e & 3) + 8 * (e >> 2) + 4 * hh; INVN[(size_t)(t0 + tok) * NH + h] = rsqrtf(fmaxf(ssq[e], 1e-24f)); BSUM[(size_t)(t0 + tok) * NH + h] = bsm[e]; } }
            }
            {
                constexpr int DST = 520;
                int lane_p; asm volatile("v_mbcnt_lo_u32_b32 %0, -1, 0\n\tv_mbcnt_hi_u32_b32 %0, -1, %0" : "=v"(lane_p)); const int r32 = lane_p & 31, hh = lane_p >> 5, tidp = wave0 * 64 + lane_p;
                lbf16* dlb = (lbf16*)lds;
                lbf16* pin = (lbf16*)(lds + 33280);
                const int c = tidp, g = c >> 7, win = 2 << g;
                const bf16* pwt = PWT + (size_t)(l * 4 + (wave >> 1)) * PG * PG; const float* psc = INP(22) + l * PW;
                for (int tile = bx; tile < T / 32; tile += G) {
                    const int t0 = tile * 32; const bool first = (t0 % SEQ) == 0;
                    __syncthreads();
                    { u32x4 pq[6];
#pragma unroll
                      for (int q = 0; q < 6; ++q) { const int ch = tidp + q * NTHR, row = ch >> 6, cc = ch & 63; pq[q] = (u32x4){0u, 0u, 0u, 0u};
                          if (ch < 47 * 64 && (row >= 15 || !first)) pq[q] = *(const u32x4*)(PROJ + (size_t)(t0 - 15 + row) * LDP + RWKV_COLS + cc * 8); }
#pragma unroll
                      for (int q = 0; q < 6; ++q) { const int ch = tidp + q * NTHR, row = ch >> 6, cc = ch & 63; if (ch < 47 * 64) *(__attribute__((address_space(3))) u32x4*)(pin + row * 520 + cc * 8) = pq[q]; } }
                    __syncthreads();
                    const lbf16* pc = pin + c;
                    float sw = 0.f;
#pragma unroll
                    for (int j = 1; j <= 15; ++j) sw += (j < win) ? bf2f(pc[(15 - j) * 520]) : 0.f;
                    const float invw = 1.f / (float)win;
#pragma unroll 8
                    for (int i = 0; i < 32; ++i) {
                        const float cur = bf2f(pc[(15 + i) * 520]);
                        sw += cur;
                        const float inv = (first && i < 15) ? 1.f / (float)min(i + 1, win) : invw;
                        dlb[i * DST + c] = f2bf(sw * inv - cur);
                        sw -= bf2f(pc[(15 + i - win + 1) * 520]);
                    }
                    __syncthreads();
                    const int gg = wave >> 1, half = wave & 1;
#pragma unroll
                    for (int ct = 0; ct < 2; ++ct) {
                        const int dd0 = half * 64 + ct * 32;
                        f32x16 acc;
#pragma unroll
                        for (int e = 0; e < 16; ++e) acc[e] = 0.f;
#pragma unroll
                        for (int ks = 0; ks < 8; ++ks) { const bf16x8_t a = *(const __attribute__((address_space(3))) bf16x8_t*)(dlb + r32 * DST + gg * PG + ks * 16 + 8 * hh);
                            const bf16x8_t w = *(const bf16x8_t*)(pwt + (size_t)(dd0 + r32) * PG + ks * 16 + 8 * hh); acc = mm32(a, w, acc); }
                        const int oc = gg * PG + dd0 + r32; const float ps = psc[oc];
#pragma unroll
                        for (int e = 0; e < 16; ++e) MIX[(size_t)(t0 + rowidx(e, hh)) * D + RW + oc] = f2bf(acc[e] * ps);
                    }
                }
            }
        }
        SEAM(pb + 2);

        if (IN(pb + 3)) { PHASE_IDS
            const bf16* Vl = l == 0 ? V0 : V1;
            const int r32 = lane & 31, hh = lane >> 5;
            if (wave < 6) {
                lbf16* At = (lbf16*)(lds + wave * 23552); lbf16* Bt = At + 2304; lbf16* Kt = Bt + 2304; lbf16* Rt = Kt + 2304; lbf16* Vv = Rt + 2304;
                LAS float* PCs = (LAS float*)(lds + wave * 23552 + 23040);
                for (int item = bx * 6 + wave; item < BATCH * NH * (SEQ / 32); item += G * 6) {
                    const int bh = item >> 7, chunk = item & 127, b = bh >> 3, h = bh & 7; const size_t t0 = (size_t)b * SEQ + chunk * 32;
                    __builtin_amdgcn_wave_barrier(); asm volatile("s_waitcnt lgkmcnt(0)" ::: "memory");
                    {
                      const int tk = lane >> 3, part = lane & 7;
                      u32x4 qr[4], qk[4], qv[4], qkk[4], qb[4]; f32x4 qw0[4], qw1[4]; float qin[4];
#pragma unroll
                      for (int p4 = 0; p4 < 4; ++p4) { const size_t o = (t0 + p4 * 8 + tk) * RW + h * HS + part * 8;
                          qr[p4] = *(const u32x4*)(Rb + o); qk[p4] = *(const u32x4*)(Kb + o); qv[p4] = *(const u32x4*)(Vl + o); qkk[p4] = *(const u32x4*)(KKb + o); qb[p4] = *(const u32x4*)(Bb + o);
                          qw0[p4] = *(const f32x4*)(Wd + o); qw1[p4] = *(const f32x4*)(Wd + o + 4); qin[p4] = INVN[(t0 + p4 * 8 + tk) * NH + h]; }
                      LAS float* Pl = (LAS float*)At;
#pragma unroll
                      for (int p4 = 0; p4 < 4; ++p4) { *(LAS f32x4*)(Pl + (p4 * 8 + tk) * 64 + part * 8) = qw0[p4]; *(LAS f32x4*)(Pl + (p4 * 8 + tk) * 64 + part * 8 + 4) = qw1[p4]; }
                      __builtin_amdgcn_wave_barrier(); asm volatile("s_waitcnt lgkmcnt(0)" ::: "memory");
                      { float P = 1.f;
#pragma unroll 8
                        for (int c = 0; c < 32; ++c) { P *= Pl[c * 64 + lane]; Pl[c * 64 + lane] = P; }
                        PCs[lane] = P; }
                      __builtin_amdgcn_wave_barrier(); asm volatile("s_waitcnt lgkmcnt(0)" ::: "memory");
                      u32x4 oa[4], orr[4], ob_[4], ok_[4];
#pragma unroll
                      for (int p4 = 0; p4 < 4; ++p4) { const int c = p4 * 8 + tk;
                          const f32x4 pa = *(const LAS f32x4*)(Pl + c * 64 + part * 8), pb2 = *(const LAS f32x4*)(Pl + c * 64 + part * 8 + 4);
                          f32x4 ma = {1.f, 1.f, 1.f, 1.f}, mb = ma; if (c > 0) { ma = *(const LAS f32x4*)(Pl + (c - 1) * 64 + part * 8); mb = *(const LAS f32x4*)(Pl + (c - 1) * 64 + part * 8 + 4); }
                          const float Pc[8] = {pa.x, pa.y, pa.z, pa.w, pb2.x, pb2.y, pb2.z, pb2.w}, Pm[8] = {ma.x, ma.y, ma.z, ma.w, mb.x, mb.y, mb.z, mb.w};
                          const unsigned rw_[4] = {qr[p4].x, qr[p4].y, qr[p4].z, qr[p4].w}, kw_[4] = {qk[p4].x, qk[p4].y, qk[p4].z, qk[p4].w}, kkw[4] = {qkk[p4].x, qkk[p4].y, qkk[p4].z, qkk[p4].w}, bw_[4] = {qb[p4].x, qb[p4].y, qb[p4].z, qb[p4].w};
                          unsigned xa[4], xr[4], xb[4], xk[4]; const float inv = qin[p4];
#pragma unroll
                          for (int i = 0; i < 4; ++i) { const float ip0 = __builtin_amdgcn_rcpf(Pc[2 * i]), ip1 = __builtin_amdgcn_rcpf(Pc[2 * i + 1]);
                              xa[i] = pk2(-__uint_as_float(kkw[i] << 16) * inv * Pm[2 * i], -__uint_as_float(kkw[i] & 0xffff0000u) * inv * Pm[2 * i + 1]);
                              xr[i] = pk2(__uint_as_float(rw_[i] << 16) * Pc[2 * i], __uint_as_float(rw_[i] & 0xffff0000u) * Pc[2 * i + 1]);
                              xb[i] = pk2(__uint_as_float(bw_[i] << 16) * inv * ip0, __uint_as_float(bw_[i] & 0xffff0000u) * inv * ip1);
                              xk[i] = pk2(__uint_as_float(kw_[i] << 16) * ip0, __uint_as_float(kw_[i] & 0xffff0000u) * ip1); }
                          oa[p4] = (u32x4){xa[0], xa[1], xa[2], xa[3]}; orr[p4] = (u32x4){xr[0], xr[1], xr[2], xr[3]}; ob_[p4] = (u32x4){xb[0], xb[1], xb[2], xb[3]}; ok_[p4] = (u32x4){xk[0], xk[1], xk[2], xk[3]}; }
                      __builtin_amdgcn_wave_barrier(); asm volatile("s_waitcnt lgkmcnt(0)" ::: "memory");
#pragma unroll
                      for (int p4 = 0; p4 < 4; ++p4) { const int c = p4 * 8 + tk, o = c * 72 + part * 8;
                          *(__attribute__((address_space(3))) u32x4*)(At + o) = oa[p4]; *(__attribute__((address_space(3))) u32x4*)(Rt + o) = orr[p4]; *(__attribute__((address_space(3))) u32x4*)(Bt + o) = ob_[p4];
                          *(__attribute__((address_space(3))) u32x4*)(Kt + o) = ok_[p4]; *(__attribute__((address_space(3))) u32x4*)(Vv + o) = qv[p4]; } }
                    __builtin_amdgcn_wave_barrier(); asm volatile("s_waitcnt lgkmcnt(0)" ::: "memory");
                    const f32x16 zero16 = {0.f, 0.f, 0.f, 0.f, 0.f, 0.f, 0.f, 0.f, 0.f, 0.f, 0.f, 0.f, 0.f, 0.f, 0.f, 0.f};
                    f32x16 X = zero16, Yt = zero16;
#pragma unroll
                    for (int ks = 0; ks < 4; ++ks) { const bf16x8_t fa = ldrow(At, r32, ks, hh), fb = ldrow(Bt, r32, ks, hh); X = mm32(fa, fb, X); Yt = mm32(fb, fa, Yt); }
#pragma unroll
                    for (int e = 0; e < 16; ++e) { const int ri = rowidx(e, hh); X[e] = (r32 < ri) ? X[e] : 0.f; Yt[e] = (ri < r32) ? Yt[e] : 0.f; }
                    f32x16 TY = Yt;
#pragma unroll
                    for (int e = 0; e < 16; ++e) TY[e] += (rowidx(e, hh) == r32) ? 1.f : 0.f;
#pragma unroll 1
                    for (int it = 0; it < 4; ++it) {
                        const bf16x8_t x0 = accop<0>(X), x1 = accop<1>(X), y0 = accop<0>(Yt), y1 = accop<1>(Yt);
                        f32x16 Xn = mm32(y0, x0, zero16); Xn = mm32(y1, x1, Xn);
                        f32x16 Yn = mm32(x0, y0, zero16); Yn = mm32(x1, y1, Yn);
                        X = Xn; Yt = Yn;
                        const bf16x8_t p0 = accop<0>(X), p1 = accop<1>(X), t0_ = accop<0>(TY), t1_ = accop<1>(TY);
                        TY = mm32(p0, t0_, TY); TY = mm32(p1, t1_, TY);
                    }
                    const bf16x8_t ty0 = accop<0>(TY), ty1 = accop<1>(TY);
                    unsigned char* rec = SCN + (size_t)item * 24576;
                    const bf16x8_t v00 = ldpermcol<0>(Vv, r32, hh), v01 = ldpermcol<1>(Vv, r32, hh), v10 = ldpermcol<0>(Vv, 32 + r32, hh), v11 = ldpermcol<1>(Vv, 32 + r32, hh);
                    f32x16 U0a, U0b;
                    { f32x16 G2T = zero16;
#pragma unroll
                      for (int ks = 0; ks < 4; ++ks) G2T = mm32(ldrow(Kt, r32, ks, hh), ldrow(At, r32, ks, hh), G2T);
#pragma unroll
                      for (int e = 0; e < 16; ++e) G2T[e] = (rowidx(e, hh) < r32) ? G2T[e] : 0.f;
                      const bf16x8_t g0 = accop<0>(G2T), g1 = accop<1>(G2T);
                      f32x16 Za = mm32(g0, v00, zero16); Za = mm32(g1, v01, Za); f32x16 Zb = mm32(g0, v10, zero16); Zb = mm32(g1, v11, Zb);
                      U0a = mm32(ty0, accop<0>(Za), zero16); U0a = mm32(ty1, accop<1>(Za), U0a); U0b = mm32(ty0, accop<0>(Zb), zero16); U0b = mm32(ty1, accop<1>(Zb), U0b); }
                    const bf16x8_t ua0 = accop<0>(U0a), ua1 = accop<1>(U0a), ub0 = accop<0>(U0b), ub1 = accop<1>(U0b);
                    f32x16 G3T = zero16;
                    { f32x16 G4T = zero16;
#pragma unroll
                      for (int ks = 0; ks < 4; ++ks) { const bf16x8_t fr = ldrow(Rt, r32, ks, hh); G3T = mm32(ldrow(Bt, r32, ks, hh), fr, G3T); G4T = mm32(ldrow(Kt, r32, ks, hh), fr, G4T); }
#pragma unroll
                      for (int e = 0; e < 16; ++e) { const bool keep = rowidx(e, hh) <= r32; G3T[e] = keep ? G3T[e] : 0.f; G4T[e] = keep ? G4T[e] : 0.f; }
                      const bf16x8_t g30 = accop<0>(G3T), g31 = accop<1>(G3T), g40 = accop<0>(G4T), g41 = accop<1>(G4T);
                      f32x16 Ya = mm32(g30, ua0, zero16); Ya = mm32(g31, ua1, Ya); Ya = mm32(g40, v00, Ya); Ya = mm32(g41, v01, Ya);
                      f32x16 Yb = mm32(g30, ub0, zero16); Yb = mm32(g31, ub1, Yb); Yb = mm32(g40, v10, Yb); Yb = mm32(g41, v11, Yb);
                      u32x4 o0, o1;
                      o0.x = cvtpk(Ya[0], Ya[1]); o0.y = cvtpk(Ya[2], Ya[3]); o0.z = cvtpk(Ya[4], Ya[5]); o0.w = cvtpk(Ya[6], Ya[7]);
                      o1.x = cvtpk(Ya[8], Ya[9]); o1.y = cvtpk(Ya[10], Ya[11]); o1.z = cvtpk(Ya[12], Ya[13]); o1.w = cvtpk(Ya[14], Ya[15]);
                      *(u32x4*)(rec + 12288 + 4096 + lane * 32) = o0; *(u32x4*)(rec + 12288 + 4096 + lane * 32 + 16) = o1;
                      o0.x = cvtpk(Yb[0], Yb[1]); o0.y = cvtpk(Yb[2], Yb[3]); o0.z = cvtpk(Yb[4], Yb[5]); o0.w = cvtpk(Yb[6], Yb[7]);
                      o1.x = cvtpk(Yb[8], Yb[9]); o1.y = cvtpk(Yb[10], Yb[11]); o1.z = cvtpk(Yb[12], Yb[13]); o1.w = cvtpk(Yb[14], Yb[15]);
                      *(u32x4*)(rec + 12288 + 6144 + 4096 + lane * 32) = o0; *(u32x4*)(rec + 12288 + 6144 + 4096 + lane * 32 + 16) = o1; }
                    f32x16 Wa0 = mm32(ty0, ldpermcol<0>(At, r32, hh), zero16); Wa0 = mm32(ty1, ldpermcol<1>(At, r32, hh), Wa0);
                    f32x16 Wa1 = mm32(ty0, ldpermcol<0>(At, 32 + r32, hh), zero16); Wa1 = mm32(ty1, ldpermcol<1>(At, 32 + r32, hh), Wa1);
                    const bf16x8_t wa00 = accop<0>(Wa0), wa01 = accop<1>(Wa0), wa10 = accop<0>(Wa1), wa11 = accop<1>(Wa1);
                    { const bf16x8_t g30 = accop<0>(G3T), g31 = accop<1>(G3T);
                      f32x16 Ra = mm32(wa00, g30, zero16); Ra = mm32(wa01, g31, Ra); f32x16 Rb_ = mm32(wa10, g30, zero16); Rb_ = mm32(wa11, g31, Rb_);
#pragma unroll
                      for (int e = 0; e < 16; ++e) { const int kr = rowidx(e, hh); Ra[e] += bf2f(Rt[r32 * 72 + kr]); Rb_[e] += bf2f(Rt[r32 * 72 + 32 + kr]); }
                      *(bf16x8_t*)(rec + 8192 + 0 * 1024 + lane * 16) = accop<0>(Ra); *(bf16x8_t*)(rec + 8192 + 1 * 1024 + lane * 16) = accop<1>(Ra);
                      *(bf16x8_t*)(rec + 8192 + 2 * 1024 + lane * 16) = accop<0>(Rb_); *(bf16x8_t*)(rec + 8192 + 3 * 1024 + lane * 16) = accop<1>(Rb_); }
                    const bf16x8_t b00 = ldpermcol<0>(Bt, r32, hh), b01 = ldpermcol<1>(Bt, r32, hh), b10 = ldpermcol<0>(Bt, 32 + r32, hh), b11 = ldpermcol<1>(Bt, 32 + r32, hh);
                    { const float pc0 = PCs[r32], pc1 = PCs[32 + r32];
#pragma unroll
                      for (int ij = 0; ij < 4; ++ij) { const int i = ij >> 1, j = ij & 1;
                          f32x16 M = mm32(i ? wa10 : wa00, j ? b10 : b00, zero16); M = mm32(i ? wa11 : wa01, j ? b11 : b01, M);
#pragma unroll
                          for (int e = 0; e < 16; ++e) { float m = M[e]; if (i == j) m += (rowidx(e, hh) == r32) ? 1.f : 0.f; M[e] = m * (j ? pc1 : pc0); }
                          *(bf16x8_t*)(rec + (ij * 2 + 0) * 1024 + lane * 16) = accop<0>(M); *(bf16x8_t*)(rec + (ij * 2 + 1) * 1024 + lane * 16) = accop<1>(M); } }
                    { const bf16x8_t k00 = ldpermcol<0>(Kt, r32, hh), k01 = ldpermcol<1>(Kt, r32, hh), k10 = ldpermcol<0>(Kt, 32 + r32, hh), k11 = ldpermcol<1>(Kt, 32 + r32, hh);
#pragma unroll
                      for (int ju = 0; ju < 4; ++ju) { const int j = ju >> 1, u = ju & 1;
                          f32x16 Dm = mm32(j ? b10 : b00, u ? ub0 : ua0, zero16); Dm = mm32(j ? b11 : b01, u ? ub1 : ua1, Dm);
                          Dm = mm32(j ? k10 : k00, u ? v10 : v00, Dm); Dm = mm32(j ? k11 : k01, u ? v11 : v01, Dm);
#pragma unroll
                          for (int e = 0; e < 16; ++e) Dm[e] *= PCs[32 * j + rowidx(e, hh)];
                          u32x4 o0, o1;
                          o0.x = cvtpk(Dm[0], Dm[1]); o0.y = cvtpk(Dm[2], Dm[3]); o0.z = cvtpk(Dm[4], Dm[5]); o0.w = cvtpk(Dm[6], Dm[7]);
                          o1.x = cvtpk(Dm[8], Dm[9]); o1.y = cvtpk(Dm[10], Dm[11]); o1.z = cvtpk(Dm[12], Dm[13]); o1.w = cvtpk(Dm[14], Dm[15]);
                          *(u32x4*)(rec + 12288 + u * 6144 + j * 2048 + lane * 32) = o0; *(u32x4*)(rec + 12288 + u * 6144 + j * 2048 + lane * 32 + 16) = o1; } }
                }
            }
        }
        { XcdBarrier xb_ = xbar; asm volatile("" : "+s"(xb_.bar)); xcd_barrier<false>(xb_); }
        if (IN(pb + 3)) { PHASE_IDS
            const int r32 = lane & 31, hh = lane >> 5;
            constexpr int SLOT = 18432, NCH = SEQ / 32, NSL = 7, AHEAD = 6;
            if (G > BATCH * NH * 2) { if (bx >= BATCH * NH * 2) convert_tables_fp6(INP(27), INP(28), U8, V8, USc, VSc, l, (bx - BATCH * NH * 2) * NWAVES + wave, (G - BATCH * NH * 2) * NWAVES, lane); }
            else convert_tables_fp6(INP(27), INP(28), U8, V8, USc, VSc, l, bx * NWAVES + wave, G * NWAVES, lane);
            for (int un = bx; un < BATCH * NH * 2; un += G) {
                const int bh = un >> 1, u = un & 1, b = bh >> 3, h = bh & 7;
                __syncthreads();
                const unsigned char* recs = SCN + (size_t)bh * NCH * 24576;
                const int lw = wave - 2;
#define S2_DMA(chunk_) do { if (wave >= 2) { LAS unsigned char* sl = lds + ((chunk_) % NSL) * SLOT; const unsigned char* rp = recs + (size_t)(chunk_) * 24576 + lane * 16; \
                    _Pragma("unroll") for (int q_ = 0; q_ < 3; ++q_) { const int p_ = lw * 3 + q_; const int so_ = p_ < 12 ? p_ * 1024 : 12288 + u * 6144 + (p_ - 12) * 1024; \
                        __builtin_amdgcn_global_load_lds((const unsigned*)(rp + so_), (LAS unsigned*)(sl + p_ * 1024), 16, 0, 0); } } } while (0)
#pragma unroll 1
                for (int c0 = 0; c0 < AHEAD; ++c0) S2_DMA(c0);
                asm volatile("s_waitcnt vmcnt(15)" ::: "memory");
                __builtin_amdgcn_s_barrier();
                f32x16 X0, X1;
                { float z_ = 0.f; asm volatile("" : "+v"(z_));
#pragma unroll
                for (int e = 0; e < 16; ++e) { X0[e] = z_; X1[e] = z_; } }
#define S2_FRAG(off) (*(const __attribute__((address_space(3))) bf16x8_t*)(sl + (off) + lane * 16))
#define S2_UNPK(dst, off) do { const u32x4 a0 = *(const LAS u32x4*)(sl + (off) + lane * 32), a1 = *(const LAS u32x4*)(sl + (off) + lane * 32 + 16); const unsigned wv[8] = {a0.x, a0.y, a0.z, a0.w, a1.x, a1.y, a1.z, a1.w}; \
                    _Pragma("unroll") for (int q = 0; q < 8; ++q) { (dst)[2 * q] = __uint_as_float(wv[q] << 16); (dst)[2 * q + 1] = __uint_as_float(wv[q] & 0xffff0000u); } } while (0)
#pragma unroll 1
                for (int n = 0; n < NCH; ++n) {
                    if (n + AHEAD < NCH) S2_DMA(n + AHEAD);
                    if (wave == 0) {
                        const LAS unsigned char* sl = lds + (n % NSL) * SLOT;
                        const bf16x8_t x00 = accop<0>(X0), x01 = accop<1>(X0), x10 = accop<0>(X1), x11 = accop<1>(X1);
                        f32x16 Yc, N0, N1;
                        S2_UNPK(Yc, 12288 + 4096); S2_UNPK(N0, 12288); S2_UNPK(N1, 12288 + 2048);
                        Yc = mm32(S2_FRAG(8192 + 0 * 1024), x00, Yc); Yc = mm32(S2_FRAG(8192 + 1 * 1024), x01, Yc); Yc = mm32(S2_FRAG(8192 + 2 * 1024), x10, Yc); Yc = mm32(S2_FRAG(8192 + 3 * 1024), x11, Yc);
                        N0 = mm32(S2_FRAG((0 * 2 + 0) * 1024), x00, N0); N0 = mm32(S2_FRAG((0 * 2 + 1) * 1024), x01, N0); N0 = mm32(S2_FRAG((2 * 2 + 0) * 1024), x10, N0); N0 = mm32(S2_FRAG((2 * 2 + 1) * 1024), x11, N0);
                        N1 = mm32(S2_FRAG((1 * 2 + 0) * 1024), x00, N1); N1 = mm32(S2_FRAG((1 * 2 + 1) * 1024), x01, N1); N1 = mm32(S2_FRAG((3 * 2 + 0) * 1024), x10, N1); N1 = mm32(S2_FRAG((3 * 2 + 1) * 1024), x11, N1);
                        X0 = N0; X1 = N1;
                        float* yp = Y + ((size_t)b * SEQ + (size_t)n * 32) * RW + h * HS + u * 32 + r32;
#pragma unroll
                        for (int e = 0; e < 16; ++e) yp[(size_t)rowidx(e, hh) * RW] = Yc[e];
                        asm volatile("s_waitcnt lgkmcnt(0)" ::: "memory");
                    } else if (wave >= 2) {
                        const int younger = (NCH - 1 - (n + 1)) < (AHEAD - 1) ? (NCH - 1 - (n + 1)) : (AHEAD - 1);
                        if (younger >= 5) asm volatile("s_waitcnt vmcnt(15)" ::: "memory"); else if (younger == 4) asm volatile("s_waitcnt vmcnt(12)" ::: "memory"); else if (younger == 3) asm volatile("s_waitcnt vmcnt(9)" ::: "memory");
                        else if (younger == 2) asm volatile("s_waitcnt vmcnt(6)" ::: "memory"); else if (younger == 1) asm volatile("s_waitcnt vmcnt(3)" ::: "memory"); else asm volatile("s_waitcnt vmcnt(0)" ::: "memory");
                    }
                    __builtin_amdgcn_s_barrier();
                }
#undef S2_FRAG
#undef S2_UNPK
#undef S2_DMA
            }
        }
        SEAM(pb + 3);

        if (IN(pb + 4)) { PHASE_IDS
            const int c8 = (tid & 63) * 8, hd = (tid & 63) >> 3, tsub = tid >> 6;
            const f32x4 lg0 = *(const f32x4*)(INP(19) + l * RW + c8), lg1 = *(const f32x4*)(INP(19) + l * RW + c8 + 4), lb0 = *(const f32x4*)(INP(20) + l * RW + c8), lb1 = *(const f32x4*)(INP(20) + l * RW + c8 + 4);
            for (int tile = bx; tile < T / 8; tile += G) {
                const int t = tile * 8 + tsub; const size_t o = (size_t)t * RW + c8;
                const f32x4 y0 = *(const f32x4*)(Y + o), y1 = *(const f32x4*)(Y + o + 4); const u32x4 gq = *(const u32x4*)(Gb + o), vq = *(const u32x4*)(BGb + o); const float bsum = BSUM[(size_t)t * NH + hd];
                float sm = (y0.x + y0.y) + (y0.z + y0.w) + (y1.x + y1.y) + (y1.z + y1.w);
                sm += dppf<0xB1>(sm); sm += dppf<0x4E>(sm); sm += dppf<0x141>(sm);
                const float mean = sm * (1.f / 64.f);
                const f32x4 d0 = y0 - mean, d1 = y1 - mean;
                float sq = (d0.x * d0.x + d0.y * d0.y) + (d0.z * d0.z + d0.w * d0.w) + (d1.x * d1.x + d1.y * d1.y) + (d1.z * d1.z + d1.w * d1.w);
                sq += dppf<0xB1>(sq); sq += dppf<0x4E>(sq); sq += dppf<0x141>(sq);
                const float rs = rsqrtf(sq * (1.f / 64.f) + GN_EPS);
                const f32x4 n0 = d0 * rs * lg0 + lb0, n1 = d1 * rs * lg1 + lb1;
                const unsigned gw_[4] = {gq.x, gq.y, gq.z, gq.w}, vw_[4] = {vq.x, vq.y, vq.z, vq.w}; const float nn[8] = {n0.x, n0.y, n0.z, n0.w, n1.x, n1.y, n1.z, n1.w}; unsigned ow[4];
#pragma unroll
                for (int i = 0; i < 4; ++i) { const float g0 = __uint_as_float(gw_[i] << 16), g1 = __uint_as_float(gw_[i] & 0xffff0000u), v0 = __uint_as_float(vw_[i] << 16), v1 = __uint_as_float(vw_[i] & 0xffff0000u);
                    ow[i] = pk2(nn[2 * i] * g0 + v0 * bsum, nn[2 * i + 1] * g1 + v1 * bsum); }
                *(u32x4*)(MIX + (size_t)t * D + c8) = (u32x4){ow[0], ow[1], ow[2], ow[3]};
            }
        }
        SEAM(pb + 4);
        if (IN(pb + 5)) { PHASE_IDS
            pg8::Gemm g{MIX, WoutT + (size_t)l * D * D, T, D, D}; pg8::StaticOrder S; S.init(T, D, G, bx);
            pg8::EpiResGate E{xin, X, modl + 2 * D};
            pg8::gemm_phase<pg8::EpiResGate, pg8::StaticOrder, true, true>(lds, g, S, E, tid); }
        SEAM(pb + 5);
        if (IN(pb + 6)) { PHASE_IDS const float* gamma = INP(24) + l * D;
            for (int row = gw; row < T; row += NGW) { const int b = row / SEQ; norm_mod_row(X + (size_t)row * D, gamma, modl + (size_t)b * 6 * D + 3 * D, modl + (size_t)b * 6 * D + 4 * D, H + (size_t)row * D, lane); } }
        SEAM(pb + 6);
        if (IN(pb + 7)) { PHASE_IDS
            pg8::Gemm g{H, PqT + (size_t)l * PH * PQ * D, T, PH * PQ, D}; pg8::StaticOrder S; S.init(T, PH * PQ, G, bx);
            pg8::EpiBf16<0> E{Q, PH * PQ, nullptr, 0, 0, 1.f};
            pg8::gemm_phase<pg8::EpiBf16<0>, pg8::StaticOrder, true, true>(lds, g, S, E, tid); }
        SEAM(pb + 7);

        if (IN(pb + 8)) { PHASE_IDS
            const bf16* KEYSl = KEYS + (size_t)l * PH * 2 * NKEYS * PHALF;
            LAS unsigned char* scr = lds + wave * 2048 + lane * 32;
            constexpr int KST = 136;
            lbf16* kl = (lbf16*)(lds + 16384);
            const int r = lane & 31, hh = lane >> 5;
            for (int item = bx; item < (T / 256) * PH; item += G) {
                const int h = item & 7, tok = (item >> 3) * 256 + wave * 32 + r;
                __syncthreads();
                { u32x4 kq[8];
#pragma unroll
                  for (int q = 0; q < 8; ++q) { const int ch = tid + q * NTHR; kq[q] = *(const u32x4*)(KEYSl + (size_t)(h * 2) * NKEYS * PHALF + (size_t)ch * 8); }
#pragma unroll
                  for (int q = 0; q < 8; ++q) { const int ch = tid + q * NTHR, row = ch >> 4, cc = ch & 15; *(__attribute__((address_space(3))) u32x4*)(kl + row * KST + cc * 8) = kq[q]; } }
                __syncthreads();
                unsigned sp0[16], sp1[16];
#pragma unroll
                for (int e = 0; e < 16; ++e) { sp0[e] = 0u; sp1[e] = 0u; }
#pragma unroll 1
                for (int p = 0; p < 2; ++p) {
                    const bf16* qp = Q + (size_t)tok * (PH * PQ) + h * PQ + p * PHALF + 8 * hh;
                    const lbf16* kp_ = kl + (p * NKEYS + r) * KST + 8 * hh;
                    bf16x8_t bq[8];
#pragma unroll
                    for (int ks = 0; ks < 8; ++ks) bq[ks] = *(const bf16x8_t*)(qp + ks * 16);
                    unsigned best[16];
#pragma unroll
                    for (int e = 0; e < 16; ++e) best[e] = 0u;
#pragma unroll 1
                    for (int kt = 0; kt < 4; ++kt) {
                        f32x16 acc;
#pragma unroll
                        for (int e = 0; e < 16; ++e) acc[e] = 0.f;
#pragma unroll
                        for (int ks = 0; ks < 8; ++ks) { const bf16x8_t ak = *(const __attribute__((address_space(3))) bf16x8_t*)(kp_ + kt * 32 * KST + ks * 16); acc = __builtin_amdgcn_mfma_f32_32x32x16_bf16(ak, bq[ks], acc, 0, 0, 0); }
                        unsigned g[16];
#pragma unroll
                        for (int e = 0; e < 16; ++e) g[e] = pack_key7(acc[e], kt * 32 + (e & 3) + 8 * (e >> 2) + 4 * hh);
                        sort16_desc(g);
                        merge_top16(best, g);
                    }
                    unsigned ob[16];
#pragma unroll
                    for (int e = 0; e < 16; ++e) ob[e] = shflxu(best[e], lane, 32);
                    merge_top16(best, ob);
#pragma unroll
                    for (int e = 0; e < 16; ++e) { sp0[e] = p == 0 ? best[e] : sp0[e]; sp1[e] = p == 0 ? sp1[e] : best[e]; }
                }
                unsigned c2[32];
                stage2_cands(sp0, sp1, hh, c2);
                sort16_desc(c2); sort16_desc(c2 + 16); merge_top16(c2, c2 + 16);
                { unsigned ob[16];
#pragma unroll
                  for (int e = 0; e < 16; ++e) ob[e] = shflxu(c2[e], lane, 32);
                  merge_top16(c2, ob); }
#pragma unroll
                for (int e = 0; e < 16; e += 4) {
                    *(LAS unsigned*)(scr + e) = (127u - (sp0[e] & 127u)) | ((127u - (sp0[e + 1] & 127u)) << 8) | ((127u - (sp0[e + 2] & 127u)) << 16) | ((127u - (sp0[e + 3] & 127u)) << 24);
                    *(LAS unsigned*)(scr + 16 + e) = (127u - (sp1[e] & 127u)) | ((127u - (sp1[e + 1] & 127u)) << 8) | ((127u - (sp1[e + 2] & 127u)) << 16) | ((127u - (sp1[e + 3] & 127u)) << 24); }
                asm volatile("s_waitcnt lgkmcnt(0)" ::: "memory");
                float sm[16]; int ex[16];
#pragma unroll
                for (int e = 0; e < 16; ++e) { const unsigned key = c2[e]; sm[e] = unpack_key8(key); const int i0 = (key >> 4) & 15, j0 = key & 15; ex[e] = (int)scr[i0] * NKEYS + (int)scr[16 + j0]; }
                float den = 0.f;
#pragma unroll
                for (int e = 0; e < 16; ++e) { sm[e] = expf(sm[e] - unpack_key8(c2[0])); den += sm[e]; }
                const float inv = 1.f / den;
                if (hh == 0) {
                    int* ip = IDX + (size_t)tok * NE + h * TOPK; float* gp = GATE + (size_t)tok * NE + h * TOPK;
#pragma unroll
                    for (int e = 0; e < 16; e += 4) { *(int4*)(ip + e) = make_int4(ex[e], ex[e + 1], ex[e + 2], ex[e + 3]); *(f32x4*)(gp + e) = (f32x4){sm[e] * inv, sm[e + 1] * inv, sm[e + 2] * inv, sm[e + 3] * inv}; }
                }
                asm volatile("s_waitcnt lgkmcnt(0)" ::: "memory");
            }
        }
        SEAM(pb + 8);

        if (IN(pb + 9)) { PHASE_IDS
            const unsigned char* Ul = U8 + (size_t)l * NEXP * ROWB; const unsigned char* Vtl = V8 + (size_t)l * NEXP * ROWB; const float* usl = USc + l * NEXP; const float* vsl = VSc + l * NEXP; const float* lnf = INP(29);
            const bool fin = (l == DEPTH - 1);
            typedef float f32x2_t __attribute__((ext_vector_type(2)));
            const __amdgpu_buffer_rsrc_t ru = __builtin_amdgcn_make_buffer_rsrc((void*)Ul, 0, NEXP * ROWB, 0x00020000), rv = __builtin_amdgcn_make_buffer_rsrc((void*)Vtl, 0, NEXP * ROWB, 0x00020000);
            typedef float f32x32_t __attribute__((ext_vector_type(32))); typedef unsigned u32x3_t __attribute__((ext_vector_type(3))); typedef unsigned u32x6_t __attribute__((ext_vector_type(6)));
            LAS float* pl = (LAS float*)(lds + wave * 18432);
            constexpr int TW = 4;
            for (int tb = gw; tb < T; tb += TW * NGW) {
#define TOKV(k) (tb + (k) * NGW < T)
#define TOK(k) (TOKV(k) ? tb + (k) * NGW : tb)
                unsigned si[TW][2]; float sus[TW][2], sgv[TW][2];
                LAS u32x4* hl = (LAS u32x4*)(pl + 32 * 68);
                { float g0[TW], g1[TW]; int lane_s; asm volatile("v_mbcnt_lo_u32_b32 %0, -1, 0\n\tv_mbcnt_hi_u32_b32 %0, -1, %0" : "=v"(lane_s));
#pragma unroll
                  for (int k = 0; k < TW; ++k) { const size_t o = (size_t)TOK(k) * NE + lane_s; si[k][0] = ((unsigned)IDX[o] << 7) | (unsigned)lane_s; si[k][1] = ((unsigned)IDX[o + 64] << 7) | (unsigned)(64 + lane_s); g0[k] = GATE[o]; g1[k] = GATE[o + 64]; }
#pragma unroll
                  for (int kk = 2; kk <= 128; kk <<= 1) {
#pragma unroll
                      for (int j = kk >> 1; j > 0; j >>= 1) {
                          if (j == 64) {
#pragma unroll
                              for (int k = 0; k < TW; ++k) { const unsigned a = si[k][0], b = si[k][1]; si[k][0] = a < b ? a : b; si[k][1] = a < b ? b : a; } }
                          else { const bool lower = (lane_s & j) == 0, tm0 = lower == ((lane_s & kk) == 0), tm1 = lower == (((lane_s + 64) & kk) == 0); const int pa = (lane_s ^ j) << 2;
#pragma unroll
                              for (int k = 0; k < TW; ++k) { const unsigned a = si[k][0], b = si[k][1], p0 = (unsigned)__builtin_amdgcn_ds_bpermute(pa, (int)a), p1 = (unsigned)__builtin_amdgcn_ds_bpermute(pa, (int)b);
                                  si[k][0] = tm0 ? (a < p0 ? a : p0) : (a < p0 ? p0 : a); si[k][1] = tm1 ? (b < p1 ? b : p1) : (b < p1 ? p1 : b); } }
                          __builtin_amdgcn_sched_barrier(0);
                      } }
#pragma unroll
                  for (int k = 0; k < TW; ++k) {
#pragma unroll
                      for (int r = 0; r < 2; ++r) { const unsigned key = si[k][r]; const int a = (int)(key & 63u) << 2; const int ga = __builtin_amdgcn_ds_bpermute(a, __float_as_int(g0[k])), gb = __builtin_amdgcn_ds_bpermute(a, __float_as_int(g1[k]));
                          const unsigned ix = key >> 7; si[k][r] = ix; sus[k][r] = usl[ix]; sgv[k][r] = __int_as_float((key & 64u) ? gb : ga) * vsl[ix]; } }
#pragma unroll
                  for (int k = 0; k < TW; ++k) { const bf16* hr = H + (size_t)TOK(k) * D + lane_s * 16; hl[(k * 2) * 64 + lane_s] = *(const u32x4*)hr; hl[(k * 2 + 1) * 64 + lane_s] = *(const u32x4*)(hr + 8); }
                }
                __builtin_amdgcn_sched_barrier(0);
#define ROWLD(dst, rs, ixv, ln) dst = __builtin_amdgcn_raw_buffer_load_b96(rs, voff, __builtin_amdgcn_readlane((int)(ixv), (ln)) * ROWB, 0)
#define LOADQ(buf, rs, ixv, ln0) do { _Pragma("unroll") for (int j_ = 0; j_ < 8; ++j_) ROWLD((buf)[j_], rs, ixv, (ln0) + j_); __builtin_amdgcn_sched_barrier(0); } while (0)
#define CVT2(a, b) const f32x32_t f_ = __builtin_amdgcn_cvt_scalef32_pk32_f32_fp6((u32x6_t){(a).x, (a).y, (a).z, (b).x, (b).y, (b).z}, 1.0f)
#define PR(i) __builtin_shufflevector(f_, f_, 2 * (i), 2 * (i) + 1)
#define DOTQ(buf, e0) do { _Pragma("unroll") for (int j_ = 0; j_ < 8; j_ += 2) { CVT2((buf)[j_], (buf)[j_ + 1]); \
                        f32x2_t a_ = hf2[0] * PR(0), b_ = hf2[0] * PR(8); a_ += hf2[1] * PR(1); b_ += hf2[1] * PR(9); a_ += hf2[2] * PR(2); b_ += hf2[2] * PR(10); a_ += hf2[3] * PR(3); b_ += hf2[3] * PR(11); \
                        a_ += hf2[4] * PR(4); b_ += hf2[4] * PR(12); a_ += hf2[5] * PR(5); b_ += hf2[5] * PR(13); a_ += hf2[6] * PR(6); b_ += hf2[6] * PR(14); a_ += hf2[7] * PR(7); b_ += hf2[7] * PR(15); \
                        pl[((e0) + j_) * 68 + lane_u] = a_.x + a_.y; pl[((e0) + j_ + 1) * 68 + lane_u] = b_.x + b_.y; __builtin_amdgcn_sched_barrier(0); } } while (0)
#define AXPYQ(buf, k, cfv, ln0) do { _Pragma("unroll") for (int j_ = 0; j_ < 8; j_ += 2) { CVT2((buf)[j_], (buf)[j_ + 1]); \
                        const float ca = __int_as_float(__builtin_amdgcn_readlane(__float_as_int(cfv), (ln0) + j_)), cb = __int_as_float(__builtin_amdgcn_readlane(__float_as_int(cfv), (ln0) + j_ + 1)); \
                        acc2[k][0] += ca * PR(0); acc2[k][1] += ca * PR(1); acc2[k][2] += ca * PR(2); acc2[k][3] += ca * PR(3); acc2[k][4] += ca * PR(4); acc2[k][5] += ca * PR(5); acc2[k][6] += ca * PR(6); acc2[k][7] += ca * PR(7); \
                        acc2[k][0] += cb * PR(8); acc2[k][1] += cb * PR(9); acc2[k][2] += cb * PR(10); acc2[k][3] += cb * PR(11); acc2[k][4] += cb * PR(12); acc2[k][5] += cb * PR(13); acc2[k][6] += cb * PR(14); acc2[k][7] += cb * PR(15); __builtin_amdgcn_sched_barrier(0); } } while (0)
                u32x3_t ba[8], bb_[8];
                int lane_u; asm volatile("v_mbcnt_lo_u32_b32 %0, -1, 0\n\tv_mbcnt_hi_u32_b32 %0, -1, %0" : "=v"(lane_u)); const int voff = lane_u * 12;
                LOADQ(ba, ru, si[0][0], 0);
#pragma unroll 1
                for (int c = 0; c < 16; ++c) {
                    const int lb = (c & 7) * 8; const bool r1 = c >= 8;
#pragma unroll
                    for (int k = 0; k < TW; ++k) {
                        f32x2_t hf2[8];
                        { const u32x4 h0 = hl[(k * 2) * 64 + lane_u], h1 = hl[(k * 2 + 1) * 64 + lane_u];
                          hf2[0] = (f32x2_t){__uint_as_float(h0.x << 16), __uint_as_float(h0.x & 0xffff0000u)}; hf2[1] = (f32x2_t){__uint_as_float(h0.y << 16), __uint_as_float(h0.y & 0xffff0000u)};
                          hf2[2] = (f32x2_t){__uint_as_float(h0.z << 16), __uint_as_float(h0.z & 0xffff0000u)}; hf2[3] = (f32x2_t){__uint_as_float(h0.w << 16), __uint_as_float(h0.w & 0xffff0000u)};
                          hf2[4] = (f32x2_t){__uint_as_float(h1.x << 16), __uint_as_float(h1.x & 0xffff0000u)}; hf2[5] = (f32x2_t){__uint_as_float(h1.y << 16), __uint_as_float(h1.y & 0xffff0000u)};
                          hf2[6] = (f32x2_t){__uint_as_float(h1.z << 16), __uint_as_float(h1.z & 0xffff0000u)}; hf2[7] = (f32x2_t){__uint_as_float(h1.w << 16), __uint_as_float(h1.w & 0xffff0000u)}; }
                        if (k & 1) { if (k < TW - 1) LOADQ(ba, ru, r1 ? si[k + 1][1] : si[k + 1][0], lb); else { const int cn = (c + 1) & 15; const __amdgpu_buffer_rsrc_t rn = c < 15 ? ru : rv; LOADQ(ba, rn, (cn >= 8) ? si[0][1] : si[0][0], (cn & 7) * 8); } DOTQ(bb_, k * 8); }
                        else { LOADQ(bb_, ru, r1 ? si[k + 1][1] : si[k + 1][0], lb); DOTQ(ba, k * 8); }
                    }
                    __builtin_amdgcn_wave_barrier(); asm volatile("s_waitcnt lgkmcnt(0)" ::: "memory");
                    float dsum;
                    { const LAS float* rp = pl + (lane_u & 31) * 68 + (lane_u >> 5) * 32; f32x4 s4 = *(const LAS f32x4*)rp;
#pragma unroll
                      for (int j = 1; j < 8; ++j) s4 += *(const LAS f32x4*)(rp + j * 4);
                      dsum = (s4.x + s4.y) + (s4.z + s4.w); }
                    dsum += shflx(dsum, lane_u, 32);
                    __builtin_amdgcn_wave_barrier(); asm volatile("s_waitcnt lgkmcnt(0)" ::: "memory");
                    const bool home = (lane_u >> 3) == (c & 7);
#pragma unroll
                    for (int k = 0; k < TW; ++k) {
                        const float dv = __int_as_float(__builtin_amdgcn_ds_bpermute((k * 8 + (lane_u & 7)) << 2, __float_as_int(dsum)));
                        const float cf = (r1 ? sgv[k][1] : sgv[k][0]) * gelu_erf(dv * (r1 ? sus[k][1] : sus[k][0]));
                        if (r1) sgv[k][1] = home ? cf : sgv[k][1]; else sgv[k][0] = home ? cf : sgv[k][0]; }
                    __builtin_amdgcn_sched_barrier(0);
                }
                f32x2_t acc2[TW][8];
#pragma unroll
                for (int k = 0; k < TW; ++k) {
#pragma unroll
                    for (int i = 0; i < 8; ++i) acc2[k][i] = (f32x2_t){0.f, 0.f}; }
#pragma unroll 1
                for (int c = 0; c < 16; ++c) {
                    const int lb = (c & 7) * 8; const bool r1 = c >= 8;
#pragma unroll
                    for (int k = 0; k < TW; ++k) {
                        const float cfk = r1 ? sgv[k][1] : sgv[k][0];
                        if (k & 1) { if (k < TW - 1) LOADQ(ba, rv, r1 ? si[k + 1][1] : si[k + 1][0], lb); else { const int cn = (c + 1) & 15; LOADQ(ba, rv, (cn >= 8) ? si[0][1] : si[0][0], (cn & 7) * 8); }     AXPYQ(bb_, k, cfk, lb); }
                        else { LOADQ(bb_, rv, r1 ? si[k + 1][1] : si[k + 1][0], lb); AXPYQ(ba, k, cfk, lb); }
                    }
                }
#undef ROWLD
#undef LOADQ
#undef CVT2
#undef PR
#undef DOTQ
#undef AXPYQ
                { int ln; asm volatile("v_mbcnt_lo_u32_b32 %0, -1, 0\n\tv_mbcnt_hi_u32_b32 %0, -1, %0" : "=v"(ln));
                  LAS f32x4* al = (LAS f32x4*)pl + ln;
#pragma unroll
                  for (int k = 0; k < TW; ++k) {
#pragma unroll
                      for (int q = 0; q < 4; ++q) al[(k * 4 + q) * 64] = (f32x4){acc2[k][q * 2].x, acc2[k][q * 2].y, acc2[k][q * 2 + 1].x, acc2[k][q * 2 + 1].y}; }
                  asm volatile("s_waitcnt lgkmcnt(0)" ::: "memory"); __builtin_amdgcn_sched_barrier(0);
#pragma unroll 1
                  for (int k = 0; k < TW; ++k) { const int t = tb + k * NGW; if (t >= T) break; const int b = t / SEQ;
                    float* xr = X + (size_t)t * D + ln * 16; const float* g2 = modl + (size_t)b * 6 * D + 5 * D + ln * 16;
                    f32x4 xv[4]; float ss = 0.f;
#pragma unroll
                    for (int q = 0; q < 4; ++q) { const f32x4 xo = *(const f32x4*)(xr + q * 4), gg = *(const f32x4*)(g2 + q * 4);
                        xv[q] = xo + gg * al[(k * 4 + q) * 64]; ss += (xv[q].x * xv[q].x + xv[q].y * xv[q].y) + (xv[q].z * xv[q].z + xv[q].w * xv[q].w); }
                    const float rs = rsqrtf(wave_sum(ss, ln) * (1.f / D) + NORM_EPS);
                    if (fin) {
#pragma unroll
                        for (int q = 0; q < 4; ++q) *(f32x4*)(xr + q * 4) = xv[q] * rs * *(const f32x4*)(lnf + ln * 16 + q * 4); }
                    else {
                        const float* gam = INP(4) + (l + 1) * D + ln * 16; const float* mn = MOD + (size_t)(l + 1) * BATCH * 6 * D + (size_t)b * 6 * D + ln * 16; u32x4 ho[2];
#pragma unroll
                        for (int q = 0; q < 4; ++q) { *(f32x4*)(xr + q * 4) = xv[q];
                            const f32x4 y = xv[q] * rs * *(const f32x4*)(gam + q * 4) * (*(const f32x4*)(mn + D + q * 4) + 1.f) + *(const f32x4*)(mn + q * 4);
                            if (q & 1) { ho[q >> 1].z = pk2(y.x, y.y); ho[q >> 1].w = pk2(y.z, y.w); } else { ho[q >> 1].x = pk2(y.x, y.y); ho[q >> 1].y = pk2(y.z, y.w); } }
                        *(u32x4*)(H + (size_t)t * D + ln * 16) = ho[0]; *(u32x4*)(H + (size_t)t * D + ln * 16 + 8) = ho[1]; }
                  }
                  asm volatile("s_waitcnt lgkmcnt(0)" ::: "memory"); __builtin_amdgcn_wave_barrier();
                }
#undef TOK
#undef TOKV
            }
        }
    }
#undef modl
#undef xin
#undef IN
#undef SEAM
}
#undef MOD
#undef H
#undef PROJ
#undef Q
#undef MIX
#undef Rb
#undef Kb
#undef V0
#undef V1
#undef KKb
#undef Bb
#undef Gb
#undef BGb
#undef Wd
#undef Y
#undef IDX
#undef GATE
#undef WinT
#undef WoutT
#undef PqT
#undef KEYS
#undef QB
#undef SH
#undef WUPT
#undef AUPT
#undef GUPT
#undef VUPT
#undef PWT
#undef INVN
#undef BSUM
#undef SCN
#undef U8
#undef V8
#undef USc
#undef VSc
#undef INP
#undef PHASE_IDS

extern "C" void kernel_launch(void* const* d_in, const int* in_sizes, int n_in, void* d_out, int out_size, void* d_ws, size_t ws_size, hipStream_t stream) {
    if (n_in != 30 || ws_size < WS_END) { fprintf(stderr, "kernel_launch: unexpected n_in %d / ws_size %zu\n", n_in, ws_size); return; }
    static int grid = 0;
    if (grid == 0) {
        int dev = 0, cus = 0, per_cu = 0;
        (void)hipGetDevice(&dev); (void)hipDeviceGetAttribute(&cus, hipDeviceAttributeMultiprocessorCount, dev);
        if (hipFuncSetAttribute((const void*)mega, hipFuncAttributeMaxDynamicSharedMemorySize, LDS_BYTES) != hipSuccess) { fprintf(stderr, "hipFuncSetAttribute failed\n"); grid = -1; return; }
        if (hipOccupancyMaxActiveBlocksPerMultiprocessor(&per_cu, (const void*)mega, NTHR, LDS_BYTES) != hipSuccess || per_cu < 1) { fprintf(stderr, "occupancy query failed (%d)\n", per_cu); per_cu = 1; }
        (void)hipGetLastError();
        grid = (cus > 0 ? cus : 256) * 1;
    }
    if (grid < 0) return;
    Args a{}; for (int i = 0; i < 30; ++i) a.in[i] = (const float*)d_in[i]; a.out = (float*)d_out; a.ws = (unsigned char*)d_ws;
    a.ph_lo = 0; a.ph_hi = NPH;
    if (hipMemsetAsync(d_ws, 0, 65536, stream) != hipSuccess) { fprintf(stderr, "memset failed\n"); return; }
    void* kargs[] = {&a};
    hipError_t e = hipLaunchCooperativeKernel((const void*)mega, dim3(grid), dim3(NTHR), kargs, LDS_BYTES, stream);
    if (e != hipSuccess) fprintf(stderr, "cooperative launch failed: %s (grid %d)\n", hipGetErrorString(e), grid);
}
```

```cpp
#include <hip/hip_runtime.h>
#include <hip/hip_cooperative_groups.h>
namespace cg = cooperative_groups;
#include <cstdio>
#include <cstdint>
#include <cmath>

constexpr int D = 1024, BATCH = 4, SEQ = 4096, T = BATCH * SEQ, DEPTH = 2;
constexpr int RW = 512, HS = 64, NH = 8;
constexpr int DL = 64, AL = 64, MVL = 32, GL = 128;
constexpr int RWKV_COLS = 3 * RW + DL + AL + GL;
constexpr int PW = 512, PG = 128;
constexpr int IN_COLS = RWKV_COLS + PW;
constexpr int LDP = 2560;
constexpr int NKEYS = 128, NEXP = NKEYS * NKEYS, PH = 8, PQ = 256, PHALF = 128, TOPK = 16;
constexpr int NE = PH * TOPK;
constexpr float NORM_EPS = 1e-6f, GN_EPS = 64e-5f;

typedef unsigned short bf16;
__device__ __forceinline__ float bf2f(bf16 u) { return __uint_as_float((unsigned)u << 16); }
typedef float cvt_f32x2 __attribute__((ext_vector_type(2))); typedef __bf16 cvt_bf16x2 __attribute__((ext_vector_type(2)));
__device__ __forceinline__ unsigned cvtpk(float lo, float hi) { const cvt_f32x2 v = {lo, hi}; const cvt_bf16x2 b = __builtin_convertvector(v, cvt_bf16x2); return __builtin_bit_cast(unsigned, b); }
__device__ __forceinline__ bf16 f2bf(float f) { return (bf16)cvtpk(f, 0.f); }

constexpr size_t MiB = 1u << 20;
constexpr size_t WS_MOD = 1 * MiB;
constexpr size_t WS_US = 1 * MiB + 256 * 1024;
constexpr size_t WS_VS = 1 * MiB + 512 * 1024;
constexpr size_t WS_H = 2 * MiB;
constexpr size_t WS_PROJ = 34 * MiB;
constexpr size_t WS_Q = WS_PROJ;
constexpr size_t WS_R = 114 * MiB;
constexpr size_t WS_K = 130 * MiB;
constexpr size_t WS_V0 = 146 * MiB;
constexpr size_t WS_V1 = 162 * MiB;
constexpr size_t WS_KK = 178 * MiB;
constexpr size_t WS_B = 194 * MiB;
constexpr size_t WS_G = 210 * MiB;
constexpr size_t WS_BG = 226 * MiB;
constexpr size_t WS_W = 242 * MiB;
constexpr size_t WS_Y = 274 * MiB;
constexpr size_t WS_MIX = 306 * MiB;
constexpr size_t WS_IDX = 338 * MiB;
constexpr size_t WS_GATE = 346 * MiB;
constexpr size_t WS_WIN_T = 354 * MiB;
constexpr size_t WS_WOUT_T = 364 * MiB;
constexpr size_t WS_PQ_T = 368 * MiB;
constexpr size_t WS_KEYS = 376 * MiB;
constexpr size_t WS_U = 378 * MiB;
constexpr size_t WS_V = 442 * MiB;
constexpr size_t WS_QB = 410 * MiB;
constexpr size_t WS_SH = 426 * MiB;
constexpr size_t WS_LORA = 428 * MiB;
constexpr size_t WS_INVN = 430 * MiB;
constexpr size_t WS_BSUM = 431 * MiB;
constexpr size_t WS_SCN = 2 * MiB;
constexpr size_t WS_END = 506 * MiB;

template <int CTRL> __device__ __forceinline__ float dppf(float x) { return __int_as_float(__builtin_amdgcn_update_dpp(0, __float_as_int(x), CTRL, 0xF, 0xF, false)); }
__device__ __forceinline__ float red16(float x) { x += dppf<0xB1>(x); x += dppf<0x4E>(x); x += dppf<0x141>(x); x += dppf<0x140>(x); return x; }
__device__ __forceinline__ float shflx(float v, int lane, int off) { return __int_as_float(__builtin_amdgcn_ds_bpermute((lane ^ off) << 2, __float_as_int(v))); }
__device__ __forceinline__ unsigned shflxu(unsigned v, int lane, int off) { return (unsigned)__builtin_amdgcn_ds_bpermute((lane ^ off) << 2, (int)v); }
__device__ __forceinline__ void sort128(unsigned& k0, unsigned& k1, int lane) {
#pragma unroll
    for (int k = 2; k <= 128; k <<= 1) {
#pragma unroll
        for (int j = k >> 1; j > 0; j >>= 1) {
            if (j == 64) { const unsigned lo = k0 < k1 ? k0 : k1, hi = k0 < k1 ? k1 : k0; k0 = lo; k1 = hi; }
            else {
                const unsigned p0 = shflxu(k0, lane, j), p1 = shflxu(k1, lane, j);
                const bool lower = (lane & j) == 0, up0 = (lane & k) == 0, up1 = ((lane + 64) & k) == 0;
                const unsigned mn0 = k0 < p0 ? k0 : p0, mx0 = k0 < p0 ? p0 : k0, mn1 = k1 < p1 ? k1 : p1, mx1 = k1 < p1 ? p1 : k1;
                k0 = (lower == up0) ? mn0 : mx0; k1 = (lower == up1) ? mn1 : mx1;
            }
        }
    }
}
__device__ __forceinline__ float wave_sum(float v, int lane) { v = red16(v); v += shflx(v, lane, 16); v += shflx(v, lane, 32); return v; }
__device__ __forceinline__ float sigmoidf_(float x) { return 1.f / (1.f + expf(-x)); }

namespace pg8 {
#define PG8_LAS __attribute__((address_space(3)))
typedef unsigned short bf16_t;
typedef short bf16x8 __attribute__((ext_vector_type(8)));
typedef float f32x4 __attribute__((ext_vector_type(4)));
typedef unsigned u32x4 __attribute__((ext_vector_type(4)));
constexpr int BM = 256, BK = 64, HALF = 128, HTB = HALF * BK * 2  , STAGE_BYTES = 8 * HTB, NXCD = 8, WGM = 8;

__host__ __device__ __forceinline__ int lds_byte(int r, int c) { const int st = (r >> 4) * 2 + (c >> 5), rr = r & 15, cc = c & 31, ob = rr * 64 + cc * 2; return st * 1024 + (ob ^ (((ob >> 9) & 1) << 5)); }
__host__ __device__ __forceinline__ void stage_rc(int b, int& R, int& C) { const int st = b / 1024, sb = b % 1024, swz = sb ^ (((sb >> 9) & 1) << 5); R = (st >> 1) * 16 + swz / 64; C = (st & 1) * 32 + (swz % 64) / 2; }
__host__ __device__ __forceinline__ int perm32(int rho) { const int n = rho >> 4, i = rho & 15; return 8 * (i >> 2) + 4 * n + (i & 3); }

struct Unit { int pm, pn; };
struct Gemm { const bf16_t* A; const bf16_t* Bt; int M, N, K; };

struct StaticOrder {
    int nM, nN, nwg, G, c;
    __host__ __device__ void init(int M, int N, int G_, int c_) { nM = M / BM; nN = N / BM; nwg = nM * nN; G = G_; c = c_; }
    __host__ __device__ bool next(int i, Unit& u) const {
        const long L = (long)i * G + c; if (L >= nwg) return false;
        int wgid = (int)L; { const int q = nwg / NXCD, r = nwg % NXCD, xcd = wgid % NXCD, off = wgid / NXCD; wgid = (xcd < r ? xcd * (q + 1) : r * (q + 1) + (xcd - r) * q) + off; }
        const int nig = WGM * nN, gid = wgid / nig, fm = gid * WGM, gsz = (nM - fm) < WGM ? (nM - fm) : WGM;
        u.pm = fm + ((wgid % nig) % gsz); u.pn = (wgid % nig) / gsz; return true;
    }
    __device__ __forceinline__ void a_ready(const Unit&) const {}
    __device__ __forceinline__ void done(const Unit&) const {}
};

__device__ __forceinline__ unsigned cvt_pk_bf16(float lo, float hi) { unsigned r; asm volatile("v_cvt_pk_bf16_f32 %0, %1, %2" : "=v"(r) : "v"(lo), "v"(hi)); return r; }
typedef float f32x2 __attribute__((ext_vector_type(2)));
__device__ __forceinline__ f32x2 gelu_pk(f32x2 v) {
    const f32x2 av = __builtin_elementwise_abs(v), d = av * 0.2316418882f + 1.0f;
    f32x2 t; t.x = __builtin_amdgcn_rcpf(d.x); t.y = __builtin_amdgcn_rcpf(d.y);
    f32x2 q = t * 0.5307027145f + (-0.7265760135f); q = q * t + 0.7107068705f; q = q * t + (-0.142248368f); q = q * t + 0.127414796f; q = q * t;
    const f32x2 s = (v * v) * (-0.72134752044f);
    f32x2 e; e.x = __builtin_amdgcn_exp2f(s.x); e.y = __builtin_amdgcn_exp2f(s.y);
    const f32x2 m = v * (q * e), r = v - m;
    f32x2 o; o.x = v.x < 0.f ? m.x : r.x; o.y = v.y < 0.f ? m.y : r.y; return o;
}

template <int ACT  > struct EpiBf16 {
    static constexpr bool PERM = true, AFTER_DRAIN = false; static_assert(ACT == 0 || ACT == 1, "EpiBf16: ACT is 0 (none) or 1 (gelu_pk)");
    bf16_t* O; int ldc; const float* bias; int split_cols; size_t split_stride; float scale0;
    __device__ __forceinline__ void operator()(const f32x4 (&acc)[2][2][4][2], const Unit& u, int wr, int wc, int fr, int fq) const {
        const int row0 = u.pm * BM + wr * 64 + fr; int colt = u.pn * BM; bf16_t* base = O;
        float sc = 1.f; if (split_cols) { const int t = colt / split_cols; base += (size_t)t * split_stride; colt -= t * split_cols; if (t == 0) sc = scale0; }
        const int col0 = colt + wc * 32 + 8 * fq, bcol0 = u.pn * BM + wc * 32 + 8 * fq;
        f32x4 bv[2][2];
#pragma unroll
        for (int bj = 0; bj < 2; ++bj)
#pragma unroll
            for (int n = 0; n < 2; ++n) bv[bj][n] = bias ? *(const f32x4*)(bias + bcol0 + bj * HALF + 4 * n) : (f32x4){0.f, 0.f, 0.f, 0.f};
#pragma unroll
        for (int ai = 0; ai < 2; ++ai)
#pragma unroll
            for (int m = 0; m < 4; ++m) { bf16_t* rowp = base + (size_t)(row0 + ai * HALF + m * 16) * ldc + col0;
#pragma unroll
                for (int bj = 0; bj < 2; ++bj) { f32x4 v0 = acc[ai][bj][m][0] + bv[bj][0], v1 = acc[ai][bj][m][1] + bv[bj][1];
                    if (ACT == 1) { f32x2 a = gelu_pk((f32x2){v0[0], v0[1]}), b = gelu_pk((f32x2){v0[2], v0[3]}), c = gelu_pk((f32x2){v1[0], v1[1]}), d = gelu_pk((f32x2){v1[2], v1[3]});
                        v0 = (f32x4){a.x, a.y, b.x, b.y}; v1 = (f32x4){c.x, c.y, d.x, d.y}; }
                    v0 = v0 * sc; v1 = v1 * sc; u32x4 w; w.x = cvt_pk_bf16(v0[0], v0[1]); w.y = cvt_pk_bf16(v0[2], v0[3]); w.z = cvt_pk_bf16(v1[0], v1[1]); w.w = cvt_pk_bf16(v1[2], v1[3]);
                    *(u32x4*)(rowp + bj * HALF) = w; } }
    }
};

struct EpiResGate {
    static constexpr bool PERM = false, AFTER_DRAIN = false;
    const float* xold; float* X; const float* gate;
    __device__ __forceinline__ void operator()(const f32x4 (&acc)[2][2][4][2], const Unit& u, int wr, int wc, int fr, int fq) const {
        const int col0 = u.pn * BM + wc * 32 + 4 * fq; const int b = (u.pm * BM) / SEQ;
        const float* gp = gate + (size_t)b * 6 * D + col0;
#pragma unroll
        for (int bj = 0; bj < 2; ++bj)
#pragma unroll
            for (int n = 0; n < 2; ++n) { const f32x4 gv = *(const f32x4*)(gp + bj * HALF + n * 16);
#pragma unroll
                for (int ai = 0; ai < 2; ++ai)
#pragma unroll
                    for (int m = 0; m < 4; ++m) { const size_t off = (size_t)(u.pm * BM + ai * HALF + wr * 64 + m * 16 + fr) * D + col0 + bj * HALF + n * 16;
                        const f32x4 xo = *(const f32x4*)(xold + off); *(f32x4*)(X + off) = xo + gv * acc[ai][bj][m][n]; } }
    }
};
template <class Epi, class Sched, bool ALIGN_EPI = false, bool SP2 = false>
__device__ __forceinline__ void gemm_phase(PG8_LAS unsigned char* lds, const Gemm g, const Sched& S, const Epi& E, int tid) {
    asm volatile("" : "+v"(tid));
    const int wid = __builtin_amdgcn_readfirstlane(tid >> 6), lane = tid & 63, wr = wid >> 2, wc = wid & 3, fr = lane & 15, fq = lane >> 4;
    const int K = g.K, nt = K / BK;
    unsigned voffA[2], voffB[2];
#pragma unroll
    for (int i = 0; i < 2; ++i) { int R, C; stage_rc(tid * 16 + i * 8192, R, C); const int Rb = Epi::PERM ? ((R & ~31) + perm32(R & 31)) : R;
        voffA[i] = (unsigned)(R * K + C) * 2u; voffB[i] = (unsigned)(Rb * K + C) * 2u; }
    const size_t kstep = (size_t)(BK * 2);
    const size_t hstep = (size_t)HALF * K * 2;
    const size_t tstep = 2 * hstep;
    const unsigned ldsw = (unsigned)wid * 1024u;
    const int aoff = lds_byte(wr * 64 + fr, fq * 8), boff = lds_byte(wc * 32 + fr, fq * 8);
#define PG8_SA(b, h) (((b) * 2 + (h)) * HTB)
#define PG8_SB(b, h) ((4 + (b) * 2 + (h)) * HTB)
#define PG8_STAGE(bufoff, gbase, voff) do { _Pragma("unroll") for (int _i = 0; _i < 2; ++_i) \
        __builtin_amdgcn_global_load_lds((const unsigned*)((const char*)(gbase) + (voff)[_i]), (PG8_LAS unsigned*)(lds + (bufoff) + ldsw + _i * 8192), 16, 0, 0); } while (0)
#define PG8_LDA(dst, b, h) do { _Pragma("unroll") for (int m = 0; m < 4; ++m) _Pragma("unroll") for (int k = 0; k < 2; ++k) dst[m][k] = *(const PG8_LAS bf16x8*)(lds + PG8_SA(b, h) + aoff + m * 2048 + k * 1024); } while (0)
#define PG8_LDB(dst, b, h) do { _Pragma("unroll") for (int n = 0; n < 2; ++n) _Pragma("unroll") for (int k = 0; k < 2; ++k) dst[n][k] = *(const PG8_LAS bf16x8*)(lds + PG8_SB(b, h) + boff + n * 2048 + k * 1024); } while (0)
#define PG8_MMA(ai, bj, At, Bt) do { __builtin_amdgcn_s_setprio(1); _Pragma("unroll") for (int m = 0; m < 4; ++m) _Pragma("unroll") for (int n = 0; n < 2; ++n) _Pragma("unroll") for (int k = 0; k < 2; ++k) \
        acc[ai][bj][m][n] = __builtin_amdgcn_mfma_f32_16x16x32_bf16(Bt[n][k], At[m][k], acc[ai][bj][m][n], 0, 0, 0); __builtin_amdgcn_s_setprio(0); } while (0)
#define PG8_WAIT_V(n) asm volatile("s_waitcnt vmcnt(" #n ")" ::: "memory")
#define PG8_WAIT_L(n) asm volatile("s_waitcnt lgkmcnt(" #n ")" ::: "memory")
#define PG8_BAR __builtin_amdgcn_s_barrier()
#define PG8_SCHED __builtin_amdgcn_sched_barrier(0)
    Unit cur, nxt; int ui = 0;
    if (!S.next(0, cur)) return;
    f32x4 acc[2][2][4][2];
#pragma unroll
    for (int a = 0; a < 2; ++a)
#pragma unroll
        for (int b = 0; b < 2; ++b)
#pragma unroll
            for (int m = 0; m < 4; ++m)
#pragma unroll
                for (int n = 0; n < 2; ++n) acc[a][b][m][n] = (f32x4){0.f, 0.f, 0.f, 0.f};
    bf16x8 At[4][2], B0[2][2], B1[2][2];
    const char* cA = (const char*)g.A + (size_t)cur.pm * tstep; const char* cB = (const char*)g.Bt + (size_t)cur.pn * tstep;
    S.a_ready(cur);
    if constexpr (SP2) {
        PG8_STAGE(PG8_SB(0, 0), cB, voffB); PG8_STAGE(PG8_SB(0, 1), cB + hstep, voffB); PG8_STAGE(PG8_SA(0, 0), cA, voffA); PG8_STAGE(PG8_SA(0, 1), cA + hstep, voffA);
        if (wr == 1) PG8_BAR;
        PG8_WAIT_V(2); PG8_BAR;
        PG8_STAGE(PG8_SB(1, 0), cB + kstep, voffB); PG8_STAGE(PG8_SA(1, 0), cA + kstep, voffA); PG8_STAGE(PG8_SB(1, 1), cB + hstep + kstep, voffB);
        PG8_WAIT_V(6); PG8_BAR;
    } else {
        PG8_STAGE(PG8_SB(0, 0), cB, voffB); PG8_STAGE(PG8_SA(0, 0), cA, voffA); PG8_STAGE(PG8_SB(0, 1), cB + hstep, voffB); PG8_STAGE(PG8_SA(0, 1), cA + hstep, voffA);
        if (wr == 1) PG8_BAR;
        PG8_WAIT_V(4); PG8_BAR;
        PG8_STAGE(PG8_SB(1, 0), cB + kstep, voffB); PG8_STAGE(PG8_SA(1, 0), cA + kstep, voffA); PG8_STAGE(PG8_SB(1, 1), cB + hstep + kstep, voffB);
        PG8_WAIT_V(6); PG8_BAR;
    }
    for (;;) {
        const bool has_next = S.next(ui + 1, nxt);
        const char* nA = has_next ? (const char*)g.A + (size_t)nxt.pm * tstep : cA; const char* nB = has_next ? (const char*)g.Bt + (size_t)nxt.pn * tstep : cB;
        for (int t = 0; t < nt; t += 2) {
            const bool last = (t == nt - 2);
            const char* a1 = cA + (size_t)(t + 1) * kstep;
            const char* a2 = last ? nA : cA + (size_t)(t + 2) * kstep; const char* b2 = last ? nB : cB + (size_t)(t + 2) * kstep;
            const char* a3 = a2 + kstep; const char* b3 = b2 + kstep;
            if (last && has_next) S.a_ready(nxt);
            if constexpr (SP2) {
            PG8_LDB(B0, 0, 0); PG8_LDB(B1, 0, 1); PG8_SCHED; PG8_LDA(At, 0, 0); PG8_STAGE(PG8_SA(1, 1), a1 + hstep, voffA);
            PG8_WAIT_V(8); PG8_WAIT_L(0); PG8_BAR; PG8_MMA(0, 0, At, B0); PG8_MMA(0, 1, At, B1); PG8_BAR; PG8_SCHED;
            PG8_LDA(At, 0, 1); PG8_STAGE(PG8_SB(0, 0), b2, voffB); PG8_STAGE(PG8_SB(0, 1), b2 + hstep, voffB); PG8_STAGE(PG8_SA(0, 0), a2, voffA);
            PG8_WAIT_V(8); PG8_WAIT_L(0); PG8_BAR; PG8_MMA(1, 0, At, B0); PG8_MMA(1, 1, At, B1); PG8_BAR; PG8_SCHED;
            PG8_LDB(B0, 1, 0); PG8_LDB(B1, 1, 1); PG8_SCHED; PG8_LDA(At, 1, 0); PG8_STAGE(PG8_SA(0, 1), a2 + hstep, voffA);
            PG8_WAIT_V(8); PG8_WAIT_L(0); PG8_BAR; PG8_MMA(0, 0, At, B0); PG8_MMA(0, 1, At, B1); PG8_BAR; PG8_SCHED;
            PG8_LDA(At, 1, 1); PG8_STAGE(PG8_SB(1, 0), b3, voffB); PG8_STAGE(PG8_SB(1, 1), b3 + hstep, voffB); PG8_STAGE(PG8_SA(1, 0), a3, voffA);
            PG8_WAIT_V(8); PG8_WAIT_L(0); PG8_BAR; PG8_MMA(1, 0, At, B0); PG8_MMA(1, 1, At, B1); PG8_BAR; PG8_SCHED;
            } else {
            PG8_LDB(B0, 0, 0); PG8_SCHED; PG8_LDA(At, 0, 0); PG8_STAGE(PG8_SA(1, 1), a1 + hstep, voffA);
            PG8_WAIT_L(8); PG8_BAR; PG8_WAIT_L(0); PG8_MMA(0, 0, At, B0); PG8_BAR; PG8_SCHED;
            PG8_LDB(B1, 0, 1); PG8_STAGE(PG8_SB(0, 0), b2, voffB);
            PG8_BAR; PG8_WAIT_L(0); PG8_MMA(0, 1, At, B1); PG8_BAR;
            PG8_LDA(At, 0, 1); PG8_STAGE(PG8_SA(0, 0), a2, voffA);
            PG8_BAR; PG8_WAIT_L(0); PG8_MMA(1, 0, At, B0); PG8_BAR; PG8_SCHED;
            PG8_STAGE(PG8_SB(0, 1), b2 + hstep, voffB);
            PG8_WAIT_V(6); PG8_BAR; PG8_MMA(1, 1, At, B1); PG8_BAR;
            PG8_LDB(B0, 1, 0); PG8_SCHED; PG8_LDA(At, 1, 0); PG8_STAGE(PG8_SA(0, 1), a2 + hstep, voffA);
            PG8_WAIT_L(8); PG8_BAR; PG8_WAIT_L(0); PG8_MMA(0, 0, At, B0); PG8_BAR; PG8_SCHED;
            PG8_LDB(B1, 1, 1); PG8_STAGE(PG8_SB(1, 0), b3, voffB);
            PG8_BAR; PG8_WAIT_L(0); PG8_MMA(0, 1, At, B1); PG8_BAR;
            PG8_LDA(At, 1, 1); PG8_STAGE(PG8_SA(1, 0), a3, voffA);
            PG8_BAR; PG8_WAIT_L(0); PG8_MMA(1, 0, At, B0); PG8_BAR; PG8_SCHED;
            PG8_STAGE(PG8_SB(1, 1), b3 + hstep, voffB);
            PG8_WAIT_V(6); PG8_BAR; PG8_MMA(1, 1, At, B1); PG8_BAR;
            }
        }
        if constexpr (ALIGN_EPI) { if (wr == 0) PG8_BAR; }
        if constexpr (!Epi::AFTER_DRAIN) { int le_; asm volatile("v_mbcnt_lo_u32_b32 %0, -1, 0\n\tv_mbcnt_hi_u32_b32 %0, -1, %0" : "=v"(le_)); E(acc, cur, wr, wc, le_ & 15, le_ >> 4); S.done(cur); }
        if (!has_next) break;
#pragma unroll
        for (int a = 0; a < 2; ++a)
#pragma unroll
            for (int b = 0; b < 2; ++b)
#pragma unroll
                for (int m = 0; m < 4; ++m)
#pragma unroll
                    for (int n = 0; n < 2; ++n) acc[a][b][m][n] = (f32x4){0.f, 0.f, 0.f, 0.f};
        cur = nxt; cA = nA; cB = nB; ++ui;
        if constexpr (ALIGN_EPI) { if (wr == 1) PG8_BAR; }
    }
    PG8_WAIT_V(0);
    if constexpr (!ALIGN_EPI) { if (wr == 0) PG8_BAR; }
    PG8_BAR;
    if constexpr (Epi::AFTER_DRAIN) { E.fused(acc, cur, wr, wc, fr, fq, lds, wid, lane); S.done(cur); }
#undef PG8_SA
#undef PG8_SB
#undef PG8_STAGE
#undef PG8_LDA
#undef PG8_LDB
#undef PG8_MMA
#undef PG8_WAIT_V
#undef PG8_WAIT_L
#undef PG8_BAR
#undef PG8_SCHED
}
}

#define LAS __attribute__((address_space(3)))
constexpr int NWAVES = 8, NTHR = 512;
constexpr int LDS_BYTES = 147456;
constexpr int NPH = 21;
typedef float f32x4 __attribute__((ext_vector_type(4)));
typedef unsigned u32x4 __attribute__((ext_vector_type(4)));

struct Args { const float* in[30]; float* out; unsigned char* ws; int ph_lo, ph_hi; };

__device__ __forceinline__ unsigned pk2(float lo, float hi) { return cvtpk(lo, hi); }

__device__ __forceinline__ void p0_transpose_item(const float* W, int K, int N, bf16* WT, int row_off, LAS float* scr, int item, int lane) {
    const int nblk = N / 32, kb = item / nblk, nb = item % nblk, k0 = 64 * kb, n0 = 32 * nb;
#pragma unroll 8
    for (int i = 0; i < 32; ++i) { const int kk = 2 * i + (lane >> 5); scr[kk * 33 + (lane & 31)] = W[(size_t)(k0 + kk) * N + n0 + (lane & 31)]; }
    asm volatile("s_waitcnt lgkmcnt(0)" ::: "memory");
    const int c = lane & 7;
#pragma unroll
    for (int j = 0; j < 4; ++j) { const int n = (lane >> 3) + 8 * j; const LAS float* s = scr + (8 * c) * 33 + n;
        u32x4 o; o.x = pk2(s[0 * 33], s[1 * 33]); o.y = pk2(s[2 * 33], s[3 * 33]); o.z = pk2(s[4 * 33], s[5 * 33]); o.w = pk2(s[6 * 33], s[7 * 33]);
        *(u32x4*)(WT + (size_t)(row_off + n0 + n) * K + k0 + 8 * c) = o; }
    asm volatile("s_waitcnt lgkmcnt(0)" ::: "memory");
}

__device__ __forceinline__ void norm_mod_row(const float* xr, const float* gamma, const float* sh, const float* sc, bf16* orow, int lane) {
    f32x4 v[4]; float ss = 0.f;
#pragma unroll
    for (int j = 0; j < 4; ++j) { v[j] = *(const f32x4*)(xr + j * 256 + lane * 4); ss += (v[j].x * v[j].x + v[j].y * v[j].y) + (v[j].z * v[j].z + v[j].w * v[j].w); }
    const float rs = rsqrtf(wave_sum(ss, lane) * (1.f / D) + NORM_EPS);
#pragma unroll
    for (int j = 0; j < 4; ++j) { const int d = j * 256 + lane * 4; const f32x4 g = *(const f32x4*)(gamma + d), a = *(const f32x4*)(sc + d), s = *(const f32x4*)(sh + d);
        const f32x4 y = v[j] * rs * g * (a + 1.f) + s; uint2 o; o.x = pk2(y.x, y.y); o.y = pk2(y.z, y.w); *(uint2*)(orow + d) = o; }
}


#define XB_TMO      128
#define XB_XCNT(j)  (256  + 64 * (j))
#define XB_XSUB(j)  (1280 + 64 * (j))
#define XB_XGEN(j)  (2304 + 64 * (j))
#define XB_TOP      3328
#define XB_TOPGEN   3392
#define XCD_BAR_WORDS 3456
#define XB_SPIN_CAP (1u << 18)

__device__ __forceinline__ unsigned xb_ld(unsigned* p)              { return __hip_atomic_load(p, __ATOMIC_RELAXED, __HIP_MEMORY_SCOPE_AGENT); }
__device__ __forceinline__ unsigned xb_add(unsigned* p, unsigned v) { return __hip_atomic_fetch_add(p, v, __ATOMIC_RELAXED, __HIP_MEMORY_SCOPE_AGENT); }
__device__ __forceinline__ unsigned xb_xcc_id() { return (unsigned)__builtin_amdgcn_s_getreg((3 << 11) | 20) & 0xFu; }
#define XB_SPIN(cond, bar) do { unsigned _sp = 0; while (cond) { __builtin_amdgcn_s_sleep(1); \
    if ((++_sp & 255u) == 0u) { if (xb_ld(&(bar)[XB_TMO])) break; if (_sp > XB_SPIN_CAP) { atomicAdd(&(bar)[XB_TMO], 1u); break; } } } } while (0)

struct XcdBarrier {
    unsigned* bar; unsigned x; int w0;
    volatile __attribute__((address_space(3))) unsigned* st;
};

__device__ __forceinline__ XcdBarrier xcd_barrier_post(unsigned* bar, volatile __attribute__((address_space(3))) unsigned* st) {
    XcdBarrier b; b.bar = bar; b.x = xb_xcc_id(); b.st = st; b.w0 = __builtin_amdgcn_readfirstlane((int)threadIdx.x >> 6);
    if (threadIdx.x == 0) (void)xb_add(&bar[XB_XCNT(b.x)], 1u);
    return b;
}
__device__ __forceinline__ void xcd_barrier_complete(unsigned* bar, unsigned x, unsigned& nloc, unsigned& nx) {
    const unsigned G = gridDim.x * gridDim.y * gridDim.z;
    unsigned sum, cnt, mine, sp = 0u;
    for (;;) {
        sum = 0u; cnt = 0u; mine = 0u;
#pragma unroll
        for (unsigned j = 0; j < 16; ++j) { const unsigned c = xb_ld(&bar[XB_XCNT(j)]); sum += c; cnt += (c > 0u) ? 1u : 0u; }
        mine = xb_ld(&bar[XB_XCNT(x)]);
        if (sum == G) break;
        __builtin_amdgcn_s_sleep(1);
        if ((++sp & 255u) == 0u) { if (xb_ld(&bar[XB_TMO])) break; if (sp > XB_SPIN_CAP) { atomicAdd(&bar[XB_TMO], 1u); break; } }
    }
    nloc = mine > 0u ? mine : 1u; nx = cnt > 0u ? cnt : 1u;
}

template <bool FIRST> __device__ __forceinline__ void xcd_barrier(const XcdBarrier& b) {
    asm volatile("s_waitcnt vmcnt(0)" ::: "memory");
    __syncthreads();
    int lid_; asm volatile("v_mbcnt_lo_u32_b32 %0, -1, 0\n\tv_mbcnt_hi_u32_b32 %0, -1, %0" : "=v"(lid_));
    if (b.w0 == 0 && lid_ == 0) {
        unsigned* bar = b.bar;
        __builtin_amdgcn_s_waitcnt(0);
        unsigned nloc = b.st[0], nx = b.st[1];
        if (FIRST && nloc == 0u) { xcd_barrier_complete(bar, b.x, nloc, nx); b.st[0] = nloc; b.st[1] = nx; }
        const unsigned old = xb_add(&bar[XB_XSUB(b.x)], 1u);
        const unsigned gen = old / nloc;
        if (old + 1u == (gen + 1u) * nloc) {
            __builtin_amdgcn_fence(__ATOMIC_RELEASE, "agent");
            asm volatile("s_waitcnt vmcnt(0)" ::: "memory");
            const unsigned og = xb_add(&bar[XB_TOP], 1u);
            const unsigned tg = og / nx;
            if (og + 1u == (tg + 1u) * nx) xb_add(&bar[XB_TOPGEN], 1u);
            else XB_SPIN(xb_ld(&bar[XB_TOPGEN]) == tg, bar);
            __builtin_amdgcn_fence(__ATOMIC_ACQUIRE, "agent");
            xb_add(&bar[XB_XGEN(b.x)], 1u);
            asm volatile("s_waitcnt vmcnt(0)" ::: "memory");
        } else {
            XB_SPIN(xb_ld(&bar[XB_XGEN(b.x)]) == gen, bar);
            __builtin_amdgcn_fence(__ATOMIC_ACQUIRE, "agent");
            asm volatile("s_waitcnt vmcnt(0)" ::: "memory");
        }
    }
    __syncthreads();
}


__device__ __forceinline__ unsigned mono_u32(float f) { unsigned u = __float_as_uint(f); return (u & 0x80000000u) ? ~u : (u | 0x80000000u); }
__device__ __forceinline__ float demono_u32(unsigned u) { return __uint_as_float((u & 0x80000000u) ? (u & 0x7FFFFFFFu) : ~u); }
__device__ __forceinline__ unsigned pack_key7(float f, int idx) { return (mono_u32(f) & 0xFFFFFF80u) | (unsigned)(127 - idx); }
__device__ __forceinline__ float unpack_key7(unsigned k) { return demono_u32((k & 0xFFFFFF80u) | 0x40u); }
__device__ __forceinline__ float unpack_key8(unsigned k) { return demono_u32((k & 0xFFFFFF00u) | 0x80u); }
__device__ __forceinline__ void ce_desc(unsigned& a, unsigned& b) { const unsigned hi = a > b ? a : b, lo = a > b ? b : a; a = hi; b = lo; }
__device__ __forceinline__ void sort16_desc(unsigned* v) {
#pragma unroll
    for (int k = 2; k <= 16; k <<= 1)
#pragma unroll
        for (int j = k >> 1; j > 0; j >>= 1)
#pragma unroll
            for (int i = 0; i < 16; ++i) { const int l = i ^ j; if (l > i) { if ((i & k) == 0) ce_desc(v[i], v[l]); else ce_desc(v[l], v[i]); } }
}
__device__ __forceinline__ void bmerge16_desc(unsigned* v) {
#pragma unroll
    for (int j = 8; j > 0; j >>= 1)
#pragma unroll
        for (int i = 0; i < 16; ++i) { const int l = i ^ j; if (l > i) ce_desc(v[i], v[l]); }
}
__device__ __forceinline__ void merge_top16(unsigned* a, const unsigned* b) {
#pragma unroll
    for (int i = 0; i < 16; ++i) { const unsigned o = b[15 - i]; a[i] = a[i] > o ? a[i] : o; }
    bmerge16_desc(a);
}
__device__ __forceinline__ void stage2_cands(const unsigned* s0, const unsigned* s1, int hh, unsigned* c) {
    float A[16], B[16];
#pragma unroll
    for (int i = 0; i < 16; ++i) { const float f0 = unpack_key7(s0[i]), f1 = unpack_key7(s1[i]); A[i] = hh ? f1 : f0; B[i] = hh ? f0 : f1; }
    int n = 0;
#pragma unroll
    for (int i = 0; i < 4; ++i)
#pragma unroll
        for (int j = i; j < 16; ++j) { if ((i + 1) * (j + 1) > 16) continue;
            const float val = A[i] + B[j]; const unsigned id = hh ? (unsigned)((j << 4) | i) : (unsigned)((i << 4) | j);
            unsigned key = (mono_u32(val) & 0xFFFFFF00u) | id; if (hh && i == j) key = 0u; c[n++] = key; }
#pragma unroll
    for (; n < 32; ++n) c[n] = 0u;
}

typedef short bf16x8_t __attribute__((ext_vector_type(8)));
typedef float f32x16 __attribute__((ext_vector_type(16)));
__device__ __forceinline__ float gelu_erf(float a) { return 0.5f * a * (1.f + erff(a * 0.70710678118654752f)); }


typedef __attribute__((address_space(3))) bf16 lbf16;

__device__ __forceinline__ f32x16 mm32(bf16x8_t a, bf16x8_t b, f32x16 c) { return __builtin_amdgcn_mfma_f32_32x32x16_bf16(a, b, c, 0, 0, 0); }
__device__ __forceinline__ bf16x8_t frag_from_u32x4(unsigned x, unsigned y, unsigned z, unsigned w) { typedef unsigned u4 __attribute__((ext_vector_type(4))); u4 t = {x, y, z, w}; return __builtin_bit_cast(bf16x8_t, t); }
template <int S> __device__ __forceinline__ bf16x8_t accop(const f32x16& z) {
    return frag_from_u32x4(cvtpk(z[8 * S], z[8 * S + 1]), cvtpk(z[8 * S + 2], z[8 * S + 3]), cvtpk(z[8 * S + 4], z[8 * S + 5]), cvtpk(z[8 * S + 6], z[8 * S + 7])); }
template <int S> __device__ __forceinline__ bf16x8_t ldpermcol(const lbf16* a, int col, int hh) {
    const lbf16* p = a + (16 * S + 4 * hh) * 72 + col;
    const unsigned e0 = p[0], e1 = p[72], e2 = p[144], e3 = p[216], e4 = p[8 * 72], e5 = p[9 * 72], e6 = p[10 * 72], e7 = p[11 * 72];
    return frag_from_u32x4(e0 | (e1 << 16), e2 | (e3 << 16), e4 | (e5 << 16), e6 | (e7 << 16)); }
__device__ __forceinline__ bf16x8_t ldrow(const lbf16* a, int row, int ks, int hh) { return *(const __attribute__((address_space(3))) bf16x8_t*)(a + row * 72 + ks * 16 + 8 * hh); }
__device__ __forceinline__ int rowidx(int e, int hh) { return (e & 3) + 8 * (e >> 2) + 4 * hh; }

constexpr int ROWB = 768;
__device__ __forceinline__ unsigned fp6code(float x, float sc) {
    const float t = fabsf(x) * sc;
    const float r = t < 16.f ? __builtin_rintf(t) : (t < 32.f ? 8.f + __builtin_rintf(t * 0.5f) : 16.f + __builtin_rintf(t * 0.25f));
    unsigned c = (unsigned)r; c = c > 31u ? 31u : c;
    return c | (x < 0.f ? 32u : 0u);
}
__device__ __forceinline__ void convert_tables_fp6(const float* pu, const float* pv, unsigned char* u8, unsigned char* v8, float* usc, float* vsc, int l, int wv, int nw, int lane) {
    for (int rr0 = wv * 2; rr0 < 2 * NEXP; rr0 += nw * 2) {
        f32x4 v[2][4]; float m[2];
#pragma unroll
        for (int rr = 0; rr < 2; ++rr) { const int q = rr0 + rr; const size_t row = (size_t)l * NEXP + (q < NEXP ? q : q - NEXP); const float* sp_ = (q < NEXP ? pu : pv) + row * D + lane * 16;
#pragma unroll
            for (int k = 0; k < 4; ++k) v[rr][k] = *(const f32x4*)(sp_ + k * 4); }
#pragma unroll
        for (int rr = 0; rr < 2; ++rr) { float mm = 0.f;
#pragma unroll
            for (int k = 0; k < 4; ++k) mm = fmaxf(fmaxf(mm, fmaxf(fabsf(v[rr][k].x), fabsf(v[rr][k].y))), fmaxf(fabsf(v[rr][k].z), fabsf(v[rr][k].w)));
#pragma unroll
            for (int o = 1; o < 64; o <<= 1) mm = fmaxf(mm, shflx(mm, lane, o));
            m[rr] = mm; }
#pragma unroll
        for (int rr = 0; rr < 2; ++rr) { const int q = rr0 + rr; const size_t row = (size_t)l * NEXP + (q < NEXP ? q : q - NEXP); const float sc = m[rr] > 0.f ? 60.f / m[rr] : 1.f;
            unsigned c[16];
#pragma unroll
            for (int k = 0; k < 4; ++k) { c[k * 4] = fp6code(v[rr][k].x, sc); c[k * 4 + 1] = fp6code(v[rr][k].y, sc); c[k * 4 + 2] = fp6code(v[rr][k].z, sc); c[k * 4 + 3] = fp6code(v[rr][k].w, sc); }
            const unsigned o0 = c[0] | (c[1] << 6) | (c[2] << 12) | (c[3] << 18) | (c[4] << 24) | (c[5] << 30);
            const unsigned o1 = (c[5] >> 2) | (c[6] << 4) | (c[7] << 10) | (c[8] << 16) | (c[9] << 22) | (c[10] << 28);
            const unsigned o2 = (c[10] >> 4) | (c[11] << 2) | (c[12] << 8) | (c[13] << 14) | (c[14] << 20) | (c[15] << 26);
            unsigned* op = (unsigned*)((q < NEXP ? u8 : v8) + row * ROWB + lane * 12);
            op[0] = o0; op[1] = o1; op[2] = o2;
            if (lane == 0) (q < NEXP ? usc : vsc)[row] = m[rr] > 0.f ? m[rr] * (1.f / 7.5f) : 1.f; }
    }
}

__global__ void __launch_bounds__(NTHR, 2) mega(Args args) {
    extern __shared__ __attribute__((aligned(16))) unsigned char lds_raw[];
    LAS unsigned char* lds = (LAS unsigned char*)lds_raw;
    const int G = gridDim.x, bx = blockIdx.x, NGW = G * NWAVES;
    const int wave0 = __builtin_amdgcn_readfirstlane((int)threadIdx.x >> 6);
    typedef const unsigned char __attribute__((address_space(4))) kbyte;
#define PHASE_IDS int tid; asm volatile("v_mbcnt_lo_u32_b32 %0, -1, 0\n\tv_mbcnt_hi_u32_b32 %0, -1, %0" : "=v"(tid)); tid += wave0 * 64;     const int lane = tid & 63, wave = __builtin_amdgcn_readfirstlane(tid >> 6), gw = bx * NWAVES + wave; (void)lane; (void)gw; \
    kbyte* kp = (kbyte*)__builtin_amdgcn_kernarg_segment_ptr(); asm volatile("" : "+s"(kp)); \
    unsigned char* const ws = (unsigned char*)*(__attribute__((address_space(1))) unsigned char* const __attribute__((address_space(4)))*)(kp + 31 * 8); float* const X = (float*)*(__attribute__((address_space(1))) float* const __attribute__((address_space(4)))*)(kp + 30 * 8); (void)ws; (void)X;
#define INP(i) ((const float*)(*(const __attribute__((address_space(1))) float* const __attribute__((address_space(4)))*)(kp + (i) * 8)))
#define MOD ((float*)(ws + WS_MOD))
#define H ((bf16*)(ws + WS_H))
#define PROJ ((bf16*)(ws + WS_PROJ))
#define Q ((bf16*)(ws + WS_Q))
#define MIX ((bf16*)(ws + WS_MIX))
#define Rb ((bf16*)(ws + WS_R))
#define Kb ((bf16*)(ws + WS_K))
#define V0 ((bf16*)(ws + WS_V0))
#define V1 ((bf16*)(ws + WS_V1))
#define KKb ((bf16*)(ws + WS_KK))
#define Bb ((bf16*)(ws + WS_B))
#define Gb ((bf16*)(ws + WS_G))
#define BGb ((bf16*)(ws + WS_BG))
#define Wd ((float*)(ws + WS_W))
#define Y ((float*)(ws + WS_Y))
#define QB ((float*)(ws + WS_QB))
#define SH ((float*)(ws + WS_SH))
#define WUPT ((bf16*)(ws + WS_LORA))
#define AUPT ((bf16*)(ws + WS_LORA + 131072))
#define GUPT ((bf16*)(ws + WS_LORA + 262144))
#define VUPT ((bf16*)(ws + WS_LORA + 524288))
#define PWT ((bf16*)(ws + WS_LORA + 655360))
#define INVN ((float*)(ws + WS_INVN))
#define BSUM ((float*)(ws + WS_BSUM))
#define SCN ((unsigned char*)(ws + WS_SCN))
#define IDX ((int*)(ws + WS_IDX))
#define GATE ((float*)(ws + WS_GATE))
#define WinT ((bf16*)(ws + WS_WIN_T))
#define WoutT ((bf16*)(ws + WS_WOUT_T))
#define PqT ((bf16*)(ws + WS_PQ_T))
#define KEYS ((bf16*)(ws + WS_KEYS))
#define U8 ((unsigned char*)(ws + WS_U))
#define V8 ((unsigned char*)(ws + WS_V))
#define USc ((float*)(ws + WS_US))
#define VSc ((float*)(ws + WS_VS))
    const int lo = args.ph_lo, hi = args.ph_hi;
    { volatile LAS unsigned* misc = (volatile LAS unsigned*)(lds + LDS_BYTES - 64); if (threadIdx.x < 4) misc[threadIdx.x] = 0u; __syncthreads(); }
    const XcdBarrier xbar = xcd_barrier_post((unsigned*)(args.ws) + 4096, (volatile LAS unsigned*)(lds + LDS_BYTES - 64));
#define IN(k) (lo <= (k) && (k) < hi)
#ifndef REP_PHASE
#define REP_PHASE (-1)
#endif
#define REPS(k) ((k) == REP_PHASE ? 3 : 1)
#define SEAM(k) do { if (IN(k) && IN((k) + 1)) { if ((k) == 0) cg::this_grid().sync(); else { XcdBarrier xb_ = xbar; asm volatile("" : "+s"(xb_.bar)); if ((k) == 1) xcd_barrier<true>(xb_); else xcd_barrier<false>(xb_); } } } while (0)

    if (IN(0)) { PHASE_IDS
        { LAS float* ca = (LAS float*)lds; LAS float* red = (LAS float*)(lds + 16384);
          const float* c = INP(1); const float* ada_w = INP(2); const float* ada_b = INP(3);
          bool have = false;
          for (int it = bx; it < 96; it += G) {
              if (!have) { for (int i = tid; i < BATCH * D; i += NTHR) { const float v = c[i]; ca[i] = v / (1.f + expf(-v)); } have = true; __syncthreads(); }
              const int l = it / 48, n = (it % 48) * 128 + (tid & 127), kq = tid >> 7;
              const float* w = ada_w + (size_t)l * D * 6 * D + (size_t)(kq * 256) * 6 * D + n;
              float a0 = 0.f, a1 = 0.f, a2 = 0.f, a3 = 0.f;
#pragma unroll 32
              for (int k = 0; k < 256; ++k) { const float wv = w[(size_t)k * 6 * D]; const int kk = kq * 256 + k; a0 += ca[kk] * wv; a1 += ca[D + kk] * wv; a2 += ca[2 * D + kk] * wv; a3 += ca[3 * D + kk] * wv; }
              red[(kq * 4 + 0) * 128 + (tid & 127)] = a0; red[(kq * 4 + 1) * 128 + (tid & 127)] = a1; red[(kq * 4 + 2) * 128 + (tid & 127)] = a2; red[(kq * 4 + 3) * 128 + (tid & 127)] = a3;
              __syncthreads();
              { const int b = tid >> 7, col = tid & 127, nn = (it % 48) * 128 + col;
                const float s = red[(0 * 4 + b) * 128 + col] + red[(1 * 4 + b) * 128 + col] + red[(2 * 4 + b) * 128 + col] + red[(3 * 4 + b) * 128 + col];
                MOD[(size_t)l * BATCH * 6 * D + (size_t)b * 6 * D + nn] = s + ada_b[l * 6 * D + nn]; }
              __syncthreads();
          }
          __syncthreads(); }
        { LAS float* scr = (LAS float*)(lds + wave * 16384);
          constexpr int I_IN = (D / 64) * (IN_COLS / 32), I_VR = (D / 64) * (MVL / 32), I_OUT = (D / 64) * (D / 32), I_PQ = (D / 64) * (PH * PQ / 32);
          constexpr int NIT = 2 * I_IN + I_VR + 2 * I_OUT + 2 * I_PQ;
          for (int it = gw; it < NIT; it += NGW) { int r = it;
              if (r < 2 * I_IN) { const int l = r / I_IN; p0_transpose_item(INP(5) + (size_t)l * D * IN_COLS, D, IN_COLS, WinT + (size_t)l * LDP * D, 0, scr, r % I_IN, lane); continue; } r -= 2 * I_IN;
              if (r < I_VR) { p0_transpose_item(INP(12), D, MVL, WinT + (size_t)1 * LDP * D, IN_COLS, scr, r, lane); continue; } r -= I_VR;
              if (r < 2 * I_OUT) { const int l = r / I_OUT; p0_transpose_item(INP(23) + (size_t)l * D * D, D, D, WoutT + (size_t)l * D * D, 0, scr, r % I_OUT, lane); continue; } r -= 2 * I_OUT;
              { const int l = r / I_PQ; p0_transpose_item(INP(25) + (size_t)l * D * PH * PQ, D, PH * PQ, PqT + (size_t)l * PH * PQ * D, 0, scr, r % I_PQ, lane); } }
          for (int it = gw; it < 2 * 16 + 2 * 16 + 2 * 32; it += NGW) { int r = it;
              if (r < 32) { const int l = r / 16; p0_transpose_item(INP(8) + (size_t)l * DL * RW, DL, RW, WUPT + (size_t)l * RW * DL, 0, scr, r % 16, lane); continue; } r -= 32;
              if (r < 32) { const int l = r / 16; p0_transpose_item(INP(10) + (size_t)l * AL * RW, AL, RW, AUPT + (size_t)l * RW * AL, 0, scr, r % 16, lane); continue; } r -= 32;
              { const int l = r / 32; p0_transpose_item(INP(11) + (size_t)l * GL * RW, GL, RW, GUPT + (size_t)l * RW * GL, 0, scr, r % 32, lane); } }
          { const float* vu = INP(15); for (int e = bx * NTHR + tid; e < MVL * RW; e += G * NTHR) { const int n = e >> 5, k = e & 31; VUPT[e] = f2bf(vu[k * RW + n]); } }
          for (int it = gw; it < 8 * 8; it += NGW) p0_transpose_item(INP(21) + (size_t)(it >> 3) * PG * PG, PG, PG, PWT + (size_t)(it >> 3) * PG * PG, 0, scr, it & 7, lane);
        }
        { const size_t gt = (size_t)bx * NTHR + tid, NT = (size_t)G * NTHR;
          constexpr size_t NK8 = (size_t)2 * PH * 2 * NKEYS * PHALF / 8;
          const float* src = INP(26); bf16* dst = KEYS;
          for (size_t i = gt; i < NK8; i += NT) {
              const f32x4 a = *(const f32x4*)(src + i * 8), b = *(const f32x4*)(src + i * 8 + 4);
              u32x4 o; o.x = pk2(a.x, a.y); o.y = pk2(a.z, a.w); o.z = pk2(b.x, b.y); o.w = pk2(b.z, b.w); *(u32x4*)(dst + i * 8) = o; }
        }
    }
    SEAM(0);

#pragma unroll
    for (int l = 0; l < DEPTH; ++l) {
        const int pb = 1 + 10 * l;
#define modl (MOD + (size_t)l * BATCH * 6 * D)
#define xin (l == 0 ? INP(0) : (const float*)X)
        if (l == 0 && IN(pb + 0)) { PHASE_IDS const float* gamma = INP(4) + l * D;
            for (int row = gw; row < T; row += NGW) { const int b = row / SEQ; norm_mod_row(xin + (size_t)row * D, gamma, modl + (size_t)b * 6 * D, modl + (size_t)b * 6 * D + D, H + (size_t)row * D, lane); } }
        SEAM(pb + 0);
        if (IN(pb + 1)) { PHASE_IDS const int N1 = l == 0 ? IN_COLS : LDP;
            pg8::Gemm g{H, WinT + (size_t)l * LDP * D, T, N1, D}; pg8::StaticOrder S; S.init(T, N1, G, bx);
            pg8::EpiBf16<0> E{PROJ, LDP, nullptr, 0, 0, 1.f};
            pg8::gemm_phase<pg8::EpiBf16<0>, pg8::StaticOrder, true, true>(lds, g, S, E, tid); }
        SEAM(pb + 1);

        if (IN(pb + 2)) { PHASE_IDS
            constexpr int LST = 296;
            LAS bf16* lin = (LAS bf16*)lds;
            const float* mu = INP(6) + l * RWKV_COLS; const float* vmu = INP(13);
            const float* w0p = INP(7) + l * RW; const float* a0p = INP(9) + l * RW; const float* kkp = INP(16) + l * RW; const float* kap = INP(17) + l * RW; const float* rkp = INP(18) + l * RW; const float* v0p = INP(14);
            const bf16* wupT = WUPT + (size_t)l * RW * DL; const bf16* aupT = AUPT + (size_t)l * RW * AL; const bf16* gupT = GUPT + (size_t)l * RW * GL; const bf16* vupT = VUPT;
            bf16* Vl = l == 0 ? V0 : V1;
            const int r32 = lane & 31, hh = lane >> 5, h = wave;
            for (int tile = bx; tile < T / 32; tile += G) {
                const int t0 = tile * 32;
                __syncthreads();
#pragma unroll 1
                for (int it0 = 0; it0 < 3; it0 += 2) {
                  u32x4 cu_[2], pv_[2]; f32x4 m0_[2], m1_[2];
#pragma unroll
                  for (int it = 0; it < 2; ++it) { const int c8 = tid + (it0 + it) * NTHR; const bool ok = c8 < 32 * 36; const int tok = ok ? c8 / 36 : 0, jc = ok ? c8 % 36 : 0, t = t0 + tok, sq = t % SEQ;
                      cu_[it] = (u32x4){0u, 0u, 0u, 0u}; pv_[it] = (u32x4){0u, 0u, 0u, 0u}; m0_[it] = (f32x4){0.f, 0.f, 0.f, 0.f}; m1_[it] = m0_[it];
                      if (ok && (jc < 32 || l > 0)) { const int col = jc < 32 ? 3 * RW + jc * 8 : IN_COLS + (jc - 32) * 8;
                          cu_[it] = *(const u32x4*)(PROJ + (size_t)t * LDP + col); if (sq > 0) pv_[it] = *(const u32x4*)(PROJ + (size_t)(t - 1) * LDP + col);
                          const float* mp = jc < 32 ? mu + col : vmu + (jc - 32) * 8; m0_[it] = *(const f32x4*)mp; m1_[it] = *(const f32x4*)(mp + 4); } }
#pragma unroll
                  for (int it = 0; it < 2; ++it) { const int c8 = tid + (it0 + it) * NTHR; if (c8 < 32 * 36) { const int tok = c8 / 36, jc = c8 % 36;
                      u32x4 o = {0u, 0u, 0u, 0u};
                      if (jc < 32 || l > 0) {
                          float x[8]; const unsigned cw[4] = {cu_[it].x, cu_[it].y, cu_[it].z, cu_[it].w}, pw[4] = {pv_[it].x, pv_[it].y, pv_[it].z, pv_[it].w}; const float mm[8] = {m0_[it].x, m0_[it].y, m0_[it].z, m0_[it].w, m1_[it].x, m1_[it].y, m1_[it].z, m1_[it].w};
#pragma unroll
                          for (int i = 0; i < 4; ++i) { const float c0 = __uint_as_float(cw[i] << 16), c1 = __uint_as_float(cw[i] & 0xffff0000u), p0 = __uint_as_float(pw[i] << 16), p1 = __uint_as_float(pw[i] & 0xffff0000u);
                              x[2 * i] = c0 + (p0 - c0) * mm[2 * i]; x[2 * i + 1] = c1 + (p1 - c1) * mm[2 * i + 1]; }
                          if (jc < 8) {
#pragma unroll
                              for (int i = 0; i < 8; ++i) { const float e2 = __expf(-2.f * fabsf(x[i])); const float th = (1.f - e2) * __builtin_amdgcn_rcpf(1.f + e2); x[i] = x[i] < 0.f ? -th : th; } }
                          else if (jc >= 16 && jc < 32) {
#pragma unroll
                              for (int i = 0; i < 8; ++i) x[i] = __builtin_amdgcn_rcpf(1.f + __expf(-x[i])); }
                          o.x = pk2(x[0], x[1]); o.y = pk2(x[2], x[3]); o.z = pk2(x[4], x[5]); o.w = pk2(x[6], x[7]);
                      }
                      *(LAS u32x4*)(lin + tok * LST + jc * 8) = o; } } }
                __syncthreads();
                const bool first = (t0 % SEQ) == 0;
                lbf16* tin = (lbf16*)(lds + 19456 + wave * 14336);
                { u32x4 iq[13]; int ql_; asm volatile("v_mbcnt_lo_u32_b32 %0, -1, 0\n\tv_mbcnt_hi_u32_b32 %0, -1, %0" : "=v"(ql_));
#pragma unroll
                  for (int i = 0; i < 13; ++i) { const int q = ql_ + 64 * i; iq[i] = (u32x4){0u, 0u, 0u, 0u};
                      if (q < 792) { const int arr = q / 264, rem = q - arr * 264, row = rem >> 3, cc = rem & 7;
                          if (!(first && row == 0)) iq[i] = *(const u32x4*)(PROJ + (size_t)(t0 - 1 + row) * LDP + arr * RW + h * HS + cc * 8); } }
#pragma unroll
                  for (int i = 0; i < 13; ++i) { const int q = ql_ + 64 * i; if (q < 792) { const int arr = q / 264, rem = q - arr * 264, row = rem >> 3, cc = rem & 7;
                      *(__attribute__((address_space(3))) u32x4*)(tin + arr * 2376 + row * 72 + cc * 8) = iq[i]; } } }
                __builtin_amdgcn_wave_barrier(); asm volatile("s_waitcnt lgkmcnt(0)" ::: "memory");
                float ssq[16], bsm[16];
#pragma unroll
                for (int e = 0; e < 16; ++e) { ssq[e] = 0.f; bsm[e] = 0.f; }
#pragma unroll 1
                for (int rt = 0; rt < 2; ++rt) {
                    f32x16 accW, accA, accG, accV;
#pragma unroll
                    for (int e = 0; e < 16; ++e) { accW[e] = 0.f; accA[e] = 0.f; accG[e] = 0.f; accV[e] = 0.f; }
                    int c = h * HS + rt * 32 + r32;
int hh8 = 8 * hh; asm volatile("" : "+v"(c), "+v"(hh8));
                    const LAS bf16* lrow = lin + r32 * LST + 8 * hh;
                    { bf16x8_t wf[18];
#pragma unroll
                      for (int ks = 0; ks < 4; ++ks) { wf[ks] = *(const bf16x8_t*)(wupT + (size_t)c * DL + ks * 16 + hh8); wf[4 + ks] = *(const bf16x8_t*)(aupT + (size_t)c * AL + ks * 16 + hh8); }
#pragma unroll
                      for (int ks = 0; ks < 8; ++ks) wf[8 + ks] = *(const bf16x8_t*)(gupT + (size_t)c * GL + ks * 16 + hh8);
                      wf[16] = bf16x8_t{}; wf[17] = bf16x8_t{};
                      if (l > 0) { wf[16] = *(const bf16x8_t*)(vupT + (size_t)c * MVL + hh8); wf[17] = *(const bf16x8_t*)(vupT + (size_t)c * MVL + 16 + hh8); }
#pragma unroll
                      for (int ks = 0; ks < 4; ++ks) { accW = __builtin_amdgcn_mfma_f32_32x32x16_bf16(*(const LAS bf16x8_t*)(lrow + ks * 16), wf[ks], accW, 0, 0, 0);
                                                       accA = __builtin_amdgcn_mfma_f32_32x32x16_bf16(*(const LAS bf16x8_t*)(lrow + 64 + ks * 16), wf[4 + ks], accA, 0, 0, 0); }
#pragma unroll
                      for (int ks = 0; ks < 8; ++ks) accG = __builtin_amdgcn_mfma_f32_32x32x16_bf16(*(const LAS bf16x8_t*)(lrow + 128 + ks * 16), wf[8 + ks], accG, 0, 0, 0);
                      if (l > 0) {
#pragma unroll
                          for (int ks = 0; ks < 2; ++ks) accV = __builtin_amdgcn_mfma_f32_32x32x16_bf16(*(const LAS bf16x8_t*)(lrow + 256 + ks * 16), wf[16 + ks], accV, 0, 0, 0); } }
                    const float mur = mu[c], muk = mu[RW + c], muv = mu[2 * RW + c], w0c = w0p[c], a0c = a0p[c], kkc = kkp[c], kac = kap[c], rkc = rkp[c];
                    const float v0c = l > 0 ? v0p[c] : 0.f;
#pragma unroll
                    for (int eb = 0; eb < 16; eb += 4) {
                        bf16 lr[4], lk[4], lv[4], lrp[4], lkp[4], lvp[4], lvf[4];
#pragma unroll
                        for (int i = 0; i < 4; ++i) { const int e = eb + i; const int tok = (e & 3) + 8 * (e >> 2) + 4 * hh, t = t0 + tok; const int ci = rt * 32 + r32;
                            lr[i] = tin[(tok + 1) * 72 + ci]; lk[i] = tin[2376 + (tok + 1) * 72 + ci]; lv[i] = tin[2 * 2376 + (tok + 1) * 72 + ci];
                            lrp[i] = tin[tok * 72 + ci]; lkp[i] = tin[2376 + tok * 72 + ci]; lvp[i] = tin[2 * 2376 + tok * 72 + ci];
                            lvf[i] = l > 0 ? V0[(size_t)t * RW + c] : (bf16)0; }
                        __builtin_amdgcn_sched_barrier(0);
#pragma unroll
                        for (int i = 0; i < 4; ++i) { const int e = eb + i; const int tok = (e & 3) + 8 * (e >> 2) + 4 * hh, t = t0 + tok; const size_t o = (size_t)t * RW + c;
                            float r = bf2f(lr[i]), k = bf2f(lk[i]), v = bf2f(lv[i]);
                            r += (bf2f(lrp[i]) - r) * mur; k += (bf2f(lkp[i]) - k) * muk; v += (bf2f(lvp[i]) - v) * muv;
                            const float z = -(w0c + accW[e]); const float sp = fmaxf(z, 0.f) + __logf(1.f + __expf(-fabsf(z)));
                            const float decay = __expf(-__expf(-sp - 0.5f));
                            const float a = __builtin_amdgcn_rcpf(1.f + __expf(-(a0c + accA[e]))); const float g = accG[e];
                            if (l > 0) { const float vfv = bf2f(lvf[i]); v = v + (vfv - v) * __builtin_amdgcn_rcpf(1.f + __expf(-(v0c + accV[e]))); }
                            const float kk = k * kkc; const float k2 = k * (1.f + (a - 1.f) * kac);
                            ssq[e] += kk * kk; bsm[e] += r * k2 * rkc;
                            { const unsigned p0_ = cvtpk(r, k2), p1_ = cvtpk(v, kk), p2_ = cvtpk(kk * a, g), p3_ = cvtpk(v * g, 0.f);
                              Rb[o] = (bf16)p0_; Kb[o] = (bf16)(p0_ >> 16); Vl[o] = (bf16)p1_; KKb[o] = (bf16)(p1_ >> 16); Bb[o] = (bf16)p2_; Gb[o] = (bf16)(p2_ >> 16); BGb[o] = (bf16)p3_; Wd[o] = decay; }
                        }
                    }
                }
#pragma unroll
                for (int e = 0; e < 16; ++e) { const int ln_ = r32 | (hh << 5); float a_ = red16(ssq[e]), b_ = red16(bsm[e]); a_ += shflx(a_, ln_, 16); b_ += shflx(b_, ln_, 16); ssq[e] = a_; bsm[e] = b_; }
                if (r32 == 0) {
#pragma unroll
                    for (int e = 0; e < 16; ++e) { const int tok = (e & 3) + 8 * (e >> 2) + 4 * hh; INVN[(size_t)(t0 + tok) * NH + h] = rsqrtf(fmaxf(ssq[e], 1e-24f)); BSUM[(size_t)(t0 + tok) * NH + h] = bsm[e]; } }
            }
            {
                constexpr int DST = 520;
                int lane_p; asm volatile("v_mbcnt_lo_u32_b32 %0, -1, 0\n\tv_mbcnt_hi_u32_b32 %0, -1, %0" : "=v"(lane_p)); const int r32 = lane_p & 31, hh = lane_p >> 5, tidp = wave0 * 64 + lane_p;
                lbf16* dlb = (lbf16*)lds;
                lbf16* pin = (lbf16*)(lds + 33280);
                const int c = tidp, g = c >> 7, win = 2 << g;
                const bf16* pwt = PWT + (size_t)(l * 4 + (wave >> 1)) * PG * PG; const float* psc = INP(22) + l * PW;
                for (int tile = bx; tile < T / 32; tile += G) {
                    const int t0 = tile * 32; const bool first = (t0 % SEQ) == 0;
                    __syncthreads();
                    { u32x4 pq[6];
#pragma unroll
                      for (int q = 0; q < 6; ++q) { const int ch = tidp + q * NTHR, row = ch >> 6, cc = ch & 63; pq[q] = (u32x4){0u, 0u, 0u, 0u};
                          if (ch < 47 * 64 && (row >= 15 || !first)) pq[q] = *(const u32x4*)(PROJ + (size_t)(t0 - 15 + row) * LDP + RWKV_COLS + cc * 8); }
#pragma unroll
                      for (int q = 0; q < 6; ++q) { const int ch = tidp + q * NTHR, row = ch >> 6, cc = ch & 63; if (ch < 47 * 64) *(__attribute__((address_space(3))) u32x4*)(pin + row * 520 + cc * 8) = pq[q]; } }
                    __syncthreads();
                    const lbf16* pc = pin + c;
                    float sw = 0.f;
#pragma unroll
                    for (int j = 1; j <= 15; ++j) sw += (j < win) ? bf2f(pc[(15 - j) * 520]) : 0.f;
                    const float invw = 1.f / (float)win;
#pragma unroll 8
                    for (int i = 0; i < 32; ++i) {
                        const float cur = bf2f(pc[(15 + i) * 520]);
                        sw += cur;
                        const float inv = (first && i < 15) ? 1.f / (float)min(i + 1, win) : invw;
                        dlb[i * DST + c] = f2bf(sw * inv - cur);
                        sw -= bf2f(pc[(15 + i - win + 1) * 520]);
                    }
                    __syncthreads();
                    const int gg = wave >> 1, half = wave & 1;
#pragma unroll
                    for (int ct = 0; ct < 2; ++ct) {
                        const int dd0 = half * 64 + ct * 32;
                        f32x16 acc;
#pragma unroll
                        for (int e = 0; e < 16; ++e) acc[e] = 0.f;
#pragma unroll
                        for (int ks = 0; ks < 8; ++ks) { const bf16x8_t a = *(const __attribute__((address_space(3))) bf16x8_t*)(dlb + r32 * DST + gg * PG + ks * 16 + 8 * hh);
                            const bf16x8_t w = *(const bf16x8_t*)(pwt + (size_t)(dd0 + r32) * PG + ks * 16 + 8 * hh); acc = mm32(a, w, acc); }
                        const int oc = gg * PG + dd0 + r32; const float ps = psc[oc];
#pragma unroll
                        for (int e = 0; e < 16; ++e) MIX[(size_t)(t0 + rowidx(e, hh)) * D + RW + oc] = f2bf(acc[e] * ps);
                    }
                }
            }
        }
        SEAM(pb + 2);

        if (IN(pb + 3)) { PHASE_IDS
            const bf16* Vl = l == 0 ? V0 : V1;
            const int r32 = lane & 31, hh = lane >> 5;
            if (wave < 6) {
                lbf16* At = (lbf16*)(lds + wave * 23552); lbf16* Bt = At + 2304; lbf16* Kt = Bt + 2304; lbf16* Rt = Kt + 2304; lbf16* Vv = Rt + 2304;
                LAS float* PCs = (LAS float*)(lds + wave * 23552 + 23040);
                for (int item = bx * 6 + wave; item < BATCH * NH * (SEQ / 32); item += G * 6) {
                    const int bh = item >> 7, chunk = item & 127, b = bh >> 3, h = bh & 7; const size_t t0 = (size_t)b * SEQ + chunk * 32;
                    __builtin_amdgcn_wave_barrier(); asm volatile("s_waitcnt lgkmcnt(0)" ::: "memory");
                    {
                      const int tk = lane >> 3, part = lane & 7;
                      u32x4 qr[4], qk[4], qv[4], qkk[4], qb[4]; f32x4 qw0[4], qw1[4]; float qin[4];
#pragma unroll
                      for (int p4 = 0; p4 < 4; ++p4) { const size_t o = (t0 + p4 * 8 + tk) * RW + h * HS + part * 8;
                          qr[p4] = *(const u32x4*)(Rb + o); qk[p4] = *(const u32x4*)(Kb + o); qv[p4] = *(const u32x4*)(Vl + o); qkk[p4] = *(const u32x4*)(KKb + o); qb[p4] = *(const u32x4*)(Bb + o);
                          qw0[p4] = *(const f32x4*)(Wd + o); qw1[p4] = *(const f32x4*)(Wd + o + 4); qin[p4] = INVN[(t0 + p4 * 8 + tk) * NH + h]; }
                      LAS float* Pl = (LAS float*)At;
#pragma unroll
                      for (int p4 = 0; p4 < 4; ++p4) { *(LAS f32x4*)(Pl + (p4 * 8 + tk) * 64 + part * 8) = qw0[p4]; *(LAS f32x4*)(Pl + (p4 * 8 + tk) * 64 + part * 8 + 4) = qw1[p4]; }
                      __builtin_amdgcn_wave_barrier(); asm volatile("s_waitcnt lgkmcnt(0)" ::: "memory");
                      { float P = 1.f;
#pragma unroll 8
                        for (int c = 0; c < 32; ++c) { P *= Pl[c * 64 + lane]; Pl[c * 64 + lane] = P; }
                        PCs[lane] = P; }
                      __builtin_amdgcn_wave_barrier(); asm volatile("s_waitcnt lgkmcnt(0)" ::: "memory");
                      u32x4 oa[4], orr[4], ob_[4], ok_[4];
#pragma unroll
                      for (int p4 = 0; p4 < 4; ++p4) { const int c = p4 * 8 + tk;
                          const f32x4 pa = *(const LAS f32x4*)(Pl + c * 64 + part * 8), pb2 = *(const LAS f32x4*)(Pl + c * 64 + part * 8 + 4);
                          f32x4 ma = {1.f, 1.f, 1.f, 1.f}, mb = ma; if (c > 0) { ma = *(const LAS f32x4*)(Pl + (c - 1) * 64 + part * 8); mb = *(const LAS f32x4*)(Pl + (c - 1) * 64 + part * 8 + 4); }
                          const float Pc[8] = {pa.x, pa.y, pa.z, pa.w, pb2.x, pb2.y, pb2.z, pb2.w}, Pm[8] = {ma.x, ma.y, ma.z, ma.w, mb.x, mb.y, mb.z, mb.w};
                          const unsigned rw_[4] = {qr[p4].x, qr[p4].y, qr[p4].z, qr[p4].w}, kw_[4] = {qk[p4].x, qk[p4].y, qk[p4].z, qk[p4].w}, kkw[4] = {qkk[p4].x, qkk[p4].y, qkk[p4].z, qkk[p4].w}, bw_[4] = {qb[p4].x, qb[p4].y, qb[p4].z, qb[p4].w};
                          unsigned xa[4], xr[4], xb[4], xk[4]; const float inv = qin[p4];
#pragma unroll
                          for (int i = 0; i < 4; ++i) { const float ip0 = __builtin_amdgcn_rcpf(Pc[2 * i]), ip1 = __builtin_amdgcn_rcpf(Pc[2 * i + 1]);
                              xa[i] = pk2(-__uint_as_float(kkw[i] << 16) * inv * Pm[2 * i], -__uint_as_float(kkw[i] & 0xffff0000u) * inv * Pm[2 * i + 1]);
                              xr[i] = pk2(__uint_as_float(rw_[i] << 16) * Pc[2 * i], __uint_as_float(rw_[i] & 0xffff0000u) * Pc[2 * i + 1]);
                              xb[i] = pk2(__uint_as_float(bw_[i] << 16) * inv * ip0, __uint_as_float(bw_[i] & 0xffff0000u) * inv * ip1);
                              xk[i] = pk2(__uint_as_float(kw_[i] << 16) * ip0, __uint_as_float(kw_[i] & 0xffff0000u) * ip1); }
                          oa[p4] = (u32x4){xa[0], xa[1], xa[2], xa[3]}; orr[p4] = (u32x4){xr[0], xr[1], xr[2], xr[3]}; ob_[p4] = (u32x4){xb[0], xb[1], xb[2], xb[3]}; ok_[p4] = (u32x4){xk[0], xk[1], xk[2], xk[3]}; }
                      __builtin_amdgcn_wave_barrier(); asm volatile("s_waitcnt lgkmcnt(0)" ::: "memory");
#pragma unroll
                      for (int p4 = 0; p4 < 4; ++p4) { const int c = p4 * 8 + tk, o = c * 72 + part * 8;
                          *(__attribute__((address_space(3))) u32x4*)(At + o) = oa[p4]; *(__attribute__((address_space(3))) u32x4*)(Rt + o) = orr[p4]; *(__attribute__((address_space(3))) u32x4*)(Bt + o) = ob_[p4];
                          *(__attribute__((address_space(3))) u32x4*)(Kt + o) = ok_[p4]; *(__attribute__((address_space(3))) u32x4*)(Vv + o) = qv[p4]; } }
                    __builtin_amdgcn_wave_barrier(); asm volatile("s_waitcnt lgkmcnt(0)" ::: "memory");
                    const f32x16 zero16 = {0.f, 0.f, 0.f, 0.f, 0.f, 0.f, 0.f, 0.f, 0.f, 0.f, 0.f, 0.f, 0.f, 0.f, 0.f, 0.f};
                    f32x16 X = zero16, Yt = zero16;
#pragma unroll
                    for (int ks = 0; ks < 4; ++ks) { const bf16x8_t fa = ldrow(At, r32, ks, hh), fb = ldrow(Bt, r32, ks, hh); X = mm32(fa, fb, X); Yt = mm32(fb, fa, Yt); }
#pragma unroll
                    for (int e = 0; e < 16; ++e) { const int ri = rowidx(e, hh); X[e] = (r32 < ri) ? X[e] : 0.f; Yt[e] = (ri < r32) ? Yt[e] : 0.f; }
                    f32x16 TY = Yt;
#pragma unroll
                    for (int e = 0; e < 16; ++e) TY[e] += (rowidx(e, hh) == r32) ? 1.f : 0.f;
#pragma unroll 1
                    for (int it = 0; it < 4; ++it) {
                        const bf16x8_t x0 = accop<0>(X), x1 = accop<1>(X), y0 = accop<0>(Yt), y1 = accop<1>(Yt);
                        f32x16 Xn = mm32(y0, x0, zero16); Xn = mm32(y1, x1, Xn);
                        f32x16 Yn = mm32(x0, y0, zero16); Yn = mm32(x1, y1, Yn);
                        X = Xn; Yt = Yn;
                        const bf16x8_t p0 = accop<0>(X), p1 = accop<1>(X), t0_ = accop<0>(TY), t1_ = accop<1>(TY);
                        TY = mm32(p0, t0_, TY); TY = mm32(p1, t1_, TY);
                    }
                    const bf16x8_t ty0 = accop<0>(TY), ty1 = accop<1>(TY);
                    unsigned char* rec = SCN + (size_t)item * 24576;
                    const bf16x8_t v00 = ldpermcol<0>(Vv, r32, hh), v01 = ldpermcol<1>(Vv, r32, hh), v10 = ldpermcol<0>(Vv, 32 + r32, hh), v11 = ldpermcol<1>(Vv, 32 + r32, hh);
                    f32x16 U0a, U0b;
                    { f32x16 G2T = zero16;
#pragma unroll
                      for (int ks = 0; ks < 4; ++ks) G2T = mm32(ldrow(Kt, r32, ks, hh), ldrow(At, r32, ks, hh), G2T);
#pragma unroll
                      for (int e = 0; e < 16; ++e) G2T[e] = (rowidx(e, hh) < r32) ? G2T[e] : 0.f;
                      const bf16x8_t g0 = accop<0>(G2T), g1 = accop<1>(G2T);
                      f32x16 Za = mm32(g0, v00, zero16); Za = mm32(g1, v01, Za); f32x16 Zb = mm32(g0, v10, zero16); Zb = mm32(g1, v11, Zb);
                      U0a = mm32(ty0, accop<0>(Za), zero16); U0a = mm32(ty1, accop<1>(Za), U0a); U0b = mm32(ty0, accop<0>(Zb), zero16); U0b = mm32(ty1, accop<1>(Zb), U0b); }
                    const bf16x8_t ua0 = accop<0>(U0a), ua1 = accop<1>(U0a), ub0 = accop<0>(U0b), ub1 = accop<1>(U0b);
                    f32x16 G3T = zero16;
                    { f32x16 G4T = zero16;
#pragma unroll
                      for (int ks = 0; ks < 4; ++ks) { const bf16x8_t fr = ldrow(Rt, r32, ks, hh); G3T = mm32(ldrow(Bt, r32, ks, hh), fr, G3T); G4T = mm32(ldrow(Kt, r32, ks, hh), fr, G4T); }
#pragma unroll
                      for (int e = 0; e < 16; ++e) { const bool keep = rowidx(e, hh) <= r32; G3T[e] = keep ? G3T[e] : 0.f; G4T[e] = keep ? G4T[e] : 0.f; }
                      const bf16x8_t g30 = accop<0>(G3T), g31 = accop<1>(G3T), g40 = accop<0>(G4T), g41 = accop<1>(G4T);
                      f32x16 Ya = mm32(g30, ua0, zero16); Ya = mm32(g31, ua1, Ya); Ya = mm32(g40, v00, Ya); Ya = mm32(g41, v01, Ya);
                      f32x16 Yb = mm32(g30, ub0, zero16); Yb = mm32(g31, ub1, Yb); Yb = mm32(g40, v10, Yb); Yb = mm32(g41, v11, Yb);
                      u32x4 o0, o1;
                      o0.x = cvtpk(Ya[0], Ya[1]); o0.y = cvtpk(Ya[2], Ya[3]); o0.z = cvtpk(Ya[4], Ya[5]); o0.w = cvtpk(Ya[6], Ya[7]);
                      o1.x = cvtpk(Ya[8], Ya[9]); o1.y = cvtpk(Ya[10], Ya[11]); o1.z = cvtpk(Ya[12], Ya[13]); o1.w = cvtpk(Ya[14], Ya[15]);
                      *(u32x4*)(rec + 12288 + 4096 + lane * 32) = o0; *(u32x4*)(rec + 12288 + 4096 + lane * 32 + 16) = o1;
                      o0.x = cvtpk(Yb[0], Yb[1]); o0.y = cvtpk(Yb[2], Yb[3]); o0.z = cvtpk(Yb[4], Yb[5]); o0.w = cvtpk(Yb[6], Yb[7]);
                      o1.x = cvtpk(Yb[8], Yb[9]); o1.y = cvtpk(Yb[10], Yb[11]); o1.z = cvtpk(Yb[12], Yb[13]); o1.w = cvtpk(Yb[14], Yb[15]);
                      *(u32x4*)(rec + 12288 + 6144 + 4096 + lane * 32) = o0; *(u32x4*)(rec + 12288 + 6144 + 4096 + lane * 32 + 16) = o1; }
                    f32x16 Wa0 = mm32(ty0, ldpermcol<0>(At, r32, hh), zero16); Wa0 = mm32(ty1, ldpermcol<1>(At, r32, hh), Wa0);
                    f32x16 Wa1 = mm32(ty0, ldpermcol<0>(At, 32 + r32, hh), zero16); Wa1 = mm32(ty1, ldpermcol<1>(At, 32 + r32, hh), Wa1);
                    const bf16x8_t wa00 = accop<0>(Wa0), wa01 = accop<1>(Wa0), wa10 = accop<0>(Wa1), wa11 = accop<1>(Wa1);
                    { const bf16x8_t g30 = accop<0>(G3T), g31 = accop<1>(G3T);
                      f32x16 Ra = mm32(wa00, g30, zero16); Ra = mm32(wa01, g31, Ra); f32x16 Rb_ = mm32(wa10, g30, zero16); Rb_ = mm32(wa11, g31, Rb_);
#pragma unroll
                      for (int e = 0; e < 16; ++e) { const int kr = rowidx(e, hh); Ra[e] += bf2f(Rt[r32 * 72 + kr]); Rb_[e] += bf2f(Rt[r32 * 72 + 32 + kr]); }
                      *(bf16x8_t*)(rec + 8192 + 0 * 1024 + lane * 16) = accop<0>(Ra); *(bf16x8_t*)(rec + 8192 + 1 * 1024 + lane * 16) = accop<1>(Ra);
                      *(bf16x8_t*)(rec + 8192 + 2 * 1024 + lane * 16) = accop<0>(Rb_); *(bf16x8_t*)(rec + 8192 + 3 * 1024 + lane * 16) = accop<1>(Rb_); }
                    const bf16x8_t b00 = ldpermcol<0>(Bt, r32, hh), b01 = ldpermcol<1>(Bt, r32, hh), b10 = ldpermcol<0>(Bt, 32 + r32, hh), b11 = ldpermcol<1>(Bt, 32 + r32, hh);
                    { const float pc0 = PCs[r32], pc1 = PCs[32 + r32];
#pragma unroll
                      for (int ij = 0; ij < 4; ++ij) { const int i = ij >> 1, j = ij & 1;
                          f32x16 M = mm32(i ? wa10 : wa00, j ? b10 : b00, zero16); M = mm32(i ? wa11 : wa01, j ? b11 : b01, M);
#pragma unroll
                          for (int e = 0; e < 16; ++e) { float m = M[e]; if (i == j) m += (rowidx(e, hh) == r32) ? 1.f : 0.f; M[e] = m * (j ? pc1 : pc0); }
                          *(bf16x8_t*)(rec + (ij * 2 + 0) * 1024 + lane * 16) = accop<0>(M); *(bf16x8_t*)(rec + (ij * 2 + 1) * 1024 + lane * 16) = accop<1>(M); } }
                    { const bf16x8_t k00 = ldpermcol<0>(Kt, r32, hh), k01 = ldpermcol<1>(Kt, r32, hh), k10 = ldpermcol<0>(Kt, 32 + r32, hh), k11 = ldpermcol<1>(Kt, 32 + r32, hh);
#pragma unroll
                      for (int ju = 0; ju < 4; ++ju) { const int j = ju >> 1, u = ju & 1;
                          f32x16 Dm = mm32(j ? b10 : b00, u ? ub0 : ua0, zero16); Dm = mm32(j ? b11 : b01, u ? ub1 : ua1, Dm);
                          Dm = mm32(j ? k10 : k00, u ? v10 : v00, Dm); Dm = mm32(j ? k11 : k01, u ? v11 : v01, Dm);
#pragma unroll
                          for (int e = 0; e < 16; ++e) Dm[e] *= PCs[32 * j + rowidx(e, hh)];
                          u32x4 o0, o1;
                          o0.x = cvtpk(Dm[0], Dm[1]); o0.y = cvtpk(Dm[2], Dm[3]); o0.z = cvtpk(Dm[4], Dm[5]); o0.w = cvtpk(Dm[6], Dm[7]);
                          o1.x = cvtpk(Dm[8], Dm[9]); o1.y = cvtpk(Dm[10], Dm[11]); o1.z = cvtpk(Dm[12], Dm[13]); o1.w = cvtpk(Dm[14], Dm[15]);
                          *(u32x4*)(rec + 12288 + u * 6144 + j * 2048 + lane * 32) = o0; *(u32x4*)(rec + 12288 + u * 6144 + j * 2048 + lane * 32 + 16) = o1; } }
                }
            }
        }
        { XcdBarrier xb_ = xbar; asm volatile("" : "+s"(xb_.bar)); xcd_barrier<false>(xb_); }
        if (IN(pb + 3)) { PHASE_IDS
            const int r32 = lane & 31, hh = lane >> 5;
            constexpr int SLOT = 18432, NCH = SEQ / 32, NSL = 7, AHEAD = 6;
            if (G > BATCH * NH * 2) { if (bx >= BATCH * NH * 2) convert_tables_fp6(INP(27), INP(28), U8, V8, USc, VSc, l, (bx - BATCH * NH * 2) * NWAVES + wave, (G - BATCH * NH * 2) * NWAVES, lane); }
            else convert_tables_fp6(INP(27), INP(28), U8, V8, USc, VSc, l, bx * NWAVES + wave, G * NWAVES, lane);
            for (int un = bx; un < BATCH * NH * 2; un += G) {
                const int bh = un >> 1, u = un & 1, b = bh >> 3, h = bh & 7;
                __syncthreads();
                const unsigned char* recs = SCN + (size_t)bh * NCH * 24576;
                const int lw = wave - 2;
#define S2_DMA(chunk_) do { if (wave >= 2) { LAS unsigned char* sl = lds + ((chunk_) % NSL) * SLOT; const unsigned char* rp = recs + (size_t)(chunk_) * 24576 + lane * 16; \
                    _Pragma("unroll") for (int q_ = 0; q_ < 3; ++q_) { const int p_ = lw * 3 + q_; const int so_ = p_ < 12 ? p_ * 1024 : 12288 + u * 6144 + (p_ - 12) * 1024; \
                        __builtin_amdgcn_global_load_lds((const unsigned*)(rp + so_), (LAS unsigned*)(sl + p_ * 1024), 16, 0, 0); } } } while (0)
#pragma unroll 1
                for (int c0 = 0; c0 < AHEAD; ++c0) S2_DMA(c0);
                asm volatile("s_waitcnt vmcnt(15)" ::: "memory");
                __builtin_amdgcn_s_barrier();
                f32x16 X0, X1;
                { float z_ = 0.f; asm volatile("" : "+v"(z_));
#pragma unroll
                for (int e = 0; e < 16; ++e) { X0[e] = z_; X1[e] = z_; } }
#define S2_FRAG(off) (*(const __attribute__((address_space(3))) bf16x8_t*)(sl + (off) + lane * 16))
#define S2_UNPK(dst, off) do { const u32x4 a0 = *(const LAS u32x4*)(sl + (off) + lane * 32), a1 = *(const LAS u32x4*)(sl + (off) + lane * 32 + 16); const unsigned wv[8] = {a0.x, a0.y, a0.z, a0.w, a1.x, a1.y, a1.z, a1.w}; \
                    _Pragma("unroll") for (int q = 0; q < 8; ++q) { (dst)[2 * q] = __uint_as_float(wv[q] << 16); (dst)[2 * q + 1] = __uint_as_float(wv[q] & 0xffff0000u); } } while (0)
#pragma unroll 1
                for (int n = 0; n < NCH; ++n) {
                    if (n + AHEAD < NCH) S2_DMA(n + AHEAD);
                    if (wave == 0) {
                        const LAS unsigned char* sl = lds + (n % NSL) * SLOT;
                        const bf16x8_t x00 = accop<0>(X0), x01 = accop<1>(X0), x10 = accop<0>(X1), x11 = accop<1>(X1);
                        f32x16 Yc, N0, N1;
                        S2_UNPK(Yc, 12288 + 4096); S2_UNPK(N0, 12288); S2_UNPK(N1, 12288 + 2048);
                        Yc = mm32(S2_FRAG(8192 + 0 * 1024), x00, Yc); Yc = mm32(S2_FRAG(8192 + 1 * 1024), x01, Yc); Yc = mm32(S2_FRAG(8192 + 2 * 1024), x10, Yc); Yc = mm32(S2_FRAG(8192 + 3 * 1024), x11, Yc);
                        N0 = mm32(S2_FRAG((0 * 2 + 0) * 1024), x00, N0); N0 = mm32(S2_FRAG((0 * 2 + 1) * 1024), x01, N0); N0 = mm32(S2_FRAG((2 * 2 + 0) * 1024), x10, N0); N0 = mm32(S2_FRAG((2 * 2 + 1) * 1024), x11, N0);
                        N1 = mm32(S2_FRAG((1 * 2 + 0) * 1024), x00, N1); N1 = mm32(S2_FRAG((1 * 2 + 1) * 1024), x01, N1); N1 = mm32(S2_FRAG((3 * 2 + 0) * 1024), x10, N1); N1 = mm32(S2_FRAG((3 * 2 + 1) * 1024), x11, N1);
                        X0 = N0; X1 = N1;
                        float* yp = Y + ((size_t)b * SEQ + (size_t)n * 32) * RW + h * HS + u * 32 + r32;
#pragma unroll
                        for (int e = 0; e < 16; ++e) yp[(size_t)rowidx(e, hh) * RW] = Yc[e];
                        asm volatile("s_waitcnt lgkmcnt(0)" ::: "memory");
                    } else if (wave >= 2) {
                        const int younger = (NCH - 1 - (n + 1)) < (AHEAD - 1) ? (NCH - 1 - (n + 1)) : (AHEAD - 1);
                        if (younger >= 5) asm volatile("s_waitcnt vmcnt(15)" ::: "memory"); else if (younger == 4) asm volatile("s_waitcnt vmcnt(12)" ::: "memory"); else if (younger == 3) asm volatile("s_waitcnt vmcnt(9)" ::: "memory");
                        else if (younger == 2) asm volatile("s_waitcnt vmcnt(6)" ::: "memory"); else if (younger == 1) asm volatile("s_waitcnt vmcnt(3)" ::: "memory"); else asm volatile("s_waitcnt vmcnt(0)" ::: "memory");
                    }
                    __builtin_amdgcn_s_barrier();
                }
#undef S2_FRAG
#undef S2_UNPK
#undef S2_DMA
            }
        }
        SEAM(pb + 3);

        if (IN(pb + 4)) { PHASE_IDS
            const int c8 = (tid & 63) * 8, hd = (tid & 63) >> 3, tsub = tid >> 6;
            const f32x4 lg0 = *(const f32x4*)(INP(19) + l * RW + c8), lg1 = *(const f32x4*)(INP(19) + l * RW + c8 + 4), lb0 = *(const f32x4*)(INP(20) + l * RW + c8), lb1 = *(const f32x4*)(INP(20) + l * RW + c8 + 4);
            for (int tile = bx; tile < T / 8; tile += G) {
                const int t = tile * 8 + tsub; const size_t o = (size_t)t * RW + c8;
                const f32x4 y0 = *(const f32x4*)(Y + o), y1 = *(const f32x4*)(Y + o + 4); const u32x4 gq = *(const u32x4*)(Gb + o), vq = *(const u32x4*)(BGb + o); const float bsum = BSUM[(size_t)t * NH + hd];
                float sm = (y0.x + y0.y) + (y0.z + y0.w) + (y1.x + y1.y) + (y1.z + y1.w);
                sm += dppf<0xB1>(sm); sm += dppf<0x4E>(sm); sm += dppf<0x141>(sm);
                const float mean = sm * (1.f / 64.f);
                const f32x4 d0 = y0 - mean, d1 = y1 - mean;
                float sq = (d0.x * d0.x + d0.y * d0.y) + (d0.z * d0.z + d0.w * d0.w) + (d1.x * d1.x + d1.y * d1.y) + (d1.z * d1.z + d1.w * d1.w);
                sq += dppf<0xB1>(sq); sq += dppf<0x4E>(sq); sq += dppf<0x141>(sq);
                const float rs = rsqrtf(sq * (1.f / 64.f) + GN_EPS);
                const f32x4 n0 = d0 * rs * lg0 + lb0, n1 = d1 * rs * lg1 + lb1;
                const unsigned gw_[4] = {gq.x, gq.y, gq.z, gq.w}, vw_[4] = {vq.x, vq.y, vq.z, vq.w}; const float nn[8] = {n0.x, n0.y, n0.z, n0.w, n1.x, n1.y, n1.z, n1.w}; unsigned ow[4];
#pragma unroll
                for (int i = 0; i < 4; ++i) { const float g0 = __uint_as_float(gw_[i] << 16), g1 = __uint_as_float(gw_[i] & 0xffff0000u), v0 = __uint_as_float(vw_[i] << 16), v1 = __uint_as_float(vw_[i] & 0xffff0000u);
                    ow[i] = pk2(nn[2 * i] * g0 + v0 * bsum, nn[2 * i + 1] * g1 + v1 * bsum); }
                *(u32x4*)(MIX + (size_t)t * D + c8) = (u32x4){ow[0], ow[1], ow[2], ow[3]};
            }
        }
        SEAM(pb + 4);
        if (IN(pb + 5)) { PHASE_IDS
            pg8::Gemm g{MIX, WoutT + (size_t)l * D * D, T, D, D}; pg8::StaticOrder S; S.init(T, D, G, bx);
            pg8::EpiResGate E{xin, X, modl + 2 * D};
            pg8::gemm_phase<pg8::EpiResGate, pg8::StaticOrder, true, true>(lds, g, S, E, tid); }
        SEAM(pb + 5);
        if (IN(pb + 6)) { PHASE_IDS const float* gamma = INP(24) + l * D;
            for (int row = gw; row < T; row += NGW) { const int b = row / SEQ; norm_mod_row(X + (size_t)row * D, gamma, modl + (size_t)b * 6 * D + 3 * D, modl + (size_t)b * 6 * D + 4 * D, H + (size_t)row * D, lane); } }
        SEAM(pb + 6);
        if (IN(pb + 7)) { PHASE_IDS
            pg8::Gemm g{H, PqT + (size_t)l * PH * PQ * D, T, PH * PQ, D}; pg8::StaticOrder S; S.init(T, PH * PQ, G, bx);
            pg8::EpiBf16<0> E{Q, PH * PQ, nullptr, 0, 0, 1.f};
            pg8::gemm_phase<pg8::EpiBf16<0>, pg8::StaticOrder, true, true>(lds, g, S, E, tid); }
        SEAM(pb + 7);

        if (IN(pb + 8)) { PHASE_IDS
            const bf16* KEYSl = KEYS + (size_t)l * PH * 2 * NKEYS * PHALF;
            LAS unsigned char* scr = lds + wave * 2048 + lane * 32;
            constexpr int KST = 136;
            lbf16* kl = (lbf16*)(lds + 16384);
            const int r = lane & 31, hh = lane >> 5;
            for (int item = bx; item < (T / 256) * PH; item += G) {
                const int h = item & 7, tok = (item >> 3) * 256 + wave * 32 + r;
                __syncthreads();
                { u32x4 kq[8];
#pragma unroll
                  for (int q = 0; q < 8; ++q) { const int ch = tid + q * NTHR; kq[q] = *(const u32x4*)(KEYSl + (size_t)(h * 2) * NKEYS * PHALF + (size_t)ch * 8); }
#pragma unroll
                  for (int q = 0; q < 8; ++q) { const int ch = tid + q * NTHR, row = ch >> 4, cc = ch & 15; *(__attribute__((address_space(3))) u32x4*)(kl + row * KST + cc * 8) = kq[q]; } }
                __syncthreads();
                unsigned sp0[16], sp1[16];
#pragma unroll
                for (int e = 0; e < 16; ++e) { sp0[e] = 0u; sp1[e] = 0u; }
#pragma unroll 1
                for (int p = 0; p < 2; ++p) {
                    const bf16* qp = Q + (size_t)tok * (PH * PQ) + h * PQ + p * PHALF + 8 * hh;
                    const lbf16* kp_ = kl + (p * NKEYS + r) * KST + 8 * hh;
                    bf16x8_t bq[8];
#pragma unroll
                    for (int ks = 0; ks < 8; ++ks) bq[ks] = *(const bf16x8_t*)(qp + ks * 16);
                    unsigned best[16];
#pragma unroll
                    for (int e = 0; e < 16; ++e) best[e] = 0u;
#pragma unroll 1
                    for (int kt = 0; kt < 4; ++kt) {
                        f32x16 acc;
#pragma unroll
                        for (int e = 0; e < 16; ++e) acc[e] = 0.f;
#pragma unroll
                        for (int ks = 0; ks < 8; ++ks) { const bf16x8_t ak = *(const __attribute__((address_space(3))) bf16x8_t*)(kp_ + kt * 32 * KST + ks * 16); acc = __builtin_amdgcn_mfma_f32_32x32x16_bf16(ak, bq[ks], acc, 0, 0, 0); }
                        unsigned g[16];
#pragma unroll
                        for (int e = 0; e < 16; ++e) g[e] = pack_key7(acc[e], kt * 32 + (e & 3) + 8 * (e >> 2) + 4 * hh);
                        sort16_desc(g);
                        merge_top16(best, g);
                    }
                    unsigned ob[16];
#pragma unroll
                    for (int e = 0; e < 16; ++e) ob[e] = shflxu(best[e], lane, 32);
                    merge_top16(best, ob);
#pragma unroll
                    for (int e = 0; e < 16; ++e) { sp0[e] = p == 0 ? best[e] : sp0[e]; sp1[e] = p == 0 ? sp1[e] : best[e]; }
                }
                unsigned c2[32];
                stage2_cands(sp0, sp1, hh, c2);
                sort16_desc(c2); sort16_desc(c2 + 16); merge_top16(c2, c2 + 16);
                { unsigned ob[16];
#pragma unroll
                  for (int e = 0; e < 16; ++e) ob[e] = shflxu(c2[e], lane, 32);
                  merge_top16(c2, ob); }
#pragma unroll
                for (int e = 0; e < 16; e += 4) {
                    *(LAS unsigned*)(scr + e) = (127u - (sp0[e] & 127u)) | ((127u - (sp0[e + 1] & 127u)) << 8) | ((127u - (sp0[e + 2] & 127u)) << 16) | ((127u - (sp0[e + 3] & 127u)) << 24);
                    *(LAS unsigned*)(scr + 16 + e) = (127u - (sp1[e] & 127u)) | ((127u - (sp1[e + 1] & 127u)) << 8) | ((127u - (sp1[e + 2] & 127u)) << 16) | ((127u - (sp1[e + 3] & 127u)) << 24); }
                asm volatile("s_waitcnt lgkmcnt(0)" ::: "memory");
                float sm[16]; int ex[16];
#pragma unroll
                for (int e = 0; e < 16; ++e) { const unsigned key = c2[e]; sm[e] = unpack_key8(key); const int i0 = (key >> 4) & 15, j0 = key & 15; ex[e] = (int)scr[i0] * NKEYS + (int)scr[16 + j0]; }
                float den = 0.f;
#pragma unroll
                for (int e = 0; e < 16; ++e) { sm[e] = expf(sm[e] - unpack_key8(c2[0])); den += sm[e]; }
                const float inv = 1.f / den;
                if (hh == 0) {
                    int* ip = IDX + (size_t)tok * NE + h * TOPK; float* gp = GATE + (size_t)tok * NE + h * TOPK;
#pragma unroll
                    for (int e = 0; e < 16; e += 4) { *(int4*)(ip + e) = make_int4(ex[e], ex[e + 1], ex[e + 2], ex[e + 3]); *(f32x4*)(gp + e) = (f32x4){sm[e] * inv, sm[e + 1] * inv, sm[e + 2] * inv, sm[e + 3] * inv}; }
                }
                asm volatile("s_waitcnt lgkmcnt(0)" ::: "memory");
            }
        }
        SEAM(pb + 8);

        if (IN(pb + 9)) { PHASE_IDS
            const unsigned char* Ul = U8 + (size_t)l * NEXP * ROWB; const unsigned char* Vtl = V8 + (size_t)l * NEXP * ROWB; const float* usl = USc + l * NEXP; const float* vsl = VSc + l * NEXP; const float* lnf = INP(29);
            const bool fin = (l == DEPTH - 1);
            typedef float f32x2_t __attribute__((ext_vector_type(2)));
            const __amdgpu_buffer_rsrc_t ru = __builtin_amdgcn_make_buffer_rsrc((void*)Ul, 0, NEXP * ROWB, 0x00020000), rv = __builtin_amdgcn_make_buffer_rsrc((void*)Vtl, 0, NEXP * ROWB, 0x00020000);
            typedef float f32x32_t __attribute__((ext_vector_type(32))); typedef unsigned u32x3_t __attribute__((ext_vector_type(3))); typedef unsigned u32x6_t __attribute__((ext_vector_type(6))); typedef unsigned u32x16_t __attribute__((ext_vector_type(16))); typedef __bf16 bf16x2_t __attribute__((ext_vector_type(2)));
            LAS float* pl = (LAS float*)(lds + wave * 18432);
            constexpr int TW = 4;
            for (int tb = gw; tb < T; tb += TW * NGW) {
#define TOKV(k) (tb + (k) * NGW < T)
#define TOK(k) (TOKV(k) ? tb + (k) * NGW : tb)
                unsigned si[TW][2]; float sus[TW][2], sgv[TW][2];
                LAS u32x4* hl = (LAS u32x4*)(pl + 32 * 68);
                { float g0[TW], g1[TW]; int lane_s; asm volatile("v_mbcnt_lo_u32_b32 %0, -1, 0\n\tv_mbcnt_hi_u32_b32 %0, -1, %0" : "=v"(lane_s));
#pragma unroll
                  for (int k = 0; k < TW; ++k) { const size_t o = (size_t)TOK(k) * NE + lane_s; si[k][0] = ((unsigned)IDX[o] << 7) | (unsigned)lane_s; si[k][1] = ((unsigned)IDX[o + 64] << 7) | (unsigned)(64 + lane_s); g0[k] = GATE[o]; g1[k] = GATE[o + 64]; }
#pragma unroll
                  for (int kk = 2; kk <= 128; kk <<= 1) {
#pragma unroll
                      for (int j = kk >> 1; j > 0; j >>= 1) {
                          if (j == 64) {
#pragma unroll
                              for (int k = 0; k < TW; ++k) { const unsigned a = si[k][0], b = si[k][1]; si[k][0] = a < b ? a : b; si[k][1] = a < b ? b : a; } }
                          else { const bool lower = (lane_s & j) == 0, tm0 = lower == ((lane_s & kk) == 0), tm1 = lower == (((lane_s + 64) & kk) == 0); const int pa = (lane_s ^ j) << 2;
#pragma unroll
                              for (int k = 0; k < TW; ++k) { const unsigned a = si[k][0], b = si[k][1], p0 = (unsigned)__builtin_amdgcn_ds_bpermute(pa, (int)a), p1 = (unsigned)__builtin_amdgcn_ds_bpermute(pa, (int)b);
                                  si[k][0] = tm0 ? (a < p0 ? a : p0) : (a < p0 ? p0 : a); si[k][1] = tm1 ? (b < p1 ? b : p1) : (b < p1 ? p1 : b); } }
                          __builtin_amdgcn_sched_barrier(0);
                      } }
#pragma unroll
                  for (int k = 0; k < TW; ++k) {
#pragma unroll
                      for (int r = 0; r < 2; ++r) { const unsigned key = si[k][r]; const int a = (int)(key & 63u) << 2; const int ga = __builtin_amdgcn_ds_bpermute(a, __float_as_int(g0[k])), gb = __builtin_amdgcn_ds_bpermute(a, __float_as_int(g1[k]));
                          const unsigned ix = key >> 7; si[k][r] = ix; sus[k][r] = usl[ix]; sgv[k][r] = __int_as_float((key & 64u) ? gb : ga) * vsl[ix]; } }
#pragma unroll
                  for (int k = 0; k < TW; ++k) { const bf16* hr = H + (size_t)TOK(k) * D + lane_s * 16; hl[(k * 2) * 64 + lane_s] = *(const u32x4*)hr; hl[(k * 2 + 1) * 64 + lane_s] = *(const u32x4*)(hr + 8); }
                }
                __builtin_amdgcn_sched_barrier(0);
#define ROWLD(dst, rs, ixv, ln) dst = __builtin_amdgcn_raw_buffer_load_b96(rs, voff, __builtin_amdgcn_readlane((int)(ixv), (ln)) * ROWB, 0)
#define LOADQ(buf, rs, ixv, ln0) do { _Pragma("unroll") for (int j_ = 0; j_ < 8; ++j_) ROWLD((buf)[j_], rs, ixv, (ln0) + j_); __builtin_amdgcn_sched_barrier(0); } while (0)
#define CVT2(a, b) const f32x32_t f_ = __builtin_amdgcn_cvt_scalef32_pk32_f32_fp6((u32x6_t){(a).x, (a).y, (a).z, (b).x, (b).y, (b).z}, 1.0f)
#define PR(i) __builtin_shufflevector(f_, f_, 2 * (i), 2 * (i) + 1)
#define DOTQ(buf, e0) do { _Pragma("unroll") for (int j_ = 0; j_ < 8; j_ += 2) { \
                        const u32x16_t g_ = __builtin_bit_cast(u32x16_t, __builtin_amdgcn_cvt_scalef32_pk32_bf16_fp6((u32x6_t){(buf)[j_].x, (buf)[j_].y, (buf)[j_].z, (buf)[j_ + 1].x, (buf)[j_ + 1].y, (buf)[j_ + 1].z}, 1.0f));     \
                        float a0_ = 0.f, a1_ = 0.f, b0_ = 0.f, b1_ = 0.f; \
                        _Pragma("unroll") for (int i_ = 0; i_ < 8; i_ += 2) { a0_ = DOT2(g_[i_], hpk[i_], a0_); b0_ = DOT2(g_[8 + i_], hpk[i_], b0_); a1_ = DOT2(g_[i_ + 1], hpk[i_ + 1], a1_); b1_ = DOT2(g_[9 + i_], hpk[i_ + 1], b1_); } \
                        pl[((e0) + j_) * 68 + lane_u] = a0_ + a1_; pl[((e0) + j_ + 1) * 68 + lane_u] = b0_ + b1_; __builtin_amdgcn_sched_barrier(0); } } while (0)
#define DOT2(x_, y_, c_) __builtin_amdgcn_fdot2_f32_bf16(__builtin_bit_cast(bf16x2_t, (unsigned)(x_)), __builtin_bit_cast(bf16x2_t, (unsigned)(y_)), (c_), false)
#define AXPYQ(buf, k, cfv, ln0) do { _Pragma("unroll") for (int j_ = 0; j_ < 8; j_ += 2) { CVT2((buf)[j_], (buf)[j_ + 1]); \
                        const float ca = __int_as_float(__builtin_amdgcn_readlane(__float_as_int(cfv), (ln0) + j_)), cb = __int_as_float(__builtin_amdgcn_readlane(__float_as_int(cfv), (ln0) + j_ + 1)); \
                        acc2[k][0] += ca * PR(0); acc2[k][1] += ca * PR(1); acc2[k][2] += ca * PR(2); acc2[k][3] += ca * PR(3); acc2[k][4] += ca * PR(4); acc2[k][5] += ca * PR(5); acc2[k][6] += ca * PR(6); acc2[k][7] += ca * PR(7); \
                        acc2[k][0] += cb * PR(8); acc2[k][1] += cb * PR(9); acc2[k][2] += cb * PR(10); acc2[k][3] += cb * PR(11); acc2[k][4] += cb * PR(12); acc2[k][5] += cb * PR(13); acc2[k][6] += cb * PR(14); acc2[k][7] += cb * PR(15); __builtin_amdgcn_sched_barrier(0); } } while (0)
                u32x3_t ba[8], bb_[8];
                int lane_u; asm volatile("v_mbcnt_lo_u32_b32 %0, -1, 0\n\tv_mbcnt_hi_u32_b32 %0, -1, %0" : "=v"(lane_u)); const int voff = lane_u * 12;
                LOADQ(ba, ru, si[0][0], 0);
#pragma unroll 1
                for (int c = 0; c < 16; ++c) {
                    const int lb = (c & 7) * 8; const bool r1 = c >= 8;
#pragma unroll
                    for (int k = 0; k < TW; ++k) {
                        unsigned hpk[8];
                        { const u32x4 h0 = hl[(k * 2) * 64 + lane_u], h1 = hl[(k * 2 + 1) * 64 + lane_u]; hpk[0] = h0.x; hpk[1] = h0.y; hpk[2] = h0.z; hpk[3] = h0.w; hpk[4] = h1.x; hpk[5] = h1.y; hpk[6] = h1.z; hpk[7] = h1.w; }
                        if (k & 1) { if (k < TW - 1) LOADQ(ba, ru, r1 ? si[k + 1][1] : si[k + 1][0], lb); else { const int cn = (c + 1) & 15; const __amdgpu_buffer_rsrc_t rn = c < 15 ? ru : rv; LOADQ(ba, rn, (cn >= 8) ? si[0][1] : si[0][0], (cn & 7) * 8); } DOTQ(bb_, k * 8); }
                        else { LOADQ(bb_, ru, r1 ? si[k + 1][1] : si[k + 1][0], lb); DOTQ(ba, k * 8); }
                    }
                    __builtin_amdgcn_wave_barrier(); asm volatile("s_waitcnt lgkmcnt(0)" ::: "memory");
                    float dsum;
                    { const LAS float* rp = pl + (lane_u & 31) * 68 + (lane_u >> 5) * 32; f32x4 s4 = *(const LAS f32x4*)rp;
#pragma unroll
                      for (int j = 1; j < 8; ++j) s4 += *(const LAS f32x4*)(rp + j * 4);
                      dsum = (s4.x + s4.y) + (s4.z + s4.w); }
                    dsum += shflx(dsum, lane_u, 32);
                    __builtin_amdgcn_wave_barrier(); asm volatile("s_waitcnt lgkmcnt(0)" ::: "memory");
                    const bool home = (lane_u >> 3) == (c & 7);
#pragma unroll
                    for (int k = 0; k < TW; ++k) {
                        const float dv = __int_as_float(__builtin_amdgcn_ds_bpermute((k * 8 + (lane_u & 7)) << 2, __float_as_int(dsum)));
                        const float cf = (r1 ? sgv[k][1] : sgv[k][0]) * gelu_erf(dv * (r1 ? sus[k][1] : sus[k][0]));
                        if (r1) sgv[k][1] = home ? cf : sgv[k][1]; else sgv[k][0] = home ? cf : sgv[k][0]; }
                    __builtin_amdgcn_sched_barrier(0);
                }
                f32x2_t acc2[TW][8];
#pragma unroll
                for (int k = 0; k < TW; ++k) {
#pragma unroll
                    for (int i = 0; i < 8; ++i) acc2[k][i] = (f32x2_t){0.f, 0.f}; }
#pragma unroll 1
                for (int c = 0; c < 16; ++c) {
                    const int lb = (c & 7) * 8; const bool r1 = c >= 8;
#pragma unroll
                    for (int k = 0; k < TW; ++k) {
                        const float cfk = r1 ? sgv[k][1] : sgv[k][0];
                        if (k & 1) { if (k < TW - 1) LOADQ(ba, rv, r1 ? si[k + 1][1] : si[k + 1][0], lb); else { const int cn = (c + 1) & 15; LOADQ(ba, rv, (cn >= 8) ? si[0][1] : si[0][0], (cn & 7) * 8); }     AXPYQ(bb_, k, cfk, lb); }
                        else { LOADQ(bb_, rv, r1 ? si[k + 1][1] : si[k + 1][0], lb); AXPYQ(ba, k, cfk, lb); }
                    }
                }
#undef ROWLD
#undef LOADQ
#undef CVT2
#undef PR
#undef DOTQ
#undef DOT2
#undef AXPYQ
                { int ln; asm volatile("v_mbcnt_lo_u32_b32 %0, -1, 0\n\tv_mbcnt_hi_u32_b32 %0, -1, %0" : "=v"(ln));
                  LAS f32x4* al = (LAS f32x4*)pl + ln;
#pragma unroll
                  for (int k = 0; k < TW; ++k) {
#pragma unroll
                      for (int q = 0; q < 4; ++q) al[(k * 4 + q) * 64] = (f32x4){acc2[k][q * 2].x, acc2[k][q * 2].y, acc2[k][q * 2 + 1].x, acc2[k][q * 2 + 1].y}; }
                  asm volatile("s_waitcnt lgkmcnt(0)" ::: "memory"); __builtin_amdgcn_sched_barrier(0);
#pragma unroll 1
                  for (int k = 0; k < TW; ++k) { const int t = tb + k * NGW; if (t >= T) break; const int b = t / SEQ;
                    float* xr = X + (size_t)t * D + ln * 16; const float* g2 = modl + (size_t)b * 6 * D + 5 * D + ln * 16;
                    f32x4 xv[4]; float ss = 0.f;
#pragma unroll
                    for (int q = 0; q < 4; ++q) { const f32x4 xo = *(const f32x4*)(xr + q * 4), gg = *(const f32x4*)(g2 + q * 4);
                        xv[q] = xo + gg * al[(k * 4 + q) * 64]; ss += (xv[q].x * xv[q].x + xv[q].y * xv[q].y) + (xv[q].z * xv[q].z + xv[q].w * xv[q].w); }
                    const float rs = rsqrtf(wave_sum(ss, ln) * (1.f / D) + NORM_EPS);
                    if (fin) {
#pragma unroll
                        for (int q = 0; q < 4; ++q) *(f32x4*)(xr + q * 4) = xv[q] * rs * *(const f32x4*)(lnf + ln * 16 + q * 4); }
                    else {
                        const float* gam = INP(4) + (l + 1) * D + ln * 16; const float* mn = MOD + (size_t)(l + 1) * BATCH * 6 * D + (size_t)b * 6 * D + ln * 16; u32x4 ho[2];
#pragma unroll
                        for (int q = 0; q < 4; ++q) { *(f32x4*)(xr + q * 4) = xv[q];
                            const f32x4 y = xv[q] * rs * *(const f32x4*)(gam + q * 4) * (*(const f32x4*)(mn + D + q * 4) + 1.f) + *(const f32x4*)(mn + q * 4);
                            if (q & 1) { ho[q >> 1].z = pk2(y.x, y.y); ho[q >> 1].w = pk2(y.z, y.w); } else { ho[q >> 1].x = pk2(y.x, y.y); ho[q >> 1].y = pk2(y.z, y.w); } }
                        *(u32x4*)(H + (size_t)t * D + ln * 16) = ho[0]; *(u32x4*)(H + (size_t)t * D + ln * 16 + 8) = ho[1]; }
                  }
                  asm volatile("s_waitcnt lgkmcnt(0)" ::: "memory"); __builtin_amdgcn_wave_barrier();
                }
#undef TOK
#undef TOKV
            }
        }
    }
#undef modl
#undef xin
#undef IN
#undef SEAM
}
#undef MOD
#undef H
#undef PROJ
#undef Q
#undef MIX
#undef Rb
#undef Kb
#undef V0
#undef V1
#undef KKb
#undef Bb
#undef Gb
#undef BGb
#undef Wd
#undef Y
#undef IDX
#undef GATE
#undef WinT
#undef WoutT
#undef PqT
#undef KEYS
#undef QB
#undef SH
#undef WUPT
#undef AUPT
#undef GUPT
#undef VUPT
#undef PWT
#undef INVN
#undef BSUM
#undef SCN
#undef U8
#undef V8
#undef USc
#undef VSc
#undef INP
#undef PHASE_IDS

extern "C" void kernel_launch(void* const* d_in, const int* in_sizes, int n_in, void* d_out, int out_size, void* d_ws, size_t ws_size, hipStream_t stream) {
    if (n_in != 30 || ws_size < WS_END) { fprintf(stderr, "kernel_launch: unexpected n_in %d / ws_size %zu\n", n_in, ws_size); return; }
    static int grid = 0;
    if (grid == 0) {
        int dev = 0, cus = 0, per_cu = 0;
        (void)hipGetDevice(&dev); (void)hipDeviceGetAttribute(&cus, hipDeviceAttributeMultiprocessorCount, dev);
        if (hipFuncSetAttribute((const void*)mega, hipFuncAttributeMaxDynamicSharedMemorySize, LDS_BYTES) != hipSuccess) { fprintf(stderr, "hipFuncSetAttribute failed\n"); grid = -1; return; }
        if (hipOccupancyMaxActiveBlocksPerMultiprocessor(&per_cu, (const void*)mega, NTHR, LDS_BYTES) != hipSuccess || per_cu < 1) { fprintf(stderr, "occupancy query failed (%d)\n", per_cu); per_cu = 1; }
        (void)hipGetLastError();
        grid = (cus > 0 ? cus : 256) * 1;
    }
    if (grid < 0) return;
    Args a{}; for (int i = 0; i < 30; ++i) a.in[i] = (const float*)d_in[i]; a.out = (float*)d_out; a.ws = (unsigned char*)d_ws;
    a.ph_lo = 0; a.ph_hi = NPH;
    if (hipMemsetAsync(d_ws, 0, 65536, stream) != hipSuccess) { fprintf(stderr, "memset failed\n"); return; }
    void* kargs[] = {&a};
    hipError_t e = hipLaunchCooperativeKernel((const void*)mega, dim3(grid), dim3(NTHR), kargs, LDS_BYTES, stream);
    if (e != hipSuccess) fprintf(stderr, "cooperative launch failed: %s (grid %d)\n", hipGetErrorString(e), grid);
}
```

```cpp
#include <hip/hip_runtime.h>
#include <hip/hip_cooperative_groups.h>
namespace cg = cooperative_groups;
#include <cstdio>
#include <cstdint>
#include <cmath>

constexpr int D = 1024, BATCH = 4, SEQ = 4096, T = BATCH * SEQ, DEPTH = 2;
constexpr int RW = 512, HS = 64, NH = 8;
constexpr int DL = 64, AL = 64, MVL = 32, GL = 128;
constexpr int RWKV_COLS = 3 * RW + DL + AL + GL;
constexpr int PW = 512, PG = 128;
constexpr int IN_COLS = RWKV_COLS + PW;
constexpr int LDP = 2560;
constexpr int NKEYS = 128, NEXP = NKEYS * NKEYS, PH = 8, PQ = 256, PHALF = 128, TOPK = 16;
constexpr int NE = PH * TOPK;
constexpr float NORM_EPS = 1e-6f, GN_EPS = 64e-5f;

typedef unsigned short bf16;
__device__ __forceinline__ float bf2f(bf16 u) { return __uint_as_float((unsigned)u << 16); }
typedef float cvt_f32x2 __attribute__((ext_vector_type(2))); typedef __bf16 cvt_bf16x2 __attribute__((ext_vector_type(2)));
__device__ __forceinline__ unsigned cvtpk(float lo, float hi) { const cvt_f32x2 v = {lo, hi}; const cvt_bf16x2 b = __builtin_convertvector(v, cvt_bf16x2); return __builtin_bit_cast(unsigned, b); }
__device__ __forceinline__ bf16 f2bf(float f) { return (bf16)cvtpk(f, 0.f); }

constexpr size_t MiB = 1u << 20;
constexpr size_t WS_MOD = 1 * MiB;
constexpr size_t WS_US = 1 * MiB + 256 * 1024;
constexpr size_t WS_VS = 1 * MiB + 512 * 1024;
constexpr size_t WS_H = 2 * MiB;
constexpr size_t WS_PROJ = 34 * MiB;
constexpr size_t WS_Q = WS_PROJ;
constexpr size_t WS_R = 114 * MiB;
constexpr size_t WS_K = 130 * MiB;
constexpr size_t WS_V0 = 146 * MiB;
constexpr size_t WS_V1 = 162 * MiB;
constexpr size_t WS_KK = 178 * MiB;
constexpr size_t WS_B = 194 * MiB;
constexpr size_t WS_G = 210 * MiB;
constexpr size_t WS_BG = 226 * MiB;
constexpr size_t WS_W = 242 * MiB;
constexpr size_t WS_Y = 274 * MiB;
constexpr size_t WS_MIX = 306 * MiB;
constexpr size_t WS_IDX = 338 * MiB;
constexpr size_t WS_GATE = 346 * MiB;
constexpr size_t WS_WIN_T = 354 * MiB;
constexpr size_t WS_WOUT_T = 364 * MiB;
constexpr size_t WS_PQ_T = 368 * MiB;
constexpr size_t WS_KEYS = 376 * MiB;
constexpr size_t WS_U = 378 * MiB;
constexpr size_t WS_V = 442 * MiB;
constexpr size_t WS_QB = 410 * MiB;
constexpr size_t WS_SH = 426 * MiB;
constexpr size_t WS_LORA = 428 * MiB;
constexpr size_t WS_INVN = 430 * MiB;
constexpr size_t WS_BSUM = 431 * MiB;
constexpr size_t WS_SCN = 2 * MiB;
constexpr size_t WS_END = 506 * MiB;

template <int CTRL> __device__ __forceinline__ float dppf(float x) { return __int_as_float(__builtin_amdgcn_update_dpp(0, __float_as_int(x), CTRL, 0xF, 0xF, false)); }
__device__ __forceinline__ float red16(float x) { x += dppf<0xB1>(x); x += dppf<0x4E>(x); x += dppf<0x141>(x); x += dppf<0x140>(x); return x; }
__device__ __forceinline__ float shflx(float v, int lane, int off) { return __int_as_float(__builtin_amdgcn_ds_bpermute((lane ^ off) << 2, __float_as_int(v))); }
__device__ __forceinline__ unsigned shflxu(unsigned v, int lane, int off) { return (unsigned)__builtin_amdgcn_ds_bpermute((lane ^ off) << 2, (int)v); }
__device__ __forceinline__ void sort128(unsigned& k0, unsigned& k1, int lane) {
#pragma unroll
    for (int k = 2; k <= 128; k <<= 1) {
#pragma unroll
        for (int j = k >> 1; j > 0; j >>= 1) {
            if (j == 64) { const unsigned lo = k0 < k1 ? k0 : k1, hi = k0 < k1 ? k1 : k0; k0 = lo; k1 = hi; }
            else {
                const unsigned p0 = shflxu(k0, lane, j), p1 = shflxu(k1, lane, j);
                const bool lower = (lane & j) == 0, up0 = (lane & k) == 0, up1 = ((lane + 64) & k) == 0;
                const unsigned mn0 = k0 < p0 ? k0 : p0, mx0 = k0 < p0 ? p0 : k0, mn1 = k1 < p1 ? k1 : p1, mx1 = k1 < p1 ? p1 : k1;
                k0 = (lower == up0) ? mn0 : mx0; k1 = (lower == up1) ? mn1 : mx1;
            }
        }
    }
}
__device__ __forceinline__ float wave_sum(float v, int lane) { v = red16(v); v += shflx(v, lane, 16); v += shflx(v, lane, 32); return v; }
__device__ __forceinline__ float sigmoidf_(float x) { return 1.f / (1.f + expf(-x)); }

namespace pg8 {
#define PG8_LAS __attribute__((address_space(3)))
typedef unsigned short bf16_t;
typedef short bf16x8 __attribute__((ext_vector_type(8)));
typedef float f32x4 __attribute__((ext_vector_type(4)));
typedef unsigned u32x4 __attribute__((ext_vector_type(4)));
constexpr int BM = 256, BK = 64, HALF = 128, HTB = HALF * BK * 2  , STAGE_BYTES = 8 * HTB, NXCD = 8, WGM = 8;

__host__ __device__ __forceinline__ int lds_byte(int r, int c) { const int st = (r >> 4) * 2 + (c >> 5), rr = r & 15, cc = c & 31, ob = rr * 64 + cc * 2; return st * 1024 + (ob ^ (((ob >> 9) & 1) << 5)); }
__host__ __device__ __forceinline__ void stage_rc(int b, int& R, int& C) { const int st = b / 1024, sb = b % 1024, swz = sb ^ (((sb >> 9) & 1) << 5); R = (st >> 1) * 16 + swz / 64; C = (st & 1) * 32 + (swz % 64) / 2; }
__host__ __device__ __forceinline__ int perm32(int rho) { const int n = rho >> 4, i = rho & 15; return 8 * (i >> 2) + 4 * n + (i & 3); }

struct Unit { int pm, pn; };
struct Gemm { const bf16_t* A; const bf16_t* Bt; int M, N, K; };

struct StaticOrder {
    int nM, nN, nwg, G, c;
    __host__ __device__ void init(int M, int N, int G_, int c_) { nM = M / BM; nN = N / BM; nwg = nM * nN; G = G_; c = c_; }
    __host__ __device__ bool next(int i, Unit& u) const {
        const long L = (long)i * G + c; if (L >= nwg) return false;
        int wgid = (int)L; { const int q = nwg / NXCD, r = nwg % NXCD, xcd = wgid % NXCD, off = wgid / NXCD; wgid = (xcd < r ? xcd * (q + 1) : r * (q + 1) + (xcd - r) * q) + off; }
        const int nig = WGM * nN, gid = wgid / nig, fm = gid * WGM, gsz = (nM - fm) < WGM ? (nM - fm) : WGM;
        u.pm = fm + ((wgid % nig) % gsz); u.pn = (wgid % nig) / gsz; return true;
    }
    __device__ __forceinline__ void a_ready(const Unit&) const {}
    __device__ __forceinline__ void done(const Unit&) const {}
};

__device__ __forceinline__ unsigned cvt_pk_bf16(float lo, float hi) { unsigned r; asm volatile("v_cvt_pk_bf16_f32 %0, %1, %2" : "=v"(r) : "v"(lo), "v"(hi)); return r; }
typedef float f32x2 __attribute__((ext_vector_type(2)));
__device__ __forceinline__ f32x2 gelu_pk(f32x2 v) {
    const f32x2 av = __builtin_elementwise_abs(v), d = av * 0.2316418882f + 1.0f;
    f32x2 t; t.x = __builtin_amdgcn_rcpf(d.x); t.y = __builtin_amdgcn_rcpf(d.y);
    f32x2 q = t * 0.5307027145f + (-0.7265760135f); q = q * t + 0.7107068705f; q = q * t + (-0.142248368f); q = q * t + 0.127414796f; q = q * t;
    const f32x2 s = (v * v) * (-0.72134752044f);
    f32x2 e; e.x = __builtin_amdgcn_exp2f(s.x); e.y = __builtin_amdgcn_exp2f(s.y);
    const f32x2 m = v * (q * e), r = v - m;
    f32x2 o; o.x = v.x < 0.f ? m.x : r.x; o.y = v.y < 0.f ? m.y : r.y; return o;
}

template <int ACT  > struct EpiBf16 {
    static constexpr bool PERM = true, AFTER_DRAIN = false; static_assert(ACT == 0 || ACT == 1, "EpiBf16: ACT is 0 (none) or 1 (gelu_pk)");
    bf16_t* O; int ldc; const float* bias; int split_cols; size_t split_stride; float scale0;
    __device__ __forceinline__ void operator()(const f32x4 (&acc)[2][2][4][2], const Unit& u, int wr, int wc, int fr, int fq) const {
        const int row0 = u.pm * BM + wr * 64 + fr; int colt = u.pn * BM; bf16_t* base = O;
        float sc = 1.f; if (split_cols) { const int t = colt / split_cols; base += (size_t)t * split_stride; colt -= t * split_cols; if (t == 0) sc = scale0; }
        const int col0 = colt + wc * 32 + 8 * fq, bcol0 = u.pn * BM + wc * 32 + 8 * fq;
        f32x4 bv[2][2];
#pragma unroll
        for (int bj = 0; bj < 2; ++bj)
#pragma unroll
            for (int n = 0; n < 2; ++n) bv[bj][n] = bias ? *(const f32x4*)(bias + bcol0 + bj * HALF + 4 * n) : (f32x4){0.f, 0.f, 0.f, 0.f};
#pragma unroll
        for (int ai = 0; ai < 2; ++ai)
#pragma unroll
            for (int m = 0; m < 4; ++m) { bf16_t* rowp = base + (size_t)(row0 + ai * HALF + m * 16) * ldc + col0;
#pragma unroll
                for (int bj = 0; bj < 2; ++bj) { f32x4 v0 = acc[ai][bj][m][0] + bv[bj][0], v1 = acc[ai][bj][m][1] + bv[bj][1];
                    if (ACT == 1) { f32x2 a = gelu_pk((f32x2){v0[0], v0[1]}), b = gelu_pk((f32x2){v0[2], v0[3]}), c = gelu_pk((f32x2){v1[0], v1[1]}), d = gelu_pk((f32x2){v1[2], v1[3]});
                        v0 = (f32x4){a.x, a.y, b.x, b.y}; v1 = (f32x4){c.x, c.y, d.x, d.y}; }
                    v0 = v0 * sc; v1 = v1 * sc; u32x4 w; w.x = cvt_pk_bf16(v0[0], v0[1]); w.y = cvt_pk_bf16(v0[2], v0[3]); w.z = cvt_pk_bf16(v1[0], v1[1]); w.w = cvt_pk_bf16(v1[2], v1[3]);
                    *(u32x4*)(rowp + bj * HALF) = w; } }
    }
};

struct EpiProj {
    static constexpr bool PERM = true, AFTER_DRAIN = false;
    bf16_t* O; int ldc; bf16_t* P; int pool0, pw;
    __device__ __forceinline__ void operator()(const f32x4 (&acc)[2][2][4][2], const Unit& u, int wr, int wc, int fr, int fq) const {
        const int row0 = u.pm * BM + wr * 64 + fr; int colt = u.pn * BM; bf16_t* base = O; int ld = ldc;
        if (colt >= pool0 && colt < pool0 + pw) { base = P; ld = pw; colt -= pool0; }
        const int col0 = colt + wc * 32 + 8 * fq;
#pragma unroll
        for (int ai = 0; ai < 2; ++ai)
#pragma unroll
            for (int m = 0; m < 4; ++m) { bf16_t* rowp = base + (size_t)(row0 + ai * HALF + m * 16) * ld + col0;
#pragma unroll
                for (int bj = 0; bj < 2; ++bj) { const f32x4 v0 = acc[ai][bj][m][0], v1 = acc[ai][bj][m][1];
                    u32x4 w; w.x = cvt_pk_bf16(v0[0], v0[1]); w.y = cvt_pk_bf16(v0[2], v0[3]); w.z = cvt_pk_bf16(v1[0], v1[1]); w.w = cvt_pk_bf16(v1[2], v1[3]);
                    *(u32x4*)(rowp + bj * HALF) = w; } }
    }
};
struct EpiResGate {
    static constexpr bool PERM = false, AFTER_DRAIN = false;
    const float* xold; float* X; const float* gate;
    __device__ __forceinline__ void operator()(const f32x4 (&acc)[2][2][4][2], const Unit& u, int wr, int wc, int fr, int fq) const {
        const int col0 = u.pn * BM + wc * 32 + 4 * fq; const int b = (u.pm * BM) / SEQ;
        const float* gp = gate + (size_t)b * 6 * D + col0;
#pragma unroll
        for (int bj = 0; bj < 2; ++bj)
#pragma unroll
            for (int n = 0; n < 2; ++n) { const f32x4 gv = *(const f32x4*)(gp + bj * HALF + n * 16);
#pragma unroll
                for (int ai = 0; ai < 2; ++ai)
#pragma unroll
                    for (int m = 0; m < 4; ++m) { const size_t off = (size_t)(u.pm * BM + ai * HALF + wr * 64 + m * 16 + fr) * D + col0 + bj * HALF + n * 16;
                        const f32x4 xo = *(const f32x4*)(xold + off); *(f32x4*)(X + off) = xo + gv * acc[ai][bj][m][n]; } }
    }
};
template <class Epi, class Sched, bool ALIGN_EPI = false, bool SP2 = false>
__device__ __forceinline__ void gemm_phase(PG8_LAS unsigned char* lds, const Gemm g, const Sched& S, const Epi& E, int tid) {
    asm volatile("" : "+v"(tid));
    const int wid = __builtin_amdgcn_readfirstlane(tid >> 6), lane = tid & 63, wr = wid >> 2, wc = wid & 3, fr = lane & 15, fq = lane >> 4;
    const int K = g.K, nt = K / BK;
    unsigned voffA[2], voffB[2];
#pragma unroll
    for (int i = 0; i < 2; ++i) { int R, C; stage_rc(tid * 16 + i * 8192, R, C); const int Rb = Epi::PERM ? ((R & ~31) + perm32(R & 31)) : R;
        voffA[i] = (unsigned)(R * K + C) * 2u; voffB[i] = (unsigned)(Rb * K + C) * 2u; }
    const size_t kstep = (size_t)(BK * 2);
    const size_t hstep = (size_t)HALF * K * 2;
    const size_t tstep = 2 * hstep;
    const unsigned ldsw = (unsigned)wid * 1024u;
    const int aoff = lds_byte(wr * 64 + fr, fq * 8), boff = lds_byte(wc * 32 + fr, fq * 8);
#define PG8_SA(b, h) (((b) * 2 + (h)) * HTB)
#define PG8_SB(b, h) ((4 + (b) * 2 + (h)) * HTB)
#define PG8_STAGE(bufoff, gbase, voff) do { _Pragma("unroll") for (int _i = 0; _i < 2; ++_i) \
        __builtin_amdgcn_global_load_lds((const unsigned*)((const char*)(gbase) + (voff)[_i]), (PG8_LAS unsigned*)(lds + (bufoff) + ldsw + _i * 8192), 16, 0, 0); } while (0)
#define PG8_LDA(dst, b, h) do { _Pragma("unroll") for (int m = 0; m < 4; ++m) _Pragma("unroll") for (int k = 0; k < 2; ++k) dst[m][k] = *(const PG8_LAS bf16x8*)(lds + PG8_SA(b, h) + aoff + m * 2048 + k * 1024); } while (0)
#define PG8_LDB(dst, b, h) do { _Pragma("unroll") for (int n = 0; n < 2; ++n) _Pragma("unroll") for (int k = 0; k < 2; ++k) dst[n][k] = *(const PG8_LAS bf16x8*)(lds + PG8_SB(b, h) + boff + n * 2048 + k * 1024); } while (0)
#define PG8_MMA(ai, bj, At, Bt) do { __builtin_amdgcn_s_setprio(1); _Pragma("unroll") for (int m = 0; m < 4; ++m) _Pragma("unroll") for (int n = 0; n < 2; ++n) _Pragma("unroll") for (int k = 0; k < 2; ++k) \
        acc[ai][bj][m][n] = __builtin_amdgcn_mfma_f32_16x16x32_bf16(Bt[n][k], At[m][k], acc[ai][bj][m][n], 0, 0, 0); __builtin_amdgcn_s_setprio(0); } while (0)
#define PG8_WAIT_V(n) asm volatile("s_waitcnt vmcnt(" #n ")" ::: "memory")
#define PG8_WAIT_L(n) asm volatile("s_waitcnt lgkmcnt(" #n ")" ::: "memory")
#define PG8_BAR __builtin_amdgcn_s_barrier()
#define PG8_SCHED __builtin_amdgcn_sched_barrier(0)
    Unit cur, nxt; int ui = 0;
    if (!S.next(0, cur)) return;
    f32x4 acc[2][2][4][2];
#pragma unroll
    for (int a = 0; a < 2; ++a)
#pragma unroll
        for (int b = 0; b < 2; ++b)
#pragma unroll
            for (int m = 0; m < 4; ++m)
#pragma unroll
                for (int n = 0; n < 2; ++n) acc[a][b][m][n] = (f32x4){0.f, 0.f, 0.f, 0.f};
    bf16x8 At[4][2], B0[2][2], B1[2][2];
    const char* cA = (const char*)g.A + (size_t)cur.pm * tstep; const char* cB = (const char*)g.Bt + (size_t)cur.pn * tstep;
    S.a_ready(cur);
    if constexpr (SP2) {
        PG8_STAGE(PG8_SB(0, 0), cB, voffB); PG8_STAGE(PG8_SB(0, 1), cB + hstep, voffB); PG8_STAGE(PG8_SA(0, 0), cA, voffA); PG8_STAGE(PG8_SA(0, 1), cA + hstep, voffA);
        if (wr == 1) PG8_BAR;
        PG8_WAIT_V(2); PG8_BAR;
        PG8_STAGE(PG8_SB(1, 0), cB + kstep, voffB); PG8_STAGE(PG8_SA(1, 0), cA + kstep, voffA); PG8_STAGE(PG8_SB(1, 1), cB + hstep + kstep, voffB);
        PG8_WAIT_V(6); PG8_BAR;
    } else {
        PG8_STAGE(PG8_SB(0, 0), cB, voffB); PG8_STAGE(PG8_SA(0, 0), cA, voffA); PG8_STAGE(PG8_SB(0, 1), cB + hstep, voffB); PG8_STAGE(PG8_SA(0, 1), cA + hstep, voffA);
        if (wr == 1) PG8_BAR;
        PG8_WAIT_V(4); PG8_BAR;
        PG8_STAGE(PG8_SB(1, 0), cB + kstep, voffB); PG8_STAGE(PG8_SA(1, 0), cA + kstep, voffA); PG8_STAGE(PG8_SB(1, 1), cB + hstep + kstep, voffB);
        PG8_WAIT_V(6); PG8_BAR;
    }
    for (;;) {
        const bool has_next = S.next(ui + 1, nxt);
        const char* nA = has_next ? (const char*)g.A + (size_t)nxt.pm * tstep : cA; const char* nB = has_next ? (const char*)g.Bt + (size_t)nxt.pn * tstep : cB;
        for (int t = 0; t < nt; t += 2) {
            const bool last = (t == nt - 2);
            const char* a1 = cA + (size_t)(t + 1) * kstep;
            const char* a2 = last ? nA : cA + (size_t)(t + 2) * kstep; const char* b2 = last ? nB : cB + (size_t)(t + 2) * kstep;
            const char* a3 = a2 + kstep; const char* b3 = b2 + kstep;
            if (last && has_next) S.a_ready(nxt);
            if constexpr (SP2) {
            PG8_LDB(B0, 0, 0); PG8_LDB(B1, 0, 1); PG8_SCHED; PG8_LDA(At, 0, 0); PG8_STAGE(PG8_SA(1, 1), a1 + hstep, voffA);
            PG8_WAIT_V(8); PG8_WAIT_L(0); PG8_BAR; PG8_MMA(0, 0, At, B0); PG8_MMA(0, 1, At, B1); PG8_BAR; PG8_SCHED;
            PG8_LDA(At, 0, 1); PG8_STAGE(PG8_SB(0, 0), b2, voffB); PG8_STAGE(PG8_SB(0, 1), b2 + hstep, voffB); PG8_STAGE(PG8_SA(0, 0), a2, voffA);
            PG8_WAIT_V(8); PG8_WAIT_L(0); PG8_BAR; PG8_MMA(1, 0, At, B0); PG8_MMA(1, 1, At, B1); PG8_BAR; PG8_SCHED;
            PG8_LDB(B0, 1, 0); PG8_LDB(B1, 1, 1); PG8_SCHED; PG8_LDA(At, 1, 0); PG8_STAGE(PG8_SA(0, 1), a2 + hstep, voffA);
            PG8_WAIT_V(8); PG8_WAIT_L(0); PG8_BAR; PG8_MMA(0, 0, At, B0); PG8_MMA(0, 1, At, B1); PG8_BAR; PG8_SCHED;
            PG8_LDA(At, 1, 1); PG8_STAGE(PG8_SB(1, 0), b3, voffB); PG8_STAGE(PG8_SB(1, 1), b3 + hstep, voffB); PG8_STAGE(PG8_SA(1, 0), a3, voffA);
            PG8_WAIT_V(8); PG8_WAIT_L(0); PG8_BAR; PG8_MMA(1, 0, At, B0); PG8_MMA(1, 1, At, B1); PG8_BAR; PG8_SCHED;
            } else {
            PG8_LDB(B0, 0, 0); PG8_SCHED; PG8_LDA(At, 0, 0); PG8_STAGE(PG8_SA(1, 1), a1 + hstep, voffA);
            PG8_WAIT_L(8); PG8_BAR; PG8_WAIT_L(0); PG8_MMA(0, 0, At, B0); PG8_BAR; PG8_SCHED;
            PG8_LDB(B1, 0, 1); PG8_STAGE(PG8_SB(0, 0), b2, voffB);
            PG8_BAR; PG8_WAIT_L(0); PG8_MMA(0, 1, At, B1); PG8_BAR;
            PG8_LDA(At, 0, 1); PG8_STAGE(PG8_SA(0, 0), a2, voffA);
            PG8_BAR; PG8_WAIT_L(0); PG8_MMA(1, 0, At, B0); PG8_BAR; PG8_SCHED;
            PG8_STAGE(PG8_SB(0, 1), b2 + hstep, voffB);
            PG8_WAIT_V(6); PG8_BAR; PG8_MMA(1, 1, At, B1); PG8_BAR;
            PG8_LDB(B0, 1, 0); PG8_SCHED; PG8_LDA(At, 1, 0); PG8_STAGE(PG8_SA(0, 1), a2 + hstep, voffA);
            PG8_WAIT_L(8); PG8_BAR; PG8_WAIT_L(0); PG8_MMA(0, 0, At, B0); PG8_BAR; PG8_SCHED;
            PG8_LDB(B1, 1, 1); PG8_STAGE(PG8_SB(1, 0), b3, voffB);
            PG8_BAR; PG8_WAIT_L(0); PG8_MMA(0, 1, At, B1); PG8_BAR;
            PG8_LDA(At, 1, 1); PG8_STAGE(PG8_SA(1, 0), a3, voffA);
            PG8_BAR; PG8_WAIT_L(0); PG8_MMA(1, 0, At, B0); PG8_BAR; PG8_SCHED;
            PG8_STAGE(PG8_SB(1, 1), b3 + hstep, voffB);
            PG8_WAIT_V(6); PG8_BAR; PG8_MMA(1, 1, At, B1); PG8_BAR;
            }
        }
        if constexpr (ALIGN_EPI) { if (wr == 0) PG8_BAR; }
        if constexpr (!Epi::AFTER_DRAIN) { int le_; asm volatile("v_mbcnt_lo_u32_b32 %0, -1, 0\n\tv_mbcnt_hi_u32_b32 %0, -1, %0" : "=v"(le_)); E(acc, cur, wr, wc, le_ & 15, le_ >> 4); S.done(cur); }
        if (!has_next) break;
#pragma unroll
        for (int a = 0; a < 2; ++a)
#pragma unroll
            for (int b = 0; b < 2; ++b)
#pragma unroll
                for (int m = 0; m < 4; ++m)
#pragma unroll
                    for (int n = 0; n < 2; ++n) acc[a][b][m][n] = (f32x4){0.f, 0.f, 0.f, 0.f};
        cur = nxt; cA = nA; cB = nB; ++ui;
        if constexpr (ALIGN_EPI) { if (wr == 1) PG8_BAR; }
    }
    PG8_WAIT_V(0);
    if constexpr (!ALIGN_EPI) { if (wr == 0) PG8_BAR; }
    PG8_BAR;
    if constexpr (Epi::AFTER_DRAIN) { E.fused(acc, cur, wr, wc, fr, fq, lds, wid, lane); S.done(cur); }
#undef PG8_SA
#undef PG8_SB
#undef PG8_STAGE
#undef PG8_LDA
#undef PG8_LDB
#undef PG8_MMA
#undef PG8_WAIT_V
#undef PG8_WAIT_L
#undef PG8_BAR
#undef PG8_SCHED
}
}

#define LAS __attribute__((address_space(3)))
constexpr int NWAVES = 8, NTHR = 512;
constexpr int LDS_BYTES = 147456;
constexpr int NPH = 21;
typedef float f32x4 __attribute__((ext_vector_type(4)));
typedef unsigned u32x4 __attribute__((ext_vector_type(4)));

struct Args { const float* in[30]; float* out; unsigned char* ws; int ph_lo, ph_hi; };

__device__ __forceinline__ unsigned pk2(float lo, float hi) { return cvtpk(lo, hi); }

__device__ __forceinline__ void p0_transpose_item(const float* W, int K, int N, bf16* WT, int row_off, LAS float* scr, int item, int lane) {
    const int nblk = N / 32, kb = item / nblk, nb = item % nblk, k0 = 64 * kb, n0 = 32 * nb;
#pragma unroll 8
    for (int i = 0; i < 32; ++i) { const int kk = 2 * i + (lane >> 5); scr[kk * 33 + (lane & 31)] = W[(size_t)(k0 + kk) * N + n0 + (lane & 31)]; }
    asm volatile("s_waitcnt lgkmcnt(0)" ::: "memory");
    const int c = lane & 7;
#pragma unroll
    for (int j = 0; j < 4; ++j) { const int n = (lane >> 3) + 8 * j; const LAS float* s = scr + (8 * c) * 33 + n;
        u32x4 o; o.x = pk2(s[0 * 33], s[1 * 33]); o.y = pk2(s[2 * 33], s[3 * 33]); o.z = pk2(s[4 * 33], s[5 * 33]); o.w = pk2(s[6 * 33], s[7 * 33]);
        *(u32x4*)(WT + (size_t)(row_off + n0 + n) * K + k0 + 8 * c) = o; }
    asm volatile("s_waitcnt lgkmcnt(0)" ::: "memory");
}

__device__ __forceinline__ void norm_mod_row(const float* xr, const float* gamma, const float* sh, const float* sc, bf16* orow, int lane) {
    f32x4 v[4]; float ss = 0.f;
#pragma unroll
    for (int j = 0; j < 4; ++j) { v[j] = *(const f32x4*)(xr + j * 256 + lane * 4); ss += (v[j].x * v[j].x + v[j].y * v[j].y) + (v[j].z * v[j].z + v[j].w * v[j].w); }
    const float rs = rsqrtf(wave_sum(ss, lane) * (1.f / D) + NORM_EPS);
#pragma unroll
    for (int j = 0; j < 4; ++j) { const int d = j * 256 + lane * 4; const f32x4 g = *(const f32x4*)(gamma + d), a = *(const f32x4*)(sc + d), s = *(const f32x4*)(sh + d);
        const f32x4 y = v[j] * rs * g * (a + 1.f) + s; uint2 o; o.x = pk2(y.x, y.y); o.y = pk2(y.z, y.w); *(uint2*)(orow + d) = o; }
}


#define XB_TMO      128
#define XB_XCNT(j)  (256  + 64 * (j))
#define XB_XSUB(j)  (1280 + 64 * (j))
#define XB_XGEN(j)  (2304 + 64 * (j))
#define XB_TOP      3328
#define XB_TOPGEN   3392
#define XCD_BAR_WORDS 3456
#define XB_SPIN_CAP (1u << 18)

__device__ __forceinline__ unsigned xb_ld(unsigned* p)              { return __hip_atomic_load(p, __ATOMIC_RELAXED, __HIP_MEMORY_SCOPE_AGENT); }
__device__ __forceinline__ unsigned xb_add(unsigned* p, unsigned v) { return __hip_atomic_fetch_add(p, v, __ATOMIC_RELAXED, __HIP_MEMORY_SCOPE_AGENT); }
__device__ __forceinline__ unsigned xb_xcc_id() { return (unsigned)__builtin_amdgcn_s_getreg((3 << 11) | 20) & 0xFu; }
#define XB_SPIN(cond, bar) do { unsigned _sp = 0; while (cond) { __builtin_amdgcn_s_sleep(1); \
    if ((++_sp & 255u) == 0u) { if (xb_ld(&(bar)[XB_TMO])) break; if (_sp > XB_SPIN_CAP) { atomicAdd(&(bar)[XB_TMO], 1u); break; } } } } while (0)

struct XcdBarrier {
    unsigned* bar; unsigned x; int w0;
    volatile __attribute__((address_space(3))) unsigned* st;
};

__device__ __forceinline__ XcdBarrier xcd_barrier_post(unsigned* bar, volatile __attribute__((address_space(3))) unsigned* st) {
    XcdBarrier b; b.bar = bar; b.x = xb_xcc_id(); b.st = st; b.w0 = __builtin_amdgcn_readfirstlane((int)threadIdx.x >> 6);
    if (threadIdx.x == 0) (void)xb_add(&bar[XB_XCNT(b.x)], 1u);
    return b;
}
__device__ __forceinline__ void xcd_barrier_complete(unsigned* bar, unsigned x, unsigned& nloc, unsigned& nx) {
    const unsigned G = gridDim.x * gridDim.y * gridDim.z;
    unsigned sum, cnt, mine, sp = 0u;
    for (;;) {
        sum = 0u; cnt = 0u; mine = 0u;
#pragma unroll
        for (unsigned j = 0; j < 16; ++j) { const unsigned c = xb_ld(&bar[XB_XCNT(j)]); sum += c; cnt += (c > 0u) ? 1u : 0u; }
        mine = xb_ld(&bar[XB_XCNT(x)]);
        if (sum == G) break;
        __builtin_amdgcn_s_sleep(1);
        if ((++sp & 255u) == 0u) { if (xb_ld(&bar[XB_TMO])) break; if (sp > XB_SPIN_CAP) { atomicAdd(&bar[XB_TMO], 1u); break; } }
    }
    nloc = mine > 0u ? mine : 1u; nx = cnt > 0u ? cnt : 1u;
}

template <bool FIRST> __device__ __forceinline__ void xcd_barrier(const XcdBarrier& b) {
    asm volatile("s_waitcnt vmcnt(0)" ::: "memory");
    __syncthreads();
    int lid_; asm volatile("v_mbcnt_lo_u32_b32 %0, -1, 0\n\tv_mbcnt_hi_u32_b32 %0, -1, %0" : "=v"(lid_));
    if (b.w0 == 0 && lid_ == 0) {
        unsigned* bar = b.bar;
        __builtin_amdgcn_s_waitcnt(0);
        unsigned nloc = b.st[0], nx = b.st[1];
        if (FIRST && nloc == 0u) { xcd_barrier_complete(bar, b.x, nloc, nx); b.st[0] = nloc; b.st[1] = nx; }
        const unsigned old = xb_add(&bar[XB_XSUB(b.x)], 1u);
        const unsigned gen = old / nloc;
        if (old + 1u == (gen + 1u) * nloc) {
            __builtin_amdgcn_fence(__ATOMIC_RELEASE, "agent");
            asm volatile("s_waitcnt vmcnt(0)" ::: "memory");
            const unsigned og = xb_add(&bar[XB_TOP], 1u);
            const unsigned tg = og / nx;
            if (og + 1u == (tg + 1u) * nx) xb_add(&bar[XB_TOPGEN], 1u);
            else XB_SPIN(xb_ld(&bar[XB_TOPGEN]) == tg, bar);
            __builtin_amdgcn_fence(__ATOMIC_ACQUIRE, "agent");
            xb_add(&bar[XB_XGEN(b.x)], 1u);
            asm volatile("s_waitcnt vmcnt(0)" ::: "memory");
        } else {
            XB_SPIN(xb_ld(&bar[XB_XGEN(b.x)]) == gen, bar);
            __builtin_amdgcn_fence(__ATOMIC_ACQUIRE, "agent");
            asm volatile("s_waitcnt vmcnt(0)" ::: "memory");
        }
    }
    __syncthreads();
}


__device__ __forceinline__ unsigned mono_u32(float f) { unsigned u = __float_as_uint(f); return (u & 0x80000000u) ? ~u : (u | 0x80000000u); }
__device__ __forceinline__ float demono_u32(unsigned u) { return __uint_as_float((u & 0x80000000u) ? (u & 0x7FFFFFFFu) : ~u); }
__device__ __forceinline__ unsigned pack_key7(float f, int idx) { return (mono_u32(f) & 0xFFFFFF80u) | (unsigned)(127 - idx); }
__device__ __forceinline__ float unpack_key7(unsigned k) { return demono_u32((k & 0xFFFFFF80u) | 0x40u); }
__device__ __forceinline__ float unpack_key8(unsigned k) { return demono_u32((k & 0xFFFFFF00u) | 0x80u); }
__device__ __forceinline__ void ce_desc(unsigned& a, unsigned& b) { const unsigned hi = a > b ? a : b, lo = a > b ? b : a; a = hi; b = lo; }
__device__ __forceinline__ void sort16_desc(unsigned* v) {
#pragma unroll
    for (int k = 2; k <= 16; k <<= 1)
#pragma unroll
        for (int j = k >> 1; j > 0; j >>= 1)
#pragma unroll
            for (int i = 0; i < 16; ++i) { const int l = i ^ j; if (l > i) { if ((i & k) == 0) ce_desc(v[i], v[l]); else ce_desc(v[l], v[i]); } }
}
__device__ __forceinline__ void bmerge16_desc(unsigned* v) {
#pragma unroll
    for (int j = 8; j > 0; j >>= 1)
#pragma unroll
        for (int i = 0; i < 16; ++i) { const int l = i ^ j; if (l > i) ce_desc(v[i], v[l]); }
}
__device__ __forceinline__ void merge_top16(unsigned* a, const unsigned* b) {
#pragma unroll
    for (int i = 0; i < 16; ++i) { const unsigned o = b[15 - i]; a[i] = a[i] > o ? a[i] : o; }
    bmerge16_desc(a);
}
__device__ __forceinline__ void stage2_cands(const unsigned* s0, const unsigned* s1, int hh, unsigned* c) {
    float A[16], B[16];
#pragma unroll
    for (int i = 0; i < 16; ++i) { const float f0 = unpack_key7(s0[i]), f1 = unpack_key7(s1[i]); A[i] = hh ? f1 : f0; B[i] = hh ? f0 : f1; }
    int n = 0;
#pragma unroll
    for (int i = 0; i < 4; ++i)
#pragma unroll
        for (int j = i; j < 16; ++j) { if ((i + 1) * (j + 1) > 16) continue;
            const float val = A[i] + B[j]; const unsigned id = hh ? (unsigned)((j << 4) | i) : (unsigned)((i << 4) | j);
            unsigned key = (mono_u32(val) & 0xFFFFFF00u) | id; if (hh && i == j) key = 0u; c[n++] = key; }
#pragma unroll
    for (; n < 32; ++n) c[n] = 0u;
}

typedef short bf16x8_t __attribute__((ext_vector_type(8)));
typedef float f32x16 __attribute__((ext_vector_type(16)));
__device__ __forceinline__ float gelu_erf(float a) { return 0.5f * a * (1.f + erff(a * 0.70710678118654752f)); }


typedef __attribute__((address_space(3))) bf16 lbf16;

__device__ __forceinline__ f32x16 mm32(bf16x8_t a, bf16x8_t b, f32x16 c) { return __builtin_amdgcn_mfma_f32_32x32x16_bf16(a, b, c, 0, 0, 0); }
__device__ __forceinline__ bf16x8_t frag_from_u32x4(unsigned x, unsigned y, unsigned z, unsigned w) { typedef unsigned u4 __attribute__((ext_vector_type(4))); u4 t = {x, y, z, w}; return __builtin_bit_cast(bf16x8_t, t); }
template <int S> __device__ __forceinline__ bf16x8_t accop(const f32x16& z) {
    return frag_from_u32x4(cvtpk(z[8 * S], z[8 * S + 1]), cvtpk(z[8 * S + 2], z[8 * S + 3]), cvtpk(z[8 * S + 4], z[8 * S + 5]), cvtpk(z[8 * S + 6], z[8 * S + 7])); }
template <int S> __device__ __forceinline__ bf16x8_t ldpermcol(const lbf16* a, int col, int hh) {
    const lbf16* p = a + (16 * S + 4 * hh) * 72 + col;
    const unsigned e0 = p[0], e1 = p[72], e2 = p[144], e3 = p[216], e4 = p[8 * 72], e5 = p[9 * 72], e6 = p[10 * 72], e7 = p[11 * 72];
    return frag_from_u32x4(e0 | (e1 << 16), e2 | (e3 << 16), e4 | (e5 << 16), e6 | (e7 << 16)); }
__device__ __forceinline__ bf16x8_t ldrow(const lbf16* a, int row, int ks, int hh) { return *(const __attribute__((address_space(3))) bf16x8_t*)(a + row * 72 + ks * 16 + 8 * hh); }
__device__ __forceinline__ int rowidx(int e, int hh) { return (e & 3) + 8 * (e >> 2) + 4 * hh; }

constexpr int ROWB = 768;
__device__ __forceinline__ unsigned fp6code(float x, float sc) {
    const float t = fabsf(x) * sc;
    const float r = t < 16.f ? __builtin_rintf(t) : (t < 32.f ? 8.f + __builtin_rintf(t * 0.5f) : 16.f + __builtin_rintf(t * 0.25f));
    unsigned c = (unsigned)r; c = c > 31u ? 31u : c;
    return c | (x < 0.f ? 32u : 0u);
}
__device__ __forceinline__ void convert_tables_fp6(const float* pu, const float* pv, unsigned char* u8, unsigned char* v8, float* usc, float* vsc, int l, int wv, int nw, int lane) {
    for (int rr0 = wv * 2; rr0 < 2 * NEXP; rr0 += nw * 2) {
        f32x4 v[2][4]; float m[2];
#pragma unroll
        for (int rr = 0; rr < 2; ++rr) { const int q = rr0 + rr; const size_t row = (size_t)l * NEXP + (q < NEXP ? q : q - NEXP); const float* sp_ = (q < NEXP ? pu : pv) + row * D + lane * 16;
#pragma unroll
            for (int k = 0; k < 4; ++k) v[rr][k] = *(const f32x4*)(sp_ + k * 4); }
#pragma unroll
        for (int rr = 0; rr < 2; ++rr) { float mm = 0.f;
#pragma unroll
            for (int k = 0; k < 4; ++k) mm = fmaxf(fmaxf(mm, fmaxf(fabsf(v[rr][k].x), fabsf(v[rr][k].y))), fmaxf(fabsf(v[rr][k].z), fabsf(v[rr][k].w)));
#pragma unroll
            for (int o = 1; o < 64; o <<= 1) mm = fmaxf(mm, shflx(mm, lane, o));
            m[rr] = mm; }
#pragma unroll
        for (int rr = 0; rr < 2; ++rr) { const int q = rr0 + rr; const size_t row = (size_t)l * NEXP + (q < NEXP ? q : q - NEXP); const float sc = m[rr] > 0.f ? 60.f / m[rr] : 1.f;
            unsigned c[16];
#pragma unroll
            for (int k = 0; k < 4; ++k) { c[k * 4] = fp6code(v[rr][k].x, sc); c[k * 4 + 1] = fp6code(v[rr][k].y, sc); c[k * 4 + 2] = fp6code(v[rr][k].z, sc); c[k * 4 + 3] = fp6code(v[rr][k].w, sc); }
            const unsigned o0 = c[0] | (c[1] << 6) | (c[2] << 12) | (c[3] << 18) | (c[4] << 24) | (c[5] << 30);
            const unsigned o1 = (c[5] >> 2) | (c[6] << 4) | (c[7] << 10) | (c[8] << 16) | (c[9] << 22) | (c[10] << 28);
            const unsigned o2 = (c[10] >> 4) | (c[11] << 2) | (c[12] << 8) | (c[13] << 14) | (c[14] << 20) | (c[15] << 26);
            unsigned* op = (unsigned*)((q < NEXP ? u8 : v8) + row * ROWB + lane * 12);
            op[0] = o0; op[1] = o1; op[2] = o2;
            if (lane == 0) (q < NEXP ? usc : vsc)[row] = m[rr] > 0.f ? m[rr] * (1.f / 7.5f) : 1.f; }
    }
}

__global__ void __launch_bounds__(NTHR, 2) mega(Args args) {
    extern __shared__ __attribute__((aligned(16))) unsigned char lds_raw[];
    LAS unsigned char* lds = (LAS unsigned char*)lds_raw;
    const int G = gridDim.x, bx = blockIdx.x, NGW = G * NWAVES;
    const int wave0 = __builtin_amdgcn_readfirstlane((int)threadIdx.x >> 6);
    typedef const unsigned char __attribute__((address_space(4))) kbyte;
#define PHASE_IDS int tid; asm volatile("v_mbcnt_lo_u32_b32 %0, -1, 0\n\tv_mbcnt_hi_u32_b32 %0, -1, %0" : "=v"(tid)); tid += wave0 * 64;     const int lane = tid & 63, wave = __builtin_amdgcn_readfirstlane(tid >> 6), gw = bx * NWAVES + wave; (void)lane; (void)gw; \
    kbyte* kp = (kbyte*)__builtin_amdgcn_kernarg_segment_ptr(); asm volatile("" : "+s"(kp)); \
    unsigned char* const ws = (unsigned char*)*(__attribute__((address_space(1))) unsigned char* const __attribute__((address_space(4)))*)(kp + 31 * 8); float* const X = (float*)*(__attribute__((address_space(1))) float* const __attribute__((address_space(4)))*)(kp + 30 * 8); (void)ws; (void)X;
#define INP(i) ((const float*)(*(const __attribute__((address_space(1))) float* const __attribute__((address_space(4)))*)(kp + (i) * 8)))
#define MOD ((float*)(ws + WS_MOD))
#define H ((bf16*)(ws + WS_H))
#define PROJ ((bf16*)(ws + WS_PROJ))
#define Q ((bf16*)(ws + WS_Q))
#define MIX ((bf16*)(ws + WS_MIX))
#define Rb ((bf16*)(ws + WS_R))
#define Kb ((bf16*)(ws + WS_K))
#define V0 ((bf16*)(ws + WS_V0))
#define V1 ((bf16*)(ws + WS_V1))
#define KKb ((bf16*)(ws + WS_KK))
#define Bb ((bf16*)(ws + WS_B))
#define Gb ((bf16*)(ws + WS_G))
#define BGb ((bf16*)(ws + WS_BG))
#define Wd ((float*)(ws + WS_W))
#define Y ((float*)(ws + WS_Y))
#define QB ((float*)(ws + WS_QB))
#define POOLIN ((bf16*)(ws + WS_QB))
#define SH ((float*)(ws + WS_SH))
#define WUPT ((bf16*)(ws + WS_LORA))
#define AUPT ((bf16*)(ws + WS_LORA + 131072))
#define GUPT ((bf16*)(ws + WS_LORA + 262144))
#define VUPT ((bf16*)(ws + WS_LORA + 524288))
#define PWT ((bf16*)(ws + WS_LORA + 655360))
#define INVN ((float*)(ws + WS_INVN))
#define BSUM ((float*)(ws + WS_BSUM))
#define SCN ((unsigned char*)(ws + WS_SCN))
#define IDX ((int*)(ws + WS_IDX))
#define GATE ((float*)(ws + WS_GATE))
#define WinT ((bf16*)(ws + WS_WIN_T))
#define WoutT ((bf16*)(ws + WS_WOUT_T))
#define PqT ((bf16*)(ws + WS_PQ_T))
#define KEYS ((bf16*)(ws + WS_KEYS))
#define U8 ((unsigned char*)(ws + WS_U))
#define V8 ((unsigned char*)(ws + WS_V))
#define USc ((float*)(ws + WS_US))
#define VSc ((float*)(ws + WS_VS))
    const int lo = args.ph_lo, hi = args.ph_hi;
    { volatile LAS unsigned* misc = (volatile LAS unsigned*)(lds + LDS_BYTES - 64); if (threadIdx.x < 4) misc[threadIdx.x] = 0u; __syncthreads(); }
    const XcdBarrier xbar = xcd_barrier_post((unsigned*)(args.ws) + 4096, (volatile LAS unsigned*)(lds + LDS_BYTES - 64));
#define IN(k) (lo <= (k) && (k) < hi)
#ifndef REP_PHASE
#define REP_PHASE (-1)
#endif
#define REPS(k) ((k) == REP_PHASE ? 3 : 1)
#define SEAM(k) do { if (IN(k) && IN((k) + 1)) { if ((k) == 0) cg::this_grid().sync(); else { XcdBarrier xb_ = xbar; asm volatile("" : "+s"(xb_.bar)); if ((k) == 1) xcd_barrier<true>(xb_); else xcd_barrier<false>(xb_); } } } while (0)

    if (IN(0)) { PHASE_IDS
        { LAS float* ca = (LAS float*)lds; LAS float* red = (LAS float*)(lds + 16384);
          const float* c = INP(1); const float* ada_w = INP(2); const float* ada_b = INP(3);
          bool have = false;
          for (int it = bx; it < 96; it += G) {
              if (!have) { for (int i = tid; i < BATCH * D; i += NTHR) { const float v = c[i]; ca[i] = v / (1.f + expf(-v)); } have = true; __syncthreads(); }
              const int l = it / 48, n = (it % 48) * 128 + (tid & 127), kq = tid >> 7;
              const float* w = ada_w + (size_t)l * D * 6 * D + (size_t)(kq * 256) * 6 * D + n;
              float a0 = 0.f, a1 = 0.f, a2 = 0.f, a3 = 0.f;
#pragma unroll 32
              for (int k = 0; k < 256; ++k) { const float wv = w[(size_t)k * 6 * D]; const int kk = kq * 256 + k; a0 += ca[kk] * wv; a1 += ca[D + kk] * wv; a2 += ca[2 * D + kk] * wv; a3 += ca[3 * D + kk] * wv; }
              red[(kq * 4 + 0) * 128 + (tid & 127)] = a0; red[(kq * 4 + 1) * 128 + (tid & 127)] = a1; red[(kq * 4 + 2) * 128 + (tid & 127)] = a2; red[(kq * 4 + 3) * 128 + (tid & 127)] = a3;
              __syncthreads();
              { const int b = tid >> 7, col = tid & 127, nn = (it % 48) * 128 + col;
                const float s = red[(0 * 4 + b) * 128 + col] + red[(1 * 4 + b) * 128 + col] + red[(2 * 4 + b) * 128 + col] + red[(3 * 4 + b) * 128 + col];
                MOD[(size_t)l * BATCH * 6 * D + (size_t)b * 6 * D + nn] = s + ada_b[l * 6 * D + nn]; }
              __syncthreads();
          }
          __syncthreads(); }
        { LAS float* scr = (LAS float*)(lds + wave * 16384);
          constexpr int I_IN = (D / 64) * (IN_COLS / 32), I_VR = (D / 64) * (MVL / 32), I_OUT = (D / 64) * (D / 32), I_PQ = (D / 64) * (PH * PQ / 32);
          constexpr int NIT = 2 * I_IN + I_VR + 2 * I_OUT + 2 * I_PQ;
          for (int it = gw; it < NIT; it += NGW) { int r = it;
              if (r < 2 * I_IN) { const int l = r / I_IN; p0_transpose_item(INP(5) + (size_t)l * D * IN_COLS, D, IN_COLS, WinT + (size_t)l * LDP * D, 0, scr, r % I_IN, lane); continue; } r -= 2 * I_IN;
              if (r < I_VR) { p0_transpose_item(INP(12), D, MVL, WinT + (size_t)1 * LDP * D, IN_COLS, scr, r, lane); continue; } r -= I_VR;
              if (r < 2 * I_OUT) { const int l = r / I_OUT; p0_transpose_item(INP(23) + (size_t)l * D * D, D, D, WoutT + (size_t)l * D * D, 0, scr, r % I_OUT, lane); continue; } r -= 2 * I_OUT;
              { const int l = r / I_PQ; p0_transpose_item(INP(25) + (size_t)l * D * PH * PQ, D, PH * PQ, PqT + (size_t)l * PH * PQ * D, 0, scr, r % I_PQ, lane); } }
          for (int it = gw; it < 2 * 16 + 2 * 16 + 2 * 32; it += NGW) { int r = it;
              if (r < 32) { const int l = r / 16; p0_transpose_item(INP(8) + (size_t)l * DL * RW, DL, RW, WUPT + (size_t)l * RW * DL, 0, scr, r % 16, lane); continue; } r -= 32;
              if (r < 32) { const int l = r / 16; p0_transpose_item(INP(10) + (size_t)l * AL * RW, AL, RW, AUPT + (size_t)l * RW * AL, 0, scr, r % 16, lane); continue; } r -= 32;
              { const int l = r / 32; p0_transpose_item(INP(11) + (size_t)l * GL * RW, GL, RW, GUPT + (size_t)l * RW * GL, 0, scr, r % 32, lane); } }
          { const float* vu = INP(15); for (int e = bx * NTHR + tid; e < MVL * RW; e += G * NTHR) { const int n = e >> 5, k = e & 31; VUPT[e] = f2bf(vu[k * RW + n]); } }
          for (int it = gw; it < 8 * 8; it += NGW) p0_transpose_item(INP(21) + (size_t)(it >> 3) * PG * PG, PG, PG, PWT + (size_t)(it >> 3) * PG * PG, 0, scr, it & 7, lane);
        }
        { const size_t gt = (size_t)bx * NTHR + tid, NT = (size_t)G * NTHR;
          constexpr size_t NK8 = (size_t)2 * PH * 2 * NKEYS * PHALF / 8;
          const float* src = INP(26); bf16* dst = KEYS;
          for (size_t i = gt; i < NK8; i += NT) {
              const f32x4 a = *(const f32x4*)(src + i * 8), b = *(const f32x4*)(src + i * 8 + 4);
              u32x4 o; o.x = pk2(a.x, a.y); o.y = pk2(a.z, a.w); o.z = pk2(b.x, b.y); o.w = pk2(b.z, b.w); *(u32x4*)(dst + i * 8) = o; }
        }
    }
    SEAM(0);

#pragma unroll
    for (int l = 0; l < DEPTH; ++l) {
        const int pb = 1 + 10 * l;
#define modl (MOD + (size_t)l * BATCH * 6 * D)
#define xin (l == 0 ? INP(0) : (const float*)X)
        if (l == 0 && IN(pb + 0)) { PHASE_IDS const float* gamma = INP(4) + l * D;
            for (int row = gw; row < T; row += NGW) { const int b = row / SEQ; norm_mod_row(xin + (size_t)row * D, gamma, modl + (size_t)b * 6 * D, modl + (size_t)b * 6 * D + D, H + (size_t)row * D, lane); } }
        SEAM(pb + 0);
        if (IN(pb + 1)) { PHASE_IDS const int N1 = l == 0 ? IN_COLS : LDP;
            pg8::Gemm g{H, WinT + (size_t)l * LDP * D, T, N1, D}; pg8::StaticOrder S; S.init(T, N1, G, bx);
            pg8::EpiProj E{PROJ, LDP, POOLIN, RWKV_COLS, PW};
            pg8::gemm_phase<pg8::EpiProj, pg8::StaticOrder, true, true>(lds, g, S, E, tid); }
        SEAM(pb + 1);

        if (IN(pb + 2)) { PHASE_IDS
            constexpr int LST = 296;
            LAS bf16* lin = (LAS bf16*)lds;
            const float* mu = INP(6) + l * RWKV_COLS; const float* vmu = INP(13);
            const float* w0p = INP(7) + l * RW; const float* a0p = INP(9) + l * RW; const float* kkp = INP(16) + l * RW; const float* kap = INP(17) + l * RW; const float* rkp = INP(18) + l * RW; const float* v0p = INP(14);
            const bf16* wupT = WUPT + (size_t)l * RW * DL; const bf16* aupT = AUPT + (size_t)l * RW * AL; const bf16* gupT = GUPT + (size_t)l * RW * GL; const bf16* vupT = VUPT;
            bf16* Vl = l == 0 ? V0 : V1;
            const int r32 = lane & 31, hh = lane >> 5, h = wave;
            for (int tile = bx; tile < T / 32; tile += G) {
                const int t0 = tile * 32;
                __syncthreads();
#pragma unroll 1
                for (int it0 = 0; it0 < 3; it0 += 2) {
                  u32x4 cu_[2], pv_[2]; f32x4 m0_[2], m1_[2];
#pragma unroll
                  for (int it = 0; it < 2; ++it) { const int c8 = tid + (it0 + it) * NTHR; const bool ok = c8 < 32 * 36; const int tok = ok ? c8 / 36 : 0, jc = ok ? c8 % 36 : 0, t = t0 + tok, sq = t % SEQ;
                      cu_[it] = (u32x4){0u, 0u, 0u, 0u}; pv_[it] = (u32x4){0u, 0u, 0u, 0u}; m0_[it] = (f32x4){0.f, 0.f, 0.f, 0.f}; m1_[it] = m0_[it];
                      if (ok && (jc < 32 || l > 0)) { const int col = jc < 32 ? 3 * RW + jc * 8 : IN_COLS + (jc - 32) * 8;
                          cu_[it] = *(const u32x4*)(PROJ + (size_t)t * LDP + col); if (sq > 0) pv_[it] = *(const u32x4*)(PROJ + (size_t)(t - 1) * LDP + col);
                          const float* mp = jc < 32 ? mu + col : vmu + (jc - 32) * 8; m0_[it] = *(const f32x4*)mp; m1_[it] = *(const f32x4*)(mp + 4); } }
#pragma unroll
                  for (int it = 0; it < 2; ++it) { const int c8 = tid + (it0 + it) * NTHR; if (c8 < 32 * 36) { const int tok = c8 / 36, jc = c8 % 36;
                      u32x4 o = {0u, 0u, 0u, 0u};
                      if (jc < 32 || l > 0) {
                          float x[8]; const unsigned cw[4] = {cu_[it].x, cu_[it].y, cu_[it].z, cu_[it].w}, pw[4] = {pv_[it].x, pv_[it].y, pv_[it].z, pv_[it].w}; const float mm[8] = {m0_[it].x, m0_[it].y, m0_[it].z, m0_[it].w, m1_[it].x, m1_[it].y, m1_[it].z, m1_[it].w};
#pragma unroll
                          for (int i = 0; i < 4; ++i) { const float c0 = __uint_as_float(cw[i] << 16), c1 = __uint_as_float(cw[i] & 0xffff0000u), p0 = __uint_as_float(pw[i] << 16), p1 = __uint_as_float(pw[i] & 0xffff0000u);
                              x[2 * i] = c0 + (p0 - c0) * mm[2 * i]; x[2 * i + 1] = c1 + (p1 - c1) * mm[2 * i + 1]; }
                          if (jc < 8) {
#pragma unroll
                              for (int i = 0; i < 8; ++i) { const float e2 = __expf(-2.f * fabsf(x[i])); const float th = (1.f - e2) * __builtin_amdgcn_rcpf(1.f + e2); x[i] = x[i] < 0.f ? -th : th; } }
                          else if (jc >= 16 && jc < 32) {
#pragma unroll
                              for (int i = 0; i < 8; ++i) x[i] = __builtin_amdgcn_rcpf(1.f + __expf(-x[i])); }
                          o.x = pk2(x[0], x[1]); o.y = pk2(x[2], x[3]); o.z = pk2(x[4], x[5]); o.w = pk2(x[6], x[7]);
                      }
                      *(LAS u32x4*)(lin + tok * LST + jc * 8) = o; } } }
                __syncthreads();
                const bool first = (t0 % SEQ) == 0;
                lbf16* tin = (lbf16*)(lds + 19456 + wave * 14336);
                { u32x4 iq[13]; int ql_; asm volatile("v_mbcnt_lo_u32_b32 %0, -1, 0\n\tv_mbcnt_hi_u32_b32 %0, -1, %0" : "=v"(ql_));
#pragma unroll
                  for (int i = 0; i < 13; ++i) { const int q = ql_ + 64 * i; iq[i] = (u32x4){0u, 0u, 0u, 0u};
                      if (q < 792) { const int arr = q / 264, rem = q - arr * 264, row = rem >> 3, cc = rem & 7;
                          if (!(first && row == 0)) iq[i] = *(const u32x4*)(PROJ + (size_t)(t0 - 1 + row) * LDP + arr * RW + h * HS + cc * 8); } }
#pragma unroll
                  for (int i = 0; i < 13; ++i) { const int q = ql_ + 64 * i; if (q < 792) { const int arr = q / 264, rem = q - arr * 264, row = rem >> 3, cc = rem & 7;
                      *(__attribute__((address_space(3))) u32x4*)(tin + arr * 2376 + row * 72 + cc * 8) = iq[i]; } } }
                __builtin_amdgcn_wave_barrier(); asm volatile("s_waitcnt lgkmcnt(0)" ::: "memory");
                float ssq[16], bsm[16];
#pragma unroll
                for (int e = 0; e < 16; ++e) { ssq[e] = 0.f; bsm[e] = 0.f; }
#pragma unroll 1
                for (int rt = 0; rt < 2; ++rt) {
                    f32x16 accW, accA, accG, accV;
#pragma unroll
                    for (int e = 0; e < 16; ++e) { accW[e] = 0.f; accA[e] = 0.f; accG[e] = 0.f; accV[e] = 0.f; }
                    int c = h * HS + rt * 32 + r32;
int hh8 = 8 * hh; asm volatile("" : "+v"(c), "+v"(hh8));
                    const LAS bf16* lrow = lin + r32 * LST + 8 * hh;
                    { bf16x8_t wf[18];
#pragma unroll
                      for (int ks = 0; ks < 4; ++ks) { wf[ks] = *(const bf16x8_t*)(wupT + (size_t)c * DL + ks * 16 + hh8); wf[4 + ks] = *(const bf16x8_t*)(aupT + (size_t)c * AL + ks * 16 + hh8); }
#pragma unroll
                      for (int ks = 0; ks < 8; ++ks) wf[8 + ks] = *(const bf16x8_t*)(gupT + (size_t)c * GL + ks * 16 + hh8);
                      wf[16] = bf16x8_t{}; wf[17] = bf16x8_t{};
                      if (l > 0) { wf[16] = *(const bf16x8_t*)(vupT + (size_t)c * MVL + hh8); wf[17] = *(const bf16x8_t*)(vupT + (size_t)c * MVL + 16 + hh8); }
#pragma unroll
                      for (int ks = 0; ks < 4; ++ks) { accW = __builtin_amdgcn_mfma_f32_32x32x16_bf16(*(const LAS bf16x8_t*)(lrow + ks * 16), wf[ks], accW, 0, 0, 0);
                                                       accA = __builtin_amdgcn_mfma_f32_32x32x16_bf16(*(const LAS bf16x8_t*)(lrow + 64 + ks * 16), wf[4 + ks], accA, 0, 0, 0); }
#pragma unroll
                      for (int ks = 0; ks < 8; ++ks) accG = __builtin_amdgcn_mfma_f32_32x32x16_bf16(*(const LAS bf16x8_t*)(lrow + 128 + ks * 16), wf[8 + ks], accG, 0, 0, 0);
                      if (l > 0) {
#pragma unroll
                          for (int ks = 0; ks < 2; ++ks) accV = __builtin_amdgcn_mfma_f32_32x32x16_bf16(*(const LAS bf16x8_t*)(lrow + 256 + ks * 16), wf[16 + ks], accV, 0, 0, 0); } }
                    const float mur = mu[c], muk = mu[RW + c], muv = mu[2 * RW + c], w0c = w0p[c], a0c = a0p[c], kkc = kkp[c], kac = kap[c], rkc = rkp[c];
                    const float v0c = l > 0 ? v0p[c] : 0.f;
#pragma unroll
                    for (int eb = 0; eb < 16; eb += 4) {
                        bf16 lr[4], lk[4], lv[4], lrp[4], lkp[4], lvp[4], lvf[4];
#pragma unroll
                        for (int i = 0; i < 4; ++i) { const int e = eb + i; const int tok = (e & 3) + 8 * (e >> 2) + 4 * hh, t = t0 + tok; const int ci = rt * 32 + r32;
                            lr[i] = tin[(tok + 1) * 72 + ci]; lk[i] = tin[2376 + (tok + 1) * 72 + ci]; lv[i] = tin[2 * 2376 + (tok + 1) * 72 + ci];
                            lrp[i] = tin[tok * 72 + ci]; lkp[i] = tin[2376 + tok * 72 + ci]; lvp[i] = tin[2 * 2376 + tok * 72 + ci];
                            lvf[i] = l > 0 ? V0[(size_t)t * RW + c] : (bf16)0; }
                        __builtin_amdgcn_sched_barrier(0);
#pragma unroll
                        for (int i = 0; i < 4; ++i) { const int e = eb + i; const int tok = (e & 3) + 8 * (e >> 2) + 4 * hh, t = t0 + tok; const size_t o = (size_t)t * RW + c;
                            float r = bf2f(lr[i]), k = bf2f(lk[i]), v = bf2f(lv[i]);
                            r += (bf2f(lrp[i]) - r) * mur; k += (bf2f(lkp[i]) - k) * muk; v += (bf2f(lvp[i]) - v) * muv;
                            const float z = -(w0c + accW[e]); const float sp = fmaxf(z, 0.f) + __logf(1.f + __expf(-fabsf(z)));
                            const float decay = __expf(-__expf(-sp - 0.5f));
                            const float a = __builtin_amdgcn_rcpf(1.f + __expf(-(a0c + accA[e]))); const float g = accG[e];
                            if (l > 0) { const float vfv = bf2f(lvf[i]); v = v + (vfv - v) * __builtin_amdgcn_rcpf(1.f + __expf(-(v0c + accV[e]))); }
                            const float kk = k * kkc; const float k2 = k * (1.f + (a - 1.f) * kac);
                            ssq[e] += kk * kk; bsm[e] += r * k2 * rkc;
                            { const unsigned p0_ = cvtpk(r, k2), p1_ = cvtpk(v, kk), p2_ = cvtpk(kk * a, g), p3_ = cvtpk(v * g, 0.f);
                              Rb[o] = (bf16)p0_; Kb[o] = (bf16)(p0_ >> 16); Vl[o] = (bf16)p1_; KKb[o] = (bf16)(p1_ >> 16); Bb[o] = (bf16)p2_; Gb[o] = (bf16)(p2_ >> 16); BGb[o] = (bf16)p3_; Wd[o] = decay; }
                        }
                    }
                }
#pragma unroll
                for (int e = 0; e < 16; ++e) { const int ln_ = r32 | (hh << 5); float a_ = red16(ssq[e]), b_ = red16(bsm[e]); a_ += shflx(a_, ln_, 16); b_ += shflx(b_, ln_, 16); ssq[e] = a_; bsm[e] = b_; }
                if (r32 == 0) {
#pragma unroll
                    for (int e = 0; e < 16; ++e) { const int tok = (e & 3) + 8 * (e >> 2) + 4 * hh; INVN[(size_t)(t0 + tok) * NH + h] = rsqrtf(fmaxf(ssq[e], 1e-24f)); BSUM[(size_t)(t0 + tok) * NH + h] = bsm[e]; } }
            }
        }
        SEAM(pb + 2);

        if (IN(pb + 3)) { PHASE_IDS
            const bf16* Vl = l == 0 ? V0 : V1;
            const int r32 = lane & 31, hh = lane >> 5;
            if (wave < 6) {
                lbf16* At = (lbf16*)(lds + wave * 23552); lbf16* Bt = At + 2304; lbf16* Kt = Bt + 2304; lbf16* Rt = Kt + 2304; lbf16* Vv = Rt + 2304;
                LAS float* PCs = (LAS float*)(lds + wave * 23552 + 23040);
                for (int item = bx * 6 + wave; item < BATCH * NH * (SEQ / 32); item += G * 6) {
                    const int bh = item >> 7, chunk = item & 127, b = bh >> 3, h = bh & 7; const size_t t0 = (size_t)b * SEQ + chunk * 32;
                    __builtin_amdgcn_wave_barrier(); asm volatile("s_waitcnt lgkmcnt(0)" ::: "memory");
                    {
                      const int tk = lane >> 3, part = lane & 7;
                      u32x4 qr[4], qk[4], qv[4], qkk[4], qb[4]; f32x4 qw0[4], qw1[4]; float qin[4];
#pragma unroll
                      for (int p4 = 0; p4 < 4; ++p4) { const size_t o = (t0 + p4 * 8 + tk) * RW + h * HS + part * 8;
                          qr[p4] = *(const u32x4*)(Rb + o); qk[p4] = *(const u32x4*)(Kb + o); qv[p4] = *(const u32x4*)(Vl + o); qkk[p4] = *(const u32x4*)(KKb + o); qb[p4] = *(const u32x4*)(Bb + o);
                          qw0[p4] = *(const f32x4*)(Wd + o); qw1[p4] = *(const f32x4*)(Wd + o + 4); qin[p4] = INVN[(t0 + p4 * 8 + tk) * NH + h]; }
                      LAS float* Pl = (LAS float*)At;
#pragma unroll
                      for (int p4 = 0; p4 < 4; ++p4) { *(LAS f32x4*)(Pl + (p4 * 8 + tk) * 64 + part * 8) = qw0[p4]; *(LAS f32x4*)(Pl + (p4 * 8 + tk) * 64 + part * 8 + 4) = qw1[p4]; }
                      __builtin_amdgcn_wave_barrier(); asm volatile("s_waitcnt lgkmcnt(0)" ::: "memory");
                      { float P = 1.f;
#pragma unroll 8
                        for (int c = 0; c < 32; ++c) { P *= Pl[c * 64 + lane]; Pl[c * 64 + lane] = P; }
                        PCs[lane] = P; }
                      __builtin_amdgcn_wave_barrier(); asm volatile("s_waitcnt lgkmcnt(0)" ::: "memory");
                      u32x4 oa[4], orr[4], ob_[4], ok_[4];
#pragma unroll
                      for (int p4 = 0; p4 < 4; ++p4) { const int c = p4 * 8 + tk;
                          const f32x4 pa = *(const LAS f32x4*)(Pl + c * 64 + part * 8), pb2 = *(const LAS f32x4*)(Pl + c * 64 + part * 8 + 4);
                          f32x4 ma = {1.f, 1.f, 1.f, 1.f}, mb = ma; if (c > 0) { ma = *(const LAS f32x4*)(Pl + (c - 1) * 64 + part * 8); mb = *(const LAS f32x4*)(Pl + (c - 1) * 64 + part * 8 + 4); }
                          const float Pc[8] = {pa.x, pa.y, pa.z, pa.w, pb2.x, pb2.y, pb2.z, pb2.w}, Pm[8] = {ma.x, ma.y, ma.z, ma.w, mb.x, mb.y, mb.z, mb.w};
                          const unsigned rw_[4] = {qr[p4].x, qr[p4].y, qr[p4].z, qr[p4].w}, kw_[4] = {qk[p4].x, qk[p4].y, qk[p4].z, qk[p4].w}, kkw[4] = {qkk[p4].x, qkk[p4].y, qkk[p4].z, qkk[p4].w}, bw_[4] = {qb[p4].x, qb[p4].y, qb[p4].z, qb[p4].w};
                          unsigned xa[4], xr[4], xb[4], xk[4]; const float inv = qin[p4];
#pragma unroll
                          for (int i = 0; i < 4; ++i) { const float ip0 = __builtin_amdgcn_rcpf(Pc[2 * i]), ip1 = __builtin_amdgcn_rcpf(Pc[2 * i + 1]);
                              xa[i] = pk2(-__uint_as_float(kkw[i] << 16) * inv * Pm[2 * i], -__uint_as_float(kkw[i] & 0xffff0000u) * inv * Pm[2 * i + 1]);
                              xr[i] = pk2(__uint_as_float(rw_[i] << 16) * Pc[2 * i], __uint_as_float(rw_[i] & 0xffff0000u) * Pc[2 * i + 1]);
                              xb[i] = pk2(__uint_as_float(bw_[i] << 16) * inv * ip0, __uint_as_float(bw_[i] & 0xffff0000u) * inv * ip1);
                              xk[i] = pk2(__uint_as_float(kw_[i] << 16) * ip0, __uint_as_float(kw_[i] & 0xffff0000u) * ip1); }
                          oa[p4] = (u32x4){xa[0], xa[1], xa[2], xa[3]}; orr[p4] = (u32x4){xr[0], xr[1], xr[2], xr[3]}; ob_[p4] = (u32x4){xb[0], xb[1], xb[2], xb[3]}; ok_[p4] = (u32x4){xk[0], xk[1], xk[2], xk[3]}; }
                      __builtin_amdgcn_wave_barrier(); asm volatile("s_waitcnt lgkmcnt(0)" ::: "memory");
#pragma unroll
                      for (int p4 = 0; p4 < 4; ++p4) { const int c = p4 * 8 + tk, o = c * 72 + part * 8;
                          *(__attribute__((address_space(3))) u32x4*)(At + o) = oa[p4]; *(__attribute__((address_space(3))) u32x4*)(Rt + o) = orr[p4]; *(__attribute__((address_space(3))) u32x4*)(Bt + o) = ob_[p4];
                          *(__attribute__((address_space(3))) u32x4*)(Kt + o) = ok_[p4]; *(__attribute__((address_space(3))) u32x4*)(Vv + o) = qv[p4]; } }
                    __builtin_amdgcn_wave_barrier(); asm volatile("s_waitcnt lgkmcnt(0)" ::: "memory");
                    const f32x16 zero16 = {0.f, 0.f, 0.f, 0.f, 0.f, 0.f, 0.f, 0.f, 0.f, 0.f, 0.f, 0.f, 0.f, 0.f, 0.f, 0.f};
                    f32x16 X = zero16, Yt = zero16;
#pragma unroll
                    for (int ks = 0; ks < 4; ++ks) { const bf16x8_t fa = ldrow(At, r32, ks, hh), fb = ldrow(Bt, r32, ks, hh); X = mm32(fa, fb, X); Yt = mm32(fb, fa, Yt); }
#pragma unroll
                    for (int e = 0; e < 16; ++e) { const int ri = rowidx(e, hh); X[e] = (r32 < ri) ? X[e] : 0.f; Yt[e] = (ri < r32) ? Yt[e] : 0.f; }
                    f32x16 TY = Yt;
#pragma unroll
                    for (int e = 0; e < 16; ++e) TY[e] += (rowidx(e, hh) == r32) ? 1.f : 0.f;
#pragma unroll 1
                    for (int it = 0; it < 4; ++it) {
                        const bf16x8_t x0 = accop<0>(X), x1 = accop<1>(X), y0 = accop<0>(Yt), y1 = accop<1>(Yt);
                        f32x16 Xn = mm32(y0, x0, zero16); Xn = mm32(y1, x1, Xn);
                        f32x16 Yn = mm32(x0, y0, zero16); Yn = mm32(x1, y1, Yn);
                        X = Xn; Yt = Yn;
                        const bf16x8_t p0 = accop<0>(X), p1 = accop<1>(X), t0_ = accop<0>(TY), t1_ = accop<1>(TY);
                        TY = mm32(p0, t0_, TY); TY = mm32(p1, t1_, TY);
                    }
                    const bf16x8_t ty0 = accop<0>(TY), ty1 = accop<1>(TY);
                    unsigned char* rec = SCN + (size_t)item * 24576;
                    const bf16x8_t v00 = ldpermcol<0>(Vv, r32, hh), v01 = ldpermcol<1>(Vv, r32, hh), v10 = ldpermcol<0>(Vv, 32 + r32, hh), v11 = ldpermcol<1>(Vv, 32 + r32, hh);
                    f32x16 U0a, U0b;
                    { f32x16 G2T = zero16;
#pragma unroll
                      for (int ks = 0; ks < 4; ++ks) G2T = mm32(ldrow(Kt, r32, ks, hh), ldrow(At, r32, ks, hh), G2T);
#pragma unroll
                      for (int e = 0; e < 16; ++e) G2T[e] = (rowidx(e, hh) < r32) ? G2T[e] : 0.f;
                      const bf16x8_t g0 = accop<0>(G2T), g1 = accop<1>(G2T);
                      f32x16 Za = mm32(g0, v00, zero16); Za = mm32(g1, v01, Za); f32x16 Zb = mm32(g0, v10, zero16); Zb = mm32(g1, v11, Zb);
                      U0a = mm32(ty0, accop<0>(Za), zero16); U0a = mm32(ty1, accop<1>(Za), U0a); U0b = mm32(ty0, accop<0>(Zb), zero16); U0b = mm32(ty1, accop<1>(Zb), U0b); }
                    const bf16x8_t ua0 = accop<0>(U0a), ua1 = accop<1>(U0a), ub0 = accop<0>(U0b), ub1 = accop<1>(U0b);
                    f32x16 G3T = zero16;
                    { f32x16 G4T = zero16;
#pragma unroll
                      for (int ks = 0; ks < 4; ++ks) { const bf16x8_t fr = ldrow(Rt, r32, ks, hh); G3T = mm32(ldrow(Bt, r32, ks, hh), fr, G3T); G4T = mm32(ldrow(Kt, r32, ks, hh), fr, G4T); }
#pragma unroll
                      for (int e = 0; e < 16; ++e) { const bool keep = rowidx(e, hh) <= r32; G3T[e] = keep ? G3T[e] : 0.f; G4T[e] = keep ? G4T[e] : 0.f; }
                      const bf16x8_t g30 = accop<0>(G3T), g31 = accop<1>(G3T), g40 = accop<0>(G4T), g41 = accop<1>(G4T);
                      f32x16 Ya = mm32(g30, ua0, zero16); Ya = mm32(g31, ua1, Ya); Ya = mm32(g40, v00, Ya); Ya = mm32(g41, v01, Ya);
                      f32x16 Yb = mm32(g30, ub0, zero16); Yb = mm32(g31, ub1, Yb); Yb = mm32(g40, v10, Yb); Yb = mm32(g41, v11, Yb);
                      u32x4 o0, o1;
                      o0.x = cvtpk(Ya[0], Ya[1]); o0.y = cvtpk(Ya[2], Ya[3]); o0.z = cvtpk(Ya[4], Ya[5]); o0.w = cvtpk(Ya[6], Ya[7]);
                      o1.x = cvtpk(Ya[8], Ya[9]); o1.y = cvtpk(Ya[10], Ya[11]); o1.z = cvtpk(Ya[12], Ya[13]); o1.w = cvtpk(Ya[14], Ya[15]);
                      *(u32x4*)(rec + 12288 + 4096 + lane * 32) = o0; *(u32x4*)(rec + 12288 + 4096 + lane * 32 + 16) = o1;
                      o0.x = cvtpk(Yb[0], Yb[1]); o0.y = cvtpk(Yb[2], Yb[3]); o0.z = cvtpk(Yb[4], Yb[5]); o0.w = cvtpk(Yb[6], Yb[7]);
                      o1.x = cvtpk(Yb[8], Yb[9]); o1.y = cvtpk(Yb[10], Yb[11]); o1.z = cvtpk(Yb[12], Yb[13]); o1.w = cvtpk(Yb[14], Yb[15]);
                      *(u32x4*)(rec + 12288 + 6144 + 4096 + lane * 32) = o0; *(u32x4*)(rec + 12288 + 6144 + 4096 + lane * 32 + 16) = o1; }
                    f32x16 Wa0 = mm32(ty0, ldpermcol<0>(At, r32, hh), zero16); Wa0 = mm32(ty1, ldpermcol<1>(At, r32, hh), Wa0);
                    f32x16 Wa1 = mm32(ty0, ldpermcol<0>(At, 32 + r32, hh), zero16); Wa1 = mm32(ty1, ldpermcol<1>(At, 32 + r32, hh), Wa1);
                    const bf16x8_t wa00 = accop<0>(Wa0), wa01 = accop<1>(Wa0), wa10 = accop<0>(Wa1), wa11 = accop<1>(Wa1);
                    { const bf16x8_t g30 = accop<0>(G3T), g31 = accop<1>(G3T);
                      f32x16 Ra = mm32(wa00, g30, zero16); Ra = mm32(wa01, g31, Ra); f32x16 Rb_ = mm32(wa10, g30, zero16); Rb_ = mm32(wa11, g31, Rb_);
#pragma unroll
                      for (int e = 0; e < 16; ++e) { const int kr = rowidx(e, hh); Ra[e] += bf2f(Rt[r32 * 72 + kr]); Rb_[e] += bf2f(Rt[r32 * 72 + 32 + kr]); }
                      *(bf16x8_t*)(rec + 8192 + 0 * 1024 + lane * 16) = accop<0>(Ra); *(bf16x8_t*)(rec + 8192 + 1 * 1024 + lane * 16) = accop<1>(Ra);
                      *(bf16x8_t*)(rec + 8192 + 2 * 1024 + lane * 16) = accop<0>(Rb_); *(bf16x8_t*)(rec + 8192 + 3 * 1024 + lane * 16) = accop<1>(Rb_); }
                    const bf16x8_t b00 = ldpermcol<0>(Bt, r32, hh), b01 = ldpermcol<1>(Bt, r32, hh), b10 = ldpermcol<0>(Bt, 32 + r32, hh), b11 = ldpermcol<1>(Bt, 32 + r32, hh);
                    { const float pc0 = PCs[r32], pc1 = PCs[32 + r32];
#pragma unroll
                      for (int ij = 0; ij < 4; ++ij) { const int i = ij >> 1, j = ij & 1;
                          f32x16 M = mm32(i ? wa10 : wa00, j ? b10 : b00, zero16); M = mm32(i ? wa11 : wa01, j ? b11 : b01, M);
#pragma unroll
                          for (int e = 0; e < 16; ++e) { float m = M[e]; if (i == j) m += (rowidx(e, hh) == r32) ? 1.f : 0.f; M[e] = m * (j ? pc1 : pc0); }
                          *(bf16x8_t*)(rec + (ij * 2 + 0) * 1024 + lane * 16) = accop<0>(M); *(bf16x8_t*)(rec + (ij * 2 + 1) * 1024 + lane * 16) = accop<1>(M); } }
                    { const bf16x8_t k00 = ldpermcol<0>(Kt, r32, hh), k01 = ldpermcol<1>(Kt, r32, hh), k10 = ldpermcol<0>(Kt, 32 + r32, hh), k11 = ldpermcol<1>(Kt, 32 + r32, hh);
#pragma unroll
                      for (int ju = 0; ju < 4; ++ju) { const int j = ju >> 1, u = ju & 1;
                          f32x16 Dm = mm32(j ? b10 : b00, u ? ub0 : ua0, zero16); Dm = mm32(j ? b11 : b01, u ? ub1 : ua1, Dm);
                          Dm = mm32(j ? k10 : k00, u ? v10 : v00, Dm); Dm = mm32(j ? k11 : k01, u ? v11 : v01, Dm);
#pragma unroll
                          for (int e = 0; e < 16; ++e) Dm[e] *= PCs[32 * j + rowidx(e, hh)];
                          u32x4 o0, o1;
                          o0.x = cvtpk(Dm[0], Dm[1]); o0.y = cvtpk(Dm[2], Dm[3]); o0.z = cvtpk(Dm[4], Dm[5]); o0.w = cvtpk(Dm[6], Dm[7]);
                          o1.x = cvtpk(Dm[8], Dm[9]); o1.y = cvtpk(Dm[10], Dm[11]); o1.z = cvtpk(Dm[12], Dm[13]); o1.w = cvtpk(Dm[14], Dm[15]);
                          *(u32x4*)(rec + 12288 + u * 6144 + j * 2048 + lane * 32) = o0; *(u32x4*)(rec + 12288 + u * 6144 + j * 2048 + lane * 32 + 16) = o1; } }
                }
            }
        }
        { XcdBarrier xb_ = xbar; asm volatile("" : "+s"(xb_.bar)); xcd_barrier<false>(xb_); }
        if (IN(pb + 3)) { PHASE_IDS
            const int r32 = lane & 31, hh = lane >> 5;
            constexpr int SLOT = 18432, NCH = SEQ / 32, NSL = 7, AHEAD = 6;
            const bool spare = G > BATCH * NH * 2; const int cw = spare ? bx - BATCH * NH * 2 : bx, cn = spare ? G - BATCH * NH * 2 : G;
            if (cw >= 0) {
                convert_tables_fp6(INP(27), INP(28), U8, V8, USc, VSc, l, cw * NWAVES + wave, cn * NWAVES, lane);
            {
                constexpr int DST = 520;
                int lane_p; asm volatile("v_mbcnt_lo_u32_b32 %0, -1, 0\n\tv_mbcnt_hi_u32_b32 %0, -1, %0" : "=v"(lane_p)); const int r32 = lane_p & 31, hh = lane_p >> 5, tidp = wave0 * 64 + lane_p;
                lbf16* dlb = (lbf16*)lds;
                lbf16* pin = (lbf16*)(lds + 33280);
                const int c = tidp, g = c >> 7, win = 2 << g;
                const bf16* pwt = PWT + (size_t)(l * 4 + (wave >> 1)) * PG * PG; const float* psc = INP(22) + l * PW;
                for (int tile = cw; tile < T / 32; tile += cn) {
                    const int t0 = tile * 32; const bool first = (t0 % SEQ) == 0;
                    __syncthreads();
                    { u32x4 pq[6];
#pragma unroll
                      for (int q = 0; q < 6; ++q) { const int ch = tidp + q * NTHR, row = ch >> 6, cc = ch & 63; pq[q] = (u32x4){0u, 0u, 0u, 0u};
                          if (ch < 47 * 64 && (row >= 15 || !first)) pq[q] = *(const u32x4*)(POOLIN + (size_t)(t0 - 15 + row) * PW + cc * 8); }
#pragma unroll
                      for (int q = 0; q < 6; ++q) { const int ch = tidp + q * NTHR, row = ch >> 6, cc = ch & 63; if (ch < 47 * 64) *(__attribute__((address_space(3))) u32x4*)(pin + row * 520 + cc * 8) = pq[q]; } }
                    __syncthreads();
                    const lbf16* pc = pin + c;
                    float sw = 0.f;
#pragma unroll
                    for (int j = 1; j <= 15; ++j) sw += (j < win) ? bf2f(pc[(15 - j) * 520]) : 0.f;
                    const float invw = 1.f / (float)win;
#pragma unroll 8
                    for (int i = 0; i < 32; ++i) {
                        const float cur = bf2f(pc[(15 + i) * 520]);
                        sw += cur;
                        const float inv = (first && i < 15) ? 1.f / (float)min(i + 1, win) : invw;
                        dlb[i * DST + c] = f2bf(sw * inv - cur);
                        sw -= bf2f(pc[(15 + i - win + 1) * 520]);
                    }
                    __syncthreads();
                    const int gg = wave >> 1, half = wave & 1;
#pragma unroll
                    for (int ct = 0; ct < 2; ++ct) {
                        const int dd0 = half * 64 + ct * 32;
                        f32x16 acc;
#pragma unroll
                        for (int e = 0; e < 16; ++e) acc[e] = 0.f;
#pragma unroll
                        for (int ks = 0; ks < 8; ++ks) { const bf16x8_t a = *(const __attribute__((address_space(3))) bf16x8_t*)(dlb + r32 * DST + gg * PG + ks * 16 + 8 * hh);
                            const bf16x8_t w = *(const bf16x8_t*)(pwt + (size_t)(dd0 + r32) * PG + ks * 16 + 8 * hh); acc = mm32(a, w, acc); }
                        const int oc = gg * PG + dd0 + r32; const float ps = psc[oc];
#pragma unroll
                        for (int e = 0; e < 16; ++e) MIX[(size_t)(t0 + rowidx(e, hh)) * D + RW + oc] = f2bf(acc[e] * ps);
                    }
                }
            }
            }
            for (int un = bx; un < BATCH * NH * 2; un += G) {
                const int bh = un >> 1, u = un & 1, b = bh >> 3, h = bh & 7;
                __syncthreads();
                const unsigned char* recs = SCN + (size_t)bh * NCH * 24576;
                const int lw = wave - 2;
#define S2_DMA(chunk_) do { if (wave >= 2) { LAS unsigned char* sl = lds + ((chunk_) % NSL) * SLOT; const unsigned char* rp = recs + (size_t)(chunk_) * 24576 + lane * 16; \
                    _Pragma("unroll") for (int q_ = 0; q_ < 3; ++q_) { const int p_ = lw * 3 + q_; const int so_ = p_ < 12 ? p_ * 1024 : 12288 + u * 6144 + (p_ - 12) * 1024; \
                        __builtin_amdgcn_global_load_lds((const unsigned*)(rp + so_), (LAS unsigned*)(sl + p_ * 1024), 16, 0, 0); } } } while (0)
#pragma unroll 1
                for (int c0 = 0; c0 < AHEAD; ++c0) S2_DMA(c0);
                asm volatile("s_waitcnt vmcnt(15)" ::: "memory");
                __builtin_amdgcn_s_barrier();
                f32x16 X0, X1;
                { float z_ = 0.f; asm volatile("" : "+v"(z_));
#pragma unroll
                for (int e = 0; e < 16; ++e) { X0[e] = z_; X1[e] = z_; } }
#define S2_FRAG(off) (*(const __attribute__((address_space(3))) bf16x8_t*)(sl + (off) + lane * 16))
#define S2_UNPK(dst, off) do { const u32x4 a0 = *(const LAS u32x4*)(sl + (off) + lane * 32), a1 = *(const LAS u32x4*)(sl + (off) + lane * 32 + 16); const unsigned wv[8] = {a0.x, a0.y, a0.z, a0.w, a1.x, a1.y, a1.z, a1.w}; \
                    _Pragma("unroll") for (int q = 0; q < 8; ++q) { (dst)[2 * q] = __uint_as_float(wv[q] << 16); (dst)[2 * q + 1] = __uint_as_float(wv[q] & 0xffff0000u); } } while (0)
#pragma unroll 1
                for (int n = 0; n < NCH; ++n) {
                    if (n + AHEAD < NCH) S2_DMA(n + AHEAD);
                    if (wave == 0) {
                        const LAS unsigned char* sl = lds + (n % NSL) * SLOT;
                        const bf16x8_t x00 = accop<0>(X0), x01 = accop<1>(X0), x10 = accop<0>(X1), x11 = accop<1>(X1);
                        f32x16 Yc, N0, N1;
                        S2_UNPK(Yc, 12288 + 4096); S2_UNPK(N0, 12288); S2_UNPK(N1, 12288 + 2048);
                        Yc = mm32(S2_FRAG(8192 + 0 * 1024), x00, Yc); Yc = mm32(S2_FRAG(8192 + 1 * 1024), x01, Yc); Yc = mm32(S2_FRAG(8192 + 2 * 1024), x10, Yc); Yc = mm32(S2_FRAG(8192 + 3 * 1024), x11, Yc);
                        N0 = mm32(S2_FRAG((0 * 2 + 0) * 1024), x00, N0); N0 = mm32(S2_FRAG((0 * 2 + 1) * 1024), x01, N0); N0 = mm32(S2_FRAG((2 * 2 + 0) * 1024), x10, N0); N0 = mm32(S2_FRAG((2 * 2 + 1) * 1024), x11, N0);
                        N1 = mm32(S2_FRAG((1 * 2 + 0) * 1024), x00, N1); N1 = mm32(S2_FRAG((1 * 2 + 1) * 1024), x01, N1); N1 = mm32(S2_FRAG((3 * 2 + 0) * 1024), x10, N1); N1 = mm32(S2_FRAG((3 * 2 + 1) * 1024), x11, N1);
                        X0 = N0; X1 = N1;
                        float* yp = Y + ((size_t)b * SEQ + (size_t)n * 32) * RW + h * HS + u * 32 + r32;
#pragma unroll
                        for (int e = 0; e < 16; ++e) yp[(size_t)rowidx(e, hh) * RW] = Yc[e];
                        asm volatile("s_waitcnt lgkmcnt(0)" ::: "memory");
                    } else if (wave >= 2) {
                        const int younger = (NCH - 1 - (n + 1)) < (AHEAD - 1) ? (NCH - 1 - (n + 1)) : (AHEAD - 1);
                        if (younger >= 5) asm volatile("s_waitcnt vmcnt(15)" ::: "memory"); else if (younger == 4) asm volatile("s_waitcnt vmcnt(12)" ::: "memory"); else if (younger == 3) asm volatile("s_waitcnt vmcnt(9)" ::: "memory");
                        else if (younger == 2) asm volatile("s_waitcnt vmcnt(6)" ::: "memory"); else if (younger == 1) asm volatile("s_waitcnt vmcnt(3)" ::: "memory"); else asm volatile("s_waitcnt vmcnt(0)" ::: "memory");
                    }
                    __builtin_amdgcn_s_barrier();
                }
#undef S2_FRAG
#undef S2_UNPK
#undef S2_DMA
            }
        }
        SEAM(pb + 3);

        if (IN(pb + 4)) { PHASE_IDS
            const int c8 = (tid & 63) * 8, hd = (tid & 63) >> 3, tsub = tid >> 6;
            const f32x4 lg0 = *(const f32x4*)(INP(19) + l * RW + c8), lg1 = *(const f32x4*)(INP(19) + l * RW + c8 + 4), lb0 = *(const f32x4*)(INP(20) + l * RW + c8), lb1 = *(const f32x4*)(INP(20) + l * RW + c8 + 4);
            for (int tile = bx; tile < T / 8; tile += G) {
                const int t = tile * 8 + tsub; const size_t o = (size_t)t * RW + c8;
                const f32x4 y0 = *(const f32x4*)(Y + o), y1 = *(const f32x4*)(Y + o + 4); const u32x4 gq = *(const u32x4*)(Gb + o), vq = *(const u32x4*)(BGb + o); const float bsum = BSUM[(size_t)t * NH + hd];
                float sm = (y0.x + y0.y) + (y0.z + y0.w) + (y1.x + y1.y) + (y1.z + y1.w);
                sm += dppf<0xB1>(sm); sm += dppf<0x4E>(sm); sm += dppf<0x141>(sm);
                const float mean = sm * (1.f / 64.f);
                const f32x4 d0 = y0 - mean, d1 = y1 - mean;
                float sq = (d0.x * d0.x + d0.y * d0.y) + (d0.z * d0.z + d0.w * d0.w) + (d1.x * d1.x + d1.y * d1.y) + (d1.z * d1.z + d1.w * d1.w);
                sq += dppf<0xB1>(sq); sq += dppf<0x4E>(sq); sq += dppf<0x141>(sq);
                const float rs = rsqrtf(sq * (1.f / 64.f) + GN_EPS);
                const f32x4 n0 = d0 * rs * lg0 + lb0, n1 = d1 * rs * lg1 + lb1;
                const unsigned gw_[4] = {gq.x, gq.y, gq.z, gq.w}, vw_[4] = {vq.x, vq.y, vq.z, vq.w}; const float nn[8] = {n0.x, n0.y, n0.z, n0.w, n1.x, n1.y, n1.z, n1.w}; unsigned ow[4];
#pragma unroll
                for (int i = 0; i < 4; ++i) { const float g0 = __uint_as_float(gw_[i] << 16), g1 = __uint_as_float(gw_[i] & 0xffff0000u), v0 = __uint_as_float(vw_[i] << 16), v1 = __uint_as_float(vw_[i] & 0xffff0000u);
                    ow[i] = pk2(nn[2 * i] * g0 + v0 * bsum, nn[2 * i + 1] * g1 + v1 * bsum); }
                *(u32x4*)(MIX + (size_t)t * D + c8) = (u32x4){ow[0], ow[1], ow[2], ow[3]};
            }
        }
        SEAM(pb + 4);
        if (IN(pb + 5)) { PHASE_IDS
            pg8::Gemm g{MIX, WoutT + (size_t)l * D * D, T, D, D}; pg8::StaticOrder S; S.init(T, D, G, bx);
            pg8::EpiResGate E{xin, X, modl + 2 * D};
            pg8::gemm_phase<pg8::EpiResGate, pg8::StaticOrder, true, true>(lds, g, S, E, tid); }
        SEAM(pb + 5);
        if (IN(pb + 6)) { PHASE_IDS const float* gamma = INP(24) + l * D;
            for (int row = gw; row < T; row += NGW) { const int b = row / SEQ; norm_mod_row(X + (size_t)row * D, gamma, modl + (size_t)b * 6 * D + 3 * D, modl + (size_t)b * 6 * D + 4 * D, H + (size_t)row * D, lane); } }
        SEAM(pb + 6);
        if (IN(pb + 7)) { PHASE_IDS
            pg8::Gemm g{H, PqT + (size_t)l * PH * PQ * D, T, PH * PQ, D}; pg8::StaticOrder S; S.init(T, PH * PQ, G, bx);
            pg8::EpiBf16<0> E{Q, PH * PQ, nullptr, 0, 0, 1.f};
            pg8::gemm_phase<pg8::EpiBf16<0>, pg8::StaticOrder, true, true>(lds, g, S, E, tid); }
        SEAM(pb + 7);

        if (IN(pb + 8)) { PHASE_IDS
            const bf16* KEYSl = KEYS + (size_t)l * PH * 2 * NKEYS * PHALF;
            LAS unsigned char* scr = lds + wave * 2048 + lane * 32;
            constexpr int KST = 136;
            lbf16* kl = (lbf16*)(lds + 16384);
            const int r = lane & 31, hh = lane >> 5;
            for (int item = bx; item < (T / 256) * PH; item += G) {
                const int h = item & 7, tok = (item >> 3) * 256 + wave * 32 + r;
                __syncthreads();
                { u32x4 kq[8];
#pragma unroll
                  for (int q = 0; q < 8; ++q) { const int ch = tid + q * NTHR; kq[q] = *(const u32x4*)(KEYSl + (size_t)(h * 2) * NKEYS * PHALF + (size_t)ch * 8); }
#pragma unroll
                  for (int q = 0; q < 8; ++q) { const int ch = tid + q * NTHR, row = ch >> 4, cc = ch & 15; *(__attribute__((address_space(3))) u32x4*)(kl + row * KST + cc * 8) = kq[q]; } }
                __syncthreads();
                unsigned sp0[16], sp1[16];
#pragma unroll
                for (int e = 0; e < 16; ++e) { sp0[e] = 0u; sp1[e] = 0u; }
#pragma unroll 1
                for (int p = 0; p < 2; ++p) {
                    const bf16* qp = Q + (size_t)tok * (PH * PQ) + h * PQ + p * PHALF + 8 * hh;
                    const lbf16* kp_ = kl + (p * NKEYS + r) * KST + 8 * hh;
                    bf16x8_t bq[8];
#pragma unroll
                    for (int ks = 0; ks < 8; ++ks) bq[ks] = *(const bf16x8_t*)(qp + ks * 16);
                    unsigned best[16];
#pragma unroll
                    for (int e = 0; e < 16; ++e) best[e] = 0u;
#pragma unroll 1
                    for (int kt = 0; kt < 4; ++kt) {
                        f32x16 acc;
#pragma unroll
                        for (int e = 0; e < 16; ++e) acc[e] = 0.f;
#pragma unroll
                        for (int ks = 0; ks < 8; ++ks) { const bf16x8_t ak = *(const __attribute__((address_space(3))) bf16x8_t*)(kp_ + kt * 32 * KST + ks * 16); acc = __builtin_amdgcn_mfma_f32_32x32x16_bf16(ak, bq[ks], acc, 0, 0, 0); }
                        unsigned g[16];
#pragma unroll
                        for (int e = 0; e < 16; ++e) g[e] = pack_key7(acc[e], kt * 32 + (e & 3) + 8 * (e >> 2) + 4 * hh);
                        sort16_desc(g);
                        merge_top16(best, g);
                    }
                    unsigned ob[16];
#pragma unroll
                    for (int e = 0; e < 16; ++e) ob[e] = shflxu(best[e], lane, 32);
                    merge_top16(best, ob);
#pragma unroll
                    for (int e = 0; e < 16; ++e) { sp0[e] = p == 0 ? best[e] : sp0[e]; sp1[e] = p == 0 ? sp1[e] : best[e]; }
                }
                unsigned c2[32];
                stage2_cands(sp0, sp1, hh, c2);
                sort16_desc(c2); sort16_desc(c2 + 16); merge_top16(c2, c2 + 16);
                { unsigned ob[16];
#pragma unroll
                  for (int e = 0; e < 16; ++e) ob[e] = shflxu(c2[e], lane, 32);
                  merge_top16(c2, ob); }
#pragma unroll
                for (int e = 0; e < 16; e += 4) {
                    *(LAS unsigned*)(scr + e) = (127u - (sp0[e] & 127u)) | ((127u - (sp0[e + 1] & 127u)) << 8) | ((127u - (sp0[e + 2] & 127u)) << 16) | ((127u - (sp0[e + 3] & 127u)) << 24);
                    *(LAS unsigned*)(scr + 16 + e) = (127u - (sp1[e] & 127u)) | ((127u - (sp1[e + 1] & 127u)) << 8) | ((127u - (sp1[e + 2] & 127u)) << 16) | ((127u - (sp1[e + 3] & 127u)) << 24); }
                asm volatile("s_waitcnt lgkmcnt(0)" ::: "memory");
                float sm[16]; int ex[16];
#pragma unroll
                for (int e = 0; e < 16; ++e) { const unsigned key = c2[e]; sm[e] = unpack_key8(key); const int i0 = (key >> 4) & 15, j0 = key & 15; ex[e] = (int)scr[i0] * NKEYS + (int)scr[16 + j0]; }
                float den = 0.f;
#pragma unroll
                for (int e = 0; e < 16; ++e) { sm[e] = expf(sm[e] - unpack_key8(c2[0])); den += sm[e]; }
                const float inv = 1.f / den;
                if (hh == 0) {
                    int* ip = IDX + (size_t)tok * NE + h * TOPK; float* gp = GATE + (size_t)tok * NE + h * TOPK;
#pragma unroll
                    for (int e = 0; e < 16; e += 4) { *(int4*)(ip + e) = make_int4(ex[e], ex[e + 1], ex[e + 2], ex[e + 3]); *(f32x4*)(gp + e) = (f32x4){sm[e] * inv, sm[e + 1] * inv, sm[e + 2] * inv, sm[e + 3] * inv}; }
                }
                asm volatile("s_waitcnt lgkmcnt(0)" ::: "memory");
            }
        }
        SEAM(pb + 8);

        if (IN(pb + 9)) { PHASE_IDS
            const unsigned char* Ul = U8 + (size_t)l * NEXP * ROWB; const unsigned char* Vtl = V8 + (size_t)l * NEXP * ROWB; const float* usl = USc + l * NEXP; const float* vsl = VSc + l * NEXP; const float* lnf = INP(29);
            const bool fin = (l == DEPTH - 1);
            typedef float f32x2_t __attribute__((ext_vector_type(2)));
            const __amdgpu_buffer_rsrc_t ru = __builtin_amdgcn_make_buffer_rsrc((void*)Ul, 0, NEXP * ROWB, 0x00020000), rv = __builtin_amdgcn_make_buffer_rsrc((void*)Vtl, 0, NEXP * ROWB, 0x00020000);
            typedef float f32x32_t __attribute__((ext_vector_type(32))); typedef unsigned u32x3_t __attribute__((ext_vector_type(3))); typedef unsigned u32x6_t __attribute__((ext_vector_type(6))); typedef unsigned u32x16_t __attribute__((ext_vector_type(16))); typedef __bf16 bf16x2_t __attribute__((ext_vector_type(2)));
            LAS float* pl = (LAS float*)(lds + wave * 18432);
            constexpr int TW = 4;
            for (int tb = gw; tb < T; tb += TW * NGW) {
#define TOKV(k) (tb + (k) * NGW < T)
#define TOK(k) (TOKV(k) ? tb + (k) * NGW : tb)
                unsigned si[TW][2]; float sus[TW][2], sgv[TW][2];
                LAS u32x4* hl = (LAS u32x4*)(pl + 32 * 68);
                { float g0[TW], g1[TW]; int lane_s; asm volatile("v_mbcnt_lo_u32_b32 %0, -1, 0\n\tv_mbcnt_hi_u32_b32 %0, -1, %0" : "=v"(lane_s));
#pragma unroll
                  for (int k = 0; k < TW; ++k) { const size_t o = (size_t)TOK(k) * NE + lane_s; si[k][0] = ((unsigned)IDX[o] << 7) | (unsigned)lane_s; si[k][1] = ((unsigned)IDX[o + 64] << 7) | (unsigned)(64 + lane_s); g0[k] = GATE[o]; g1[k] = GATE[o + 64]; }
#pragma unroll
                  for (int kk = 2; kk <= 128; kk <<= 1) {
#pragma unroll
                      for (int j = kk >> 1; j > 0; j >>= 1) {
                          if (j == 64) {
#pragma unroll
                              for (int k = 0; k < TW; ++k) { const unsigned a = si[k][0], b = si[k][1]; si[k][0] = a < b ? a : b; si[k][1] = a < b ? b : a; } }
                          else { const bool lower = (lane_s & j) == 0, tm0 = lower == ((lane_s & kk) == 0), tm1 = lower == (((lane_s + 64) & kk) == 0); const int pa = (lane_s ^ j) << 2;
#pragma unroll
                              for (int k = 0; k < TW; ++k) { const unsigned a = si[k][0], b = si[k][1], p0 = (unsigned)__builtin_amdgcn_ds_bpermute(pa, (int)a), p1 = (unsigned)__builtin_amdgcn_ds_bpermute(pa, (int)b);
                                  si[k][0] = tm0 ? (a < p0 ? a : p0) : (a < p0 ? p0 : a); si[k][1] = tm1 ? (b < p1 ? b : p1) : (b < p1 ? p1 : b); } }
                          __builtin_amdgcn_sched_barrier(0);
                      } }
#pragma unroll
                  for (int k = 0; k < TW; ++k) {
#pragma unroll
                      for (int r = 0; r < 2; ++r) { const unsigned key = si[k][r]; const int a = (int)(key & 63u) << 2; const int ga = __builtin_amdgcn_ds_bpermute(a, __float_as_int(g0[k])), gb = __builtin_amdgcn_ds_bpermute(a, __float_as_int(g1[k]));
                          const unsigned ix = key >> 7; si[k][r] = ix; sus[k][r] = usl[ix]; sgv[k][r] = __int_as_float((key & 64u) ? gb : ga) * vsl[ix]; } }
#pragma unroll
                  for (int k = 0; k < TW; ++k) { const bf16* hr = H + (size_t)TOK(k) * D + lane_s * 16; hl[(k * 2) * 64 + lane_s] = *(const u32x4*)hr; hl[(k * 2 + 1) * 64 + lane_s] = *(const u32x4*)(hr + 8); }
                }
                __builtin_amdgcn_sched_barrier(0);
#define ROWLD(dst, rs, ixv, ln) dst = __builtin_amdgcn_raw_buffer_load_b96(rs, voff, __builtin_amdgcn_readlane((int)(ixv), (ln)) * ROWB, 0)
#define LOADQ(buf, rs, ixv, ln0) do { _Pragma("unroll") for (int j_ = 0; j_ < 8; ++j_) ROWLD((buf)[j_], rs, ixv, (ln0) + j_); __builtin_amdgcn_sched_barrier(0); } while (0)
#define CVT2(a, b) const f32x32_t f_ = __builtin_amdgcn_cvt_scalef32_pk32_f32_fp6((u32x6_t){(a).x, (a).y, (a).z, (b).x, (b).y, (b).z}, 1.0f)
#define PR(i) __builtin_shufflevector(f_, f_, 2 * (i), 2 * (i) + 1)
#define DOTQ(buf, e0) do { _Pragma("unroll") for (int j_ = 0; j_ < 8; j_ += 2) { \
                        const u32x16_t g_ = __builtin_bit_cast(u32x16_t, __builtin_amdgcn_cvt_scalef32_pk32_bf16_fp6((u32x6_t){(buf)[j_].x, (buf)[j_].y, (buf)[j_].z, (buf)[j_ + 1].x, (buf)[j_ + 1].y, (buf)[j_ + 1].z}, 1.0f));     \
                        float a0_ = 0.f, a1_ = 0.f, b0_ = 0.f, b1_ = 0.f; \
                        _Pragma("unroll") for (int i_ = 0; i_ < 8; i_ += 2) { a0_ = DOT2(g_[i_], hpk[i_], a0_); b0_ = DOT2(g_[8 + i_], hpk[i_], b0_); a1_ = DOT2(g_[i_ + 1], hpk[i_ + 1], a1_); b1_ = DOT2(g_[9 + i_], hpk[i_ + 1], b1_); } \
                        pl[((e0) + j_) * 68 + lane_u] = a0_ + a1_; pl[((e0) + j_ + 1) * 68 + lane_u] = b0_ + b1_; __builtin_amdgcn_sched_barrier(0); } } while (0)
#define DOT2(x_, y_, c_) __builtin_amdgcn_fdot2_f32_bf16(__builtin_bit_cast(bf16x2_t, (unsigned)(x_)), __builtin_bit_cast(bf16x2_t, (unsigned)(y_)), (c_), false)
#define AXPYQ(buf, k, cfv, ln0) do { _Pragma("unroll") for (int j_ = 0; j_ < 8; j_ += 2) { CVT2((buf)[j_], (buf)[j_ + 1]); \
                        const float ca = __int_as_float(__builtin_amdgcn_readlane(__float_as_int(cfv), (ln0) + j_)), cb = __int_as_float(__builtin_amdgcn_readlane(__float_as_int(cfv), (ln0) + j_ + 1)); \
                        acc2[k][0] += ca * PR(0); acc2[k][1] += ca * PR(1); acc2[k][2] += ca * PR(2); acc2[k][3] += ca * PR(3); acc2[k][4] += ca * PR(4); acc2[k][5] += ca * PR(5); acc2[k][6] += ca * PR(6); acc2[k][7] += ca * PR(7); \
                        acc2[k][0] += cb * PR(8); acc2[k][1] += cb * PR(9); acc2[k][2] += cb * PR(10); acc2[k][3] += cb * PR(11); acc2[k][4] += cb * PR(12); acc2[k][5] += cb * PR(13); acc2[k][6] += cb * PR(14); acc2[k][7] += cb * PR(15); __builtin_amdgcn_sched_barrier(0); } } while (0)
                u32x3_t ba[8], bb_[8];
                int lane_u; asm volatile("v_mbcnt_lo_u32_b32 %0, -1, 0\n\tv_mbcnt_hi_u32_b32 %0, -1, %0" : "=v"(lane_u)); const int voff = lane_u * 12;
                LOADQ(ba, ru, si[0][0], 0);
#pragma unroll 1
                for (int c = 0; c < 16; ++c) {
                    const int lb = (c & 7) * 8; const bool r1 = c >= 8;
#pragma unroll
                    for (int k = 0; k < TW; ++k) {
                        unsigned hpk[8];
                        { const u32x4 h0 = hl[(k * 2) * 64 + lane_u], h1 = hl[(k * 2 + 1) * 64 + lane_u]; hpk[0] = h0.x; hpk[1] = h0.y; hpk[2] = h0.z; hpk[3] = h0.w; hpk[4] = h1.x; hpk[5] = h1.y; hpk[6] = h1.z; hpk[7] = h1.w; }
                        if (k & 1) { if (k < TW - 1) LOADQ(ba, ru, r1 ? si[k + 1][1] : si[k + 1][0], lb); else { const int cn = (c + 1) & 15; const __amdgpu_buffer_rsrc_t rn = c < 15 ? ru : rv; LOADQ(ba, rn, (cn >= 8) ? si[0][1] : si[0][0], (cn & 7) * 8); } DOTQ(bb_, k * 8); }
                        else { LOADQ(bb_, ru, r1 ? si[k + 1][1] : si[k + 1][0], lb); DOTQ(ba, k * 8); }
                    }
                    __builtin_amdgcn_wave_barrier(); asm volatile("s_waitcnt lgkmcnt(0)" ::: "memory");
                    float dsum;
                    { const LAS float* rp = pl + (lane_u & 31) * 68 + (lane_u >> 5) * 32; f32x4 s4 = *(const LAS f32x4*)rp;
#pragma unroll
                      for (int j = 1; j < 8; ++j) s4 += *(const LAS f32x4*)(rp + j * 4);
                      dsum = (s4.x + s4.y) + (s4.z + s4.w); }
                    dsum += shflx(dsum, lane_u, 32);
                    __builtin_amdgcn_wave_barrier(); asm volatile("s_waitcnt lgkmcnt(0)" ::: "memory");
                    const bool home = (lane_u >> 3) == (c & 7);
#pragma unroll
                    for (int k = 0; k < TW; ++k) {
                        const float dv = __int_as_float(__builtin_amdgcn_ds_bpermute((k * 8 + (lane_u & 7)) << 2, __float_as_int(dsum)));
                        const float cf = (r1 ? sgv[k][1] : sgv[k][0]) * gelu_erf(dv * (r1 ? sus[k][1] : sus[k][0]));
                        if (r1) sgv[k][1] = home ? cf : sgv[k][1]; else sgv[k][0] = home ? cf : sgv[k][0]; }
                    __builtin_amdgcn_sched_barrier(0);
                }
                f32x2_t acc2[TW][8];
#pragma unroll
                for (int k = 0; k < TW; ++k) {
#pragma unroll
                    for (int i = 0; i < 8; ++i) acc2[k][i] = (f32x2_t){0.f, 0.f}; }
#pragma unroll 1
                for (int c = 0; c < 16; ++c) {
                    const int lb = (c & 7) * 8; const bool r1 = c >= 8;
#pragma unroll
                    for (int k = 0; k < TW; ++k) {
                        const float cfk = r1 ? sgv[k][1] : sgv[k][0];
                        if (k & 1) { if (k < TW - 1) LOADQ(ba, rv, r1 ? si[k + 1][1] : si[k + 1][0], lb); else { const int cn = (c + 1) & 15; LOADQ(ba, rv, (cn >= 8) ? si[0][1] : si[0][0], (cn & 7) * 8); }     AXPYQ(bb_, k, cfk, lb); }
                        else { LOADQ(bb_, rv, r1 ? si[k + 1][1] : si[k + 1][0], lb); AXPYQ(ba, k, cfk, lb); }
                    }
                }
#undef ROWLD
#undef LOADQ
#undef CVT2
#undef PR
#undef DOTQ
#undef DOT2
#undef AXPYQ
                { int ln; asm volatile("v_mbcnt_lo_u32_b32 %0, -1, 0\n\tv_mbcnt_hi_u32_b32 %0, -1, %0" : "=v"(ln));
                  LAS f32x4* al = (LAS f32x4*)pl + ln;
#pragma unroll
                  for (int k = 0; k < TW; ++k) {
#pragma unroll
                      for (int q = 0; q < 4; ++q) al[(k * 4 + q) * 64] = (f32x4){acc2[k][q * 2].x, acc2[k][q * 2].y, acc2[k][q * 2 + 1].x, acc2[k][q * 2 + 1].y}; }
                  asm volatile("s_waitcnt lgkmcnt(0)" ::: "memory"); __builtin_amdgcn_sched_barrier(0);
#pragma unroll 1
                  for (int k = 0; k < TW; ++k) { const int t = tb + k * NGW; if (t >= T) break; const int b = t / SEQ;
                    float* xr = X + (size_t)t * D + ln * 16; const float* g2 = modl + (size_t)b * 6 * D + 5 * D + ln * 16;
                    f32x4 xv[4]; float ss = 0.f;
#pragma unroll
                    for (int q = 0; q < 4; ++q) { const f32x4 xo = *(const f32x4*)(xr + q * 4), gg = *(const f32x4*)(g2 + q * 4);
                        xv[q] = xo + gg * al[(k * 4 + q) * 64]; ss += (xv[q].x * xv[q].x + xv[q].y * xv[q].y) + (xv[q].z * xv[q].z + xv[q].w * xv[q].w); }
                    const float rs = rsqrtf(wave_sum(ss, ln) * (1.f / D) + NORM_EPS);
                    if (fin) {
#pragma unroll
                        for (int q = 0; q < 4; ++q) *(f32x4*)(xr + q * 4) = xv[q] * rs * *(const f32x4*)(lnf + ln * 16 + q * 4); }
                    else {
                        const float* gam = INP(4) + (l + 1) * D + ln * 16; const float* mn = MOD + (size_t)(l + 1) * BATCH * 6 * D + (size_t)b * 6 * D + ln * 16; u32x4 ho[2];
#pragma unroll
                        for (int q = 0; q < 4; ++q) { *(f32x4*)(xr + q * 4) = xv[q];
                            const f32x4 y = xv[q] * rs * *(const f32x4*)(gam + q * 4) * (*(const f32x4*)(mn + D + q * 4) + 1.f) + *(const f32x4*)(mn + q * 4);
                            if (q & 1) { ho[q >> 1].z = pk2(y.x, y.y); ho[q >> 1].w = pk2(y.z, y.w); } else { ho[q >> 1].x = pk2(y.x, y.y); ho[q >> 1].y = pk2(y.z, y.w); } }
                        *(u32x4*)(H + (size_t)t * D + ln * 16) = ho[0]; *(u32x4*)(H + (size_t)t * D + ln * 16 + 8) = ho[1]; }
                  }
                  asm volatile("s_waitcnt lgkmcnt(0)" ::: "memory"); __builtin_amdgcn_wave_barrier();
                }
#undef TOK
#undef TOKV
            }
        }
    }
#undef modl
#undef xin
#undef IN
#undef SEAM
}
#undef MOD
#undef H
#undef PROJ
#undef Q
#undef MIX
#undef Rb
#undef Kb
#undef V0
#undef V1
#undef KKb
#undef Bb
#undef Gb
#undef BGb
#undef Wd
#undef Y
#undef IDX
#undef GATE
#undef WinT
#undef WoutT
#undef PqT
#undef KEYS
#undef QB
#undef POOLIN
#undef SH
#undef WUPT
#undef AUPT
#undef GUPT
#undef VUPT
#undef PWT
#undef INVN
#undef BSUM
#undef SCN
#undef U8
#undef V8
#undef USc
#undef VSc
#undef INP
#undef PHASE_IDS

extern "C" void kernel_launch(void* const* d_in, const int* in_sizes, int n_in, void* d_out, int out_size, void* d_ws, size_t ws_size, hipStream_t stream) {
    if (n_in != 30 || ws_size < WS_END) { fprintf(stderr, "kernel_launch: unexpected n_in %d / ws_size %zu\n", n_in, ws_size); return; }
    static int grid = 0;
    if (grid == 0) {
        int dev = 0, cus = 0, per_cu = 0;
        (void)hipGetDevice(&dev); (void)hipDeviceGetAttribute(&cus, hipDeviceAttributeMultiprocessorCount, dev);
        if (hipFuncSetAttribute((const void*)mega, hipFuncAttributeMaxDynamicSharedMemorySize, LDS_BYTES) != hipSuccess) { fprintf(stderr, "hipFuncSetAttribute failed\n"); grid = -1; return; }
        if (hipOccupancyMaxActiveBlocksPerMultiprocessor(&per_cu, (const void*)mega, NTHR, LDS_BYTES) != hipSuccess || per_cu < 1) { fprintf(stderr, "occupancy query failed (%d)\n", per_cu); per_cu = 1; }
        (void)hipGetLastError();
        grid = (cus > 0 ? cus : 256) * 1;
    }
    if (grid < 0) return;
    Args a{}; for (int i = 0; i < 30; ++i) a.in[i] = (const float*)d_in[i]; a.out = (float*)d_out; a.ws = (unsigned char*)d_ws;
    a.ph_lo = 0; a.ph_hi = NPH;
    if (hipMemsetAsync(d_ws, 0, 65536, stream) != hipSuccess) { fprintf(stderr, "memset failed\n"); return; }
    void* kargs[] = {&a};
    hipError_t e = hipLaunchCooperativeKernel((const void*)mega, dim3(grid), dim3(NTHR), kargs, LDS_BYTES, stream);
    if (e != hipSuccess) fprintf(stderr, "cooperative launch failed: %s (grid %d)\n", hipGetErrorString(e), grid);
}
```

```cpp
#include <hip/hip_runtime.h>
#include <hip/hip_cooperative_groups.h>
namespace cg = cooperative_groups;
#include <cstdio>
#include <cstdint>
#include <cmath>

constexpr int D = 1024, BATCH = 4, SEQ = 4096, T = BATCH * SEQ, DEPTH = 2;
constexpr int RW = 512, HS = 64, NH = 8;
constexpr int DL = 64, AL = 64, MVL = 32, GL = 128;
constexpr int RWKV_COLS = 3 * RW + DL + AL + GL;
constexpr int PW = 512, PG = 128;
constexpr int IN_COLS = RWKV_COLS + PW;
constexpr int LDP = 2560;
constexpr int NKEYS = 128, NEXP = NKEYS * NKEYS, PH = 8, PQ = 256, PHALF = 128, TOPK = 16;
constexpr int NE = PH * TOPK;
constexpr float NORM_EPS = 1e-6f, GN_EPS = 64e-5f;

typedef unsigned short bf16;
__device__ __forceinline__ float bf2f(bf16 u) { return __uint_as_float((unsigned)u << 16); }
typedef float cvt_f32x2 __attribute__((ext_vector_type(2))); typedef __bf16 cvt_bf16x2 __attribute__((ext_vector_type(2)));
__device__ __forceinline__ unsigned cvtpk(float lo, float hi) { const cvt_f32x2 v = {lo, hi}; const cvt_bf16x2 b = __builtin_convertvector(v, cvt_bf16x2); return __builtin_bit_cast(unsigned, b); }
__device__ __forceinline__ bf16 f2bf(float f) { return (bf16)cvtpk(f, 0.f); }

constexpr size_t MiB = 1u << 20;
constexpr size_t WS_MOD = 1 * MiB;
constexpr size_t WS_US = 1 * MiB + 256 * 1024;
constexpr size_t WS_VS = 1 * MiB + 512 * 1024;
constexpr size_t WS_H = 2 * MiB;
constexpr size_t WS_PROJ = 34 * MiB;
constexpr size_t WS_Q = WS_PROJ;
constexpr size_t WS_R = 114 * MiB;
constexpr size_t WS_K = 130 * MiB;
constexpr size_t WS_V0 = 146 * MiB;
constexpr size_t WS_V1 = 162 * MiB;
constexpr size_t WS_KK = 178 * MiB;
constexpr size_t WS_B = 194 * MiB;
constexpr size_t WS_G = 210 * MiB;
constexpr size_t WS_BG = 226 * MiB;
constexpr size_t WS_W = 242 * MiB;
constexpr size_t WS_Y = 274 * MiB;
constexpr size_t WS_MIX = 306 * MiB;
constexpr size_t WS_IDX = 338 * MiB;
constexpr size_t WS_GATE = 346 * MiB;
constexpr size_t WS_WIN_T = 354 * MiB;
constexpr size_t WS_WOUT_T = 364 * MiB;
constexpr size_t WS_PQ_T = 368 * MiB;
constexpr size_t WS_KEYS = 376 * MiB;
constexpr size_t WS_U = 378 * MiB;
constexpr size_t WS_V = 442 * MiB;
constexpr size_t WS_QB = 410 * MiB;
constexpr size_t WS_SH = 426 * MiB;
constexpr size_t WS_LORA = 428 * MiB;
constexpr size_t WS_INVN = 430 * MiB;
constexpr size_t WS_BSUM = 431 * MiB;
constexpr size_t WS_SCN = 2 * MiB;
constexpr size_t WS_END = 506 * MiB;

template <int CTRL> __device__ __forceinline__ float dppf(float x) { return __int_as_float(__builtin_amdgcn_update_dpp(0, __float_as_int(x), CTRL, 0xF, 0xF, false)); }
__device__ __forceinline__ float red16(float x) { x += dppf<0xB1>(x); x += dppf<0x4E>(x); x += dppf<0x141>(x); x += dppf<0x140>(x); return x; }
__device__ __forceinline__ float shflx(float v, int lane, int off) { return __int_as_float(__builtin_amdgcn_ds_bpermute((lane ^ off) << 2, __float_as_int(v))); }
__device__ __forceinline__ unsigned shflxu(unsigned v, int lane, int off) { return (unsigned)__builtin_amdgcn_ds_bpermute((lane ^ off) << 2, (int)v); }
__device__ __forceinline__ void sort128(unsigned& k0, unsigned& k1, int lane) {
#pragma unroll
    for (int k = 2; k <= 128; k <<= 1) {
#pragma unroll
        for (int j = k >> 1; j > 0; j >>= 1) {
            if (j == 64) { const unsigned lo = k0 < k1 ? k0 : k1, hi = k0 < k1 ? k1 : k0; k0 = lo; k1 = hi; }
            else {
                const unsigned p0 = shflxu(k0, lane, j), p1 = shflxu(k1, lane, j);
                const bool lower = (lane & j) == 0, up0 = (lane & k) == 0, up1 = ((lane + 64) & k) == 0;
                const unsigned mn0 = k0 < p0 ? k0 : p0, mx0 = k0 < p0 ? p0 : k0, mn1 = k1 < p1 ? k1 : p1, mx1 = k1 < p1 ? p1 : k1;
                k0 = (lower == up0) ? mn0 : mx0; k1 = (lower == up1) ? mn1 : mx1;
            }
        }
    }
}
__device__ __forceinline__ float wave_sum(float v, int lane) { v = red16(v); v += shflx(v, lane, 16); v += shflx(v, lane, 32); return v; }
__device__ __forceinline__ float sigmoidf_(float x) { return 1.f / (1.f + expf(-x)); }

namespace pg8 {
#define PG8_LAS __attribute__((address_space(3)))
typedef unsigned short bf16_t;
typedef short bf16x8 __attribute__((ext_vector_type(8)));
typedef float f32x4 __attribute__((ext_vector_type(4)));
typedef unsigned u32x4 __attribute__((ext_vector_type(4)));
constexpr int BM = 256, BK = 64, HALF = 128, HTB = HALF * BK * 2  , STAGE_BYTES = 8 * HTB, NXCD = 8, WGM = 8;

__host__ __device__ __forceinline__ int lds_byte(int r, int c) { const int st = (r >> 4) * 2 + (c >> 5), rr = r & 15, cc = c & 31, ob = rr * 64 + cc * 2; return st * 1024 + (ob ^ (((ob >> 9) & 1) << 5)); }
__host__ __device__ __forceinline__ void stage_rc(int b, int& R, int& C) { const int st = b / 1024, sb = b % 1024, swz = sb ^ (((sb >> 9) & 1) << 5); R = (st >> 1) * 16 + swz / 64; C = (st & 1) * 32 + (swz % 64) / 2; }
__host__ __device__ __forceinline__ int perm32(int rho) { const int n = rho >> 4, i = rho & 15; return 8 * (i >> 2) + 4 * n + (i & 3); }

struct Unit { int pm, pn; };
struct Gemm { const bf16_t* A; const bf16_t* Bt; int M, N, K; };

struct StaticOrder {
    int nM, nN, nwg, G, c;
    __host__ __device__ void init(int M, int N, int G_, int c_) { nM = M / BM; nN = N / BM; nwg = nM * nN; G = G_; c = c_; }
    __host__ __device__ bool next(int i, Unit& u) const {
        const long L = (long)i * G + c; if (L >= nwg) return false;
        int wgid = (int)L; { const int q = nwg / NXCD, r = nwg % NXCD, xcd = wgid % NXCD, off = wgid / NXCD; wgid = (xcd < r ? xcd * (q + 1) : r * (q + 1) + (xcd - r) * q) + off; }
        const int nig = WGM * nN, gid = wgid / nig, fm = gid * WGM, gsz = (nM - fm) < WGM ? (nM - fm) : WGM;
        u.pm = fm + ((wgid % nig) % gsz); u.pn = (wgid % nig) / gsz; return true;
    }
    __device__ __forceinline__ void a_ready(const Unit&) const {}
    __device__ __forceinline__ void done(const Unit&) const {}
};

__device__ __forceinline__ unsigned cvt_pk_bf16(float lo, float hi) { unsigned r; asm volatile("v_cvt_pk_bf16_f32 %0, %1, %2" : "=v"(r) : "v"(lo), "v"(hi)); return r; }
typedef float f32x2 __attribute__((ext_vector_type(2)));
__device__ __forceinline__ f32x2 gelu_pk(f32x2 v) {
    const f32x2 av = __builtin_elementwise_abs(v), d = av * 0.2316418882f + 1.0f;
    f32x2 t; t.x = __builtin_amdgcn_rcpf(d.x); t.y = __builtin_amdgcn_rcpf(d.y);
    f32x2 q = t * 0.5307027145f + (-0.7265760135f); q = q * t + 0.7107068705f; q = q * t + (-0.142248368f); q = q * t + 0.127414796f; q = q * t;
    const f32x2 s = (v * v) * (-0.72134752044f);
    f32x2 e; e.x = __builtin_amdgcn_exp2f(s.x); e.y = __builtin_amdgcn_exp2f(s.y);
    const f32x2 m = v * (q * e), r = v - m;
    f32x2 o; o.x = v.x < 0.f ? m.x : r.x; o.y = v.y < 0.f ? m.y : r.y; return o;
}

template <int ACT  > struct EpiBf16 {
    static constexpr bool PERM = true, AFTER_DRAIN = false; static_assert(ACT == 0 || ACT == 1, "EpiBf16: ACT is 0 (none) or 1 (gelu_pk)");
    bf16_t* O; int ldc; const float* bias; int split_cols; size_t split_stride; float scale0;
    __device__ __forceinline__ void operator()(const f32x4 (&acc)[2][2][4][2], const Unit& u, int wr, int wc, int fr, int fq) const {
        const int row0 = u.pm * BM + wr * 64 + fr; int colt = u.pn * BM; bf16_t* base = O;
        float sc = 1.f; if (split_cols) { const int t = colt / split_cols; base += (size_t)t * split_stride; colt -= t * split_cols; if (t == 0) sc = scale0; }
        const int col0 = colt + wc * 32 + 8 * fq, bcol0 = u.pn * BM + wc * 32 + 8 * fq;
        f32x4 bv[2][2];
#pragma unroll
        for (int bj = 0; bj < 2; ++bj)
#pragma unroll
            for (int n = 0; n < 2; ++n) bv[bj][n] = bias ? *(const f32x4*)(bias + bcol0 + bj * HALF + 4 * n) : (f32x4){0.f, 0.f, 0.f, 0.f};
#pragma unroll
        for (int ai = 0; ai < 2; ++ai)
#pragma unroll
            for (int m = 0; m < 4; ++m) { bf16_t* rowp = base + (size_t)(row0 + ai * HALF + m * 16) * ldc + col0;
#pragma unroll
                for (int bj = 0; bj < 2; ++bj) { f32x4 v0 = acc[ai][bj][m][0] + bv[bj][0], v1 = acc[ai][bj][m][1] + bv[bj][1];
                    if (ACT == 1) { f32x2 a = gelu_pk((f32x2){v0[0], v0[1]}), b = gelu_pk((f32x2){v0[2], v0[3]}), c = gelu_pk((f32x2){v1[0], v1[1]}), d = gelu_pk((f32x2){v1[2], v1[3]});
                        v0 = (f32x4){a.x, a.y, b.x, b.y}; v1 = (f32x4){c.x, c.y, d.x, d.y}; }
                    v0 = v0 * sc; v1 = v1 * sc; u32x4 w; w.x = cvt_pk_bf16(v0[0], v0[1]); w.y = cvt_pk_bf16(v0[2], v0[3]); w.z = cvt_pk_bf16(v1[0], v1[1]); w.w = cvt_pk_bf16(v1[2], v1[3]);
                    *(u32x4*)(rowp + bj * HALF) = w; } }
    }
};

struct EpiProj {
    static constexpr bool PERM = true, AFTER_DRAIN = false;
    bf16_t* O; int ldc; bf16_t* P; int pool0, pw;
    __device__ __forceinline__ void operator()(const f32x4 (&acc)[2][2][4][2], const Unit& u, int wr, int wc, int fr, int fq) const {
        const int row0 = u.pm * BM + wr * 64 + fr; int colt = u.pn * BM; bf16_t* base = O; int ld = ldc;
        if (colt >= pool0 && colt < pool0 + pw) { base = P; ld = pw; colt -= pool0; }
        const int col0 = colt + wc * 32 + 8 * fq;
#pragma unroll
        for (int ai = 0; ai < 2; ++ai)
#pragma unroll
            for (int m = 0; m < 4; ++m) { bf16_t* rowp = base + (size_t)(row0 + ai * HALF + m * 16) * ld + col0;
#pragma unroll
                for (int bj = 0; bj < 2; ++bj) { const f32x4 v0 = acc[ai][bj][m][0], v1 = acc[ai][bj][m][1];
                    u32x4 w; w.x = cvt_pk_bf16(v0[0], v0[1]); w.y = cvt_pk_bf16(v0[2], v0[3]); w.z = cvt_pk_bf16(v1[0], v1[1]); w.w = cvt_pk_bf16(v1[2], v1[3]);
                    *(u32x4*)(rowp + bj * HALF) = w; } }
    }
};
struct EpiResGate {
    static constexpr bool PERM = false, AFTER_DRAIN = false;
    const float* xold; float* X; const float* gate;
    __device__ __forceinline__ void operator()(const f32x4 (&acc)[2][2][4][2], const Unit& u, int wr, int wc, int fr, int fq) const {
        const int col0 = u.pn * BM + wc * 32 + 4 * fq; const int b = (u.pm * BM) / SEQ;
        const float* gp = gate + (size_t)b * 6 * D + col0;
#pragma unroll
        for (int bj = 0; bj < 2; ++bj)
#pragma unroll
            for (int n = 0; n < 2; ++n) { const f32x4 gv = *(const f32x4*)(gp + bj * HALF + n * 16);
#pragma unroll
                for (int ai = 0; ai < 2; ++ai)
#pragma unroll
                    for (int m = 0; m < 4; ++m) { const size_t off = (size_t)(u.pm * BM + ai * HALF + wr * 64 + m * 16 + fr) * D + col0 + bj * HALF + n * 16;
                        const f32x4 xo = *(const f32x4*)(xold + off); *(f32x4*)(X + off) = xo + gv * acc[ai][bj][m][n]; } }
    }
};
template <class Epi, class Sched, bool ALIGN_EPI = false, bool SP2 = false>
__device__ __forceinline__ void gemm_phase(PG8_LAS unsigned char* lds, const Gemm g, const Sched& S, const Epi& E, int tid) {
    asm volatile("" : "+v"(tid));
    const int wid = __builtin_amdgcn_readfirstlane(tid >> 6), lane = tid & 63, wr = wid >> 2, wc = wid & 3, fr = lane & 15, fq = lane >> 4;
    const int K = g.K, nt = K / BK;
    unsigned voffA[2], voffB[2];
#pragma unroll
    for (int i = 0; i < 2; ++i) { int R, C; stage_rc(tid * 16 + i * 8192, R, C); const int Rb = Epi::PERM ? ((R & ~31) + perm32(R & 31)) : R;
        voffA[i] = (unsigned)(R * K + C) * 2u; voffB[i] = (unsigned)(Rb * K + C) * 2u; }
    const size_t kstep = (size_t)(BK * 2);
    const size_t hstep = (size_t)HALF * K * 2;
    const size_t tstep = 2 * hstep;
    const unsigned ldsw = (unsigned)wid * 1024u;
    const int aoff = lds_byte(wr * 64 + fr, fq * 8), boff = lds_byte(wc * 32 + fr, fq * 8);
#define PG8_SA(b, h) (((b) * 2 + (h)) * HTB)
#define PG8_SB(b, h) ((4 + (b) * 2 + (h)) * HTB)
#define PG8_STAGE(bufoff, gbase, voff) do { _Pragma("unroll") for (int _i = 0; _i < 2; ++_i) \
        __builtin_amdgcn_global_load_lds((const unsigned*)((const char*)(gbase) + (voff)[_i]), (PG8_LAS unsigned*)(lds + (bufoff) + ldsw + _i * 8192), 16, 0, 0); } while (0)
#define PG8_LDA(dst, b, h) do { _Pragma("unroll") for (int m = 0; m < 4; ++m) _Pragma("unroll") for (int k = 0; k < 2; ++k) dst[m][k] = *(const PG8_LAS bf16x8*)(lds + PG8_SA(b, h) + aoff + m * 2048 + k * 1024); } while (0)
#define PG8_LDB(dst, b, h) do { _Pragma("unroll") for (int n = 0; n < 2; ++n) _Pragma("unroll") for (int k = 0; k < 2; ++k) dst[n][k] = *(const PG8_LAS bf16x8*)(lds + PG8_SB(b, h) + boff + n * 2048 + k * 1024); } while (0)
#define PG8_MMA(ai, bj, At, Bt) do { __builtin_amdgcn_s_setprio(1); _Pragma("unroll") for (int m = 0; m < 4; ++m) _Pragma("unroll") for (int n = 0; n < 2; ++n) _Pragma("unroll") for (int k = 0; k < 2; ++k) \
        acc[ai][bj][m][n] = __builtin_amdgcn_mfma_f32_16x16x32_bf16(Bt[n][k], At[m][k], acc[ai][bj][m][n], 0, 0, 0); __builtin_amdgcn_s_setprio(0); } while (0)
#define PG8_WAIT_V(n) asm volatile("s_waitcnt vmcnt(" #n ")" ::: "memory")
#define PG8_WAIT_L(n) asm volatile("s_waitcnt lgkmcnt(" #n ")" ::: "memory")
#define PG8_BAR __builtin_amdgcn_s_barrier()
#define PG8_SCHED __builtin_amdgcn_sched_barrier(0)
    Unit cur, nxt; int ui = 0;
    if (!S.next(0, cur)) return;
    f32x4 acc[2][2][4][2];
#pragma unroll
    for (int a = 0; a < 2; ++a)
#pragma unroll
        for (int b = 0; b < 2; ++b)
#pragma unroll
            for (int m = 0; m < 4; ++m)
#pragma unroll
                for (int n = 0; n < 2; ++n) acc[a][b][m][n] = (f32x4){0.f, 0.f, 0.f, 0.f};
    bf16x8 At[4][2], B0[2][2], B1[2][2];
    const char* cA = (const char*)g.A + (size_t)cur.pm * tstep; const char* cB = (const char*)g.Bt + (size_t)cur.pn * tstep;
    S.a_ready(cur);
    if constexpr (SP2) {
        PG8_STAGE(PG8_SB(0, 0), cB, voffB); PG8_STAGE(PG8_SB(0, 1), cB + hstep, voffB); PG8_STAGE(PG8_SA(0, 0), cA, voffA); PG8_STAGE(PG8_SA(0, 1), cA + hstep, voffA);
        if (wr == 1) PG8_BAR;
        PG8_WAIT_V(2); PG8_BAR;
        PG8_STAGE(PG8_SB(1, 0), cB + kstep, voffB); PG8_STAGE(PG8_SA(1, 0), cA + kstep, voffA); PG8_STAGE(PG8_SB(1, 1), cB + hstep + kstep, voffB);
        PG8_WAIT_V(6); PG8_BAR;
    } else {
        PG8_STAGE(PG8_SB(0, 0), cB, voffB); PG8_STAGE(PG8_SA(0, 0), cA, voffA); PG8_STAGE(PG8_SB(0, 1), cB + hstep, voffB); PG8_STAGE(PG8_SA(0, 1), cA + hstep, voffA);
        if (wr == 1) PG8_BAR;
        PG8_WAIT_V(4); PG8_BAR;
        PG8_STAGE(PG8_SB(1, 0), cB + kstep, voffB); PG8_STAGE(PG8_SA(1, 0), cA + kstep, voffA); PG8_STAGE(PG8_SB(1, 1), cB + hstep + kstep, voffB);
        PG8_WAIT_V(6); PG8_BAR;
    }
    for (;;) {
        const bool has_next = S.next(ui + 1, nxt);
        const char* nA = has_next ? (const char*)g.A + (size_t)nxt.pm * tstep : cA; const char* nB = has_next ? (const char*)g.Bt + (size_t)nxt.pn * tstep : cB;
        for (int t = 0; t < nt; t += 2) {
            const bool last = (t == nt - 2);
            const char* a1 = cA + (size_t)(t + 1) * kstep;
            const char* a2 = last ? nA : cA + (size_t)(t + 2) * kstep; const char* b2 = last ? nB : cB + (size_t)(t + 2) * kstep;
            const char* a3 = a2 + kstep; const char* b3 = b2 + kstep;
            if (last && has_next) S.a_ready(nxt);
            if constexpr (SP2) {
            PG8_LDB(B0, 0, 0); PG8_LDB(B1, 0, 1); PG8_SCHED; PG8_LDA(At, 0, 0); PG8_STAGE(PG8_SA(1, 1), a1 + hstep, voffA);
            PG8_WAIT_V(8); PG8_WAIT_L(0); PG8_BAR; PG8_MMA(0, 0, At, B0); PG8_MMA(0, 1, At, B1); PG8_BAR; PG8_SCHED;
            PG8_LDA(At, 0, 1); PG8_STAGE(PG8_SB(0, 0), b2, voffB); PG8_STAGE(PG8_SB(0, 1), b2 + hstep, voffB); PG8_STAGE(PG8_SA(0, 0), a2, voffA);
            PG8_WAIT_V(8); PG8_WAIT_L(0); PG8_BAR; PG8_MMA(1, 0, At, B0); PG8_MMA(1, 1, At, B1); PG8_BAR; PG8_SCHED;
            PG8_LDB(B0, 1, 0); PG8_LDB(B1, 1, 1); PG8_SCHED; PG8_LDA(At, 1, 0); PG8_STAGE(PG8_SA(0, 1), a2 + hstep, voffA);
            PG8_WAIT_V(8); PG8_WAIT_L(0); PG8_BAR; PG8_MMA(0, 0, At, B0); PG8_MMA(0, 1, At, B1); PG8_BAR; PG8_SCHED;
            PG8_LDA(At, 1, 1); PG8_STAGE(PG8_SB(1, 0), b3, voffB); PG8_STAGE(PG8_SB(1, 1), b3 + hstep, voffB); PG8_STAGE(PG8_SA(1, 0), a3, voffA);
            PG8_WAIT_V(8); PG8_WAIT_L(0); PG8_BAR; PG8_MMA(1, 0, At, B0); PG8_MMA(1, 1, At, B1); PG8_BAR; PG8_SCHED;
            } else {
            PG8_LDB(B0, 0, 0); PG8_SCHED; PG8_LDA(At, 0, 0); PG8_STAGE(PG8_SA(1, 1), a1 + hstep, voffA);
            PG8_WAIT_L(8); PG8_BAR; PG8_WAIT_L(0); PG8_MMA(0, 0, At, B0); PG8_BAR; PG8_SCHED;
            PG8_LDB(B1, 0, 1); PG8_STAGE(PG8_SB(0, 0), b2, voffB);
            PG8_BAR; PG8_WAIT_L(0); PG8_MMA(0, 1, At, B1); PG8_BAR;
            PG8_LDA(At, 0, 1); PG8_STAGE(PG8_SA(0, 0), a2, voffA);
            PG8_BAR; PG8_WAIT_L(0); PG8_MMA(1, 0, At, B0); PG8_BAR; PG8_SCHED;
            PG8_STAGE(PG8_SB(0, 1), b2 + hstep, voffB);
            PG8_WAIT_V(6); PG8_BAR; PG8_MMA(1, 1, At, B1); PG8_BAR;
            PG8_LDB(B0, 1, 0); PG8_SCHED; PG8_LDA(At, 1, 0); PG8_STAGE(PG8_SA(0, 1), a2 + hstep, voffA);
            PG8_WAIT_L(8); PG8_BAR; PG8_WAIT_L(0); PG8_MMA(0, 0, At, B0); PG8_BAR; PG8_SCHED;
            PG8_LDB(B1, 1, 1); PG8_STAGE(PG8_SB(1, 0), b3, voffB);
            PG8_BAR; PG8_WAIT_L(0); PG8_MMA(0, 1, At, B1); PG8_BAR;
            PG8_LDA(At, 1, 1); PG8_STAGE(PG8_SA(1, 0), a3, voffA);
            PG8_BAR; PG8_WAIT_L(0); PG8_MMA(1, 0, At, B0); PG8_BAR; PG8_SCHED;
            PG8_STAGE(PG8_SB(1, 1), b3 + hstep, voffB);
            PG8_WAIT_V(6); PG8_BAR; PG8_MMA(1, 1, At, B1); PG8_BAR;
            }
        }
        if constexpr (ALIGN_EPI) { if (wr == 0) PG8_BAR; }
        if constexpr (!Epi::AFTER_DRAIN) { int le_; asm volatile("v_mbcnt_lo_u32_b32 %0, -1, 0\n\tv_mbcnt_hi_u32_b32 %0, -1, %0" : "=v"(le_)); E(acc, cur, wr, wc, le_ & 15, le_ >> 4); S.done(cur); }
        if (!has_next) break;
#pragma unroll
        for (int a = 0; a < 2; ++a)
#pragma unroll
            for (int b = 0; b < 2; ++b)
#pragma unroll
                for (int m = 0; m < 4; ++m)
#pragma unroll
                    for (int n = 0; n < 2; ++n) acc[a][b][m][n] = (f32x4){0.f, 0.f, 0.f, 0.f};
        cur = nxt; cA = nA; cB = nB; ++ui;
        if constexpr (ALIGN_EPI) { if (wr == 1) PG8_BAR; }
    }
    PG8_WAIT_V(0);
    if constexpr (!ALIGN_EPI) { if (wr == 0) PG8_BAR; }
    PG8_BAR;
    if constexpr (Epi::AFTER_DRAIN) { E.fused(acc, cur, wr, wc, fr, fq, lds, wid, lane); S.done(cur); }
#undef PG8_SA
#undef PG8_SB
#undef PG8_STAGE
#undef PG8_LDA
#undef PG8_LDB
#undef PG8_MMA
#undef PG8_WAIT_V
#undef PG8_WAIT_L
#undef PG8_BAR
#undef PG8_SCHED
}
}

#define LAS __attribute__((address_space(3)))
constexpr int NWAVES = 8, NTHR = 512;
constexpr int LDS_BYTES = 147456;
constexpr int NPH = 21;
typedef float f32x4 __attribute__((ext_vector_type(4)));
typedef unsigned u32x4 __attribute__((ext_vector_type(4)));

struct Args { const float* in[30]; float* out; unsigned char* ws; int ph_lo, ph_hi; };

__device__ __forceinline__ unsigned pk2(float lo, float hi) { return cvtpk(lo, hi); }

__device__ __forceinline__ void p0_transpose_item(const float* W, int K, int N, bf16* WT, int row_off, LAS float* scr, int item, int lane) {
    const int nblk = N / 32, kb = item / nblk, nb = item % nblk, k0 = 64 * kb, n0 = 32 * nb;
#pragma unroll 8
    for (int i = 0; i < 32; ++i) { const int kk = 2 * i + (lane >> 5); scr[kk * 33 + (lane & 31)] = W[(size_t)(k0 + kk) * N + n0 + (lane & 31)]; }
    asm volatile("s_waitcnt lgkmcnt(0)" ::: "memory");
    const int c = lane & 7;
#pragma unroll
    for (int j = 0; j < 4; ++j) { const int n = (lane >> 3) + 8 * j; const LAS float* s = scr + (8 * c) * 33 + n;
        u32x4 o; o.x = pk2(s[0 * 33], s[1 * 33]); o.y = pk2(s[2 * 33], s[3 * 33]); o.z = pk2(s[4 * 33], s[5 * 33]); o.w = pk2(s[6 * 33], s[7 * 33]);
        *(u32x4*)(WT + (size_t)(row_off + n0 + n) * K + k0 + 8 * c) = o; }
    asm volatile("s_waitcnt lgkmcnt(0)" ::: "memory");
}

__device__ __forceinline__ void norm_mod_row(const float* xr, const float* gamma, const float* sh, const float* sc, bf16* orow, int lane) {
    f32x4 v[4]; float ss = 0.f;
#pragma unroll
    for (int j = 0; j < 4; ++j) { v[j] = *(const f32x4*)(xr + j * 256 + lane * 4); ss += (v[j].x * v[j].x + v[j].y * v[j].y) + (v[j].z * v[j].z + v[j].w * v[j].w); }
    const float rs = rsqrtf(wave_sum(ss, lane) * (1.f / D) + NORM_EPS);
#pragma unroll
    for (int j = 0; j < 4; ++j) { const int d = j * 256 + lane * 4; const f32x4 g = *(const f32x4*)(gamma + d), a = *(const f32x4*)(sc + d), s = *(const f32x4*)(sh + d);
        const f32x4 y = v[j] * rs * g * (a + 1.f) + s; uint2 o; o.x = pk2(y.x, y.y); o.y = pk2(y.z, y.w); *(uint2*)(orow + d) = o; }
}


#define XB_TMO      128
#define XB_XCNT(j)  (256  + 64 * (j))
#define XB_XSUB(j)  (1280 + 64 * (j))
#define XB_XGEN(j)  (2304 + 64 * (j))
#define XB_TOP      3328
#define XB_TOPGEN   3392
#define XCD_BAR_WORDS 3456
#define XB_SPIN_CAP (1u << 18)

__device__ __forceinline__ unsigned xb_ld(unsigned* p)              { return __hip_atomic_load(p, __ATOMIC_RELAXED, __HIP_MEMORY_SCOPE_AGENT); }
__device__ __forceinline__ unsigned xb_add(unsigned* p, unsigned v) { return __hip_atomic_fetch_add(p, v, __ATOMIC_RELAXED, __HIP_MEMORY_SCOPE_AGENT); }
__device__ __forceinline__ unsigned xb_xcc_id() { return (unsigned)__builtin_amdgcn_s_getreg((3 << 11) | 20) & 0xFu; }
#define XB_SPIN(cond, bar) do { unsigned _sp = 0; while (cond) { __builtin_amdgcn_s_sleep(1); \
    if ((++_sp & 255u) == 0u) { if (xb_ld(&(bar)[XB_TMO])) break; if (_sp > XB_SPIN_CAP) { atomicAdd(&(bar)[XB_TMO], 1u); break; } } } } while (0)

struct XcdBarrier {
    unsigned* bar; unsigned x; int w0;
    volatile __attribute__((address_space(3))) unsigned* st;
};

__device__ __forceinline__ XcdBarrier xcd_barrier_post(unsigned* bar, volatile __attribute__((address_space(3))) unsigned* st) {
    XcdBarrier b; b.bar = bar; b.x = xb_xcc_id(); b.st = st; b.w0 = __builtin_amdgcn_readfirstlane((int)threadIdx.x >> 6);
    if (threadIdx.x == 0) (void)xb_add(&bar[XB_XCNT(b.x)], 1u);
    return b;
}
__device__ __forceinline__ void xcd_barrier_complete(unsigned* bar, unsigned x, unsigned& nloc, unsigned& nx) {
    const unsigned G = gridDim.x * gridDim.y * gridDim.z;
    unsigned sum, cnt, mine, sp = 0u;
    for (;;) {
        sum = 0u; cnt = 0u; mine = 0u;
#pragma unroll
        for (unsigned j = 0; j < 16; ++j) { const unsigned c = xb_ld(&bar[XB_XCNT(j)]); sum += c; cnt += (c > 0u) ? 1u : 0u; }
        mine = xb_ld(&bar[XB_XCNT(x)]);
        if (sum == G) break;
        __builtin_amdgcn_s_sleep(1);
        if ((++sp & 255u) == 0u) { if (xb_ld(&bar[XB_TMO])) break; if (sp > XB_SPIN_CAP) { atomicAdd(&bar[XB_TMO], 1u); break; } }
    }
    nloc = mine > 0u ? mine : 1u; nx = cnt > 0u ? cnt : 1u;
}

template <bool FIRST> __device__ __forceinline__ void xcd_barrier(const XcdBarrier& b) {
    asm volatile("s_waitcnt vmcnt(0)" ::: "memory");
    __syncthreads();
    int lid_; asm volatile("v_mbcnt_lo_u32_b32 %0, -1, 0\n\tv_mbcnt_hi_u32_b32 %0, -1, %0" : "=v"(lid_));
    if (b.w0 == 0 && lid_ == 0) {
        unsigned* bar = b.bar;
        __builtin_amdgcn_s_waitcnt(0);
        unsigned nloc = b.st[0], nx = b.st[1];
        if (FIRST && nloc == 0u) { xcd_barrier_complete(bar, b.x, nloc, nx); b.st[0] = nloc; b.st[1] = nx; }
        const unsigned old = xb_add(&bar[XB_XSUB(b.x)], 1u);
        const unsigned gen = old / nloc;
        if (old + 1u == (gen + 1u) * nloc) {
            __builtin_amdgcn_fence(__ATOMIC_RELEASE, "agent");
            asm volatile("s_waitcnt vmcnt(0)" ::: "memory");
            const unsigned og = xb_add(&bar[XB_TOP], 1u);
            const unsigned tg = og / nx;
            if (og + 1u == (tg + 1u) * nx) xb_add(&bar[XB_TOPGEN], 1u);
            else XB_SPIN(xb_ld(&bar[XB_TOPGEN]) == tg, bar);
            __builtin_amdgcn_fence(__ATOMIC_ACQUIRE, "agent");
            xb_add(&bar[XB_XGEN(b.x)], 1u);
            asm volatile("s_waitcnt vmcnt(0)" ::: "memory");
        } else {
            XB_SPIN(xb_ld(&bar[XB_XGEN(b.x)]) == gen, bar);
            __builtin_amdgcn_fence(__ATOMIC_ACQUIRE, "agent");
            asm volatile("s_waitcnt vmcnt(0)" ::: "memory");
        }
    }
    __syncthreads();
}


__device__ __forceinline__ unsigned mono_u32(float f) { unsigned u = __float_as_uint(f); return (u & 0x80000000u) ? ~u : (u | 0x80000000u); }
__device__ __forceinline__ float demono_u32(unsigned u) { return __uint_as_float((u & 0x80000000u) ? (u & 0x7FFFFFFFu) : ~u); }
__device__ __forceinline__ unsigned pack_key7(float f, int idx) { return (mono_u32(f) & 0xFFFFFF80u) | (unsigned)(127 - idx); }
__device__ __forceinline__ float unpack_key7(unsigned k) { return demono_u32((k & 0xFFFFFF80u) | 0x40u); }
__device__ __forceinline__ float unpack_key8(unsigned k) { return demono_u32((k & 0xFFFFFF00u) | 0x80u); }
__device__ __forceinline__ void ce_desc(unsigned& a, unsigned& b) { const unsigned hi = a > b ? a : b, lo = a > b ? b : a; a = hi; b = lo; }
__device__ __forceinline__ void sort16_desc(unsigned* v) {
#pragma unroll
    for (int k = 2; k <= 16; k <<= 1)
#pragma unroll
        for (int j = k >> 1; j > 0; j >>= 1)
#pragma unroll
            for (int i = 0; i < 16; ++i) { const int l = i ^ j; if (l > i) { if ((i & k) == 0) ce_desc(v[i], v[l]); else ce_desc(v[l], v[i]); } }
}
__device__ __forceinline__ void bmerge16_desc(unsigned* v) {
#pragma unroll
    for (int j = 8; j > 0; j >>= 1)
#pragma unroll
        for (int i = 0; i < 16; ++i) { const int l = i ^ j; if (l > i) ce_desc(v[i], v[l]); }
}
__device__ __forceinline__ void merge_top16(unsigned* a, const unsigned* b) {
#pragma unroll
    for (int i = 0; i < 16; ++i) { const unsigned o = b[15 - i]; a[i] = a[i] > o ? a[i] : o; }
    bmerge16_desc(a);
}
__device__ __forceinline__ void stage2_cands(const unsigned* s0, const unsigned* s1, int hh, unsigned* c) {
    float A[16], B[16];
#pragma unroll
    for (int i = 0; i < 16; ++i) { const float f0 = unpack_key7(s0[i]), f1 = unpack_key7(s1[i]); A[i] = hh ? f1 : f0; B[i] = hh ? f0 : f1; }
    int n = 0;
#pragma unroll
    for (int i = 0; i < 4; ++i)
#pragma unroll
        for (int j = i; j < 16; ++j) { if ((i + 1) * (j + 1) > 16) continue;
            const float val = A[i] + B[j]; const unsigned id = hh ? (unsigned)((j << 4) | i) : (unsigned)((i << 4) | j);
            unsigned key = (mono_u32(val) & 0xFFFFFF00u) | id; if (hh && i == j) key = 0u; c[n++] = key; }
#pragma unroll
    for (; n < 32; ++n) c[n] = 0u;
}

typedef short bf16x8_t __attribute__((ext_vector_type(8)));
typedef float f32x16 __attribute__((ext_vector_type(16)));
__device__ __forceinline__ float gelu_erf(float a) { return 0.5f * a * (1.f + erff(a * 0.70710678118654752f)); }


typedef __attribute__((address_space(3))) bf16 lbf16;

__device__ __forceinline__ f32x16 mm32(bf16x8_t a, bf16x8_t b, f32x16 c) { return __builtin_amdgcn_mfma_f32_32x32x16_bf16(a, b, c, 0, 0, 0); }
__device__ __forceinline__ bf16x8_t frag_from_u32x4(unsigned x, unsigned y, unsigned z, unsigned w) { typedef unsigned u4 __attribute__((ext_vector_type(4))); u4 t = {x, y, z, w}; return __builtin_bit_cast(bf16x8_t, t); }
template <int S> __device__ __forceinline__ bf16x8_t accop(const f32x16& z) {
    return frag_from_u32x4(cvtpk(z[8 * S], z[8 * S + 1]), cvtpk(z[8 * S + 2], z[8 * S + 3]), cvtpk(z[8 * S + 4], z[8 * S + 5]), cvtpk(z[8 * S + 6], z[8 * S + 7])); }
template <int S> __device__ __forceinline__ bf16x8_t ldpermcol(const lbf16* a, int col, int hh) {
    const lbf16* p = a + (16 * S + 4 * hh) * 72 + col;
    const unsigned e0 = p[0], e1 = p[72], e2 = p[144], e3 = p[216], e4 = p[8 * 72], e5 = p[9 * 72], e6 = p[10 * 72], e7 = p[11 * 72];
    return frag_from_u32x4(e0 | (e1 << 16), e2 | (e3 << 16), e4 | (e5 << 16), e6 | (e7 << 16)); }
__device__ __forceinline__ bf16x8_t ldrow(const lbf16* a, int row, int ks, int hh) { return *(const __attribute__((address_space(3))) bf16x8_t*)(a + row * 72 + ks * 16 + 8 * hh); }
__device__ __forceinline__ int rowidx(int e, int hh) { return (e & 3) + 8 * (e >> 2) + 4 * hh; }

constexpr int ROWB = 768;
__device__ __forceinline__ unsigned fp6code(float x, float sc) {
    const float t = fabsf(x) * sc;
    const float r = t < 16.f ? __builtin_rintf(t) : (t < 32.f ? 8.f + __builtin_rintf(t * 0.5f) : 16.f + __builtin_rintf(t * 0.25f));
    unsigned c = (unsigned)r; c = c > 31u ? 31u : c;
    return c | (x < 0.f ? 32u : 0u);
}
__device__ __forceinline__ void convert_tables_fp6(const float* pu, const float* pv, unsigned char* u8, unsigned char* v8, float* usc, float* vsc, int l, int wv, int nw, int lane) {
    for (int rr0 = wv * 2; rr0 < 2 * NEXP; rr0 += nw * 2) {
        f32x4 v[2][4]; float m[2];
#pragma unroll
        for (int rr = 0; rr < 2; ++rr) { const int q = rr0 + rr; const size_t row = (size_t)l * NEXP + (q < NEXP ? q : q - NEXP); const float* sp_ = (q < NEXP ? pu : pv) + row * D + lane * 16;
#pragma unroll
            for (int k = 0; k < 4; ++k) v[rr][k] = *(const f32x4*)(sp_ + k * 4); }
#pragma unroll
        for (int rr = 0; rr < 2; ++rr) { float mm = 0.f;
#pragma unroll
            for (int k = 0; k < 4; ++k) mm = fmaxf(fmaxf(mm, fmaxf(fabsf(v[rr][k].x), fabsf(v[rr][k].y))), fmaxf(fabsf(v[rr][k].z), fabsf(v[rr][k].w)));
#pragma unroll
            for (int o = 1; o < 64; o <<= 1) mm = fmaxf(mm, shflx(mm, lane, o));
            m[rr] = mm; }
#pragma unroll
        for (int rr = 0; rr < 2; ++rr) { const int q = rr0 + rr; const size_t row = (size_t)l * NEXP + (q < NEXP ? q : q - NEXP); const float sc = m[rr] > 0.f ? 60.f / m[rr] : 1.f;
            unsigned c[16];
#pragma unroll
            for (int k = 0; k < 4; ++k) { c[k * 4] = fp6code(v[rr][k].x, sc); c[k * 4 + 1] = fp6code(v[rr][k].y, sc); c[k * 4 + 2] = fp6code(v[rr][k].z, sc); c[k * 4 + 3] = fp6code(v[rr][k].w, sc); }
            const unsigned o0 = c[0] | (c[1] << 6) | (c[2] << 12) | (c[3] << 18) | (c[4] << 24) | (c[5] << 30);
            const unsigned o1 = (c[5] >> 2) | (c[6] << 4) | (c[7] << 10) | (c[8] << 16) | (c[9] << 22) | (c[10] << 28);
            const unsigned o2 = (c[10] >> 4) | (c[11] << 2) | (c[12] << 8) | (c[13] << 14) | (c[14] << 20) | (c[15] << 26);
            unsigned* op = (unsigned*)((q < NEXP ? u8 : v8) + row * ROWB + lane * 12);
            op[0] = o0; op[1] = o1; op[2] = o2;
            if (lane == 0) (q < NEXP ? usc : vsc)[row] = m[rr] > 0.f ? m[rr] * (1.f / 7.5f) : 1.f; }
    }
}

__global__ void __launch_bounds__(NTHR, 2) mega(Args args) {
    extern __shared__ __attribute__((aligned(16))) unsigned char lds_raw[];
    LAS unsigned char* lds = (LAS unsigned char*)lds_raw;
    const int G = gridDim.x, bx = blockIdx.x, NGW = G * NWAVES;
    const int wave0 = __builtin_amdgcn_readfirstlane((int)threadIdx.x >> 6);
    typedef const unsigned char __attribute__((address_space(4))) kbyte;
#define PHASE_IDS int tid; asm volatile("v_mbcnt_lo_u32_b32 %0, -1, 0\n\tv_mbcnt_hi_u32_b32 %0, -1, %0" : "=v"(tid)); tid += wave0 * 64;     const int lane = tid & 63, wave = __builtin_amdgcn_readfirstlane(tid >> 6), gw = bx * NWAVES + wave; (void)lane; (void)gw; \
    kbyte* kp = (kbyte*)__builtin_amdgcn_kernarg_segment_ptr(); asm volatile("" : "+s"(kp)); \
    unsigned char* const ws = (unsigned char*)*(__attribute__((address_space(1))) unsigned char* const __attribute__((address_space(4)))*)(kp + 31 * 8); float* const X = (float*)*(__attribute__((address_space(1))) float* const __attribute__((address_space(4)))*)(kp + 30 * 8); (void)ws; (void)X;
#define INP(i) ((const float*)(*(const __attribute__((address_space(1))) float* const __attribute__((address_space(4)))*)(kp + (i) * 8)))
#define MOD ((float*)(ws + WS_MOD))
#define H ((bf16*)(ws + WS_H))
#define PROJ ((bf16*)(ws + WS_PROJ))
#define Q ((bf16*)(ws + WS_Q))
#define MIX ((bf16*)(ws + WS_MIX))
#define Rb ((bf16*)(ws + WS_R))
#define Kb ((bf16*)(ws + WS_K))
#define V0 ((bf16*)(ws + WS_V0))
#define V1 ((bf16*)(ws + WS_V1))
#define KKb ((bf16*)(ws + WS_KK))
#define Bb ((bf16*)(ws + WS_B))
#define Gb ((bf16*)(ws + WS_G))
#define BGb ((bf16*)(ws + WS_BG))
#define Wd ((float*)(ws + WS_W))
#define Y ((float*)(ws + WS_Y))
#define QB ((float*)(ws + WS_QB))
#define POOLIN ((bf16*)(ws + WS_QB))
#define SH ((float*)(ws + WS_SH))
#define WUPT ((bf16*)(ws + WS_LORA))
#define AUPT ((bf16*)(ws + WS_LORA + 131072))
#define GUPT ((bf16*)(ws + WS_LORA + 262144))
#define VUPT ((bf16*)(ws + WS_LORA + 524288))
#define PWT ((bf16*)(ws + WS_LORA + 655360))
#define INVN ((float*)(ws + WS_INVN))
#define BSUM ((float*)(ws + WS_BSUM))
#define SCN ((unsigned char*)(ws + WS_SCN))
#define IDX ((int*)(ws + WS_IDX))
#define GATE ((float*)(ws + WS_GATE))
#define WinT ((bf16*)(ws + WS_WIN_T))
#define WoutT ((bf16*)(ws + WS_WOUT_T))
#define PqT ((bf16*)(ws + WS_PQ_T))
#define KEYS ((bf16*)(ws + WS_KEYS))
#define U8 ((unsigned char*)(ws + WS_U))
#define V8 ((unsigned char*)(ws + WS_V))
#define USc ((float*)(ws + WS_US))
#define VSc ((float*)(ws + WS_VS))
    const int lo = args.ph_lo, hi = args.ph_hi;
    { volatile LAS unsigned* misc = (volatile LAS unsigned*)(lds + LDS_BYTES - 64); if (threadIdx.x < 4) misc[threadIdx.x] = 0u; __syncthreads(); }
    const XcdBarrier xbar = xcd_barrier_post((unsigned*)(args.ws) + 4096, (volatile LAS unsigned*)(lds + LDS_BYTES - 64));
#define IN(k) (lo <= (k) && (k) < hi)
#ifndef REP_PHASE
#define REP_PHASE (-1)
#endif
#define REPS(k) ((k) == REP_PHASE ? 3 : 1)
#define SEAM(k) do { if (IN(k) && IN((k) + 1)) { if ((k) == 0) cg::this_grid().sync(); else { XcdBarrier xb_ = xbar; asm volatile("" : "+s"(xb_.bar)); if ((k) == 1) xcd_barrier<true>(xb_); else xcd_barrier<false>(xb_); } } } while (0)

    if (IN(0)) { PHASE_IDS
        { LAS float* ca = (LAS float*)lds; LAS float* red = (LAS float*)(lds + 16384);
          const float* c = INP(1); const float* ada_w = INP(2); const float* ada_b = INP(3);
          bool have = false;
          for (int it = bx; it < 96; it += G) {
              if (!have) { for (int i = tid; i < BATCH * D; i += NTHR) { const float v = c[i]; ca[i] = v / (1.f + expf(-v)); } have = true; __syncthreads(); }
              const int l = it / 48, n = (it % 48) * 128 + (tid & 127), kq = tid >> 7;
              const float* w = ada_w + (size_t)l * D * 6 * D + (size_t)(kq * 256) * 6 * D + n;
              float a0 = 0.f, a1 = 0.f, a2 = 0.f, a3 = 0.f;
#pragma unroll 32
              for (int k = 0; k < 256; ++k) { const float wv = w[(size_t)k * 6 * D]; const int kk = kq * 256 + k; a0 += ca[kk] * wv; a1 += ca[D + kk] * wv; a2 += ca[2 * D + kk] * wv; a3 += ca[3 * D + kk] * wv; }
              red[(kq * 4 + 0) * 128 + (tid & 127)] = a0; red[(kq * 4 + 1) * 128 + (tid & 127)] = a1; red[(kq * 4 + 2) * 128 + (tid & 127)] = a2; red[(kq * 4 + 3) * 128 + (tid & 127)] = a3;
              __syncthreads();
              { const int b = tid >> 7, col = tid & 127, nn = (it % 48) * 128 + col;
                const float s = red[(0 * 4 + b) * 128 + col] + red[(1 * 4 + b) * 128 + col] + red[(2 * 4 + b) * 128 + col] + red[(3 * 4 + b) * 128 + col];
                MOD[(size_t)l * BATCH * 6 * D + (size_t)b * 6 * D + nn] = s + ada_b[l * 6 * D + nn]; }
              __syncthreads();
          }
          __syncthreads(); }
        { LAS float* scr = (LAS float*)(lds + wave * 16384);
          constexpr int I_IN = (D / 64) * (IN_COLS / 32), I_VR = (D / 64) * (MVL / 32), I_OUT = (D / 64) * (D / 32), I_PQ = (D / 64) * (PH * PQ / 32);
          constexpr int NIT = 2 * I_IN + I_VR + 2 * I_OUT + 2 * I_PQ;
          for (int it = gw; it < NIT; it += NGW) { int r = it;
              if (r < 2 * I_IN) { const int l = r / I_IN; p0_transpose_item(INP(5) + (size_t)l * D * IN_COLS, D, IN_COLS, WinT + (size_t)l * LDP * D, 0, scr, r % I_IN, lane); continue; } r -= 2 * I_IN;
              if (r < I_VR) { p0_transpose_item(INP(12), D, MVL, WinT + (size_t)1 * LDP * D, IN_COLS, scr, r, lane); continue; } r -= I_VR;
              if (r < 2 * I_OUT) { const int l = r / I_OUT; p0_transpose_item(INP(23) + (size_t)l * D * D, D, D, WoutT + (size_t)l * D * D, 0, scr, r % I_OUT, lane); continue; } r -= 2 * I_OUT;
              { const int l = r / I_PQ; p0_transpose_item(INP(25) + (size_t)l * D * PH * PQ, D, PH * PQ, PqT + (size_t)l * PH * PQ * D, 0, scr, r % I_PQ, lane); } }
          for (int it = gw; it < 2 * 16 + 2 * 16 + 2 * 32; it += NGW) { int r = it;
              if (r < 32) { const int l = r / 16; p0_transpose_item(INP(8) + (size_t)l * DL * RW, DL, RW, WUPT + (size_t)l * RW * DL, 0, scr, r % 16, lane); continue; } r -= 32;
              if (r < 32) { const int l = r / 16; p0_transpose_item(INP(10) + (size_t)l * AL * RW, AL, RW, AUPT + (size_t)l * RW * AL, 0, scr, r % 16, lane); continue; } r -= 32;
              { const int l = r / 32; p0_transpose_item(INP(11) + (size_t)l * GL * RW, GL, RW, GUPT + (size_t)l * RW * GL, 0, scr, r % 32, lane); } }
          { const float* vu = INP(15); for (int e = bx * NTHR + tid; e < MVL * RW; e += G * NTHR) { const int n = e >> 5, k = e & 31; VUPT[e] = f2bf(vu[k * RW + n]); } }
          for (int it = gw; it < 8 * 8; it += NGW) p0_transpose_item(INP(21) + (size_t)(it >> 3) * PG * PG, PG, PG, PWT + (size_t)(it >> 3) * PG * PG, 0, scr, it & 7, lane);
        }
        { const size_t gt = (size_t)bx * NTHR + tid, NT = (size_t)G * NTHR;
          constexpr size_t NK8 = (size_t)2 * PH * 2 * NKEYS * PHALF / 8;
          const float* src = INP(26); bf16* dst = KEYS;
          for (size_t i = gt; i < NK8; i += NT) {
              const f32x4 a = *(const f32x4*)(src + i * 8), b = *(const f32x4*)(src + i * 8 + 4);
              u32x4 o; o.x = pk2(a.x, a.y); o.y = pk2(a.z, a.w); o.z = pk2(b.x, b.y); o.w = pk2(b.z, b.w); *(u32x4*)(dst + i * 8) = o; }
        }
    }
    SEAM(0);

#pragma unroll
    for (int l = 0; l < DEPTH; ++l) {
        const int pb = 1 + 10 * l;
#define modl (MOD + (size_t)l * BATCH * 6 * D)
#define xin (l == 0 ? INP(0) : (const float*)X)
        if (l == 0 && IN(pb + 0)) { PHASE_IDS const float* gamma = INP(4) + l * D;
            for (int row = gw; row < T; row += NGW) { const int b = row / SEQ; norm_mod_row(xin + (size_t)row * D, gamma, modl + (size_t)b * 6 * D, modl + (size_t)b * 6 * D + D, H + (size_t)row * D, lane); } }
        SEAM(pb + 0);
        if (IN(pb + 1)) { PHASE_IDS const int N1 = l == 0 ? IN_COLS : LDP;
            pg8::Gemm g{H, WinT + (size_t)l * LDP * D, T, N1, D}; pg8::StaticOrder S; S.init(T, N1, G, bx);
            pg8::EpiProj E{PROJ, LDP, POOLIN, RWKV_COLS, PW};
            pg8::gemm_phase<pg8::EpiProj, pg8::StaticOrder, true, true>(lds, g, S, E, tid); }
        SEAM(pb + 1);

        if (IN(pb + 2)) { PHASE_IDS
            constexpr int LST = 296;
            LAS bf16* lin = (LAS bf16*)lds;
            const float* mu = INP(6) + l * RWKV_COLS; const float* vmu = INP(13);
            const float* w0p = INP(7) + l * RW; const float* a0p = INP(9) + l * RW; const float* kkp = INP(16) + l * RW; const float* kap = INP(17) + l * RW; const float* rkp = INP(18) + l * RW; const float* v0p = INP(14);
            const bf16* wupT = WUPT + (size_t)l * RW * DL; const bf16* aupT = AUPT + (size_t)l * RW * AL; const bf16* gupT = GUPT + (size_t)l * RW * GL; const bf16* vupT = VUPT;
            bf16* Vl = l == 0 ? V0 : V1;
            const int r32 = lane & 31, hh = lane >> 5, h = wave;
            for (int tile = bx; tile < T / 32; tile += G) {
                const int t0 = tile * 32;
                __syncthreads();
#pragma unroll 1
                for (int it0 = 0; it0 < 3; it0 += 2) {
                  u32x4 cu_[2], pv_[2]; f32x4 m0_[2], m1_[2];
#pragma unroll
                  for (int it = 0; it < 2; ++it) { const int c8 = tid + (it0 + it) * NTHR; const bool ok = c8 < 32 * 36; const int tok = ok ? c8 / 36 : 0, jc = ok ? c8 % 36 : 0, t = t0 + tok, sq = t % SEQ;
                      cu_[it] = (u32x4){0u, 0u, 0u, 0u}; pv_[it] = (u32x4){0u, 0u, 0u, 0u}; m0_[it] = (f32x4){0.f, 0.f, 0.f, 0.f}; m1_[it] = m0_[it];
                      if (ok && (jc < 32 || l > 0)) { const int col = jc < 32 ? 3 * RW + jc * 8 : IN_COLS + (jc - 32) * 8;
                          cu_[it] = *(const u32x4*)(PROJ + (size_t)t * LDP + col); if (sq > 0) pv_[it] = *(const u32x4*)(PROJ + (size_t)(t - 1) * LDP + col);
                          const float* mp = jc < 32 ? mu + col : vmu + (jc - 32) * 8; m0_[it] = *(const f32x4*)mp; m1_[it] = *(const f32x4*)(mp + 4); } }
#pragma unroll
                  for (int it = 0; it < 2; ++it) { const int c8 = tid + (it0 + it) * NTHR; if (c8 < 32 * 36) { const int tok = c8 / 36, jc = c8 % 36;
                      u32x4 o = {0u, 0u, 0u, 0u};
                      if (jc < 32 || l > 0) {
                          float x[8]; const unsigned cw[4] = {cu_[it].x, cu_[it].y, cu_[it].z, cu_[it].w}, pw[4] = {pv_[it].x, pv_[it].y, pv_[it].z, pv_[it].w}; const float mm[8] = {m0_[it].x, m0_[it].y, m0_[it].z, m0_[it].w, m1_[it].x, m1_[it].y, m1_[it].z, m1_[it].w};
#pragma unroll
                          for (int i = 0; i < 4; ++i) { const float c0 = __uint_as_float(cw[i] << 16), c1 = __uint_as_float(cw[i] & 0xffff0000u), p0 = __uint_as_float(pw[i] << 16), p1 = __uint_as_float(pw[i] & 0xffff0000u);
                              x[2 * i] = c0 + (p0 - c0) * mm[2 * i]; x[2 * i + 1] = c1 + (p1 - c1) * mm[2 * i + 1]; }
                          if (jc < 8) {
#pragma unroll
                              for (int i = 0; i < 8; ++i) { const float e2 = __expf(-2.f * fabsf(x[i])); const float th = (1.f - e2) * __builtin_amdgcn_rcpf(1.f + e2); x[i] = x[i] < 0.f ? -th : th; } }
                          else if (jc >= 16 && jc < 32) {
#pragma unroll
                              for (int i = 0; i < 8; ++i) x[i] = __builtin_amdgcn_rcpf(1.f + __expf(-x[i])); }
                          o.x = pk2(x[0], x[1]); o.y = pk2(x[2], x[3]); o.z = pk2(x[4], x[5]); o.w = pk2(x[6], x[7]);
                      }
                      *(LAS u32x4*)(lin + tok * LST + jc * 8) = o; } } }
                __syncthreads();
                const bool first = (t0 % SEQ) == 0;
                lbf16* tin = (lbf16*)(lds + 19456 + wave * 14336);
                { u32x4 iq[13]; int ql_; asm volatile("v_mbcnt_lo_u32_b32 %0, -1, 0\n\tv_mbcnt_hi_u32_b32 %0, -1, %0" : "=v"(ql_));
#pragma unroll
                  for (int i = 0; i < 13; ++i) { const int q = ql_ + 64 * i; iq[i] = (u32x4){0u, 0u, 0u, 0u};
                      if (q < 792) { const int arr = q / 264, rem = q - arr * 264, row = rem >> 3, cc = rem & 7;
                          if (!(first && row == 0)) iq[i] = *(const u32x4*)(PROJ + (size_t)(t0 - 1 + row) * LDP + arr * RW + h * HS + cc * 8); } }
#pragma unroll
                  for (int i = 0; i < 13; ++i) { const int q = ql_ + 64 * i; if (q < 792) { const int arr = q / 264, rem = q - arr * 264, row = rem >> 3, cc = rem & 7;
                      *(__attribute__((address_space(3))) u32x4*)(tin + arr * 2376 + row * 72 + cc * 8) = iq[i]; } } }
                __builtin_amdgcn_wave_barrier(); asm volatile("s_waitcnt lgkmcnt(0)" ::: "memory");
                float ssq[16], bsm[16];
#pragma unroll
                for (int e = 0; e < 16; ++e) { ssq[e] = 0.f; bsm[e] = 0.f; }
#pragma unroll 1
                for (int rt = 0; rt < 2; ++rt) {
                    f32x16 accW, accA, accG, accV;
#pragma unroll
                    for (int e = 0; e < 16; ++e) { accW[e] = 0.f; accA[e] = 0.f; accG[e] = 0.f; accV[e] = 0.f; }
                    int c = h * HS + rt * 32 + r32;
int hh8 = 8 * hh; asm volatile("" : "+v"(c), "+v"(hh8));
                    const LAS bf16* lrow = lin + r32 * LST + 8 * hh;
                    { bf16x8_t wf[18];
#pragma unroll
                      for (int ks = 0; ks < 4; ++ks) { wf[ks] = *(const bf16x8_t*)(wupT + (size_t)c * DL + ks * 16 + hh8); wf[4 + ks] = *(const bf16x8_t*)(aupT + (size_t)c * AL + ks * 16 + hh8); }
#pragma unroll
                      for (int ks = 0; ks < 8; ++ks) wf[8 + ks] = *(const bf16x8_t*)(gupT + (size_t)c * GL + ks * 16 + hh8);
                      wf[16] = bf16x8_t{}; wf[17] = bf16x8_t{};
                      if (l > 0) { wf[16] = *(const bf16x8_t*)(vupT + (size_t)c * MVL + hh8); wf[17] = *(const bf16x8_t*)(vupT + (size_t)c * MVL + 16 + hh8); }
#pragma unroll
                      for (int ks = 0; ks < 4; ++ks) { accW = __builtin_amdgcn_mfma_f32_32x32x16_bf16(*(const LAS bf16x8_t*)(lrow + ks * 16), wf[ks], accW, 0, 0, 0);
                                                       accA = __builtin_amdgcn_mfma_f32_32x32x16_bf16(*(const LAS bf16x8_t*)(lrow + 64 + ks * 16), wf[4 + ks], accA, 0, 0, 0); }
#pragma unroll
                      for (int ks = 0; ks < 8; ++ks) accG = __builtin_amdgcn_mfma_f32_32x32x16_bf16(*(const LAS bf16x8_t*)(lrow + 128 + ks * 16), wf[8 + ks], accG, 0, 0, 0);
                      if (l > 0) {
#pragma unroll
                          for (int ks = 0; ks < 2; ++ks) accV = __builtin_amdgcn_mfma_f32_32x32x16_bf16(*(const LAS bf16x8_t*)(lrow + 256 + ks * 16), wf[16 + ks], accV, 0, 0, 0); } }
                    const float mur = mu[c], muk = mu[RW + c], muv = mu[2 * RW + c], w0c = w0p[c], a0c = a0p[c], kkc = kkp[c], kac = kap[c], rkc = rkp[c];
                    const float v0c = l > 0 ? v0p[c] : 0.f;
#pragma unroll
                    for (int eb = 0; eb < 16; eb += 4) {
                        bf16 lr[4], lk[4], lv[4], lrp[4], lkp[4], lvp[4], lvf[4];
#pragma unroll
                        for (int i = 0; i < 4; ++i) { const int e = eb + i; const int tok = (e & 3) + 8 * (e >> 2) + 4 * hh, t = t0 + tok; const int ci = rt * 32 + r32;
                            lr[i] = tin[(tok + 1) * 72 + ci]; lk[i] = tin[2376 + (tok + 1) * 72 + ci]; lv[i] = tin[2 * 2376 + (tok + 1) * 72 + ci];
                            lrp[i] = tin[tok * 72 + ci]; lkp[i] = tin[2376 + tok * 72 + ci]; lvp[i] = tin[2 * 2376 + tok * 72 + ci];
                            lvf[i] = l > 0 ? V0[(size_t)t * RW + c] : (bf16)0; }
                        __builtin_amdgcn_sched_barrier(0);
#pragma unroll
                        for (int i = 0; i < 4; ++i) { const int e = eb + i; const int tok = (e & 3) + 8 * (e >> 2) + 4 * hh, t = t0 + tok; const size_t o = (size_t)t * RW + c;
                            float r = bf2f(lr[i]), k = bf2f(lk[i]), v = bf2f(lv[i]);
                            r += (bf2f(lrp[i]) - r) * mur; k += (bf2f(lkp[i]) - k) * muk; v += (bf2f(lvp[i]) - v) * muv;
                            const float z = -(w0c + accW[e]); const float sp = fmaxf(z, 0.f) + __logf(1.f + __expf(-fabsf(z)));
                            const float decay = __expf(-__expf(-sp - 0.5f));
                            const float a = __builtin_amdgcn_rcpf(1.f + __expf(-(a0c + accA[e]))); const float g = accG[e];
                            if (l > 0) { const float vfv = bf2f(lvf[i]); v = v + (vfv - v) * __builtin_amdgcn_rcpf(1.f + __expf(-(v0c + accV[e]))); }
                            const float kk = k * kkc; const float k2 = k * (1.f + (a - 1.f) * kac);
                            ssq[e] += kk * kk; bsm[e] += r * k2 * rkc;
                            { const unsigned p0_ = cvtpk(r, k2), p1_ = cvtpk(v, kk), p2_ = cvtpk(kk * a, g), p3_ = cvtpk(v * g, 0.f);
                              Rb[o] = (bf16)p0_; Kb[o] = (bf16)(p0_ >> 16); Vl[o] = (bf16)p1_; KKb[o] = (bf16)(p1_ >> 16); Bb[o] = (bf16)p2_; Gb[o] = (bf16)(p2_ >> 16); BGb[o] = (bf16)p3_; Wd[o] = decay; }
                        }
                    }
                }
#pragma unroll
                for (int e = 0; e < 16; ++e) { const int ln_ = r32 | (hh << 5); float a_ = red16(ssq[e]), b_ = red16(bsm[e]); a_ += shflx(a_, ln_, 16); b_ += shflx(b_, ln_, 16); ssq[e] = a_; bsm[e] = b_; }
                if (r32 == 0) {
#pragma unroll
                    for (int e = 0; e < 16; ++e) { const int tok = (e & 3) + 8 * (e >> 2) + 4 * hh; INVN[(size_t)(t0 + tok) * NH + h] = rsqrtf(fmaxf(ssq[e], 1e-24f)); BSUM[(size_t)(t0 + tok) * NH + h] = bsm[e]; } }
            }
        }
        SEAM(pb + 2);

        if (IN(pb + 3)) { PHASE_IDS
            const bf16* Vl = l == 0 ? V0 : V1;
            const int r32 = lane & 31, hh = lane >> 5;
            if (wave < 6) {
                lbf16* At = (lbf16*)(lds + wave * 23552); lbf16* Bt = At + 2304; lbf16* Kt = Bt + 2304; lbf16* Rt = Kt + 2304; lbf16* Vv = Rt + 2304;
                LAS float* PCs = (LAS float*)(lds + wave * 23552 + 23040);
                for (int item = bx * 6 + wave; item < BATCH * NH * (SEQ / 32); item += G * 6) {
                    const int bh = item >> 7, chunk = item & 127, b = bh >> 3, h = bh & 7; const size_t t0 = (size_t)b * SEQ + chunk * 32;
                    __builtin_amdgcn_wave_barrier(); asm volatile("s_waitcnt lgkmcnt(0)" ::: "memory");
                    {
                      const int tk = lane >> 3, part = lane & 7;
                      u32x4 qr[4], qk[4], qv[4], qkk[4], qb[4]; f32x4 qw0[4], qw1[4]; float qin[4];
#pragma unroll
                      for (int p4 = 0; p4 < 4; ++p4) { const size_t o = (t0 + p4 * 8 + tk) * RW + h * HS + part * 8;
                          qr[p4] = *(const u32x4*)(Rb + o); qk[p4] = *(const u32x4*)(Kb + o); qv[p4] = *(const u32x4*)(Vl + o); qkk[p4] = *(const u32x4*)(KKb + o); qb[p4] = *(const u32x4*)(Bb + o);
                          qw0[p4] = *(const f32x4*)(Wd + o); qw1[p4] = *(const f32x4*)(Wd + o + 4); qin[p4] = INVN[(t0 + p4 * 8 + tk) * NH + h]; }
                      LAS float* Pl = (LAS float*)At;
#pragma unroll
                      for (int p4 = 0; p4 < 4; ++p4) { *(LAS f32x4*)(Pl + (p4 * 8 + tk) * 64 + part * 8) = qw0[p4]; *(LAS f32x4*)(Pl + (p4 * 8 + tk) * 64 + part * 8 + 4) = qw1[p4]; }
                      __builtin_amdgcn_wave_barrier(); asm volatile("s_waitcnt lgkmcnt(0)" ::: "memory");
                      { float P = 1.f;
#pragma unroll 8
                        for (int c = 0; c < 32; ++c) { P *= Pl[c * 64 + lane]; Pl[c * 64 + lane] = P; }
                        PCs[lane] = P; }
                      __builtin_amdgcn_wave_barrier(); asm volatile("s_waitcnt lgkmcnt(0)" ::: "memory");
                      u32x4 oa[4], orr[4], ob_[4], ok_[4];
#pragma unroll
                      for (int p4 = 0; p4 < 4; ++p4) { const int c = p4 * 8 + tk;
                          const f32x4 pa = *(const LAS f32x4*)(Pl + c * 64 + part * 8), pb2 = *(const LAS f32x4*)(Pl + c * 64 + part * 8 + 4);
                          f32x4 ma = {1.f, 1.f, 1.f, 1.f}, mb = ma; if (c > 0) { ma = *(const LAS f32x4*)(Pl + (c - 1) * 64 + part * 8); mb = *(const LAS f32x4*)(Pl + (c - 1) * 64 + part * 8 + 4); }
                          const float Pc[8] = {pa.x, pa.y, pa.z, pa.w, pb2.x, pb2.y, pb2.z, pb2.w}, Pm[8] = {ma.x, ma.y, ma.z, ma.w, mb.x, mb.y, mb.z, mb.w};
                          const unsigned rw_[4] = {qr[p4].x, qr[p4].y, qr[p4].z, qr[p4].w}, kw_[4] = {qk[p4].x, qk[p4].y, qk[p4].z, qk[p4].w}, kkw[4] = {qkk[p4].x, qkk[p4].y, qkk[p4].z, qkk[p4].w}, bw_[4] = {qb[p4].x, qb[p4].y, qb[p4].z, qb[p4].w};
                          unsigned xa[4], xr[4], xb[4], xk[4]; const float inv = qin[p4];
#pragma unroll
                          for (int i = 0; i < 4; ++i) { const float ip0 = __builtin_amdgcn_rcpf(Pc[2 * i]), ip1 = __builtin_amdgcn_rcpf(Pc[2 * i + 1]);
                              xa[i] = pk2(-__uint_as_float(kkw[i] << 16) * inv * Pm[2 * i], -__uint_as_float(kkw[i] & 0xffff0000u) * inv * Pm[2 * i + 1]);
                              xr[i] = pk2(__uint_as_float(rw_[i] << 16) * Pc[2 * i], __uint_as_float(rw_[i] & 0xffff0000u) * Pc[2 * i + 1]);
                              xb[i] = pk2(__uint_as_float(bw_[i] << 16) * inv * ip0, __uint_as_float(bw_[i] & 0xffff0000u) * inv * ip1);
                              xk[i] = pk2(__uint_as_float(kw_[i] << 16) * ip0, __uint_as_float(kw_[i] & 0xffff0000u) * ip1); }
                          oa[p4] = (u32x4){xa[0], xa[1], xa[2], xa[3]}; orr[p4] = (u32x4){xr[0], xr[1], xr[2], xr[3]}; ob_[p4] = (u32x4){xb[0], xb[1], xb[2], xb[3]}; ok_[p4] = (u32x4){xk[0], xk[1], xk[2], xk[3]}; }
                      __builtin_amdgcn_wave_barrier(); asm volatile("s_waitcnt lgkmcnt(0)" ::: "memory");
#pragma unroll
                      for (int p4 = 0; p4 < 4; ++p4) { const int c = p4 * 8 + tk, o = c * 72 + part * 8;
                          *(__attribute__((address_space(3))) u32x4*)(At + o) = oa[p4]; *(__attribute__((address_space(3))) u32x4*)(Rt + o) = orr[p4]; *(__attribute__((address_space(3))) u32x4*)(Bt + o) = ob_[p4];
                          *(__attribute__((address_space(3))) u32x4*)(Kt + o) = ok_[p4]; *(__attribute__((address_space(3))) u32x4*)(Vv + o) = qv[p4]; } }
                    __builtin_amdgcn_wave_barrier(); asm volatile("s_waitcnt lgkmcnt(0)" ::: "memory");
                    const f32x16 zero16 = {0.f, 0.f, 0.f, 0.f, 0.f, 0.f, 0.f, 0.f, 0.f, 0.f, 0.f, 0.f, 0.f, 0.f, 0.f, 0.f};
                    f32x16 X = zero16, Yt = zero16;
#pragma unroll
                    for (int ks = 0; ks < 4; ++ks) { const bf16x8_t fa = ldrow(At, r32, ks, hh), fb = ldrow(Bt, r32, ks, hh); X = mm32(fa, fb, X); Yt = mm32(fb, fa, Yt); }
#pragma unroll
                    for (int e = 0; e < 16; ++e) { const int ri = rowidx(e, hh); X[e] = (r32 < ri) ? X[e] : 0.f; Yt[e] = (ri < r32) ? Yt[e] : 0.f; }
                    f32x16 TY = Yt;
#pragma unroll
                    for (int e = 0; e < 16; ++e) TY[e] += (rowidx(e, hh) == r32) ? 1.f : 0.f;
#pragma unroll 1
                    for (int it = 0; it < 4; ++it) {
                        const bf16x8_t x0 = accop<0>(X), x1 = accop<1>(X), y0 = accop<0>(Yt), y1 = accop<1>(Yt);
                        f32x16 Xn = mm32(y0, x0, zero16); Xn = mm32(y1, x1, Xn);
                        f32x16 Yn = mm32(x0, y0, zero16); Yn = mm32(x1, y1, Yn);
                        X = Xn; Yt = Yn;
                        const bf16x8_t p0 = accop<0>(X), p1 = accop<1>(X), t0_ = accop<0>(TY), t1_ = accop<1>(TY);
                        TY = mm32(p0, t0_, TY); TY = mm32(p1, t1_, TY);
                    }
                    const bf16x8_t ty0 = accop<0>(TY), ty1 = accop<1>(TY);
                    unsigned char* rec = SCN + (size_t)item * 24576;
                    const bf16x8_t v00 = ldpermcol<0>(Vv, r32, hh), v01 = ldpermcol<1>(Vv, r32, hh), v10 = ldpermcol<0>(Vv, 32 + r32, hh), v11 = ldpermcol<1>(Vv, 32 + r32, hh);
                    f32x16 U0a, U0b;
                    { f32x16 G2T = zero16;
#pragma unroll
                      for (int ks = 0; ks < 4; ++ks) G2T = mm32(ldrow(Kt, r32, ks, hh), ldrow(At, r32, ks, hh), G2T);
#pragma unroll
                      for (int e = 0; e < 16; ++e) G2T[e] = (rowidx(e, hh) < r32) ? G2T[e] : 0.f;
                      const bf16x8_t g0 = accop<0>(G2T), g1 = accop<1>(G2T);
                      f32x16 Za = mm32(g0, v00, zero16); Za = mm32(g1, v01, Za); f32x16 Zb = mm32(g0, v10, zero16); Zb = mm32(g1, v11, Zb);
                      U0a = mm32(ty0, accop<0>(Za), zero16); U0a = mm32(ty1, accop<1>(Za), U0a); U0b = mm32(ty0, accop<0>(Zb), zero16); U0b = mm32(ty1, accop<1>(Zb), U0b); }
                    const bf16x8_t ua0 = accop<0>(U0a), ua1 = accop<1>(U0a), ub0 = accop<0>(U0b), ub1 = accop<1>(U0b);
                    f32x16 G3T = zero16;
                    { f32x16 G4T = zero16;
#pragma unroll
                      for (int ks = 0; ks < 4; ++ks) { const bf16x8_t fr = ldrow(Rt, r32, ks, hh); G3T = mm32(ldrow(Bt, r32, ks, hh), fr, G3T); G4T = mm32(ldrow(Kt, r32, ks, hh), fr, G4T); }
#pragma unroll
                      for (int e = 0; e < 16; ++e) { const bool keep = rowidx(e, hh) <= r32; G3T[e] = keep ? G3T[e] : 0.f; G4T[e] = keep ? G4T[e] : 0.f; }
                      const bf16x8_t g30 = accop<0>(G3T), g31 = accop<1>(G3T), g40 = accop<0>(G4T), g41 = accop<1>(G4T);
                      f32x16 Ya = mm32(g30, ua0, zero16); Ya = mm32(g31, ua1, Ya); Ya = mm32(g40, v00, Ya); Ya = mm32(g41, v01, Ya);
                      f32x16 Yb = mm32(g30, ub0, zero16); Yb = mm32(g31, ub1, Yb); Yb = mm32(g40, v10, Yb); Yb = mm32(g41, v11, Yb);
                      u32x4 o0, o1;
                      o0.x = cvtpk(Ya[0], Ya[1]); o0.y = cvtpk(Ya[2], Ya[3]); o0.z = cvtpk(Ya[4], Ya[5]); o0.w = cvtpk(Ya[6], Ya[7]);
                      o1.x = cvtpk(Ya[8], Ya[9]); o1.y = cvtpk(Ya[10], Ya[11]); o1.z = cvtpk(Ya[12], Ya[13]); o1.w = cvtpk(Ya[14], Ya[15]);
                      *(u32x4*)(rec + 12288 + 4096 + lane * 32) = o0; *(u32x4*)(rec + 12288 + 4096 + lane * 32 + 16) = o1;
                      o0.x = cvtpk(Yb[0], Yb[1]); o0.y = cvtpk(Yb[2], Yb[3]); o0.z = cvtpk(Yb[4], Yb[5]); o0.w = cvtpk(Yb[6], Yb[7]);
                      o1.x = cvtpk(Yb[8], Yb[9]); o1.y = cvtpk(Yb[10], Yb[11]); o1.z = cvtpk(Yb[12], Yb[13]); o1.w = cvtpk(Yb[14], Yb[15]);
                      *(u32x4*)(rec + 12288 + 6144 + 4096 + lane * 32) = o0; *(u32x4*)(rec + 12288 + 6144 + 4096 + lane * 32 + 16) = o1; }
                    f32x16 Wa0 = mm32(ty0, ldpermcol<0>(At, r32, hh), zero16); Wa0 = mm32(ty1, ldpermcol<1>(At, r32, hh), Wa0);
                    f32x16 Wa1 = mm32(ty0, ldpermcol<0>(At, 32 + r32, hh), zero16); Wa1 = mm32(ty1, ldpermcol<1>(At, 32 + r32, hh), Wa1);
                    const bf16x8_t wa00 = accop<0>(Wa0), wa01 = accop<1>(Wa0), wa10 = accop<0>(Wa1), wa11 = accop<1>(Wa1);
                    { const bf16x8_t g30 = accop<0>(G3T), g31 = accop<1>(G3T);
                      f32x16 Ra = mm32(wa00, g30, zero16); Ra = mm32(wa01, g31, Ra); f32x16 Rb_ = mm32(wa10, g30, zero16); Rb_ = mm32(wa11, g31, Rb_);
#pragma unroll
                      for (int e = 0; e < 16; ++e) { const int kr = rowidx(e, hh); Ra[e] += bf2f(Rt[r32 * 72 + kr]); Rb_[e] += bf2f(Rt[r32 * 72 + 32 + kr]); }
                      *(bf16x8_t*)(rec + 8192 + 0 * 1024 + lane * 16) = accop<0>(Ra); *(bf16x8_t*)(rec + 8192 + 1 * 1024 + lane * 16) = accop<1>(Ra);
                      *(bf16x8_t*)(rec + 8192 + 2 * 1024 + lane * 16) = accop<0>(Rb_); *(bf16x8_t*)(rec + 8192 + 3 * 1024 + lane * 16) = accop<1>(Rb_); }
                    const bf16x8_t b00 = ldpermcol<0>(Bt, r32, hh), b01 = ldpermcol<1>(Bt, r32, hh), b10 = ldpermcol<0>(Bt, 32 + r32, hh), b11 = ldpermcol<1>(Bt, 32 + r32, hh);
                    { const float pc0 = PCs[r32], pc1 = PCs[32 + r32];
#pragma unroll
                      for (int ij = 0; ij < 4; ++ij) { const int i = ij >> 1, j = ij & 1;
                          f32x16 M = mm32(i ? wa10 : wa00, j ? b10 : b00, zero16); M = mm32(i ? wa11 : wa01, j ? b11 : b01, M);
#pragma unroll
                          for (int e = 0; e < 16; ++e) { float m = M[e]; if (i == j) m += (rowidx(e, hh) == r32) ? 1.f : 0.f; M[e] = m * (j ? pc1 : pc0); }
                          *(bf16x8_t*)(rec + (ij * 2 + 0) * 1024 + lane * 16) = accop<0>(M); *(bf16x8_t*)(rec + (ij * 2 + 1) * 1024 + lane * 16) = accop<1>(M); } }
                    { const bf16x8_t k00 = ldpermcol<0>(Kt, r32, hh), k01 = ldpermcol<1>(Kt, r32, hh), k10 = ldpermcol<0>(Kt, 32 + r32, hh), k11 = ldpermcol<1>(Kt, 32 + r32, hh);
#pragma unroll
                      for (int ju = 0; ju < 4; ++ju) { const int j = ju >> 1, u = ju & 1;
                          f32x16 Dm = mm32(j ? b10 : b00, u ? ub0 : ua0, zero16); Dm = mm32(j ? b11 : b01, u ? ub1 : ua1, Dm);
                          Dm = mm32(j ? k10 : k00, u ? v10 : v00, Dm); Dm = mm32(j ? k11 : k01, u ? v11 : v01, Dm);
#pragma unroll
                          for (int e = 0; e < 16; ++e) Dm[e] *= PCs[32 * j + rowidx(e, hh)];
                          u32x4 o0, o1;
                          o0.x = cvtpk(Dm[0], Dm[1]); o0.y = cvtpk(Dm[2], Dm[3]); o0.z = cvtpk(Dm[4], Dm[5]); o0.w = cvtpk(Dm[6], Dm[7]);
                          o1.x = cvtpk(Dm[8], Dm[9]); o1.y = cvtpk(Dm[10], Dm[11]); o1.z = cvtpk(Dm[12], Dm[13]); o1.w = cvtpk(Dm[14], Dm[15]);
                          *(u32x4*)(rec + 12288 + u * 6144 + j * 2048 + lane * 32) = o0; *(u32x4*)(rec + 12288 + u * 6144 + j * 2048 + lane * 32 + 16) = o1; } }
                }
            }
        }
        { XcdBarrier xb_ = xbar; asm volatile("" : "+s"(xb_.bar)); xcd_barrier<false>(xb_); }
        if (IN(pb + 3)) { PHASE_IDS
            const int r32 = lane & 31, hh = lane >> 5;
            constexpr int SLOT = 18432, NCH = SEQ / 32, NSL = 7, AHEAD = 6;
            const bool spare = G > BATCH * NH * 2; const int cw = spare ? bx - BATCH * NH * 2 : bx, cn = spare ? G - BATCH * NH * 2 : G;
            if (cw >= 0) {
                convert_tables_fp6(INP(27), INP(28), U8, V8, USc, VSc, l, cw * NWAVES + wave, cn * NWAVES, lane);
            {
                constexpr int DST = 520;
                int lane_p; asm volatile("v_mbcnt_lo_u32_b32 %0, -1, 0\n\tv_mbcnt_hi_u32_b32 %0, -1, %0" : "=v"(lane_p)); const int r32 = lane_p & 31, hh = lane_p >> 5, tidp = wave0 * 64 + lane_p;
                lbf16* dlb = (lbf16*)lds;
                lbf16* pin = (lbf16*)(lds + 33280);
                const int c = tidp, g = c >> 7, win = 2 << g;
                const bf16* pwt = PWT + (size_t)(l * 4 + (wave >> 1)) * PG * PG; const float* psc = INP(22) + l * PW;
                for (int tile = cw; tile < T / 32; tile += cn) {
                    const int t0 = tile * 32; const bool first = (t0 % SEQ) == 0;
                    __syncthreads();
                    { u32x4 pq[6];
#pragma unroll
                      for (int q = 0; q < 6; ++q) { const int ch = tidp + q * NTHR, row = ch >> 6, cc = ch & 63; pq[q] = (u32x4){0u, 0u, 0u, 0u};
                          if (ch < 47 * 64 && (row >= 15 || !first)) pq[q] = *(const u32x4*)(POOLIN + (size_t)(t0 - 15 + row) * PW + cc * 8); }
#pragma unroll
                      for (int q = 0; q < 6; ++q) { const int ch = tidp + q * NTHR, row = ch >> 6, cc = ch & 63; if (ch < 47 * 64) *(__attribute__((address_space(3))) u32x4*)(pin + row * 520 + cc * 8) = pq[q]; } }
                    __syncthreads();
                    const lbf16* pc = pin + c;
                    float sw = 0.f;
#pragma unroll
                    for (int j = 1; j <= 15; ++j) sw += (j < win) ? bf2f(pc[(15 - j) * 520]) : 0.f;
                    const float invw = 1.f / (float)win;
#pragma unroll 8
                    for (int i = 0; i < 32; ++i) {
                        const float cur = bf2f(pc[(15 + i) * 520]);
                        sw += cur;
                        const float inv = (first && i < 15) ? 1.f / (float)min(i + 1, win) : invw;
                        dlb[i * DST + c] = f2bf(sw * inv - cur);
                        sw -= bf2f(pc[(15 + i - win + 1) * 520]);
                    }
                    __syncthreads();
                    const int gg = wave >> 1, half = wave & 1;
#pragma unroll
                    for (int ct = 0; ct < 2; ++ct) {
                        const int dd0 = half * 64 + ct * 32;
                        f32x16 acc;
#pragma unroll
                        for (int e = 0; e < 16; ++e) acc[e] = 0.f;
#pragma unroll
                        for (int ks = 0; ks < 8; ++ks) { const bf16x8_t a = *(const __attribute__((address_space(3))) bf16x8_t*)(dlb + r32 * DST + gg * PG + ks * 16 + 8 * hh);
                            const bf16x8_t w = *(const bf16x8_t*)(pwt + (size_t)(dd0 + r32) * PG + ks * 16 + 8 * hh); acc = mm32(a, w, acc); }
                        const int oc = gg * PG + dd0 + r32; const float ps = psc[oc];
#pragma unroll
                        for (int e = 0; e < 16; ++e) MIX[(size_t)(t0 + rowidx(e, hh)) * D + RW + oc] = f2bf(acc[e] * ps);
                    }
                }
            }
            }
            for (int un = bx; un < BATCH * NH * 2; un += G) {
                const int bh = un >> 1, u = un & 1, b = bh >> 3, h = bh & 7;
                __syncthreads();
                const unsigned char* recs = SCN + (size_t)bh * NCH * 24576;
                const int lw = wave - 2;
#define S2_DMA(chunk_) do { if (wave >= 2) { LAS unsigned char* sl = lds + ((chunk_) % NSL) * SLOT; const unsigned char* rp = recs + (size_t)(chunk_) * 24576 + lane * 16; \
                    _Pragma("unroll") for (int q_ = 0; q_ < 3; ++q_) { const int p_ = lw * 3 + q_; const int so_ = p_ < 12 ? p_ * 1024 : 12288 + u * 6144 + (p_ - 12) * 1024; \
                        __builtin_amdgcn_global_load_lds((const unsigned*)(rp + so_), (LAS unsigned*)(sl + p_ * 1024), 16, 0, 0); } } } while (0)
#pragma unroll 1
                for (int c0 = 0; c0 < AHEAD; ++c0) S2_DMA(c0);
                asm volatile("s_waitcnt vmcnt(15)" ::: "memory");
                __builtin_amdgcn_s_barrier();
                f32x16 X0, X1;
                { float z_ = 0.f; asm volatile("" : "+v"(z_));
#pragma unroll
                for (int e = 0; e < 16; ++e) { X0[e] = z_; X1[e] = z_; } }
#define S2_FRAG(off) (*(const __attribute__((address_space(3))) bf16x8_t*)(sl + (off) + lane * 16))
#define S2_UNPK(dst, off) do { const u32x4 a0 = *(const LAS u32x4*)(sl + (off) + lane * 32), a1 = *(const LAS u32x4*)(sl + (off) + lane * 32 + 16); const unsigned wv[8] = {a0.x, a0.y, a0.z, a0.w, a1.x, a1.y, a1.z, a1.w}; \
                    _Pragma("unroll") for (int q = 0; q < 8; ++q) { (dst)[2 * q] = __uint_as_float(wv[q] << 16); (dst)[2 * q + 1] = __uint_as_float(wv[q] & 0xffff0000u); } } while (0)
#pragma unroll 1
                for (int n = 0; n < NCH; ++n) {
                    if (n + AHEAD < NCH) S2_DMA(n + AHEAD);
                    if (wave == 0) {
                        const LAS unsigned char* sl = lds + (n % NSL) * SLOT;
                        const bf16x8_t x00 = accop<0>(X0), x01 = accop<1>(X0), x10 = accop<0>(X1), x11 = accop<1>(X1);
                        f32x16 Yc, N0, N1;
                        S2_UNPK(Yc, 12288 + 4096); S2_UNPK(N0, 12288); S2_UNPK(N1, 12288 + 2048);
                        Yc = mm32(S2_FRAG(8192 + 0 * 1024), x00, Yc); Yc = mm32(S2_FRAG(8192 + 1 * 1024), x01, Yc); Yc = mm32(S2_FRAG(8192 + 2 * 1024), x10, Yc); Yc = mm32(S2_FRAG(8192 + 3 * 1024), x11, Yc);
                        N0 = mm32(S2_FRAG((0 * 2 + 0) * 1024), x00, N0); N0 = mm32(S2_FRAG((0 * 2 + 1) * 1024), x01, N0); N0 = mm32(S2_FRAG((2 * 2 + 0) * 1024), x10, N0); N0 = mm32(S2_FRAG((2 * 2 + 1) * 1024), x11, N0);
                        N1 = mm32(S2_FRAG((1 * 2 + 0) * 1024), x00, N1); N1 = mm32(S2_FRAG((1 * 2 + 1) * 1024), x01, N1); N1 = mm32(S2_FRAG((3 * 2 + 0) * 1024), x10, N1); N1 = mm32(S2_FRAG((3 * 2 + 1) * 1024), x11, N1);
                        X0 = N0; X1 = N1;
                        float* yp = Y + ((size_t)b * SEQ + (size_t)n * 32) * RW + h * HS + u * 32 + r32;
#pragma unroll
                        for (int e = 0; e < 16; ++e) yp[(size_t)rowidx(e, hh) * RW] = Yc[e];
                        asm volatile("s_waitcnt lgkmcnt(0)" ::: "memory");
                    } else if (wave >= 2) {
                        const int younger = (NCH - 1 - (n + 1)) < (AHEAD - 1) ? (NCH - 1 - (n + 1)) : (AHEAD - 1);
                        if (younger >= 5) asm volatile("s_waitcnt vmcnt(15)" ::: "memory"); else if (younger == 4) asm volatile("s_waitcnt vmcnt(12)" ::: "memory"); else if (younger == 3) asm volatile("s_waitcnt vmcnt(9)" ::: "memory");
                        else if (younger == 2) asm volatile("s_waitcnt vmcnt(6)" ::: "memory"); else if (younger == 1) asm volatile("s_waitcnt vmcnt(3)" ::: "memory"); else asm volatile("s_waitcnt vmcnt(0)" ::: "memory");
                    }
                    __builtin_amdgcn_s_barrier();
                }
#undef S2_FRAG
#undef S2_UNPK
#undef S2_DMA
            }
        }
        SEAM(pb + 3);

        if (IN(pb + 4)) { PHASE_IDS
            const int c8 = (tid & 63) * 8, hd = (tid & 63) >> 3, tsub = tid >> 6;
            const f32x4 lg0 = *(const f32x4*)(INP(19) + l * RW + c8), lg1 = *(const f32x4*)(INP(19) + l * RW + c8 + 4), lb0 = *(const f32x4*)(INP(20) + l * RW + c8), lb1 = *(const f32x4*)(INP(20) + l * RW + c8 + 4);
            for (int tile = bx; tile < T / 8; tile += G) {
                const int t = tile * 8 + tsub; const size_t o = (size_t)t * RW + c8;
                const f32x4 y0 = *(const f32x4*)(Y + o), y1 = *(const f32x4*)(Y + o + 4); const u32x4 gq = *(const u32x4*)(Gb + o), vq = *(const u32x4*)(BGb + o); const float bsum = BSUM[(size_t)t * NH + hd];
                float sm = (y0.x + y0.y) + (y0.z + y0.w) + (y1.x + y1.y) + (y1.z + y1.w);
                sm += dppf<0xB1>(sm); sm += dppf<0x4E>(sm); sm += dppf<0x141>(sm);
                const float mean = sm * (1.f / 64.f);
                const f32x4 d0 = y0 - mean, d1 = y1 - mean;
                float sq = (d0.x * d0.x + d0.y * d0.y) + (d0.z * d0.z + d0.w * d0.w) + (d1.x * d1.x + d1.y * d1.y) + (d1.z * d1.z + d1.w * d1.w);
                sq += dppf<0xB1>(sq); sq += dppf<0x4E>(sq); sq += dppf<0x141>(sq);
                const float rs = rsqrtf(sq * (1.f / 64.f) + GN_EPS);
                const f32x4 n0 = d0 * rs * lg0 + lb0, n1 = d1 * rs * lg1 + lb1;
                const unsigned gw_[4] = {gq.x, gq.y, gq.z, gq.w}, vw_[4] = {vq.x, vq.y, vq.z, vq.w}; const float nn[8] = {n0.x, n0.y, n0.z, n0.w, n1.x, n1.y, n1.z, n1.w}; unsigned ow[4];
#pragma unroll
                for (int i = 0; i < 4; ++i) { const float g0 = __uint_as_float(gw_[i] << 16), g1 = __uint_as_float(gw_[i] & 0xffff0000u), v0 = __uint_as_float(vw_[i] << 16), v1 = __uint_as_float(vw_[i] & 0xffff0000u);
                    ow[i] = pk2(nn[2 * i] * g0 + v0 * bsum, nn[2 * i + 1] * g1 + v1 * bsum); }
                *(u32x4*)(MIX + (size_t)t * D + c8) = (u32x4){ow[0], ow[1], ow[2], ow[3]};
            }
        }
        SEAM(pb + 4);
        if (IN(pb + 5)) { PHASE_IDS
            pg8::Gemm g{MIX, WoutT + (size_t)l * D * D, T, D, D}; pg8::StaticOrder S; S.init(T, D, G, bx);
            pg8::EpiResGate E{xin, X, modl + 2 * D};
            pg8::gemm_phase<pg8::EpiResGate, pg8::StaticOrder, true, true>(lds, g, S, E, tid); }
        SEAM(pb + 5);
        if (IN(pb + 6)) { PHASE_IDS const float* gamma = INP(24) + l * D;
            for (int row = gw; row < T; row += NGW) { const int b = row / SEQ; norm_mod_row(X + (size_t)row * D, gamma, modl + (size_t)b * 6 * D + 3 * D, modl + (size_t)b * 6 * D + 4 * D, H + (size_t)row * D, lane); } }
        SEAM(pb + 6);
        if (IN(pb + 7)) { PHASE_IDS
            pg8::Gemm g{H, PqT + (size_t)l * PH * PQ * D, T, PH * PQ, D}; pg8::StaticOrder S; S.init(T, PH * PQ, G, bx);
            pg8::EpiBf16<0> E{Q, PH * PQ, nullptr, 0, 0, 1.f};
            pg8::gemm_phase<pg8::EpiBf16<0>, pg8::StaticOrder, true, true>(lds, g, S, E, tid); }
        SEAM(pb + 7);

        if (IN(pb + 8)) { PHASE_IDS
            const bf16* KEYSl = KEYS + (size_t)l * PH * 2 * NKEYS * PHALF;
            LAS unsigned char* scr = lds + wave * 2048 + lane * 32;
            constexpr int KST = 136;
            lbf16* kl = (lbf16*)(lds + 16384);
            const int r = lane & 31, hh = lane >> 5;
            for (int item = bx; item < (T / 256) * PH; item += G) {
                const int h = item & 7, tok = (item >> 3) * 256 + wave * 32 + r;
                __syncthreads();
                { u32x4 kq[8];
#pragma unroll
                  for (int q = 0; q < 8; ++q) { const int ch = tid + q * NTHR; kq[q] = *(const u32x4*)(KEYSl + (size_t)(h * 2) * NKEYS * PHALF + (size_t)ch * 8); }
#pragma unroll
                  for (int q = 0; q < 8; ++q) { const int ch = tid + q * NTHR, row = ch >> 4, cc = ch & 15; *(__attribute__((address_space(3))) u32x4*)(kl + row * KST + cc * 8) = kq[q]; } }
                __syncthreads();
                unsigned sp0[16], sp1[16];
#pragma unroll
                for (int e = 0; e < 16; ++e) { sp0[e] = 0u; sp1[e] = 0u; }
#pragma unroll 1
                for (int p = 0; p < 2; ++p) {
                    const bf16* qp = Q + (size_t)tok * (PH * PQ) + h * PQ + p * PHALF + 8 * hh;
                    const lbf16* kp_ = kl + (p * NKEYS + r) * KST + 8 * hh;
                    bf16x8_t bq[8];
#pragma unroll
                    for (int ks = 0; ks < 8; ++ks) bq[ks] = *(const bf16x8_t*)(qp + ks * 16);
                    unsigned best[16];
#pragma unroll
                    for (int e = 0; e < 16; ++e) best[e] = 0u;
#pragma unroll 1
                    for (int kt = 0; kt < 4; ++kt) {
                        f32x16 acc;
#pragma unroll
                        for (int e = 0; e < 16; ++e) acc[e] = 0.f;
#pragma unroll
                        for (int ks = 0; ks < 8; ++ks) { const bf16x8_t ak = *(const __attribute__((address_space(3))) bf16x8_t*)(kp_ + kt * 32 * KST + ks * 16); acc = __builtin_amdgcn_mfma_f32_32x32x16_bf16(ak, bq[ks], acc, 0, 0, 0); }
                        unsigned g[16];
#pragma unroll
                        for (int e = 0; e < 16; ++e) g[e] = pack_key7(acc[e], kt * 32 + (e & 3) + 8 * (e >> 2) + 4 * hh);
                        sort16_desc(g);
                        merge_top16(best, g);
                    }
                    unsigned ob[16];
#pragma unroll
                    for (int e = 0; e < 16; ++e) ob[e] = shflxu(best[e], lane, 32);
                    merge_top16(best, ob);
#pragma unroll
                    for (int e = 0; e < 16; ++e) { sp0[e] = p == 0 ? best[e] : sp0[e]; sp1[e] = p == 0 ? sp1[e] : best[e]; }
                }
                unsigned c2[32];
                stage2_cands(sp0, sp1, hh, c2);
                sort16_desc(c2); sort16_desc(c2 + 16); merge_top16(c2, c2 + 16);
                { unsigned ob[16];
#pragma unroll
                  for (int e = 0; e < 16; ++e) ob[e] = shflxu(c2[e], lane, 32);
                  merge_top16(c2, ob); }
#pragma unroll
                for (int e = 0; e < 16; e += 4) {
                    *(LAS unsigned*)(scr + e) = (127u - (sp0[e] & 127u)) | ((127u - (sp0[e + 1] & 127u)) << 8) | ((127u - (sp0[e + 2] & 127u)) << 16) | ((127u - (sp0[e + 3] & 127u)) << 24);
                    *(LAS unsigned*)(scr + 16 + e) = (127u - (sp1[e] & 127u)) | ((127u - (sp1[e + 1] & 127u)) << 8) | ((127u - (sp1[e + 2] & 127u)) << 16) | ((127u - (sp1[e + 3] & 127u)) << 24); }
                asm volatile("s_waitcnt lgkmcnt(0)" ::: "memory");
                float sm[16]; int ex[16];
#pragma unroll
                for (int e = 0; e < 16; ++e) { const unsigned key = c2[e]; sm[e] = unpack_key8(key); const int i0 = (key >> 4) & 15, j0 = key & 15; ex[e] = (int)scr[i0] * NKEYS + (int)scr[16 + j0]; }
                float den = 0.f;
#pragma unroll
                for (int e = 0; e < 16; ++e) { sm[e] = expf(sm[e] - unpack_key8(c2[0])); den += sm[e]; }
                const float inv = 1.f / den;
                if (hh == 0) {
                    int* ip = IDX + (size_t)tok * NE + h * TOPK; float* gp = GATE + (size_t)tok * NE + h * TOPK;
#pragma unroll
                    for (int e = 0; e < 16; e += 4) { *(int4*)(ip + e) = make_int4(ex[e], ex[e + 1], ex[e + 2], ex[e + 3]); *(f32x4*)(gp + e) = (f32x4){sm[e] * inv, sm[e + 1] * inv, sm[e + 2] * inv, sm[e + 3] * inv}; }
                }
                asm volatile("s_waitcnt lgkmcnt(0)" ::: "memory");
            }
        }
        SEAM(pb + 8);

        if (IN(pb + 9)) { PHASE_IDS
            const unsigned char* Ul = U8 + (size_t)l * NEXP * ROWB; const unsigned char* Vtl = V8 + (size_t)l * NEXP * ROWB; const float* usl = USc + l * NEXP; const float* vsl = VSc + l * NEXP; const float* lnf = INP(29);
            const bool fin = (l == DEPTH - 1);
            typedef float f32x2_t __attribute__((ext_vector_type(2)));
            const __amdgpu_buffer_rsrc_t ru = __builtin_amdgcn_make_buffer_rsrc((void*)Ul, 0, NEXP * ROWB, 0x00020000), rv = __builtin_amdgcn_make_buffer_rsrc((void*)Vtl, 0, NEXP * ROWB, 0x00020000);
            typedef float f32x32_t __attribute__((ext_vector_type(32))); typedef unsigned u32x3_t __attribute__((ext_vector_type(3))); typedef unsigned u32x6_t __attribute__((ext_vector_type(6))); typedef unsigned u32x16_t __attribute__((ext_vector_type(16))); typedef __bf16 bf16x2_t __attribute__((ext_vector_type(2)));
            LAS float* pl = (LAS float*)(lds + wave * 18432);
            constexpr int TW = 4;
            for (int tb = gw; tb < T; tb += TW * NGW) {
#define TOKV(k) (tb + (k) * NGW < T)
#define TOK(k) (TOKV(k) ? tb + (k) * NGW : tb)
                unsigned si[TW][2]; float sus[TW][2], sgv[TW][2];
                LAS u32x4* hl = (LAS u32x4*)(pl + 32 * 68);
                { float g0[TW], g1[TW]; int lane_s; asm volatile("v_mbcnt_lo_u32_b32 %0, -1, 0\n\tv_mbcnt_hi_u32_b32 %0, -1, %0" : "=v"(lane_s));
#pragma unroll
                  for (int k = 0; k < TW; ++k) { const size_t o = (size_t)TOK(k) * NE + lane_s; si[k][0] = ((unsigned)IDX[o] << 7) | (unsigned)lane_s; si[k][1] = ((unsigned)IDX[o + 64] << 7) | (unsigned)(64 + lane_s); g0[k] = GATE[o]; g1[k] = GATE[o + 64]; }
#pragma unroll
                  for (int kk = 2; kk <= 128; kk <<= 1) {
#pragma unroll
                      for (int j = kk >> 1; j > 0; j >>= 1) {
                          if (j == 64) {
#pragma unroll
                              for (int k = 0; k < TW; ++k) { const unsigned a = si[k][0], b = si[k][1]; si[k][0] = a < b ? a : b; si[k][1] = a < b ? b : a; } }
                          else { const bool lower = (lane_s & j) == 0, tm0 = lower == ((lane_s & kk) == 0), tm1 = lower == (((lane_s + 64) & kk) == 0); const int pa = (lane_s ^ j) << 2;
#pragma unroll
                              for (int k = 0; k < TW; ++k) { const unsigned a = si[k][0], b = si[k][1], p0 = (unsigned)__builtin_amdgcn_ds_bpermute(pa, (int)a), p1 = (unsigned)__builtin_amdgcn_ds_bpermute(pa, (int)b);
                                  si[k][0] = tm0 ? (a < p0 ? a : p0) : (a < p0 ? p0 : a); si[k][1] = tm1 ? (b < p1 ? b : p1) : (b < p1 ? p1 : b); } }
                          __builtin_amdgcn_sched_barrier(0);
                      } }
#pragma unroll
                  for (int k = 0; k < TW; ++k) {
#pragma unroll
                      for (int r = 0; r < 2; ++r) { const unsigned key = si[k][r]; const int a = (int)(key & 63u) << 2; const int ga = __builtin_amdgcn_ds_bpermute(a, __float_as_int(g0[k])), gb = __builtin_amdgcn_ds_bpermute(a, __float_as_int(g1[k]));
                          const unsigned ix = key >> 7; si[k][r] = ix; sus[k][r] = usl[ix]; sgv[k][r] = __int_as_float((key & 64u) ? gb : ga) * vsl[ix]; } }
#pragma unroll
                  for (int k = 0; k < TW; ++k) { const bf16* hr = H + (size_t)TOK(k) * D + lane_s * 16; hl[(k * 2) * 64 + lane_s] = *(const u32x4*)hr; hl[(k * 2 + 1) * 64 + lane_s] = *(const u32x4*)(hr + 8); }
                }
                __builtin_amdgcn_sched_barrier(0);
#define ROWLD(dst, rs, ixv, ln) dst = __builtin_amdgcn_raw_buffer_load_b96(rs, voff, __builtin_amdgcn_readlane((int)(ixv), (ln)) * ROWB, 0)
#define LOADQ(buf, rs, ixv, ln0) do { _Pragma("unroll") for (int j_ = 0; j_ < 8; ++j_) ROWLD((buf)[j_], rs, ixv, (ln0) + j_); __builtin_amdgcn_sched_barrier(0); } while (0)
#define CVT2(a, b) const f32x32_t f_ = __builtin_amdgcn_cvt_scalef32_pk32_f32_fp6((u32x6_t){(a).x, (a).y, (a).z, (b).x, (b).y, (b).z}, 1.0f)
#define PR(i) __builtin_shufflevector(f_, f_, 2 * (i), 2 * (i) + 1)
#define DOTQ(buf, e0) do { _Pragma("unroll") for (int j_ = 0; j_ < 8; j_ += 2) { \
                        const u32x16_t g_ = __builtin_bit_cast(u32x16_t, __builtin_amdgcn_cvt_scalef32_pk32_bf16_fp6((u32x6_t){(buf)[j_].x, (buf)[j_].y, (buf)[j_].z, (buf)[j_ + 1].x, (buf)[j_ + 1].y, (buf)[j_ + 1].z}, 1.0f));     \
                        float a0_ = 0.f, a1_ = 0.f, b0_ = 0.f, b1_ = 0.f; \
                        _Pragma("unroll") for (int i_ = 0; i_ < 8; i_ += 2) { a0_ = DOT2(g_[i_], hpk[i_], a0_); b0_ = DOT2(g_[8 + i_], hpk[i_], b0_); a1_ = DOT2(g_[i_ + 1], hpk[i_ + 1], a1_); b1_ = DOT2(g_[9 + i_], hpk[i_ + 1], b1_); } \
                        pl[((e0) + j_) * 68 + lane_u] = a0_ + a1_; pl[((e0) + j_ + 1) * 68 + lane_u] = b0_ + b1_; __builtin_amdgcn_sched_barrier(0); } } while (0)
#define DOT2(x_, y_, c_) __builtin_amdgcn_fdot2_f32_bf16(__builtin_bit_cast(bf16x2_t, (unsigned)(x_)), __builtin_bit_cast(bf16x2_t, (unsigned)(y_)), (c_), false)
#define AXPYQ(buf, k, cfv, ln0) do { _Pragma("unroll") for (int j_ = 0; j_ < 8; j_ += 2) { CVT2((buf)[j_], (buf)[j_ + 1]); \
                        const float ca = __int_as_float(__builtin_amdgcn_readlane(__float_as_int(cfv), (ln0) + j_)), cb = __int_as_float(__builtin_amdgcn_readlane(__float_as_int(cfv), (ln0) + j_ + 1)); \
                        acc2[k][0] += ca * PR(0); acc2[k][1] += ca * PR(1); acc2[k][2] += ca * PR(2); acc2[k][3] += ca * PR(3); acc2[k][4] += ca * PR(4); acc2[k][5] += ca * PR(5); acc2[k][6] += ca * PR(6); acc2[k][7] += ca * PR(7); \
                        acc2[k][0] += cb * PR(8); acc2[k][1] += cb * PR(9); acc2[k][2] += cb * PR(10); acc2[k][3] += cb * PR(11); acc2[k][4] += cb * PR(12); acc2[k][5] += cb * PR(13); acc2[k][6] += cb * PR(14); acc2[k][7] += cb * PR(15); __builtin_amdgcn_sched_barrier(0); } } while (0)
                u32x3_t ba[8], bb_[8];
                int lane_u; asm volatile("v_mbcnt_lo_u32_b32 %0, -1, 0\n\tv_mbcnt_hi_u32_b32 %0, -1, %0" : "=v"(lane_u)); const int voff = lane_u * 12;
                LOADQ(ba, ru, si[0][0], 0);
#pragma unroll 1
                for (int c = 0; c < 16; ++c) {
                    const int lb = (c & 7) * 8; const bool r1 = c >= 8;
#pragma unroll
                    for (int k = 0; k < TW; ++k) {
                        unsigned hpk[8];
                        { const u32x4 h0 = hl[(k * 2) * 64 + lane_u], h1 = hl[(k * 2 + 1) * 64 + lane_u]; hpk[0] = h0.x; hpk[1] = h0.y; hpk[2] = h0.z; hpk[3] = h0.w; hpk[4] = h1.x; hpk[5] = h1.y; hpk[6] = h1.z; hpk[7] = h1.w; }
                        if (k & 1) { if (k < TW - 1) LOADQ(ba, ru, r1 ? si[k + 1][1] : si[k + 1][0], lb); else { const int cn = (c + 1) & 15; const __amdgpu_buffer_rsrc_t rn = c < 15 ? ru : rv; LOADQ(ba, rn, (cn >= 8) ? si[0][1] : si[0][0], (cn & 7) * 8); } DOTQ(bb_, k * 8); }
                        else { LOADQ(bb_, ru, r1 ? si[k + 1][1] : si[k + 1][0], lb); DOTQ(ba, k * 8); }
                    }
                    __builtin_amdgcn_wave_barrier(); asm volatile("s_waitcnt lgkmcnt(0)" ::: "memory");
                    float dsum;
                    { const LAS float* rp = pl + (lane_u & 31) * 68 + (lane_u >> 5) * 32; f32x4 s4 = *(const LAS f32x4*)rp;
#pragma unroll
                      for (int j = 1; j < 8; ++j) s4 += *(const LAS f32x4*)(rp + j * 4);
                      dsum = (s4.x + s4.y) + (s4.z + s4.w); }
                    dsum += shflx(dsum, lane_u, 32);
                    __builtin_amdgcn_wave_barrier(); asm volatile("s_waitcnt lgkmcnt(0)" ::: "memory");
                    const bool home = (lane_u >> 3) == (c & 7);
#pragma unroll
                    for (int k = 0; k < TW; ++k) {
                        const float dv = __int_as_float(__builtin_amdgcn_ds_bpermute((k * 8 + (lane_u & 7)) << 2, __float_as_int(dsum)));
                        const float cf = (r1 ? sgv[k][1] : sgv[k][0]) * gelu_erf(dv * (r1 ? sus[k][1] : sus[k][0]));
                        if (r1) sgv[k][1] = home ? cf : sgv[k][1]; else sgv[k][0] = home ? cf : sgv[k][0]; }
                    __builtin_amdgcn_sched_barrier(0);
                }
                f32x2_t acc2[TW][8];
#pragma unroll
                for (int k = 0; k < TW; ++k) {
#pragma unroll
                    for (int i = 0; i < 8; ++i) acc2[k][i] = (f32x2_t){0.f, 0.f}; }
#pragma unroll 1
                for (int c = 0; c < 16; ++c) {
                    const int lb = (c & 7) * 8; const bool r1 = c >= 8;
#pragma unroll
                    for (int k = 0; k < TW; ++k) {
                        const float cfk = r1 ? sgv[k][1] : sgv[k][0];
                        if (k & 1) { if (k < TW - 1) LOADQ(ba, rv, r1 ? si[k + 1][1] : si[k + 1][0], lb); else { const int cn = (c + 1) & 15; LOADQ(ba, rv, (cn >= 8) ? si[0][1] : si[0][0], (cn & 7) * 8); }     AXPYQ(bb_, k, cfk, lb); }
                        else { LOADQ(bb_, rv, r1 ? si[k + 1][1] : si[k + 1][0], lb); AXPYQ(ba, k, cfk, lb); }
                    }
                }
#undef ROWLD
#undef LOADQ
#undef CVT2
#undef PR
#undef DOTQ
#undef DOT2
#undef AXPYQ
                { int ln; asm volatile("v_mbcnt_lo_u32_b32 %0, -1, 0\n\tv_mbcnt_hi_u32_b32 %0, -1, %0" : "=v"(ln));
                  LAS f32x4* al = (LAS f32x4*)pl + ln;
#pragma unroll
                  for (int k = 0; k < TW; ++k) {
#pragma unroll
                      for (int q = 0; q < 4; ++q) al[(k * 4 + q) * 64] = (f32x4){acc2[k][q * 2].x, acc2[k][q * 2].y, acc2[k][q * 2 + 1].x, acc2[k][q * 2 + 1].y}; }
                  asm volatile("s_waitcnt lgkmcnt(0)" ::: "memory"); __builtin_amdgcn_sched_barrier(0);
                  f32x4 xn[4];
#pragma unroll
                  for (int q = 0; q < 4; ++q) xn[q] = *(const f32x4*)(X + (size_t)tb * D + ln * 16 + q * 4);
#pragma unroll 1
                  for (int k = 0; k < TW; ++k) { const int t = tb + k * NGW; if (t >= T) break; const int b = t / SEQ;
                    float* xr = X + (size_t)t * D + ln * 16; const float* g2 = modl + (size_t)b * 6 * D + 5 * D + ln * 16;
                    f32x4 xv[4]; float ss = 0.f;
#pragma unroll
                    for (int q = 0; q < 4; ++q) xv[q] = xn[q];
                    { const float* xnp = X + (size_t)((k + 1 < TW && t + NGW < T) ? t + NGW : t) * D + ln * 16;
#pragma unroll
                      for (int q = 0; q < 4; ++q) xn[q] = *(const f32x4*)(xnp + q * 4); }
                    __builtin_amdgcn_sched_barrier(0);
#pragma unroll
                    for (int q = 0; q < 4; ++q) { const f32x4 xo = xv[q], gg = *(const f32x4*)(g2 + q * 4);
                        xv[q] = xo + gg * al[(k * 4 + q) * 64]; ss += (xv[q].x * xv[q].x + xv[q].y * xv[q].y) + (xv[q].z * xv[q].z + xv[q].w * xv[q].w); }
                    const float rs = rsqrtf(wave_sum(ss, ln) * (1.f / D) + NORM_EPS);
                    if (fin) {
#pragma unroll
                        for (int q = 0; q < 4; ++q) *(f32x4*)(xr + q * 4) = xv[q] * rs * *(const f32x4*)(lnf + ln * 16 + q * 4); }
                    else {
                        const float* gam = INP(4) + (l + 1) * D + ln * 16; const float* mn = MOD + (size_t)(l + 1) * BATCH * 6 * D + (size_t)b * 6 * D + ln * 16; u32x4 ho[2];
#pragma unroll
                        for (int q = 0; q < 4; ++q) { *(f32x4*)(xr + q * 4) = xv[q];
                            const f32x4 y = xv[q] * rs * *(const f32x4*)(gam + q * 4) * (*(const f32x4*)(mn + D + q * 4) + 1.f) + *(const f32x4*)(mn + q * 4);
                            if (q & 1) { ho[q >> 1].z = pk2(y.x, y.y); ho[q >> 1].w = pk2(y.z, y.w); } else { ho[q >> 1].x = pk2(y.x, y.y); ho[q >> 1].y = pk2(y.z, y.w); } }
                        *(u32x4*)(H + (size_t)t * D + ln * 16) = ho[0]; *(u32x4*)(H + (size_t)t * D + ln * 16 + 8) = ho[1]; }
                  }
                  asm volatile("s_waitcnt lgkmcnt(0)" ::: "memory"); __builtin_amdgcn_wave_barrier();
                }
#undef TOK
#undef TOKV
            }
        }
    }
#undef modl
#undef xin
#undef IN
#undef SEAM
}
#undef MOD
#undef H
#undef PROJ
#undef Q
#undef MIX
#undef Rb
#undef Kb
#undef V0
#undef V1
#undef KKb
#undef Bb
#undef Gb
#undef BGb
#undef Wd
#undef Y
#undef IDX
#undef GATE
#undef WinT
#undef WoutT
#undef PqT
#undef KEYS
#undef QB
#undef POOLIN
#undef SH
#undef WUPT
#undef AUPT
#undef GUPT
#undef VUPT
#undef PWT
#undef INVN
#undef BSUM
#undef SCN
#undef U8
#undef V8
#undef USc
#undef VSc
#undef INP
#undef PHASE_IDS

extern "C" void kernel_launch(void* const* d_in, const int* in_sizes, int n_in, void* d_out, int out_size, void* d_ws, size_t ws_size, hipStream_t stream) {
    if (n_in != 30 || ws_size < WS_END) { fprintf(stderr, "kernel_launch: unexpected n_in %d / ws_size %zu\n", n_in, ws_size); return; }
    static int grid = 0;
    if (grid == 0) {
        int dev = 0, cus = 0, per_cu = 0;
        (void)hipGetDevice(&dev); (void)hipDeviceGetAttribute(&cus, hipDeviceAttributeMultiprocessorCount, dev);
        if (hipFuncSetAttribute((const void*)mega, hipFuncAttributeMaxDynamicSharedMemorySize, LDS_BYTES) != hipSuccess) { fprintf(stderr, "hipFuncSetAttribute failed\n"); grid = -1; return; }
        if (hipOccupancyMaxActiveBlocksPerMultiprocessor(&per_cu, (const void*)mega, NTHR, LDS_BYTES) != hipSuccess || per_cu < 1) { fprintf(stderr, "occupancy query failed (%d)\n", per_cu); per_cu = 1; }
        (void)hipGetLastError();
        grid = (cus > 0 ? cus : 256) * 1;
    }
    if (grid < 0) return;
    Args a{}; for (int i = 0; i < 30; ++i) a.in[i] = (const float*)d_in[i]; a.out = (float*)d_out; a.ws = (unsigned char*)d_ws;
    a.ph_lo = 0; a.ph_hi = NPH;
    if (hipMemsetAsync(d_ws, 0, 65536, stream) != hipSuccess) { fprintf(stderr, "memset failed\n"); return; }
    void* kargs[] = {&a};
    hipError_t e = hipLaunchCooperativeKernel((const void*)mega, dim3(grid), dim3(NTHR), kargs, LDS_BYTES, stream);
    if (e != hipSuccess) fprintf(stderr, "cooperative launch failed: %s (grid %d)\n", hipGetErrorString(e), grid);
}
```

```cpp
#include <hip/hip_runtime.h>
#include <hip/hip_cooperative_groups.h>
namespace cg = cooperative_groups;
#include <cstdio>
#include <cstdint>
#include <cmath>

constexpr int D = 1024, BATCH = 4, SEQ = 4096, T = BATCH * SEQ, DEPTH = 2;
constexpr int RW = 512, HS = 64, NH = 8;
constexpr int DL = 64, AL = 64, MVL = 32, GL = 128;
constexpr int RWKV_COLS = 3 * RW + DL + AL + GL;
constexpr int PW = 512, PG = 128;
constexpr int IN_COLS = RWKV_COLS + PW;
constexpr int LDP = 2560;
constexpr int NKEYS = 128, NEXP = NKEYS * NKEYS, PH = 8, PQ = 256, PHALF = 128, TOPK = 16;
constexpr int NE = PH * TOPK;
constexpr float NORM_EPS = 1e-6f, GN_EPS = 64e-5f;

typedef unsigned short bf16;
__device__ __forceinline__ float bf2f(bf16 u) { return __uint_as_float((unsigned)u << 16); }
typedef float cvt_f32x2 __attribute__((ext_vector_type(2))); typedef __bf16 cvt_bf16x2 __attribute__((ext_vector_type(2)));
__device__ __forceinline__ unsigned cvtpk(float lo, float hi) { const cvt_f32x2 v = {lo, hi}; const cvt_bf16x2 b = __builtin_convertvector(v, cvt_bf16x2); return __builtin_bit_cast(unsigned, b); }
__device__ __forceinline__ bf16 f2bf(float f) { return (bf16)cvtpk(f, 0.f); }

constexpr size_t MiB = 1u << 20;
constexpr size_t WS_MOD = 1 * MiB;
constexpr size_t WS_US = 1 * MiB + 256 * 1024;
constexpr size_t WS_VS = 1 * MiB + 512 * 1024;
constexpr size_t WS_H = 2 * MiB;
constexpr size_t WS_PROJ = 34 * MiB;
constexpr size_t WS_Q = WS_PROJ;
constexpr size_t WS_R = 114 * MiB;
constexpr size_t WS_K = 130 * MiB;
constexpr size_t WS_V0 = 146 * MiB;
constexpr size_t WS_V1 = 162 * MiB;
constexpr size_t WS_KK = 178 * MiB;
constexpr size_t WS_B = 194 * MiB;
constexpr size_t WS_G = 210 * MiB;
constexpr size_t WS_BG = 226 * MiB;
constexpr size_t WS_W = 242 * MiB;
constexpr size_t WS_Y = 274 * MiB;
constexpr size_t WS_MIX = 306 * MiB;
constexpr size_t WS_IDX = 338 * MiB;
constexpr size_t WS_GATE = 346 * MiB;
constexpr size_t WS_WIN_T = 354 * MiB;
constexpr size_t WS_WOUT_T = 364 * MiB;
constexpr size_t WS_PQ_T = 368 * MiB;
constexpr size_t WS_KEYS = 376 * MiB;
constexpr size_t WS_U = 378 * MiB;
constexpr size_t WS_V = 442 * MiB;
constexpr size_t WS_QB = 410 * MiB;
constexpr size_t WS_SH = 426 * MiB;
constexpr size_t WS_LORA = 428 * MiB;
constexpr size_t WS_INVN = 430 * MiB;
constexpr size_t WS_BSUM = 431 * MiB;
constexpr size_t WS_SCN = 2 * MiB;
constexpr size_t WS_END = 506 * MiB;

template <int CTRL> __device__ __forceinline__ float dppf(float x) { return __int_as_float(__builtin_amdgcn_update_dpp(0, __float_as_int(x), CTRL, 0xF, 0xF, false)); }
__device__ __forceinline__ float red16(float x) { x += dppf<0xB1>(x); x += dppf<0x4E>(x); x += dppf<0x141>(x); x += dppf<0x140>(x); return x; }
__device__ __forceinline__ float shflx(float v, int lane, int off) { return __int_as_float(__builtin_amdgcn_ds_bpermute((lane ^ off) << 2, __float_as_int(v))); }
__device__ __forceinline__ unsigned shflxu(unsigned v, int lane, int off) { return (unsigned)__builtin_amdgcn_ds_bpermute((lane ^ off) << 2, (int)v); }
__device__ __forceinline__ void sort128(unsigned& k0, unsigned& k1, int lane) {
#pragma unroll
    for (int k = 2; k <= 128; k <<= 1) {
#pragma unroll
        for (int j = k >> 1; j > 0; j >>= 1) {
            if (j == 64) { const unsigned lo = k0 < k1 ? k0 : k1, hi = k0 < k1 ? k1 : k0; k0 = lo; k1 = hi; }
            else {
                const unsigned p0 = shflxu(k0, lane, j), p1 = shflxu(k1, lane, j);
                const bool lower = (lane & j) == 0, up0 = (lane & k) == 0, up1 = ((lane + 64) & k) == 0;
                const unsigned mn0 = k0 < p0 ? k0 : p0, mx0 = k0 < p0 ? p0 : k0, mn1 = k1 < p1 ? k1 : p1, mx1 = k1 < p1 ? p1 : k1;
                k0 = (lower == up0) ? mn0 : mx0; k1 = (lower == up1) ? mn1 : mx1;
            }
        }
    }
}
__device__ __forceinline__ float wave_sum(float v, int lane) { v = red16(v); v += shflx(v, lane, 16); v += shflx(v, lane, 32); return v; }
__device__ __forceinline__ float sigmoidf_(float x) { return 1.f / (1.f + expf(-x)); }

namespace pg8 {
#define PG8_LAS __attribute__((address_space(3)))
typedef unsigned short bf16_t;
typedef short bf16x8 __attribute__((ext_vector_type(8)));
typedef float f32x4 __attribute__((ext_vector_type(4)));
typedef unsigned u32x4 __attribute__((ext_vector_type(4)));
constexpr int BM = 256, BK = 64, HALF = 128, HTB = HALF * BK * 2  , STAGE_BYTES = 8 * HTB, NXCD = 8, WGM = 8;

__host__ __device__ __forceinline__ int lds_byte(int r, int c) { const int st = (r >> 4) * 2 + (c >> 5), rr = r & 15, cc = c & 31, ob = rr * 64 + cc * 2; return st * 1024 + (ob ^ (((ob >> 9) & 1) << 5)); }
__host__ __device__ __forceinline__ void stage_rc(int b, int& R, int& C) { const int st = b / 1024, sb = b % 1024, swz = sb ^ (((sb >> 9) & 1) << 5); R = (st >> 1) * 16 + swz / 64; C = (st & 1) * 32 + (swz % 64) / 2; }
__host__ __device__ __forceinline__ int perm32(int rho) { const int n = rho >> 4, i = rho & 15; return 8 * (i >> 2) + 4 * n + (i & 3); }

struct Unit { int pm, pn; };
struct Gemm { const bf16_t* A; const bf16_t* Bt; int M, N, K; };

struct StaticOrder {
    int nM, nN, nwg, G, c;
    __host__ __device__ void init(int M, int N, int G_, int c_) { nM = M / BM; nN = N / BM; nwg = nM * nN; G = G_; c = c_; }
    __host__ __device__ bool next(int i, Unit& u) const {
        const long L = (long)i * G + c; if (L >= nwg) return false;
        int wgid = (int)L; { const int q = nwg / NXCD, r = nwg % NXCD, xcd = wgid % NXCD, off = wgid / NXCD; wgid = (xcd < r ? xcd * (q + 1) : r * (q + 1) + (xcd - r) * q) + off; }
        const int nig = WGM * nN, gid = wgid / nig, fm = gid * WGM, gsz = (nM - fm) < WGM ? (nM - fm) : WGM;
        u.pm = fm + ((wgid % nig) % gsz); u.pn = (wgid % nig) / gsz; return true;
    }
    __device__ __forceinline__ void a_ready(const Unit&) const {}
    __device__ __forceinline__ void done(const Unit&) const {}
};

__device__ __forceinline__ unsigned cvt_pk_bf16(float lo, float hi) { unsigned r; asm volatile("v_cvt_pk_bf16_f32 %0, %1, %2" : "=v"(r) : "v"(lo), "v"(hi)); return r; }
typedef float f32x2 __attribute__((ext_vector_type(2)));
__device__ __forceinline__ f32x2 gelu_pk(f32x2 v) {
    const f32x2 av = __builtin_elementwise_abs(v), d = av * 0.2316418882f + 1.0f;
    f32x2 t; t.x = __builtin_amdgcn_rcpf(d.x); t.y = __builtin_amdgcn_rcpf(d.y);
    f32x2 q = t * 0.5307027145f + (-0.7265760135f); q = q * t + 0.7107068705f; q = q * t + (-0.142248368f); q = q * t + 0.127414796f; q = q * t;
    const f32x2 s = (v * v) * (-0.72134752044f);
    f32x2 e; e.x = __builtin_amdgcn_exp2f(s.x); e.y = __builtin_amdgcn_exp2f(s.y);
    const f32x2 m = v * (q * e), r = v - m;
    f32x2 o; o.x = v.x < 0.f ? m.x : r.x; o.y = v.y < 0.f ? m.y : r.y; return o;
}

template <int ACT  > struct EpiBf16 {
    static constexpr bool PERM = true, AFTER_DRAIN = false; static_assert(ACT == 0 || ACT == 1, "EpiBf16: ACT is 0 (none) or 1 (gelu_pk)");
    bf16_t* O; int ldc; const float* bias; int split_cols; size_t split_stride; float scale0;
    __device__ __forceinline__ void operator()(const f32x4 (&acc)[2][2][4][2], const Unit& u, int wr, int wc, int fr, int fq) const {
        const int row0 = u.pm * BM + wr * 64 + fr; int colt = u.pn * BM; bf16_t* base = O;
        float sc = 1.f; if (split_cols) { const int t = colt / split_cols; base += (size_t)t * split_stride; colt -= t * split_cols; if (t == 0) sc = scale0; }
        const int col0 = colt + wc * 32 + 8 * fq, bcol0 = u.pn * BM + wc * 32 + 8 * fq;
        f32x4 bv[2][2];
#pragma unroll
        for (int bj = 0; bj < 2; ++bj)
#pragma unroll
            for (int n = 0; n < 2; ++n) bv[bj][n] = bias ? *(const f32x4*)(bias + bcol0 + bj * HALF + 4 * n) : (f32x4){0.f, 0.f, 0.f, 0.f};
#pragma unroll
        for (int ai = 0; ai < 2; ++ai)
#pragma unroll
            for (int m = 0; m < 4; ++m) { bf16_t* rowp = base + (size_t)(row0 + ai * HALF + m * 16) * ldc + col0;
#pragma unroll
                for (int bj = 0; bj < 2; ++bj) { f32x4 v0 = acc[ai][bj][m][0] + bv[bj][0], v1 = acc[ai][bj][m][1] + bv[bj][1];
                    if (ACT == 1) { f32x2 a = gelu_pk((f32x2){v0[0], v0[1]}), b = gelu_pk((f32x2){v0[2], v0[3]}), c = gelu_pk((f32x2){v1[0], v1[1]}), d = gelu_pk((f32x2){v1[2], v1[3]});
                        v0 = (f32x4){a.x, a.y, b.x, b.y}; v1 = (f32x4){c.x, c.y, d.x, d.y}; }
                    v0 = v0 * sc; v1 = v1 * sc; u32x4 w; w.x = cvt_pk_bf16(v0[0], v0[1]); w.y = cvt_pk_bf16(v0[2], v0[3]); w.z = cvt_pk_bf16(v1[0], v1[1]); w.w = cvt_pk_bf16(v1[2], v1[3]);
                    *(u32x4*)(rowp + bj * HALF) = w; } }
    }
};

struct EpiProj {
    static constexpr bool PERM = true, AFTER_DRAIN = false;
    bf16_t* O; int ldc; bf16_t* P; int pool0, pw;
    __device__ __forceinline__ void operator()(const f32x4 (&acc)[2][2][4][2], const Unit& u, int wr, int wc, int fr, int fq) const {
        const int row0 = u.pm * BM + wr * 64 + fr; int colt = u.pn * BM; bf16_t* base = O; int ld = ldc;
        if (colt >= pool0 && colt < pool0 + pw) { base = P; ld = pw; colt -= pool0; }
        const int col0 = colt + wc * 32 + 8 * fq;
#pragma unroll
        for (int ai = 0; ai < 2; ++ai)
#pragma unroll
            for (int m = 0; m < 4; ++m) { bf16_t* rowp = base + (size_t)(row0 + ai * HALF + m * 16) * ld + col0;
#pragma unroll
                for (int bj = 0; bj < 2; ++bj) { const f32x4 v0 = acc[ai][bj][m][0], v1 = acc[ai][bj][m][1];
                    u32x4 w; w.x = cvt_pk_bf16(v0[0], v0[1]); w.y = cvt_pk_bf16(v0[2], v0[3]); w.z = cvt_pk_bf16(v1[0], v1[1]); w.w = cvt_pk_bf16(v1[2], v1[3]);
                    *(u32x4*)(rowp + bj * HALF) = w; } }
    }
};
struct EpiResGate {
    static constexpr bool PERM = false, AFTER_DRAIN = false;
    const float* xold; float* X; const float* gate;
    __device__ __forceinline__ void operator()(const f32x4 (&acc)[2][2][4][2], const Unit& u, int wr, int wc, int fr, int fq) const {
        const int col0 = u.pn * BM + wc * 32 + 4 * fq; const int b = (u.pm * BM) / SEQ;
        const float* gp = gate + (size_t)b * 6 * D + col0;
#pragma unroll
        for (int bj = 0; bj < 2; ++bj)
#pragma unroll
            for (int n = 0; n < 2; ++n) { const f32x4 gv = *(const f32x4*)(gp + bj * HALF + n * 16);
#pragma unroll
                for (int ai = 0; ai < 2; ++ai)
#pragma unroll
                    for (int m = 0; m < 4; ++m) { const size_t off = (size_t)(u.pm * BM + ai * HALF + wr * 64 + m * 16 + fr) * D + col0 + bj * HALF + n * 16;
                        const f32x4 xo = *(const f32x4*)(xold + off); *(f32x4*)(X + off) = xo + gv * acc[ai][bj][m][n]; } }
    }
};
template <class Epi, class Sched, bool ALIGN_EPI = false, bool SP2 = false>
__device__ __forceinline__ void gemm_phase(PG8_LAS unsigned char* lds, const Gemm g, const Sched& S, const Epi& E, int tid) {
    asm volatile("" : "+v"(tid));
    const int wid = __builtin_amdgcn_readfirstlane(tid >> 6), lane = tid & 63, wr = wid >> 2, wc = wid & 3, fr = lane & 15, fq = lane >> 4;
    const int K = g.K, nt = K / BK;
    unsigned voffA[2], voffB[2];
#pragma unroll
    for (int i = 0; i < 2; ++i) { int R, C; stage_rc(tid * 16 + i * 8192, R, C); const int Rb = Epi::PERM ? ((R & ~31) + perm32(R & 31)) : R;
        voffA[i] = (unsigned)(R * K + C) * 2u; voffB[i] = (unsigned)(Rb * K + C) * 2u; }
    const size_t kstep = (size_t)(BK * 2);
    const size_t hstep = (size_t)HALF * K * 2;
    const size_t tstep = 2 * hstep;
    const unsigned ldsw = (unsigned)wid * 1024u;
    const int aoff = lds_byte(wr * 64 + fr, fq * 8), boff = lds_byte(wc * 32 + fr, fq * 8);
#define PG8_SA(b, h) (((b) * 2 + (h)) * HTB)
#define PG8_SB(b, h) ((4 + (b) * 2 + (h)) * HTB)
#define PG8_STAGE(bufoff, gbase, voff) do { _Pragma("unroll") for (int _i = 0; _i < 2; ++_i) \
        __builtin_amdgcn_global_load_lds((const unsigned*)((const char*)(gbase) + (voff)[_i]), (PG8_LAS unsigned*)(lds + (bufoff) + ldsw + _i * 8192), 16, 0, 0); } while (0)
#define PG8_LDA(dst, b, h) do { _Pragma("unroll") for (int m = 0; m < 4; ++m) _Pragma("unroll") for (int k = 0; k < 2; ++k) dst[m][k] = *(const PG8_LAS bf16x8*)(lds + PG8_SA(b, h) + aoff + m * 2048 + k * 1024); } while (0)
#define PG8_LDB(dst, b, h) do { _Pragma("unroll") for (int n = 0; n < 2; ++n) _Pragma("unroll") for (int k = 0; k < 2; ++k) dst[n][k] = *(const PG8_LAS bf16x8*)(lds + PG8_SB(b, h) + boff + n * 2048 + k * 1024); } while (0)
#define PG8_MMA(ai, bj, At, Bt) do { __builtin_amdgcn_s_setprio(1); _Pragma("unroll") for (int m = 0; m < 4; ++m) _Pragma("unroll") for (int n = 0; n < 2; ++n) _Pragma("unroll") for (int k = 0; k < 2; ++k) \
        acc[ai][bj][m][n] = __builtin_amdgcn_mfma_f32_16x16x32_bf16(Bt[n][k], At[m][k], acc[ai][bj][m][n], 0, 0, 0); __builtin_amdgcn_s_setprio(0); } while (0)
#define PG8_WAIT_V(n) asm volatile("s_waitcnt vmcnt(" #n ")" ::: "memory")
#define PG8_WAIT_L(n) asm volatile("s_waitcnt lgkmcnt(" #n ")" ::: "memory")
#define PG8_BAR __builtin_amdgcn_s_barrier()
#define PG8_SCHED __builtin_amdgcn_sched_barrier(0)
    Unit cur, nxt; int ui = 0;
    if (!S.next(0, cur)) return;
    f32x4 acc[2][2][4][2];
#pragma unroll
    for (int a = 0; a < 2; ++a)
#pragma unroll
        for (int b = 0; b < 2; ++b)
#pragma unroll
            for (int m = 0; m < 4; ++m)
#pragma unroll
                for (int n = 0; n < 2; ++n) acc[a][b][m][n] = (f32x4){0.f, 0.f, 0.f, 0.f};
    bf16x8 At[4][2], B0[2][2], B1[2][2];
    const char* cA = (const char*)g.A + (size_t)cur.pm * tstep; const char* cB = (const char*)g.Bt + (size_t)cur.pn * tstep;
    S.a_ready(cur);
    if constexpr (SP2) {
        PG8_STAGE(PG8_SB(0, 0), cB, voffB); PG8_STAGE(PG8_SB(0, 1), cB + hstep, voffB); PG8_STAGE(PG8_SA(0, 0), cA, voffA); PG8_STAGE(PG8_SA(0, 1), cA + hstep, voffA);
        if (wr == 1) PG8_BAR;
        PG8_WAIT_V(2); PG8_BAR;
        PG8_STAGE(PG8_SB(1, 0), cB + kstep, voffB); PG8_STAGE(PG8_SA(1, 0), cA + kstep, voffA); PG8_STAGE(PG8_SB(1, 1), cB + hstep + kstep, voffB);
        PG8_WAIT_V(6); PG8_BAR;
    } else {
        PG8_STAGE(PG8_SB(0, 0), cB, voffB); PG8_STAGE(PG8_SA(0, 0), cA, voffA); PG8_STAGE(PG8_SB(0, 1), cB + hstep, voffB); PG8_STAGE(PG8_SA(0, 1), cA + hstep, voffA);
        if (wr == 1) PG8_BAR;
        PG8_WAIT_V(4); PG8_BAR;
        PG8_STAGE(PG8_SB(1, 0), cB + kstep, voffB); PG8_STAGE(PG8_SA(1, 0), cA + kstep, voffA); PG8_STAGE(PG8_SB(1, 1), cB + hstep + kstep, voffB);
        PG8_WAIT_V(6); PG8_BAR;
    }
    for (;;) {
        const bool has_next = S.next(ui + 1, nxt);
        const char* nA = has_next ? (const char*)g.A + (size_t)nxt.pm * tstep : cA; const char* nB = has_next ? (const char*)g.Bt + (size_t)nxt.pn * tstep : cB;
        for (int t = 0; t < nt; t += 2) {
            const bool last = (t == nt - 2);
            const char* a1 = cA + (size_t)(t + 1) * kstep;
            const char* a2 = last ? nA : cA + (size_t)(t + 2) * kstep; const char* b2 = last ? nB : cB + (size_t)(t + 2) * kstep;
            const char* a3 = a2 + kstep; const char* b3 = b2 + kstep;
            if (last && has_next) S.a_ready(nxt);
            if constexpr (SP2) {
            PG8_LDB(B0, 0, 0); PG8_LDB(B1, 0, 1); PG8_SCHED; PG8_LDA(At, 0, 0); PG8_STAGE(PG8_SA(1, 1), a1 + hstep, voffA);
            PG8_WAIT_V(8); PG8_WAIT_L(0); PG8_BAR; PG8_MMA(0, 0, At, B0); PG8_MMA(0, 1, At, B1); PG8_BAR; PG8_SCHED;
            PG8_LDA(At, 0, 1); PG8_STAGE(PG8_SB(0, 0), b2, voffB); PG8_STAGE(PG8_SB(0, 1), b2 + hstep, voffB); PG8_STAGE(PG8_SA(0, 0), a2, voffA);
            PG8_WAIT_V(8); PG8_WAIT_L(0); PG8_BAR; PG8_MMA(1, 0, At, B0); PG8_MMA(1, 1, At, B1); PG8_BAR; PG8_SCHED;
            PG8_LDB(B0, 1, 0); PG8_LDB(B1, 1, 1); PG8_SCHED; PG8_LDA(At, 1, 0); PG8_STAGE(PG8_SA(0, 1), a2 + hstep, voffA);
            PG8_WAIT_V(8); PG8_WAIT_L(0); PG8_BAR; PG8_MMA(0, 0, At, B0); PG8_MMA(0, 1, At, B1); PG8_BAR; PG8_SCHED;
            PG8_LDA(At, 1, 1); PG8_STAGE(PG8_SB(1, 0), b3, voffB); PG8_STAGE(PG8_SB(1, 1), b3 + hstep, voffB); PG8_STAGE(PG8_SA(1, 0), a3, voffA);
            PG8_WAIT_V(8); PG8_WAIT_L(0); PG8_BAR; PG8_MMA(1, 0, At, B0); PG8_MMA(1, 1, At, B1); PG8_BAR; PG8_SCHED;
            } else {
            PG8_LDB(B0, 0, 0); PG8_SCHED; PG8_LDA(At, 0, 0); PG8_STAGE(PG8_SA(1, 1), a1 + hstep, voffA);
            PG8_WAIT_L(8); PG8_BAR; PG8_WAIT_L(0); PG8_MMA(0, 0, At, B0); PG8_BAR; PG8_SCHED;
            PG8_LDB(B1, 0, 1); PG8_STAGE(PG8_SB(0, 0), b2, voffB);
            PG8_BAR; PG8_WAIT_L(0); PG8_MMA(0, 1, At, B1); PG8_BAR;
            PG8_LDA(At, 0, 1); PG8_STAGE(PG8_SA(0, 0), a2, voffA);
            PG8_BAR; PG8_WAIT_L(0); PG8_MMA(1, 0, At, B0); PG8_BAR; PG8_SCHED;
            PG8_STAGE(PG8_SB(0, 1), b2 + hstep, voffB);
            PG8_WAIT_V(6); PG8_BAR; PG8_MMA(1, 1, At, B1); PG8_BAR;
            PG8_LDB(B0, 1, 0); PG8_SCHED; PG8_LDA(At, 1, 0); PG8_STAGE(PG8_SA(0, 1), a2 + hstep, voffA);
            PG8_WAIT_L(8); PG8_BAR; PG8_WAIT_L(0); PG8_MMA(0, 0, At, B0); PG8_BAR; PG8_SCHED;
            PG8_LDB(B1, 1, 1); PG8_STAGE(PG8_SB(1, 0), b3, voffB);
            PG8_BAR; PG8_WAIT_L(0); PG8_MMA(0, 1, At, B1); PG8_BAR;
            PG8_LDA(At, 1, 1); PG8_STAGE(PG8_SA(1, 0), a3, voffA);
            PG8_BAR; PG8_WAIT_L(0); PG8_MMA(1, 0, At, B0); PG8_BAR; PG8_SCHED;
            PG8_STAGE(PG8_SB(1, 1), b3 + hstep, voffB);
            PG8_WAIT_V(6); PG8_BAR; PG8_MMA(1, 1, At, B1); PG8_BAR;
            }
        }
        if constexpr (ALIGN_EPI) { if (wr == 0) PG8_BAR; }
        if constexpr (!Epi::AFTER_DRAIN) { int le_; asm volatile("v_mbcnt_lo_u32_b32 %0, -1, 0\n\tv_mbcnt_hi_u32_b32 %0, -1, %0" : "=v"(le_)); E(acc, cur, wr, wc, le_ & 15, le_ >> 4); S.done(cur); }
        if (!has_next) break;
#pragma unroll
        for (int a = 0; a < 2; ++a)
#pragma unroll
            for (int b = 0; b < 2; ++b)
#pragma unroll
                for (int m = 0; m < 4; ++m)
#pragma unroll
                    for (int n = 0; n < 2; ++n) acc[a][b][m][n] = (f32x4){0.f, 0.f, 0.f, 0.f};
        cur = nxt; cA = nA; cB = nB; ++ui;
        if constexpr (ALIGN_EPI) { if (wr == 1) PG8_BAR; }
    }
    PG8_WAIT_V(0);
    if constexpr (!ALIGN_EPI) { if (wr == 0) PG8_BAR; }
    PG8_BAR;
    if constexpr (Epi::AFTER_DRAIN) { E.fused(acc, cur, wr, wc, fr, fq, lds, wid, lane); S.done(cur); }
#undef PG8_SA
#undef PG8_SB
#undef PG8_STAGE
#undef PG8_LDA
#undef PG8_LDB
#undef PG8_MMA
#undef PG8_WAIT_V
#undef PG8_WAIT_L
#undef PG8_BAR
#undef PG8_SCHED
}
}

#define LAS __attribute__((address_space(3)))
constexpr int NWAVES = 8, NTHR = 512;
constexpr int LDS_BYTES = 147456;
constexpr int NPH = 21;
typedef float f32x4 __attribute__((ext_vector_type(4)));
typedef unsigned u32x4 __attribute__((ext_vector_type(4)));

struct Args { const float* in[30]; float* out; unsigned char* ws; int ph_lo, ph_hi; };

__device__ __forceinline__ unsigned pk2(float lo, float hi) { return cvtpk(lo, hi); }

__device__ __forceinline__ void p0_transpose_item(const float* W, int K, int N, bf16* WT, int row_off, LAS float* scr, int item, int lane) {
    const int nblk = N / 32, kb = item / nblk, nb = item % nblk, k0 = 64 * kb, n0 = 32 * nb;
#pragma unroll 8
    for (int i = 0; i < 32; ++i) { const int kk = 2 * i + (lane >> 5); scr[kk * 33 + (lane & 31)] = W[(size_t)(k0 + kk) * N + n0 + (lane & 31)]; }
    asm volatile("s_waitcnt lgkmcnt(0)" ::: "memory");
    const int c = lane & 7;
#pragma unroll
    for (int j = 0; j < 4; ++j) { const int n = (lane >> 3) + 8 * j; const LAS float* s = scr + (8 * c) * 33 + n;
        u32x4 o; o.x = pk2(s[0 * 33], s[1 * 33]); o.y = pk2(s[2 * 33], s[3 * 33]); o.z = pk2(s[4 * 33], s[5 * 33]); o.w = pk2(s[6 * 33], s[7 * 33]);
        *(u32x4*)(WT + (size_t)(row_off + n0 + n) * K + k0 + 8 * c) = o; }
    asm volatile("s_waitcnt lgkmcnt(0)" ::: "memory");
}

__device__ __forceinline__ void norm_mod_row(const float* xr, const float* gamma, const float* sh, const float* sc, bf16* orow, int lane) {
    f32x4 v[4]; float ss = 0.f;
#pragma unroll
    for (int j = 0; j < 4; ++j) { v[j] = *(const f32x4*)(xr + j * 256 + lane * 4); ss += (v[j].x * v[j].x + v[j].y * v[j].y) + (v[j].z * v[j].z + v[j].w * v[j].w); }
    const float rs = rsqrtf(wave_sum(ss, lane) * (1.f / D) + NORM_EPS);
#pragma unroll
    for (int j = 0; j < 4; ++j) { const int d = j * 256 + lane * 4; const f32x4 g = *(const f32x4*)(gamma + d), a = *(const f32x4*)(sc + d), s = *(const f32x4*)(sh + d);
        const f32x4 y = v[j] * rs * g * (a + 1.f) + s; uint2 o; o.x = pk2(y.x, y.y); o.y = pk2(y.z, y.w); *(uint2*)(orow + d) = o; }
}


#define XB_TMO      128
#define XB_XCNT(j)  (256  + 64 * (j))
#define XB_XSUB(j)  (1280 + 64 * (j))
#define XB_XGEN(j)  (2304 + 64 * (j))
#define XB_TOP      3328
#define XB_TOPGEN   3392
#define XCD_BAR_WORDS 3456
#define XB_SPIN_CAP (1u << 18)

__device__ __forceinline__ unsigned xb_ld(unsigned* p)              { return __hip_atomic_load(p, __ATOMIC_RELAXED, __HIP_MEMORY_SCOPE_AGENT); }
__device__ __forceinline__ unsigned xb_add(unsigned* p, unsigned v) { return __hip_atomic_fetch_add(p, v, __ATOMIC_RELAXED, __HIP_MEMORY_SCOPE_AGENT); }
__device__ __forceinline__ unsigned xb_xcc_id() { return (unsigned)__builtin_amdgcn_s_getreg((3 << 11) | 20) & 0xFu; }
#define XB_SPIN(cond, bar) do { unsigned _sp = 0; while (cond) { __builtin_amdgcn_s_sleep(1); \
    if ((++_sp & 255u) == 0u) { if (xb_ld(&(bar)[XB_TMO])) break; if (_sp > XB_SPIN_CAP) { atomicAdd(&(bar)[XB_TMO], 1u); break; } } } } while (0)

struct XcdBarrier {
    unsigned* bar; unsigned x; int w0;
    volatile __attribute__((address_space(3))) unsigned* st;
};

__device__ __forceinline__ XcdBarrier xcd_barrier_post(unsigned* bar, volatile __attribute__((address_space(3))) unsigned* st) {
    XcdBarrier b; b.bar = bar; b.x = xb_xcc_id(); b.st = st; b.w0 = __builtin_amdgcn_readfirstlane((int)threadIdx.x >> 6);
    if (threadIdx.x == 0) (void)xb_add(&bar[XB_XCNT(b.x)], 1u);
    return b;
}
__device__ __forceinline__ void xcd_barrier_complete(unsigned* bar, unsigned x, unsigned& nloc, unsigned& nx) {
    const unsigned G = gridDim.x * gridDim.y * gridDim.z;
    unsigned sum, cnt, mine, sp = 0u;
    for (;;) {
        sum = 0u; cnt = 0u; mine = 0u;
#pragma unroll
        for (unsigned j = 0; j < 16; ++j) { const unsigned c = xb_ld(&bar[XB_XCNT(j)]); sum += c; cnt += (c > 0u) ? 1u : 0u; }
        mine = xb_ld(&bar[XB_XCNT(x)]);
        if (sum == G) break;
        __builtin_amdgcn_s_sleep(1);
        if ((++sp & 255u) == 0u) { if (xb_ld(&bar[XB_TMO])) break; if (sp > XB_SPIN_CAP) { atomicAdd(&bar[XB_TMO], 1u); break; } }
    }
    nloc = mine > 0u ? mine : 1u; nx = cnt > 0u ? cnt : 1u;
}

template <bool FIRST> __device__ __forceinline__ void xcd_barrier(const XcdBarrier& b) {
    asm volatile("s_waitcnt vmcnt(0)" ::: "memory");
    __syncthreads();
    int lid_; asm volatile("v_mbcnt_lo_u32_b32 %0, -1, 0\n\tv_mbcnt_hi_u32_b32 %0, -1, %0" : "=v"(lid_));
    if (b.w0 == 0 && lid_ == 0) {
        unsigned* bar = b.bar;
        __builtin_amdgcn_s_waitcnt(0);
        unsigned nloc = b.st[0], nx = b.st[1];
        if (FIRST && nloc == 0u) { xcd_barrier_complete(bar, b.x, nloc, nx); b.st[0] = nloc; b.st[1] = nx; }
        const unsigned old = xb_add(&bar[XB_XSUB(b.x)], 1u);
        const unsigned gen = old / nloc;
        if (old + 1u == (gen + 1u) * nloc) {
            __builtin_amdgcn_fence(__ATOMIC_RELEASE, "agent");
            asm volatile("s_waitcnt vmcnt(0)" ::: "memory");
            const unsigned og = xb_add(&bar[XB_TOP], 1u);
            const unsigned tg = og / nx;
            if (og + 1u == (tg + 1u) * nx) xb_add(&bar[XB_TOPGEN], 1u);
            else XB_SPIN(xb_ld(&bar[XB_TOPGEN]) == tg, bar);
            __builtin_amdgcn_fence(__ATOMIC_ACQUIRE, "agent");
            xb_add(&bar[XB_XGEN(b.x)], 1u);
            asm volatile("s_waitcnt vmcnt(0)" ::: "memory");
        } else {
            XB_SPIN(xb_ld(&bar[XB_XGEN(b.x)]) == gen, bar);
            __builtin_amdgcn_fence(__ATOMIC_ACQUIRE, "agent");
            asm volatile("s_waitcnt vmcnt(0)" ::: "memory");
        }
    }
    __syncthreads();
}


__device__ __forceinline__ unsigned mono_u32(float f) { unsigned u = __float_as_uint(f); return (u & 0x80000000u) ? ~u : (u | 0x80000000u); }
__device__ __forceinline__ float demono_u32(unsigned u) { return __uint_as_float((u & 0x80000000u) ? (u & 0x7FFFFFFFu) : ~u); }
__device__ __forceinline__ unsigned pack_key7(float f, int idx) { return (mono_u32(f) & 0xFFFFFF80u) | (unsigned)(127 - idx); }
__device__ __forceinline__ float unpack_key7(unsigned k) { return demono_u32((k & 0xFFFFFF80u) | 0x40u); }
__device__ __forceinline__ float unpack_key8(unsigned k) { return demono_u32((k & 0xFFFFFF00u) | 0x80u); }
__device__ __forceinline__ void ce_desc(unsigned& a, unsigned& b) { const unsigned hi = a > b ? a : b, lo = a > b ? b : a; a = hi; b = lo; }
__device__ __forceinline__ void sort16_desc(unsigned* v) {
#pragma unroll
    for (int k = 2; k <= 16; k <<= 1)
#pragma unroll
        for (int j = k >> 1; j > 0; j >>= 1)
#pragma unroll
            for (int i = 0; i < 16; ++i) { const int l = i ^ j; if (l > i) { if ((i & k) == 0) ce_desc(v[i], v[l]); else ce_desc(v[l], v[i]); } }
}
__device__ __forceinline__ void bmerge16_desc(unsigned* v) {
#pragma unroll
    for (int j = 8; j > 0; j >>= 1)
#pragma unroll
        for (int i = 0; i < 16; ++i) { const int l = i ^ j; if (l > i) ce_desc(v[i], v[l]); }
}
__device__ __forceinline__ void merge_top16(unsigned* a, const unsigned* b) {
#pragma unroll
    for (int i = 0; i < 16; ++i) { const unsigned o = b[15 - i]; a[i] = a[i] > o ? a[i] : o; }
    bmerge16_desc(a);
}
__device__ __forceinline__ void stage2_cands(const unsigned* s0, const unsigned* s1, int hh, unsigned* c) {
    float A[16], B[16];
#pragma unroll
    for (int i = 0; i < 16; ++i) { const float f0 = unpack_key7(s0[i]), f1 = unpack_key7(s1[i]); A[i] = hh ? f1 : f0; B[i] = hh ? f0 : f1; }
    int n = 0;
#pragma unroll
    for (int i = 0; i < 4; ++i)
#pragma unroll
        for (int j = i; j < 16; ++j) { if ((i + 1) * (j + 1) > 16) continue;
            const float val = A[i] + B[j]; const unsigned id = hh ? (unsigned)((j << 4) | i) : (unsigned)((i << 4) | j);
            unsigned key = (mono_u32(val) & 0xFFFFFF00u) | id; if (hh && i == j) key = 0u; c[n++] = key; }
#pragma unroll
    for (; n < 32; ++n) c[n] = 0u;
}

typedef short bf16x8_t __attribute__((ext_vector_type(8)));
typedef float f32x16 __attribute__((ext_vector_type(16)));
__device__ __forceinline__ float gelu_erf(float a) { return 0.5f * a * (1.f + erff(a * 0.70710678118654752f)); }


typedef __attribute__((address_space(3))) bf16 lbf16;

__device__ __forceinline__ f32x16 mm32(bf16x8_t a, bf16x8_t b, f32x16 c) { return __builtin_amdgcn_mfma_f32_32x32x16_bf16(a, b, c, 0, 0, 0); }
__device__ __forceinline__ bf16x8_t frag_from_u32x4(unsigned x, unsigned y, unsigned z, unsigned w) { typedef unsigned u4 __attribute__((ext_vector_type(4))); u4 t = {x, y, z, w}; return __builtin_bit_cast(bf16x8_t, t); }
template <int S> __device__ __forceinline__ bf16x8_t accop(const f32x16& z) {
    return frag_from_u32x4(cvtpk(z[8 * S], z[8 * S + 1]), cvtpk(z[8 * S + 2], z[8 * S + 3]), cvtpk(z[8 * S + 4], z[8 * S + 5]), cvtpk(z[8 * S + 6], z[8 * S + 7])); }
template <int S> __device__ __forceinline__ bf16x8_t ldpermcol(const lbf16* a, int col, int hh) {
    const lbf16* p = a + (16 * S + 4 * hh) * 72 + col;
    const unsigned e0 = p[0], e1 = p[72], e2 = p[144], e3 = p[216], e4 = p[8 * 72], e5 = p[9 * 72], e6 = p[10 * 72], e7 = p[11 * 72];
    return frag_from_u32x4(e0 | (e1 << 16), e2 | (e3 << 16), e4 | (e5 << 16), e6 | (e7 << 16)); }
__device__ __forceinline__ bf16x8_t ldrow(const lbf16* a, int row, int ks, int hh) { return *(const __attribute__((address_space(3))) bf16x8_t*)(a + row * 72 + ks * 16 + 8 * hh); }
__device__ __forceinline__ int rowidx(int e, int hh) { return (e & 3) + 8 * (e >> 2) + 4 * hh; }

constexpr int ROWB = 768;
__device__ __forceinline__ unsigned fp6code(float x, float sc) {
    const float t = fabsf(x) * sc;
    const float r = t < 16.f ? __builtin_rintf(t) : (t < 32.f ? 8.f + __builtin_rintf(t * 0.5f) : 16.f + __builtin_rintf(t * 0.25f));
    unsigned c = (unsigned)r; c = c > 31u ? 31u : c;
    return c | (x < 0.f ? 32u : 0u);
}
__device__ __forceinline__ void convert_tables_fp6(const float* pu, const float* pv, unsigned char* u8, unsigned char* v8, float* usc, float* vsc, int l, int wv, int nw, int lane) {
    for (int rr0 = wv * 2; rr0 < 2 * NEXP; rr0 += nw * 2) {
        f32x4 v[2][4]; float m[2];
#pragma unroll
        for (int rr = 0; rr < 2; ++rr) { const int q = rr0 + rr; const size_t row = (size_t)l * NEXP + (q < NEXP ? q : q - NEXP); const float* sp_ = (q < NEXP ? pu : pv) + row * D + lane * 16;
#pragma unroll
            for (int k = 0; k < 4; ++k) v[rr][k] = *(const f32x4*)(sp_ + k * 4); }
#pragma unroll
        for (int rr = 0; rr < 2; ++rr) { float mm = 0.f;
#pragma unroll
            for (int k = 0; k < 4; ++k) mm = fmaxf(fmaxf(mm, fmaxf(fabsf(v[rr][k].x), fabsf(v[rr][k].y))), fmaxf(fabsf(v[rr][k].z), fabsf(v[rr][k].w)));
#pragma unroll
            for (int o = 1; o < 64; o <<= 1) mm = fmaxf(mm, shflx(mm, lane, o));
            m[rr] = mm; }
#pragma unroll
        for (int rr = 0; rr < 2; ++rr) { const int q = rr0 + rr; const size_t row = (size_t)l * NEXP + (q < NEXP ? q : q - NEXP); const float sc = m[rr] > 0.f ? 60.f / m[rr] : 1.f;
            unsigned c[16];
#pragma unroll
            for (int k = 0; k < 4; ++k) { c[k * 4] = fp6code(v[rr][k].x, sc); c[k * 4 + 1] = fp6code(v[rr][k].y, sc); c[k * 4 + 2] = fp6code(v[rr][k].z, sc); c[k * 4 + 3] = fp6code(v[rr][k].w, sc); }
            const unsigned o0 = c[0] | (c[1] << 6) | (c[2] << 12) | (c[3] << 18) | (c[4] << 24) | (c[5] << 30);
            const unsigned o1 = (c[5] >> 2) | (c[6] << 4) | (c[7] << 10) | (c[8] << 16) | (c[9] << 22) | (c[10] << 28);
            const unsigned o2 = (c[10] >> 4) | (c[11] << 2) | (c[12] << 8) | (c[13] << 14) | (c[14] << 20) | (c[15] << 26);
            unsigned* op = (unsigned*)((q < NEXP ? u8 : v8) + row * ROWB + lane * 12);
            op[0] = o0; op[1] = o1; op[2] = o2;
            if (lane == 0) (q < NEXP ? usc : vsc)[row] = m[rr] > 0.f ? m[rr] * (1.f / 7.5f) : 1.f; }
    }
}

__global__ void __launch_bounds__(NTHR, 2) mega(Args args) {
    extern __shared__ __attribute__((aligned(16))) unsigned char lds_raw[];
    LAS unsigned char* lds = (LAS unsigned char*)lds_raw;
    const int G = gridDim.x, bx = blockIdx.x, NGW = G * NWAVES;
    const int wave0 = __builtin_amdgcn_readfirstlane((int)threadIdx.x >> 6);
    typedef const unsigned char __attribute__((address_space(4))) kbyte;
#define PHASE_IDS int tid; asm volatile("v_mbcnt_lo_u32_b32 %0, -1, 0\n\tv_mbcnt_hi_u32_b32 %0, -1, %0" : "=v"(tid)); tid += wave0 * 64;     const int lane = tid & 63, wave = __builtin_amdgcn_readfirstlane(tid >> 6), gw = bx * NWAVES + wave; (void)lane; (void)gw; \
    kbyte* kp = (kbyte*)__builtin_amdgcn_kernarg_segment_ptr(); asm volatile("" : "+s"(kp)); \
    unsigned char* const ws = (unsigned char*)*(__attribute__((address_space(1))) unsigned char* const __attribute__((address_space(4)))*)(kp + 31 * 8); float* const X = (float*)*(__attribute__((address_space(1))) float* const __attribute__((address_space(4)))*)(kp + 30 * 8); (void)ws; (void)X;
#define INP(i) ((const float*)(*(const __attribute__((address_space(1))) float* const __attribute__((address_space(4)))*)(kp + (i) * 8)))
#define MOD ((float*)(ws + WS_MOD))
#define H ((bf16*)(ws + WS_H))
#define PROJ ((bf16*)(ws + WS_PROJ))
#define Q ((bf16*)(ws + WS_Q))
#define MIX ((bf16*)(ws + WS_MIX))
#define Rb ((bf16*)(ws + WS_R))
#define Kb ((bf16*)(ws + WS_K))
#define V0 ((bf16*)(ws + WS_V0))
#define V1 ((bf16*)(ws + WS_V1))
#define KKb ((bf16*)(ws + WS_KK))
#define Bb ((bf16*)(ws + WS_B))
#define Gb ((bf16*)(ws + WS_G))
#define BGb ((bf16*)(ws + WS_BG))
#define Wd ((float*)(ws + WS_W))
#define Y ((float*)(ws + WS_Y))
#define QB ((float*)(ws + WS_QB))
#define POOLIN ((bf16*)(ws + WS_QB))
#define SH ((float*)(ws + WS_SH))
#define WUPT ((bf16*)(ws + WS_LORA))
#define AUPT ((bf16*)(ws + WS_LORA + 131072))
#define GUPT ((bf16*)(ws + WS_LORA + 262144))
#define VUPT ((bf16*)(ws + WS_LORA + 524288))
#define PWT ((bf16*)(ws + WS_LORA + 655360))
#define INVN ((float*)(ws + WS_INVN))
#define BSUM ((float*)(ws + WS_BSUM))
#define SCN ((unsigned char*)(ws + WS_SCN))
#define IDX ((int*)(ws + WS_IDX))
#define GATE ((float*)(ws + WS_GATE))
#define WinT ((bf16*)(ws + WS_WIN_T))
#define WoutT ((bf16*)(ws + WS_WOUT_T))
#define PqT ((bf16*)(ws + WS_PQ_T))
#define KEYS ((bf16*)(ws + WS_KEYS))
#define U8 ((unsigned char*)(ws + WS_U))
#define V8 ((unsigned char*)(ws + WS_V))
#define USc ((float*)(ws + WS_US))
#define VSc ((float*)(ws + WS_VS))
    const int lo = args.ph_lo, hi = args.ph_hi;
    { volatile LAS unsigned* misc = (volatile LAS unsigned*)(lds + LDS_BYTES - 64); if (threadIdx.x < 4) misc[threadIdx.x] = 0u; __syncthreads(); }
    const XcdBarrier xbar = xcd_barrier_post((unsigned*)(args.ws) + 4096, (volatile LAS unsigned*)(lds + LDS_BYTES - 64));
#define IN(k) (lo <= (k) && (k) < hi)
#ifndef REP_PHASE
#define REP_PHASE (-1)
#endif
#define REPS(k) ((k) == REP_PHASE ? 3 : 1)
#define SEAM(k) do { if (IN(k) && IN((k) + 1)) { if ((k) == 0) cg::this_grid().sync(); else { XcdBarrier xb_ = xbar; asm volatile("" : "+s"(xb_.bar)); if ((k) == 1) xcd_barrier<true>(xb_); else xcd_barrier<false>(xb_); } } } while (0)

    if (IN(0)) { PHASE_IDS
        { LAS float* ca = (LAS float*)lds; LAS float* red = (LAS float*)(lds + 16384);
          const float* c = INP(1); const float* ada_w = INP(2); const float* ada_b = INP(3);
          bool have = false;
          for (int it = bx; it < 96; it += G) {
              if (!have) { for (int i = tid; i < BATCH * D; i += NTHR) { const float v = c[i]; ca[i] = v / (1.f + expf(-v)); } have = true; __syncthreads(); }
              const int l = it / 48, n = (it % 48) * 128 + (tid & 127), kq = tid >> 7;
              const float* w = ada_w + (size_t)l * D * 6 * D + (size_t)(kq * 256) * 6 * D + n;
              float a0 = 0.f, a1 = 0.f, a2 = 0.f, a3 = 0.f;
#pragma unroll 32
              for (int k = 0; k < 256; ++k) { const float wv = w[(size_t)k * 6 * D]; const int kk = kq * 256 + k; a0 += ca[kk] * wv; a1 += ca[D + kk] * wv; a2 += ca[2 * D + kk] * wv; a3 += ca[3 * D + kk] * wv; }
              red[(kq * 4 + 0) * 128 + (tid & 127)] = a0; red[(kq * 4 + 1) * 128 + (tid & 127)] = a1; red[(kq * 4 + 2) * 128 + (tid & 127)] = a2; red[(kq * 4 + 3) * 128 + (tid & 127)] = a3;
              __syncthreads();
              { const int b = tid >> 7, col = tid & 127, nn = (it % 48) * 128 + col;
                const float s = red[(0 * 4 + b) * 128 + col] + red[(1 * 4 + b) * 128 + col] + red[(2 * 4 + b) * 128 + col] + red[(3 * 4 + b) * 128 + col];
                MOD[(size_t)l * BATCH * 6 * D + (size_t)b * 6 * D + nn] = s + ada_b[l * 6 * D + nn]; }
              __syncthreads();
          }
          __syncthreads(); }
        { LAS float* scr = (LAS float*)(lds + wave * 16384);
          constexpr int I_IN = (D / 64) * (IN_COLS / 32), I_VR = (D / 64) * (MVL / 32), I_OUT = (D / 64) * (D / 32), I_PQ = (D / 64) * (PH * PQ / 32);
          constexpr int NIT = 2 * I_IN + I_VR + 2 * I_OUT + 2 * I_PQ;
          for (int it = gw; it < NIT; it += NGW) { int r = it;
              if (r < 2 * I_IN) { const int l = r / I_IN; p0_transpose_item(INP(5) + (size_t)l * D * IN_COLS, D, IN_COLS, WinT + (size_t)l * LDP * D, 0, scr, r % I_IN, lane); continue; } r -= 2 * I_IN;
              if (r < I_VR) { p0_transpose_item(INP(12), D, MVL, WinT + (size_t)1 * LDP * D, IN_COLS, scr, r, lane); continue; } r -= I_VR;
              if (r < 2 * I_OUT) { const int l = r / I_OUT; p0_transpose_item(INP(23) + (size_t)l * D * D, D, D, WoutT + (size_t)l * D * D, 0, scr, r % I_OUT, lane); continue; } r -= 2 * I_OUT;
              { const int l = r / I_PQ; p0_transpose_item(INP(25) + (size_t)l * D * PH * PQ, D, PH * PQ, PqT + (size_t)l * PH * PQ * D, 0, scr, r % I_PQ, lane); } }
          for (int it = gw; it < 2 * 16 + 2 * 16 + 2 * 32; it += NGW) { int r = it;
              if (r < 32) { const int l = r / 16; p0_transpose_item(INP(8) + (size_t)l * DL * RW, DL, RW, WUPT + (size_t)l * RW * DL, 0, scr, r % 16, lane); continue; } r -= 32;
              if (r < 32) { const int l = r / 16; p0_transpose_item(INP(10) + (size_t)l * AL * RW, AL, RW, AUPT + (size_t)l * RW * AL, 0, scr, r % 16, lane); continue; } r -= 32;
              { const int l = r / 32; p0_transpose_item(INP(11) + (size_t)l * GL * RW, GL, RW, GUPT + (size_t)l * RW * GL, 0, scr, r % 32, lane); } }
          { const float* vu = INP(15); for (int e = bx * NTHR + tid; e < MVL * RW; e += G * NTHR) { const int n = e >> 5, k = e & 31; VUPT[e] = f2bf(vu[k * RW + n]); } }
          for (int it = gw; it < 8 * 8; it += NGW) p0_transpose_item(INP(21) + (size_t)(it >> 3) * PG * PG, PG, PG, PWT + (size_t)(it >> 3) * PG * PG, 0, scr, it & 7, lane);
        }
        { const size_t gt = (size_t)bx * NTHR + tid, NT = (size_t)G * NTHR;
          constexpr size_t NK8 = (size_t)2 * PH * 2 * NKEYS * PHALF / 8;
          const float* src = INP(26); bf16* dst = KEYS;
          for (size_t i = gt; i < NK8; i += NT) {
              const f32x4 a = *(const f32x4*)(src + i * 8), b = *(const f32x4*)(src + i * 8 + 4);
              u32x4 o; o.x = pk2(a.x, a.y); o.y = pk2(a.z, a.w); o.z = pk2(b.x, b.y); o.w = pk2(b.z, b.w); *(u32x4*)(dst + i * 8) = o; }
        }
    }
    SEAM(0);

#pragma unroll
    for (int l = 0; l < DEPTH; ++l) {
        const int pb = 1 + 10 * l;
#define modl (MOD + (size_t)l * BATCH * 6 * D)
#define xin (l == 0 ? INP(0) : (const float*)X)
        if (l == 0 && IN(pb + 0)) { PHASE_IDS const float* gamma = INP(4) + l * D;
            for (int row = gw; row < T; row += NGW) { const int b = row / SEQ; norm_mod_row(xin + (size_t)row * D, gamma, modl + (size_t)b * 6 * D, modl + (size_t)b * 6 * D + D, H + (size_t)row * D, lane); } }
        SEAM(pb + 0);
        if (IN(pb + 1)) { PHASE_IDS const int N1 = l == 0 ? IN_COLS : LDP;
            pg8::Gemm g{H, WinT + (size_t)l * LDP * D, T, N1, D}; pg8::StaticOrder S; S.init(T, N1, G, bx);
            pg8::EpiProj E{PROJ, LDP, POOLIN, RWKV_COLS, PW};
            pg8::gemm_phase<pg8::EpiProj, pg8::StaticOrder, true, true>(lds, g, S, E, tid); }
        SEAM(pb + 1);

        if (IN(pb + 2)) { PHASE_IDS
            constexpr int LST = 296;
            LAS bf16* lin = (LAS bf16*)lds;
            const float* mu = INP(6) + l * RWKV_COLS; const float* vmu = INP(13);
            const float* w0p = INP(7) + l * RW; const float* a0p = INP(9) + l * RW; const float* kkp = INP(16) + l * RW; const float* kap = INP(17) + l * RW; const float* rkp = INP(18) + l * RW; const float* v0p = INP(14);
            const bf16* wupT = WUPT + (size_t)l * RW * DL; const bf16* aupT = AUPT + (size_t)l * RW * AL; const bf16* gupT = GUPT + (size_t)l * RW * GL; const bf16* vupT = VUPT;
            bf16* Vl = l == 0 ? V0 : V1;
            const int r32 = lane & 31, hh = lane >> 5, h = wave;
            for (int tile = bx; tile < T / 32; tile += G) {
                const int t0 = tile * 32;
                __syncthreads();
#pragma unroll 1
                for (int it0 = 0; it0 < 3; it0 += 2) {
                  u32x4 cu_[2], pv_[2]; f32x4 m0_[2], m1_[2];
#pragma unroll
                  for (int it = 0; it < 2; ++it) { const int c8 = tid + (it0 + it) * NTHR; const bool ok = c8 < 32 * 36; const int tok = ok ? c8 / 36 : 0, jc = ok ? c8 % 36 : 0, t = t0 + tok, sq = t % SEQ;
                      cu_[it] = (u32x4){0u, 0u, 0u, 0u}; pv_[it] = (u32x4){0u, 0u, 0u, 0u}; m0_[it] = (f32x4){0.f, 0.f, 0.f, 0.f}; m1_[it] = m0_[it];
                      if (ok && (jc < 32 || l > 0)) { const int col = jc < 32 ? 3 * RW + jc * 8 : IN_COLS + (jc - 32) * 8;
                          cu_[it] = *(const u32x4*)(PROJ + (size_t)t * LDP + col); if (sq > 0) pv_[it] = *(const u32x4*)(PROJ + (size_t)(t - 1) * LDP + col);
                          const float* mp = jc < 32 ? mu + col : vmu + (jc - 32) * 8; m0_[it] = *(const f32x4*)mp; m1_[it] = *(const f32x4*)(mp + 4); } }
#pragma unroll
                  for (int it = 0; it < 2; ++it) { const int c8 = tid + (it0 + it) * NTHR; if (c8 < 32 * 36) { const int tok = c8 / 36, jc = c8 % 36;
                      u32x4 o = {0u, 0u, 0u, 0u};
                      if (jc < 32 || l > 0) {
                          float x[8]; const unsigned cw[4] = {cu_[it].x, cu_[it].y, cu_[it].z, cu_[it].w}, pw[4] = {pv_[it].x, pv_[it].y, pv_[it].z, pv_[it].w}; const float mm[8] = {m0_[it].x, m0_[it].y, m0_[it].z, m0_[it].w, m1_[it].x, m1_[it].y, m1_[it].z, m1_[it].w};
#pragma unroll
                          for (int i = 0; i < 4; ++i) { const float c0 = __uint_as_float(cw[i] << 16), c1 = __uint_as_float(cw[i] & 0xffff0000u), p0 = __uint_as_float(pw[i] << 16), p1 = __uint_as_float(pw[i] & 0xffff0000u);
                              x[2 * i] = c0 + (p0 - c0) * mm[2 * i]; x[2 * i + 1] = c1 + (p1 - c1) * mm[2 * i + 1]; }
                          if (jc < 8) {
#pragma unroll
                              for (int i = 0; i < 8; ++i) { const float e2 = __expf(-2.f * fabsf(x[i])); const float th = (1.f - e2) * __builtin_amdgcn_rcpf(1.f + e2); x[i] = x[i] < 0.f ? -th : th; } }
                          else if (jc >= 16 && jc < 32) {
#pragma unroll
                              for (int i = 0; i < 8; ++i) x[i] = __builtin_amdgcn_rcpf(1.f + __expf(-x[i])); }
                          o.x = pk2(x[0], x[1]); o.y = pk2(x[2], x[3]); o.z = pk2(x[4], x[5]); o.w = pk2(x[6], x[7]);
                      }
                      *(LAS u32x4*)(lin + tok * LST + jc * 8) = o; } } }
                __syncthreads();
                const bool first = (t0 % SEQ) == 0;
                lbf16* tin = (lbf16*)(lds + 19456 + wave * 14336);
                { u32x4 iq[13]; int ql_; asm volatile("v_mbcnt_lo_u32_b32 %0, -1, 0\n\tv_mbcnt_hi_u32_b32 %0, -1, %0" : "=v"(ql_));
#pragma unroll
                  for (int i = 0; i < 13; ++i) { const int q = ql_ + 64 * i; iq[i] = (u32x4){0u, 0u, 0u, 0u};
                      if (q < 792) { const int arr = q / 264, rem = q - arr * 264, row = rem >> 3, cc = rem & 7;
                          if (!(first && row == 0)) iq[i] = *(const u32x4*)(PROJ + (size_t)(t0 - 1 + row) * LDP + arr * RW + h * HS + cc * 8); } }
#pragma unroll
                  for (int i = 0; i < 13; ++i) { const int q = ql_ + 64 * i; if (q < 792) { const int arr = q / 264, rem = q - arr * 264, row = rem >> 3, cc = rem & 7;
                      *(__attribute__((address_space(3))) u32x4*)(tin + arr * 2376 + row * 72 + cc * 8) = iq[i]; } } }
                __builtin_amdgcn_wave_barrier(); asm volatile("s_waitcnt lgkmcnt(0)" ::: "memory");
                float ssq[16], bsm[16];
#pragma unroll
                for (int e = 0; e < 16; ++e) { ssq[e] = 0.f; bsm[e] = 0.f; }
#pragma unroll 1
                for (int rt = 0; rt < 2; ++rt) {
                    f32x16 accW, accA, accG, accV;
#pragma unroll
                    for (int e = 0; e < 16; ++e) { accW[e] = 0.f; accA[e] = 0.f; accG[e] = 0.f; accV[e] = 0.f; }
                    int c = h * HS + rt * 32 + r32;
int hh8 = 8 * hh; asm volatile("" : "+v"(c), "+v"(hh8));
                    const LAS bf16* lrow = lin + r32 * LST + 8 * hh;
                    { bf16x8_t wf[18];
#pragma unroll
                      for (int ks = 0; ks < 4; ++ks) { wf[ks] = *(const bf16x8_t*)(wupT + (size_t)c * DL + ks * 16 + hh8); wf[4 + ks] = *(const bf16x8_t*)(aupT + (size_t)c * AL + ks * 16 + hh8); }
#pragma unroll
                      for (int ks = 0; ks < 8; ++ks) wf[8 + ks] = *(const bf16x8_t*)(gupT + (size_t)c * GL + ks * 16 + hh8);
                      wf[16] = bf16x8_t{}; wf[17] = bf16x8_t{};
                      if (l > 0) { wf[16] = *(const bf16x8_t*)(vupT + (size_t)c * MVL + hh8); wf[17] = *(const bf16x8_t*)(vupT + (size_t)c * MVL + 16 + hh8); }
#pragma unroll
                      for (int ks = 0; ks < 4; ++ks) { accW = __builtin_amdgcn_mfma_f32_32x32x16_bf16(*(const LAS bf16x8_t*)(lrow + ks * 16), wf[ks], accW, 0, 0, 0);
                                                       accA = __builtin_amdgcn_mfma_f32_32x32x16_bf16(*(const LAS bf16x8_t*)(lrow + 64 + ks * 16), wf[4 + ks], accA, 0, 0, 0); }
#pragma unroll
                      for (int ks = 0; ks < 8; ++ks) accG = __builtin_amdgcn_mfma_f32_32x32x16_bf16(*(const LAS bf16x8_t*)(lrow + 128 + ks * 16), wf[8 + ks], accG, 0, 0, 0);
                      if (l > 0) {
#pragma unroll
                          for (int ks = 0; ks < 2; ++ks) accV = __builtin_amdgcn_mfma_f32_32x32x16_bf16(*(const LAS bf16x8_t*)(lrow + 256 + ks * 16), wf[16 + ks], accV, 0, 0, 0); } }
                    const float mur = mu[c], muk = mu[RW + c], muv = mu[2 * RW + c], w0c = w0p[c], a0c = a0p[c], kkc = kkp[c], kac = kap[c], rkc = rkp[c];
                    const float v0c = l > 0 ? v0p[c] : 0.f;
#pragma unroll
                    for (int eb = 0; eb < 16; eb += 4) {
                        bf16 lr[4], lk[4], lv[4], lrp[4], lkp[4], lvp[4], lvf[4];
#pragma unroll
                        for (int i = 0; i < 4; ++i) { const int e = eb + i; const int tok = (e & 3) + 8 * (e >> 2) + 4 * hh, t = t0 + tok; const int ci = rt * 32 + r32;
                            lr[i] = tin[(tok + 1) * 72 + ci]; lk[i] = tin[2376 + (tok + 1) * 72 + ci]; lv[i] = tin[2 * 2376 + (tok + 1) * 72 + ci];
                            lrp[i] = tin[tok * 72 + ci]; lkp[i] = tin[2376 + tok * 72 + ci]; lvp[i] = tin[2 * 2376 + tok * 72 + ci];
                            lvf[i] = l > 0 ? V0[(size_t)t * RW + c] : (bf16)0; }
                        __builtin_amdgcn_sched_barrier(0);
#pragma unroll
                        for (int i = 0; i < 4; ++i) { const int e = eb + i; const int tok = (e & 3) + 8 * (e >> 2) + 4 * hh, t = t0 + tok; const size_t o = (size_t)t * RW + c;
                            float r = bf2f(lr[i]), k = bf2f(lk[i]), v = bf2f(lv[i]);
                            r += (bf2f(lrp[i]) - r) * mur; k += (bf2f(lkp[i]) - k) * muk; v += (bf2f(lvp[i]) - v) * muv;
                            const float z = -(w0c + accW[e]); const float sp = fmaxf(z, 0.f) + __logf(1.f + __expf(-fabsf(z)));
                            const float decay = __expf(-__expf(-sp - 0.5f));
                            const float a = __builtin_amdgcn_rcpf(1.f + __expf(-(a0c + accA[e]))); const float g = accG[e];
                            if (l > 0) { const float vfv = bf2f(lvf[i]); v = v + (vfv - v) * __builtin_amdgcn_rcpf(1.f + __expf(-(v0c + accV[e]))); }
                            const float kk = k * kkc; const float k2 = k * (1.f + (a - 1.f) * kac);
                            ssq[e] += kk * kk; bsm[e] += r * k2 * rkc;
                            { const unsigned p0_ = cvtpk(r, k2), p1_ = cvtpk(v, kk), p2_ = cvtpk(kk * a, g), p3_ = cvtpk(v * g, 0.f);
                              Rb[o] = (bf16)p0_; Kb[o] = (bf16)(p0_ >> 16); Vl[o] = (bf16)p1_; KKb[o] = (bf16)(p1_ >> 16); Bb[o] = (bf16)p2_; Gb[o] = (bf16)(p2_ >> 16); BGb[o] = (bf16)p3_; Wd[o] = decay; }
                        }
                    }
                }
#pragma unroll
                for (int e = 0; e < 16; ++e) { const int ln_ = r32 | (hh << 5); float a_ = red16(ssq[e]), b_ = red16(bsm[e]); a_ += shflx(a_, ln_, 16); b_ += shflx(b_, ln_, 16); ssq[e] = a_; bsm[e] = b_; }
                if (r32 == 0) {
#pragma unroll
                    for (int e = 0; e < 16; ++e) { const int tok = (e & 3) + 8 * (e >> 2) + 4 * hh; INVN[(size_t)(t0 + tok) * NH + h] = rsqrtf(fmaxf(ssq[e], 1e-24f)); BSUM[(size_t)(t0 + tok) * NH + h] = bsm[e]; } }
            }
        }
        SEAM(pb + 2);

        if (IN(pb + 3)) { PHASE_IDS
            const bf16* Vl = l == 0 ? V0 : V1;
            const int r32 = lane & 31, hh = lane >> 5;
            if (wave < 6) {
                lbf16* At = (lbf16*)(lds + wave * 23552); lbf16* Bt = At + 2304; lbf16* Kt = Bt + 2304; lbf16* Rt = Kt + 2304; lbf16* Vv = Rt + 2304;
                LAS float* PCs = (LAS float*)(lds + wave * 23552 + 23040);
                for (int item = bx * 6 + wave; item < BATCH * NH * (SEQ / 32); item += G * 6) {
                    const int bh = item >> 7, chunk = item & 127, b = bh >> 3, h = bh & 7; const size_t t0 = (size_t)b * SEQ + chunk * 32;
                    __builtin_amdgcn_wave_barrier(); asm volatile("s_waitcnt lgkmcnt(0)" ::: "memory");
                    {
                      const int tk = lane >> 3, part = lane & 7;
                      u32x4 qr[4], qk[4], qv[4], qkk[4], qb[4]; f32x4 qw0[4], qw1[4]; float qin[4];
#pragma unroll
                      for (int p4 = 0; p4 < 4; ++p4) { const size_t o = (t0 + p4 * 8 + tk) * RW + h * HS + part * 8;
                          qr[p4] = *(const u32x4*)(Rb + o); qk[p4] = *(const u32x4*)(Kb + o); qv[p4] = *(const u32x4*)(Vl + o); qkk[p4] = *(const u32x4*)(KKb + o); qb[p4] = *(const u32x4*)(Bb + o);
                          qw0[p4] = *(const f32x4*)(Wd + o); qw1[p4] = *(const f32x4*)(Wd + o + 4); qin[p4] = INVN[(t0 + p4 * 8 + tk) * NH + h]; }
                      LAS float* Pl = (LAS float*)At;
#pragma unroll
                      for (int p4 = 0; p4 < 4; ++p4) { *(LAS f32x4*)(Pl + (p4 * 8 + tk) * 64 + part * 8) = qw0[p4]; *(LAS f32x4*)(Pl + (p4 * 8 + tk) * 64 + part * 8 + 4) = qw1[p4]; }
                      __builtin_amdgcn_wave_barrier(); asm volatile("s_waitcnt lgkmcnt(0)" ::: "memory");
                      { float P = 1.f;
#pragma unroll 8
                        for (int c = 0; c < 32; ++c) { P *= Pl[c * 64 + lane]; Pl[c * 64 + lane] = P; }
                        PCs[lane] = P; }
                      __builtin_amdgcn_wave_barrier(); asm volatile("s_waitcnt lgkmcnt(0)" ::: "memory");
                      u32x4 oa[4], orr[4], ob_[4], ok_[4];
#pragma unroll
                      for (int p4 = 0; p4 < 4; ++p4) { const int c = p4 * 8 + tk;
                          const f32x4 pa = *(const LAS f32x4*)(Pl + c * 64 + part * 8), pb2 = *(const LAS f32x4*)(Pl + c * 64 + part * 8 + 4);
                          f32x4 ma = {1.f, 1.f, 1.f, 1.f}, mb = ma; if (c > 0) { ma = *(const LAS f32x4*)(Pl + (c - 1) * 64 + part * 8); mb = *(const LAS f32x4*)(Pl + (c - 1) * 64 + part * 8 + 4); }
                          const float Pc[8] = {pa.x, pa.y, pa.z, pa.w, pb2.x, pb2.y, pb2.z, pb2.w}, Pm[8] = {ma.x, ma.y, ma.z, ma.w, mb.x, mb.y, mb.z, mb.w};
                          const unsigned rw_[4] = {qr[p4].x, qr[p4].y, qr[p4].z, qr[p4].w}, kw_[4] = {qk[p4].x, qk[p4].y, qk[p4].z, qk[p4].w}, kkw[4] = {qkk[p4].x, qkk[p4].y, qkk[p4].z, qkk[p4].w}, bw_[4] = {qb[p4].x, qb[p4].y, qb[p4].z, qb[p4].w};
                          unsigned xa[4], xr[4], xb[4], xk[4]; const float inv = qin[p4];
#pragma unroll
                          for (int i = 0; i < 4; ++i) { const float ip0 = __builtin_amdgcn_rcpf(Pc[2 * i]), ip1 = __builtin_amdgcn_rcpf(Pc[2 * i + 1]);
                              xa[i] = pk2(-__uint_as_float(kkw[i] << 16) * inv * Pm[2 * i], -__uint_as_float(kkw[i] & 0xffff0000u) * inv * Pm[2 * i + 1]);
                              xr[i] = pk2(__uint_as_float(rw_[i] << 16) * Pc[2 * i], __uint_as_float(rw_[i] & 0xffff0000u) * Pc[2 * i + 1]);
                              xb[i] = pk2(__uint_as_float(bw_[i] << 16) * inv * ip0, __uint_as_float(bw_[i] & 0xffff0000u) * inv * ip1);
                              xk[i] = pk2(__uint_as_float(kw_[i] << 16) * ip0, __uint_as_float(kw_[i] & 0xffff0000u) * ip1); }
                          oa[p4] = (u32x4){xa[0], xa[1], xa[2], xa[3]}; orr[p4] = (u32x4){xr[0], xr[1], xr[2], xr[3]}; ob_[p4] = (u32x4){xb[0], xb[1], xb[2], xb[3]}; ok_[p4] = (u32x4){xk[0], xk[1], xk[2], xk[3]}; }
                      __builtin_amdgcn_wave_barrier(); asm volatile("s_waitcnt lgkmcnt(0)" ::: "memory");
#pragma unroll
                      for (int p4 = 0; p4 < 4; ++p4) { const int c = p4 * 8 + tk, o = c * 72 + part * 8;
                          *(__attribute__((address_space(3))) u32x4*)(At + o) = oa[p4]; *(__attribute__((address_space(3))) u32x4*)(Rt + o) = orr[p4]; *(__attribute__((address_space(3))) u32x4*)(Bt + o) = ob_[p4];
                          *(__attribute__((address_space(3))) u32x4*)(Kt + o) = ok_[p4]; *(__attribute__((address_space(3))) u32x4*)(Vv + o) = qv[p4]; } }
                    __builtin_amdgcn_wave_barrier(); asm volatile("s_waitcnt lgkmcnt(0)" ::: "memory");
                    const f32x16 zero16 = {0.f, 0.f, 0.f, 0.f, 0.f, 0.f, 0.f, 0.f, 0.f, 0.f, 0.f, 0.f, 0.f, 0.f, 0.f, 0.f};
                    f32x16 X = zero16, Yt = zero16;
#pragma unroll
                    for (int ks = 0; ks < 4; ++ks) { const bf16x8_t fa = ldrow(At, r32, ks, hh), fb = ldrow(Bt, r32, ks, hh); X = mm32(fa, fb, X); Yt = mm32(fb, fa, Yt); }
#pragma unroll
                    for (int e = 0; e < 16; ++e) { const int ri = rowidx(e, hh); X[e] = (r32 < ri) ? X[e] : 0.f; Yt[e] = (ri < r32) ? Yt[e] : 0.f; }
                    f32x16 TY = Yt;
#pragma unroll
                    for (int e = 0; e < 16; ++e) TY[e] += (rowidx(e, hh) == r32) ? 1.f : 0.f;
#pragma unroll 1
                    for (int it = 0; it < 4; ++it) {
                        const bf16x8_t x0 = accop<0>(X), x1 = accop<1>(X), y0 = accop<0>(Yt), y1 = accop<1>(Yt);
                        f32x16 Xn = mm32(y0, x0, zero16); Xn = mm32(y1, x1, Xn);
                        f32x16 Yn = mm32(x0, y0, zero16); Yn = mm32(x1, y1, Yn);
                        X = Xn; Yt = Yn;
                        const bf16x8_t p0 = accop<0>(X), p1 = accop<1>(X), t0_ = accop<0>(TY), t1_ = accop<1>(TY);
                        TY = mm32(p0, t0_, TY); TY = mm32(p1, t1_, TY);
                    }
                    const bf16x8_t ty0 = accop<0>(TY), ty1 = accop<1>(TY);
                    unsigned char* rec = SCN + (size_t)item * 24576;
                    const bf16x8_t v00 = ldpermcol<0>(Vv, r32, hh), v01 = ldpermcol<1>(Vv, r32, hh), v10 = ldpermcol<0>(Vv, 32 + r32, hh), v11 = ldpermcol<1>(Vv, 32 + r32, hh);
                    f32x16 U0a, U0b;
                    { f32x16 G2T = zero16;
#pragma unroll
                      for (int ks = 0; ks < 4; ++ks) G2T = mm32(ldrow(Kt, r32, ks, hh), ldrow(At, r32, ks, hh), G2T);
#pragma unroll
                      for (int e = 0; e < 16; ++e) G2T[e] = (rowidx(e, hh) < r32) ? G2T[e] : 0.f;
                      const bf16x8_t g0 = accop<0>(G2T), g1 = accop<1>(G2T);
                      f32x16 Za = mm32(g0, v00, zero16); Za = mm32(g1, v01, Za); f32x16 Zb = mm32(g0, v10, zero16); Zb = mm32(g1, v11, Zb);
                      U0a = mm32(ty0, accop<0>(Za), zero16); U0a = mm32(ty1, accop<1>(Za), U0a); U0b = mm32(ty0, accop<0>(Zb), zero16); U0b = mm32(ty1, accop<1>(Zb), U0b); }
                    const bf16x8_t ua0 = accop<0>(U0a), ua1 = accop<1>(U0a), ub0 = accop<0>(U0b), ub1 = accop<1>(U0b);
                    f32x16 G3T = zero16;
                    { f32x16 G4T = zero16;
#pragma unroll
                      for (int ks = 0; ks < 4; ++ks) { const bf16x8_t fr = ldrow(Rt, r32, ks, hh); G3T = mm32(ldrow(Bt, r32, ks, hh), fr, G3T); G4T = mm32(ldrow(Kt, r32, ks, hh), fr, G4T); }
#pragma unroll
                      for (int e = 0; e < 16; ++e) { const bool keep = rowidx(e, hh) <= r32; G3T[e] = keep ? G3T[e] : 0.f; G4T[e] = keep ? G4T[e] : 0.f; }
                      const bf16x8_t g30 = accop<0>(G3T), g31 = accop<1>(G3T), g40 = accop<0>(G4T), g41 = accop<1>(G4T);
                      f32x16 Ya = mm32(g30, ua0, zero16); Ya = mm32(g31, ua1, Ya); Ya = mm32(g40, v00, Ya); Ya = mm32(g41, v01, Ya);
                      f32x16 Yb = mm32(g30, ub0, zero16); Yb = mm32(g31, ub1, Yb); Yb = mm32(g40, v10, Yb); Yb = mm32(g41, v11, Yb);
                      u32x4 o0, o1;
                      o0.x = cvtpk(Ya[0], Ya[1]); o0.y = cvtpk(Ya[2], Ya[3]); o0.z = cvtpk(Ya[4], Ya[5]); o0.w = cvtpk(Ya[6], Ya[7]);
                      o1.x = cvtpk(Ya[8], Ya[9]); o1.y = cvtpk(Ya[10], Ya[11]); o1.z = cvtpk(Ya[12], Ya[13]); o1.w = cvtpk(Ya[14], Ya[15]);
                      *(u32x4*)(rec + 12288 + 4096 + lane * 32) = o0; *(u32x4*)(rec + 12288 + 4096 + lane * 32 + 16) = o1;
                      o0.x = cvtpk(Yb[0], Yb[1]); o0.y = cvtpk(Yb[2], Yb[3]); o0.z = cvtpk(Yb[4], Yb[5]); o0.w = cvtpk(Yb[6], Yb[7]);
                      o1.x = cvtpk(Yb[8], Yb[9]); o1.y = cvtpk(Yb[10], Yb[11]); o1.z = cvtpk(Yb[12], Yb[13]); o1.w = cvtpk(Yb[14], Yb[15]);
                      *(u32x4*)(rec + 12288 + 6144 + 4096 + lane * 32) = o0; *(u32x4*)(rec + 12288 + 6144 + 4096 + lane * 32 + 16) = o1; }
                    f32x16 Wa0 = mm32(ty0, ldpermcol<0>(At, r32, hh), zero16); Wa0 = mm32(ty1, ldpermcol<1>(At, r32, hh), Wa0);
                    f32x16 Wa1 = mm32(ty0, ldpermcol<0>(At, 32 + r32, hh), zero16); Wa1 = mm32(ty1, ldpermcol<1>(At, 32 + r32, hh), Wa1);
                    const bf16x8_t wa00 = accop<0>(Wa0), wa01 = accop<1>(Wa0), wa10 = accop<0>(Wa1), wa11 = accop<1>(Wa1);
                    { const bf16x8_t g30 = accop<0>(G3T), g31 = accop<1>(G3T);
                      f32x16 Ra = mm32(wa00, g30, zero16); Ra = mm32(wa01, g31, Ra); f32x16 Rb_ = mm32(wa10, g30, zero16); Rb_ = mm32(wa11, g31, Rb_);
#pragma unroll
                      for (int e = 0; e < 16; ++e) { const int kr = rowidx(e, hh); Ra[e] += bf2f(Rt[r32 * 72 + kr]); Rb_[e] += bf2f(Rt[r32 * 72 + 32 + kr]); }
                      *(bf16x8_t*)(rec + 8192 + 0 * 1024 + lane * 16) = accop<0>(Ra); *(bf16x8_t*)(rec + 8192 + 1 * 1024 + lane * 16) = accop<1>(Ra);
                      *(bf16x8_t*)(rec + 8192 + 2 * 1024 + lane * 16) = accop<0>(Rb_); *(bf16x8_t*)(rec + 8192 + 3 * 1024 + lane * 16) = accop<1>(Rb_); }
                    const bf16x8_t b00 = ldpermcol<0>(Bt, r32, hh), b01 = ldpermcol<1>(Bt, r32, hh), b10 = ldpermcol<0>(Bt, 32 + r32, hh), b11 = ldpermcol<1>(Bt, 32 + r32, hh);
                    { const float pc0 = PCs[r32], pc1 = PCs[32 + r32];
#pragma unroll
                      for (int ij = 0; ij < 4; ++ij) { const int i = ij >> 1, j = ij & 1;
                          f32x16 M = mm32(i ? wa10 : wa00, j ? b10 : b00, zero16); M = mm32(i ? wa11 : wa01, j ? b11 : b01, M);
#pragma unroll
                          for (int e = 0; e < 16; ++e) { float m = M[e]; if (i == j) m += (rowidx(e, hh) == r32) ? 1.f : 0.f; M[e] = m * (j ? pc1 : pc0); }
                          *(bf16x8_t*)(rec + (ij * 2 + 0) * 1024 + lane * 16) = accop<0>(M); *(bf16x8_t*)(rec + (ij * 2 + 1) * 1024 + lane * 16) = accop<1>(M); } }
                    { const bf16x8_t k00 = ldpermcol<0>(Kt, r32, hh), k01 = ldpermcol<1>(Kt, r32, hh), k10 = ldpermcol<0>(Kt, 32 + r32, hh), k11 = ldpermcol<1>(Kt, 32 + r32, hh);
#pragma unroll
                      for (int ju = 0; ju < 4; ++ju) { const int j = ju >> 1, u = ju & 1;
                          f32x16 Dm = mm32(j ? b10 : b00, u ? ub0 : ua0, zero16); Dm = mm32(j ? b11 : b01, u ? ub1 : ua1, Dm);
                          Dm = mm32(j ? k10 : k00, u ? v10 : v00, Dm); Dm = mm32(j ? k11 : k01, u ? v11 : v01, Dm);
#pragma unroll
                          for (int e = 0; e < 16; ++e) Dm[e] *= PCs[32 * j + rowidx(e, hh)];
                          u32x4 o0, o1;
                          o0.x = cvtpk(Dm[0], Dm[1]); o0.y = cvtpk(Dm[2], Dm[3]); o0.z = cvtpk(Dm[4], Dm[5]); o0.w = cvtpk(Dm[6], Dm[7]);
                          o1.x = cvtpk(Dm[8], Dm[9]); o1.y = cvtpk(Dm[10], Dm[11]); o1.z = cvtpk(Dm[12], Dm[13]); o1.w = cvtpk(Dm[14], Dm[15]);
                          *(u32x4*)(rec + 12288 + u * 6144 + j * 2048 + lane * 32) = o0; *(u32x4*)(rec + 12288 + u * 6144 + j * 2048 + lane * 32 + 16) = o1; } }
                }
            }
        }
        { XcdBarrier xb_ = xbar; asm volatile("" : "+s"(xb_.bar)); xcd_barrier<false>(xb_); }
        if (IN(pb + 3)) { PHASE_IDS
            const int r32 = lane & 31, hh = lane >> 5;
            constexpr int SLOT = 18432, NCH = SEQ / 32, NSL = 7, AHEAD = 6;
            const bool spare = G > BATCH * NH * 2; const int cw = spare ? bx - BATCH * NH * 2 : bx, cn = spare ? G - BATCH * NH * 2 : G;
            if (cw >= 0) {
                convert_tables_fp6(INP(27), INP(28), U8, V8, USc, VSc, l, cw * NWAVES + wave, cn * NWAVES, lane);
            {
                constexpr int DST = 520;
                int lane_p; asm volatile("v_mbcnt_lo_u32_b32 %0, -1, 0\n\tv_mbcnt_hi_u32_b32 %0, -1, %0" : "=v"(lane_p)); const int r32 = lane_p & 31, hh = lane_p >> 5, tidp = wave0 * 64 + lane_p;
                lbf16* dlb = (lbf16*)lds;
                lbf16* pin = (lbf16*)(lds + 33280);
                const int c = tidp, g = c >> 7, win = 2 << g;
                const bf16* pwt = PWT + (size_t)(l * 4 + (wave >> 1)) * PG * PG; const float* psc = INP(22) + l * PW;
                for (int tile = cw; tile < T / 32; tile += cn) {
                    const int t0 = tile * 32; const bool first = (t0 % SEQ) == 0;
                    __syncthreads();
                    { u32x4 pq[6];
#pragma unroll
                      for (int q = 0; q < 6; ++q) { const int ch = tidp + q * NTHR, row = ch >> 6, cc = ch & 63; pq[q] = (u32x4){0u, 0u, 0u, 0u};
                          if (ch < 47 * 64 && (row >= 15 || !first)) pq[q] = *(const u32x4*)(POOLIN + (size_t)(t0 - 15 + row) * PW + cc * 8); }
#pragma unroll
                      for (int q = 0; q < 6; ++q) { const int ch = tidp + q * NTHR, row = ch >> 6, cc = ch & 63; if (ch < 47 * 64) *(__attribute__((address_space(3))) u32x4*)(pin + row * 520 + cc * 8) = pq[q]; } }
                    __syncthreads();
                    const lbf16* pc = pin + c;
                    float sw = 0.f;
#pragma unroll
                    for (int j = 1; j <= 15; ++j) sw += (j < win) ? bf2f(pc[(15 - j) * 520]) : 0.f;
                    const float invw = 1.f / (float)win;
#pragma unroll 8
                    for (int i = 0; i < 32; ++i) {
                        const float cur = bf2f(pc[(15 + i) * 520]);
                        sw += cur;
                        const float inv = (first && i < 15) ? 1.f / (float)min(i + 1, win) : invw;
                        dlb[i * DST + c] = f2bf(sw * inv - cur);
                        sw -= bf2f(pc[(15 + i - win + 1) * 520]);
                    }
                    __syncthreads();
                    const int gg = wave >> 1, half = wave & 1;
#pragma unroll
                    for (int ct = 0; ct < 2; ++ct) {
                        const int dd0 = half * 64 + ct * 32;
                        f32x16 acc;
#pragma unroll
                        for (int e = 0; e < 16; ++e) acc[e] = 0.f;
#pragma unroll
                        for (int ks = 0; ks < 8; ++ks) { const bf16x8_t a = *(const __attribute__((address_space(3))) bf16x8_t*)(dlb + r32 * DST + gg * PG + ks * 16 + 8 * hh);
                            const bf16x8_t w = *(const bf16x8_t*)(pwt + (size_t)(dd0 + r32) * PG + ks * 16 + 8 * hh); acc = mm32(a, w, acc); }
                        const int oc = gg * PG + dd0 + r32; const float ps = psc[oc];
#pragma unroll
                        for (int e = 0; e < 16; ++e) MIX[(size_t)(t0 + rowidx(e, hh)) * D + RW + oc] = f2bf(acc[e] * ps);
                    }
                }
            }
            }
            for (int un = bx; un < BATCH * NH * 2; un += G) {
                const int bh = un >> 1, u = un & 1, b = bh >> 3, h = bh & 7;
                __syncthreads();
                const unsigned char* recs = SCN + (size_t)bh * NCH * 24576;
                const int lw = wave - 2;
#define S2_DMA(chunk_) do { if (wave >= 2) { LAS unsigned char* sl = lds + ((chunk_) % NSL) * SLOT; const unsigned char* rp = recs + (size_t)(chunk_) * 24576 + lane * 16; \
                    _Pragma("unroll") for (int q_ = 0; q_ < 3; ++q_) { const int p_ = lw * 3 + q_; const int so_ = p_ < 12 ? p_ * 1024 : 12288 + u * 6144 + (p_ - 12) * 1024; \
                        __builtin_amdgcn_global_load_lds((const unsigned*)(rp + so_), (LAS unsigned*)(sl + p_ * 1024), 16, 0, 0); } } } while (0)
#pragma unroll 1
                for (int c0 = 0; c0 < AHEAD; ++c0) S2_DMA(c0);
                asm volatile("s_waitcnt vmcnt(15)" ::: "memory");
                __builtin_amdgcn_s_barrier();
                f32x16 X0, X1;
                { float z_ = 0.f; asm volatile("" : "+v"(z_));
#pragma unroll
                for (int e = 0; e < 16; ++e) { X0[e] = z_; X1[e] = z_; } }
#define S2_FRAG(off) (*(const __attribute__((address_space(3))) bf16x8_t*)(sl + (off) + lane * 16))
#define S2_UNPK(dst, off) do { const u32x4 a0 = *(const LAS u32x4*)(sl + (off) + lane * 32), a1 = *(const LAS u32x4*)(sl + (off) + lane * 32 + 16); const unsigned wv[8] = {a0.x, a0.y, a0.z, a0.w, a1.x, a1.y, a1.z, a1.w}; \
                    _Pragma("unroll") for (int q = 0; q < 8; ++q) { (dst)[2 * q] = __uint_as_float(wv[q] << 16); (dst)[2 * q + 1] = __uint_as_float(wv[q] & 0xffff0000u); } } while (0)
#pragma unroll 1
                for (int n = 0; n < NCH; ++n) {
                    if (n + AHEAD < NCH) S2_DMA(n + AHEAD);
                    if (wave == 0) {
                        const LAS unsigned char* sl = lds + (n % NSL) * SLOT;
                        const bf16x8_t x00 = accop<0>(X0), x01 = accop<1>(X0), x10 = accop<0>(X1), x11 = accop<1>(X1);
                        f32x16 Yc, N0, N1;
                        S2_UNPK(Yc, 12288 + 4096); S2_UNPK(N0, 12288); S2_UNPK(N1, 12288 + 2048);
                        Yc = mm32(S2_FRAG(8192 + 0 * 1024), x00, Yc); Yc = mm32(S2_FRAG(8192 + 1 * 1024), x01, Yc); Yc = mm32(S2_FRAG(8192 + 2 * 1024), x10, Yc); Yc = mm32(S2_FRAG(8192 + 3 * 1024), x11, Yc);
                        N0 = mm32(S2_FRAG((0 * 2 + 0) * 1024), x00, N0); N0 = mm32(S2_FRAG((0 * 2 + 1) * 1024), x01, N0); N0 = mm32(S2_FRAG((2 * 2 + 0) * 1024), x10, N0); N0 = mm32(S2_FRAG((2 * 2 + 1) * 1024), x11, N0);
                        N1 = mm32(S2_FRAG((1 * 2 + 0) * 1024), x00, N1); N1 = mm32(S2_FRAG((1 * 2 + 1) * 1024), x01, N1); N1 = mm32(S2_FRAG((3 * 2 + 0) * 1024), x10, N1); N1 = mm32(S2_FRAG((3 * 2 + 1) * 1024), x11, N1);
                        X0 = N0; X1 = N1;
                        float* yp = Y + ((size_t)b * SEQ + (size_t)n * 32) * RW + h * HS + u * 32 + r32;
#pragma unroll
                        for (int e = 0; e < 16; ++e) yp[(size_t)rowidx(e, hh) * RW] = Yc[e];
                        asm volatile("s_waitcnt lgkmcnt(0)" ::: "memory");
                    } else if (wave >= 2) {
                        const int younger = (NCH - 1 - (n + 1)) < (AHEAD - 1) ? (NCH - 1 - (n + 1)) : (AHEAD - 1);
                        if (younger >= 5) asm volatile("s_waitcnt vmcnt(15)" ::: "memory"); else if (younger == 4) asm volatile("s_waitcnt vmcnt(12)" ::: "memory"); else if (younger == 3) asm volatile("s_waitcnt vmcnt(9)" ::: "memory");
                        else if (younger == 2) asm volatile("s_waitcnt vmcnt(6)" ::: "memory"); else if (younger == 1) asm volatile("s_waitcnt vmcnt(3)" ::: "memory"); else asm volatile("s_waitcnt vmcnt(0)" ::: "memory");
                    }
                    __builtin_amdgcn_s_barrier();
                }
#undef S2_FRAG
#undef S2_UNPK
#undef S2_DMA
            }
        }
        SEAM(pb + 3);

        if (IN(pb + 4)) { PHASE_IDS
            const int c8 = (tid & 63) * 8, hd = (tid & 63) >> 3, tsub = tid >> 6;
            const f32x4 lg0 = *(const f32x4*)(INP(19) + l * RW + c8), lg1 = *(const f32x4*)(INP(19) + l * RW + c8 + 4), lb0 = *(const f32x4*)(INP(20) + l * RW + c8), lb1 = *(const f32x4*)(INP(20) + l * RW + c8 + 4);
            for (int tile = bx; tile < T / 8; tile += G) {
                const int t = tile * 8 + tsub; const size_t o = (size_t)t * RW + c8;
                const f32x4 y0 = *(const f32x4*)(Y + o), y1 = *(const f32x4*)(Y + o + 4); const u32x4 gq = *(const u32x4*)(Gb + o), vq = *(const u32x4*)(BGb + o); const float bsum = BSUM[(size_t)t * NH + hd];
                float sm = (y0.x + y0.y) + (y0.z + y0.w) + (y1.x + y1.y) + (y1.z + y1.w);
                sm += dppf<0xB1>(sm); sm += dppf<0x4E>(sm); sm += dppf<0x141>(sm);
                const float mean = sm * (1.f / 64.f);
                const f32x4 d0 = y0 - mean, d1 = y1 - mean;
                float sq = (d0.x * d0.x + d0.y * d0.y) + (d0.z * d0.z + d0.w * d0.w) + (d1.x * d1.x + d1.y * d1.y) + (d1.z * d1.z + d1.w * d1.w);
                sq += dppf<0xB1>(sq); sq += dppf<0x4E>(sq); sq += dppf<0x141>(sq);
                const float rs = rsqrtf(sq * (1.f / 64.f) + GN_EPS);
                const f32x4 n0 = d0 * rs * lg0 + lb0, n1 = d1 * rs * lg1 + lb1;
                const unsigned gw_[4] = {gq.x, gq.y, gq.z, gq.w}, vw_[4] = {vq.x, vq.y, vq.z, vq.w}; const float nn[8] = {n0.x, n0.y, n0.z, n0.w, n1.x, n1.y, n1.z, n1.w}; unsigned ow[4];
#pragma unroll
                for (int i = 0; i < 4; ++i) { const float g0 = __uint_as_float(gw_[i] << 16), g1 = __uint_as_float(gw_[i] & 0xffff0000u), v0 = __uint_as_float(vw_[i] << 16), v1 = __uint_as_float(vw_[i] & 0xffff0000u);
                    ow[i] = pk2(nn[2 * i] * g0 + v0 * bsum, nn[2 * i + 1] * g1 + v1 * bsum); }
                *(u32x4*)(MIX + (size_t)t * D + c8) = (u32x4){ow[0], ow[1], ow[2], ow[3]};
            }
        }
        SEAM(pb + 4);
        if (IN(pb + 5)) { PHASE_IDS
            pg8::Gemm g{MIX, WoutT + (size_t)l * D * D, T, D, D}; pg8::StaticOrder S; S.init(T, D, G, bx);
            pg8::EpiResGate E{xin, X, modl + 2 * D};
            pg8::gemm_phase<pg8::EpiResGate, pg8::StaticOrder, true, true>(lds, g, S, E, tid); }
        SEAM(pb + 5);
        if (IN(pb + 6)) { PHASE_IDS const float* gamma = INP(24) + l * D;
            for (int row = gw; row < T; row += NGW) { const int b = row / SEQ; norm_mod_row(X + (size_t)row * D, gamma, modl + (size_t)b * 6 * D + 3 * D, modl + (size_t)b * 6 * D + 4 * D, H + (size_t)row * D, lane); } }
        SEAM(pb + 6);
        if (IN(pb + 7)) { PHASE_IDS
            pg8::Gemm g{H, PqT + (size_t)l * PH * PQ * D, T, PH * PQ, D}; pg8::StaticOrder S; S.init(T, PH * PQ, G, bx);
            pg8::EpiBf16<0> E{Q, PH * PQ, nullptr, 0, 0, 1.f};
            pg8::gemm_phase<pg8::EpiBf16<0>, pg8::StaticOrder, true, true>(lds, g, S, E, tid); }
        if (IN(pb + 7) && IN(pb + 8)) { asm volatile("s_waitcnt vmcnt(0)" ::: "memory"); __syncthreads(); }

        if (IN(pb + 8)) { PHASE_IDS
            const bf16* KEYSl = KEYS + (size_t)l * PH * 2 * NKEYS * PHALF;
            LAS unsigned char* scr = lds + wave * 2048 + lane * 32;
            constexpr int KST = 136;
            lbf16* kl = (lbf16*)(lds + 16384);
            const int r = lane & 31, hh = lane >> 5;
            pg8::StaticOrder S; S.init(T, PH * PQ, G, bx);
            for (int ui = 0;; ++ui) { pg8::Unit un_; if (!S.next(ui, un_)) break;
                const int h = un_.pn, tok = un_.pm * 256 + wave * 32 + r;
                __syncthreads();
                { u32x4 kq[8];
#pragma unroll
                  for (int q = 0; q < 8; ++q) { const int ch = tid + q * NTHR; kq[q] = *(const u32x4*)(KEYSl + (size_t)(h * 2) * NKEYS * PHALF + (size_t)ch * 8); }
#pragma unroll
                  for (int q = 0; q < 8; ++q) { const int ch = tid + q * NTHR, row = ch >> 4, cc = ch & 15; *(__attribute__((address_space(3))) u32x4*)(kl + row * KST + cc * 8) = kq[q]; } }
                __syncthreads();
                unsigned sp0[16], sp1[16];
#pragma unroll
                for (int e = 0; e < 16; ++e) { sp0[e] = 0u; sp1[e] = 0u; }
#pragma unroll 1
                for (int p = 0; p < 2; ++p) {
                    const bf16* qp = Q + (size_t)tok * (PH * PQ) + h * PQ + p * PHALF + 8 * hh;
                    const lbf16* kp_ = kl + (p * NKEYS + r) * KST + 8 * hh;
                    bf16x8_t bq[8];
#pragma unroll
                    for (int ks = 0; ks < 8; ++ks) bq[ks] = *(const bf16x8_t*)(qp + ks * 16);
                    unsigned best[16];
#pragma unroll
                    for (int e = 0; e < 16; ++e) best[e] = 0u;
#pragma unroll 1
                    for (int kt = 0; kt < 4; ++kt) {
                        f32x16 acc;
#pragma unroll
                        for (int e = 0; e < 16; ++e) acc[e] = 0.f;
#pragma unroll
                        for (int ks = 0; ks < 8; ++ks) { const bf16x8_t ak = *(const __attribute__((address_space(3))) bf16x8_t*)(kp_ + kt * 32 * KST + ks * 16); acc = __builtin_amdgcn_mfma_f32_32x32x16_bf16(ak, bq[ks], acc, 0, 0, 0); }
                        unsigned g[16];
#pragma unroll
                        for (int e = 0; e < 16; ++e) g[e] = pack_key7(acc[e], kt * 32 + (e & 3) + 8 * (e >> 2) + 4 * hh);
                        sort16_desc(g);
                        merge_top16(best, g);
                    }
                    unsigned ob[16];
#pragma unroll
                    for (int e = 0; e < 16; ++e) ob[e] = shflxu(best[e], lane, 32);
                    merge_top16(best, ob);
#pragma unroll
                    for (int e = 0; e < 16; ++e) { sp0[e] = p == 0 ? best[e] : sp0[e]; sp1[e] = p == 0 ? sp1[e] : best[e]; }
                }
                unsigned c2[32];
                stage2_cands(sp0, sp1, hh, c2);
                sort16_desc(c2); sort16_desc(c2 + 16); merge_top16(c2, c2 + 16);
                { unsigned ob[16];
#pragma unroll
                  for (int e = 0; e < 16; ++e) ob[e] = shflxu(c2[e], lane, 32);
                  merge_top16(c2, ob); }
#pragma unroll
                for (int e = 0; e < 16; e += 4) {
                    *(LAS unsigned*)(scr + e) = (127u - (sp0[e] & 127u)) | ((127u - (sp0[e + 1] & 127u)) << 8) | ((127u - (sp0[e + 2] & 127u)) << 16) | ((127u - (sp0[e + 3] & 127u)) << 24);
                    *(LAS unsigned*)(scr + 16 + e) = (127u - (sp1[e] & 127u)) | ((127u - (sp1[e + 1] & 127u)) << 8) | ((127u - (sp1[e + 2] & 127u)) << 16) | ((127u - (sp1[e + 3] & 127u)) << 24); }
                asm volatile("s_waitcnt lgkmcnt(0)" ::: "memory");
                float sm[16]; int ex[16];
#pragma unroll
                for (int e = 0; e < 16; ++e) { const unsigned key = c2[e]; sm[e] = unpack_key8(key); const int i0 = (key >> 4) & 15, j0 = key & 15; ex[e] = (int)scr[i0] * NKEYS + (int)scr[16 + j0]; }
                float den = 0.f;
#pragma unroll
                for (int e = 0; e < 16; ++e) { sm[e] = expf(sm[e] - unpack_key8(c2[0])); den += sm[e]; }
                const float inv = 1.f / den;
                if (hh == 0) {
                    int* ip = IDX + (size_t)tok * NE + h * TOPK; float* gp = GATE + (size_t)tok * NE + h * TOPK;
#pragma unroll
                    for (int e = 0; e < 16; e += 4) { *(int4*)(ip + e) = make_int4(ex[e], ex[e + 1], ex[e + 2], ex[e + 3]); *(f32x4*)(gp + e) = (f32x4){sm[e] * inv, sm[e + 1] * inv, sm[e + 2] * inv, sm[e + 3] * inv}; }
                }
                asm volatile("s_waitcnt lgkmcnt(0)" ::: "memory");
            }
        }
        SEAM(pb + 8);

        if (IN(pb + 9)) { PHASE_IDS
            const unsigned char* Ul = U8 + (size_t)l * NEXP * ROWB; const unsigned char* Vtl = V8 + (size_t)l * NEXP * ROWB; const float* usl = USc + l * NEXP; const float* vsl = VSc + l * NEXP; const float* lnf = INP(29);
            const bool fin = (l == DEPTH - 1);
            typedef float f32x2_t __attribute__((ext_vector_type(2)));
            const __amdgpu_buffer_rsrc_t ru = __builtin_amdgcn_make_buffer_rsrc((void*)Ul, 0, NEXP * ROWB, 0x00020000), rv = __builtin_amdgcn_make_buffer_rsrc((void*)Vtl, 0, NEXP * ROWB, 0x00020000);
            typedef float f32x32_t __attribute__((ext_vector_type(32))); typedef unsigned u32x3_t __attribute__((ext_vector_type(3))); typedef unsigned u32x6_t __attribute__((ext_vector_type(6))); typedef unsigned u32x16_t __attribute__((ext_vector_type(16))); typedef __bf16 bf16x2_t __attribute__((ext_vector_type(2)));
            LAS float* pl = (LAS float*)(lds + wave * 18432);
            constexpr int TW = 4;
            for (int tb = gw; tb < T; tb += TW * NGW) {
#define TOKV(k) (tb + (k) * NGW < T)
#define TOK(k) (TOKV(k) ? tb + (k) * NGW : tb)
                unsigned si[TW][2]; float sus[TW][2], sgv[TW][2];
                LAS u32x4* hl = (LAS u32x4*)(pl + 32 * 68);
                { float g0[TW], g1[TW]; int lane_s; asm volatile("v_mbcnt_lo_u32_b32 %0, -1, 0\n\tv_mbcnt_hi_u32_b32 %0, -1, %0" : "=v"(lane_s));
#pragma unroll
                  for (int k = 0; k < TW; ++k) { const size_t o = (size_t)TOK(k) * NE + lane_s; si[k][0] = ((unsigned)IDX[o] << 7) | (unsigned)lane_s; si[k][1] = ((unsigned)IDX[o + 64] << 7) | (unsigned)(64 + lane_s); g0[k] = GATE[o]; g1[k] = GATE[o + 64]; }
#pragma unroll
                  for (int kk = 2; kk <= 128; kk <<= 1) {
#pragma unroll
                      for (int j = kk >> 1; j > 0; j >>= 1) {
                          if (j == 64) {
#pragma unroll
                              for (int k = 0; k < TW; ++k) { const unsigned a = si[k][0], b = si[k][1]; si[k][0] = a < b ? a : b; si[k][1] = a < b ? b : a; } }
                          else { const bool lower = (lane_s & j) == 0, tm0 = lower == ((lane_s & kk) == 0), tm1 = lower == (((lane_s + 64) & kk) == 0); const int pa = (lane_s ^ j) << 2;
#pragma unroll
                              for (int k = 0; k < TW; ++k) { const unsigned a = si[k][0], b = si[k][1], p0 = (unsigned)__builtin_amdgcn_ds_bpermute(pa, (int)a), p1 = (unsigned)__builtin_amdgcn_ds_bpermute(pa, (int)b);
                                  si[k][0] = tm0 ? (a < p0 ? a : p0) : (a < p0 ? p0 : a); si[k][1] = tm1 ? (b < p1 ? b : p1) : (b < p1 ? p1 : b); } }
                          __builtin_amdgcn_sched_barrier(0);
                      } }
#pragma unroll
                  for (int k = 0; k < TW; ++k) {
#pragma unroll
                      for (int r = 0; r < 2; ++r) { const unsigned key = si[k][r]; const int a = (int)(key & 63u) << 2; const int ga = __builtin_amdgcn_ds_bpermute(a, __float_as_int(g0[k])), gb = __builtin_amdgcn_ds_bpermute(a, __float_as_int(g1[k]));
                          const unsigned ix = key >> 7; si[k][r] = ix; sus[k][r] = usl[ix]; sgv[k][r] = __int_as_float((key & 64u) ? gb : ga) * vsl[ix]; } }
#pragma unroll
                  for (int k = 0; k < TW; ++k) { const bf16* hr = H + (size_t)TOK(k) * D + lane_s * 16; hl[(k * 2) * 64 + lane_s] = *(const u32x4*)hr; hl[(k * 2 + 1) * 64 + lane_s] = *(const u32x4*)(hr + 8); }
                }
                __builtin_amdgcn_sched_barrier(0);
#define ROWLD(dst, rs, ixv, ln) dst = __builtin_amdgcn_raw_buffer_load_b96(rs, voff, __builtin_amdgcn_readlane((int)(ixv), (ln)) * ROWB, 0)
#define LOADQ(buf, rs, ixv, ln0) do { _Pragma("unroll") for (int j_ = 0; j_ < 8; ++j_) ROWLD((buf)[j_], rs, ixv, (ln0) + j_); __builtin_amdgcn_sched_barrier(0); } while (0)
#define CVT2(a, b) const f32x32_t f_ = __builtin_amdgcn_cvt_scalef32_pk32_f32_fp6((u32x6_t){(a).x, (a).y, (a).z, (b).x, (b).y, (b).z}, 1.0f)
#define PR(i) __builtin_shufflevector(f_, f_, 2 * (i), 2 * (i) + 1)
#define DOTQ(buf, e0) do { _Pragma("unroll") for (int j_ = 0; j_ < 8; j_ += 2) { \
                        const u32x16_t g_ = __builtin_bit_cast(u32x16_t, __builtin_amdgcn_cvt_scalef32_pk32_bf16_fp6((u32x6_t){(buf)[j_].x, (buf)[j_].y, (buf)[j_].z, (buf)[j_ + 1].x, (buf)[j_ + 1].y, (buf)[j_ + 1].z}, 1.0f));     \
                        float a0_ = 0.f, a1_ = 0.f, b0_ = 0.f, b1_ = 0.f; \
                        _Pragma("unroll") for (int i_ = 0; i_ < 8; i_ += 2) { a0_ = DOT2(g_[i_], hpk[i_], a0_); b0_ = DOT2(g_[8 + i_], hpk[i_], b0_); a1_ = DOT2(g_[i_ + 1], hpk[i_ + 1], a1_); b1_ = DOT2(g_[9 + i_], hpk[i_ + 1], b1_); } \
                        pl[((e0) + j_) * 68 + lane_u] = a0_ + a1_; pl[((e0) + j_ + 1) * 68 + lane_u] = b0_ + b1_; __builtin_amdgcn_sched_barrier(0); } } while (0)
#define DOT2(x_, y_, c_) __builtin_amdgcn_fdot2_f32_bf16(__builtin_bit_cast(bf16x2_t, (unsigned)(x_)), __builtin_bit_cast(bf16x2_t, (unsigned)(y_)), (c_), false)
#define AXPYQ(buf, k, cfv, ln0) do { _Pragma("unroll") for (int j_ = 0; j_ < 8; j_ += 2) { CVT2((buf)[j_], (buf)[j_ + 1]); \
                        const float ca = __int_as_float(__builtin_amdgcn_readlane(__float_as_int(cfv), (ln0) + j_)), cb = __int_as_float(__builtin_amdgcn_readlane(__float_as_int(cfv), (ln0) + j_ + 1)); \
                        acc2[k][0] += ca * PR(0); acc2[k][1] += ca * PR(1); acc2[k][2] += ca * PR(2); acc2[k][3] += ca * PR(3); acc2[k][4] += ca * PR(4); acc2[k][5] += ca * PR(5); acc2[k][6] += ca * PR(6); acc2[k][7] += ca * PR(7); \
                        acc2[k][0] += cb * PR(8); acc2[k][1] += cb * PR(9); acc2[k][2] += cb * PR(10); acc2[k][3] += cb * PR(11); acc2[k][4] += cb * PR(12); acc2[k][5] += cb * PR(13); acc2[k][6] += cb * PR(14); acc2[k][7] += cb * PR(15); __builtin_amdgcn_sched_barrier(0); } } while (0)
                u32x3_t ba[8], bb_[8];
                int lane_u; asm volatile("v_mbcnt_lo_u32_b32 %0, -1, 0\n\tv_mbcnt_hi_u32_b32 %0, -1, %0" : "=v"(lane_u)); const int voff = lane_u * 12;
                LOADQ(ba, ru, si[0][0], 0);
#pragma unroll 1
                for (int c = 0; c < 16; ++c) {
                    const int lb = (c & 7) * 8; const bool r1 = c >= 8;
#pragma unroll
                    for (int k = 0; k < TW; ++k) {
                        unsigned hpk[8];
                        { const u32x4 h0 = hl[(k * 2) * 64 + lane_u], h1 = hl[(k * 2 + 1) * 64 + lane_u]; hpk[0] = h0.x; hpk[1] = h0.y; hpk[2] = h0.z; hpk[3] = h0.w; hpk[4] = h1.x; hpk[5] = h1.y; hpk[6] = h1.z; hpk[7] = h1.w; }
                        if (k & 1) { if (k < TW - 1) LOADQ(ba, ru, r1 ? si[k + 1][1] : si[k + 1][0], lb); else { const int cn = (c + 1) & 15; const __amdgpu_buffer_rsrc_t rn = c < 15 ? ru : rv; LOADQ(ba, rn, (cn >= 8) ? si[0][1] : si[0][0], (cn & 7) * 8); } DOTQ(bb_, k * 8); }
                        else { LOADQ(bb_, ru, r1 ? si[k + 1][1] : si[k + 1][0], lb); DOTQ(ba, k * 8); }
                    }
                    __builtin_amdgcn_wave_barrier(); asm volatile("s_waitcnt lgkmcnt(0)" ::: "memory");
                    float dsum;
                    { const LAS float* rp = pl + (lane_u & 31) * 68 + (lane_u >> 5) * 32; f32x4 s4 = *(const LAS f32x4*)rp;
#pragma unroll
                      for (int j = 1; j < 8; ++j) s4 += *(const LAS f32x4*)(rp + j * 4);
                      dsum = (s4.x + s4.y) + (s4.z + s4.w); }
                    dsum += shflx(dsum, lane_u, 32);
                    __builtin_amdgcn_wave_barrier(); asm volatile("s_waitcnt lgkmcnt(0)" ::: "memory");
                    const bool home = (lane_u >> 3) == (c & 7);
#pragma unroll
                    for (int k = 0; k < TW; ++k) {
                        const float dv = __int_as_float(__builtin_amdgcn_ds_bpermute((k * 8 + (lane_u & 7)) << 2, __float_as_int(dsum)));
                        const float cf = (r1 ? sgv[k][1] : sgv[k][0]) * gelu_erf(dv * (r1 ? sus[k][1] : sus[k][0]));
                        if (r1) sgv[k][1] = home ? cf : sgv[k][1]; else sgv[k][0] = home ? cf : sgv[k][0]; }
                    __builtin_amdgcn_sched_barrier(0);
                }
                f32x2_t acc2[TW][8];
#pragma unroll
                for (int k = 0; k < TW; ++k) {
#pragma unroll
                    for (int i = 0; i < 8; ++i) acc2[k][i] = (f32x2_t){0.f, 0.f}; }
#pragma unroll 1
                for (int c = 0; c < 16; ++c) {
                    const int lb = (c & 7) * 8; const bool r1 = c >= 8;
#pragma unroll
                    for (int k = 0; k < TW; ++k) {
                        const float cfk = r1 ? sgv[k][1] : sgv[k][0];
                        if (k & 1) { if (k < TW - 1) LOADQ(ba, rv, r1 ? si[k + 1][1] : si[k + 1][0], lb); else { const int cn = (c + 1) & 15; LOADQ(ba, rv, (cn >= 8) ? si[0][1] : si[0][0], (cn & 7) * 8); }     AXPYQ(bb_, k, cfk, lb); }
                        else { LOADQ(bb_, rv, r1 ? si[k + 1][1] : si[k + 1][0], lb); AXPYQ(ba, k, cfk, lb); }
                    }
                }
#undef ROWLD
#undef LOADQ
#undef CVT2
#undef PR
#undef DOTQ
#undef DOT2
#undef AXPYQ
                { int ln; asm volatile("v_mbcnt_lo_u32_b32 %0, -1, 0\n\tv_mbcnt_hi_u32_b32 %0, -1, %0" : "=v"(ln));
                  LAS f32x4* al = (LAS f32x4*)pl + ln;
#pragma unroll
                  for (int k = 0; k < TW; ++k) {
#pragma unroll
                      for (int q = 0; q < 4; ++q) al[(k * 4 + q) * 64] = (f32x4){acc2[k][q * 2].x, acc2[k][q * 2].y, acc2[k][q * 2 + 1].x, acc2[k][q * 2 + 1].y}; }
                  asm volatile("s_waitcnt lgkmcnt(0)" ::: "memory"); __builtin_amdgcn_sched_barrier(0);
                  f32x4 xn[4];
#pragma unroll
                  for (int q = 0; q < 4; ++q) xn[q] = *(const f32x4*)(X + (size_t)tb * D + ln * 16 + q * 4);
#pragma unroll 1
                  for (int k = 0; k < TW; ++k) { const int t = tb + k * NGW; if (t >= T) break; const int b = t / SEQ;
                    float* xr = X + (size_t)t * D + ln * 16; const float* g2 = modl + (size_t)b * 6 * D + 5 * D + ln * 16;
                    f32x4 xv[4]; float ss = 0.f;
#pragma unroll
                    for (int q = 0; q < 4; ++q) xv[q] = xn[q];
                    { const float* xnp = X + (size_t)((k + 1 < TW && t + NGW < T) ? t + NGW : t) * D + ln * 16;
#pragma unroll
                      for (int q = 0; q < 4; ++q) xn[q] = *(const f32x4*)(xnp + q * 4); }
                    __builtin_amdgcn_sched_barrier(0);
#pragma unroll
                    for (int q = 0; q < 4; ++q) { const f32x4 xo = xv[q], gg = *(const f32x4*)(g2 + q * 4);
                        xv[q] = xo + gg * al[(k * 4 + q) * 64]; ss += (xv[q].x * xv[q].x + xv[q].y * xv[q].y) + (xv[q].z * xv[q].z + xv[q].w * xv[q].w); }
                    const float rs = rsqrtf(wave_sum(ss, ln) * (1.f / D) + NORM_EPS);
                    if (fin) {
#pragma unroll
                        for (int q = 0; q < 4; ++q) *(f32x4*)(xr + q * 4) = xv[q] * rs * *(const f32x4*)(lnf + ln * 16 + q * 4); }
                    else {
                        const float* gam = INP(4) + (l + 1) * D + ln * 16; const float* mn = MOD + (size_t)(l + 1) * BATCH * 6 * D + (size_t)b * 6 * D + ln * 16; u32x4 ho[2];
#pragma unroll
                        for (int q = 0; q < 4; ++q) { *(f32x4*)(xr + q * 4) = xv[q];
                            const f32x4 y = xv[q] * rs * *(const f32x4*)(gam + q * 4) * (*(const f32x4*)(mn + D + q * 4) + 1.f) + *(const f32x4*)(mn + q * 4);
                            if (q & 1) { ho[q >> 1].z = pk2(y.x, y.y); ho[q >> 1].w = pk2(y.z, y.w); } else { ho[q >> 1].x = pk2(y.x, y.y); ho[q >> 1].y = pk2(y.z, y.w); } }
                        *(u32x4*)(H + (size_t)t * D + ln * 16) = ho[0]; *(u32x4*)(H + (size_t)t * D + ln * 16 + 8) = ho[1]; }
                  }
                  asm volatile("s_waitcnt lgkmcnt(0)" ::: "memory"); __builtin_amdgcn_wave_barrier();
                }
#undef TOK
#undef TOKV
            }
        }
    }
#undef modl
#undef xin
#undef IN
#undef SEAM
}
#undef MOD
#undef H
#undef PROJ
#undef Q
#undef MIX
#undef Rb
#undef Kb
#undef V0
#undef V1
#undef KKb
#undef Bb
#undef Gb
#undef BGb
#undef Wd
#undef Y
#undef IDX
#undef GATE
#undef WinT
#undef WoutT
#undef PqT
#undef KEYS
#undef QB
#undef POOLIN
#undef SH
#undef WUPT
#undef AUPT
#undef GUPT
#undef VUPT
#undef PWT
#undef INVN
#undef BSUM
#undef SCN
#undef U8
#undef V8
#undef USc
#undef VSc
#undef INP
#undef PHASE_IDS

extern "C" void kernel_launch(void* const* d_in, const int* in_sizes, int n_in, void* d_out, int out_size, void* d_ws, size_t ws_size, hipStream_t stream) {
    if (n_in != 30 || ws_size < WS_END) { fprintf(stderr, "kernel_launch: unexpected n_in %d / ws_size %zu\n", n_in, ws_size); return; }
    static int grid = 0;
    if (grid == 0) {
        int dev = 0, cus = 0, per_cu = 0;
        (void)hipGetDevice(&dev); (void)hipDeviceGetAttribute(&cus, hipDeviceAttributeMultiprocessorCount, dev);
        if (hipFuncSetAttribute((const void*)mega, hipFuncAttributeMaxDynamicSharedMemorySize, LDS_BYTES) != hipSuccess) { fprintf(stderr, "hipFuncSetAttribute failed\n"); grid = -1; return; }
        if (hipOccupancyMaxActiveBlocksPerMultiprocessor(&per_cu, (const void*)mega, NTHR, LDS_BYTES) != hipSuccess || per_cu < 1) { fprintf(stderr, "occupancy query failed (%d)\n", per_cu); per_cu = 1; }
        (void)hipGetLastError();
        grid = (cus > 0 ? cus : 256) * 1;
    }
    if (grid < 0) return;
    Args a{}; for (int i = 0; i < 30; ++i) a.in[i] = (const float*)d_in[i]; a.out = (float*)d_out; a.ws = (unsigned char*)d_ws;
    a.ph_lo = 0; a.ph_hi = NPH;
    if (hipMemsetAsync(d_ws, 0, 65536, stream) != hipSuccess) { fprintf(stderr, "memset failed\n"); return; }
    void* kargs[] = {&a};
    hipError_t e = hipLaunchCooperativeKernel((const void*)mega, dim3(grid), dim3(NTHR), kargs, LDS_BYTES, stream);
    if (e != hipSuccess) fprintf(stderr, "cooperative launch failed: %s (grid %d)\n", hipGetErrorString(e), grid);
}
```

```cpp
#include <hip/hip_runtime.h>
#include <hip/hip_cooperative_groups.h>
namespace cg = cooperative_groups;
#include <cstdio>
#include <cstdint>
#include <cmath>

constexpr int D = 1024, BATCH = 4, SEQ = 4096, T = BATCH * SEQ, DEPTH = 2;
constexpr int RW = 512, HS = 64, NH = 8;
constexpr int DL = 64, AL = 64, MVL = 32, GL = 128;
constexpr int RWKV_COLS = 3 * RW + DL + AL + GL;
constexpr int PW = 512, PG = 128;
constexpr int IN_COLS = RWKV_COLS + PW;
constexpr int LDP = 2560;
constexpr int NKEYS = 128, NEXP = NKEYS * NKEYS, PH = 8, PQ = 256, PHALF = 128, TOPK = 16;
constexpr int NE = PH * TOPK;
constexpr float NORM_EPS = 1e-6f, GN_EPS = 64e-5f;

typedef unsigned short bf16;
__device__ __forceinline__ float bf2f(bf16 u) { return __uint_as_float((unsigned)u << 16); }
typedef float cvt_f32x2 __attribute__((ext_vector_type(2))); typedef __bf16 cvt_bf16x2 __attribute__((ext_vector_type(2)));
__device__ __forceinline__ unsigned cvtpk(float lo, float hi) { const cvt_f32x2 v = {lo, hi}; const cvt_bf16x2 b = __builtin_convertvector(v, cvt_bf16x2); return __builtin_bit_cast(unsigned, b); }
__device__ __forceinline__ bf16 f2bf(float f) { return (bf16)cvtpk(f, 0.f); }

constexpr size_t MiB = 1u << 20;
constexpr size_t WS_MOD = 1 * MiB;
constexpr size_t WS_US = 1 * MiB + 256 * 1024;
constexpr size_t WS_VS = 1 * MiB + 512 * 1024;
constexpr size_t WS_H = 2 * MiB;
constexpr size_t WS_PROJ = 34 * MiB;
constexpr size_t WS_Q = WS_PROJ;
constexpr size_t WS_R = 114 * MiB;
constexpr size_t WS_K = 130 * MiB;
constexpr size_t WS_V0 = 146 * MiB;
constexpr size_t WS_V1 = 162 * MiB;
constexpr size_t WS_KK = 178 * MiB;
constexpr size_t WS_B = 194 * MiB;
constexpr size_t WS_G = 210 * MiB;
constexpr size_t WS_BG = 226 * MiB;
constexpr size_t WS_W = 242 * MiB;
constexpr size_t WS_Y = 274 * MiB;
constexpr size_t WS_MIX = 306 * MiB;
constexpr size_t WS_IDX = 338 * MiB;
constexpr size_t WS_GATE = 346 * MiB;
constexpr size_t WS_WIN_T = 354 * MiB;
constexpr size_t WS_WOUT_T = 364 * MiB;
constexpr size_t WS_PQ_T = 368 * MiB;
constexpr size_t WS_KEYS = 376 * MiB;
constexpr size_t WS_U = 378 * MiB;
constexpr size_t WS_V = 442 * MiB;
constexpr size_t WS_QB = 410 * MiB;
constexpr size_t WS_SH = 426 * MiB;
constexpr size_t WS_LORA = 428 * MiB;
constexpr size_t WS_INVN = 430 * MiB;
constexpr size_t WS_BSUM = 431 * MiB;
constexpr size_t WS_SCN = 2 * MiB;
constexpr size_t WS_END = 506 * MiB;

template <int CTRL> __device__ __forceinline__ float dppf(float x) { return __int_as_float(__builtin_amdgcn_update_dpp(0, __float_as_int(x), CTRL, 0xF, 0xF, false)); }
__device__ __forceinline__ float red16(float x) { x += dppf<0xB1>(x); x += dppf<0x4E>(x); x += dppf<0x141>(x); x += dppf<0x140>(x); return x; }
__device__ __forceinline__ float shflx(float v, int lane, int off) { return __int_as_float(__builtin_amdgcn_ds_bpermute((lane ^ off) << 2, __float_as_int(v))); }
__device__ __forceinline__ unsigned shflxu(unsigned v, int lane, int off) { return (unsigned)__builtin_amdgcn_ds_bpermute((lane ^ off) << 2, (int)v); }
__device__ __forceinline__ void sort128(unsigned& k0, unsigned& k1, int lane) {
#pragma unroll
    for (int k = 2; k <= 128; k <<= 1) {
#pragma unroll
        for (int j = k >> 1; j > 0; j >>= 1) {
            if (j == 64) { const unsigned lo = k0 < k1 ? k0 : k1, hi = k0 < k1 ? k1 : k0; k0 = lo; k1 = hi; }
            else {
                const unsigned p0 = shflxu(k0, lane, j), p1 = shflxu(k1, lane, j);
                const bool lower = (lane & j) == 0, up0 = (lane & k) == 0, up1 = ((lane + 64) & k) == 0;
                const unsigned mn0 = k0 < p0 ? k0 : p0, mx0 = k0 < p0 ? p0 : k0, mn1 = k1 < p1 ? k1 : p1, mx1 = k1 < p1 ? p1 : k1;
                k0 = (lower == up0) ? mn0 : mx0; k1 = (lower == up1) ? mn1 : mx1;
            }
        }
    }
}
__device__ __forceinline__ float wave_sum(float v, int lane) { v = red16(v); v += shflx(v, lane, 16); v += shflx(v, lane, 32); return v; }
__device__ __forceinline__ float sigmoidf_(float x) { return 1.f / (1.f + expf(-x)); }

namespace pg8 {
#define PG8_LAS __attribute__((address_space(3)))
typedef unsigned short bf16_t;
typedef short bf16x8 __attribute__((ext_vector_type(8)));
typedef float f32x4 __attribute__((ext_vector_type(4)));
typedef unsigned u32x4 __attribute__((ext_vector_type(4)));
constexpr int BM = 256, BK = 64, HALF = 128, HTB = HALF * BK * 2  , STAGE_BYTES = 8 * HTB, NXCD = 8, WGM = 8;

__host__ __device__ __forceinline__ int lds_byte(int r, int c) { const int st = (r >> 4) * 2 + (c >> 5), rr = r & 15, cc = c & 31, ob = rr * 64 + cc * 2; return st * 1024 + (ob ^ (((ob >> 9) & 1) << 5)); }
__host__ __device__ __forceinline__ void stage_rc(int b, int& R, int& C) { const int st = b / 1024, sb = b % 1024, swz = sb ^ (((sb >> 9) & 1) << 5); R = (st >> 1) * 16 + swz / 64; C = (st & 1) * 32 + (swz % 64) / 2; }
__host__ __device__ __forceinline__ int perm32(int rho) { const int n = rho >> 4, i = rho & 15; return 8 * (i >> 2) + 4 * n + (i & 3); }

struct Unit { int pm, pn; };
struct Gemm { const bf16_t* A; const bf16_t* Bt; int M, N, K; };

struct StaticOrder {
    int nM, nN, nwg, G, c;
    __host__ __device__ void init(int M, int N, int G_, int c_) { nM = M / BM; nN = N / BM; nwg = nM * nN; G = G_; c = c_; }
    __host__ __device__ bool next(int i, Unit& u) const {
        const long L = (long)i * G + c; if (L >= nwg) return false;
        int wgid = (int)L; { const int q = nwg / NXCD, r = nwg % NXCD, xcd = wgid % NXCD, off = wgid / NXCD; wgid = (xcd < r ? xcd * (q + 1) : r * (q + 1) + (xcd - r) * q) + off; }
        const int nig = WGM * nN, gid = wgid / nig, fm = gid * WGM, gsz = (nM - fm) < WGM ? (nM - fm) : WGM;
        u.pm = fm + ((wgid % nig) % gsz); u.pn = (wgid % nig) / gsz; return true;
    }
    __device__ __forceinline__ void a_ready(const Unit&) const {}
    __device__ __forceinline__ void done(const Unit&) const {}
};

__device__ __forceinline__ unsigned cvt_pk_bf16(float lo, float hi) { unsigned r; asm volatile("v_cvt_pk_bf16_f32 %0, %1, %2" : "=v"(r) : "v"(lo), "v"(hi)); return r; }
typedef float f32x2 __attribute__((ext_vector_type(2)));
__device__ __forceinline__ f32x2 gelu_pk(f32x2 v) {
    const f32x2 av = __builtin_elementwise_abs(v), d = av * 0.2316418882f + 1.0f;
    f32x2 t; t.x = __builtin_amdgcn_rcpf(d.x); t.y = __builtin_amdgcn_rcpf(d.y);
    f32x2 q = t * 0.5307027145f + (-0.7265760135f); q = q * t + 0.7107068705f; q = q * t + (-0.142248368f); q = q * t + 0.127414796f; q = q * t;
    const f32x2 s = (v * v) * (-0.72134752044f);
    f32x2 e; e.x = __builtin_amdgcn_exp2f(s.x); e.y = __builtin_amdgcn_exp2f(s.y);
    const f32x2 m = v * (q * e), r = v - m;
    f32x2 o; o.x = v.x < 0.f ? m.x : r.x; o.y = v.y < 0.f ? m.y : r.y; return o;
}

template <int ACT  > struct EpiBf16 {
    static constexpr bool PERM = true, AFTER_DRAIN = false; static_assert(ACT == 0 || ACT == 1, "EpiBf16: ACT is 0 (none) or 1 (gelu_pk)");
    bf16_t* O; int ldc; const float* bias; int split_cols; size_t split_stride; float scale0;
    __device__ __forceinline__ void operator()(const f32x4 (&acc)[2][2][4][2], const Unit& u, int wr, int wc, int fr, int fq) const {
        const int row0 = u.pm * BM + wr * 64 + fr; int colt = u.pn * BM; bf16_t* base = O;
        float sc = 1.f; if (split_cols) { const int t = colt / split_cols; base += (size_t)t * split_stride; colt -= t * split_cols; if (t == 0) sc = scale0; }
        const int col0 = colt + wc * 32 + 8 * fq, bcol0 = u.pn * BM + wc * 32 + 8 * fq;
        f32x4 bv[2][2];
#pragma unroll
        for (int bj = 0; bj < 2; ++bj)
#pragma unroll
            for (int n = 0; n < 2; ++n) bv[bj][n] = bias ? *(const f32x4*)(bias + bcol0 + bj * HALF + 4 * n) : (f32x4){0.f, 0.f, 0.f, 0.f};
#pragma unroll
        for (int ai = 0; ai < 2; ++ai)
#pragma unroll
            for (int m = 0; m < 4; ++m) { bf16_t* rowp = base + (size_t)(row0 + ai * HALF + m * 16) * ldc + col0;
#pragma unroll
                for (int bj = 0; bj < 2; ++bj) { f32x4 v0 = acc[ai][bj][m][0] + bv[bj][0], v1 = acc[ai][bj][m][1] + bv[bj][1];
                    if (ACT == 1) { f32x2 a = gelu_pk((f32x2){v0[0], v0[1]}), b = gelu_pk((f32x2){v0[2], v0[3]}), c = gelu_pk((f32x2){v1[0], v1[1]}), d = gelu_pk((f32x2){v1[2], v1[3]});
                        v0 = (f32x4){a.x, a.y, b.x, b.y}; v1 = (f32x4){c.x, c.y, d.x, d.y}; }
                    v0 = v0 * sc; v1 = v1 * sc; u32x4 w; w.x = cvt_pk_bf16(v0[0], v0[1]); w.y = cvt_pk_bf16(v0[2], v0[3]); w.z = cvt_pk_bf16(v1[0], v1[1]); w.w = cvt_pk_bf16(v1[2], v1[3]);
                    *(u32x4*)(rowp + bj * HALF) = w; } }
    }
};

struct EpiProj {
    static constexpr bool PERM = true, AFTER_DRAIN = false;
    bf16_t* O; int ldc; bf16_t* P; int pool0, pw;
    __device__ __forceinline__ void operator()(const f32x4 (&acc)[2][2][4][2], const Unit& u, int wr, int wc, int fr, int fq) const {
        const int row0 = u.pm * BM + wr * 64 + fr; int colt = u.pn * BM; bf16_t* base = O; int ld = ldc;
        if (colt >= pool0 && colt < pool0 + pw) { base = P; ld = pw; colt -= pool0; }
        const int col0 = colt + wc * 32 + 8 * fq;
#pragma unroll
        for (int ai = 0; ai < 2; ++ai)
#pragma unroll
            for (int m = 0; m < 4; ++m) { bf16_t* rowp = base + (size_t)(row0 + ai * HALF + m * 16) * ld + col0;
#pragma unroll
                for (int bj = 0; bj < 2; ++bj) { const f32x4 v0 = acc[ai][bj][m][0], v1 = acc[ai][bj][m][1];
                    u32x4 w; w.x = cvt_pk_bf16(v0[0], v0[1]); w.y = cvt_pk_bf16(v0[2], v0[3]); w.z = cvt_pk_bf16(v1[0], v1[1]); w.w = cvt_pk_bf16(v1[2], v1[3]);
                    *(u32x4*)(rowp + bj * HALF) = w; } }
    }
};
struct EpiResGate {
    static constexpr bool PERM = true, AFTER_DRAIN = false;
    const float* xold; float* X; const float* gate;
    bf16_t* XB; const float* sv; unsigned long long* ssq;
    __device__ __forceinline__ void operator()(const f32x4 (&acc)[2][2][4][2], const Unit& u, int wr, int wc, int fr, int fq) const {
        const int col0 = u.pn * BM + wc * 32 + 8 * fq; const int b = (u.pm * BM) / SEQ;
        const float* gp = gate + (size_t)b * 6 * D + col0; const float* sp = sv + (size_t)b * D + col0;
        float rsum[2][4];
#pragma unroll
        for (int ai = 0; ai < 2; ++ai)
#pragma unroll
            for (int m = 0; m < 4; ++m) rsum[ai][m] = 0.f;
#pragma unroll
        for (int bj = 0; bj < 2; ++bj) { const f32x4 g0 = *(const f32x4*)(gp + bj * HALF), g1 = *(const f32x4*)(gp + bj * HALF + 4), s0 = *(const f32x4*)(sp + bj * HALF), s1 = *(const f32x4*)(sp + bj * HALF + 4);
#pragma unroll
            for (int ai = 0; ai < 2; ++ai)
#pragma unroll
                for (int m = 0; m < 4; ++m) { const size_t off = (size_t)(u.pm * BM + ai * HALF + wr * 64 + m * 16 + fr) * D + col0 + bj * HALF;
                    const f32x4 xa = *(const f32x4*)(xold + off) + g0 * acc[ai][bj][m][0], xb = *(const f32x4*)(xold + off + 4) + g1 * acc[ai][bj][m][1];
                    *(f32x4*)(X + off) = xa; *(f32x4*)(X + off + 4) = xb;
                    rsum[ai][m] += ((xa[0] * xa[0] + xa[1] * xa[1]) + (xa[2] * xa[2] + xa[3] * xa[3])) + ((xb[0] * xb[0] + xb[1] * xb[1]) + (xb[2] * xb[2] + xb[3] * xb[3]));
                    const f32x4 ya = xa * s0, yb = xb * s1; u32x4 o; o.x = cvt_pk_bf16(ya[0], ya[1]); o.y = cvt_pk_bf16(ya[2], ya[3]); o.z = cvt_pk_bf16(yb[0], yb[1]); o.w = cvt_pk_bf16(yb[2], yb[3]);
                    *(u32x4*)(XB + off) = o; } }
        const int lane_ = fr | (fq << 4);
#pragma unroll
        for (int ai = 0; ai < 2; ++ai)
#pragma unroll
            for (int m = 0; m < 4; ++m) { float v = rsum[ai][m];
                v += __int_as_float(__builtin_amdgcn_ds_bpermute((lane_ ^ 16) << 2, __float_as_int(v))); v += __int_as_float(__builtin_amdgcn_ds_bpermute((lane_ ^ 32) << 2, __float_as_int(v)));
                if (fq == 0) (void)__hip_atomic_fetch_add(ssq + (u.pm * BM + ai * HALF + wr * 64 + m * 16 + fr), (unsigned long long)(v * 1048576.f + 0.5f), __ATOMIC_RELAXED, __HIP_MEMORY_SCOPE_AGENT); }
    }
};
struct EpiQ {
    static constexpr bool PERM = true, AFTER_DRAIN = false;
    bf16_t* O; int ldc; const float* cv; const unsigned long long* ssq;
    __device__ __forceinline__ void operator()(const f32x4 (&acc)[2][2][4][2], const Unit& u, int wr, int wc, int fr, int fq) const {
        const int row0 = u.pm * BM + wr * 64 + fr, colt = u.pn * BM, b = (u.pm * BM) / SEQ;
        const int col0 = colt + wc * 32 + 8 * fq;
        f32x4 bv[2][2];
#pragma unroll
        for (int bj = 0; bj < 2; ++bj)
#pragma unroll
            for (int n = 0; n < 2; ++n) bv[bj][n] = *(const f32x4*)(cv + (size_t)b * ldc + col0 + bj * HALF + 4 * n);
#pragma unroll
        for (int ai = 0; ai < 2; ++ai)
#pragma unroll
            for (int m = 0; m < 4; ++m) { const int row = row0 + ai * HALF + m * 16; bf16_t* rowp = O + (size_t)row * ldc + col0;
                const float rs = rsqrtf((float)ssq[row] * (1.f / (1048576.f * 1024.f)) + 1e-6f);
#pragma unroll
                for (int bj = 0; bj < 2; ++bj) { const f32x4 v0 = acc[ai][bj][m][0] * rs + bv[bj][0], v1 = acc[ai][bj][m][1] * rs + bv[bj][1];
                    u32x4 w; w.x = cvt_pk_bf16(v0[0], v0[1]); w.y = cvt_pk_bf16(v0[2], v0[3]); w.z = cvt_pk_bf16(v1[0], v1[1]); w.w = cvt_pk_bf16(v1[2], v1[3]);
                    *(u32x4*)(rowp + bj * HALF) = w; } }
    }
};
template <class Epi, class Sched, bool ALIGN_EPI = false, bool SP2 = false>
__device__ __forceinline__ void gemm_phase(PG8_LAS unsigned char* lds, const Gemm g, const Sched& S, const Epi& E, int tid) {
    asm volatile("" : "+v"(tid));
    const int wid = __builtin_amdgcn_readfirstlane(tid >> 6), lane = tid & 63, wr = wid >> 2, wc = wid & 3, fr = lane & 15, fq = lane >> 4;
    const int K = g.K, nt = K / BK;
    unsigned voffA[2], voffB[2];
#pragma unroll
    for (int i = 0; i < 2; ++i) { int R, C; stage_rc(tid * 16 + i * 8192, R, C); const int Rb = Epi::PERM ? ((R & ~31) + perm32(R & 31)) : R;
        voffA[i] = (unsigned)(R * K + C) * 2u; voffB[i] = (unsigned)(Rb * K + C) * 2u; }
    const size_t kstep = (size_t)(BK * 2);
    const size_t hstep = (size_t)HALF * K * 2;
    const size_t tstep = 2 * hstep;
    const unsigned ldsw = (unsigned)wid * 1024u;
    const int aoff = lds_byte(wr * 64 + fr, fq * 8), boff = lds_byte(wc * 32 + fr, fq * 8);
#define PG8_SA(b, h) (((b) * 2 + (h)) * HTB)
#define PG8_SB(b, h) ((4 + (b) * 2 + (h)) * HTB)
#define PG8_STAGE(bufoff, gbase, voff) do { _Pragma("unroll") for (int _i = 0; _i < 2; ++_i) \
        __builtin_amdgcn_global_load_lds((const unsigned*)((const char*)(gbase) + (voff)[_i]), (PG8_LAS unsigned*)(lds + (bufoff) + ldsw + _i * 8192), 16, 0, 0); } while (0)
#define PG8_LDA(dst, b, h) do { _Pragma("unroll") for (int m = 0; m < 4; ++m) _Pragma("unroll") for (int k = 0; k < 2; ++k) dst[m][k] = *(const PG8_LAS bf16x8*)(lds + PG8_SA(b, h) + aoff + m * 2048 + k * 1024); } while (0)
#define PG8_LDB(dst, b, h) do { _Pragma("unroll") for (int n = 0; n < 2; ++n) _Pragma("unroll") for (int k = 0; k < 2; ++k) dst[n][k] = *(const PG8_LAS bf16x8*)(lds + PG8_SB(b, h) + boff + n * 2048 + k * 1024); } while (0)
#define PG8_MMA(ai, bj, At, Bt) do { __builtin_amdgcn_s_setprio(1); _Pragma("unroll") for (int m = 0; m < 4; ++m) _Pragma("unroll") for (int n = 0; n < 2; ++n) _Pragma("unroll") for (int k = 0; k < 2; ++k) \
        acc[ai][bj][m][n] = __builtin_amdgcn_mfma_f32_16x16x32_bf16(Bt[n][k], At[m][k], acc[ai][bj][m][n], 0, 0, 0); __builtin_amdgcn_s_setprio(0); } while (0)
#define PG8_WAIT_V(n) asm volatile("s_waitcnt vmcnt(" #n ")" ::: "memory")
#define PG8_WAIT_L(n) asm volatile("s_waitcnt lgkmcnt(" #n ")" ::: "memory")
#define PG8_BAR __builtin_amdgcn_s_barrier()
#define PG8_SCHED __builtin_amdgcn_sched_barrier(0)
    Unit cur, nxt; int ui = 0;
    if (!S.next(0, cur)) return;
    f32x4 acc[2][2][4][2];
#pragma unroll
    for (int a = 0; a < 2; ++a)
#pragma unroll
        for (int b = 0; b < 2; ++b)
#pragma unroll
            for (int m = 0; m < 4; ++m)
#pragma unroll
                for (int n = 0; n < 2; ++n) acc[a][b][m][n] = (f32x4){0.f, 0.f, 0.f, 0.f};
    bf16x8 At[4][2], B0[2][2], B1[2][2];
    const char* cA = (const char*)g.A + (size_t)cur.pm * tstep; const char* cB = (const char*)g.Bt + (size_t)cur.pn * tstep;
    S.a_ready(cur);
    if constexpr (SP2) {
        PG8_STAGE(PG8_SB(0, 0), cB, voffB); PG8_STAGE(PG8_SB(0, 1), cB + hstep, voffB); PG8_STAGE(PG8_SA(0, 0), cA, voffA); PG8_STAGE(PG8_SA(0, 1), cA + hstep, voffA);
        if (wr == 1) PG8_BAR;
        PG8_WAIT_V(2); PG8_BAR;
        PG8_STAGE(PG8_SB(1, 0), cB + kstep, voffB); PG8_STAGE(PG8_SA(1, 0), cA + kstep, voffA); PG8_STAGE(PG8_SB(1, 1), cB + hstep + kstep, voffB);
        PG8_WAIT_V(6); PG8_BAR;
    } else {
        PG8_STAGE(PG8_SB(0, 0), cB, voffB); PG8_STAGE(PG8_SA(0, 0), cA, voffA); PG8_STAGE(PG8_SB(0, 1), cB + hstep, voffB); PG8_STAGE(PG8_SA(0, 1), cA + hstep, voffA);
        if (wr == 1) PG8_BAR;
        PG8_WAIT_V(4); PG8_BAR;
        PG8_STAGE(PG8_SB(1, 0), cB + kstep, voffB); PG8_STAGE(PG8_SA(1, 0), cA + kstep, voffA); PG8_STAGE(PG8_SB(1, 1), cB + hstep + kstep, voffB);
        PG8_WAIT_V(6); PG8_BAR;
    }
    for (;;) {
        const bool has_next = S.next(ui + 1, nxt);
        const char* nA = has_next ? (const char*)g.A + (size_t)nxt.pm * tstep : cA; const char* nB = has_next ? (const char*)g.Bt + (size_t)nxt.pn * tstep : cB;
        for (int t = 0; t < nt; t += 2) {
            const bool last = (t == nt - 2);
            const char* a1 = cA + (size_t)(t + 1) * kstep;
            const char* a2 = last ? nA : cA + (size_t)(t + 2) * kstep; const char* b2 = last ? nB : cB + (size_t)(t + 2) * kstep;
            const char* a3 = a2 + kstep; const char* b3 = b2 + kstep;
            if (last && has_next) S.a_ready(nxt);
            if constexpr (SP2) {
            PG8_LDB(B0, 0, 0); PG8_LDB(B1, 0, 1); PG8_SCHED; PG8_LDA(At, 0, 0); PG8_STAGE(PG8_SA(1, 1), a1 + hstep, voffA);
            PG8_WAIT_V(8); PG8_WAIT_L(0); PG8_BAR; PG8_MMA(0, 0, At, B0); PG8_MMA(0, 1, At, B1); PG8_BAR; PG8_SCHED;
            PG8_LDA(At, 0, 1); PG8_STAGE(PG8_SB(0, 0), b2, voffB); PG8_STAGE(PG8_SB(0, 1), b2 + hstep, voffB); PG8_STAGE(PG8_SA(0, 0), a2, voffA);
            PG8_WAIT_V(8); PG8_WAIT_L(0); PG8_BAR; PG8_MMA(1, 0, At, B0); PG8_MMA(1, 1, At, B1); PG8_BAR; PG8_SCHED;
            PG8_LDB(B0, 1, 0); PG8_LDB(B1, 1, 1); PG8_SCHED; PG8_LDA(At, 1, 0); PG8_STAGE(PG8_SA(0, 1), a2 + hstep, voffA);
            PG8_WAIT_V(8); PG8_WAIT_L(0); PG8_BAR; PG8_MMA(0, 0, At, B0); PG8_MMA(0, 1, At, B1); PG8_BAR; PG8_SCHED;
            PG8_LDA(At, 1, 1); PG8_STAGE(PG8_SB(1, 0), b3, voffB); PG8_STAGE(PG8_SB(1, 1), b3 + hstep, voffB); PG8_STAGE(PG8_SA(1, 0), a3, voffA);
            PG8_WAIT_V(8); PG8_WAIT_L(0); PG8_BAR; PG8_MMA(1, 0, At, B0); PG8_MMA(1, 1, At, B1); PG8_BAR; PG8_SCHED;
            } else {
            PG8_LDB(B0, 0, 0); PG8_SCHED; PG8_LDA(At, 0, 0); PG8_STAGE(PG8_SA(1, 1), a1 + hstep, voffA);
            PG8_WAIT_L(8); PG8_BAR; PG8_WAIT_L(0); PG8_MMA(0, 0, At, B0); PG8_BAR; PG8_SCHED;
            PG8_LDB(B1, 0, 1); PG8_STAGE(PG8_SB(0, 0), b2, voffB);
            PG8_BAR; PG8_WAIT_L(0); PG8_MMA(0, 1, At, B1); PG8_BAR;
            PG8_LDA(At, 0, 1); PG8_STAGE(PG8_SA(0, 0), a2, voffA);
            PG8_BAR; PG8_WAIT_L(0); PG8_MMA(1, 0, At, B0); PG8_BAR; PG8_SCHED;
            PG8_STAGE(PG8_SB(0, 1), b2 + hstep, voffB);
            PG8_WAIT_V(6); PG8_BAR; PG8_MMA(1, 1, At, B1); PG8_BAR;
            PG8_LDB(B0, 1, 0); PG8_SCHED; PG8_LDA(At, 1, 0); PG8_STAGE(PG8_SA(0, 1), a2 + hstep, voffA);
            PG8_WAIT_L(8); PG8_BAR; PG8_WAIT_L(0); PG8_MMA(0, 0, At, B0); PG8_BAR; PG8_SCHED;
            PG8_LDB(B1, 1, 1); PG8_STAGE(PG8_SB(1, 0), b3, voffB);
            PG8_BAR; PG8_WAIT_L(0); PG8_MMA(0, 1, At, B1); PG8_BAR;
            PG8_LDA(At, 1, 1); PG8_STAGE(PG8_SA(1, 0), a3, voffA);
            PG8_BAR; PG8_WAIT_L(0); PG8_MMA(1, 0, At, B0); PG8_BAR; PG8_SCHED;
            PG8_STAGE(PG8_SB(1, 1), b3 + hstep, voffB);
            PG8_WAIT_V(6); PG8_BAR; PG8_MMA(1, 1, At, B1); PG8_BAR;
            }
        }
        if constexpr (ALIGN_EPI) { if (wr == 0) PG8_BAR; }
        if constexpr (!Epi::AFTER_DRAIN) { int le_; asm volatile("v_mbcnt_lo_u32_b32 %0, -1, 0\n\tv_mbcnt_hi_u32_b32 %0, -1, %0" : "=v"(le_)); E(acc, cur, wr, wc, le_ & 15, le_ >> 4); S.done(cur); }
        if (!has_next) break;
#pragma unroll
        for (int a = 0; a < 2; ++a)
#pragma unroll
            for (int b = 0; b < 2; ++b)
#pragma unroll
                for (int m = 0; m < 4; ++m)
#pragma unroll
                    for (int n = 0; n < 2; ++n) acc[a][b][m][n] = (f32x4){0.f, 0.f, 0.f, 0.f};
        cur = nxt; cA = nA; cB = nB; ++ui;
        if constexpr (ALIGN_EPI) { if (wr == 1) PG8_BAR; }
    }
    PG8_WAIT_V(0);
    if constexpr (!ALIGN_EPI) { if (wr == 0) PG8_BAR; }
    PG8_BAR;
    if constexpr (Epi::AFTER_DRAIN) { E.fused(acc, cur, wr, wc, fr, fq, lds, wid, lane); S.done(cur); }
#undef PG8_SA
#undef PG8_SB
#undef PG8_STAGE
#undef PG8_LDA
#undef PG8_LDB
#undef PG8_MMA
#undef PG8_WAIT_V
#undef PG8_WAIT_L
#undef PG8_BAR
#undef PG8_SCHED
}
}

#define LAS __attribute__((address_space(3)))
constexpr int NWAVES = 8, NTHR = 512;
constexpr int LDS_BYTES = 147456;
constexpr int NPH = 21;
typedef float f32x4 __attribute__((ext_vector_type(4)));
typedef unsigned u32x4 __attribute__((ext_vector_type(4)));

struct Args { const float* in[30]; float* out; unsigned char* ws; int ph_lo, ph_hi; };

__device__ __forceinline__ unsigned pk2(float lo, float hi) { return cvtpk(lo, hi); }

__device__ __forceinline__ void p0_transpose_item(const float* W, int K, int N, bf16* WT, int row_off, LAS float* scr, int item, int lane) {
    const int nblk = N / 32, kb = item / nblk, nb = item % nblk, k0 = 64 * kb, n0 = 32 * nb;
#pragma unroll 8
    for (int i = 0; i < 32; ++i) { const int kk = 2 * i + (lane >> 5); scr[kk * 33 + (lane & 31)] = W[(size_t)(k0 + kk) * N + n0 + (lane & 31)]; }
    asm volatile("s_waitcnt lgkmcnt(0)" ::: "memory");
    const int c = lane & 7;
#pragma unroll
    for (int j = 0; j < 4; ++j) { const int n = (lane >> 3) + 8 * j; const LAS float* s = scr + (8 * c) * 33 + n;
        u32x4 o; o.x = pk2(s[0 * 33], s[1 * 33]); o.y = pk2(s[2 * 33], s[3 * 33]); o.z = pk2(s[4 * 33], s[5 * 33]); o.w = pk2(s[6 * 33], s[7 * 33]);
        *(u32x4*)(WT + (size_t)(row_off + n0 + n) * K + k0 + 8 * c) = o; }
    asm volatile("s_waitcnt lgkmcnt(0)" ::: "memory");
}

__device__ __forceinline__ void norm_mod_row(const float* xr, const float* gamma, const float* sh, const float* sc, bf16* orow, int lane) {
    f32x4 v[4]; float ss = 0.f;
#pragma unroll
    for (int j = 0; j < 4; ++j) { v[j] = *(const f32x4*)(xr + j * 256 + lane * 4); ss += (v[j].x * v[j].x + v[j].y * v[j].y) + (v[j].z * v[j].z + v[j].w * v[j].w); }
    const float rs = rsqrtf(wave_sum(ss, lane) * (1.f / D) + NORM_EPS);
#pragma unroll
    for (int j = 0; j < 4; ++j) { const int d = j * 256 + lane * 4; const f32x4 g = *(const f32x4*)(gamma + d), a = *(const f32x4*)(sc + d), s = *(const f32x4*)(sh + d);
        const f32x4 y = v[j] * rs * g * (a + 1.f) + s; uint2 o; o.x = pk2(y.x, y.y); o.y = pk2(y.z, y.w); *(uint2*)(orow + d) = o; }
}


#define XB_TMO      128
#define XB_XCNT(j)  (256  + 64 * (j))
#define XB_XSUB(j)  (1280 + 64 * (j))
#define XB_XGEN(j)  (2304 + 64 * (j))
#define XB_TOP      3328
#define XB_TOPGEN   3392
#define XCD_BAR_WORDS 3456
#define XB_SPIN_CAP (1u << 18)

__device__ __forceinline__ unsigned xb_ld(unsigned* p)              { return __hip_atomic_load(p, __ATOMIC_RELAXED, __HIP_MEMORY_SCOPE_AGENT); }
__device__ __forceinline__ unsigned xb_add(unsigned* p, unsigned v) { return __hip_atomic_fetch_add(p, v, __ATOMIC_RELAXED, __HIP_MEMORY_SCOPE_AGENT); }
__device__ __forceinline__ unsigned xb_xcc_id() { return (unsigned)__builtin_amdgcn_s_getreg((3 << 11) | 20) & 0xFu; }
#define XB_SPIN(cond, bar) do { unsigned _sp = 0; while (cond) { __builtin_amdgcn_s_sleep(1); \
    if ((++_sp & 255u) == 0u) { if (xb_ld(&(bar)[XB_TMO])) break; if (_sp > XB_SPIN_CAP) { atomicAdd(&(bar)[XB_TMO], 1u); break; } } } } while (0)

struct XcdBarrier {
    unsigned* bar; unsigned x; int w0;
    volatile __attribute__((address_space(3))) unsigned* st;
};

__device__ __forceinline__ XcdBarrier xcd_barrier_post(unsigned* bar, volatile __attribute__((address_space(3))) unsigned* st) {
    XcdBarrier b; b.bar = bar; b.x = xb_xcc_id(); b.st = st; b.w0 = __builtin_amdgcn_readfirstlane((int)threadIdx.x >> 6);
    if (threadIdx.x == 0) (void)xb_add(&bar[XB_XCNT(b.x)], 1u);
    return b;
}
__device__ __forceinline__ void xcd_barrier_complete(unsigned* bar, unsigned x, unsigned& nloc, unsigned& nx) {
    const unsigned G = gridDim.x * gridDim.y * gridDim.z;
    unsigned sum, cnt, mine, sp = 0u;
    for (;;) {
        sum = 0u; cnt = 0u; mine = 0u;
#pragma unroll
        for (unsigned j = 0; j < 16; ++j) { const unsigned c = xb_ld(&bar[XB_XCNT(j)]); sum += c; cnt += (c > 0u) ? 1u : 0u; }
        mine = xb_ld(&bar[XB_XCNT(x)]);
        if (sum == G) break;
        __builtin_amdgcn_s_sleep(1);
        if ((++sp & 255u) == 0u) { if (xb_ld(&bar[XB_TMO])) break; if (sp > XB_SPIN_CAP) { atomicAdd(&bar[XB_TMO], 1u); break; } }
    }
    nloc = mine > 0u ? mine : 1u; nx = cnt > 0u ? cnt : 1u;
}

template <bool FIRST> __device__ __forceinline__ void xcd_barrier(const XcdBarrier& b) {
    asm volatile("s_waitcnt vmcnt(0)" ::: "memory");
    __syncthreads();
    int lid_; asm volatile("v_mbcnt_lo_u32_b32 %0, -1, 0\n\tv_mbcnt_hi_u32_b32 %0, -1, %0" : "=v"(lid_));
    if (b.w0 == 0 && lid_ == 0) {
        unsigned* bar = b.bar;
        __builtin_amdgcn_s_waitcnt(0);
        unsigned nloc = b.st[0], nx = b.st[1];
        if (FIRST && nloc == 0u) { xcd_barrier_complete(bar, b.x, nloc, nx); b.st[0] = nloc; b.st[1] = nx; }
        const unsigned old = xb_add(&bar[XB_XSUB(b.x)], 1u);
        const unsigned gen = old / nloc;
        if (old + 1u == (gen + 1u) * nloc) {
            __builtin_amdgcn_fence(__ATOMIC_RELEASE, "agent");
            asm volatile("s_waitcnt vmcnt(0)" ::: "memory");
            const unsigned og = xb_add(&bar[XB_TOP], 1u);
            const unsigned tg = og / nx;
            if (og + 1u == (tg + 1u) * nx) xb_add(&bar[XB_TOPGEN], 1u);
            else XB_SPIN(xb_ld(&bar[XB_TOPGEN]) == tg, bar);
            __builtin_amdgcn_fence(__ATOMIC_ACQUIRE, "agent");
            xb_add(&bar[XB_XGEN(b.x)], 1u);
            asm volatile("s_waitcnt vmcnt(0)" ::: "memory");
        } else {
            XB_SPIN(xb_ld(&bar[XB_XGEN(b.x)]) == gen, bar);
            __builtin_amdgcn_fence(__ATOMIC_ACQUIRE, "agent");
            asm volatile("s_waitcnt vmcnt(0)" ::: "memory");
        }
    }
    __syncthreads();
}


__device__ __forceinline__ unsigned mono_u32(float f) { unsigned u = __float_as_uint(f); return (u & 0x80000000u) ? ~u : (u | 0x80000000u); }
__device__ __forceinline__ float demono_u32(unsigned u) { return __uint_as_float((u & 0x80000000u) ? (u & 0x7FFFFFFFu) : ~u); }
__device__ __forceinline__ unsigned pack_key7(float f, int idx) { return (mono_u32(f) & 0xFFFFFF80u) | (unsigned)(127 - idx); }
__device__ __forceinline__ float unpack_key7(unsigned k) { return demono_u32((k & 0xFFFFFF80u) | 0x40u); }
__device__ __forceinline__ float unpack_key8(unsigned k) { return demono_u32((k & 0xFFFFFF00u) | 0x80u); }
__device__ __forceinline__ void ce_desc(unsigned& a, unsigned& b) { const unsigned hi = a > b ? a : b, lo = a > b ? b : a; a = hi; b = lo; }
__device__ __forceinline__ void sort16_desc(unsigned* v) {
#pragma unroll
    for (int k = 2; k <= 16; k <<= 1)
#pragma unroll
        for (int j = k >> 1; j > 0; j >>= 1)
#pragma unroll
            for (int i = 0; i < 16; ++i) { const int l = i ^ j; if (l > i) { if ((i & k) == 0) ce_desc(v[i], v[l]); else ce_desc(v[l], v[i]); } }
}
__device__ __forceinline__ void bmerge16_desc(unsigned* v) {
#pragma unroll
    for (int j = 8; j > 0; j >>= 1)
#pragma unroll
        for (int i = 0; i < 16; ++i) { const int l = i ^ j; if (l > i) ce_desc(v[i], v[l]); }
}
__device__ __forceinline__ void merge_top16(unsigned* a, const unsigned* b) {
#pragma unroll
    for (int i = 0; i < 16; ++i) { const unsigned o = b[15 - i]; a[i] = a[i] > o ? a[i] : o; }
    bmerge16_desc(a);
}
__device__ __forceinline__ void stage2_cands(const unsigned* s0, const unsigned* s1, int hh, unsigned* c) {
    float A[16], B[16];
#pragma unroll
    for (int i = 0; i < 16; ++i) { const float f0 = unpack_key7(s0[i]), f1 = unpack_key7(s1[i]); A[i] = hh ? f1 : f0; B[i] = hh ? f0 : f1; }
    int n = 0;
#pragma unroll
    for (int i = 0; i < 4; ++i)
#pragma unroll
        for (int j = i; j < 16; ++j) { if ((i + 1) * (j + 1) > 16) continue;
            const float val = A[i] + B[j]; const unsigned id = hh ? (unsigned)((j << 4) | i) : (unsigned)((i << 4) | j);
            unsigned key = (mono_u32(val) & 0xFFFFFF00u) | id; if (hh && i == j) key = 0u; c[n++] = key; }
#pragma unroll
    for (; n < 32; ++n) c[n] = 0u;
}

typedef short bf16x8_t __attribute__((ext_vector_type(8)));
typedef float f32x16 __attribute__((ext_vector_type(16)));
__device__ __forceinline__ float gelu_erf(float a) { return 0.5f * a * (1.f + erff(a * 0.70710678118654752f)); }


typedef __attribute__((address_space(3))) bf16 lbf16;

__device__ __forceinline__ f32x16 mm32(bf16x8_t a, bf16x8_t b, f32x16 c) { return __builtin_amdgcn_mfma_f32_32x32x16_bf16(a, b, c, 0, 0, 0); }
__device__ __forceinline__ bf16x8_t frag_from_u32x4(unsigned x, unsigned y, unsigned z, unsigned w) { typedef unsigned u4 __attribute__((ext_vector_type(4))); u4 t = {x, y, z, w}; return __builtin_bit_cast(bf16x8_t, t); }
template <int S> __device__ __forceinline__ bf16x8_t accop(const f32x16& z) {
    return frag_from_u32x4(cvtpk(z[8 * S], z[8 * S + 1]), cvtpk(z[8 * S + 2], z[8 * S + 3]), cvtpk(z[8 * S + 4], z[8 * S + 5]), cvtpk(z[8 * S + 6], z[8 * S + 7])); }
template <int S> __device__ __forceinline__ bf16x8_t ldpermcol(const lbf16* a, int col, int hh) {
    const lbf16* p = a + (16 * S + 4 * hh) * 72 + col;
    const unsigned e0 = p[0], e1 = p[72], e2 = p[144], e3 = p[216], e4 = p[8 * 72], e5 = p[9 * 72], e6 = p[10 * 72], e7 = p[11 * 72];
    return frag_from_u32x4(e0 | (e1 << 16), e2 | (e3 << 16), e4 | (e5 << 16), e6 | (e7 << 16)); }
__device__ __forceinline__ bf16x8_t ldrow(const lbf16* a, int row, int ks, int hh) { return *(const __attribute__((address_space(3))) bf16x8_t*)(a + row * 72 + ks * 16 + 8 * hh); }
__device__ __forceinline__ int rowidx(int e, int hh) { return (e & 3) + 8 * (e >> 2) + 4 * hh; }

constexpr int ROWB = 768;
__device__ __forceinline__ unsigned fp6code(float x, float sc) {
    const float t = fabsf(x) * sc;
    const float r = t < 16.f ? __builtin_rintf(t) : (t < 32.f ? 8.f + __builtin_rintf(t * 0.5f) : 16.f + __builtin_rintf(t * 0.25f));
    unsigned c = (unsigned)r; c = c > 31u ? 31u : c;
    return c | (x < 0.f ? 32u : 0u);
}
__device__ __forceinline__ void convert_tables_fp6(const float* pu, const float* pv, unsigned char* u8, unsigned char* v8, float* usc, float* vsc, int l, int wv, int nw, int lane) {
    for (int rr0 = wv * 2; rr0 < 2 * NEXP; rr0 += nw * 2) {
        f32x4 v[2][4]; float m[2];
#pragma unroll
        for (int rr = 0; rr < 2; ++rr) { const int q = rr0 + rr; const size_t row = (size_t)l * NEXP + (q < NEXP ? q : q - NEXP); const float* sp_ = (q < NEXP ? pu : pv) + row * D + lane * 16;
#pragma unroll
            for (int k = 0; k < 4; ++k) v[rr][k] = *(const f32x4*)(sp_ + k * 4); }
#pragma unroll
        for (int rr = 0; rr < 2; ++rr) { float mm = 0.f;
#pragma unroll
            for (int k = 0; k < 4; ++k) mm = fmaxf(fmaxf(mm, fmaxf(fabsf(v[rr][k].x), fabsf(v[rr][k].y))), fmaxf(fabsf(v[rr][k].z), fabsf(v[rr][k].w)));
#pragma unroll
            for (int o = 1; o < 64; o <<= 1) mm = fmaxf(mm, shflx(mm, lane, o));
            m[rr] = mm; }
#pragma unroll
        for (int rr = 0; rr < 2; ++rr) { const int q = rr0 + rr; const size_t row = (size_t)l * NEXP + (q < NEXP ? q : q - NEXP); const float sc = m[rr] > 0.f ? 60.f / m[rr] : 1.f;
            unsigned c[16];
#pragma unroll
            for (int k = 0; k < 4; ++k) { c[k * 4] = fp6code(v[rr][k].x, sc); c[k * 4 + 1] = fp6code(v[rr][k].y, sc); c[k * 4 + 2] = fp6code(v[rr][k].z, sc); c[k * 4 + 3] = fp6code(v[rr][k].w, sc); }
            const unsigned o0 = c[0] | (c[1] << 6) | (c[2] << 12) | (c[3] << 18) | (c[4] << 24) | (c[5] << 30);
            const unsigned o1 = (c[5] >> 2) | (c[6] << 4) | (c[7] << 10) | (c[8] << 16) | (c[9] << 22) | (c[10] << 28);
            const unsigned o2 = (c[10] >> 4) | (c[11] << 2) | (c[12] << 8) | (c[13] << 14) | (c[14] << 20) | (c[15] << 26);
            unsigned* op = (unsigned*)((q < NEXP ? u8 : v8) + row * ROWB + lane * 12);
            op[0] = o0; op[1] = o1; op[2] = o2;
            if (lane == 0) (q < NEXP ? usc : vsc)[row] = m[rr] > 0.f ? m[rr] * (1.f / 7.5f) : 1.f; }
    }
}

__global__ void __launch_bounds__(NTHR, 2) mega(Args args) {
    extern __shared__ __attribute__((aligned(16))) unsigned char lds_raw[];
    LAS unsigned char* lds = (LAS unsigned char*)lds_raw;
    const int G = gridDim.x, bx = blockIdx.x, NGW = G * NWAVES;
    const int wave0 = __builtin_amdgcn_readfirstlane((int)threadIdx.x >> 6);
    typedef const unsigned char __attribute__((address_space(4))) kbyte;
#define PHASE_IDS int tid; asm volatile("v_mbcnt_lo_u32_b32 %0, -1, 0\n\tv_mbcnt_hi_u32_b32 %0, -1, %0" : "=v"(tid)); tid += wave0 * 64;     const int lane = tid & 63, wave = __builtin_amdgcn_readfirstlane(tid >> 6), gw = bx * NWAVES + wave; (void)lane; (void)gw; \
    kbyte* kp = (kbyte*)__builtin_amdgcn_kernarg_segment_ptr(); asm volatile("" : "+s"(kp)); \
    unsigned char* const ws = (unsigned char*)*(__attribute__((address_space(1))) unsigned char* const __attribute__((address_space(4)))*)(kp + 31 * 8); float* const X = (float*)*(__attribute__((address_space(1))) float* const __attribute__((address_space(4)))*)(kp + 30 * 8); (void)ws; (void)X;
#define INP(i) ((const float*)(*(const __attribute__((address_space(1))) float* const __attribute__((address_space(4)))*)(kp + (i) * 8)))
#define MOD ((float*)(ws + WS_MOD))
#define H ((bf16*)(ws + WS_H))
#define PROJ ((bf16*)(ws + WS_PROJ))
#define Q ((bf16*)(ws + WS_Q))
#define MIX ((bf16*)(ws + WS_MIX))
#define Rb ((bf16*)(ws + WS_R))
#define Kb ((bf16*)(ws + WS_K))
#define V0 ((bf16*)(ws + WS_V0))
#define V1 ((bf16*)(ws + WS_V1))
#define KKb ((bf16*)(ws + WS_KK))
#define Bb ((bf16*)(ws + WS_B))
#define Gb ((bf16*)(ws + WS_G))
#define BGb ((bf16*)(ws + WS_BG))
#define Wd ((float*)(ws + WS_W))
#define Y ((float*)(ws + WS_Y))
#define QB ((float*)(ws + WS_QB))
#define POOLIN ((bf16*)(ws + WS_QB))
#define SH ((float*)(ws + WS_SH))
#define SSQ ((unsigned long long*)(ws + WS_SH))
#define CVEC ((float*)(ws + WS_SH + 512 * 1024))
#define S2V ((float*)(ws + WS_SH + 640 * 1024))
#define XB2 ((bf16*)(ws + WS_R))
#define WUPT ((bf16*)(ws + WS_LORA))
#define AUPT ((bf16*)(ws + WS_LORA + 131072))
#define GUPT ((bf16*)(ws + WS_LORA + 262144))
#define VUPT ((bf16*)(ws + WS_LORA + 524288))
#define PWT ((bf16*)(ws + WS_LORA + 655360))
#define INVN ((float*)(ws + WS_INVN))
#define BSUM ((float*)(ws + WS_BSUM))
#define SCN ((unsigned char*)(ws + WS_SCN))
#define IDX ((int*)(ws + WS_IDX))
#define GATE ((float*)(ws + WS_GATE))
#define WinT ((bf16*)(ws + WS_WIN_T))
#define WoutT ((bf16*)(ws + WS_WOUT_T))
#define PqT ((bf16*)(ws + WS_PQ_T))
#define KEYS ((bf16*)(ws + WS_KEYS))
#define U8 ((unsigned char*)(ws + WS_U))
#define V8 ((unsigned char*)(ws + WS_V))
#define USc ((float*)(ws + WS_US))
#define VSc ((float*)(ws + WS_VS))
    const int lo = args.ph_lo, hi = args.ph_hi;
    { volatile LAS unsigned* misc = (volatile LAS unsigned*)(lds + LDS_BYTES - 64); if (threadIdx.x < 4) misc[threadIdx.x] = 0u; __syncthreads(); }
    const XcdBarrier xbar = xcd_barrier_post((unsigned*)(args.ws) + 4096, (volatile LAS unsigned*)(lds + LDS_BYTES - 64));
#define IN(k) (lo <= (k) && (k) < hi)
#ifndef REP_PHASE
#define REP_PHASE (-1)
#endif
#define REPS(k) ((k) == REP_PHASE ? 3 : 1)
#define SEAM(k) do { if (IN(k) && IN((k) + 1)) { if ((k) == 0) cg::this_grid().sync(); else { XcdBarrier xb_ = xbar; asm volatile("" : "+s"(xb_.bar)); if ((k) == 1) xcd_barrier<true>(xb_); else xcd_barrier<false>(xb_); } } } while (0)

    if (IN(0)) { PHASE_IDS
        { unsigned long long* z = SSQ; for (int i = bx * NTHR + tid; i < 2 * T; i += G * NTHR) z[i] = 0ull; }
        { LAS float* ca = (LAS float*)lds; LAS float* red = (LAS float*)(lds + 16384);
          const float* c = INP(1); const float* ada_w = INP(2); const float* ada_b = INP(3);
          bool have = false;
          for (int it = bx; it < 96; it += G) {
              if (!have) { for (int i = tid; i < BATCH * D; i += NTHR) { const float v = c[i]; ca[i] = v / (1.f + expf(-v)); } have = true; __syncthreads(); }
              const int l = it / 48, n = (it % 48) * 128 + (tid & 127), kq = tid >> 7;
              const float* w = ada_w + (size_t)l * D * 6 * D + (size_t)(kq * 256) * 6 * D + n;
              float a0 = 0.f, a1 = 0.f, a2 = 0.f, a3 = 0.f;
#pragma unroll 32
              for (int k = 0; k < 256; ++k) { const float wv = w[(size_t)k * 6 * D]; const int kk = kq * 256 + k; a0 += ca[kk] * wv; a1 += ca[D + kk] * wv; a2 += ca[2 * D + kk] * wv; a3 += ca[3 * D + kk] * wv; }
              red[(kq * 4 + 0) * 128 + (tid & 127)] = a0; red[(kq * 4 + 1) * 128 + (tid & 127)] = a1; red[(kq * 4 + 2) * 128 + (tid & 127)] = a2; red[(kq * 4 + 3) * 128 + (tid & 127)] = a3;
              __syncthreads();
              { const int b = tid >> 7, col = tid & 127, nn = (it % 48) * 128 + col;
                const float s = red[(0 * 4 + b) * 128 + col] + red[(1 * 4 + b) * 128 + col] + red[(2 * 4 + b) * 128 + col] + red[(3 * 4 + b) * 128 + col];
                MOD[(size_t)l * BATCH * 6 * D + (size_t)b * 6 * D + nn] = s + ada_b[l * 6 * D + nn]; }
              __syncthreads();
          }
          __syncthreads(); }
        { LAS float* scr = (LAS float*)(lds + wave * 16384);
          constexpr int I_IN = (D / 64) * (IN_COLS / 32), I_VR = (D / 64) * (MVL / 32), I_OUT = (D / 64) * (D / 32), I_PQ = (D / 64) * (PH * PQ / 32);
          constexpr int NIT = 2 * I_IN + I_VR + 2 * I_OUT + 2 * I_PQ;
          for (int it = gw; it < NIT; it += NGW) { int r = it;
              if (r < 2 * I_IN) { const int l = r / I_IN; p0_transpose_item(INP(5) + (size_t)l * D * IN_COLS, D, IN_COLS, WinT + (size_t)l * LDP * D, 0, scr, r % I_IN, lane); continue; } r -= 2 * I_IN;
              if (r < I_VR) { p0_transpose_item(INP(12), D, MVL, WinT + (size_t)1 * LDP * D, IN_COLS, scr, r, lane); continue; } r -= I_VR;
              if (r < 2 * I_OUT) { const int l = r / I_OUT; p0_transpose_item(INP(23) + (size_t)l * D * D, D, D, WoutT + (size_t)l * D * D, 0, scr, r % I_OUT, lane); continue; } r -= 2 * I_OUT;
              { const int l = r / I_PQ; p0_transpose_item(INP(25) + (size_t)l * D * PH * PQ, D, PH * PQ, PqT + (size_t)l * PH * PQ * D, 0, scr, r % I_PQ, lane); } }
          for (int it = gw; it < 2 * 16 + 2 * 16 + 2 * 32; it += NGW) { int r = it;
              if (r < 32) { const int l = r / 16; p0_transpose_item(INP(8) + (size_t)l * DL * RW, DL, RW, WUPT + (size_t)l * RW * DL, 0, scr, r % 16, lane); continue; } r -= 32;
              if (r < 32) { const int l = r / 16; p0_transpose_item(INP(10) + (size_t)l * AL * RW, AL, RW, AUPT + (size_t)l * RW * AL, 0, scr, r % 16, lane); continue; } r -= 32;
              { const int l = r / 32; p0_transpose_item(INP(11) + (size_t)l * GL * RW, GL, RW, GUPT + (size_t)l * RW * GL, 0, scr, r % 32, lane); } }
          { const float* vu = INP(15); for (int e = bx * NTHR + tid; e < MVL * RW; e += G * NTHR) { const int n = e >> 5, k = e & 31; VUPT[e] = f2bf(vu[k * RW + n]); } }
          for (int it = gw; it < 8 * 8; it += NGW) p0_transpose_item(INP(21) + (size_t)(it >> 3) * PG * PG, PG, PG, PWT + (size_t)(it >> 3) * PG * PG, 0, scr, it & 7, lane);
        }
        { const size_t gt = (size_t)bx * NTHR + tid, NT = (size_t)G * NTHR;
          constexpr size_t NK8 = (size_t)2 * PH * 2 * NKEYS * PHALF / 8;
          const float* src = INP(26); bf16* dst = KEYS;
          for (size_t i = gt; i < NK8; i += NT) {
              const f32x4 a = *(const f32x4*)(src + i * 8), b = *(const f32x4*)(src + i * 8 + 4);
              u32x4 o; o.x = pk2(a.x, a.y); o.y = pk2(a.z, a.w); o.z = pk2(b.x, b.y); o.w = pk2(b.z, b.w); *(u32x4*)(dst + i * 8) = o; }
        }
    }
    SEAM(0);

#pragma unroll
    for (int l = 0; l < DEPTH; ++l) {
        const int pb = 1 + 10 * l;
#define modl (MOD + (size_t)l * BATCH * 6 * D)
#define xin (l == 0 ? INP(0) : (const float*)X)
        if (l == 0 && IN(pb + 0)) { PHASE_IDS const float* gamma = INP(4) + l * D;
            for (int row = gw; row < T; row += NGW) { const int b = row / SEQ; norm_mod_row(xin + (size_t)row * D, gamma, modl + (size_t)b * 6 * D, modl + (size_t)b * 6 * D + D, H + (size_t)row * D, lane); } }
        SEAM(pb + 0);
        if (IN(pb + 1)) { PHASE_IDS const int N1 = l == 0 ? IN_COLS : LDP;
            pg8::Gemm g{H, WinT + (size_t)l * LDP * D, T, N1, D}; pg8::StaticOrder S; S.init(T, N1, G, bx);
            pg8::EpiProj E{PROJ, LDP, POOLIN, RWKV_COLS, PW};
            pg8::gemm_phase<pg8::EpiProj, pg8::StaticOrder, true, true>(lds, g, S, E, tid); }
        SEAM(pb + 1);

        if (IN(pb + 2)) { PHASE_IDS
            constexpr int LST = 296;
            LAS bf16* lin = (LAS bf16*)lds;
            const float* mu = INP(6) + l * RWKV_COLS; const float* vmu = INP(13);
            const float* w0p = INP(7) + l * RW; const float* a0p = INP(9) + l * RW; const float* kkp = INP(16) + l * RW; const float* kap = INP(17) + l * RW; const float* rkp = INP(18) + l * RW; const float* v0p = INP(14);
            const bf16* wupT = WUPT + (size_t)l * RW * DL; const bf16* aupT = AUPT + (size_t)l * RW * AL; const bf16* gupT = GUPT + (size_t)l * RW * GL; const bf16* vupT = VUPT;
            bf16* Vl = l == 0 ? V0 : V1;
            const int r32 = lane & 31, hh = lane >> 5, h = wave;
            for (int tile = bx; tile < T / 32; tile += G) {
                const int t0 = tile * 32;
                __syncthreads();
#pragma unroll 1
                for (int it0 = 0; it0 < 3; it0 += 2) {
                  u32x4 cu_[2], pv_[2]; f32x4 m0_[2], m1_[2];
#pragma unroll
                  for (int it = 0; it < 2; ++it) { const int c8 = tid + (it0 + it) * NTHR; const bool ok = c8 < 32 * 36; const int tok = ok ? c8 / 36 : 0, jc = ok ? c8 % 36 : 0, t = t0 + tok, sq = t % SEQ;
                      cu_[it] = (u32x4){0u, 0u, 0u, 0u}; pv_[it] = (u32x4){0u, 0u, 0u, 0u}; m0_[it] = (f32x4){0.f, 0.f, 0.f, 0.f}; m1_[it] = m0_[it];
                      if (ok && (jc < 32 || l > 0)) { const int col = jc < 32 ? 3 * RW + jc * 8 : IN_COLS + (jc - 32) * 8;
                          cu_[it] = *(const u32x4*)(PROJ + (size_t)t * LDP + col); if (sq > 0) pv_[it] = *(const u32x4*)(PROJ + (size_t)(t - 1) * LDP + col);
                          const float* mp = jc < 32 ? mu + col : vmu + (jc - 32) * 8; m0_[it] = *(const f32x4*)mp; m1_[it] = *(const f32x4*)(mp + 4); } }
#pragma unroll
                  for (int it = 0; it < 2; ++it) { const int c8 = tid + (it0 + it) * NTHR; if (c8 < 32 * 36) { const int tok = c8 / 36, jc = c8 % 36;
                      u32x4 o = {0u, 0u, 0u, 0u};
                      if (jc < 32 || l > 0) {
                          float x[8]; const unsigned cw[4] = {cu_[it].x, cu_[it].y, cu_[it].z, cu_[it].w}, pw[4] = {pv_[it].x, pv_[it].y, pv_[it].z, pv_[it].w}; const float mm[8] = {m0_[it].x, m0_[it].y, m0_[it].z, m0_[it].w, m1_[it].x, m1_[it].y, m1_[it].z, m1_[it].w};
#pragma unroll
                          for (int i = 0; i < 4; ++i) { const float c0 = __uint_as_float(cw[i] << 16), c1 = __uint_as_float(cw[i] & 0xffff0000u), p0 = __uint_as_float(pw[i] << 16), p1 = __uint_as_float(pw[i] & 0xffff0000u);
                              x[2 * i] = c0 + (p0 - c0) * mm[2 * i]; x[2 * i + 1] = c1 + (p1 - c1) * mm[2 * i + 1]; }
                          if (jc < 8) {
#pragma unroll
                              for (int i = 0; i < 8; ++i) { const float e2 = __expf(-2.f * fabsf(x[i])); const float th = (1.f - e2) * __builtin_amdgcn_rcpf(1.f + e2); x[i] = x[i] < 0.f ? -th : th; } }
                          else if (jc >= 16 && jc < 32) {
#pragma unroll
                              for (int i = 0; i < 8; ++i) x[i] = __builtin_amdgcn_rcpf(1.f + __expf(-x[i])); }
                          o.x = pk2(x[0], x[1]); o.y = pk2(x[2], x[3]); o.z = pk2(x[4], x[5]); o.w = pk2(x[6], x[7]);
                      }
                      *(LAS u32x4*)(lin + tok * LST + jc * 8) = o; } } }
                __syncthreads();
                const bool first = (t0 % SEQ) == 0;
                lbf16* tin = (lbf16*)(lds + 19456 + wave * 14336);
                { u32x4 iq[13]; int ql_; asm volatile("v_mbcnt_lo_u32_b32 %0, -1, 0\n\tv_mbcnt_hi_u32_b32 %0, -1, %0" : "=v"(ql_));
#pragma unroll
                  for (int i = 0; i < 13; ++i) { const int q = ql_ + 64 * i; iq[i] = (u32x4){0u, 0u, 0u, 0u};
                      if (q < 792) { const int arr = q / 264, rem = q - arr * 264, row = rem >> 3, cc = rem & 7;
                          if (!(first && row == 0)) iq[i] = *(const u32x4*)(PROJ + (size_t)(t0 - 1 + row) * LDP + arr * RW + h * HS + cc * 8); } }
#pragma unroll
                  for (int i = 0; i < 13; ++i) { const int q = ql_ + 64 * i; if (q < 792) { const int arr = q / 264, rem = q - arr * 264, row = rem >> 3, cc = rem & 7;
                      *(__attribute__((address_space(3))) u32x4*)(tin + arr * 2376 + row * 72 + cc * 8) = iq[i]; } } }
                __builtin_amdgcn_wave_barrier(); asm volatile("s_waitcnt lgkmcnt(0)" ::: "memory");
                float ssq[16], bsm[16];
#pragma unroll
                for (int e = 0; e < 16; ++e) { ssq[e] = 0.f; bsm[e] = 0.f; }
#pragma unroll 1
                for (int rt = 0; rt < 2; ++rt) {
                    f32x16 accW, accA, accG, accV;
#pragma unroll
                    for (int e = 0; e < 16; ++e) { accW[e] = 0.f; accA[e] = 0.f; accG[e] = 0.f; accV[e] = 0.f; }
                    int c = h * HS + rt * 32 + r32;
int hh8 = 8 * hh; asm volatile("" : "+v"(c), "+v"(hh8));
                    const LAS bf16* lrow = lin + r32 * LST + 8 * hh;
                    { bf16x8_t wf[18];
#pragma unroll
                      for (int ks = 0; ks < 4; ++ks) { wf[ks] = *(const bf16x8_t*)(wupT + (size_t)c * DL + ks * 16 + hh8); wf[4 + ks] = *(const bf16x8_t*)(aupT + (size_t)c * AL + ks * 16 + hh8); }
#pragma unroll
                      for (int ks = 0; ks < 8; ++ks) wf[8 + ks] = *(const bf16x8_t*)(gupT + (size_t)c * GL + ks * 16 + hh8);
                      wf[16] = bf16x8_t{}; wf[17] = bf16x8_t{};
                      if (l > 0) { wf[16] = *(const bf16x8_t*)(vupT + (size_t)c * MVL + hh8); wf[17] = *(const bf16x8_t*)(vupT + (size_t)c * MVL + 16 + hh8); }
#pragma unroll
                      for (int ks = 0; ks < 4; ++ks) { accW = __builtin_amdgcn_mfma_f32_32x32x16_bf16(*(const LAS bf16x8_t*)(lrow + ks * 16), wf[ks], accW, 0, 0, 0);
                                                       accA = __builtin_amdgcn_mfma_f32_32x32x16_bf16(*(const LAS bf16x8_t*)(lrow + 64 + ks * 16), wf[4 + ks], accA, 0, 0, 0); }
#pragma unroll
                      for (int ks = 0; ks < 8; ++ks) accG = __builtin_amdgcn_mfma_f32_32x32x16_bf16(*(const LAS bf16x8_t*)(lrow + 128 + ks * 16), wf[8 + ks], accG, 0, 0, 0);
                      if (l > 0) {
#pragma unroll
                          for (int ks = 0; ks < 2; ++ks) accV = __builtin_amdgcn_mfma_f32_32x32x16_bf16(*(const LAS bf16x8_t*)(lrow + 256 + ks * 16), wf[16 + ks], accV, 0, 0, 0); } }
                    const float mur = mu[c], muk = mu[RW + c], muv = mu[2 * RW + c], w0c = w0p[c], a0c = a0p[c], kkc = kkp[c], kac = kap[c], rkc = rkp[c];
                    const float v0c = l > 0 ? v0p[c] : 0.f;
#pragma unroll
                    for (int eb = 0; eb < 16; eb += 4) {
                        bf16 lr[4], lk[4], lv[4], lrp[4], lkp[4], lvp[4], lvf[4];
#pragma unroll
                        for (int i = 0; i < 4; ++i) { const int e = eb + i; const int tok = (e & 3) + 8 * (e >> 2) + 4 * hh, t = t0 + tok; const int ci = rt * 32 + r32;
                            lr[i] = tin[(tok + 1) * 72 + ci]; lk[i] = tin[2376 + (tok + 1) * 72 + ci]; lv[i] = tin[2 * 2376 + (tok + 1) * 72 + ci];
                            lrp[i] = tin[tok * 72 + ci]; lkp[i] = tin[2376 + tok * 72 + ci]; lvp[i] = tin[2 * 2376 + tok * 72 + ci];
                            lvf[i] = l > 0 ? V0[(size_t)t * RW + c] : (bf16)0; }
                        __builtin_amdgcn_sched_barrier(0);
#pragma unroll
                        for (int i = 0; i < 4; ++i) { const int e = eb + i; const int tok = (e & 3) + 8 * (e >> 2) + 4 * hh, t = t0 + tok; const size_t o = (size_t)t * RW + c;
                            float r = bf2f(lr[i]), k = bf2f(lk[i]), v = bf2f(lv[i]);
                            r += (bf2f(lrp[i]) - r) * mur; k += (bf2f(lkp[i]) - k) * muk; v += (bf2f(lvp[i]) - v) * muv;
                            const float z = -(w0c + accW[e]); const float sp = fmaxf(z, 0.f) + __logf(1.f + __expf(-fabsf(z)));
                            const float decay = __expf(-__expf(-sp - 0.5f));
                            const float a = __builtin_amdgcn_rcpf(1.f + __expf(-(a0c + accA[e]))); const float g = accG[e];
                            if (l > 0) { const float vfv = bf2f(lvf[i]); v = v + (vfv - v) * __builtin_amdgcn_rcpf(1.f + __expf(-(v0c + accV[e]))); }
                            const float kk = k * kkc; const float k2 = k * (1.f + (a - 1.f) * kac);
                            ssq[e] += kk * kk; bsm[e] += r * k2 * rkc;
                            { const unsigned p0_ = cvtpk(r, k2), p1_ = cvtpk(v, kk), p2_ = cvtpk(kk * a, g), p3_ = cvtpk(v * g, 0.f);
                              Rb[o] = (bf16)p0_; Kb[o] = (bf16)(p0_ >> 16); Vl[o] = (bf16)p1_; KKb[o] = (bf16)(p1_ >> 16); Bb[o] = (bf16)p2_; Gb[o] = (bf16)(p2_ >> 16); BGb[o] = (bf16)p3_; Wd[o] = decay; }
                        }
                    }
                }
#pragma unroll
                for (int e = 0; e < 16; ++e) { const int ln_ = r32 | (hh << 5); float a_ = red16(ssq[e]), b_ = red16(bsm[e]); a_ += shflx(a_, ln_, 16); b_ += shflx(b_, ln_, 16); ssq[e] = a_; bsm[e] = b_; }
                if (r32 == 0) {
#pragma unroll
                    for (int e = 0; e < 16; ++e) { const int tok = (e & 3) + 8 * (e >> 2) + 4 * hh; INVN[(size_t)(t0 + tok) * NH + h] = rsqrtf(fmaxf(ssq[e], 1e-24f)); BSUM[(size_t)(t0 + tok) * NH + h] = bsm[e]; } }
            }
        }
        SEAM(pb + 2);

        if (IN(pb + 3)) { PHASE_IDS
            const bf16* Vl = l == 0 ? V0 : V1;
            const int r32 = lane & 31, hh = lane >> 5;
            if (wave < 6) {
                lbf16* At = (lbf16*)(lds + wave * 23552); lbf16* Bt = At + 2304; lbf16* Kt = Bt + 2304; lbf16* Rt = Kt + 2304; lbf16* Vv = Rt + 2304;
                LAS float* PCs = (LAS float*)(lds + wave * 23552 + 23040);
                for (int item = bx * 6 + wave; item < BATCH * NH * (SEQ / 32); item += G * 6) {
                    const int bh = item >> 7, chunk = item & 127, b = bh >> 3, h = bh & 7; const size_t t0 = (size_t)b * SEQ + chunk * 32;
                    __builtin_amdgcn_wave_barrier(); asm volatile("s_waitcnt lgkmcnt(0)" ::: "memory");
                    {
                      const int tk = lane >> 3, part = lane & 7;
                      u32x4 qr[4], qk[4], qv[4], qkk[4], qb[4]; f32x4 qw0[4], qw1[4]; float qin[4];
#pragma unroll
                      for (int p4 = 0; p4 < 4; ++p4) { const size_t o = (t0 + p4 * 8 + tk) * RW + h * HS + part * 8;
                          qr[p4] = *(const u32x4*)(Rb + o); qk[p4] = *(const u32x4*)(Kb + o); qv[p4] = *(const u32x4*)(Vl + o); qkk[p4] = *(const u32x4*)(KKb + o); qb[p4] = *(const u32x4*)(Bb + o);
                          qw0[p4] = *(const f32x4*)(Wd + o); qw1[p4] = *(const f32x4*)(Wd + o + 4); qin[p4] = INVN[(t0 + p4 * 8 + tk) * NH + h]; }
                      LAS float* Pl = (LAS float*)At;
#pragma unroll
                      for (int p4 = 0; p4 < 4; ++p4) { *(LAS f32x4*)(Pl + (p4 * 8 + tk) * 64 + part * 8) = qw0[p4]; *(LAS f32x4*)(Pl + (p4 * 8 + tk) * 64 + part * 8 + 4) = qw1[p4]; }
                      __builtin_amdgcn_wave_barrier(); asm volatile("s_waitcnt lgkmcnt(0)" ::: "memory");
                      { float P = 1.f;
#pragma unroll 8
                        for (int c = 0; c < 32; ++c) { P *= Pl[c * 64 + lane]; Pl[c * 64 + lane] = P; }
                        PCs[lane] = P; }
                      __builtin_amdgcn_wave_barrier(); asm volatile("s_waitcnt lgkmcnt(0)" ::: "memory");
                      u32x4 oa[4], orr[4], ob_[4], ok_[4];
#pragma unroll
                      for (int p4 = 0; p4 < 4; ++p4) { const int c = p4 * 8 + tk;
                          const f32x4 pa = *(const LAS f32x4*)(Pl + c * 64 + part * 8), pb2 = *(const LAS f32x4*)(Pl + c * 64 + part * 8 + 4);
                          f32x4 ma = {1.f, 1.f, 1.f, 1.f}, mb = ma; if (c > 0) { ma = *(const LAS f32x4*)(Pl + (c - 1) * 64 + part * 8); mb = *(const LAS f32x4*)(Pl + (c - 1) * 64 + part * 8 + 4); }
                          const float Pc[8] = {pa.x, pa.y, pa.z, pa.w, pb2.x, pb2.y, pb2.z, pb2.w}, Pm[8] = {ma.x, ma.y, ma.z, ma.w, mb.x, mb.y, mb.z, mb.w};
                          const unsigned rw_[4] = {qr[p4].x, qr[p4].y, qr[p4].z, qr[p4].w}, kw_[4] = {qk[p4].x, qk[p4].y, qk[p4].z, qk[p4].w}, kkw[4] = {qkk[p4].x, qkk[p4].y, qkk[p4].z, qkk[p4].w}, bw_[4] = {qb[p4].x, qb[p4].y, qb[p4].z, qb[p4].w};
                          unsigned xa[4], xr[4], xb[4], xk[4]; const float inv = qin[p4];
#pragma unroll
                          for (int i = 0; i < 4; ++i) { const float ip0 = __builtin_amdgcn_rcpf(Pc[2 * i]), ip1 = __builtin_amdgcn_rcpf(Pc[2 * i + 1]);
                              xa[i] = pk2(-__uint_as_float(kkw[i] << 16) * inv * Pm[2 * i], -__uint_as_float(kkw[i] & 0xffff0000u) * inv * Pm[2 * i + 1]);
                              xr[i] = pk2(__uint_as_float(rw_[i] << 16) * Pc[2 * i], __uint_as_float(rw_[i] & 0xffff0000u) * Pc[2 * i + 1]);
                              xb[i] = pk2(__uint_as_float(bw_[i] << 16) * inv * ip0, __uint_as_float(bw_[i] & 0xffff0000u) * inv * ip1);
                              xk[i] = pk2(__uint_as_float(kw_[i] << 16) * ip0, __uint_as_float(kw_[i] & 0xffff0000u) * ip1); }
                          oa[p4] = (u32x4){xa[0], xa[1], xa[2], xa[3]}; orr[p4] = (u32x4){xr[0], xr[1], xr[2], xr[3]}; ob_[p4] = (u32x4){xb[0], xb[1], xb[2], xb[3]}; ok_[p4] = (u32x4){xk[0], xk[1], xk[2], xk[3]}; }
                      __builtin_amdgcn_wave_barrier(); asm volatile("s_waitcnt lgkmcnt(0)" ::: "memory");
#pragma unroll
                      for (int p4 = 0; p4 < 4; ++p4) { const int c = p4 * 8 + tk, o = c * 72 + part * 8;
                          *(__attribute__((address_space(3))) u32x4*)(At + o) = oa[p4]; *(__attribute__((address_space(3))) u32x4*)(Rt + o) = orr[p4]; *(__attribute__((address_space(3))) u32x4*)(Bt + o) = ob_[p4];
                          *(__attribute__((address_space(3))) u32x4*)(Kt + o) = ok_[p4]; *(__attribute__((address_space(3))) u32x4*)(Vv + o) = qv[p4]; } }
                    __builtin_amdgcn_wave_barrier(); asm volatile("s_waitcnt lgkmcnt(0)" ::: "memory");
                    const f32x16 zero16 = {0.f, 0.f, 0.f, 0.f, 0.f, 0.f, 0.f, 0.f, 0.f, 0.f, 0.f, 0.f, 0.f, 0.f, 0.f, 0.f};
                    f32x16 X = zero16, Yt = zero16;
#pragma unroll
                    for (int ks = 0; ks < 4; ++ks) { const bf16x8_t fa = ldrow(At, r32, ks, hh), fb = ldrow(Bt, r32, ks, hh); X = mm32(fa, fb, X); Yt = mm32(fb, fa, Yt); }
#pragma unroll
                    for (int e = 0; e < 16; ++e) { const int ri = rowidx(e, hh); X[e] = (r32 < ri) ? X[e] : 0.f; Yt[e] = (ri < r32) ? Yt[e] : 0.f; }
                    f32x16 TY = Yt;
#pragma unroll
                    for (int e = 0; e < 16; ++e) TY[e] += (rowidx(e, hh) == r32) ? 1.f : 0.f;
#pragma unroll 1
                    for (int it = 0; it < 4; ++it) {
                        const bf16x8_t x0 = accop<0>(X), x1 = accop<1>(X), y0 = accop<0>(Yt), y1 = accop<1>(Yt);
                        f32x16 Xn = mm32(y0, x0, zero16); Xn = mm32(y1, x1, Xn);
                        f32x16 Yn = mm32(x0, y0, zero16); Yn = mm32(x1, y1, Yn);
                        X = Xn; Yt = Yn;
                        const bf16x8_t p0 = accop<0>(X), p1 = accop<1>(X), t0_ = accop<0>(TY), t1_ = accop<1>(TY);
                        TY = mm32(p0, t0_, TY); TY = mm32(p1, t1_, TY);
                    }
                    const bf16x8_t ty0 = accop<0>(TY), ty1 = accop<1>(TY);
                    unsigned char* rec = SCN + (size_t)item * 24576;
                    const bf16x8_t v00 = ldpermcol<0>(Vv, r32, hh), v01 = ldpermcol<1>(Vv, r32, hh), v10 = ldpermcol<0>(Vv, 32 + r32, hh), v11 = ldpermcol<1>(Vv, 32 + r32, hh);
                    f32x16 U0a, U0b;
                    { f32x16 G2T = zero16;
#pragma unroll
                      for (int ks = 0; ks < 4; ++ks) G2T = mm32(ldrow(Kt, r32, ks, hh), ldrow(At, r32, ks, hh), G2T);
#pragma unroll
                      for (int e = 0; e < 16; ++e) G2T[e] = (rowidx(e, hh) < r32) ? G2T[e] : 0.f;
                      const bf16x8_t g0 = accop<0>(G2T), g1 = accop<1>(G2T);
                      f32x16 Za = mm32(g0, v00, zero16); Za = mm32(g1, v01, Za); f32x16 Zb = mm32(g0, v10, zero16); Zb = mm32(g1, v11, Zb);
                      U0a = mm32(ty0, accop<0>(Za), zero16); U0a = mm32(ty1, accop<1>(Za), U0a); U0b = mm32(ty0, accop<0>(Zb), zero16); U0b = mm32(ty1, accop<1>(Zb), U0b); }
                    const bf16x8_t ua0 = accop<0>(U0a), ua1 = accop<1>(U0a), ub0 = accop<0>(U0b), ub1 = accop<1>(U0b);
                    f32x16 G3T = zero16;
                    { f32x16 G4T = zero16;
#pragma unroll
                      for (int ks = 0; ks < 4; ++ks) { const bf16x8_t fr = ldrow(Rt, r32, ks, hh); G3T = mm32(ldrow(Bt, r32, ks, hh), fr, G3T); G4T = mm32(ldrow(Kt, r32, ks, hh), fr, G4T); }
#pragma unroll
                      for (int e = 0; e < 16; ++e) { const bool keep = rowidx(e, hh) <= r32; G3T[e] = keep ? G3T[e] : 0.f; G4T[e] = keep ? G4T[e] : 0.f; }
                      const bf16x8_t g30 = accop<0>(G3T), g31 = accop<1>(G3T), g40 = accop<0>(G4T), g41 = accop<1>(G4T);
                      f32x16 Ya = mm32(g30, ua0, zero16); Ya = mm32(g31, ua1, Ya); Ya = mm32(g40, v00, Ya); Ya = mm32(g41, v01, Ya);
                      f32x16 Yb = mm32(g30, ub0, zero16); Yb = mm32(g31, ub1, Yb); Yb = mm32(g40, v10, Yb); Yb = mm32(g41, v11, Yb);
                      u32x4 o0, o1;
                      o0.x = cvtpk(Ya[0], Ya[1]); o0.y = cvtpk(Ya[2], Ya[3]); o0.z = cvtpk(Ya[4], Ya[5]); o0.w = cvtpk(Ya[6], Ya[7]);
                      o1.x = cvtpk(Ya[8], Ya[9]); o1.y = cvtpk(Ya[10], Ya[11]); o1.z = cvtpk(Ya[12], Ya[13]); o1.w = cvtpk(Ya[14], Ya[15]);
                      *(u32x4*)(rec + 12288 + 4096 + lane * 32) = o0; *(u32x4*)(rec + 12288 + 4096 + lane * 32 + 16) = o1;
                      o0.x = cvtpk(Yb[0], Yb[1]); o0.y = cvtpk(Yb[2], Yb[3]); o0.z = cvtpk(Yb[4], Yb[5]); o0.w = cvtpk(Yb[6], Yb[7]);
                      o1.x = cvtpk(Yb[8], Yb[9]); o1.y = cvtpk(Yb[10], Yb[11]); o1.z = cvtpk(Yb[12], Yb[13]); o1.w = cvtpk(Yb[14], Yb[15]);
                      *(u32x4*)(rec + 12288 + 6144 + 4096 + lane * 32) = o0; *(u32x4*)(rec + 12288 + 6144 + 4096 + lane * 32 + 16) = o1; }
                    f32x16 Wa0 = mm32(ty0, ldpermcol<0>(At, r32, hh), zero16); Wa0 = mm32(ty1, ldpermcol<1>(At, r32, hh), Wa0);
                    f32x16 Wa1 = mm32(ty0, ldpermcol<0>(At, 32 + r32, hh), zero16); Wa1 = mm32(ty1, ldpermcol<1>(At, 32 + r32, hh), Wa1);
                    const bf16x8_t wa00 = accop<0>(Wa0), wa01 = accop<1>(Wa0), wa10 = accop<0>(Wa1), wa11 = accop<1>(Wa1);
                    { const bf16x8_t g30 = accop<0>(G3T), g31 = accop<1>(G3T);
                      f32x16 Ra = mm32(wa00, g30, zero16); Ra = mm32(wa01, g31, Ra); f32x16 Rb_ = mm32(wa10, g30, zero16); Rb_ = mm32(wa11, g31, Rb_);
#pragma unroll
                      for (int e = 0; e < 16; ++e) { const int kr = rowidx(e, hh); Ra[e] += bf2f(Rt[r32 * 72 + kr]); Rb_[e] += bf2f(Rt[r32 * 72 + 32 + kr]); }
                      *(bf16x8_t*)(rec + 8192 + 0 * 1024 + lane * 16) = accop<0>(Ra); *(bf16x8_t*)(rec + 8192 + 1 * 1024 + lane * 16) = accop<1>(Ra);
                      *(bf16x8_t*)(rec + 8192 + 2 * 1024 + lane * 16) = accop<0>(Rb_); *(bf16x8_t*)(rec + 8192 + 3 * 1024 + lane * 16) = accop<1>(Rb_); }
                    const bf16x8_t b00 = ldpermcol<0>(Bt, r32, hh), b01 = ldpermcol<1>(Bt, r32, hh), b10 = ldpermcol<0>(Bt, 32 + r32, hh), b11 = ldpermcol<1>(Bt, 32 + r32, hh);
                    { const float pc0 = PCs[r32], pc1 = PCs[32 + r32];
#pragma unroll
                      for (int ij = 0; ij < 4; ++ij) { const int i = ij >> 1, j = ij & 1;
                          f32x16 M = mm32(i ? wa10 : wa00, j ? b10 : b00, zero16); M = mm32(i ? wa11 : wa01, j ? b11 : b01, M);
#pragma unroll
                          for (int e = 0; e < 16; ++e) { float m = M[e]; if (i == j) m += (rowidx(e, hh) == r32) ? 1.f : 0.f; M[e] = m * (j ? pc1 : pc0); }
                          *(bf16x8_t*)(rec + (ij * 2 + 0) * 1024 + lane * 16) = accop<0>(M); *(bf16x8_t*)(rec + (ij * 2 + 1) * 1024 + lane * 16) = accop<1>(M); } }
                    { const bf16x8_t k00 = ldpermcol<0>(Kt, r32, hh), k01 = ldpermcol<1>(Kt, r32, hh), k10 = ldpermcol<0>(Kt, 32 + r32, hh), k11 = ldpermcol<1>(Kt, 32 + r32, hh);
#pragma unroll
                      for (int ju = 0; ju < 4; ++ju) { const int j = ju >> 1, u = ju & 1;
                          f32x16 Dm = mm32(j ? b10 : b00, u ? ub0 : ua0, zero16); Dm = mm32(j ? b11 : b01, u ? ub1 : ua1, Dm);
                          Dm = mm32(j ? k10 : k00, u ? v10 : v00, Dm); Dm = mm32(j ? k11 : k01, u ? v11 : v01, Dm);
#pragma unroll
                          for (int e = 0; e < 16; ++e) Dm[e] *= PCs[32 * j + rowidx(e, hh)];
                          u32x4 o0, o1;
                          o0.x = cvtpk(Dm[0], Dm[1]); o0.y = cvtpk(Dm[2], Dm[3]); o0.z = cvtpk(Dm[4], Dm[5]); o0.w = cvtpk(Dm[6], Dm[7]);
                          o1.x = cvtpk(Dm[8], Dm[9]); o1.y = cvtpk(Dm[10], Dm[11]); o1.z = cvtpk(Dm[12], Dm[13]); o1.w = cvtpk(Dm[14], Dm[15]);
                          *(u32x4*)(rec + 12288 + u * 6144 + j * 2048 + lane * 32) = o0; *(u32x4*)(rec + 12288 + u * 6144 + j * 2048 + lane * 32 + 16) = o1; } }
                }
            }
        }
        { XcdBarrier xb_ = xbar; asm volatile("" : "+s"(xb_.bar)); xcd_barrier<false>(xb_); }
        if (IN(pb + 3)) { PHASE_IDS
            const int r32 = lane & 31, hh = lane >> 5;
            constexpr int SLOT = 18432, NCH = SEQ / 32, NSL = 7, AHEAD = 6;
            const bool spare = G > BATCH * NH * 2; const int cw = spare ? bx - BATCH * NH * 2 : bx, cn = spare ? G - BATCH * NH * 2 : G;
            if (cw >= 0) {
                if (cw == 0) { for (int i = tid; i < BATCH * D; i += NTHR) { const int b = i / D, d = i % D; S2V[(size_t)l * BATCH * D + i] = INP(24)[l * D + d] * (1.f + modl[(size_t)b * 6 * D + 4 * D + d]); } }
                for (int n = cw * NWAVES + wave; n < PH * PQ; n += cn * NWAVES) {
                    const bf16* wr_ = PqT + (size_t)l * PH * PQ * D + (size_t)n * D + lane * 16; const u32x4 w0 = *(const u32x4*)wr_, w1 = *(const u32x4*)(wr_ + 8);
                    const unsigned ww[8] = {w0.x, w0.y, w0.z, w0.w, w1.x, w1.y, w1.z, w1.w};
#pragma unroll
                    for (int b = 0; b < BATCH; ++b) { const float* sh = modl + (size_t)b * 6 * D + 3 * D + lane * 16; float a = 0.f;
#pragma unroll
                        for (int q = 0; q < 4; ++q) { const f32x4 sv_ = *(const f32x4*)(sh + q * 4);
                            a += sv_.x * __uint_as_float(ww[2 * q] << 16) + sv_.y * __uint_as_float(ww[2 * q] & 0xffff0000u) + sv_.z * __uint_as_float(ww[2 * q + 1] << 16) + sv_.w * __uint_as_float(ww[2 * q + 1] & 0xffff0000u); }
                        a = wave_sum(a, lane); if (lane == 0) CVEC[(size_t)l * BATCH * PH * PQ + (size_t)b * PH * PQ + n] = a; } }
                convert_tables_fp6(INP(27), INP(28), U8, V8, USc, VSc, l, cw * NWAVES + wave, cn * NWAVES, lane);
            {
                constexpr int DST = 520;
                int lane_p; asm volatile("v_mbcnt_lo_u32_b32 %0, -1, 0\n\tv_mbcnt_hi_u32_b32 %0, -1, %0" : "=v"(lane_p)); const int r32 = lane_p & 31, hh = lane_p >> 5, tidp = wave0 * 64 + lane_p;
                lbf16* dlb = (lbf16*)lds;
                lbf16* pin = (lbf16*)(lds + 33280);
                const int c = tidp, g = c >> 7, win = 2 << g;
                const bf16* pwt = PWT + (size_t)(l * 4 + (wave >> 1)) * PG * PG; const float* psc = INP(22) + l * PW;
                for (int tile = cw; tile < T / 32; tile += cn) {
                    const int t0 = tile * 32; const bool first = (t0 % SEQ) == 0;
                    __syncthreads();
                    { u32x4 pq[6];
#pragma unroll
                      for (int q = 0; q < 6; ++q) { const int ch = tidp + q * NTHR, row = ch >> 6, cc = ch & 63; pq[q] = (u32x4){0u, 0u, 0u, 0u};
                          if (ch < 47 * 64 && (row >= 15 || !first)) pq[q] = *(const u32x4*)(POOLIN + (size_t)(t0 - 15 + row) * PW + cc * 8); }
#pragma unroll
                      for (int q = 0; q < 6; ++q) { const int ch = tidp + q * NTHR, row = ch >> 6, cc = ch & 63; if (ch < 47 * 64) *(__attribute__((address_space(3))) u32x4*)(pin + row * 520 + cc * 8) = pq[q]; } }
                    __syncthreads();
                    const lbf16* pc = pin + c;
                    float sw = 0.f;
#pragma unroll
                    for (int j = 1; j <= 15; ++j) sw += (j < win) ? bf2f(pc[(15 - j) * 520]) : 0.f;
                    const float invw = 1.f / (float)win;
#pragma unroll 8
                    for (int i = 0; i < 32; ++i) {
                        const float cur = bf2f(pc[(15 + i) * 520]);
                        sw += cur;
                        const float inv = (first && i < 15) ? 1.f / (float)min(i + 1, win) : invw;
                        dlb[i * DST + c] = f2bf(sw * inv - cur);
                        sw -= bf2f(pc[(15 + i - win + 1) * 520]);
                    }
                    __syncthreads();
                    const int gg = wave >> 1, half = wave & 1;
#pragma unroll
                    for (int ct = 0; ct < 2; ++ct) {
                        const int dd0 = half * 64 + ct * 32;
                        f32x16 acc;
#pragma unroll
                        for (int e = 0; e < 16; ++e) acc[e] = 0.f;
#pragma unroll
                        for (int ks = 0; ks < 8; ++ks) { const bf16x8_t a = *(const __attribute__((address_space(3))) bf16x8_t*)(dlb + r32 * DST + gg * PG + ks * 16 + 8 * hh);
                            const bf16x8_t w = *(const bf16x8_t*)(pwt + (size_t)(dd0 + r32) * PG + ks * 16 + 8 * hh); acc = mm32(a, w, acc); }
                        const int oc = gg * PG + dd0 + r32; const float ps = psc[oc];
#pragma unroll
                        for (int e = 0; e < 16; ++e) MIX[(size_t)(t0 + rowidx(e, hh)) * D + RW + oc] = f2bf(acc[e] * ps);
                    }
                }
            }
            }
            for (int un = bx; un < BATCH * NH * 2; un += G) {
                const int bh = un >> 1, u = un & 1, b = bh >> 3, h = bh & 7;
                __syncthreads();
                const unsigned char* recs = SCN + (size_t)bh * NCH * 24576;
                const int lw = wave - 2;
#define S2_DMA(chunk_) do { if (wave >= 2) { LAS unsigned char* sl = lds + ((chunk_) % NSL) * SLOT; const unsigned char* rp = recs + (size_t)(chunk_) * 24576 + lane * 16; \
                    _Pragma("unroll") for (int q_ = 0; q_ < 3; ++q_) { const int p_ = lw * 3 + q_; const int so_ = p_ < 12 ? p_ * 1024 : 12288 + u * 6144 + (p_ - 12) * 1024; \
                        __builtin_amdgcn_global_load_lds((const unsigned*)(rp + so_), (LAS unsigned*)(sl + p_ * 1024), 16, 0, 0); } } } while (0)
#pragma unroll 1
                for (int c0 = 0; c0 < AHEAD; ++c0) S2_DMA(c0);
                asm volatile("s_waitcnt vmcnt(15)" ::: "memory");
                __builtin_amdgcn_s_barrier();
                f32x16 X0, X1;
                { float z_ = 0.f; asm volatile("" : "+v"(z_));
#pragma unroll
                for (int e = 0; e < 16; ++e) { X0[e] = z_; X1[e] = z_; } }
#define S2_FRAG(off) (*(const __attribute__((address_space(3))) bf16x8_t*)(sl + (off) + lane * 16))
#define S2_UNPK(dst, off) do { const u32x4 a0 = *(const LAS u32x4*)(sl + (off) + lane * 32), a1 = *(const LAS u32x4*)(sl + (off) + lane * 32 + 16); const unsigned wv[8] = {a0.x, a0.y, a0.z, a0.w, a1.x, a1.y, a1.z, a1.w}; \
                    _Pragma("unroll") for (int q = 0; q < 8; ++q) { (dst)[2 * q] = __uint_as_float(wv[q] << 16); (dst)[2 * q + 1] = __uint_as_float(wv[q] & 0xffff0000u); } } while (0)
#pragma unroll 1
                for (int n = 0; n < NCH; ++n) {
                    if (n + AHEAD < NCH) S2_DMA(n + AHEAD);
                    if (wave == 0) {
                        const LAS unsigned char* sl = lds + (n % NSL) * SLOT;
                        const bf16x8_t x00 = accop<0>(X0), x01 = accop<1>(X0), x10 = accop<0>(X1), x11 = accop<1>(X1);
                        f32x16 Yc, N0, N1;
                        S2_UNPK(Yc, 12288 + 4096); S2_UNPK(N0, 12288); S2_UNPK(N1, 12288 + 2048);
                        Yc = mm32(S2_FRAG(8192 + 0 * 1024), x00, Yc); Yc = mm32(S2_FRAG(8192 + 1 * 1024), x01, Yc); Yc = mm32(S2_FRAG(8192 + 2 * 1024), x10, Yc); Yc = mm32(S2_FRAG(8192 + 3 * 1024), x11, Yc);
                        N0 = mm32(S2_FRAG((0 * 2 + 0) * 1024), x00, N0); N0 = mm32(S2_FRAG((0 * 2 + 1) * 1024), x01, N0); N0 = mm32(S2_FRAG((2 * 2 + 0) * 1024), x10, N0); N0 = mm32(S2_FRAG((2 * 2 + 1) * 1024), x11, N0);
                        N1 = mm32(S2_FRAG((1 * 2 + 0) * 1024), x00, N1); N1 = mm32(S2_FRAG((1 * 2 + 1) * 1024), x01, N1); N1 = mm32(S2_FRAG((3 * 2 + 0) * 1024), x10, N1); N1 = mm32(S2_FRAG((3 * 2 + 1) * 1024), x11, N1);
                        X0 = N0; X1 = N1;
                        float* yp = Y + ((size_t)b * SEQ + (size_t)n * 32) * RW + h * HS + u * 32 + r32;
#pragma unroll
                        for (int e = 0; e < 16; ++e) yp[(size_t)rowidx(e, hh) * RW] = Yc[e];
                        asm volatile("s_waitcnt lgkmcnt(0)" ::: "memory");
                    } else if (wave >= 2) {
                        const int younger = (NCH - 1 - (n + 1)) < (AHEAD - 1) ? (NCH - 1 - (n + 1)) : (AHEAD - 1);
                        if (younger >= 5) asm volatile("s_waitcnt vmcnt(15)" ::: "memory"); else if (younger == 4) asm volatile("s_waitcnt vmcnt(12)" ::: "memory"); else if (younger == 3) asm volatile("s_waitcnt vmcnt(9)" ::: "memory");
                        else if (younger == 2) asm volatile("s_waitcnt vmcnt(6)" ::: "memory"); else if (younger == 1) asm volatile("s_waitcnt vmcnt(3)" ::: "memory"); else asm volatile("s_waitcnt vmcnt(0)" ::: "memory");
                    }
                    __builtin_amdgcn_s_barrier();
                }
#undef S2_FRAG
#undef S2_UNPK
#undef S2_DMA
            }
        }
        SEAM(pb + 3);

        if (IN(pb + 4)) { PHASE_IDS
            const int c8 = (tid & 63) * 8, hd = (tid & 63) >> 3, tsub = tid >> 6;
            const f32x4 lg0 = *(const f32x4*)(INP(19) + l * RW + c8), lg1 = *(const f32x4*)(INP(19) + l * RW + c8 + 4), lb0 = *(const f32x4*)(INP(20) + l * RW + c8), lb1 = *(const f32x4*)(INP(20) + l * RW + c8 + 4);
            for (int tile = bx; tile < T / 8; tile += G) {
                const int t = tile * 8 + tsub; const size_t o = (size_t)t * RW + c8;
                const f32x4 y0 = *(const f32x4*)(Y + o), y1 = *(const f32x4*)(Y + o + 4); const u32x4 gq = *(const u32x4*)(Gb + o), vq = *(const u32x4*)(BGb + o); const float bsum = BSUM[(size_t)t * NH + hd];
                float sm = (y0.x + y0.y) + (y0.z + y0.w) + (y1.x + y1.y) + (y1.z + y1.w);
                sm += dppf<0xB1>(sm); sm += dppf<0x4E>(sm); sm += dppf<0x141>(sm);
                const float mean = sm * (1.f / 64.f);
                const f32x4 d0 = y0 - mean, d1 = y1 - mean;
                float sq = (d0.x * d0.x + d0.y * d0.y) + (d0.z * d0.z + d0.w * d0.w) + (d1.x * d1.x + d1.y * d1.y) + (d1.z * d1.z + d1.w * d1.w);
                sq += dppf<0xB1>(sq); sq += dppf<0x4E>(sq); sq += dppf<0x141>(sq);
                const float rs = rsqrtf(sq * (1.f / 64.f) + GN_EPS);
                const f32x4 n0 = d0 * rs * lg0 + lb0, n1 = d1 * rs * lg1 + lb1;
                const unsigned gw_[4] = {gq.x, gq.y, gq.z, gq.w}, vw_[4] = {vq.x, vq.y, vq.z, vq.w}; const float nn[8] = {n0.x, n0.y, n0.z, n0.w, n1.x, n1.y, n1.z, n1.w}; unsigned ow[4];
#pragma unroll
                for (int i = 0; i < 4; ++i) { const float g0 = __uint_as_float(gw_[i] << 16), g1 = __uint_as_float(gw_[i] & 0xffff0000u), v0 = __uint_as_float(vw_[i] << 16), v1 = __uint_as_float(vw_[i] & 0xffff0000u);
                    ow[i] = pk2(nn[2 * i] * g0 + v0 * bsum, nn[2 * i + 1] * g1 + v1 * bsum); }
                *(u32x4*)(MIX + (size_t)t * D + c8) = (u32x4){ow[0], ow[1], ow[2], ow[3]};
            }
        }
        SEAM(pb + 4);
        if (IN(pb + 5)) { PHASE_IDS
            pg8::Gemm g{MIX, WoutT + (size_t)l * D * D, T, D, D}; pg8::StaticOrder S; S.init(T, D, G, bx);
            pg8::EpiResGate E{xin, X, modl + 2 * D, XB2, S2V + (size_t)l * BATCH * D, SSQ + (size_t)l * T};
            pg8::gemm_phase<pg8::EpiResGate, pg8::StaticOrder, true, true>(lds, g, S, E, tid); }
        SEAM(pb + 5);
        if (IN(pb + 7)) { PHASE_IDS
            pg8::Gemm g{XB2, PqT + (size_t)l * PH * PQ * D, T, PH * PQ, D}; pg8::StaticOrder S; S.init(T, PH * PQ, G, bx);
            pg8::EpiQ E{Q, PH * PQ, CVEC + (size_t)l * BATCH * PH * PQ, SSQ + (size_t)l * T};
            pg8::gemm_phase<pg8::EpiQ, pg8::StaticOrder, true, true>(lds, g, S, E, tid); }
        if (IN(pb + 7) && IN(pb + 8)) { asm volatile("s_waitcnt vmcnt(0)" ::: "memory"); __syncthreads(); }

        if (IN(pb + 8)) { PHASE_IDS
            const bf16* KEYSl = KEYS + (size_t)l * PH * 2 * NKEYS * PHALF;
            LAS unsigned char* scr = lds + wave * 2048 + lane * 32;
            constexpr int KST = 136;
            lbf16* kl = (lbf16*)(lds + 16384);
            const int r = lane & 31, hh = lane >> 5;
            pg8::StaticOrder S; S.init(T, PH * PQ, G, bx);
            for (int ui = 0;; ++ui) { pg8::Unit un_; if (!S.next(ui, un_)) break;
                const int h = un_.pn, tok = un_.pm * 256 + wave * 32 + r;
                __syncthreads();
                { u32x4 kq[8];
#pragma unroll
                  for (int q = 0; q < 8; ++q) { const int ch = tid + q * NTHR; kq[q] = *(const u32x4*)(KEYSl + (size_t)(h * 2) * NKEYS * PHALF + (size_t)ch * 8); }
#pragma unroll
                  for (int q = 0; q < 8; ++q) { const int ch = tid + q * NTHR, row = ch >> 4, cc = ch & 15; *(__attribute__((address_space(3))) u32x4*)(kl + row * KST + cc * 8) = kq[q]; } }
                __syncthreads();
                unsigned sp0[16], sp1[16];
#pragma unroll
                for (int e = 0; e < 16; ++e) { sp0[e] = 0u; sp1[e] = 0u; }
#pragma unroll 1
                for (int p = 0; p < 2; ++p) {
                    const bf16* qp = Q + (size_t)tok * (PH * PQ) + h * PQ + p * PHALF + 8 * hh;
                    const lbf16* kp_ = kl + (p * NKEYS + r) * KST + 8 * hh;
                    bf16x8_t bq[8];
#pragma unroll
                    for (int ks = 0; ks < 8; ++ks) bq[ks] = *(const bf16x8_t*)(qp + ks * 16);
                    unsigned best[16];
#pragma unroll
                    for (int e = 0; e < 16; ++e) best[e] = 0u;
#pragma unroll 1
                    for (int kt = 0; kt < 4; ++kt) {
                        f32x16 acc;
#pragma unroll
                        for (int e = 0; e < 16; ++e) acc[e] = 0.f;
#pragma unroll
                        for (int ks = 0; ks < 8; ++ks) { const bf16x8_t ak = *(const __attribute__((address_space(3))) bf16x8_t*)(kp_ + kt * 32 * KST + ks * 16); acc = __builtin_amdgcn_mfma_f32_32x32x16_bf16(ak, bq[ks], acc, 0, 0, 0); }
                        unsigned g[16];
#pragma unroll
                        for (int e = 0; e < 16; ++e) g[e] = pack_key7(acc[e], kt * 32 + (e & 3) + 8 * (e >> 2) + 4 * hh);
                        sort16_desc(g);
                        merge_top16(best, g);
                    }
                    unsigned ob[16];
#pragma unroll
                    for (int e = 0; e < 16; ++e) ob[e] = shflxu(best[e], lane, 32);
                    merge_top16(best, ob);
#pragma unroll
                    for (int e = 0; e < 16; ++e) { sp0[e] = p == 0 ? best[e] : sp0[e]; sp1[e] = p == 0 ? sp1[e] : best[e]; }
                }
                unsigned c2[32];
                stage2_cands(sp0, sp1, hh, c2);
                sort16_desc(c2); sort16_desc(c2 + 16); merge_top16(c2, c2 + 16);
                { unsigned ob[16];
#pragma unroll
                  for (int e = 0; e < 16; ++e) ob[e] = shflxu(c2[e], lane, 32);
                  merge_top16(c2, ob); }
#pragma unroll
                for (int e = 0; e < 16; e += 4) {
                    *(LAS unsigned*)(scr + e) = (127u - (sp0[e] & 127u)) | ((127u - (sp0[e + 1] & 127u)) << 8) | ((127u - (sp0[e + 2] & 127u)) << 16) | ((127u - (sp0[e + 3] & 127u)) << 24);
                    *(LAS unsigned*)(scr + 16 + e) = (127u - (sp1[e] & 127u)) | ((127u - (sp1[e + 1] & 127u)) << 8) | ((127u - (sp1[e + 2] & 127u)) << 16) | ((127u - (sp1[e + 3] & 127u)) << 24); }
                asm volatile("s_waitcnt lgkmcnt(0)" ::: "memory");
                float sm[16]; int ex[16];
#pragma unroll
                for (int e = 0; e < 16; ++e) { const unsigned key = c2[e]; sm[e] = unpack_key8(key); const int i0 = (key >> 4) & 15, j0 = key & 15; ex[e] = (int)scr[i0] * NKEYS + (int)scr[16 + j0]; }
                float den = 0.f;
#pragma unroll
                for (int e = 0; e < 16; ++e) { sm[e] = expf(sm[e] - unpack_key8(c2[0])); den += sm[e]; }
                const float inv = 1.f / den;
                if (hh == 0) {
                    int* ip = IDX + (size_t)tok * NE + h * TOPK; float* gp = GATE + (size_t)tok * NE + h * TOPK;
#pragma unroll
                    for (int e = 0; e < 16; e += 4) { *(int4*)(ip + e) = make_int4(ex[e], ex[e + 1], ex[e + 2], ex[e + 3]); *(f32x4*)(gp + e) = (f32x4){sm[e] * inv, sm[e + 1] * inv, sm[e + 2] * inv, sm[e + 3] * inv}; }
                }
                asm volatile("s_waitcnt lgkmcnt(0)" ::: "memory");
            }
        }
        SEAM(pb + 8);

        if (IN(pb + 9)) { PHASE_IDS
            const unsigned char* Ul = U8 + (size_t)l * NEXP * ROWB; const unsigned char* Vtl = V8 + (size_t)l * NEXP * ROWB; const float* usl = USc + l * NEXP; const float* vsl = VSc + l * NEXP; const float* lnf = INP(29);
            const bool fin = (l == DEPTH - 1);
            typedef float f32x2_t __attribute__((ext_vector_type(2)));
            const __amdgpu_buffer_rsrc_t ru = __builtin_amdgcn_make_buffer_rsrc((void*)Ul, 0, NEXP * ROWB, 0x00020000), rv = __builtin_amdgcn_make_buffer_rsrc((void*)Vtl, 0, NEXP * ROWB, 0x00020000);
            typedef float f32x32_t __attribute__((ext_vector_type(32))); typedef unsigned u32x3_t __attribute__((ext_vector_type(3))); typedef unsigned u32x6_t __attribute__((ext_vector_type(6))); typedef unsigned u32x16_t __attribute__((ext_vector_type(16))); typedef __bf16 bf16x2_t __attribute__((ext_vector_type(2)));
            LAS float* pl = (LAS float*)(lds + wave * 18432);
            constexpr int TW = 4;
            for (int tb = gw; tb < T; tb += TW * NGW) {
#define TOKV(k) (tb + (k) * NGW < T)
#define TOK(k) (TOKV(k) ? tb + (k) * NGW : tb)
                unsigned si[TW][2]; float sus[TW][2], sgv[TW][2];
                LAS u32x4* hl = (LAS u32x4*)(pl + 32 * 68);
                { float g0[TW], g1[TW]; int lane_s; asm volatile("v_mbcnt_lo_u32_b32 %0, -1, 0\n\tv_mbcnt_hi_u32_b32 %0, -1, %0" : "=v"(lane_s));
#pragma unroll
                  for (int k = 0; k < TW; ++k) { const size_t o = (size_t)TOK(k) * NE + lane_s; si[k][0] = ((unsigned)IDX[o] << 7) | (unsigned)lane_s; si[k][1] = ((unsigned)IDX[o + 64] << 7) | (unsigned)(64 + lane_s); g0[k] = GATE[o]; g1[k] = GATE[o + 64]; }
#pragma unroll
                  for (int kk = 2; kk <= 128; kk <<= 1) {
#pragma unroll
                      for (int j = kk >> 1; j > 0; j >>= 1) {
                          if (j == 64) {
#pragma unroll
                              for (int k = 0; k < TW; ++k) { const unsigned a = si[k][0], b = si[k][1]; si[k][0] = a < b ? a : b; si[k][1] = a < b ? b : a; } }
                          else { const bool lower = (lane_s & j) == 0, tm0 = lower == ((lane_s & kk) == 0), tm1 = lower == (((lane_s + 64) & kk) == 0); const int pa = (lane_s ^ j) << 2;
#pragma unroll
                              for (int k = 0; k < TW; ++k) { const unsigned a = si[k][0], b = si[k][1], p0 = (unsigned)__builtin_amdgcn_ds_bpermute(pa, (int)a), p1 = (unsigned)__builtin_amdgcn_ds_bpermute(pa, (int)b);
                                  si[k][0] = tm0 ? (a < p0 ? a : p0) : (a < p0 ? p0 : a); si[k][1] = tm1 ? (b < p1 ? b : p1) : (b < p1 ? p1 : b); } }
                          __builtin_amdgcn_sched_barrier(0);
                      } }
#pragma unroll
                  for (int k = 0; k < TW; ++k) {
#pragma unroll
                      for (int r = 0; r < 2; ++r) { const unsigned key = si[k][r]; const int a = (int)(key & 63u) << 2; const int ga = __builtin_amdgcn_ds_bpermute(a, __float_as_int(g0[k])), gb = __builtin_amdgcn_ds_bpermute(a, __float_as_int(g1[k]));
                          const unsigned ix = key >> 7; si[k][r] = ix; sus[k][r] = usl[ix]; sgv[k][r] = __int_as_float((key & 64u) ? gb : ga) * vsl[ix]; } }
#pragma unroll
                  for (int k = 0; k < TW; ++k) {
                      const int t_ = TOK(k); const bf16* hr = XB2 + (size_t)t_ * D + lane_s * 16; const u32x4 a0 = *(const u32x4*)hr, a1 = *(const u32x4*)(hr + 8);
                      const float rs_ = rsqrtf((float)SSQ[(size_t)l * T + t_] * (1.f / (1048576.f * D)) + NORM_EPS); const float* shp = modl + (size_t)(t_ / SEQ) * 6 * D + 3 * D + lane_s * 16;
                      const unsigned aw[8] = {a0.x, a0.y, a0.z, a0.w, a1.x, a1.y, a1.z, a1.w}; unsigned ow[8];
#pragma unroll
                      for (int q = 0; q < 4; ++q) { const f32x4 s4 = *(const f32x4*)(shp + q * 4);
                          ow[2 * q] = pk2(__uint_as_float(aw[2 * q] << 16) * rs_ + s4.x, __uint_as_float(aw[2 * q] & 0xffff0000u) * rs_ + s4.y);
                          ow[2 * q + 1] = pk2(__uint_as_float(aw[2 * q + 1] << 16) * rs_ + s4.z, __uint_as_float(aw[2 * q + 1] & 0xffff0000u) * rs_ + s4.w); }
                      hl[(k * 2) * 64 + lane_s] = (u32x4){ow[0], ow[1], ow[2], ow[3]}; hl[(k * 2 + 1) * 64 + lane_s] = (u32x4){ow[4], ow[5], ow[6], ow[7]}; }
                }
                __builtin_amdgcn_sched_barrier(0);
#define ROWLD(dst, rs, ixv, ln) dst = __builtin_amdgcn_raw_buffer_load_b96(rs, voff, __builtin_amdgcn_readlane((int)(ixv), (ln)) * ROWB, 0)
#define LOADQ(buf, rs, ixv, ln0) do { _Pragma("unroll") for (int j_ = 0; j_ < 8; ++j_) ROWLD((buf)[j_], rs, ixv, (ln0) + j_); __builtin_amdgcn_sched_barrier(0); } while (0)
#define CVT2(a, b) const f32x32_t f_ = __builtin_amdgcn_cvt_scalef32_pk32_f32_fp6((u32x6_t){(a).x, (a).y, (a).z, (b).x, (b).y, (b).z}, 1.0f)
#define PR(i) __builtin_shufflevector(f_, f_, 2 * (i), 2 * (i) + 1)
#define DOTQ(buf, e0) do { _Pragma("unroll") for (int j_ = 0; j_ < 8; j_ += 2) { \
                        const u32x16_t g_ = __builtin_bit_cast(u32x16_t, __builtin_amdgcn_cvt_scalef32_pk32_bf16_fp6((u32x6_t){(buf)[j_].x, (buf)[j_].y, (buf)[j_].z, (buf)[j_ + 1].x, (buf)[j_ + 1].y, (buf)[j_ + 1].z}, 1.0f));     \
                        float a0_ = 0.f, a1_ = 0.f, b0_ = 0.f, b1_ = 0.f; \
                        _Pragma("unroll") for (int i_ = 0; i_ < 8; i_ += 2) { a0_ = DOT2(g_[i_], hpk[i_], a0_); b0_ = DOT2(g_[8 + i_], hpk[i_], b0_); a1_ = DOT2(g_[i_ + 1], hpk[i_ + 1], a1_); b1_ = DOT2(g_[9 + i_], hpk[i_ + 1], b1_); } \
                        pl[((e0) + j_) * 68 + lane_u] = a0_ + a1_; pl[((e0) + j_ + 1) * 68 + lane_u] = b0_ + b1_; __builtin_amdgcn_sched_barrier(0); } } while (0)
#define DOT2(x_, y_, c_) __builtin_amdgcn_fdot2_f32_bf16(__builtin_bit_cast(bf16x2_t, (unsigned)(x_)), __builtin_bit_cast(bf16x2_t, (unsigned)(y_)), (c_), false)
#define AXPYQ(buf, k, cfv, ln0) do { _Pragma("unroll") for (int j_ = 0; j_ < 8; j_ += 2) { CVT2((buf)[j_], (buf)[j_ + 1]); \
                        const float ca = __int_as_float(__builtin_amdgcn_readlane(__float_as_int(cfv), (ln0) + j_)), cb = __int_as_float(__builtin_amdgcn_readlane(__float_as_int(cfv), (ln0) + j_ + 1)); \
                        acc2[k][0] += ca * PR(0); acc2[k][1] += ca * PR(1); acc2[k][2] += ca * PR(2); acc2[k][3] += ca * PR(3); acc2[k][4] += ca * PR(4); acc2[k][5] += ca * PR(5); acc2[k][6] += ca * PR(6); acc2[k][7] += ca * PR(7); \
                        acc2[k][0] += cb * PR(8); acc2[k][1] += cb * PR(9); acc2[k][2] += cb * PR(10); acc2[k][3] += cb * PR(11); acc2[k][4] += cb * PR(12); acc2[k][5] += cb * PR(13); acc2[k][6] += cb * PR(14); acc2[k][7] += cb * PR(15); __builtin_amdgcn_sched_barrier(0); } } while (0)
                u32x3_t ba[8], bb_[8];
                int lane_u; asm volatile("v_mbcnt_lo_u32_b32 %0, -1, 0\n\tv_mbcnt_hi_u32_b32 %0, -1, %0" : "=v"(lane_u)); const int voff = lane_u * 12;
                LOADQ(ba, ru, si[0][0], 0);
#pragma unroll 1
                for (int c = 0; c < 16; ++c) {
                    const int lb = (c & 7) * 8; const bool r1 = c >= 8;
#pragma unroll
                    for (int k = 0; k < TW; ++k) {
                        unsigned hpk[8];
                        { const u32x4 h0 = hl[(k * 2) * 64 + lane_u], h1 = hl[(k * 2 + 1) * 64 + lane_u]; hpk[0] = h0.x; hpk[1] = h0.y; hpk[2] = h0.z; hpk[3] = h0.w; hpk[4] = h1.x; hpk[5] = h1.y; hpk[6] = h1.z; hpk[7] = h1.w; }
                        if (k & 1) { if (k < TW - 1) LOADQ(ba, ru, r1 ? si[k + 1][1] : si[k + 1][0], lb); else { const int cn = (c + 1) & 15; const __amdgpu_buffer_rsrc_t rn = c < 15 ? ru : rv; LOADQ(ba, rn, (cn >= 8) ? si[0][1] : si[0][0], (cn & 7) * 8); } DOTQ(bb_, k * 8); }
                        else { LOADQ(bb_, ru, r1 ? si[k + 1][1] : si[k + 1][0], lb); DOTQ(ba, k * 8); }
                    }
                    __builtin_amdgcn_wave_barrier(); asm volatile("s_waitcnt lgkmcnt(0)" ::: "memory");
                    float dsum;
                    { const LAS float* rp = pl + (lane_u & 31) * 68 + (lane_u >> 5) * 32; f32x4 s4 = *(const LAS f32x4*)rp;
#pragma unroll
                      for (int j = 1; j < 8; ++j) s4 += *(const LAS f32x4*)(rp + j * 4);
                      dsum = (s4.x + s4.y) + (s4.z + s4.w); }
                    dsum += shflx(dsum, lane_u, 32);
                    __builtin_amdgcn_wave_barrier(); asm volatile("s_waitcnt lgkmcnt(0)" ::: "memory");
                    const bool home = (lane_u >> 3) == (c & 7);
#pragma unroll
                    for (int k = 0; k < TW; ++k) {
                        const float dv = __int_as_float(__builtin_amdgcn_ds_bpermute((k * 8 + (lane_u & 7)) << 2, __float_as_int(dsum)));
                        const float cf = (r1 ? sgv[k][1] : sgv[k][0]) * gelu_erf(dv * (r1 ? sus[k][1] : sus[k][0]));
                        if (r1) sgv[k][1] = home ? cf : sgv[k][1]; else sgv[k][0] = home ? cf : sgv[k][0]; }
                    __builtin_amdgcn_sched_barrier(0);
                }
                f32x2_t acc2[TW][8];
#pragma unroll
                for (int k = 0; k < TW; ++k) {
#pragma unroll
                    for (int i = 0; i < 8; ++i) acc2[k][i] = (f32x2_t){0.f, 0.f}; }
#pragma unroll 1
                for (int c = 0; c < 16; ++c) {
                    const int lb = (c & 7) * 8; const bool r1 = c >= 8;
#pragma unroll
                    for (int k = 0; k < TW; ++k) {
                        const float cfk = r1 ? sgv[k][1] : sgv[k][0];
                        if (k & 1) { if (k < TW - 1) LOADQ(ba, rv, r1 ? si[k + 1][1] : si[k + 1][0], lb); else { const int cn = (c + 1) & 15; LOADQ(ba, rv, (cn >= 8) ? si[0][1] : si[0][0], (cn & 7) * 8); }     AXPYQ(bb_, k, cfk, lb); }
                        else { LOADQ(bb_, rv, r1 ? si[k + 1][1] : si[k + 1][0], lb); AXPYQ(ba, k, cfk, lb); }
                    }
                }
#undef ROWLD
#undef LOADQ
#undef CVT2
#undef PR
#undef DOTQ
#undef DOT2
#undef AXPYQ
                { int ln; asm volatile("v_mbcnt_lo_u32_b32 %0, -1, 0\n\tv_mbcnt_hi_u32_b32 %0, -1, %0" : "=v"(ln));
                  LAS f32x4* al = (LAS f32x4*)pl + ln;
#pragma unroll
                  for (int k = 0; k < TW; ++k) {
#pragma unroll
                      for (int q = 0; q < 4; ++q) al[(k * 4 + q) * 64] = (f32x4){acc2[k][q * 2].x, acc2[k][q * 2].y, acc2[k][q * 2 + 1].x, acc2[k][q * 2 + 1].y}; }
                  asm volatile("s_waitcnt lgkmcnt(0)" ::: "memory"); __builtin_amdgcn_sched_barrier(0);
                  f32x4 xn[4];
#pragma unroll
                  for (int q = 0; q < 4; ++q) xn[q] = *(const f32x4*)(X + (size_t)tb * D + ln * 16 + q * 4);
#pragma unroll 1
                  for (int k = 0; k < TW; ++k) { const int t = tb + k * NGW; if (t >= T) break; const int b = t / SEQ;
                    float* xr = X + (size_t)t * D + ln * 16; const float* g2 = modl + (size_t)b * 6 * D + 5 * D + ln * 16;
                    f32x4 xv[4]; float ss = 0.f;
#pragma unroll
                    for (int q = 0; q < 4; ++q) xv[q] = xn[q];
                    { const float* xnp = X + (size_t)((k + 1 < TW && t + NGW < T) ? t + NGW : t) * D + ln * 16;
#pragma unroll
                      for (int q = 0; q < 4; ++q) xn[q] = *(const f32x4*)(xnp + q * 4); }
                    __builtin_amdgcn_sched_barrier(0);
#pragma unroll
                    for (int q = 0; q < 4; ++q) { const f32x4 xo = xv[q], gg = *(const f32x4*)(g2 + q * 4);
                        xv[q] = xo + gg * al[(k * 4 + q) * 64]; ss += (xv[q].x * xv[q].x + xv[q].y * xv[q].y) + (xv[q].z * xv[q].z + xv[q].w * xv[q].w); }
                    const float rs = rsqrtf(wave_sum(ss, ln) * (1.f / D) + NORM_EPS);
                    if (fin) {
#pragma unroll
                        for (int q = 0; q < 4; ++q) *(f32x4*)(xr + q * 4) = xv[q] * rs * *(const f32x4*)(lnf + ln * 16 + q * 4); }
                    else {
                        const float* gam = INP(4) + (l + 1) * D + ln * 16; const float* mn = MOD + (size_t)(l + 1) * BATCH * 6 * D + (size_t)b * 6 * D + ln * 16; u32x4 ho[2];
#pragma unroll
                        for (int q = 0; q < 4; ++q) { *(f32x4*)(xr + q * 4) = xv[q];
                            const f32x4 y = xv[q] * rs * *(const f32x4*)(gam + q * 4) * (*(const f32x4*)(mn + D + q * 4) + 1.f) + *(const f32x4*)(mn + q * 4);
                            if (q & 1) { ho[q >> 1].z = pk2(y.x, y.y); ho[q >> 1].w = pk2(y.z, y.w); } else { ho[q >> 1].x = pk2(y.x, y.y); ho[q >> 1].y = pk2(y.z, y.w); } }
                        *(u32x4*)(H + (size_t)t * D + ln * 16) = ho[0]; *(u32x4*)(H + (size_t)t * D + ln * 16 + 8) = ho[1]; }
                  }
                  asm volatile("s_waitcnt lgkmcnt(0)" ::: "memory"); __builtin_amdgcn_wave_barrier();
                }
#undef TOK
#undef TOKV
            }
        }
    }
#undef modl
#undef xin
#undef IN
#undef SEAM
}
#undef MOD
#undef H
#undef PROJ
#undef Q
#undef MIX
#undef Rb
#undef Kb
#undef V0
#undef V1
#undef KKb
#undef Bb
#undef Gb
#undef BGb
#undef Wd
#undef Y
#undef IDX
#undef GATE
#undef WinT
#undef WoutT
#undef PqT
#undef KEYS
#undef QB
#undef POOLIN
#undef SH
#undef SSQ
#undef CVEC
#undef S2V
#undef XB2
#undef WUPT
#undef AUPT
#undef GUPT
#undef VUPT
#undef PWT
#undef INVN
#undef BSUM
#undef SCN
#undef U8
#undef V8
#undef USc
#undef VSc
#undef INP
#undef PHASE_IDS

extern "C" void kernel_launch(void* const* d_in, const int* in_sizes, int n_in, void* d_out, int out_size, void* d_ws, size_t ws_size, hipStream_t stream) {
    if (n_in != 30 || ws_size < WS_END) { fprintf(stderr, "kernel_launch: unexpected n_in %d / ws_size %zu\n", n_in, ws_size); return; }
    static int grid = 0;
    if (grid == 0) {
        int dev = 0, cus = 0, per_cu = 0;
        (void)hipGetDevice(&dev); (void)hipDeviceGetAttribute(&cus, hipDeviceAttributeMultiprocessorCount, dev);
        if (hipFuncSetAttribute((const void*)mega, hipFuncAttributeMaxDynamicSharedMemorySize, LDS_BYTES) != hipSuccess) { fprintf(stderr, "hipFuncSetAttribute failed\n"); grid = -1; return; }
        if (hipOccupancyMaxActiveBlocksPerMultiprocessor(&per_cu, (const void*)mega, NTHR, LDS_BYTES) != hipSuccess || per_cu < 1) { fprintf(stderr, "occupancy query failed (%d)\n", per_cu); per_cu = 1; }
        (void)hipGetLastError();
        grid = (cus > 0 ? cus : 256) * 1;
    }
    if (grid < 0) return;
    Args a{}; for (int i = 0; i < 30; ++i) a.in[i] = (const float*)d_in[i]; a.out = (float*)d_out; a.ws = (unsigned char*)d_ws;
    a.ph_lo = 0; a.ph_hi = NPH;
    if (hipMemsetAsync(d_ws, 0, 65536, stream) != hipSuccess) { fprintf(stderr, "memset failed\n"); return; }
    void* kargs[] = {&a};
    hipError_t e = hipLaunchCooperativeKernel((const void*)mega, dim3(grid), dim3(NTHR), kargs, LDS_BYTES, stream);
    if (e != hipSuccess) fprintf(stderr, "cooperative launch failed: %s (grid %d)\n", hipGetErrorString(e), grid);
}
```

```cpp
#include <hip/hip_runtime.h>
#include <hip/hip_cooperative_groups.h>
namespace cg = cooperative_groups;
#include <cstdio>
#include <cstdint>
#include <cmath>

constexpr int D = 1024, BATCH = 4, SEQ = 4096, T = BATCH * SEQ, DEPTH = 2;
constexpr int RW = 512, HS = 64, NH = 8;
constexpr int DL = 64, AL = 64, MVL = 32, GL = 128;
constexpr int RWKV_COLS = 3 * RW + DL + AL + GL;
constexpr int PW = 512, PG = 128;
constexpr int IN_COLS = RWKV_COLS + PW;
constexpr int LDP = 2560;
constexpr int NKEYS = 128, NEXP = NKEYS * NKEYS, PH = 8, PQ = 256, PHALF = 128, TOPK = 16;
constexpr int NE = PH * TOPK;
constexpr float NORM_EPS = 1e-6f, GN_EPS = 64e-5f;

typedef unsigned short bf16;
__device__ __forceinline__ float bf2f(bf16 u) { return __uint_as_float((unsigned)u << 16); }
typedef float cvt_f32x2 __attribute__((ext_vector_type(2))); typedef __bf16 cvt_bf16x2 __attribute__((ext_vector_type(2)));
__device__ __forceinline__ unsigned cvtpk(float lo, float hi) { const cvt_f32x2 v = {lo, hi}; const cvt_bf16x2 b = __builtin_convertvector(v, cvt_bf16x2); return __builtin_bit_cast(unsigned, b); }
__device__ __forceinline__ bf16 f2bf(float f) { return (bf16)cvtpk(f, 0.f); }

constexpr size_t MiB = 1u << 20;
constexpr size_t WS_MOD = 1 * MiB;
constexpr size_t WS_US = 1 * MiB + 256 * 1024;
constexpr size_t WS_VS = 1 * MiB + 512 * 1024;
constexpr size_t WS_H = 2 * MiB;
constexpr size_t WS_PROJ = 34 * MiB;
constexpr size_t WS_Q = WS_PROJ;
constexpr size_t WS_R = 114 * MiB;
constexpr size_t WS_K = 130 * MiB;
constexpr size_t WS_V0 = 146 * MiB;
constexpr size_t WS_V1 = 162 * MiB;
constexpr size_t WS_KK = 178 * MiB;
constexpr size_t WS_B = 194 * MiB;
constexpr size_t WS_G = 210 * MiB;
constexpr size_t WS_BG = 226 * MiB;
constexpr size_t WS_W = 242 * MiB;
constexpr size_t WS_Y = 274 * MiB;
constexpr size_t WS_MIX = 306 * MiB;
constexpr size_t WS_IDX = 338 * MiB;
constexpr size_t WS_GATE = 346 * MiB;
constexpr size_t WS_WIN_T = 354 * MiB;
constexpr size_t WS_WOUT_T = 364 * MiB;
constexpr size_t WS_PQ_T = 368 * MiB;
constexpr size_t WS_KEYS = 376 * MiB;
constexpr size_t WS_U = 378 * MiB;
constexpr size_t WS_V = 442 * MiB;
constexpr size_t WS_QB = 410 * MiB;
constexpr size_t WS_SH = 426 * MiB;
constexpr size_t WS_LORA = 428 * MiB;
constexpr size_t WS_INVN = 430 * MiB;
constexpr size_t WS_BSUM = 431 * MiB;
constexpr size_t WS_SCN = 2 * MiB;
constexpr size_t WS_END = 506 * MiB;

template <int CTRL> __device__ __forceinline__ float dppf(float x) { return __int_as_float(__builtin_amdgcn_update_dpp(0, __float_as_int(x), CTRL, 0xF, 0xF, false)); }
__device__ __forceinline__ float red16(float x) { x += dppf<0xB1>(x); x += dppf<0x4E>(x); x += dppf<0x141>(x); x += dppf<0x140>(x); return x; }
__device__ __forceinline__ float shflx(float v, int lane, int off) { return __int_as_float(__builtin_amdgcn_ds_bpermute((lane ^ off) << 2, __float_as_int(v))); }
__device__ __forceinline__ unsigned shflxu(unsigned v, int lane, int off) { return (unsigned)__builtin_amdgcn_ds_bpermute((lane ^ off) << 2, (int)v); }
__device__ __forceinline__ void sort128(unsigned& k0, unsigned& k1, int lane) {
#pragma unroll
    for (int k = 2; k <= 128; k <<= 1) {
#pragma unroll
        for (int j = k >> 1; j > 0; j >>= 1) {
            if (j == 64) { const unsigned lo = k0 < k1 ? k0 : k1, hi = k0 < k1 ? k1 : k0; k0 = lo; k1 = hi; }
            else {
                const unsigned p0 = shflxu(k0, lane, j), p1 = shflxu(k1, lane, j);
                const bool lower = (lane & j) == 0, up0 = (lane & k) == 0, up1 = ((lane + 64) & k) == 0;
                const unsigned mn0 = k0 < p0 ? k0 : p0, mx0 = k0 < p0 ? p0 : k0, mn1 = k1 < p1 ? k1 : p1, mx1 = k1 < p1 ? p1 : k1;
                k0 = (lower == up0) ? mn0 : mx0; k1 = (lower == up1) ? mn1 : mx1;
            }
        }
    }
}
__device__ __forceinline__ float wave_sum(float v, int lane) { v = red16(v); v += shflx(v, lane, 16); v += shflx(v, lane, 32); return v; }
__device__ __forceinline__ float sigmoidf_(float x) { return 1.f / (1.f + expf(-x)); }

namespace pg8 {
#define PG8_LAS __attribute__((address_space(3)))
typedef unsigned short bf16_t;
typedef short bf16x8 __attribute__((ext_vector_type(8)));
typedef float f32x4 __attribute__((ext_vector_type(4)));
typedef unsigned u32x4 __attribute__((ext_vector_type(4)));
constexpr int BM = 256, BK = 64, HALF = 128, HTB = HALF * BK * 2  , STAGE_BYTES = 8 * HTB, NXCD = 8, WGM = 8;

__host__ __device__ __forceinline__ int lds_byte(int r, int c) { const int st = (r >> 4) * 2 + (c >> 5), rr = r & 15, cc = c & 31, ob = rr * 64 + cc * 2; return st * 1024 + (ob ^ (((ob >> 9) & 1) << 5)); }
__host__ __device__ __forceinline__ void stage_rc(int b, int& R, int& C) { const int st = b / 1024, sb = b % 1024, swz = sb ^ (((sb >> 9) & 1) << 5); R = (st >> 1) * 16 + swz / 64; C = (st & 1) * 32 + (swz % 64) / 2; }
__host__ __device__ __forceinline__ int perm32(int rho) { const int n = rho >> 4, i = rho & 15; return 8 * (i >> 2) + 4 * n + (i & 3); }

struct Unit { int pm, pn; };
struct Gemm { const bf16_t* A; const bf16_t* Bt; int M, N, K; };

struct StaticOrder {
    int nM, nN, nwg, G, c;
    __host__ __device__ void init(int M, int N, int G_, int c_) { nM = M / BM; nN = N / BM; nwg = nM * nN; G = G_; c = c_; }
    __host__ __device__ bool next(int i, Unit& u) const {
        const long L = (long)i * G + c; if (L >= nwg) return false;
        int wgid = (int)L; { const int q = nwg / NXCD, r = nwg % NXCD, xcd = wgid % NXCD, off = wgid / NXCD; wgid = (xcd < r ? xcd * (q + 1) : r * (q + 1) + (xcd - r) * q) + off; }
        const int nig = WGM * nN, gid = wgid / nig, fm = gid * WGM, gsz = (nM - fm) < WGM ? (nM - fm) : WGM;
        u.pm = fm + ((wgid % nig) % gsz); u.pn = (wgid % nig) / gsz; return true;
    }
    __device__ __forceinline__ void a_ready(const Unit&) const {}
    __device__ __forceinline__ void done(const Unit&) const {}
};

__device__ __forceinline__ unsigned cvt_pk_bf16(float lo, float hi) { unsigned r; asm volatile("v_cvt_pk_bf16_f32 %0, %1, %2" : "=v"(r) : "v"(lo), "v"(hi)); return r; }
typedef float f32x2 __attribute__((ext_vector_type(2)));
__device__ __forceinline__ f32x2 gelu_pk(f32x2 v) {
    const f32x2 av = __builtin_elementwise_abs(v), d = av * 0.2316418882f + 1.0f;
    f32x2 t; t.x = __builtin_amdgcn_rcpf(d.x); t.y = __builtin_amdgcn_rcpf(d.y);
    f32x2 q = t * 0.5307027145f + (-0.7265760135f); q = q * t + 0.7107068705f; q = q * t + (-0.142248368f); q = q * t + 0.127414796f; q = q * t;
    const f32x2 s = (v * v) * (-0.72134752044f);
    f32x2 e; e.x = __builtin_amdgcn_exp2f(s.x); e.y = __builtin_amdgcn_exp2f(s.y);
    const f32x2 m = v * (q * e), r = v - m;
    f32x2 o; o.x = v.x < 0.f ? m.x : r.x; o.y = v.y < 0.f ? m.y : r.y; return o;
}

template <int ACT  > struct EpiBf16 {
    static constexpr bool PERM = true, AFTER_DRAIN = false; static_assert(ACT == 0 || ACT == 1, "EpiBf16: ACT is 0 (none) or 1 (gelu_pk)");
    bf16_t* O; int ldc; const float* bias; int split_cols; size_t split_stride; float scale0;
    __device__ __forceinline__ void operator()(const f32x4 (&acc)[2][2][4][2], const Unit& u, int wr, int wc, int fr, int fq) const {
        const int row0 = u.pm * BM + wr * 64 + fr; int colt = u.pn * BM; bf16_t* base = O;
        float sc = 1.f; if (split_cols) { const int t = colt / split_cols; base += (size_t)t * split_stride; colt -= t * split_cols; if (t == 0) sc = scale0; }
        const int col0 = colt + wc * 32 + 8 * fq, bcol0 = u.pn * BM + wc * 32 + 8 * fq;
        f32x4 bv[2][2];
#pragma unroll
        for (int bj = 0; bj < 2; ++bj)
#pragma unroll
            for (int n = 0; n < 2; ++n) bv[bj][n] = bias ? *(const f32x4*)(bias + bcol0 + bj * HALF + 4 * n) : (f32x4){0.f, 0.f, 0.f, 0.f};
#pragma unroll
        for (int ai = 0; ai < 2; ++ai)
#pragma unroll
            for (int m = 0; m < 4; ++m) { bf16_t* rowp = base + (size_t)(row0 + ai * HALF + m * 16) * ldc + col0;
#pragma unroll
                for (int bj = 0; bj < 2; ++bj) { f32x4 v0 = acc[ai][bj][m][0] + bv[bj][0], v1 = acc[ai][bj][m][1] + bv[bj][1];
                    if (ACT == 1) { f32x2 a = gelu_pk((f32x2){v0[0], v0[1]}), b = gelu_pk((f32x2){v0[2], v0[3]}), c = gelu_pk((f32x2){v1[0], v1[1]}), d = gelu_pk((f32x2){v1[2], v1[3]});
                        v0 = (f32x4){a.x, a.y, b.x, b.y}; v1 = (f32x4){c.x, c.y, d.x, d.y}; }
                    v0 = v0 * sc; v1 = v1 * sc; u32x4 w; w.x = cvt_pk_bf16(v0[0], v0[1]); w.y = cvt_pk_bf16(v0[2], v0[3]); w.z = cvt_pk_bf16(v1[0], v1[1]); w.w = cvt_pk_bf16(v1[2], v1[3]);
                    *(u32x4*)(rowp + bj * HALF) = w; } }
    }
};

struct EpiProj {
    static constexpr bool PERM = true, AFTER_DRAIN = false;
    bf16_t* O; int ldc; bf16_t* P; int pool0, pw;
    __device__ __forceinline__ void operator()(const f32x4 (&acc)[2][2][4][2], const Unit& u, int wr, int wc, int fr, int fq) const {
        const int row0 = u.pm * BM + wr * 64 + fr; int colt = u.pn * BM; bf16_t* base = O; int ld = ldc;
        if (colt >= pool0 && colt < pool0 + pw) { base = P; ld = pw; colt -= pool0; }
        const int col0 = colt + wc * 32 + 8 * fq;
#pragma unroll
        for (int ai = 0; ai < 2; ++ai)
#pragma unroll
            for (int m = 0; m < 4; ++m) { bf16_t* rowp = base + (size_t)(row0 + ai * HALF + m * 16) * ld + col0;
#pragma unroll
                for (int bj = 0; bj < 2; ++bj) { const f32x4 v0 = acc[ai][bj][m][0], v1 = acc[ai][bj][m][1];
                    u32x4 w; w.x = cvt_pk_bf16(v0[0], v0[1]); w.y = cvt_pk_bf16(v0[2], v0[3]); w.z = cvt_pk_bf16(v1[0], v1[1]); w.w = cvt_pk_bf16(v1[2], v1[3]);
                    *(u32x4*)(rowp + bj * HALF) = w; } }
    }
};
struct EpiResGate {
    static constexpr bool PERM = true, AFTER_DRAIN = false;
    const float* xold; float* X; const float* gate;
    bf16_t* XB; const float* sv; unsigned long long* ssq;
    __device__ __forceinline__ void operator()(const f32x4 (&acc)[2][2][4][2], const Unit& u, int wr, int wc, int fr, int fq) const {
        const int col0 = u.pn * BM + wc * 32 + 8 * fq; const int b = (u.pm * BM) / SEQ;
        const float* gp = gate + (size_t)b * 6 * D + col0; const float* sp = sv + (size_t)b * D + col0;
        float rsum[2][4];
#pragma unroll
        for (int ai = 0; ai < 2; ++ai)
#pragma unroll
            for (int m = 0; m < 4; ++m) rsum[ai][m] = 0.f;
#pragma unroll
        for (int bj = 0; bj < 2; ++bj) { const f32x4 g0 = *(const f32x4*)(gp + bj * HALF), g1 = *(const f32x4*)(gp + bj * HALF + 4), s0 = *(const f32x4*)(sp + bj * HALF), s1 = *(const f32x4*)(sp + bj * HALF + 4);
#pragma unroll
            for (int ai = 0; ai < 2; ++ai)
#pragma unroll
                for (int m = 0; m < 4; ++m) { const size_t off = (size_t)(u.pm * BM + ai * HALF + wr * 64 + m * 16 + fr) * D + col0 + bj * HALF;
                    const f32x4 xa = *(const f32x4*)(xold + off) + g0 * acc[ai][bj][m][0], xb = *(const f32x4*)(xold + off + 4) + g1 * acc[ai][bj][m][1];
                    *(f32x4*)(X + off) = xa; *(f32x4*)(X + off + 4) = xb;
                    rsum[ai][m] += ((xa[0] * xa[0] + xa[1] * xa[1]) + (xa[2] * xa[2] + xa[3] * xa[3])) + ((xb[0] * xb[0] + xb[1] * xb[1]) + (xb[2] * xb[2] + xb[3] * xb[3]));
                    const f32x4 ya = xa * s0, yb = xb * s1; u32x4 o; o.x = cvt_pk_bf16(ya[0], ya[1]); o.y = cvt_pk_bf16(ya[2], ya[3]); o.z = cvt_pk_bf16(yb[0], yb[1]); o.w = cvt_pk_bf16(yb[2], yb[3]);
                    *(u32x4*)(XB + off) = o; } }
        const int lane_ = fr | (fq << 4);
#pragma unroll
        for (int ai = 0; ai < 2; ++ai)
#pragma unroll
            for (int m = 0; m < 4; ++m) { float v = rsum[ai][m];
                v += __int_as_float(__builtin_amdgcn_ds_bpermute((lane_ ^ 16) << 2, __float_as_int(v))); v += __int_as_float(__builtin_amdgcn_ds_bpermute((lane_ ^ 32) << 2, __float_as_int(v)));
                if (fq == 0) (void)__hip_atomic_fetch_add(ssq + (u.pm * BM + ai * HALF + wr * 64 + m * 16 + fr), (unsigned long long)(v * 1048576.f + 0.5f), __ATOMIC_RELAXED, __HIP_MEMORY_SCOPE_AGENT); }
    }
};
struct EpiQ {
    static constexpr bool PERM = true, AFTER_DRAIN = false;
    bf16_t* O; int ldc; const float* cv; const unsigned long long* ssq;
    __device__ __forceinline__ void operator()(const f32x4 (&acc)[2][2][4][2], const Unit& u, int wr, int wc, int fr, int fq) const {
        const int row0 = u.pm * BM + wr * 64 + fr, colt = u.pn * BM, b = (u.pm * BM) / SEQ;
        const int col0 = colt + wc * 32 + 8 * fq;
        f32x4 bv[2][2];
#pragma unroll
        for (int bj = 0; bj < 2; ++bj)
#pragma unroll
            for (int n = 0; n < 2; ++n) bv[bj][n] = *(const f32x4*)(cv + (size_t)b * ldc + col0 + bj * HALF + 4 * n);
#pragma unroll
        for (int ai = 0; ai < 2; ++ai)
#pragma unroll
            for (int m = 0; m < 4; ++m) { const int row = row0 + ai * HALF + m * 16; bf16_t* rowp = O + (size_t)row * ldc + col0;
                const float rs = rsqrtf((float)ssq[row] * (1.f / (1048576.f * 1024.f)) + 1e-6f);
#pragma unroll
                for (int bj = 0; bj < 2; ++bj) { const f32x4 v0 = acc[ai][bj][m][0] * rs + bv[bj][0], v1 = acc[ai][bj][m][1] * rs + bv[bj][1];
                    u32x4 w; w.x = cvt_pk_bf16(v0[0], v0[1]); w.y = cvt_pk_bf16(v0[2], v0[3]); w.z = cvt_pk_bf16(v1[0], v1[1]); w.w = cvt_pk_bf16(v1[2], v1[3]);
                    *(u32x4*)(rowp + bj * HALF) = w; } }
    }
};
template <class Epi, class Sched, bool ALIGN_EPI = false, bool SP2 = false>
__device__ __forceinline__ void gemm_phase(PG8_LAS unsigned char* lds, const Gemm g, const Sched& S, const Epi& E, int tid) {
    asm volatile("" : "+v"(tid));
    const int wid = __builtin_amdgcn_readfirstlane(tid >> 6), lane = tid & 63, wr = wid >> 2, wc = wid & 3, fr = lane & 15, fq = lane >> 4;
    const int K = g.K, nt = K / BK;
    unsigned voffA[2], voffB[2];
#pragma unroll
    for (int i = 0; i < 2; ++i) { int R, C; stage_rc(tid * 16 + i * 8192, R, C); const int Rb = Epi::PERM ? ((R & ~31) + perm32(R & 31)) : R;
        voffA[i] = (unsigned)(R * K + C) * 2u; voffB[i] = (unsigned)(Rb * K + C) * 2u; }
    const size_t kstep = (size_t)(BK * 2);
    const size_t hstep = (size_t)HALF * K * 2;
    const size_t tstep = 2 * hstep;
    const unsigned ldsw = (unsigned)wid * 1024u;
    const int aoff = lds_byte(wr * 64 + fr, fq * 8), boff = lds_byte(wc * 32 + fr, fq * 8);
#define PG8_SA(b, h) (((b) * 2 + (h)) * HTB)
#define PG8_SB(b, h) ((4 + (b) * 2 + (h)) * HTB)
#define PG8_STAGE(bufoff, gbase, voff) do { _Pragma("unroll") for (int _i = 0; _i < 2; ++_i) \
        __builtin_amdgcn_global_load_lds((const unsigned*)((const char*)(gbase) + (voff)[_i]), (PG8_LAS unsigned*)(lds + (bufoff) + ldsw + _i * 8192), 16, 0, 0); } while (0)
#define PG8_LDA(dst, b, h) do { _Pragma("unroll") for (int m = 0; m < 4; ++m) _Pragma("unroll") for (int k = 0; k < 2; ++k) dst[m][k] = *(const PG8_LAS bf16x8*)(lds + PG8_SA(b, h) + aoff + m * 2048 + k * 1024); } while (0)
#define PG8_LDB(dst, b, h) do { _Pragma("unroll") for (int n = 0; n < 2; ++n) _Pragma("unroll") for (int k = 0; k < 2; ++k) dst[n][k] = *(const PG8_LAS bf16x8*)(lds + PG8_SB(b, h) + boff + n * 2048 + k * 1024); } while (0)
#define PG8_MMA(ai, bj, At, Bt) do { __builtin_amdgcn_s_setprio(1); _Pragma("unroll") for (int m = 0; m < 4; ++m) _Pragma("unroll") for (int n = 0; n < 2; ++n) _Pragma("unroll") for (int k = 0; k < 2; ++k) \
        acc[ai][bj][m][n] = __builtin_amdgcn_mfma_f32_16x16x32_bf16(Bt[n][k], At[m][k], acc[ai][bj][m][n], 0, 0, 0); __builtin_amdgcn_s_setprio(0); } while (0)
#define PG8_WAIT_V(n) asm volatile("s_waitcnt vmcnt(" #n ")" ::: "memory")
#define PG8_WAIT_L(n) asm volatile("s_waitcnt lgkmcnt(" #n ")" ::: "memory")
#define PG8_BAR __builtin_amdgcn_s_barrier()
#define PG8_SCHED __builtin_amdgcn_sched_barrier(0)
    Unit cur, nxt; int ui = 0;
    if (!S.next(0, cur)) return;
    f32x4 acc[2][2][4][2];
#pragma unroll
    for (int a = 0; a < 2; ++a)
#pragma unroll
        for (int b = 0; b < 2; ++b)
#pragma unroll
            for (int m = 0; m < 4; ++m)
#pragma unroll
                for (int n = 0; n < 2; ++n) acc[a][b][m][n] = (f32x4){0.f, 0.f, 0.f, 0.f};
    bf16x8 At[4][2], B0[2][2], B1[2][2];
    const char* cA = (const char*)g.A + (size_t)cur.pm * tstep; const char* cB = (const char*)g.Bt + (size_t)cur.pn * tstep;
    S.a_ready(cur);
    if constexpr (SP2) {
        PG8_STAGE(PG8_SB(0, 0), cB, voffB); PG8_STAGE(PG8_SB(0, 1), cB + hstep, voffB); PG8_STAGE(PG8_SA(0, 0), cA, voffA); PG8_STAGE(PG8_SA(0, 1), cA + hstep, voffA);
        if (wr == 1) PG8_BAR;
        PG8_WAIT_V(2); PG8_BAR;
        PG8_STAGE(PG8_SB(1, 0), cB + kstep, voffB); PG8_STAGE(PG8_SA(1, 0), cA + kstep, voffA); PG8_STAGE(PG8_SB(1, 1), cB + hstep + kstep, voffB);
        PG8_WAIT_V(6); PG8_BAR;
    } else {
        PG8_STAGE(PG8_SB(0, 0), cB, voffB); PG8_STAGE(PG8_SA(0, 0), cA, voffA); PG8_STAGE(PG8_SB(0, 1), cB + hstep, voffB); PG8_STAGE(PG8_SA(0, 1), cA + hstep, voffA);
        if (wr == 1) PG8_BAR;
        PG8_WAIT_V(4); PG8_BAR;
        PG8_STAGE(PG8_SB(1, 0), cB + kstep, voffB); PG8_STAGE(PG8_SA(1, 0), cA + kstep, voffA); PG8_STAGE(PG8_SB(1, 1), cB + hstep + kstep, voffB);
        PG8_WAIT_V(6); PG8_BAR;
    }
    for (;;) {
        const bool has_next = S.next(ui + 1, nxt);
        const char* nA = has_next ? (const char*)g.A + (size_t)nxt.pm * tstep : cA; const char* nB = has_next ? (const char*)g.Bt + (size_t)nxt.pn * tstep : cB;
        for (int t = 0; t < nt; t += 2) {
            const bool last = (t == nt - 2);
            const char* a1 = cA + (size_t)(t + 1) * kstep;
            const char* a2 = last ? nA : cA + (size_t)(t + 2) * kstep; const char* b2 = last ? nB : cB + (size_t)(t + 2) * kstep;
            const char* a3 = a2 + kstep; const char* b3 = b2 + kstep;
            if (last && has_next) S.a_ready(nxt);
            if constexpr (SP2) {
            PG8_LDB(B0, 0, 0); PG8_LDB(B1, 0, 1); PG8_SCHED; PG8_LDA(At, 0, 0); PG8_STAGE(PG8_SA(1, 1), a1 + hstep, voffA);
            PG8_WAIT_V(8); PG8_WAIT_L(0); PG8_BAR; PG8_MMA(0, 0, At, B0); PG8_MMA(0, 1, At, B1); PG8_BAR; PG8_SCHED;
            PG8_LDA(At, 0, 1); PG8_STAGE(PG8_SB(0, 0), b2, voffB); PG8_STAGE(PG8_SB(0, 1), b2 + hstep, voffB); PG8_STAGE(PG8_SA(0, 0), a2, voffA);
            PG8_WAIT_V(8); PG8_WAIT_L(0); PG8_BAR; PG8_MMA(1, 0, At, B0); PG8_MMA(1, 1, At, B1); PG8_BAR; PG8_SCHED;
            PG8_LDB(B0, 1, 0); PG8_LDB(B1, 1, 1); PG8_SCHED; PG8_LDA(At, 1, 0); PG8_STAGE(PG8_SA(0, 1), a2 + hstep, voffA);
            PG8_WAIT_V(8); PG8_WAIT_L(0); PG8_BAR; PG8_MMA(0, 0, At, B0); PG8_MMA(0, 1, At, B1); PG8_BAR; PG8_SCHED;
            PG8_LDA(At, 1, 1); PG8_STAGE(PG8_SB(1, 0), b3, voffB); PG8_STAGE(PG8_SB(1, 1), b3 + hstep, voffB); PG8_STAGE(PG8_SA(1, 0), a3, voffA);
            PG8_WAIT_V(8); PG8_WAIT_L(0); PG8_BAR; PG8_MMA(1, 0, At, B0); PG8_MMA(1, 1, At, B1); PG8_BAR; PG8_SCHED;
            } else {
            PG8_LDB(B0, 0, 0); PG8_SCHED; PG8_LDA(At, 0, 0); PG8_STAGE(PG8_SA(1, 1), a1 + hstep, voffA);
            PG8_WAIT_L(8); PG8_BAR; PG8_WAIT_L(0); PG8_MMA(0, 0, At, B0); PG8_BAR; PG8_SCHED;
            PG8_LDB(B1, 0, 1); PG8_STAGE(PG8_SB(0, 0), b2, voffB);
            PG8_BAR; PG8_WAIT_L(0); PG8_MMA(0, 1, At, B1); PG8_BAR;
            PG8_LDA(At, 0, 1); PG8_STAGE(PG8_SA(0, 0), a2, voffA);
            PG8_BAR; PG8_WAIT_L(0); PG8_MMA(1, 0, At, B0); PG8_BAR; PG8_SCHED;
            PG8_STAGE(PG8_SB(0, 1), b2 + hstep, voffB);
            PG8_WAIT_V(6); PG8_BAR; PG8_MMA(1, 1, At, B1); PG8_BAR;
            PG8_LDB(B0, 1, 0); PG8_SCHED; PG8_LDA(At, 1, 0); PG8_STAGE(PG8_SA(0, 1), a2 + hstep, voffA);
            PG8_WAIT_L(8); PG8_BAR; PG8_WAIT_L(0); PG8_MMA(0, 0, At, B0); PG8_BAR; PG8_SCHED;
            PG8_LDB(B1, 1, 1); PG8_STAGE(PG8_SB(1, 0), b3, voffB);
            PG8_BAR; PG8_WAIT_L(0); PG8_MMA(0, 1, At, B1); PG8_BAR;
            PG8_LDA(At, 1, 1); PG8_STAGE(PG8_SA(1, 0), a3, voffA);
            PG8_BAR; PG8_WAIT_L(0); PG8_MMA(1, 0, At, B0); PG8_BAR; PG8_SCHED;
            PG8_STAGE(PG8_SB(1, 1), b3 + hstep, voffB);
            PG8_WAIT_V(6); PG8_BAR; PG8_MMA(1, 1, At, B1); PG8_BAR;
            }
        }
        if constexpr (ALIGN_EPI) { if (wr == 0) PG8_BAR; }
        if constexpr (!Epi::AFTER_DRAIN) { int le_; asm volatile("v_mbcnt_lo_u32_b32 %0, -1, 0\n\tv_mbcnt_hi_u32_b32 %0, -1, %0" : "=v"(le_)); E(acc, cur, wr, wc, le_ & 15, le_ >> 4); S.done(cur); }
        if (!has_next) break;
#pragma unroll
        for (int a = 0; a < 2; ++a)
#pragma unroll
            for (int b = 0; b < 2; ++b)
#pragma unroll
                for (int m = 0; m < 4; ++m)
#pragma unroll
                    for (int n = 0; n < 2; ++n) acc[a][b][m][n] = (f32x4){0.f, 0.f, 0.f, 0.f};
        cur = nxt; cA = nA; cB = nB; ++ui;
        if constexpr (ALIGN_EPI) { if (wr == 1) PG8_BAR; }
    }
    PG8_WAIT_V(0);
    if constexpr (!ALIGN_EPI) { if (wr == 0) PG8_BAR; }
    PG8_BAR;
    if constexpr (Epi::AFTER_DRAIN) { E.fused(acc, cur, wr, wc, fr, fq, lds, wid, lane); S.done(cur); }
#undef PG8_SA
#undef PG8_SB
#undef PG8_STAGE
#undef PG8_LDA
#undef PG8_LDB
#undef PG8_MMA
#undef PG8_WAIT_V
#undef PG8_WAIT_L
#undef PG8_BAR
#undef PG8_SCHED
}
}

#define LAS __attribute__((address_space(3)))
constexpr int NWAVES = 8, NTHR = 512;
constexpr int LDS_BYTES = 147456;
constexpr int NPH = 21;
typedef float f32x4 __attribute__((ext_vector_type(4)));
typedef unsigned u32x4 __attribute__((ext_vector_type(4)));

struct Args { const float* in[30]; float* out; unsigned char* ws; int ph_lo, ph_hi; };

__device__ __forceinline__ unsigned pk2(float lo, float hi) { return cvtpk(lo, hi); }

__device__ __forceinline__ void p0_transpose_item(const float* W, int K, int N, bf16* WT, int row_off, LAS float* scr, int item, int lane) {
    const int nblk = N / 32, kb = item / nblk, nb = item % nblk, k0 = 64 * kb, n0 = 32 * nb;
#pragma unroll 8
    for (int i = 0; i < 32; ++i) { const int kk = 2 * i + (lane >> 5); scr[kk * 33 + (lane & 31)] = W[(size_t)(k0 + kk) * N + n0 + (lane & 31)]; }
    asm volatile("s_waitcnt lgkmcnt(0)" ::: "memory");
    const int c = lane & 7;
#pragma unroll
    for (int j = 0; j < 4; ++j) { const int n = (lane >> 3) + 8 * j; const LAS float* s = scr + (8 * c) * 33 + n;
        u32x4 o; o.x = pk2(s[0 * 33], s[1 * 33]); o.y = pk2(s[2 * 33], s[3 * 33]); o.z = pk2(s[4 * 33], s[5 * 33]); o.w = pk2(s[6 * 33], s[7 * 33]);
        *(u32x4*)(WT + (size_t)(row_off + n0 + n) * K + k0 + 8 * c) = o; }
    asm volatile("s_waitcnt lgkmcnt(0)" ::: "memory");
}

__device__ __forceinline__ void norm_mod_row(const float* xr, const float* gamma, const float* sh, const float* sc, bf16* orow, int lane) {
    f32x4 v[4]; float ss = 0.f;
#pragma unroll
    for (int j = 0; j < 4; ++j) { v[j] = *(const f32x4*)(xr + j * 256 + lane * 4); ss += (v[j].x * v[j].x + v[j].y * v[j].y) + (v[j].z * v[j].z + v[j].w * v[j].w); }
    const float rs = rsqrtf(wave_sum(ss, lane) * (1.f / D) + NORM_EPS);
#pragma unroll
    for (int j = 0; j < 4; ++j) { const int d = j * 256 + lane * 4; const f32x4 g = *(const f32x4*)(gamma + d), a = *(const f32x4*)(sc + d), s = *(const f32x4*)(sh + d);
        const f32x4 y = v[j] * rs * g * (a + 1.f) + s; uint2 o; o.x = pk2(y.x, y.y); o.y = pk2(y.z, y.w); *(uint2*)(orow + d) = o; }
}


#define XB_TMO      128
#define XB_XCNT(j)  (256  + 64 * (j))
#define XB_XSUB(j)  (1280 + 64 * (j))
#define XB_XGEN(j)  (2304 + 64 * (j))
#define XB_TOP      3328
#define XB_TOPGEN   3392
#define XCD_BAR_WORDS 3456
#define XB_SPIN_CAP (1u << 18)

__device__ __forceinline__ unsigned xb_ld(unsigned* p)              { return __hip_atomic_load(p, __ATOMIC_RELAXED, __HIP_MEMORY_SCOPE_AGENT); }
__device__ __forceinline__ unsigned xb_add(unsigned* p, unsigned v) { return __hip_atomic_fetch_add(p, v, __ATOMIC_RELAXED, __HIP_MEMORY_SCOPE_AGENT); }
__device__ __forceinline__ unsigned xb_xcc_id() { return (unsigned)__builtin_amdgcn_s_getreg((3 << 11) | 20) & 0xFu; }
#define XB_SPIN(cond, bar) do { unsigned _sp = 0; while (cond) { __builtin_amdgcn_s_sleep(1); \
    if ((++_sp & 255u) == 0u) { if (xb_ld(&(bar)[XB_TMO])) break; if (_sp > XB_SPIN_CAP) { atomicAdd(&(bar)[XB_TMO], 1u); break; } } } } while (0)

struct XcdBarrier {
    unsigned* bar; unsigned x; int w0;
    volatile __attribute__((address_space(3))) unsigned* st;
};

__device__ __forceinline__ XcdBarrier xcd_barrier_post(unsigned* bar, volatile __attribute__((address_space(3))) unsigned* st) {
    XcdBarrier b; b.bar = bar; b.x = xb_xcc_id(); b.st = st; b.w0 = __builtin_amdgcn_readfirstlane((int)threadIdx.x >> 6);
    if (threadIdx.x == 0) (void)xb_add(&bar[XB_XCNT(b.x)], 1u);
    return b;
}
__device__ __forceinline__ void xcd_barrier_complete(unsigned* bar, unsigned x, unsigned& nloc, unsigned& nx) {
    const unsigned G = gridDim.x * gridDim.y * gridDim.z;
    unsigned sum, cnt, mine, sp = 0u;
    for (;;) {
        sum = 0u; cnt = 0u; mine = 0u;
#pragma unroll
        for (unsigned j = 0; j < 16; ++j) { const unsigned c = xb_ld(&bar[XB_XCNT(j)]); sum += c; cnt += (c > 0u) ? 1u : 0u; }
        mine = xb_ld(&bar[XB_XCNT(x)]);
        if (sum == G) break;
        __builtin_amdgcn_s_sleep(1);
        if ((++sp & 255u) == 0u) { if (xb_ld(&bar[XB_TMO])) break; if (sp > XB_SPIN_CAP) { atomicAdd(&bar[XB_TMO], 1u); break; } }
    }
    nloc = mine > 0u ? mine : 1u; nx = cnt > 0u ? cnt : 1u;
}

template <bool FIRST> __device__ __forceinline__ void xcd_barrier(const XcdBarrier& b) {
    asm volatile("s_waitcnt vmcnt(0)" ::: "memory");
    __syncthreads();
    int lid_; asm volatile("v_mbcnt_lo_u32_b32 %0, -1, 0\n\tv_mbcnt_hi_u32_b32 %0, -1, %0" : "=v"(lid_));
    if (b.w0 == 0 && lid_ == 0) {
        unsigned* bar = b.bar;
        __builtin_amdgcn_s_waitcnt(0);
        unsigned nloc = b.st[0], nx = b.st[1];
        if (FIRST && nloc == 0u) { xcd_barrier_complete(bar, b.x, nloc, nx); b.st[0] = nloc; b.st[1] = nx; }
        const unsigned old = xb_add(&bar[XB_XSUB(b.x)], 1u);
        const unsigned gen = old / nloc;
        if (old + 1u == (gen + 1u) * nloc) {
            __builtin_amdgcn_fence(__ATOMIC_RELEASE, "agent");
            asm volatile("s_waitcnt vmcnt(0)" ::: "memory");
            const unsigned og = xb_add(&bar[XB_TOP], 1u);
            const unsigned tg = og / nx;
            if (og + 1u == (tg + 1u) * nx) xb_add(&bar[XB_TOPGEN], 1u);
            else XB_SPIN(xb_ld(&bar[XB_TOPGEN]) == tg, bar);
            __builtin_amdgcn_fence(__ATOMIC_ACQUIRE, "agent");
            xb_add(&bar[XB_XGEN(b.x)], 1u);
            asm volatile("s_waitcnt vmcnt(0)" ::: "memory");
        } else {
            XB_SPIN(xb_ld(&bar[XB_XGEN(b.x)]) == gen, bar);
            __builtin_amdgcn_fence(__ATOMIC_ACQUIRE, "agent");
            asm volatile("s_waitcnt vmcnt(0)" ::: "memory");
        }
    }
    __syncthreads();
}


__device__ __forceinline__ unsigned mono_u32(float f) { unsigned u = __float_as_uint(f); return (u & 0x80000000u) ? ~u : (u | 0x80000000u); }
__device__ __forceinline__ float demono_u32(unsigned u) { return __uint_as_float((u & 0x80000000u) ? (u & 0x7FFFFFFFu) : ~u); }
__device__ __forceinline__ unsigned pack_key7(float f, int idx) { return (mono_u32(f) & 0xFFFFFF80u) | (unsigned)(127 - idx); }
__device__ __forceinline__ float unpack_key7(unsigned k) { return demono_u32((k & 0xFFFFFF80u) | 0x40u); }
__device__ __forceinline__ float unpack_key8(unsigned k) { return demono_u32((k & 0xFFFFFF00u) | 0x80u); }
__device__ __forceinline__ void ce_desc(unsigned& a, unsigned& b) { const unsigned hi = a > b ? a : b, lo = a > b ? b : a; a = hi; b = lo; }
__device__ __forceinline__ void sort16_desc(unsigned* v) {
#pragma unroll
    for (int k = 2; k <= 16; k <<= 1)
#pragma unroll
        for (int j = k >> 1; j > 0; j >>= 1)
#pragma unroll
            for (int i = 0; i < 16; ++i) { const int l = i ^ j; if (l > i) { if ((i & k) == 0) ce_desc(v[i], v[l]); else ce_desc(v[l], v[i]); } }
}
__device__ __forceinline__ void bmerge16_desc(unsigned* v) {
#pragma unroll
    for (int j = 8; j > 0; j >>= 1)
#pragma unroll
        for (int i = 0; i < 16; ++i) { const int l = i ^ j; if (l > i) ce_desc(v[i], v[l]); }
}
__device__ __forceinline__ void merge_top16(unsigned* a, const unsigned* b) {
#pragma unroll
    for (int i = 0; i < 16; ++i) { const unsigned o = b[15 - i]; a[i] = a[i] > o ? a[i] : o; }
    bmerge16_desc(a);
}
__device__ __forceinline__ void stage2_cands(const unsigned* s0, const unsigned* s1, int hh, unsigned* c) {
    float A[16], B[16];
#pragma unroll
    for (int i = 0; i < 16; ++i) { const float f0 = unpack_key7(s0[i]), f1 = unpack_key7(s1[i]); A[i] = hh ? f1 : f0; B[i] = hh ? f0 : f1; }
    int n = 0;
#pragma unroll
    for (int i = 0; i < 4; ++i)
#pragma unroll
        for (int j = i; j < 16; ++j) { if ((i + 1) * (j + 1) > 16) continue;
            const float val = A[i] + B[j]; const unsigned id = hh ? (unsigned)((j << 4) | i) : (unsigned)((i << 4) | j);
            unsigned key = (mono_u32(val) & 0xFFFFFF00u) | id; if (hh && i == j) key = 0u; c[n++] = key; }
#pragma unroll
    for (; n < 32; ++n) c[n] = 0u;
}

typedef short bf16x8_t __attribute__((ext_vector_type(8)));
typedef float f32x16 __attribute__((ext_vector_type(16)));
__device__ __forceinline__ float gelu_erf(float a) { return 0.5f * a * (1.f + erff(a * 0.70710678118654752f)); }


typedef __attribute__((address_space(3))) bf16 lbf16;

__device__ __forceinline__ f32x16 mm32(bf16x8_t a, bf16x8_t b, f32x16 c) { return __builtin_amdgcn_mfma_f32_32x32x16_bf16(a, b, c, 0, 0, 0); }
__device__ __forceinline__ bf16x8_t frag_from_u32x4(unsigned x, unsigned y, unsigned z, unsigned w) { typedef unsigned u4 __attribute__((ext_vector_type(4))); u4 t = {x, y, z, w}; return __builtin_bit_cast(bf16x8_t, t); }
template <int S> __device__ __forceinline__ bf16x8_t accop(const f32x16& z) {
    return frag_from_u32x4(cvtpk(z[8 * S], z[8 * S + 1]), cvtpk(z[8 * S + 2], z[8 * S + 3]), cvtpk(z[8 * S + 4], z[8 * S + 5]), cvtpk(z[8 * S + 6], z[8 * S + 7])); }
template <int S> __device__ __forceinline__ bf16x8_t ldpermcol(const lbf16* a, int col, int hh) {
    const lbf16* p = a + (16 * S + 4 * hh) * 72 + col;
    const unsigned e0 = p[0], e1 = p[72], e2 = p[144], e3 = p[216], e4 = p[8 * 72], e5 = p[9 * 72], e6 = p[10 * 72], e7 = p[11 * 72];
    return frag_from_u32x4(e0 | (e1 << 16), e2 | (e3 << 16), e4 | (e5 << 16), e6 | (e7 << 16)); }
__device__ __forceinline__ bf16x8_t ldrow(const lbf16* a, int row, int ks, int hh) { return *(const __attribute__((address_space(3))) bf16x8_t*)(a + row * 72 + ks * 16 + 8 * hh); }
__device__ __forceinline__ int rowidx(int e, int hh) { return (e & 3) + 8 * (e >> 2) + 4 * hh; }

constexpr int ROWB = 768;
__device__ __forceinline__ unsigned fp6code(float x, float sc) {
    const float t = fabsf(x) * sc;
    const float r = t < 16.f ? __builtin_rintf(t) : (t < 32.f ? 8.f + __builtin_rintf(t * 0.5f) : 16.f + __builtin_rintf(t * 0.25f));
    unsigned c = (unsigned)r; c = c > 31u ? 31u : c;
    return c | (x < 0.f ? 32u : 0u);
}
__device__ __forceinline__ void convert_tables_fp6(const float* pu, const float* pv, unsigned char* u8, unsigned char* v8, float* usc, float* vsc, int l, int wv, int nw, int lane) {
    for (int rr0 = wv * 2; rr0 < 2 * NEXP; rr0 += nw * 2) {
        f32x4 v[2][4]; float m[2];
#pragma unroll
        for (int rr = 0; rr < 2; ++rr) { const int q = rr0 + rr; const size_t row = (size_t)l * NEXP + (q < NEXP ? q : q - NEXP); const float* sp_ = (q < NEXP ? pu : pv) + row * D + lane * 16;
#pragma unroll
            for (int k = 0; k < 4; ++k) v[rr][k] = *(const f32x4*)(sp_ + k * 4); }
#pragma unroll
        for (int rr = 0; rr < 2; ++rr) { float mm = 0.f;
#pragma unroll
            for (int k = 0; k < 4; ++k) mm = fmaxf(fmaxf(mm, fmaxf(fabsf(v[rr][k].x), fabsf(v[rr][k].y))), fmaxf(fabsf(v[rr][k].z), fabsf(v[rr][k].w)));
#pragma unroll
            for (int o = 1; o < 64; o <<= 1) mm = fmaxf(mm, shflx(mm, lane, o));
            m[rr] = mm; }
#pragma unroll
        for (int rr = 0; rr < 2; ++rr) { const int q = rr0 + rr; const size_t row = (size_t)l * NEXP + (q < NEXP ? q : q - NEXP); const float sc = m[rr] > 0.f ? 60.f / m[rr] : 1.f;
            unsigned c[16];
#pragma unroll
            for (int k = 0; k < 4; ++k) { c[k * 4] = fp6code(v[rr][k].x, sc); c[k * 4 + 1] = fp6code(v[rr][k].y, sc); c[k * 4 + 2] = fp6code(v[rr][k].z, sc); c[k * 4 + 3] = fp6code(v[rr][k].w, sc); }
            const unsigned o0 = c[0] | (c[1] << 6) | (c[2] << 12) | (c[3] << 18) | (c[4] << 24) | (c[5] << 30);
            const unsigned o1 = (c[5] >> 2) | (c[6] << 4) | (c[7] << 10) | (c[8] << 16) | (c[9] << 22) | (c[10] << 28);
            const unsigned o2 = (c[10] >> 4) | (c[11] << 2) | (c[12] << 8) | (c[13] << 14) | (c[14] << 20) | (c[15] << 26);
            unsigned* op = (unsigned*)((q < NEXP ? u8 : v8) + row * ROWB + lane * 12);
            op[0] = o0; op[1] = o1; op[2] = o2;
            if (lane == 0) (q < NEXP ? usc : vsc)[row] = m[rr] > 0.f ? m[rr] * (1.f / 7.5f) : 1.f; }
    }
}

__global__ void __launch_bounds__(NTHR, 2) mega(Args args) {
    extern __shared__ __attribute__((aligned(16))) unsigned char lds_raw[];
    LAS unsigned char* lds = (LAS unsigned char*)lds_raw;
    const int G = gridDim.x, bx = blockIdx.x, NGW = G * NWAVES;
    const int wave0 = __builtin_amdgcn_readfirstlane((int)threadIdx.x >> 6);
    typedef const unsigned char __attribute__((address_space(4))) kbyte;
#define PHASE_IDS int tid; asm volatile("v_mbcnt_lo_u32_b32 %0, -1, 0\n\tv_mbcnt_hi_u32_b32 %0, -1, %0" : "=v"(tid)); tid += wave0 * 64;     const int lane = tid & 63, wave = __builtin_amdgcn_readfirstlane(tid >> 6), gw = bx * NWAVES + wave; (void)lane; (void)gw; \
    kbyte* kp = (kbyte*)__builtin_amdgcn_kernarg_segment_ptr(); asm volatile("" : "+s"(kp)); \
    unsigned char* const ws = (unsigned char*)*(__attribute__((address_space(1))) unsigned char* const __attribute__((address_space(4)))*)(kp + 31 * 8); float* const X = (float*)*(__attribute__((address_space(1))) float* const __attribute__((address_space(4)))*)(kp + 30 * 8); (void)ws; (void)X;
#define INP(i) ((const float*)(*(const __attribute__((address_space(1))) float* const __attribute__((address_space(4)))*)(kp + (i) * 8)))
#define MOD ((float*)(ws + WS_MOD))
#define H ((bf16*)(ws + WS_H))
#define PROJ ((bf16*)(ws + WS_PROJ))
#define Q ((bf16*)(ws + WS_Q))
#define MIX ((bf16*)(ws + WS_MIX))
#define Rb ((bf16*)(ws + WS_R))
#define Kb ((bf16*)(ws + WS_K))
#define V0 ((bf16*)(ws + WS_V0))
#define V1 ((bf16*)(ws + WS_V1))
#define KKb ((bf16*)(ws + WS_KK))
#define Bb ((bf16*)(ws + WS_B))
#define Gb ((bf16*)(ws + WS_G))
#define BGb ((bf16*)(ws + WS_BG))
#define Wd ((float*)(ws + WS_W))
#define Y ((float*)(ws + WS_Y))
#define QB ((float*)(ws + WS_QB))
#define POOLIN ((bf16*)(ws + WS_QB))
#define SH ((float*)(ws + WS_SH))
#define SSQ ((unsigned long long*)(ws + WS_SH))
#define CVEC ((float*)(ws + WS_SH + 512 * 1024))
#define S2V ((float*)(ws + WS_SH + 640 * 1024))
#define XB2 ((bf16*)(ws + WS_R))
#define WUPT ((bf16*)(ws + WS_LORA))
#define AUPT ((bf16*)(ws + WS_LORA + 131072))
#define GUPT ((bf16*)(ws + WS_LORA + 262144))
#define VUPT ((bf16*)(ws + WS_LORA + 524288))
#define PWT ((bf16*)(ws + WS_LORA + 655360))
#define INVN ((float*)(ws + WS_INVN))
#define BSUM ((float*)(ws + WS_BSUM))
#define SCN ((unsigned char*)(ws + WS_SCN))
#define IDX ((int*)(ws + WS_IDX))
#define GATE ((float*)(ws + WS_GATE))
#define WinT ((bf16*)(ws + WS_WIN_T))
#define WoutT ((bf16*)(ws + WS_WOUT_T))
#define PqT ((bf16*)(ws + WS_PQ_T))
#define KEYS ((bf16*)(ws + WS_KEYS))
#define U8 ((unsigned char*)(ws + WS_U))
#define V8 ((unsigned char*)(ws + WS_V))
#define USc ((float*)(ws + WS_US))
#define VSc ((float*)(ws + WS_VS))
    const int lo = args.ph_lo, hi = args.ph_hi;
    { volatile LAS unsigned* misc = (volatile LAS unsigned*)(lds + LDS_BYTES - 64); if (threadIdx.x < 4) misc[threadIdx.x] = 0u; __syncthreads(); }
    const XcdBarrier xbar = xcd_barrier_post((unsigned*)(args.ws) + 4096, (volatile LAS unsigned*)(lds + LDS_BYTES - 64));
#define IN(k) (lo <= (k) && (k) < hi)
#ifndef REP_PHASE
#define REP_PHASE (-1)
#endif
#define REPS(k) ((k) == REP_PHASE ? 3 : 1)
#define SEAM(k) do { if (IN(k) && IN((k) + 1)) { if ((k) == 0) cg::this_grid().sync(); else { XcdBarrier xb_ = xbar; asm volatile("" : "+s"(xb_.bar)); if ((k) == 1) xcd_barrier<true>(xb_); else xcd_barrier<false>(xb_); } } } while (0)

    if (IN(0)) { PHASE_IDS
        { unsigned long long* z = SSQ; for (int i = bx * NTHR + tid; i < 2 * T; i += G * NTHR) z[i] = 0ull; }
        { LAS float* ca = (LAS float*)lds; LAS float* red = (LAS float*)(lds + 16384);
          const float* c = INP(1); const float* ada_w = INP(2); const float* ada_b = INP(3);
          bool have = false;
          for (int it = bx; it < 96; it += G) {
              if (!have) { for (int i = tid; i < BATCH * D; i += NTHR) { const float v = c[i]; ca[i] = v / (1.f + expf(-v)); } have = true; __syncthreads(); }
              const int l = it / 48, n = (it % 48) * 128 + (tid & 127), kq = tid >> 7;
              const float* w = ada_w + (size_t)l * D * 6 * D + (size_t)(kq * 256) * 6 * D + n;
              float a0 = 0.f, a1 = 0.f, a2 = 0.f, a3 = 0.f;
#pragma unroll 32
              for (int k = 0; k < 256; ++k) { const float wv = w[(size_t)k * 6 * D]; const int kk = kq * 256 + k; a0 += ca[kk] * wv; a1 += ca[D + kk] * wv; a2 += ca[2 * D + kk] * wv; a3 += ca[3 * D + kk] * wv; }
              red[(kq * 4 + 0) * 128 + (tid & 127)] = a0; red[(kq * 4 + 1) * 128 + (tid & 127)] = a1; red[(kq * 4 + 2) * 128 + (tid & 127)] = a2; red[(kq * 4 + 3) * 128 + (tid & 127)] = a3;
              __syncthreads();
              { const int b = tid >> 7, col = tid & 127, nn = (it % 48) * 128 + col;
                const float s = red[(0 * 4 + b) * 128 + col] + red[(1 * 4 + b) * 128 + col] + red[(2 * 4 + b) * 128 + col] + red[(3 * 4 + b) * 128 + col];
                MOD[(size_t)l * BATCH * 6 * D + (size_t)b * 6 * D + nn] = s + ada_b[l * 6 * D + nn]; }
              __syncthreads();
          }
          __syncthreads(); }
        { LAS float* scr = (LAS float*)(lds + wave * 16384);
          constexpr int I_IN = (D / 64) * (IN_COLS / 32), I_VR = (D / 64) * (MVL / 32), I_OUT = (D / 64) * (D / 32), I_PQ = (D / 64) * (PH * PQ / 32);
          constexpr int NIT = 2 * I_IN + I_VR + 2 * I_OUT + 2 * I_PQ;
          for (int it = gw; it < NIT; it += NGW) { int r = it;
              if (r < 2 * I_IN) { const int l = r / I_IN; p0_transpose_item(INP(5) + (size_t)l * D * IN_COLS, D, IN_COLS, WinT + (size_t)l * LDP * D, 0, scr, r % I_IN, lane); continue; } r -= 2 * I_IN;
              if (r < I_VR) { p0_transpose_item(INP(12), D, MVL, WinT + (size_t)1 * LDP * D, IN_COLS, scr, r, lane); continue; } r -= I_VR;
              if (r < 2 * I_OUT) { const int l = r / I_OUT; p0_transpose_item(INP(23) + (size_t)l * D * D, D, D, WoutT + (size_t)l * D * D, 0, scr, r % I_OUT, lane); continue; } r -= 2 * I_OUT;
              { const int l = r / I_PQ; p0_transpose_item(INP(25) + (size_t)l * D * PH * PQ, D, PH * PQ, PqT + (size_t)l * PH * PQ * D, 0, scr, r % I_PQ, lane); } }
          for (int it = gw; it < 2 * 16 + 2 * 16 + 2 * 32; it += NGW) { int r = it;
              if (r < 32) { const int l = r / 16; p0_transpose_item(INP(8) + (size_t)l * DL * RW, DL, RW, WUPT + (size_t)l * RW * DL, 0, scr, r % 16, lane); continue; } r -= 32;
              if (r < 32) { const int l = r / 16; p0_transpose_item(INP(10) + (size_t)l * AL * RW, AL, RW, AUPT + (size_t)l * RW * AL, 0, scr, r % 16, lane); continue; } r -= 32;
              { const int l = r / 32; p0_transpose_item(INP(11) + (size_t)l * GL * RW, GL, RW, GUPT + (size_t)l * RW * GL, 0, scr, r % 32, lane); } }
          { const float* vu = INP(15); for (int e = bx * NTHR + tid; e < MVL * RW; e += G * NTHR) { const int n = e >> 5, k = e & 31; VUPT[e] = f2bf(vu[k * RW + n]); } }
          for (int it = gw; it < 8 * 8; it += NGW) p0_transpose_item(INP(21) + (size_t)(it >> 3) * PG * PG, PG, PG, PWT + (size_t)(it >> 3) * PG * PG, 0, scr, it & 7, lane);
        }
        { const size_t gt = (size_t)bx * NTHR + tid, NT = (size_t)G * NTHR;
          constexpr size_t NK8 = (size_t)2 * PH * 2 * NKEYS * PHALF / 8;
          const float* src = INP(26); bf16* dst = KEYS;
          for (size_t i = gt; i < NK8; i += NT) {
              const f32x4 a = *(const f32x4*)(src + i * 8), b = *(const f32x4*)(src + i * 8 + 4);
              u32x4 o; o.x = pk2(a.x, a.y); o.y = pk2(a.z, a.w); o.z = pk2(b.x, b.y); o.w = pk2(b.z, b.w); *(u32x4*)(dst + i * 8) = o; }
        }
    }
    SEAM(0);

#pragma unroll
    for (int l = 0; l < DEPTH; ++l) {
        const int pb = 1 + 10 * l;
#define modl (MOD + (size_t)l * BATCH * 6 * D)
#define xin (l == 0 ? INP(0) : (const float*)X)
        if (l == 0 && IN(pb + 0)) { PHASE_IDS const float* gamma = INP(4) + l * D;
            for (int row = gw; row < T; row += NGW) { const int b = row / SEQ; norm_mod_row(xin + (size_t)row * D, gamma, modl + (size_t)b * 6 * D, modl + (size_t)b * 6 * D + D, H + (size_t)row * D, lane); } }
        SEAM(pb + 0);
        if (IN(pb + 1)) { PHASE_IDS const int N1 = l == 0 ? IN_COLS : LDP;
            pg8::Gemm g{H, WinT + (size_t)l * LDP * D, T, N1, D}; pg8::StaticOrder S; S.init(T, N1, G, bx);
            pg8::EpiProj E{PROJ, LDP, POOLIN, RWKV_COLS, PW};
            pg8::gemm_phase<pg8::EpiProj, pg8::StaticOrder, true, true>(lds, g, S, E, tid); }
        SEAM(pb + 1);

        if (IN(pb + 2)) { PHASE_IDS
            constexpr int LST = 296;
            LAS bf16* lin = (LAS bf16*)lds;
            const float* mu = INP(6) + l * RWKV_COLS; const float* vmu = INP(13);
            const float* w0p = INP(7) + l * RW; const float* a0p = INP(9) + l * RW; const float* kkp = INP(16) + l * RW; const float* kap = INP(17) + l * RW; const float* rkp = INP(18) + l * RW; const float* v0p = INP(14);
            const bf16* wupT = WUPT + (size_t)l * RW * DL; const bf16* aupT = AUPT + (size_t)l * RW * AL; const bf16* gupT = GUPT + (size_t)l * RW * GL; const bf16* vupT = VUPT;
            bf16* Vl = l == 0 ? V0 : V1;
            const int r32 = lane & 31, hh = lane >> 5, h = wave;
            for (int tile = bx; tile < T / 32; tile += G) {
                const int t0 = tile * 32;
                __syncthreads();
#pragma unroll 1
                for (int it0 = 0; it0 < 3; it0 += 2) {
                  u32x4 cu_[2], pv_[2]; f32x4 m0_[2], m1_[2];
#pragma unroll
                  for (int it = 0; it < 2; ++it) { const int c8 = tid + (it0 + it) * NTHR; const bool ok = c8 < 32 * 36; const int tok = ok ? c8 / 36 : 0, jc = ok ? c8 % 36 : 0, t = t0 + tok, sq = t % SEQ;
                      cu_[it] = (u32x4){0u, 0u, 0u, 0u}; pv_[it] = (u32x4){0u, 0u, 0u, 0u}; m0_[it] = (f32x4){0.f, 0.f, 0.f, 0.f}; m1_[it] = m0_[it];
                      if (ok && (jc < 32 || l > 0)) { const int col = jc < 32 ? 3 * RW + jc * 8 : IN_COLS + (jc - 32) * 8;
                          cu_[it] = *(const u32x4*)(PROJ + (size_t)t * LDP + col); if (sq > 0) pv_[it] = *(const u32x4*)(PROJ + (size_t)(t - 1) * LDP + col);
                          const float* mp = jc < 32 ? mu + col : vmu + (jc - 32) * 8; m0_[it] = *(const f32x4*)mp; m1_[it] = *(const f32x4*)(mp + 4); } }
#pragma unroll
                  for (int it = 0; it < 2; ++it) { const int c8 = tid + (it0 + it) * NTHR; if (c8 < 32 * 36) { const int tok = c8 / 36, jc = c8 % 36;
                      u32x4 o = {0u, 0u, 0u, 0u};
                      if (jc < 32 || l > 0) {
                          float x[8]; const unsigned cw[4] = {cu_[it].x, cu_[it].y, cu_[it].z, cu_[it].w}, pw[4] = {pv_[it].x, pv_[it].y, pv_[it].z, pv_[it].w}; const float mm[8] = {m0_[it].x, m0_[it].y, m0_[it].z, m0_[it].w, m1_[it].x, m1_[it].y, m1_[it].z, m1_[it].w};
#pragma unroll
                          for (int i = 0; i < 4; ++i) { const float c0 = __uint_as_float(cw[i] << 16), c1 = __uint_as_float(cw[i] & 0xffff0000u), p0 = __uint_as_float(pw[i] << 16), p1 = __uint_as_float(pw[i] & 0xffff0000u);
                              x[2 * i] = c0 + (p0 - c0) * mm[2 * i]; x[2 * i + 1] = c1 + (p1 - c1) * mm[2 * i + 1]; }
                          if (jc < 8) {
#pragma unroll
                              for (int i = 0; i < 8; ++i) { const float e2 = __expf(-2.f * fabsf(x[i])); const float th = (1.f - e2) * __builtin_amdgcn_rcpf(1.f + e2); x[i] = x[i] < 0.f ? -th : th; } }
                          else if (jc >= 16 && jc < 32) {
#pragma unroll
                              for (int i = 0; i < 8; ++i) x[i] = __builtin_amdgcn_rcpf(1.f + __expf(-x[i])); }
                          o.x = pk2(x[0], x[1]); o.y = pk2(x[2], x[3]); o.z = pk2(x[4], x[5]); o.w = pk2(x[6], x[7]);
                      }
                      *(LAS u32x4*)(lin + tok * LST + jc * 8) = o; } } }
                __syncthreads();
                const bool first = (t0 % SEQ) == 0;
                lbf16* tin = (lbf16*)(lds + 19456 + wave * 14336);
                { u32x4 iq[13]; int ql_; asm volatile("v_mbcnt_lo_u32_b32 %0, -1, 0\n\tv_mbcnt_hi_u32_b32 %0, -1, %0" : "=v"(ql_));
#pragma unroll
                  for (int i = 0; i < 13; ++i) { const int q = ql_ + 64 * i; iq[i] = (u32x4){0u, 0u, 0u, 0u};
                      if (q < 792) { const int arr = q / 264, rem = q - arr * 264, row = rem >> 3, cc = rem & 7;
                          if (!(first && row == 0)) iq[i] = *(const u32x4*)(PROJ + (size_t)(t0 - 1 + row) * LDP + arr * RW + h * HS + cc * 8); } }
#pragma unroll
                  for (int i = 0; i < 13; ++i) { const int q = ql_ + 64 * i; if (q < 792) { const int arr = q / 264, rem = q - arr * 264, row = rem >> 3, cc = rem & 7;
                      *(__attribute__((address_space(3))) u32x4*)(tin + arr * 2376 + row * 72 + cc * 8) = iq[i]; } } }
                __builtin_amdgcn_wave_barrier(); asm volatile("s_waitcnt lgkmcnt(0)" ::: "memory");
                float ssq[16], bsm[16];
#pragma unroll
                for (int e = 0; e < 16; ++e) { ssq[e] = 0.f; bsm[e] = 0.f; }
#pragma unroll 1
                for (int rt = 0; rt < 2; ++rt) {
                    f32x16 accW, accA, accG, accV;
#pragma unroll
                    for (int e = 0; e < 16; ++e) { accW[e] = 0.f; accA[e] = 0.f; accG[e] = 0.f; accV[e] = 0.f; }
                    int c = h * HS + rt * 32 + r32;
int hh8 = 8 * hh; asm volatile("" : "+v"(c), "+v"(hh8));
                    const LAS bf16* lrow = lin + r32 * LST + 8 * hh;
                    { bf16x8_t wf[18];
#pragma unroll
                      for (int ks = 0; ks < 4; ++ks) { wf[ks] = *(const bf16x8_t*)(wupT + (size_t)c * DL + ks * 16 + hh8); wf[4 + ks] = *(const bf16x8_t*)(aupT + (size_t)c * AL + ks * 16 + hh8); }
#pragma unroll
                      for (int ks = 0; ks < 8; ++ks) wf[8 + ks] = *(const bf16x8_t*)(gupT + (size_t)c * GL + ks * 16 + hh8);
                      wf[16] = bf16x8_t{}; wf[17] = bf16x8_t{};
                      if (l > 0) { wf[16] = *(const bf16x8_t*)(vupT + (size_t)c * MVL + hh8); wf[17] = *(const bf16x8_t*)(vupT + (size_t)c * MVL + 16 + hh8); }
#pragma unroll
                      for (int ks = 0; ks < 4; ++ks) { accW = __builtin_amdgcn_mfma_f32_32x32x16_bf16(*(const LAS bf16x8_t*)(lrow + ks * 16), wf[ks], accW, 0, 0, 0);
                                                       accA = __builtin_amdgcn_mfma_f32_32x32x16_bf16(*(const LAS bf16x8_t*)(lrow + 64 + ks * 16), wf[4 + ks], accA, 0, 0, 0); }
#pragma unroll
                      for (int ks = 0; ks < 8; ++ks) accG = __builtin_amdgcn_mfma_f32_32x32x16_bf16(*(const LAS bf16x8_t*)(lrow + 128 + ks * 16), wf[8 + ks], accG, 0, 0, 0);
                      if (l > 0) {
#pragma unroll
                          for (int ks = 0; ks < 2; ++ks) accV = __builtin_amdgcn_mfma_f32_32x32x16_bf16(*(const LAS bf16x8_t*)(lrow + 256 + ks * 16), wf[16 + ks], accV, 0, 0, 0); } }
                    const float mur = mu[c], muk = mu[RW + c], muv = mu[2 * RW + c], w0c = w0p[c], a0c = a0p[c], kkc = kkp[c], kac = kap[c], rkc = rkp[c];
                    const float v0c = l > 0 ? v0p[c] : 0.f;
#pragma unroll
                    for (int eb = 0; eb < 16; eb += 4) {
                        bf16 lr[4], lk[4], lv[4], lrp[4], lkp[4], lvp[4], lvf[4];
#pragma unroll
                        for (int i = 0; i < 4; ++i) { const int e = eb + i; const int tok = (e & 3) + 8 * (e >> 2) + 4 * hh, t = t0 + tok; const int ci = rt * 32 + r32;
                            lr[i] = tin[(tok + 1) * 72 + ci]; lk[i] = tin[2376 + (tok + 1) * 72 + ci]; lv[i] = tin[2 * 2376 + (tok + 1) * 72 + ci];
                            lrp[i] = tin[tok * 72 + ci]; lkp[i] = tin[2376 + tok * 72 + ci]; lvp[i] = tin[2 * 2376 + tok * 72 + ci];
                            lvf[i] = l > 0 ? V0[(size_t)t * RW + c] : (bf16)0; }
                        __builtin_amdgcn_sched_barrier(0);
#pragma unroll
                        for (int i = 0; i < 4; ++i) { const int e = eb + i; const int tok = (e & 3) + 8 * (e >> 2) + 4 * hh, t = t0 + tok; const size_t o = (size_t)t * RW + c;
                            float r = bf2f(lr[i]), k = bf2f(lk[i]), v = bf2f(lv[i]);
                            r += (bf2f(lrp[i]) - r) * mur; k += (bf2f(lkp[i]) - k) * muk; v += (bf2f(lvp[i]) - v) * muv;
                            const float z = -(w0c + accW[e]); const float sp = fmaxf(z, 0.f) + __logf(1.f + __expf(-fabsf(z)));
                            const float decay = __expf(-__expf(-sp - 0.5f));
                            const float a = __builtin_amdgcn_rcpf(1.f + __expf(-(a0c + accA[e]))); const float g = accG[e];
                            if (l > 0) { const float vfv = bf2f(lvf[i]); v = v + (vfv - v) * __builtin_amdgcn_rcpf(1.f + __expf(-(v0c + accV[e]))); }
                            const float kk = k * kkc; const float k2 = k * (1.f + (a - 1.f) * kac);
                            ssq[e] += kk * kk; bsm[e] += r * k2 * rkc;
                            { const unsigned p0_ = cvtpk(r, k2), p1_ = cvtpk(v, kk), p2_ = cvtpk(kk * a, g), p3_ = cvtpk(v * g, 0.f);
                              Rb[o] = (bf16)p0_; Kb[o] = (bf16)(p0_ >> 16); Vl[o] = (bf16)p1_; KKb[o] = (bf16)(p1_ >> 16); Bb[o] = (bf16)p2_; Gb[o] = (bf16)(p2_ >> 16); BGb[o] = (bf16)p3_; Wd[o] = decay; }
                        }
                    }
                }
#pragma unroll
                for (int e = 0; e < 16; ++e) { const int ln_ = r32 | (hh << 5); float a_ = red16(ssq[e]), b_ = red16(bsm[e]); a_ += shflx(a_, ln_, 16); b_ += shflx(b_, ln_, 16); ssq[e] = a_; bsm[e] = b_; }
                if (r32 == 0) {
#pragma unroll
                    for (int e = 0; e < 16; ++e) { const int tok = (e & 3) + 8 * (e >> 2) + 4 * hh; INVN[(size_t)(t0 + tok) * NH + h] = rsqrtf(fmaxf(ssq[e], 1e-24f)); BSUM[(size_t)(t0 + tok) * NH + h] = bsm[e]; } }
            }
        }
        if (IN(pb + 2) && IN(pb + 3)) { asm volatile("s_waitcnt vmcnt(0)" ::: "memory"); __syncthreads(); }

        if (IN(pb + 3)) { PHASE_IDS
            const bf16* Vl = l == 0 ? V0 : V1;
            const int r32 = lane & 31, hh = lane >> 5;
            if (wave < 6) {
                lbf16* At = (lbf16*)(lds + wave * 23552); lbf16* Bt = At + 2304; lbf16* Kt = Bt + 2304; lbf16* Rt = Kt + 2304; lbf16* Vv = Rt + 2304;
                LAS float* PCs = (LAS float*)(lds + wave * 23552 + 23040);
                const int ntl = bx < T / 32 ? (T / 32 - bx + G - 1) / G : 0;
                for (int q = wave; q < ntl * NH; q += 6) {
                    const int tile = bx + (q >> 3) * G, h = q & 7, b = tile >> 7, chunk = tile & 127, bh = b * NH + h, item = bh * (SEQ / 32) + chunk; const size_t t0 = (size_t)tile * 32;
                    __builtin_amdgcn_wave_barrier(); asm volatile("s_waitcnt lgkmcnt(0)" ::: "memory");
                    {
                      const int tk = lane >> 3, part = lane & 7;
                      u32x4 qr[4], qk[4], qv[4], qkk[4], qb[4]; f32x4 qw0[4], qw1[4]; float qin[4];
#pragma unroll
                      for (int p4 = 0; p4 < 4; ++p4) { const size_t o = (t0 + p4 * 8 + tk) * RW + h * HS + part * 8;
                          qr[p4] = *(const u32x4*)(Rb + o); qk[p4] = *(const u32x4*)(Kb + o); qv[p4] = *(const u32x4*)(Vl + o); qkk[p4] = *(const u32x4*)(KKb + o); qb[p4] = *(const u32x4*)(Bb + o);
                          qw0[p4] = *(const f32x4*)(Wd + o); qw1[p4] = *(const f32x4*)(Wd + o + 4); qin[p4] = INVN[(t0 + p4 * 8 + tk) * NH + h]; }
                      LAS float* Pl = (LAS float*)At;
#pragma unroll
                      for (int p4 = 0; p4 < 4; ++p4) { *(LAS f32x4*)(Pl + (p4 * 8 + tk) * 64 + part * 8) = qw0[p4]; *(LAS f32x4*)(Pl + (p4 * 8 + tk) * 64 + part * 8 + 4) = qw1[p4]; }
                      __builtin_amdgcn_wave_barrier(); asm volatile("s_waitcnt lgkmcnt(0)" ::: "memory");
                      { float P = 1.f;
#pragma unroll 8
                        for (int c = 0; c < 32; ++c) { P *= Pl[c * 64 + lane]; Pl[c * 64 + lane] = P; }
                        PCs[lane] = P; }
                      __builtin_amdgcn_wave_barrier(); asm volatile("s_waitcnt lgkmcnt(0)" ::: "memory");
                      u32x4 oa[4], orr[4], ob_[4], ok_[4];
#pragma unroll
                      for (int p4 = 0; p4 < 4; ++p4) { const int c = p4 * 8 + tk;
                          const f32x4 pa = *(const LAS f32x4*)(Pl + c * 64 + part * 8), pb2 = *(const LAS f32x4*)(Pl + c * 64 + part * 8 + 4);
                          f32x4 ma = {1.f, 1.f, 1.f, 1.f}, mb = ma; if (c > 0) { ma = *(const LAS f32x4*)(Pl + (c - 1) * 64 + part * 8); mb = *(const LAS f32x4*)(Pl + (c - 1) * 64 + part * 8 + 4); }
                          const float Pc[8] = {pa.x, pa.y, pa.z, pa.w, pb2.x, pb2.y, pb2.z, pb2.w}, Pm[8] = {ma.x, ma.y, ma.z, ma.w, mb.x, mb.y, mb.z, mb.w};
                          const unsigned rw_[4] = {qr[p4].x, qr[p4].y, qr[p4].z, qr[p4].w}, kw_[4] = {qk[p4].x, qk[p4].y, qk[p4].z, qk[p4].w}, kkw[4] = {qkk[p4].x, qkk[p4].y, qkk[p4].z, qkk[p4].w}, bw_[4] = {qb[p4].x, qb[p4].y, qb[p4].z, qb[p4].w};
                          unsigned xa[4], xr[4], xb[4], xk[4]; const float inv = qin[p4];
#pragma unroll
                          for (int i = 0; i < 4; ++i) { const float ip0 = __builtin_amdgcn_rcpf(Pc[2 * i]), ip1 = __builtin_amdgcn_rcpf(Pc[2 * i + 1]);
                              xa[i] = pk2(-__uint_as_float(kkw[i] << 16) * inv * Pm[2 * i], -__uint_as_float(kkw[i] & 0xffff0000u) * inv * Pm[2 * i + 1]);
                              xr[i] = pk2(__uint_as_float(rw_[i] << 16) * Pc[2 * i], __uint_as_float(rw_[i] & 0xffff0000u) * Pc[2 * i + 1]);
                              xb[i] = pk2(__uint_as_float(bw_[i] << 16) * inv * ip0, __uint_as_float(bw_[i] & 0xffff0000u) * inv * ip1);
                              xk[i] = pk2(__uint_as_float(kw_[i] << 16) * ip0, __uint_as_float(kw_[i] & 0xffff0000u) * ip1); }
                          oa[p4] = (u32x4){xa[0], xa[1], xa[2], xa[3]}; orr[p4] = (u32x4){xr[0], xr[1], xr[2], xr[3]}; ob_[p4] = (u32x4){xb[0], xb[1], xb[2], xb[3]}; ok_[p4] = (u32x4){xk[0], xk[1], xk[2], xk[3]}; }
                      __builtin_amdgcn_wave_barrier(); asm volatile("s_waitcnt lgkmcnt(0)" ::: "memory");
#pragma unroll
                      for (int p4 = 0; p4 < 4; ++p4) { const int c = p4 * 8 + tk, o = c * 72 + part * 8;
                          *(__attribute__((address_space(3))) u32x4*)(At + o) = oa[p4]; *(__attribute__((address_space(3))) u32x4*)(Rt + o) = orr[p4]; *(__attribute__((address_space(3))) u32x4*)(Bt + o) = ob_[p4];
                          *(__attribute__((address_space(3))) u32x4*)(Kt + o) = ok_[p4]; *(__attribute__((address_space(3))) u32x4*)(Vv + o) = qv[p4]; } }
                    __builtin_amdgcn_wave_barrier(); asm volatile("s_waitcnt lgkmcnt(0)" ::: "memory");
                    const f32x16 zero16 = {0.f, 0.f, 0.f, 0.f, 0.f, 0.f, 0.f, 0.f, 0.f, 0.f, 0.f, 0.f, 0.f, 0.f, 0.f, 0.f};
                    f32x16 X = zero16, Yt = zero16;
#pragma unroll
                    for (int ks = 0; ks < 4; ++ks) { const bf16x8_t fa = ldrow(At, r32, ks, hh), fb = ldrow(Bt, r32, ks, hh); X = mm32(fa, fb, X); Yt = mm32(fb, fa, Yt); }
#pragma unroll
                    for (int e = 0; e < 16; ++e) { const int ri = rowidx(e, hh); X[e] = (r32 < ri) ? X[e] : 0.f; Yt[e] = (ri < r32) ? Yt[e] : 0.f; }
                    f32x16 TY = Yt;
#pragma unroll
                    for (int e = 0; e < 16; ++e) TY[e] += (rowidx(e, hh) == r32) ? 1.f : 0.f;
#pragma unroll 1
                    for (int it = 0; it < 4; ++it) {
                        const bf16x8_t x0 = accop<0>(X), x1 = accop<1>(X), y0 = accop<0>(Yt), y1 = accop<1>(Yt);
                        f32x16 Xn = mm32(y0, x0, zero16); Xn = mm32(y1, x1, Xn);
                        f32x16 Yn = mm32(x0, y0, zero16); Yn = mm32(x1, y1, Yn);
                        X = Xn; Yt = Yn;
                        const bf16x8_t p0 = accop<0>(X), p1 = accop<1>(X), t0_ = accop<0>(TY), t1_ = accop<1>(TY);
                        TY = mm32(p0, t0_, TY); TY = mm32(p1, t1_, TY);
                    }
                    const bf16x8_t ty0 = accop<0>(TY), ty1 = accop<1>(TY);
                    unsigned char* rec = SCN + (size_t)item * 24576;
                    const bf16x8_t v00 = ldpermcol<0>(Vv, r32, hh), v01 = ldpermcol<1>(Vv, r32, hh), v10 = ldpermcol<0>(Vv, 32 + r32, hh), v11 = ldpermcol<1>(Vv, 32 + r32, hh);
                    f32x16 U0a, U0b;
                    { f32x16 G2T = zero16;
#pragma unroll
                      for (int ks = 0; ks < 4; ++ks) G2T = mm32(ldrow(Kt, r32, ks, hh), ldrow(At, r32, ks, hh), G2T);
#pragma unroll
                      for (int e = 0; e < 16; ++e) G2T[e] = (rowidx(e, hh) < r32) ? G2T[e] : 0.f;
                      const bf16x8_t g0 = accop<0>(G2T), g1 = accop<1>(G2T);
                      f32x16 Za = mm32(g0, v00, zero16); Za = mm32(g1, v01, Za); f32x16 Zb = mm32(g0, v10, zero16); Zb = mm32(g1, v11, Zb);
                      U0a = mm32(ty0, accop<0>(Za), zero16); U0a = mm32(ty1, accop<1>(Za), U0a); U0b = mm32(ty0, accop<0>(Zb), zero16); U0b = mm32(ty1, accop<1>(Zb), U0b); }
                    const bf16x8_t ua0 = accop<0>(U0a), ua1 = accop<1>(U0a), ub0 = accop<0>(U0b), ub1 = accop<1>(U0b);
                    f32x16 G3T = zero16;
                    { f32x16 G4T = zero16;
#pragma unroll
                      for (int ks = 0; ks < 4; ++ks) { const bf16x8_t fr = ldrow(Rt, r32, ks, hh); G3T = mm32(ldrow(Bt, r32, ks, hh), fr, G3T); G4T = mm32(ldrow(Kt, r32, ks, hh), fr, G4T); }
#pragma unroll
                      for (int e = 0; e < 16; ++e) { const bool keep = rowidx(e, hh) <= r32; G3T[e] = keep ? G3T[e] : 0.f; G4T[e] = keep ? G4T[e] : 0.f; }
                      const bf16x8_t g30 = accop<0>(G3T), g31 = accop<1>(G3T), g40 = accop<0>(G4T), g41 = accop<1>(G4T);
                      f32x16 Ya = mm32(g30, ua0, zero16); Ya = mm32(g31, ua1, Ya); Ya = mm32(g40, v00, Ya); Ya = mm32(g41, v01, Ya);
                      f32x16 Yb = mm32(g30, ub0, zero16); Yb = mm32(g31, ub1, Yb); Yb = mm32(g40, v10, Yb); Yb = mm32(g41, v11, Yb);
                      u32x4 o0, o1;
                      o0.x = cvtpk(Ya[0], Ya[1]); o0.y = cvtpk(Ya[2], Ya[3]); o0.z = cvtpk(Ya[4], Ya[5]); o0.w = cvtpk(Ya[6], Ya[7]);
                      o1.x = cvtpk(Ya[8], Ya[9]); o1.y = cvtpk(Ya[10], Ya[11]); o1.z = cvtpk(Ya[12], Ya[13]); o1.w = cvtpk(Ya[14], Ya[15]);
                      *(u32x4*)(rec + 12288 + 4096 + lane * 32) = o0; *(u32x4*)(rec + 12288 + 4096 + lane * 32 + 16) = o1;
                      o0.x = cvtpk(Yb[0], Yb[1]); o0.y = cvtpk(Yb[2], Yb[3]); o0.z = cvtpk(Yb[4], Yb[5]); o0.w = cvtpk(Yb[6], Yb[7]);
                      o1.x = cvtpk(Yb[8], Yb[9]); o1.y = cvtpk(Yb[10], Yb[11]); o1.z = cvtpk(Yb[12], Yb[13]); o1.w = cvtpk(Yb[14], Yb[15]);
                      *(u32x4*)(rec + 12288 + 6144 + 4096 + lane * 32) = o0; *(u32x4*)(rec + 12288 + 6144 + 4096 + lane * 32 + 16) = o1; }
                    f32x16 Wa0 = mm32(ty0, ldpermcol<0>(At, r32, hh), zero16); Wa0 = mm32(ty1, ldpermcol<1>(At, r32, hh), Wa0);
                    f32x16 Wa1 = mm32(ty0, ldpermcol<0>(At, 32 + r32, hh), zero16); Wa1 = mm32(ty1, ldpermcol<1>(At, 32 + r32, hh), Wa1);
                    const bf16x8_t wa00 = accop<0>(Wa0), wa01 = accop<1>(Wa0), wa10 = accop<0>(Wa1), wa11 = accop<1>(Wa1);
                    { const bf16x8_t g30 = accop<0>(G3T), g31 = accop<1>(G3T);
                      f32x16 Ra = mm32(wa00, g30, zero16); Ra = mm32(wa01, g31, Ra); f32x16 Rb_ = mm32(wa10, g30, zero16); Rb_ = mm32(wa11, g31, Rb_);
#pragma unroll
                      for (int e = 0; e < 16; ++e) { const int kr = rowidx(e, hh); Ra[e] += bf2f(Rt[r32 * 72 + kr]); Rb_[e] += bf2f(Rt[r32 * 72 + 32 + kr]); }
                      *(bf16x8_t*)(rec + 8192 + 0 * 1024 + lane * 16) = accop<0>(Ra); *(bf16x8_t*)(rec + 8192 + 1 * 1024 + lane * 16) = accop<1>(Ra);
                      *(bf16x8_t*)(rec + 8192 + 2 * 1024 + lane * 16) = accop<0>(Rb_); *(bf16x8_t*)(rec + 8192 + 3 * 1024 + lane * 16) = accop<1>(Rb_); }
                    const bf16x8_t b00 = ldpermcol<0>(Bt, r32, hh), b01 = ldpermcol<1>(Bt, r32, hh), b10 = ldpermcol<0>(Bt, 32 + r32, hh), b11 = ldpermcol<1>(Bt, 32 + r32, hh);
                    { const float pc0 = PCs[r32], pc1 = PCs[32 + r32];
#pragma unroll
                      for (int ij = 0; ij < 4; ++ij) { const int i = ij >> 1, j = ij & 1;
                          f32x16 M = mm32(i ? wa10 : wa00, j ? b10 : b00, zero16); M = mm32(i ? wa11 : wa01, j ? b11 : b01, M);
#pragma unroll
                          for (int e = 0; e < 16; ++e) { float m = M[e]; if (i == j) m += (rowidx(e, hh) == r32) ? 1.f : 0.f; M[e] = m * (j ? pc1 : pc0); }
                          *(bf16x8_t*)(rec + (ij * 2 + 0) * 1024 + lane * 16) = accop<0>(M); *(bf16x8_t*)(rec + (ij * 2 + 1) * 1024 + lane * 16) = accop<1>(M); } }
                    { const bf16x8_t k00 = ldpermcol<0>(Kt, r32, hh), k01 = ldpermcol<1>(Kt, r32, hh), k10 = ldpermcol<0>(Kt, 32 + r32, hh), k11 = ldpermcol<1>(Kt, 32 + r32, hh);
#pragma unroll
                      for (int ju = 0; ju < 4; ++ju) { const int j = ju >> 1, u = ju & 1;
                          f32x16 Dm = mm32(j ? b10 : b00, u ? ub0 : ua0, zero16); Dm = mm32(j ? b11 : b01, u ? ub1 : ua1, Dm);
                          Dm = mm32(j ? k10 : k00, u ? v10 : v00, Dm); Dm = mm32(j ? k11 : k01, u ? v11 : v01, Dm);
#pragma unroll
                          for (int e = 0; e < 16; ++e) Dm[e] *= PCs[32 * j + rowidx(e, hh)];
                          u32x4 o0, o1;
                          o0.x = cvtpk(Dm[0], Dm[1]); o0.y = cvtpk(Dm[2], Dm[3]); o0.z = cvtpk(Dm[4], Dm[5]); o0.w = cvtpk(Dm[6], Dm[7]);
                          o1.x = cvtpk(Dm[8], Dm[9]); o1.y = cvtpk(Dm[10], Dm[11]); o1.z = cvtpk(Dm[12], Dm[13]); o1.w = cvtpk(Dm[14], Dm[15]);
                          *(u32x4*)(rec + 12288 + u * 6144 + j * 2048 + lane * 32) = o0; *(u32x4*)(rec + 12288 + u * 6144 + j * 2048 + lane * 32 + 16) = o1; } }
                }
            }
        }
        { XcdBarrier xb_ = xbar; asm volatile("" : "+s"(xb_.bar)); xcd_barrier<false>(xb_); }
        if (IN(pb + 3)) { PHASE_IDS
            const int r32 = lane & 31, hh = lane >> 5;
            constexpr int SLOT = 18432, NCH = SEQ / 32, NSL = 7, AHEAD = 6;
            const bool spare = G > BATCH * NH * 2; const int cw = spare ? bx - BATCH * NH * 2 : bx, cn = spare ? G - BATCH * NH * 2 : G;
            if (cw >= 0) {
                if (cw == 0) { for (int i = tid; i < BATCH * D; i += NTHR) { const int b = i / D, d = i % D; S2V[(size_t)l * BATCH * D + i] = INP(24)[l * D + d] * (1.f + modl[(size_t)b * 6 * D + 4 * D + d]); } }
                for (int n = cw * NWAVES + wave; n < PH * PQ; n += cn * NWAVES) {
                    const bf16* wr_ = PqT + (size_t)l * PH * PQ * D + (size_t)n * D + lane * 16; const u32x4 w0 = *(const u32x4*)wr_, w1 = *(const u32x4*)(wr_ + 8);
                    const unsigned ww[8] = {w0.x, w0.y, w0.z, w0.w, w1.x, w1.y, w1.z, w1.w};
#pragma unroll
                    for (int b = 0; b < BATCH; ++b) { const float* sh = modl + (size_t)b * 6 * D + 3 * D + lane * 16; float a = 0.f;
#pragma unroll
                        for (int q = 0; q < 4; ++q) { const f32x4 sv_ = *(const f32x4*)(sh + q * 4);
                            a += sv_.x * __uint_as_float(ww[2 * q] << 16) + sv_.y * __uint_as_float(ww[2 * q] & 0xffff0000u) + sv_.z * __uint_as_float(ww[2 * q + 1] << 16) + sv_.w * __uint_as_float(ww[2 * q + 1] & 0xffff0000u); }
                        a = wave_sum(a, lane); if (lane == 0) CVEC[(size_t)l * BATCH * PH * PQ + (size_t)b * PH * PQ + n] = a; } }
                convert_tables_fp6(INP(27), INP(28), U8, V8, USc, VSc, l, cw * NWAVES + wave, cn * NWAVES, lane);
            {
                constexpr int DST = 520;
                int lane_p; asm volatile("v_mbcnt_lo_u32_b32 %0, -1, 0\n\tv_mbcnt_hi_u32_b32 %0, -1, %0" : "=v"(lane_p)); const int r32 = lane_p & 31, hh = lane_p >> 5, tidp = wave0 * 64 + lane_p;
                lbf16* dlb = (lbf16*)lds;
                lbf16* pin = (lbf16*)(lds + 33280);
                const int c = tidp, g = c >> 7, win = 2 << g;
                const bf16* pwt = PWT + (size_t)(l * 4 + (wave >> 1)) * PG * PG; const float* psc = INP(22) + l * PW;
                for (int tile = cw; tile < T / 32; tile += cn) {
                    const int t0 = tile * 32; const bool first = (t0 % SEQ) == 0;
                    __syncthreads();
                    { u32x4 pq[6];
#pragma unroll
                      for (int q = 0; q < 6; ++q) { const int ch = tidp + q * NTHR, row = ch >> 6, cc = ch & 63; pq[q] = (u32x4){0u, 0u, 0u, 0u};
                          if (ch < 47 * 64 && (row >= 15 || !first)) pq[q] = *(const u32x4*)(POOLIN + (size_t)(t0 - 15 + row) * PW + cc * 8); }
#pragma unroll
                      for (int q = 0; q < 6; ++q) { const int ch = tidp + q * NTHR, row = ch >> 6, cc = ch & 63; if (ch < 47 * 64) *(__attribute__((address_space(3))) u32x4*)(pin + row * 520 + cc * 8) = pq[q]; } }
                    __syncthreads();
                    const lbf16* pc = pin + c;
                    float sw = 0.f;
#pragma unroll
                    for (int j = 1; j <= 15; ++j) sw += (j < win) ? bf2f(pc[(15 - j) * 520]) : 0.f;
                    const float invw = 1.f / (float)win;
#pragma unroll 8
                    for (int i = 0; i < 32; ++i) {
                        const float cur = bf2f(pc[(15 + i) * 520]);
                        sw += cur;
                        const float inv = (first && i < 15) ? 1.f / (float)min(i + 1, win) : invw;
                        dlb[i * DST + c] = f2bf(sw * inv - cur);
                        sw -= bf2f(pc[(15 + i - win + 1) * 520]);
                    }
                    __syncthreads();
                    const int gg = wave >> 1, half = wave & 1;
#pragma unroll
                    for (int ct = 0; ct < 2; ++ct) {
                        const int dd0 = half * 64 + ct * 32;
                        f32x16 acc;
#pragma unroll
                        for (int e = 0; e < 16; ++e) acc[e] = 0.f;
#pragma unroll
                        for (int ks = 0; ks < 8; ++ks) { const bf16x8_t a = *(const __attribute__((address_space(3))) bf16x8_t*)(dlb + r32 * DST + gg * PG + ks * 16 + 8 * hh);
                            const bf16x8_t w = *(const bf16x8_t*)(pwt + (size_t)(dd0 + r32) * PG + ks * 16 + 8 * hh); acc = mm32(a, w, acc); }
                        const int oc = gg * PG + dd0 + r32; const float ps = psc[oc];
#pragma unroll
                        for (int e = 0; e < 16; ++e) MIX[(size_t)(t0 + rowidx(e, hh)) * D + RW + oc] = f2bf(acc[e] * ps);
                    }
                }
            }
            }
            for (int un = bx; un < BATCH * NH * 2; un += G) {
                const int bh = un >> 1, u = un & 1, b = bh >> 3, h = bh & 7;
                __syncthreads();
                const unsigned char* recs = SCN + (size_t)bh * NCH * 24576;
                const int lw = wave - 2;
#define S2_DMA(chunk_) do { if (wave >= 2) { LAS unsigned char* sl = lds + ((chunk_) % NSL) * SLOT; const unsigned char* rp = recs + (size_t)(chunk_) * 24576 + lane * 16; \
                    _Pragma("unroll") for (int q_ = 0; q_ < 3; ++q_) { const int p_ = lw * 3 + q_; const int so_ = p_ < 12 ? p_ * 1024 : 12288 + u * 6144 + (p_ - 12) * 1024; \
                        __builtin_amdgcn_global_load_lds((const unsigned*)(rp + so_), (LAS unsigned*)(sl + p_ * 1024), 16, 0, 0); } } } while (0)
#pragma unroll 1
                for (int c0 = 0; c0 < AHEAD; ++c0) S2_DMA(c0);
                asm volatile("s_waitcnt vmcnt(15)" ::: "memory");
                __builtin_amdgcn_s_barrier();
                f32x16 X0, X1;
                { float z_ = 0.f; asm volatile("" : "+v"(z_));
#pragma unroll
                for (int e = 0; e < 16; ++e) { X0[e] = z_; X1[e] = z_; } }
#define S2_FRAG(off) (*(const __attribute__((address_space(3))) bf16x8_t*)(sl + (off) + lane * 16))
#define S2_UNPK(dst, off) do { const u32x4 a0 = *(const LAS u32x4*)(sl + (off) + lane * 32), a1 = *(const LAS u32x4*)(sl + (off) + lane * 32 + 16); const unsigned wv[8] = {a0.x, a0.y, a0.z, a0.w, a1.x, a1.y, a1.z, a1.w}; \
                    _Pragma("unroll") for (int q = 0; q < 8; ++q) { (dst)[2 * q] = __uint_as_float(wv[q] << 16); (dst)[2 * q + 1] = __uint_as_float(wv[q] & 0xffff0000u); } } while (0)
#pragma unroll 1
                for (int n = 0; n < NCH; ++n) {
                    if (n + AHEAD < NCH) S2_DMA(n + AHEAD);
                    if (wave == 0) {
                        const LAS unsigned char* sl = lds + (n % NSL) * SLOT;
                        const bf16x8_t x00 = accop<0>(X0), x01 = accop<1>(X0), x10 = accop<0>(X1), x11 = accop<1>(X1);
                        f32x16 Yc, N0, N1;
                        S2_UNPK(Yc, 12288 + 4096); S2_UNPK(N0, 12288); S2_UNPK(N1, 12288 + 2048);
                        Yc = mm32(S2_FRAG(8192 + 0 * 1024), x00, Yc); Yc = mm32(S2_FRAG(8192 + 1 * 1024), x01, Yc); Yc = mm32(S2_FRAG(8192 + 2 * 1024), x10, Yc); Yc = mm32(S2_FRAG(8192 + 3 * 1024), x11, Yc);
                        N0 = mm32(S2_FRAG((0 * 2 + 0) * 1024), x00, N0); N0 = mm32(S2_FRAG((0 * 2 + 1) * 1024), x01, N0); N0 = mm32(S2_FRAG((2 * 2 + 0) * 1024), x10, N0); N0 = mm32(S2_FRAG((2 * 2 + 1) * 1024), x11, N0);
                        N1 = mm32(S2_FRAG((1 * 2 + 0) * 1024), x00, N1); N1 = mm32(S2_FRAG((1 * 2 + 1) * 1024), x01, N1); N1 = mm32(S2_FRAG((3 * 2 + 0) * 1024), x10, N1); N1 = mm32(S2_FRAG((3 * 2 + 1) * 1024), x11, N1);
                        X0 = N0; X1 = N1;
                        float* yp = Y + ((size_t)b * SEQ + (size_t)n * 32) * RW + h * HS + u * 32 + r32;
#pragma unroll
                        for (int e = 0; e < 16; ++e) yp[(size_t)rowidx(e, hh) * RW] = Yc[e];
                        asm volatile("s_waitcnt lgkmcnt(0)" ::: "memory");
                    } else if (wave >= 2) {
                        const int younger = (NCH - 1 - (n + 1)) < (AHEAD - 1) ? (NCH - 1 - (n + 1)) : (AHEAD - 1);
                        if (younger >= 5) asm volatile("s_waitcnt vmcnt(15)" ::: "memory"); else if (younger == 4) asm volatile("s_waitcnt vmcnt(12)" ::: "memory"); else if (younger == 3) asm volatile("s_waitcnt vmcnt(9)" ::: "memory");
                        else if (younger == 2) asm volatile("s_waitcnt vmcnt(6)" ::: "memory"); else if (younger == 1) asm volatile("s_waitcnt vmcnt(3)" ::: "memory"); else asm volatile("s_waitcnt vmcnt(0)" ::: "memory");
                    }
                    __builtin_amdgcn_s_barrier();
                }
#undef S2_FRAG
#undef S2_UNPK
#undef S2_DMA
            }
        }
        SEAM(pb + 3);

        if (IN(pb + 4)) { PHASE_IDS
            const int c8 = (tid & 63) * 8, hd = (tid & 63) >> 3, tsub = tid >> 6;
            const f32x4 lg0 = *(const f32x4*)(INP(19) + l * RW + c8), lg1 = *(const f32x4*)(INP(19) + l * RW + c8 + 4), lb0 = *(const f32x4*)(INP(20) + l * RW + c8), lb1 = *(const f32x4*)(INP(20) + l * RW + c8 + 4);
            for (int tile = bx; tile < T / 8; tile += G) {
                const int t = tile * 8 + tsub; const size_t o = (size_t)t * RW + c8;
                const f32x4 y0 = *(const f32x4*)(Y + o), y1 = *(const f32x4*)(Y + o + 4); const u32x4 gq = *(const u32x4*)(Gb + o), vq = *(const u32x4*)(BGb + o); const float bsum = BSUM[(size_t)t * NH + hd];
                float sm = (y0.x + y0.y) + (y0.z + y0.w) + (y1.x + y1.y) + (y1.z + y1.w);
                sm += dppf<0xB1>(sm); sm += dppf<0x4E>(sm); sm += dppf<0x141>(sm);
                const float mean = sm * (1.f / 64.f);
                const f32x4 d0 = y0 - mean, d1 = y1 - mean;
                float sq = (d0.x * d0.x + d0.y * d0.y) + (d0.z * d0.z + d0.w * d0.w) + (d1.x * d1.x + d1.y * d1.y) + (d1.z * d1.z + d1.w * d1.w);
                sq += dppf<0xB1>(sq); sq += dppf<0x4E>(sq); sq += dppf<0x141>(sq);
                const float rs = rsqrtf(sq * (1.f / 64.f) + GN_EPS);
                const f32x4 n0 = d0 * rs * lg0 + lb0, n1 = d1 * rs * lg1 + lb1;
                const unsigned gw_[4] = {gq.x, gq.y, gq.z, gq.w}, vw_[4] = {vq.x, vq.y, vq.z, vq.w}; const float nn[8] = {n0.x, n0.y, n0.z, n0.w, n1.x, n1.y, n1.z, n1.w}; unsigned ow[4];
#pragma unroll
                for (int i = 0; i < 4; ++i) { const float g0 = __uint_as_float(gw_[i] << 16), g1 = __uint_as_float(gw_[i] & 0xffff0000u), v0 = __uint_as_float(vw_[i] << 16), v1 = __uint_as_float(vw_[i] & 0xffff0000u);
                    ow[i] = pk2(nn[2 * i] * g0 + v0 * bsum, nn[2 * i + 1] * g1 + v1 * bsum); }
                *(u32x4*)(MIX + (size_t)t * D + c8) = (u32x4){ow[0], ow[1], ow[2], ow[3]};
            }
        }
        SEAM(pb + 4);
        if (IN(pb + 5)) { PHASE_IDS
            pg8::Gemm g{MIX, WoutT + (size_t)l * D * D, T, D, D}; pg8::StaticOrder S; S.init(T, D, G, bx);
            pg8::EpiResGate E{xin, X, modl + 2 * D, XB2, S2V + (size_t)l * BATCH * D, SSQ + (size_t)l * T};
            pg8::gemm_phase<pg8::EpiResGate, pg8::StaticOrder, true, true>(lds, g, S, E, tid); }
        SEAM(pb + 5);
        if (IN(pb + 7)) { PHASE_IDS
            pg8::Gemm g{XB2, PqT + (size_t)l * PH * PQ * D, T, PH * PQ, D}; pg8::StaticOrder S; S.init(T, PH * PQ, G, bx);
            pg8::EpiQ E{Q, PH * PQ, CVEC + (size_t)l * BATCH * PH * PQ, SSQ + (size_t)l * T};
            pg8::gemm_phase<pg8::EpiQ, pg8::StaticOrder, true, true>(lds, g, S, E, tid); }
        if (IN(pb + 7) && IN(pb + 8)) { asm volatile("s_waitcnt vmcnt(0)" ::: "memory"); __syncthreads(); }

        if (IN(pb + 8)) { PHASE_IDS
            const bf16* KEYSl = KEYS + (size_t)l * PH * 2 * NKEYS * PHALF;
            LAS unsigned char* scr = lds + wave * 2048 + lane * 32;
            constexpr int KST = 136;
            lbf16* kl = (lbf16*)(lds + 16384);
            const int r = lane & 31, hh = lane >> 5;
            pg8::StaticOrder S; S.init(T, PH * PQ, G, bx);
            for (int ui = 0;; ++ui) { pg8::Unit un_; if (!S.next(ui, un_)) break;
                const int h = un_.pn, tok = un_.pm * 256 + wave * 32 + r;
                __syncthreads();
                { u32x4 kq[8];
#pragma unroll
                  for (int q = 0; q < 8; ++q) { const int ch = tid + q * NTHR; kq[q] = *(const u32x4*)(KEYSl + (size_t)(h * 2) * NKEYS * PHALF + (size_t)ch * 8); }
#pragma unroll
                  for (int q = 0; q < 8; ++q) { const int ch = tid + q * NTHR, row = ch >> 4, cc = ch & 15; *(__attribute__((address_space(3))) u32x4*)(kl + row * KST + cc * 8) = kq[q]; } }
                __syncthreads();
                unsigned sp0[16], sp1[16];
#pragma unroll
                for (int e = 0; e < 16; ++e) { sp0[e] = 0u; sp1[e] = 0u; }
#pragma unroll 1
                for (int p = 0; p < 2; ++p) {
                    const bf16* qp = Q + (size_t)tok * (PH * PQ) + h * PQ + p * PHALF + 8 * hh;
                    const lbf16* kp_ = kl + (p * NKEYS + r) * KST + 8 * hh;
                    bf16x8_t bq[8];
#pragma unroll
                    for (int ks = 0; ks < 8; ++ks) bq[ks] = *(const bf16x8_t*)(qp + ks * 16);
                    unsigned best[16];
#pragma unroll
                    for (int e = 0; e < 16; ++e) best[e] = 0u;
#pragma unroll 1
                    for (int kt = 0; kt < 4; ++kt) {
                        f32x16 acc;
#pragma unroll
                        for (int e = 0; e < 16; ++e) acc[e] = 0.f;
#pragma unroll
                        for (int ks = 0; ks < 8; ++ks) { const bf16x8_t ak = *(const __attribute__((address_space(3))) bf16x8_t*)(kp_ + kt * 32 * KST + ks * 16); acc = __builtin_amdgcn_mfma_f32_32x32x16_bf16(ak, bq[ks], acc, 0, 0, 0); }
                        unsigned g[16];
#pragma unroll
                        for (int e = 0; e < 16; ++e) g[e] = pack_key7(acc[e], kt * 32 + (e & 3) + 8 * (e >> 2) + 4 * hh);
                        sort16_desc(g);
                        merge_top16(best, g);
                    }
                    unsigned ob[16];
#pragma unroll
                    for (int e = 0; e < 16; ++e) ob[e] = shflxu(best[e], lane, 32);
                    merge_top16(best, ob);
#pragma unroll
                    for (int e = 0; e < 16; ++e) { sp0[e] = p == 0 ? best[e] : sp0[e]; sp1[e] = p == 0 ? sp1[e] : best[e]; }
                }
                unsigned c2[32];
                stage2_cands(sp0, sp1, hh, c2);
                sort16_desc(c2); sort16_desc(c2 + 16); merge_top16(c2, c2 + 16);
                { unsigned ob[16];
#pragma unroll
                  for (int e = 0; e < 16; ++e) ob[e] = shflxu(c2[e], lane, 32);
                  merge_top16(c2, ob); }
#pragma unroll
                for (int e = 0; e < 16; e += 4) {
                    *(LAS unsigned*)(scr + e) = (127u - (sp0[e] & 127u)) | ((127u - (sp0[e + 1] & 127u)) << 8) | ((127u - (sp0[e + 2] & 127u)) << 16) | ((127u - (sp0[e + 3] & 127u)) << 24);
                    *(LAS unsigned*)(scr + 16 + e) = (127u - (sp1[e] & 127u)) | ((127u - (sp1[e + 1] & 127u)) << 8) | ((127u - (sp1[e + 2] & 127u)) << 16) | ((127u - (sp1[e + 3] & 127u)) << 24); }
                asm volatile("s_waitcnt lgkmcnt(0)" ::: "memory");
                float sm[16]; int ex[16];
#pragma unroll
                for (int e = 0; e < 16; ++e) { const unsigned key = c2[e]; sm[e] = unpack_key8(key); const int i0 = (key >> 4) & 15, j0 = key & 15; ex[e] = (int)scr[i0] * NKEYS + (int)scr[16 + j0]; }
                float den = 0.f;
#pragma unroll
                for (int e = 0; e < 16; ++e) { sm[e] = expf(sm[e] - unpack_key8(c2[0])); den += sm[e]; }
                const float inv = 1.f / den;
                if (hh == 0) {
                    int* ip = IDX + (size_t)tok * NE + h * TOPK; float* gp = GATE + (size_t)tok * NE + h * TOPK;
#pragma unroll
                    for (int e = 0; e < 16; e += 4) { *(int4*)(ip + e) = make_int4(ex[e], ex[e + 1], ex[e + 2], ex[e + 3]); *(f32x4*)(gp + e) = (f32x4){sm[e] * inv, sm[e + 1] * inv, sm[e + 2] * inv, sm[e + 3] * inv}; }
                }
                asm volatile("s_waitcnt lgkmcnt(0)" ::: "memory");
            }
        }
        SEAM(pb + 8);

        if (IN(pb + 9)) { PHASE_IDS
            const unsigned char* Ul = U8 + (size_t)l * NEXP * ROWB; const unsigned char* Vtl = V8 + (size_t)l * NEXP * ROWB; const float* usl = USc + l * NEXP; const float* vsl = VSc + l * NEXP; const float* lnf = INP(29);
            const bool fin = (l == DEPTH - 1);
            typedef float f32x2_t __attribute__((ext_vector_type(2)));
            const __amdgpu_buffer_rsrc_t ru = __builtin_amdgcn_make_buffer_rsrc((void*)Ul, 0, NEXP * ROWB, 0x00020000), rv = __builtin_amdgcn_make_buffer_rsrc((void*)Vtl, 0, NEXP * ROWB, 0x00020000);
            typedef float f32x32_t __attribute__((ext_vector_type(32))); typedef unsigned u32x3_t __attribute__((ext_vector_type(3))); typedef unsigned u32x6_t __attribute__((ext_vector_type(6))); typedef unsigned u32x16_t __attribute__((ext_vector_type(16))); typedef __bf16 bf16x2_t __attribute__((ext_vector_type(2)));
            LAS float* pl = (LAS float*)(lds + wave * 18432);
            constexpr int TW = 4;
            for (int tb = gw; tb < T; tb += TW * NGW) {
#define TOKV(k) (tb + (k) * NGW < T)
#define TOK(k) (TOKV(k) ? tb + (k) * NGW : tb)
                unsigned si[TW][2]; float sus[TW][2], sgv[TW][2];
                LAS u32x4* hl = (LAS u32x4*)(pl + 32 * 68);
                { float g0[TW], g1[TW]; int lane_s; asm volatile("v_mbcnt_lo_u32_b32 %0, -1, 0\n\tv_mbcnt_hi_u32_b32 %0, -1, %0" : "=v"(lane_s));
#pragma unroll
                  for (int k = 0; k < TW; ++k) { const size_t o = (size_t)TOK(k) * NE + lane_s; si[k][0] = ((unsigned)IDX[o] << 7) | (unsigned)lane_s; si[k][1] = ((unsigned)IDX[o + 64] << 7) | (unsigned)(64 + lane_s); g0[k] = GATE[o]; g1[k] = GATE[o + 64]; }
#pragma unroll
                  for (int kk = 2; kk <= 128; kk <<= 1) {
#pragma unroll
                      for (int j = kk >> 1; j > 0; j >>= 1) {
                          if (j == 64) {
#pragma unroll
                              for (int k = 0; k < TW; ++k) { const unsigned a = si[k][0], b = si[k][1]; si[k][0] = a < b ? a : b; si[k][1] = a < b ? b : a; } }
                          else { const bool lower = (lane_s & j) == 0, tm0 = lower == ((lane_s & kk) == 0), tm1 = lower == (((lane_s + 64) & kk) == 0); const int pa = (lane_s ^ j) << 2;
#pragma unroll
                              for (int k = 0; k < TW; ++k) { const unsigned a = si[k][0], b = si[k][1], p0 = (unsigned)__builtin_amdgcn_ds_bpermute(pa, (int)a), p1 = (unsigned)__builtin_amdgcn_ds_bpermute(pa, (int)b);
                                  si[k][0] = tm0 ? (a < p0 ? a : p0) : (a < p0 ? p0 : a); si[k][1] = tm1 ? (b < p1 ? b : p1) : (b < p1 ? p1 : b); } }
                          __builtin_amdgcn_sched_barrier(0);
                      } }
#pragma unroll
                  for (int k = 0; k < TW; ++k) {
#pragma unroll
                      for (int r = 0; r < 2; ++r) { const unsigned key = si[k][r]; const int a = (int)(key & 63u) << 2; const int ga = __builtin_amdgcn_ds_bpermute(a, __float_as_int(g0[k])), gb = __builtin_amdgcn_ds_bpermute(a, __float_as_int(g1[k]));
                          const unsigned ix = key >> 7; si[k][r] = ix; sus[k][r] = usl[ix]; sgv[k][r] = __int_as_float((key & 64u) ? gb : ga) * vsl[ix]; } }
#pragma unroll
                  for (int k = 0; k < TW; ++k) {
                      const int t_ = TOK(k); const bf16* hr = XB2 + (size_t)t_ * D + lane_s * 16; const u32x4 a0 = *(const u32x4*)hr, a1 = *(const u32x4*)(hr + 8);
                      const float rs_ = rsqrtf((float)SSQ[(size_t)l * T + t_] * (1.f / (1048576.f * D)) + NORM_EPS); const float* shp = modl + (size_t)(t_ / SEQ) * 6 * D + 3 * D + lane_s * 16;
                      const unsigned aw[8] = {a0.x, a0.y, a0.z, a0.w, a1.x, a1.y, a1.z, a1.w}; unsigned ow[8];
#pragma unroll
                      for (int q = 0; q < 4; ++q) { const f32x4 s4 = *(const f32x4*)(shp + q * 4);
                          ow[2 * q] = pk2(__uint_as_float(aw[2 * q] << 16) * rs_ + s4.x, __uint_as_float(aw[2 * q] & 0xffff0000u) * rs_ + s4.y);
                          ow[2 * q + 1] = pk2(__uint_as_float(aw[2 * q + 1] << 16) * rs_ + s4.z, __uint_as_float(aw[2 * q + 1] & 0xffff0000u) * rs_ + s4.w); }
                      hl[(k * 2) * 64 + lane_s] = (u32x4){ow[0], ow[1], ow[2], ow[3]}; hl[(k * 2 + 1) * 64 + lane_s] = (u32x4){ow[4], ow[5], ow[6], ow[7]}; }
                }
                __builtin_amdgcn_sched_barrier(0);
#define ROWLD(dst, rs, ixv, ln) dst = __builtin_amdgcn_raw_buffer_load_b96(rs, voff, __builtin_amdgcn_readlane((int)(ixv), (ln)) * ROWB, 0)
#define LOADQ(buf, rs, ixv, ln0) do { _Pragma("unroll") for (int j_ = 0; j_ < 8; ++j_) ROWLD((buf)[j_], rs, ixv, (ln0) + j_); __builtin_amdgcn_sched_barrier(0); } while (0)
#define CVT2(a, b) const f32x32_t f_ = __builtin_amdgcn_cvt_scalef32_pk32_f32_fp6((u32x6_t){(a).x, (a).y, (a).z, (b).x, (b).y, (b).z}, 1.0f)
#define PR(i) __builtin_shufflevector(f_, f_, 2 * (i), 2 * (i) + 1)
#define DOTQ(buf, e0) do { _Pragma("unroll") for (int j_ = 0; j_ < 8; j_ += 2) { \
                        const u32x16_t g_ = __builtin_bit_cast(u32x16_t, __builtin_amdgcn_cvt_scalef32_pk32_bf16_fp6((u32x6_t){(buf)[j_].x, (buf)[j_].y, (buf)[j_].z, (buf)[j_ + 1].x, (buf)[j_ + 1].y, (buf)[j_ + 1].z}, 1.0f));     \
                        float a0_ = 0.f, a1_ = 0.f, b0_ = 0.f, b1_ = 0.f; \
                        _Pragma("unroll") for (int i_ = 0; i_ < 8; i_ += 2) { a0_ = DOT2(g_[i_], hpk[i_], a0_); b0_ = DOT2(g_[8 + i_], hpk[i_], b0_); a1_ = DOT2(g_[i_ + 1], hpk[i_ + 1], a1_); b1_ = DOT2(g_[9 + i_], hpk[i_ + 1], b1_); } \
                        pl[((e0) + j_) * 68 + lane_u] = a0_ + a1_; pl[((e0) + j_ + 1) * 68 + lane_u] = b0_ + b1_; __builtin_amdgcn_sched_barrier(0); } } while (0)
#define DOT2(x_, y_, c_) __builtin_amdgcn_fdot2_f32_bf16(__builtin_bit_cast(bf16x2_t, (unsigned)(x_)), __builtin_bit_cast(bf16x2_t, (unsigned)(y_)), (c_), false)
#define AXPYQ(buf, k, cfv, ln0) do { _Pragma("unroll") for (int j_ = 0; j_ < 8; j_ += 2) { CVT2((buf)[j_], (buf)[j_ + 1]); \
                        const float ca = __int_as_float(__builtin_amdgcn_readlane(__float_as_int(cfv), (ln0) + j_)), cb = __int_as_float(__builtin_amdgcn_readlane(__float_as_int(cfv), (ln0) + j_ + 1)); \
                        acc2[k][0] += ca * PR(0); acc2[k][1] += ca * PR(1); acc2[k][2] += ca * PR(2); acc2[k][3] += ca * PR(3); acc2[k][4] += ca * PR(4); acc2[k][5] += ca * PR(5); acc2[k][6] += ca * PR(6); acc2[k][7] += ca * PR(7); \
                        acc2[k][0] += cb * PR(8); acc2[k][1] += cb * PR(9); acc2[k][2] += cb * PR(10); acc2[k][3] += cb * PR(11); acc2[k][4] += cb * PR(12); acc2[k][5] += cb * PR(13); acc2[k][6] += cb * PR(14); acc2[k][7] += cb * PR(15); __builtin_amdgcn_sched_barrier(0); } } while (0)
                u32x3_t ba[8], bb_[8];
                int lane_u; asm volatile("v_mbcnt_lo_u32_b32 %0, -1, 0\n\tv_mbcnt_hi_u32_b32 %0, -1, %0" : "=v"(lane_u)); const int voff = lane_u * 12;
                LOADQ(ba, ru, si[0][0], 0);
#pragma unroll 1
                for (int c = 0; c < 16; ++c) {
                    const int lb = (c & 7) * 8; const bool r1 = c >= 8;
#pragma unroll
                    for (int k = 0; k < TW; ++k) {
                        unsigned hpk[8];
                        { const u32x4 h0 = hl[(k * 2) * 64 + lane_u], h1 = hl[(k * 2 + 1) * 64 + lane_u]; hpk[0] = h0.x; hpk[1] = h0.y; hpk[2] = h0.z; hpk[3] = h0.w; hpk[4] = h1.x; hpk[5] = h1.y; hpk[6] = h1.z; hpk[7] = h1.w; }
                        if (k & 1) { if (k < TW - 1) LOADQ(ba, ru, r1 ? si[k + 1][1] : si[k + 1][0], lb); else { const int cn = (c + 1) & 15; const __amdgpu_buffer_rsrc_t rn = c < 15 ? ru : rv; LOADQ(ba, rn, (cn >= 8) ? si[0][1] : si[0][0], (cn & 7) * 8); } DOTQ(bb_, k * 8); }
                        else { LOADQ(bb_, ru, r1 ? si[k + 1][1] : si[k + 1][0], lb); DOTQ(ba, k * 8); }
                    }
                    __builtin_amdgcn_wave_barrier(); asm volatile("s_waitcnt lgkmcnt(0)" ::: "memory");
                    float dsum;
                    { const LAS float* rp = pl + (lane_u & 31) * 68 + (lane_u >> 5) * 32; f32x4 s4 = *(const LAS f32x4*)rp;
#pragma unroll
                      for (int j = 1; j < 8; ++j) s4 += *(const LAS f32x4*)(rp + j * 4);
                      dsum = (s4.x + s4.y) + (s4.z + s4.w); }
                    dsum += shflx(dsum, lane_u, 32);
                    __builtin_amdgcn_wave_barrier(); asm volatile("s_waitcnt lgkmcnt(0)" ::: "memory");
                    const bool home = (lane_u >> 3) == (c & 7);
#pragma unroll
                    for (int k = 0; k < TW; ++k) {
                        const float dv = __int_as_float(__builtin_amdgcn_ds_bpermute((k * 8 + (lane_u & 7)) << 2, __float_as_int(dsum)));
                        const float cf = (r1 ? sgv[k][1] : sgv[k][0]) * gelu_erf(dv * (r1 ? sus[k][1] : sus[k][0]));
                        if (r1) sgv[k][1] = home ? cf : sgv[k][1]; else sgv[k][0] = home ? cf : sgv[k][0]; }
                    __builtin_amdgcn_sched_barrier(0);
                }
                f32x2_t acc2[TW][8];
#pragma unroll
                for (int k = 0; k < TW; ++k) {
#pragma unroll
                    for (int i = 0; i < 8; ++i) acc2[k][i] = (f32x2_t){0.f, 0.f}; }
#pragma unroll 1
                for (int c = 0; c < 16; ++c) {
                    const int lb = (c & 7) * 8; const bool r1 = c >= 8;
#pragma unroll
                    for (int k = 0; k < TW; ++k) {
                        const float cfk = r1 ? sgv[k][1] : sgv[k][0];
                        if (k & 1) { if (k < TW - 1) LOADQ(ba, rv, r1 ? si[k + 1][1] : si[k + 1][0], lb); else { const int cn = (c + 1) & 15; LOADQ(ba, rv, (cn >= 8) ? si[0][1] : si[0][0], (cn & 7) * 8); }     AXPYQ(bb_, k, cfk, lb); }
                        else { LOADQ(bb_, rv, r1 ? si[k + 1][1] : si[k + 1][0], lb); AXPYQ(ba, k, cfk, lb); }
                    }
                }
#undef ROWLD
#undef LOADQ
#undef CVT2
#undef PR
#undef DOTQ
#undef DOT2
#undef AXPYQ
                { int ln; asm volatile("v_mbcnt_lo_u32_b32 %0, -1, 0\n\tv_mbcnt_hi_u32_b32 %0, -1, %0" : "=v"(ln));
                  LAS f32x4* al = (LAS f32x4*)pl + ln;
#pragma unroll
                  for (int k = 0; k < TW; ++k) {
#pragma unroll
                      for (int q = 0; q < 4; ++q) al[(k * 4 + q) * 64] = (f32x4){acc2[k][q * 2].x, acc2[k][q * 2].y, acc2[k][q * 2 + 1].x, acc2[k][q * 2 + 1].y}; }
                  asm volatile("s_waitcnt lgkmcnt(0)" ::: "memory"); __builtin_amdgcn_sched_barrier(0);
                  f32x4 xn[4];
#pragma unroll
                  for (int q = 0; q < 4; ++q) xn[q] = *(const f32x4*)(X + (size_t)tb * D + ln * 16 + q * 4);
#pragma unroll 1
                  for (int k = 0; k < TW; ++k) { const int t = tb + k * NGW; if (t >= T) break; const int b = t / SEQ;
                    float* xr = X + (size_t)t * D + ln * 16; const float* g2 = modl + (size_t)b * 6 * D + 5 * D + ln * 16;
                    f32x4 xv[4]; float ss = 0.f;
#pragma unroll
                    for (int q = 0; q < 4; ++q) xv[q] = xn[q];
                    { const float* xnp = X + (size_t)((k + 1 < TW && t + NGW < T) ? t + NGW : t) * D + ln * 16;
#pragma unroll
                      for (int q = 0; q < 4; ++q) xn[q] = *(const f32x4*)(xnp + q * 4); }
                    __builtin_amdgcn_sched_barrier(0);
#pragma unroll
                    for (int q = 0; q < 4; ++q) { const f32x4 xo = xv[q], gg = *(const f32x4*)(g2 + q * 4);
                        xv[q] = xo + gg * al[(k * 4 + q) * 64]; ss += (xv[q].x * xv[q].x + xv[q].y * xv[q].y) + (xv[q].z * xv[q].z + xv[q].w * xv[q].w); }
                    const float rs = rsqrtf(wave_sum(ss, ln) * (1.f / D) + NORM_EPS);
                    if (fin) {
#pragma unroll
                        for (int q = 0; q < 4; ++q) *(f32x4*)(xr + q * 4) = xv[q] * rs * *(const f32x4*)(lnf + ln * 16 + q * 4); }
                    else {
                        const float* gam = INP(4) + (l + 1) * D + ln * 16; const float* mn = MOD + (size_t)(l + 1) * BATCH * 6 * D + (size_t)b * 6 * D + ln * 16; u32x4 ho[2];
#pragma unroll
                        for (int q = 0; q < 4; ++q) { *(f32x4*)(xr + q * 4) = xv[q];
                            const f32x4 y = xv[q] * rs * *(const f32x4*)(gam + q * 4) * (*(const f32x4*)(mn + D + q * 4) + 1.f) + *(const f32x4*)(mn + q * 4);
                            if (q & 1) { ho[q >> 1].z = pk2(y.x, y.y); ho[q >> 1].w = pk2(y.z, y.w); } else { ho[q >> 1].x = pk2(y.x, y.y); ho[q >> 1].y = pk2(y.z, y.w); } }
                        *(u32x4*)(H + (size_t)t * D + ln * 16) = ho[0]; *(u32x4*)(H + (size_t)t * D + ln * 16 + 8) = ho[1]; }
                  }
                  asm volatile("s_waitcnt lgkmcnt(0)" ::: "memory"); __builtin_amdgcn_wave_barrier();
                }
#undef TOK
#undef TOKV
            }
        }
    }
#undef modl
#undef xin
#undef IN
#undef SEAM
}
#undef MOD
#undef H
#undef PROJ
#undef Q
#undef MIX
#undef Rb
#undef Kb
#undef V0
#undef V1
#undef KKb
#undef Bb
#undef Gb
#undef BGb
#undef Wd
#undef Y
#undef IDX
#undef GATE
#undef WinT
#undef WoutT
#undef PqT
#undef KEYS
#undef QB
#undef POOLIN
#undef SH
#undef SSQ
#undef CVEC
#undef S2V
#undef XB2
#undef WUPT
#undef AUPT
#undef GUPT
#undef VUPT
#undef PWT
#undef INVN
#undef BSUM
#undef SCN
#undef U8
#undef V8
#undef USc
#undef VSc
#undef INP
#undef PHASE_IDS

extern "C" void kernel_launch(void* const* d_in, const int* in_sizes, int n_in, void* d_out, int out_size, void* d_ws, size_t ws_size, hipStream_t stream) {
    if (n_in != 30 || ws_size < WS_END) { fprintf(stderr, "kernel_launch: unexpected n_in %d / ws_size %zu\n", n_in, ws_size); return; }
    static int grid = 0;
    if (grid == 0) {
        int dev = 0, cus = 0, per_cu = 0;
        (void)hipGetDevice(&dev); (void)hipDeviceGetAttribute(&cus, hipDeviceAttributeMultiprocessorCount, dev);
        if (hipFuncSetAttribute((const void*)mega, hipFuncAttributeMaxDynamicSharedMemorySize, LDS_BYTES) != hipSuccess) { fprintf(stderr, "hipFuncSetAttribute failed\n"); grid = -1; return; }
        if (hipOccupancyMaxActiveBlocksPerMultiprocessor(&per_cu, (const void*)mega, NTHR, LDS_BYTES) != hipSuccess || per_cu < 1) { fprintf(stderr, "occupancy query failed (%d)\n", per_cu); per_cu = 1; }
        (void)hipGetLastError();
        grid = (cus > 0 ? cus : 256) * 1;
    }
    if (grid < 0) return;
    Args a{}; for (int i = 0; i < 30; ++i) a.in[i] = (const float*)d_in[i]; a.out = (float*)d_out; a.ws = (unsigned char*)d_ws;
    a.ph_lo = 0; a.ph_hi = NPH;
    if (hipMemsetAsync(d_ws, 0, 65536, stream) != hipSuccess) { fprintf(stderr, "memset failed\n"); return; }
    void* kargs[] = {&a};
    hipError_t e = hipLaunchCooperativeKernel((const void*)mega, dim3(grid), dim3(NTHR), kargs, LDS_BYTES, stream);
    if (e != hipSuccess) fprintf(stderr, "cooperative launch failed: %s (grid %d)\n", hipGetErrorString(e), grid);
}
```

```cpp
#include <hip/hip_runtime.h>
#include <hip/hip_cooperative_groups.h>
namespace cg = cooperative_groups;
#include <cstdio>
#include <cstdint>
#include <cmath>

constexpr int D = 1024, BATCH = 4, SEQ = 4096, T = BATCH * SEQ, DEPTH = 2;
constexpr int RW = 512, HS = 64, NH = 8;
constexpr int DL = 64, AL = 64, MVL = 32, GL = 128;
constexpr int RWKV_COLS = 3 * RW + DL + AL + GL;
constexpr int PW = 512, PG = 128;
constexpr int IN_COLS = RWKV_COLS + PW;
constexpr int LDP = 2560;
constexpr int NKEYS = 128, NEXP = NKEYS * NKEYS, PH = 8, PQ = 256, PHALF = 128, TOPK = 16;
constexpr int NE = PH * TOPK;
constexpr float NORM_EPS = 1e-6f, GN_EPS = 64e-5f;

typedef unsigned short bf16;
__device__ __forceinline__ float bf2f(bf16 u) { return __uint_as_float((unsigned)u << 16); }
typedef float cvt_f32x2 __attribute__((ext_vector_type(2))); typedef __bf16 cvt_bf16x2 __attribute__((ext_vector_type(2)));
__device__ __forceinline__ unsigned cvtpk(float lo, float hi) { const cvt_f32x2 v = {lo, hi}; const cvt_bf16x2 b = __builtin_convertvector(v, cvt_bf16x2); return __builtin_bit_cast(unsigned, b); }
__device__ __forceinline__ bf16 f2bf(float f) { return (bf16)cvtpk(f, 0.f); }

constexpr size_t MiB = 1u << 20;
constexpr size_t WS_MOD = 1 * MiB;
constexpr size_t WS_US = 1 * MiB + 256 * 1024;
constexpr size_t WS_VS = 1 * MiB + 512 * 1024;
constexpr size_t WS_H = 2 * MiB;
constexpr size_t WS_PROJ = 34 * MiB;
constexpr size_t WS_Q = WS_PROJ;
constexpr size_t WS_R = 114 * MiB;
constexpr size_t WS_K = 130 * MiB;
constexpr size_t WS_V0 = 146 * MiB;
constexpr size_t WS_V1 = 162 * MiB;
constexpr size_t WS_KK = 178 * MiB;
constexpr size_t WS_B = 194 * MiB;
constexpr size_t WS_G = 210 * MiB;
constexpr size_t WS_BG = 226 * MiB;
constexpr size_t WS_W = 242 * MiB;
constexpr size_t WS_Y = 274 * MiB;
constexpr size_t WS_MIX = 306 * MiB;
constexpr size_t WS_IDX = 338 * MiB;
constexpr size_t WS_GATE = 346 * MiB;
constexpr size_t WS_WIN_T = 354 * MiB;
constexpr size_t WS_WOUT_T = 364 * MiB;
constexpr size_t WS_PQ_T = 368 * MiB;
constexpr size_t WS_KEYS = 376 * MiB;
constexpr size_t WS_U = 378 * MiB;
constexpr size_t WS_V = 442 * MiB;
constexpr size_t WS_QB = 410 * MiB;
constexpr size_t WS_SH = 426 * MiB;
constexpr size_t WS_LORA = 428 * MiB;
constexpr size_t WS_INVN = 430 * MiB;
constexpr size_t WS_BSUM = 431 * MiB;
constexpr size_t WS_SCN = 2 * MiB;
constexpr size_t WS_END = 506 * MiB;

template <int CTRL> __device__ __forceinline__ float dppf(float x) { return __int_as_float(__builtin_amdgcn_update_dpp(0, __float_as_int(x), CTRL, 0xF, 0xF, false)); }
__device__ __forceinline__ float red16(float x) { x += dppf<0xB1>(x); x += dppf<0x4E>(x); x += dppf<0x141>(x); x += dppf<0x140>(x); return x; }
__device__ __forceinline__ float shflx(float v, int lane, int off) { return __int_as_float(__builtin_amdgcn_ds_bpermute((lane ^ off) << 2, __float_as_int(v))); }
__device__ __forceinline__ unsigned shflxu(unsigned v, int lane, int off) { return (unsigned)__builtin_amdgcn_ds_bpermute((lane ^ off) << 2, (int)v); }
__device__ __forceinline__ void sort128(unsigned& k0, unsigned& k1, int lane) {
#pragma unroll
    for (int k = 2; k <= 128; k <<= 1) {
#pragma unroll
        for (int j = k >> 1; j > 0; j >>= 1) {
            if (j == 64) { const unsigned lo = k0 < k1 ? k0 : k1, hi = k0 < k1 ? k1 : k0; k0 = lo; k1 = hi; }
            else {
                const unsigned p0 = shflxu(k0, lane, j), p1 = shflxu(k1, lane, j);
                const bool lower = (lane & j) == 0, up0 = (lane & k) == 0, up1 = ((lane + 64) & k) == 0;
                const unsigned mn0 = k0 < p0 ? k0 : p0, mx0 = k0 < p0 ? p0 : k0, mn1 = k1 < p1 ? k1 : p1, mx1 = k1 < p1 ? p1 : k1;
                k0 = (lower == up0) ? mn0 : mx0; k1 = (lower == up1) ? mn1 : mx1;
            }
        }
    }
}
__device__ __forceinline__ float wave_sum(float v, int lane) { v = red16(v); v += shflx(v, lane, 16); v += shflx(v, lane, 32); return v; }
__device__ __forceinline__ float sigmoidf_(float x) { return 1.f / (1.f + expf(-x)); }

namespace pg8 {
#define PG8_LAS __attribute__((address_space(3)))
typedef unsigned short bf16_t;
typedef short bf16x8 __attribute__((ext_vector_type(8)));
typedef float f32x4 __attribute__((ext_vector_type(4)));
typedef unsigned u32x4 __attribute__((ext_vector_type(4)));
constexpr int BM = 256, BK = 64, HALF = 128, HTB = HALF * BK * 2  , STAGE_BYTES = 8 * HTB, NXCD = 8, WGM = 8;

__host__ __device__ __forceinline__ int lds_byte(int r, int c) { const int st = (r >> 4) * 2 + (c >> 5), rr = r & 15, cc = c & 31, ob = rr * 64 + cc * 2; return st * 1024 + (ob ^ (((ob >> 9) & 1) << 5)); }
__host__ __device__ __forceinline__ void stage_rc(int b, int& R, int& C) { const int st = b / 1024, sb = b % 1024, swz = sb ^ (((sb >> 9) & 1) << 5); R = (st >> 1) * 16 + swz / 64; C = (st & 1) * 32 + (swz % 64) / 2; }
__host__ __device__ __forceinline__ int perm32(int rho) { const int n = rho >> 4, i = rho & 15; return 8 * (i >> 2) + 4 * n + (i & 3); }

struct Unit { int pm, pn; };
struct Gemm { const bf16_t* A; const bf16_t* Bt; int M, N, K; };

struct StaticOrder {
    int nM, nN, nwg, G, c;
    __host__ __device__ void init(int M, int N, int G_, int c_) { nM = M / BM; nN = N / BM; nwg = nM * nN; G = G_; c = c_; }
    __host__ __device__ bool next(int i, Unit& u) const {
        const long L = (long)i * G + c; if (L >= nwg) return false;
        int wgid = (int)L; { const int q = nwg / NXCD, r = nwg % NXCD, xcd = wgid % NXCD, off = wgid / NXCD; wgid = (xcd < r ? xcd * (q + 1) : r * (q + 1) + (xcd - r) * q) + off; }
        const int nig = WGM * nN, gid = wgid / nig, fm = gid * WGM, gsz = (nM - fm) < WGM ? (nM - fm) : WGM;
        u.pm = fm + ((wgid % nig) % gsz); u.pn = (wgid % nig) / gsz; return true;
    }
    __device__ __forceinline__ void a_ready(const Unit&) const {}
    __device__ __forceinline__ void done(const Unit&) const {}
};

__device__ __forceinline__ unsigned cvt_pk_bf16(float lo, float hi) { unsigned r; asm volatile("v_cvt_pk_bf16_f32 %0, %1, %2" : "=v"(r) : "v"(lo), "v"(hi)); return r; }
typedef float f32x2 __attribute__((ext_vector_type(2)));
__device__ __forceinline__ f32x2 gelu_pk(f32x2 v) {
    const f32x2 av = __builtin_elementwise_abs(v), d = av * 0.2316418882f + 1.0f;
    f32x2 t; t.x = __builtin_amdgcn_rcpf(d.x); t.y = __builtin_amdgcn_rcpf(d.y);
    f32x2 q = t * 0.5307027145f + (-0.7265760135f); q = q * t + 0.7107068705f; q = q * t + (-0.142248368f); q = q * t + 0.127414796f; q = q * t;
    const f32x2 s = (v * v) * (-0.72134752044f);
    f32x2 e; e.x = __builtin_amdgcn_exp2f(s.x); e.y = __builtin_amdgcn_exp2f(s.y);
    const f32x2 m = v * (q * e), r = v - m;
    f32x2 o; o.x = v.x < 0.f ? m.x : r.x; o.y = v.y < 0.f ? m.y : r.y; return o;
}

template <int ACT  > struct EpiBf16 {
    static constexpr bool PERM = true, AFTER_DRAIN = false; static_assert(ACT == 0 || ACT == 1, "EpiBf16: ACT is 0 (none) or 1 (gelu_pk)");
    bf16_t* O; int ldc; const float* bias; int split_cols; size_t split_stride; float scale0;
    __device__ __forceinline__ void operator()(const f32x4 (&acc)[2][2][4][2], const Unit& u, int wr, int wc, int fr, int fq) const {
        const int row0 = u.pm * BM + wr * 64 + fr; int colt = u.pn * BM; bf16_t* base = O;
        float sc = 1.f; if (split_cols) { const int t = colt / split_cols; base += (size_t)t * split_stride; colt -= t * split_cols; if (t == 0) sc = scale0; }
        const int col0 = colt + wc * 32 + 8 * fq, bcol0 = u.pn * BM + wc * 32 + 8 * fq;
        f32x4 bv[2][2];
#pragma unroll
        for (int bj = 0; bj < 2; ++bj)
#pragma unroll
            for (int n = 0; n < 2; ++n) bv[bj][n] = bias ? *(const f32x4*)(bias + bcol0 + bj * HALF + 4 * n) : (f32x4){0.f, 0.f, 0.f, 0.f};
#pragma unroll
        for (int ai = 0; ai < 2; ++ai)
#pragma unroll
            for (int m = 0; m < 4; ++m) { bf16_t* rowp = base + (size_t)(row0 + ai * HALF + m * 16) * ldc + col0;
#pragma unroll
                for (int bj = 0; bj < 2; ++bj) { f32x4 v0 = acc[ai][bj][m][0] + bv[bj][0], v1 = acc[ai][bj][m][1] + bv[bj][1];
                    if (ACT == 1) { f32x2 a = gelu_pk((f32x2){v0[0], v0[1]}), b = gelu_pk((f32x2){v0[2], v0[3]}), c = gelu_pk((f32x2){v1[0], v1[1]}), d = gelu_pk((f32x2){v1[2], v1[3]});
                        v0 = (f32x4){a.x, a.y, b.x, b.y}; v1 = (f32x4){c.x, c.y, d.x, d.y}; }
                    v0 = v0 * sc; v1 = v1 * sc; u32x4 w; w.x = cvt_pk_bf16(v0[0], v0[1]); w.y = cvt_pk_bf16(v0[2], v0[3]); w.z = cvt_pk_bf16(v1[0], v1[1]); w.w = cvt_pk_bf16(v1[2], v1[3]);
                    *(u32x4*)(rowp + bj * HALF) = w; } }
    }
};

struct EpiProj {
    static constexpr bool PERM = true, AFTER_DRAIN = false;
    bf16_t* O; int ldc; bf16_t* P; int pool0, pw;
    __device__ __forceinline__ void operator()(const f32x4 (&acc)[2][2][4][2], const Unit& u, int wr, int wc, int fr, int fq) const {
        const int row0 = u.pm * BM + wr * 64 + fr; int colt = u.pn * BM; bf16_t* base = O; int ld = ldc;
        if (colt >= pool0 && colt < pool0 + pw) { base = P; ld = pw; colt -= pool0; }
        const int col0 = colt + wc * 32 + 8 * fq;
#pragma unroll
        for (int ai = 0; ai < 2; ++ai)
#pragma unroll
            for (int m = 0; m < 4; ++m) { bf16_t* rowp = base + (size_t)(row0 + ai * HALF + m * 16) * ld + col0;
#pragma unroll
                for (int bj = 0; bj < 2; ++bj) { const f32x4 v0 = acc[ai][bj][m][0], v1 = acc[ai][bj][m][1];
                    u32x4 w; w.x = cvt_pk_bf16(v0[0], v0[1]); w.y = cvt_pk_bf16(v0[2], v0[3]); w.z = cvt_pk_bf16(v1[0], v1[1]); w.w = cvt_pk_bf16(v1[2], v1[3]);
                    *(u32x4*)(rowp + bj * HALF) = w; } }
    }
};
struct EpiResGate {
    static constexpr bool PERM = true, AFTER_DRAIN = false;
    const float* xold; float* X; const float* gate;
    bf16_t* XB; const float* sv; unsigned long long* ssq;
    __device__ __forceinline__ void operator()(const f32x4 (&acc)[2][2][4][2], const Unit& u, int wr, int wc, int fr, int fq) const {
        const int col0 = u.pn * BM + wc * 32 + 8 * fq; const int b = (u.pm * BM) / SEQ;
        const float* gp = gate + (size_t)b * 6 * D + col0; const float* sp = sv + (size_t)b * D + col0;
        float rsum[2][4];
#pragma unroll
        for (int ai = 0; ai < 2; ++ai)
#pragma unroll
            for (int m = 0; m < 4; ++m) rsum[ai][m] = 0.f;
#pragma unroll
        for (int bj = 0; bj < 2; ++bj) { const f32x4 g0 = *(const f32x4*)(gp + bj * HALF), g1 = *(const f32x4*)(gp + bj * HALF + 4), s0 = *(const f32x4*)(sp + bj * HALF), s1 = *(const f32x4*)(sp + bj * HALF + 4);
#pragma unroll
            for (int ai = 0; ai < 2; ++ai)
#pragma unroll
                for (int m = 0; m < 4; ++m) { const size_t off = (size_t)(u.pm * BM + ai * HALF + wr * 64 + m * 16 + fr) * D + col0 + bj * HALF;
                    const f32x4 xa = *(const f32x4*)(xold + off) + g0 * acc[ai][bj][m][0], xb = *(const f32x4*)(xold + off + 4) + g1 * acc[ai][bj][m][1];
                    *(f32x4*)(X + off) = xa; *(f32x4*)(X + off + 4) = xb;
                    rsum[ai][m] += ((xa[0] * xa[0] + xa[1] * xa[1]) + (xa[2] * xa[2] + xa[3] * xa[3])) + ((xb[0] * xb[0] + xb[1] * xb[1]) + (xb[2] * xb[2] + xb[3] * xb[3]));
                    const f32x4 ya = xa * s0, yb = xb * s1; u32x4 o; o.x = cvt_pk_bf16(ya[0], ya[1]); o.y = cvt_pk_bf16(ya[2], ya[3]); o.z = cvt_pk_bf16(yb[0], yb[1]); o.w = cvt_pk_bf16(yb[2], yb[3]);
                    *(u32x4*)(XB + off) = o; } }
        const int lane_ = fr | (fq << 4);
#pragma unroll
        for (int ai = 0; ai < 2; ++ai)
#pragma unroll
            for (int m = 0; m < 4; ++m) { float v = rsum[ai][m];
                v += __int_as_float(__builtin_amdgcn_ds_bpermute((lane_ ^ 16) << 2, __float_as_int(v))); v += __int_as_float(__builtin_amdgcn_ds_bpermute((lane_ ^ 32) << 2, __float_as_int(v)));
                if (fq == 0) (void)__hip_atomic_fetch_add(ssq + (u.pm * BM + ai * HALF + wr * 64 + m * 16 + fr), (unsigned long long)(v * 1048576.f + 0.5f), __ATOMIC_RELAXED, __HIP_MEMORY_SCOPE_AGENT); }
    }
};
struct EpiQ {
    static constexpr bool PERM = true, AFTER_DRAIN = false;
    bf16_t* O; int ldc; const float* cv; const unsigned long long* ssq;
    __device__ __forceinline__ void operator()(const f32x4 (&acc)[2][2][4][2], const Unit& u, int wr, int wc, int fr, int fq) const {
        const int row0 = u.pm * BM + wr * 64 + fr, colt = u.pn * BM, b = (u.pm * BM) / SEQ;
        const int col0 = colt + wc * 32 + 8 * fq;
        f32x4 bv[2][2];
#pragma unroll
        for (int bj = 0; bj < 2; ++bj)
#pragma unroll
            for (int n = 0; n < 2; ++n) bv[bj][n] = *(const f32x4*)(cv + (size_t)b * ldc + col0 + bj * HALF + 4 * n);
#pragma unroll
        for (int ai = 0; ai < 2; ++ai)
#pragma unroll
            for (int m = 0; m < 4; ++m) { const int row = row0 + ai * HALF + m * 16; bf16_t* rowp = O + (size_t)row * ldc + col0;
                const float rs = rsqrtf((float)ssq[row] * (1.f / (1048576.f * 1024.f)) + 1e-6f);
#pragma unroll
                for (int bj = 0; bj < 2; ++bj) { const f32x4 v0 = acc[ai][bj][m][0] * rs + bv[bj][0], v1 = acc[ai][bj][m][1] * rs + bv[bj][1];
                    u32x4 w; w.x = cvt_pk_bf16(v0[0], v0[1]); w.y = cvt_pk_bf16(v0[2], v0[3]); w.z = cvt_pk_bf16(v1[0], v1[1]); w.w = cvt_pk_bf16(v1[2], v1[3]);
                    *(u32x4*)(rowp + bj * HALF) = w; } }
    }
};
template <class Epi, class Sched, bool ALIGN_EPI = false, bool SP2 = false>
__device__ __forceinline__ void gemm_phase(PG8_LAS unsigned char* lds, const Gemm g, const Sched& S, const Epi& E, int tid) {
    asm volatile("" : "+v"(tid));
    const int wid = __builtin_amdgcn_readfirstlane(tid >> 6), lane = tid & 63, wr = wid >> 2, wc = wid & 3, fr = lane & 15, fq = lane >> 4;
    const int K = g.K, nt = K / BK;
    unsigned voffA[2], voffB[2];
#pragma unroll
    for (int i = 0; i < 2; ++i) { int R, C; stage_rc(tid * 16 + i * 8192, R, C); const int Rb = Epi::PERM ? ((R & ~31) + perm32(R & 31)) : R;
        voffA[i] = (unsigned)(R * K + C) * 2u; voffB[i] = (unsigned)(Rb * K + C) * 2u; }
    const size_t kstep = (size_t)(BK * 2);
    const size_t hstep = (size_t)HALF * K * 2;
    const size_t tstep = 2 * hstep;
    const unsigned ldsw = (unsigned)wid * 1024u;
    const int aoff = lds_byte(wr * 64 + fr, fq * 8), boff = lds_byte(wc * 32 + fr, fq * 8);
#define PG8_SA(b, h) (((b) * 2 + (h)) * HTB)
#define PG8_SB(b, h) ((4 + (b) * 2 + (h)) * HTB)
#define PG8_STAGE(bufoff, gbase, voff) do { _Pragma("unroll") for (int _i = 0; _i < 2; ++_i) \
        __builtin_amdgcn_global_load_lds((const unsigned*)((const char*)(gbase) + (voff)[_i]), (PG8_LAS unsigned*)(lds + (bufoff) + ldsw + _i * 8192), 16, 0, 0); } while (0)
#define PG8_LDA(dst, b, h) do { _Pragma("unroll") for (int m = 0; m < 4; ++m) _Pragma("unroll") for (int k = 0; k < 2; ++k) dst[m][k] = *(const PG8_LAS bf16x8*)(lds + PG8_SA(b, h) + aoff + m * 2048 + k * 1024); } while (0)
#define PG8_LDB(dst, b, h) do { _Pragma("unroll") for (int n = 0; n < 2; ++n) _Pragma("unroll") for (int k = 0; k < 2; ++k) dst[n][k] = *(const PG8_LAS bf16x8*)(lds + PG8_SB(b, h) + boff + n * 2048 + k * 1024); } while (0)
#define PG8_MMA(ai, bj, At, Bt) do { __builtin_amdgcn_s_setprio(1); _Pragma("unroll") for (int m = 0; m < 4; ++m) _Pragma("unroll") for (int n = 0; n < 2; ++n) _Pragma("unroll") for (int k = 0; k < 2; ++k) \
        acc[ai][bj][m][n] = __builtin_amdgcn_mfma_f32_16x16x32_bf16(Bt[n][k], At[m][k], acc[ai][bj][m][n], 0, 0, 0); __builtin_amdgcn_s_setprio(0); } while (0)
#define PG8_WAIT_V(n) asm volatile("s_waitcnt vmcnt(" #n ")" ::: "memory")
#define PG8_WAIT_L(n) asm volatile("s_waitcnt lgkmcnt(" #n ")" ::: "memory")
#define PG8_BAR __builtin_amdgcn_s_barrier()
#define PG8_SCHED __builtin_amdgcn_sched_barrier(0)
    Unit cur, nxt; int ui = 0;
    if (!S.next(0, cur)) return;
    f32x4 acc[2][2][4][2];
#pragma unroll
    for (int a = 0; a < 2; ++a)
#pragma unroll
        for (int b = 0; b < 2; ++b)
#pragma unroll
            for (int m = 0; m < 4; ++m)
#pragma unroll
                for (int n = 0; n < 2; ++n) acc[a][b][m][n] = (f32x4){0.f, 0.f, 0.f, 0.f};
    bf16x8 At[4][2], B0[2][2], B1[2][2];
    const char* cA = (const char*)g.A + (size_t)cur.pm * tstep; const char* cB = (const char*)g.Bt + (size_t)cur.pn * tstep;
    S.a_ready(cur);
    if constexpr (SP2) {
        PG8_STAGE(PG8_SB(0, 0), cB, voffB); PG8_STAGE(PG8_SB(0, 1), cB + hstep, voffB); PG8_STAGE(PG8_SA(0, 0), cA, voffA); PG8_STAGE(PG8_SA(0, 1), cA + hstep, voffA);
        if (wr == 1) PG8_BAR;
        PG8_WAIT_V(2); PG8_BAR;
        PG8_STAGE(PG8_SB(1, 0), cB + kstep, voffB); PG8_STAGE(PG8_SA(1, 0), cA + kstep, voffA); PG8_STAGE(PG8_SB(1, 1), cB + hstep + kstep, voffB);
        PG8_WAIT_V(6); PG8_BAR;
    } else {
        PG8_STAGE(PG8_SB(0, 0), cB, voffB); PG8_STAGE(PG8_SA(0, 0), cA, voffA); PG8_STAGE(PG8_SB(0, 1), cB + hstep, voffB); PG8_STAGE(PG8_SA(0, 1), cA + hstep, voffA);
        if (wr == 1) PG8_BAR;
        PG8_WAIT_V(4); PG8_BAR;
        PG8_STAGE(PG8_SB(1, 0), cB + kstep, voffB); PG8_STAGE(PG8_SA(1, 0), cA + kstep, voffA); PG8_STAGE(PG8_SB(1, 1), cB + hstep + kstep, voffB);
        PG8_WAIT_V(6); PG8_BAR;
    }
    for (;;) {
        const bool has_next = S.next(ui + 1, nxt);
        const char* nA = has_next ? (const char*)g.A + (size_t)nxt.pm * tstep : cA; const char* nB = has_next ? (const char*)g.Bt + (size_t)nxt.pn * tstep : cB;
        for (int t = 0; t < nt; t += 2) {
            const bool last = (t == nt - 2);
            const char* a1 = cA + (size_t)(t + 1) * kstep;
            const char* a2 = last ? nA : cA + (size_t)(t + 2) * kstep; const char* b2 = last ? nB : cB + (size_t)(t + 2) * kstep;
            const char* a3 = a2 + kstep; const char* b3 = b2 + kstep;
            if (last && has_next) S.a_ready(nxt);
            if constexpr (SP2) {
            PG8_LDB(B0, 0, 0); PG8_LDB(B1, 0, 1); PG8_SCHED; PG8_LDA(At, 0, 0); PG8_STAGE(PG8_SA(1, 1), a1 + hstep, voffA);
            PG8_WAIT_V(8); PG8_WAIT_L(0); PG8_BAR; PG8_MMA(0, 0, At, B0); PG8_MMA(0, 1, At, B1); PG8_BAR; PG8_SCHED;
            PG8_LDA(At, 0, 1); PG8_STAGE(PG8_SB(0, 0), b2, voffB); PG8_STAGE(PG8_SB(0, 1), b2 + hstep, voffB); PG8_STAGE(PG8_SA(0, 0), a2, voffA);
            PG8_WAIT_V(8); PG8_WAIT_L(0); PG8_BAR; PG8_MMA(1, 0, At, B0); PG8_MMA(1, 1, At, B1); PG8_BAR; PG8_SCHED;
            PG8_LDB(B0, 1, 0); PG8_LDB(B1, 1, 1); PG8_SCHED; PG8_LDA(At, 1, 0); PG8_STAGE(PG8_SA(0, 1), a2 + hstep, voffA);
            PG8_WAIT_V(8); PG8_WAIT_L(0); PG8_BAR; PG8_MMA(0, 0, At, B0); PG8_MMA(0, 1, At, B1); PG8_BAR; PG8_SCHED;
            PG8_LDA(At, 1, 1); PG8_STAGE(PG8_SB(1, 0), b3, voffB); PG8_STAGE(PG8_SB(1, 1), b3 + hstep, voffB); PG8_STAGE(PG8_SA(1, 0), a3, voffA);
            PG8_WAIT_V(8); PG8_WAIT_L(0); PG8_BAR; PG8_MMA(1, 0, At, B0); PG8_MMA(1, 1, At, B1); PG8_BAR; PG8_SCHED;
            } else {
            PG8_LDB(B0, 0, 0); PG8_SCHED; PG8_LDA(At, 0, 0); PG8_STAGE(PG8_SA(1, 1), a1 + hstep, voffA);
            PG8_WAIT_L(8); PG8_BAR; PG8_WAIT_L(0); PG8_MMA(0, 0, At, B0); PG8_BAR; PG8_SCHED;
            PG8_LDB(B1, 0, 1); PG8_STAGE(PG8_SB(0, 0), b2, voffB);
            PG8_BAR; PG8_WAIT_L(0); PG8_MMA(0, 1, At, B1); PG8_BAR;
            PG8_LDA(At, 0, 1); PG8_STAGE(PG8_SA(0, 0), a2, voffA);
            PG8_BAR; PG8_WAIT_L(0); PG8_MMA(1, 0, At, B0); PG8_BAR; PG8_SCHED;
            PG8_STAGE(PG8_SB(0, 1), b2 + hstep, voffB);
            PG8_WAIT_V(6); PG8_BAR; PG8_MMA(1, 1, At, B1); PG8_BAR;
            PG8_LDB(B0, 1, 0); PG8_SCHED; PG8_LDA(At, 1, 0); PG8_STAGE(PG8_SA(0, 1), a2 + hstep, voffA);
            PG8_WAIT_L(8); PG8_BAR; PG8_WAIT_L(0); PG8_MMA(0, 0, At, B0); PG8_BAR; PG8_SCHED;
            PG8_LDB(B1, 1, 1); PG8_STAGE(PG8_SB(1, 0), b3, voffB);
            PG8_BAR; PG8_WAIT_L(0); PG8_MMA(0, 1, At, B1); PG8_BAR;
            PG8_LDA(At, 1, 1); PG8_STAGE(PG8_SA(1, 0), a3, voffA);
            PG8_BAR; PG8_WAIT_L(0); PG8_MMA(1, 0, At, B0); PG8_BAR; PG8_SCHED;
            PG8_STAGE(PG8_SB(1, 1), b3 + hstep, voffB);
            PG8_WAIT_V(6); PG8_BAR; PG8_MMA(1, 1, At, B1); PG8_BAR;
            }
        }
        if constexpr (ALIGN_EPI) { if (wr == 0) PG8_BAR; }
        if constexpr (!Epi::AFTER_DRAIN) { int le_; asm volatile("v_mbcnt_lo_u32_b32 %0, -1, 0\n\tv_mbcnt_hi_u32_b32 %0, -1, %0" : "=v"(le_)); E(acc, cur, wr, wc, le_ & 15, le_ >> 4); S.done(cur); }
        if (!has_next) break;
#pragma unroll
        for (int a = 0; a < 2; ++a)
#pragma unroll
            for (int b = 0; b < 2; ++b)
#pragma unroll
                for (int m = 0; m < 4; ++m)
#pragma unroll
                    for (int n = 0; n < 2; ++n) acc[a][b][m][n] = (f32x4){0.f, 0.f, 0.f, 0.f};
        cur = nxt; cA = nA; cB = nB; ++ui;
        if constexpr (ALIGN_EPI) { if (wr == 1) PG8_BAR; }
    }
    PG8_WAIT_V(0);
    if constexpr (!ALIGN_EPI) { if (wr == 0) PG8_BAR; }
    PG8_BAR;
    if constexpr (Epi::AFTER_DRAIN) { E.fused(acc, cur, wr, wc, fr, fq, lds, wid, lane); S.done(cur); }
#undef PG8_SA
#undef PG8_SB
#undef PG8_STAGE
#undef PG8_LDA
#undef PG8_LDB
#undef PG8_MMA
#undef PG8_WAIT_V
#undef PG8_WAIT_L
#undef PG8_BAR
#undef PG8_SCHED
}
}

#define LAS __attribute__((address_space(3)))
constexpr int NWAVES = 8, NTHR = 512;
constexpr int LDS_BYTES = 147456;
constexpr int NPH = 21;
typedef float f32x4 __attribute__((ext_vector_type(4)));
typedef unsigned u32x4 __attribute__((ext_vector_type(4)));

struct Args { const float* in[30]; float* out; unsigned char* ws; int ph_lo, ph_hi; };

__device__ __forceinline__ unsigned pk2(float lo, float hi) { return cvtpk(lo, hi); }

__device__ __forceinline__ void p0_transpose_item(const float* W, int K, int N, bf16* WT, int row_off, LAS float* scr, int item, int lane) {
    const int nblk = N / 32, kb = item / nblk, nb = item % nblk, k0 = 64 * kb, n0 = 32 * nb;
#pragma unroll 8
    for (int i = 0; i < 32; ++i) { const int kk = 2 * i + (lane >> 5); scr[kk * 33 + (lane & 31)] = W[(size_t)(k0 + kk) * N + n0 + (lane & 31)]; }
    asm volatile("s_waitcnt lgkmcnt(0)" ::: "memory");
    const int c = lane & 7;
#pragma unroll
    for (int j = 0; j < 4; ++j) { const int n = (lane >> 3) + 8 * j; const LAS float* s = scr + (8 * c) * 33 + n;
        u32x4 o; o.x = pk2(s[0 * 33], s[1 * 33]); o.y = pk2(s[2 * 33], s[3 * 33]); o.z = pk2(s[4 * 33], s[5 * 33]); o.w = pk2(s[6 * 33], s[7 * 33]);
        *(u32x4*)(WT + (size_t)(row_off + n0 + n) * K + k0 + 8 * c) = o; }
    asm volatile("s_waitcnt lgkmcnt(0)" ::: "memory");
}

__device__ __forceinline__ void norm_mod_row(const float* xr, const float* gamma, const float* sh, const float* sc, bf16* orow, int lane) {
    f32x4 v[4]; float ss = 0.f;
#pragma unroll
    for (int j = 0; j < 4; ++j) { v[j] = *(const f32x4*)(xr + j * 256 + lane * 4); ss += (v[j].x * v[j].x + v[j].y * v[j].y) + (v[j].z * v[j].z + v[j].w * v[j].w); }
    const float rs = rsqrtf(wave_sum(ss, lane) * (1.f / D) + NORM_EPS);
#pragma unroll
    for (int j = 0; j < 4; ++j) { const int d = j * 256 + lane * 4; const f32x4 g = *(const f32x4*)(gamma + d), a = *(const f32x4*)(sc + d), s = *(const f32x4*)(sh + d);
        const f32x4 y = v[j] * rs * g * (a + 1.f) + s; uint2 o; o.x = pk2(y.x, y.y); o.y = pk2(y.z, y.w); *(uint2*)(orow + d) = o; }
}


#define XB_TMO      128
#define XB_XCNT(j)  (256  + 64 * (j))
#define XB_XSUB(j)  (1280 + 64 * (j))
#define XB_XGEN(j)  (2304 + 64 * (j))
#define XB_TOP      3328
#define XB_TOPGEN   3392
#define XCD_BAR_WORDS 3456
#define XB_SPIN_CAP (1u << 18)

__device__ __forceinline__ unsigned xb_ld(unsigned* p)              { return __hip_atomic_load(p, __ATOMIC_RELAXED, __HIP_MEMORY_SCOPE_AGENT); }
__device__ __forceinline__ unsigned xb_add(unsigned* p, unsigned v) { return __hip_atomic_fetch_add(p, v, __ATOMIC_RELAXED, __HIP_MEMORY_SCOPE_AGENT); }
__device__ __forceinline__ unsigned xb_xcc_id() { return (unsigned)__builtin_amdgcn_s_getreg((3 << 11) | 20) & 0xFu; }
#define XB_SPIN(cond, bar) do { unsigned _sp = 0; while (cond) { __builtin_amdgcn_s_sleep(1); \
    if ((++_sp & 255u) == 0u) { if (xb_ld(&(bar)[XB_TMO])) break; if (_sp > XB_SPIN_CAP) { atomicAdd(&(bar)[XB_TMO], 1u); break; } } } } while (0)

struct XcdBarrier {
    unsigned* bar; unsigned x; int w0;
    volatile __attribute__((address_space(3))) unsigned* st;
};

__device__ __forceinline__ XcdBarrier xcd_barrier_post(unsigned* bar, volatile __attribute__((address_space(3))) unsigned* st) {
    XcdBarrier b; b.bar = bar; b.x = xb_xcc_id(); b.st = st; b.w0 = __builtin_amdgcn_readfirstlane((int)threadIdx.x >> 6);
    if (threadIdx.x == 0) (void)xb_add(&bar[XB_XCNT(b.x)], 1u);
    return b;
}
__device__ __forceinline__ void xcd_barrier_complete(unsigned* bar, unsigned x, unsigned& nloc, unsigned& nx) {
    const unsigned G = gridDim.x * gridDim.y * gridDim.z;
    unsigned sum, cnt, mine, sp = 0u;
    for (;;) {
        sum = 0u; cnt = 0u; mine = 0u;
#pragma unroll
        for (unsigned j = 0; j < 16; ++j) { const unsigned c = xb_ld(&bar[XB_XCNT(j)]); sum += c; cnt += (c > 0u) ? 1u : 0u; }
        mine = xb_ld(&bar[XB_XCNT(x)]);
        if (sum == G) break;
        __builtin_amdgcn_s_sleep(1);
        if ((++sp & 255u) == 0u) { if (xb_ld(&bar[XB_TMO])) break; if (sp > XB_SPIN_CAP) { atomicAdd(&bar[XB_TMO], 1u); break; } }
    }
    nloc = mine > 0u ? mine : 1u; nx = cnt > 0u ? cnt : 1u;
}

template <bool FIRST> __device__ __forceinline__ void xcd_barrier(const XcdBarrier& b) {
    asm volatile("s_waitcnt vmcnt(0)" ::: "memory");
    __syncthreads();
    int lid_; asm volatile("v_mbcnt_lo_u32_b32 %0, -1, 0\n\tv_mbcnt_hi_u32_b32 %0, -1, %0" : "=v"(lid_));
    if (b.w0 == 0 && lid_ == 0) {
        unsigned* bar = b.bar;
        __builtin_amdgcn_s_waitcnt(0);
        unsigned nloc = b.st[0], nx = b.st[1];
        if (FIRST && nloc == 0u) { xcd_barrier_complete(bar, b.x, nloc, nx); b.st[0] = nloc; b.st[1] = nx; }
        const unsigned old = xb_add(&bar[XB_XSUB(b.x)], 1u);
        const unsigned gen = old / nloc;
        if (old + 1u == (gen + 1u) * nloc) {
            __builtin_amdgcn_fence(__ATOMIC_RELEASE, "agent");
            asm volatile("s_waitcnt vmcnt(0)" ::: "memory");
            const unsigned og = xb_add(&bar[XB_TOP], 1u);
            const unsigned tg = og / nx;
            if (og + 1u == (tg + 1u) * nx) xb_add(&bar[XB_TOPGEN], 1u);
            else XB_SPIN(xb_ld(&bar[XB_TOPGEN]) == tg, bar);
            __builtin_amdgcn_fence(__ATOMIC_ACQUIRE, "agent");
            xb_add(&bar[XB_XGEN(b.x)], 1u);
            asm volatile("s_waitcnt vmcnt(0)" ::: "memory");
        } else {
            XB_SPIN(xb_ld(&bar[XB_XGEN(b.x)]) == gen, bar);
            __builtin_amdgcn_fence(__ATOMIC_ACQUIRE, "agent");
            asm volatile("s_waitcnt vmcnt(0)" ::: "memory");
        }
    }
    __syncthreads();
}


__device__ __forceinline__ unsigned mono_u32(float f) { unsigned u = __float_as_uint(f); return (u & 0x80000000u) ? ~u : (u | 0x80000000u); }
__device__ __forceinline__ float demono_u32(unsigned u) { return __uint_as_float((u & 0x80000000u) ? (u & 0x7FFFFFFFu) : ~u); }
__device__ __forceinline__ unsigned pack_key7(float f, int idx) { return (mono_u32(f) & 0xFFFFFF80u) | (unsigned)(127 - idx); }
__device__ __forceinline__ float unpack_key7(unsigned k) { return demono_u32((k & 0xFFFFFF80u) | 0x40u); }
__device__ __forceinline__ float unpack_key8(unsigned k) { return demono_u32((k & 0xFFFFFF00u) | 0x80u); }
__device__ __forceinline__ void ce_desc(unsigned& a, unsigned& b) { const unsigned hi = a > b ? a : b, lo = a > b ? b : a; a = hi; b = lo; }
__device__ __forceinline__ void sort16_desc(unsigned* v) {
#pragma unroll
    for (int k = 2; k <= 16; k <<= 1)
#pragma unroll
        for (int j = k >> 1; j > 0; j >>= 1)
#pragma unroll
            for (int i = 0; i < 16; ++i) { const int l = i ^ j; if (l > i) { if ((i & k) == 0) ce_desc(v[i], v[l]); else ce_desc(v[l], v[i]); } }
}
__device__ __forceinline__ void bmerge16_desc(unsigned* v) {
#pragma unroll
    for (int j = 8; j > 0; j >>= 1)
#pragma unroll
        for (int i = 0; i < 16; ++i) { const int l = i ^ j; if (l > i) ce_desc(v[i], v[l]); }
}
__device__ __forceinline__ void merge_top16(unsigned* a, const unsigned* b) {
#pragma unroll
    for (int i = 0; i < 16; ++i) { const unsigned o = b[15 - i]; a[i] = a[i] > o ? a[i] : o; }
    bmerge16_desc(a);
}
__device__ __forceinline__ void stage2_cands(const unsigned* s0, const unsigned* s1, int hh, unsigned* c) {
    float A[16], B[16];
#pragma unroll
    for (int i = 0; i < 16; ++i) { const float f0 = unpack_key7(s0[i]), f1 = unpack_key7(s1[i]); A[i] = hh ? f1 : f0; B[i] = hh ? f0 : f1; }
    int n = 0;
#pragma unroll
    for (int i = 0; i < 4; ++i)
#pragma unroll
        for (int j = i; j < 16; ++j) { if ((i + 1) * (j + 1) > 16) continue;
            const float val = A[i] + B[j]; const unsigned id = hh ? (unsigned)((j << 4) | i) : (unsigned)((i << 4) | j);
            unsigned key = (mono_u32(val) & 0xFFFFFF00u) | id; if (hh && i == j) key = 0u; c[n++] = key; }
#pragma unroll
    for (; n < 32; ++n) c[n] = 0u;
}

typedef short bf16x8_t __attribute__((ext_vector_type(8)));
typedef float f32x16 __attribute__((ext_vector_type(16)));
__device__ __forceinline__ float gelu_erf(float a) { return 0.5f * a * (1.f + erff(a * 0.70710678118654752f)); }


typedef __attribute__((address_space(3))) bf16 lbf16;

__device__ __forceinline__ f32x16 mm32(bf16x8_t a, bf16x8_t b, f32x16 c) { return __builtin_amdgcn_mfma_f32_32x32x16_bf16(a, b, c, 0, 0, 0); }
__device__ __forceinline__ bf16x8_t frag_from_u32x4(unsigned x, unsigned y, unsigned z, unsigned w) { typedef unsigned u4 __attribute__((ext_vector_type(4))); u4 t = {x, y, z, w}; return __builtin_bit_cast(bf16x8_t, t); }
template <int S> __device__ __forceinline__ bf16x8_t accop(const f32x16& z) {
    return frag_from_u32x4(cvtpk(z[8 * S], z[8 * S + 1]), cvtpk(z[8 * S + 2], z[8 * S + 3]), cvtpk(z[8 * S + 4], z[8 * S + 5]), cvtpk(z[8 * S + 6], z[8 * S + 7])); }
template <int S> __device__ __forceinline__ bf16x8_t ldpermcol(const lbf16* a, int col, int hh) {
    const lbf16* p = a + (16 * S + 4 * hh) * 72 + col;
    const unsigned e0 = p[0], e1 = p[72], e2 = p[144], e3 = p[216], e4 = p[8 * 72], e5 = p[9 * 72], e6 = p[10 * 72], e7 = p[11 * 72];
    return frag_from_u32x4(e0 | (e1 << 16), e2 | (e3 << 16), e4 | (e5 << 16), e6 | (e7 << 16)); }
__device__ __forceinline__ bf16x8_t ldrow(const lbf16* a, int row, int ks, int hh) { return *(const __attribute__((address_space(3))) bf16x8_t*)(a + row * 72 + ks * 16 + 8 * hh); }
__device__ __forceinline__ int rowidx(int e, int hh) { return (e & 3) + 8 * (e >> 2) + 4 * hh; }

constexpr int CONV_S1_ROWS = 0;
constexpr int ROWB = 768;
__device__ __forceinline__ unsigned fp6code(float x, float sc) {
    const float t = fabsf(x) * sc;
    const float r = t < 16.f ? __builtin_rintf(t) : (t < 32.f ? 8.f + __builtin_rintf(t * 0.5f) : 16.f + __builtin_rintf(t * 0.25f));
    unsigned c = (unsigned)r; c = c > 31u ? 31u : c;
    return c | (x < 0.f ? 32u : 0u);
}
__device__ __forceinline__ void convert_tables_fp6(const float* pu, const float* pv, unsigned char* u8, unsigned char* v8, float* usc, float* vsc, int l, int wv, int nw, int lane, int q_lo, int q_hi) {
    for (int rr0 = q_lo + wv * 2; rr0 < q_hi; rr0 += nw * 2) {
        f32x4 v[2][4]; float m[2];
#pragma unroll
        for (int rr = 0; rr < 2; ++rr) { const int q = rr0 + rr; const size_t row = (size_t)l * NEXP + (q < NEXP ? q : q - NEXP); const float* sp_ = (q < NEXP ? pu : pv) + row * D + lane * 4;
#pragma unroll
            for (int k = 0; k < 4; ++k) v[rr][k] = *(const f32x4*)(sp_ + k * 256); }
#pragma unroll
        for (int rr = 0; rr < 2; ++rr) { float mm = 0.f;
#pragma unroll
            for (int k = 0; k < 4; ++k) mm = fmaxf(fmaxf(mm, fmaxf(fabsf(v[rr][k].x), fabsf(v[rr][k].y))), fmaxf(fabsf(v[rr][k].z), fabsf(v[rr][k].w)));
#pragma unroll
            for (int o = 1; o < 64; o <<= 1) mm = fmaxf(mm, shflx(mm, lane, o));
            m[rr] = mm; }
        { typedef float f32x16_t __attribute__((ext_vector_type(16))); typedef unsigned u32x6_t __attribute__((ext_vector_type(6)));
          const float sc0 = m[0] > 0.f ? 7.5f / m[0] : 1.f, sc1 = m[1] > 0.f ? 7.5f / m[1] : 1.f; f32x16_t pa, pb;
#pragma unroll
          for (int k = 0; k < 4; ++k) {
              pa[k * 2] = v[0][k].x * sc0; pb[k * 2] = v[0][k].y * sc0; pa[k * 2 + 1] = v[0][k].z * sc0; pb[k * 2 + 1] = v[0][k].w * sc0;
              pa[8 + k * 2] = v[1][k].x * sc1; pb[8 + k * 2] = v[1][k].y * sc1; pa[8 + k * 2 + 1] = v[1][k].z * sc1; pb[8 + k * 2 + 1] = v[1][k].w * sc1; }
          const u32x6_t pk = __builtin_amdgcn_cvt_scalef32_2xpk16_fp6_f32(pa, pb, 1.0f);
#pragma unroll
          for (int rr = 0; rr < 2; ++rr) { const int q = rr0 + rr; const size_t row = (size_t)l * NEXP + (q < NEXP ? q : q - NEXP);
              unsigned* op = (unsigned*)((q < NEXP ? u8 : v8) + row * ROWB + lane * 12);
              op[0] = pk[rr * 3]; op[1] = pk[rr * 3 + 1]; op[2] = pk[rr * 3 + 2];
              if (lane == 0) (q < NEXP ? usc : vsc)[row] = m[rr] > 0.f ? m[rr] * (1.f / 7.5f) : 1.f; } }
    }
}

__global__ void __launch_bounds__(NTHR, 2) mega(Args args) {
    extern __shared__ __attribute__((aligned(16))) unsigned char lds_raw[];
    LAS unsigned char* lds = (LAS unsigned char*)lds_raw;
    const int G = gridDim.x, bx = blockIdx.x, NGW = G * NWAVES;
    const int wave0 = __builtin_amdgcn_readfirstlane((int)threadIdx.x >> 6);
    typedef const unsigned char __attribute__((address_space(4))) kbyte;
#define PHASE_IDS int tid; asm volatile("v_mbcnt_lo_u32_b32 %0, -1, 0\n\tv_mbcnt_hi_u32_b32 %0, -1, %0" : "=v"(tid)); tid += wave0 * 64;     const int lane = tid & 63, wave = __builtin_amdgcn_readfirstlane(tid >> 6), gw = bx * NWAVES + wave; (void)lane; (void)gw; \
    kbyte* kp = (kbyte*)__builtin_amdgcn_kernarg_segment_ptr(); asm volatile("" : "+s"(kp)); \
    unsigned char* const ws = (unsigned char*)*(__attribute__((address_space(1))) unsigned char* const __attribute__((address_space(4)))*)(kp + 31 * 8); float* const X = (float*)*(__attribute__((address_space(1))) float* const __attribute__((address_space(4)))*)(kp + 30 * 8); (void)ws; (void)X;
#define INP(i) ((const float*)(*(const __attribute__((address_space(1))) float* const __attribute__((address_space(4)))*)(kp + (i) * 8)))
#define MOD ((float*)(ws + WS_MOD))
#define H ((bf16*)(ws + WS_H))
#define PROJ ((bf16*)(ws + WS_PROJ))
#define Q ((bf16*)(ws + WS_Q))
#define MIX ((bf16*)(ws + WS_MIX))
#define Rb ((bf16*)(ws + WS_R))
#define Kb ((bf16*)(ws + WS_K))
#define V0 ((bf16*)(ws + WS_V0))
#define V1 ((bf16*)(ws + WS_V1))
#define KKb ((bf16*)(ws + WS_KK))
#define Bb ((bf16*)(ws + WS_B))
#define Gb ((bf16*)(ws + WS_G))
#define BGb ((bf16*)(ws + WS_BG))
#define Wd ((float*)(ws + WS_W))
#define Y ((float*)(ws + WS_Y))
#define QB ((float*)(ws + WS_QB))
#define POOLIN ((bf16*)(ws + WS_QB))
#define SH ((float*)(ws + WS_SH))
#define SSQ ((unsigned long long*)(ws + WS_SH))
#define CVEC ((float*)(ws + WS_SH + 512 * 1024))
#define S2V ((float*)(ws + WS_SH + 640 * 1024))
#define XB2 ((bf16*)(ws + WS_R))
#define WUPT ((bf16*)(ws + WS_LORA))
#define AUPT ((bf16*)(ws + WS_LORA + 131072))
#define GUPT ((bf16*)(ws + WS_LORA + 262144))
#define VUPT ((bf16*)(ws + WS_LORA + 524288))
#define PWT ((bf16*)(ws + WS_LORA + 655360))
#define INVN ((float*)(ws + WS_INVN))
#define BSUM ((float*)(ws + WS_BSUM))
#define SCN ((unsigned char*)(ws + WS_SCN))
#define IDX ((int*)(ws + WS_IDX))
#define GATE ((float*)(ws + WS_GATE))
#define WinT ((bf16*)(ws + WS_WIN_T))
#define WoutT ((bf16*)(ws + WS_WOUT_T))
#define PqT ((bf16*)(ws + WS_PQ_T))
#define KEYS ((bf16*)(ws + WS_KEYS))
#define U8 ((unsigned char*)(ws + WS_U))
#define V8 ((unsigned char*)(ws + WS_V))
#define USc ((float*)(ws + WS_US))
#define VSc ((float*)(ws + WS_VS))
    const int lo = args.ph_lo, hi = args.ph_hi;
    { volatile LAS unsigned* misc = (volatile LAS unsigned*)(lds + LDS_BYTES - 64); if (threadIdx.x < 4) misc[threadIdx.x] = 0u; __syncthreads(); }
    const XcdBarrier xbar = xcd_barrier_post((unsigned*)(args.ws) + 4096, (volatile LAS unsigned*)(lds + LDS_BYTES - 64));
#define IN(k) (lo <= (k) && (k) < hi)
#ifndef REP_PHASE
#define REP_PHASE (-1)
#endif
#define REPS(k) ((k) == REP_PHASE ? 3 : 1)
#define SEAM(k) do { if (IN(k) && IN((k) + 1)) { if ((k) == 0) cg::this_grid().sync(); else { XcdBarrier xb_ = xbar; asm volatile("" : "+s"(xb_.bar)); if ((k) == 1) xcd_barrier<true>(xb_); else xcd_barrier<false>(xb_); } } } while (0)

    if (IN(0)) { PHASE_IDS
        { unsigned long long* z = SSQ; for (int i = bx * NTHR + tid; i < 2 * T; i += G * NTHR) z[i] = 0ull; }
        { LAS float* ca = (LAS float*)lds; LAS float* red = (LAS float*)(lds + 16384);
          const float* c = INP(1); const float* ada_w = INP(2); const float* ada_b = INP(3);
          bool have = false;
          for (int it = bx; it < 96; it += G) {
              if (!have) { for (int i = tid; i < BATCH * D; i += NTHR) { const float v = c[i]; ca[i] = v / (1.f + expf(-v)); } have = true; __syncthreads(); }
              const int l = it / 48, n = (it % 48) * 128 + (tid & 127), kq = tid >> 7;
              const float* w = ada_w + (size_t)l * D * 6 * D + (size_t)(kq * 256) * 6 * D + n;
              float a0 = 0.f, a1 = 0.f, a2 = 0.f, a3 = 0.f;
#pragma unroll 32
              for (int k = 0; k < 256; ++k) { const float wv = w[(size_t)k * 6 * D]; const int kk = kq * 256 + k; a0 += ca[kk] * wv; a1 += ca[D + kk] * wv; a2 += ca[2 * D + kk] * wv; a3 += ca[3 * D + kk] * wv; }
              red[(kq * 4 + 0) * 128 + (tid & 127)] = a0; red[(kq * 4 + 1) * 128 + (tid & 127)] = a1; red[(kq * 4 + 2) * 128 + (tid & 127)] = a2; red[(kq * 4 + 3) * 128 + (tid & 127)] = a3;
              __syncthreads();
              { const int b = tid >> 7, col = tid & 127, nn = (it % 48) * 128 + col;
                const float s = red[(0 * 4 + b) * 128 + col] + red[(1 * 4 + b) * 128 + col] + red[(2 * 4 + b) * 128 + col] + red[(3 * 4 + b) * 128 + col];
                MOD[(size_t)l * BATCH * 6 * D + (size_t)b * 6 * D + nn] = s + ada_b[l * 6 * D + nn]; }
              __syncthreads();
          }
          __syncthreads(); }
        { LAS float* scr = (LAS float*)(lds + wave * 16384);
          constexpr int I_IN = (D / 64) * (IN_COLS / 32), I_VR = (D / 64) * (MVL / 32), I_OUT = (D / 64) * (D / 32), I_PQ = (D / 64) * (PH * PQ / 32);
          constexpr int NIT = 2 * I_IN + I_VR + 2 * I_OUT + 2 * I_PQ;
          for (int it = gw; it < NIT; it += NGW) { int r = it;
              if (r < 2 * I_IN) { const int l = r / I_IN; p0_transpose_item(INP(5) + (size_t)l * D * IN_COLS, D, IN_COLS, WinT + (size_t)l * LDP * D, 0, scr, r % I_IN, lane); continue; } r -= 2 * I_IN;
              if (r < I_VR) { p0_transpose_item(INP(12), D, MVL, WinT + (size_t)1 * LDP * D, IN_COLS, scr, r, lane); continue; } r -= I_VR;
              if (r < 2 * I_OUT) { const int l = r / I_OUT; p0_transpose_item(INP(23) + (size_t)l * D * D, D, D, WoutT + (size_t)l * D * D, 0, scr, r % I_OUT, lane); continue; } r -= 2 * I_OUT;
              { const int l = r / I_PQ; p0_transpose_item(INP(25) + (size_t)l * D * PH * PQ, D, PH * PQ, PqT + (size_t)l * PH * PQ * D, 0, scr, r % I_PQ, lane); } }
          for (int it = gw; it < 2 * 16 + 2 * 16 + 2 * 32; it += NGW) { int r = it;
              if (r < 32) { const int l = r / 16; p0_transpose_item(INP(8) + (size_t)l * DL * RW, DL, RW, WUPT + (size_t)l * RW * DL, 0, scr, r % 16, lane); continue; } r -= 32;
              if (r < 32) { const int l = r / 16; p0_transpose_item(INP(10) + (size_t)l * AL * RW, AL, RW, AUPT + (size_t)l * RW * AL, 0, scr, r % 16, lane); continue; } r -= 32;
              { const int l = r / 32; p0_transpose_item(INP(11) + (size_t)l * GL * RW, GL, RW, GUPT + (size_t)l * RW * GL, 0, scr, r % 32, lane); } }
          { const float* vu = INP(15); for (int e = bx * NTHR + tid; e < MVL * RW; e += G * NTHR) { const int n = e >> 5, k = e & 31; VUPT[e] = f2bf(vu[k * RW + n]); } }
          for (int it = gw; it < 8 * 8; it += NGW) p0_transpose_item(INP(21) + (size_t)(it >> 3) * PG * PG, PG, PG, PWT + (size_t)(it >> 3) * PG * PG, 0, scr, it & 7, lane);
        }
        { const size_t gt = (size_t)bx * NTHR + tid, NT = (size_t)G * NTHR;
          constexpr size_t NK8 = (size_t)2 * PH * 2 * NKEYS * PHALF / 8;
          const float* src = INP(26); bf16* dst = KEYS;
          for (size_t i = gt; i < NK8; i += NT) {
              const f32x4 a = *(const f32x4*)(src + i * 8), b = *(const f32x4*)(src + i * 8 + 4);
              u32x4 o; o.x = pk2(a.x, a.y); o.y = pk2(a.z, a.w); o.z = pk2(b.x, b.y); o.w = pk2(b.z, b.w); *(u32x4*)(dst + i * 8) = o; }
        }
    }
    SEAM(0);

#pragma unroll
    for (int l = 0; l < DEPTH; ++l) {
        const int pb = 1 + 10 * l;
#define modl (MOD + (size_t)l * BATCH * 6 * D)
#define xin (l == 0 ? INP(0) : (const float*)X)
        if (l == 0 && IN(pb + 0)) { PHASE_IDS const float* gamma = INP(4) + l * D;
            for (int row = gw; row < T; row += NGW) { const int b = row / SEQ; norm_mod_row(xin + (size_t)row * D, gamma, modl + (size_t)b * 6 * D, modl + (size_t)b * 6 * D + D, H + (size_t)row * D, lane); } }
        SEAM(pb + 0);
        if (IN(pb + 1)) { PHASE_IDS const int N1 = l == 0 ? IN_COLS : LDP;
            pg8::Gemm g{H, WinT + (size_t)l * LDP * D, T, N1, D}; pg8::StaticOrder S; S.init(T, N1, G, bx);
            pg8::EpiProj E{PROJ, LDP, POOLIN, RWKV_COLS, PW};
            pg8::gemm_phase<pg8::EpiProj, pg8::StaticOrder, true, true>(lds, g, S, E, tid); }
        SEAM(pb + 1);

        if (IN(pb + 2)) { PHASE_IDS
            constexpr int LST = 296;
            LAS bf16* lin = (LAS bf16*)lds;
            const float* mu = INP(6) + l * RWKV_COLS; const float* vmu = INP(13);
            const float* w0p = INP(7) + l * RW; const float* a0p = INP(9) + l * RW; const float* kkp = INP(16) + l * RW; const float* kap = INP(17) + l * RW; const float* rkp = INP(18) + l * RW; const float* v0p = INP(14);
            const bf16* wupT = WUPT + (size_t)l * RW * DL; const bf16* aupT = AUPT + (size_t)l * RW * AL; const bf16* gupT = GUPT + (size_t)l * RW * GL; const bf16* vupT = VUPT;
            bf16* Vl = l == 0 ? V0 : V1;
            const int r32 = lane & 31, hh = lane >> 5, h = wave;
            for (int tile = bx; tile < T / 32; tile += G) {
                const int t0 = tile * 32;
                __syncthreads();
#pragma unroll 1
                for (int it0 = 0; it0 < 3; it0 += 2) {
                  u32x4 cu_[2], pv_[2]; f32x4 m0_[2], m1_[2];
#pragma unroll
                  for (int it = 0; it < 2; ++it) { const int c8 = tid + (it0 + it) * NTHR; const bool ok = c8 < 32 * 36; const int tok = ok ? c8 / 36 : 0, jc = ok ? c8 % 36 : 0, t = t0 + tok, sq = t % SEQ;
                      cu_[it] = (u32x4){0u, 0u, 0u, 0u}; pv_[it] = (u32x4){0u, 0u, 0u, 0u}; m0_[it] = (f32x4){0.f, 0.f, 0.f, 0.f}; m1_[it] = m0_[it];
                      if (ok && (jc < 32 || l > 0)) { const int col = jc < 32 ? 3 * RW + jc * 8 : IN_COLS + (jc - 32) * 8;
                          cu_[it] = *(const u32x4*)(PROJ + (size_t)t * LDP + col); if (sq > 0) pv_[it] = *(const u32x4*)(PROJ + (size_t)(t - 1) * LDP + col);
                          const float* mp = jc < 32 ? mu + col : vmu + (jc - 32) * 8; m0_[it] = *(const f32x4*)mp; m1_[it] = *(const f32x4*)(mp + 4); } }
#pragma unroll
                  for (int it = 0; it < 2; ++it) { const int c8 = tid + (it0 + it) * NTHR; if (c8 < 32 * 36) { const int tok = c8 / 36, jc = c8 % 36;
                      u32x4 o = {0u, 0u, 0u, 0u};
                      if (jc < 32 || l > 0) {
                          float x[8]; const unsigned cw[4] = {cu_[it].x, cu_[it].y, cu_[it].z, cu_[it].w}, pw[4] = {pv_[it].x, pv_[it].y, pv_[it].z, pv_[it].w}; const float mm[8] = {m0_[it].x, m0_[it].y, m0_[it].z, m0_[it].w, m1_[it].x, m1_[it].y, m1_[it].z, m1_[it].w};
#pragma unroll
                          for (int i = 0; i < 4; ++i) { const float c0 = __uint_as_float(cw[i] << 16), c1 = __uint_as_float(cw[i] & 0xffff0000u), p0 = __uint_as_float(pw[i] << 16), p1 = __uint_as_float(pw[i] & 0xffff0000u);
                              x[2 * i] = c0 + (p0 - c0) * mm[2 * i]; x[2 * i + 1] = c1 + (p1 - c1) * mm[2 * i + 1]; }
                          if (jc < 8) {
#pragma unroll
                              for (int i = 0; i < 8; ++i) { const float e2 = __expf(-2.f * fabsf(x[i])); const float th = (1.f - e2) * __builtin_amdgcn_rcpf(1.f + e2); x[i] = x[i] < 0.f ? -th : th; } }
                          else if (jc >= 16 && jc < 32) {
#pragma unroll
                              for (int i = 0; i < 8; ++i) x[i] = __builtin_amdgcn_rcpf(1.f + __expf(-x[i])); }
                          o.x = pk2(x[0], x[1]); o.y = pk2(x[2], x[3]); o.z = pk2(x[4], x[5]); o.w = pk2(x[6], x[7]);
                      }
                      *(LAS u32x4*)(lin + tok * LST + jc * 8) = o; } } }
                __syncthreads();
                const bool first = (t0 % SEQ) == 0;
                lbf16* tin = (lbf16*)(lds + 19456 + wave * 14336);
                { u32x4 iq[13]; int ql_; asm volatile("v_mbcnt_lo_u32_b32 %0, -1, 0\n\tv_mbcnt_hi_u32_b32 %0, -1, %0" : "=v"(ql_));
#pragma unroll
                  for (int i = 0; i < 13; ++i) { const int q = ql_ + 64 * i; iq[i] = (u32x4){0u, 0u, 0u, 0u};
                      if (q < 792) { const int arr = q / 264, rem = q - arr * 264, row = rem >> 3, cc = rem & 7;
                          if (!(first && row == 0)) iq[i] = *(const u32x4*)(PROJ + (size_t)(t0 - 1 + row) * LDP + arr * RW + h * HS + cc * 8); } }
#pragma unroll
                  for (int i = 0; i < 13; ++i) { const int q = ql_ + 64 * i; if (q < 792) { const int arr = q / 264, rem = q - arr * 264, row = rem >> 3, cc = rem & 7;
                      *(__attribute__((address_space(3))) u32x4*)(tin + arr * 2376 + row * 72 + cc * 8) = iq[i]; } } }
                __builtin_amdgcn_wave_barrier(); asm volatile("s_waitcnt lgkmcnt(0)" ::: "memory");
                float ssq[16], bsm[16];
#pragma unroll
                for (int e = 0; e < 16; ++e) { ssq[e] = 0.f; bsm[e] = 0.f; }
#pragma unroll 1
                for (int rt = 0; rt < 2; ++rt) {
                    f32x16 accW, accA, accG, accV;
#pragma unroll
                    for (int e = 0; e < 16; ++e) { accW[e] = 0.f; accA[e] = 0.f; accG[e] = 0.f; accV[e] = 0.f; }
                    int c = h * HS + rt * 32 + r32;
int hh8 = 8 * hh; asm volatile("" : "+v"(c), "+v"(hh8));
                    const LAS bf16* lrow = lin + r32 * LST + 8 * hh;
                    { bf16x8_t wf[18];
#pragma unroll
                      for (int ks = 0; ks < 4; ++ks) { wf[ks] = *(const bf16x8_t*)(wupT + (size_t)c * DL + ks * 16 + hh8); wf[4 + ks] = *(const bf16x8_t*)(aupT + (size_t)c * AL + ks * 16 + hh8); }
#pragma unroll
                      for (int ks = 0; ks < 8; ++ks) wf[8 + ks] = *(const bf16x8_t*)(gupT + (size_t)c * GL + ks * 16 + hh8);
                      wf[16] = bf16x8_t{}; wf[17] = bf16x8_t{};
                      if (l > 0) { wf[16] = *(const bf16x8_t*)(vupT + (size_t)c * MVL + hh8); wf[17] = *(const bf16x8_t*)(vupT + (size_t)c * MVL + 16 + hh8); }
#pragma unroll
                      for (int ks = 0; ks < 4; ++ks) { accW = __builtin_amdgcn_mfma_f32_32x32x16_bf16(*(const LAS bf16x8_t*)(lrow + ks * 16), wf[ks], accW, 0, 0, 0);
                                                       accA = __builtin_amdgcn_mfma_f32_32x32x16_bf16(*(const LAS bf16x8_t*)(lrow + 64 + ks * 16), wf[4 + ks], accA, 0, 0, 0); }
#pragma unroll
                      for (int ks = 0; ks < 8; ++ks) accG = __builtin_amdgcn_mfma_f32_32x32x16_bf16(*(const LAS bf16x8_t*)(lrow + 128 + ks * 16), wf[8 + ks], accG, 0, 0, 0);
                      if (l > 0) {
#pragma unroll
                          for (int ks = 0; ks < 2; ++ks) accV = __builtin_amdgcn_mfma_f32_32x32x16_bf16(*(const LAS bf16x8_t*)(lrow + 256 + ks * 16), wf[16 + ks], accV, 0, 0, 0); } }
                    const float mur = mu[c], muk = mu[RW + c], muv = mu[2 * RW + c], w0c = w0p[c], a0c = a0p[c], kkc = kkp[c], kac = kap[c], rkc = rkp[c];
                    const float v0c = l > 0 ? v0p[c] : 0.f;
#pragma unroll
                    for (int eb = 0; eb < 16; eb += 4) {
                        bf16 lr[4], lk[4], lv[4], lrp[4], lkp[4], lvp[4], lvf[4];
#pragma unroll
                        for (int i = 0; i < 4; ++i) { const int e = eb + i; const int tok = (e & 3) + 8 * (e >> 2) + 4 * hh, t = t0 + tok; const int ci = rt * 32 + r32;
                            lr[i] = tin[(tok + 1) * 72 + ci]; lk[i] = tin[2376 + (tok + 1) * 72 + ci]; lv[i] = tin[2 * 2376 + (tok + 1) * 72 + ci];
                            lrp[i] = tin[tok * 72 + ci]; lkp[i] = tin[2376 + tok * 72 + ci]; lvp[i] = tin[2 * 2376 + tok * 72 + ci];
                            lvf[i] = l > 0 ? V0[(size_t)t * RW + c] : (bf16)0; }
                        __builtin_amdgcn_sched_barrier(0);
#pragma unroll
                        for (int i = 0; i < 4; ++i) { const int e = eb + i; const int tok = (e & 3) + 8 * (e >> 2) + 4 * hh, t = t0 + tok; const size_t o = (size_t)t * RW + c;
                            float r = bf2f(lr[i]), k = bf2f(lk[i]), v = bf2f(lv[i]);
                            r += (bf2f(lrp[i]) - r) * mur; k += (bf2f(lkp[i]) - k) * muk; v += (bf2f(lvp[i]) - v) * muv;
                            const float z = -(w0c + accW[e]); const float sp = fmaxf(z, 0.f) + __logf(1.f + __expf(-fabsf(z)));
                            const float decay = __expf(-__expf(-sp - 0.5f));
                            const float a = __builtin_amdgcn_rcpf(1.f + __expf(-(a0c + accA[e]))); const float g = accG[e];
                            if (l > 0) { const float vfv = bf2f(lvf[i]); v = v + (vfv - v) * __builtin_amdgcn_rcpf(1.f + __expf(-(v0c + accV[e]))); }
                            const float kk = k * kkc; const float k2 = k * (1.f + (a - 1.f) * kac);
                            ssq[e] += kk * kk; bsm[e] += r * k2 * rkc;
                            { const unsigned p0_ = cvtpk(r, k2), p1_ = cvtpk(v, kk), p2_ = cvtpk(kk * a, g), p3_ = cvtpk(v * g, 0.f);
                              Rb[o] = (bf16)p0_; Kb[o] = (bf16)(p0_ >> 16); Vl[o] = (bf16)p1_; KKb[o] = (bf16)(p1_ >> 16); Bb[o] = (bf16)p2_; Gb[o] = (bf16)(p2_ >> 16); BGb[o] = (bf16)p3_; Wd[o] = decay; }
                        }
                    }
                }
#pragma unroll
                for (int e = 0; e < 16; ++e) { const int ln_ = r32 | (hh << 5); float a_ = red16(ssq[e]), b_ = red16(bsm[e]); a_ += shflx(a_, ln_, 16); b_ += shflx(b_, ln_, 16); ssq[e] = a_; bsm[e] = b_; }
                if (r32 == 0) {
#pragma unroll
                    for (int e = 0; e < 16; ++e) { const int tok = (e & 3) + 8 * (e >> 2) + 4 * hh; INVN[(size_t)(t0 + tok) * NH + h] = rsqrtf(fmaxf(ssq[e], 1e-24f)); BSUM[(size_t)(t0 + tok) * NH + h] = bsm[e]; } }
            }
        }
        if (IN(pb + 2) && IN(pb + 3)) { asm volatile("s_waitcnt vmcnt(0)" ::: "memory"); __syncthreads(); }

        if (IN(pb + 3)) { PHASE_IDS
            const bf16* Vl = l == 0 ? V0 : V1;
            const int r32 = lane & 31, hh = lane >> 5;
            if (wave < 6) {
                lbf16* At = (lbf16*)(lds + wave * 23552); lbf16* Bt = At + 2304; lbf16* Kt = Bt + 2304; lbf16* Rt = Kt + 2304; lbf16* Vv = Rt + 2304;
                LAS float* PCs = (LAS float*)(lds + wave * 23552 + 23040);
                const int ntl = bx < T / 32 ? (T / 32 - bx + G - 1) / G : 0;
                for (int q = wave; q < ntl * NH; q += 6) {
                    const int tile = bx + (q >> 3) * G, h = q & 7, b = tile >> 7, chunk = tile & 127, bh = b * NH + h, item = bh * (SEQ / 32) + chunk; const size_t t0 = (size_t)tile * 32;
                    __builtin_amdgcn_wave_barrier(); asm volatile("s_waitcnt lgkmcnt(0)" ::: "memory");
                    {
                      const int tk = lane >> 3, part = lane & 7;
                      u32x4 qr[4], qk[4], qv[4], qkk[4], qb[4]; f32x4 qw0[4], qw1[4]; float qin[4];
#pragma unroll
                      for (int p4 = 0; p4 < 4; ++p4) { const size_t o = (t0 + p4 * 8 + tk) * RW + h * HS + part * 8;
                          qr[p4] = *(const u32x4*)(Rb + o); qk[p4] = *(const u32x4*)(Kb + o); qv[p4] = *(const u32x4*)(Vl + o); qkk[p4] = *(const u32x4*)(KKb + o); qb[p4] = *(const u32x4*)(Bb + o);
                          qw0[p4] = *(const f32x4*)(Wd + o); qw1[p4] = *(const f32x4*)(Wd + o + 4); qin[p4] = INVN[(t0 + p4 * 8 + tk) * NH + h]; }
                      LAS float* Pl = (LAS float*)At;
#pragma unroll
                      for (int p4 = 0; p4 < 4; ++p4) { *(LAS f32x4*)(Pl + (p4 * 8 + tk) * 64 + part * 8) = qw0[p4]; *(LAS f32x4*)(Pl + (p4 * 8 + tk) * 64 + part * 8 + 4) = qw1[p4]; }
                      __builtin_amdgcn_wave_barrier(); asm volatile("s_waitcnt lgkmcnt(0)" ::: "memory");
                      { float P = 1.f;
#pragma unroll 8
                        for (int c = 0; c < 32; ++c) { P *= Pl[c * 64 + lane]; Pl[c * 64 + lane] = P; }
                        PCs[lane] = P; }
                      __builtin_amdgcn_wave_barrier(); asm volatile("s_waitcnt lgkmcnt(0)" ::: "memory");
                      u32x4 oa[4], orr[4], ob_[4], ok_[4];
#pragma unroll
                      for (int p4 = 0; p4 < 4; ++p4) { const int c = p4 * 8 + tk;
                          const f32x4 pa = *(const LAS f32x4*)(Pl + c * 64 + part * 8), pb2 = *(const LAS f32x4*)(Pl + c * 64 + part * 8 + 4);
                          f32x4 ma = {1.f, 1.f, 1.f, 1.f}, mb = ma; if (c > 0) { ma = *(const LAS f32x4*)(Pl + (c - 1) * 64 + part * 8); mb = *(const LAS f32x4*)(Pl + (c - 1) * 64 + part * 8 + 4); }
                          const float Pc[8] = {pa.x, pa.y, pa.z, pa.w, pb2.x, pb2.y, pb2.z, pb2.w}, Pm[8] = {ma.x, ma.y, ma.z, ma.w, mb.x, mb.y, mb.z, mb.w};
                          const unsigned rw_[4] = {qr[p4].x, qr[p4].y, qr[p4].z, qr[p4].w}, kw_[4] = {qk[p4].x, qk[p4].y, qk[p4].z, qk[p4].w}, kkw[4] = {qkk[p4].x, qkk[p4].y, qkk[p4].z, qkk[p4].w}, bw_[4] = {qb[p4].x, qb[p4].y, qb[p4].z, qb[p4].w};
                          unsigned xa[4], xr[4], xb[4], xk[4]; const float inv = qin[p4];
#pragma unroll
                          for (int i = 0; i < 4; ++i) { const float ip0 = __builtin_amdgcn_rcpf(Pc[2 * i]), ip1 = __builtin_amdgcn_rcpf(Pc[2 * i + 1]);
                              xa[i] = pk2(-__uint_as_float(kkw[i] << 16) * inv * Pm[2 * i], -__uint_as_float(kkw[i] & 0xffff0000u) * inv * Pm[2 * i + 1]);
                              xr[i] = pk2(__uint_as_float(rw_[i] << 16) * Pc[2 * i], __uint_as_float(rw_[i] & 0xffff0000u) * Pc[2 * i + 1]);
                              xb[i] = pk2(__uint_as_float(bw_[i] << 16) * inv * ip0, __uint_as_float(bw_[i] & 0xffff0000u) * inv * ip1);
                              xk[i] = pk2(__uint_as_float(kw_[i] << 16) * ip0, __uint_as_float(kw_[i] & 0xffff0000u) * ip1); }
                          oa[p4] = (u32x4){xa[0], xa[1], xa[2], xa[3]}; orr[p4] = (u32x4){xr[0], xr[1], xr[2], xr[3]}; ob_[p4] = (u32x4){xb[0], xb[1], xb[2], xb[3]}; ok_[p4] = (u32x4){xk[0], xk[1], xk[2], xk[3]}; }
                      __builtin_amdgcn_wave_barrier(); asm volatile("s_waitcnt lgkmcnt(0)" ::: "memory");
#pragma unroll
                      for (int p4 = 0; p4 < 4; ++p4) { const int c = p4 * 8 + tk, o = c * 72 + part * 8;
                          *(__attribute__((address_space(3))) u32x4*)(At + o) = oa[p4]; *(__attribute__((address_space(3))) u32x4*)(Rt + o) = orr[p4]; *(__attribute__((address_space(3))) u32x4*)(Bt + o) = ob_[p4];
                          *(__attribute__((address_space(3))) u32x4*)(Kt + o) = ok_[p4]; *(__attribute__((address_space(3))) u32x4*)(Vv + o) = qv[p4]; } }
                    __builtin_amdgcn_wave_barrier(); asm volatile("s_waitcnt lgkmcnt(0)" ::: "memory");
                    const f32x16 zero16 = {0.f, 0.f, 0.f, 0.f, 0.f, 0.f, 0.f, 0.f, 0.f, 0.f, 0.f, 0.f, 0.f, 0.f, 0.f, 0.f};
                    f32x16 X = zero16, Yt = zero16;
#pragma unroll
                    for (int ks = 0; ks < 4; ++ks) { const bf16x8_t fa = ldrow(At, r32, ks, hh), fb = ldrow(Bt, r32, ks, hh); X = mm32(fa, fb, X); Yt = mm32(fb, fa, Yt); }
#pragma unroll
                    for (int e = 0; e < 16; ++e) { const int ri = rowidx(e, hh); X[e] = (r32 < ri) ? X[e] : 0.f; Yt[e] = (ri < r32) ? Yt[e] : 0.f; }
                    f32x16 TY = Yt;
#pragma unroll
                    for (int e = 0; e < 16; ++e) TY[e] += (rowidx(e, hh) == r32) ? 1.f : 0.f;
#pragma unroll 1
                    for (int it = 0; it < 4; ++it) {
                        const bf16x8_t x0 = accop<0>(X), x1 = accop<1>(X), y0 = accop<0>(Yt), y1 = accop<1>(Yt);
                        f32x16 Xn = mm32(y0, x0, zero16); Xn = mm32(y1, x1, Xn);
                        f32x16 Yn = mm32(x0, y0, zero16); Yn = mm32(x1, y1, Yn);
                        X = Xn; Yt = Yn;
                        const bf16x8_t p0 = accop<0>(X), p1 = accop<1>(X), t0_ = accop<0>(TY), t1_ = accop<1>(TY);
                        TY = mm32(p0, t0_, TY); TY = mm32(p1, t1_, TY);
                    }
                    const bf16x8_t ty0 = accop<0>(TY), ty1 = accop<1>(TY);
                    unsigned char* rec = SCN + (size_t)item * 24576;
                    const bf16x8_t v00 = ldpermcol<0>(Vv, r32, hh), v01 = ldpermcol<1>(Vv, r32, hh), v10 = ldpermcol<0>(Vv, 32 + r32, hh), v11 = ldpermcol<1>(Vv, 32 + r32, hh);
                    f32x16 U0a, U0b;
                    { f32x16 G2T = zero16;
#pragma unroll
                      for (int ks = 0; ks < 4; ++ks) G2T = mm32(ldrow(Kt, r32, ks, hh), ldrow(At, r32, ks, hh), G2T);
#pragma unroll
                      for (int e = 0; e < 16; ++e) G2T[e] = (rowidx(e, hh) < r32) ? G2T[e] : 0.f;
                      const bf16x8_t g0 = accop<0>(G2T), g1 = accop<1>(G2T);
                      f32x16 Za = mm32(g0, v00, zero16); Za = mm32(g1, v01, Za); f32x16 Zb = mm32(g0, v10, zero16); Zb = mm32(g1, v11, Zb);
                      U0a = mm32(ty0, accop<0>(Za), zero16); U0a = mm32(ty1, accop<1>(Za), U0a); U0b = mm32(ty0, accop<0>(Zb), zero16); U0b = mm32(ty1, accop<1>(Zb), U0b); }
                    const bf16x8_t ua0 = accop<0>(U0a), ua1 = accop<1>(U0a), ub0 = accop<0>(U0b), ub1 = accop<1>(U0b);
                    f32x16 G3T = zero16;
                    { f32x16 G4T = zero16;
#pragma unroll
                      for (int ks = 0; ks < 4; ++ks) { const bf16x8_t fr = ldrow(Rt, r32, ks, hh); G3T = mm32(ldrow(Bt, r32, ks, hh), fr, G3T); G4T = mm32(ldrow(Kt, r32, ks, hh), fr, G4T); }
#pragma unroll
                      for (int e = 0; e < 16; ++e) { const bool keep = rowidx(e, hh) <= r32; G3T[e] = keep ? G3T[e] : 0.f; G4T[e] = keep ? G4T[e] : 0.f; }
                      const bf16x8_t g30 = accop<0>(G3T), g31 = accop<1>(G3T), g40 = accop<0>(G4T), g41 = accop<1>(G4T);
                      f32x16 Ya = mm32(g30, ua0, zero16); Ya = mm32(g31, ua1, Ya); Ya = mm32(g40, v00, Ya); Ya = mm32(g41, v01, Ya);
                      f32x16 Yb = mm32(g30, ub0, zero16); Yb = mm32(g31, ub1, Yb); Yb = mm32(g40, v10, Yb); Yb = mm32(g41, v11, Yb);
                      u32x4 o0, o1;
                      o0.x = cvtpk(Ya[0], Ya[1]); o0.y = cvtpk(Ya[2], Ya[3]); o0.z = cvtpk(Ya[4], Ya[5]); o0.w = cvtpk(Ya[6], Ya[7]);
                      o1.x = cvtpk(Ya[8], Ya[9]); o1.y = cvtpk(Ya[10], Ya[11]); o1.z = cvtpk(Ya[12], Ya[13]); o1.w = cvtpk(Ya[14], Ya[15]);
                      *(u32x4*)(rec + 12288 + 4096 + lane * 32) = o0; *(u32x4*)(rec + 12288 + 4096 + lane * 32 + 16) = o1;
                      o0.x = cvtpk(Yb[0], Yb[1]); o0.y = cvtpk(Yb[2], Yb[3]); o0.z = cvtpk(Yb[4], Yb[5]); o0.w = cvtpk(Yb[6], Yb[7]);
                      o1.x = cvtpk(Yb[8], Yb[9]); o1.y = cvtpk(Yb[10], Yb[11]); o1.z = cvtpk(Yb[12], Yb[13]); o1.w = cvtpk(Yb[14], Yb[15]);
                      *(u32x4*)(rec + 12288 + 6144 + 4096 + lane * 32) = o0; *(u32x4*)(rec + 12288 + 6144 + 4096 + lane * 32 + 16) = o1; }
                    f32x16 Wa0 = mm32(ty0, ldpermcol<0>(At, r32, hh), zero16); Wa0 = mm32(ty1, ldpermcol<1>(At, r32, hh), Wa0);
                    f32x16 Wa1 = mm32(ty0, ldpermcol<0>(At, 32 + r32, hh), zero16); Wa1 = mm32(ty1, ldpermcol<1>(At, 32 + r32, hh), Wa1);
                    const bf16x8_t wa00 = accop<0>(Wa0), wa01 = accop<1>(Wa0), wa10 = accop<0>(Wa1), wa11 = accop<1>(Wa1);
                    { const bf16x8_t g30 = accop<0>(G3T), g31 = accop<1>(G3T);
                      f32x16 Ra = mm32(wa00, g30, zero16); Ra = mm32(wa01, g31, Ra); f32x16 Rb_ = mm32(wa10, g30, zero16); Rb_ = mm32(wa11, g31, Rb_);
#pragma unroll
                      for (int e = 0; e < 16; ++e) { const int kr = rowidx(e, hh); Ra[e] += bf2f(Rt[r32 * 72 + kr]); Rb_[e] += bf2f(Rt[r32 * 72 + 32 + kr]); }
                      *(bf16x8_t*)(rec + 8192 + 0 * 1024 + lane * 16) = accop<0>(Ra); *(bf16x8_t*)(rec + 8192 + 1 * 1024 + lane * 16) = accop<1>(Ra);
                      *(bf16x8_t*)(rec + 8192 + 2 * 1024 + lane * 16) = accop<0>(Rb_); *(bf16x8_t*)(rec + 8192 + 3 * 1024 + lane * 16) = accop<1>(Rb_); }
                    const bf16x8_t b00 = ldpermcol<0>(Bt, r32, hh), b01 = ldpermcol<1>(Bt, r32, hh), b10 = ldpermcol<0>(Bt, 32 + r32, hh), b11 = ldpermcol<1>(Bt, 32 + r32, hh);
                    { const float pc0 = PCs[r32], pc1 = PCs[32 + r32];
#pragma unroll
                      for (int ij = 0; ij < 4; ++ij) { const int i = ij >> 1, j = ij & 1;
                          f32x16 M = mm32(i ? wa10 : wa00, j ? b10 : b00, zero16); M = mm32(i ? wa11 : wa01, j ? b11 : b01, M);
#pragma unroll
                          for (int e = 0; e < 16; ++e) { float m = M[e]; if (i == j) m += (rowidx(e, hh) == r32) ? 1.f : 0.f; M[e] = m * (j ? pc1 : pc0); }
                          *(bf16x8_t*)(rec + (ij * 2 + 0) * 1024 + lane * 16) = accop<0>(M); *(bf16x8_t*)(rec + (ij * 2 + 1) * 1024 + lane * 16) = accop<1>(M); } }
                    { const bf16x8_t k00 = ldpermcol<0>(Kt, r32, hh), k01 = ldpermcol<1>(Kt, r32, hh), k10 = ldpermcol<0>(Kt, 32 + r32, hh), k11 = ldpermcol<1>(Kt, 32 + r32, hh);
#pragma unroll
                      for (int ju = 0; ju < 4; ++ju) { const int j = ju >> 1, u = ju & 1;
                          f32x16 Dm = mm32(j ? b10 : b00, u ? ub0 : ua0, zero16); Dm = mm32(j ? b11 : b01, u ? ub1 : ua1, Dm);
                          Dm = mm32(j ? k10 : k00, u ? v10 : v00, Dm); Dm = mm32(j ? k11 : k01, u ? v11 : v01, Dm);
#pragma unroll
                          for (int e = 0; e < 16; ++e) Dm[e] *= PCs[32 * j + rowidx(e, hh)];
                          u32x4 o0, o1;
                          o0.x = cvtpk(Dm[0], Dm[1]); o0.y = cvtpk(Dm[2], Dm[3]); o0.z = cvtpk(Dm[4], Dm[5]); o0.w = cvtpk(Dm[6], Dm[7]);
                          o1.x = cvtpk(Dm[8], Dm[9]); o1.y = cvtpk(Dm[10], Dm[11]); o1.z = cvtpk(Dm[12], Dm[13]); o1.w = cvtpk(Dm[14], Dm[15]);
                          *(u32x4*)(rec + 12288 + u * 6144 + j * 2048 + lane * 32) = o0; *(u32x4*)(rec + 12288 + u * 6144 + j * 2048 + lane * 32 + 16) = o1; } }
                }
            }
        }
        { XcdBarrier xb_ = xbar; asm volatile("" : "+s"(xb_.bar)); xcd_barrier<false>(xb_); }
        if (IN(pb + 3)) { PHASE_IDS
            const int r32 = lane & 31, hh = lane >> 5;
            constexpr int SLOT = 18432, NCH = SEQ / 32, NSL = 7, AHEAD = 5;
            const bool spare = G > BATCH * NH * 2; const int cw = spare ? bx - BATCH * NH * 2 : bx, cn = spare ? G - BATCH * NH * 2 : G;
            if (cw >= 0) {
                for (int i = cw * NTHR + tid; i < BATCH * D; i += cn * NTHR) { const int b = i / D, d = i % D; S2V[(size_t)l * BATCH * D + i] = INP(24)[l * D + d] * (1.f + modl[(size_t)b * 6 * D + 4 * D + d]); }
                for (int n = cw * NWAVES + wave; n < PH * PQ; n += cn * NWAVES) {
                    const bf16* wr_ = PqT + (size_t)l * PH * PQ * D + (size_t)n * D + lane * 16; const u32x4 w0 = *(const u32x4*)wr_, w1 = *(const u32x4*)(wr_ + 8);
                    const unsigned ww[8] = {w0.x, w0.y, w0.z, w0.w, w1.x, w1.y, w1.z, w1.w};
#pragma unroll
                    for (int b = 0; b < BATCH; ++b) { const float* sh = modl + (size_t)b * 6 * D + 3 * D + lane * 16; float a = 0.f;
#pragma unroll
                        for (int q = 0; q < 4; ++q) { const f32x4 sv_ = *(const f32x4*)(sh + q * 4);
                            a += sv_.x * __uint_as_float(ww[2 * q] << 16) + sv_.y * __uint_as_float(ww[2 * q] & 0xffff0000u) + sv_.z * __uint_as_float(ww[2 * q + 1] << 16) + sv_.w * __uint_as_float(ww[2 * q + 1] & 0xffff0000u); }
                        a = wave_sum(a, lane); if (lane == 0) CVEC[(size_t)l * BATCH * PH * PQ + (size_t)b * PH * PQ + n] = a; } }
                convert_tables_fp6(INP(27), INP(28), U8, V8, USc, VSc, l, cw * NWAVES + wave, cn * NWAVES, lane, CONV_S1_ROWS, 2 * NEXP);
            {
                constexpr int DST = 520;
                int lane_p; asm volatile("v_mbcnt_lo_u32_b32 %0, -1, 0\n\tv_mbcnt_hi_u32_b32 %0, -1, %0" : "=v"(lane_p)); const int r32 = lane_p & 31, hh = lane_p >> 5, tidp = wave0 * 64 + lane_p;
                lbf16* dlb = (lbf16*)lds;
                lbf16* pin = (lbf16*)(lds + 33280);
                const int c = tidp, g = c >> 7, win = 2 << g;
                const bf16* pwt = PWT + (size_t)(l * 4 + (wave >> 1)) * PG * PG; const float* psc = INP(22) + l * PW;
                for (int tile = cw; tile < T / 32; tile += cn) {
                    const int t0 = tile * 32; const bool first = (t0 % SEQ) == 0;
                    __syncthreads();
                    { u32x4 pq[6];
#pragma unroll
                      for (int q = 0; q < 6; ++q) { const int ch = tidp + q * NTHR, row = ch >> 6, cc = ch & 63; pq[q] = (u32x4){0u, 0u, 0u, 0u};
                          if (ch < 47 * 64 && (row >= 15 || !first)) pq[q] = *(const u32x4*)(POOLIN + (size_t)(t0 - 15 + row) * PW + cc * 8); }
#pragma unroll
                      for (int q = 0; q < 6; ++q) { const int ch = tidp + q * NTHR, row = ch >> 6, cc = ch & 63; if (ch < 47 * 64) *(__attribute__((address_space(3))) u32x4*)(pin + row * 520 + cc * 8) = pq[q]; } }
                    __syncthreads();
                    const lbf16* pc = pin + c;
                    float sw = 0.f;
#pragma unroll
                    for (int j = 1; j <= 15; ++j) sw += (j < win) ? bf2f(pc[(15 - j) * 520]) : 0.f;
                    const float invw = 1.f / (float)win;
#pragma unroll 8
                    for (int i = 0; i < 32; ++i) {
                        const float cur = bf2f(pc[(15 + i) * 520]);
                        sw += cur;
                        const float inv = (first && i < 15) ? 1.f / (float)min(i + 1, win) : invw;
                        dlb[i * DST + c] = f2bf(sw * inv - cur);
                        sw -= bf2f(pc[(15 + i - win + 1) * 520]);
                    }
                    __syncthreads();
                    const int gg = wave >> 1, half = wave & 1;
#pragma unroll
                    for (int ct = 0; ct < 2; ++ct) {
                        const int dd0 = half * 64 + ct * 32;
                        f32x16 acc;
#pragma unroll
                        for (int e = 0; e < 16; ++e) acc[e] = 0.f;
#pragma unroll
                        for (int ks = 0; ks < 8; ++ks) { const bf16x8_t a = *(const __attribute__((address_space(3))) bf16x8_t*)(dlb + r32 * DST + gg * PG + ks * 16 + 8 * hh);
                            const bf16x8_t w = *(const bf16x8_t*)(pwt + (size_t)(dd0 + r32) * PG + ks * 16 + 8 * hh); acc = mm32(a, w, acc); }
                        const int oc = gg * PG + dd0 + r32; const float ps = psc[oc];
#pragma unroll
                        for (int e = 0; e < 16; ++e) MIX[(size_t)(t0 + rowidx(e, hh)) * D + RW + oc] = f2bf(acc[e] * ps);
                    }
                }
            }
            }
            for (int un = bx; un < BATCH * NH * 2; un += G) {
                const int bh = un >> 1, u = un & 1, b = bh >> 3, h = bh & 7;
                __syncthreads();
                const unsigned char* recs = SCN + (size_t)bh * NCH * 24576;
                const int lw = wave - 2;
#define S2_DMA(chunk_) do { if (wave >= 2) { LAS unsigned char* sl = lds + ((chunk_) % NSL) * SLOT; const unsigned char* rp = recs + (size_t)(chunk_) * 24576 + lane * 16; \
                    _Pragma("unroll") for (int q_ = 0; q_ < 3; ++q_) { const int p_ = lw * 3 + q_; const int so_ = p_ < 12 ? p_ * 1024 : 12288 + u * 6144 + (p_ - 12) * 1024; \
                        __builtin_amdgcn_global_load_lds((const unsigned*)(rp + so_), (LAS unsigned*)(sl + p_ * 1024), 16, 0, 0); } } } while (0)
#pragma unroll 1
                for (int c0 = 0; c0 < AHEAD; ++c0) S2_DMA(c0);
                asm volatile("s_waitcnt vmcnt(12)" ::: "memory");
                __builtin_amdgcn_s_barrier();
                f32x16 X0, X1;
                { float z_ = 0.f; asm volatile("" : "+v"(z_));
#pragma unroll
                for (int e = 0; e < 16; ++e) { X0[e] = z_; X1[e] = z_; } }
#define S2_FRAG(off) (*(const __attribute__((address_space(3))) bf16x8_t*)(sl + (off) + lane * 16))
#define S2_UNPK(dst, off) do { const u32x4 a0 = *(const LAS u32x4*)(sl + (off) + lane * 32), a1 = *(const LAS u32x4*)(sl + (off) + lane * 32 + 16); const unsigned wv[8] = {a0.x, a0.y, a0.z, a0.w, a1.x, a1.y, a1.z, a1.w}; \
                    _Pragma("unroll") for (int q = 0; q < 8; ++q) { (dst)[2 * q] = __uint_as_float(wv[q] << 16); (dst)[2 * q + 1] = __uint_as_float(wv[q] & 0xffff0000u); } } while (0)
                LAS unsigned char* xbuf = lds + NSL * SLOT;
#define S2_YOUT(nn_) do { const LAS unsigned char* sl = lds + ((nn_) % NSL) * SLOT; const LAS unsigned char* xb_ = xbuf + ((nn_) & 1) * 4096 + lane * 16; \
                        const bf16x8_t x00 = *(const LAS bf16x8_t*)(xb_), x01 = *(const LAS bf16x8_t*)(xb_ + 1024), x10 = *(const LAS bf16x8_t*)(xb_ + 2048), x11 = *(const LAS bf16x8_t*)(xb_ + 3072); \
                        f32x16 Yc; S2_UNPK(Yc, 12288 + 4096); \
                        Yc = mm32(S2_FRAG(8192 + 0 * 1024), x00, Yc); Yc = mm32(S2_FRAG(8192 + 1 * 1024), x01, Yc); Yc = mm32(S2_FRAG(8192 + 2 * 1024), x10, Yc); Yc = mm32(S2_FRAG(8192 + 3 * 1024), x11, Yc); \
                        float* yp = Y + ((size_t)b * SEQ + (size_t)(nn_) * 32) * RW + h * HS + u * 32 + r32; \
                        _Pragma("unroll") for (int e = 0; e < 16; ++e) yp[(size_t)rowidx(e, hh) * RW] = Yc[e]; } while (0)
#pragma unroll 1
                for (int n = 0; n < NCH; ++n) {
                    if (n + AHEAD < NCH) S2_DMA(n + AHEAD);
                    if (wave == 0) {
                        const LAS unsigned char* sl = lds + (n % NSL) * SLOT;
                        const bf16x8_t x00 = accop<0>(X0), x01 = accop<1>(X0), x10 = accop<0>(X1), x11 = accop<1>(X1);
                        { LAS unsigned char* xb_ = xbuf + (n & 1) * 4096 + lane * 16; *(LAS bf16x8_t*)(xb_) = x00; *(LAS bf16x8_t*)(xb_ + 1024) = x01; *(LAS bf16x8_t*)(xb_ + 2048) = x10; *(LAS bf16x8_t*)(xb_ + 3072) = x11; }
                        f32x16 N0, N1;
                        S2_UNPK(N0, 12288); S2_UNPK(N1, 12288 + 2048);
                        N0 = mm32(S2_FRAG((0 * 2 + 0) * 1024), x00, N0); N1 = mm32(S2_FRAG((1 * 2 + 0) * 1024), x00, N1); N0 = mm32(S2_FRAG((0 * 2 + 1) * 1024), x01, N0); N1 = mm32(S2_FRAG((1 * 2 + 1) * 1024), x01, N1);
                        N0 = mm32(S2_FRAG((2 * 2 + 0) * 1024), x10, N0); N1 = mm32(S2_FRAG((3 * 2 + 0) * 1024), x10, N1); N0 = mm32(S2_FRAG((2 * 2 + 1) * 1024), x11, N0); N1 = mm32(S2_FRAG((3 * 2 + 1) * 1024), x11, N1);
                        X0 = N0; X1 = N1;
                        asm volatile("s_waitcnt lgkmcnt(0)" ::: "memory");
                    } else if (wave == 1) {
                        if (n > 0) S2_YOUT(n - 1);
                        asm volatile("s_waitcnt lgkmcnt(0)" ::: "memory");
                    } else {
                        const int younger = (NCH - 1 - (n + 1)) < (AHEAD - 1) ? (NCH - 1 - (n + 1)) : (AHEAD - 1);
                        if (younger >= 5) asm volatile("s_waitcnt vmcnt(15)" ::: "memory"); else if (younger == 4) asm volatile("s_waitcnt vmcnt(12)" ::: "memory"); else if (younger == 3) asm volatile("s_waitcnt vmcnt(9)" ::: "memory");
                        else if (younger == 2) asm volatile("s_waitcnt vmcnt(6)" ::: "memory"); else if (younger == 1) asm volatile("s_waitcnt vmcnt(3)" ::: "memory"); else asm volatile("s_waitcnt vmcnt(0)" ::: "memory");
                    }
                    __builtin_amdgcn_s_barrier();
                }
                if (wave == 1) { S2_YOUT(NCH - 1); asm volatile("s_waitcnt lgkmcnt(0)" ::: "memory"); }
#undef S2_YOUT
#undef S2_FRAG
#undef S2_UNPK
#undef S2_DMA
            }
        }
        SEAM(pb + 3);

        if (IN(pb + 4)) { PHASE_IDS
            const int c8 = (tid & 63) * 8, hd = (tid & 63) >> 3, tsub = tid >> 6;
            const f32x4 lg0 = *(const f32x4*)(INP(19) + l * RW + c8), lg1 = *(const f32x4*)(INP(19) + l * RW + c8 + 4), lb0 = *(const f32x4*)(INP(20) + l * RW + c8), lb1 = *(const f32x4*)(INP(20) + l * RW + c8 + 4);
            for (int tile = bx; tile < T / 8; tile += G) {
                const int t = tile * 8 + tsub; const size_t o = (size_t)t * RW + c8;
                const f32x4 y0 = *(const f32x4*)(Y + o), y1 = *(const f32x4*)(Y + o + 4); const u32x4 gq = *(const u32x4*)(Gb + o), vq = *(const u32x4*)(BGb + o); const float bsum = BSUM[(size_t)t * NH + hd];
                float sm = (y0.x + y0.y) + (y0.z + y0.w) + (y1.x + y1.y) + (y1.z + y1.w);
                sm += dppf<0xB1>(sm); sm += dppf<0x4E>(sm); sm += dppf<0x141>(sm);
                const float mean = sm * (1.f / 64.f);
                const f32x4 d0 = y0 - mean, d1 = y1 - mean;
                float sq = (d0.x * d0.x + d0.y * d0.y) + (d0.z * d0.z + d0.w * d0.w) + (d1.x * d1.x + d1.y * d1.y) + (d1.z * d1.z + d1.w * d1.w);
                sq += dppf<0xB1>(sq); sq += dppf<0x4E>(sq); sq += dppf<0x141>(sq);
                const float rs = rsqrtf(sq * (1.f / 64.f) + GN_EPS);
                const f32x4 n0 = d0 * rs * lg0 + lb0, n1 = d1 * rs * lg1 + lb1;
                const unsigned gw_[4] = {gq.x, gq.y, gq.z, gq.w}, vw_[4] = {vq.x, vq.y, vq.z, vq.w}; const float nn[8] = {n0.x, n0.y, n0.z, n0.w, n1.x, n1.y, n1.z, n1.w}; unsigned ow[4];
#pragma unroll
                for (int i = 0; i < 4; ++i) { const float g0 = __uint_as_float(gw_[i] << 16), g1 = __uint_as_float(gw_[i] & 0xffff0000u), v0 = __uint_as_float(vw_[i] << 16), v1 = __uint_as_float(vw_[i] & 0xffff0000u);
                    ow[i] = pk2(nn[2 * i] * g0 + v0 * bsum, nn[2 * i + 1] * g1 + v1 * bsum); }
                *(u32x4*)(MIX + (size_t)t * D + c8) = (u32x4){ow[0], ow[1], ow[2], ow[3]};
            }
        }
        SEAM(pb + 4);
        if (IN(pb + 5)) { PHASE_IDS
            pg8::Gemm g{MIX, WoutT + (size_t)l * D * D, T, D, D}; pg8::StaticOrder S; S.init(T, D, G, bx);
            pg8::EpiResGate E{xin, X, modl + 2 * D, XB2, S2V + (size_t)l * BATCH * D, SSQ + (size_t)l * T};
            pg8::gemm_phase<pg8::EpiResGate, pg8::StaticOrder, true, true>(lds, g, S, E, tid); }
        SEAM(pb + 5);
        if (IN(pb + 7)) { PHASE_IDS
            pg8::Gemm g{XB2, PqT + (size_t)l * PH * PQ * D, T, PH * PQ, D}; pg8::StaticOrder S; S.init(T, PH * PQ, G, bx);
            pg8::EpiQ E{Q, PH * PQ, CVEC + (size_t)l * BATCH * PH * PQ, SSQ + (size_t)l * T};
            pg8::gemm_phase<pg8::EpiQ, pg8::StaticOrder, true, true>(lds, g, S, E, tid); }
        if (IN(pb + 7) && IN(pb + 8)) { asm volatile("s_waitcnt vmcnt(0)" ::: "memory"); __syncthreads(); }

        if (IN(pb + 8)) { PHASE_IDS
            const bf16* KEYSl = KEYS + (size_t)l * PH * 2 * NKEYS * PHALF;
            LAS unsigned char* scr = lds + wave * 2048 + lane * 32;
            constexpr int KST = 136;
            lbf16* kl = (lbf16*)(lds + 16384);
            const int r = lane & 31, hh = lane >> 5;
            pg8::StaticOrder S; S.init(T, PH * PQ, G, bx);
            for (int ui = 0;; ++ui) { pg8::Unit un_; if (!S.next(ui, un_)) break;
                const int h = un_.pn, tok = un_.pm * 256 + wave * 32 + r;
                __syncthreads();
                { u32x4 kq[8];
#pragma unroll
                  for (int q = 0; q < 8; ++q) { const int ch = tid + q * NTHR; kq[q] = *(const u32x4*)(KEYSl + (size_t)(h * 2) * NKEYS * PHALF + (size_t)ch * 8); }
#pragma unroll
                  for (int q = 0; q < 8; ++q) { const int ch = tid + q * NTHR, row = ch >> 4, cc = ch & 15; *(__attribute__((address_space(3))) u32x4*)(kl + row * KST + cc * 8) = kq[q]; } }
                __syncthreads();
                unsigned sp0[16], sp1[16];
#pragma unroll
                for (int e = 0; e < 16; ++e) { sp0[e] = 0u; sp1[e] = 0u; }
#pragma unroll 1
                for (int p = 0; p < 2; ++p) {
                    const bf16* qp = Q + (size_t)tok * (PH * PQ) + h * PQ + p * PHALF + 8 * hh;
                    const lbf16* kp_ = kl + (p * NKEYS + r) * KST + 8 * hh;
                    bf16x8_t bq[8];
#pragma unroll
                    for (int ks = 0; ks < 8; ++ks) bq[ks] = *(const bf16x8_t*)(qp + ks * 16);
                    unsigned best[16];
#pragma unroll
                    for (int e = 0; e < 16; ++e) best[e] = 0u;
#pragma unroll 1
                    for (int kt = 0; kt < 4; ++kt) {
                        f32x16 acc;
#pragma unroll
                        for (int e = 0; e < 16; ++e) acc[e] = 0.f;
#pragma unroll
                        for (int ks = 0; ks < 8; ++ks) { const bf16x8_t ak = *(const __attribute__((address_space(3))) bf16x8_t*)(kp_ + kt * 32 * KST + ks * 16); acc = __builtin_amdgcn_mfma_f32_32x32x16_bf16(ak, bq[ks], acc, 0, 0, 0); }
                        unsigned g[16];
#pragma unroll
                        for (int e = 0; e < 16; ++e) g[e] = pack_key7(acc[e], kt * 32 + (e & 3) + 8 * (e >> 2) + 4 * hh);
                        sort16_desc(g);
                        merge_top16(best, g);
                    }
                    unsigned ob[16];
#pragma unroll
                    for (int e = 0; e < 16; ++e) ob[e] = shflxu(best[e], lane, 32);
                    merge_top16(best, ob);
#pragma unroll
                    for (int e = 0; e < 16; ++e) { sp0[e] = p == 0 ? best[e] : sp0[e]; sp1[e] = p == 0 ? sp1[e] : best[e]; }
                }
                unsigned c2[32];
                stage2_cands(sp0, sp1, hh, c2);
                sort16_desc(c2); sort16_desc(c2 + 16); merge_top16(c2, c2 + 16);
                { unsigned ob[16];
#pragma unroll
                  for (int e = 0; e < 16; ++e) ob[e] = shflxu(c2[e], lane, 32);
                  merge_top16(c2, ob); }
#pragma unroll
                for (int e = 0; e < 16; e += 4) {
                    *(LAS unsigned*)(scr + e) = (127u - (sp0[e] & 127u)) | ((127u - (sp0[e + 1] & 127u)) << 8) | ((127u - (sp0[e + 2] & 127u)) << 16) | ((127u - (sp0[e + 3] & 127u)) << 24);
                    *(LAS unsigned*)(scr + 16 + e) = (127u - (sp1[e] & 127u)) | ((127u - (sp1[e + 1] & 127u)) << 8) | ((127u - (sp1[e + 2] & 127u)) << 16) | ((127u - (sp1[e + 3] & 127u)) << 24); }
                asm volatile("s_waitcnt lgkmcnt(0)" ::: "memory");
                float sm[16]; int ex[16];
#pragma unroll
                for (int e = 0; e < 16; ++e) { const unsigned key = c2[e]; sm[e] = unpack_key8(key); const int i0 = (key >> 4) & 15, j0 = key & 15; ex[e] = (int)scr[i0] * NKEYS + (int)scr[16 + j0]; }
                float den = 0.f;
#pragma unroll
                for (int e = 0; e < 16; ++e) { sm[e] = expf(sm[e] - unpack_key8(c2[0])); den += sm[e]; }
                const float inv = 1.f / den;
                if (hh == 0) {
                    int* ip = IDX + (size_t)tok * NE + h * TOPK; float* gp = GATE + (size_t)tok * NE + h * TOPK;
#pragma unroll
                    for (int e = 0; e < 16; e += 4) { *(int4*)(ip + e) = make_int4(ex[e], ex[e + 1], ex[e + 2], ex[e + 3]); *(f32x4*)(gp + e) = (f32x4){sm[e] * inv, sm[e + 1] * inv, sm[e + 2] * inv, sm[e + 3] * inv}; }
                }
                asm volatile("s_waitcnt lgkmcnt(0)" ::: "memory");
            }
        }
        SEAM(pb + 8);

        if (IN(pb + 9)) { PHASE_IDS
            const unsigned char* Ul = U8 + (size_t)l * NEXP * ROWB; const unsigned char* Vtl = V8 + (size_t)l * NEXP * ROWB; const float* usl = USc + l * NEXP; const float* vsl = VSc + l * NEXP; const float* lnf = INP(29);
            const bool fin = (l == DEPTH - 1);
            typedef float f32x2_t __attribute__((ext_vector_type(2)));
            const __amdgpu_buffer_rsrc_t ru = __builtin_amdgcn_make_buffer_rsrc((void*)Ul, 0, NEXP * ROWB, 0x00020000), rv = __builtin_amdgcn_make_buffer_rsrc((void*)Vtl, 0, NEXP * ROWB, 0x00020000);
            typedef float f32x32_t __attribute__((ext_vector_type(32))); typedef unsigned u32x3_t __attribute__((ext_vector_type(3))); typedef unsigned u32x6_t __attribute__((ext_vector_type(6))); typedef unsigned u32x16_t __attribute__((ext_vector_type(16))); typedef __bf16 bf16x2_t __attribute__((ext_vector_type(2)));
            LAS float* pl = (LAS float*)(lds + wave * 18432);
            constexpr int TW = 4;
            for (int tb = gw; tb < T; tb += TW * NGW) {
#define TOKV(k) (tb + (k) * NGW < T)
#define TOK(k) (TOKV(k) ? tb + (k) * NGW : tb)
                unsigned si[TW][2]; float sus[TW][2], sgv[TW][2];
                LAS u32x4* hl = (LAS u32x4*)(pl + 32 * 68);
                { float g0[TW], g1[TW]; int lane_s; asm volatile("v_mbcnt_lo_u32_b32 %0, -1, 0\n\tv_mbcnt_hi_u32_b32 %0, -1, %0" : "=v"(lane_s));
#pragma unroll
                  for (int k = 0; k < TW; ++k) { const size_t o = (size_t)TOK(k) * NE + lane_s; si[k][0] = ((unsigned)IDX[o] << 7) | (unsigned)lane_s; si[k][1] = ((unsigned)IDX[o + 64] << 7) | (unsigned)(64 + lane_s); g0[k] = GATE[o]; g1[k] = GATE[o + 64]; }
#pragma unroll
                  for (int kk = 2; kk <= 128; kk <<= 1) {
#pragma unroll
                      for (int j = kk >> 1; j > 0; j >>= 1) {
                          if (j == 64) {
#pragma unroll
                              for (int k = 0; k < TW; ++k) { const unsigned a = si[k][0], b = si[k][1]; si[k][0] = a < b ? a : b; si[k][1] = a < b ? b : a; } }
                          else { const bool lower = (lane_s & j) == 0, tm0 = lower == ((lane_s & kk) == 0), tm1 = lower == (((lane_s + 64) & kk) == 0); const int pa = (lane_s ^ j) << 2;
#pragma unroll
                              for (int k = 0; k < TW; ++k) { const unsigned a = si[k][0], b = si[k][1], p0 = (unsigned)__builtin_amdgcn_ds_bpermute(pa, (int)a), p1 = (unsigned)__builtin_amdgcn_ds_bpermute(pa, (int)b);
                                  si[k][0] = tm0 ? (a < p0 ? a : p0) : (a < p0 ? p0 : a); si[k][1] = tm1 ? (b < p1 ? b : p1) : (b < p1 ? p1 : b); } }
                          __builtin_amdgcn_sched_barrier(0);
                      } }
#pragma unroll
                  for (int k = 0; k < TW; ++k) {
#pragma unroll
                      for (int r = 0; r < 2; ++r) { const unsigned key = si[k][r]; const int a = (int)(key & 63u) << 2; const int ga = __builtin_amdgcn_ds_bpermute(a, __float_as_int(g0[k])), gb = __builtin_amdgcn_ds_bpermute(a, __float_as_int(g1[k]));
                          const unsigned ix = key >> 7; si[k][r] = ix; sus[k][r] = usl[ix]; sgv[k][r] = __int_as_float((key & 64u) ? gb : ga) * vsl[ix]; } }
#pragma unroll
                  for (int k = 0; k < TW; ++k) {
                      const int t_ = TOK(k); const bf16* hr = XB2 + (size_t)t_ * D + lane_s * 4; const uint2 a0 = *(const uint2*)hr, a1 = *(const uint2*)(hr + 256), a2 = *(const uint2*)(hr + 512), a3 = *(const uint2*)(hr + 768);
                      const float rs_ = rsqrtf((float)SSQ[(size_t)l * T + t_] * (1.f / (1048576.f * D)) + NORM_EPS); const float* shp = modl + (size_t)(t_ / SEQ) * 6 * D + 3 * D + lane_s * 4;
                      const unsigned aw[8] = {a0.x, a0.y, a1.x, a1.y, a2.x, a2.y, a3.x, a3.y}; unsigned ow[8];
#pragma unroll
                      for (int q = 0; q < 4; ++q) { const f32x4 s4 = *(const f32x4*)(shp + q * 256);
                          ow[2 * q] = pk2(__uint_as_float(aw[2 * q] << 16) * rs_ + s4.x, __uint_as_float(aw[2 * q] & 0xffff0000u) * rs_ + s4.y);
                          ow[2 * q + 1] = pk2(__uint_as_float(aw[2 * q + 1] << 16) * rs_ + s4.z, __uint_as_float(aw[2 * q + 1] & 0xffff0000u) * rs_ + s4.w); }
                      hl[(k * 2) * 64 + lane_s] = (u32x4){ow[0], ow[1], ow[2], ow[3]}; hl[(k * 2 + 1) * 64 + lane_s] = (u32x4){ow[4], ow[5], ow[6], ow[7]}; }
                }
                __builtin_amdgcn_sched_barrier(0);
#define ROWLD(dst, rs, ixv, ln) dst = __builtin_amdgcn_raw_buffer_load_b96(rs, voff, __builtin_amdgcn_readlane((int)(ixv), (ln)) * ROWB, 0)
#define LOADQ(buf, rs, ixv, ln0) do { _Pragma("unroll") for (int j_ = 0; j_ < 8; ++j_) ROWLD((buf)[j_], rs, ixv, (ln0) + j_); __builtin_amdgcn_sched_barrier(0); } while (0)
#define CVT2(a, b) const f32x32_t f_ = __builtin_amdgcn_cvt_scalef32_pk32_f32_fp6((u32x6_t){(a).x, (a).y, (a).z, (b).x, (b).y, (b).z}, 1.0f)
#define PR(i) __builtin_shufflevector(f_, f_, 2 * (i), 2 * (i) + 1)
#define DOTQ(buf, e0) do { _Pragma("unroll") for (int j_ = 0; j_ < 8; j_ += 2) { \
                        const u32x16_t g_ = __builtin_bit_cast(u32x16_t, __builtin_amdgcn_cvt_scalef32_pk32_bf16_fp6((u32x6_t){(buf)[j_].x, (buf)[j_].y, (buf)[j_].z, (buf)[j_ + 1].x, (buf)[j_ + 1].y, (buf)[j_ + 1].z}, 1.0f));     \
                        float a0_ = 0.f, a1_ = 0.f, b0_ = 0.f, b1_ = 0.f; \
                        _Pragma("unroll") for (int i_ = 0; i_ < 8; i_ += 2) { a0_ = DOT2(g_[i_], hpk[i_], a0_); b0_ = DOT2(g_[8 + i_], hpk[i_], b0_); a1_ = DOT2(g_[i_ + 1], hpk[i_ + 1], a1_); b1_ = DOT2(g_[9 + i_], hpk[i_ + 1], b1_); } \
                        pl[((e0) + j_) * 68 + lane_u] = a0_ + a1_; pl[((e0) + j_ + 1) * 68 + lane_u] = b0_ + b1_; __builtin_amdgcn_sched_barrier(0); } } while (0)
#define DOT2(x_, y_, c_) __builtin_amdgcn_fdot2_f32_bf16(__builtin_bit_cast(bf16x2_t, (unsigned)(x_)), __builtin_bit_cast(bf16x2_t, (unsigned)(y_)), (c_), false)
#define AXPYQ(buf, k, cfv, ln0) do { _Pragma("unroll") for (int j_ = 0; j_ < 8; j_ += 2) { CVT2((buf)[j_], (buf)[j_ + 1]); \
                        const float ca = __int_as_float(__builtin_amdgcn_readlane(__float_as_int(cfv), (ln0) + j_)), cb = __int_as_float(__builtin_amdgcn_readlane(__float_as_int(cfv), (ln0) + j_ + 1)); \
                        acc2[k][0] += ca * PR(0); acc2[k][1] += ca * PR(1); acc2[k][2] += ca * PR(2); acc2[k][3] += ca * PR(3); acc2[k][4] += ca * PR(4); acc2[k][5] += ca * PR(5); acc2[k][6] += ca * PR(6); acc2[k][7] += ca * PR(7); \
                        acc2[k][0] += cb * PR(8); acc2[k][1] += cb * PR(9); acc2[k][2] += cb * PR(10); acc2[k][3] += cb * PR(11); acc2[k][4] += cb * PR(12); acc2[k][5] += cb * PR(13); acc2[k][6] += cb * PR(14); acc2[k][7] += cb * PR(15); __builtin_amdgcn_sched_barrier(0); } } while (0)
                u32x3_t ba[8], bb_[8];
                int lane_u; asm volatile("v_mbcnt_lo_u32_b32 %0, -1, 0\n\tv_mbcnt_hi_u32_b32 %0, -1, %0" : "=v"(lane_u)); const int voff = lane_u * 12;
                LOADQ(ba, ru, si[0][0], 0);
#pragma unroll 1
                for (int c = 0; c < 16; ++c) {
                    const int lb = (c & 7) * 8; const bool r1 = c >= 8;
#pragma unroll
                    for (int k = 0; k < TW; ++k) {
                        unsigned hpk[8];
                        { const u32x4 h0 = hl[(k * 2) * 64 + lane_u], h1 = hl[(k * 2 + 1) * 64 + lane_u]; hpk[0] = h0.x; hpk[1] = h0.y; hpk[2] = h0.z; hpk[3] = h0.w; hpk[4] = h1.x; hpk[5] = h1.y; hpk[6] = h1.z; hpk[7] = h1.w; }
                        if (k & 1) { if (k < TW - 1) LOADQ(ba, ru, r1 ? si[k + 1][1] : si[k + 1][0], lb); else { const int cn = (c + 1) & 15; const __amdgpu_buffer_rsrc_t rn = c < 15 ? ru : rv; LOADQ(ba, rn, (cn >= 8) ? si[0][1] : si[0][0], (cn & 7) * 8); } DOTQ(bb_, k * 8); }
                        else { LOADQ(bb_, ru, r1 ? si[k + 1][1] : si[k + 1][0], lb); DOTQ(ba, k * 8); }
                    }
                    __builtin_amdgcn_wave_barrier(); asm volatile("s_waitcnt lgkmcnt(0)" ::: "memory");
                    float dsum;
                    { const LAS float* rp = pl + (lane_u & 31) * 68 + (lane_u >> 5) * 32; f32x4 s4 = *(const LAS f32x4*)rp;
#pragma unroll
                      for (int j = 1; j < 8; ++j) s4 += *(const LAS f32x4*)(rp + j * 4);
                      dsum = (s4.x + s4.y) + (s4.z + s4.w); }
                    dsum += shflx(dsum, lane_u, 32);
                    __builtin_amdgcn_wave_barrier(); asm volatile("s_waitcnt lgkmcnt(0)" ::: "memory");
                    const bool home = (lane_u >> 3) == (c & 7);
#pragma unroll
                    for (int k = 0; k < TW; ++k) {
                        const float dv = __int_as_float(__builtin_amdgcn_ds_bpermute((k * 8 + (lane_u & 7)) << 2, __float_as_int(dsum)));
                        const float cf = (r1 ? sgv[k][1] : sgv[k][0]) * gelu_erf(dv * (r1 ? sus[k][1] : sus[k][0]));
                        if (r1) sgv[k][1] = home ? cf : sgv[k][1]; else sgv[k][0] = home ? cf : sgv[k][0]; }
                    __builtin_amdgcn_sched_barrier(0);
                }
                f32x2_t acc2[TW][8];
#pragma unroll
                for (int k = 0; k < TW; ++k) {
#pragma unroll
                    for (int i = 0; i < 8; ++i) acc2[k][i] = (f32x2_t){0.f, 0.f}; }
#pragma unroll 1
                for (int c = 0; c < 16; ++c) {
                    const int lb = (c & 7) * 8; const bool r1 = c >= 8;
#pragma unroll
                    for (int k = 0; k < TW; ++k) {
                        const float cfk = r1 ? sgv[k][1] : sgv[k][0];
                        if (k & 1) { if (k < TW - 1) LOADQ(ba, rv, r1 ? si[k + 1][1] : si[k + 1][0], lb); else { const int cn = (c + 1) & 15; LOADQ(ba, rv, (cn >= 8) ? si[0][1] : si[0][0], (cn & 7) * 8); }     AXPYQ(bb_, k, cfk, lb); }
                        else { LOADQ(bb_, rv, r1 ? si[k + 1][1] : si[k + 1][0], lb); AXPYQ(ba, k, cfk, lb); }
                    }
                }
#undef ROWLD
#undef LOADQ
#undef CVT2
#undef PR
#undef DOTQ
#undef DOT2
#undef AXPYQ
                { int ln; asm volatile("v_mbcnt_lo_u32_b32 %0, -1, 0\n\tv_mbcnt_hi_u32_b32 %0, -1, %0" : "=v"(ln));
                  LAS f32x4* al = (LAS f32x4*)pl + ln;
#pragma unroll
                  for (int k = 0; k < TW; ++k) {
#pragma unroll
                      for (int q = 0; q < 4; ++q) al[(k * 4 + q) * 64] = (f32x4){acc2[k][q * 2].x, acc2[k][q * 2].y, acc2[k][q * 2 + 1].x, acc2[k][q * 2 + 1].y}; }
                  asm volatile("s_waitcnt lgkmcnt(0)" ::: "memory"); __builtin_amdgcn_sched_barrier(0);
                  f32x4 xn[4];
#pragma unroll
                  for (int q = 0; q < 4; ++q) xn[q] = *(const f32x4*)(X + (size_t)tb * D + ln * 4 + q * 256);
#pragma unroll 1
                  for (int k = 0; k < TW; ++k) { const int t = tb + k * NGW; if (t >= T) break; const int b = t / SEQ;
                    float* xr = X + (size_t)t * D + ln * 4; const float* g2 = modl + (size_t)b * 6 * D + 5 * D + ln * 4;
                    f32x4 xv[4]; float ss = 0.f;
#pragma unroll
                    for (int q = 0; q < 4; ++q) xv[q] = xn[q];
                    { const float* xnp = X + (size_t)((k + 1 < TW && t + NGW < T) ? t + NGW : t) * D + ln * 4;
#pragma unroll
                      for (int q = 0; q < 4; ++q) xn[q] = *(const f32x4*)(xnp + q * 256); }
                    __builtin_amdgcn_sched_barrier(0);
#pragma unroll
                    for (int q = 0; q < 4; ++q) { const f32x4 xo = xv[q], gg = *(const f32x4*)(g2 + q * 256);
                        xv[q] = xo + gg * al[(k * 4 + q) * 64]; ss += (xv[q].x * xv[q].x + xv[q].y * xv[q].y) + (xv[q].z * xv[q].z + xv[q].w * xv[q].w); }
                    const float rs = rsqrtf(wave_sum(ss, ln) * (1.f / D) + NORM_EPS);
                    if (fin) {
#pragma unroll
                        for (int q = 0; q < 4; ++q) *(f32x4*)(xr + q * 256) = xv[q] * rs * *(const f32x4*)(lnf + ln * 4 + q * 256); }
                    else {
                        const float* gam = INP(4) + (l + 1) * D + ln * 4; const float* mn = MOD + (size_t)(l + 1) * BATCH * 6 * D + (size_t)b * 6 * D + ln * 4;
#pragma unroll
                        for (int q = 0; q < 4; ++q) { *(f32x4*)(xr + q * 256) = xv[q];
                            const f32x4 y = xv[q] * rs * *(const f32x4*)(gam + q * 256) * (*(const f32x4*)(mn + D + q * 256) + 1.f) + *(const f32x4*)(mn + q * 256);
                            uint2 ho; ho.x = pk2(y.x, y.y); ho.y = pk2(y.z, y.w); *(uint2*)(H + (size_t)t * D + q * 256 + ln * 4) = ho; } }
                  }
                  asm volatile("s_waitcnt lgkmcnt(0)" ::: "memory"); __builtin_amdgcn_wave_barrier();
                }
#undef TOK
#undef TOKV
            }
        }
    }
#undef modl
#undef xin
#undef IN
#undef SEAM
}
#undef MOD
#undef H
#undef PROJ
#undef Q
#undef MIX
#undef Rb
#undef Kb
#undef V0
#undef V1
#undef KKb
#undef Bb
#undef Gb
#undef BGb
#undef Wd
#undef Y
#undef IDX
#undef GATE
#undef WinT
#undef WoutT
#undef PqT
#undef KEYS
#undef QB
#undef POOLIN
#undef SH
#undef SSQ
#undef CVEC
#undef S2V
#undef XB2
#undef WUPT
#undef AUPT
#undef GUPT
#undef VUPT
#undef PWT
#undef INVN
#undef BSUM
#undef SCN
#undef U8
#undef V8
#undef USc
#undef VSc
#undef INP
#undef PHASE_IDS

extern "C" void kernel_launch(void* const* d_in, const int* in_sizes, int n_in, void* d_out, int out_size, void* d_ws, size_t ws_size, hipStream_t stream) {
    if (n_in != 30 || ws_size < WS_END) { fprintf(stderr, "kernel_launch: unexpected n_in %d / ws_size %zu\n", n_in, ws_size); return; }
    static int grid = 0;
    if (grid == 0) {
        int dev = 0, cus = 0, per_cu = 0;
        (void)hipGetDevice(&dev); (void)hipDeviceGetAttribute(&cus, hipDeviceAttributeMultiprocessorCount, dev);
        if (hipFuncSetAttribute((const void*)mega, hipFuncAttributeMaxDynamicSharedMemorySize, LDS_BYTES) != hipSuccess) { fprintf(stderr, "hipFuncSetAttribute failed\n"); grid = -1; return; }
        if (hipOccupancyMaxActiveBlocksPerMultiprocessor(&per_cu, (const void*)mega, NTHR, LDS_BYTES) != hipSuccess || per_cu < 1) { fprintf(stderr, "occupancy query failed (%d)\n", per_cu); per_cu = 1; }
        (void)hipGetLastError();
        grid = (cus > 0 ? cus : 256) * 1;
    }
    if (grid < 0) return;
    Args a{}; for (int i = 0; i < 30; ++i) a.in[i] = (const float*)d_in[i]; a.out = (float*)d_out; a.ws = (unsigned char*)d_ws;
    a.ph_lo = 0; a.ph_hi = NPH;
    if (hipMemsetAsync(d_ws, 0, 65536, stream) != hipSuccess) { fprintf(stderr, "memset failed\n"); return; }
    void* kargs[] = {&a};
    hipError_t e = hipLaunchCooperativeKernel((const void*)mega, dim3(grid), dim3(NTHR), kargs, LDS_BYTES, stream);
    if (e != hipSuccess) fprintf(stderr, "cooperative launch failed: %s (grid %d)\n", hipGetErrorString(e), grid);
}
```

```cpp
#include <hip/hip_runtime.h>
#include <hip/hip_cooperative_groups.h>
namespace cg = cooperative_groups;
#include <cstdio>
#include <cstdint>
#include <cmath>

constexpr int D = 1024, BATCH = 4, SEQ = 4096, T = BATCH * SEQ, DEPTH = 2;
constexpr int RW = 512, HS = 64, NH = 8;
constexpr int DL = 64, AL = 64, MVL = 32, GL = 128;
constexpr int RWKV_COLS = 3 * RW + DL + AL + GL;
constexpr int PW = 512, PG = 128;
constexpr int IN_COLS = RWKV_COLS + PW;
constexpr int LDP = 2560;
constexpr int NKEYS = 128, NEXP = NKEYS * NKEYS, PH = 8, PQ = 256, PHALF = 128, TOPK = 16;
constexpr int NE = PH * TOPK;
constexpr float NORM_EPS = 1e-6f, GN_EPS = 64e-5f;

typedef unsigned short bf16;
__device__ __forceinline__ float bf2f(bf16 u) { return __uint_as_float((unsigned)u << 16); }
typedef float cvt_f32x2 __attribute__((ext_vector_type(2))); typedef __bf16 cvt_bf16x2 __attribute__((ext_vector_type(2)));
__device__ __forceinline__ unsigned cvtpk(float lo, float hi) { const cvt_f32x2 v = {lo, hi}; const cvt_bf16x2 b = __builtin_convertvector(v, cvt_bf16x2); return __builtin_bit_cast(unsigned, b); }
__device__ __forceinline__ bf16 f2bf(float f) { return (bf16)cvtpk(f, 0.f); }

constexpr size_t MiB = 1u << 20;
constexpr size_t WS_MOD = 1 * MiB;
constexpr size_t WS_US = 1 * MiB + 256 * 1024;
constexpr size_t WS_VS = 1 * MiB + 512 * 1024;
constexpr size_t WS_H = 2 * MiB;
constexpr size_t WS_PROJ = 34 * MiB;
constexpr size_t WS_Q = WS_PROJ;
constexpr size_t WS_R = 114 * MiB;
constexpr size_t WS_K = 130 * MiB;
constexpr size_t WS_V0 = 146 * MiB;
constexpr size_t WS_V1 = 162 * MiB;
constexpr size_t WS_KK = 178 * MiB;
constexpr size_t WS_B = 194 * MiB;
constexpr size_t WS_G = 210 * MiB;
constexpr size_t WS_BG = 226 * MiB;
constexpr size_t WS_W = 242 * MiB;
constexpr size_t WS_Y = 274 * MiB;
constexpr size_t WS_MIX = 306 * MiB;
constexpr size_t WS_IDX = 338 * MiB;
constexpr size_t WS_GATE = 346 * MiB;
constexpr size_t WS_WIN_T = 354 * MiB;
constexpr size_t WS_WOUT_T = 364 * MiB;
constexpr size_t WS_PQ_T = 368 * MiB;
constexpr size_t WS_KEYS = 376 * MiB;
constexpr size_t WS_U = 378 * MiB;
constexpr size_t WS_V = 442 * MiB;
constexpr size_t WS_QB = 410 * MiB;
constexpr size_t WS_SH = 426 * MiB;
constexpr size_t WS_LORA = 428 * MiB;
constexpr size_t WS_INVN = 430 * MiB;
constexpr size_t WS_BSUM = 431 * MiB;
constexpr size_t WS_SCN = 2 * MiB;
constexpr size_t WS_END = 506 * MiB;

template <int CTRL> __device__ __forceinline__ float dppf(float x) { return __int_as_float(__builtin_amdgcn_update_dpp(0, __float_as_int(x), CTRL, 0xF, 0xF, false)); }
__device__ __forceinline__ float red16(float x) { x += dppf<0xB1>(x); x += dppf<0x4E>(x); x += dppf<0x141>(x); x += dppf<0x140>(x); return x; }
__device__ __forceinline__ float shflx(float v, int lane, int off) { return __int_as_float(__builtin_amdgcn_ds_bpermute((lane ^ off) << 2, __float_as_int(v))); }
__device__ __forceinline__ unsigned shflxu(unsigned v, int lane, int off) { return (unsigned)__builtin_amdgcn_ds_bpermute((lane ^ off) << 2, (int)v); }
__device__ __forceinline__ void sort128(unsigned& k0, unsigned& k1, int lane) {
#pragma unroll
    for (int k = 2; k <= 128; k <<= 1) {
#pragma unroll
        for (int j = k >> 1; j > 0; j >>= 1) {
            if (j == 64) { const unsigned lo = k0 < k1 ? k0 : k1, hi = k0 < k1 ? k1 : k0; k0 = lo; k1 = hi; }
            else {
                const unsigned p0 = shflxu(k0, lane, j), p1 = shflxu(k1, lane, j);
                const bool lower = (lane & j) == 0, up0 = (lane & k) == 0, up1 = ((lane + 64) & k) == 0;
                const unsigned mn0 = k0 < p0 ? k0 : p0, mx0 = k0 < p0 ? p0 : k0, mn1 = k1 < p1 ? k1 : p1, mx1 = k1 < p1 ? p1 : k1;
                k0 = (lower == up0) ? mn0 : mx0; k1 = (lower == up1) ? mn1 : mx1;
            }
        }
    }
}
__device__ __forceinline__ float wave_sum(float v, int lane) { v = red16(v); v += shflx(v, lane, 16); v += shflx(v, lane, 32); return v; }
__device__ __forceinline__ float sigmoidf_(float x) { return 1.f / (1.f + expf(-x)); }

namespace pg8 {
#define PG8_LAS __attribute__((address_space(3)))
typedef unsigned short bf16_t;
typedef short bf16x8 __attribute__((ext_vector_type(8)));
typedef float f32x4 __attribute__((ext_vector_type(4)));
typedef unsigned u32x4 __attribute__((ext_vector_type(4)));
constexpr int BM = 256, BK = 64, HALF = 128, HTB = HALF * BK * 2  , STAGE_BYTES = 8 * HTB, NXCD = 8, WGM = 8;

__host__ __device__ __forceinline__ int lds_byte(int r, int c) { const int st = (r >> 4) * 2 + (c >> 5), rr = r & 15, cc = c & 31, ob = rr * 64 + cc * 2; return st * 1024 + (ob ^ (((ob >> 9) & 1) << 5)); }
__host__ __device__ __forceinline__ void stage_rc(int b, int& R, int& C) { const int st = b / 1024, sb = b % 1024, swz = sb ^ (((sb >> 9) & 1) << 5); R = (st >> 1) * 16 + swz / 64; C = (st & 1) * 32 + (swz % 64) / 2; }
__host__ __device__ __forceinline__ int perm32(int rho) { const int n = rho >> 4, i = rho & 15; return 8 * (i >> 2) + 4 * n + (i & 3); }

struct Unit { int pm, pn; };
struct Gemm { const bf16_t* A; const bf16_t* Bt; int M, N, K; };

struct StaticOrder {
    int nM, nN, nwg, G, c;
    __host__ __device__ void init(int M, int N, int G_, int c_) { nM = M / BM; nN = N / BM; nwg = nM * nN; G = G_; c = c_; }
    __host__ __device__ bool next(int i, Unit& u) const {
        const long L = (long)i * G + c; if (L >= nwg) return false;
        int wgid = (int)L; { const int q = nwg / NXCD, r = nwg % NXCD, xcd = wgid % NXCD, off = wgid / NXCD; wgid = (xcd < r ? xcd * (q + 1) : r * (q + 1) + (xcd - r) * q) + off; }
        const int nig = WGM * nN, gid = wgid / nig, fm = gid * WGM, gsz = (nM - fm) < WGM ? (nM - fm) : WGM;
        u.pm = fm + ((wgid % nig) % gsz); u.pn = (wgid % nig) / gsz; return true;
    }
    __device__ __forceinline__ void a_ready(const Unit&) const {}
    __device__ __forceinline__ void done(const Unit&) const {}
};

__device__ __forceinline__ unsigned cvt_pk_bf16(float lo, float hi) { unsigned r; asm volatile("v_cvt_pk_bf16_f32 %0, %1, %2" : "=v"(r) : "v"(lo), "v"(hi)); return r; }
typedef float f32x2 __attribute__((ext_vector_type(2)));
__device__ __forceinline__ f32x2 gelu_pk(f32x2 v) {
    const f32x2 av = __builtin_elementwise_abs(v), d = av * 0.2316418882f + 1.0f;
    f32x2 t; t.x = __builtin_amdgcn_rcpf(d.x); t.y = __builtin_amdgcn_rcpf(d.y);
    f32x2 q = t * 0.5307027145f + (-0.7265760135f); q = q * t + 0.7107068705f; q = q * t + (-0.142248368f); q = q * t + 0.127414796f; q = q * t;
    const f32x2 s = (v * v) * (-0.72134752044f);
    f32x2 e; e.x = __builtin_amdgcn_exp2f(s.x); e.y = __builtin_amdgcn_exp2f(s.y);
    const f32x2 m = v * (q * e), r = v - m;
    f32x2 o; o.x = v.x < 0.f ? m.x : r.x; o.y = v.y < 0.f ? m.y : r.y; return o;
}

template <int ACT  > struct EpiBf16 {
    static constexpr bool PERM = true, AFTER_DRAIN = false; static_assert(ACT == 0 || ACT == 1, "EpiBf16: ACT is 0 (none) or 1 (gelu_pk)");
    bf16_t* O; int ldc; const float* bias; int split_cols; size_t split_stride; float scale0;
    __device__ __forceinline__ void operator()(const f32x4 (&acc)[2][2][4][2], const Unit& u, int wr, int wc, int fr, int fq) const {
        const int row0 = u.pm * BM + wr * 64 + fr; int colt = u.pn * BM; bf16_t* base = O;
        float sc = 1.f; if (split_cols) { const int t = colt / split_cols; base += (size_t)t * split_stride; colt -= t * split_cols; if (t == 0) sc = scale0; }
        const int col0 = colt + wc * 32 + 8 * fq, bcol0 = u.pn * BM + wc * 32 + 8 * fq;
        f32x4 bv[2][2];
#pragma unroll
        for (int bj = 0; bj < 2; ++bj)
#pragma unroll
            for (int n = 0; n < 2; ++n) bv[bj][n] = bias ? *(const f32x4*)(bias + bcol0 + bj * HALF + 4 * n) : (f32x4){0.f, 0.f, 0.f, 0.f};
#pragma unroll
        for (int ai = 0; ai < 2; ++ai)
#pragma unroll
            for (int m = 0; m < 4; ++m) { bf16_t* rowp = base + (size_t)(row0 + ai * HALF + m * 16) * ldc + col0;
#pragma unroll
                for (int bj = 0; bj < 2; ++bj) { f32x4 v0 = acc[ai][bj][m][0] + bv[bj][0], v1 = acc[ai][bj][m][1] + bv[bj][1];
                    if (ACT == 1) { f32x2 a = gelu_pk((f32x2){v0[0], v0[1]}), b = gelu_pk((f32x2){v0[2], v0[3]}), c = gelu_pk((f32x2){v1[0], v1[1]}), d = gelu_pk((f32x2){v1[2], v1[3]});
                        v0 = (f32x4){a.x, a.y, b.x, b.y}; v1 = (f32x4){c.x, c.y, d.x, d.y}; }
                    v0 = v0 * sc; v1 = v1 * sc; u32x4 w; w.x = cvt_pk_bf16(v0[0], v0[1]); w.y = cvt_pk_bf16(v0[2], v0[3]); w.z = cvt_pk_bf16(v1[0], v1[1]); w.w = cvt_pk_bf16(v1[2], v1[3]);
                    *(u32x4*)(rowp + bj * HALF) = w; } }
    }
};

struct EpiProj {
    static constexpr bool PERM = true, AFTER_DRAIN = false;
    bf16_t* O; int ldc; bf16_t* P; int pool0, pw;
    __device__ __forceinline__ void operator()(const f32x4 (&acc)[2][2][4][2], const Unit& u, int wr, int wc, int fr, int fq) const {
        const int row0 = u.pm * BM + wr * 64 + fr; int colt = u.pn * BM; bf16_t* base = O; int ld = ldc;
        if (colt >= pool0 && colt < pool0 + pw) { base = P; ld = pw; colt -= pool0; }
        const int col0 = colt + wc * 32 + 8 * fq;
#pragma unroll
        for (int ai = 0; ai < 2; ++ai)
#pragma unroll
            for (int m = 0; m < 4; ++m) { bf16_t* rowp = base + (size_t)(row0 + ai * HALF + m * 16) * ld + col0;
#pragma unroll
                for (int bj = 0; bj < 2; ++bj) { const f32x4 v0 = acc[ai][bj][m][0], v1 = acc[ai][bj][m][1];
                    u32x4 w; w.x = cvt_pk_bf16(v0[0], v0[1]); w.y = cvt_pk_bf16(v0[2], v0[3]); w.z = cvt_pk_bf16(v1[0], v1[1]); w.w = cvt_pk_bf16(v1[2], v1[3]);
                    *(u32x4*)(rowp + bj * HALF) = w; } }
    }
};
struct EpiResGate {
    static constexpr bool PERM = true, AFTER_DRAIN = false;
    const float* xold; float* X; const float* gate;
    bf16_t* XB; const float* sv; unsigned long long* ssq;
    __device__ __forceinline__ void operator()(const f32x4 (&acc)[2][2][4][2], const Unit& u, int wr, int wc, int fr, int fq) const {
        const int col0 = u.pn * BM + wc * 32 + 8 * fq; const int b = (u.pm * BM) / SEQ;
        const float* gp = gate + (size_t)b * 6 * D + col0; const float* sp = sv + (size_t)b * D + col0;
        float rsum[2][4];
#pragma unroll
        for (int ai = 0; ai < 2; ++ai)
#pragma unroll
            for (int m = 0; m < 4; ++m) rsum[ai][m] = 0.f;
#pragma unroll
        for (int bj = 0; bj < 2; ++bj) { const f32x4 g0 = *(const f32x4*)(gp + bj * HALF), g1 = *(const f32x4*)(gp + bj * HALF + 4), s0 = *(const f32x4*)(sp + bj * HALF), s1 = *(const f32x4*)(sp + bj * HALF + 4);
#pragma unroll
            for (int ai = 0; ai < 2; ++ai)
#pragma unroll
                for (int m = 0; m < 4; ++m) { const size_t off = (size_t)(u.pm * BM + ai * HALF + wr * 64 + m * 16 + fr) * D + col0 + bj * HALF;
                    const f32x4 xa = *(const f32x4*)(xold + off) + g0 * acc[ai][bj][m][0], xb = *(const f32x4*)(xold + off + 4) + g1 * acc[ai][bj][m][1];
                    *(f32x4*)(X + off) = xa; *(f32x4*)(X + off + 4) = xb;
                    rsum[ai][m] += ((xa[0] * xa[0] + xa[1] * xa[1]) + (xa[2] * xa[2] + xa[3] * xa[3])) + ((xb[0] * xb[0] + xb[1] * xb[1]) + (xb[2] * xb[2] + xb[3] * xb[3]));
                    const f32x4 ya = xa * s0, yb = xb * s1; u32x4 o; o.x = cvt_pk_bf16(ya[0], ya[1]); o.y = cvt_pk_bf16(ya[2], ya[3]); o.z = cvt_pk_bf16(yb[0], yb[1]); o.w = cvt_pk_bf16(yb[2], yb[3]);
                    *(u32x4*)(XB + off) = o; } }
        const int lane_ = fr | (fq << 4);
#pragma unroll
        for (int ai = 0; ai < 2; ++ai)
#pragma unroll
            for (int m = 0; m < 4; ++m) { float v = rsum[ai][m];
                v += __int_as_float(__builtin_amdgcn_ds_bpermute((lane_ ^ 16) << 2, __float_as_int(v))); v += __int_as_float(__builtin_amdgcn_ds_bpermute((lane_ ^ 32) << 2, __float_as_int(v)));
                if (fq == 0) (void)__hip_atomic_fetch_add(ssq + (u.pm * BM + ai * HALF + wr * 64 + m * 16 + fr), (unsigned long long)(v * 1048576.f + 0.5f), __ATOMIC_RELAXED, __HIP_MEMORY_SCOPE_AGENT); }
    }
};
struct EpiQ {
    static constexpr bool PERM = true, AFTER_DRAIN = false;
    bf16_t* O; int ldc; const float* cv; const unsigned long long* ssq;
    __device__ __forceinline__ void operator()(const f32x4 (&acc)[2][2][4][2], const Unit& u, int wr, int wc, int fr, int fq) const {
        const int row0 = u.pm * BM + wr * 64 + fr, colt = u.pn * BM, b = (u.pm * BM) / SEQ;
        const int col0 = colt + wc * 32 + 8 * fq;
        f32x4 bv[2][2];
#pragma unroll
        for (int bj = 0; bj < 2; ++bj)
#pragma unroll
            for (int n = 0; n < 2; ++n) bv[bj][n] = *(const f32x4*)(cv + (size_t)b * ldc + col0 + bj * HALF + 4 * n);
#pragma unroll
        for (int ai = 0; ai < 2; ++ai)
#pragma unroll
            for (int m = 0; m < 4; ++m) { const int row = row0 + ai * HALF + m * 16; bf16_t* rowp = O + (size_t)row * ldc + col0;
                const float rs = rsqrtf((float)ssq[row] * (1.f / (1048576.f * 1024.f)) + 1e-6f);
#pragma unroll
                for (int bj = 0; bj < 2; ++bj) { const f32x4 v0 = acc[ai][bj][m][0] * rs + bv[bj][0], v1 = acc[ai][bj][m][1] * rs + bv[bj][1];
                    u32x4 w; w.x = cvt_pk_bf16(v0[0], v0[1]); w.y = cvt_pk_bf16(v0[2], v0[3]); w.z = cvt_pk_bf16(v1[0], v1[1]); w.w = cvt_pk_bf16(v1[2], v1[3]);
                    *(u32x4*)(rowp + bj * HALF) = w; } }
    }
};
template <class Epi, class Sched, bool ALIGN_EPI = false, bool SP2 = false>
__device__ __forceinline__ void gemm_phase(PG8_LAS unsigned char* lds, const Gemm g, const Sched& S, const Epi& E, int tid) {
    asm volatile("" : "+v"(tid));
    const int wid = __builtin_amdgcn_readfirstlane(tid >> 6), lane = tid & 63, wr = wid >> 2, wc = wid & 3, fr = lane & 15, fq = lane >> 4;
    const int K = g.K, nt = K / BK;
    unsigned voffA[2], voffB[2];
#pragma unroll
    for (int i = 0; i < 2; ++i) { int R, C; stage_rc(tid * 16 + i * 8192, R, C); const int Rb = Epi::PERM ? ((R & ~31) + perm32(R & 31)) : R;
        voffA[i] = (unsigned)(R * K + C) * 2u; voffB[i] = (unsigned)(Rb * K + C) * 2u; }
    const size_t kstep = (size_t)(BK * 2);
    const size_t hstep = (size_t)HALF * K * 2;
    const size_t tstep = 2 * hstep;
    const unsigned ldsw = (unsigned)wid * 1024u;
    const int aoff = lds_byte(wr * 64 + fr, fq * 8), boff = lds_byte(wc * 32 + fr, fq * 8);
#define PG8_SA(b, h) (((b) * 2 + (h)) * HTB)
#define PG8_SB(b, h) ((4 + (b) * 2 + (h)) * HTB)
#define PG8_STAGE(bufoff, gbase, voff) do { _Pragma("unroll") for (int _i = 0; _i < 2; ++_i) \
        __builtin_amdgcn_global_load_lds((const unsigned*)((const char*)(gbase) + (voff)[_i]), (PG8_LAS unsigned*)(lds + (bufoff) + ldsw + _i * 8192), 16, 0, 0); } while (0)
#define PG8_LDA(dst, b, h) do { _Pragma("unroll") for (int m = 0; m < 4; ++m) _Pragma("unroll") for (int k = 0; k < 2; ++k) dst[m][k] = *(const PG8_LAS bf16x8*)(lds + PG8_SA(b, h) + aoff + m * 2048 + k * 1024); } while (0)
#define PG8_LDB(dst, b, h) do { _Pragma("unroll") for (int n = 0; n < 2; ++n) _Pragma("unroll") for (int k = 0; k < 2; ++k) dst[n][k] = *(const PG8_LAS bf16x8*)(lds + PG8_SB(b, h) + boff + n * 2048 + k * 1024); } while (0)
#define PG8_MMA(ai, bj, At, Bt) do { __builtin_amdgcn_s_setprio(1); _Pragma("unroll") for (int m = 0; m < 4; ++m) _Pragma("unroll") for (int n = 0; n < 2; ++n) _Pragma("unroll") for (int k = 0; k < 2; ++k) \
        acc[ai][bj][m][n] = __builtin_amdgcn_mfma_f32_16x16x32_bf16(Bt[n][k], At[m][k], acc[ai][bj][m][n], 0, 0, 0); __builtin_amdgcn_s_setprio(0); } while (0)
#define PG8_WAIT_V(n) asm volatile("s_waitcnt vmcnt(" #n ")" ::: "memory")
#define PG8_WAIT_L(n) asm volatile("s_waitcnt lgkmcnt(" #n ")" ::: "memory")
#define PG8_BAR __builtin_amdgcn_s_barrier()
#define PG8_SCHED __builtin_amdgcn_sched_barrier(0)
    Unit cur, nxt; int ui = 0;
    if (!S.next(0, cur)) return;
    f32x4 acc[2][2][4][2];
#pragma unroll
    for (int a = 0; a < 2; ++a)
#pragma unroll
        for (int b = 0; b < 2; ++b)
#pragma unroll
            for (int m = 0; m < 4; ++m)
#pragma unroll
                for (int n = 0; n < 2; ++n) acc[a][b][m][n] = (f32x4){0.f, 0.f, 0.f, 0.f};
    bf16x8 At[4][2], B0[2][2], B1[2][2];
    const char* cA = (const char*)g.A + (size_t)cur.pm * tstep; const char* cB = (const char*)g.Bt + (size_t)cur.pn * tstep;
    S.a_ready(cur);
    if constexpr (SP2) {
        PG8_STAGE(PG8_SB(0, 0), cB, voffB); PG8_STAGE(PG8_SB(0, 1), cB + hstep, voffB); PG8_STAGE(PG8_SA(0, 0), cA, voffA); PG8_STAGE(PG8_SA(0, 1), cA + hstep, voffA);
        if (wr == 1) PG8_BAR;
        PG8_WAIT_V(2); PG8_BAR;
        PG8_STAGE(PG8_SB(1, 0), cB + kstep, voffB); PG8_STAGE(PG8_SA(1, 0), cA + kstep, voffA); PG8_STAGE(PG8_SB(1, 1), cB + hstep + kstep, voffB);
        PG8_WAIT_V(6); PG8_BAR;
    } else {
        PG8_STAGE(PG8_SB(0, 0), cB, voffB); PG8_STAGE(PG8_SA(0, 0), cA, voffA); PG8_STAGE(PG8_SB(0, 1), cB + hstep, voffB); PG8_STAGE(PG8_SA(0, 1), cA + hstep, voffA);
        if (wr == 1) PG8_BAR;
        PG8_WAIT_V(4); PG8_BAR;
        PG8_STAGE(PG8_SB(1, 0), cB + kstep, voffB); PG8_STAGE(PG8_SA(1, 0), cA + kstep, voffA); PG8_STAGE(PG8_SB(1, 1), cB + hstep + kstep, voffB);
        PG8_WAIT_V(6); PG8_BAR;
    }
    for (;;) {
        const bool has_next = S.next(ui + 1, nxt);
        const char* nA = has_next ? (const char*)g.A + (size_t)nxt.pm * tstep : cA; const char* nB = has_next ? (const char*)g.Bt + (size_t)nxt.pn * tstep : cB;
        for (int t = 0; t < nt; t += 2) {
            const bool last = (t == nt - 2);
            const char* a1 = cA + (size_t)(t + 1) * kstep;
            const char* a2 = last ? nA : cA + (size_t)(t + 2) * kstep; const char* b2 = last ? nB : cB + (size_t)(t + 2) * kstep;
            const char* a3 = a2 + kstep; const char* b3 = b2 + kstep;
            if (last && has_next) S.a_ready(nxt);
            if constexpr (SP2) {
            PG8_LDB(B0, 0, 0); PG8_LDB(B1, 0, 1); PG8_SCHED; PG8_LDA(At, 0, 0); PG8_STAGE(PG8_SA(1, 1), a1 + hstep, voffA);
            PG8_WAIT_V(8); PG8_WAIT_L(0); PG8_BAR; PG8_MMA(0, 0, At, B0); PG8_MMA(0, 1, At, B1); PG8_BAR; PG8_SCHED;
            PG8_LDA(At, 0, 1); PG8_STAGE(PG8_SB(0, 0), b2, voffB); PG8_STAGE(PG8_SB(0, 1), b2 + hstep, voffB); PG8_STAGE(PG8_SA(0, 0), a2, voffA);
            PG8_WAIT_V(8); PG8_WAIT_L(0); PG8_BAR; PG8_MMA(1, 0, At, B0); PG8_MMA(1, 1, At, B1); PG8_BAR; PG8_SCHED;
            PG8_LDB(B0, 1, 0); PG8_LDB(B1, 1, 1); PG8_SCHED; PG8_LDA(At, 1, 0); PG8_STAGE(PG8_SA(0, 1), a2 + hstep, voffA);
            PG8_WAIT_V(8); PG8_WAIT_L(0); PG8_BAR; PG8_MMA(0, 0, At, B0); PG8_MMA(0, 1, At, B1); PG8_BAR; PG8_SCHED;
            PG8_LDA(At, 1, 1); PG8_STAGE(PG8_SB(1, 0), b3, voffB); PG8_STAGE(PG8_SB(1, 1), b3 + hstep, voffB); PG8_STAGE(PG8_SA(1, 0), a3, voffA);
            PG8_WAIT_V(8); PG8_WAIT_L(0); PG8_BAR; PG8_MMA(1, 0, At, B0); PG8_MMA(1, 1, At, B1); PG8_BAR; PG8_SCHED;
            } else {
            PG8_LDB(B0, 0, 0); PG8_SCHED; PG8_LDA(At, 0, 0); PG8_STAGE(PG8_SA(1, 1), a1 + hstep, voffA);
            PG8_WAIT_L(8); PG8_BAR; PG8_WAIT_L(0); PG8_MMA(0, 0, At, B0); PG8_BAR; PG8_SCHED;
            PG8_LDB(B1, 0, 1); PG8_STAGE(PG8_SB(0, 0), b2, voffB);
            PG8_BAR; PG8_WAIT_L(0); PG8_MMA(0, 1, At, B1); PG8_BAR;
            PG8_LDA(At, 0, 1); PG8_STAGE(PG8_SA(0, 0), a2, voffA);
            PG8_BAR; PG8_WAIT_L(0); PG8_MMA(1, 0, At, B0); PG8_BAR; PG8_SCHED;
            PG8_STAGE(PG8_SB(0, 1), b2 + hstep, voffB);
            PG8_WAIT_V(6); PG8_BAR; PG8_MMA(1, 1, At, B1); PG8_BAR;
            PG8_LDB(B0, 1, 0); PG8_SCHED; PG8_LDA(At, 1, 0); PG8_STAGE(PG8_SA(0, 1), a2 + hstep, voffA);
            PG8_WAIT_L(8); PG8_BAR; PG8_WAIT_L(0); PG8_MMA(0, 0, At, B0); PG8_BAR; PG8_SCHED;
            PG8_LDB(B1, 1, 1); PG8_STAGE(PG8_SB(1, 0), b3, voffB);
            PG8_BAR; PG8_WAIT_L(0); PG8_MMA(0, 1, At, B1); PG8_BAR;
            PG8_LDA(At, 1, 1); PG8_STAGE(PG8_SA(1, 0), a3, voffA);
            PG8_BAR; PG8_WAIT_L(0); PG8_MMA(1, 0, At, B0); PG8_BAR; PG8_SCHED;
            PG8_STAGE(PG8_SB(1, 1), b3 + hstep, voffB);
            PG8_WAIT_V(6); PG8_BAR; PG8_MMA(1, 1, At, B1); PG8_BAR;
            }
        }
        if constexpr (ALIGN_EPI) { if (wr == 0) PG8_BAR; }
        if constexpr (!Epi::AFTER_DRAIN) { int le_; asm volatile("v_mbcnt_lo_u32_b32 %0, -1, 0\n\tv_mbcnt_hi_u32_b32 %0, -1, %0" : "=v"(le_)); E(acc, cur, wr, wc, le_ & 15, le_ >> 4); S.done(cur); }
        if (!has_next) break;
#pragma unroll
        for (int a = 0; a < 2; ++a)
#pragma unroll
            for (int b = 0; b < 2; ++b)
#pragma unroll
                for (int m = 0; m < 4; ++m)
#pragma unroll
                    for (int n = 0; n < 2; ++n) acc[a][b][m][n] = (f32x4){0.f, 0.f, 0.f, 0.f};
        cur = nxt; cA = nA; cB = nB; ++ui;
        if constexpr (ALIGN_EPI) { if (wr == 1) PG8_BAR; }
    }
    PG8_WAIT_V(0);
    if constexpr (!ALIGN_EPI) { if (wr == 0) PG8_BAR; }
    PG8_BAR;
    if constexpr (Epi::AFTER_DRAIN) { E.fused(acc, cur, wr, wc, fr, fq, lds, wid, lane); S.done(cur); }
#undef PG8_SA
#undef PG8_SB
#undef PG8_STAGE
#undef PG8_LDA
#undef PG8_LDB
#undef PG8_MMA
#undef PG8_WAIT_V
#undef PG8_WAIT_L
#undef PG8_BAR
#undef PG8_SCHED
}
}

#define LAS __attribute__((address_space(3)))
constexpr int NWAVES = 8, NTHR = 512;
constexpr int LDS_BYTES = 147456;
constexpr int NPH = 21;
typedef float f32x4 __attribute__((ext_vector_type(4)));
typedef unsigned u32x4 __attribute__((ext_vector_type(4)));

struct Args { const float* in[30]; float* out; unsigned char* ws; int ph_lo, ph_hi; };

__device__ __forceinline__ unsigned pk2(float lo, float hi) { return cvtpk(lo, hi); }

__device__ __forceinline__ void p0_transpose_item(const float* W, int K, int N, bf16* WT, int row_off, LAS float* scr, int item, int lane) {
    const int nblk = N / 32, kb = item / nblk, nb = item % nblk, k0 = 64 * kb, n0 = 32 * nb;
#pragma unroll 8
    for (int i = 0; i < 32; ++i) { const int kk = 2 * i + (lane >> 5); scr[kk * 33 + (lane & 31)] = W[(size_t)(k0 + kk) * N + n0 + (lane & 31)]; }
    asm volatile("s_waitcnt lgkmcnt(0)" ::: "memory");
    const int c = lane & 7;
#pragma unroll
    for (int j = 0; j < 4; ++j) { const int n = (lane >> 3) + 8 * j; const LAS float* s = scr + (8 * c) * 33 + n;
        u32x4 o; o.x = pk2(s[0 * 33], s[1 * 33]); o.y = pk2(s[2 * 33], s[3 * 33]); o.z = pk2(s[4 * 33], s[5 * 33]); o.w = pk2(s[6 * 33], s[7 * 33]);
        *(u32x4*)(WT + (size_t)(row_off + n0 + n) * K + k0 + 8 * c) = o; }
    asm volatile("s_waitcnt lgkmcnt(0)" ::: "memory");
}

__device__ __forceinline__ void norm_mod_row(const float* xr, const float* gamma, const float* sh, const float* sc, bf16* orow, int lane) {
    f32x4 v[4]; float ss = 0.f;
#pragma unroll
    for (int j = 0; j < 4; ++j) { v[j] = *(const f32x4*)(xr + j * 256 + lane * 4); ss += (v[j].x * v[j].x + v[j].y * v[j].y) + (v[j].z * v[j].z + v[j].w * v[j].w); }
    const float rs = rsqrtf(wave_sum(ss, lane) * (1.f / D) + NORM_EPS);
#pragma unroll
    for (int j = 0; j < 4; ++j) { const int d = j * 256 + lane * 4; const f32x4 g = *(const f32x4*)(gamma + d), a = *(const f32x4*)(sc + d), s = *(const f32x4*)(sh + d);
        const f32x4 y = v[j] * rs * g * (a + 1.f) + s; uint2 o; o.x = pk2(y.x, y.y); o.y = pk2(y.z, y.w); *(uint2*)(orow + d) = o; }
}


#define XB_TMO      128
#define XB_XCNT(j)  (256  + 64 * (j))
#define XB_XSUB(j)  (1280 + 64 * (j))
#define XB_XGEN(j)  (2304 + 64 * (j))
#define XB_TOP      3328
#define XB_TOPGEN   3392
#define XCD_BAR_WORDS 3456
#define XB_SPIN_CAP (1u << 18)

__device__ __forceinline__ unsigned xb_ld(unsigned* p)              { return __hip_atomic_load(p, __ATOMIC_RELAXED, __HIP_MEMORY_SCOPE_AGENT); }
__device__ __forceinline__ unsigned xb_add(unsigned* p, unsigned v) { return __hip_atomic_fetch_add(p, v, __ATOMIC_RELAXED, __HIP_MEMORY_SCOPE_AGENT); }
__device__ __forceinline__ unsigned xb_xcc_id() { return (unsigned)__builtin_amdgcn_s_getreg((3 << 11) | 20) & 0xFu; }
#define XB_SPIN(cond, bar) do { unsigned _sp = 0; while (cond) { __builtin_amdgcn_s_sleep(1); \
    if ((++_sp & 255u) == 0u) { if (xb_ld(&(bar)[XB_TMO])) break; if (_sp > XB_SPIN_CAP) { atomicAdd(&(bar)[XB_TMO], 1u); break; } } } } while (0)

struct XcdBarrier {
    unsigned* bar; unsigned x; int w0;
    volatile __attribute__((address_space(3))) unsigned* st;
};

__device__ __forceinline__ XcdBarrier xcd_barrier_post(unsigned* bar, volatile __attribute__((address_space(3))) unsigned* st) {
    XcdBarrier b; b.bar = bar; b.x = xb_xcc_id(); b.st = st; b.w0 = __builtin_amdgcn_readfirstlane((int)threadIdx.x >> 6);
    if (threadIdx.x == 0) (void)xb_add(&bar[XB_XCNT(b.x)], 1u);
    return b;
}
__device__ __forceinline__ void xcd_barrier_complete(unsigned* bar, unsigned x, unsigned& nloc, unsigned& nx) {
    const unsigned G = gridDim.x * gridDim.y * gridDim.z;
    unsigned sum, cnt, mine, sp = 0u;
    for (;;) {
        sum = 0u; cnt = 0u; mine = 0u;
#pragma unroll
        for (unsigned j = 0; j < 16; ++j) { const unsigned c = xb_ld(&bar[XB_XCNT(j)]); sum += c; cnt += (c > 0u) ? 1u : 0u; }
        mine = xb_ld(&bar[XB_XCNT(x)]);
        if (sum == G) break;
        __builtin_amdgcn_s_sleep(1);
        if ((++sp & 255u) == 0u) { if (xb_ld(&bar[XB_TMO])) break; if (sp > XB_SPIN_CAP) { atomicAdd(&bar[XB_TMO], 1u); break; } }
    }
    nloc = mine > 0u ? mine : 1u; nx = cnt > 0u ? cnt : 1u;
}

template <bool FIRST> __device__ __forceinline__ void xcd_barrier(const XcdBarrier& b) {
    asm volatile("s_waitcnt vmcnt(0)" ::: "memory");
    __syncthreads();
    int lid_; asm volatile("v_mbcnt_lo_u32_b32 %0, -1, 0\n\tv_mbcnt_hi_u32_b32 %0, -1, %0" : "=v"(lid_));
    if (b.w0 == 0 && lid_ == 0) {
        unsigned* bar = b.bar;
        __builtin_amdgcn_s_waitcnt(0);
        unsigned nloc = b.st[0], nx = b.st[1];
        if (FIRST && nloc == 0u) { xcd_barrier_complete(bar, b.x, nloc, nx); b.st[0] = nloc; b.st[1] = nx; }
        const unsigned old = xb_add(&bar[XB_XSUB(b.x)], 1u);
        const unsigned gen = old / nloc;
        if (old + 1u == (gen + 1u) * nloc) {
            __builtin_amdgcn_fence(__ATOMIC_RELEASE, "agent");
            asm volatile("s_waitcnt vmcnt(0)" ::: "memory");
            const unsigned og = xb_add(&bar[XB_TOP], 1u);
            const unsigned tg = og / nx;
            if (og + 1u == (tg + 1u) * nx) xb_add(&bar[XB_TOPGEN], 1u);
            else XB_SPIN(xb_ld(&bar[XB_TOPGEN]) == tg, bar);
            __builtin_amdgcn_fence(__ATOMIC_ACQUIRE, "agent");
            xb_add(&bar[XB_XGEN(b.x)], 1u);
            asm volatile("s_waitcnt vmcnt(0)" ::: "memory");
        } else {
            XB_SPIN(xb_ld(&bar[XB_XGEN(b.x)]) == gen, bar);
            __builtin_amdgcn_fence(__ATOMIC_ACQUIRE, "agent");
            asm volatile("s_waitcnt vmcnt(0)" ::: "memory");
        }
    }
    __syncthreads();
}


__device__ __forceinline__ unsigned mono_u32(float f) { unsigned u = __float_as_uint(f); return (u & 0x80000000u) ? ~u : (u | 0x80000000u); }
__device__ __forceinline__ float demono_u32(unsigned u) { return __uint_as_float((u & 0x80000000u) ? (u & 0x7FFFFFFFu) : ~u); }
__device__ __forceinline__ unsigned pack_key7(float f, int idx) { return (mono_u32(f) & 0xFFFFFF80u) | (unsigned)(127 - idx); }
__device__ __forceinline__ float unpack_key7(unsigned k) { return demono_u32((k & 0xFFFFFF80u) | 0x40u); }
__device__ __forceinline__ float unpack_key8(unsigned k) { return demono_u32((k & 0xFFFFFF00u) | 0x80u); }
__device__ __forceinline__ void ce_desc(unsigned& a, unsigned& b) { const unsigned hi = a > b ? a : b, lo = a > b ? b : a; a = hi; b = lo; }
__device__ __forceinline__ void sort16_desc(unsigned* v) {
#pragma unroll
    for (int k = 2; k <= 16; k <<= 1)
#pragma unroll
        for (int j = k >> 1; j > 0; j >>= 1)
#pragma unroll
            for (int i = 0; i < 16; ++i) { const int l = i ^ j; if (l > i) { if ((i & k) == 0) ce_desc(v[i], v[l]); else ce_desc(v[l], v[i]); } }
}
__device__ __forceinline__ void bmerge16_desc(unsigned* v) {
#pragma unroll
    for (int j = 8; j > 0; j >>= 1)
#pragma unroll
        for (int i = 0; i < 16; ++i) { const int l = i ^ j; if (l > i) ce_desc(v[i], v[l]); }
}
__device__ __forceinline__ void merge_top16(unsigned* a, const unsigned* b) {
#pragma unroll
    for (int i = 0; i < 16; ++i) { const unsigned o = b[15 - i]; a[i] = a[i] > o ? a[i] : o; }
    bmerge16_desc(a);
}
__device__ __forceinline__ void stage2_cands(const unsigned* s0, const unsigned* s1, int hh, unsigned* c) {
    float A[16], B[16];
#pragma unroll
    for (int i = 0; i < 16; ++i) { const float f0 = unpack_key7(s0[i]), f1 = unpack_key7(s1[i]); A[i] = hh ? f1 : f0; B[i] = hh ? f0 : f1; }
    int n = 0;
#pragma unroll
    for (int i = 0; i < 4; ++i)
#pragma unroll
        for (int j = i; j < 16; ++j) { if ((i + 1) * (j + 1) > 16) continue;
            const float val = A[i] + B[j]; const unsigned id = hh ? (unsigned)((j << 4) | i) : (unsigned)((i << 4) | j);
            unsigned key = (mono_u32(val) & 0xFFFFFF00u) | id; if (hh && i == j) key = 0u; c[n++] = key; }
#pragma unroll
    for (; n < 32; ++n) c[n] = 0u;
}

typedef short bf16x8_t __attribute__((ext_vector_type(8)));
typedef float f32x16 __attribute__((ext_vector_type(16)));
__device__ __forceinline__ float gelu_erf(float a) { return 0.5f * a * (1.f + erff(a * 0.70710678118654752f)); }


typedef __attribute__((address_space(3))) bf16 lbf16;

__device__ __forceinline__ f32x16 mm32(bf16x8_t a, bf16x8_t b, f32x16 c) { return __builtin_amdgcn_mfma_f32_32x32x16_bf16(a, b, c, 0, 0, 0); }
__device__ __forceinline__ bf16x8_t frag_from_u32x4(unsigned x, unsigned y, unsigned z, unsigned w) { typedef unsigned u4 __attribute__((ext_vector_type(4))); u4 t = {x, y, z, w}; return __builtin_bit_cast(bf16x8_t, t); }
template <int S> __device__ __forceinline__ bf16x8_t accop(const f32x16& z) {
    return frag_from_u32x4(cvtpk(z[8 * S], z[8 * S + 1]), cvtpk(z[8 * S + 2], z[8 * S + 3]), cvtpk(z[8 * S + 4], z[8 * S + 5]), cvtpk(z[8 * S + 6], z[8 * S + 7])); }
template <int S> __device__ __forceinline__ bf16x8_t ldpermcol(const lbf16* a, int col, int hh) {
    const lbf16* p = a + (16 * S + 4 * hh) * 72 + col;
    const unsigned e0 = p[0], e1 = p[72], e2 = p[144], e3 = p[216], e4 = p[8 * 72], e5 = p[9 * 72], e6 = p[10 * 72], e7 = p[11 * 72];
    return frag_from_u32x4(e0 | (e1 << 16), e2 | (e3 << 16), e4 | (e5 << 16), e6 | (e7 << 16)); }
__device__ __forceinline__ bf16x8_t ldrow(const lbf16* a, int row, int ks, int hh) { return *(const __attribute__((address_space(3))) bf16x8_t*)(a + row * 72 + ks * 16 + 8 * hh); }
__device__ __forceinline__ int rowidx(int e, int hh) { return (e & 3) + 8 * (e >> 2) + 4 * hh; }

constexpr int CONV_S1_ROWS = 0;
constexpr int ROWB = 768;
__device__ __forceinline__ unsigned fp6code(float x, float sc) {
    const float t = fabsf(x) * sc;
    const float r = t < 16.f ? __builtin_rintf(t) : (t < 32.f ? 8.f + __builtin_rintf(t * 0.5f) : 16.f + __builtin_rintf(t * 0.25f));
    unsigned c = (unsigned)r; c = c > 31u ? 31u : c;
    return c | (x < 0.f ? 32u : 0u);
}
__device__ __forceinline__ void convert_tables_fp6(const float* pu, const float* pv, unsigned char* u8, unsigned char* v8, float* usc, float* vsc, int l, int wv, int nw, int lane, int q_lo, int q_hi) {
    for (int rr0 = q_lo + wv * 2; rr0 < q_hi; rr0 += nw * 2) {
        f32x4 v[2][4]; float m[2];
#pragma unroll
        for (int rr = 0; rr < 2; ++rr) { const int q = rr0 + rr; const size_t row = (size_t)l * NEXP + (q < NEXP ? q : q - NEXP); const float* sp_ = (q < NEXP ? pu : pv) + row * D + lane * 4;
#pragma unroll
            for (int k = 0; k < 4; ++k) v[rr][k] = *(const f32x4*)(sp_ + k * 256); }
#pragma unroll
        for (int rr = 0; rr < 2; ++rr) { float mm = 0.f;
#pragma unroll
            for (int k = 0; k < 4; ++k) mm = fmaxf(fmaxf(mm, fmaxf(fabsf(v[rr][k].x), fabsf(v[rr][k].y))), fmaxf(fabsf(v[rr][k].z), fabsf(v[rr][k].w)));
#pragma unroll
            for (int o = 1; o < 64; o <<= 1) mm = fmaxf(mm, shflx(mm, lane, o));
            m[rr] = mm; }
        { typedef float f32x16_t __attribute__((ext_vector_type(16))); typedef unsigned u32x6_t __attribute__((ext_vector_type(6)));
          const float sc0 = m[0] > 0.f ? 7.5f / m[0] : 1.f, sc1 = m[1] > 0.f ? 7.5f / m[1] : 1.f; f32x16_t pa, pb;
#pragma unroll
          for (int k = 0; k < 4; ++k) {
              pa[k * 2] = v[0][k].x * sc0; pb[k * 2] = v[0][k].y * sc0; pa[k * 2 + 1] = v[0][k].z * sc0; pb[k * 2 + 1] = v[0][k].w * sc0;
              pa[8 + k * 2] = v[1][k].x * sc1; pb[8 + k * 2] = v[1][k].y * sc1; pa[8 + k * 2 + 1] = v[1][k].z * sc1; pb[8 + k * 2 + 1] = v[1][k].w * sc1; }
          const u32x6_t pk = __builtin_amdgcn_cvt_scalef32_2xpk16_fp6_f32(pa, pb, 1.0f);
#pragma unroll
          for (int rr = 0; rr < 2; ++rr) { const int q = rr0 + rr; const size_t row = (size_t)l * NEXP + (q < NEXP ? q : q - NEXP);
              unsigned* op = (unsigned*)((q < NEXP ? u8 : v8) + row * ROWB + lane * 12);
              op[0] = pk[rr * 3]; op[1] = pk[rr * 3 + 1]; op[2] = pk[rr * 3 + 2];
              if (lane == 0) (q < NEXP ? usc : vsc)[row] = m[rr] > 0.f ? m[rr] * (1.f / 7.5f) : 1.f; } }
    }
}

__global__ void __launch_bounds__(NTHR, 2) mega(Args args) {
    extern __shared__ __attribute__((aligned(16))) unsigned char lds_raw[];
    LAS unsigned char* lds = (LAS unsigned char*)lds_raw;
    const int G = gridDim.x, bx = blockIdx.x, NGW = G * NWAVES;
    const int wave0 = __builtin_amdgcn_readfirstlane((int)threadIdx.x >> 6);
    typedef const unsigned char __attribute__((address_space(4))) kbyte;
#define PHASE_IDS int tid; asm volatile("v_mbcnt_lo_u32_b32 %0, -1, 0\n\tv_mbcnt_hi_u32_b32 %0, -1, %0" : "=v"(tid)); tid += wave0 * 64;     const int lane = tid & 63, wave = __builtin_amdgcn_readfirstlane(tid >> 6), gw = bx * NWAVES + wave; (void)lane; (void)gw; \
    kbyte* kp = (kbyte*)__builtin_amdgcn_kernarg_segment_ptr(); asm volatile("" : "+s"(kp)); \
    unsigned char* const ws = (unsigned char*)*(__attribute__((address_space(1))) unsigned char* const __attribute__((address_space(4)))*)(kp + 31 * 8); float* const X = (float*)*(__attribute__((address_space(1))) float* const __attribute__((address_space(4)))*)(kp + 30 * 8); (void)ws; (void)X;
#define INP(i) ((const float*)(*(const __attribute__((address_space(1))) float* const __attribute__((address_space(4)))*)(kp + (i) * 8)))
#define MOD ((float*)(ws + WS_MOD))
#define H ((bf16*)(ws + WS_H))
#define PROJ ((bf16*)(ws + WS_PROJ))
#define Q ((bf16*)(ws + WS_Q))
#define MIX ((bf16*)(ws + WS_MIX))
#define Rb ((bf16*)(ws + WS_R))
#define Kb ((bf16*)(ws + WS_K))
#define V0 ((bf16*)(ws + WS_V0))
#define V1 ((bf16*)(ws + WS_V1))
#define KKb ((bf16*)(ws + WS_KK))
#define Bb ((bf16*)(ws + WS_B))
#define Gb ((bf16*)(ws + WS_G))
#define BGb ((bf16*)(ws + WS_BG))
#define Wd ((float*)(ws + WS_W))
#define Y ((float*)(ws + WS_Y))
#define QB ((float*)(ws + WS_QB))
#define POOLIN ((bf16*)(ws + WS_QB))
#define SH ((float*)(ws + WS_SH))
#define SSQ ((unsigned long long*)(ws + WS_SH))
#define CVEC ((float*)(ws + WS_SH + 512 * 1024))
#define S2V ((float*)(ws + WS_SH + 640 * 1024))
#define XB2 ((bf16*)(ws + WS_R))
#define WUPT ((bf16*)(ws + WS_LORA))
#define AUPT ((bf16*)(ws + WS_LORA + 131072))
#define GUPT ((bf16*)(ws + WS_LORA + 262144))
#define VUPT ((bf16*)(ws + WS_LORA + 524288))
#define PWT ((bf16*)(ws + WS_LORA + 655360))
#define INVN ((float*)(ws + WS_INVN))
#define BSUM ((float*)(ws + WS_BSUM))
#define SCN ((unsigned char*)(ws + WS_SCN))
#define IDX ((int*)(ws + WS_IDX))
#define GATE ((float*)(ws + WS_GATE))
#define WinT ((bf16*)(ws + WS_WIN_T))
#define WoutT ((bf16*)(ws + WS_WOUT_T))
#define PqT ((bf16*)(ws + WS_PQ_T))
#define KEYS ((bf16*)(ws + WS_KEYS))
#define U8 ((unsigned char*)(ws + WS_U))
#define V8 ((unsigned char*)(ws + WS_V))
#define USc ((float*)(ws + WS_US))
#define VSc ((float*)(ws + WS_VS))
    const int lo = args.ph_lo, hi = args.ph_hi;
    { volatile LAS unsigned* misc = (volatile LAS unsigned*)(lds + LDS_BYTES - 64); if (threadIdx.x < 4) misc[threadIdx.x] = 0u; __syncthreads(); }
    const XcdBarrier xbar = xcd_barrier_post((unsigned*)(args.ws) + 4096, (volatile LAS unsigned*)(lds + LDS_BYTES - 64));
#define IN(k) (lo <= (k) && (k) < hi)
#ifndef REP_PHASE
#define REP_PHASE (-1)
#endif
#define REPS(k) ((k) == REP_PHASE ? 3 : 1)
#define SEAM(k) do { if (IN(k) && IN((k) + 1)) { if ((k) == 0) cg::this_grid().sync(); else { XcdBarrier xb_ = xbar; asm volatile("" : "+s"(xb_.bar)); if ((k) == 1) xcd_barrier<true>(xb_); else xcd_barrier<false>(xb_); } } } while (0)

    if (IN(0)) { PHASE_IDS
        { unsigned long long* z = SSQ; for (int i = bx * NTHR + tid; i < 2 * T; i += G * NTHR) z[i] = 0ull; }
        { LAS float* ca = (LAS float*)lds; LAS float* red = (LAS float*)(lds + 16384);
          const float* c = INP(1); const float* ada_w = INP(2); const float* ada_b = INP(3);
          bool have = false;
          for (int it = bx; it < 192; it += G) {
              if (!have) { for (int i = tid; i < BATCH * D; i += NTHR) { const float v = c[i]; ca[i] = v / (1.f + expf(-v)); } have = true; __syncthreads(); }
              const int l = it / 96, n = (it % 96) * 64 + (tid & 63), kq = tid >> 6;
              const float* w = ada_w + (size_t)l * D * 6 * D + (size_t)(kq * 128) * 6 * D + n;
              float a0 = 0.f, a1 = 0.f, a2 = 0.f, a3 = 0.f;
#pragma unroll 32
              for (int k = 0; k < 128; ++k) { const float wv = w[(size_t)k * 6 * D]; const int kk = kq * 128 + k; a0 += ca[kk] * wv; a1 += ca[D + kk] * wv; a2 += ca[2 * D + kk] * wv; a3 += ca[3 * D + kk] * wv; }
              red[(kq * 4 + 0) * 64 + (tid & 63)] = a0; red[(kq * 4 + 1) * 64 + (tid & 63)] = a1; red[(kq * 4 + 2) * 64 + (tid & 63)] = a2; red[(kq * 4 + 3) * 64 + (tid & 63)] = a3;
              __syncthreads();
              if (tid < 256) { const int b = tid >> 6, col = tid & 63, nn = (it % 96) * 64 + col; float s = 0.f;
#pragma unroll
                for (int q = 0; q < 8; ++q) s += red[(q * 4 + b) * 64 + col];
                MOD[(size_t)l * BATCH * 6 * D + (size_t)b * 6 * D + nn] = s + ada_b[l * 6 * D + nn]; }
              __syncthreads();
          }
          __syncthreads(); }
        { LAS float* scr = (LAS float*)(lds + wave * 16384);
          constexpr int I_IN = (D / 64) * (IN_COLS / 32), I_VR = (D / 64) * (MVL / 32), I_OUT = (D / 64) * (D / 32), I_PQ = (D / 64) * (PH * PQ / 32);
          constexpr int NIT = 2 * I_IN + I_VR + 2 * I_OUT + 2 * I_PQ;
          for (int it = gw; it < NIT; it += NGW) { int r = it;
              if (r < 2 * I_IN) { const int l = r / I_IN; p0_transpose_item(INP(5) + (size_t)l * D * IN_COLS, D, IN_COLS, WinT + (size_t)l * LDP * D, 0, scr, r % I_IN, lane); continue; } r -= 2 * I_IN;
              if (r < I_VR) { p0_transpose_item(INP(12), D, MVL, WinT + (size_t)1 * LDP * D, IN_COLS, scr, r, lane); continue; } r -= I_VR;
              if (r < 2 * I_OUT) { const int l = r / I_OUT; p0_transpose_item(INP(23) + (size_t)l * D * D, D, D, WoutT + (size_t)l * D * D, 0, scr, r % I_OUT, lane); continue; } r -= 2 * I_OUT;
              { const int l = r / I_PQ; p0_transpose_item(INP(25) + (size_t)l * D * PH * PQ, D, PH * PQ, PqT + (size_t)l * PH * PQ * D, 0, scr, r % I_PQ, lane); } }
          for (int it = gw; it < 2 * 16 + 2 * 16 + 2 * 32; it += NGW) { int r = it;
              if (r < 32) { const int l = r / 16; p0_transpose_item(INP(8) + (size_t)l * DL * RW, DL, RW, WUPT + (size_t)l * RW * DL, 0, scr, r % 16, lane); continue; } r -= 32;
              if (r < 32) { const int l = r / 16; p0_transpose_item(INP(10) + (size_t)l * AL * RW, AL, RW, AUPT + (size_t)l * RW * AL, 0, scr, r % 16, lane); continue; } r -= 32;
              { const int l = r / 32; p0_transpose_item(INP(11) + (size_t)l * GL * RW, GL, RW, GUPT + (size_t)l * RW * GL, 0, scr, r % 32, lane); } }
          { const float* vu = INP(15); for (int e = bx * NTHR + tid; e < MVL * RW; e += G * NTHR) { const int n = e >> 5, k = e & 31; VUPT[e] = f2bf(vu[k * RW + n]); } }
          for (int it = gw; it < 8 * 8; it += NGW) p0_transpose_item(INP(21) + (size_t)(it >> 3) * PG * PG, PG, PG, PWT + (size_t)(it >> 3) * PG * PG, 0, scr, it & 7, lane);
        }
        { const size_t gt = (size_t)bx * NTHR + tid, NT = (size_t)G * NTHR;
          constexpr size_t NK8 = (size_t)2 * PH * 2 * NKEYS * PHALF / 8;
          const float* src = INP(26); bf16* dst = KEYS;
          for (size_t i = gt; i < NK8; i += NT) {
              const f32x4 a = *(const f32x4*)(src + i * 8), b = *(const f32x4*)(src + i * 8 + 4);
              u32x4 o; o.x = pk2(a.x, a.y); o.y = pk2(a.z, a.w); o.z = pk2(b.x, b.y); o.w = pk2(b.z, b.w); *(u32x4*)(dst + i * 8) = o; }
        }
    }
    SEAM(0);

#pragma unroll
    for (int l = 0; l < DEPTH; ++l) {
        const int pb = 1 + 10 * l;
#define modl (MOD + (size_t)l * BATCH * 6 * D)
#define xin (l == 0 ? INP(0) : (const float*)X)
        if (l == 0 && IN(pb + 0)) { PHASE_IDS const float* gamma = INP(4) + l * D;
            for (int row = gw; row < T; row += NGW) { const int b = row / SEQ; norm_mod_row(xin + (size_t)row * D, gamma, modl + (size_t)b * 6 * D, modl + (size_t)b * 6 * D + D, H + (size_t)row * D, lane); } }
        SEAM(pb + 0);
        if (IN(pb + 1)) { PHASE_IDS const int N1 = l == 0 ? IN_COLS : LDP;
            pg8::Gemm g{H, WinT + (size_t)l * LDP * D, T, N1, D}; pg8::StaticOrder S; S.init(T, N1, G, bx);
            pg8::EpiProj E{PROJ, LDP, POOLIN, RWKV_COLS, PW};
            pg8::gemm_phase<pg8::EpiProj, pg8::StaticOrder, true, true>(lds, g, S, E, tid); }
        SEAM(pb + 1);

        if (IN(pb + 2)) { PHASE_IDS
            constexpr int LST = 296;
            LAS bf16* lin = (LAS bf16*)lds;
            const float* mu = INP(6) + l * RWKV_COLS; const float* vmu = INP(13);
            const float* w0p = INP(7) + l * RW; const float* a0p = INP(9) + l * RW; const float* kkp = INP(16) + l * RW; const float* kap = INP(17) + l * RW; const float* rkp = INP(18) + l * RW; const float* v0p = INP(14);
            const bf16* wupT = WUPT + (size_t)l * RW * DL; const bf16* aupT = AUPT + (size_t)l * RW * AL; const bf16* gupT = GUPT + (size_t)l * RW * GL; const bf16* vupT = VUPT;
            bf16* Vl = l == 0 ? V0 : V1;
            const int r32 = lane & 31, hh = lane >> 5, h = wave;
            for (int tile = bx; tile < T / 32; tile += G) {
                const int t0 = tile * 32;
                __syncthreads();
#pragma unroll 1
                for (int it0 = 0; it0 < 3; it0 += 2) {
                  u32x4 cu_[2], pv_[2]; f32x4 m0_[2], m1_[2];
#pragma unroll
                  for (int it = 0; it < 2; ++it) { const int c8 = tid + (it0 + it) * NTHR; const bool ok = c8 < 32 * 36; const int tok = ok ? c8 / 36 : 0, jc = ok ? c8 % 36 : 0, t = t0 + tok, sq = t % SEQ;
                      cu_[it] = (u32x4){0u, 0u, 0u, 0u}; pv_[it] = (u32x4){0u, 0u, 0u, 0u}; m0_[it] = (f32x4){0.f, 0.f, 0.f, 0.f}; m1_[it] = m0_[it];
                      if (ok && (jc < 32 || l > 0)) { const int col = jc < 32 ? 3 * RW + jc * 8 : IN_COLS + (jc - 32) * 8;
                          cu_[it] = *(const u32x4*)(PROJ + (size_t)t * LDP + col); if (sq > 0) pv_[it] = *(const u32x4*)(PROJ + (size_t)(t - 1) * LDP + col);
                          const float* mp = jc < 32 ? mu + col : vmu + (jc - 32) * 8; m0_[it] = *(const f32x4*)mp; m1_[it] = *(const f32x4*)(mp + 4); } }
#pragma unroll
                  for (int it = 0; it < 2; ++it) { const int c8 = tid + (it0 + it) * NTHR; if (c8 < 32 * 36) { const int tok = c8 / 36, jc = c8 % 36;
                      u32x4 o = {0u, 0u, 0u, 0u};
                      if (jc < 32 || l > 0) {
                          float x[8]; const unsigned cw[4] = {cu_[it].x, cu_[it].y, cu_[it].z, cu_[it].w}, pw[4] = {pv_[it].x, pv_[it].y, pv_[it].z, pv_[it].w}; const float mm[8] = {m0_[it].x, m0_[it].y, m0_[it].z, m0_[it].w, m1_[it].x, m1_[it].y, m1_[it].z, m1_[it].w};
#pragma unroll
                          for (int i = 0; i < 4; ++i) { const float c0 = __uint_as_float(cw[i] << 16), c1 = __uint_as_float(cw[i] & 0xffff0000u), p0 = __uint_as_float(pw[i] << 16), p1 = __uint_as_float(pw[i] & 0xffff0000u);
                              x[2 * i] = c0 + (p0 - c0) * mm[2 * i]; x[2 * i + 1] = c1 + (p1 - c1) * mm[2 * i + 1]; }
                          if (jc < 8) {
#pragma unroll
                              for (int i = 0; i < 8; ++i) { const float e2 = __expf(-2.f * fabsf(x[i])); const float th = (1.f - e2) * __builtin_amdgcn_rcpf(1.f + e2); x[i] = x[i] < 0.f ? -th : th; } }
                          else if (jc >= 16 && jc < 32) {
#pragma unroll
                              for (int i = 0; i < 8; ++i) x[i] = __builtin_amdgcn_rcpf(1.f + __expf(-x[i])); }
                          o.x = pk2(x[0], x[1]); o.y = pk2(x[2], x[3]); o.z = pk2(x[4], x[5]); o.w = pk2(x[6], x[7]);
                      }
                      *(LAS u32x4*)(lin + tok * LST + jc * 8) = o; } } }
                __syncthreads();
                const bool first = (t0 % SEQ) == 0;
                lbf16* tin = (lbf16*)(lds + 19456 + wave * 14336);
                { u32x4 iq[13]; int ql_; asm volatile("v_mbcnt_lo_u32_b32 %0, -1, 0\n\tv_mbcnt_hi_u32_b32 %0, -1, %0" : "=v"(ql_));
#pragma unroll
                  for (int i = 0; i < 13; ++i) { const int q = ql_ + 64 * i; iq[i] = (u32x4){0u, 0u, 0u, 0u};
                      if (q < 792) { const int arr = q / 264, rem = q - arr * 264, row = rem >> 3, cc = rem & 7;
                          if (!(first && row == 0)) iq[i] = *(const u32x4*)(PROJ + (size_t)(t0 - 1 + row) * LDP + arr * RW + h * HS + cc * 8); } }
#pragma unroll
                  for (int i = 0; i < 13; ++i) { const int q = ql_ + 64 * i; if (q < 792) { const int arr = q / 264, rem = q - arr * 264, row = rem >> 3, cc = rem & 7;
                      *(__attribute__((address_space(3))) u32x4*)(tin + arr * 2376 + row * 72 + cc * 8) = iq[i]; } } }
                __builtin_amdgcn_wave_barrier(); asm volatile("s_waitcnt lgkmcnt(0)" ::: "memory");
                float ssq[16], bsm[16];
#pragma unroll
                for (int e = 0; e < 16; ++e) { ssq[e] = 0.f; bsm[e] = 0.f; }
#pragma unroll 1
                for (int rt = 0; rt < 2; ++rt) {
                    f32x16 accW, accA, accG, accV;
#pragma unroll
                    for (int e = 0; e < 16; ++e) { accW[e] = 0.f; accA[e] = 0.f; accG[e] = 0.f; accV[e] = 0.f; }
                    int c = h * HS + rt * 32 + r32;
int hh8 = 8 * hh; asm volatile("" : "+v"(c), "+v"(hh8));
                    const LAS bf16* lrow = lin + r32 * LST + 8 * hh;
                    { bf16x8_t wf[18];
#pragma unroll
                      for (int ks = 0; ks < 4; ++ks) { wf[ks] = *(const bf16x8_t*)(wupT + (size_t)c * DL + ks * 16 + hh8); wf[4 + ks] = *(const bf16x8_t*)(aupT + (size_t)c * AL + ks * 16 + hh8); }
#pragma unroll
                      for (int ks = 0; ks < 8; ++ks) wf[8 + ks] = *(const bf16x8_t*)(gupT + (size_t)c * GL + ks * 16 + hh8);
                      wf[16] = bf16x8_t{}; wf[17] = bf16x8_t{};
                      if (l > 0) { wf[16] = *(const bf16x8_t*)(vupT + (size_t)c * MVL + hh8); wf[17] = *(const bf16x8_t*)(vupT + (size_t)c * MVL + 16 + hh8); }
#pragma unroll
                      for (int ks = 0; ks < 4; ++ks) { accW = __builtin_amdgcn_mfma_f32_32x32x16_bf16(*(const LAS bf16x8_t*)(lrow + ks * 16), wf[ks], accW, 0, 0, 0);
                                                       accA = __builtin_amdgcn_mfma_f32_32x32x16_bf16(*(const LAS bf16x8_t*)(lrow + 64 + ks * 16), wf[4 + ks], accA, 0, 0, 0); }
#pragma unroll
                      for (int ks = 0; ks < 8; ++ks) accG = __builtin_amdgcn_mfma_f32_32x32x16_bf16(*(const LAS bf16x8_t*)(lrow + 128 + ks * 16), wf[8 + ks], accG, 0, 0, 0);
                      if (l > 0) {
#pragma unroll
                          for (int ks = 0; ks < 2; ++ks) accV = __builtin_amdgcn_mfma_f32_32x32x16_bf16(*(const LAS bf16x8_t*)(lrow + 256 + ks * 16), wf[16 + ks], accV, 0, 0, 0); } }
                    const float mur = mu[c], muk = mu[RW + c], muv = mu[2 * RW + c], w0c = w0p[c], a0c = a0p[c], kkc = kkp[c], kac = kap[c], rkc = rkp[c];
                    const float v0c = l > 0 ? v0p[c] : 0.f;
#pragma unroll
                    for (int eb = 0; eb < 16; eb += 4) {
                        bf16 lr[4], lk[4], lv[4], lrp[4], lkp[4], lvp[4], lvf[4];
#pragma unroll
                        for (int i = 0; i < 4; ++i) { const int e = eb + i; const int tok = (e & 3) + 8 * (e >> 2) + 4 * hh, t = t0 + tok; const int ci = rt * 32 + r32;
                            lr[i] = tin[(tok + 1) * 72 + ci]; lk[i] = tin[2376 + (tok + 1) * 72 + ci]; lv[i] = tin[2 * 2376 + (tok + 1) * 72 + ci];
                            lrp[i] = tin[tok * 72 + ci]; lkp[i] = tin[2376 + tok * 72 + ci]; lvp[i] = tin[2 * 2376 + tok * 72 + ci];
                            lvf[i] = l > 0 ? V0[(size_t)t * RW + c] : (bf16)0; }
                        __builtin_amdgcn_sched_barrier(0);
#pragma unroll
                        for (int i = 0; i < 4; ++i) { const int e = eb + i; const int tok = (e & 3) + 8 * (e >> 2) + 4 * hh, t = t0 + tok; const size_t o = (size_t)t * RW + c;
                            float r = bf2f(lr[i]), k = bf2f(lk[i]), v = bf2f(lv[i]);
                            r += (bf2f(lrp[i]) - r) * mur; k += (bf2f(lkp[i]) - k) * muk; v += (bf2f(lvp[i]) - v) * muv;
                            const float z = -(w0c + accW[e]); const float sp = fmaxf(z, 0.f) + __logf(1.f + __expf(-fabsf(z)));
                            const float decay = __expf(-__expf(-sp - 0.5f));
                            const float a = __builtin_amdgcn_rcpf(1.f + __expf(-(a0c + accA[e]))); const float g = accG[e];
                            if (l > 0) { const float vfv = bf2f(lvf[i]); v = v + (vfv - v) * __builtin_amdgcn_rcpf(1.f + __expf(-(v0c + accV[e]))); }
                            const float kk = k * kkc; const float k2 = k * (1.f + (a - 1.f) * kac);
                            ssq[e] += kk * kk; bsm[e] += r * k2 * rkc;
                            { const unsigned p0_ = cvtpk(r, k2), p1_ = cvtpk(v, kk), p2_ = cvtpk(kk * a, g), p3_ = cvtpk(v * g, 0.f);
                              Rb[o] = (bf16)p0_; Kb[o] = (bf16)(p0_ >> 16); Vl[o] = (bf16)p1_; KKb[o] = (bf16)(p1_ >> 16); Bb[o] = (bf16)p2_; Gb[o] = (bf16)(p2_ >> 16); BGb[o] = (bf16)p3_; Wd[o] = decay; }
                        }
                    }
                }
#pragma unroll
                for (int e = 0; e < 16; ++e) { const int ln_ = r32 | (hh << 5); float a_ = red16(ssq[e]), b_ = red16(bsm[e]); a_ += shflx(a_, ln_, 16); b_ += shflx(b_, ln_, 16); ssq[e] = a_; bsm[e] = b_; }
                if (r32 == 0) {
#pragma unroll
                    for (int e = 0; e < 16; ++e) { const int tok = (e & 3) + 8 * (e >> 2) + 4 * hh; INVN[(size_t)(t0 + tok) * NH + h] = rsqrtf(fmaxf(ssq[e], 1e-24f)); BSUM[(size_t)(t0 + tok) * NH + h] = bsm[e]; } }
            }
        }
        if (IN(pb + 2) && IN(pb + 3)) { asm volatile("s_waitcnt vmcnt(0)" ::: "memory"); __syncthreads(); }

        if (IN(pb + 3)) { PHASE_IDS
            const bf16* Vl = l == 0 ? V0 : V1;
            const int r32 = lane & 31, hh = lane >> 5;
            if (wave < 6) {
                lbf16* At = (lbf16*)(lds + wave * 23552); lbf16* Bt = At + 2304; lbf16* Kt = Bt + 2304; lbf16* Rt = Kt + 2304; lbf16* Vv = Rt + 2304;
                LAS float* PCs = (LAS float*)(lds + wave * 23552 + 23040);
                const int ntl = bx < T / 32 ? (T / 32 - bx + G - 1) / G : 0;
                for (int q = wave; q < ntl * NH; q += 6) {
                    const int tile = bx + (q >> 3) * G, h = q & 7, b = tile >> 7, chunk = tile & 127, bh = b * NH + h, item = bh * (SEQ / 32) + chunk; const size_t t0 = (size_t)tile * 32;
                    __builtin_amdgcn_wave_barrier(); asm volatile("s_waitcnt lgkmcnt(0)" ::: "memory");
                    {
                      const int tk = lane >> 3, part = lane & 7;
                      u32x4 qr[4], qk[4], qv[4], qkk[4], qb[4]; f32x4 qw0[4], qw1[4]; float qin[4];
#pragma unroll
                      for (int p4 = 0; p4 < 4; ++p4) { const size_t o = (t0 + p4 * 8 + tk) * RW + h * HS + part * 8;
                          qr[p4] = *(const u32x4*)(Rb + o); qk[p4] = *(const u32x4*)(Kb + o); qv[p4] = *(const u32x4*)(Vl + o); qkk[p4] = *(const u32x4*)(KKb + o); qb[p4] = *(const u32x4*)(Bb + o);
                          qw0[p4] = *(const f32x4*)(Wd + o); qw1[p4] = *(const f32x4*)(Wd + o + 4); qin[p4] = INVN[(t0 + p4 * 8 + tk) * NH + h]; }
                      LAS float* Pl = (LAS float*)At;
#pragma unroll
                      for (int p4 = 0; p4 < 4; ++p4) { *(LAS f32x4*)(Pl + (p4 * 8 + tk) * 64 + part * 8) = qw0[p4]; *(LAS f32x4*)(Pl + (p4 * 8 + tk) * 64 + part * 8 + 4) = qw1[p4]; }
                      __builtin_amdgcn_wave_barrier(); asm volatile("s_waitcnt lgkmcnt(0)" ::: "memory");
                      { float P = 1.f;
#pragma unroll 8
                        for (int c = 0; c < 32; ++c) { P *= Pl[c * 64 + lane]; Pl[c * 64 + lane] = P; }
                        PCs[lane] = P; }
                      __builtin_amdgcn_wave_barrier(); asm volatile("s_waitcnt lgkmcnt(0)" ::: "memory");
                      u32x4 oa[4], orr[4], ob_[4], ok_[4];
#pragma unroll
                      for (int p4 = 0; p4 < 4; ++p4) { const int c = p4 * 8 + tk;
                          const f32x4 pa = *(const LAS f32x4*)(Pl + c * 64 + part * 8), pb2 = *(const LAS f32x4*)(Pl + c * 64 + part * 8 + 4);
                          f32x4 ma = {1.f, 1.f, 1.f, 1.f}, mb = ma; if (c > 0) { ma = *(const LAS f32x4*)(Pl + (c - 1) * 64 + part * 8); mb = *(const LAS f32x4*)(Pl + (c - 1) * 64 + part * 8 + 4); }
                          const float Pc[8] = {pa.x, pa.y, pa.z, pa.w, pb2.x, pb2.y, pb2.z, pb2.w}, Pm[8] = {ma.x, ma.y, ma.z, ma.w, mb.x, mb.y, mb.z, mb.w};
                          const unsigned rw_[4] = {qr[p4].x, qr[p4].y, qr[p4].z, qr[p4].w}, kw_[4] = {qk[p4].x, qk[p4].y, qk[p4].z, qk[p4].w}, kkw[4] = {qkk[p4].x, qkk[p4].y, qkk[p4].z, qkk[p4].w}, bw_[4] = {qb[p4].x, qb[p4].y, qb[p4].z, qb[p4].w};
                          unsigned xa[4], xr[4], xb[4], xk[4]; const float inv = qin[p4];
#pragma unroll
                          for (int i = 0; i < 4; ++i) { const float ip0 = __builtin_amdgcn_rcpf(Pc[2 * i]), ip1 = __builtin_amdgcn_rcpf(Pc[2 * i + 1]);
                              xa[i] = pk2(-__uint_as_float(kkw[i] << 16) * inv * Pm[2 * i], -__uint_as_float(kkw[i] & 0xffff0000u) * inv * Pm[2 * i + 1]);
                              xr[i] = pk2(__uint_as_float(rw_[i] << 16) * Pc[2 * i], __uint_as_float(rw_[i] & 0xffff0000u) * Pc[2 * i + 1]);
                              xb[i] = pk2(__uint_as_float(bw_[i] << 16) * inv * ip0, __uint_as_float(bw_[i] & 0xffff0000u) * inv * ip1);
                              xk[i] = pk2(__uint_as_float(kw_[i] << 16) * ip0, __uint_as_float(kw_[i] & 0xffff0000u) * ip1); }
                          oa[p4] = (u32x4){xa[0], xa[1], xa[2], xa[3]}; orr[p4] = (u32x4){xr[0], xr[1], xr[2], xr[3]}; ob_[p4] = (u32x4){xb[0], xb[1], xb[2], xb[3]}; ok_[p4] = (u32x4){xk[0], xk[1], xk[2], xk[3]}; }
                      __builtin_amdgcn_wave_barrier(); asm volatile("s_waitcnt lgkmcnt(0)" ::: "memory");
#pragma unroll
                      for (int p4 = 0; p4 < 4; ++p4) { const int c = p4 * 8 + tk, o = c * 72 + part * 8;
                          *(__attribute__((address_space(3))) u32x4*)(At + o) = oa[p4]; *(__attribute__((address_space(3))) u32x4*)(Rt + o) = orr[p4]; *(__attribute__((address_space(3))) u32x4*)(Bt + o) = ob_[p4];
                          *(__attribute__((address_space(3))) u32x4*)(Kt + o) = ok_[p4]; *(__attribute__((address_space(3))) u32x4*)(Vv + o) = qv[p4]; } }
                    __builtin_amdgcn_wave_barrier(); asm volatile("s_waitcnt lgkmcnt(0)" ::: "memory");
                    const f32x16 zero16 = {0.f, 0.f, 0.f, 0.f, 0.f, 0.f, 0.f, 0.f, 0.f, 0.f, 0.f, 0.f, 0.f, 0.f, 0.f, 0.f};
                    f32x16 X = zero16, Yt = zero16;
#pragma unroll
                    for (int ks = 0; ks < 4; ++ks) { const bf16x8_t fa = ldrow(At, r32, ks, hh), fb = ldrow(Bt, r32, ks, hh); X = mm32(fa, fb, X); Yt = mm32(fb, fa, Yt); }
#pragma unroll
                    for (int e = 0; e < 16; ++e) { const int ri = rowidx(e, hh); X[e] = (r32 < ri) ? X[e] : 0.f; Yt[e] = (ri < r32) ? Yt[e] : 0.f; }
                    f32x16 TY = Yt;
#pragma unroll
                    for (int e = 0; e < 16; ++e) TY[e] += (rowidx(e, hh) == r32) ? 1.f : 0.f;
#pragma unroll 1
                    for (int it = 0; it < 4; ++it) {
                        const bf16x8_t x0 = accop<0>(X), x1 = accop<1>(X), y0 = accop<0>(Yt), y1 = accop<1>(Yt);
                        f32x16 Xn = mm32(y0, x0, zero16); Xn = mm32(y1, x1, Xn);
                        f32x16 Yn = mm32(x0, y0, zero16); Yn = mm32(x1, y1, Yn);
                        X = Xn; Yt = Yn;
                        const bf16x8_t p0 = accop<0>(X), p1 = accop<1>(X), t0_ = accop<0>(TY), t1_ = accop<1>(TY);
                        TY = mm32(p0, t0_, TY); TY = mm32(p1, t1_, TY);
                    }
                    const bf16x8_t ty0 = accop<0>(TY), ty1 = accop<1>(TY);
                    unsigned char* rec = SCN + (size_t)item * 24576;
                    const bf16x8_t v00 = ldpermcol<0>(Vv, r32, hh), v01 = ldpermcol<1>(Vv, r32, hh), v10 = ldpermcol<0>(Vv, 32 + r32, hh), v11 = ldpermcol<1>(Vv, 32 + r32, hh);
                    f32x16 U0a, U0b;
                    { f32x16 G2T = zero16;
#pragma unroll
                      for (int ks = 0; ks < 4; ++ks) G2T = mm32(ldrow(Kt, r32, ks, hh), ldrow(At, r32, ks, hh), G2T);
#pragma unroll
                      for (int e = 0; e < 16; ++e) G2T[e] = (rowidx(e, hh) < r32) ? G2T[e] : 0.f;
                      const bf16x8_t g0 = accop<0>(G2T), g1 = accop<1>(G2T);
                      f32x16 Za = mm32(g0, v00, zero16); Za = mm32(g1, v01, Za); f32x16 Zb = mm32(g0, v10, zero16); Zb = mm32(g1, v11, Zb);
                      U0a = mm32(ty0, accop<0>(Za), zero16); U0a = mm32(ty1, accop<1>(Za), U0a); U0b = mm32(ty0, accop<0>(Zb), zero16); U0b = mm32(ty1, accop<1>(Zb), U0b); }
                    const bf16x8_t ua0 = accop<0>(U0a), ua1 = accop<1>(U0a), ub0 = accop<0>(U0b), ub1 = accop<1>(U0b);
                    f32x16 G3T = zero16;
                    { f32x16 G4T = zero16;
#pragma unroll
                      for (int ks = 0; ks < 4; ++ks) { const bf16x8_t fr = ldrow(Rt, r32, ks, hh); G3T = mm32(ldrow(Bt, r32, ks, hh), fr, G3T); G4T = mm32(ldrow(Kt, r32, ks, hh), fr, G4T); }
#pragma unroll
                      for (int e = 0; e < 16; ++e) { const bool keep = rowidx(e, hh) <= r32; G3T[e] = keep ? G3T[e] : 0.f; G4T[e] = keep ? G4T[e] : 0.f; }
                      const bf16x8_t g30 = accop<0>(G3T), g31 = accop<1>(G3T), g40 = accop<0>(G4T), g41 = accop<1>(G4T);
                      f32x16 Ya = mm32(g30, ua0, zero16); Ya = mm32(g31, ua1, Ya); Ya = mm32(g40, v00, Ya); Ya = mm32(g41, v01, Ya);
                      f32x16 Yb = mm32(g30, ub0, zero16); Yb = mm32(g31, ub1, Yb); Yb = mm32(g40, v10, Yb); Yb = mm32(g41, v11, Yb);
                      u32x4 o0, o1;
                      o0.x = cvtpk(Ya[0], Ya[1]); o0.y = cvtpk(Ya[2], Ya[3]); o0.z = cvtpk(Ya[4], Ya[5]); o0.w = cvtpk(Ya[6], Ya[7]);
                      o1.x = cvtpk(Ya[8], Ya[9]); o1.y = cvtpk(Ya[10], Ya[11]); o1.z = cvtpk(Ya[12], Ya[13]); o1.w = cvtpk(Ya[14], Ya[15]);
                      *(u32x4*)(rec + 12288 + 4096 + lane * 32) = o0; *(u32x4*)(rec + 12288 + 4096 + lane * 32 + 16) = o1;
                      o0.x = cvtpk(Yb[0], Yb[1]); o0.y = cvtpk(Yb[2], Yb[3]); o0.z = cvtpk(Yb[4], Yb[5]); o0.w = cvtpk(Yb[6], Yb[7]);
                      o1.x = cvtpk(Yb[8], Yb[9]); o1.y = cvtpk(Yb[10], Yb[11]); o1.z = cvtpk(Yb[12], Yb[13]); o1.w = cvtpk(Yb[14], Yb[15]);
                      *(u32x4*)(rec + 12288 + 6144 + 4096 + lane * 32) = o0; *(u32x4*)(rec + 12288 + 6144 + 4096 + lane * 32 + 16) = o1; }
                    f32x16 Wa0 = mm32(ty0, ldpermcol<0>(At, r32, hh), zero16); Wa0 = mm32(ty1, ldpermcol<1>(At, r32, hh), Wa0);
                    f32x16 Wa1 = mm32(ty0, ldpermcol<0>(At, 32 + r32, hh), zero16); Wa1 = mm32(ty1, ldpermcol<1>(At, 32 + r32, hh), Wa1);
                    const bf16x8_t wa00 = accop<0>(Wa0), wa01 = accop<1>(Wa0), wa10 = accop<0>(Wa1), wa11 = accop<1>(Wa1);
                    { const bf16x8_t g30 = accop<0>(G3T), g31 = accop<1>(G3T);
                      f32x16 Ra = mm32(wa00, g30, zero16); Ra = mm32(wa01, g31, Ra); f32x16 Rb_ = mm32(wa10, g30, zero16); Rb_ = mm32(wa11, g31, Rb_);
#pragma unroll
                      for (int e = 0; e < 16; ++e) { const int kr = rowidx(e, hh); Ra[e] += bf2f(Rt[r32 * 72 + kr]); Rb_[e] += bf2f(Rt[r32 * 72 + 32 + kr]); }
                      *(bf16x8_t*)(rec + 8192 + 0 * 1024 + lane * 16) = accop<0>(Ra); *(bf16x8_t*)(rec + 8192 + 1 * 1024 + lane * 16) = accop<1>(Ra);
                      *(bf16x8_t*)(rec + 8192 + 2 * 1024 + lane * 16) = accop<0>(Rb_); *(bf16x8_t*)(rec + 8192 + 3 * 1024 + lane * 16) = accop<1>(Rb_); }
                    const bf16x8_t b00 = ldpermcol<0>(Bt, r32, hh), b01 = ldpermcol<1>(Bt, r32, hh), b10 = ldpermcol<0>(Bt, 32 + r32, hh), b11 = ldpermcol<1>(Bt, 32 + r32, hh);
                    { const float pc0 = PCs[r32], pc1 = PCs[32 + r32];
#pragma unroll
                      for (int ij = 0; ij < 4; ++ij) { const int i = ij >> 1, j = ij & 1;
                          f32x16 M = mm32(i ? wa10 : wa00, j ? b10 : b00, zero16); M = mm32(i ? wa11 : wa01, j ? b11 : b01, M);
#pragma unroll
                          for (int e = 0; e < 16; ++e) { float m = M[e]; if (i == j) m += (rowidx(e, hh) == r32) ? 1.f : 0.f; M[e] = m * (j ? pc1 : pc0); }
                          *(bf16x8_t*)(rec + (ij * 2 + 0) * 1024 + lane * 16) = accop<0>(M); *(bf16x8_t*)(rec + (ij * 2 + 1) * 1024 + lane * 16) = accop<1>(M); } }
                    { const bf16x8_t k00 = ldpermcol<0>(Kt, r32, hh), k01 = ldpermcol<1>(Kt, r32, hh), k10 = ldpermcol<0>(Kt, 32 + r32, hh), k11 = ldpermcol<1>(Kt, 32 + r32, hh);
#pragma unroll
                      for (int ju = 0; ju < 4; ++ju) { const int j = ju >> 1, u = ju & 1;
                          f32x16 Dm = mm32(j ? b10 : b00, u ? ub0 : ua0, zero16); Dm = mm32(j ? b11 : b01, u ? ub1 : ua1, Dm);
                          Dm = mm32(j ? k10 : k00, u ? v10 : v00, Dm); Dm = mm32(j ? k11 : k01, u ? v11 : v01, Dm);
#pragma unroll
                          for (int e = 0; e < 16; ++e) Dm[e] *= PCs[32 * j + rowidx(e, hh)];
                          u32x4 o0, o1;
                          o0.x = cvtpk(Dm[0], Dm[1]); o0.y = cvtpk(Dm[2], Dm[3]); o0.z = cvtpk(Dm[4], Dm[5]); o0.w = cvtpk(Dm[6], Dm[7]);
                          o1.x = cvtpk(Dm[8], Dm[9]); o1.y = cvtpk(Dm[10], Dm[11]); o1.z = cvtpk(Dm[12], Dm[13]); o1.w = cvtpk(Dm[14], Dm[15]);
                          *(u32x4*)(rec + 12288 + u * 6144 + j * 2048 + lane * 32) = o0; *(u32x4*)(rec + 12288 + u * 6144 + j * 2048 + lane * 32 + 16) = o1; } }
                }
            }
        }
        { XcdBarrier xb_ = xbar; asm volatile("" : "+s"(xb_.bar)); xcd_barrier<false>(xb_); }
        if (IN(pb + 3)) { PHASE_IDS
            const int r32 = lane & 31, hh = lane >> 5;
            constexpr int SLOT = 18432, NCH = SEQ / 32, NSL = 7, AHEAD = 5;
            const bool spare = G > BATCH * NH * 2; const int cw = spare ? bx - BATCH * NH * 2 : bx, cn = spare ? G - BATCH * NH * 2 : G;
            if (cw >= 0) {
                for (int i = cw * NTHR + tid; i < BATCH * D; i += cn * NTHR) { const int b = i / D, d = i % D; S2V[(size_t)l * BATCH * D + i] = INP(24)[l * D + d] * (1.f + modl[(size_t)b * 6 * D + 4 * D + d]); }
                for (int n = cw * NWAVES + wave; n < PH * PQ; n += cn * NWAVES) {
                    const bf16* wr_ = PqT + (size_t)l * PH * PQ * D + (size_t)n * D + lane * 16; const u32x4 w0 = *(const u32x4*)wr_, w1 = *(const u32x4*)(wr_ + 8);
                    const unsigned ww[8] = {w0.x, w0.y, w0.z, w0.w, w1.x, w1.y, w1.z, w1.w};
#pragma unroll
                    for (int b = 0; b < BATCH; ++b) { const float* sh = modl + (size_t)b * 6 * D + 3 * D + lane * 16; float a = 0.f;
#pragma unroll
                        for (int q = 0; q < 4; ++q) { const f32x4 sv_ = *(const f32x4*)(sh + q * 4);
                            a += sv_.x * __uint_as_float(ww[2 * q] << 16) + sv_.y * __uint_as_float(ww[2 * q] & 0xffff0000u) + sv_.z * __uint_as_float(ww[2 * q + 1] << 16) + sv_.w * __uint_as_float(ww[2 * q + 1] & 0xffff0000u); }
                        a = wave_sum(a, lane); if (lane == 0) CVEC[(size_t)l * BATCH * PH * PQ + (size_t)b * PH * PQ + n] = a; } }
                convert_tables_fp6(INP(27), INP(28), U8, V8, USc, VSc, l, cw * NWAVES + wave, cn * NWAVES, lane, CONV_S1_ROWS, 2 * NEXP);
            {
                constexpr int DST = 520;
                int lane_p; asm volatile("v_mbcnt_lo_u32_b32 %0, -1, 0\n\tv_mbcnt_hi_u32_b32 %0, -1, %0" : "=v"(lane_p)); const int r32 = lane_p & 31, hh = lane_p >> 5, tidp = wave0 * 64 + lane_p;
                lbf16* dlb = (lbf16*)lds;
                lbf16* pin = (lbf16*)(lds + 33280);
                const int c = tidp, g = c >> 7, win = 2 << g;
                const bf16* pwt = PWT + (size_t)(l * 4 + (wave >> 1)) * PG * PG; const float* psc = INP(22) + l * PW;
                for (int tile = cw; tile < T / 32; tile += cn) {
                    const int t0 = tile * 32; const bool first = (t0 % SEQ) == 0;
                    __syncthreads();
                    { u32x4 pq[6];
#pragma unroll
                      for (int q = 0; q < 6; ++q) { const int ch = tidp + q * NTHR, row = ch >> 6, cc = ch & 63; pq[q] = (u32x4){0u, 0u, 0u, 0u};
                          if (ch < 47 * 64 && (row >= 15 || !first)) pq[q] = *(const u32x4*)(POOLIN + (size_t)(t0 - 15 + row) * PW + cc * 8); }
#pragma unroll
                      for (int q = 0; q < 6; ++q) { const int ch = tidp + q * NTHR, row = ch >> 6, cc = ch & 63; if (ch < 47 * 64) *(__attribute__((address_space(3))) u32x4*)(pin + row * 520 + cc * 8) = pq[q]; } }
                    __syncthreads();
                    const lbf16* pc = pin + c;
                    float sw = 0.f;
#pragma unroll
                    for (int j = 1; j <= 15; ++j) sw += (j < win) ? bf2f(pc[(15 - j) * 520]) : 0.f;
                    const float invw = 1.f / (float)win;
#pragma unroll 8
                    for (int i = 0; i < 32; ++i) {
                        const float cur = bf2f(pc[(15 + i) * 520]);
                        sw += cur;
                        const float inv = (first && i < 15) ? 1.f / (float)min(i + 1, win) : invw;
                        dlb[i * DST + c] = f2bf(sw * inv - cur);
                        sw -= bf2f(pc[(15 + i - win + 1) * 520]);
                    }
                    __syncthreads();
                    const int gg = wave >> 1, half = wave & 1;
#pragma unroll
                    for (int ct = 0; ct < 2; ++ct) {
                        const int dd0 = half * 64 + ct * 32;
                        f32x16 acc;
#pragma unroll
                        for (int e = 0; e < 16; ++e) acc[e] = 0.f;
#pragma unroll
                        for (int ks = 0; ks < 8; ++ks) { const bf16x8_t a = *(const __attribute__((address_space(3))) bf16x8_t*)(dlb + r32 * DST + gg * PG + ks * 16 + 8 * hh);
                            const bf16x8_t w = *(const bf16x8_t*)(pwt + (size_t)(dd0 + r32) * PG + ks * 16 + 8 * hh); acc = mm32(a, w, acc); }
                        const int oc = gg * PG + dd0 + r32; const float ps = psc[oc];
#pragma unroll
                        for (int e = 0; e < 16; ++e) MIX[(size_t)(t0 + rowidx(e, hh)) * D + RW + oc] = f2bf(acc[e] * ps);
                    }
                }
            }
            }
            for (int un = bx; un < BATCH * NH * 2; un += G) {
                const int bh = un >> 1, u = un & 1, b = bh >> 3, h = bh & 7;
                __syncthreads();
                const unsigned char* recs = SCN + (size_t)bh * NCH * 24576;
                const int lw = wave - 2;
#define S2_DMA(chunk_) do { if (wave >= 2) { LAS unsigned char* sl = lds + ((chunk_) % NSL) * SLOT; const unsigned char* rp = recs + (size_t)(chunk_) * 24576 + lane * 16; \
                    _Pragma("unroll") for (int q_ = 0; q_ < 3; ++q_) { const int p_ = lw * 3 + q_; const int so_ = p_ < 12 ? p_ * 1024 : 12288 + u * 6144 + (p_ - 12) * 1024; \
                        __builtin_amdgcn_global_load_lds((const unsigned*)(rp + so_), (LAS unsigned*)(sl + p_ * 1024), 16, 0, 0); } } } while (0)
#pragma unroll 1
                for (int c0 = 0; c0 < AHEAD; ++c0) S2_DMA(c0);
                asm volatile("s_waitcnt vmcnt(12)" ::: "memory");
                __builtin_amdgcn_s_barrier();
                f32x16 X0, X1;
                { float z_ = 0.f; asm volatile("" : "+v"(z_));
#pragma unroll
                for (int e = 0; e < 16; ++e) { X0[e] = z_; X1[e] = z_; } }
#define S2_FRAG(off) (*(const __attribute__((address_space(3))) bf16x8_t*)(sl + (off) + lane * 16))
#define S2_UNPK(dst, off) do { const u32x4 a0 = *(const LAS u32x4*)(sl + (off) + lane * 32), a1 = *(const LAS u32x4*)(sl + (off) + lane * 32 + 16); const unsigned wv[8] = {a0.x, a0.y, a0.z, a0.w, a1.x, a1.y, a1.z, a1.w}; \
                    _Pragma("unroll") for (int q = 0; q < 8; ++q) { (dst)[2 * q] = __uint_as_float(wv[q] << 16); (dst)[2 * q + 1] = __uint_as_float(wv[q] & 0xffff0000u); } } while (0)
                LAS unsigned char* xbuf = lds + NSL * SLOT;
#define S2_YOUT(nn_) do { const LAS unsigned char* sl = lds + ((nn_) % NSL) * SLOT; const LAS unsigned char* xb_ = xbuf + ((nn_) & 1) * 4096 + lane * 16; \
                        const bf16x8_t x00 = *(const LAS bf16x8_t*)(xb_), x01 = *(const LAS bf16x8_t*)(xb_ + 1024), x10 = *(const LAS bf16x8_t*)(xb_ + 2048), x11 = *(const LAS bf16x8_t*)(xb_ + 3072); \
                        f32x16 Yc; S2_UNPK(Yc, 12288 + 4096); \
                        Yc = mm32(S2_FRAG(8192 + 0 * 1024), x00, Yc); Yc = mm32(S2_FRAG(8192 + 1 * 1024), x01, Yc); Yc = mm32(S2_FRAG(8192 + 2 * 1024), x10, Yc); Yc = mm32(S2_FRAG(8192 + 3 * 1024), x11, Yc); \
                        float* yp = Y + ((size_t)b * SEQ + (size_t)(nn_) * 32) * RW + h * HS + u * 32 + r32; \
                        _Pragma("unroll") for (int e = 0; e < 16; ++e) yp[(size_t)rowidx(e, hh) * RW] = Yc[e]; } while (0)
#pragma unroll 1
                for (int n = 0; n < NCH; ++n) {
                    if (n + AHEAD < NCH) S2_DMA(n + AHEAD);
                    if (wave == 0) {
                        const LAS unsigned char* sl = lds + (n % NSL) * SLOT;
                        const bf16x8_t x00 = accop<0>(X0), x01 = accop<1>(X0), x10 = accop<0>(X1), x11 = accop<1>(X1);
                        { LAS unsigned char* xb_ = xbuf + (n & 1) * 4096 + lane * 16; *(LAS bf16x8_t*)(xb_) = x00; *(LAS bf16x8_t*)(xb_ + 1024) = x01; *(LAS bf16x8_t*)(xb_ + 2048) = x10; *(LAS bf16x8_t*)(xb_ + 3072) = x11; }
                        f32x16 N0, N1;
                        S2_UNPK(N0, 12288); S2_UNPK(N1, 12288 + 2048);
                        N0 = mm32(S2_FRAG((0 * 2 + 0) * 1024), x00, N0); N1 = mm32(S2_FRAG((1 * 2 + 0) * 1024), x00, N1); N0 = mm32(S2_FRAG((0 * 2 + 1) * 1024), x01, N0); N1 = mm32(S2_FRAG((1 * 2 + 1) * 1024), x01, N1);
                        N0 = mm32(S2_FRAG((2 * 2 + 0) * 1024), x10, N0); N1 = mm32(S2_FRAG((3 * 2 + 0) * 1024), x10, N1); N0 = mm32(S2_FRAG((2 * 2 + 1) * 1024), x11, N0); N1 = mm32(S2_FRAG((3 * 2 + 1) * 1024), x11, N1);
                        X0 = N0; X1 = N1;
                        asm volatile("s_waitcnt lgkmcnt(0)" ::: "memory");
                    } else if (wave == 1) {
                        if (n > 0) S2_YOUT(n - 1);
                        asm volatile("s_waitcnt lgkmcnt(0)" ::: "memory");
                    } else {
                        const int younger = (NCH - 1 - (n + 1)) < (AHEAD - 1) ? (NCH - 1 - (n + 1)) : (AHEAD - 1);
                        if (younger >= 5) asm volatile("s_waitcnt vmcnt(15)" ::: "memory"); else if (younger == 4) asm volatile("s_waitcnt vmcnt(12)" ::: "memory"); else if (younger == 3) asm volatile("s_waitcnt vmcnt(9)" ::: "memory");
                        else if (younger == 2) asm volatile("s_waitcnt vmcnt(6)" ::: "memory"); else if (younger == 1) asm volatile("s_waitcnt vmcnt(3)" ::: "memory"); else asm volatile("s_waitcnt vmcnt(0)" ::: "memory");
                    }
                    __builtin_amdgcn_s_barrier();
                }
                if (wave == 1) { S2_YOUT(NCH - 1); asm volatile("s_waitcnt lgkmcnt(0)" ::: "memory"); }
#undef S2_YOUT
#undef S2_FRAG
#undef S2_UNPK
#undef S2_DMA
            }
        }
        SEAM(pb + 3);

        if (IN(pb + 4)) { PHASE_IDS
            const int c8 = (tid & 63) * 8, hd = (tid & 63) >> 3, tsub = tid >> 6;
            const f32x4 lg0 = *(const f32x4*)(INP(19) + l * RW + c8), lg1 = *(const f32x4*)(INP(19) + l * RW + c8 + 4), lb0 = *(const f32x4*)(INP(20) + l * RW + c8), lb1 = *(const f32x4*)(INP(20) + l * RW + c8 + 4);
            for (int tile = bx; tile < T / 8; tile += G) {
                const int t = tile * 8 + tsub; const size_t o = (size_t)t * RW + c8;
                const f32x4 y0 = *(const f32x4*)(Y + o), y1 = *(const f32x4*)(Y + o + 4); const u32x4 gq = *(const u32x4*)(Gb + o), vq = *(const u32x4*)(BGb + o); const float bsum = BSUM[(size_t)t * NH + hd];
                float sm = (y0.x + y0.y) + (y0.z + y0.w) + (y1.x + y1.y) + (y1.z + y1.w);
                sm += dppf<0xB1>(sm); sm += dppf<0x4E>(sm); sm += dppf<0x141>(sm);
                const float mean = sm * (1.f / 64.f);
                const f32x4 d0 = y0 - mean, d1 = y1 - mean;
                float sq = (d0.x * d0.x + d0.y * d0.y) + (d0.z * d0.z + d0.w * d0.w) + (d1.x * d1.x + d1.y * d1.y) + (d1.z * d1.z + d1.w * d1.w);
                sq += dppf<0xB1>(sq); sq += dppf<0x4E>(sq); sq += dppf<0x141>(sq);
                const float rs = rsqrtf(sq * (1.f / 64.f) + GN_EPS);
                const f32x4 n0 = d0 * rs * lg0 + lb0, n1 = d1 * rs * lg1 + lb1;
                const unsigned gw_[4] = {gq.x, gq.y, gq.z, gq.w}, vw_[4] = {vq.x, vq.y, vq.z, vq.w}; const float nn[8] = {n0.x, n0.y, n0.z, n0.w, n1.x, n1.y, n1.z, n1.w}; unsigned ow[4];
#pragma unroll
                for (int i = 0; i < 4; ++i) { const float g0 = __uint_as_float(gw_[i] << 16), g1 = __uint_as_float(gw_[i] & 0xffff0000u), v0 = __uint_as_float(vw_[i] << 16), v1 = __uint_as_float(vw_[i] & 0xffff0000u);
                    ow[i] = pk2(nn[2 * i] * g0 + v0 * bsum, nn[2 * i + 1] * g1 + v1 * bsum); }
                *(u32x4*)(MIX + (size_t)t * D + c8) = (u32x4){ow[0], ow[1], ow[2], ow[3]};
            }
        }
        SEAM(pb + 4);
        if (IN(pb + 5)) { PHASE_IDS
            pg8::Gemm g{MIX, WoutT + (size_t)l * D * D, T, D, D}; pg8::StaticOrder S; S.init(T, D, G, bx);
            pg8::EpiResGate E{xin, X, modl + 2 * D, XB2, S2V + (size_t)l * BATCH * D, SSQ + (size_t)l * T};
            pg8::gemm_phase<pg8::EpiResGate, pg8::StaticOrder, true, true>(lds, g, S, E, tid); }
        SEAM(pb + 5);
        if (IN(pb + 7)) { PHASE_IDS
            pg8::Gemm g{XB2, PqT + (size_t)l * PH * PQ * D, T, PH * PQ, D}; pg8::StaticOrder S; S.init(T, PH * PQ, G, bx);
            pg8::EpiQ E{Q, PH * PQ, CVEC + (size_t)l * BATCH * PH * PQ, SSQ + (size_t)l * T};
            pg8::gemm_phase<pg8::EpiQ, pg8::StaticOrder, true, true>(lds, g, S, E, tid); }
        if (IN(pb + 7) && IN(pb + 8)) { asm volatile("s_waitcnt vmcnt(0)" ::: "memory"); __syncthreads(); }

        if (IN(pb + 8)) { PHASE_IDS
            const bf16* KEYSl = KEYS + (size_t)l * PH * 2 * NKEYS * PHALF;
            LAS unsigned char* scr = lds + wave * 2048 + lane * 32;
            constexpr int KST = 136;
            lbf16* kl = (lbf16*)(lds + 16384);
            const int r = lane & 31, hh = lane >> 5;
            pg8::StaticOrder S; S.init(T, PH * PQ, G, bx);
            for (int ui = 0;; ++ui) { pg8::Unit un_; if (!S.next(ui, un_)) break;
                const int h = un_.pn, tok = un_.pm * 256 + wave * 32 + r;
                __syncthreads();
                { u32x4 kq[8];
#pragma unroll
                  for (int q = 0; q < 8; ++q) { const int ch = tid + q * NTHR; kq[q] = *(const u32x4*)(KEYSl + (size_t)(h * 2) * NKEYS * PHALF + (size_t)ch * 8); }
#pragma unroll
                  for (int q = 0; q < 8; ++q) { const int ch = tid + q * NTHR, row = ch >> 4, cc = ch & 15; *(__attribute__((address_space(3))) u32x4*)(kl + row * KST + cc * 8) = kq[q]; } }
                __syncthreads();
                unsigned sp0[16], sp1[16];
#pragma unroll
                for (int e = 0; e < 16; ++e) { sp0[e] = 0u; sp1[e] = 0u; }
#pragma unroll 1
                for (int p = 0; p < 2; ++p) {
                    const bf16* qp = Q + (size_t)tok * (PH * PQ) + h * PQ + p * PHALF + 8 * hh;
                    const lbf16* kp_ = kl + (p * NKEYS + r) * KST + 8 * hh;
                    bf16x8_t bq[8];
#pragma unroll
                    for (int ks = 0; ks < 8; ++ks) bq[ks] = *(const bf16x8_t*)(qp + ks * 16);
                    unsigned best[16];
#pragma unroll
                    for (int e = 0; e < 16; ++e) best[e] = 0u;
#pragma unroll 1
                    for (int kt = 0; kt < 4; ++kt) {
                        f32x16 acc;
#pragma unroll
                        for (int e = 0; e < 16; ++e) acc[e] = 0.f;
#pragma unroll
                        for (int ks = 0; ks < 8; ++ks) { const bf16x8_t ak = *(const __attribute__((address_space(3))) bf16x8_t*)(kp_ + kt * 32 * KST + ks * 16); acc = __builtin_amdgcn_mfma_f32_32x32x16_bf16(ak, bq[ks], acc, 0, 0, 0); }
                        unsigned g[16];
#pragma unroll
                        for (int e = 0; e < 16; ++e) g[e] = pack_key7(acc[e], kt * 32 + (e & 3) + 8 * (e >> 2) + 4 * hh);
                        sort16_desc(g);
                        merge_top16(best, g);
                    }
                    unsigned ob[16];
#pragma unroll
                    for (int e = 0; e < 16; ++e) ob[e] = shflxu(best[e], lane, 32);
                    merge_top16(best, ob);
#pragma unroll
                    for (int e = 0; e < 16; ++e) { sp0[e] = p == 0 ? best[e] : sp0[e]; sp1[e] = p == 0 ? sp1[e] : best[e]; }
                }
                unsigned c2[32];
                stage2_cands(sp0, sp1, hh, c2);
                sort16_desc(c2); sort16_desc(c2 + 16); merge_top16(c2, c2 + 16);
                { unsigned ob[16];
#pragma unroll
                  for (int e = 0; e < 16; ++e) ob[e] = shflxu(c2[e], lane, 32);
                  merge_top16(c2, ob); }
#pragma unroll
                for (int e = 0; e < 16; e += 4) {
                    *(LAS unsigned*)(scr + e) = (127u - (sp0[e] & 127u)) | ((127u - (sp0[e + 1] & 127u)) << 8) | ((127u - (sp0[e + 2] & 127u)) << 16) | ((127u - (sp0[e + 3] & 127u)) << 24);
                    *(LAS unsigned*)(scr + 16 + e) = (127u - (sp1[e] & 127u)) | ((127u - (sp1[e + 1] & 127u)) << 8) | ((127u - (sp1[e + 2] & 127u)) << 16) | ((127u - (sp1[e + 3] & 127u)) << 24); }
                asm volatile("s_waitcnt lgkmcnt(0)" ::: "memory");
                float sm[16]; int ex[16];
#pragma unroll
                for (int e = 0; e < 16; ++e) { const unsigned key = c2[e]; sm[e] = unpack_key8(key); const int i0 = (key >> 4) & 15, j0 = key & 15; ex[e] = (int)scr[i0] * NKEYS + (int)scr[16 + j0]; }
                float den = 0.f;
#pragma unroll
                for (int e = 0; e < 16; ++e) { sm[e] = expf(sm[e] - unpack_key8(c2[0])); den += sm[e]; }
                const float inv = 1.f / den;
                if (hh == 0) {
                    int* ip = IDX + (size_t)tok * NE + h * TOPK; float* gp = GATE + (size_t)tok * NE + h * TOPK;
#pragma unroll
                    for (int e = 0; e < 16; e += 4) { *(int4*)(ip + e) = make_int4(ex[e], ex[e + 1], ex[e + 2], ex[e + 3]); *(f32x4*)(gp + e) = (f32x4){sm[e] * inv, sm[e + 1] * inv, sm[e + 2] * inv, sm[e + 3] * inv}; }
                }
                asm volatile("s_waitcnt lgkmcnt(0)" ::: "memory");
            }
        }
        SEAM(pb + 8);

        if (IN(pb + 9)) { PHASE_IDS
            const unsigned char* Ul = U8 + (size_t)l * NEXP * ROWB; const unsigned char* Vtl = V8 + (size_t)l * NEXP * ROWB; const float* usl = USc + l * NEXP; const float* vsl = VSc + l * NEXP; const float* lnf = INP(29);
            const bool fin = (l == DEPTH - 1);
            typedef float f32x2_t __attribute__((ext_vector_type(2)));
            const __amdgpu_buffer_rsrc_t ru = __builtin_amdgcn_make_buffer_rsrc((void*)Ul, 0, NEXP * ROWB, 0x00020000), rv = __builtin_amdgcn_make_buffer_rsrc((void*)Vtl, 0, NEXP * ROWB, 0x00020000);
            typedef float f32x32_t __attribute__((ext_vector_type(32))); typedef unsigned u32x3_t __attribute__((ext_vector_type(3))); typedef unsigned u32x6_t __attribute__((ext_vector_type(6))); typedef unsigned u32x16_t __attribute__((ext_vector_type(16))); typedef __bf16 bf16x2_t __attribute__((ext_vector_type(2)));
            LAS float* pl = (LAS float*)(lds + wave * 18432);
            constexpr int TW = 4;
            for (int tb = gw; tb < T; tb += TW * NGW) {
#define TOKV(k) (tb + (k) * NGW < T)
#define TOK(k) (TOKV(k) ? tb + (k) * NGW : tb)
                unsigned si[TW][2]; float sus[TW][2], sgv[TW][2];
                LAS u32x4* hl = (LAS u32x4*)(pl + 32 * 68);
                { float g0[TW], g1[TW]; int lane_s; asm volatile("v_mbcnt_lo_u32_b32 %0, -1, 0\n\tv_mbcnt_hi_u32_b32 %0, -1, %0" : "=v"(lane_s));
#pragma unroll
                  for (int k = 0; k < TW; ++k) { const size_t o = (size_t)TOK(k) * NE + lane_s; si[k][0] = ((unsigned)IDX[o] << 7) | (unsigned)lane_s; si[k][1] = ((unsigned)IDX[o + 64] << 7) | (unsigned)(64 + lane_s); g0[k] = GATE[o]; g1[k] = GATE[o + 64]; }
#pragma unroll
                  for (int kk = 2; kk <= 128; kk <<= 1) {
#pragma unroll
                      for (int j = kk >> 1; j > 0; j >>= 1) {
                          if (j == 64) {
#pragma unroll
                              for (int k = 0; k < TW; ++k) { const unsigned a = si[k][0], b = si[k][1]; si[k][0] = a < b ? a : b; si[k][1] = a < b ? b : a; } }
                          else { const bool lower = (lane_s & j) == 0, tm0 = lower == ((lane_s & kk) == 0), tm1 = lower == (((lane_s + 64) & kk) == 0); const int pa = (lane_s ^ j) << 2;
#pragma unroll
                              for (int k = 0; k < TW; ++k) { const unsigned a = si[k][0], b = si[k][1], p0 = (unsigned)__builtin_amdgcn_ds_bpermute(pa, (int)a), p1 = (unsigned)__builtin_amdgcn_ds_bpermute(pa, (int)b);
                                  si[k][0] = tm0 ? (a < p0 ? a : p0) : (a < p0 ? p0 : a); si[k][1] = tm1 ? (b < p1 ? b : p1) : (b < p1 ? p1 : b); } }
                          __builtin_amdgcn_sched_barrier(0);
                      } }
#pragma unroll
                  for (int k = 0; k < TW; ++k) {
#pragma unroll
                      for (int r = 0; r < 2; ++r) { const unsigned key = si[k][r]; const int a = (int)(key & 63u) << 2; const int ga = __builtin_amdgcn_ds_bpermute(a, __float_as_int(g0[k])), gb = __builtin_amdgcn_ds_bpermute(a, __float_as_int(g1[k]));
                          const unsigned ix = key >> 7; si[k][r] = ix; sus[k][r] = usl[ix]; sgv[k][r] = __int_as_float((key & 64u) ? gb : ga) * vsl[ix]; } }
#pragma unroll
                  for (int k = 0; k < TW; ++k) {
                      const int t_ = TOK(k); const bf16* hr = XB2 + (size_t)t_ * D + lane_s * 4; const uint2 a0 = *(const uint2*)hr, a1 = *(const uint2*)(hr + 256), a2 = *(const uint2*)(hr + 512), a3 = *(const uint2*)(hr + 768);
                      const float rs_ = rsqrtf((float)SSQ[(size_t)l * T + t_] * (1.f / (1048576.f * D)) + NORM_EPS); const float* shp = modl + (size_t)(t_ / SEQ) * 6 * D + 3 * D + lane_s * 4;
                      const unsigned aw[8] = {a0.x, a0.y, a1.x, a1.y, a2.x, a2.y, a3.x, a3.y}; unsigned ow[8];
#pragma unroll
                      for (int q = 0; q < 4; ++q) { const f32x4 s4 = *(const f32x4*)(shp + q * 256);
                          ow[2 * q] = pk2(__uint_as_float(aw[2 * q] << 16) * rs_ + s4.x, __uint_as_float(aw[2 * q] & 0xffff0000u) * rs_ + s4.y);
                          ow[2 * q + 1] = pk2(__uint_as_float(aw[2 * q + 1] << 16) * rs_ + s4.z, __uint_as_float(aw[2 * q + 1] & 0xffff0000u) * rs_ + s4.w); }
                      hl[(k * 2) * 64 + lane_s] = (u32x4){ow[0], ow[1], ow[2], ow[3]}; hl[(k * 2 + 1) * 64 + lane_s] = (u32x4){ow[4], ow[5], ow[6], ow[7]}; }
                }
                __builtin_amdgcn_sched_barrier(0);
#define ROWLD(dst, rs, ixv, ln) dst = __builtin_amdgcn_raw_buffer_load_b96(rs, voff, __builtin_amdgcn_readlane((int)(ixv), (ln)) * ROWB, 0)
#define LOADQ(buf, rs, ixv, ln0) do { _Pragma("unroll") for (int j_ = 0; j_ < 8; ++j_) ROWLD((buf)[j_], rs, ixv, (ln0) + j_); __builtin_amdgcn_sched_barrier(0); } while (0)
#define CVT2(a, b) const f32x32_t f_ = __builtin_amdgcn_cvt_scalef32_pk32_f32_fp6((u32x6_t){(a).x, (a).y, (a).z, (b).x, (b).y, (b).z}, 1.0f)
#define PR(i) __builtin_shufflevector(f_, f_, 2 * (i), 2 * (i) + 1)
#define DOTQ(buf, e0) do { _Pragma("unroll") for (int j_ = 0; j_ < 8; j_ += 2) { \
                        const u32x16_t g_ = __builtin_bit_cast(u32x16_t, __builtin_amdgcn_cvt_scalef32_pk32_bf16_fp6((u32x6_t){(buf)[j_].x, (buf)[j_].y, (buf)[j_].z, (buf)[j_ + 1].x, (buf)[j_ + 1].y, (buf)[j_ + 1].z}, 1.0f));     \
                        float a0_ = 0.f, a1_ = 0.f, b0_ = 0.f, b1_ = 0.f; \
                        _Pragma("unroll") for (int i_ = 0; i_ < 8; i_ += 2) { a0_ = DOT2(g_[i_], hpk[i_], a0_); b0_ = DOT2(g_[8 + i_], hpk[i_], b0_); a1_ = DOT2(g_[i_ + 1], hpk[i_ + 1], a1_); b1_ = DOT2(g_[9 + i_], hpk[i_ + 1], b1_); } \
                        pl[((e0) + j_) * 68 + lane_u] = a0_ + a1_; pl[((e0) + j_ + 1) * 68 + lane_u] = b0_ + b1_; __builtin_amdgcn_sched_barrier(0); } } while (0)
#define DOT2(x_, y_, c_) __builtin_amdgcn_fdot2_f32_bf16(__builtin_bit_cast(bf16x2_t, (unsigned)(x_)), __builtin_bit_cast(bf16x2_t, (unsigned)(y_)), (c_), false)
#define AXPYQ(buf, k, cfv, ln0) do { _Pragma("unroll") for (int j_ = 0; j_ < 8; j_ += 2) { CVT2((buf)[j_], (buf)[j_ + 1]); \
                        const float ca = __int_as_float(__builtin_amdgcn_readlane(__float_as_int(cfv), (ln0) + j_)), cb = __int_as_float(__builtin_amdgcn_readlane(__float_as_int(cfv), (ln0) + j_ + 1)); \
                        acc2[k][0] += ca * PR(0); acc2[k][1] += ca * PR(1); acc2[k][2] += ca * PR(2); acc2[k][3] += ca * PR(3); acc2[k][4] += ca * PR(4); acc2[k][5] += ca * PR(5); acc2[k][6] += ca * PR(6); acc2[k][7] += ca * PR(7); \
                        acc2[k][0] += cb * PR(8); acc2[k][1] += cb * PR(9); acc2[k][2] += cb * PR(10); acc2[k][3] += cb * PR(11); acc2[k][4] += cb * PR(12); acc2[k][5] += cb * PR(13); acc2[k][6] += cb * PR(14); acc2[k][7] += cb * PR(15); __builtin_amdgcn_sched_barrier(0); } } while (0)
                u32x3_t ba[8], bb_[8];
                int lane_u; asm volatile("v_mbcnt_lo_u32_b32 %0, -1, 0\n\tv_mbcnt_hi_u32_b32 %0, -1, %0" : "=v"(lane_u)); const int voff = lane_u * 12;
                LOADQ(ba, ru, si[0][0], 0);
#pragma unroll 1
                for (int c = 0; c < 16; ++c) {
                    const int lb = (c & 7) * 8; const bool r1 = c >= 8;
#pragma unroll
                    for (int k = 0; k < TW; ++k) {
                        unsigned hpk[8];
                        { const u32x4 h0 = hl[(k * 2) * 64 + lane_u], h1 = hl[(k * 2 + 1) * 64 + lane_u]; hpk[0] = h0.x; hpk[1] = h0.y; hpk[2] = h0.z; hpk[3] = h0.w; hpk[4] = h1.x; hpk[5] = h1.y; hpk[6] = h1.z; hpk[7] = h1.w; }
                        if (k & 1) { if (k < TW - 1) LOADQ(ba, ru, r1 ? si[k + 1][1] : si[k + 1][0], lb); else { const int cn = (c + 1) & 15; const __amdgpu_buffer_rsrc_t rn = c < 15 ? ru : rv; LOADQ(ba, rn, (cn >= 8) ? si[0][1] : si[0][0], (cn & 7) * 8); } DOTQ(bb_, k * 8); }
                        else { LOADQ(bb_, ru, r1 ? si[k + 1][1] : si[k + 1][0], lb); DOTQ(ba, k * 8); }
                    }
                    __builtin_amdgcn_wave_barrier(); asm volatile("s_waitcnt lgkmcnt(0)" ::: "memory");
                    float dsum;
                    { const LAS float* rp = pl + (lane_u & 31) * 68 + (lane_u >> 5) * 32; f32x4 s4 = *(const LAS f32x4*)rp;
#pragma unroll
                      for (int j = 1; j < 8; ++j) s4 += *(const LAS f32x4*)(rp + j * 4);
                      dsum = (s4.x + s4.y) + (s4.z + s4.w); }
                    dsum += shflx(dsum, lane_u, 32);
                    __builtin_amdgcn_wave_barrier(); asm volatile("s_waitcnt lgkmcnt(0)" ::: "memory");
                    const bool home = (lane_u >> 3) == (c & 7);
#pragma unroll
                    for (int k = 0; k < TW; ++k) {
                        const float dv = __int_as_float(__builtin_amdgcn_ds_bpermute((k * 8 + (lane_u & 7)) << 2, __float_as_int(dsum)));
                        const float cf = (r1 ? sgv[k][1] : sgv[k][0]) * gelu_erf(dv * (r1 ? sus[k][1] : sus[k][0]));
                        if (r1) sgv[k][1] = home ? cf : sgv[k][1]; else sgv[k][0] = home ? cf : sgv[k][0]; }
                    __builtin_amdgcn_sched_barrier(0);
                }
                f32x2_t acc2[TW][8];
#pragma unroll
                for (int k = 0; k < TW; ++k) {
#pragma unroll
                    for (int i = 0; i < 8; ++i) acc2[k][i] = (f32x2_t){0.f, 0.f}; }
#pragma unroll 1
                for (int c = 0; c < 16; ++c) {
                    const int lb = (c & 7) * 8; const bool r1 = c >= 8;
#pragma unroll
                    for (int k = 0; k < TW; ++k) {
                        const float cfk = r1 ? sgv[k][1] : sgv[k][0];
                        if (k & 1) { if (k < TW - 1) LOADQ(ba, rv, r1 ? si[k + 1][1] : si[k + 1][0], lb); else { const int cn = (c + 1) & 15; LOADQ(ba, rv, (cn >= 8) ? si[0][1] : si[0][0], (cn & 7) * 8); }     AXPYQ(bb_, k, cfk, lb); }
                        else { LOADQ(bb_, rv, r1 ? si[k + 1][1] : si[k + 1][0], lb); AXPYQ(ba, k, cfk, lb); }
                    }
                }
#undef ROWLD
#undef LOADQ
#undef CVT2
#undef PR
#undef DOTQ
#undef DOT2
#undef AXPYQ
                { int ln; asm volatile("v_mbcnt_lo_u32_b32 %0, -1, 0\n\tv_mbcnt_hi_u32_b32 %0, -1, %0" : "=v"(ln));
                  LAS f32x4* al = (LAS f32x4*)pl + ln;
#pragma unroll
                  for (int k = 0; k < TW; ++k) {
#pragma unroll
                      for (int q = 0; q < 4; ++q) al[(k * 4 + q) * 64] = (f32x4){acc2[k][q * 2].x, acc2[k][q * 2].y, acc2[k][q * 2 + 1].x, acc2[k][q * 2 + 1].y}; }
                  asm volatile("s_waitcnt lgkmcnt(0)" ::: "memory"); __builtin_amdgcn_sched_barrier(0);
                  f32x4 xn[4];
#pragma unroll
                  for (int q = 0; q < 4; ++q) xn[q] = *(const f32x4*)(X + (size_t)tb * D + ln * 4 + q * 256);
#pragma unroll 1
                  for (int k = 0; k < TW; ++k) { const int t = tb + k * NGW; if (t >= T) break; const int b = t / SEQ;
                    float* xr = X + (size_t)t * D + ln * 4; const float* g2 = modl + (size_t)b * 6 * D + 5 * D + ln * 4;
                    f32x4 xv[4]; float ss = 0.f;
#pragma unroll
                    for (int q = 0; q < 4; ++q) xv[q] = xn[q];
                    { const float* xnp = X + (size_t)((k + 1 < TW && t + NGW < T) ? t + NGW : t) * D + ln * 4;
#pragma unroll
                      for (int q = 0; q < 4; ++q) xn[q] = *(const f32x4*)(xnp + q * 256); }
                    __builtin_amdgcn_sched_barrier(0);
#pragma unroll
                    for (int q = 0; q < 4; ++q) { const f32x4 xo = xv[q], gg = *(const f32x4*)(g2 + q * 256);
                        xv[q] = xo + gg * al[(k * 4 + q) * 64]; ss += (xv[q].x * xv[q].x + xv[q].y * xv[q].y) + (xv[q].z * xv[q].z + xv[q].w * xv[q].w); }
                    const float rs = rsqrtf(wave_sum(ss, ln) * (1.f / D) + NORM_EPS);
                    if (fin) {
#pragma unroll
                        for (int q = 0; q < 4; ++q) *(f32x4*)(xr + q * 256) = xv[q] * rs * *(const f32x4*)(lnf + ln * 4 + q * 256); }
                    else {
                        const float* gam = INP(4) + (l + 1) * D + ln * 4; const float* mn = MOD + (size_t)(l + 1) * BATCH * 6 * D + (size_t)b * 6 * D + ln * 4;
#pragma unroll
                        for (int q = 0; q < 4; ++q) { *(f32x4*)(xr + q * 256) = xv[q];
                            const f32x4 y = xv[q] * rs * *(const f32x4*)(gam + q * 256) * (*(const f32x4*)(mn + D + q * 256) + 1.f) + *(const f32x4*)(mn + q * 256);
                            uint2 ho; ho.x = pk2(y.x, y.y); ho.y = pk2(y.z, y.w); *(uint2*)(H + (size_t)t * D + q * 256 + ln * 4) = ho; } }
                  }
                  asm volatile("s_waitcnt lgkmcnt(0)" ::: "memory"); __builtin_amdgcn_wave_barrier();
                }
#undef TOK
#undef TOKV
            }
        }
    }
#undef modl
#undef xin
#undef IN
#undef SEAM
}
#undef MOD
#undef H
#undef PROJ
#undef Q
#undef MIX
#undef Rb
#undef Kb
#undef V0
#undef V1
#undef KKb
#undef Bb
#undef Gb
#undef BGb
#undef Wd
#undef Y
#undef IDX
#undef GATE
#undef WinT
#undef WoutT
#undef PqT
#undef KEYS
#undef QB
#undef POOLIN
#undef SH
#undef SSQ
#undef CVEC
#undef S2V
#undef XB2
#undef WUPT
#undef AUPT
#undef GUPT
#undef VUPT
#undef PWT
#undef INVN
#undef BSUM
#undef SCN
#undef U8
#undef V8
#undef USc
#undef VSc
#undef INP
#undef PHASE_IDS

extern "C" void kernel_launch(void* const* d_in, const int* in_sizes, int n_in, void* d_out, int out_size, void* d_ws, size_t ws_size, hipStream_t stream) {
    if (n_in != 30 || ws_size < WS_END) { fprintf(stderr, "kernel_launch: unexpected n_in %d / ws_size %zu\n", n_in, ws_size); return; }
    static int grid = 0;
    if (grid == 0) {
        int dev = 0, cus = 0, per_cu = 0;
        (void)hipGetDevice(&dev); (void)hipDeviceGetAttribute(&cus, hipDeviceAttributeMultiprocessorCount, dev);
        if (hipFuncSetAttribute((const void*)mega, hipFuncAttributeMaxDynamicSharedMemorySize, LDS_BYTES) != hipSuccess) { fprintf(stderr, "hipFuncSetAttribute failed\n"); grid = -1; return; }
        if (hipOccupancyMaxActiveBlocksPerMultiprocessor(&per_cu, (const void*)mega, NTHR, LDS_BYTES) != hipSuccess || per_cu < 1) { fprintf(stderr, "occupancy query failed (%d)\n", per_cu); per_cu = 1; }
        (void)hipGetLastError();
        grid = (cus > 0 ? cus : 256) * 1;
    }
    if (grid < 0) return;
    Args a{}; for (int i = 0; i < 30; ++i) a.in[i] = (const float*)d_in[i]; a.out = (float*)d_out; a.ws = (unsigned char*)d_ws;
    a.ph_lo = 0; a.ph_hi = NPH;
    if (hipMemsetAsync(d_ws, 0, 65536, stream) != hipSuccess) { fprintf(stderr, "memset failed\n"); return; }
    void* kargs[] = {&a};
    hipError_t e = hipLaunchCooperativeKernel((const void*)mega, dim3(grid), dim3(NTHR), kargs, LDS_BYTES, stream);
    if (e != hipSuccess) fprintf(stderr, "cooperative launch failed: %s (grid %d)\n", hipGetErrorString(e), grid);
}
```

```cpp
#include <hip/hip_runtime.h>
#include <hip/hip_cooperative_groups.h>
namespace cg = cooperative_groups;
#include <cstdio>
#include <cstdint>
#include <cmath>

constexpr int D = 1024, BATCH = 4, SEQ = 4096, T = BATCH * SEQ, DEPTH = 2;
constexpr int RW = 512, HS = 64, NH = 8;
constexpr int DL = 64, AL = 64, MVL = 32, GL = 128;
constexpr int RWKV_COLS = 3 * RW + DL + AL + GL;
constexpr int PW = 512, PG = 128;
constexpr int IN_COLS = RWKV_COLS + PW;
constexpr int LDP = 2560;
constexpr int NKEYS = 128, NEXP = NKEYS * NKEYS, PH = 8, PQ = 256, PHALF = 128, TOPK = 16;
constexpr int NE = PH * TOPK;
constexpr float NORM_EPS = 1e-6f, GN_EPS = 64e-5f;

typedef unsigned short bf16;
__device__ __forceinline__ float bf2f(bf16 u) { return __uint_as_float((unsigned)u << 16); }
typedef float cvt_f32x2 __attribute__((ext_vector_type(2))); typedef __bf16 cvt_bf16x2 __attribute__((ext_vector_type(2)));
__device__ __forceinline__ unsigned cvtpk(float lo, float hi) { const cvt_f32x2 v = {lo, hi}; const cvt_bf16x2 b = __builtin_convertvector(v, cvt_bf16x2); return __builtin_bit_cast(unsigned, b); }
__device__ __forceinline__ bf16 f2bf(float f) { return (bf16)cvtpk(f, 0.f); }

constexpr size_t MiB = 1u << 20;
constexpr size_t WS_MOD = 1 * MiB;
constexpr size_t WS_US = 1 * MiB + 256 * 1024;
constexpr size_t WS_VS = 1 * MiB + 512 * 1024;
constexpr size_t WS_H = 2 * MiB;
constexpr size_t WS_PROJ = 34 * MiB;
constexpr size_t WS_Q = WS_PROJ;
constexpr size_t WS_R = 114 * MiB;
constexpr size_t WS_K = 130 * MiB;
constexpr size_t WS_V0 = 146 * MiB;
constexpr size_t WS_V1 = 162 * MiB;
constexpr size_t WS_KK = 178 * MiB;
constexpr size_t WS_B = 194 * MiB;
constexpr size_t WS_G = 210 * MiB;
constexpr size_t WS_BG = 226 * MiB;
constexpr size_t WS_W = 242 * MiB;
constexpr size_t WS_Y = 274 * MiB;
constexpr size_t WS_MIX = 306 * MiB;
constexpr size_t WS_IDX = 338 * MiB;
constexpr size_t WS_GATE = 346 * MiB;
constexpr size_t WS_WIN_T = 354 * MiB;
constexpr size_t WS_WOUT_T = 364 * MiB;
constexpr size_t WS_PQ_T = 368 * MiB;
constexpr size_t WS_KEYS = 376 * MiB;
constexpr size_t WS_U = 378 * MiB;
constexpr size_t WS_V = 442 * MiB;
constexpr size_t WS_QB = 410 * MiB;
constexpr size_t WS_SH = 426 * MiB;
constexpr size_t WS_LORA = 428 * MiB;
constexpr size_t WS_INVN = 430 * MiB;
constexpr size_t WS_BSUM = 431 * MiB;
constexpr size_t WS_SCN = 2 * MiB;
constexpr size_t WS_END = 506 * MiB;

template <int CTRL> __device__ __forceinline__ float dppf(float x) { return __int_as_float(__builtin_amdgcn_update_dpp(0, __float_as_int(x), CTRL, 0xF, 0xF, false)); }
__device__ __forceinline__ float red16(float x) { x += dppf<0xB1>(x); x += dppf<0x4E>(x); x += dppf<0x141>(x); x += dppf<0x140>(x); return x; }
__device__ __forceinline__ float shflx(float v, int lane, int off) { return __int_as_float(__builtin_amdgcn_ds_bpermute((lane ^ off) << 2, __float_as_int(v))); }
__device__ __forceinline__ unsigned shflxu(unsigned v, int lane, int off) { return (unsigned)__builtin_amdgcn_ds_bpermute((lane ^ off) << 2, (int)v); }
__device__ __forceinline__ void sort128(unsigned& k0, unsigned& k1, int lane) {
#pragma unroll
    for (int k = 2; k <= 128; k <<= 1) {
#pragma unroll
        for (int j = k >> 1; j > 0; j >>= 1) {
            if (j == 64) { const unsigned lo = k0 < k1 ? k0 : k1, hi = k0 < k1 ? k1 : k0; k0 = lo; k1 = hi; }
            else {
                const unsigned p0 = shflxu(k0, lane, j), p1 = shflxu(k1, lane, j);
                const bool lower = (lane & j) == 0, up0 = (lane & k) == 0, up1 = ((lane + 64) & k) == 0;
                const unsigned mn0 = k0 < p0 ? k0 : p0, mx0 = k0 < p0 ? p0 : k0, mn1 = k1 < p1 ? k1 : p1, mx1 = k1 < p1 ? p1 : k1;
                k0 = (lower == up0) ? mn0 : mx0; k1 = (lower == up1) ? mn1 : mx1;
            }
        }
    }
}
__device__ __forceinline__ float wave_sum(float v, int lane) { v = red16(v); v += shflx(v, lane, 16); v += shflx(v, lane, 32); return v; }
__device__ __forceinline__ float sigmoidf_(float x) { return 1.f / (1.f + expf(-x)); }

namespace pg8 {
#define PG8_LAS __attribute__((address_space(3)))
typedef unsigned short bf16_t;
typedef short bf16x8 __attribute__((ext_vector_type(8)));
typedef float f32x4 __attribute__((ext_vector_type(4)));
typedef unsigned u32x4 __attribute__((ext_vector_type(4)));
constexpr int BM = 256, BK = 64, HALF = 128, HTB = HALF * BK * 2  , STAGE_BYTES = 8 * HTB, NXCD = 8, WGM = 8;

__host__ __device__ __forceinline__ int lds_byte(int r, int c) { const int st = (r >> 4) * 2 + (c >> 5), rr = r & 15, cc = c & 31, ob = rr * 64 + cc * 2; return st * 1024 + (ob ^ (((ob >> 9) & 1) << 5)); }
__host__ __device__ __forceinline__ void stage_rc(int b, int& R, int& C) { const int st = b / 1024, sb = b % 1024, swz = sb ^ (((sb >> 9) & 1) << 5); R = (st >> 1) * 16 + swz / 64; C = (st & 1) * 32 + (swz % 64) / 2; }
__host__ __device__ __forceinline__ int perm32(int rho) { const int n = rho >> 4, i = rho & 15; return 8 * (i >> 2) + 4 * n + (i & 3); }

struct Unit { int pm, pn; };
struct Gemm { const bf16_t* A; const bf16_t* Bt; int M, N, K; };

struct StaticOrder {
    int nM, nN, nwg, G, c;
    __host__ __device__ void init(int M, int N, int G_, int c_) { nM = M / BM; nN = N / BM; nwg = nM * nN; G = G_; c = c_; }
    __host__ __device__ bool next(int i, Unit& u) const {
        const long L = (long)i * G + c; if (L >= nwg) return false;
        int wgid = (int)L; { const int q = nwg / NXCD, r = nwg % NXCD, xcd = wgid % NXCD, off = wgid / NXCD; wgid = (xcd < r ? xcd * (q + 1) : r * (q + 1) + (xcd - r) * q) + off; }
        const int nig = WGM * nN, gid = wgid / nig, fm = gid * WGM, gsz = (nM - fm) < WGM ? (nM - fm) : WGM;
        u.pm = fm + ((wgid % nig) % gsz); u.pn = (wgid % nig) / gsz; return true;
    }
    __device__ __forceinline__ void a_ready(const Unit&) const {}
    __device__ __forceinline__ void done(const Unit&) const {}
};

__device__ __forceinline__ unsigned cvt_pk_bf16(float lo, float hi) { unsigned r; asm volatile("v_cvt_pk_bf16_f32 %0, %1, %2" : "=v"(r) : "v"(lo), "v"(hi)); return r; }
typedef float f32x2 __attribute__((ext_vector_type(2)));
__device__ __forceinline__ f32x2 gelu_pk(f32x2 v) {
    const f32x2 av = __builtin_elementwise_abs(v), d = av * 0.2316418882f + 1.0f;
    f32x2 t; t.x = __builtin_amdgcn_rcpf(d.x); t.y = __builtin_amdgcn_rcpf(d.y);
    f32x2 q = t * 0.5307027145f + (-0.7265760135f); q = q * t + 0.7107068705f; q = q * t + (-0.142248368f); q = q * t + 0.127414796f; q = q * t;
    const f32x2 s = (v * v) * (-0.72134752044f);
    f32x2 e; e.x = __builtin_amdgcn_exp2f(s.x); e.y = __builtin_amdgcn_exp2f(s.y);
    const f32x2 m = v * (q * e), r = v - m;
    f32x2 o; o.x = v.x < 0.f ? m.x : r.x; o.y = v.y < 0.f ? m.y : r.y; return o;
}

template <int ACT  > struct EpiBf16 {
    static constexpr bool PERM = true, AFTER_DRAIN = false; static_assert(ACT == 0 || ACT == 1, "EpiBf16: ACT is 0 (none) or 1 (gelu_pk)");
    bf16_t* O; int ldc; const float* bias; int split_cols; size_t split_stride; float scale0;
    __device__ __forceinline__ void operator()(const f32x4 (&acc)[2][2][4][2], const Unit& u, int wr, int wc, int fr, int fq) const {
        const int row0 = u.pm * BM + wr * 64 + fr; int colt = u.pn * BM; bf16_t* base = O;
        float sc = 1.f; if (split_cols) { const int t = colt / split_cols; base += (size_t)t * split_stride; colt -= t * split_cols; if (t == 0) sc = scale0; }
        const int col0 = colt + wc * 32 + 8 * fq, bcol0 = u.pn * BM + wc * 32 + 8 * fq;
        f32x4 bv[2][2];
#pragma unroll
        for (int bj = 0; bj < 2; ++bj)
#pragma unroll
            for (int n = 0; n < 2; ++n) bv[bj][n] = bias ? *(const f32x4*)(bias + bcol0 + bj * HALF + 4 * n) : (f32x4){0.f, 0.f, 0.f, 0.f};
#pragma unroll
        for (int ai = 0; ai < 2; ++ai)
#pragma unroll
            for (int m = 0; m < 4; ++m) { bf16_t* rowp = base + (size_t)(row0 + ai * HALF + m * 16) * ldc + col0;
#pragma unroll
                for (int bj = 0; bj < 2; ++bj) { f32x4 v0 = acc[ai][bj][m][0] + bv[bj][0], v1 = acc[ai][bj][m][1] + bv[bj][1];
                    if (ACT == 1) { f32x2 a = gelu_pk((f32x2){v0[0], v0[1]}), b = gelu_pk((f32x2){v0[2], v0[3]}), c = gelu_pk((f32x2){v1[0], v1[1]}), d = gelu_pk((f32x2){v1[2], v1[3]});
                        v0 = (f32x4){a.x, a.y, b.x, b.y}; v1 = (f32x4){c.x, c.y, d.x, d.y}; }
                    v0 = v0 * sc; v1 = v1 * sc; u32x4 w; w.x = cvt_pk_bf16(v0[0], v0[1]); w.y = cvt_pk_bf16(v0[2], v0[3]); w.z = cvt_pk_bf16(v1[0], v1[1]); w.w = cvt_pk_bf16(v1[2], v1[3]);
                    *(u32x4*)(rowp + bj * HALF) = w; } }
    }
};

struct EpiProj {
    static constexpr bool PERM = true, AFTER_DRAIN = false;
    bf16_t* O; int ldc; bf16_t* P; int pool0, pw;
    __device__ __forceinline__ void operator()(const f32x4 (&acc)[2][2][4][2], const Unit& u, int wr, int wc, int fr, int fq) const {
        const int row0 = u.pm * BM + wr * 64 + fr; int colt = u.pn * BM; bf16_t* base = O; int ld = ldc;
        if (colt >= pool0 && colt < pool0 + pw) { base = P; ld = pw; colt -= pool0; }
        const int col0 = colt + wc * 32 + 8 * fq;
#pragma unroll
        for (int ai = 0; ai < 2; ++ai)
#pragma unroll
            for (int m = 0; m < 4; ++m) { bf16_t* rowp = base + (size_t)(row0 + ai * HALF + m * 16) * ld + col0;
#pragma unroll
                for (int bj = 0; bj < 2; ++bj) { const f32x4 v0 = acc[ai][bj][m][0], v1 = acc[ai][bj][m][1];
                    u32x4 w; w.x = cvt_pk_bf16(v0[0], v0[1]); w.y = cvt_pk_bf16(v0[2], v0[3]); w.z = cvt_pk_bf16(v1[0], v1[1]); w.w = cvt_pk_bf16(v1[2], v1[3]);
                    *(u32x4*)(rowp + bj * HALF) = w; } }
    }
};
struct EpiResGate {
    static constexpr bool PERM = true, AFTER_DRAIN = false;
    const float* xold; float* X; const float* gate;
    bf16_t* XB; const float* sv; unsigned long long* ssq;
    __device__ __forceinline__ void operator()(const f32x4 (&acc)[2][2][4][2], const Unit& u, int wr, int wc, int fr, int fq) const {
        const int col0 = u.pn * BM + wc * 32 + 8 * fq; const int b = (u.pm * BM) / SEQ;
        const float* gp = gate + (size_t)b * 6 * D + col0; const float* sp = sv + (size_t)b * D + col0;
        float rsum[2][4];
#pragma unroll
        for (int ai = 0; ai < 2; ++ai)
#pragma unroll
            for (int m = 0; m < 4; ++m) rsum[ai][m] = 0.f;
#pragma unroll
        for (int bj = 0; bj < 2; ++bj) { const f32x4 g0 = *(const f32x4*)(gp + bj * HALF), g1 = *(const f32x4*)(gp + bj * HALF + 4), s0 = *(const f32x4*)(sp + bj * HALF), s1 = *(const f32x4*)(sp + bj * HALF + 4);
#pragma unroll
            for (int ai = 0; ai < 2; ++ai)
#pragma unroll
                for (int m = 0; m < 4; ++m) { const size_t off = (size_t)(u.pm * BM + ai * HALF + wr * 64 + m * 16 + fr) * D + col0 + bj * HALF;
                    const f32x4 xa = *(const f32x4*)(xold + off) + g0 * acc[ai][bj][m][0], xb = *(const f32x4*)(xold + off + 4) + g1 * acc[ai][bj][m][1];
                    *(f32x4*)(X + off) = xa; *(f32x4*)(X + off + 4) = xb;
                    rsum[ai][m] += ((xa[0] * xa[0] + xa[1] * xa[1]) + (xa[2] * xa[2] + xa[3] * xa[3])) + ((xb[0] * xb[0] + xb[1] * xb[1]) + (xb[2] * xb[2] + xb[3] * xb[3]));
                    const f32x4 ya = xa * s0, yb = xb * s1; u32x4 o; o.x = cvt_pk_bf16(ya[0], ya[1]); o.y = cvt_pk_bf16(ya[2], ya[3]); o.z = cvt_pk_bf16(yb[0], yb[1]); o.w = cvt_pk_bf16(yb[2], yb[3]);
                    *(u32x4*)(XB + off) = o; } }
        const int lane_ = fr | (fq << 4);
#pragma unroll
        for (int ai = 0; ai < 2; ++ai)
#pragma unroll
            for (int m = 0; m < 4; ++m) { float v = rsum[ai][m];
                v += __int_as_float(__builtin_amdgcn_ds_bpermute((lane_ ^ 16) << 2, __float_as_int(v))); v += __int_as_float(__builtin_amdgcn_ds_bpermute((lane_ ^ 32) << 2, __float_as_int(v)));
                if (fq == 0) (void)__hip_atomic_fetch_add(ssq + (u.pm * BM + ai * HALF + wr * 64 + m * 16 + fr), (unsigned long long)(v * 1048576.f + 0.5f), __ATOMIC_RELAXED, __HIP_MEMORY_SCOPE_AGENT); }
    }
};
struct EpiQ {
    static constexpr bool PERM = true, AFTER_DRAIN = false;
    bf16_t* O; int ldc; const float* cv; const unsigned long long* ssq;
    __device__ __forceinline__ void operator()(const f32x4 (&acc)[2][2][4][2], const Unit& u, int wr, int wc, int fr, int fq) const {
        const int row0 = u.pm * BM + wr * 64 + fr, colt = u.pn * BM, b = (u.pm * BM) / SEQ;
        const int col0 = colt + wc * 32 + 8 * fq;
        f32x4 bv[2][2];
#pragma unroll
        for (int bj = 0; bj < 2; ++bj)
#pragma unroll
            for (int n = 0; n < 2; ++n) bv[bj][n] = *(const f32x4*)(cv + (size_t)b * ldc + col0 + bj * HALF + 4 * n);
#pragma unroll
        for (int ai = 0; ai < 2; ++ai)
#pragma unroll
            for (int m = 0; m < 4; ++m) { const int row = row0 + ai * HALF + m * 16; bf16_t* rowp = O + (size_t)row * ldc + col0;
                const float rs = rsqrtf((float)ssq[row] * (1.f / (1048576.f * 1024.f)) + 1e-6f);
#pragma unroll
                for (int bj = 0; bj < 2; ++bj) { const f32x4 v0 = acc[ai][bj][m][0] * rs + bv[bj][0], v1 = acc[ai][bj][m][1] * rs + bv[bj][1];
                    u32x4 w; w.x = cvt_pk_bf16(v0[0], v0[1]); w.y = cvt_pk_bf16(v0[2], v0[3]); w.z = cvt_pk_bf16(v1[0], v1[1]); w.w = cvt_pk_bf16(v1[2], v1[3]);
                    *(u32x4*)(rowp + bj * HALF) = w; } }
    }
};
template <class Epi, class Sched, bool ALIGN_EPI = false, bool SP2 = false>
__device__ __forceinline__ void gemm_phase(PG8_LAS unsigned char* lds, const Gemm g, const Sched& S, const Epi& E, int tid) {
    asm volatile("" : "+v"(tid));
    const int wid = __builtin_amdgcn_readfirstlane(tid >> 6), lane = tid & 63, wr = wid >> 2, wc = wid & 3, fr = lane & 15, fq = lane >> 4;
    const int K = g.K, nt = K / BK;
    unsigned voffA[2], voffB[2];
#pragma unroll
    for (int i = 0; i < 2; ++i) { int R, C; stage_rc(tid * 16 + i * 8192, R, C); const int Rb = Epi::PERM ? ((R & ~31) + perm32(R & 31)) : R;
        voffA[i] = (unsigned)(R * K + C) * 2u; voffB[i] = (unsigned)(Rb * K + C) * 2u; }
    const size_t kstep = (size_t)(BK * 2);
    const size_t hstep = (size_t)HALF * K * 2;
    const size_t tstep = 2 * hstep;
    const unsigned ldsw = (unsigned)wid * 1024u;
    const int aoff = lds_byte(wr * 64 + fr, fq * 8), boff = lds_byte(wc * 32 + fr, fq * 8);
#define PG8_SA(b, h) (((b) * 2 + (h)) * HTB)
#define PG8_SB(b, h) ((4 + (b) * 2 + (h)) * HTB)
#define PG8_STAGE(bufoff, gbase, voff) do { _Pragma("unroll") for (int _i = 0; _i < 2; ++_i) \
        __builtin_amdgcn_global_load_lds((const unsigned*)((const char*)(gbase) + (voff)[_i]), (PG8_LAS unsigned*)(lds + (bufoff) + ldsw + _i * 8192), 16, 0, 0); } while (0)
#define PG8_LDA(dst, b, h) do { _Pragma("unroll") for (int m = 0; m < 4; ++m) _Pragma("unroll") for (int k = 0; k < 2; ++k) dst[m][k] = *(const PG8_LAS bf16x8*)(lds + PG8_SA(b, h) + aoff + m * 2048 + k * 1024); } while (0)
#define PG8_LDB(dst, b, h) do { _Pragma("unroll") for (int n = 0; n < 2; ++n) _Pragma("unroll") for (int k = 0; k < 2; ++k) dst[n][k] = *(const PG8_LAS bf16x8*)(lds + PG8_SB(b, h) + boff + n * 2048 + k * 1024); } while (0)
#define PG8_MMA(ai, bj, At, Bt) do { __builtin_amdgcn_s_setprio(1); _Pragma("unroll") for (int m = 0; m < 4; ++m) _Pragma("unroll") for (int n = 0; n < 2; ++n) _Pragma("unroll") for (int k = 0; k < 2; ++k) \
        acc[ai][bj][m][n] = __builtin_amdgcn_mfma_f32_16x16x32_bf16(Bt[n][k], At[m][k], acc[ai][bj][m][n], 0, 0, 0); __builtin_amdgcn_s_setprio(0); } while (0)
#define PG8_WAIT_V(n) asm volatile("s_waitcnt vmcnt(" #n ")" ::: "memory")
#define PG8_WAIT_L(n) asm volatile("s_waitcnt lgkmcnt(" #n ")" ::: "memory")
#define PG8_BAR __builtin_amdgcn_s_barrier()
#define PG8_SCHED __builtin_amdgcn_sched_barrier(0)
    Unit cur, nxt; int ui = 0;
    if (!S.next(0, cur)) return;
    f32x4 acc[2][2][4][2];
#pragma unroll
    for (int a = 0; a < 2; ++a)
#pragma unroll
        for (int b = 0; b < 2; ++b)
#pragma unroll
            for (int m = 0; m < 4; ++m)
#pragma unroll
                for (int n = 0; n < 2; ++n) acc[a][b][m][n] = (f32x4){0.f, 0.f, 0.f, 0.f};
    bf16x8 At[4][2], B0[2][2], B1[2][2];
    const char* cA = (const char*)g.A + (size_t)cur.pm * tstep; const char* cB = (const char*)g.Bt + (size_t)cur.pn * tstep;
    S.a_ready(cur);
    if constexpr (SP2) {
        PG8_STAGE(PG8_SB(0, 0), cB, voffB); PG8_STAGE(PG8_SB(0, 1), cB + hstep, voffB); PG8_STAGE(PG8_SA(0, 0), cA, voffA); PG8_STAGE(PG8_SA(0, 1), cA + hstep, voffA);
        if (wr == 1) PG8_BAR;
        PG8_WAIT_V(2); PG8_BAR;
        PG8_STAGE(PG8_SB(1, 0), cB + kstep, voffB); PG8_STAGE(PG8_SA(1, 0), cA + kstep, voffA); PG8_STAGE(PG8_SB(1, 1), cB + hstep + kstep, voffB);
        PG8_WAIT_V(6); PG8_BAR;
    } else {
        PG8_STAGE(PG8_SB(0, 0), cB, voffB); PG8_STAGE(PG8_SA(0, 0), cA, voffA); PG8_STAGE(PG8_SB(0, 1), cB + hstep, voffB); PG8_STAGE(PG8_SA(0, 1), cA + hstep, voffA);
        if (wr == 1) PG8_BAR;
        PG8_WAIT_V(4); PG8_BAR;
        PG8_STAGE(PG8_SB(1, 0), cB + kstep, voffB); PG8_STAGE(PG8_SA(1, 0), cA + kstep, voffA); PG8_STAGE(PG8_SB(1, 1), cB + hstep + kstep, voffB);
        PG8_WAIT_V(6); PG8_BAR;
    }
    for (;;) {
        const bool has_next = S.next(ui + 1, nxt);
        const char* nA = has_next ? (const char*)g.A + (size_t)nxt.pm * tstep : cA; const char* nB = has_next ? (const char*)g.Bt + (size_t)nxt.pn * tstep : cB;
        for (int t = 0; t < nt; t += 2) {
            const bool last = (t == nt - 2);
            const char* a1 = cA + (size_t)(t + 1) * kstep;
            const char* a2 = last ? nA : cA + (size_t)(t + 2) * kstep; const char* b2 = last ? nB : cB + (size_t)(t + 2) * kstep;
            const char* a3 = a2 + kstep; const char* b3 = b2 + kstep;
            if (last && has_next) S.a_ready(nxt);
            if constexpr (SP2) {
            PG8_LDB(B0, 0, 0); PG8_LDB(B1, 0, 1); PG8_SCHED; PG8_LDA(At, 0, 0); PG8_STAGE(PG8_SA(1, 1), a1 + hstep, voffA);
            PG8_WAIT_V(8); PG8_WAIT_L(0); PG8_BAR; PG8_MMA(0, 0, At, B0); PG8_MMA(0, 1, At, B1); PG8_BAR; PG8_SCHED;
            PG8_LDA(At, 0, 1); PG8_STAGE(PG8_SB(0, 0), b2, voffB); PG8_STAGE(PG8_SB(0, 1), b2 + hstep, voffB); PG8_STAGE(PG8_SA(0, 0), a2, voffA);
            PG8_WAIT_V(8); PG8_WAIT_L(0); PG8_BAR; PG8_MMA(1, 0, At, B0); PG8_MMA(1, 1, At, B1); PG8_BAR; PG8_SCHED;
            PG8_LDB(B0, 1, 0); PG8_LDB(B1, 1, 1); PG8_SCHED; PG8_LDA(At, 1, 0); PG8_STAGE(PG8_SA(0, 1), a2 + hstep, voffA);
            PG8_WAIT_V(8); PG8_WAIT_L(0); PG8_BAR; PG8_MMA(0, 0, At, B0); PG8_MMA(0, 1, At, B1); PG8_BAR; PG8_SCHED;
            PG8_LDA(At, 1, 1); PG8_STAGE(PG8_SB(1, 0), b3, voffB); PG8_STAGE(PG8_SB(1, 1), b3 + hstep, voffB); PG8_STAGE(PG8_SA(1, 0), a3, voffA);
            PG8_WAIT_V(8); PG8_WAIT_L(0); PG8_BAR; PG8_MMA(1, 0, At, B0); PG8_MMA(1, 1, At, B1); PG8_BAR; PG8_SCHED;
            } else {
            PG8_LDB(B0, 0, 0); PG8_SCHED; PG8_LDA(At, 0, 0); PG8_STAGE(PG8_SA(1, 1), a1 + hstep, voffA);
            PG8_WAIT_L(8); PG8_BAR; PG8_WAIT_L(0); PG8_MMA(0, 0, At, B0); PG8_BAR; PG8_SCHED;
            PG8_LDB(B1, 0, 1); PG8_STAGE(PG8_SB(0, 0), b2, voffB);
            PG8_BAR; PG8_WAIT_L(0); PG8_MMA(0, 1, At, B1); PG8_BAR;
            PG8_LDA(At, 0, 1); PG8_STAGE(PG8_SA(0, 0), a2, voffA);
            PG8_BAR; PG8_WAIT_L(0); PG8_MMA(1, 0, At, B0); PG8_BAR; PG8_SCHED;
            PG8_STAGE(PG8_SB(0, 1), b2 + hstep, voffB);
            PG8_WAIT_V(6); PG8_BAR; PG8_MMA(1, 1, At, B1); PG8_BAR;
            PG8_LDB(B0, 1, 0); PG8_SCHED; PG8_LDA(At, 1, 0); PG8_STAGE(PG8_SA(0, 1), a2 + hstep, voffA);
            PG8_WAIT_L(8); PG8_BAR; PG8_WAIT_L(0); PG8_MMA(0, 0, At, B0); PG8_BAR; PG8_SCHED;
            PG8_LDB(B1, 1, 1); PG8_STAGE(PG8_SB(1, 0), b3, voffB);
            PG8_BAR; PG8_WAIT_L(0); PG8_MMA(0, 1, At, B1); PG8_BAR;
            PG8_LDA(At, 1, 1); PG8_STAGE(PG8_SA(1, 0), a3, voffA);
            PG8_BAR; PG8_WAIT_L(0); PG8_MMA(1, 0, At, B0); PG8_BAR; PG8_SCHED;
            PG8_STAGE(PG8_SB(1, 1), b3 + hstep, voffB);
            PG8_WAIT_V(6); PG8_BAR; PG8_MMA(1, 1, At, B1); PG8_BAR;
            }
        }
        if constexpr (ALIGN_EPI) { if (wr == 0) PG8_BAR; }
        if constexpr (!Epi::AFTER_DRAIN) { int le_; asm volatile("v_mbcnt_lo_u32_b32 %0, -1, 0\n\tv_mbcnt_hi_u32_b32 %0, -1, %0" : "=v"(le_)); E(acc, cur, wr, wc, le_ & 15, le_ >> 4); S.done(cur); }
        if (!has_next) break;
#pragma unroll
        for (int a = 0; a < 2; ++a)
#pragma unroll
            for (int b = 0; b < 2; ++b)
#pragma unroll
                for (int m = 0; m < 4; ++m)
#pragma unroll
                    for (int n = 0; n < 2; ++n) acc[a][b][m][n] = (f32x4){0.f, 0.f, 0.f, 0.f};
        cur = nxt; cA = nA; cB = nB; ++ui;
        if constexpr (ALIGN_EPI) { if (wr == 1) PG8_BAR; }
    }
    PG8_WAIT_V(0);
    if constexpr (!ALIGN_EPI) { if (wr == 0) PG8_BAR; }
    PG8_BAR;
    if constexpr (Epi::AFTER_DRAIN) { E.fused(acc, cur, wr, wc, fr, fq, lds, wid, lane); S.done(cur); }
#undef PG8_SA
#undef PG8_SB
#undef PG8_STAGE
#undef PG8_LDA
#undef PG8_LDB
#undef PG8_MMA
#undef PG8_WAIT_V
#undef PG8_WAIT_L
#undef PG8_BAR
#undef PG8_SCHED
}
}

#define LAS __attribute__((address_space(3)))
constexpr int NWAVES = 8, NTHR = 512;
constexpr int LDS_BYTES = 147456;
constexpr int NPH = 21;
typedef float f32x4 __attribute__((ext_vector_type(4)));
typedef unsigned u32x4 __attribute__((ext_vector_type(4)));

struct Args { const float* in[30]; float* out; unsigned char* ws; int ph_lo, ph_hi; };

__device__ __forceinline__ unsigned pk2(float lo, float hi) { return cvtpk(lo, hi); }

__device__ __forceinline__ void p0_transpose_item(const float* W, int K, int N, bf16* WT, int row_off, LAS float* scr, int item, int lane) {
    const int nblk = N / 32, kb = item / nblk, nb = item % nblk, k0 = 64 * kb, n0 = 32 * nb;
#pragma unroll 8
    for (int i = 0; i < 32; ++i) { const int kk = 2 * i + (lane >> 5); scr[kk * 33 + (lane & 31)] = W[(size_t)(k0 + kk) * N + n0 + (lane & 31)]; }
    asm volatile("s_waitcnt lgkmcnt(0)" ::: "memory");
    const int c = lane & 7;
#pragma unroll
    for (int j = 0; j < 4; ++j) { const int n = (lane >> 3) + 8 * j; const LAS float* s = scr + (8 * c) * 33 + n;
        u32x4 o; o.x = pk2(s[0 * 33], s[1 * 33]); o.y = pk2(s[2 * 33], s[3 * 33]); o.z = pk2(s[4 * 33], s[5 * 33]); o.w = pk2(s[6 * 33], s[7 * 33]);
        *(u32x4*)(WT + (size_t)(row_off + n0 + n) * K + k0 + 8 * c) = o; }
    asm volatile("s_waitcnt lgkmcnt(0)" ::: "memory");
}

__device__ __forceinline__ void norm_mod_row(const float* xr, const float* gamma, const float* sh, const float* sc, bf16* orow, int lane) {
    f32x4 v[4]; float ss = 0.f;
#pragma unroll
    for (int j = 0; j < 4; ++j) { v[j] = *(const f32x4*)(xr + j * 256 + lane * 4); ss += (v[j].x * v[j].x + v[j].y * v[j].y) + (v[j].z * v[j].z + v[j].w * v[j].w); }
    const float rs = rsqrtf(wave_sum(ss, lane) * (1.f / D) + NORM_EPS);
#pragma unroll
    for (int j = 0; j < 4; ++j) { const int d = j * 256 + lane * 4; const f32x4 g = *(const f32x4*)(gamma + d), a = *(const f32x4*)(sc + d), s = *(const f32x4*)(sh + d);
        const f32x4 y = v[j] * rs * g * (a + 1.f) + s; uint2 o; o.x = pk2(y.x, y.y); o.y = pk2(y.z, y.w); *(uint2*)(orow + d) = o; }
}


#define XB_TMO      128
#define XB_XCNT(j)  (256  + 64 * (j))
#define XB_XSUB(j)  (1280 + 64 * (j))
#define XB_XGEN(j)  (2304 + 64 * (j))
#define XB_TOP      3328
#define XB_TOPGEN   3392
#define XCD_BAR_WORDS 3456
#define XB_SPIN_CAP (1u << 18)

__device__ __forceinline__ unsigned xb_ld(unsigned* p)              { return __hip_atomic_load(p, __ATOMIC_RELAXED, __HIP_MEMORY_SCOPE_AGENT); }
__device__ __forceinline__ unsigned xb_add(unsigned* p, unsigned v) { return __hip_atomic_fetch_add(p, v, __ATOMIC_RELAXED, __HIP_MEMORY_SCOPE_AGENT); }
__device__ __forceinline__ unsigned xb_xcc_id() { return (unsigned)__builtin_amdgcn_s_getreg((3 << 11) | 20) & 0xFu; }
#define XB_SPIN(cond, bar) do { unsigned _sp = 0; while (cond) { __builtin_amdgcn_s_sleep(1); \
    if ((++_sp & 255u) == 0u) { if (xb_ld(&(bar)[XB_TMO])) break; if (_sp > XB_SPIN_CAP) { atomicAdd(&(bar)[XB_TMO], 1u); break; } } } } while (0)

struct XcdBarrier {
    unsigned* bar; unsigned x; int w0;
    volatile __attribute__((address_space(3))) unsigned* st;
};

__device__ __forceinline__ XcdBarrier xcd_barrier_post(unsigned* bar, volatile __attribute__((address_space(3))) unsigned* st) {
    XcdBarrier b; b.bar = bar; b.x = xb_xcc_id(); b.st = st; b.w0 = __builtin_amdgcn_readfirstlane((int)threadIdx.x >> 6);
    if (threadIdx.x == 0) (void)xb_add(&bar[XB_XCNT(b.x)], 1u);
    return b;
}
__device__ __forceinline__ void xcd_barrier_complete(unsigned* bar, unsigned x, unsigned& nloc, unsigned& nx) {
    const unsigned G = gridDim.x * gridDim.y * gridDim.z;
    unsigned sum, cnt, mine, sp = 0u;
    for (;;) {
        sum = 0u; cnt = 0u; mine = 0u;
#pragma unroll
        for (unsigned j = 0; j < 16; ++j) { const unsigned c = xb_ld(&bar[XB_XCNT(j)]); sum += c; cnt += (c > 0u) ? 1u : 0u; }
        mine = xb_ld(&bar[XB_XCNT(x)]);
        if (sum == G) break;
        __builtin_amdgcn_s_sleep(1);
        if ((++sp & 255u) == 0u) { if (xb_ld(&bar[XB_TMO])) break; if (sp > XB_SPIN_CAP) { atomicAdd(&bar[XB_TMO], 1u); break; } }
    }
    nloc = mine > 0u ? mine : 1u; nx = cnt > 0u ? cnt : 1u;
}

template <bool FIRST> __device__ __forceinline__ void xcd_barrier(const XcdBarrier& b) {
    asm volatile("s_waitcnt vmcnt(0)" ::: "memory");
    __syncthreads();
    int lid_; asm volatile("v_mbcnt_lo_u32_b32 %0, -1, 0\n\tv_mbcnt_hi_u32_b32 %0, -1, %0" : "=v"(lid_));
    if (b.w0 == 0 && lid_ == 0) {
        unsigned* bar = b.bar;
        __builtin_amdgcn_s_waitcnt(0);
        unsigned nloc = b.st[0], nx = b.st[1];
        if (FIRST && nloc == 0u) { xcd_barrier_complete(bar, b.x, nloc, nx); b.st[0] = nloc; b.st[1] = nx; }
        const unsigned old = xb_add(&bar[XB_XSUB(b.x)], 1u);
        const unsigned gen = old / nloc;
        if (old + 1u == (gen + 1u) * nloc) {
            __builtin_amdgcn_fence(__ATOMIC_RELEASE, "agent");
            asm volatile("s_waitcnt vmcnt(0)" ::: "memory");
            const unsigned og = xb_add(&bar[XB_TOP], 1u);
            const unsigned tg = og / nx;
            if (og + 1u == (tg + 1u) * nx) xb_add(&bar[XB_TOPGEN], 1u);
            else XB_SPIN(xb_ld(&bar[XB_TOPGEN]) == tg, bar);
            __builtin_amdgcn_fence(__ATOMIC_ACQUIRE, "agent");
            xb_add(&bar[XB_XGEN(b.x)], 1u);
            asm volatile("s_waitcnt vmcnt(0)" ::: "memory");
        } else {
            XB_SPIN(xb_ld(&bar[XB_XGEN(b.x)]) == gen, bar);
            __builtin_amdgcn_fence(__ATOMIC_ACQUIRE, "agent");
            asm volatile("s_waitcnt vmcnt(0)" ::: "memory");
        }
    }
    __syncthreads();
}


__device__ __forceinline__ unsigned mono_u32(float f) { unsigned u = __float_as_uint(f); return (u & 0x80000000u) ? ~u : (u | 0x80000000u); }
__device__ __forceinline__ float demono_u32(unsigned u) { return __uint_as_float((u & 0x80000000u) ? (u & 0x7FFFFFFFu) : ~u); }
__device__ __forceinline__ unsigned pack_key7(float f, int idx) { return (mono_u32(f) & 0xFFFFFF80u) | (unsigned)(127 - idx); }
__device__ __forceinline__ float unpack_key7(unsigned k) { return demono_u32((k & 0xFFFFFF80u) | 0x40u); }
__device__ __forceinline__ float unpack_key8(unsigned k) { return demono_u32((k & 0xFFFFFF00u) | 0x80u); }
__device__ __forceinline__ void ce_desc(unsigned& a, unsigned& b) { const unsigned hi = a > b ? a : b, lo = a > b ? b : a; a = hi; b = lo; }
__device__ __forceinline__ void sort16_desc(unsigned* v) {
#pragma unroll
    for (int k = 2; k <= 16; k <<= 1)
#pragma unroll
        for (int j = k >> 1; j > 0; j >>= 1)
#pragma unroll
            for (int i = 0; i < 16; ++i) { const int l = i ^ j; if (l > i) { if ((i & k) == 0) ce_desc(v[i], v[l]); else ce_desc(v[l], v[i]); } }
}
__device__ __forceinline__ void bmerge16_desc(unsigned* v) {
#pragma unroll
    for (int j = 8; j > 0; j >>= 1)
#pragma unroll
        for (int i = 0; i < 16; ++i) { const int l = i ^ j; if (l > i) ce_desc(v[i], v[l]); }
}
__device__ __forceinline__ void merge_top16(unsigned* a, const unsigned* b) {
#pragma unroll
    for (int i = 0; i < 16; ++i) { const unsigned o = b[15 - i]; a[i] = a[i] > o ? a[i] : o; }
    bmerge16_desc(a);
}
__device__ __forceinline__ void stage2_cands(const unsigned* s0, const unsigned* s1, int hh, unsigned* c) {
    float A[16], B[16];
#pragma unroll
    for (int i = 0; i < 16; ++i) { const float f0 = unpack_key7(s0[i]), f1 = unpack_key7(s1[i]); A[i] = hh ? f1 : f0; B[i] = hh ? f0 : f1; }
    int n = 0;
#pragma unroll
    for (int i = 0; i < 4; ++i)
#pragma unroll
        for (int j = i; j < 16; ++j) { if ((i + 1) * (j + 1) > 16) continue;
            const float val = A[i] + B[j]; const unsigned id = hh ? (unsigned)((j << 4) | i) : (unsigned)((i << 4) | j);
            unsigned key = (mono_u32(val) & 0xFFFFFF00u) | id; if (hh && i == j) key = 0u; c[n++] = key; }
#pragma unroll
    for (; n < 32; ++n) c[n] = 0u;
}

typedef short bf16x8_t __attribute__((ext_vector_type(8)));
typedef float f32x16 __attribute__((ext_vector_type(16)));
__device__ __forceinline__ float gelu_erf(float a) { return 0.5f * a * (1.f + erff(a * 0.70710678118654752f)); }


typedef __attribute__((address_space(3))) bf16 lbf16;

__device__ __forceinline__ f32x16 mm32(bf16x8_t a, bf16x8_t b, f32x16 c) { return __builtin_amdgcn_mfma_f32_32x32x16_bf16(a, b, c, 0, 0, 0); }
__device__ __forceinline__ bf16x8_t frag_from_u32x4(unsigned x, unsigned y, unsigned z, unsigned w) { typedef unsigned u4 __attribute__((ext_vector_type(4))); u4 t = {x, y, z, w}; return __builtin_bit_cast(bf16x8_t, t); }
template <int S> __device__ __forceinline__ bf16x8_t accop(const f32x16& z) {
    return frag_from_u32x4(cvtpk(z[8 * S], z[8 * S + 1]), cvtpk(z[8 * S + 2], z[8 * S + 3]), cvtpk(z[8 * S + 4], z[8 * S + 5]), cvtpk(z[8 * S + 6], z[8 * S + 7])); }
template <int S> __device__ __forceinline__ bf16x8_t ldpermcol(const lbf16* a, int col, int hh) {
    const lbf16* p = a + (16 * S + 4 * hh) * 72 + col;
    const unsigned e0 = p[0], e1 = p[72], e2 = p[144], e3 = p[216], e4 = p[8 * 72], e5 = p[9 * 72], e6 = p[10 * 72], e7 = p[11 * 72];
    return frag_from_u32x4(e0 | (e1 << 16), e2 | (e3 << 16), e4 | (e5 << 16), e6 | (e7 << 16)); }
__device__ __forceinline__ bf16x8_t ldrow(const lbf16* a, int row, int ks, int hh) { return *(const __attribute__((address_space(3))) bf16x8_t*)(a + row * 72 + ks * 16 + 8 * hh); }
__device__ __forceinline__ int rowidx(int e, int hh) { return (e & 3) + 8 * (e >> 2) + 4 * hh; }

constexpr int CONV_S1_ROWS = 0;
constexpr int ROWB = 768;
__device__ __forceinline__ unsigned fp6code(float x, float sc) {
    const float t = fabsf(x) * sc;
    const float r = t < 16.f ? __builtin_rintf(t) : (t < 32.f ? 8.f + __builtin_rintf(t * 0.5f) : 16.f + __builtin_rintf(t * 0.25f));
    unsigned c = (unsigned)r; c = c > 31u ? 31u : c;
    return c | (x < 0.f ? 32u : 0u);
}
__device__ __forceinline__ void convert_tables_fp6(const float* pu, const float* pv, unsigned char* u8, unsigned char* v8, float* usc, float* vsc, int l, int wv, int nw, int lane, int q_lo, int q_hi) {
    for (int rr0 = q_lo + wv * 2; rr0 < q_hi; rr0 += nw * 2) {
        f32x4 v[2][4]; float m[2];
#pragma unroll
        for (int rr = 0; rr < 2; ++rr) { const int q = rr0 + rr; const size_t row = (size_t)l * NEXP + (q < NEXP ? q : q - NEXP); const float* sp_ = (q < NEXP ? pu : pv) + row * D + lane * 4;
#pragma unroll
            for (int k = 0; k < 4; ++k) v[rr][k] = *(const f32x4*)(sp_ + k * 256); }
#pragma unroll
        for (int rr = 0; rr < 2; ++rr) { float mm = 0.f;
#pragma unroll
            for (int k = 0; k < 4; ++k) mm = fmaxf(fmaxf(mm, fmaxf(fabsf(v[rr][k].x), fabsf(v[rr][k].y))), fmaxf(fabsf(v[rr][k].z), fabsf(v[rr][k].w)));
#pragma unroll
            for (int o = 1; o < 64; o <<= 1) mm = fmaxf(mm, shflx(mm, lane, o));
            m[rr] = mm; }
        { typedef float f32x16_t __attribute__((ext_vector_type(16))); typedef unsigned u32x6_t __attribute__((ext_vector_type(6)));
          const float sc0 = m[0] > 0.f ? 7.5f / m[0] : 1.f, sc1 = m[1] > 0.f ? 7.5f / m[1] : 1.f; f32x16_t pa, pb;
#pragma unroll
          for (int k = 0; k < 4; ++k) {
              pa[k * 2] = v[0][k].x * sc0; pb[k * 2] = v[0][k].y * sc0; pa[k * 2 + 1] = v[0][k].z * sc0; pb[k * 2 + 1] = v[0][k].w * sc0;
              pa[8 + k * 2] = v[1][k].x * sc1; pb[8 + k * 2] = v[1][k].y * sc1; pa[8 + k * 2 + 1] = v[1][k].z * sc1; pb[8 + k * 2 + 1] = v[1][k].w * sc1; }
          const u32x6_t pk = __builtin_amdgcn_cvt_scalef32_2xpk16_fp6_f32(pa, pb, 1.0f);
#pragma unroll
          for (int rr = 0; rr < 2; ++rr) { const int q = rr0 + rr; const size_t row = (size_t)l * NEXP + (q < NEXP ? q : q - NEXP);
              unsigned* op = (unsigned*)((q < NEXP ? u8 : v8) + row * ROWB + lane * 12);
              op[0] = pk[rr * 3]; op[1] = pk[rr * 3 + 1]; op[2] = pk[rr * 3 + 2];
              if (lane == 0) (q < NEXP ? usc : vsc)[row] = m[rr] > 0.f ? m[rr] * (1.f / 7.5f) : 1.f; } }
    }
}

__global__ void __launch_bounds__(NTHR, 2) mega(Args args) {
    extern __shared__ __attribute__((aligned(16))) unsigned char lds_raw[];
    LAS unsigned char* lds = (LAS unsigned char*)lds_raw;
    const int G = gridDim.x, bx = blockIdx.x, NGW = G * NWAVES;
    const int wave0 = __builtin_amdgcn_readfirstlane((int)threadIdx.x >> 6);
    typedef const unsigned char __attribute__((address_space(4))) kbyte;
#define PHASE_IDS int tid; asm volatile("v_mbcnt_lo_u32_b32 %0, -1, 0\n\tv_mbcnt_hi_u32_b32 %0, -1, %0" : "=v"(tid)); tid += wave0 * 64;     const int lane = tid & 63, wave = __builtin_amdgcn_readfirstlane(tid >> 6), gw = bx * NWAVES + wave; (void)lane; (void)gw; \
    kbyte* kp = (kbyte*)__builtin_amdgcn_kernarg_segment_ptr(); asm volatile("" : "+s"(kp)); \
    unsigned char* const ws = (unsigned char*)*(__attribute__((address_space(1))) unsigned char* const __attribute__((address_space(4)))*)(kp + 31 * 8); float* const X = (float*)*(__attribute__((address_space(1))) float* const __attribute__((address_space(4)))*)(kp + 30 * 8); (void)ws; (void)X;
#define INP(i) ((const float*)(*(const __attribute__((address_space(1))) float* const __attribute__((address_space(4)))*)(kp + (i) * 8)))
#define MOD ((float*)(ws + WS_MOD))
#define H ((bf16*)(ws + WS_H))
#define PROJ ((bf16*)(ws + WS_PROJ))
#define Q ((bf16*)(ws + WS_Q))
#define MIX ((bf16*)(ws + WS_MIX))
#define Rb ((bf16*)(ws + WS_R))
#define Kb ((bf16*)(ws + WS_K))
#define V0 ((bf16*)(ws + WS_V0))
#define V1 ((bf16*)(ws + WS_V1))
#define KKb ((bf16*)(ws + WS_KK))
#define Bb ((bf16*)(ws + WS_B))
#define Gb ((bf16*)(ws + WS_G))
#define BGb ((bf16*)(ws + WS_BG))
#define Wd ((float*)(ws + WS_W))
#define Y ((float*)(ws + WS_Y))
#define QB ((float*)(ws + WS_QB))
#define POOLIN ((bf16*)(ws + WS_QB))
#define SH ((float*)(ws + WS_SH))
#define SSQ ((unsigned long long*)(ws + WS_SH))
#define CVEC ((float*)(ws + WS_SH + 512 * 1024))
#define S2V ((float*)(ws + WS_SH + 640 * 1024))
#define XB2 ((bf16*)(ws + WS_R))
#define WUPT ((bf16*)(ws + WS_LORA))
#define AUPT ((bf16*)(ws + WS_LORA + 131072))
#define GUPT ((bf16*)(ws + WS_LORA + 262144))
#define VUPT ((bf16*)(ws + WS_LORA + 524288))
#define PWT ((bf16*)(ws + WS_LORA + 655360))
#define INVN ((float*)(ws + WS_INVN))
#define BSUM ((float*)(ws + WS_BSUM))
#define SCN ((unsigned char*)(ws + WS_SCN))
#define IDX ((int*)(ws + WS_IDX))
#define GATE ((float*)(ws + WS_GATE))
#define WinT ((bf16*)(ws + WS_WIN_T))
#define WoutT ((bf16*)(ws + WS_WOUT_T))
#define PqT ((bf16*)(ws + WS_PQ_T))
#define KEYS ((bf16*)(ws + WS_KEYS))
#define U8 ((unsigned char*)(ws + WS_U))
#define V8 ((unsigned char*)(ws + WS_V))
#define USc ((float*)(ws + WS_US))
#define VSc ((float*)(ws + WS_VS))
    const int lo = args.ph_lo, hi = args.ph_hi;
    { volatile LAS unsigned* misc = (volatile LAS unsigned*)(lds + LDS_BYTES - 64); if (threadIdx.x < 4) misc[threadIdx.x] = 0u; __syncthreads(); }
    const XcdBarrier xbar = xcd_barrier_post((unsigned*)(args.ws) + 4096, (volatile LAS unsigned*)(lds + LDS_BYTES - 64));
#define IN(k) (lo <= (k) && (k) < hi)
#ifndef REP_PHASE
#define REP_PHASE (-1)
#endif
#define REPS(k) ((k) == REP_PHASE ? 3 : 1)
#define SEAM(k) do { if (IN(k) && IN((k) + 1)) { if ((k) == 0) cg::this_grid().sync(); else { XcdBarrier xb_ = xbar; asm volatile("" : "+s"(xb_.bar)); if ((k) == 1) xcd_barrier<true>(xb_); else xcd_barrier<false>(xb_); } } } while (0)

    if (IN(0)) { PHASE_IDS
        { unsigned long long* z = SSQ; for (int i = bx * NTHR + tid; i < 2 * T; i += G * NTHR) z[i] = 0ull; }
        { LAS float* ca = (LAS float*)lds; LAS float* red = (LAS float*)(lds + 16384);
          const float* c = INP(1); const float* ada_w = INP(2); const float* ada_b = INP(3);
          bool have = false;
          for (int it = bx; it < 192; it += G) {
              if (!have) { for (int i = tid; i < BATCH * D; i += NTHR) { const float v = c[i]; ca[i] = v / (1.f + expf(-v)); } have = true; __syncthreads(); }
              const int l = it / 96, n = (it % 96) * 64 + (tid & 63), kq = tid >> 6;
              const float* w = ada_w + (size_t)l * D * 6 * D + (size_t)(kq * 128) * 6 * D + n;
              float a0 = 0.f, a1 = 0.f, a2 = 0.f, a3 = 0.f;
#pragma unroll 32
              for (int k = 0; k < 128; ++k) { const float wv = w[(size_t)k * 6 * D]; const int kk = kq * 128 + k; a0 += ca[kk] * wv; a1 += ca[D + kk] * wv; a2 += ca[2 * D + kk] * wv; a3 += ca[3 * D + kk] * wv; }
              red[(kq * 4 + 0) * 64 + (tid & 63)] = a0; red[(kq * 4 + 1) * 64 + (tid & 63)] = a1; red[(kq * 4 + 2) * 64 + (tid & 63)] = a2; red[(kq * 4 + 3) * 64 + (tid & 63)] = a3;
              __syncthreads();
              if (tid < 256) { const int b = tid >> 6, col = tid & 63, nn = (it % 96) * 64 + col; float s = 0.f;
#pragma unroll
                for (int q = 0; q < 8; ++q) s += red[(q * 4 + b) * 64 + col];
                MOD[(size_t)l * BATCH * 6 * D + (size_t)b * 6 * D + nn] = s + ada_b[l * 6 * D + nn]; }
              __syncthreads();
          }
          __syncthreads(); }
        { LAS float* scr = (LAS float*)(lds + wave * 16384);
          constexpr int I_IN = (D / 64) * (IN_COLS / 32), I_VR = (D / 64) * (MVL / 32), I_OUT = (D / 64) * (D / 32), I_PQ = (D / 64) * (PH * PQ / 32);
          constexpr int NIT = 2 * I_IN + I_VR + 2 * I_OUT + 2 * I_PQ;
          for (int it = gw; it < NIT; it += NGW) { int r = it;
              if (r < 2 * I_IN) { const int l = r / I_IN; p0_transpose_item(INP(5) + (size_t)l * D * IN_COLS, D, IN_COLS, WinT + (size_t)l * LDP * D, 0, scr, r % I_IN, lane); continue; } r -= 2 * I_IN;
              if (r < I_VR) { p0_transpose_item(INP(12), D, MVL, WinT + (size_t)1 * LDP * D, IN_COLS, scr, r, lane); continue; } r -= I_VR;
              if (r < 2 * I_OUT) { const int l = r / I_OUT; p0_transpose_item(INP(23) + (size_t)l * D * D, D, D, WoutT + (size_t)l * D * D, 0, scr, r % I_OUT, lane); continue; } r -= 2 * I_OUT;
              { const int l = r / I_PQ; p0_transpose_item(INP(25) + (size_t)l * D * PH * PQ, D, PH * PQ, PqT + (size_t)l * PH * PQ * D, 0, scr, r % I_PQ, lane); } }
          for (int it = gw; it < 2 * 16 + 2 * 16 + 2 * 32; it += NGW) { int r = it;
              if (r < 32) { const int l = r / 16; p0_transpose_item(INP(8) + (size_t)l * DL * RW, DL, RW, WUPT + (size_t)l * RW * DL, 0, scr, r % 16, lane); continue; } r -= 32;
              if (r < 32) { const int l = r / 16; p0_transpose_item(INP(10) + (size_t)l * AL * RW, AL, RW, AUPT + (size_t)l * RW * AL, 0, scr, r % 16, lane); continue; } r -= 32;
              { const int l = r / 32; p0_transpose_item(INP(11) + (size_t)l * GL * RW, GL, RW, GUPT + (size_t)l * RW * GL, 0, scr, r % 32, lane); } }
          { const float* vu = INP(15); for (int e = bx * NTHR + tid; e < MVL * RW; e += G * NTHR) { const int n = e >> 5, k = e & 31; VUPT[e] = f2bf(vu[k * RW + n]); } }
          for (int it = gw; it < 8 * 8; it += NGW) p0_transpose_item(INP(21) + (size_t)(it >> 3) * PG * PG, PG, PG, PWT + (size_t)(it >> 3) * PG * PG, 0, scr, it & 7, lane);
        }
        { const size_t gt = (size_t)bx * NTHR + tid, NT = (size_t)G * NTHR;
          constexpr size_t NK8 = (size_t)2 * PH * 2 * NKEYS * PHALF / 8;
          const float* src = INP(26); bf16* dst = KEYS;
          for (size_t i = gt; i < NK8; i += NT) {
              const f32x4 a = *(const f32x4*)(src + i * 8), b = *(const f32x4*)(src + i * 8 + 4);
              u32x4 o; o.x = pk2(a.x, a.y); o.y = pk2(a.z, a.w); o.z = pk2(b.x, b.y); o.w = pk2(b.z, b.w); *(u32x4*)(dst + i * 8) = o; }
        }
    }
    SEAM(0);

#pragma unroll
    for (int l = 0; l < DEPTH; ++l) {
        const int pb = 1 + 10 * l;
#define modl (MOD + (size_t)l * BATCH * 6 * D)
#define xin (l == 0 ? INP(0) : (const float*)X)
        if (l == 0 && IN(pb + 0)) { PHASE_IDS const float* gamma = INP(4) + l * D;
            for (int row = gw; row < T; row += NGW) { const int b = row / SEQ; norm_mod_row(xin + (size_t)row * D, gamma, modl + (size_t)b * 6 * D, modl + (size_t)b * 6 * D + D, H + (size_t)row * D, lane); } }
        SEAM(pb + 0);
        if (IN(pb + 1)) { PHASE_IDS const int N1 = l == 0 ? IN_COLS : LDP;
            pg8::Gemm g{H, WinT + (size_t)l * LDP * D, T, N1, D}; pg8::StaticOrder S; S.init(T, N1, G, bx);
            pg8::EpiProj E{PROJ, LDP, POOLIN, RWKV_COLS, PW};
            pg8::gemm_phase<pg8::EpiProj, pg8::StaticOrder, true, true>(lds, g, S, E, tid); }
        SEAM(pb + 1);

        if (IN(pb + 2)) { PHASE_IDS
            constexpr int LST = 296;
            LAS bf16* lin = (LAS bf16*)lds;
            const float* mu = INP(6) + l * RWKV_COLS; const float* vmu = INP(13);
            const float* w0p = INP(7) + l * RW; const float* a0p = INP(9) + l * RW; const float* kkp = INP(16) + l * RW; const float* kap = INP(17) + l * RW; const float* rkp = INP(18) + l * RW; const float* v0p = INP(14);
            const bf16* wupT = WUPT + (size_t)l * RW * DL; const bf16* aupT = AUPT + (size_t)l * RW * AL; const bf16* gupT = GUPT + (size_t)l * RW * GL; const bf16* vupT = VUPT;
            bf16* Vl = l == 0 ? V0 : V1;
            const int r32 = lane & 31, hh = lane >> 5, h = wave;
            for (int tile = bx; tile < T / 32; tile += G) {
                const int t0 = tile * 32;
                __syncthreads();
#pragma unroll 1
                for (int it0 = 0; it0 < 3; it0 += 2) {
                  u32x4 cu_[2], pv_[2]; f32x4 m0_[2], m1_[2];
#pragma unroll
                  for (int it = 0; it < 2; ++it) { const int c8 = tid + (it0 + it) * NTHR; const bool ok = c8 < 32 * 36; const int tok = ok ? c8 / 36 : 0, jc = ok ? c8 % 36 : 0, t = t0 + tok, sq = t % SEQ;
                      cu_[it] = (u32x4){0u, 0u, 0u, 0u}; pv_[it] = (u32x4){0u, 0u, 0u, 0u}; m0_[it] = (f32x4){0.f, 0.f, 0.f, 0.f}; m1_[it] = m0_[it];
                      if (ok && (jc < 32 || l > 0)) { const int col = jc < 32 ? 3 * RW + jc * 8 : IN_COLS + (jc - 32) * 8;
                          cu_[it] = *(const u32x4*)(PROJ + (size_t)t * LDP + col); if (sq > 0) pv_[it] = *(const u32x4*)(PROJ + (size_t)(t - 1) * LDP + col);
                          const float* mp = jc < 32 ? mu + col : vmu + (jc - 32) * 8; m0_[it] = *(const f32x4*)mp; m1_[it] = *(const f32x4*)(mp + 4); } }
#pragma unroll
                  for (int it = 0; it < 2; ++it) { const int c8 = tid + (it0 + it) * NTHR; if (c8 < 32 * 36) { const int tok = c8 / 36, jc = c8 % 36;
                      u32x4 o = {0u, 0u, 0u, 0u};
                      if (jc < 32 || l > 0) {
                          float x[8]; const unsigned cw[4] = {cu_[it].x, cu_[it].y, cu_[it].z, cu_[it].w}, pw[4] = {pv_[it].x, pv_[it].y, pv_[it].z, pv_[it].w}; const float mm[8] = {m0_[it].x, m0_[it].y, m0_[it].z, m0_[it].w, m1_[it].x, m1_[it].y, m1_[it].z, m1_[it].w};
#pragma unroll
                          for (int i = 0; i < 4; ++i) { const float c0 = __uint_as_float(cw[i] << 16), c1 = __uint_as_float(cw[i] & 0xffff0000u), p0 = __uint_as_float(pw[i] << 16), p1 = __uint_as_float(pw[i] & 0xffff0000u);
                              x[2 * i] = c0 + (p0 - c0) * mm[2 * i]; x[2 * i + 1] = c1 + (p1 - c1) * mm[2 * i + 1]; }
                          if (jc < 8) {
#pragma unroll
                              for (int i = 0; i < 8; ++i) { const float e2 = __expf(-2.f * fabsf(x[i])); const float th = (1.f - e2) * __builtin_amdgcn_rcpf(1.f + e2); x[i] = x[i] < 0.f ? -th : th; } }
                          else if (jc >= 16 && jc < 32) {
#pragma unroll
                              for (int i = 0; i < 8; ++i) x[i] = __builtin_amdgcn_rcpf(1.f + __expf(-x[i])); }
                          o.x = pk2(x[0], x[1]); o.y = pk2(x[2], x[3]); o.z = pk2(x[4], x[5]); o.w = pk2(x[6], x[7]);
                      }
                      *(LAS u32x4*)(lin + tok * LST + jc * 8) = o; } } }
                __syncthreads();
                const bool first = (t0 % SEQ) == 0;
                lbf16* tin = (lbf16*)(lds + 19456 + wave * 14336);
                { u32x4 iq[13]; int ql_; asm volatile("v_mbcnt_lo_u32_b32 %0, -1, 0\n\tv_mbcnt_hi_u32_b32 %0, -1, %0" : "=v"(ql_));
#pragma unroll
                  for (int i = 0; i < 13; ++i) { const int q = ql_ + 64 * i; iq[i] = (u32x4){0u, 0u, 0u, 0u};
                      if (q < 792) { const int arr = q / 264, rem = q - arr * 264, row = rem >> 3, cc = rem & 7;
                          if (!(first && row == 0)) iq[i] = *(const u32x4*)(PROJ + (size_t)(t0 - 1 + row) * LDP + arr * RW + h * HS + cc * 8); } }
#pragma unroll
                  for (int i = 0; i < 13; ++i) { const int q = ql_ + 64 * i; if (q < 792) { const int arr = q / 264, rem = q - arr * 264, row = rem >> 3, cc = rem & 7;
                      *(__attribute__((address_space(3))) u32x4*)(tin + arr * 2376 + row * 72 + cc * 8) = iq[i]; } } }
                __builtin_amdgcn_wave_barrier(); asm volatile("s_waitcnt lgkmcnt(0)" ::: "memory");
                float ssq[16], bsm[16];
#pragma unroll
                for (int e = 0; e < 16; ++e) { ssq[e] = 0.f; bsm[e] = 0.f; }
#pragma unroll 1
                for (int rt = 0; rt < 2; ++rt) {
                    f32x16 accW, accA, accG, accV;
#pragma unroll
                    for (int e = 0; e < 16; ++e) { accW[e] = 0.f; accA[e] = 0.f; accG[e] = 0.f; accV[e] = 0.f; }
                    int c = h * HS + rt * 32 + r32;
int hh8 = 8 * hh; asm volatile("" : "+v"(c), "+v"(hh8));
                    const LAS bf16* lrow = lin + r32 * LST + 8 * hh;
                    { bf16x8_t wf[18];
#pragma unroll
                      for (int ks = 0; ks < 4; ++ks) { wf[ks] = *(const bf16x8_t*)(wupT + (size_t)c * DL + ks * 16 + hh8); wf[4 + ks] = *(const bf16x8_t*)(aupT + (size_t)c * AL + ks * 16 + hh8); }
#pragma unroll
                      for (int ks = 0; ks < 8; ++ks) wf[8 + ks] = *(const bf16x8_t*)(gupT + (size_t)c * GL + ks * 16 + hh8);
                      wf[16] = bf16x8_t{}; wf[17] = bf16x8_t{};
                      if (l > 0) { wf[16] = *(const bf16x8_t*)(vupT + (size_t)c * MVL + hh8); wf[17] = *(const bf16x8_t*)(vupT + (size_t)c * MVL + 16 + hh8); }
#pragma unroll
                      for (int ks = 0; ks < 4; ++ks) { accW = __builtin_amdgcn_mfma_f32_32x32x16_bf16(*(const LAS bf16x8_t*)(lrow + ks * 16), wf[ks], accW, 0, 0, 0);
                                                       accA = __builtin_amdgcn_mfma_f32_32x32x16_bf16(*(const LAS bf16x8_t*)(lrow + 64 + ks * 16), wf[4 + ks], accA, 0, 0, 0); }
#pragma unroll
                      for (int ks = 0; ks < 8; ++ks) accG = __builtin_amdgcn_mfma_f32_32x32x16_bf16(*(const LAS bf16x8_t*)(lrow + 128 + ks * 16), wf[8 + ks], accG, 0, 0, 0);
                      if (l > 0) {
#pragma unroll
                          for (int ks = 0; ks < 2; ++ks) accV = __builtin_amdgcn_mfma_f32_32x32x16_bf16(*(const LAS bf16x8_t*)(lrow + 256 + ks * 16), wf[16 + ks], accV, 0, 0, 0); } }
                    const float mur = mu[c], muk = mu[RW + c], muv = mu[2 * RW + c], w0c = w0p[c], a0c = a0p[c], kkc = kkp[c], kac = kap[c], rkc = rkp[c];
                    const float v0c = l > 0 ? v0p[c] : 0.f;
#pragma unroll
                    for (int eb = 0; eb < 16; eb += 4) {
                        bf16 lr[4], lk[4], lv[4], lrp[4], lkp[4], lvp[4], lvf[4];
#pragma unroll
                        for (int i = 0; i < 4; ++i) { const int e = eb + i; const int tok = (e & 3) + 8 * (e >> 2) + 4 * hh, t = t0 + tok; const int ci = rt * 32 + r32;
                            lr[i] = tin[(tok + 1) * 72 + ci]; lk[i] = tin[2376 + (tok + 1) * 72 + ci]; lv[i] = tin[2 * 2376 + (tok + 1) * 72 + ci];
                            lrp[i] = tin[tok * 72 + ci]; lkp[i] = tin[2376 + tok * 72 + ci]; lvp[i] = tin[2 * 2376 + tok * 72 + ci];
                            lvf[i] = l > 0 ? V0[(size_t)t * RW + c] : (bf16)0; }
                        __builtin_amdgcn_sched_barrier(0);
#pragma unroll
                        for (int i = 0; i < 4; ++i) { const int e = eb + i; const int tok = (e & 3) + 8 * (e >> 2) + 4 * hh, t = t0 + tok; const size_t o = (size_t)t * RW + c;
                            float r = bf2f(lr[i]), k = bf2f(lk[i]), v = bf2f(lv[i]);
                            r += (bf2f(lrp[i]) - r) * mur; k += (bf2f(lkp[i]) - k) * muk; v += (bf2f(lvp[i]) - v) * muv;
                            const float z = -(w0c + accW[e]); const float sp = fmaxf(z, 0.f) + __logf(1.f + __expf(-fabsf(z)));
                            const float decay = __expf(-__expf(-sp - 0.5f));
                            const float a = __builtin_amdgcn_rcpf(1.f + __expf(-(a0c + accA[e]))); const float g = accG[e];
                            if (l > 0) { const float vfv = bf2f(lvf[i]); v = v + (vfv - v) * __builtin_amdgcn_rcpf(1.f + __expf(-(v0c + accV[e]))); }
                            const float kk = k * kkc; const float k2 = k * (1.f + (a - 1.f) * kac);
                            ssq[e] += kk * kk; bsm[e] += r * k2 * rkc;
                            { const unsigned p0_ = cvtpk(r, k2), p1_ = cvtpk(v, kk), p2_ = cvtpk(kk * a, g), p3_ = cvtpk(v * g, 0.f);
                              Rb[o] = (bf16)p0_; Kb[o] = (bf16)(p0_ >> 16); Vl[o] = (bf16)p1_; KKb[o] = (bf16)(p1_ >> 16); Bb[o] = (bf16)p2_; Gb[o] = (bf16)(p2_ >> 16); BGb[o] = (bf16)p3_; Wd[o] = decay; }
                        }
                    }
                }
#pragma unroll
                for (int e = 0; e < 16; ++e) { const int ln_ = r32 | (hh << 5); float a_ = red16(ssq[e]), b_ = red16(bsm[e]); a_ += shflx(a_, ln_, 16); b_ += shflx(b_, ln_, 16); ssq[e] = a_; bsm[e] = b_; }
                if (r32 == 0) {
#pragma unroll
                    for (int e = 0; e < 16; ++e) { const int tok = (e & 3) + 8 * (e >> 2) + 4 * hh; INVN[(size_t)(t0 + tok) * NH + h] = rsqrtf(fmaxf(ssq[e], 1e-24f)); BSUM[(size_t)(t0 + tok) * NH + h] = bsm[e]; } }
            }
        }
        if (IN(pb + 2) && IN(pb + 3)) { asm volatile("s_waitcnt vmcnt(0)" ::: "memory"); __syncthreads(); }

        if (IN(pb + 3)) { PHASE_IDS
            const bf16* Vl = l == 0 ? V0 : V1;
            const int r32 = lane & 31, hh = lane >> 5;
            if (wave < 6) {
                lbf16* At = (lbf16*)(lds + wave * 23552); lbf16* Bt = At + 2304; lbf16* Kt = Bt + 2304; lbf16* Rt = Kt + 2304; lbf16* Vv = Rt + 2304;
                LAS float* PCs = (LAS float*)(lds + wave * 23552 + 23040);
                const int ntl = bx < T / 32 ? (T / 32 - bx + G - 1) / G : 0;
                for (int q = wave; q < ntl * NH; q += 6) {
                    const int tile = bx + (q >> 3) * G, h = q & 7, b = tile >> 7, chunk = tile & 127, bh = b * NH + h, item = bh * (SEQ / 32) + chunk; const size_t t0 = (size_t)tile * 32;
                    __builtin_amdgcn_wave_barrier(); asm volatile("s_waitcnt lgkmcnt(0)" ::: "memory");
                    {
                      const int tk = lane >> 3, part = lane & 7;
                      u32x4 qr[4], qk[4], qv[4], qkk[4], qb[4]; f32x4 qw0[4], qw1[4]; float qin[4];
#pragma unroll
                      for (int p4 = 0; p4 < 4; ++p4) { const size_t o = (t0 + p4 * 8 + tk) * RW + h * HS + part * 8;
                          qr[p4] = *(const u32x4*)(Rb + o); qk[p4] = *(const u32x4*)(Kb + o); qv[p4] = *(const u32x4*)(Vl + o); qkk[p4] = *(const u32x4*)(KKb + o); qb[p4] = *(const u32x4*)(Bb + o);
                          qw0[p4] = *(const f32x4*)(Wd + o); qw1[p4] = *(const f32x4*)(Wd + o + 4); qin[p4] = INVN[(t0 + p4 * 8 + tk) * NH + h]; }
                      LAS float* Pl = (LAS float*)At;
#pragma unroll
                      for (int p4 = 0; p4 < 4; ++p4) { *(LAS f32x4*)(Pl + (p4 * 8 + tk) * 64 + part * 8) = qw0[p4]; *(LAS f32x4*)(Pl + (p4 * 8 + tk) * 64 + part * 8 + 4) = qw1[p4]; }
                      __builtin_amdgcn_wave_barrier(); asm volatile("s_waitcnt lgkmcnt(0)" ::: "memory");
                      { float P = 1.f;
#pragma unroll 8
                        for (int c = 0; c < 32; ++c) { P *= Pl[c * 64 + lane]; Pl[c * 64 + lane] = P; }
                        PCs[lane] = P; }
                      __builtin_amdgcn_wave_barrier(); asm volatile("s_waitcnt lgkmcnt(0)" ::: "memory");
                      u32x4 oa[4], orr[4], ob_[4], ok_[4];
#pragma unroll
                      for (int p4 = 0; p4 < 4; ++p4) { const int c = p4 * 8 + tk;
                          const f32x4 pa = *(const LAS f32x4*)(Pl + c * 64 + part * 8), pb2 = *(const LAS f32x4*)(Pl + c * 64 + part * 8 + 4);
                          f32x4 ma = {1.f, 1.f, 1.f, 1.f}, mb = ma; if (c > 0) { ma = *(const LAS f32x4*)(Pl + (c - 1) * 64 + part * 8); mb = *(const LAS f32x4*)(Pl + (c - 1) * 64 + part * 8 + 4); }
                          const float Pc[8] = {pa.x, pa.y, pa.z, pa.w, pb2.x, pb2.y, pb2.z, pb2.w}, Pm[8] = {ma.x, ma.y, ma.z, ma.w, mb.x, mb.y, mb.z, mb.w};
                          const unsigned rw_[4] = {qr[p4].x, qr[p4].y, qr[p4].z, qr[p4].w}, kw_[4] = {qk[p4].x, qk[p4].y, qk[p4].z, qk[p4].w}, kkw[4] = {qkk[p4].x, qkk[p4].y, qkk[p4].z, qkk[p4].w}, bw_[4] = {qb[p4].x, qb[p4].y, qb[p4].z, qb[p4].w};
                          unsigned xa[4], xr[4], xb[4], xk[4]; const float inv = qin[p4];
#pragma unroll
                          for (int i = 0; i < 4; ++i) { const float ip0 = __builtin_amdgcn_rcpf(Pc[2 * i]), ip1 = __builtin_amdgcn_rcpf(Pc[2 * i + 1]);
                              xa[i] = pk2(-__uint_as_float(kkw[i] << 16) * inv * Pm[2 * i], -__uint_as_float(kkw[i] & 0xffff0000u) * inv * Pm[2 * i + 1]);
                              xr[i] = pk2(__uint_as_float(rw_[i] << 16) * Pc[2 * i], __uint_as_float(rw_[i] & 0xffff0000u) * Pc[2 * i + 1]);
                              xb[i] = pk2(__uint_as_float(bw_[i] << 16) * inv * ip0, __uint_as_float(bw_[i] & 0xffff0000u) * inv * ip1);
                              xk[i] = pk2(__uint_as_float(kw_[i] << 16) * ip0, __uint_as_float(kw_[i] & 0xffff0000u) * ip1); }
                          oa[p4] = (u32x4){xa[0], xa[1], xa[2], xa[3]}; orr[p4] = (u32x4){xr[0], xr[1], xr[2], xr[3]}; ob_[p4] = (u32x4){xb[0], xb[1], xb[2], xb[3]}; ok_[p4] = (u32x4){xk[0], xk[1], xk[2], xk[3]}; }
                      __builtin_amdgcn_wave_barrier(); asm volatile("s_waitcnt lgkmcnt(0)" ::: "memory");
#pragma unroll
                      for (int p4 = 0; p4 < 4; ++p4) { const int c = p4 * 8 + tk, o = c * 72 + part * 8;
                          *(__attribute__((address_space(3))) u32x4*)(At + o) = oa[p4]; *(__attribute__((address_space(3))) u32x4*)(Rt + o) = orr[p4]; *(__attribute__((address_space(3))) u32x4*)(Bt + o) = ob_[p4];
                          *(__attribute__((address_space(3))) u32x4*)(Kt + o) = ok_[p4]; *(__attribute__((address_space(3))) u32x4*)(Vv + o) = qv[p4]; } }
                    __builtin_amdgcn_wave_barrier(); asm volatile("s_waitcnt lgkmcnt(0)" ::: "memory");
                    const f32x16 zero16 = {0.f, 0.f, 0.f, 0.f, 0.f, 0.f, 0.f, 0.f, 0.f, 0.f, 0.f, 0.f, 0.f, 0.f, 0.f, 0.f};
                    f32x16 X = zero16, Yt = zero16;
#pragma unroll
                    for (int ks = 0; ks < 4; ++ks) { const bf16x8_t fa = ldrow(At, r32, ks, hh), fb = ldrow(Bt, r32, ks, hh); X = mm32(fa, fb, X); Yt = mm32(fb, fa, Yt); }
#pragma unroll
                    for (int e = 0; e < 16; ++e) { const int ri = rowidx(e, hh); X[e] = (r32 < ri) ? X[e] : 0.f; Yt[e] = (ri < r32) ? Yt[e] : 0.f; }
                    f32x16 TY = Yt;
#pragma unroll
                    for (int e = 0; e < 16; ++e) TY[e] += (rowidx(e, hh) == r32) ? 1.f : 0.f;
#pragma unroll 1
                    for (int it = 0; it < 4; ++it) {
                        const bf16x8_t x0 = accop<0>(X), x1 = accop<1>(X), y0 = accop<0>(Yt), y1 = accop<1>(Yt);
                        f32x16 Xn = mm32(y0, x0, zero16); Xn = mm32(y1, x1, Xn);
                        f32x16 Yn = mm32(x0, y0, zero16); Yn = mm32(x1, y1, Yn);
                        X = Xn; Yt = Yn;
                        const bf16x8_t p0 = accop<0>(X), p1 = accop<1>(X), t0_ = accop<0>(TY), t1_ = accop<1>(TY);
                        TY = mm32(p0, t0_, TY); TY = mm32(p1, t1_, TY);
                    }
                    const bf16x8_t ty0 = accop<0>(TY), ty1 = accop<1>(TY);
                    unsigned char* rec = SCN + (size_t)item * 24576;
                    const bf16x8_t v00 = ldpermcol<0>(Vv, r32, hh), v01 = ldpermcol<1>(Vv, r32, hh), v10 = ldpermcol<0>(Vv, 32 + r32, hh), v11 = ldpermcol<1>(Vv, 32 + r32, hh);
                    f32x16 U0a, U0b;
                    { f32x16 G2T = zero16;
#pragma unroll
                      for (int ks = 0; ks < 4; ++ks) G2T = mm32(ldrow(Kt, r32, ks, hh), ldrow(At, r32, ks, hh), G2T);
#pragma unroll
                      for (int e = 0; e < 16; ++e) G2T[e] = (rowidx(e, hh) < r32) ? G2T[e] : 0.f;
                      const bf16x8_t g0 = accop<0>(G2T), g1 = accop<1>(G2T);
                      f32x16 Za = mm32(g0, v00, zero16); Za = mm32(g1, v01, Za); f32x16 Zb = mm32(g0, v10, zero16); Zb = mm32(g1, v11, Zb);
                      U0a = mm32(ty0, accop<0>(Za), zero16); U0a = mm32(ty1, accop<1>(Za), U0a); U0b = mm32(ty0, accop<0>(Zb), zero16); U0b = mm32(ty1, accop<1>(Zb), U0b); }
                    const bf16x8_t ua0 = accop<0>(U0a), ua1 = accop<1>(U0a), ub0 = accop<0>(U0b), ub1 = accop<1>(U0b);
                    f32x16 G3T = zero16;
                    { f32x16 G4T = zero16;
#pragma unroll
                      for (int ks = 0; ks < 4; ++ks) { const bf16x8_t fr = ldrow(Rt, r32, ks, hh); G3T = mm32(ldrow(Bt, r32, ks, hh), fr, G3T); G4T = mm32(ldrow(Kt, r32, ks, hh), fr, G4T); }
#pragma unroll
                      for (int e = 0; e < 16; ++e) { const bool keep = rowidx(e, hh) <= r32; G3T[e] = keep ? G3T[e] : 0.f; G4T[e] = keep ? G4T[e] : 0.f; }
                      const bf16x8_t g30 = accop<0>(G3T), g31 = accop<1>(G3T), g40 = accop<0>(G4T), g41 = accop<1>(G4T);
                      f32x16 Ya = mm32(g30, ua0, zero16); Ya = mm32(g31, ua1, Ya); Ya = mm32(g40, v00, Ya); Ya = mm32(g41, v01, Ya);
                      f32x16 Yb = mm32(g30, ub0, zero16); Yb = mm32(g31, ub1, Yb); Yb = mm32(g40, v10, Yb); Yb = mm32(g41, v11, Yb);
                      u32x4 o0, o1;
                      o0.x = cvtpk(Ya[0], Ya[1]); o0.y = cvtpk(Ya[2], Ya[3]); o0.z = cvtpk(Ya[4], Ya[5]); o0.w = cvtpk(Ya[6], Ya[7]);
                      o1.x = cvtpk(Ya[8], Ya[9]); o1.y = cvtpk(Ya[10], Ya[11]); o1.z = cvtpk(Ya[12], Ya[13]); o1.w = cvtpk(Ya[14], Ya[15]);
                      *(u32x4*)(rec + 12288 + 4096 + lane * 32) = o0; *(u32x4*)(rec + 12288 + 4096 + lane * 32 + 16) = o1;
                      o0.x = cvtpk(Yb[0], Yb[1]); o0.y = cvtpk(Yb[2], Yb[3]); o0.z = cvtpk(Yb[4], Yb[5]); o0.w = cvtpk(Yb[6], Yb[7]);
                      o1.x = cvtpk(Yb[8], Yb[9]); o1.y = cvtpk(Yb[10], Yb[11]); o1.z = cvtpk(Yb[12], Yb[13]); o1.w = cvtpk(Yb[14], Yb[15]);
                      *(u32x4*)(rec + 12288 + 6144 + 4096 + lane * 32) = o0; *(u32x4*)(rec + 12288 + 6144 + 4096 + lane * 32 + 16) = o1; }
                    f32x16 Wa0 = mm32(ty0, ldpermcol<0>(At, r32, hh), zero16); Wa0 = mm32(ty1, ldpermcol<1>(At, r32, hh), Wa0);
                    f32x16 Wa1 = mm32(ty0, ldpermcol<0>(At, 32 + r32, hh), zero16); Wa1 = mm32(ty1, ldpermcol<1>(At, 32 + r32, hh), Wa1);
                    const bf16x8_t wa00 = accop<0>(Wa0), wa01 = accop<1>(Wa0), wa10 = accop<0>(Wa1), wa11 = accop<1>(Wa1);
                    { const bf16x8_t g30 = accop<0>(G3T), g31 = accop<1>(G3T);
                      f32x16 Ra = mm32(wa00, g30, zero16); Ra = mm32(wa01, g31, Ra); f32x16 Rb_ = mm32(wa10, g30, zero16); Rb_ = mm32(wa11, g31, Rb_);
#pragma unroll
                      for (int e = 0; e < 16; ++e) { const int kr = rowidx(e, hh); Ra[e] += bf2f(Rt[r32 * 72 + kr]); Rb_[e] += bf2f(Rt[r32 * 72 + 32 + kr]); }
                      *(bf16x8_t*)(rec + 8192 + 0 * 1024 + lane * 16) = accop<0>(Ra); *(bf16x8_t*)(rec + 8192 + 1 * 1024 + lane * 16) = accop<1>(Ra);
                      *(bf16x8_t*)(rec + 8192 + 2 * 1024 + lane * 16) = accop<0>(Rb_); *(bf16x8_t*)(rec + 8192 + 3 * 1024 + lane * 16) = accop<1>(Rb_); }
                    const bf16x8_t b00 = ldpermcol<0>(Bt, r32, hh), b01 = ldpermcol<1>(Bt, r32, hh), b10 = ldpermcol<0>(Bt, 32 + r32, hh), b11 = ldpermcol<1>(Bt, 32 + r32, hh);
                    { const float pc0 = PCs[r32], pc1 = PCs[32 + r32];
#pragma unroll
                      for (int ij = 0; ij < 4; ++ij) { const int i = ij >> 1, j = ij & 1;
                          f32x16 M = mm32(i ? wa10 : wa00, j ? b10 : b00, zero16); M = mm32(i ? wa11 : wa01, j ? b11 : b01, M);
#pragma unroll
                          for (int e = 0; e < 16; ++e) { float m = M[e]; if (i == j) m += (rowidx(e, hh) == r32) ? 1.f : 0.f; M[e] = m * (j ? pc1 : pc0); }
                          *(bf16x8_t*)(rec + (ij * 2 + 0) * 1024 + lane * 16) = accop<0>(M); *(bf16x8_t*)(rec + (ij * 2 + 1) * 1024 + lane * 16) = accop<1>(M); } }
                    { const bf16x8_t k00 = ldpermcol<0>(Kt, r32, hh), k01 = ldpermcol<1>(Kt, r32, hh), k10 = ldpermcol<0>(Kt, 32 + r32, hh), k11 = ldpermcol<1>(Kt, 32 + r32, hh);
#pragma unroll
                      for (int ju = 0; ju < 4; ++ju) { const int j = ju >> 1, u = ju & 1;
                          f32x16 Dm = mm32(j ? b10 : b00, u ? ub0 : ua0, zero16); Dm = mm32(j ? b11 : b01, u ? ub1 : ua1, Dm);
                          Dm = mm32(j ? k10 : k00, u ? v10 : v00, Dm); Dm = mm32(j ? k11 : k01, u ? v11 : v01, Dm);
#pragma unroll
                          for (int e = 0; e < 16; ++e) Dm[e] *= PCs[32 * j + rowidx(e, hh)];
                          u32x4 o0, o1;
                          o0.x = cvtpk(Dm[0], Dm[1]); o0.y = cvtpk(Dm[2], Dm[3]); o0.z = cvtpk(Dm[4], Dm[5]); o0.w = cvtpk(Dm[6], Dm[7]);
                          o1.x = cvtpk(Dm[8], Dm[9]); o1.y = cvtpk(Dm[10], Dm[11]); o1.z = cvtpk(Dm[12], Dm[13]); o1.w = cvtpk(Dm[14], Dm[15]);
                          *(u32x4*)(rec + 12288 + u * 6144 + j * 2048 + lane * 32) = o0; *(u32x4*)(rec + 12288 + u * 6144 + j * 2048 + lane * 32 + 16) = o1; } }
                }
            }
        }
        { XcdBarrier xb_ = xbar; asm volatile("" : "+s"(xb_.bar)); xcd_barrier<false>(xb_); }
        if (IN(pb + 3)) { PHASE_IDS
            const int r32 = lane & 31, hh = lane >> 5;
            constexpr int SLOT = 18432, NCH = SEQ / 32, NSL = 7, AHEAD = 5;
            const bool spare = G > BATCH * NH * 2; const int cw = spare ? bx - BATCH * NH * 2 : bx, cn = spare ? G - BATCH * NH * 2 : G;
            if (cw >= 0) {
                for (int i = cw * NTHR + tid; i < BATCH * D; i += cn * NTHR) { const int b = i / D, d = i % D; S2V[(size_t)l * BATCH * D + i] = INP(24)[l * D + d] * (1.f + modl[(size_t)b * 6 * D + 4 * D + d]); }
                for (int n = cw * NWAVES + wave; n < PH * PQ; n += cn * NWAVES) {
                    const bf16* wr_ = PqT + (size_t)l * PH * PQ * D + (size_t)n * D + lane * 16; const u32x4 w0 = *(const u32x4*)wr_, w1 = *(const u32x4*)(wr_ + 8);
                    const unsigned ww[8] = {w0.x, w0.y, w0.z, w0.w, w1.x, w1.y, w1.z, w1.w};
#pragma unroll
                    for (int b = 0; b < BATCH; ++b) { const float* sh = modl + (size_t)b * 6 * D + 3 * D + lane * 16; float a = 0.f;
#pragma unroll
                        for (int q = 0; q < 4; ++q) { const f32x4 sv_ = *(const f32x4*)(sh + q * 4);
                            a += sv_.x * __uint_as_float(ww[2 * q] << 16) + sv_.y * __uint_as_float(ww[2 * q] & 0xffff0000u) + sv_.z * __uint_as_float(ww[2 * q + 1] << 16) + sv_.w * __uint_as_float(ww[2 * q + 1] & 0xffff0000u); }
                        a = wave_sum(a, lane); if (lane == 0) CVEC[(size_t)l * BATCH * PH * PQ + (size_t)b * PH * PQ + n] = a; } }
                convert_tables_fp6(INP(27), INP(28), U8, V8, USc, VSc, l, cw * NWAVES + wave, cn * NWAVES, lane, CONV_S1_ROWS, 2 * NEXP);
            {
                constexpr int DST = 520;
                int lane_p; asm volatile("v_mbcnt_lo_u32_b32 %0, -1, 0\n\tv_mbcnt_hi_u32_b32 %0, -1, %0" : "=v"(lane_p)); const int r32 = lane_p & 31, hh = lane_p >> 5, tidp = wave0 * 64 + lane_p;
                lbf16* dlb = (lbf16*)lds;
                lbf16* pin = (lbf16*)(lds + 33280);
                const int c = tidp, g = c >> 7, win = 2 << g;
                const bf16* pwt = PWT + (size_t)(l * 4 + (wave >> 1)) * PG * PG; const float* psc = INP(22) + l * PW;
                for (int tile = cw; tile < T / 32; tile += cn) {
                    const int t0 = tile * 32; const bool first = (t0 % SEQ) == 0;
                    __syncthreads();
                    { u32x4 pq[6];
#pragma unroll
                      for (int q = 0; q < 6; ++q) { const int ch = tidp + q * NTHR, row = ch >> 6, cc = ch & 63; pq[q] = (u32x4){0u, 0u, 0u, 0u};
                          if (ch < 47 * 64 && (row >= 15 || !first)) pq[q] = *(const u32x4*)(POOLIN + (size_t)(t0 - 15 + row) * PW + cc * 8); }
#pragma unroll
                      for (int q = 0; q < 6; ++q) { const int ch = tidp + q * NTHR, row = ch >> 6, cc = ch & 63; if (ch < 47 * 64) *(__attribute__((address_space(3))) u32x4*)(pin + row * 520 + cc * 8) = pq[q]; } }
                    __syncthreads();
                    const lbf16* pc = pin + c;
                    float sw = 0.f;
#pragma unroll
                    for (int j = 1; j <= 15; ++j) sw += (j < win) ? bf2f(pc[(15 - j) * 520]) : 0.f;
                    const float invw = 1.f / (float)win;
#pragma unroll 8
                    for (int i = 0; i < 32; ++i) {
                        const float cur = bf2f(pc[(15 + i) * 520]);
                        sw += cur;
                        const float inv = (first && i < 15) ? 1.f / (float)min(i + 1, win) : invw;
                        dlb[i * DST + c] = f2bf(sw * inv - cur);
                        sw -= bf2f(pc[(15 + i - win + 1) * 520]);
                    }
                    __syncthreads();
                    const int gg = wave >> 1, half = wave & 1;
#pragma unroll
                    for (int ct = 0; ct < 2; ++ct) {
                        const int dd0 = half * 64 + ct * 32;
                        f32x16 acc;
#pragma unroll
                        for (int e = 0; e < 16; ++e) acc[e] = 0.f;
#pragma unroll
                        for (int ks = 0; ks < 8; ++ks) { const bf16x8_t a = *(const __attribute__((address_space(3))) bf16x8_t*)(dlb + r32 * DST + gg * PG + ks * 16 + 8 * hh);
                            const bf16x8_t w = *(const bf16x8_t*)(pwt + (size_t)(dd0 + r32) * PG + ks * 16 + 8 * hh); acc = mm32(a, w, acc); }
                        const int oc = gg * PG + dd0 + r32; const float ps = psc[oc];
#pragma unroll
                        for (int e = 0; e < 16; ++e) MIX[(size_t)(t0 + rowidx(e, hh)) * D + RW + oc] = f2bf(acc[e] * ps);
                    }
                }
            }
            }
            for (int un = bx; un < BATCH * NH * 2; un += G) {
                const int bh = un >> 1, u = un & 1, b = bh >> 3, h = bh & 7;
                __syncthreads();
                const unsigned char* recs = SCN + (size_t)bh * NCH * 24576;
                const int lw = wave - 2;
#define S2_DMA(chunk_) do { if (wave >= 2) { LAS unsigned char* sl = lds + ((chunk_) % NSL) * SLOT; const unsigned char* rp = recs + (size_t)(chunk_) * 24576 + lane * 16; \
                    _Pragma("unroll") for (int q_ = 0; q_ < 3; ++q_) { const int p_ = lw * 3 + q_; const int so_ = p_ < 12 ? p_ * 1024 : 12288 + u * 6144 + (p_ - 12) * 1024; \
                        __builtin_amdgcn_global_load_lds((const unsigned*)(rp + so_), (LAS unsigned*)(sl + p_ * 1024), 16, 0, 0); } } } while (0)
#pragma unroll 1
                for (int c0 = 0; c0 < AHEAD; ++c0) S2_DMA(c0);
                asm volatile("s_waitcnt vmcnt(12)" ::: "memory");
                __builtin_amdgcn_s_barrier();
                f32x16 X0, X1;
                { float z_ = 0.f; asm volatile("" : "+v"(z_));
#pragma unroll
                for (int e = 0; e < 16; ++e) { X0[e] = z_; X1[e] = z_; } }
#define S2_FRAG(off) (*(const __attribute__((address_space(3))) bf16x8_t*)(sl + (off) + lane * 16))
#define S2_UNPK(dst, off) do { const u32x4 a0 = *(const LAS u32x4*)(sl + (off) + lane * 32), a1 = *(const LAS u32x4*)(sl + (off) + lane * 32 + 16); const unsigned wv[8] = {a0.x, a0.y, a0.z, a0.w, a1.x, a1.y, a1.z, a1.w}; \
                    _Pragma("unroll") for (int q = 0; q < 8; ++q) { (dst)[2 * q] = __uint_as_float(wv[q] << 16); (dst)[2 * q + 1] = __uint_as_float(wv[q] & 0xffff0000u); } } while (0)
                LAS unsigned char* xbuf = lds + NSL * SLOT;
#define S2_YOUT(nn_) do { const LAS unsigned char* sl = lds + ((nn_) % NSL) * SLOT; const LAS unsigned char* xb_ = xbuf + ((nn_) & 1) * 4096 + lane * 16; \
                        const bf16x8_t x00 = *(const LAS bf16x8_t*)(xb_), x01 = *(const LAS bf16x8_t*)(xb_ + 1024), x10 = *(const LAS bf16x8_t*)(xb_ + 2048), x11 = *(const LAS bf16x8_t*)(xb_ + 3072); \
                        f32x16 Yc; S2_UNPK(Yc, 12288 + 4096); \
                        Yc = mm32(S2_FRAG(8192 + 0 * 1024), x00, Yc); Yc = mm32(S2_FRAG(8192 + 1 * 1024), x01, Yc); Yc = mm32(S2_FRAG(8192 + 2 * 1024), x10, Yc); Yc = mm32(S2_FRAG(8192 + 3 * 1024), x11, Yc); \
                        float* yp = Y + ((size_t)b * SEQ + (size_t)(nn_) * 32) * RW + h * HS + u * 32 + r32; \
                        _Pragma("unroll") for (int e = 0; e < 16; ++e) yp[(size_t)rowidx(e, hh) * RW] = Yc[e]; } while (0)
#pragma unroll 1
                for (int n = 0; n < NCH; ++n) {
                    if (n + AHEAD < NCH) S2_DMA(n + AHEAD);
                    if (wave == 0) {
                        const LAS unsigned char* sl = lds + (n % NSL) * SLOT;
                        const bf16x8_t x00 = accop<0>(X0), x01 = accop<1>(X0), x10 = accop<0>(X1), x11 = accop<1>(X1);
                        { LAS unsigned char* xb_ = xbuf + (n & 1) * 4096 + lane * 16; *(LAS bf16x8_t*)(xb_) = x00; *(LAS bf16x8_t*)(xb_ + 1024) = x01; *(LAS bf16x8_t*)(xb_ + 2048) = x10; *(LAS bf16x8_t*)(xb_ + 3072) = x11; }
                        f32x16 N0, N1;
                        S2_UNPK(N0, 12288); S2_UNPK(N1, 12288 + 2048);
                        N0 = mm32(S2_FRAG((0 * 2 + 0) * 1024), x00, N0); N1 = mm32(S2_FRAG((1 * 2 + 0) * 1024), x00, N1); N0 = mm32(S2_FRAG((0 * 2 + 1) * 1024), x01, N0); N1 = mm32(S2_FRAG((1 * 2 + 1) * 1024), x01, N1);
                        N0 = mm32(S2_FRAG((2 * 2 + 0) * 1024), x10, N0); N1 = mm32(S2_FRAG((3 * 2 + 0) * 1024), x10, N1); N0 = mm32(S2_FRAG((2 * 2 + 1) * 1024), x11, N0); N1 = mm32(S2_FRAG((3 * 2 + 1) * 1024), x11, N1);
                        X0 = N0; X1 = N1;
                        asm volatile("s_waitcnt lgkmcnt(0)" ::: "memory");
                    } else if (wave == 1) {
                        if (n > 0) S2_YOUT(n - 1);
                        asm volatile("s_waitcnt lgkmcnt(0)" ::: "memory");
                    } else {
                        const int younger = (NCH - 1 - (n + 1)) < (AHEAD - 1) ? (NCH - 1 - (n + 1)) : (AHEAD - 1);
                        if (younger >= 5) asm volatile("s_waitcnt vmcnt(15)" ::: "memory"); else if (younger == 4) asm volatile("s_waitcnt vmcnt(12)" ::: "memory"); else if (younger == 3) asm volatile("s_waitcnt vmcnt(9)" ::: "memory");
                        else if (younger == 2) asm volatile("s_waitcnt vmcnt(6)" ::: "memory"); else if (younger == 1) asm volatile("s_waitcnt vmcnt(3)" ::: "memory"); else asm volatile("s_waitcnt vmcnt(0)" ::: "memory");
                    }
                    __builtin_amdgcn_s_barrier();
                }
                if (wave == 1) { S2_YOUT(NCH - 1); asm volatile("s_waitcnt lgkmcnt(0)" ::: "memory"); }
#undef S2_YOUT
#undef S2_FRAG
#undef S2_UNPK
#undef S2_DMA
            }
        }
        SEAM(pb + 3);

        if (IN(pb + 4)) { PHASE_IDS
            const int c8 = (tid & 63) * 8, hd = (tid & 63) >> 3, tsub = tid >> 6;
            const f32x4 lg0 = *(const f32x4*)(INP(19) + l * RW + c8), lg1 = *(const f32x4*)(INP(19) + l * RW + c8 + 4), lb0 = *(const f32x4*)(INP(20) + l * RW + c8), lb1 = *(const f32x4*)(INP(20) + l * RW + c8 + 4);
            for (int tile = bx; tile < T / 8; tile += G) {
                const int t = tile * 8 + tsub; const size_t o = (size_t)t * RW + c8;
                const f32x4 y0 = *(const f32x4*)(Y + o), y1 = *(const f32x4*)(Y + o + 4); const u32x4 gq = *(const u32x4*)(Gb + o), vq = *(const u32x4*)(BGb + o); const float bsum = BSUM[(size_t)t * NH + hd];
                float sm = (y0.x + y0.y) + (y0.z + y0.w) + (y1.x + y1.y) + (y1.z + y1.w);
                sm += dppf<0xB1>(sm); sm += dppf<0x4E>(sm); sm += dppf<0x141>(sm);
                const float mean = sm * (1.f / 64.f);
                const f32x4 d0 = y0 - mean, d1 = y1 - mean;
                float sq = (d0.x * d0.x + d0.y * d0.y) + (d0.z * d0.z + d0.w * d0.w) + (d1.x * d1.x + d1.y * d1.y) + (d1.z * d1.z + d1.w * d1.w);
                sq += dppf<0xB1>(sq); sq += dppf<0x4E>(sq); sq += dppf<0x141>(sq);
                const float rs = rsqrtf(sq * (1.f / 64.f) + GN_EPS);
                const f32x4 n0 = d0 * rs * lg0 + lb0, n1 = d1 * rs * lg1 + lb1;
                const unsigned gw_[4] = {gq.x, gq.y, gq.z, gq.w}, vw_[4] = {vq.x, vq.y, vq.z, vq.w}; const float nn[8] = {n0.x, n0.y, n0.z, n0.w, n1.x, n1.y, n1.z, n1.w}; unsigned ow[4];
#pragma unroll
                for (int i = 0; i < 4; ++i) { const float g0 = __uint_as_float(gw_[i] << 16), g1 = __uint_as_float(gw_[i] & 0xffff0000u), v0 = __uint_as_float(vw_[i] << 16), v1 = __uint_as_float(vw_[i] & 0xffff0000u);
                    ow[i] = pk2(nn[2 * i] * g0 + v0 * bsum, nn[2 * i + 1] * g1 + v1 * bsum); }
                *(u32x4*)(MIX + (size_t)t * D + c8) = (u32x4){ow[0], ow[1], ow[2], ow[3]};
            }
        }
        SEAM(pb + 4);
        if (IN(pb + 5)) { PHASE_IDS
            pg8::Gemm g{MIX, WoutT + (size_t)l * D * D, T, D, D}; pg8::StaticOrder S; S.init(T, D, G, bx);
            pg8::EpiResGate E{xin, X, modl + 2 * D, XB2, S2V + (size_t)l * BATCH * D, SSQ + (size_t)l * T};
            pg8::gemm_phase<pg8::EpiResGate, pg8::StaticOrder, true, true>(lds, g, S, E, tid); }
        SEAM(pb + 5);
        if (IN(pb + 7)) { PHASE_IDS
            pg8::Gemm g{XB2, PqT + (size_t)l * PH * PQ * D, T, PH * PQ, D}; pg8::StaticOrder S; S.init(T, PH * PQ, G, bx);
            pg8::EpiQ E{Q, PH * PQ, CVEC + (size_t)l * BATCH * PH * PQ, SSQ + (size_t)l * T};
            pg8::gemm_phase<pg8::EpiQ, pg8::StaticOrder, true, true>(lds, g, S, E, tid); }
        if (IN(pb + 7) && IN(pb + 8)) { asm volatile("s_waitcnt vmcnt(0)" ::: "memory"); __syncthreads(); }

        if (IN(pb + 8)) { PHASE_IDS
            const bf16* KEYSl = KEYS + (size_t)l * PH * 2 * NKEYS * PHALF;
            LAS unsigned char* scr = lds + wave * 2048 + lane * 32;
            constexpr int KST = 136;
            lbf16* kl = (lbf16*)(lds + 16384);
            const int r = lane & 31, hh = lane >> 5;
            pg8::StaticOrder S; S.init(T, PH * PQ, G, bx);
            for (int ui = 0;; ++ui) { pg8::Unit un_; if (!S.next(ui, un_)) break;
                const int h = un_.pn, tok = un_.pm * 256 + wave * 32 + r;
                __syncthreads();
                { u32x4 kq[8];
#pragma unroll
                  for (int q = 0; q < 8; ++q) { const int ch = tid + q * NTHR; kq[q] = *(const u32x4*)(KEYSl + (size_t)(h * 2) * NKEYS * PHALF + (size_t)ch * 8); }
#pragma unroll
                  for (int q = 0; q < 8; ++q) { const int ch = tid + q * NTHR, row = ch >> 4, cc = ch & 15; *(__attribute__((address_space(3))) u32x4*)(kl + row * KST + cc * 8) = kq[q]; } }
                __syncthreads();
                unsigned sp0[16], sp1[16];
#pragma unroll
                for (int e = 0; e < 16; ++e) { sp0[e] = 0u; sp1[e] = 0u; }
#pragma unroll 1
                for (int p = 0; p < 2; ++p) {
                    const bf16* qp = Q + (size_t)tok * (PH * PQ) + h * PQ + p * PHALF + 8 * hh;
                    const lbf16* kp_ = kl + (p * NKEYS + r) * KST + 8 * hh;
                    bf16x8_t bq[8];
#pragma unroll
                    for (int ks = 0; ks < 8; ++ks) bq[ks] = *(const bf16x8_t*)(qp + ks * 16);
                    unsigned best[16];
#pragma unroll
                    for (int e = 0; e < 16; ++e) best[e] = 0u;
#pragma unroll 1
                    for (int kt = 0; kt < 4; ++kt) {
                        f32x16 acc;
#pragma unroll
                        for (int e = 0; e < 16; ++e) acc[e] = 0.f;
#pragma unroll
                        for (int ks = 0; ks < 8; ++ks) { const bf16x8_t ak = *(const __attribute__((address_space(3))) bf16x8_t*)(kp_ + kt * 32 * KST + ks * 16); acc = __builtin_amdgcn_mfma_f32_32x32x16_bf16(ak, bq[ks], acc, 0, 0, 0); }
                        unsigned g[16];
#pragma unroll
                        for (int e = 0; e < 16; ++e) g[e] = pack_key7(acc[e], kt * 32 + (e & 3) + 8 * (e >> 2) + 4 * hh);
                        sort16_desc(g);
                        merge_top16(best, g);
                    }
                    unsigned ob[16];
#pragma unroll
                    for (int e = 0; e < 16; ++e) ob[e] = shflxu(best[e], lane, 32);
                    merge_top16(best, ob);
#pragma unroll
                    for (int e = 0; e < 16; ++e) { sp0[e] = p == 0 ? best[e] : sp0[e]; sp1[e] = p == 0 ? sp1[e] : best[e]; }
                }
                unsigned c2[32];
                stage2_cands(sp0, sp1, hh, c2);
                sort16_desc(c2); sort16_desc(c2 + 16); merge_top16(c2, c2 + 16);
                { unsigned ob[16];
#pragma unroll
                  for (int e = 0; e < 16; ++e) ob[e] = shflxu(c2[e], lane, 32);
                  merge_top16(c2, ob); }
#pragma unroll
                for (int e = 0; e < 16; e += 4) {
                    *(LAS unsigned*)(scr + e) = (127u - (sp0[e] & 127u)) | ((127u - (sp0[e + 1] & 127u)) << 8) | ((127u - (sp0[e + 2] & 127u)) << 16) | ((127u - (sp0[e + 3] & 127u)) << 24);
                    *(LAS unsigned*)(scr + 16 + e) = (127u - (sp1[e] & 127u)) | ((127u - (sp1[e + 1] & 127u)) << 8) | ((127u - (sp1[e + 2] & 127u)) << 16) | ((127u - (sp1[e + 3] & 127u)) << 24); }
                asm volatile("s_waitcnt lgkmcnt(0)" ::: "memory");
                float sm[16]; int ex[16];
#pragma unroll
                for (int e = 0; e < 16; ++e) { const unsigned key = c2[e]; sm[e] = unpack_key8(key); const int i0 = (key >> 4) & 15, j0 = key & 15; ex[e] = (int)scr[i0] * NKEYS + (int)scr[16 + j0]; }
                float den = 0.f;
#pragma unroll
                for (int e = 0; e < 16; ++e) { sm[e] = expf(sm[e] - unpack_key8(c2[0])); den += sm[e]; }
                const float inv = 1.f / den;
                if (hh == 0) {
                    int* ip = IDX + (size_t)tok * NE + h * TOPK; float* gp = GATE + (size_t)tok * NE + h * TOPK;
#pragma unroll
                    for (int e = 0; e < 16; e += 4) { *(int4*)(ip + e) = make_int4(ex[e], ex[e + 1], ex[e + 2], ex[e + 3]); *(f32x4*)(gp + e) = (f32x4){sm[e] * inv, sm[e + 1] * inv, sm[e + 2] * inv, sm[e + 3] * inv}; }
                }
                asm volatile("s_waitcnt lgkmcnt(0)" ::: "memory");
            }
        }
        SEAM(pb + 8);

        if (IN(pb + 9)) { PHASE_IDS
            const unsigned char* Ul = U8 + (size_t)l * NEXP * ROWB; const unsigned char* Vtl = V8 + (size_t)l * NEXP * ROWB; const float* usl = USc + l * NEXP; const float* vsl = VSc + l * NEXP; const float* lnf = INP(29);
            const bool fin = (l == DEPTH - 1);
            typedef float f32x2_t __attribute__((ext_vector_type(2)));
            const __amdgpu_buffer_rsrc_t ru = __builtin_amdgcn_make_buffer_rsrc((void*)Ul, 0, NEXP * ROWB, 0x00020000), rv = __builtin_amdgcn_make_buffer_rsrc((void*)Vtl, 0, NEXP * ROWB, 0x00020000);
            typedef float f32x32_t __attribute__((ext_vector_type(32))); typedef unsigned u32x3_t __attribute__((ext_vector_type(3))); typedef unsigned u32x6_t __attribute__((ext_vector_type(6))); typedef unsigned u32x16_t __attribute__((ext_vector_type(16))); typedef __bf16 bf16x2_t __attribute__((ext_vector_type(2)));
            LAS float* pl = (LAS float*)(lds + wave * 18432);
            constexpr int TW = 4;
            for (int tb = gw; tb < T; tb += TW * NGW) {
#define TOKV(k) (tb + (k) * NGW < T)
#define TOK(k) (TOKV(k) ? tb + (k) * NGW : tb)
                unsigned si[TW][2]; float sus[TW][2], sgv[TW][2];
                LAS u32x4* hl = (LAS u32x4*)(pl + 32 * 68);
                { float g0[TW], g1[TW]; int lane_s; asm volatile("v_mbcnt_lo_u32_b32 %0, -1, 0\n\tv_mbcnt_hi_u32_b32 %0, -1, %0" : "=v"(lane_s));
#pragma unroll
                  for (int k = 0; k < TW; ++k) { const size_t o = (size_t)TOK(k) * NE + lane_s; si[k][0] = ((unsigned)IDX[o] << 7) | (unsigned)lane_s; si[k][1] = ((unsigned)IDX[o + 64] << 7) | (unsigned)(64 + lane_s); g0[k] = GATE[o]; g1[k] = GATE[o + 64]; }
#pragma unroll
                  for (int kk = 2; kk <= 128; kk <<= 1) {
#pragma unroll
                      for (int j = kk >> 1; j > 0; j >>= 1) {
                          if (j == 64) {
#pragma unroll
                              for (int k = 0; k < TW; ++k) { const unsigned a = si[k][0], b = si[k][1]; si[k][0] = a < b ? a : b; si[k][1] = a < b ? b : a; } }
                          else { const bool lower = (lane_s & j) == 0, tm0 = lower == ((lane_s & kk) == 0), tm1 = lower == (((lane_s + 64) & kk) == 0); const int pa = (lane_s ^ j) << 2;
#pragma unroll
                              for (int k = 0; k < TW; ++k) { const unsigned a = si[k][0], b = si[k][1], p0 = (unsigned)__builtin_amdgcn_ds_bpermute(pa, (int)a), p1 = (unsigned)__builtin_amdgcn_ds_bpermute(pa, (int)b);
                                  si[k][0] = tm0 ? (a < p0 ? a : p0) : (a < p0 ? p0 : a); si[k][1] = tm1 ? (b < p1 ? b : p1) : (b < p1 ? p1 : b); } }
                          __builtin_amdgcn_sched_barrier(0);
                      } }
#pragma unroll
                  for (int k = 0; k < TW; ++k) {
#pragma unroll
                      for (int r = 0; r < 2; ++r) { const unsigned key = si[k][r]; const int a = (int)(key & 63u) << 2; const int ga = __builtin_amdgcn_ds_bpermute(a, __float_as_int(g0[k])), gb = __builtin_amdgcn_ds_bpermute(a, __float_as_int(g1[k]));
                          const unsigned ix = key >> 7; si[k][r] = ix; sus[k][r] = usl[ix]; sgv[k][r] = __int_as_float((key & 64u) ? gb : ga) * vsl[ix]; } }
#pragma unroll
                  for (int k = 0; k < TW; ++k) {
                      const int t_ = TOK(k); const bf16* hr = XB2 + (size_t)t_ * D + lane_s * 4; const uint2 a0 = *(const uint2*)hr, a1 = *(const uint2*)(hr + 256), a2 = *(const uint2*)(hr + 512), a3 = *(const uint2*)(hr + 768);
                      const float rs_ = rsqrtf((float)SSQ[(size_t)l * T + t_] * (1.f / (1048576.f * D)) + NORM_EPS); const float* shp = modl + (size_t)(t_ / SEQ) * 6 * D + 3 * D + lane_s * 4;
                      const unsigned aw[8] = {a0.x, a0.y, a1.x, a1.y, a2.x, a2.y, a3.x, a3.y}; unsigned ow[8];
#pragma unroll
                      for (int q = 0; q < 4; ++q) { const f32x4 s4 = *(const f32x4*)(shp + q * 256);
                          ow[2 * q] = pk2(__uint_as_float(aw[2 * q] << 16) * rs_ + s4.x, __uint_as_float(aw[2 * q] & 0xffff0000u) * rs_ + s4.y);
                          ow[2 * q + 1] = pk2(__uint_as_float(aw[2 * q + 1] << 16) * rs_ + s4.z, __uint_as_float(aw[2 * q + 1] & 0xffff0000u) * rs_ + s4.w); }
                      hl[(k * 2) * 64 + lane_s] = (u32x4){ow[0], ow[1], ow[2], ow[3]}; hl[(k * 2 + 1) * 64 + lane_s] = (u32x4){ow[4], ow[5], ow[6], ow[7]}; }
                }
                __builtin_amdgcn_sched_barrier(0);
#define ROWLD(dst, rs, ixv, ln) dst = __builtin_amdgcn_raw_buffer_load_b96(rs, voff, __builtin_amdgcn_readlane((int)(ixv), (ln)) * ROWB, 0)
#define LOADQ(buf, rs, ixv, ln0) do { _Pragma("unroll") for (int j_ = 0; j_ < 8; ++j_) ROWLD((buf)[j_], rs, ixv, (ln0) + j_); __builtin_amdgcn_sched_barrier(0); } while (0)
#define CVT2(a, b) const f32x32_t f_ = __builtin_amdgcn_cvt_scalef32_pk32_f32_fp6((u32x6_t){(a).x, (a).y, (a).z, (b).x, (b).y, (b).z}, 1.0f)
#define PR(i) __builtin_shufflevector(f_, f_, 2 * (i), 2 * (i) + 1)
#define DOTQ(buf, e0) do { _Pragma("unroll") for (int j_ = 0; j_ < 8; j_ += 2) { \
                        const u32x16_t g_ = __builtin_bit_cast(u32x16_t, __builtin_amdgcn_cvt_scalef32_pk32_bf16_fp6((u32x6_t){(buf)[j_].x, (buf)[j_].y, (buf)[j_].z, (buf)[j_ + 1].x, (buf)[j_ + 1].y, (buf)[j_ + 1].z}, 1.0f));     \
                        float a0_ = 0.f, a1_ = 0.f, b0_ = 0.f, b1_ = 0.f; \
                        _Pragma("unroll") for (int i_ = 0; i_ < 8; i_ += 2) { a0_ = DOT2(g_[i_], hpk[i_], a0_); b0_ = DOT2(g_[8 + i_], hpk[i_], b0_); a1_ = DOT2(g_[i_ + 1], hpk[i_ + 1], a1_); b1_ = DOT2(g_[9 + i_], hpk[i_ + 1], b1_); } \
                        pl[((e0) + j_) * 68 + lane_u] = a0_ + a1_; pl[((e0) + j_ + 1) * 68 + lane_u] = b0_ + b1_; __builtin_amdgcn_sched_barrier(0); } } while (0)
#define DOT2(x_, y_, c_) __builtin_amdgcn_fdot2_f32_bf16(__builtin_bit_cast(bf16x2_t, (unsigned)(x_)), __builtin_bit_cast(bf16x2_t, (unsigned)(y_)), (c_), false)
#define AXPYQ(buf, k, cfv, ln0) do { _Pragma("unroll") for (int j_ = 0; j_ < 8; j_ += 2) { CVT2((buf)[j_], (buf)[j_ + 1]); \
                        const float ca = __int_as_float(__builtin_amdgcn_readlane(__float_as_int(cfv), (ln0) + j_)), cb = __int_as_float(__builtin_amdgcn_readlane(__float_as_int(cfv), (ln0) + j_ + 1)); \
                        acc2[k][0] += ca * PR(0); acc2[k][1] += ca * PR(1); acc2[k][2] += ca * PR(2); acc2[k][3] += ca * PR(3); acc2[k][4] += ca * PR(4); acc2[k][5] += ca * PR(5); acc2[k][6] += ca * PR(6); acc2[k][7] += ca * PR(7); \
                        acc2[k][0] += cb * PR(8); acc2[k][1] += cb * PR(9); acc2[k][2] += cb * PR(10); acc2[k][3] += cb * PR(11); acc2[k][4] += cb * PR(12); acc2[k][5] += cb * PR(13); acc2[k][6] += cb * PR(14); acc2[k][7] += cb * PR(15); __builtin_amdgcn_sched_barrier(0); } } while (0)
                u32x3_t ba[8], bb_[8];
                int lane_u; asm volatile("v_mbcnt_lo_u32_b32 %0, -1, 0\n\tv_mbcnt_hi_u32_b32 %0, -1, %0" : "=v"(lane_u)); const int voff = lane_u * 12;
                LOADQ(ba, ru, si[0][0], 0);
#pragma unroll 1
                for (int c = 0; c < 16; ++c) {
                    const int lb = (c & 7) * 8; const bool r1 = c >= 8;
#pragma unroll
                    for (int k = 0; k < TW; ++k) {
                        unsigned hpk[8];
                        { const u32x4 h0 = hl[(k * 2) * 64 + lane_u], h1 = hl[(k * 2 + 1) * 64 + lane_u]; hpk[0] = h0.x; hpk[1] = h0.y; hpk[2] = h0.z; hpk[3] = h0.w; hpk[4] = h1.x; hpk[5] = h1.y; hpk[6] = h1.z; hpk[7] = h1.w; }
                        if (k & 1) { if (k < TW - 1) LOADQ(ba, ru, r1 ? si[k + 1][1] : si[k + 1][0], lb); else { const int cn = (c + 1) & 15; const __amdgpu_buffer_rsrc_t rn = c < 15 ? ru : rv; LOADQ(ba, rn, (cn >= 8) ? si[0][1] : si[0][0], (cn & 7) * 8); } DOTQ(bb_, k * 8); }
                        else { LOADQ(bb_, ru, r1 ? si[k + 1][1] : si[k + 1][0], lb); DOTQ(ba, k * 8); }
                    }
                    __builtin_amdgcn_wave_barrier(); asm volatile("s_waitcnt lgkmcnt(0)" ::: "memory");
                    float dsum;
                    { const LAS float* rp = pl + (lane_u & 31) * 68 + (lane_u >> 5) * 32; f32x4 s4 = *(const LAS f32x4*)rp;
#pragma unroll
                      for (int j = 1; j < 8; ++j) s4 += *(const LAS f32x4*)(rp + j * 4);
                      dsum = (s4.x + s4.y) + (s4.z + s4.w); }
                    dsum += shflx(dsum, lane_u, 32);
                    __builtin_amdgcn_wave_barrier(); asm volatile("s_waitcnt lgkmcnt(0)" ::: "memory");
                    const bool home = (lane_u >> 3) == (c & 7);
#pragma unroll
                    for (int k = 0; k < TW; ++k) {
                        const float dv = __int_as_float(__builtin_amdgcn_ds_bpermute((k * 8 + (lane_u & 7)) << 2, __float_as_int(dsum)));
                        const float cf = (r1 ? sgv[k][1] : sgv[k][0]) * gelu_erf(dv * (r1 ? sus[k][1] : sus[k][0]));
                        if (r1) sgv[k][1] = home ? cf : sgv[k][1]; else sgv[k][0] = home ? cf : sgv[k][0]; }
                    __builtin_amdgcn_sched_barrier(0);
                }
                f32x2_t acc2[TW][8];
#pragma unroll
                for (int k = 0; k < TW; ++k) {
#pragma unroll
                    for (int i = 0; i < 8; ++i) acc2[k][i] = (f32x2_t){0.f, 0.f}; }
#pragma unroll 1
                for (int c = 0; c < 16; ++c) {
                    const int lb = (c & 7) * 8; const bool r1 = c >= 8;
#pragma unroll
                    for (int k = 0; k < TW; ++k) {
                        const float cfk = r1 ? sgv[k][1] : sgv[k][0];
                        if (k & 1) { if (k < TW - 1) LOADQ(ba, rv, r1 ? si[k + 1][1] : si[k + 1][0], lb); else { const int cn = (c + 1) & 15; LOADQ(ba, rv, (cn >= 8) ? si[0][1] : si[0][0], (cn & 7) * 8); }     AXPYQ(bb_, k, cfk, lb); }
                        else { LOADQ(bb_, rv, r1 ? si[k + 1][1] : si[k + 1][0], lb); AXPYQ(ba, k, cfk, lb); }
                    }
                }
#undef ROWLD
#undef LOADQ
#undef CVT2
#undef PR
#undef DOTQ
#undef DOT2
#undef AXPYQ
                { int ln; asm volatile("v_mbcnt_lo_u32_b32 %0, -1, 0\n\tv_mbcnt_hi_u32_b32 %0, -1, %0" : "=v"(ln));
                  LAS f32x4* al = (LAS f32x4*)pl + ln;
#pragma unroll
                  for (int k = 0; k < TW; ++k) {
#pragma unroll
                      for (int q = 0; q < 4; ++q) al[(k * 4 + q) * 64] = (f32x4){acc2[k][q * 2].x, acc2[k][q * 2].y, acc2[k][q * 2 + 1].x, acc2[k][q * 2 + 1].y}; }
                  asm volatile("s_waitcnt lgkmcnt(0)" ::: "memory"); __builtin_amdgcn_sched_barrier(0);
                  f32x4 xv[TW][4], gq[TW][4]; float rs[TW];
#pragma unroll
                  for (int k = 0; k < TW; ++k) { const int t = TOK(k), b = t / SEQ; const float* xr = X + (size_t)t * D + ln * 4; const float* g2 = modl + (size_t)b * 6 * D + 5 * D + ln * 4;
#pragma unroll
                      for (int q = 0; q < 4; ++q) { xv[k][q] = *(const f32x4*)(xr + q * 256); gq[k][q] = *(const f32x4*)(g2 + q * 256); } }
                  f32x4 wl[4];
#pragma unroll
                  for (int q = 0; q < 4; ++q) wl[q] = *(const f32x4*)((fin ? lnf : INP(4) + (l + 1) * D) + ln * 4 + q * 256);
                  __builtin_amdgcn_sched_barrier(0);
#pragma unroll
                  for (int k = 0; k < TW; ++k) { float ss = 0.f;
#pragma unroll
                      for (int q = 0; q < 4; ++q) { xv[k][q] = xv[k][q] + gq[k][q] * al[(k * 4 + q) * 64]; ss += (xv[k][q].x * xv[k][q].x + xv[k][q].y * xv[k][q].y) + (xv[k][q].z * xv[k][q].z + xv[k][q].w * xv[k][q].w); }
                      rs[k] = rsqrtf(wave_sum(ss, ln) * (1.f / D) + NORM_EPS); }
                  __builtin_amdgcn_sched_barrier(0);
                  if (fin) {
#pragma unroll
                      for (int k = 0; k < TW; ++k) { if (TOKV(k)) { float* xr = X + (size_t)(tb + k * NGW) * D + ln * 4;
#pragma unroll
                          for (int q = 0; q < 4; ++q) *(f32x4*)(xr + q * 256) = xv[k][q] * rs[k] * wl[q]; } } }
                  else {
#pragma unroll
                      for (int k = 0; k < TW; ++k) { if (TOKV(k)) { float* xr = X + (size_t)(tb + k * NGW) * D + ln * 4;
#pragma unroll
                          for (int q = 0; q < 4; ++q) *(f32x4*)(xr + q * 256) = xv[k][q]; } }
#pragma unroll
                      for (int kp = 0; kp < TW; kp += 2) { f32x4 sc_[2][4], sh_[2][4];
#pragma unroll
                          for (int j = 0; j < 2; ++j) { const int b = TOK(kp + j) / SEQ; const float* mn = MOD + (size_t)(l + 1) * BATCH * 6 * D + (size_t)b * 6 * D + ln * 4;
#pragma unroll
                              for (int q = 0; q < 4; ++q) { sc_[j][q] = *(const f32x4*)(mn + D + q * 256); sh_[j][q] = *(const f32x4*)(mn + q * 256); } }
#pragma unroll
                          for (int j = 0; j < 2; ++j) { const int k = kp + j; if (TOKV(k)) { const int t = tb + k * NGW;
#pragma unroll
                              for (int q = 0; q < 4; ++q) { const f32x4 y = xv[k][q] * rs[k] * wl[q] * (sc_[j][q] + 1.f) + sh_[j][q];
                                  uint2 ho; ho.x = pk2(y.x, y.y); ho.y = pk2(y.z, y.w); *(uint2*)(H + (size_t)t * D + q * 256 + ln * 4) = ho; } } } } }
                  asm volatile("s_waitcnt lgkmcnt(0)" ::: "memory"); __builtin_amdgcn_wave_barrier();
                }
#undef TOK
#undef TOKV
            }
        }
    }
#undef modl
#undef xin
#undef IN
#undef SEAM
}
#undef MOD
#undef H
#undef PROJ
#undef Q
#undef MIX
#undef Rb
#undef Kb
#undef V0
#undef V1
#undef KKb
#undef Bb
#undef Gb
#undef BGb
#undef Wd
#undef Y
#undef IDX
#undef GATE
#undef WinT
#undef WoutT
#undef PqT
#undef KEYS
#undef QB
#undef POOLIN
#undef SH
#undef SSQ
#undef CVEC
#undef S2V
#undef XB2
#undef WUPT
#undef AUPT
#undef GUPT
#undef VUPT
#undef PWT
#undef INVN
#undef BSUM
#undef SCN
#undef U8
#undef V8
#undef USc
#undef VSc
#undef INP
#undef PHASE_IDS

extern "C" void kernel_launch(void* const* d_in, const int* in_sizes, int n_in, void* d_out, int out_size, void* d_ws, size_t ws_size, hipStream_t stream) {
    if (n_in != 30 || ws_size < WS_END) { fprintf(stderr, "kernel_launch: unexpected n_in %d / ws_size %zu\n", n_in, ws_size); return; }
    static int grid = 0;
    if (grid == 0) {
        int dev = 0, cus = 0, per_cu = 0;
        (void)hipGetDevice(&dev); (void)hipDeviceGetAttribute(&cus, hipDeviceAttributeMultiprocessorCount, dev);
        if (hipFuncSetAttribute((const void*)mega, hipFuncAttributeMaxDynamicSharedMemorySize, LDS_BYTES) != hipSuccess) { fprintf(stderr, "hipFuncSetAttribute failed\n"); grid = -1; return; }
        if (hipOccupancyMaxActiveBlocksPerMultiprocessor(&per_cu, (const void*)mega, NTHR, LDS_BYTES) != hipSuccess || per_cu < 1) { fprintf(stderr, "occupancy query failed (%d)\n", per_cu); per_cu = 1; }
        (void)hipGetLastError();
        grid = (cus > 0 ? cus : 256) * 1;
    }
    if (grid < 0) return;
    Args a{}; for (int i = 0; i < 30; ++i) a.in[i] = (const float*)d_in[i]; a.out = (float*)d_out; a.ws = (unsigned char*)d_ws;
    a.ph_lo = 0; a.ph_hi = NPH;
    if (hipMemsetAsync(d_ws, 0, 65536, stream) != hipSuccess) { fprintf(stderr, "memset failed\n"); return; }
    void* kargs[] = {&a};
    hipError_t e = hipLaunchCooperativeKernel((const void*)mega, dim3(grid), dim3(NTHR), kargs, LDS_BYTES, stream);
    if (e != hipSuccess) fprintf(stderr, "cooperative launch failed: %s (grid %d)\n", hipGetErrorString(e), grid);
}
```

```cpp
#include <hip/hip_runtime.h>
#include <hip/hip_cooperative_groups.h>
namespace cg = cooperative_groups;
#include <cstdio>
#include <cstdint>
#include <cmath>

constexpr int D = 1024, BATCH = 4, SEQ = 4096, T = BATCH * SEQ, DEPTH = 2;
constexpr int RW = 512, HS = 64, NH = 8;
constexpr int DL = 64, AL = 64, MVL = 32, GL = 128;
constexpr int RWKV_COLS = 3 * RW + DL + AL + GL;
constexpr int PW = 512, PG = 128;
constexpr int IN_COLS = RWKV_COLS + PW;
constexpr int LDP = 2560;
constexpr int NKEYS = 128, NEXP = NKEYS * NKEYS, PH = 8, PQ = 256, PHALF = 128, TOPK = 16;
constexpr int NE = PH * TOPK;
constexpr float NORM_EPS = 1e-6f, GN_EPS = 64e-5f;

typedef unsigned short bf16;
__device__ __forceinline__ float bf2f(bf16 u) { return __uint_as_float((unsigned)u << 16); }
typedef float cvt_f32x2 __attribute__((ext_vector_type(2))); typedef __bf16 cvt_bf16x2 __attribute__((ext_vector_type(2)));
__device__ __forceinline__ unsigned cvtpk(float lo, float hi) { const cvt_f32x2 v = {lo, hi}; const cvt_bf16x2 b = __builtin_convertvector(v, cvt_bf16x2); return __builtin_bit_cast(unsigned, b); }
__device__ __forceinline__ bf16 f2bf(float f) { return (bf16)cvtpk(f, 0.f); }

constexpr size_t MiB = 1u << 20;
constexpr size_t WS_MOD = 1 * MiB;
constexpr size_t WS_US = 1 * MiB + 256 * 1024;
constexpr size_t WS_VS = 1 * MiB + 512 * 1024;
constexpr size_t WS_H = 2 * MiB;
constexpr size_t WS_PROJ = 34 * MiB;
constexpr size_t WS_Q = WS_PROJ;
constexpr size_t WS_R = 114 * MiB;
constexpr size_t WS_K = 130 * MiB;
constexpr size_t WS_V0 = 146 * MiB;
constexpr size_t WS_V1 = 162 * MiB;
constexpr size_t WS_KK = 178 * MiB;
constexpr size_t WS_B = 194 * MiB;
constexpr size_t WS_G = 210 * MiB;
constexpr size_t WS_BG = 226 * MiB;
constexpr size_t WS_W = 242 * MiB;
constexpr size_t WS_Y = 274 * MiB;
constexpr size_t WS_MIX = 306 * MiB;
constexpr size_t WS_IDX = 338 * MiB;
constexpr size_t WS_GATE = 346 * MiB;
constexpr size_t WS_WIN_T = 354 * MiB;
constexpr size_t WS_WOUT_T = 364 * MiB;
constexpr size_t WS_PQ_T = 368 * MiB;
constexpr size_t WS_KEYS = 376 * MiB;
constexpr size_t WS_U = 378 * MiB;
constexpr size_t WS_V = 442 * MiB;
constexpr size_t WS_QB = 410 * MiB;
constexpr size_t WS_SH = 426 * MiB;
constexpr size_t WS_LORA = 428 * MiB;
constexpr size_t WS_INVN = 430 * MiB;
constexpr size_t WS_BSUM = 431 * MiB;
constexpr size_t WS_SCN = 2 * MiB;
constexpr size_t WS_END = 506 * MiB;

template <int CTRL> __device__ __forceinline__ float dppf(float x) { return __int_as_float(__builtin_amdgcn_update_dpp(0, __float_as_int(x), CTRL, 0xF, 0xF, false)); }
__device__ __forceinline__ float red16(float x) { x += dppf<0xB1>(x); x += dppf<0x4E>(x); x += dppf<0x141>(x); x += dppf<0x140>(x); return x; }
__device__ __forceinline__ float shflx(float v, int lane, int off) { return __int_as_float(__builtin_amdgcn_ds_bpermute((lane ^ off) << 2, __float_as_int(v))); }
__device__ __forceinline__ unsigned shflxu(unsigned v, int lane, int off) { return (unsigned)__builtin_amdgcn_ds_bpermute((lane ^ off) << 2, (int)v); }
__device__ __forceinline__ void sort128(unsigned& k0, unsigned& k1, int lane) {
#pragma unroll
    for (int k = 2; k <= 128; k <<= 1) {
#pragma unroll
        for (int j = k >> 1; j > 0; j >>= 1) {
            if (j == 64) { const unsigned lo = k0 < k1 ? k0 : k1, hi = k0 < k1 ? k1 : k0; k0 = lo; k1 = hi; }
            else {
                const unsigned p0 = shflxu(k0, lane, j), p1 = shflxu(k1, lane, j);
                const bool lower = (lane & j) == 0, up0 = (lane & k) == 0, up1 = ((lane + 64) & k) == 0;
                const unsigned mn0 = k0 < p0 ? k0 : p0, mx0 = k0 < p0 ? p0 : k0, mn1 = k1 < p1 ? k1 : p1, mx1 = k1 < p1 ? p1 : k1;
                k0 = (lower == up0) ? mn0 : mx0; k1 = (lower == up1) ? mn1 : mx1;
            }
        }
    }
}
typedef unsigned ntu32x2 __attribute__((ext_vector_type(2)));
__device__ __forceinline__ uint2 ntld2(const void* p) { const ntu32x2 v = __builtin_nontemporal_load((const ntu32x2*)p); return make_uint2(v.x, v.y); }
__device__ __forceinline__ float wave_sum(float v, int lane) { v = red16(v); v += shflx(v, lane, 16); v += shflx(v, lane, 32); return v; }
__device__ __forceinline__ float sigmoidf_(float x) { return 1.f / (1.f + expf(-x)); }

namespace pg8 {
#define PG8_LAS __attribute__((address_space(3)))
typedef unsigned short bf16_t;
typedef short bf16x8 __attribute__((ext_vector_type(8)));
typedef float f32x4 __attribute__((ext_vector_type(4)));
typedef unsigned u32x4 __attribute__((ext_vector_type(4)));
constexpr int BM = 256, BK = 64, HALF = 128, HTB = HALF * BK * 2  , STAGE_BYTES = 8 * HTB, NXCD = 8, WGM = 8;

__host__ __device__ __forceinline__ int lds_byte(int r, int c) { const int st = (r >> 4) * 2 + (c >> 5), rr = r & 15, cc = c & 31, ob = rr * 64 + cc * 2; return st * 1024 + (ob ^ (((ob >> 9) & 1) << 5)); }
__host__ __device__ __forceinline__ void stage_rc(int b, int& R, int& C) { const int st = b / 1024, sb = b % 1024, swz = sb ^ (((sb >> 9) & 1) << 5); R = (st >> 1) * 16 + swz / 64; C = (st & 1) * 32 + (swz % 64) / 2; }
__host__ __device__ __forceinline__ int perm32(int rho) { const int n = rho >> 4, i = rho & 15; return 8 * (i >> 2) + 4 * n + (i & 3); }

struct Unit { int pm, pn; };
struct Gemm { const bf16_t* A; const bf16_t* Bt; int M, N, K; };

struct StaticOrder {
    int nM, nN, nwg, G, c;
    __host__ __device__ void init(int M, int N, int G_, int c_) { nM = M / BM; nN = N / BM; nwg = nM * nN; G = G_; c = c_; }
    __host__ __device__ bool next(int i, Unit& u) const {
        const long L = (long)i * G + c; if (L >= nwg) return false;
        int wgid = (int)L; { const int q = nwg / NXCD, r = nwg % NXCD, xcd = wgid % NXCD, off = wgid / NXCD; wgid = (xcd < r ? xcd * (q + 1) : r * (q + 1) + (xcd - r) * q) + off; }
        const int nig = WGM * nN, gid = wgid / nig, fm = gid * WGM, gsz = (nM - fm) < WGM ? (nM - fm) : WGM;
        u.pm = fm + ((wgid % nig) % gsz); u.pn = (wgid % nig) / gsz; return true;
    }
    __device__ __forceinline__ void a_ready(const Unit&) const {}
    __device__ __forceinline__ void done(const Unit&) const {}
};

__device__ __forceinline__ unsigned cvt_pk_bf16(float lo, float hi) { unsigned r; asm volatile("v_cvt_pk_bf16_f32 %0, %1, %2" : "=v"(r) : "v"(lo), "v"(hi)); return r; }
typedef float f32x2 __attribute__((ext_vector_type(2)));
__device__ __forceinline__ f32x2 gelu_pk(f32x2 v) {
    const f32x2 av = __builtin_elementwise_abs(v), d = av * 0.2316418882f + 1.0f;
    f32x2 t; t.x = __builtin_amdgcn_rcpf(d.x); t.y = __builtin_amdgcn_rcpf(d.y);
    f32x2 q = t * 0.5307027145f + (-0.7265760135f); q = q * t + 0.7107068705f; q = q * t + (-0.142248368f); q = q * t + 0.127414796f; q = q * t;
    const f32x2 s = (v * v) * (-0.72134752044f);
    f32x2 e; e.x = __builtin_amdgcn_exp2f(s.x); e.y = __builtin_amdgcn_exp2f(s.y);
    const f32x2 m = v * (q * e), r = v - m;
    f32x2 o; o.x = v.x < 0.f ? m.x : r.x; o.y = v.y < 0.f ? m.y : r.y; return o;
}

template <int ACT  > struct EpiBf16 {
    static constexpr bool PERM = true, AFTER_DRAIN = false; static_assert(ACT == 0 || ACT == 1, "EpiBf16: ACT is 0 (none) or 1 (gelu_pk)");
    bf16_t* O; int ldc; const float* bias; int split_cols; size_t split_stride; float scale0;
    __device__ __forceinline__ void operator()(const f32x4 (&acc)[2][2][4][2], const Unit& u, int wr, int wc, int fr, int fq) const {
        const int row0 = u.pm * BM + wr * 64 + fr; int colt = u.pn * BM; bf16_t* base = O;
        float sc = 1.f; if (split_cols) { const int t = colt / split_cols; base += (size_t)t * split_stride; colt -= t * split_cols; if (t == 0) sc = scale0; }
        const int col0 = colt + wc * 32 + 8 * fq, bcol0 = u.pn * BM + wc * 32 + 8 * fq;
        f32x4 bv[2][2];
#pragma unroll
        for (int bj = 0; bj < 2; ++bj)
#pragma unroll
            for (int n = 0; n < 2; ++n) bv[bj][n] = bias ? *(const f32x4*)(bias + bcol0 + bj * HALF + 4 * n) : (f32x4){0.f, 0.f, 0.f, 0.f};
#pragma unroll
        for (int ai = 0; ai < 2; ++ai)
#pragma unroll
            for (int m = 0; m < 4; ++m) { bf16_t* rowp = base + (size_t)(row0 + ai * HALF + m * 16) * ldc + col0;
#pragma unroll
                for (int bj = 0; bj < 2; ++bj) { f32x4 v0 = acc[ai][bj][m][0] + bv[bj][0], v1 = acc[ai][bj][m][1] + bv[bj][1];
                    if (ACT == 1) { f32x2 a = gelu_pk((f32x2){v0[0], v0[1]}), b = gelu_pk((f32x2){v0[2], v0[3]}), c = gelu_pk((f32x2){v1[0], v1[1]}), d = gelu_pk((f32x2){v1[2], v1[3]});
                        v0 = (f32x4){a.x, a.y, b.x, b.y}; v1 = (f32x4){c.x, c.y, d.x, d.y}; }
                    v0 = v0 * sc; v1 = v1 * sc; u32x4 w; w.x = cvt_pk_bf16(v0[0], v0[1]); w.y = cvt_pk_bf16(v0[2], v0[3]); w.z = cvt_pk_bf16(v1[0], v1[1]); w.w = cvt_pk_bf16(v1[2], v1[3]);
                    *(u32x4*)(rowp + bj * HALF) = w; } }
    }
};

struct EpiProj {
    static constexpr bool PERM = true, AFTER_DRAIN = false;
    bf16_t* O; int ldc; bf16_t* P; int pool0, pw;
    __device__ __forceinline__ void operator()(const f32x4 (&acc)[2][2][4][2], const Unit& u, int wr, int wc, int fr, int fq) const {
        const int row0 = u.pm * BM + wr * 64 + fr; int colt = u.pn * BM; bf16_t* base = O; int ld = ldc;
        if (colt >= pool0 && colt < pool0 + pw) { base = P; ld = pw; colt -= pool0; }
        const int col0 = colt + wc * 32 + 8 * fq;
#pragma unroll
        for (int ai = 0; ai < 2; ++ai)
#pragma unroll
            for (int m = 0; m < 4; ++m) { bf16_t* rowp = base + (size_t)(row0 + ai * HALF + m * 16) * ld + col0;
#pragma unroll
                for (int bj = 0; bj < 2; ++bj) { const f32x4 v0 = acc[ai][bj][m][0], v1 = acc[ai][bj][m][1];
                    u32x4 w; w.x = cvt_pk_bf16(v0[0], v0[1]); w.y = cvt_pk_bf16(v0[2], v0[3]); w.z = cvt_pk_bf16(v1[0], v1[1]); w.w = cvt_pk_bf16(v1[2], v1[3]);
                    *(u32x4*)(rowp + bj * HALF) = w; } }
    }
};
struct EpiResGate {
    static constexpr bool PERM = true, AFTER_DRAIN = false;
    const bf16_t* xold; bf16_t* X; const float* gate;
    bf16_t* XB; const float* sv; unsigned long long* ssq;
    __device__ __forceinline__ void operator()(const f32x4 (&acc)[2][2][4][2], const Unit& u, int wr, int wc, int fr, int fq) const {
        const int col0 = u.pn * BM + wc * 32 + 8 * fq; const int b = (u.pm * BM) / SEQ;
        const float* gp = gate + (size_t)b * 6 * D + col0; const float* sp = sv + (size_t)b * D + col0;
        float rsum[2][4];
#pragma unroll
        for (int ai = 0; ai < 2; ++ai)
#pragma unroll
            for (int m = 0; m < 4; ++m) rsum[ai][m] = 0.f;
#pragma unroll
        for (int bj = 0; bj < 2; ++bj) { const f32x4 g0 = *(const f32x4*)(gp + bj * HALF), g1 = *(const f32x4*)(gp + bj * HALF + 4), s0 = *(const f32x4*)(sp + bj * HALF), s1 = *(const f32x4*)(sp + bj * HALF + 4);
#pragma unroll
            for (int ai = 0; ai < 2; ++ai)
#pragma unroll
                for (int m = 0; m < 4; ++m) { const size_t off = (size_t)(u.pm * BM + ai * HALF + wr * 64 + m * 16 + fr) * D + col0 + bj * HALF;
                    const u32x4 xo_ = *(const u32x4*)(xold + off);
                    const f32x4 xa = (f32x4){__uint_as_float(xo_.x << 16), __uint_as_float(xo_.x & 0xffff0000u), __uint_as_float(xo_.y << 16), __uint_as_float(xo_.y & 0xffff0000u)} + g0 * acc[ai][bj][m][0],
                                xb = (f32x4){__uint_as_float(xo_.z << 16), __uint_as_float(xo_.z & 0xffff0000u), __uint_as_float(xo_.w << 16), __uint_as_float(xo_.w & 0xffff0000u)} + g1 * acc[ai][bj][m][1];
                    { u32x4 xs_; xs_.x = cvt_pk_bf16(xa[0], xa[1]); xs_.y = cvt_pk_bf16(xa[2], xa[3]); xs_.z = cvt_pk_bf16(xb[0], xb[1]); xs_.w = cvt_pk_bf16(xb[2], xb[3]); *(u32x4*)(X + off) = xs_; }
                    rsum[ai][m] += ((xa[0] * xa[0] + xa[1] * xa[1]) + (xa[2] * xa[2] + xa[3] * xa[3])) + ((xb[0] * xb[0] + xb[1] * xb[1]) + (xb[2] * xb[2] + xb[3] * xb[3]));
                    const f32x4 ya = xa * s0, yb = xb * s1; u32x4 o; o.x = cvt_pk_bf16(ya[0], ya[1]); o.y = cvt_pk_bf16(ya[2], ya[3]); o.z = cvt_pk_bf16(yb[0], yb[1]); o.w = cvt_pk_bf16(yb[2], yb[3]);
                    *(u32x4*)(XB + off) = o; } }
        const int lane_ = fr | (fq << 4);
#pragma unroll
        for (int ai = 0; ai < 2; ++ai)
#pragma unroll
            for (int m = 0; m < 4; ++m) { float v = rsum[ai][m];
                v += __int_as_float(__builtin_amdgcn_ds_bpermute((lane_ ^ 16) << 2, __float_as_int(v))); v += __int_as_float(__builtin_amdgcn_ds_bpermute((lane_ ^ 32) << 2, __float_as_int(v)));
                if (fq == 0) (void)__hip_atomic_fetch_add(ssq + (u.pm * BM + ai * HALF + wr * 64 + m * 16 + fr), (unsigned long long)(v * 1048576.f + 0.5f), __ATOMIC_RELAXED, __HIP_MEMORY_SCOPE_AGENT); }
    }
};
struct EpiQ {
    static constexpr bool PERM = true, AFTER_DRAIN = false;
    bf16_t* O; int ldc; const float* cv; const unsigned long long* ssq;
    __device__ __forceinline__ void operator()(const f32x4 (&acc)[2][2][4][2], const Unit& u, int wr, int wc, int fr, int fq) const {
        const int row0 = u.pm * BM + wr * 64 + fr, colt = u.pn * BM, b = (u.pm * BM) / SEQ;
        const int col0 = colt + wc * 32 + 8 * fq;
        f32x4 bv[2][2];
#pragma unroll
        for (int bj = 0; bj < 2; ++bj)
#pragma unroll
            for (int n = 0; n < 2; ++n) bv[bj][n] = *(const f32x4*)(cv + (size_t)b * ldc + col0 + bj * HALF + 4 * n);
#pragma unroll
        for (int ai = 0; ai < 2; ++ai)
#pragma unroll
            for (int m = 0; m < 4; ++m) { const int row = row0 + ai * HALF + m * 16; bf16_t* rowp = O + (size_t)row * ldc + col0;
                const float rs = rsqrtf((float)ssq[row] * (1.f / (1048576.f * 1024.f)) + 1e-6f);
#pragma unroll
                for (int bj = 0; bj < 2; ++bj) { const f32x4 v0 = acc[ai][bj][m][0] * rs + bv[bj][0], v1 = acc[ai][bj][m][1] * rs + bv[bj][1];
                    u32x4 w; w.x = cvt_pk_bf16(v0[0], v0[1]); w.y = cvt_pk_bf16(v0[2], v0[3]); w.z = cvt_pk_bf16(v1[0], v1[1]); w.w = cvt_pk_bf16(v1[2], v1[3]);
                    *(u32x4*)(rowp + bj * HALF) = w; } }
    }
};
template <class Epi, class Sched, bool ALIGN_EPI = false, bool SP2 = false>
__device__ __forceinline__ void gemm_phase(PG8_LAS unsigned char* lds, const Gemm g, const Sched& S, const Epi& E, int tid) {
    asm volatile("" : "+v"(tid));
    const int wid = __builtin_amdgcn_readfirstlane(tid >> 6), lane = tid & 63, wr = wid >> 2, wc = wid & 3, fr = lane & 15, fq = lane >> 4;
    const int K = g.K, nt = K / BK;
    unsigned voffA[2], voffB[2];
#pragma unroll
    for (int i = 0; i < 2; ++i) { int R, C; stage_rc(tid * 16 + i * 8192, R, C); const int Rb = Epi::PERM ? ((R & ~31) + perm32(R & 31)) : R;
        voffA[i] = (unsigned)(R * K + C) * 2u; voffB[i] = (unsigned)(Rb * BK + C) * 2u; }
    const size_t kstep = (size_t)(BK * 2);
    const size_t hstep = (size_t)HALF * K * 2;
    const size_t tstep = 2 * hstep;
    const size_t kstepB = (size_t)BM * BK * 2, hstepB = (size_t)HALF * BK * 2;
    const unsigned ldsw = (unsigned)wid * 1024u;
    const int aoff = lds_byte(wr * 64 + fr, fq * 8), boff = lds_byte(wc * 32 + fr, fq * 8);
#define PG8_SA(b, h) (((b) * 2 + (h)) * HTB)
#define PG8_SB(b, h) ((4 + (b) * 2 + (h)) * HTB)
#define PG8_STAGE(bufoff, gbase, voff) do { _Pragma("unroll") for (int _i = 0; _i < 2; ++_i) \
        __builtin_amdgcn_global_load_lds((const unsigned*)((const char*)(gbase) + (voff)[_i]), (PG8_LAS unsigned*)(lds + (bufoff) + ldsw + _i * 8192), 16, 0, 0); } while (0)
#define PG8_LDA(dst, b, h) do { _Pragma("unroll") for (int m = 0; m < 4; ++m) _Pragma("unroll") for (int k = 0; k < 2; ++k) dst[m][k] = *(const PG8_LAS bf16x8*)(lds + PG8_SA(b, h) + aoff + m * 2048 + k * 1024); } while (0)
#define PG8_LDB(dst, b, h) do { _Pragma("unroll") for (int n = 0; n < 2; ++n) _Pragma("unroll") for (int k = 0; k < 2; ++k) dst[n][k] = *(const PG8_LAS bf16x8*)(lds + PG8_SB(b, h) + boff + n * 2048 + k * 1024); } while (0)
#define PG8_MMA(ai, bj, At, Bt) do { __builtin_amdgcn_s_setprio(1); _Pragma("unroll") for (int m = 0; m < 4; ++m) _Pragma("unroll") for (int n = 0; n < 2; ++n) _Pragma("unroll") for (int k = 0; k < 2; ++k) \
        acc[ai][bj][m][n] = __builtin_amdgcn_mfma_f32_16x16x32_bf16(Bt[n][k], At[m][k], acc[ai][bj][m][n], 0, 0, 0); __builtin_amdgcn_s_setprio(0); } while (0)
#define PG8_WAIT_V(n) asm volatile("s_waitcnt vmcnt(" #n ")" ::: "memory")
#define PG8_WAIT_L(n) asm volatile("s_waitcnt lgkmcnt(" #n ")" ::: "memory")
#define PG8_BAR __builtin_amdgcn_s_barrier()
#define PG8_SCHED __builtin_amdgcn_sched_barrier(0)
    Unit cur, nxt; int ui = 0;
    if (!S.next(0, cur)) return;
    f32x4 acc[2][2][4][2];
#pragma unroll
    for (int a = 0; a < 2; ++a)
#pragma unroll
        for (int b = 0; b < 2; ++b)
#pragma unroll
            for (int m = 0; m < 4; ++m)
#pragma unroll
                for (int n = 0; n < 2; ++n) acc[a][b][m][n] = (f32x4){0.f, 0.f, 0.f, 0.f};
    bf16x8 At[4][2], B0[2][2], B1[2][2];
    const char* cA = (const char*)g.A + (size_t)cur.pm * tstep; const char* cB = (const char*)g.Bt + (size_t)cur.pn * tstep;
    S.a_ready(cur);
    if constexpr (SP2) {
        PG8_STAGE(PG8_SB(0, 0), cB, voffB); PG8_STAGE(PG8_SB(0, 1), cB + hstepB, voffB); PG8_STAGE(PG8_SA(0, 0), cA, voffA); PG8_STAGE(PG8_SA(0, 1), cA + hstep, voffA);
        if (wr == 1) PG8_BAR;
        PG8_WAIT_V(2); PG8_BAR;
        PG8_STAGE(PG8_SB(1, 0), cB + kstepB, voffB); PG8_STAGE(PG8_SA(1, 0), cA + kstep, voffA); PG8_STAGE(PG8_SB(1, 1), cB + hstepB + kstepB, voffB);
        PG8_WAIT_V(6); PG8_BAR;
    } else {
        PG8_STAGE(PG8_SB(0, 0), cB, voffB); PG8_STAGE(PG8_SA(0, 0), cA, voffA); PG8_STAGE(PG8_SB(0, 1), cB + hstepB, voffB); PG8_STAGE(PG8_SA(0, 1), cA + hstep, voffA);
        if (wr == 1) PG8_BAR;
        PG8_WAIT_V(4); PG8_BAR;
        PG8_STAGE(PG8_SB(1, 0), cB + kstepB, voffB); PG8_STAGE(PG8_SA(1, 0), cA + kstep, voffA); PG8_STAGE(PG8_SB(1, 1), cB + hstepB + kstepB, voffB);
        PG8_WAIT_V(6); PG8_BAR;
    }
    for (;;) {
        const bool has_next = S.next(ui + 1, nxt);
        const char* nA = has_next ? (const char*)g.A + (size_t)nxt.pm * tstep : cA; const char* nB = has_next ? (const char*)g.Bt + (size_t)nxt.pn * tstep : cB;
        for (int t = 0; t < nt; t += 2) {
            const bool last = (t == nt - 2);
            const char* a1 = cA + (size_t)(t + 1) * kstep;
            const char* a2 = last ? nA : cA + (size_t)(t + 2) * kstep; const char* b2 = last ? nB : cB + (size_t)(t + 2) * kstepB;
            const char* a3 = a2 + kstep; const char* b3 = b2 + kstepB;
            if (last && has_next) S.a_ready(nxt);
            if constexpr (SP2) {
            PG8_LDB(B0, 0, 0); PG8_LDB(B1, 0, 1); PG8_SCHED; PG8_LDA(At, 0, 0); PG8_STAGE(PG8_SA(1, 1), a1 + hstep, voffA);
            PG8_WAIT_V(8); PG8_WAIT_L(0); PG8_BAR; PG8_MMA(0, 0, At, B0); PG8_MMA(0, 1, At, B1); PG8_BAR; PG8_SCHED;
            PG8_LDA(At, 0, 1); PG8_STAGE(PG8_SB(0, 0), b2, voffB); PG8_STAGE(PG8_SB(0, 1), b2 + hstepB, voffB); PG8_STAGE(PG8_SA(0, 0), a2, voffA);
            PG8_WAIT_V(8); PG8_WAIT_L(0); PG8_BAR; PG8_MMA(1, 0, At, B0); PG8_MMA(1, 1, At, B1); PG8_BAR; PG8_SCHED;
            PG8_LDB(B0, 1, 0); PG8_LDB(B1, 1, 1); PG8_SCHED; PG8_LDA(At, 1, 0); PG8_STAGE(PG8_SA(0, 1), a2 + hstep, voffA);
            PG8_WAIT_V(8); PG8_WAIT_L(0); PG8_BAR; PG8_MMA(0, 0, At, B0); PG8_MMA(0, 1, At, B1); PG8_BAR; PG8_SCHED;
            PG8_LDA(At, 1, 1); PG8_STAGE(PG8_SB(1, 0), b3, voffB); PG8_STAGE(PG8_SB(1, 1), b3 + hstepB, voffB); PG8_STAGE(PG8_SA(1, 0), a3, voffA);
            PG8_WAIT_V(8); PG8_WAIT_L(0); PG8_BAR; PG8_MMA(1, 0, At, B0); PG8_MMA(1, 1, At, B1); PG8_BAR; PG8_SCHED;
            } else {
            PG8_LDB(B0, 0, 0); PG8_SCHED; PG8_LDA(At, 0, 0); PG8_STAGE(PG8_SA(1, 1), a1 + hstep, voffA);
            PG8_WAIT_L(8); PG8_BAR; PG8_WAIT_L(0); PG8_MMA(0, 0, At, B0); PG8_BAR; PG8_SCHED;
            PG8_LDB(B1, 0, 1); PG8_STAGE(PG8_SB(0, 0), b2, voffB);
            PG8_BAR; PG8_WAIT_L(0); PG8_MMA(0, 1, At, B1); PG8_BAR;
            PG8_LDA(At, 0, 1); PG8_STAGE(PG8_SA(0, 0), a2, voffA);
            PG8_BAR; PG8_WAIT_L(0); PG8_MMA(1, 0, At, B0); PG8_BAR; PG8_SCHED;
            PG8_STAGE(PG8_SB(0, 1), b2 + hstepB, voffB);
            PG8_WAIT_V(6); PG8_BAR; PG8_MMA(1, 1, At, B1); PG8_BAR;
            PG8_LDB(B0, 1, 0); PG8_SCHED; PG8_LDA(At, 1, 0); PG8_STAGE(PG8_SA(0, 1), a2 + hstep, voffA);
            PG8_WAIT_L(8); PG8_BAR; PG8_WAIT_L(0); PG8_MMA(0, 0, At, B0); PG8_BAR; PG8_SCHED;
            PG8_LDB(B1, 1, 1); PG8_STAGE(PG8_SB(1, 0), b3, voffB);
            PG8_BAR; PG8_WAIT_L(0); PG8_MMA(0, 1, At, B1); PG8_BAR;
            PG8_LDA(At, 1, 1); PG8_STAGE(PG8_SA(1, 0), a3, voffA);
            PG8_BAR; PG8_WAIT_L(0); PG8_MMA(1, 0, At, B0); PG8_BAR; PG8_SCHED;
            PG8_STAGE(PG8_SB(1, 1), b3 + hstepB, voffB);
            PG8_WAIT_V(6); PG8_BAR; PG8_MMA(1, 1, At, B1); PG8_BAR;
            }
        }
        if constexpr (ALIGN_EPI) { if (wr == 0) PG8_BAR; }
        if constexpr (!Epi::AFTER_DRAIN) { int le_; asm volatile("v_mbcnt_lo_u32_b32 %0, -1, 0\n\tv_mbcnt_hi_u32_b32 %0, -1, %0" : "=v"(le_)); E(acc, cur, wr, wc, le_ & 15, le_ >> 4); S.done(cur); }
        if (!has_next) break;
#pragma unroll
        for (int a = 0; a < 2; ++a)
#pragma unroll
            for (int b = 0; b < 2; ++b)
#pragma unroll
                for (int m = 0; m < 4; ++m)
#pragma unroll
                    for (int n = 0; n < 2; ++n) acc[a][b][m][n] = (f32x4){0.f, 0.f, 0.f, 0.f};
        cur = nxt; cA = nA; cB = nB; ++ui;
        if constexpr (ALIGN_EPI) { if (wr == 1) PG8_BAR; }
    }
    PG8_WAIT_V(0);
    if constexpr (!ALIGN_EPI) { if (wr == 0) PG8_BAR; }
    PG8_BAR;
    if constexpr (Epi::AFTER_DRAIN) { E.fused(acc, cur, wr, wc, fr, fq, lds, wid, lane); S.done(cur); }
#undef PG8_SA
#undef PG8_SB
#undef PG8_STAGE
#undef PG8_LDA
#undef PG8_LDB
#undef PG8_MMA
#undef PG8_WAIT_V
#undef PG8_WAIT_L
#undef PG8_BAR
#undef PG8_SCHED
}
}

#define LAS __attribute__((address_space(3)))
constexpr int NWAVES = 8, NTHR = 512;
constexpr int LDS_BYTES = 147456;
constexpr int NPH = 21;
typedef float f32x4 __attribute__((ext_vector_type(4)));
typedef unsigned u32x4 __attribute__((ext_vector_type(4)));

struct Args { const float* in[30]; float* out; unsigned char* ws; int ph_lo, ph_hi; };

__device__ __forceinline__ unsigned pk2(float lo, float hi) { return cvtpk(lo, hi); }

template <bool BLK = false> __device__ __forceinline__ void p0_transpose_item(const float* W, int K, int N, bf16* WT, int row_off, LAS float* scr, int item, int lane) {
    const int nblk = N / 32, kb = item / nblk, nb = item % nblk, k0 = 64 * kb, n0 = 32 * nb;
#pragma unroll 8
    for (int i = 0; i < 32; ++i) { const int kk = 2 * i + (lane >> 5); scr[kk * 33 + (lane & 31)] = W[(size_t)(k0 + kk) * N + n0 + (lane & 31)]; }
    asm volatile("s_waitcnt lgkmcnt(0)" ::: "memory");
    const int c = lane & 7;
#pragma unroll
    for (int j = 0; j < 4; ++j) { const int n = (lane >> 3) + 8 * j; const LAS float* s = scr + (8 * c) * 33 + n;
        u32x4 o; o.x = pk2(s[0 * 33], s[1 * 33]); o.y = pk2(s[2 * 33], s[3 * 33]); o.z = pk2(s[4 * 33], s[5 * 33]); o.w = pk2(s[6 * 33], s[7 * 33]);
        if constexpr (BLK) { const int ng = row_off + n0 + n; *(u32x4*)(WT + ((size_t)((ng >> 8) * (K >> 6) + (k0 >> 6)) * 256 + (ng & 255)) * 64 + 8 * c) = o; }
        else *(u32x4*)(WT + (size_t)(row_off + n0 + n) * K + k0 + 8 * c) = o; }
    asm volatile("s_waitcnt lgkmcnt(0)" ::: "memory");
}

__device__ __forceinline__ void norm_mod_row(const float* xr, const float* gamma, const float* sh, const float* sc, bf16* orow, bf16* xcopy, int lane) {
    f32x4 v[4]; float ss = 0.f;
#pragma unroll
    for (int j = 0; j < 4; ++j) { v[j] = __builtin_nontemporal_load((const f32x4*)(xr + j * 256 + lane * 4)); { uint2 c_; c_.x = pk2(v[j].x, v[j].y); c_.y = pk2(v[j].z, v[j].w); *(uint2*)(xcopy + j * 256 + lane * 4) = c_; } ss += (v[j].x * v[j].x + v[j].y * v[j].y) + (v[j].z * v[j].z + v[j].w * v[j].w); }
    const float rs = rsqrtf(wave_sum(ss, lane) * (1.f / D) + NORM_EPS);
#pragma unroll
    for (int j = 0; j < 4; ++j) { const int d = j * 256 + lane * 4; const f32x4 g = *(const f32x4*)(gamma + d), a = *(const f32x4*)(sc + d), s = *(const f32x4*)(sh + d);
        const f32x4 y = v[j] * rs * g * (a + 1.f) + s; uint2 o; o.x = pk2(y.x, y.y); o.y = pk2(y.z, y.w); *(uint2*)(orow + d) = o; }
}


#define XB_TMO      128
#define XB_XCNT(j)  (256  + 64 * (j))
#define XB_XSUB(j)  (1280 + 64 * (j))
#define XB_XGEN(j)  (2304 + 64 * (j))
#define XB_TOP      3328
#define XB_TOPGEN   3392
#define XCD_BAR_WORDS 3456
#define XB_SPIN_CAP (1u << 18)

__device__ __forceinline__ unsigned xb_ld(unsigned* p)              { return __hip_atomic_load(p, __ATOMIC_RELAXED, __HIP_MEMORY_SCOPE_AGENT); }
__device__ __forceinline__ unsigned xb_add(unsigned* p, unsigned v) { return __hip_atomic_fetch_add(p, v, __ATOMIC_RELAXED, __HIP_MEMORY_SCOPE_AGENT); }
__device__ __forceinline__ unsigned xb_xcc_id() { return (unsigned)__builtin_amdgcn_s_getreg((3 << 11) | 20) & 0xFu; }
#define XB_SPIN(cond, bar) do { unsigned _sp = 0; while (cond) { __builtin_amdgcn_s_sleep(1); \
    if ((++_sp & 255u) == 0u) { if (xb_ld(&(bar)[XB_TMO])) break; if (_sp > XB_SPIN_CAP) { atomicAdd(&(bar)[XB_TMO], 1u); break; } } } } while (0)

struct XcdBarrier {
    unsigned* bar; unsigned x; int w0;
    volatile __attribute__((address_space(3))) unsigned* st;
};

__device__ __forceinline__ XcdBarrier xcd_barrier_post(unsigned* bar, volatile __attribute__((address_space(3))) unsigned* st) {
    XcdBarrier b; b.bar = bar; b.x = xb_xcc_id(); b.st = st; b.w0 = __builtin_amdgcn_readfirstlane((int)threadIdx.x >> 6);
    if (threadIdx.x == 0) (void)xb_add(&bar[XB_XCNT(b.x)], 1u);
    return b;
}
__device__ __forceinline__ void xcd_barrier_complete(unsigned* bar, unsigned x, unsigned& nloc, unsigned& nx) {
    const unsigned G = gridDim.x * gridDim.y * gridDim.z;
    unsigned sum, cnt, mine, sp = 0u;
    for (;;) {
        sum = 0u; cnt = 0u; mine = 0u;
#pragma unroll
        for (unsigned j = 0; j < 16; ++j) { const unsigned c = xb_ld(&bar[XB_XCNT(j)]); sum += c; cnt += (c > 0u) ? 1u : 0u; }
        mine = xb_ld(&bar[XB_XCNT(x)]);
        if (sum == G) break;
        __builtin_amdgcn_s_sleep(1);
        if ((++sp & 255u) == 0u) { if (xb_ld(&bar[XB_TMO])) break; if (sp > XB_SPIN_CAP) { atomicAdd(&bar[XB_TMO], 1u); break; } }
    }
    nloc = mine > 0u ? mine : 1u; nx = cnt > 0u ? cnt : 1u;
}

template <bool FIRST> __device__ __forceinline__ void xcd_barrier(const XcdBarrier& b) {
    asm volatile("s_waitcnt vmcnt(0)" ::: "memory");
    __syncthreads();
    int lid_; asm volatile("v_mbcnt_lo_u32_b32 %0, -1, 0\n\tv_mbcnt_hi_u32_b32 %0, -1, %0" : "=v"(lid_));
    if (b.w0 == 0 && lid_ == 0) {
        unsigned* bar = b.bar;
        __builtin_amdgcn_s_waitcnt(0);
        unsigned nloc = b.st[0], nx = b.st[1];
        if (FIRST && nloc == 0u) { xcd_barrier_complete(bar, b.x, nloc, nx); b.st[0] = nloc; b.st[1] = nx; }
        const unsigned old = xb_add(&bar[XB_XSUB(b.x)], 1u);
        const unsigned gen = old / nloc;
        if (old + 1u == (gen + 1u) * nloc) {
            __builtin_amdgcn_fence(__ATOMIC_RELEASE, "agent");
            asm volatile("s_waitcnt vmcnt(0)" ::: "memory");
            const unsigned og = xb_add(&bar[XB_TOP], 1u);
            const unsigned tg = og / nx;
            if (og + 1u == (tg + 1u) * nx) xb_add(&bar[XB_TOPGEN], 1u);
            else XB_SPIN(xb_ld(&bar[XB_TOPGEN]) == tg, bar);
            __builtin_amdgcn_fence(__ATOMIC_ACQUIRE, "agent");
            asm volatile("s_waitcnt vmcnt(0)" ::: "memory");
        } else {
            XB_SPIN(xb_ld(&bar[XB_TOPGEN]) == gen, bar);
            __builtin_amdgcn_fence(__ATOMIC_ACQUIRE, "agent");
            asm volatile("s_waitcnt vmcnt(0)" ::: "memory");
        }
    }
    __syncthreads();
}


__device__ __forceinline__ unsigned mono_u32(float f) { unsigned u = __float_as_uint(f); return (u & 0x80000000u) ? ~u : (u | 0x80000000u); }
__device__ __forceinline__ float demono_u32(unsigned u) { return __uint_as_float((u & 0x80000000u) ? (u & 0x7FFFFFFFu) : ~u); }
__device__ __forceinline__ unsigned pack_key7(float f, int idx) { return (mono_u32(f) & 0xFFFFFF80u) | (unsigned)(127 - idx); }
__device__ __forceinline__ float unpack_key7(unsigned k) { return demono_u32((k & 0xFFFFFF80u) | 0x40u); }
__device__ __forceinline__ float unpack_key8(unsigned k) { return demono_u32((k & 0xFFFFFF00u) | 0x80u); }
__device__ __forceinline__ void ce_desc(unsigned& a, unsigned& b) { const unsigned hi = a > b ? a : b, lo = a > b ? b : a; a = hi; b = lo; }
__device__ __forceinline__ void sort16_desc(unsigned* v) {
#define CE_(a, b) ce_desc(v[a], v[b]);
    CE_(0,13) CE_(1,12) CE_(2,15) CE_(3,14) CE_(4,8) CE_(5,6) CE_(7,11) CE_(9,10)
    CE_(0,5) CE_(1,7) CE_(2,9) CE_(3,4) CE_(6,13) CE_(8,14) CE_(10,15) CE_(11,12)
    CE_(0,1) CE_(2,3) CE_(4,5) CE_(6,8) CE_(7,9) CE_(10,11) CE_(12,13) CE_(14,15)
    CE_(0,2) CE_(1,3) CE_(4,10) CE_(5,11) CE_(6,7) CE_(8,9) CE_(12,14) CE_(13,15)
    CE_(1,2) CE_(3,12) CE_(4,6) CE_(5,7) CE_(8,10) CE_(9,11) CE_(13,14)
    CE_(1,4) CE_(2,6) CE_(5,8) CE_(7,10) CE_(9,13) CE_(11,14)
    CE_(2,4) CE_(3,6) CE_(9,12) CE_(11,13)
    CE_(3,5) CE_(6,8) CE_(7,9) CE_(10,12)
    CE_(3,4) CE_(5,6) CE_(7,8) CE_(9,10) CE_(11,12)
    CE_(6,7) CE_(8,9)
#undef CE_
}
__device__ __forceinline__ void bmerge16_desc(unsigned* v) {
#pragma unroll
    for (int j = 8; j > 0; j >>= 1)
#pragma unroll
        for (int i = 0; i < 16; ++i) { const int l = i ^ j; if (l > i) ce_desc(v[i], v[l]); }
}
__device__ __forceinline__ void merge_top16(unsigned* a, const unsigned* b) {
#pragma unroll
    for (int i = 0; i < 16; ++i) { const unsigned o = b[15 - i]; a[i] = a[i] > o ? a[i] : o; }
    bmerge16_desc(a);
}
__device__ __forceinline__ void stage2_cands(const unsigned* s0, const unsigned* s1, int hh, unsigned* c) {
    float A[16], B[16];
#pragma unroll
    for (int i = 0; i < 16; ++i) { const float f0 = unpack_key7(s0[i]), f1 = unpack_key7(s1[i]); A[i] = hh ? f1 : f0; B[i] = hh ? f0 : f1; }
    int n = 0;
#pragma unroll
    for (int i = 0; i < 4; ++i)
#pragma unroll
        for (int j = i; j < 16; ++j) { if ((i + 1) * (j + 1) > 16) continue;
            const float val = A[i] + B[j]; const unsigned id = hh ? (unsigned)((j << 4) | i) : (unsigned)((i << 4) | j);
            unsigned key = (mono_u32(val) & 0xFFFFFF00u) | id; if (hh && i == j) key = 0u; c[n++] = key; }
#pragma unroll
    for (; n < 32; ++n) c[n] = 0u;
}

typedef short bf16x8_t __attribute__((ext_vector_type(8)));
typedef float f32x16 __attribute__((ext_vector_type(16)));
__device__ __forceinline__ float gelu_erf(float a) { return 0.5f * a * (1.f + erff(a * 0.70710678118654752f)); }


typedef __attribute__((address_space(3))) bf16 lbf16;

__device__ __forceinline__ f32x16 mm32(bf16x8_t a, bf16x8_t b, f32x16 c) { return __builtin_amdgcn_mfma_f32_32x32x16_bf16(a, b, c, 0, 0, 0); }
__device__ __forceinline__ bf16x8_t frag_from_u32x4(unsigned x, unsigned y, unsigned z, unsigned w) { typedef unsigned u4 __attribute__((ext_vector_type(4))); u4 t = {x, y, z, w}; return __builtin_bit_cast(bf16x8_t, t); }
template <int S> __device__ __forceinline__ bf16x8_t accop(const f32x16& z) {
    return frag_from_u32x4(cvtpk(z[8 * S], z[8 * S + 1]), cvtpk(z[8 * S + 2], z[8 * S + 3]), cvtpk(z[8 * S + 4], z[8 * S + 5]), cvtpk(z[8 * S + 6], z[8 * S + 7])); }
template <int S> __device__ __forceinline__ bf16x8_t ldpermcol(const lbf16* a, int col, int hh) {
    const lbf16* p = a + (16 * S + 4 * hh) * 72 + col;
    const unsigned e0 = p[0], e1 = p[72], e2 = p[144], e3 = p[216], e4 = p[8 * 72], e5 = p[9 * 72], e6 = p[10 * 72], e7 = p[11 * 72];
    return frag_from_u32x4(e0 | (e1 << 16), e2 | (e3 << 16), e4 | (e5 << 16), e6 | (e7 << 16)); }
__device__ __forceinline__ bf16x8_t ldrow(const lbf16* a, int row, int ks, int hh) { return *(const __attribute__((address_space(3))) bf16x8_t*)(a + row * 72 + ks * 16 + 8 * hh); }
__device__ __forceinline__ int rowidx(int e, int hh) { return (e & 3) + 8 * (e >> 2) + 4 * hh; }

constexpr int CONV_S1_ROWS = 0;
constexpr int ROWB = 768;
__device__ __forceinline__ unsigned fp6code(float x, float sc) {
    const float t = fabsf(x) * sc;
    const float r = t < 16.f ? __builtin_rintf(t) : (t < 32.f ? 8.f + __builtin_rintf(t * 0.5f) : 16.f + __builtin_rintf(t * 0.25f));
    unsigned c = (unsigned)r; c = c > 31u ? 31u : c;
    return c | (x < 0.f ? 32u : 0u);
}
__device__ __forceinline__ void convert_tables_fp6(const float* pu, const float* pv, unsigned char* u8, unsigned char* v8, float* usc, float* vsc, int l, int wv, int nw, int lane, int q_lo, int q_hi) {
    for (int rr0 = q_lo + wv * 2; rr0 < q_hi; rr0 += nw * 2) {
        f32x4 v[2][4]; float m[2];
#pragma unroll
        for (int rr = 0; rr < 2; ++rr) { const int q = rr0 + rr; const size_t row = (size_t)l * NEXP + (q < NEXP ? q : q - NEXP); const float* sp_ = (q < NEXP ? pu : pv) + row * D + lane * 4;
#pragma unroll
            for (int k = 0; k < 4; ++k) v[rr][k] = __builtin_nontemporal_load((const f32x4*)(sp_ + k * 256)); }
#pragma unroll
        for (int rr = 0; rr < 2; ++rr) { float mm = 0.f;
#pragma unroll
            for (int k = 0; k < 4; ++k) mm = fmaxf(fmaxf(mm, fmaxf(fabsf(v[rr][k].x), fabsf(v[rr][k].y))), fmaxf(fabsf(v[rr][k].z), fabsf(v[rr][k].w)));
#pragma unroll
            for (int o = 1; o < 64; o <<= 1) mm = fmaxf(mm, shflx(mm, lane, o));
            m[rr] = mm; }
        if (rr0 >= NEXP) {
#pragma unroll
            for (int rr = 0; rr < 2; ++rr) { const size_t row = (size_t)l * NEXP + (rr0 + rr - NEXP); const float sc = m[rr] > 0.f ? 6.f / (0.9f * m[rr]) : 1.f; unsigned w[2] = {0u, 0u};
#pragma unroll
                for (int k = 0; k < 4; ++k) { const float a0 = __builtin_amdgcn_fmed3f(v[rr][k].x * sc, -6.f, 6.f), a1 = __builtin_amdgcn_fmed3f(v[rr][k].y * sc, -6.f, 6.f), a2 = __builtin_amdgcn_fmed3f(v[rr][k].z * sc, -6.f, 6.f), a3 = __builtin_amdgcn_fmed3f(v[rr][k].w * sc, -6.f, 6.f);
                    if (k & 1) { w[k >> 1] = __builtin_amdgcn_cvt_scalef32_pk_fp4_f32(w[k >> 1], a0, a1, 1.0f, 2); w[k >> 1] = __builtin_amdgcn_cvt_scalef32_pk_fp4_f32(w[k >> 1], a2, a3, 1.0f, 3); }
                    else       { w[k >> 1] = __builtin_amdgcn_cvt_scalef32_pk_fp4_f32(w[k >> 1], a0, a1, 1.0f, 0); w[k >> 1] = __builtin_amdgcn_cvt_scalef32_pk_fp4_f32(w[k >> 1], a2, a3, 1.0f, 1); } }
                *(uint2*)(v8 + row * ROWB + lane * 8) = make_uint2(w[0], w[1]);
                if (lane == 0) vsc[row] = m[rr] > 0.f ? m[rr] * (0.9f / 6.f) : 1.f; }
            continue; }
        { typedef float f32x16_t __attribute__((ext_vector_type(16))); typedef unsigned u32x6_t __attribute__((ext_vector_type(6)));
          const float sc0 = m[0] > 0.f ? 7.5f / m[0] : 1.f, sc1 = m[1] > 0.f ? 7.5f / m[1] : 1.f; f32x16_t pa, pb;
#pragma unroll
          for (int k = 0; k < 4; ++k) {
              pa[k * 2] = v[0][k].x * sc0; pb[k * 2] = v[0][k].y * sc0; pa[k * 2 + 1] = v[0][k].z * sc0; pb[k * 2 + 1] = v[0][k].w * sc0;
              pa[8 + k * 2] = v[1][k].x * sc1; pb[8 + k * 2] = v[1][k].y * sc1; pa[8 + k * 2 + 1] = v[1][k].z * sc1; pb[8 + k * 2 + 1] = v[1][k].w * sc1; }
          const u32x6_t pk = __builtin_amdgcn_cvt_scalef32_2xpk16_fp6_f32(pa, pb, 1.0f);
#pragma unroll
          for (int rr = 0; rr < 2; ++rr) { const int q = rr0 + rr; const size_t row = (size_t)l * NEXP + (q < NEXP ? q : q - NEXP);
              unsigned* op = (unsigned*)((q < NEXP ? u8 : v8) + row * ROWB + lane * 12);
              __builtin_nontemporal_store(pk[rr * 3], op); __builtin_nontemporal_store(pk[rr * 3 + 1], op + 1); __builtin_nontemporal_store(pk[rr * 3 + 2], op + 2);
              if (lane == 0) (q < NEXP ? usc : vsc)[row] = m[rr] > 0.f ? m[rr] * (1.f / 7.5f) : 1.f; } }
    }
}

__global__ void __launch_bounds__(NTHR, 2) mega(Args args) {
    extern __shared__ __attribute__((aligned(16))) unsigned char lds_raw[];
    LAS unsigned char* lds = (LAS unsigned char*)lds_raw;
    const int G = gridDim.x, bx = blockIdx.x, NGW = G * NWAVES;
    const int wave0 = __builtin_amdgcn_readfirstlane((int)threadIdx.x >> 6);
    typedef const unsigned char __attribute__((address_space(4))) kbyte;
#define PHASE_IDS int tid; asm volatile("v_mbcnt_lo_u32_b32 %0, -1, 0\n\tv_mbcnt_hi_u32_b32 %0, -1, %0" : "=v"(tid)); tid += wave0 * 64;     const int lane = tid & 63, wave = __builtin_amdgcn_readfirstlane(tid >> 6), gw = bx * NWAVES + wave; (void)lane; (void)gw; \
    kbyte* kp = (kbyte*)__builtin_amdgcn_kernarg_segment_ptr(); asm volatile("" : "+s"(kp)); \
    unsigned char* const ws = (unsigned char*)*(__attribute__((address_space(1))) unsigned char* const __attribute__((address_space(4)))*)(kp + 31 * 8); float* const X = (float*)*(__attribute__((address_space(1))) float* const __attribute__((address_space(4)))*)(kp + 30 * 8); (void)ws; (void)X;
#define INP(i) ((const float*)(*(const __attribute__((address_space(1))) float* const __attribute__((address_space(4)))*)(kp + (i) * 8)))
#define MOD ((float*)(ws + WS_MOD))
#define H ((bf16*)(ws + WS_H))
#define PROJ ((bf16*)(ws + WS_PROJ))
#define Q ((bf16*)(ws + WS_Q))
#define MIX ((bf16*)(ws + WS_MIX))
#define RKp ((unsigned*)(ws + WS_R))
#define KKBp ((unsigned*)(ws + WS_KK))
#define GBGp ((unsigned*)(ws + WS_G))
#define Rb ((bf16*)(ws + WS_R))
#define Kb ((bf16*)(ws + WS_K))
#define V0 ((bf16*)(ws + WS_V0))
#define V1 ((bf16*)(ws + WS_V1))
#define KKb ((bf16*)(ws + WS_KK))
#define Bb ((bf16*)(ws + WS_B))
#define Gb ((bf16*)(ws + WS_G))
#define BGb ((bf16*)(ws + WS_BG))
#define Wd ((float*)(ws + WS_W))
#define Y ((float*)(ws + WS_Y))
#define QB ((float*)(ws + WS_QB))
#define POOLIN ((bf16*)(ws + WS_QB))
#define SH ((float*)(ws + WS_SH))
#define SSQ ((unsigned long long*)(ws + WS_SH))
#define CVEC ((float*)(ws + WS_SH + 512 * 1024))
#define S2V ((float*)(ws + WS_SH + 640 * 1024))
#define XBF ((bf16*)(ws + 466 * MiB))
#define XB2 ((bf16*)(ws + WS_R))
#define WUPT ((bf16*)(ws + WS_LORA))
#define AUPT ((bf16*)(ws + WS_LORA + 131072))
#define GUPT ((bf16*)(ws + WS_LORA + 262144))
#define VUPT ((bf16*)(ws + WS_LORA + 524288))
#define PWT ((bf16*)(ws + WS_LORA + 655360))
#define INVN ((float*)(ws + WS_INVN))
#define BSUM ((float*)(ws + WS_BSUM))
#define SCN ((unsigned char*)(ws + WS_SCN))
#define IDX ((int*)(ws + WS_IDX))
#define GATE ((float*)(ws + WS_GATE))
#define WinT ((bf16*)(ws + WS_WIN_T))
#define WoutT ((bf16*)(ws + WS_WOUT_T))
#define PqT ((bf16*)(ws + WS_PQ_T))
#define KEYS ((bf16*)(ws + WS_KEYS))
#define U8 ((unsigned char*)(ws + WS_U))
#define V8 ((unsigned char*)(ws + WS_V))
#define USc ((float*)(ws + WS_US))
#define VSc ((float*)(ws + WS_VS))
    const int lo = args.ph_lo, hi = args.ph_hi;
    { volatile LAS unsigned* misc = (volatile LAS unsigned*)(lds + LDS_BYTES - 64); if (threadIdx.x < 4) misc[threadIdx.x] = 0u; __syncthreads(); }
    const XcdBarrier xbar = xcd_barrier_post((unsigned*)(args.ws) + 4096, (volatile LAS unsigned*)(lds + LDS_BYTES - 64));
#define IN(k) (lo <= (k) && (k) < hi)
#ifndef REP_PHASE
#define REP_PHASE (-1)
#endif
#define REPS(k) ((k) == REP_PHASE ? 3 : 1)
#define SEAM(k) do { if (IN(k) && IN((k) + 1)) { if ((k) == 0) cg::this_grid().sync(); else { XcdBarrier xb_ = xbar; asm volatile("" : "+s"(xb_.bar)); if ((k) == 1) xcd_barrier<true>(xb_); else xcd_barrier<false>(xb_); } } } while (0)

    if (IN(0)) { PHASE_IDS
        { unsigned long long* z = SSQ; for (int i = bx * NTHR + tid; i < 2 * T; i += G * NTHR) z[i] = 0ull; }
        { LAS float* ca = (LAS float*)lds; LAS float* red = (LAS float*)(lds + 16384);
          const float* c = INP(1); const float* ada_w = INP(2); const float* ada_b = INP(3);
          bool have = false;
          for (int it = bx; it < 192; it += G) {
              if (!have) { for (int i = tid; i < BATCH * D; i += NTHR) { const float v = c[i]; ca[i] = v / (1.f + expf(-v)); } have = true; __syncthreads(); }
              const int l = it / 96, n = (it % 96) * 64 + (tid & 63), kq = tid >> 6;
              const float* w = ada_w + (size_t)l * D * 6 * D + (size_t)(kq * 128) * 6 * D + n;
              float a0 = 0.f, a1 = 0.f, a2 = 0.f, a3 = 0.f;
#pragma unroll 32
              for (int k = 0; k < 128; ++k) { const float wv = w[(size_t)k * 6 * D]; const int kk = kq * 128 + k; a0 += ca[kk] * wv; a1 += ca[D + kk] * wv; a2 += ca[2 * D + kk] * wv; a3 += ca[3 * D + kk] * wv; }
              red[(kq * 4 + 0) * 64 + (tid & 63)] = a0; red[(kq * 4 + 1) * 64 + (tid & 63)] = a1; red[(kq * 4 + 2) * 64 + (tid & 63)] = a2; red[(kq * 4 + 3) * 64 + (tid & 63)] = a3;
              __syncthreads();
              if (tid < 256) { const int b = tid >> 6, col = tid & 63, nn = (it % 96) * 64 + col; float s = 0.f;
#pragma unroll
                for (int q = 0; q < 8; ++q) s += red[(q * 4 + b) * 64 + col];
                MOD[(size_t)l * BATCH * 6 * D + (size_t)b * 6 * D + nn] = s + ada_b[l * 6 * D + nn]; }
              __syncthreads();
          }
          __syncthreads(); }
        { LAS float* scr = (LAS float*)(lds + wave * 16384);
          constexpr int I_IN = (D / 64) * (IN_COLS / 32), I_VR = (D / 64) * (MVL / 32), I_OUT = (D / 64) * (D / 32), I_PQ = (D / 64) * (PH * PQ / 32);
          constexpr int NIT = 2 * I_IN + I_VR + 2 * I_OUT + 2 * I_PQ;
          for (int it = gw; it < NIT; it += NGW) { int r = it;
              if (r < 2 * I_IN) { const int l = r / I_IN; p0_transpose_item<true>(INP(5) + (size_t)l * D * IN_COLS, D, IN_COLS, WinT + (size_t)l * LDP * D, 0, scr, r % I_IN, lane); continue; } r -= 2 * I_IN;
              if (r < I_VR) { p0_transpose_item<true>(INP(12), D, MVL, WinT + (size_t)1 * LDP * D, IN_COLS, scr, r, lane); continue; } r -= I_VR;
              if (r < 2 * I_OUT) { const int l = r / I_OUT; p0_transpose_item<true>(INP(23) + (size_t)l * D * D, D, D, WoutT + (size_t)l * D * D, 0, scr, r % I_OUT, lane); continue; } r -= 2 * I_OUT;
              { const int l = r / I_PQ; p0_transpose_item<true>(INP(25) + (size_t)l * D * PH * PQ, D, PH * PQ, PqT + (size_t)l * PH * PQ * D, 0, scr, r % I_PQ, lane); } }
          for (int it = gw; it < 2 * 16 + 2 * 16 + 2 * 32; it += NGW) { int r = it;
              if (r < 32) { const int l = r / 16; p0_transpose_item(INP(8) + (size_t)l * DL * RW, DL, RW, WUPT + (size_t)l * RW * DL, 0, scr, r % 16, lane); continue; } r -= 32;
              if (r < 32) { const int l = r / 16; p0_transpose_item(INP(10) + (size_t)l * AL * RW, AL, RW, AUPT + (size_t)l * RW * AL, 0, scr, r % 16, lane); continue; } r -= 32;
              { const int l = r / 32; p0_transpose_item(INP(11) + (size_t)l * GL * RW, GL, RW, GUPT + (size_t)l * RW * GL, 0, scr, r % 32, lane); } }
          { const float* vu = INP(15); for (int e = bx * NTHR + tid; e < MVL * RW; e += G * NTHR) { const int n = e >> 5, k = e & 31; VUPT[e] = f2bf(vu[k * RW + n]); } }
          for (int it = gw; it < 8 * 8; it += NGW) p0_transpose_item(INP(21) + (size_t)(it >> 3) * PG * PG, PG, PG, PWT + (size_t)(it >> 3) * PG * PG, 0, scr, it & 7, lane);
        }
        { const size_t gt = (size_t)bx * NTHR + tid, NT = (size_t)G * NTHR;
          constexpr size_t NK8 = (size_t)2 * PH * 2 * NKEYS * PHALF / 8;
          const float* src = INP(26); bf16* dst = KEYS;
          for (size_t i = gt; i < NK8; i += NT) {
              const f32x4 a = *(const f32x4*)(src + i * 8), b = *(const f32x4*)(src + i * 8 + 4);
              u32x4 o; o.x = pk2(a.x, a.y); o.y = pk2(a.z, a.w); o.z = pk2(b.x, b.y); o.w = pk2(b.z, b.w); *(u32x4*)(dst + i * 8) = o; }
        }
    }
    SEAM(0);

#pragma unroll
    for (int l = 0; l < DEPTH; ++l) {
        const int pb = 1 + 10 * l;
#define modl (MOD + (size_t)l * BATCH * 6 * D)
#define xin (l == 0 ? INP(0) : (const float*)X)
        if (l == 0 && IN(pb + 0)) { PHASE_IDS const float* gamma = INP(4) + l * D;
            for (int row = gw; row < T; row += NGW) { const int b = row / SEQ; norm_mod_row(INP(0) + (size_t)row * D, gamma, modl + (size_t)b * 6 * D, modl + (size_t)b * 6 * D + D, H + (size_t)row * D, XBF + (size_t)row * D, lane); } }
        SEAM(pb + 0);
        if (IN(pb + 1)) { PHASE_IDS const int N1 = l == 0 ? IN_COLS : LDP;
            pg8::Gemm g{H, WinT + (size_t)l * LDP * D, T, N1, D}; pg8::StaticOrder S; S.init(T, N1, G, bx);
            pg8::EpiProj E{PROJ, LDP, POOLIN, RWKV_COLS, PW};
            pg8::gemm_phase<pg8::EpiProj, pg8::StaticOrder, true, true>(lds, g, S, E, tid); }
        SEAM(pb + 1);

        if (IN(pb + 2)) { PHASE_IDS
            constexpr int LST = 296;
            LAS bf16* lin = (LAS bf16*)lds;
            const float* mu = INP(6) + l * RWKV_COLS; const float* vmu = INP(13);
            const float* w0p = INP(7) + l * RW; const float* a0p = INP(9) + l * RW; const float* kkp = INP(16) + l * RW; const float* kap = INP(17) + l * RW; const float* rkp = INP(18) + l * RW; const float* v0p = INP(14);
            const bf16* wupT = WUPT + (size_t)l * RW * DL; const bf16* aupT = AUPT + (size_t)l * RW * AL; const bf16* gupT = GUPT + (size_t)l * RW * GL; const bf16* vupT = VUPT;
            bf16* Vl = l == 0 ? V0 : V1;
            const int r32 = lane & 31, hh = lane >> 5, h = wave;
            for (int tile = bx; tile < T / 32; tile += G) {
                const int t0 = tile * 32;
                __syncthreads();
#pragma unroll 1
                for (int it0 = 0; it0 < 3; it0 += 2) {
                  u32x4 cu_[2], pv_[2]; f32x4 m0_[2], m1_[2];
#pragma unroll
                  for (int it = 0; it < 2; ++it) { const int c8 = tid + (it0 + it) * NTHR; const bool ok = c8 < 32 * 36; const int tok = ok ? c8 / 36 : 0, jc = ok ? c8 % 36 : 0, t = t0 + tok, sq = t % SEQ;
                      cu_[it] = (u32x4){0u, 0u, 0u, 0u}; pv_[it] = (u32x4){0u, 0u, 0u, 0u}; m0_[it] = (f32x4){0.f, 0.f, 0.f, 0.f}; m1_[it] = m0_[it];
                      if (ok && (jc < 32 || l > 0)) { const int col = jc < 32 ? 3 * RW + jc * 8 : IN_COLS + (jc - 32) * 8;
                          cu_[it] = *(const u32x4*)(PROJ + (size_t)t * LDP + col); if (sq > 0) pv_[it] = *(const u32x4*)(PROJ + (size_t)(t - 1) * LDP + col);
                          const float* mp = jc < 32 ? mu + col : vmu + (jc - 32) * 8; m0_[it] = *(const f32x4*)mp; m1_[it] = *(const f32x4*)(mp + 4); } }
#pragma unroll
                  for (int it = 0; it < 2; ++it) { const int c8 = tid + (it0 + it) * NTHR; if (c8 < 32 * 36) { const int tok = c8 / 36, jc = c8 % 36;
                      u32x4 o = {0u, 0u, 0u, 0u};
                      if (jc < 32 || l > 0) {
                          float x[8]; const unsigned cw[4] = {cu_[it].x, cu_[it].y, cu_[it].z, cu_[it].w}, pw[4] = {pv_[it].x, pv_[it].y, pv_[it].z, pv_[it].w}; const float mm[8] = {m0_[it].x, m0_[it].y, m0_[it].z, m0_[it].w, m1_[it].x, m1_[it].y, m1_[it].z, m1_[it].w};
#pragma unroll
                          for (int i = 0; i < 4; ++i) { const float c0 = __uint_as_float(cw[i] << 16), c1 = __uint_as_float(cw[i] & 0xffff0000u), p0 = __uint_as_float(pw[i] << 16), p1 = __uint_as_float(pw[i] & 0xffff0000u);
                              x[2 * i] = c0 + (p0 - c0) * mm[2 * i]; x[2 * i + 1] = c1 + (p1 - c1) * mm[2 * i + 1]; }
                          if (jc < 8) {
#pragma unroll
                              for (int i = 0; i < 8; ++i) { const float e2 = __expf(-2.f * fabsf(x[i])); const float th = (1.f - e2) * __builtin_amdgcn_rcpf(1.f + e2); x[i] = x[i] < 0.f ? -th : th; } }
                          else if (jc >= 16 && jc < 32) {
#pragma unroll
                              for (int i = 0; i < 8; ++i) x[i] = __builtin_amdgcn_rcpf(1.f + __expf(-x[i])); }
                          o.x = pk2(x[0], x[1]); o.y = pk2(x[2], x[3]); o.z = pk2(x[4], x[5]); o.w = pk2(x[6], x[7]);
                      }
                      *(LAS u32x4*)(lin + tok * LST + jc * 8) = o; } } }
                __syncthreads();
                const bool first = (t0 % SEQ) == 0;
                lbf16* tin = (lbf16*)(lds + 19456 + wave * 14336);
                { u32x4 iq[13]; int ql_; asm volatile("v_mbcnt_lo_u32_b32 %0, -1, 0\n\tv_mbcnt_hi_u32_b32 %0, -1, %0" : "=v"(ql_));
#pragma unroll
                  for (int i = 0; i < 13; ++i) { const int q = ql_ + 64 * i; iq[i] = (u32x4){0u, 0u, 0u, 0u};
                      if (q < 792) { const int arr = q / 264, rem = q - arr * 264, row = rem >> 3, cc = rem & 7;
                          if (!(first && row == 0)) iq[i] = *(const u32x4*)(PROJ + (size_t)(t0 - 1 + row) * LDP + arr * RW + h * HS + cc * 8); } }
#pragma unroll
                  for (int i = 0; i < 13; ++i) { const int q = ql_ + 64 * i; if (q < 792) { const int arr = q / 264, rem = q - arr * 264, row = rem >> 3, cc = rem & 7;
                      *(__attribute__((address_space(3))) u32x4*)(tin + arr * 2376 + row * 72 + cc * 8) = iq[i]; } } }
                __builtin_amdgcn_wave_barrier(); asm volatile("s_waitcnt lgkmcnt(0)" ::: "memory");
                float ssq[16], bsm[16];
#pragma unroll
                for (int e = 0; e < 16; ++e) { ssq[e] = 0.f; bsm[e] = 0.f; }
#pragma unroll 1
                for (int rt = 0; rt < 2; ++rt) {
                    f32x16 accW, accA, accG, accV;
#pragma unroll
                    for (int e = 0; e < 16; ++e) { accW[e] = 0.f; accA[e] = 0.f; accG[e] = 0.f; accV[e] = 0.f; }
                    int c = h * HS + rt * 32 + r32;
int hh8 = 8 * hh; asm volatile("" : "+v"(c), "+v"(hh8));
                    const LAS bf16* lrow = lin + r32 * LST + 8 * hh;
                    { bf16x8_t wf[18];
#pragma unroll
                      for (int ks = 0; ks < 4; ++ks) { wf[ks] = *(const bf16x8_t*)(wupT + (size_t)c * DL + ks * 16 + hh8); wf[4 + ks] = *(const bf16x8_t*)(aupT + (size_t)c * AL + ks * 16 + hh8); }
#pragma unroll
                      for (int ks = 0; ks < 8; ++ks) wf[8 + ks] = *(const bf16x8_t*)(gupT + (size_t)c * GL + ks * 16 + hh8);
                      wf[16] = bf16x8_t{}; wf[17] = bf16x8_t{};
                      if (l > 0) { wf[16] = *(const bf16x8_t*)(vupT + (size_t)c * MVL + hh8); wf[17] = *(const bf16x8_t*)(vupT + (size_t)c * MVL + 16 + hh8); }
#pragma unroll
                      for (int ks = 0; ks < 4; ++ks) { accW = __builtin_amdgcn_mfma_f32_32x32x16_bf16(*(const LAS bf16x8_t*)(lrow + ks * 16), wf[ks], accW, 0, 0, 0);
                                                       accA = __builtin_amdgcn_mfma_f32_32x32x16_bf16(*(const LAS bf16x8_t*)(lrow + 64 + ks * 16), wf[4 + ks], accA, 0, 0, 0); }
#pragma unroll
                      for (int ks = 0; ks < 8; ++ks) accG = __builtin_amdgcn_mfma_f32_32x32x16_bf16(*(const LAS bf16x8_t*)(lrow + 128 + ks * 16), wf[8 + ks], accG, 0, 0, 0);
                      if (l > 0) {
#pragma unroll
                          for (int ks = 0; ks < 2; ++ks) accV = __builtin_amdgcn_mfma_f32_32x32x16_bf16(*(const LAS bf16x8_t*)(lrow + 256 + ks * 16), wf[16 + ks], accV, 0, 0, 0); } }
                    const float mur = mu[c], muk = mu[RW + c], muv = mu[2 * RW + c], w0c = w0p[c], a0c = a0p[c], kkc = kkp[c], kac = kap[c], rkc = rkp[c];
                    const float v0c = l > 0 ? v0p[c] : 0.f;
#pragma unroll
                    for (int eb = 0; eb < 16; eb += 4) {
                        bf16 lr[4], lk[4], lv[4], lrp[4], lkp[4], lvp[4], lvf[4];
#pragma unroll
                        for (int i = 0; i < 4; ++i) { const int e = eb + i; const int tok = (e & 3) + 8 * (e >> 2) + 4 * hh, t = t0 + tok; const int ci = rt * 32 + r32;
                            lr[i] = tin[(tok + 1) * 72 + ci]; lk[i] = tin[2376 + (tok + 1) * 72 + ci]; lv[i] = tin[2 * 2376 + (tok + 1) * 72 + ci];
                            lrp[i] = tin[tok * 72 + ci]; lkp[i] = tin[2376 + tok * 72 + ci]; lvp[i] = tin[2 * 2376 + tok * 72 + ci];
                            lvf[i] = l > 0 ? V0[(size_t)t * RW + c] : (bf16)0; }
                        __builtin_amdgcn_sched_barrier(0);
#pragma unroll
                        for (int i = 0; i < 4; ++i) { const int e = eb + i; const int tok = (e & 3) + 8 * (e >> 2) + 4 * hh, t = t0 + tok; const size_t o = (size_t)t * RW + c;
                            float r = bf2f(lr[i]), k = bf2f(lk[i]), v = bf2f(lv[i]);
                            r += (bf2f(lrp[i]) - r) * mur; k += (bf2f(lkp[i]) - k) * muk; v += (bf2f(lvp[i]) - v) * muv;
                            const float z = -(w0c + accW[e]); const float sp = fmaxf(z, 0.f) + __logf(1.f + __expf(-fabsf(z)));
                            const float decay = __expf(-__expf(-sp - 0.5f));
                            const float a = __builtin_amdgcn_rcpf(1.f + __expf(-(a0c + accA[e]))); const float g = accG[e];
                            if (l > 0) { const float vfv = bf2f(lvf[i]); v = v + (vfv - v) * __builtin_amdgcn_rcpf(1.f + __expf(-(v0c + accV[e]))); }
                            const float kk = k * kkc; const float k2 = k * (1.f + (a - 1.f) * kac);
                            ssq[e] += kk * kk; bsm[e] += r * k2 * rkc;
                            { const unsigned p0_ = cvtpk(r, k2), p1_ = cvtpk(kk, kk * a), p2_ = cvtpk(g, v * g), p3_ = cvtpk(v, 0.f);
                              RKp[o] = p0_; KKBp[o] = p1_; __builtin_nontemporal_store(p2_, GBGp + o);     Vl[o] = (bf16)p3_; Wd[o] = decay; }
                        }
                    }
                }
#pragma unroll
                for (int e = 0; e < 16; ++e) { const int ln_ = r32 | (hh << 5); float a_ = red16(ssq[e]), b_ = red16(bsm[e]); a_ += shflx(a_, ln_, 16); b_ += shflx(b_, ln_, 16); ssq[e] = a_; bsm[e] = b_; }
                if (r32 == 0) {
#pragma unroll
                    for (int e = 0; e < 16; ++e) { const int tok = (e & 3) + 8 * (e >> 2) + 4 * hh; INVN[(size_t)(t0 + tok) * NH + h] = rsqrtf(fmaxf(ssq[e], 1e-24f)); BSUM[(size_t)(t0 + tok) * NH + h] = bsm[e]; } }
            }
        }
        if (IN(pb + 2) && IN(pb + 3)) { asm volatile("s_waitcnt vmcnt(0)" ::: "memory"); __syncthreads(); }

        if (IN(pb + 3)) { PHASE_IDS
            const bf16* Vl = l == 0 ? V0 : V1;
            const int r32 = lane & 31, hh = lane >> 5;
            if (wave < 6) {
                lbf16* At = (lbf16*)(lds + wave * 23552); lbf16* Bt = At + 2304; lbf16* Kt = Bt + 2304; lbf16* Rt = Kt + 2304; lbf16* Vv = Rt + 2304;
                LAS float* PCs = (LAS float*)(lds + wave * 23552 + 23040);
                const int ntl = bx < T / 32 ? (T / 32 - bx + G - 1) / G : 0;
                for (int q = wave; q < ntl * NH; q += 6) {
                    const int tile = bx + (q >> 3) * G, h = q & 7, b = tile >> 7, chunk = tile & 127, bh = b * NH + h, item = bh * (SEQ / 32) + chunk; const size_t t0 = (size_t)tile * 32;
                    __builtin_amdgcn_wave_barrier(); asm volatile("s_waitcnt lgkmcnt(0)" ::: "memory");
                    {
                      const int tk = lane >> 3, part = lane & 7;
                      u32x4 qr[4], qk[4], qv[4], qkk[4], qb[4]; f32x4 qw0[4], qw1[4]; float qin[4];
#pragma unroll
                      for (int p4 = 0; p4 < 4; ++p4) { const size_t o = (t0 + p4 * 8 + tk) * RW + h * HS + part * 8;
                          qr[p4] = __builtin_nontemporal_load((const u32x4*)(RKp + o)); qk[p4] = __builtin_nontemporal_load((const u32x4*)(RKp + o + 4)); qv[p4] = __builtin_nontemporal_load((const u32x4*)(Vl + o)); qkk[p4] = __builtin_nontemporal_load((const u32x4*)(KKBp + o)); qb[p4] = __builtin_nontemporal_load((const u32x4*)(KKBp + o + 4));
                          qw0[p4] = __builtin_nontemporal_load((const f32x4*)(Wd + o)); qw1[p4] = __builtin_nontemporal_load((const f32x4*)(Wd + o + 4));     qin[p4] = INVN[(t0 + p4 * 8 + tk) * NH + h]; }
                      LAS float* Pl = (LAS float*)At;
#pragma unroll
                      for (int p4 = 0; p4 < 4; ++p4) { *(LAS f32x4*)(Pl + (p4 * 8 + tk) * 64 + part * 8) = qw0[p4]; *(LAS f32x4*)(Pl + (p4 * 8 + tk) * 64 + part * 8 + 4) = qw1[p4]; }
                      __builtin_amdgcn_wave_barrier(); asm volatile("s_waitcnt lgkmcnt(0)" ::: "memory");
                      { float P = 1.f;
#pragma unroll 8
                        for (int c = 0; c < 32; ++c) { P *= Pl[c * 64 + lane]; Pl[c * 64 + lane] = P; }
                        PCs[lane] = P; }
                      __builtin_amdgcn_wave_barrier(); asm volatile("s_waitcnt lgkmcnt(0)" ::: "memory");
                      u32x4 oa[4], orr[4], ob_[4], ok_[4];
#pragma unroll
                      for (int p4 = 0; p4 < 4; ++p4) { const int c = p4 * 8 + tk;
                          const f32x4 pa = *(const LAS f32x4*)(Pl + c * 64 + part * 8), pb2 = *(const LAS f32x4*)(Pl + c * 64 + part * 8 + 4);
                          f32x4 ma = {1.f, 1.f, 1.f, 1.f}, mb = ma; if (c > 0) { ma = *(const LAS f32x4*)(Pl + (c - 1) * 64 + part * 8); mb = *(const LAS f32x4*)(Pl + (c - 1) * 64 + part * 8 + 4); }
                          const float Pc[8] = {pa.x, pa.y, pa.z, pa.w, pb2.x, pb2.y, pb2.z, pb2.w}, Pm[8] = {ma.x, ma.y, ma.z, ma.w, mb.x, mb.y, mb.z, mb.w};
                          const unsigned rk_[8] = {qr[p4].x, qr[p4].y, qr[p4].z, qr[p4].w, qk[p4].x, qk[p4].y, qk[p4].z, qk[p4].w}, kb_[8] = {qkk[p4].x, qkk[p4].y, qkk[p4].z, qkk[p4].w, qb[p4].x, qb[p4].y, qb[p4].z, qb[p4].w};
                          unsigned xa[4], xr[4], xb[4], xk[4]; const float inv = qin[p4];
#pragma unroll
                          for (int i = 0; i < 4; ++i) { const float ip0 = __builtin_amdgcn_rcpf(Pc[2 * i]), ip1 = __builtin_amdgcn_rcpf(Pc[2 * i + 1]);
                              xa[i] = pk2(-__uint_as_float(kb_[2 * i] << 16) * inv * Pm[2 * i], -__uint_as_float(kb_[2 * i + 1] << 16) * inv * Pm[2 * i + 1]);
                              xr[i] = pk2(__uint_as_float(rk_[2 * i] << 16) * Pc[2 * i], __uint_as_float(rk_[2 * i + 1] << 16) * Pc[2 * i + 1]);
                              xb[i] = pk2(__uint_as_float(kb_[2 * i] & 0xffff0000u) * inv * ip0, __uint_as_float(kb_[2 * i + 1] & 0xffff0000u) * inv * ip1);
                              xk[i] = pk2(__uint_as_float(rk_[2 * i] & 0xffff0000u) * ip0, __uint_as_float(rk_[2 * i + 1] & 0xffff0000u) * ip1); }
                          oa[p4] = (u32x4){xa[0], xa[1], xa[2], xa[3]}; orr[p4] = (u32x4){xr[0], xr[1], xr[2], xr[3]}; ob_[p4] = (u32x4){xb[0], xb[1], xb[2], xb[3]}; ok_[p4] = (u32x4){xk[0], xk[1], xk[2], xk[3]}; }
                      __builtin_amdgcn_wave_barrier(); asm volatile("s_waitcnt lgkmcnt(0)" ::: "memory");
#pragma unroll
                      for (int p4 = 0; p4 < 4; ++p4) { const int c = p4 * 8 + tk, o = c * 72 + part * 8;
                          *(__attribute__((address_space(3))) u32x4*)(At + o) = oa[p4]; *(__attribute__((address_space(3))) u32x4*)(Rt + o) = orr[p4]; *(__attribute__((address_space(3))) u32x4*)(Bt + o) = ob_[p4];
                          *(__attribute__((address_space(3))) u32x4*)(Kt + o) = ok_[p4]; *(__attribute__((address_space(3))) u32x4*)(Vv + o) = qv[p4]; } }
                    __builtin_amdgcn_wave_barrier(); asm volatile("s_waitcnt lgkmcnt(0)" ::: "memory");
                    const f32x16 zero16 = {0.f, 0.f, 0.f, 0.f, 0.f, 0.f, 0.f, 0.f, 0.f, 0.f, 0.f, 0.f, 0.f, 0.f, 0.f, 0.f};
                    f32x16 X = zero16, Yt = zero16;
#pragma unroll
                    for (int ks = 0; ks < 4; ++ks) { const bf16x8_t fa = ldrow(At, r32, ks, hh), fb = ldrow(Bt, r32, ks, hh); X = mm32(fa, fb, X); Yt = mm32(fb, fa, Yt); }
#pragma unroll
                    for (int e = 0; e < 16; ++e) { const int ri = rowidx(e, hh); X[e] = (r32 < ri) ? X[e] : 0.f; Yt[e] = (ri < r32) ? Yt[e] : 0.f; }
                    f32x16 TY = Yt;
#pragma unroll
                    for (int e = 0; e < 16; ++e) TY[e] += (rowidx(e, hh) == r32) ? 1.f : 0.f;
#pragma unroll 1
                    for (int it = 0; it < 4; ++it) {
                        const bf16x8_t x0 = accop<0>(X), x1 = accop<1>(X), y0 = accop<0>(Yt), y1 = accop<1>(Yt);
                        f32x16 Xn = mm32(y0, x0, zero16); Xn = mm32(y1, x1, Xn);
                        f32x16 Yn = mm32(x0, y0, zero16); Yn = mm32(x1, y1, Yn);
                        X = Xn; Yt = Yn;
                        const bf16x8_t p0 = accop<0>(X), p1 = accop<1>(X), t0_ = accop<0>(TY), t1_ = accop<1>(TY);
                        TY = mm32(p0, t0_, TY); TY = mm32(p1, t1_, TY);
                    }
                    const bf16x8_t ty0 = accop<0>(TY), ty1 = accop<1>(TY);
                    unsigned char* rec = SCN + (size_t)item * 24576;
                    const bf16x8_t v00 = ldpermcol<0>(Vv, r32, hh), v01 = ldpermcol<1>(Vv, r32, hh), v10 = ldpermcol<0>(Vv, 32 + r32, hh), v11 = ldpermcol<1>(Vv, 32 + r32, hh);
                    f32x16 U0a, U0b;
                    { f32x16 G2T = zero16;
#pragma unroll
                      for (int ks = 0; ks < 4; ++ks) G2T = mm32(ldrow(Kt, r32, ks, hh), ldrow(At, r32, ks, hh), G2T);
#pragma unroll
                      for (int e = 0; e < 16; ++e) G2T[e] = (rowidx(e, hh) < r32) ? G2T[e] : 0.f;
                      const bf16x8_t g0 = accop<0>(G2T), g1 = accop<1>(G2T);
                      f32x16 Za = mm32(g0, v00, zero16); Za = mm32(g1, v01, Za); f32x16 Zb = mm32(g0, v10, zero16); Zb = mm32(g1, v11, Zb);
                      U0a = mm32(ty0, accop<0>(Za), zero16); U0a = mm32(ty1, accop<1>(Za), U0a); U0b = mm32(ty0, accop<0>(Zb), zero16); U0b = mm32(ty1, accop<1>(Zb), U0b); }
                    const bf16x8_t ua0 = accop<0>(U0a), ua1 = accop<1>(U0a), ub0 = accop<0>(U0b), ub1 = accop<1>(U0b);
                    f32x16 G3T = zero16;
                    { f32x16 G4T = zero16;
#pragma unroll
                      for (int ks = 0; ks < 4; ++ks) { const bf16x8_t fr = ldrow(Rt, r32, ks, hh); G3T = mm32(ldrow(Bt, r32, ks, hh), fr, G3T); G4T = mm32(ldrow(Kt, r32, ks, hh), fr, G4T); }
#pragma unroll
                      for (int e = 0; e < 16; ++e) { const bool keep = rowidx(e, hh) <= r32; G3T[e] = keep ? G3T[e] : 0.f; G4T[e] = keep ? G4T[e] : 0.f; }
                      const bf16x8_t g30 = accop<0>(G3T), g31 = accop<1>(G3T), g40 = accop<0>(G4T), g41 = accop<1>(G4T);
                      f32x16 Ya = mm32(g30, ua0, zero16); Ya = mm32(g31, ua1, Ya); Ya = mm32(g40, v00, Ya); Ya = mm32(g41, v01, Ya);
                      f32x16 Yb = mm32(g30, ub0, zero16); Yb = mm32(g31, ub1, Yb); Yb = mm32(g40, v10, Yb); Yb = mm32(g41, v11, Yb);
                      u32x4 o0, o1;
                      o0.x = cvtpk(Ya[0], Ya[1]); o0.y = cvtpk(Ya[2], Ya[3]); o0.z = cvtpk(Ya[4], Ya[5]); o0.w = cvtpk(Ya[6], Ya[7]);
                      o1.x = cvtpk(Ya[8], Ya[9]); o1.y = cvtpk(Ya[10], Ya[11]); o1.z = cvtpk(Ya[12], Ya[13]); o1.w = cvtpk(Ya[14], Ya[15]);
                      *(u32x4*)(rec + 12288 + 4096 + lane * 32) = o0; *(u32x4*)(rec + 12288 + 4096 + lane * 32 + 16) = o1;
                      o0.x = cvtpk(Yb[0], Yb[1]); o0.y = cvtpk(Yb[2], Yb[3]); o0.z = cvtpk(Yb[4], Yb[5]); o0.w = cvtpk(Yb[6], Yb[7]);
                      o1.x = cvtpk(Yb[8], Yb[9]); o1.y = cvtpk(Yb[10], Yb[11]); o1.z = cvtpk(Yb[12], Yb[13]); o1.w = cvtpk(Yb[14], Yb[15]);
                      *(u32x4*)(rec + 12288 + 6144 + 4096 + lane * 32) = o0; *(u32x4*)(rec + 12288 + 6144 + 4096 + lane * 32 + 16) = o1; }
                    f32x16 Wa0 = mm32(ty0, ldpermcol<0>(At, r32, hh), zero16); Wa0 = mm32(ty1, ldpermcol<1>(At, r32, hh), Wa0);
                    f32x16 Wa1 = mm32(ty0, ldpermcol<0>(At, 32 + r32, hh), zero16); Wa1 = mm32(ty1, ldpermcol<1>(At, 32 + r32, hh), Wa1);
                    const bf16x8_t wa00 = accop<0>(Wa0), wa01 = accop<1>(Wa0), wa10 = accop<0>(Wa1), wa11 = accop<1>(Wa1);
                    { const bf16x8_t g30 = accop<0>(G3T), g31 = accop<1>(G3T);
                      f32x16 Ra = mm32(wa00, g30, zero16); Ra = mm32(wa01, g31, Ra); f32x16 Rb_ = mm32(wa10, g30, zero16); Rb_ = mm32(wa11, g31, Rb_);
#pragma unroll
                      for (int e = 0; e < 16; ++e) { const int kr = rowidx(e, hh); Ra[e] += bf2f(Rt[r32 * 72 + kr]); Rb_[e] += bf2f(Rt[r32 * 72 + 32 + kr]); }
                      *(bf16x8_t*)(rec + 8192 + 0 * 1024 + lane * 16) = accop<0>(Ra); *(bf16x8_t*)(rec + 8192 + 1 * 1024 + lane * 16) = accop<1>(Ra);
                      *(bf16x8_t*)(rec + 8192 + 2 * 1024 + lane * 16) = accop<0>(Rb_); *(bf16x8_t*)(rec + 8192 + 3 * 1024 + lane * 16) = accop<1>(Rb_); }
                    const bf16x8_t b00 = ldpermcol<0>(Bt, r32, hh), b01 = ldpermcol<1>(Bt, r32, hh), b10 = ldpermcol<0>(Bt, 32 + r32, hh), b11 = ldpermcol<1>(Bt, 32 + r32, hh);
                    { const float pc0 = PCs[r32], pc1 = PCs[32 + r32];
#pragma unroll
                      for (int ij = 0; ij < 4; ++ij) { const int i = ij >> 1, j = ij & 1;
                          f32x16 M = mm32(i ? wa10 : wa00, j ? b10 : b00, zero16); M = mm32(i ? wa11 : wa01, j ? b11 : b01, M);
#pragma unroll
                          for (int e = 0; e < 16; ++e) { float m = M[e]; if (i == j) m += (rowidx(e, hh) == r32) ? 1.f : 0.f; M[e] = m * (j ? pc1 : pc0); }
                          *(bf16x8_t*)(rec + (ij * 2 + 0) * 1024 + lane * 16) = accop<0>(M); *(bf16x8_t*)(rec + (ij * 2 + 1) * 1024 + lane * 16) = accop<1>(M); } }
                    { const bf16x8_t k00 = ldpermcol<0>(Kt, r32, hh), k01 = ldpermcol<1>(Kt, r32, hh), k10 = ldpermcol<0>(Kt, 32 + r32, hh), k11 = ldpermcol<1>(Kt, 32 + r32, hh);
#pragma unroll
                      for (int ju = 0; ju < 4; ++ju) { const int j = ju >> 1, u = ju & 1;
                          f32x16 Dm = mm32(j ? b10 : b00, u ? ub0 : ua0, zero16); Dm = mm32(j ? b11 : b01, u ? ub1 : ua1, Dm);
                          Dm = mm32(j ? k10 : k00, u ? v10 : v00, Dm); Dm = mm32(j ? k11 : k01, u ? v11 : v01, Dm);
#pragma unroll
                          for (int e = 0; e < 16; ++e) Dm[e] *= PCs[32 * j + rowidx(e, hh)];
                          u32x4 o0, o1;
                          o0.x = cvtpk(Dm[0], Dm[1]); o0.y = cvtpk(Dm[2], Dm[3]); o0.z = cvtpk(Dm[4], Dm[5]); o0.w = cvtpk(Dm[6], Dm[7]);
                          o1.x = cvtpk(Dm[8], Dm[9]); o1.y = cvtpk(Dm[10], Dm[11]); o1.z = cvtpk(Dm[12], Dm[13]); o1.w = cvtpk(Dm[14], Dm[15]);
                          *(u32x4*)(rec + 12288 + u * 6144 + j * 2048 + lane * 32) = o0; *(u32x4*)(rec + 12288 + u * 6144 + j * 2048 + lane * 32 + 16) = o1; } }
                }
            }
        }
        { XcdBarrier xb_ = xbar; asm volatile("" : "+s"(xb_.bar)); xcd_barrier<false>(xb_); }
        if (IN(pb + 3)) { PHASE_IDS
            const int r32 = lane & 31, hh = lane >> 5;
            constexpr int SLOT = 18432, NCH = SEQ / 32, NSL = 7, AHEAD = 5;
            const bool spare = G > BATCH * NH * 2; const int cw = spare ? bx - BATCH * NH * 2 : bx, cn = spare ? G - BATCH * NH * 2 : G;
            if (cw >= 0) {
                for (int i = cw * NTHR + tid; i < BATCH * D; i += cn * NTHR) { const int b = i / D, d = i % D; S2V[(size_t)l * BATCH * D + i] = INP(24)[l * D + d] * (1.f + modl[(size_t)b * 6 * D + 4 * D + d]); }
                for (int n = cw * NWAVES + wave; n < PH * PQ; n += cn * NWAVES) {
                    const bf16* wr_ = PqT + (size_t)l * PH * PQ * D + ((size_t)((n >> 8) * (D >> 6) + (lane >> 2)) * 256 + (n & 255)) * 64 + (lane & 3) * 16;     const u32x4 w0 = *(const u32x4*)wr_, w1 = *(const u32x4*)(wr_ + 8);
                    const unsigned ww[8] = {w0.x, w0.y, w0.z, w0.w, w1.x, w1.y, w1.z, w1.w};
#pragma unroll
                    for (int b = 0; b < BATCH; ++b) { const float* sh = modl + (size_t)b * 6 * D + 3 * D + lane * 16; float a = 0.f;
#pragma unroll
                        for (int q = 0; q < 4; ++q) { const f32x4 sv_ = *(const f32x4*)(sh + q * 4);
                            a += sv_.x * __uint_as_float(ww[2 * q] << 16) + sv_.y * __uint_as_float(ww[2 * q] & 0xffff0000u) + sv_.z * __uint_as_float(ww[2 * q + 1] << 16) + sv_.w * __uint_as_float(ww[2 * q + 1] & 0xffff0000u); }
                        a = wave_sum(a, lane); if (lane == 0) CVEC[(size_t)l * BATCH * PH * PQ + (size_t)b * PH * PQ + n] = a; } }
#pragma unroll 1
            for (int ps_ = 0; ps_ < 2; ++ps_) {
            if (((ps_ ^ (cw >> 3)) & 1) == 0) {
                convert_tables_fp6(INP(27), INP(28), U8, V8, USc, VSc, l, cw * NWAVES + wave, cn * NWAVES, lane, CONV_S1_ROWS, 2 * NEXP);
            } else
            {
                constexpr int DST = 520;
                int lane_p; asm volatile("v_mbcnt_lo_u32_b32 %0, -1, 0\n\tv_mbcnt_hi_u32_b32 %0, -1, %0" : "=v"(lane_p)); const int r32 = lane_p & 31, hh = lane_p >> 5, tidp = wave0 * 64 + lane_p;
                lbf16* dlb = (lbf16*)lds;
                lbf16* pin = (lbf16*)(lds + 33280);
                const int c = tidp, g = c >> 7, win = 2 << g;
                const bf16* pwt = PWT + (size_t)(l * 4 + (wave >> 1)) * PG * PG; const float* psc = INP(22) + l * PW;
                for (int tile = cw; tile < T / 32; tile += cn) {
                    const int t0 = tile * 32; const bool first = (t0 % SEQ) == 0;
                    __syncthreads();
                    { u32x4 pq[6];
#pragma unroll
                      for (int q = 0; q < 6; ++q) { const int ch = tidp + q * NTHR, row = ch >> 6, cc = ch & 63; pq[q] = (u32x4){0u, 0u, 0u, 0u};
                          if (ch < 47 * 64 && (row >= 15 || !first)) pq[q] = *(const u32x4*)(POOLIN + (size_t)(t0 - 15 + row) * PW + cc * 8); }
#pragma unroll
                      for (int q = 0; q < 6; ++q) { const int ch = tidp + q * NTHR, row = ch >> 6, cc = ch & 63; if (ch < 47 * 64) *(__attribute__((address_space(3))) u32x4*)(pin + row * 520 + cc * 8) = pq[q]; } }
                    __syncthreads();
                    const lbf16* pc = pin + c;
                    float sw = 0.f;
#pragma unroll
                    for (int j = 1; j <= 15; ++j) sw += (j < win) ? bf2f(pc[(15 - j) * 520]) : 0.f;
                    const float invw = 1.f / (float)win;
#pragma unroll 8
                    for (int i = 0; i < 32; ++i) {
                        const float cur = bf2f(pc[(15 + i) * 520]);
                        sw += cur;
                        const float inv = (first && i < 15) ? 1.f / (float)min(i + 1, win) : invw;
                        dlb[i * DST + c] = f2bf(sw * inv - cur);
                        sw -= bf2f(pc[(15 + i - win + 1) * 520]);
                    }
                    __syncthreads();
                    const int gg = wave >> 1, half = wave & 1;
#pragma unroll
                    for (int ct = 0; ct < 2; ++ct) {
                        const int dd0 = half * 64 + ct * 32;
                        f32x16 acc;
#pragma unroll
                        for (int e = 0; e < 16; ++e) acc[e] = 0.f;
#pragma unroll
                        for (int ks = 0; ks < 8; ++ks) { const bf16x8_t a = *(const __attribute__((address_space(3))) bf16x8_t*)(dlb + r32 * DST + gg * PG + ks * 16 + 8 * hh);
                            const bf16x8_t w = *(const bf16x8_t*)(pwt + (size_t)(dd0 + r32) * PG + ks * 16 + 8 * hh); acc = mm32(a, w, acc); }
                        const int oc = gg * PG + dd0 + r32; const float ps = psc[oc];
#pragma unroll
                        for (int e = 0; e < 16; ++e) MIX[(size_t)(t0 + rowidx(e, hh)) * D + RW + oc] = f2bf(acc[e] * ps);
                    }
                }
            }
            }
            }
            for (int un = bx; un < BATCH * NH * 2; un += G) {
                const int bh = un >> 1, u = un & 1, b = bh >> 3, h = bh & 7;
                __syncthreads();
                const unsigned char* recs = SCN + (size_t)bh * NCH * 24576;
                const int lw = wave - 2;
#define S2_DMA(chunk_) do { if (wave >= 2) { LAS unsigned char* sl = lds + ((chunk_) % NSL) * SLOT; const unsigned char* rp = recs + (size_t)(chunk_) * 24576 + lane * 16; \
                    _Pragma("unroll") for (int q_ = 0; q_ < 3; ++q_) { const int p_ = lw * 3 + q_; const int so_ = p_ < 12 ? p_ * 1024 : 12288 + u * 6144 + (p_ - 12) * 1024; \
                        __builtin_amdgcn_global_load_lds((const unsigned*)(rp + so_), (LAS unsigned*)(sl + p_ * 1024), 16, 0, 0); } } } while (0)
#pragma unroll 1
                for (int c0 = 0; c0 < AHEAD; ++c0) S2_DMA(c0);
                asm volatile("s_waitcnt vmcnt(12)" ::: "memory");
                __builtin_amdgcn_s_barrier();
                f32x16 X0, X1;
                { float z_ = 0.f; asm volatile("" : "+v"(z_));
#pragma unroll
                for (int e = 0; e < 16; ++e) { X0[e] = z_; X1[e] = z_; } }
#define S2_FRAG(off) (*(const __attribute__((address_space(3))) bf16x8_t*)(sl + (off) + lane * 16))
#define S2_UNPK(dst, off) do { const u32x4 a0 = *(const LAS u32x4*)(sl + (off) + lane * 32), a1 = *(const LAS u32x4*)(sl + (off) + lane * 32 + 16); const unsigned wv[8] = {a0.x, a0.y, a0.z, a0.w, a1.x, a1.y, a1.z, a1.w}; \
                    _Pragma("unroll") for (int q = 0; q < 8; ++q) { (dst)[2 * q] = __uint_as_float(wv[q] << 16); (dst)[2 * q + 1] = __uint_as_float(wv[q] & 0xffff0000u); } } while (0)
                LAS unsigned char* xbuf = lds + NSL * SLOT;
#define S2_YOUT(nn_) do { const LAS unsigned char* sl = lds + ((nn_) % NSL) * SLOT; const LAS unsigned char* xb_ = xbuf + ((nn_) & 1) * 4096 + lane * 16; \
                        const bf16x8_t x00 = *(const LAS bf16x8_t*)(xb_), x01 = *(const LAS bf16x8_t*)(xb_ + 1024), x10 = *(const LAS bf16x8_t*)(xb_ + 2048), x11 = *(const LAS bf16x8_t*)(xb_ + 3072); \
                        f32x16 Yc; S2_UNPK(Yc, 12288 + 4096); \
                        Yc = mm32(S2_FRAG(8192 + 0 * 1024), x00, Yc); Yc = mm32(S2_FRAG(8192 + 1 * 1024), x01, Yc); Yc = mm32(S2_FRAG(8192 + 2 * 1024), x10, Yc); Yc = mm32(S2_FRAG(8192 + 3 * 1024), x11, Yc); \
                        float* yp = Y + ((size_t)b * SEQ + (size_t)(nn_) * 32) * RW + h * HS + u * 32 + r32; \
                        _Pragma("unroll") for (int e = 0; e < 16; ++e) yp[(size_t)rowidx(e, hh) * RW] = Yc[e]; } while (0)
#pragma unroll 1
                for (int n = 0; n < NCH; ++n) {
                    if (n + AHEAD < NCH) S2_DMA(n + AHEAD);
                    if (wave == 0) {
                        const LAS unsigned char* sl = lds + (n % NSL) * SLOT;
                        const bf16x8_t x00 = accop<0>(X0), x01 = accop<1>(X0), x10 = accop<0>(X1), x11 = accop<1>(X1);
                        { LAS unsigned char* xb_ = xbuf + (n & 1) * 4096 + lane * 16; *(LAS bf16x8_t*)(xb_) = x00; *(LAS bf16x8_t*)(xb_ + 1024) = x01; *(LAS bf16x8_t*)(xb_ + 2048) = x10; *(LAS bf16x8_t*)(xb_ + 3072) = x11; }
                        f32x16 N0, N1;
                        S2_UNPK(N0, 12288); S2_UNPK(N1, 12288 + 2048);
                        N0 = mm32(S2_FRAG((0 * 2 + 0) * 1024), x00, N0); N1 = mm32(S2_FRAG((1 * 2 + 0) * 1024), x00, N1); N0 = mm32(S2_FRAG((0 * 2 + 1) * 1024), x01, N0); N1 = mm32(S2_FRAG((1 * 2 + 1) * 1024), x01, N1);
                        N0 = mm32(S2_FRAG((2 * 2 + 0) * 1024), x10, N0); N1 = mm32(S2_FRAG((3 * 2 + 0) * 1024), x10, N1); N0 = mm32(S2_FRAG((2 * 2 + 1) * 1024), x11, N0); N1 = mm32(S2_FRAG((3 * 2 + 1) * 1024), x11, N1);
                        X0 = N0; X1 = N1;
                        asm volatile("s_waitcnt lgkmcnt(0)" ::: "memory");
                    } else if (wave == 1) {
                        if (n > 0) S2_YOUT(n - 1);
                        asm volatile("s_waitcnt lgkmcnt(0)" ::: "memory");
                    } else {
                        const int younger = (NCH - 1 - (n + 1)) < (AHEAD - 1) ? (NCH - 1 - (n + 1)) : (AHEAD - 1);
                        if (younger >= 5) asm volatile("s_waitcnt vmcnt(15)" ::: "memory"); else if (younger == 4) asm volatile("s_waitcnt vmcnt(12)" ::: "memory"); else if (younger == 3) asm volatile("s_waitcnt vmcnt(9)" ::: "memory");
                        else if (younger == 2) asm volatile("s_waitcnt vmcnt(6)" ::: "memory"); else if (younger == 1) asm volatile("s_waitcnt vmcnt(3)" ::: "memory"); else asm volatile("s_waitcnt vmcnt(0)" ::: "memory");
                    }
                    __builtin_amdgcn_s_barrier();
                }
                if (wave == 1) { S2_YOUT(NCH - 1); asm volatile("s_waitcnt lgkmcnt(0)" ::: "memory"); }
#undef S2_YOUT
#undef S2_FRAG
#undef S2_UNPK
#undef S2_DMA
            }
        }
        SEAM(pb + 3);

        if (IN(pb + 4)) { PHASE_IDS
            const int c8 = (tid & 63) * 8, hd = (tid & 63) >> 3, tsub = tid >> 6;
            const f32x4 lg0 = *(const f32x4*)(INP(19) + l * RW + c8), lg1 = *(const f32x4*)(INP(19) + l * RW + c8 + 4), lb0 = *(const f32x4*)(INP(20) + l * RW + c8), lb1 = *(const f32x4*)(INP(20) + l * RW + c8 + 4);
            for (int tile = bx; tile < T / 8; tile += G) {
                const int t = tile * 8 + tsub; const size_t o = (size_t)t * RW + c8;
                const f32x4 y0 = *(const f32x4*)(Y + o), y1 = *(const f32x4*)(Y + o + 4); const u32x4 gq = *(const u32x4*)(GBGp + o), vq = *(const u32x4*)(GBGp + o + 4);     const float bsum = BSUM[(size_t)t * NH + hd];
                float sm = (y0.x + y0.y) + (y0.z + y0.w) + (y1.x + y1.y) + (y1.z + y1.w);
                sm += dppf<0xB1>(sm); sm += dppf<0x4E>(sm); sm += dppf<0x141>(sm);
                const float mean = sm * (1.f / 64.f);
                const f32x4 d0 = y0 - mean, d1 = y1 - mean;
                float sq = (d0.x * d0.x + d0.y * d0.y) + (d0.z * d0.z + d0.w * d0.w) + (d1.x * d1.x + d1.y * d1.y) + (d1.z * d1.z + d1.w * d1.w);
                sq += dppf<0xB1>(sq); sq += dppf<0x4E>(sq); sq += dppf<0x141>(sq);
                const float rs = rsqrtf(sq * (1.f / 64.f) + GN_EPS);
                const f32x4 n0 = d0 * rs * lg0 + lb0, n1 = d1 * rs * lg1 + lb1;
                const unsigned gw_[4] = {gq.x, gq.y, gq.z, gq.w}, vw_[4] = {vq.x, vq.y, vq.z, vq.w}; const float nn[8] = {n0.x, n0.y, n0.z, n0.w, n1.x, n1.y, n1.z, n1.w}; unsigned ow[4];
                const unsigned gb_[8] = {gw_[0], gw_[1], gw_[2], gw_[3], vw_[0], vw_[1], vw_[2], vw_[3]};
#pragma unroll
                for (int i = 0; i < 4; ++i) { const float g0 = __uint_as_float(gb_[2 * i] << 16), g1 = __uint_as_float(gb_[2 * i + 1] << 16), v0 = __uint_as_float(gb_[2 * i] & 0xffff0000u), v1 = __uint_as_float(gb_[2 * i + 1] & 0xffff0000u);
                    ow[i] = pk2(nn[2 * i] * g0 + v0 * bsum, nn[2 * i + 1] * g1 + v1 * bsum); }
                *(u32x4*)(MIX + (size_t)t * D + c8) = (u32x4){ow[0], ow[1], ow[2], ow[3]};
            }
        }
        SEAM(pb + 4);
        if (IN(pb + 5)) { PHASE_IDS
            pg8::Gemm g{MIX, WoutT + (size_t)l * D * D, T, D, D}; pg8::StaticOrder S; S.init(T, D, G, bx);
            pg8::EpiResGate E{XBF, XBF, modl + 2 * D, XB2, S2V + (size_t)l * BATCH * D, SSQ + (size_t)l * T};
            pg8::gemm_phase<pg8::EpiResGate, pg8::StaticOrder, true, true>(lds, g, S, E, tid); }
        SEAM(pb + 5);
        if (IN(pb + 7)) { PHASE_IDS
            pg8::Gemm g{XB2, PqT + (size_t)l * PH * PQ * D, T, PH * PQ, D}; pg8::StaticOrder S; S.init(T, PH * PQ, G, bx);
            pg8::EpiQ E{Q, PH * PQ, CVEC + (size_t)l * BATCH * PH * PQ, SSQ + (size_t)l * T};
            pg8::gemm_phase<pg8::EpiQ, pg8::StaticOrder, true, true>(lds, g, S, E, tid); }
        if (IN(pb + 7) && IN(pb + 8)) { asm volatile("s_waitcnt vmcnt(0)" ::: "memory"); __syncthreads(); }

        if (IN(pb + 8)) { PHASE_IDS
            const bf16* KEYSl = KEYS + (size_t)l * PH * 2 * NKEYS * PHALF;
            LAS unsigned char* scr = lds + wave * 2048 + lane * 32;
            constexpr int KST = 136;
            lbf16* kl = (lbf16*)(lds + 16384);
            const int r = lane & 31, hh = lane >> 5;
            pg8::StaticOrder S; S.init(T, PH * PQ, G, bx);
            for (int ui = 0;; ++ui) { pg8::Unit un_; if (!S.next(ui, un_)) break;
                const int h = un_.pn, tok = un_.pm * 256 + wave * 32 + r;
                __syncthreads();
                { u32x4 kq[8];
#pragma unroll
                  for (int q = 0; q < 8; ++q) { const int ch = tid + q * NTHR; kq[q] = *(const u32x4*)(KEYSl + (size_t)(h * 2) * NKEYS * PHALF + (size_t)ch * 8); }
#pragma unroll
                  for (int q = 0; q < 8; ++q) { const int ch = tid + q * NTHR, row = ch >> 4, cc = ch & 15; *(__attribute__((address_space(3))) u32x4*)(kl + row * KST + cc * 8) = kq[q]; } }
                __syncthreads();
                unsigned sp0[16], sp1[16];
#pragma unroll
                for (int e = 0; e < 16; ++e) { sp0[e] = 0u; sp1[e] = 0u; }
#pragma unroll 1
                for (int p = 0; p < 2; ++p) {
                    const bf16* qp = Q + (size_t)tok * (PH * PQ) + h * PQ + p * PHALF + 8 * hh;
                    const lbf16* kp_ = kl + (p * NKEYS + r) * KST + 8 * hh;
                    bf16x8_t bq[8];
#pragma unroll
                    for (int ks = 0; ks < 8; ++ks) bq[ks] = *(const bf16x8_t*)(qp + ks * 16);
                    unsigned best[16];
#pragma unroll
                    for (int e = 0; e < 16; ++e) best[e] = 0u;
#pragma unroll 1
                    for (int kt = 0; kt < 4; ++kt) {
                        f32x16 acc;
#pragma unroll
                        for (int e = 0; e < 16; ++e) acc[e] = 0.f;
#pragma unroll
                        for (int ks = 0; ks < 8; ++ks) { const bf16x8_t ak = *(const __attribute__((address_space(3))) bf16x8_t*)(kp_ + kt * 32 * KST + ks * 16); acc = __builtin_amdgcn_mfma_f32_32x32x16_bf16(ak, bq[ks], acc, 0, 0, 0); }
                        unsigned g[16];
#pragma unroll
                        for (int e = 0; e < 16; ++e) g[e] = pack_key7(acc[e], kt * 32 + (e & 3) + 8 * (e >> 2) + 4 * hh);
                        sort16_desc(g);
                        merge_top16(best, g);
                    }
                    unsigned ob[16];
#pragma unroll
                    for (int e = 0; e < 16; ++e) ob[e] = shflxu(best[e], lane, 32);
                    merge_top16(best, ob);
#pragma unroll
                    for (int e = 0; e < 16; ++e) { sp0[e] = p == 0 ? best[e] : sp0[e]; sp1[e] = p == 0 ? sp1[e] : best[e]; }
                }
                unsigned c2[32];
                stage2_cands(sp0, sp1, hh, c2);
                sort16_desc(c2); sort16_desc(c2 + 16); merge_top16(c2, c2 + 16);
                { unsigned ob[16];
#pragma unroll
                  for (int e = 0; e < 16; ++e) ob[e] = shflxu(c2[e], lane, 32);
                  merge_top16(c2, ob); }
#pragma unroll
                for (int e = 0; e < 16; e += 4) {
                    *(LAS unsigned*)(scr + e) = (127u - (sp0[e] & 127u)) | ((127u - (sp0[e + 1] & 127u)) << 8) | ((127u - (sp0[e + 2] & 127u)) << 16) | ((127u - (sp0[e + 3] & 127u)) << 24);
                    *(LAS unsigned*)(scr + 16 + e) = (127u - (sp1[e] & 127u)) | ((127u - (sp1[e + 1] & 127u)) << 8) | ((127u - (sp1[e + 2] & 127u)) << 16) | ((127u - (sp1[e + 3] & 127u)) << 24); }
                asm volatile("s_waitcnt lgkmcnt(0)" ::: "memory");
                float sm[16]; int ex[16];
#pragma unroll
                for (int e = 0; e < 16; ++e) { const unsigned key = c2[e]; sm[e] = unpack_key8(key); const int i0 = (key >> 4) & 15, j0 = key & 15; ex[e] = (int)scr[i0] * NKEYS + (int)scr[16 + j0]; }
                float den = 0.f;
#pragma unroll
                for (int e = 0; e < 16; ++e) { sm[e] = __expf(sm[e] - unpack_key8(c2[0])); den += sm[e]; }
                const float inv = 1.f / den;
                if (hh == 0) {
                    int* ip = IDX + (size_t)tok * NE + h * TOPK;
#pragma unroll
                    for (int e = 0; e < 16; e += 4) *(int4*)(ip + e) = make_int4((ex[e] << 16) | (int)f2bf(sm[e] * inv), (ex[e + 1] << 16) | (int)f2bf(sm[e + 1] * inv), (ex[e + 2] << 16) | (int)f2bf(sm[e + 2] * inv), (ex[e + 3] << 16) | (int)f2bf(sm[e + 3] * inv));
                }
                asm volatile("s_waitcnt lgkmcnt(0)" ::: "memory");
            }
        }
        SEAM(pb + 8);

        if (IN(pb + 9)) { PHASE_IDS
            const unsigned char* Ul = U8 + (size_t)l * NEXP * ROWB; const unsigned char* Vtl = V8 + (size_t)l * NEXP * ROWB; const float* usl = USc + l * NEXP; const float* vsl = VSc + l * NEXP; const float* lnf = INP(29);
            const bool fin = (l == DEPTH - 1);
            typedef float f32x2_t __attribute__((ext_vector_type(2)));
            const __amdgpu_buffer_rsrc_t ru = __builtin_amdgcn_make_buffer_rsrc((void*)Ul, 0, NEXP * ROWB, 0x00020000), rv = __builtin_amdgcn_make_buffer_rsrc((void*)Vtl, 0, NEXP * ROWB, 0x00020000);
            typedef float f32x32_t __attribute__((ext_vector_type(32))); typedef unsigned u32x3_t __attribute__((ext_vector_type(3))); typedef unsigned u32x2_t __attribute__((ext_vector_type(2))); typedef unsigned u32x6_t __attribute__((ext_vector_type(6))); typedef unsigned u32x16_t __attribute__((ext_vector_type(16))); typedef __bf16 bf16x2_t __attribute__((ext_vector_type(2)));
            LAS float* pl = (LAS float*)(lds + wave * 18432);
            constexpr int TW = 4;
            for (int tb = gw; tb < T; tb += TW * NGW) {
#define TOKV(k) (tb + (k) * NGW < T)
#define TOK(k) (TOKV(k) ? tb + (k) * NGW : tb)
                unsigned si[TW][2]; float sus[TW][2], sgv[TW][2];
                u32x3_t ba[8], bb_[8];
                int lane_u; asm volatile("v_mbcnt_lo_u32_b32 %0, -1, 0\n\tv_mbcnt_hi_u32_b32 %0, -1, %0" : "=v"(lane_u)); const int voff = lane_u * 12, voff8 = lane_u * 8;
                LAS u32x4* hl = (LAS u32x4*)(pl + 32 * 68);
                { int lane_s; asm volatile("v_mbcnt_lo_u32_b32 %0, -1, 0\n\tv_mbcnt_hi_u32_b32 %0, -1, %0" : "=v"(lane_s));
#pragma unroll
                  for (int k = 0; k < TW; ++k) { const size_t o = (size_t)TOK(k) * NE + lane_s; si[k][0] = (unsigned)__builtin_nontemporal_load(IDX + o); si[k][1] = (unsigned)__builtin_nontemporal_load(IDX + o + 64); }
#pragma unroll
                  for (int kk = 2; kk <= 128; kk <<= 1) {
#pragma unroll
                      for (int j = kk >> 1; j > 0; j >>= 1) {
                          if (j == 64) {
#pragma unroll
                              for (int k = 0; k < TW; ++k) { const unsigned a = si[k][0], b = si[k][1]; si[k][0] = a < b ? a : b; si[k][1] = a < b ? b : a; } }
                          else { const bool lower = (lane_s & j) == 0, tm0 = lower == ((lane_s & kk) == 0), tm1 = lower == (((lane_s + 64) & kk) == 0); const int pa = (lane_s ^ j) << 2;
#pragma unroll
                              for (int k = 0; k < TW; ++k) { const unsigned a = si[k][0], b = si[k][1], p0 = (unsigned)__builtin_amdgcn_ds_bpermute(pa, (int)a), p1 = (unsigned)__builtin_amdgcn_ds_bpermute(pa, (int)b);
                                  si[k][0] = tm0 ? (a < p0 ? a : p0) : (a < p0 ? p0 : a); si[k][1] = tm1 ? (b < p1 ? b : p1) : (b < p1 ? p1 : b); } }
                          __builtin_amdgcn_sched_barrier(0);
                      } }
#pragma unroll
                  for (int k = 0; k < TW; ++k) {
#pragma unroll
                      for (int r = 0; r < 2; ++r) { const unsigned key = si[k][r];
                          const unsigned ix = key >> 16; si[k][r] = ix * ROWB;     sus[k][r] = usl[ix]; sgv[k][r] = __uint_as_float(key << 16) * vsl[ix]; } }
                  { int so_[8];
#pragma unroll
                    for (int j_ = 0; j_ < 8; ++j_) so_[j_] = __builtin_amdgcn_readlane((int)si[0][0], j_);
#pragma unroll
                    for (int j_ = 0; j_ < 8; ++j_) ba[j_] = __builtin_amdgcn_raw_buffer_load_b96(ru, voff, so_[j_], 0); }
#pragma unroll
                  for (int k = 0; k < TW; ++k) {
                      const int t_ = TOK(k); const bf16* hr = XB2 + (size_t)t_ * D + lane_s * 4; const uint2 a0 = ntld2(hr), a1 = ntld2(hr + 256), a2 = ntld2(hr + 512), a3 = ntld2(hr + 768);
                      const float rs_ = rsqrtf((float)SSQ[(size_t)l * T + t_] * (1.f / (1048576.f * D)) + NORM_EPS); const float* shp = modl + (size_t)(t_ / SEQ) * 6 * D + 3 * D + lane_s * 4;
                      const unsigned aw[8] = {a0.x, a0.y, a1.x, a1.y, a2.x, a2.y, a3.x, a3.y}; unsigned ow[8];
#pragma unroll
                      for (int q = 0; q < 4; ++q) { const f32x4 s4 = *(const f32x4*)(shp + q * 256);
                          ow[2 * q] = pk2(__uint_as_float(aw[2 * q] << 16) * rs_ + s4.x, __uint_as_float(aw[2 * q] & 0xffff0000u) * rs_ + s4.y);
                          ow[2 * q + 1] = pk2(__uint_as_float(aw[2 * q + 1] << 16) * rs_ + s4.z, __uint_as_float(aw[2 * q + 1] & 0xffff0000u) * rs_ + s4.w); }
                      hl[(k * 2) * 64 + lane_s] = (u32x4){ow[0], ow[1], ow[2], ow[3]}; hl[(k * 2 + 1) * 64 + lane_s] = (u32x4){ow[4], ow[5], ow[6], ow[7]}; }
                }
                __builtin_amdgcn_sched_barrier(0);
#define ROWLD(dst, rs, ixv, ln) dst = __builtin_amdgcn_raw_buffer_load_b96(rs, voff, __builtin_amdgcn_readlane((int)(ixv), (ln)), 0)
#define LOADQO(buf, rs, ixv, ln0, vo) do { __builtin_amdgcn_s_setprio(2); int so_[8]; _Pragma("unroll") for (int j_ = 0; j_ < 8; ++j_) so_[j_] = __builtin_amdgcn_readlane((int)(ixv), (ln0) + j_);     \
                        _Pragma("unroll") for (int j_ = 0; j_ < 8; ++j_) (buf)[j_] = __builtin_amdgcn_raw_buffer_load_b96(rs, vo, so_[j_], 0); __builtin_amdgcn_s_setprio(0); __builtin_amdgcn_sched_barrier(0); } while (0)
#define LOADQ(buf, rs, ixv, ln0) LOADQO(buf, rs, ixv, ln0, voff)
#define LOADV(buf, ixv, ln0) do { __builtin_amdgcn_s_setprio(2); int so_[8]; _Pragma("unroll") for (int j_ = 0; j_ < 8; ++j_) so_[j_] = __builtin_amdgcn_readlane((int)(ixv), (ln0) + j_); \
                        _Pragma("unroll") for (int j_ = 0; j_ < 8; ++j_) (buf)[j_] = __builtin_amdgcn_raw_buffer_load_b64(rv, voff8, so_[j_], 0); __builtin_amdgcn_s_setprio(0); __builtin_amdgcn_sched_barrier(0); } while (0)
#define CVT2(a, b) const f32x32_t f_ = __builtin_amdgcn_cvt_scalef32_pk32_f32_fp6((u32x6_t){(a).x, (a).y, (a).z, (b).x, (b).y, (b).z}, 1.0f)
#define PR(i) __builtin_shufflevector(f_, f_, 2 * (i), 2 * (i) + 1)
#define DOTQ(buf, e0) do { _Pragma("unroll") for (int j_ = 0; j_ < 8; j_ += 2) { \
                        const u32x16_t g_ = __builtin_bit_cast(u32x16_t, __builtin_amdgcn_cvt_scalef32_pk32_bf16_fp6((u32x6_t){(buf)[j_].x, (buf)[j_].y, (buf)[j_].z, (buf)[j_ + 1].x, (buf)[j_ + 1].y, (buf)[j_ + 1].z}, 1.0f));     \
                        float a0_ = 0.f, b0_ = 0.f; \
                        _Pragma("unroll") for (int i_ = 0; i_ < 8; ++i_) { a0_ = DOT2(g_[i_], hpk[i_], a0_); b0_ = DOT2(g_[8 + i_], hpk[i_], b0_); } \
                        pl[((e0) + j_) * 68 + lane_u] = a0_; pl[((e0) + j_ + 1) * 68 + lane_u] = b0_; __builtin_amdgcn_sched_barrier(0); } } while (0)
#define DOT2(x_, y_, c_) __builtin_amdgcn_fdot2_f32_bf16(__builtin_bit_cast(bf16x2_t, (unsigned)(x_)), __builtin_bit_cast(bf16x2_t, (unsigned)(y_)), (c_), false)
#define F4(w_, b_) __builtin_amdgcn_cvt_scalef32_pk_f32_fp4((w_), 1.0f, (b_))
#define AXPYQ(buf, k, cfv, ln0) do { _Pragma("unroll") for (int j_ = 0; j_ < 8; ++j_) { \
                        const float ca = __int_as_float(__builtin_amdgcn_readlane(__float_as_int(cfv), (ln0) + j_)); const unsigned w0_ = (buf)[j_].x, w1_ = (buf)[j_].y; \
                        acc2[k][0] += ca * F4(w0_, 0); acc2[k][1] += ca * F4(w0_, 1); acc2[k][2] += ca * F4(w0_, 2); acc2[k][3] += ca * F4(w0_, 3); acc2[k][4] += ca * F4(w1_, 0); acc2[k][5] += ca * F4(w1_, 1); acc2[k][6] += ca * F4(w1_, 2); acc2[k][7] += ca * F4(w1_, 3); \
                        if (j_ & 1) __builtin_amdgcn_sched_barrier(0); } } while (0)
#pragma unroll 1
                for (int c = 0; c < 16; ++c) {
                    const int lb = (c & 7) * 8; const bool r1 = c >= 8;
#pragma unroll
                    for (int k = 0; k < TW; ++k) {
                        unsigned hpk[8];
                        { const u32x4 h0 = hl[(k * 2) * 64 + lane_u], h1 = hl[(k * 2 + 1) * 64 + lane_u]; hpk[0] = h0.x; hpk[1] = h0.y; hpk[2] = h0.z; hpk[3] = h0.w; hpk[4] = h1.x; hpk[5] = h1.y; hpk[6] = h1.z; hpk[7] = h1.w; }
                        if (k & 1) { if (k < TW - 1) LOADQ(ba, ru, r1 ? si[k + 1][1] : si[k + 1][0], lb); else { const int cn = (c + 1) & 15; const __amdgpu_buffer_rsrc_t rn = c < 15 ? ru : rv; const int von = c < 15 ? voff : voff8; LOADQO(ba, rn, (cn >= 8) ? si[0][1] : si[0][0], (cn & 7) * 8, von); } DOTQ(bb_, k * 8); }
                        else { LOADQ(bb_, ru, r1 ? si[k + 1][1] : si[k + 1][0], lb); DOTQ(ba, k * 8); }
                    }
                    __builtin_amdgcn_wave_barrier(); asm volatile("s_waitcnt lgkmcnt(0)" ::: "memory");
                    float dsum;
                    { const LAS float* rp = pl + (lane_u & 31) * 68 + (lane_u >> 5) * 32; f32x4 s4 = *(const LAS f32x4*)rp;
#pragma unroll
                      for (int j = 1; j < 8; ++j) s4 += *(const LAS f32x4*)(rp + j * 4);
                      dsum = (s4.x + s4.y) + (s4.z + s4.w); }
                    dsum += shflx(dsum, lane_u, 32);
                    __builtin_amdgcn_wave_barrier(); asm volatile("s_waitcnt lgkmcnt(0)" ::: "memory");
                    const bool home = (lane_u >> 3) == (c & 7);
                    const int srcl = (lb + (lane_u & 7)) << 2, kl_ = (lane_u >> 3) & 3;
                    float suL = 0.f, sgL = 0.f;
#pragma unroll
                    for (int k = 0; k < TW; ++k) { const float a_ = __int_as_float(__builtin_amdgcn_ds_bpermute(srcl, __float_as_int(r1 ? sus[k][1] : sus[k][0]))), g_ = __int_as_float(__builtin_amdgcn_ds_bpermute(srcl, __float_as_int(r1 ? sgv[k][1] : sgv[k][0])));
                        suL = kl_ == k ? a_ : suL; sgL = kl_ == k ? g_ : sgL; }
                    const float cfL = sgL * gelu_erf(dsum * suL);
#pragma unroll
                    for (int k = 0; k < TW; ++k) { const float cf = __int_as_float(__builtin_amdgcn_ds_bpermute((k * 8 + (lane_u & 7)) << 2, __float_as_int(cfL)));
                        if (r1) sgv[k][1] = home ? cf : sgv[k][1]; else sgv[k][0] = home ? cf : sgv[k][0]; }
                    __builtin_amdgcn_sched_barrier(0);
                }
                f32x2_t acc2[TW][8];
#pragma unroll
                for (int k = 0; k < TW; ++k) {
#pragma unroll
                    for (int i = 0; i < 8; ++i) acc2[k][i] = (f32x2_t){0.f, 0.f}; }
                u32x2_t va[8], vb[8];
#pragma unroll
                for (int j = 0; j < 8; ++j) va[j] = (u32x2_t){ba[j].x, ba[j].y};
#pragma unroll 1
                for (int c = 0; c < 16; ++c) {
                    const int lb = (c & 7) * 8; const bool r1 = c >= 8;
#pragma unroll
                    for (int k = 0; k < TW; ++k) {
                        const float cfk = r1 ? sgv[k][1] : sgv[k][0];
                        if (k & 1) { if (k < TW - 1) LOADV(va, r1 ? si[k + 1][1] : si[k + 1][0], lb); else { const int cn = (c + 1) & 15; LOADV(va, (cn >= 8) ? si[0][1] : si[0][0], (cn & 7) * 8); }     AXPYQ(vb, k, cfk, lb); }
                        else { LOADV(vb, r1 ? si[k + 1][1] : si[k + 1][0], lb); AXPYQ(va, k, cfk, lb); }
                    }
                }
#undef ROWLD
#undef LOADQ
#undef LOADQO
#undef LOADV
#undef F4
#undef CVT2
#undef PR
#undef DOTQ
#undef DOT2
#undef AXPYQ
                { int ln; asm volatile("v_mbcnt_lo_u32_b32 %0, -1, 0\n\tv_mbcnt_hi_u32_b32 %0, -1, %0" : "=v"(ln));
                  LAS f32x4* al = (LAS f32x4*)pl + ln;
#pragma unroll
                  for (int k = 0; k < TW; ++k) {
#pragma unroll
                      for (int q = 0; q < 4; ++q) al[(k * 4 + q) * 64] = (f32x4){acc2[k][q * 2].x, acc2[k][q * 2].y, acc2[k][q * 2 + 1].x, acc2[k][q * 2 + 1].y}; }
                  asm volatile("s_waitcnt lgkmcnt(0)" ::: "memory"); __builtin_amdgcn_sched_barrier(0);
                  f32x4 xv[TW][4], gq[TW][4]; float rs[TW];
#pragma unroll
                  for (int k = 0; k < TW; ++k) { const int t = TOK(k), b = t / SEQ; const bf16* xr = XBF + (size_t)t * D + ln * 4; const float* g2 = modl + (size_t)b * 6 * D + 5 * D + ln * 4;
#pragma unroll
                      for (int q = 0; q < 4; ++q) { const uint2 xw_ = ntld2(xr + q * 256); xv[k][q] = (f32x4){__uint_as_float(xw_.x << 16), __uint_as_float(xw_.x & 0xffff0000u), __uint_as_float(xw_.y << 16), __uint_as_float(xw_.y & 0xffff0000u)}; gq[k][q] = *(const f32x4*)(g2 + q * 256); } }
                  f32x4 wl[4];
#pragma unroll
                  for (int q = 0; q < 4; ++q) wl[q] = *(const f32x4*)((fin ? lnf : INP(4) + (l + 1) * D) + ln * 4 + q * 256);
                  __builtin_amdgcn_sched_barrier(0);
#pragma unroll
                  for (int k = 0; k < TW; ++k) { float ss = 0.f;
#pragma unroll
                      for (int q = 0; q < 4; ++q) { xv[k][q] = xv[k][q] + gq[k][q] * al[(k * 4 + q) * 64]; ss += (xv[k][q].x * xv[k][q].x + xv[k][q].y * xv[k][q].y) + (xv[k][q].z * xv[k][q].z + xv[k][q].w * xv[k][q].w); }
                      rs[k] = rsqrtf(wave_sum(ss, ln) * (1.f / D) + NORM_EPS); }
                  __builtin_amdgcn_sched_barrier(0);
                  if (fin) {
#pragma unroll
                      for (int k = 0; k < TW; ++k) { if (TOKV(k)) { float* xr = X + (size_t)(tb + k * NGW) * D + ln * 4;
#pragma unroll
                          for (int q = 0; q < 4; ++q) *(f32x4*)(xr + q * 256) = xv[k][q] * rs[k] * wl[q]; } } }
                  else {
#pragma unroll
                      for (int k = 0; k < TW; ++k) { if (TOKV(k)) { bf16* xr = XBF + (size_t)(tb + k * NGW) * D + ln * 4;
#pragma unroll
                          for (int q = 0; q < 4; ++q) { uint2 xs_; xs_.x = pk2(xv[k][q].x, xv[k][q].y); xs_.y = pk2(xv[k][q].z, xv[k][q].w); *(uint2*)(xr + q * 256) = xs_; } } }
#pragma unroll
                      for (int kp = 0; kp < TW; kp += 2) { f32x4 sc_[2][4], sh_[2][4];
#pragma unroll
                          for (int j = 0; j < 2; ++j) { const int b = TOK(kp + j) / SEQ; const float* mn = MOD + (size_t)(l + 1) * BATCH * 6 * D + (size_t)b * 6 * D + ln * 4;
#pragma unroll
                              for (int q = 0; q < 4; ++q) { sc_[j][q] = *(const f32x4*)(mn + D + q * 256); sh_[j][q] = *(const f32x4*)(mn + q * 256); } }
#pragma unroll
                          for (int j = 0; j < 2; ++j) { const int k = kp + j; if (TOKV(k)) { const int t = tb + k * NGW;
#pragma unroll
                              for (int q = 0; q < 4; ++q) { const f32x4 y = xv[k][q] * rs[k] * wl[q] * (sc_[j][q] + 1.f) + sh_[j][q];
                                  uint2 ho; ho.x = pk2(y.x, y.y); ho.y = pk2(y.z, y.w); *(uint2*)(H + (size_t)t * D + q * 256 + ln * 4) = ho; } } } } }
                  asm volatile("s_waitcnt lgkmcnt(0)" ::: "memory"); __builtin_amdgcn_wave_barrier();
                }
#undef TOK
#undef TOKV
            }
        }
    }
#undef modl
#undef xin
#undef IN
#undef SEAM
}
#undef MOD
#undef H
#undef PROJ
#undef Q
#undef MIX
#undef Rb
#undef RKp
#undef KKBp
#undef GBGp
#undef Kb
#undef V0
#undef V1
#undef KKb
#undef Bb
#undef Gb
#undef BGb
#undef Wd
#undef Y
#undef IDX
#undef GATE
#undef WinT
#undef WoutT
#undef PqT
#undef KEYS
#undef QB
#undef POOLIN
#undef SH
#undef SSQ
#undef CVEC
#undef S2V
#undef XB2
#undef XBF
#undef WUPT
#undef AUPT
#undef GUPT
#undef VUPT
#undef PWT
#undef INVN
#undef BSUM
#undef SCN
#undef U8
#undef V8
#undef USc
#undef VSc
#undef INP
#undef PHASE_IDS

extern "C" void kernel_launch(void* const* d_in, const int* in_sizes, int n_in, void* d_out, int out_size, void* d_ws, size_t ws_size, hipStream_t stream) {
    if (n_in != 30 || ws_size < WS_END) { fprintf(stderr, "kernel_launch: unexpected n_in %d / ws_size %zu\n", n_in, ws_size); return; }
    static int grid = 0;
    if (grid == 0) {
        int dev = 0, cus = 0, per_cu = 0;
        (void)hipGetDevice(&dev); (void)hipDeviceGetAttribute(&cus, hipDeviceAttributeMultiprocessorCount, dev);
        if (hipFuncSetAttribute((const void*)mega, hipFuncAttributeMaxDynamicSharedMemorySize, LDS_BYTES) != hipSuccess) { fprintf(stderr, "hipFuncSetAttribute failed\n"); grid = -1; return; }
        if (hipOccupancyMaxActiveBlocksPerMultiprocessor(&per_cu, (const void*)mega, NTHR, LDS_BYTES) != hipSuccess || per_cu < 1) { fprintf(stderr, "occupancy query failed (%d)\n", per_cu); per_cu = 1; }
        (void)hipGetLastError();
        grid = (cus > 0 ? cus : 256) * 1;
    }
    if (grid < 0) return;
    Args a{}; for (int i = 0; i < 30; ++i) a.in[i] = (const float*)d_in[i]; a.out = (float*)d_out; a.ws = (unsigned char*)d_ws;
    a.ph_lo = 0; a.ph_hi = NPH;
    if (hipMemsetAsync(d_ws, 0, 65536, stream) != hipSuccess) { fprintf(stderr, "memset failed\n"); return; }
    void* kargs[] = {&a};
    hipError_t e = hipLaunchCooperativeKernel((const void*)mega, dim3(grid), dim3(NTHR), kargs, LDS_BYTES, stream);
    if (e != hipSuccess) fprintf(stderr, "cooperative launch failed: %s (grid %d)\n", hipGetErrorString(e), grid);
}
```
